# Optimizing an MI355X kernel written in HIP

```python
import jax, jax.numpy as jnp
from jax import lax
import numpy as np

D_MODEL = 1024
BATCH = 16
SEQ = 4096
DEPTH = 1

N_META = 16
HEAD_DIM = 64
FOX_HEADS = 8
FOX_WIDTH = FOX_HEADS * HEAD_DIM
RWKV_HEADS = 8
RWKV_WIDTH = RWKV_HEADS * HEAD_DIM
DECAY_LORA = 64
AAA_LORA = 64
GATE_LORA = 160
ATTN_BLOCK = 128
PEER_HEADS = 8
PEER_QDIM = 256
N_KEYS = 128
N_EXPERTS = N_KEYS * N_KEYS
PEER_TOPK = 16
PEER_CHUNK = 128
NORM_EPS = 1e-6
RWKV_GN_EPS = 64e-5
MASK_VALUE = -1e30

FOX_COLS = 3 * FOX_WIDTH + FOX_HEADS
RWKV_COLS = 3 * RWKV_WIDTH + DECAY_LORA + AAA_LORA + GATE_LORA
GATE_COLS = 2 * D_MODEL
IN_COLS = FOX_COLS + RWKV_COLS + GATE_COLS

kernel_name = 'fox_rwkv7_peer_hybrid_block'


def _split(z, sizes):
    idx = np.cumsum(sizes)[:-1].tolist()
    return jnp.split(z, idx, axis=-1)


def rmsnorm(x, g):
    xf = x.astype(jnp.float32)
    y = xf * lax.rsqrt(jnp.mean(xf * xf, axis=-1, keepdims=True) + NORM_EPS)
    return (y * g.astype(jnp.float32)).astype(x.dtype)


def fox_attention(q, k, v, log_f):
    B, T, H, Dh = q.shape
    pad = (-T) % ATTN_BLOCK
    L = T + pad
    nb = L // ATTN_BLOCK
    pad4 = ((0, 0), (pad, 0), (0, 0), (0, 0))
    qp = jnp.pad(q, pad4)
    k32 = jnp.pad(k, pad4).astype(jnp.float32)
    vp = jnp.pad(v, pad4)
    c = jnp.cumsum(jnp.pad(log_f, ((0, 0), (pad, 0), (0, 0))), axis=1)
    c_k = jnp.transpose(c, (0, 2, 1))
    kpos = jnp.arange(L)
    k_valid = kpos >= pad
    q_blocks = jnp.moveaxis(qp.reshape(B, nb, ATTN_BLOCK, H, Dh), 1, 0)
    c_blocks = jnp.moveaxis(c.reshape(B, nb, ATTN_BLOCK, H), 1, 0)
    scale = Dh ** -0.5

    def one_block(args):
        i, q_i, c_i = args
        s = jnp.einsum('bqhd,bkhd->bhqk', q_i.astype(jnp.float32), k32) * scale
        s = s + jnp.transpose(c_i, (0, 2, 1))[..., :, None] - c_k[:, :, None, :]
        qpos = i * ATTN_BLOCK + jnp.arange(ATTN_BLOCK)
        mask = (kpos[None, :] <= qpos[:, None]) & k_valid[None, :]
        p = jax.nn.softmax(jnp.where(mask, s, MASK_VALUE), axis=-1)
        return jnp.einsum('bhqk,bkhd->bqhd', p.astype(vp.dtype), vp)

    o = lax.map(one_block, (jnp.arange(nb), q_blocks, c_blocks))
    o = jnp.moveaxis(o, 0, 1).reshape(B, L, H, Dh)
    return o[:, pad:]


def rwkv7_time_mix(z, mu, w0, w_up, a0, a_up, g_up, k_k, k_a, r_k, ln_g, ln_b):
    B, T, _ = z.shape
    f32 = jnp.float32
    z_prev = jnp.pad(z, ((0, 0), (1, 0), (0, 0)))[:, :-1]
    z = z + mu * (z_prev - z)
    r, k, v, wd, ad, gd = _split(z, [RWKV_WIDTH] * 3 + [DECAY_LORA, AAA_LORA, GATE_LORA])
    w = -jax.nn.softplus(-(w0 + jnp.tanh(wd) @ w_up)) - 0.5
    decay = jnp.exp(-jnp.exp(w.astype(f32)))
    a = jax.nn.sigmoid(a0 + ad @ a_up)
    g = jax.nn.sigmoid(gd) @ g_up
    kk = k * k_k
    k = k * (1.0 + (a - 1.0) * k_a)

    def heads(t):
        return t.reshape(B, T, RWKV_HEADS, HEAD_DIM).astype(f32)

    r, k, v, decay, a, kk = (heads(t) for t in (r, k, v, decay, a, kk))
    kk = kk / jnp.maximum(jnp.sqrt(jnp.sum(kk * kk, axis=-1, keepdims=True)), 1e-12)

    def step(S, inp):
        r_t, w_t, k_t, v_t, kk_t, a_t = inp
        sa = jnp.einsum('bhvk,bhk->bhv', S, -kk_t)
        S = (S * w_t[:, :, None, :] + sa[..., None] * (kk_t * a_t)[:, :, None, :]
             + v_t[..., None] * k_t[:, :, None, :])
        return S, jnp.einsum('bhvk,bhk->bhv', S, r_t)

    xs = tuple(jnp.moveaxis(t, 1, 0) for t in (r, decay, k, v, kk, a))
    S0 = jnp.zeros((B, RWKV_HEADS, HEAD_DIM, HEAD_DIM), f32)
    _, y = lax.scan(step, S0, xs)
    y = jnp.moveaxis(y, 0, 1)
    mean = jnp.mean(y, axis=-1, keepdims=True)
    var = jnp.mean(jnp.square(y - mean), axis=-1, keepdims=True)
    y = (y - mean) * lax.rsqrt(var + RWKV_GN_EPS)
    y = y.reshape(B, T, RWKV_WIDTH) * ln_g + ln_b
    bonus = (jnp.sum(r * k * r_k, axis=-1, keepdims=True) * v).reshape(B, T, RWKV_WIDTH)
    return ((y + bonus) * g).astype(z.dtype)


def peer_ffn(xn, w_q, sub_k1, sub_k2, u, v):
    B, T, D = xn.shape
    xc = xn.reshape(-1, PEER_CHUNK, D)
    half = PEER_QDIM // 2

    def one_chunk(x_c):
        q = (x_c @ w_q).reshape(PEER_CHUNK, PEER_HEADS, PEER_QDIM)
        s1 = jnp.einsum('chd,nd->chn', q[..., :half], sub_k1).astype(jnp.float32)
        s2 = jnp.einsum('chd,nd->chn', q[..., half:], sub_k2).astype(jnp.float32)
        t1, i1 = lax.top_k(s1, PEER_TOPK)
        t2, i2 = lax.top_k(s2, PEER_TOPK)
        cand_s = (t1[..., :, None] + t2[..., None, :]).reshape(PEER_CHUNK, PEER_HEADS, PEER_TOPK ** 2)
        cand_i = (i1[..., :, None] * N_KEYS + i2[..., None, :]).reshape(PEER_CHUNK, PEER_HEADS, PEER_TOPK ** 2)
        top_s, pos = lax.top_k(cand_s, PEER_TOPK)
        ids = jnp.take_along_axis(cand_i, pos, axis=-1)
        gate = jax.nn.softmax(top_s, axis=-1)
        hid = jax.nn.gelu(jnp.einsum('chkd,cd->chk', u[ids], x_c).astype(jnp.float32), approximate=False)
        return jnp.einsum('chk,chkd->cd', (gate * hid).astype(v.dtype), v[ids])

    return lax.map(one_chunk, xc).reshape(B, T, D)


def setup_inputs(seed: int = 0) -> dict:
    key = jax.random.key(seed)
    ks = iter(jax.random.split(key, 32))
    L = DEPTH

    def nrm(shape, scale):
        return scale * jax.random.normal(next(ks), shape, jnp.float32)

    def uni(shape, lo, hi):
        return jax.random.uniform(next(ks), shape, jnp.float32, lo, hi)

    return {
        'x': nrm((BATCH, SEQ, D_MODEL), 1.0),
        'meta_tokens': nrm((N_META, D_MODEL), 1.0),
        'norm1_g': 1.0 + nrm((L, D_MODEL), 0.02),
        'w_in': nrm((L, D_MODEL, IN_COLS), D_MODEL ** -0.5),
        'fox_q_norm': 1.0 + nrm((L, FOX_HEADS, HEAD_DIM), 0.02),
        'fox_k_norm': 1.0 + nrm((L, FOX_HEADS, HEAD_DIM), 0.02),
        'fox_f_bias': 4.0 + nrm((L, FOX_HEADS), 0.5),
        'rwkv_mu': uni((L, RWKV_COLS), 0.0, 1.0),
        'rwkv_w0': uni((L, RWKV_WIDTH), -6.0, -1.0),
        'rwkv_w_up': nrm((L, DECAY_LORA, RWKV_WIDTH), 0.1),
        'rwkv_a0': nrm((L, RWKV_WIDTH), 0.1),
        'rwkv_a_up': nrm((L, AAA_LORA, RWKV_WIDTH), 0.5 * AAA_LORA ** -0.5),
        'rwkv_g_up': nrm((L, GATE_LORA, RWKV_WIDTH), GATE_LORA ** -0.5),
        'rwkv_k_k': 0.85 + nrm((L, RWKV_WIDTH), 0.05),
        'rwkv_k_a': 1.0 + nrm((L, RWKV_WIDTH), 0.05),
        'rwkv_r_k': nrm((L, RWKV_HEADS, HEAD_DIM), 0.1),
        'rwkv_ln_g': 1.0 + nrm((L, RWKV_WIDTH), 0.02),
        'rwkv_ln_b': nrm((L, RWKV_WIDTH), 0.02),
        'w_branch_fox': nrm((L, FOX_WIDTH, D_MODEL), FOX_WIDTH ** -0.5),
        'w_branch_rwkv': nrm((L, RWKV_WIDTH, D_MODEL), RWKV_WIDTH ** -0.5),
        'w_out': nrm((L, D_MODEL, D_MODEL), D_MODEL ** -0.5),
        'norm2_g': 1.0 + nrm((L, D_MODEL), 0.02),
        'peer_w_q': nrm((L, D_MODEL, PEER_HEADS * PEER_QDIM), D_MODEL ** -0.5),
        'peer_sub_k1': nrm((L, N_KEYS, PEER_QDIM // 2), (PEER_QDIM // 2) ** -0.5),
        'peer_sub_k2': nrm((L, N_KEYS, PEER_QDIM // 2), (PEER_QDIM // 2) ** -0.5),
        'peer_u': nrm((L, N_EXPERTS, D_MODEL), D_MODEL ** -0.5),
        'peer_v': nrm((L, N_EXPERTS, D_MODEL), 0.5),
    }


def reference(x, meta_tokens, norm1_g, w_in, fox_q_norm, fox_k_norm, fox_f_bias,
              rwkv_mu, rwkv_w0, rwkv_w_up, rwkv_a0, rwkv_a_up, rwkv_g_up, rwkv_k_k,
              rwkv_k_a, rwkv_r_k, rwkv_ln_g, rwkv_ln_b, w_branch_fox, w_branch_rwkv,
              w_out, norm2_g, peer_w_q, peer_sub_k1, peer_sub_k2, peer_u, peer_v):
    B = x.shape[0]
    meta = jnp.broadcast_to(meta_tokens[None].astype(x.dtype), (B, N_META, D_MODEL))
    h = jnp.concatenate([meta, x], axis=1)
    for l in range(DEPTH):
        T = h.shape[1]
        xn = rmsnorm(h, norm1_g[l])
        z = xn @ w_in[l]
        z_fox, z_rwkv, z_gate = _split(z, [FOX_COLS, RWKV_COLS, GATE_COLS])
        fq, fk, fv, f_logit = _split(z_fox, [FOX_WIDTH] * 3 + [FOX_HEADS])
        fq = rmsnorm(fq.reshape(B, T, FOX_HEADS, HEAD_DIM), fox_q_norm[l])
        fk = rmsnorm(fk.reshape(B, T, FOX_HEADS, HEAD_DIM), fox_k_norm[l])
        fv = fv.reshape(B, T, FOX_HEADS, HEAD_DIM)
        log_f = jax.nn.log_sigmoid((f_logit + fox_f_bias[l]).astype(jnp.float32))
        y_fox = fox_attention(fq, fk, fv, log_f).reshape(B, T, FOX_WIDTH)
        y_rwkv = rwkv7_time_mix(z_rwkv, rwkv_mu[l], rwkv_w0[l], rwkv_w_up[l], rwkv_a0[l],
                                rwkv_a_up[l], rwkv_g_up[l], rwkv_k_k[l], rwkv_k_a[l],
                                rwkv_r_k[l], rwkv_ln_g[l], rwkv_ln_b[l])
        gate_fox, gate_rwkv = jnp.split(jax.nn.sigmoid(z_gate), 2, axis=-1)
        mixed = gate_fox * (y_fox @ w_branch_fox[l]) + gate_rwkv * (y_rwkv @ w_branch_rwkv[l])
        h = h + mixed @ w_out[l]
        if l == DEPTH - 1:
            h = h[:, N_META:]
        h = h + peer_ffn(rmsnorm(h, norm2_g[l]), peer_w_q[l], peer_sub_k1[l],
                         peer_sub_k2[l], peer_u[l], peer_v[l])
    return h
```

```cpp
#include <hip/hip_runtime.h>
#include <hip/hip_cooperative_groups.h>
#include <hip/hip_bf16.h>
#include <cstdio>
#include <cstdint>
#include <cmath>
namespace cg = cooperative_groups;
#ifndef DIAG
#define DIAG 0
#endif
namespace pg8 {
#define PG8_LAS __attribute__((address_space(3)))
typedef unsigned short bf16_t;
typedef short bf16x8 __attribute__((ext_vector_type(8)));
typedef float f32x4 __attribute__((ext_vector_type(4)));
typedef unsigned u32x4 __attribute__((ext_vector_type(4)));
constexpr int BM = 256, BK = 64, HALF = 128, HTB = HALF * BK * 2  , STAGE_BYTES = 8 * HTB, NXCD = 8, WGM = 8;

__host__ __device__ __forceinline__ int lds_byte(int r, int c) { const int st = (r >> 4) * 2 + (c >> 5), rr = r & 15, cc = c & 31, ob = rr * 64 + cc * 2; return st * 1024 + (ob ^ (((ob >> 9) & 1) << 5)); }
__host__ __device__ __forceinline__ void stage_rc(int b, int& R, int& C) { const int st = b / 1024, sb = b % 1024, swz = sb ^ (((sb >> 9) & 1) << 5); R = (st >> 1) * 16 + swz / 64; C = (st & 1) * 32 + (swz % 64) / 2; }
__host__ __device__ __forceinline__ int perm32(int rho) { const int n = rho >> 4, i = rho & 15; return 8 * (i >> 2) + 4 * n + (i & 3); }

struct Unit { int pm, pn; };
struct Gemm { const bf16_t* A; const bf16_t* Bt; int M, N, K; };

struct StaticOrder {
    int nM, nN, nwg, G, c;
    __host__ __device__ void init(int M, int N, int G_, int c_) { nM = M / BM; nN = N / BM; nwg = nM * nN; G = G_; c = c_; }
    __host__ __device__ bool next(int i, Unit& u) const {
        const int L = i * G + c; if (L >= nwg) return false;
        int wgid = (int)L; { const int q = nwg / NXCD, r = nwg % NXCD, xcd = wgid % NXCD, off = wgid / NXCD; wgid = (xcd < r ? xcd * (q + 1) : r * (q + 1) + (xcd - r) * q) + off; }
        const int nig = WGM * nN, gid = wgid / nig, fm = gid * WGM, gsz = (nM - fm) < WGM ? (nM - fm) : WGM;
        u.pm = fm + ((wgid % nig) % gsz); u.pn = (wgid % nig) / gsz; return true;
    }
    __device__ __forceinline__ void a_ready(const Unit&) const {}
    __device__ __forceinline__ void done(const Unit&) const {}
};

__device__ __forceinline__ unsigned cvt_pk_bf16(float lo, float hi) { unsigned r; asm volatile("v_cvt_pk_bf16_f32 %0, %1, %2" : "=v"(r) : "v"(lo), "v"(hi)); return r; }
typedef float f32x2 __attribute__((ext_vector_type(2)));
template <class Epi, class Sched, bool ALIGN_EPI = false, bool SP2 = false>
__device__ __forceinline__ void gemm_phase(PG8_LAS unsigned char* lds, const Gemm g, const Sched& S, const Epi& E) {
    int tid_ = threadIdx.x; asm volatile("" : "+v"(tid_));
    const int tid = tid_, wid = __builtin_amdgcn_readfirstlane(tid >> 6), lane = tid & 63, wr = wid >> 2, wc = wid & 3, fr = lane & 15, fq = lane >> 4;
    const int K = g.K, nt = K / BK;
    unsigned voffA[2], voffB[2];
#pragma unroll
    for (int i = 0; i < 2; ++i) { int R, C; stage_rc(tid * 16 + i * 8192, R, C); const int Rb = Epi::PERM ? ((R & ~31) + perm32(R & 31)) : R;
        voffA[i] = (unsigned)(R * K + C) * 2u; voffB[i] = (unsigned)(Rb * K + C) * 2u; }
    const size_t kstep = (size_t)(BK * 2);
    const size_t hstep = (size_t)HALF * K * 2;
    const size_t tstep = 2 * hstep;
    const unsigned ldsw = (unsigned)wid * 1024u;
    const int aoff = lds_byte(wr * 64 + fr, fq * 8), boff = lds_byte(wc * 32 + fr, fq * 8);
#define PG8_SA(b, h) (((b) * 2 + (h)) * HTB)
#define PG8_SB(b, h) ((4 + (b) * 2 + (h)) * HTB)
#define PG8_STAGE(bufoff, gbase, voff) do { _Pragma("unroll") for (int _i = 0; _i < 2; ++_i) \
        __builtin_amdgcn_global_load_lds((const unsigned*)((const char*)(gbase) + (voff)[_i]), (PG8_LAS unsigned*)(lds + (bufoff) + ldsw + _i * 8192), 16, 0, 0); } while (0)
#define PG8_LDA(dst, b, h) do { _Pragma("unroll") for (int m = 0; m < 4; ++m) _Pragma("unroll") for (int k = 0; k < 2; ++k) dst[m][k] = *(const PG8_LAS bf16x8*)(lds + PG8_SA(b, h) + aoff + m * 2048 + k * 1024); } while (0)
#define PG8_LDB(dst, b, h) do { _Pragma("unroll") for (int n = 0; n < 2; ++n) _Pragma("unroll") for (int k = 0; k < 2; ++k) dst[n][k] = *(const PG8_LAS bf16x8*)(lds + PG8_SB(b, h) + boff + n * 2048 + k * 1024); } while (0)
#define PG8_MMA(ai, bj, At, Bt) do { __builtin_amdgcn_s_setprio(1); _Pragma("unroll") for (int m = 0; m < 4; ++m) _Pragma("unroll") for (int n = 0; n < 2; ++n) _Pragma("unroll") for (int k = 0; k < 2; ++k) \
        acc[ai][bj][m][n] = __builtin_amdgcn_mfma_f32_16x16x32_bf16(Bt[n][k], At[m][k], acc[ai][bj][m][n], 0, 0, 0); __builtin_amdgcn_s_setprio(0); } while (0)
#define PG8_WAIT_V(n) asm volatile("s_waitcnt vmcnt(" #n ")" ::: "memory")
#define PG8_WAIT_L(n) asm volatile("s_waitcnt lgkmcnt(" #n ")" ::: "memory")
#define PG8_BAR __builtin_amdgcn_s_barrier()
#define PG8_SCHED __builtin_amdgcn_sched_barrier(0)
    Unit cur, nxt; int ui = 0;
    if (!S.next(0, cur)) return;
    f32x4 acc[2][2][4][2];
#pragma unroll
    for (int a = 0; a < 2; ++a)
#pragma unroll
        for (int b = 0; b < 2; ++b)
#pragma unroll
            for (int m = 0; m < 4; ++m)
#pragma unroll
                for (int n = 0; n < 2; ++n) acc[a][b][m][n] = (f32x4){0.f, 0.f, 0.f, 0.f};
    bf16x8 At[4][2], B0[2][2], B1[2][2];
    const char* cA = (const char*)g.A + (size_t)cur.pm * tstep; const char* cB = (const char*)g.Bt + (size_t)cur.pn * tstep;
    S.a_ready(cur);
    if constexpr (SP2) {
        PG8_STAGE(PG8_SB(0, 0), cB, voffB); PG8_STAGE(PG8_SB(0, 1), cB + hstep, voffB); PG8_STAGE(PG8_SA(0, 0), cA, voffA); PG8_STAGE(PG8_SA(0, 1), cA + hstep, voffA);
        if (wr == 1) PG8_BAR;
        PG8_WAIT_V(2); PG8_BAR;
        PG8_STAGE(PG8_SB(1, 0), cB + kstep, voffB); PG8_STAGE(PG8_SA(1, 0), cA + kstep, voffA); PG8_STAGE(PG8_SB(1, 1), cB + hstep + kstep, voffB);
        PG8_WAIT_V(6); PG8_BAR;
    } else {
        PG8_STAGE(PG8_SB(0, 0), cB, voffB); PG8_STAGE(PG8_SA(0, 0), cA, voffA); PG8_STAGE(PG8_SB(0, 1), cB + hstep, voffB); PG8_STAGE(PG8_SA(0, 1), cA + hstep, voffA);
        if (wr == 1) PG8_BAR;
        PG8_WAIT_V(4); PG8_BAR;
        PG8_STAGE(PG8_SB(1, 0), cB + kstep, voffB); PG8_STAGE(PG8_SA(1, 0), cA + kstep, voffA); PG8_STAGE(PG8_SB(1, 1), cB + hstep + kstep, voffB);
        PG8_WAIT_V(6); PG8_BAR;
    }
    for (;;) {
        const bool has_next = S.next(ui + 1, nxt);
        const char* nA = has_next ? (const char*)g.A + (size_t)nxt.pm * tstep : cA; const char* nB = has_next ? (const char*)g.Bt + (size_t)nxt.pn * tstep : cB;
        for (int t = 0; t < nt; t += 2) {
            const bool last = (t == nt - 2);
            const char* a1 = cA + (size_t)(t + 1) * kstep;
            const char* a2 = last ? nA : cA + (size_t)(t + 2) * kstep; const char* b2 = last ? nB : cB + (size_t)(t + 2) * kstep;
            const char* a3 = a2 + kstep; const char* b3 = b2 + kstep;
            if (last && has_next) S.a_ready(nxt);
            if constexpr (SP2) {
            PG8_LDB(B0, 0, 0); PG8_LDB(B1, 0, 1); PG8_SCHED; PG8_LDA(At, 0, 0); PG8_STAGE(PG8_SA(1, 1), a1 + hstep, voffA);
            PG8_WAIT_V(8); PG8_WAIT_L(0); PG8_BAR; PG8_MMA(0, 0, At, B0); PG8_MMA(0, 1, At, B1); PG8_BAR; PG8_SCHED;
            PG8_LDA(At, 0, 1); PG8_STAGE(PG8_SB(0, 0), b2, voffB); PG8_STAGE(PG8_SB(0, 1), b2 + hstep, voffB); PG8_STAGE(PG8_SA(0, 0), a2, voffA);
            PG8_WAIT_V(8); PG8_WAIT_L(0); PG8_BAR; PG8_MMA(1, 0, At, B0); PG8_MMA(1, 1, At, B1); PG8_BAR; PG8_SCHED;
            PG8_LDB(B0, 1, 0); PG8_LDB(B1, 1, 1); PG8_SCHED; PG8_LDA(At, 1, 0); PG8_STAGE(PG8_SA(0, 1), a2 + hstep, voffA);
            PG8_WAIT_V(8); PG8_WAIT_L(0); PG8_BAR; PG8_MMA(0, 0, At, B0); PG8_MMA(0, 1, At, B1); PG8_BAR; PG8_SCHED;
            PG8_LDA(At, 1, 1); PG8_STAGE(PG8_SB(1, 0), b3, voffB); PG8_STAGE(PG8_SB(1, 1), b3 + hstep, voffB); PG8_STAGE(PG8_SA(1, 0), a3, voffA);
            PG8_WAIT_V(8); PG8_WAIT_L(0); PG8_BAR; PG8_MMA(1, 0, At, B0); PG8_MMA(1, 1, At, B1); PG8_BAR; PG8_SCHED;
            } else {
            PG8_LDB(B0, 0, 0); PG8_SCHED; PG8_LDA(At, 0, 0); PG8_STAGE(PG8_SA(1, 1), a1 + hstep, voffA);
            PG8_WAIT_L(8); PG8_BAR; PG8_WAIT_L(0); PG8_MMA(0, 0, At, B0); PG8_BAR; PG8_SCHED;
            PG8_LDB(B1, 0, 1); PG8_STAGE(PG8_SB(0, 0), b2, voffB);
            PG8_BAR; PG8_WAIT_L(0); PG8_MMA(0, 1, At, B1); PG8_BAR;
            PG8_LDA(At, 0, 1); PG8_STAGE(PG8_SA(0, 0), a2, voffA);
            PG8_BAR; PG8_WAIT_L(0); PG8_MMA(1, 0, At, B0); PG8_BAR; PG8_SCHED;
            PG8_STAGE(PG8_SB(0, 1), b2 + hstep, voffB);
            PG8_WAIT_V(6); PG8_BAR; PG8_MMA(1, 1, At, B1); PG8_BAR;
            PG8_LDB(B0, 1, 0); PG8_SCHED; PG8_LDA(At, 1, 0); PG8_STAGE(PG8_SA(0, 1), a2 + hstep, voffA);
            PG8_WAIT_L(8); PG8_BAR; PG8_WAIT_L(0); PG8_MMA(0, 0, At, B0); PG8_BAR; PG8_SCHED;
            PG8_LDB(B1, 1, 1); PG8_STAGE(PG8_SB(1, 0), b3, voffB);
            PG8_BAR; PG8_WAIT_L(0); PG8_MMA(0, 1, At, B1); PG8_BAR;
            PG8_LDA(At, 1, 1); PG8_STAGE(PG8_SA(1, 0), a3, voffA);
            PG8_BAR; PG8_WAIT_L(0); PG8_MMA(1, 0, At, B0); PG8_BAR; PG8_SCHED;
            PG8_STAGE(PG8_SB(1, 1), b3 + hstep, voffB);
            PG8_WAIT_V(6); PG8_BAR; PG8_MMA(1, 1, At, B1); PG8_BAR;
            }
        }
        if constexpr (ALIGN_EPI) { if (wr == 0) PG8_BAR; }
        if constexpr (!Epi::AFTER_DRAIN) { E(acc, cur, wr, wc, fr, fq); S.done(cur); }
        if (!has_next) break;
#pragma unroll
        for (int a = 0; a < 2; ++a)
#pragma unroll
            for (int b = 0; b < 2; ++b)
#pragma unroll
                for (int m = 0; m < 4; ++m)
#pragma unroll
                    for (int n = 0; n < 2; ++n) acc[a][b][m][n] = (f32x4){0.f, 0.f, 0.f, 0.f};
        cur = nxt; cA = nA; cB = nB; ++ui;
        if constexpr (ALIGN_EPI) { if (wr == 1) PG8_BAR; }
    }
    PG8_WAIT_V(0);
    if constexpr (!ALIGN_EPI) { if (wr == 0) PG8_BAR; }
    PG8_BAR;
    if constexpr (Epi::AFTER_DRAIN) { E.fused(acc, cur, wr, wc, fr, fq, lds, wid, lane); S.done(cur); }
#undef PG8_SA
#undef PG8_SB
#undef PG8_STAGE
#undef PG8_LDA
#undef PG8_LDB
#undef PG8_MMA
#undef PG8_WAIT_V
#undef PG8_WAIT_L
#undef PG8_BAR
#undef PG8_SCHED
}
}
namespace attn_body {
using bf16=__hip_bfloat16;
using bf16x8=__attribute__((ext_vector_type(8)))short;
using s16x4=__attribute__((ext_vector_type(4)))short;
using f32x16=__attribute__((ext_vector_type(16)))float;
using u32x4=__attribute__((ext_vector_type(4)))unsigned;
using f32x4k=__attribute__((ext_vector_type(4)))float;
constexpr int BATCH=16,NHEAD=8,TPAD=4160,D=64,DM=NHEAD*D;
constexpr int NW=8,QBLK=32,QB=QBLK*NW,KVBLK=64,NQB=16;
constexpr int ATTN_PITCH=DM, ATTN_UNIT_ROWS=QB;
__device__ __forceinline__ int crow(int r,int hi){return (r&3)+8*(r>>2)+4*hi;}
#define SBAR() __builtin_amdgcn_sched_barrier(0)
__device__ __forceinline__ void cmask(f32x16&p0,f32x16&p1,int jb,int qrel,int hi){
  const float NEG=-INFINITY; int kb=64*jb+4*hi;
  #pragma unroll
  for(int r=0;r<16;++r){int kv=kb+(r&3)+8*(r>>2); if(kv>qrel)p0[r]=NEG; if(kv+32>qrel)p1[r]=NEG;}
}

constexpr int NSLOT=3, SLOTB=8192;
constexpr int LDS_K=0, LDS_V=NSLOT*SLOTB, LDS_WS=2*NSLOT*SLOTB, LDS_OST=LDS_WS+NW*64*4, LDS_KB=LDS_OST+NW*4096, LDS_BYTES=LDS_KB+TPAD*4;
constexpr float C2=0.125f*1.4426950408889634f;
__device__ __forceinline__ void glds16(const void*gsrc,unsigned lds_dst){unsigned keep;
  asm volatile("s_mov_b32 %0, m0\n\ts_mov_b32 m0, %2\n\ts_nop 0\n\tglobal_load_lds_dwordx4 %1, off\n\ts_mov_b32 m0, %0":"=&s"(keep):"v"(gsrc),"s"(lds_dst):"memory");}
__device__ __forceinline__ float max3f(float a,float b,float c){float r;asm("v_max3_f32 %0, %1, %2, %3":"=v"(r):"v"(a),"v"(b),"v"(c));return r;}
__device__ __forceinline__ float max2f(float a,float b){float r;asm("v_max_f32_e32 %0, %1, %2":"=v"(r):"v"(a),"v"(b));return r;}
__device__ __forceinline__ float fadd_s(float a,float b){float r;asm("v_add_f32_e32 %0, %1, %2":"=v"(r):"v"(a),"v"(b));return r;}
__device__ __forceinline__ float fsub_s(float a,float b){float r;asm("v_sub_f32_e32 %0, %1, %2":"=v"(r):"v"(a),"v"(b));return r;}
typedef float f32x2_t __attribute__((ext_vector_type(2))); typedef __bf16 bf16x2_t __attribute__((ext_vector_type(2)));
__device__ __forceinline__ unsigned cvtpk_s(float lo,float hi){f32x2_t v={lo,hi};bf16x2_t b=__builtin_convertvector(v,bf16x2_t);return __builtin_bit_cast(unsigned,b);}
#define WAIT_BAR(N) asm volatile("s_waitcnt vmcnt(" #N ") lgkmcnt(0)\n\ts_barrier":::"memory")

__device__ __forceinline__ void qkt(f32x16&p0,f32x16&p1,const char*Kslot,const bf16x8*qr,int r32,int hi){
  const char*kb=Kslot+hi*1024+r32*16;
  #pragma unroll
  for(int d0=0;d0<4;++d0){
    const bf16x8 b0=*reinterpret_cast<const bf16x8*>(kb+d0*2048);
    const bf16x8 b1=*reinterpret_cast<const bf16x8*>(kb+d0*2048+512);
    {p0=__builtin_amdgcn_mfma_f32_32x32x16_bf16(b0,qr[d0],p0,0,0,0);p1=__builtin_amdgcn_mfma_f32_32x32x16_bf16(b1,qr[d0],p1,0,0,0);}}
}
typedef __attribute__((address_space(3))) const char* lds_cptr;
typedef short v4i16_t __attribute__((ext_vector_type(4)));
__device__ __forceinline__ void kload8(bf16x8*kf,lds_cptr kp){
  kf[0]=*(const __attribute__((address_space(3))) bf16x8*)(kp);      kf[1]=*(const __attribute__((address_space(3))) bf16x8*)(kp+512);
  kf[2]=*(const __attribute__((address_space(3))) bf16x8*)(kp+2048); kf[3]=*(const __attribute__((address_space(3))) bf16x8*)(kp+2560);
  kf[4]=*(const __attribute__((address_space(3))) bf16x8*)(kp+4096); kf[5]=*(const __attribute__((address_space(3))) bf16x8*)(kp+4608);
  kf[6]=*(const __attribute__((address_space(3))) bf16x8*)(kp+6144); kf[7]=*(const __attribute__((address_space(3))) bf16x8*)(kp+6656);
}
__device__ __forceinline__ void kload2(bf16x8*kf,lds_cptr kp,int j){ kf[2*j]=*(const __attribute__((address_space(3))) bf16x8*)(kp+j*2048); kf[2*j+1]=*(const __attribute__((address_space(3))) bf16x8*)(kp+j*2048+512); }
__device__ __forceinline__ s16x4 vtr(lds_cptr p){ return __builtin_bit_cast(s16x4,__builtin_amdgcn_ds_read_tr16_b64_v4i16((__attribute__((address_space(3))) v4i16_t*)p)); }
__device__ __forceinline__ float rowmax(const f32x16&p0,const f32x16&p1){
  float a=max3f(p0[0],p0[1],p1[0]),b=max3f(p0[2],p0[3],p1[1]);a=max3f(a,p1[2],p1[3]);
  #pragma unroll
  for(int r=4;r<16;r+=4){a=max3f(a,p0[r],p0[r+1]);b=max3f(b,p0[r+2],p0[r+3]);a=max3f(a,p1[r],p1[r+1]);b=max3f(b,p1[r+2],p1[r+3]);}
  const float m=max2f(a,b);
  auto rr=__builtin_amdgcn_permlane32_swap(__float_as_uint(m),__float_as_uint(m),false,false);
  return max2f(__uint_as_float(rr[0]),__uint_as_float(rr[1]));
}
__device__ __forceinline__ void pv(f32x16*o,int vb,bf16x8 pa0,bf16x8 pa1,bf16x8 pa2,bf16x8 pa3){
  #pragma unroll
  for(int d0=0;d0<2;++d0){s16x4 lo[4],hi[4];
    #pragma unroll
    for(int ks=0;ks<4;++ks){
      asm volatile("ds_read_b64_tr_b16 %0,%1 offset:%c2":"=&v"(lo[ks]):"v"(vb),"i"(d0*4096+ks*1024):"memory");
      asm volatile("ds_read_b64_tr_b16 %0,%1 offset:%c2":"=&v"(hi[ks]):"v"(vb),"i"(d0*4096+ks*1024+512):"memory");}
    asm volatile("s_waitcnt lgkmcnt(0)":::"memory");SBAR();
    #define PK(k) (bf16x8){lo[k][0],lo[k][1],lo[k][2],lo[k][3],hi[k][0],hi[k][1],hi[k][2],hi[k][3]}
    o[d0]=__builtin_amdgcn_mfma_f32_32x32x16_bf16(pa0,PK(0),o[d0],0,0,0);
    o[d0]=__builtin_amdgcn_mfma_f32_32x32x16_bf16(pa1,PK(1),o[d0],0,0,0);
    o[d0]=__builtin_amdgcn_mfma_f32_32x32x16_bf16(pa2,PK(2),o[d0],0,0,0);
    o[d0]=__builtin_amdgcn_mfma_f32_32x32x16_bf16(pa3,PK(3),o[d0],0,0,0);
    #undef PK
  }
}

#ifndef ATTN_STORE16
#define ATTN_STORE16(p,v) (*(u32x4*)(p)=(v))
#endif
template<int THRL> __device__ __forceinline__ void attn_unit(int b,int h,int qb,const bf16*Q,const bf16*__restrict__ K,const bf16*__restrict__ V,bf16*O,char*shm){
  int tid_=threadIdx.x; asm volatile("":"+v"(tid_)); const int tid=tid_,lane=tid&63,r32=lane&31,hi=lane>>5; const int wid=__builtin_amdgcn_readfirstlane(tid>>6);
  const long rowbase=(long)b*TPAD; const int q0=64+qb*QB;
  const bf16*Qw=Q+(rowbase+q0+wid*QBLK)*DM+h*D;
  const bf16*Kh=K+rowbase*DM+h*D,*Vh=V+rowbase*DM+h*D;
  const unsigned lds0=(unsigned)(uintptr_t)shm;
  float*wsf=(float*)(shm+LDS_WS)+wid*64;
  const bf16*ksrc=Kh+(long)lane*DM+wid*8;
  const bf16*vsrc=Vh+(long)(16*(wid&3)+(lane>>2))*DM+(wid>>2)*32+(lane&3)*8;
  const unsigned kdst=lds0+LDS_K+wid*1024, vdst=lds0+LDS_V+wid*1024;
  #define DMA_K(t,slot) glds16(ksrc+(long)(t)*KVBLK*DM,(unsigned)__builtin_amdgcn_readfirstlane(kdst+(slot)))
  #define DMA_V(t,slot) glds16(vsrc+(long)(t)*KVBLK*DM,(unsigned)__builtin_amdgcn_readfirstlane(vdst+(slot)))
  const int vb0=(int)(lds0+LDS_V)+((lane>>4)&1)*32+(lane&3)*8+(4*hi+((lane&15)>>2))*64;
  const char*Kbase=shm+LDS_K; bf16x8 kf[8];
  const lds_cptr shm3=(lds_cptr)shm; const lds_cptr kp0=shm3+LDS_K+hi*1024+r32*16; const lds_cptr vp0=shm3+LDS_V+((lane>>4)&1)*32+(lane&3)*8+(4*hi+((lane&15)>>2))*64;
  const int NT=(q0+QB)/KVBLK;
  typedef __attribute__((address_space(3))) const f32x4k* lds_f4p; const __attribute__((address_space(3))) float* kbp0=(const __attribute__((address_space(3))) float*)(shm3+LDS_KB)+4*hi;
  #define KBINIT(C0,C1,t) do{ const __attribute__((address_space(3))) float* kp_=kbp0+(t)*64; _Pragma("unroll") for(int g_=0;g_<4;++g_){ const f32x4k a_=*(lds_f4p)(kp_+8*g_); const f32x4k b_=*(lds_f4p)(kp_+32+8*g_); _Pragma("unroll") for(int e_=0;e_<4;++e_){ C0[4*g_+e_]=a_[e_]-mhat; C1[4*g_+e_]=b_[e_]-mhat; } } }while(0)
  DMA_K(0,0);DMA_V(0,0);DMA_K(1,SLOTB);
  bf16x8 qr[4];
  #pragma unroll
  for(int d0=0;d0<4;++d0)qr[d0]=*reinterpret_cast<const bf16x8*>(&Qw[(long)r32*DM+d0*16+hi*8]);
  float mhat=0.f,l_reg=0.f;f32x16 o[2];o[0]=f32x16{};o[1]=f32x16{};
  const int qrel=wid*QBLK+r32;
  #define CMASK(P0,P1,t) do{int jb_=(t)-(NT-4); if(jb_>=0)cmask(P0,P1,jb_,qrel,hi);}while(0)
  bool resc=false;
  #define START(P0,P1) do{ const float rm=rowmax(P0,P1); resc=false; \
    { const float dl=rm; mhat=fadd_s(mhat,dl); \
      _Pragma("unroll") for(int r=0;r<16;++r){P0[r]=fsub_s(P0[r],dl);P1[r]=fsub_s(P1[r],dl);} } \
    _Pragma("unroll") for(int r=0;r<16;++r)P0[r]=__builtin_amdgcn_exp2f(P0[r]); }while(0)
  #define RESC() do{ if(resc){ asm volatile("s_waitcnt lgkmcnt(0)":::"memory"); \
      _Pragma("unroll") for(int d_=0;d_<2;++d_) _Pragma("unroll") for(int r=0;r<16;++r)o[d_][r]*=wsf[crow(r,hi)]; } }while(0)
  f32x16 pA0,pA1,pB0,pB1;
  int sl_prev=0,sl_cur=0,sl_next=SLOTB;
  #define ROT() do{sl_prev=sl_cur;sl_cur=sl_next;sl_next=(sl_next==(NSLOT-1)*SLOTB)?0:sl_next+SLOTB;}while(0)
  DMA_K(2,2*SLOTB);
  WAIT_BAR(3);
  KBINIT(pA0,pA1,0); qkt(pA0,pA1,Kbase,qr,r32,hi);asm volatile("s_nop 15\n\ts_nop 7":"+v"(pA0),"+v"(pA1));CMASK(pA0,pA1,0);
  START(pA0,pA1);
  _Pragma("unroll") for(int r=0;r<16;++r)pA1[r]=__builtin_amdgcn_exp2f(pA1[r]);
  WAIT_BAR(0);
  DMA_K(3,0);DMA_V(1,SLOTB);
  ROT();
  kload8(kf,kp0+sl_cur);
  WAIT_BAR(2);
  s16x4 vlo[8],vhi[8]; u32x4 pw0,pw1,pw2,pw3;
  #define PKW(P,B) cvtpk_s(P[B],P[B+1])
  #define PAF(k) __builtin_bit_cast(bf16x8,pw##k)
  #define VFR(i) (bf16x8){vlo[i][0],vlo[i][1],vlo[i][2],vlo[i][3],vhi[i][0],vhi[i][1],vhi[i][2],vhi[i][3]}
  #define PIN(x) asm volatile("":"+v"(x))
  #define MX3(a,b,c) __builtin_fmaxf(__builtin_fmaxf((a),(b)),(c))
  #define GAPA(MF,A0,A1,A2,A3,W0,W1,PW) do{ MF; sacc+=A0; sacc+=A1; sacc+=A2; sacc+=A3; PIN(sacc); W0; W1; PIN(PW); SBAR(); }while(0)
  #define EX(v) __builtin_amdgcn_exp2f(v)
  #define GAPB(MF,X,B) do{ MF; X[B]=EX(X[B]); X[B+1]=EX(X[B+1]); X[B+2]=EX(X[B+2]); X[B+3]=EX(X[B+3]); PIN(X); SBAR(); }while(0)
  #define VRD(i) do{ vlo[i]=vtr(vp_+(((i)>>2)*4096+((i)&3)*1024)); vhi[i]=vtr(vp_+(((i)>>2)*4096+((i)&3)*1024+512)); }while(0)
  #define KRD(G,j) do{ if(G){ kload2(kf,kp0+sl_next,j); SBAR(); } }while(0)
  #define STEP(C0,C1,P0,P1,t,GK,GV,GL) do{ SBAR(); \
    const lds_cptr vp_=vp0+sl_prev; \
    KBINIT(C0,C1,t); SBAR(); \
    VRD(0); SBAR(); float sacc=(P0[0]+P0[1]); \
    GAPA(C0=__builtin_amdgcn_mfma_f32_32x32x16_bf16(kf[0],qr[0],C0,0,0,0), P0[2],P0[3],P0[4],P0[5],     pw0[0]=PKW(P0,0), pw0[1]=PKW(P0,2), pw0); \
    VRD(4); SBAR(); GAPA(C1=__builtin_amdgcn_mfma_f32_32x32x16_bf16(kf[1],qr[0],C1,0,0,0), P0[6],P0[7],P0[8],P0[9],     pw0[2]=PKW(P0,4), pw0[3]=PKW(P0,6), pw0); \
    VRD(1); SBAR(); GAPA(C0=__builtin_amdgcn_mfma_f32_32x32x16_bf16(kf[2],qr[1],C0,0,0,0),   P0[10],P0[11],P0[12],P0[13], pw1[0]=PKW(P0,8), pw1[1]=PKW(P0,10), pw1); \
    VRD(5); SBAR(); GAPA(C1=__builtin_amdgcn_mfma_f32_32x32x16_bf16(kf[3],qr[1],C1,0,0,0),   P0[14],P0[15],P1[0],P1[1],   pw1[2]=PKW(P0,12),pw1[3]=PKW(P0,14), pw1); \
    VRD(2); SBAR(); GAPA(C0=__builtin_amdgcn_mfma_f32_32x32x16_bf16(kf[4],qr[2],C0,0,0,0),   P1[2],P1[3],P1[4],P1[5],     pw2[0]=PKW(P1,0), pw2[1]=PKW(P1,2), pw2); \
    VRD(6); SBAR(); GAPA(C1=__builtin_amdgcn_mfma_f32_32x32x16_bf16(kf[5],qr[2],C1,0,0,0),   P1[6],P1[7],P1[8],P1[9],     pw2[2]=PKW(P1,4), pw2[3]=PKW(P1,6), pw2); \
    VRD(3); SBAR(); GAPA(C0=__builtin_amdgcn_mfma_f32_32x32x16_bf16(kf[6],qr[3],C0,0,0,0),   P1[10],P1[11],P1[12],P1[13], pw3[0]=PKW(P1,8), pw3[1]=PKW(P1,10), pw3); \
    VRD(7); SBAR(); GAPA(C1=__builtin_amdgcn_mfma_f32_32x32x16_bf16(kf[7],qr[3],C1,0,0,0),   P1[14],P1[15],0.f,0.f,       pw3[2]=PKW(P1,12),pw3[3]=PKW(P1,14), pw3); \
    l_reg+=sacc; \
    if(GK){DMA_K((t)+3,sl_cur);} if(GV){DMA_V((t)+1,sl_next);} \
    CMASK(C0,C1,t); \
    { float a=MX3(C0[0],C0[1],C1[0]),b=MX3(C0[2],C0[3],C1[1]); a=MX3(a,C1[2],C1[3]); \
      _Pragma("unroll") for(int r=4;r<16;r+=4){a=MX3(a,C0[r],C0[r+1]);b=MX3(b,C0[r+2],C0[r+3]);a=MX3(a,C1[r],C1[r+1]);b=MX3(b,C1[r+2],C1[r+3]);} \
      float rm=__builtin_fmaxf(a,b); { auto rr=__builtin_amdgcn_permlane32_swap(__float_as_uint(rm),__float_as_uint(rm),false,false); rm=__builtin_fmaxf(__uint_as_float(rr[0]),__uint_as_float(rr[1])); } \
      resc=false; \
      if(__builtin_expect(__any(rm>(float)THRL),0)){ const float dl=__builtin_fmaxf(rm,0.f); mhat+=dl; \
        _Pragma("unroll") for(int r=0;r<16;++r){C0[r]-=dl;C1[r]-=dl;} \
        const float f=__builtin_amdgcn_exp2f(-dl); l_reg*=f; if(hi==0)wsf[r32]=f; resc=true; } } \
    SBAR(); \
    GAPB(o[0]=__builtin_amdgcn_mfma_f32_32x32x16_bf16(PAF(0),VFR(0),o[0],0,0,0), C0,0); \
    GAPB(o[1]=__builtin_amdgcn_mfma_f32_32x32x16_bf16(PAF(0),VFR(4),o[1],0,0,0), C0,4); \
    KRD(GL,0); GAPB(o[0]=__builtin_amdgcn_mfma_f32_32x32x16_bf16(PAF(1),VFR(1),o[0],0,0,0), C0,8); \
    KRD(GL,1); GAPB(o[1]=__builtin_amdgcn_mfma_f32_32x32x16_bf16(PAF(1),VFR(5),o[1],0,0,0), C0,12); \
    KRD(GL,2); GAPB(o[0]=__builtin_amdgcn_mfma_f32_32x32x16_bf16(PAF(2),VFR(2),o[0],0,0,0), C1,0); \
    KRD(GL,3); GAPB(o[1]=__builtin_amdgcn_mfma_f32_32x32x16_bf16(PAF(2),VFR(6),o[1],0,0,0), C1,4); \
    GAPB(o[0]=__builtin_amdgcn_mfma_f32_32x32x16_bf16(PAF(3),VFR(3),o[0],0,0,0), C1,8); \
    GAPB(o[1]=__builtin_amdgcn_mfma_f32_32x32x16_bf16(PAF(3),VFR(7),o[1],0,0,0), C1,12); \
    }while(0)
  int t=1;
  #undef CMASK
  #define CMASK(P0,P1,t) do{}while(0)
  for(;t+5<NT;t+=2){
    STEP(pB0,pB1,pA0,pA1,t,true,true,true);     WAIT_BAR(2); RESC(); ROT();
    STEP(pA0,pA1,pB0,pB1,t+1,true,true,true);   WAIT_BAR(2); RESC(); ROT();
  }
  #undef CMASK
  #define CMASK(P0,P1,t) do{int jb_=(t)-(NT-4); if(jb_>=0)cmask(P0,P1,jb_,qrel,hi);}while(0)
  #define ENDW(tt) do{ if((tt)+3<NT){WAIT_BAR(2);} else if((tt)+2<NT){WAIT_BAR(1);} else {WAIT_BAR(0);} }while(0)
  for(;t+1<NT;t+=2){
    STEP(pB0,pB1,pA0,pA1,t,(t+3<NT),(t+1<NT),(t+1<NT));       ENDW(t);   RESC(); ROT();
    STEP(pA0,pA1,pB0,pB1,t+1,(t+4<NT),(t+2<NT),(t+2<NT));     ENDW(t+1); RESC(); ROT();
  }
  { float sacc=pA0[0]+pA0[1]; _Pragma("unroll") for(int r=2;r<16;++r)sacc+=pA0[r]; _Pragma("unroll") for(int r=0;r<16;++r)sacc+=pA1[r]; l_reg+=sacc;
    pw0=(u32x4){PKW(pA0,0),PKW(pA0,2),PKW(pA0,4),PKW(pA0,6)};pw1=(u32x4){PKW(pA0,8),PKW(pA0,10),PKW(pA0,12),PKW(pA0,14)};pw2=(u32x4){PKW(pA1,0),PKW(pA1,2),PKW(pA1,4),PKW(pA1,6)};pw3=(u32x4){PKW(pA1,8),PKW(pA1,10),PKW(pA1,12),PKW(pA1,14)};
    SBAR(); pv(o,vb0+sl_prev,PAF(0),PAF(1),PAF(2),PAF(3)); }
  #undef PKW
  #undef PAF
  #undef VFR
  #undef PIN
  #undef MX3
  #undef GAPA
  #undef GAPB
  #undef EX
  #undef VRD
  #undef KRD
  #undef STEP
  #undef ENDW
  {auto rr=__builtin_amdgcn_permlane32_swap(__float_as_uint(l_reg),__float_as_uint(l_reg),false,false);l_reg=__uint_as_float(rr[0])+__uint_as_float(rr[1]);}
  if(hi==0)wsf[32+r32]=l_reg;asm volatile("s_waitcnt lgkmcnt(0)":::"memory");
  float rli[16];
  #pragma unroll
  for(int r=0;r<16;++r)rli[r]=__builtin_amdgcn_rcpf(wsf[32+crow(r,hi)]);
  bf16*Ow=O+(rowbase+q0+wid*QBLK)*DM+h*D;
  { bf16*stg=(bf16*)(shm+LDS_OST)+wid*2048;
    #pragma unroll
    for(int r=0;r<16;++r){const int orow=crow(r,hi);
      #pragma unroll
      for(int d0=0;d0<2;++d0)stg[orow*64+d0*32+r32]=__float2bfloat16(o[d0][r]*rli[r]);}
    asm volatile("s_waitcnt lgkmcnt(0)":::"memory");
    #pragma unroll
    for(int i=0;i<4;++i){const int row=i*8+(lane>>3),ch=lane&7; const u32x4 v=*(const u32x4*)(stg+row*64+ch*8); ATTN_STORE16(Ow+(long)row*DM+ch*8,v);} }
  asm volatile("s_waitcnt lgkmcnt(0)\n\ts_barrier":::"memory");
  #undef DMA_K
  #undef DMA_V
  #undef CMASK
  #undef START
  #undef RESC
  #undef ROT
  #undef KBINIT
}
constexpr int ATTN_LDS_BYTES=LDS_BYTES;
#undef SBAR
#undef WAIT_BAR
}

#define LAS __attribute__((address_space(3)))
typedef unsigned short bf16;
typedef unsigned v4u __attribute__((ext_vector_type(4)));
typedef unsigned v2u __attribute__((ext_vector_type(2)));
typedef float f32x4 __attribute__((ext_vector_type(4)));
typedef short bf16x8 __attribute__((ext_vector_type(8)));
typedef float f32x16v __attribute__((ext_vector_type(16)));

constexpr int NB = 16, SEQ = 4096, DMODEL = 1024, NMETA = 16;
constexpr int TP = 4160;
constexpr int R = NB * TP;
constexpr int NTOK = NB * SEQ;
constexpr int N1 = 5632;
constexpr int IN_COLS = 5416;
constexpr int NWAVES = 8, NTHREADS = 512;
constexpr float NORM_EPS = 1e-6f, GN_EPS = 64e-5f;
constexpr float LOG2E = 1.4426950408889634f;

constexpr size_t MiB = 1u << 20;
constexpr size_t U65 = 65 * MiB;
constexpr size_t WS_WTIN = 1 * MiB;
constexpr size_t WS_WTQ = 12 * MiB;
constexpr size_t WS_WTFOX = 16 * MiB;
constexpr size_t WS_WTRWKV = 17 * MiB;
constexpr size_t WS_WTOUT = 18 * MiB;
constexpr size_t WS_WTWA = 20 * MiB;
constexpr size_t WS_WTG = 20 * MiB + 512 * 1024;
constexpr size_t WS_KS = 21 * MiB;
constexpr size_t WS_KB = 22 * MiB;
constexpr size_t WS_LF = 25 * MiB;
constexpr size_t WS_BS = 28 * MiB;
constexpr size_t WS_U16 = 32 * MiB;
constexpr size_t WS_V16 = 64 * MiB;
constexpr size_t WS_F = 96 * MiB;
constexpr size_t WS_FQ = WS_F, WS_FK = WS_F + U65, WS_FV = WS_F + 2 * U65, WS_ZRR = WS_F + 3 * U65, WS_ZRK = WS_F + 4 * U65, WS_ZRV = WS_F + 5 * U65, WS_ZM = WS_F + 6 * U65;
constexpr size_t WS_ZG = WS_F + 7 * U65;
constexpr size_t WS_XN = WS_ZG + 4 * U65;
constexpr size_t WS_IDS = 941 * MiB;
constexpr size_t WS_GATES = 973 * MiB;
constexpr size_t WS_END = 1005 * MiB;
constexpr size_t WS_LA = WS_XN;
constexpr size_t WS_LG = WS_XN + 20 * MiB;
constexpr size_t WS_KP = WS_XN;
constexpr size_t WS_KN = WS_XN + U65;
constexpr size_t WS_Y = WS_ZM;
constexpr size_t WS_MIX = WS_XN;
constexpr size_t WS_XN2 = WS_XN;
constexpr size_t WS_PQ = WS_F;
constexpr size_t DO_XW = 0, DO_AA = U65, DO_GG = 2 * U65;

__device__ __forceinline__ unsigned f2bf(float f) { unsigned u = __builtin_bit_cast(unsigned, f); return (u + 0x7fffu + ((u >> 16) & 1u)) >> 16; }
__device__ __forceinline__ unsigned pk2(float lo, float hi) { return f2bf(lo) | (f2bf(hi) << 16); }
__device__ __forceinline__ float bflo(unsigned w) { return __builtin_bit_cast(float, w << 16); }
__device__ __forceinline__ float bfhi(unsigned w) { return __builtin_bit_cast(float, w & 0xffff0000u); }
__device__ __forceinline__ void unpack8(const v4u w, float (&f)[8]) { f[0] = bflo(w.x); f[1] = bfhi(w.x); f[2] = bflo(w.y); f[3] = bfhi(w.y); f[4] = bflo(w.z); f[5] = bfhi(w.z); f[6] = bflo(w.w); f[7] = bfhi(w.w); }
__device__ __forceinline__ v4u pack8(const float (&f)[8]) { v4u w; w.x = pk2(f[0], f[1]); w.y = pk2(f[2], f[3]); w.z = pk2(f[4], f[5]); w.w = pk2(f[6], f[7]); return w; }
__device__ __forceinline__ float sigmoidf_(float x) { return __builtin_amdgcn_rcpf(1.0f + __builtin_amdgcn_exp2f(-x * LOG2E)); }
__device__ __forceinline__ float wave_sum(float v) {
#pragma unroll
    for (int o = 1; o < 64; o <<= 1) v += __shfl_xor(v, o);
    return v;
}
__device__ __forceinline__ float sum8(float v) { v += __shfl_xor(v, 1); v += __shfl_xor(v, 2); v += __shfl_xor(v, 4); return v; }

struct Params {
    const float* in[27];
    float* out;
    unsigned char* ws;
};
enum { I_X = 0, I_META, I_N1G, I_WIN, I_FQN, I_FKN, I_FBIAS, I_MU, I_W0, I_WUP, I_A0, I_AUP, I_GUP, I_KK, I_KA, I_RK, I_LNG, I_LNB, I_WFOX, I_WRWKV, I_WOUT, I_N2G, I_PWQ, I_SK1, I_SK2, I_PU, I_PV };

__device__ __forceinline__ int win_src_col(int n) {
    if (n < 1536) return n;
    if (n < 3072) return 1544 + (n - 1536);
    if (n < 3584) { const int m = n - 3072; if (m < 288) return 3080 + m; if (m < 296) return 1536 + (m - 288); return -1; }
    return 3368 + (n - 3584);
}
template <bool REMAP>
__device__ __forceinline__ void transpose_item(const float* W, int ldw, int K, int N, bf16* WT, LAS float* scr, int item, int lane) {
    const int nblk = N / 32, kb = item / nblk, nb = item % nblk, k0 = 64 * kb, n0 = 32 * nb;
    const int n = n0 + (lane & 31); const int sc = REMAP ? win_src_col(n) : n;
#pragma unroll 8
    for (int i = 0; i < 32; ++i) { const int kk = 2 * i + (lane >> 5); scr[kk * 33 + (lane & 31)] = (sc >= 0) ? W[(size_t)(k0 + kk) * ldw + sc] : 0.f; }
    asm volatile("s_waitcnt lgkmcnt(0)" ::: "memory");
    const int c = lane & 7;
#pragma unroll
    for (int j = 0; j < 4; ++j) { const int nn = (lane >> 3) + 8 * j; const LAS float* s = scr + (8 * c) * 33 + nn;
        v4u o; o.x = pk2(s[0 * 33], s[1 * 33]); o.y = pk2(s[2 * 33], s[3 * 33]); o.z = pk2(s[4 * 33], s[5 * 33]); o.w = pk2(s[6 * 33], s[7 * 33]);
        *(v4u*)(WT + (size_t)(n0 + nn) * K + k0 + 8 * c) = o; }
    asm volatile("s_waitcnt lgkmcnt(0)" ::: "memory");
}
__device__ __forceinline__ void p0_prologue(const Params& p, LAS unsigned char* lds, int vcu, int G, int wave, int lane) {
    unsigned char* ws = p.ws;
    LAS float* scr = (LAS float*)(lds + wave * 16384);
    const int gw = vcu * NWAVES + wave, NGW = G * NWAVES;
    constexpr int I_IN = 16 * (N1 / 32), I_Q = 16 * 64, I_FX = 8 * 32, I_O = 16 * 32;
    constexpr int NITEMS = I_IN + I_Q + 2 * I_FX + I_O;
    for (int it = gw; it < NITEMS; it += NGW) {
        int r = it;
        if (r < I_IN) { transpose_item<true>(p.in[I_WIN], IN_COLS, 1024, N1, (bf16*)(ws + WS_WTIN), scr, r, lane); continue; } r -= I_IN;
        if (r < I_Q) { transpose_item<false>(p.in[I_PWQ], 2048, 1024, 2048, (bf16*)(ws + WS_WTQ), scr, r, lane); continue; } r -= I_Q;
        if (r < I_FX) { transpose_item<false>(p.in[I_WFOX], 1024, 512, 1024, (bf16*)(ws + WS_WTFOX), scr, r, lane); continue; } r -= I_FX;
        if (r < I_FX) { transpose_item<false>(p.in[I_WRWKV], 1024, 512, 1024, (bf16*)(ws + WS_WTRWKV), scr, r, lane); continue; } r -= I_FX;
        transpose_item<false>(p.in[I_WOUT], 1024, 1024, 1024, (bf16*)(ws + WS_WTOUT), scr, r, lane);
    }
    const int gt = gw * 64 + lane, NGT = NGW * 64;
    for (int i = gt; i < 1024 * 128; i += NGT) { const int n = i >> 7, k = i & 127; float v = 0.f;
        if (n < 512) { if (k < 64) v = p.in[I_WUP][k * 512 + n]; } else { if (k >= 64) v = p.in[I_AUP][(k - 64) * 512 + (n - 512)]; }
        ((bf16*)(ws + WS_WTWA))[i] = (bf16)f2bf(v); }
    for (int i = gt; i < 512 * 256; i += NGT) { const int n = i >> 8, k = i & 255; const float v = (k < 160) ? p.in[I_GUP][k * 512 + n] : 0.f; ((bf16*)(ws + WS_WTG))[i] = (bf16)f2bf(v); }
    for (int i = gt; i < 2 * 128 * 128; i += NGT) { const float v = (i < 16384) ? p.in[I_SK1][i] : p.in[I_SK2][i - 16384]; ((bf16*)(ws + WS_KS))[i] = (bf16)f2bf(v); }
    for (int i = gt; i < 16384 * 1024 / 4; i += NGT) {
        const f32x4 a = ((const f32x4*)p.in[I_PU])[i]; v2u o; o.x = pk2(a.x, a.y); o.y = pk2(a.z, a.w); ((v2u*)(ws + WS_U16))[i] = o;
        const f32x4 b = ((const f32x4*)p.in[I_PV])[i]; v2u q; q.x = pk2(b.x, b.y); q.y = pk2(b.z, b.w); ((v2u*)(ws + WS_V16))[i] = q; }
    const f32x4* g4 = (const f32x4*)p.in[I_N1G] + lane;
    for (int m = gw; m < R; m += NGW) {
        const int b = m / TP, pp = m - b * TP;
        unsigned long long* o8 = (unsigned long long*)(ws + WS_XN + (size_t)m * 2048) + lane;
        if (pp < 48) {
#pragma unroll
            for (int j = 0; j < 4; ++j) o8[64 * j] = 0ull;
            continue; }
        const float* xrow = (pp < 64) ? p.in[I_META] + (size_t)(pp - 48) * 1024 : p.in[I_X] + ((size_t)b * SEQ + (pp - 64)) * 1024;
        const f32x4* xr = (const f32x4*)xrow + lane;
        f32x4 v[4]; float s = 0.f;
#pragma unroll
        for (int j = 0; j < 4; ++j) { v[j] = xr[64 * j]; s += (v[j].x * v[j].x + v[j].y * v[j].y) + (v[j].z * v[j].z + v[j].w * v[j].w); }
        const float rs = 1.0f / sqrtf(wave_sum(s) * (1.f / 1024.f) + NORM_EPS);
#pragma unroll
        for (int j = 0; j < 4; ++j) { const f32x4 g = g4[64 * j]; o8[64 * j] = (unsigned long long)pk2(v[j].x * rs * g.x, v[j].y * rs * g.y) | ((unsigned long long)pk2(v[j].z * rs * g.z, v[j].w * rs * g.w) << 32); }
    }
}

template <class F> struct EpiT {
    static constexpr bool PERM = true, AFTER_DRAIN = false;
    F f;
    __device__ __forceinline__ void operator()(const pg8::f32x4 (&acc)[2][2][4][2], const pg8::Unit& u, int wr, int wc, int fr, int fq) const {
        const int row0 = u.pm * 256 + wr * 64 + fr, col0 = u.pn * 256 + wc * 32 + 8 * fq;
#pragma unroll
        for (int ai = 0; ai < 2; ++ai)
#pragma unroll
            for (int m = 0; m < 4; ++m)
#pragma unroll
                for (int bj = 0; bj < 2; ++bj) {
                    const pg8::f32x4 a = acc[ai][bj][m][0], b = acc[ai][bj][m][1];
                    float v[8] = {a[0], a[1], a[2], a[3], b[0], b[1], b[2], b[3]};
                    f.store(row0 + ai * 128 + m * 16, col0 + bj * 128, v);
                }
    }
};
struct F_Gemm1 {
    bf16* F; bf16* ZG;
    __device__ __forceinline__ void store(int row, int col, float (&v)[8]) const {
        if (col < 3584) { const int buf = col >> 9, c = col & 511; *(v4u*)(F + (size_t)buf * ((size_t)R * 512) + (size_t)row * 512 + c) = pack8(v); }
        else { const int c = col - 3584;
#pragma unroll
            for (int e = 0; e < 8; ++e) v[e] = sigmoidf_(v[e]);
            *(v4u*)(ZG + (size_t)row * 2048 + c) = pack8(v); }
    }
};
struct F_LoraW {
    bf16* XW; const float* w0;
    __device__ __forceinline__ void store(int row, int col, float (&v)[8]) const {
        const f32x4 b0 = *(const f32x4*)(w0 + col), b1 = *(const f32x4*)(w0 + col + 4); const float bb[8] = {b0.x, b0.y, b0.z, b0.w, b1.x, b1.y, b1.z, b1.w};
#pragma unroll
        for (int e = 0; e < 8; ++e) { const float x = v[e] + bb[e];
            const float sp = fmaxf(-x, 0.f) + __logf(1.0f + __expf(-fabsf(x)));
            const float ew = __expf(-sp - 0.5f);
            v[e] = 1.0f - __expf(-ew); }
        *(v4u*)(XW + (size_t)row * 512 + col) = pack8(v);
    }
};
struct F_LoraA {
    bf16* AA; const float* a0;
    __device__ __forceinline__ void store(int row, int col, float (&v)[8]) const {
        const f32x4 b0 = *(const f32x4*)(a0 + col), b1 = *(const f32x4*)(a0 + col + 4); const float bb[8] = {b0.x, b0.y, b0.z, b0.w, b1.x, b1.y, b1.z, b1.w};
#pragma unroll
        for (int e = 0; e < 8; ++e) v[e] = sigmoidf_(v[e] + bb[e]);
        *(v4u*)(AA + (size_t)row * 512 + col) = pack8(v);
    }
};
struct F_Plain {
    bf16* O; int ldc;
    __device__ __forceinline__ void store(int row, int col, float (&v)[8]) const { *(v4u*)(O + (size_t)row * ldc + col) = pack8(v); }
};
struct F_MixA {
    bf16* MIX; const bf16* ZG;
    __device__ __forceinline__ void store(int row, int col, float (&v)[8]) const {
        float g[8]; unpack8(*(const v4u*)(ZG + (size_t)row * 2048 + col), g);
#pragma unroll
        for (int e = 0; e < 8; ++e) v[e] *= g[e];
        *(v4u*)(MIX + (size_t)row * 1024 + col) = pack8(v);
    }
};
struct F_MixB {
    bf16* MIX; const bf16* ZG;
    __device__ __forceinline__ void store(int row, int col, float (&v)[8]) const {
        float g[8], m[8]; unpack8(*(const v4u*)(ZG + (size_t)row * 2048 + 1024 + col), g); unpack8(*(const v4u*)(MIX + (size_t)row * 1024 + col), m);
#pragma unroll
        for (int e = 0; e < 8; ++e) v[e] = m[e] + v[e] * g[e];
        *(v4u*)(MIX + (size_t)row * 1024 + col) = pack8(v);
    }
};
struct F_Out {
    const float* x; float* out;
    __device__ __forceinline__ void store(int row, int col, float (&v)[8]) const {
        const int b = row / TP, pp = row - b * TP; if (pp < 64) return;
        const size_t off = ((size_t)b * SEQ + (pp - 64)) * 1024 + col;
        const f32x4 x0 = *(const f32x4*)(x + off), x1 = *(const f32x4*)(x + off + 4);
        *(f32x4*)(out + off) = (f32x4){x0.x + v[0], x0.y + v[1], x0.z + v[2], x0.w + v[3]};
        *(f32x4*)(out + off + 4) = (f32x4){x1.x + v[4], x1.y + v[5], x1.z + v[6], x1.w + v[7]};
    }
};
template <class F>
__device__ __forceinline__ void run_gemm(LAS unsigned char* lds, const bf16* A, const bf16* Bt, int M, int N, int K, int G, int bid, const F& f) {
    asm volatile("" : "+s"(M), "+s"(N), "+s"(G));
    pg8::Gemm g{A, Bt, M, N, K}; pg8::StaticOrder S; S.init(M, N, G, bid);
    EpiT<F> E{f};
    pg8::gemm_phase<EpiT<F>, pg8::StaticOrder, true, true>(lds, g, S, E);
}

__device__ __forceinline__ void p2_prep1(const Params& p, int vcu, int G, int wave, int lane) {
    unsigned char* ws = p.ws;
    const int gw = vcu * NWAVES + wave, NGW = G * NWAVES;
    float gq[8], gk[8], mu[8];
#pragma unroll
    for (int e = 0; e < 8; ++e) { gq[e] = p.in[I_FQN][lane * 8 + e] * attn_body::C2; gk[e] = p.in[I_FKN][lane * 8 + e]; mu[e] = (lane < 36) ? p.in[I_MU][1536 + lane * 8 + e] : 0.f; }
    for (int m = gw; m < R; m += NGW) {
        const int b = m / TP, pp = m - b * TP;
        {
            v4u* qp = (v4u*)(ws + WS_FQ + (size_t)m * 1024) + lane; v4u* kp = (v4u*)(ws + WS_FK + (size_t)m * 1024) + lane;
            float q[8], k[8]; unpack8(*qp, q); unpack8(*kp, k);
            float sq = 0.f, sk = 0.f;
#pragma unroll
            for (int e = 0; e < 8; ++e) { sq += q[e] * q[e]; sk += k[e] * k[e]; }
            sq = sum8(sq); sk = sum8(sk);
            const float rq = 1.0f / sqrtf(sq * (1.f / 64.f) + NORM_EPS), rk = 1.0f / sqrtf(sk * (1.f / 64.f) + NORM_EPS);
#pragma unroll
            for (int e = 0; e < 8; ++e) { q[e] *= rq * gq[e]; k[e] *= rk * gk[e]; }
            *qp = pack8(q); *kp = pack8(k);
        }
        if (lane < 36) {
            float z[8], zp[8]; unpack8(*((const v4u*)(ws + WS_ZM + (size_t)m * 1024) + lane), z);
            if (pp > 0) unpack8(*((const v4u*)(ws + WS_ZM + (size_t)(m - 1) * 1024) + lane), zp); else {
#pragma unroll
                for (int e = 0; e < 8; ++e) zp[e] = 0.f; }
#pragma unroll
            for (int e = 0; e < 8; ++e) { const float s = z[e] + mu[e] * (zp[e] - z[e]); z[e] = (lane < 8) ? tanhf(s) : (lane < 16) ? s : sigmoidf_(s); }
            if (lane < 16) *((v4u*)(ws + WS_LA + (size_t)m * 256) + lane) = pack8(z);
            else *((v4u*)(ws + WS_LG + (size_t)m * 512) + (lane - 16)) = pack8(z);
        } else if (lane == 36) {
            float z[8]; unpack8(*((const v4u*)(ws + WS_ZM + (size_t)m * 1024) + 36), z);
#pragma unroll
            for (int e = 0; e < 8; ++e) { const float x = z[e] + p.in[I_FBIAS][e]; z[e] = fminf(x, 0.f) - __logf(1.0f + __expf(-fabsf(x))); }
            float* lf = (float*)(ws + WS_LF) + (size_t)m * 8;
            *(f32x4*)lf = (f32x4){z[0], z[1], z[2], z[3]}; *(f32x4*)(lf + 4) = (f32x4){z[4], z[5], z[6], z[7]};
        } else if (lane < 49) {
            *((v4u*)(ws + WS_LG + (size_t)m * 512) + (lane - 37 + 20)) = (v4u){0u, 0u, 0u, 0u};
        }
    }
}
__device__ __forceinline__ void p3_cumsum(const Params& p, int seq, int lane) {
    unsigned char* ws = p.ws;
    const int b = seq >> 3, h = seq & 7;
    const float* lf = (const float*)(ws + WS_LF) + (size_t)b * TP * 8 + h;
    float* kb = (float*)(ws + WS_KB) + (size_t)seq * TP;
    float carry = 0.f;
    for (int c0 = 0; c0 < 65; c0 += 13) {
        float v[13];
#pragma unroll
        for (int i = 0; i < 13; ++i) { const int pp = (c0 + i) * 64 + lane; v[i] = (pp >= 48) ? lf[(size_t)pp * 8] : 0.f; }
#pragma unroll
        for (int i = 0; i < 13; ++i) {
            float x = v[i];
#pragma unroll
            for (int o = 1; o < 64; o <<= 1) { const float y = __shfl_up(x, o); if (lane >= o) x += y; }
            const int pp = (c0 + i) * 64 + lane;
            const float c = carry + x;
            kb[pp] = (pp >= 48) ? -c * LOG2E : -1e30f;
            carry += __shfl(x, 63);
        }
    }
}

__device__ __forceinline__ void p4_prep2(const Params& p, int vcu, int G, int wave, int lane) {
    unsigned char* ws = p.ws; unsigned char* dob = (unsigned char*)p.out;
    const int gw = vcu * NWAVES + wave, NGW = G * NWAVES;
    float mur[8], muk[8], kk_[8], ka_[8], rk_[8];
#pragma unroll
    for (int e = 0; e < 8; ++e) { const int c = lane * 8 + e; mur[e] = p.in[I_MU][c]; muk[e] = p.in[I_MU][512 + c]; kk_[e] = p.in[I_KK][c]; ka_[e] = p.in[I_KA][c]; rk_[e] = p.in[I_RK][c]; }
    for (int m = gw; m < R; m += NGW) {
        const int b = m / TP, pp = m - b * TP;
        float r[8], k[8], rp[8], kp[8], a[8];
        unpack8(*((const v4u*)(ws + WS_ZRR + (size_t)m * 1024) + lane), r); unpack8(*((const v4u*)(ws + WS_ZRK + (size_t)m * 1024) + lane), k);
        if (pp > 0) { unpack8(*((const v4u*)(ws + WS_ZRR + (size_t)(m - 1) * 1024) + lane), rp); unpack8(*((const v4u*)(ws + WS_ZRK + (size_t)(m - 1) * 1024) + lane), kp); }
        else {
#pragma unroll
            for (int e = 0; e < 8; ++e) { rp[e] = 0.f; kp[e] = 0.f; } }
        v4u* aap = (v4u*)(dob + DO_AA + (size_t)m * 1024) + lane;
        unpack8(*aap, a);
        float kkv[8], kpr[8]; float ss = 0.f, bon = 0.f;
#pragma unroll
        for (int e = 0; e < 8; ++e) { const float rs = r[e] + mur[e] * (rp[e] - r[e]); const float ks = k[e] + muk[e] * (kp[e] - k[e]);
            kkv[e] = ks * kk_[e]; kpr[e] = ks * (1.0f + (a[e] - 1.0f) * ka_[e]); ss += kkv[e] * kkv[e]; bon += rs * kpr[e] * rk_[e]; }
        ss = sum8(ss); bon = sum8(bon);
        const float inv = 1.0f / fmaxf(sqrtf(ss), 1e-12f);
        float bb[8];
#pragma unroll
        for (int e = 0; e < 8; ++e) { kkv[e] *= inv; bb[e] = kkv[e] * a[e]; }
        *((v4u*)(ws + WS_KP + (size_t)m * 1024) + lane) = pack8(kpr);
        *((v4u*)(ws + WS_KN + (size_t)m * 1024) + lane) = pack8(kkv);
        *aap = pack8(bb);
        if ((lane & 7) == 0) ((float*)(ws + WS_BS))[(size_t)m * 8 + (lane >> 3)] = bon;
    }
}

constexpr int SC_CH = 32, SC_STRIDE = 5 * 64 + 32;
__device__ __forceinline__ float dpp_sum16(float x) {
    x += __builtin_bit_cast(float, __builtin_amdgcn_update_dpp(0, __builtin_bit_cast(int, x), 0xB1, 0xF, 0xF, true));
    x += __builtin_bit_cast(float, __builtin_amdgcn_update_dpp(0, __builtin_bit_cast(int, x), 0x4E, 0xF, 0xF, true));
    x += __builtin_bit_cast(float, __builtin_amdgcn_update_dpp(0, __builtin_bit_cast(int, x), 0x141, 0xF, 0xF, true));
    x += __builtin_bit_cast(float, __builtin_amdgcn_update_dpp(0, __builtin_bit_cast(int, x), 0x140, 0xF, 0xF, true));
    return x;
}
__device__ __forceinline__ void p5_scan_item(const Params& p, LAS unsigned char* lds, int item, int tid, int wave, int lane) {
    unsigned char* ws = p.ws; unsigned char* dob = (unsigned char*)p.out;
    const int half = item & 1, bh = item >> 1, b = bh >> 3, h = bh & 7;
    LAS float* buf = (LAS float*)lds;
    LAS float* ybuf = buf + SC_CH * SC_STRIDE;
    const size_t rowb = (size_t)b * TP;
    const int st_step = (tid >> 3) & 31, st_grp = tid >> 8, c8 = tid & 7;
    const size_t colb = (size_t)h * 64 + c8 * 8;
    const bf16* aXW = (const bf16*)(dob + DO_XW); const bf16* aKN = (const bf16*)(ws + WS_KN); const bf16* aBB = (const bf16*)(dob + DO_AA); const bf16* aKP = (const bf16*)(ws + WS_KP);
    const bf16* aR = (const bf16*)(ws + WS_ZRR); const bf16* aV = (const bf16*)(ws + WS_ZRV);
    float mu8[8];
#pragma unroll
    for (int e = 0; e < 8; ++e) mu8[e] = (st_grp == 0) ? p.in[I_MU][h * 64 + c8 * 8 + e] : ((c8 < 4) ? p.in[I_MU][1024 + h * 64 + half * 32 + c8 * 8 + e] : 0.f);
    v4u g0, g1, g2, g3;
    auto issue = [&](int t0) {
        const size_t row = rowb + t0 + st_step;
        if (st_grp == 0) { g0 = *(const v4u*)(aXW + row * 512 + colb); g1 = *(const v4u*)(aKN + row * 512 + colb); g2 = *(const v4u*)(aR + row * 512 + colb); g3 = *(const v4u*)(aR + (row - 1) * 512 + colb); }
        else { g0 = *(const v4u*)(aBB + row * 512 + colb); g1 = *(const v4u*)(aKP + row * 512 + colb);
            if (c8 < 4) { const size_t cv = (size_t)h * 64 + half * 32 + c8 * 8; g2 = *(const v4u*)(aV + row * 512 + cv); g3 = *(const v4u*)(aV + (row - 1) * 512 + cv); } }
    };
    auto commit = [&]() {
        LAS float* d = buf + st_step * SC_STRIDE;
        float a[8], c[8];
        if (st_grp == 0) {
            unpack8(g0, a); *(LAS f32x4*)(d + 0 * 64 + c8 * 8) = (f32x4){a[0], a[1], a[2], a[3]}; *(LAS f32x4*)(d + 0 * 64 + c8 * 8 + 4) = (f32x4){a[4], a[5], a[6], a[7]};
            unpack8(g1, a); *(LAS f32x4*)(d + 1 * 64 + c8 * 8) = (f32x4){a[0], a[1], a[2], a[3]}; *(LAS f32x4*)(d + 1 * 64 + c8 * 8 + 4) = (f32x4){a[4], a[5], a[6], a[7]};
            unpack8(g2, a); unpack8(g3, c);
#pragma unroll
            for (int e = 0; e < 8; ++e) a[e] = a[e] + mu8[e] * (c[e] - a[e]);
            *(LAS f32x4*)(d + 4 * 64 + c8 * 8) = (f32x4){a[0], a[1], a[2], a[3]}; *(LAS f32x4*)(d + 4 * 64 + c8 * 8 + 4) = (f32x4){a[4], a[5], a[6], a[7]};
        } else {
            unpack8(g0, a); *(LAS f32x4*)(d + 2 * 64 + c8 * 8) = (f32x4){a[0], a[1], a[2], a[3]}; *(LAS f32x4*)(d + 2 * 64 + c8 * 8 + 4) = (f32x4){a[4], a[5], a[6], a[7]};
            unpack8(g1, a); *(LAS f32x4*)(d + 3 * 64 + c8 * 8) = (f32x4){a[0], a[1], a[2], a[3]}; *(LAS f32x4*)(d + 3 * 64 + c8 * 8 + 4) = (f32x4){a[4], a[5], a[6], a[7]};
            if (c8 < 4) { unpack8(g2, a); unpack8(g3, c);
#pragma unroll
                for (int e = 0; e < 8; ++e) a[e] = a[e] + mu8[e] * (c[e] - a[e]);
                *(LAS f32x4*)(d + 5 * 64 + c8 * 8) = (f32x4){a[0], a[1], a[2], a[3]}; *(LAS f32x4*)(d + 5 * 64 + c8 * 8 + 4) = (f32x4){a[4], a[5], a[6], a[7]}; }
        }
    };
    const int rl = lane >> 4, kq = lane & 15, myrow = wave * 4 + rl;
    float S0 = 0.f, S1 = 0.f, S2 = 0.f, S3 = 0.f;
    constexpr int T0 = 32, NCH = (TP - T0) / SC_CH;
    bf16* Y = (bf16*)(ws + WS_Y);
    issue(T0);
    for (int ch = 0; ch < NCH; ++ch) {
        const int t0 = T0 + ch * SC_CH;
        __syncthreads();
        commit();
        __syncthreads();
        if (ch + 1 < NCH) issue(t0 + SC_CH);
        const LAS float* sp = buf + kq * 4;
#pragma unroll 4
        for (int s = 0; s < SC_CH; ++s) {
            const LAS float* q = sp + s * SC_STRIDE;
            const f32x4 xw = *(const LAS f32x4*)(q), kn = *(const LAS f32x4*)(q + 64), bb = *(const LAS f32x4*)(q + 128), kp = *(const LAS f32x4*)(q + 192), rr = *(const LAS f32x4*)(q + 256);
            const float vv = buf[s * SC_STRIDE + 320 + myrow];
            float sa = S0 * kn.x; sa = fmaf(S1, kn.y, sa); sa = fmaf(S2, kn.z, sa); sa = fmaf(S3, kn.w, sa);
            sa = -dpp_sum16(sa);
            S0 = fmaf(vv, kp.x, fmaf(sa, bb.x, fmaf(-S0, xw.x, S0)));
            S1 = fmaf(vv, kp.y, fmaf(sa, bb.y, fmaf(-S1, xw.y, S1)));
            S2 = fmaf(vv, kp.z, fmaf(sa, bb.z, fmaf(-S2, xw.z, S2)));
            S3 = fmaf(vv, kp.w, fmaf(sa, bb.w, fmaf(-S3, xw.w, S3)));
            float y = S0 * rr.x; y = fmaf(S1, rr.y, y); y = fmaf(S2, rr.z, y); y = fmaf(S3, rr.w, y);
            y = dpp_sum16(y);
            if (kq == 0) ybuf[s * 32 + myrow] = y;
        }
        __syncthreads();
        {
            const int s = tid >> 4, rp = tid & 15;
            const float y0 = ybuf[s * 32 + 2 * rp], y1 = ybuf[s * 32 + 2 * rp + 1];
            *(unsigned*)(Y + (rowb + t0 + s) * 512 + h * 64 + half * 32 + 2 * rp) = pk2(y0, y1);
        }
    }
    __syncthreads();
}

__device__ __forceinline__ void p6_prep3(const Params& p, int vcu, int G, int wave, int lane) {
    unsigned char* ws = p.ws; unsigned char* dob = (unsigned char*)p.out;
    const int gw = vcu * NWAVES + wave, NGW = G * NWAVES;
    float lg[8], lb[8], muv[8];
#pragma unroll
    for (int e = 0; e < 8; ++e) { const int c = lane * 8 + e; lg[e] = p.in[I_LNG][c]; lb[e] = p.in[I_LNB][c]; muv[e] = p.in[I_MU][1024 + c]; }
    for (int m = gw; m < R; m += NGW) {
        const int b = m / TP, pp = m - b * TP;
        v4u* yp = (v4u*)(ws + WS_Y + (size_t)m * 1024) + lane;
        if (pp < 48) { *yp = (v4u){0u, 0u, 0u, 0u}; continue; }
        float y[8], v[8], vp[8], g[8];
        unpack8(*yp, y); unpack8(*((const v4u*)(ws + WS_ZRV + (size_t)m * 1024) + lane), v); unpack8(*((const v4u*)(ws + WS_ZRV + (size_t)(m - 1) * 1024) + lane), vp);
        unpack8(*((const v4u*)(dob + DO_GG + (size_t)m * 1024) + lane), g);
        float s = 0.f;
#pragma unroll
        for (int e = 0; e < 8; ++e) s += y[e];
        const float mean = sum8(s) * (1.f / 64.f); float q = 0.f;
#pragma unroll
        for (int e = 0; e < 8; ++e) { y[e] -= mean; q += y[e] * y[e]; }
        const float rstd = 1.0f / sqrtf(sum8(q) * (1.f / 64.f) + GN_EPS);
        const float bon = ((const float*)(ws + WS_BS))[(size_t)m * 8 + (lane >> 3)];
#pragma unroll
        for (int e = 0; e < 8; ++e) { const float vs = v[e] + muv[e] * (vp[e] - v[e]); y[e] = (y[e] * rstd * lg[e] + lb[e] + bon * vs) * g[e]; }
        *yp = pack8(y);
    }
}
__device__ __forceinline__ void p9_norm2(const Params& p, int vcu, int G, int wave, int lane) {
    unsigned char* ws = p.ws;
    const int gw = vcu * NWAVES + wave, NGW = G * NWAVES;
    const f32x4* g4 = (const f32x4*)p.in[I_N2G] + lane;
    for (int m = gw; m < NTOK; m += NGW) {
        const f32x4* xr = (const f32x4*)(p.out + (size_t)m * 1024) + lane;
        f32x4 v[4]; float s = 0.f;
#pragma unroll
        for (int j = 0; j < 4; ++j) { v[j] = xr[64 * j]; s += (v[j].x * v[j].x + v[j].y * v[j].y) + (v[j].z * v[j].z + v[j].w * v[j].w); }
        const float rs = 1.0f / sqrtf(wave_sum(s) * (1.f / 1024.f) + NORM_EPS);
        unsigned long long* o8 = (unsigned long long*)(ws + WS_XN2 + (size_t)m * 2048) + lane;
#pragma unroll
        for (int j = 0; j < 4; ++j) { const f32x4 g = g4[64 * j]; o8[64 * j] = (unsigned long long)pk2(v[j].x * rs * g.x, v[j].y * rs * g.y) | ((unsigned long long)pk2(v[j].z * rs * g.z, v[j].w * rs * g.w) << 32); }
    }
}

typedef __bf16 bf16x2_t __attribute__((ext_vector_type(2)));
__device__ __forceinline__ unsigned mono(float f) { const unsigned u = __builtin_bit_cast(unsigned, f); return u ^ ((unsigned)((int)u >> 31) | 0x80000000u); }
__device__ __forceinline__ float unmono(unsigned m) { const unsigned u = (m & 0x80000000u) ? (m ^ 0x80000000u) : ~m; return __builtin_bit_cast(float, u); }
__device__ __forceinline__ void ce_desc(unsigned& a, unsigned& b) { const unsigned hi = a > b ? a : b, lo = a > b ? b : a; a = hi; b = lo; }
template <int BASE, int N> __device__ __forceinline__ void bitonic_sort_desc(unsigned (&v)[N]) {
#pragma unroll
    for (int k = 2; k <= 16; k <<= 1)
#pragma unroll
        for (int j = k >> 1; j > 0; j >>= 1)
#pragma unroll
            for (int i = 0; i < 16; ++i) { const int l = i ^ j; if (l > i) { if ((i & k) == 0) ce_desc(v[BASE + i], v[BASE + l]); else ce_desc(v[BASE + l], v[BASE + i]); } }
}
template <int A, int B, int N> __device__ __forceinline__ void merge_top16(unsigned (&v)[N]) {
#pragma unroll
    for (int i = 0; i < 16; ++i) { const unsigned x = v[A + i], y = v[B + 15 - i]; v[A + i] = x > y ? x : y; }
#pragma unroll
    for (int j = 8; j > 0; j >>= 1)
#pragma unroll
        for (int i = 0; i < 16; ++i) { const int l = i ^ j; if (l > i) ce_desc(v[A + i], v[A + l]); }
}
constexpr int KS_STRIDE = 272;
constexpr int RT_KS_BYTES = 256 * KS_STRIDE;
constexpr int RT_TAB_WORDS = 33;
__device__ __forceinline__ void p11_route(const Params& p, LAS unsigned char* lds, int vcu, int G, int tid, int wave, int lane) {
    unsigned char* ws = p.ws;
    for (int i = tid; i < 256 * 16; i += NTHREADS) { const int row = i >> 4, ch = i & 15; *(LAS v4u*)(lds + row * KS_STRIDE + ch * 16) = *((const v4u*)(ws + WS_KS) + i); }
    __syncthreads();
    LAS unsigned* tab = (LAS unsigned*)(lds + RT_KS_BYTES) + (wave * 64 + lane) * RT_TAB_WORDS;
    const int r32 = lane & 31, hi = lane >> 5;
    const int gw = vcu * NWAVES + wave, NGW = G * NWAVES;
    const bf16* PQ = (const bf16*)(ws + WS_PQ);
    int* IDS = (int*)(ws + WS_IDS); float* GATES = (float*)(ws + WS_GATES);
    for (int task = gw; task < (NTOK / 32) * 8; task += NGW) {
        const int tb = task >> 3, h = task & 7;
        const int token = tb * 32 + r32;
        unsigned v[128];
        {
            const bf16* qrow = PQ + (size_t)token * 2048 + h * 256 + hi * 8;
#pragma unroll
            for (int t = 0; t < 4; ++t) {
                f32x16v acc[2];
#pragma unroll
                for (int w = 0; w < 2; ++w) {
                    f32x16v c = {};
                    const LAS unsigned char* kb = lds + (w * 128 + t * 32 + r32) * KS_STRIDE + hi * 16;
#pragma unroll
                    for (int s = 0; s < 8; ++s) { const bf16x8 a = *(const LAS bf16x8*)(kb + s * 32); const bf16x8 qf = *(const bf16x8*)(qrow + w * 128 + 16 * s); c = __builtin_amdgcn_mfma_f32_32x32x16_bf16(a, qf, c, 0, 0, 0); }
                    acc[w] = c;
                }
#pragma unroll
                for (int r = 0; r < 16; ++r) {
                    const float xa = acc[0][r], xb = acc[1][r];
                    auto rr = __builtin_amdgcn_permlane32_swap(__float_as_uint(xa), __float_as_uint(xb), false, false);
                    const unsigned r0 = rr[0], r1 = rr[1];
                    const int cr = (r & 3) + 8 * (r >> 2);
                    v[t * 16 + r] = (mono(__uint_as_float(r0)) & ~0x7Fu) | (unsigned)(32 * t + cr);
                    v[64 + t * 16 + r] = (mono(__uint_as_float(r1)) & ~0x7Fu) | (unsigned)(32 * t + cr + 4);
                }
            }
        }
        bitonic_sort_desc<0>(v); bitonic_sort_desc<16>(v); bitonic_sort_desc<32>(v); bitonic_sort_desc<48>(v);
        bitonic_sort_desc<64>(v); bitonic_sort_desc<80>(v); bitonic_sort_desc<96>(v); bitonic_sort_desc<112>(v);
        merge_top16<0, 16>(v); merge_top16<32, 48>(v); merge_top16<64, 80>(v); merge_top16<96, 112>(v);
        merge_top16<0, 32>(v); merge_top16<64, 96>(v);
        merge_top16<0, 64>(v);
        unsigned T[16], U[16];
#pragma unroll
        for (int i = 0; i < 16; ++i) { auto rr = __builtin_amdgcn_permlane32_swap(v[i], v[i], false, false); T[i] = v[i]; U[i] = hi ? rr[0] : rr[1]; }
        { const int bT = hi ? 16 : 0, bU = hi ? 0 : 16;
#pragma unroll
          for (int i = 0; i < 16; ++i) { tab[bT + i] = T[i] & 0x7Fu; tab[bU + i] = U[i] & 0x7Fu; } }
        float tv[16], uv[16];
#pragma unroll
        for (int i = 0; i < 16; ++i) { tv[i] = unmono(T[i] & ~0x7Fu); uv[i] = unmono(U[i] & ~0x7Fu); }
        unsigned c[32];
        {
            int n = 0;
#pragma unroll
            for (int i = 0; i < 4; ++i)
#pragma unroll
                for (int j = i; j < 16; ++j) if ((i + 1) * (j + 1) <= 16) {
                    const float s = tv[i] + uv[j];
                    const unsigned pay = hi ? (unsigned)((j << 4) | i) : (unsigned)((i << 4) | j);
                    unsigned key = (mono(s) & ~0xFFu) | pay;
                    if (i == j && hi) key = 0u;
                    c[n++] = key;
                }
#pragma unroll
            for (int k = 27; k < 32; ++k) c[k] = 0u;
        }
        bitonic_sort_desc<0>(c); bitonic_sort_desc<16>(c); merge_top16<0, 16>(c);
        unsigned W[32];
#pragma unroll
        for (int i = 0; i < 16; ++i) { auto rr = __builtin_amdgcn_permlane32_swap(c[i], c[i], false, false); W[i] = rr[0]; W[16 + i] = rr[1]; }
        merge_top16<0, 16>(W);
        asm volatile("s_waitcnt lgkmcnt(0)" ::: "memory");
        if (!hi) {
            int ids[16];
#pragma unroll
            for (int k = 0; k < 16; ++k) ids[k] = (int)(tab[(W[k] >> 4) & 15u] * 128u + tab[16 + (W[k] & 15u)]);
            int* o = IDS + (size_t)token * 128 + h * 16;
#pragma unroll
            for (int k = 0; k < 16; k += 4) *(v4u*)(o + k) = (v4u){(unsigned)ids[k], (unsigned)ids[k + 1], (unsigned)ids[k + 2], (unsigned)ids[k + 3]};
        } else {
            float e[16]; const float s0 = unmono(W[0] & ~0xFFu); float sum = 0.f;
#pragma unroll
            for (int k = 0; k < 16; ++k) { e[k] = __expf(unmono(W[k] & ~0xFFu) - s0); sum += e[k]; }
            const float inv = 1.0f / sum;
            float* o = GATES + (size_t)token * 128 + h * 16;
#pragma unroll
            for (int k = 0; k < 16; k += 4) *(f32x4*)(o + k) = (f32x4){e[k] * inv, e[k + 1] * inv, e[k + 2] * inv, e[k + 3] * inv};
        }
        asm volatile("s_waitcnt lgkmcnt(0)" ::: "memory");
    }
}

__device__ __forceinline__ void p12_gather(const Params& p, LAS unsigned char* lds, int vcu, int G, int wave, int lane) {
    unsigned char* ws = p.ws;
    const int gw = vcu * NWAVES + wave, NGW = G * NWAVES;
    LAS float* hb = (LAS float*)lds + wave * 256;
    LAS int* ib = (LAS int*)(hb + 128);
    const bf16* U16 = (const bf16*)(ws + WS_U16); const bf16* V16 = (const bf16*)(ws + WS_V16);
    const int g = lane >> 4, j = lane & 15;
    for (int t = gw; t < NTOK; t += NGW) {
        const int* idp = (const int*)(ws + WS_IDS) + (size_t)t * 128; const float* gp = (const float*)(ws + WS_GATES) + (size_t)t * 128;
        const int id_lo = idp[lane], id_hi = idp[lane + 64]; const float g_lo = gp[lane], g_hi = gp[lane + 64];
        ib[lane] = id_lo; ib[lane + 64] = id_hi;
        v4u x[8];
        const bf16* xr = (const bf16*)(ws + WS_XN2) + (size_t)t * 1024 + 8 * j;
#pragma unroll
        for (int c = 0; c < 8; ++c) x[c] = *(const v4u*)(xr + c * 128);
#pragma unroll 1
        for (int i = 0; i < 32; ++i) {
            const int e = 4 * i + g;
            const int id = __shfl((i < 16) ? id_lo : id_hi, e & 63);
            const bf16* ur = U16 + (size_t)id * 1024 + 8 * j;
            v4u u[8];
#pragma unroll
            for (int c = 0; c < 8; ++c) u[c] = *(const v4u*)(ur + c * 128);
            float a0 = 0.f, a1 = 0.f;
#pragma unroll
            for (int c = 0; c < 8; ++c) {
                const unsigned ux = u[c].x, uy = u[c].y, uz = u[c].z, uw = u[c].w, xx = x[c].x, xy = x[c].y, xz = x[c].z, xw = x[c].w;
                a0 = __builtin_amdgcn_fdot2_f32_bf16(__builtin_bit_cast(bf16x2_t, ux), __builtin_bit_cast(bf16x2_t, xx), a0, false);
                a1 = __builtin_amdgcn_fdot2_f32_bf16(__builtin_bit_cast(bf16x2_t, uy), __builtin_bit_cast(bf16x2_t, xy), a1, false);
                a0 = __builtin_amdgcn_fdot2_f32_bf16(__builtin_bit_cast(bf16x2_t, uz), __builtin_bit_cast(bf16x2_t, xz), a0, false);
                a1 = __builtin_amdgcn_fdot2_f32_bf16(__builtin_bit_cast(bf16x2_t, uw), __builtin_bit_cast(bf16x2_t, xw), a1, false);
            }
            const float s = dpp_sum16(a0 + a1);
            if (j == 0) hb[e] = s;
        }
        asm volatile("s_waitcnt lgkmcnt(0)" ::: "memory");
        {
            const float h0 = hb[lane], h1 = hb[lane + 64];
            const float w0 = g_lo * 0.5f * h0 * (1.0f + erff(h0 * 0.70710678118654752f)), w1 = g_hi * 0.5f * h1 * (1.0f + erff(h1 * 0.70710678118654752f));
            asm volatile("s_waitcnt lgkmcnt(0)" ::: "memory");
            hb[lane] = w0; hb[lane + 64] = w1;
        }
        asm volatile("s_waitcnt lgkmcnt(0)" ::: "memory");
        float o[16];
#pragma unroll
        for (int k = 0; k < 16; ++k) o[k] = 0.f;
        for (int e0 = 0; e0 < 128; e0 += 8) {
            v4u va[8], vb[8]; float w[8];
#pragma unroll
            for (int q = 0; q < 8; ++q) {
                const int id = __builtin_amdgcn_readfirstlane(ib[e0 + q]); { const float hv = hb[e0 + q]; w[q] = __int_as_float(__builtin_amdgcn_readfirstlane(__float_as_int(hv))); }
                const bf16* vr = V16 + (size_t)id * 1024 + 8 * lane;
                va[q] = *(const v4u*)vr; vb[q] = *(const v4u*)(vr + 512);
            }
#pragma unroll
            for (int q = 0; q < 8; ++q) {
                float f[8]; unpack8(va[q], f);
#pragma unroll
                for (int k = 0; k < 8; ++k) o[k] = fmaf(w[q], f[k], o[k]);
                unpack8(vb[q], f);
#pragma unroll
                for (int k = 0; k < 8; ++k) o[8 + k] = fmaf(w[q], f[k], o[8 + k]);
            }
        }
        float* orow = p.out + (size_t)t * 1024 + 8 * lane;
        const f32x4 r0 = *(const f32x4*)orow, r1 = *(const f32x4*)(orow + 4), r2 = *(const f32x4*)(orow + 512), r3 = *(const f32x4*)(orow + 516);
        *(f32x4*)orow = (f32x4){r0.x + o[0], r0.y + o[1], r0.z + o[2], r0.w + o[3]};
        *(f32x4*)(orow + 4) = (f32x4){r1.x + o[4], r1.y + o[5], r1.z + o[6], r1.w + o[7]};
        *(f32x4*)(orow + 512) = (f32x4){r2.x + o[8], r2.y + o[9], r2.z + o[10], r2.w + o[11]};
        *(f32x4*)(orow + 516) = (f32x4){r3.x + o[12], r3.y + o[13], r3.z + o[14], r3.w + o[15]};
    }
}


#if DIAG
constexpr size_t WS_DIAG = 1006 * MiB;
constexpr size_t WS_DSAVE = 1007 * MiB;
__device__ __forceinline__ unsigned dhash(unsigned x) { x ^= x >> 16; x *= 0x7feb352dU; x ^= x >> 15; x *= 0x846ca68bU; x ^= x >> 16; return x; }
__device__ __forceinline__ float bf2f(bf16 b) { return __builtin_bit_cast(float, (unsigned)b << 16); }
__device__ __forceinline__ float rbf(float x) { return bf2f((bf16)f2bf(x)); }
__device__ __forceinline__ void diag_report(const Params& p, int stage, float err) {
    if (!(err == err)) err = 1e30f;
#pragma unroll
    for (int o = 1; o < 64; o <<= 1) err = fmaxf(err, __shfl_xor(err, o));
    int t_ = threadIdx.x; asm volatile("" : "+v"(t_)); if ((t_ & 63) == 0) atomicMax((unsigned*)(p.ws + WS_DIAG) + stage, __builtin_bit_cast(unsigned, err));
}
#define DG_IDS() int tid_ = threadIdx.x; asm volatile("" : "+v"(tid_)); const int tid = tid_, lane = tid & 63; int G_ = gridDim.x; asm volatile("" : "+s"(G_)); const int gt = blockIdx.x * NTHREADS + tid, NGT = G_ * NTHREADS; const int gwv = gt >> 6, NGWV = NGT >> 6; (void)lane; (void)gwv; (void)NGWV; (void)NGT
__device__ __forceinline__ float relerr(float got, float ref, float fl) { return fabsf(got - ref) / (fabsf(ref) + fl); }

__device__ __forceinline__ void dg_p0(const Params& p) {
    DG_IDS(); unsigned char* ws = p.ws; float e1 = 0.f, e2 = 0.f;
    for (int s = gwv; s < 4096; s += NGWV) {
        const int m = dhash(s * 7 + 1) % R; const int b = m / TP, pp = m - b * TP;
        const bf16* xn = (const bf16*)(ws + WS_XN) + (size_t)m * 1024;
        if (pp < 48) { for (int c = lane; c < 1024; c += 64) e1 = fmaxf(e1, fabsf(bf2f(xn[c]))); continue; }
        const float* xr = (pp < 64) ? p.in[I_META] + (size_t)(pp - 48) * 1024 : p.in[I_X] + ((size_t)b * SEQ + (pp - 64)) * 1024;
        float ss = 0.f; for (int c = lane; c < 1024; c += 64) ss += xr[c] * xr[c];
        ss = wave_sum(ss); const float rs = 1.0f / sqrtf(ss / 1024.f + NORM_EPS);
        for (int c = lane; c < 1024; c += 64) e1 = fmaxf(e1, relerr(bf2f(xn[c]), xr[c] * rs * p.in[I_N1G][c], 0.05f));
    }
    for (int s = gt; s < 200000; s += NGT) {
        const unsigned hsh = dhash(s * 3 + 5); const int k = hsh & 1023, n = (hsh >> 10) % N1; const int sc = win_src_col(n);
        const float ref = sc >= 0 ? p.in[I_WIN][(size_t)k * IN_COLS + sc] : 0.f;
        e2 = fmaxf(e2, fabsf(bf2f(((const bf16*)(ws + WS_WTIN))[(size_t)n * 1024 + k]) - rbf(ref)));
        const int n2 = (hsh >> 10) & 2047;
        e2 = fmaxf(e2, fabsf(bf2f(((const bf16*)(ws + WS_WTQ))[(size_t)n2 * 1024 + k]) - rbf(p.in[I_PWQ][(size_t)k * 2048 + n2])));
        const int n3 = n2 & 1023, k3 = k & 511;
        e2 = fmaxf(e2, fabsf(bf2f(((const bf16*)(ws + WS_WTFOX))[(size_t)n3 * 512 + k3]) - rbf(p.in[I_WFOX][(size_t)k3 * 1024 + n3])));
        e2 = fmaxf(e2, fabsf(bf2f(((const bf16*)(ws + WS_WTRWKV))[(size_t)n3 * 512 + k3]) - rbf(p.in[I_WRWKV][(size_t)k3 * 1024 + n3])));
        e2 = fmaxf(e2, fabsf(bf2f(((const bf16*)(ws + WS_WTOUT))[(size_t)n3 * 1024 + k]) - rbf(p.in[I_WOUT][(size_t)k * 1024 + n3])));
        const size_t ei = (size_t)(hsh % (16384u * 1024u));
        e2 = fmaxf(e2, fabsf(bf2f(((const bf16*)(ws + WS_U16))[ei]) - rbf(p.in[I_PU][ei])));
        e2 = fmaxf(e2, fabsf(bf2f(((const bf16*)(ws + WS_V16))[ei]) - rbf(p.in[I_PV][ei])));
    }
    diag_report(p, 1, e1 / 0.03f); diag_report(p, 2, e2 / 1e-6f);
}
__device__ __forceinline__ float dg_dot(const bf16* A, size_t row, const bf16* Bt, size_t n, int K) {
    const bf16* a = A + row * K; const bf16* b = Bt + n * K; float s = 0.f;
    for (int k = 0; k < K; k += 8) { float x[8], y[8]; unpack8(*(const v4u*)(a + k), x); unpack8(*(const v4u*)(b + k), y);
#pragma unroll
        for (int e = 0; e < 8; ++e) s = fmaf(x[e], y[e], s); }
    return s;
}
__device__ __forceinline__ void dg_gemm1(const Params& p) {
    DG_IDS(); unsigned char* ws = p.ws; float e = 0.f;
    for (int s = gt; s < 262144; s += NGT) {
        const unsigned hsh = dhash(s * 11 + 3); const int row = hsh % R, n = dhash(hsh) % N1;
        const float ref = dg_dot((const bf16*)(ws + WS_XN), row, (const bf16*)(ws + WS_WTIN), n, 1024);
        float got, want;
        if (n < 3584) { got = bf2f(((const bf16*)(ws + WS_F))[(size_t)(n >> 9) * ((size_t)R * 512) + (size_t)row * 512 + (n & 511)]); want = ref; }
        else { got = bf2f(((const bf16*)(ws + WS_ZG))[(size_t)row * 2048 + (n - 3584)]); want = 1.0f / (1.0f + expf(-ref)); }
        e = fmaxf(e, relerr(got, want, 0.25f));
    }
    diag_report(p, 3, e / 0.02f);
}
__device__ __forceinline__ void dg_p2(const Params& p) {
    DG_IDS(); unsigned char* ws = p.ws; float e = 0.f;
    for (int s = gt; s < 262144; s += NGT) {
        const unsigned hsh = dhash(s * 13 + 7); const int m = hsh % R, c = dhash(hsh) % 296; const int pp = m % TP;
        const bf16* zm = (const bf16*)(ws + WS_ZM);
        const float z = bf2f(zm[(size_t)m * 512 + c]);
        if (c >= 288) { const float x = z + p.in[I_FBIAS][c - 288]; const float want = -log1pf(expf(-x)); e = fmaxf(e, relerr(((const float*)(ws + WS_LF))[(size_t)m * 8 + (c - 288)], want, 0.01f)); continue; }
        const float zp = pp > 0 ? bf2f(zm[(size_t)(m - 1) * 512 + c]) : 0.f; const float mu = p.in[I_MU][1536 + c];
        const float zs = z + mu * (zp - z);
        if (c < 64) e = fmaxf(e, relerr(bf2f(((const bf16*)(ws + WS_LA))[(size_t)m * 128 + c]), tanhf(zs), 0.1f));
        else if (c < 128) e = fmaxf(e, relerr(bf2f(((const bf16*)(ws + WS_LA))[(size_t)m * 128 + c]), zs, 0.1f));
        else e = fmaxf(e, relerr(bf2f(((const bf16*)(ws + WS_LG))[(size_t)m * 256 + (c - 128)]), 1.0f / (1.0f + expf(-zs)), 0.1f));
        if (pp >= 48) { const int h = c & 7; float sq = 0.f, sk = 0.f;
            for (int d = 0; d < 64; ++d) { const float q = bf2f(((const bf16*)(ws + WS_FQ))[(size_t)m * 512 + h * 64 + d]) / (p.in[I_FQN][h * 64 + d] * attn_body::C2); sq += q * q;
                const float k = bf2f(((const bf16*)(ws + WS_FK))[(size_t)m * 512 + h * 64 + d]) / p.in[I_FKN][h * 64 + d]; sk += k * k; }
            e = fmaxf(e, fabsf(sq / 64.f - 1.f)); e = fmaxf(e, fabsf(sk / 64.f - 1.f)); }
    }
    diag_report(p, 4, e / 0.03f);
}
__device__ __forceinline__ void dg_p3(const Params& p) {
    DG_IDS(); unsigned char* ws = p.ws; unsigned char* dob = (unsigned char*)p.out; float e5 = 0.f, e6 = 0.f;
    for (int s = gt; s < 131072; s += NGT) {
        const unsigned hsh = dhash(s * 17 + 9); const int seq = hsh & 127, pp = (hsh >> 7) % TP; const int b = seq >> 3, h = seq & 7;
        const float* kb = (const float*)(ws + WS_KB) + (size_t)seq * TP; const float lf = ((const float*)(ws + WS_LF))[((size_t)b * TP + pp) * 8 + h];
        if (pp < 48) e5 = fmaxf(e5, kb[pp] < -1e29f ? 0.f : 1.f);
        else if (pp == 48) e5 = fmaxf(e5, fabsf(kb[pp] + lf * LOG2E));
        else e5 = fmaxf(e5, fabsf((kb[pp] - kb[pp - 1]) + lf * LOG2E));
        const int m = dhash(hsh) % R, c = dhash(hsh + 1) % 1536;
        const bf16* la = (const bf16*)(ws + WS_LA) + (size_t)m * 128; const bf16* lg = (const bf16*)(ws + WS_LG) + (size_t)m * 256;
        if (c < 512) { float a = p.in[I_W0][c]; for (int k = 0; k < 64; ++k) a += bf2f(la[k]) * rbf(p.in[I_WUP][k * 512 + c]);
            const float w = -log1pf(expf(-a)) - 0.5f; const float want = 1.0f - expf(-expf(w));
            e6 = fmaxf(e6, relerr(bf2f(((const bf16*)(dob + DO_XW))[(size_t)m * 512 + c]), want, 0.002f)); }
        else if (c < 1024) { float a = p.in[I_A0][c - 512]; for (int k = 0; k < 64; ++k) a += bf2f(la[64 + k]) * rbf(p.in[I_AUP][k * 512 + (c - 512)]);
            e6 = fmaxf(e6, relerr(bf2f(((const bf16*)(dob + DO_AA))[(size_t)m * 512 + (c - 512)]), 1.0f / (1.0f + expf(-a)), 0.05f)); }
        else { float a = 0.f; for (int k = 0; k < 160; ++k) a += bf2f(lg[k]) * rbf(p.in[I_GUP][k * 512 + (c - 1024)]);
            e6 = fmaxf(e6, relerr(bf2f(((const bf16*)(dob + DO_GG))[(size_t)m * 512 + (c - 1024)]), a, 0.1f)); }
    }
    diag_report(p, 5, e5 / 1e-3f); diag_report(p, 6, e6 / 0.03f);
}
constexpr int DG_NS4 = 2048;
__device__ __forceinline__ void dg_p4_pre(const Params& p) {
    DG_IDS(); unsigned char* dob = (unsigned char*)p.out; float* sv = (float*)(p.ws + WS_DSAVE);
    for (int s = gt; s < DG_NS4 * 64; s += NGT) { const int i = s >> 6, d = s & 63; const unsigned hsh = dhash(i * 19 + 11); const int m = hsh % R, h = (hsh >> 20) & 7;
        sv[s] = bf2f(((const bf16*)(dob + DO_AA))[(size_t)m * 512 + h * 64 + d]); }
}
__device__ __forceinline__ void dg_p4_post(const Params& p) {
    DG_IDS(); unsigned char* ws = p.ws; unsigned char* dob = (unsigned char*)p.out; const float* sv = (const float*)(ws + WS_DSAVE); float e = 0.f;
    for (int i = gwv; i < DG_NS4; i += NGWV) {
        const unsigned hsh = dhash(i * 19 + 11); const int m = hsh % R, h = (hsh >> 20) & 7; const int pp = m % TP; const int c = h * 64 + lane;
        const float a = sv[i * 64 + lane];
        const float r0 = bf2f(((const bf16*)(ws + WS_ZRR))[(size_t)m * 512 + c]), k0 = bf2f(((const bf16*)(ws + WS_ZRK))[(size_t)m * 512 + c]);
        const float r1 = pp > 0 ? bf2f(((const bf16*)(ws + WS_ZRR))[(size_t)(m - 1) * 512 + c]) : 0.f, k1 = pp > 0 ? bf2f(((const bf16*)(ws + WS_ZRK))[(size_t)(m - 1) * 512 + c]) : 0.f;
        const float rs = r0 + p.in[I_MU][c] * (r1 - r0), ks = k0 + p.in[I_MU][512 + c] * (k1 - k0);
        const float kk = ks * p.in[I_KK][c], kp = ks * (1.0f + (a - 1.0f) * p.in[I_KA][c]);
        const float nrm = fmaxf(sqrtf(wave_sum(kk * kk)), 1e-12f); const float kn = kk / nrm, bb = kn * a; const float bs = wave_sum(rs * kp * p.in[I_RK][c]);
        e = fmaxf(e, relerr(bf2f(((const bf16*)(ws + WS_KP))[(size_t)m * 512 + c]), kp, 0.1f));
        e = fmaxf(e, relerr(bf2f(((const bf16*)(ws + WS_KN))[(size_t)m * 512 + c]), kn, 0.02f));
        e = fmaxf(e, relerr(bf2f(((const bf16*)(dob + DO_AA))[(size_t)m * 512 + c]), bb, 0.02f));
        e = fmaxf(e, relerr(((const float*)(ws + WS_BS))[(size_t)m * 8 + h], bs, 0.1f));
    }
    diag_report(p, 7, e / 0.03f);
}
constexpr int DG_NS8 = 1024;
__device__ __forceinline__ void dg_attn_sample(int i, int& b, int& h, int& t) { const unsigned hsh = dhash(i * 23 + 13); b = hsh & 15; h = (hsh >> 4) & 7; t = (hsh >> 8) & 4095; if (i < 8) t = (i & 1) ? 4095 - (i >> 1) : (i >> 1); }
__device__ __forceinline__ void dg_attn_pre(const Params& p) {
    DG_IDS(); float* sv = (float*)(p.ws + WS_DSAVE + 512 * 1024);
    for (int s = gt; s < DG_NS8 * 64; s += NGT) { const int i = s >> 6, d = s & 63; int b, h, t; dg_attn_sample(i, b, h, t);
        sv[s] = bf2f(((const bf16*)(p.ws + WS_FQ))[((size_t)b * TP + 64 + t) * 512 + h * 64 + d]); }
}
__device__ __forceinline__ void dg_attn_post(const Params& p) {
    DG_IDS(); unsigned char* ws = p.ws; const float* sv = (const float*)(ws + WS_DSAVE + 512 * 1024); float e = 0.f;
    for (int i = gwv; i < DG_NS8; i += NGWV) {
        int b, h, t; dg_attn_sample(i, b, h, t);
        const int npos = 64 + t;
        const float* kb = (const float*)(ws + WS_KB) + (size_t)(b * 8 + h) * TP;
        const bf16* K = (const bf16*)(ws + WS_FK) + (size_t)b * TP * 512 + h * 64; const bf16* V = (const bf16*)(ws + WS_FV) + (size_t)b * TP * 512 + h * 64;
        float mx = -1e38f;
        for (int j = 48 + lane; j <= npos; j += 64) { float s = 0.f; for (int d = 0; d < 64; ++d) s += sv[i * 64 + d] * bf2f(K[(size_t)j * 512 + d]); s += kb[j]; mx = fmaxf(mx, s); }
        for (int o = 1; o < 64; o <<= 1) mx = fmaxf(mx, __shfl_xor(mx, o));
        float l = 0.f, acc = 0.f;
        for (int j = 48; j <= npos; ++j) { float s = 0.f; for (int d = 0; d < 64; ++d) s += sv[i * 64 + d] * bf2f(K[(size_t)j * 512 + d]); const float pj = exp2f(s + kb[j] - mx); l += pj; acc += pj * bf2f(V[(size_t)j * 512 + lane]); }
        const float want = acc / l; const float got = bf2f(((const bf16*)(ws + WS_FQ))[((size_t)b * TP + 64 + t) * 512 + h * 64 + lane]);
        e = fmaxf(e, fabsf(got - want) / (fabsf(want) + 0.05f));
    }
    diag_report(p, 8, e / 0.05f);
}
__device__ __forceinline__ void dg_scan(const Params& p) {
    DG_IDS(); unsigned char* ws = p.ws; unsigned char* dob = (unsigned char*)p.out; float e = 0.f;
    if (gwv < 4) {
        const int bh = (gwv * 37 + 5) & 127, b = bh >> 3, h = bh & 7; const size_t rowb = (size_t)b * TP; const int cb = h * 64;
        float S[64];
#pragma unroll
        for (int k = 0; k < 64; ++k) S[k] = 0.f;
        const bf16* aXW = (const bf16*)(dob + DO_XW); const bf16* aKN = (const bf16*)(ws + WS_KN); const bf16* aBB = (const bf16*)(dob + DO_AA); const bf16* aKP = (const bf16*)(ws + WS_KP);
        const bf16* aR = (const bf16*)(ws + WS_ZRR); const bf16* aV = (const bf16*)(ws + WS_ZRV);
        const float muv = p.in[I_MU][1024 + cb + lane];
        for (int pp = 48; pp < TP; ++pp) {
            const size_t ro = (rowb + pp) * 512 + cb;
            const float v0 = bf2f(aV[ro + lane]), v1 = bf2f(aV[ro - 512 + lane]); const float vv = v0 + muv * (v1 - v0);
            float sa = 0.f;
#pragma unroll
            for (int k = 0; k < 64; ++k) sa += S[k] * bf2f(aKN[ro + k]);
            sa = -sa; float y = 0.f;
#pragma unroll
            for (int k = 0; k < 64; ++k) { const float dec = 1.0f - bf2f(aXW[ro + k]); S[k] = S[k] * dec + sa * bf2f(aBB[ro + k]) + vv * bf2f(aKP[ro + k]);
                const float r0 = bf2f(aR[ro + k]), r1 = bf2f(aR[ro - 512 + k]); y += S[k] * (r0 + p.in[I_MU][cb + k] * (r1 - r0)); }
            const float got = bf2f(((const bf16*)(ws + WS_Y))[ro + lane]);
            e = fmaxf(e, fabsf(got - y) / (fabsf(y) + 0.3f));
        }
    }
    diag_report(p, 9, e / 0.05f);
}
__device__ __forceinline__ void dg_p6_pre(const Params& p) {
    DG_IDS(); float* sv = (float*)(p.ws + WS_DSAVE + 768 * 1024);
    for (int s = gt; s < DG_NS4 * 64; s += NGT) { const int i = s >> 6, d = s & 63; const unsigned hsh = dhash(i * 29 + 17); const int m = hsh % R, h = (hsh >> 20) & 7;
        sv[s] = bf2f(((const bf16*)(p.ws + WS_Y))[(size_t)m * 512 + h * 64 + d]); }
}
__device__ __forceinline__ void dg_p6_post(const Params& p) {
    DG_IDS(); unsigned char* ws = p.ws; unsigned char* dob = (unsigned char*)p.out; const float* sv = (const float*)(ws + WS_DSAVE + 768 * 1024); float e = 0.f;
    for (int i = gwv; i < DG_NS4; i += NGWV) {
        const unsigned hsh = dhash(i * 29 + 17); const int m = hsh % R, h = (hsh >> 20) & 7; const int pp = m % TP; const int c = h * 64 + lane;
        if (pp < 48) continue;
        const float y = sv[i * 64 + lane]; const float mean = wave_sum(y) / 64.f; const float var = wave_sum((y - mean) * (y - mean)) / 64.f;
        const float gn = (y - mean) / sqrtf(var + GN_EPS) * p.in[I_LNG][c] + p.in[I_LNB][c];
        const float v0 = bf2f(((const bf16*)(ws + WS_ZRV))[(size_t)m * 512 + c]), v1 = bf2f(((const bf16*)(ws + WS_ZRV))[(size_t)(m - 1) * 512 + c]);
        const float vs = v0 + p.in[I_MU][1024 + c] * (v1 - v0);
        const float want = (gn + ((const float*)(ws + WS_BS))[(size_t)m * 8 + h] * vs) * bf2f(((const bf16*)(dob + DO_GG))[(size_t)m * 512 + c]);
        e = fmaxf(e, relerr(bf2f(((const bf16*)(ws + WS_Y))[(size_t)m * 512 + c]), want, 0.1f));
    }
    diag_report(p, 10, e / 0.03f);
}
__device__ __forceinline__ void dg_mix(const Params& p, int stage) {
    DG_IDS(); unsigned char* ws = p.ws; float e = 0.f;
    for (int s = gt; s < 131072; s += NGT) {
        const unsigned hsh = dhash(s * 31 + 19 + stage); const int row = hsh % R, c = dhash(hsh) & 1023;
        float want = dg_dot((const bf16*)(ws + WS_FQ), row, (const bf16*)(ws + WS_WTFOX), c, 512) * bf2f(((const bf16*)(ws + WS_ZG))[(size_t)row * 2048 + c]);
        if (stage == 12) want = rbf(want) + dg_dot((const bf16*)(ws + WS_Y), row, (const bf16*)(ws + WS_WTRWKV), c, 512) * bf2f(((const bf16*)(ws + WS_ZG))[(size_t)row * 2048 + 1024 + c]);
        e = fmaxf(e, relerr(bf2f(((const bf16*)(ws + WS_MIX))[(size_t)row * 1024 + c]), want, 0.1f));
    }
    diag_report(p, stage, e / 0.03f);
}
__device__ __forceinline__ void dg_out(const Params& p) {
    DG_IDS(); unsigned char* ws = p.ws; float e = 0.f;
    for (int s = gt; s < 131072; s += NGT) {
        const unsigned hsh = dhash(s * 37 + 23); const int tok = hsh & 65535, c = dhash(hsh) & 1023; const int b = tok >> 12, t = tok & 4095;
        const float want = p.in[I_X][(size_t)tok * 1024 + c] + dg_dot((const bf16*)(ws + WS_MIX), (size_t)b * TP + 64 + t, (const bf16*)(ws + WS_WTOUT), c, 1024);
        e = fmaxf(e, relerr(p.out[(size_t)tok * 1024 + c], want, 0.3f));
    }
    diag_report(p, 13, e / 0.01f);
}
__device__ __forceinline__ void dg_norm2(const Params& p) {
    DG_IDS(); unsigned char* ws = p.ws; float e = 0.f;
    for (int s = gwv; s < 4096; s += NGWV) {
        const int m = dhash(s * 41 + 29) & 65535; const float* xr = p.out + (size_t)m * 1024;
        float ss = 0.f; for (int c = lane; c < 1024; c += 64) ss += xr[c] * xr[c];
        ss = wave_sum(ss); const float rs = 1.0f / sqrtf(ss / 1024.f + NORM_EPS);
        for (int c = lane; c < 1024; c += 64) e = fmaxf(e, relerr(bf2f(((const bf16*)(ws + WS_XN2))[(size_t)m * 1024 + c]), xr[c] * rs * p.in[I_N2G][c], 0.05f));
    }
    diag_report(p, 14, e / 0.03f);
}
__device__ __forceinline__ void dg_pq(const Params& p) {
    DG_IDS(); unsigned char* ws = p.ws; float e = 0.f;
    for (int s = gt; s < 131072; s += NGT) {
        const unsigned hsh = dhash(s * 43 + 31); const int tok = hsh & 65535, c = dhash(hsh) & 2047;
        const float want = dg_dot((const bf16*)(ws + WS_XN2), tok, (const bf16*)(ws + WS_WTQ), c, 1024);
        e = fmaxf(e, relerr(bf2f(((const bf16*)(ws + WS_PQ))[(size_t)tok * 2048 + c]), want, 0.25f));
    }
    diag_report(p, 15, e / 0.02f);
}
__device__ __forceinline__ void dg_route(const Params& p, LAS unsigned char* lds) {
    DG_IDS(); unsigned char* ws = p.ws; float e16 = 0.f, e17 = 0.f;
    LAS float* s2l = (LAS float*)lds + (tid >> 6) * 128;
    for (int i = gwv; i < 2048; i += NGWV) {
        const unsigned hsh = dhash(i * 47 + 37); const int tok = hsh & 65535, h = (hsh >> 16) & 7;
        const bf16* q = (const bf16*)(ws + WS_PQ) + (size_t)tok * 2048 + h * 256; const bf16* ks = (const bf16*)(ws + WS_KS);
        float s1a = 0.f, s1b = 0.f, s2a = 0.f, s2b = 0.f;
        for (int d = 0; d < 128; ++d) { const float q1 = bf2f(q[d]), q2 = bf2f(q[128 + d]);
            s1a += q1 * bf2f(ks[(size_t)lane * 128 + d]); s1b += q1 * bf2f(ks[(size_t)(lane + 64) * 128 + d]);
            s2a += q2 * bf2f(ks[(size_t)(128 + lane) * 128 + d]); s2b += q2 * bf2f(ks[(size_t)(192 + lane) * 128 + d]); }
        s2l[lane] = s2a; s2l[lane + 64] = s2b; asm volatile("s_waitcnt lgkmcnt(0)" ::: "memory");
        float prev_s = 3e38f; int prev_id = -1; float top_s[16]; int top_id[16];
#pragma unroll 1
        for (int r = 0; r < 16; ++r) {
            float bs = -3e38f; int bi = 0x7fffffff;
            for (int j = 0; j < 128; ++j) { const float t2 = s2l[j];
                { const float sm = s1a + t2; const int id = lane * 128 + j; const bool ok = (sm < prev_s) || (sm == prev_s && id > prev_id); if (ok && (sm > bs || (sm == bs && id < bi))) { bs = sm; bi = id; } }
                { const float sm = s1b + t2; const int id = (lane + 64) * 128 + j; const bool ok = (sm < prev_s) || (sm == prev_s && id > prev_id); if (ok && (sm > bs || (sm == bs && id < bi))) { bs = sm; bi = id; } } }
            for (int o = 1; o < 64; o <<= 1) { const float os = __shfl_xor(bs, o); const int oi = __shfl_xor(bi, o); if (os > bs || (os == bs && oi < bi)) { bs = os; bi = oi; } }
            top_s[r] = bs; top_id[r] = bi; prev_s = bs; prev_id = bi;
        }
        const int* ids = (const int*)(ws + WS_IDS) + (size_t)tok * 128 + h * 16; const float* gts = (const float*)(ws + WS_GATES) + (size_t)tok * 128 + h * 16;
        float den = 0.f;
#pragma unroll
        for (int r = 0; r < 16; ++r) den += expf(top_s[r] - top_s[0]);
        int miss = 0;
#pragma unroll
        for (int r = 0; r < 16; ++r) {
            bool found = false; for (int k = 0; k < 16; ++k) found |= (ids[k] == top_id[r]);
            if (!found && top_s[r] > top_s[15] + 2e-3f * fabsf(top_s[15]) + 1e-4f) ++miss;
            e17 = fmaxf(e17, fabsf(gts[r] - expf(top_s[r] - top_s[0]) / den));
        }
        e16 = fmaxf(e16, (float)miss);
        if (lane == 0 && miss) atomicAdd((float*)(ws + WS_DIAG) + 19, (float)miss);
    }
    diag_report(p, 16, e16 / 0.5f); diag_report(p, 17, e17 / 0.01f);
}
constexpr int DG_NS18 = 128;
__device__ __forceinline__ void dg_gather_pre(const Params& p) {
    DG_IDS(); float* sv = (float*)(p.ws + WS_DSAVE + 1280 * 1024);
    for (int s = gt; s < DG_NS18 * 1024; s += NGT) { const int i = s >> 10, c = s & 1023; const int tok = dhash(i * 53 + 41) & 65535; sv[s] = p.out[(size_t)tok * 1024 + c]; }
}
__device__ __forceinline__ void dg_gather_post(const Params& p) {
    DG_IDS(); unsigned char* ws = p.ws; const float* sv = (const float*)(ws + WS_DSAVE + 1280 * 1024); float e = 0.f;
    for (int i = gwv; i < DG_NS18; i += NGWV) {
        const int tok = dhash(i * 53 + 41) & 65535;
        const int* ids = (const int*)(ws + WS_IDS) + (size_t)tok * 128; const float* gts = (const float*)(ws + WS_GATES) + (size_t)tok * 128;
        const bf16* xn = (const bf16*)(ws + WS_XN2) + (size_t)tok * 1024;
        float o[16];
#pragma unroll
        for (int k = 0; k < 16; ++k) o[k] = 0.f;
        for (int ex = 0; ex < 128; ++ex) {
            const int id = ids[ex]; const bf16* ur = (const bf16*)(ws + WS_U16) + (size_t)id * 1024; const bf16* vr = (const bf16*)(ws + WS_V16) + (size_t)id * 1024;
            float d = 0.f;
#pragma unroll
            for (int k = 0; k < 16; ++k) d += bf2f(ur[lane * 16 + k]) * bf2f(xn[lane * 16 + k]);
            d = wave_sum(d); const float w = gts[ex] * 0.5f * d * (1.0f + erff(d * 0.70710678f));
#pragma unroll
            for (int k = 0; k < 16; ++k) o[k] += w * bf2f(vr[lane * 16 + k]);
        }
        float ss = 0.f;
#pragma unroll
        for (int k = 0; k < 16; ++k) ss += o[k] * o[k];
        const float rms = sqrtf(wave_sum(ss) / 1024.f);
#pragma unroll
        for (int k = 0; k < 16; ++k) e = fmaxf(e, fabsf((p.out[(size_t)tok * 1024 + lane * 16 + k] - sv[i * 1024 + lane * 16 + k]) - o[k]) / (rms + 1e-3f));
    }
    diag_report(p, 18, e / 0.05f);
}
__device__ __forceinline__ void dg_final(const Params& p) {
    DG_IDS(); const float* dg = (const float*)(p.ws + WS_DIAG);
    int k = 0;
    for (int s = 1; s <= 18; ++s) if (k == 0 && !(dg[s] <= 1.0f)) k = s;
#ifdef DIAG_SKIP
    { int kk = 0; for (int s = 1; s <= 18; ++s) if (kk == 0 && s > DIAG_SKIP && !(dg[s] <= 1.0f)) kk = s; k = kk; }
#endif
#ifdef DIAG_VALUE
    const float a = fminf(fmaxf(dg[DIAG_VALUE], 1e-3f), 1e6f) * 16.f;
#else
    const float a = exp2f((float)k);
#endif
    for (size_t i = gt; i < (size_t)NTOK * 1024 / 4; i += NGT) ((f32x4*)p.out)[i] = (f32x4){a, a, a, a};
}
#endif
#if DIAG
#define DG(...) __VA_ARGS__
#else
#define DG(...)
#endif
constexpr int LDS_BYTES = 147456;
static_assert(attn_body::ATTN_LDS_BYTES <= 131072, "attention LDS");
static_assert(RT_KS_BYTES + NTHREADS * RT_TAB_WORDS * 4 <= LDS_BYTES, "routing LDS");
static_assert((SC_CH * SC_STRIDE + SC_CH * 32) * 4 <= LDS_BYTES, "scan LDS");

__global__ void __launch_bounds__(NTHREADS, 2) hybrid_fwd(Params p) {
    extern __shared__ __attribute__((aligned(16))) unsigned char lds_raw[];
    cg::grid_group grid = cg::this_grid();
    LAS unsigned char* lds = (LAS unsigned char*)lds_raw;
    const int G0 = gridDim.x, bid = blockIdx.x;
#define LANE_IDS() int tid = threadIdx.x; asm volatile("" : "+v"(tid)); const int lane = tid & 63, wave = __builtin_amdgcn_readfirstlane(tid >> 6); (void)lane; (void)wave; int G = G0; asm volatile("" : "+s"(G))
    const int vcu = (G0 % 8 == 0) ? (bid % 8) * (G0 / 8) + bid / 8 : bid;
    unsigned char* ws = p.ws; unsigned char* dob = (unsigned char*)p.out;

    DG({ int t_ = threadIdx.x; asm volatile("" : "+v"(t_)); if (bid == 0 && t_ < 64) ((float*)(ws + WS_DIAG))[t_] = 0.f; })
    { LANE_IDS(); p0_prologue(p, lds, vcu, G, wave, lane); }
    grid.sync();
    DG(dg_p0(p);)
    run_gemm(lds, (const bf16*)(ws + WS_XN), (const bf16*)(ws + WS_WTIN), R, N1, 1024, G0, bid, F_Gemm1{(bf16*)(ws + WS_F), (bf16*)(ws + WS_ZG)});
    grid.sync();
    DG(dg_gemm1(p); grid.sync();)
    { LANE_IDS(); p2_prep1(p, vcu, G, wave, lane); }
    grid.sync();
    DG(dg_p2(p);)
    { LANE_IDS(); const int gwv = vcu * NWAVES + wave; for (int s = gwv; s < 128; s += G * NWAVES) p3_cumsum(p, s, lane); }
    __syncthreads();
    run_gemm(lds, (const bf16*)(ws + WS_LA), (const bf16*)(ws + WS_WTWA), R, 512, 128, G0, bid, F_LoraW{(bf16*)(dob + DO_XW), p.in[I_W0]});
    run_gemm(lds, (const bf16*)(ws + WS_LA), (const bf16*)(ws + WS_WTWA) + 512 * 128, R, 512, 128, G0, bid, F_LoraA{(bf16*)(dob + DO_AA), p.in[I_A0]});
    run_gemm(lds, (const bf16*)(ws + WS_LG), (const bf16*)(ws + WS_WTG), R, 512, 256, G0, bid, F_Plain{(bf16*)(dob + DO_GG), 512});
    grid.sync();
    DG(dg_p3(p); dg_p4_pre(p); grid.sync();)
    { LANE_IDS(); p4_prep2(p, vcu, G, wave, lane); }
    grid.sync();
    DG(dg_p4_post(p); dg_attn_pre(p); grid.sync();)
    {
        LANE_IDS();
        const int per = (1024 + G - 1) / G;
        int last_bh = -1;
        for (int pi = vcu * per; pi < (vcu + 1) * per && pi < 1024; ++pi) {
            const int bh = pi >> 3, pr = pi & 7;
            if (bh != last_bh) {
                __syncthreads();
                const float* kbg = (const float*)(ws + WS_KB) + (size_t)bh * TP; LAS float* kbl = (LAS float*)(lds + attn_body::LDS_KB);
                for (int i = tid; i < TP; i += NTHREADS) kbl[i] = kbg[i];
                asm volatile("s_waitcnt vmcnt(0) lgkmcnt(0)" ::: "memory");
                __syncthreads();
                last_bh = bh;
            }
#pragma unroll 1
            for (int k = 0; k < 2; ++k) {
                const int qb = k ? 15 - pr : pr;
                attn_body::attn_unit<8>(bh >> 3, bh & 7, qb, (const attn_body::bf16*)(ws + WS_FQ), (const attn_body::bf16*)(ws + WS_FK), (const attn_body::bf16*)(ws + WS_FV), (attn_body::bf16*)(ws + WS_FQ), (char*)lds_raw);
            }
        }
        __syncthreads();
        { int tid2 = threadIdx.x; asm volatile("" : "+v"(tid2)); for (int item = vcu; item < 256; item += G0) p5_scan_item(p, lds, item, tid2, __builtin_amdgcn_readfirstlane(tid2 >> 6), tid2 & 63); }
    }
    grid.sync();
    DG(dg_attn_post(p); dg_scan(p); dg_p6_pre(p); grid.sync();)
    { LANE_IDS(); p6_prep3(p, vcu, G, wave, lane); }
    grid.sync();
    DG(dg_p6_post(p);)
    run_gemm(lds, (const bf16*)(ws + WS_FQ), (const bf16*)(ws + WS_WTFOX), R, 1024, 512, G0, bid, F_MixA{(bf16*)(ws + WS_MIX), (const bf16*)(ws + WS_ZG)});
    grid.sync();
    DG(dg_mix(p, 11); grid.sync();)
    run_gemm(lds, (const bf16*)(ws + WS_Y), (const bf16*)(ws + WS_WTRWKV), R, 1024, 512, G0, bid, F_MixB{(bf16*)(ws + WS_MIX), (const bf16*)(ws + WS_ZG)});
    grid.sync();
    DG(dg_mix(p, 12);)
    run_gemm(lds, (const bf16*)(ws + WS_MIX), (const bf16*)(ws + WS_WTOUT), R, 1024, 1024, G0, bid, F_Out{p.in[I_X], p.out});
    grid.sync();
    DG(dg_out(p); grid.sync();)
    { LANE_IDS(); p9_norm2(p, vcu, G, wave, lane); }
    grid.sync();
    DG(dg_norm2(p);)
    run_gemm(lds, (const bf16*)(ws + WS_XN2), (const bf16*)(ws + WS_WTQ), NTOK, 2048, 1024, G0, bid, F_Plain{(bf16*)(ws + WS_PQ), 2048});
    grid.sync();
    DG(dg_pq(p);)
    { LANE_IDS(); p11_route(p, lds, vcu, G, tid, wave, lane); }
    grid.sync();
    DG(__syncthreads(); dg_route(p, lds); dg_gather_pre(p); grid.sync();)
    { LANE_IDS(); p12_gather(p, lds, vcu, G, wave, lane); }
    DG(grid.sync(); dg_gather_post(p); grid.sync(); dg_final(p);)
}

extern "C" void kernel_launch(void* const* d_in, const int* in_sizes, int n_in, void* d_out, int out_size, void* d_ws, size_t ws_size, hipStream_t stream) {
    static int grid = 0;
    if (grid == 0) {
        if (n_in != 27 || out_size != NTOK * DMODEL || ws_size < WS_END) { fprintf(stderr, "kernel_launch: unexpected shapes (n_in %d, out %d, ws %zu)\n", n_in, out_size, ws_size); grid = -1; return; }
        int dev = 0, cus = 0, per_cu = 0;
        hipGetDevice(&dev);
        hipDeviceGetAttribute(&cus, hipDeviceAttributeMultiprocessorCount, dev);
        hipFuncSetAttribute((const void*)hybrid_fwd, hipFuncAttributeMaxDynamicSharedMemorySize, LDS_BYTES);
        hipOccupancyMaxActiveBlocksPerMultiprocessor(&per_cu, (const void*)hybrid_fwd, NTHREADS, LDS_BYTES);
        if (per_cu < 1) { fprintf(stderr, "kernel_launch: occupancy query says %d blocks per CU\n", per_cu); grid = -1; return; }
        grid = cus;
    }
    if (grid < 0) return;
    Params p{};
    for (int i = 0; i < 27; ++i) p.in[i] = (const float*)d_in[i];
    p.out = (float*)d_out; p.ws = (unsigned char*)d_ws;
    void* args[] = {&p};
    hipError_t e = hipLaunchCooperativeKernel((const void*)hybrid_fwd, dim3(grid), dim3(NTHREADS), args, LDS_BYTES, stream);
    if (e != hipSuccess) fprintf(stderr, "cooperative launch failed: %s (grid %d)\n", hipGetErrorString(e), grid);
}
```

```cpp
#include <hip/hip_runtime.h>
#include <hip/hip_cooperative_groups.h>
#include <hip/hip_bf16.h>
#include <cstdio>
#include <cstdint>
#include <cmath>
namespace cg = cooperative_groups;
#ifndef DIAG
#define DIAG 0
#endif
namespace pg8 {
#define PG8_LAS __attribute__((address_space(3)))
typedef unsigned short bf16_t;
typedef short bf16x8 __attribute__((ext_vector_type(8)));
typedef float f32x4 __attribute__((ext_vector_type(4)));
typedef unsigned u32x4 __attribute__((ext_vector_type(4)));
constexpr int BM = 256, BK = 64, HALF = 128, HTB = HALF * BK * 2  , STAGE_BYTES = 8 * HTB, NXCD = 8, WGM = 8;

__host__ __device__ __forceinline__ int lds_byte(int r, int c) { const int st = (r >> 4) * 2 + (c >> 5), rr = r & 15, cc = c & 31, ob = rr * 64 + cc * 2; return st * 1024 + (ob ^ (((ob >> 9) & 1) << 5)); }
__host__ __device__ __forceinline__ void stage_rc(int b, int& R, int& C) { const int st = b / 1024, sb = b % 1024, swz = sb ^ (((sb >> 9) & 1) << 5); R = (st >> 1) * 16 + swz / 64; C = (st & 1) * 32 + (swz % 64) / 2; }
__host__ __device__ __forceinline__ int perm32(int rho) { const int n = rho >> 4, i = rho & 15; return 8 * (i >> 2) + 4 * n + (i & 3); }

struct Unit { int pm, pn; };
struct Gemm { const bf16_t* A; const bf16_t* Bt; int M, N, K; };

struct StaticOrder {
    int nM, nN, nwg, G, c;
    __host__ __device__ void init(int M, int N, int G_, int c_) { nM = M / BM; nN = N / BM; nwg = nM * nN; G = G_; c = c_; }
    __host__ __device__ bool next(int i, Unit& u) const {
        const int L = i * G + c; if (L >= nwg) return false;
        int wgid = (int)L; { const int q = nwg / NXCD, r = nwg % NXCD, xcd = wgid % NXCD, off = wgid / NXCD; wgid = (xcd < r ? xcd * (q + 1) : r * (q + 1) + (xcd - r) * q) + off; }
        const int nig = WGM * nN, gid = wgid / nig, fm = gid * WGM, gsz = (nM - fm) < WGM ? (nM - fm) : WGM;
        u.pm = fm + ((wgid % nig) % gsz); u.pn = (wgid % nig) / gsz; return true;
    }
    __device__ __forceinline__ void a_ready(const Unit&) const {}
    __device__ __forceinline__ void done(const Unit&) const {}
};

__device__ __forceinline__ unsigned cvt_pk_bf16(float lo, float hi) { unsigned r; asm volatile("v_cvt_pk_bf16_f32 %0, %1, %2" : "=v"(r) : "v"(lo), "v"(hi)); return r; }
typedef float f32x2 __attribute__((ext_vector_type(2)));
template <class Epi, class Sched, bool ALIGN_EPI = false, bool SP2 = false>
__device__ __forceinline__ void gemm_phase(PG8_LAS unsigned char* lds, const Gemm g, const Sched& S, const Epi& E) {
    int tid_ = threadIdx.x; asm volatile("" : "+v"(tid_));
    const int tid = tid_, wid = __builtin_amdgcn_readfirstlane(tid >> 6), lane = tid & 63, wr = wid >> 2, wc = wid & 3, fr = lane & 15, fq = lane >> 4;
    const int K = g.K, nt = K / BK;
    unsigned voffA[2], voffB[2];
#pragma unroll
    for (int i = 0; i < 2; ++i) { int R, C; stage_rc(tid * 16 + i * 8192, R, C); const int Rb = Epi::PERM ? ((R & ~31) + perm32(R & 31)) : R;
        voffA[i] = (unsigned)(R * K + C) * 2u; voffB[i] = (unsigned)(Rb * K + C) * 2u; }
    const size_t kstep = (size_t)(BK * 2);
    const size_t hstep = (size_t)HALF * K * 2;
    const size_t tstep = 2 * hstep;
    const unsigned ldsw = (unsigned)wid * 1024u;
    const int aoff = lds_byte(wr * 64 + fr, fq * 8), boff = lds_byte(wc * 32 + fr, fq * 8);
#define PG8_SA(b, h) (((b) * 2 + (h)) * HTB)
#define PG8_SB(b, h) ((4 + (b) * 2 + (h)) * HTB)
#define PG8_STAGE(bufoff, gbase, voff) do { _Pragma("unroll") for (int _i = 0; _i < 2; ++_i) \
        __builtin_amdgcn_global_load_lds((const unsigned*)((const char*)(gbase) + (voff)[_i]), (PG8_LAS unsigned*)(lds + (bufoff) + ldsw + _i * 8192), 16, 0, 0); } while (0)
#define PG8_LDA(dst, b, h) do { _Pragma("unroll") for (int m = 0; m < 4; ++m) _Pragma("unroll") for (int k = 0; k < 2; ++k) dst[m][k] = *(const PG8_LAS bf16x8*)(lds + PG8_SA(b, h) + aoff + m * 2048 + k * 1024); } while (0)
#define PG8_LDB(dst, b, h) do { _Pragma("unroll") for (int n = 0; n < 2; ++n) _Pragma("unroll") for (int k = 0; k < 2; ++k) dst[n][k] = *(const PG8_LAS bf16x8*)(lds + PG8_SB(b, h) + boff + n * 2048 + k * 1024); } while (0)
#define PG8_MMA(ai, bj, At, Bt) do { __builtin_amdgcn_s_setprio(1); _Pragma("unroll") for (int m = 0; m < 4; ++m) _Pragma("unroll") for (int n = 0; n < 2; ++n) _Pragma("unroll") for (int k = 0; k < 2; ++k) \
        acc[ai][bj][m][n] = __builtin_amdgcn_mfma_f32_16x16x32_bf16(Bt[n][k], At[m][k], acc[ai][bj][m][n], 0, 0, 0); __builtin_amdgcn_s_setprio(0); } while (0)
#define PG8_WAIT_V(n) asm volatile("s_waitcnt vmcnt(" #n ")" ::: "memory")
#define PG8_WAIT_L(n) asm volatile("s_waitcnt lgkmcnt(" #n ")" ::: "memory")
#define PG8_BAR __builtin_amdgcn_s_barrier()
#define PG8_SCHED __builtin_amdgcn_sched_barrier(0)
    Unit cur, nxt; int ui = 0;
    if (!S.next(0, cur)) return;
    f32x4 acc[2][2][4][2];
#pragma unroll
    for (int a = 0; a < 2; ++a)
#pragma unroll
        for (int b = 0; b < 2; ++b)
#pragma unroll
            for (int m = 0; m < 4; ++m)
#pragma unroll
                for (int n = 0; n < 2; ++n) acc[a][b][m][n] = (f32x4){0.f, 0.f, 0.f, 0.f};
    bf16x8 At[4][2], B0[2][2], B1[2][2];
    const char* cA = (const char*)g.A + (size_t)cur.pm * tstep; const char* cB = (const char*)g.Bt + (size_t)cur.pn * tstep;
    S.a_ready(cur);
    if constexpr (SP2) {
        PG8_STAGE(PG8_SB(0, 0), cB, voffB); PG8_STAGE(PG8_SB(0, 1), cB + hstep, voffB); PG8_STAGE(PG8_SA(0, 0), cA, voffA); PG8_STAGE(PG8_SA(0, 1), cA + hstep, voffA);
        if (wr == 1) PG8_BAR;
        PG8_WAIT_V(2); PG8_BAR;
        PG8_STAGE(PG8_SB(1, 0), cB + kstep, voffB); PG8_STAGE(PG8_SA(1, 0), cA + kstep, voffA); PG8_STAGE(PG8_SB(1, 1), cB + hstep + kstep, voffB);
        PG8_WAIT_V(6); PG8_BAR;
    } else {
        PG8_STAGE(PG8_SB(0, 0), cB, voffB); PG8_STAGE(PG8_SA(0, 0), cA, voffA); PG8_STAGE(PG8_SB(0, 1), cB + hstep, voffB); PG8_STAGE(PG8_SA(0, 1), cA + hstep, voffA);
        if (wr == 1) PG8_BAR;
        PG8_WAIT_V(4); PG8_BAR;
        PG8_STAGE(PG8_SB(1, 0), cB + kstep, voffB); PG8_STAGE(PG8_SA(1, 0), cA + kstep, voffA); PG8_STAGE(PG8_SB(1, 1), cB + hstep + kstep, voffB);
        PG8_WAIT_V(6); PG8_BAR;
    }
    for (;;) {
        const bool has_next = S.next(ui + 1, nxt);
        const char* nA = has_next ? (const char*)g.A + (size_t)nxt.pm * tstep : cA; const char* nB = has_next ? (const char*)g.Bt + (size_t)nxt.pn * tstep : cB;
        for (int t = 0; t < nt; t += 2) {
            const bool last = (t == nt - 2);
            const char* a1 = cA + (size_t)(t + 1) * kstep;
            const char* a2 = last ? nA : cA + (size_t)(t + 2) * kstep; const char* b2 = last ? nB : cB + (size_t)(t + 2) * kstep;
            const char* a3 = a2 + kstep; const char* b3 = b2 + kstep;
            if (last && has_next) S.a_ready(nxt);
            if constexpr (SP2) {
            PG8_LDB(B0, 0, 0); PG8_LDB(B1, 0, 1); PG8_SCHED; PG8_LDA(At, 0, 0); PG8_STAGE(PG8_SA(1, 1), a1 + hstep, voffA);
            PG8_WAIT_V(8); PG8_WAIT_L(0); PG8_BAR; PG8_MMA(0, 0, At, B0); PG8_MMA(0, 1, At, B1); PG8_BAR; PG8_SCHED;
            PG8_LDA(At, 0, 1); PG8_STAGE(PG8_SB(0, 0), b2, voffB); PG8_STAGE(PG8_SB(0, 1), b2 + hstep, voffB); PG8_STAGE(PG8_SA(0, 0), a2, voffA);
            PG8_WAIT_V(8); PG8_WAIT_L(0); PG8_BAR; PG8_MMA(1, 0, At, B0); PG8_MMA(1, 1, At, B1); PG8_BAR; PG8_SCHED;
            PG8_LDB(B0, 1, 0); PG8_LDB(B1, 1, 1); PG8_SCHED; PG8_LDA(At, 1, 0); PG8_STAGE(PG8_SA(0, 1), a2 + hstep, voffA);
            PG8_WAIT_V(8); PG8_WAIT_L(0); PG8_BAR; PG8_MMA(0, 0, At, B0); PG8_MMA(0, 1, At, B1); PG8_BAR; PG8_SCHED;
            PG8_LDA(At, 1, 1); PG8_STAGE(PG8_SB(1, 0), b3, voffB); PG8_STAGE(PG8_SB(1, 1), b3 + hstep, voffB); PG8_STAGE(PG8_SA(1, 0), a3, voffA);
            PG8_WAIT_V(8); PG8_WAIT_L(0); PG8_BAR; PG8_MMA(1, 0, At, B0); PG8_MMA(1, 1, At, B1); PG8_BAR; PG8_SCHED;
            } else {
            PG8_LDB(B0, 0, 0); PG8_SCHED; PG8_LDA(At, 0, 0); PG8_STAGE(PG8_SA(1, 1), a1 + hstep, voffA);
            PG8_WAIT_L(8); PG8_BAR; PG8_WAIT_L(0); PG8_MMA(0, 0, At, B0); PG8_BAR; PG8_SCHED;
            PG8_LDB(B1, 0, 1); PG8_STAGE(PG8_SB(0, 0), b2, voffB);
            PG8_BAR; PG8_WAIT_L(0); PG8_MMA(0, 1, At, B1); PG8_BAR;
            PG8_LDA(At, 0, 1); PG8_STAGE(PG8_SA(0, 0), a2, voffA);
            PG8_BAR; PG8_WAIT_L(0); PG8_MMA(1, 0, At, B0); PG8_BAR; PG8_SCHED;
            PG8_STAGE(PG8_SB(0, 1), b2 + hstep, voffB);
            PG8_WAIT_V(6); PG8_BAR; PG8_MMA(1, 1, At, B1); PG8_BAR;
            PG8_LDB(B0, 1, 0); PG8_SCHED; PG8_LDA(At, 1, 0); PG8_STAGE(PG8_SA(0, 1), a2 + hstep, voffA);
            PG8_WAIT_L(8); PG8_BAR; PG8_WAIT_L(0); PG8_MMA(0, 0, At, B0); PG8_BAR; PG8_SCHED;
            PG8_LDB(B1, 1, 1); PG8_STAGE(PG8_SB(1, 0), b3, voffB);
            PG8_BAR; PG8_WAIT_L(0); PG8_MMA(0, 1, At, B1); PG8_BAR;
            PG8_LDA(At, 1, 1); PG8_STAGE(PG8_SA(1, 0), a3, voffA);
            PG8_BAR; PG8_WAIT_L(0); PG8_MMA(1, 0, At, B0); PG8_BAR; PG8_SCHED;
            PG8_STAGE(PG8_SB(1, 1), b3 + hstep, voffB);
            PG8_WAIT_V(6); PG8_BAR; PG8_MMA(1, 1, At, B1); PG8_BAR;
            }
        }
        if constexpr (ALIGN_EPI) { if (wr == 0) PG8_BAR; }
        if constexpr (!Epi::AFTER_DRAIN) { E(acc, cur, wr, wc, fr, fq); S.done(cur); }
        if (!has_next) break;
#pragma unroll
        for (int a = 0; a < 2; ++a)
#pragma unroll
            for (int b = 0; b < 2; ++b)
#pragma unroll
                for (int m = 0; m < 4; ++m)
#pragma unroll
                    for (int n = 0; n < 2; ++n) acc[a][b][m][n] = (f32x4){0.f, 0.f, 0.f, 0.f};
        cur = nxt; cA = nA; cB = nB; ++ui;
        if constexpr (ALIGN_EPI) { if (wr == 1) PG8_BAR; }
    }
    PG8_WAIT_V(0);
    if constexpr (!ALIGN_EPI) { if (wr == 0) PG8_BAR; }
    PG8_BAR;
    if constexpr (Epi::AFTER_DRAIN) { E.fused(acc, cur, wr, wc, fr, fq, lds, wid, lane); S.done(cur); }
#undef PG8_SA
#undef PG8_SB
#undef PG8_STAGE
#undef PG8_LDA
#undef PG8_LDB
#undef PG8_MMA
#undef PG8_WAIT_V
#undef PG8_WAIT_L
#undef PG8_BAR
#undef PG8_SCHED
}
}
namespace attn_body {
using bf16=__hip_bfloat16;
using bf16x8=__attribute__((ext_vector_type(8)))short;
using s16x4=__attribute__((ext_vector_type(4)))short;
using f32x16=__attribute__((ext_vector_type(16)))float;
using u32x4=__attribute__((ext_vector_type(4)))unsigned;
using f32x4k=__attribute__((ext_vector_type(4)))float;
constexpr int BATCH=16,NHEAD=8,TPAD=4160,D=64,DM=NHEAD*D;
constexpr int NW=8,QBLK=32,QB=QBLK*NW,KVBLK=64,NQB=16;
constexpr int ATTN_PITCH=DM, ATTN_UNIT_ROWS=QB;
__device__ __forceinline__ int crow(int r,int hi){return (r&3)+8*(r>>2)+4*hi;}
#define SBAR() __builtin_amdgcn_sched_barrier(0)
__device__ __forceinline__ void cmask(f32x16&p0,f32x16&p1,int jb,int qrel,int hi){
  const float NEG=-INFINITY; int kb=64*jb+4*hi;
  #pragma unroll
  for(int r=0;r<16;++r){int kv=kb+(r&3)+8*(r>>2); if(kv>qrel)p0[r]=NEG; if(kv+32>qrel)p1[r]=NEG;}
}

constexpr int NSLOT=3, SLOTB=8192;
constexpr int LDS_K=0, LDS_V=NSLOT*SLOTB, LDS_WS=2*NSLOT*SLOTB, LDS_OST=LDS_WS+NW*64*4, LDS_KB=LDS_OST+NW*4096, LDS_BYTES=LDS_KB+TPAD*4;
constexpr float C2=0.125f*1.4426950408889634f;
__device__ __forceinline__ void glds16(const void*gsrc,unsigned lds_dst){unsigned keep;
  asm volatile("s_mov_b32 %0, m0\n\ts_mov_b32 m0, %2\n\ts_nop 0\n\tglobal_load_lds_dwordx4 %1, off\n\ts_mov_b32 m0, %0":"=&s"(keep):"v"(gsrc),"s"(lds_dst):"memory");}
__device__ __forceinline__ float max3f(float a,float b,float c){float r;asm("v_max3_f32 %0, %1, %2, %3":"=v"(r):"v"(a),"v"(b),"v"(c));return r;}
__device__ __forceinline__ float max2f(float a,float b){float r;asm("v_max_f32_e32 %0, %1, %2":"=v"(r):"v"(a),"v"(b));return r;}
__device__ __forceinline__ float fadd_s(float a,float b){float r;asm("v_add_f32_e32 %0, %1, %2":"=v"(r):"v"(a),"v"(b));return r;}
__device__ __forceinline__ float fsub_s(float a,float b){float r;asm("v_sub_f32_e32 %0, %1, %2":"=v"(r):"v"(a),"v"(b));return r;}
typedef float f32x2_t __attribute__((ext_vector_type(2))); typedef __bf16 bf16x2_t __attribute__((ext_vector_type(2)));
__device__ __forceinline__ unsigned cvtpk_s(float lo,float hi){f32x2_t v={lo,hi};bf16x2_t b=__builtin_convertvector(v,bf16x2_t);return __builtin_bit_cast(unsigned,b);}
#define WAIT_BAR(N) asm volatile("s_waitcnt vmcnt(" #N ") lgkmcnt(0)\n\ts_barrier":::"memory")

__device__ __forceinline__ void qkt(f32x16&p0,f32x16&p1,const char*Kslot,const bf16x8*qr,int r32,int hi){
  const char*kb=Kslot+hi*1024+r32*16;
  #pragma unroll
  for(int d0=0;d0<4;++d0){
    const bf16x8 b0=*reinterpret_cast<const bf16x8*>(kb+d0*2048);
    const bf16x8 b1=*reinterpret_cast<const bf16x8*>(kb+d0*2048+512);
    {p0=__builtin_amdgcn_mfma_f32_32x32x16_bf16(b0,qr[d0],p0,0,0,0);p1=__builtin_amdgcn_mfma_f32_32x32x16_bf16(b1,qr[d0],p1,0,0,0);}}
}
typedef __attribute__((address_space(3))) const char* lds_cptr;
typedef short v4i16_t __attribute__((ext_vector_type(4)));
__device__ __forceinline__ void kload8(bf16x8*kf,lds_cptr kp){
  kf[0]=*(const __attribute__((address_space(3))) bf16x8*)(kp);      kf[1]=*(const __attribute__((address_space(3))) bf16x8*)(kp+512);
  kf[2]=*(const __attribute__((address_space(3))) bf16x8*)(kp+2048); kf[3]=*(const __attribute__((address_space(3))) bf16x8*)(kp+2560);
  kf[4]=*(const __attribute__((address_space(3))) bf16x8*)(kp+4096); kf[5]=*(const __attribute__((address_space(3))) bf16x8*)(kp+4608);
  kf[6]=*(const __attribute__((address_space(3))) bf16x8*)(kp+6144); kf[7]=*(const __attribute__((address_space(3))) bf16x8*)(kp+6656);
}
__device__ __forceinline__ void kload2(bf16x8*kf,lds_cptr kp,int j){ kf[2*j]=*(const __attribute__((address_space(3))) bf16x8*)(kp+j*2048); kf[2*j+1]=*(const __attribute__((address_space(3))) bf16x8*)(kp+j*2048+512); }
__device__ __forceinline__ s16x4 vtr(lds_cptr p){ return __builtin_bit_cast(s16x4,__builtin_amdgcn_ds_read_tr16_b64_v4i16((__attribute__((address_space(3))) v4i16_t*)p)); }
__device__ __forceinline__ float rowmax(const f32x16&p0,const f32x16&p1){
  float a=max3f(p0[0],p0[1],p1[0]),b=max3f(p0[2],p0[3],p1[1]);a=max3f(a,p1[2],p1[3]);
  #pragma unroll
  for(int r=4;r<16;r+=4){a=max3f(a,p0[r],p0[r+1]);b=max3f(b,p0[r+2],p0[r+3]);a=max3f(a,p1[r],p1[r+1]);b=max3f(b,p1[r+2],p1[r+3]);}
  const float m=max2f(a,b);
  auto rr=__builtin_amdgcn_permlane32_swap(__float_as_uint(m),__float_as_uint(m),false,false);
  return max2f(__uint_as_float(rr[0]),__uint_as_float(rr[1]));
}
__device__ __forceinline__ void pv(f32x16*o,int vb,bf16x8 pa0,bf16x8 pa1,bf16x8 pa2,bf16x8 pa3){
  #pragma unroll
  for(int d0=0;d0<2;++d0){s16x4 lo[4],hi[4];
    #pragma unroll
    for(int ks=0;ks<4;++ks){
      asm volatile("ds_read_b64_tr_b16 %0,%1 offset:%c2":"=&v"(lo[ks]):"v"(vb),"i"(d0*4096+ks*1024):"memory");
      asm volatile("ds_read_b64_tr_b16 %0,%1 offset:%c2":"=&v"(hi[ks]):"v"(vb),"i"(d0*4096+ks*1024+512):"memory");}
    asm volatile("s_waitcnt lgkmcnt(0)":::"memory");SBAR();
    #define PK(k) (bf16x8){lo[k][0],lo[k][1],lo[k][2],lo[k][3],hi[k][0],hi[k][1],hi[k][2],hi[k][3]}
    o[d0]=__builtin_amdgcn_mfma_f32_32x32x16_bf16(pa0,PK(0),o[d0],0,0,0);
    o[d0]=__builtin_amdgcn_mfma_f32_32x32x16_bf16(pa1,PK(1),o[d0],0,0,0);
    o[d0]=__builtin_amdgcn_mfma_f32_32x32x16_bf16(pa2,PK(2),o[d0],0,0,0);
    o[d0]=__builtin_amdgcn_mfma_f32_32x32x16_bf16(pa3,PK(3),o[d0],0,0,0);
    #undef PK
  }
}

#ifndef ATTN_STORE16
#define ATTN_STORE16(p,v) (*(u32x4*)(p)=(v))
#endif
template<int THRL> __device__ __forceinline__ void attn_unit(int b,int h,int qb,const bf16*Q,const bf16*__restrict__ K,const bf16*__restrict__ V,bf16*O,char*shm){
  int tid_=threadIdx.x; asm volatile("":"+v"(tid_)); const int tid=tid_,lane=tid&63,r32=lane&31,hi=lane>>5; const int wid=__builtin_amdgcn_readfirstlane(tid>>6);
  const long rowbase=(long)b*TPAD; const int q0=64+qb*QB;
  const bf16*Qw=Q+(rowbase+q0+wid*QBLK)*DM+h*D;
  const bf16*Kh=K+rowbase*DM+h*D,*Vh=V+rowbase*DM+h*D;
  const unsigned lds0=(unsigned)(uintptr_t)shm;
  float*wsf=(float*)(shm+LDS_WS)+wid*64;
  const bf16*ksrc=Kh+(long)lane*DM+wid*8;
  const bf16*vsrc=Vh+(long)(16*(wid&3)+(lane>>2))*DM+(wid>>2)*32+(lane&3)*8;
  const unsigned kdst=lds0+LDS_K+wid*1024, vdst=lds0+LDS_V+wid*1024;
  #define DMA_K(t,slot) glds16(ksrc+(long)(t)*KVBLK*DM,(unsigned)__builtin_amdgcn_readfirstlane(kdst+(slot)))
  #define DMA_V(t,slot) glds16(vsrc+(long)(t)*KVBLK*DM,(unsigned)__builtin_amdgcn_readfirstlane(vdst+(slot)))
  const int vb0=(int)(lds0+LDS_V)+((lane>>4)&1)*32+(lane&3)*8+(4*hi+((lane&15)>>2))*64;
  const char*Kbase=shm+LDS_K; bf16x8 kf[8];
  const lds_cptr shm3=(lds_cptr)shm; const lds_cptr kp0=shm3+LDS_K+hi*1024+r32*16; const lds_cptr vp0=shm3+LDS_V+((lane>>4)&1)*32+(lane&3)*8+(4*hi+((lane&15)>>2))*64;
  const int NT=(q0+QB)/KVBLK;
  typedef __attribute__((address_space(3))) const f32x4k* lds_f4p; const __attribute__((address_space(3))) float* kbp0=(const __attribute__((address_space(3))) float*)(shm3+LDS_KB)+4*hi;
  #define KBINIT(C0,C1,t) do{ const __attribute__((address_space(3))) float* kp_=kbp0+(t)*64; _Pragma("unroll") for(int g_=0;g_<4;++g_){ const f32x4k a_=*(lds_f4p)(kp_+8*g_); const f32x4k b_=*(lds_f4p)(kp_+32+8*g_); _Pragma("unroll") for(int e_=0;e_<4;++e_){ C0[4*g_+e_]=a_[e_]-mhat; C1[4*g_+e_]=b_[e_]-mhat; } } }while(0)
  DMA_K(0,0);DMA_V(0,0);DMA_K(1,SLOTB);
  bf16x8 qr[4];
  #pragma unroll
  for(int d0=0;d0<4;++d0)qr[d0]=*reinterpret_cast<const bf16x8*>(&Qw[(long)r32*DM+d0*16+hi*8]);
  float mhat=0.f,l_reg=0.f;f32x16 o[2];o[0]=f32x16{};o[1]=f32x16{};
  const int qrel=wid*QBLK+r32;
  #define CMASK(P0,P1,t) do{int jb_=(t)-(NT-4); if(jb_>=0)cmask(P0,P1,jb_,qrel,hi);}while(0)
  bool resc=false;
  #define START(P0,P1) do{ const float rm=rowmax(P0,P1); resc=false; \
    { const float dl=rm; mhat=fadd_s(mhat,dl); \
      _Pragma("unroll") for(int r=0;r<16;++r){P0[r]=fsub_s(P0[r],dl);P1[r]=fsub_s(P1[r],dl);} } \
    _Pragma("unroll") for(int r=0;r<16;++r)P0[r]=__builtin_amdgcn_exp2f(P0[r]); }while(0)
  #define RESC() do{ if(resc){ asm volatile("s_waitcnt lgkmcnt(0)":::"memory"); \
      _Pragma("unroll") for(int d_=0;d_<2;++d_) _Pragma("unroll") for(int r=0;r<16;++r)o[d_][r]*=wsf[crow(r,hi)]; } }while(0)
  f32x16 pA0,pA1,pB0,pB1;
  int sl_prev=0,sl_cur=0,sl_next=SLOTB;
  #define ROT() do{sl_prev=sl_cur;sl_cur=sl_next;sl_next=(sl_next==(NSLOT-1)*SLOTB)?0:sl_next+SLOTB;}while(0)
  DMA_K(2,2*SLOTB);
  WAIT_BAR(3);
  KBINIT(pA0,pA1,0); qkt(pA0,pA1,Kbase,qr,r32,hi);asm volatile("s_nop 15\n\ts_nop 7":"+v"(pA0),"+v"(pA1));CMASK(pA0,pA1,0);
  START(pA0,pA1);
  _Pragma("unroll") for(int r=0;r<16;++r)pA1[r]=__builtin_amdgcn_exp2f(pA1[r]);
  WAIT_BAR(0);
  DMA_K(3,0);DMA_V(1,SLOTB);
  ROT();
  kload8(kf,kp0+sl_cur);
  WAIT_BAR(2);
  s16x4 vlo[8],vhi[8]; u32x4 pw0,pw1,pw2,pw3;
  #define PKW(P,B) cvtpk_s(P[B],P[B+1])
  #define PAF(k) __builtin_bit_cast(bf16x8,pw##k)
  #define VFR(i) (bf16x8){vlo[i][0],vlo[i][1],vlo[i][2],vlo[i][3],vhi[i][0],vhi[i][1],vhi[i][2],vhi[i][3]}
  #define PIN(x) asm volatile("":"+v"(x))
  #define MX3(a,b,c) __builtin_fmaxf(__builtin_fmaxf((a),(b)),(c))
  #define GAPA(MF,A0,A1,A2,A3,W0,W1,PW) do{ MF; sacc+=A0; sacc+=A1; sacc+=A2; sacc+=A3; PIN(sacc); W0; W1; PIN(PW); SBAR(); }while(0)
  #define EX(v) __builtin_amdgcn_exp2f(v)
  #define GAPB(MF,X,B) do{ MF; X[B]=EX(X[B]); X[B+1]=EX(X[B+1]); X[B+2]=EX(X[B+2]); X[B+3]=EX(X[B+3]); PIN(X); SBAR(); }while(0)
  #define VRD(i) do{ vlo[i]=vtr(vp_+(((i)>>2)*4096+((i)&3)*1024)); vhi[i]=vtr(vp_+(((i)>>2)*4096+((i)&3)*1024+512)); }while(0)
  #define KRD(G,j) do{ if(G){ kload2(kf,kp0+sl_next,j); SBAR(); } }while(0)
  #define STEP(C0,C1,P0,P1,t,GK,GV,GL) do{ SBAR(); \
    const lds_cptr vp_=vp0+sl_prev; \
    KBINIT(C0,C1,t); SBAR(); \
    VRD(0); SBAR(); float sacc=(P0[0]+P0[1]); \
    GAPA(C0=__builtin_amdgcn_mfma_f32_32x32x16_bf16(kf[0],qr[0],C0,0,0,0), P0[2],P0[3],P0[4],P0[5],     pw0[0]=PKW(P0,0), pw0[1]=PKW(P0,2), pw0); \
    VRD(4); SBAR(); GAPA(C1=__builtin_amdgcn_mfma_f32_32x32x16_bf16(kf[1],qr[0],C1,0,0,0), P0[6],P0[7],P0[8],P0[9],     pw0[2]=PKW(P0,4), pw0[3]=PKW(P0,6), pw0); \
    VRD(1); SBAR(); GAPA(C0=__builtin_amdgcn_mfma_f32_32x32x16_bf16(kf[2],qr[1],C0,0,0,0),   P0[10],P0[11],P0[12],P0[13], pw1[0]=PKW(P0,8), pw1[1]=PKW(P0,10), pw1); \
    VRD(5); SBAR(); GAPA(C1=__builtin_amdgcn_mfma_f32_32x32x16_bf16(kf[3],qr[1],C1,0,0,0),   P0[14],P0[15],P1[0],P1[1],   pw1[2]=PKW(P0,12),pw1[3]=PKW(P0,14), pw1); \
    VRD(2); SBAR(); GAPA(C0=__builtin_amdgcn_mfma_f32_32x32x16_bf16(kf[4],qr[2],C0,0,0,0),   P1[2],P1[3],P1[4],P1[5],     pw2[0]=PKW(P1,0), pw2[1]=PKW(P1,2), pw2); \
    VRD(6); SBAR(); GAPA(C1=__builtin_amdgcn_mfma_f32_32x32x16_bf16(kf[5],qr[2],C1,0,0,0),   P1[6],P1[7],P1[8],P1[9],     pw2[2]=PKW(P1,4), pw2[3]=PKW(P1,6), pw2); \
    VRD(3); SBAR(); GAPA(C0=__builtin_amdgcn_mfma_f32_32x32x16_bf16(kf[6],qr[3],C0,0,0,0),   P1[10],P1[11],P1[12],P1[13], pw3[0]=PKW(P1,8), pw3[1]=PKW(P1,10), pw3); \
    VRD(7); SBAR(); GAPA(C1=__builtin_amdgcn_mfma_f32_32x32x16_bf16(kf[7],qr[3],C1,0,0,0),   P1[14],P1[15],0.f,0.f,       pw3[2]=PKW(P1,12),pw3[3]=PKW(P1,14), pw3); \
    l_reg+=sacc; \
    if(GK){DMA_K((t)+3,sl_cur);} if(GV){DMA_V((t)+1,sl_next);} \
    CMASK(C0,C1,t); \
    { float a=MX3(C0[0],C0[1],C1[0]),b=MX3(C0[2],C0[3],C1[1]); a=MX3(a,C1[2],C1[3]); \
      _Pragma("unroll") for(int r=4;r<16;r+=4){a=MX3(a,C0[r],C0[r+1]);b=MX3(b,C0[r+2],C0[r+3]);a=MX3(a,C1[r],C1[r+1]);b=MX3(b,C1[r+2],C1[r+3]);} \
      float rm=__builtin_fmaxf(a,b); { auto rr=__builtin_amdgcn_permlane32_swap(__float_as_uint(rm),__float_as_uint(rm),false,false); rm=__builtin_fmaxf(__uint_as_float(rr[0]),__uint_as_float(rr[1])); } \
      resc=false; \
      if(__builtin_expect(__any(rm>(float)THRL),0)){ const float dl=__builtin_fmaxf(rm,0.f); mhat+=dl; \
        _Pragma("unroll") for(int r=0;r<16;++r){C0[r]-=dl;C1[r]-=dl;} \
        const float f=__builtin_amdgcn_exp2f(-dl); l_reg*=f; if(hi==0)wsf[r32]=f; resc=true; } } \
    SBAR(); \
    GAPB(o[0]=__builtin_amdgcn_mfma_f32_32x32x16_bf16(PAF(0),VFR(0),o[0],0,0,0), C0,0); \
    GAPB(o[1]=__builtin_amdgcn_mfma_f32_32x32x16_bf16(PAF(0),VFR(4),o[1],0,0,0), C0,4); \
    KRD(GL,0); GAPB(o[0]=__builtin_amdgcn_mfma_f32_32x32x16_bf16(PAF(1),VFR(1),o[0],0,0,0), C0,8); \
    KRD(GL,1); GAPB(o[1]=__builtin_amdgcn_mfma_f32_32x32x16_bf16(PAF(1),VFR(5),o[1],0,0,0), C0,12); \
    KRD(GL,2); GAPB(o[0]=__builtin_amdgcn_mfma_f32_32x32x16_bf16(PAF(2),VFR(2),o[0],0,0,0), C1,0); \
    KRD(GL,3); GAPB(o[1]=__builtin_amdgcn_mfma_f32_32x32x16_bf16(PAF(2),VFR(6),o[1],0,0,0), C1,4); \
    GAPB(o[0]=__builtin_amdgcn_mfma_f32_32x32x16_bf16(PAF(3),VFR(3),o[0],0,0,0), C1,8); \
    GAPB(o[1]=__builtin_amdgcn_mfma_f32_32x32x16_bf16(PAF(3),VFR(7),o[1],0,0,0), C1,12); \
    }while(0)
  int t=1;
  #undef CMASK
  #define CMASK(P0,P1,t) do{}while(0)
  for(;t+5<NT;t+=2){
    STEP(pB0,pB1,pA0,pA1,t,true,true,true);     WAIT_BAR(2); RESC(); ROT();
    STEP(pA0,pA1,pB0,pB1,t+1,true,true,true);   WAIT_BAR(2); RESC(); ROT();
  }
  #undef CMASK
  #define CMASK(P0,P1,t) do{int jb_=(t)-(NT-4); if(jb_>=0)cmask(P0,P1,jb_,qrel,hi);}while(0)
  #define ENDW(tt) do{ if((tt)+3<NT){WAIT_BAR(2);} else if((tt)+2<NT){WAIT_BAR(1);} else {WAIT_BAR(0);} }while(0)
  for(;t+1<NT;t+=2){
    STEP(pB0,pB1,pA0,pA1,t,(t+3<NT),(t+1<NT),(t+1<NT));       ENDW(t);   RESC(); ROT();
    STEP(pA0,pA1,pB0,pB1,t+1,(t+4<NT),(t+2<NT),(t+2<NT));     ENDW(t+1); RESC(); ROT();
  }
  { float sacc=pA0[0]+pA0[1]; _Pragma("unroll") for(int r=2;r<16;++r)sacc+=pA0[r]; _Pragma("unroll") for(int r=0;r<16;++r)sacc+=pA1[r]; l_reg+=sacc;
    pw0=(u32x4){PKW(pA0,0),PKW(pA0,2),PKW(pA0,4),PKW(pA0,6)};pw1=(u32x4){PKW(pA0,8),PKW(pA0,10),PKW(pA0,12),PKW(pA0,14)};pw2=(u32x4){PKW(pA1,0),PKW(pA1,2),PKW(pA1,4),PKW(pA1,6)};pw3=(u32x4){PKW(pA1,8),PKW(pA1,10),PKW(pA1,12),PKW(pA1,14)};
    SBAR(); pv(o,vb0+sl_prev,PAF(0),PAF(1),PAF(2),PAF(3)); }
  #undef PKW
  #undef PAF
  #undef VFR
  #undef PIN
  #undef MX3
  #undef GAPA
  #undef GAPB
  #undef EX
  #undef VRD
  #undef KRD
  #undef STEP
  #undef ENDW
  {auto rr=__builtin_amdgcn_permlane32_swap(__float_as_uint(l_reg),__float_as_uint(l_reg),false,false);l_reg=__uint_as_float(rr[0])+__uint_as_float(rr[1]);}
  if(hi==0)wsf[32+r32]=l_reg;asm volatile("s_waitcnt lgkmcnt(0)":::"memory");
  float rli[16];
  #pragma unroll
  for(int r=0;r<16;++r)rli[r]=__builtin_amdgcn_rcpf(wsf[32+crow(r,hi)]);
  bf16*Ow=O+(rowbase+q0+wid*QBLK)*DM+h*D;
  { bf16*stg=(bf16*)(shm+LDS_OST)+wid*2048;
    #pragma unroll
    for(int r=0;r<16;++r){const int orow=crow(r,hi);
      #pragma unroll
      for(int d0=0;d0<2;++d0)stg[orow*64+d0*32+r32]=__float2bfloat16(o[d0][r]*rli[r]);}
    asm volatile("s_waitcnt lgkmcnt(0)":::"memory");
    #pragma unroll
    for(int i=0;i<4;++i){const int row=i*8+(lane>>3),ch=lane&7; const u32x4 v=*(const u32x4*)(stg+row*64+ch*8); ATTN_STORE16(Ow+(long)row*DM+ch*8,v);} }
  asm volatile("s_waitcnt lgkmcnt(0)\n\ts_barrier":::"memory");
  #undef DMA_K
  #undef DMA_V
  #undef CMASK
  #undef START
  #undef RESC
  #undef ROT
  #undef KBINIT
}
constexpr int ATTN_LDS_BYTES=LDS_BYTES;
#undef SBAR
#undef WAIT_BAR
}

#define LAS __attribute__((address_space(3)))
typedef unsigned short bf16;
typedef unsigned v4u __attribute__((ext_vector_type(4)));
typedef unsigned v2u __attribute__((ext_vector_type(2)));
typedef float f32x4 __attribute__((ext_vector_type(4)));
typedef short bf16x8 __attribute__((ext_vector_type(8)));
typedef float f32x16v __attribute__((ext_vector_type(16)));

constexpr int NB = 16, SEQ = 4096, DMODEL = 1024, NMETA = 16;
constexpr int TP = 4160;
constexpr int R = NB * TP;
constexpr int NTOK = NB * SEQ;
constexpr int N1 = 5632;
constexpr int IN_COLS = 5416;
constexpr int NWAVES = 8, NTHREADS = 512;
constexpr float NORM_EPS = 1e-6f, GN_EPS = 64e-5f;
constexpr float LOG2E = 1.4426950408889634f;

constexpr size_t MiB = 1u << 20;
constexpr size_t U65 = 65 * MiB;
constexpr size_t WS_WTIN = 1 * MiB;
constexpr size_t WS_WTQ = 12 * MiB;
constexpr size_t WS_WTFOX = 16 * MiB;
constexpr size_t WS_WTRWKV = 17 * MiB;
constexpr size_t WS_WTOUT = 18 * MiB;
constexpr size_t WS_WTWA = 20 * MiB;
constexpr size_t WS_WTG = 20 * MiB + 512 * 1024;
constexpr size_t WS_KS = 21 * MiB;
constexpr size_t WS_KB = 22 * MiB;
constexpr size_t WS_LF = 25 * MiB;
constexpr size_t WS_BS = 28 * MiB;
constexpr size_t WS_U16 = 32 * MiB;
constexpr size_t WS_V16 = 64 * MiB;
constexpr size_t WS_F = 96 * MiB;
constexpr size_t WS_FQ = WS_F, WS_FK = WS_F + U65, WS_FV = WS_F + 2 * U65, WS_ZRR = WS_F + 3 * U65, WS_ZRK = WS_F + 4 * U65, WS_ZRV = WS_F + 5 * U65, WS_ZM = WS_F + 6 * U65;
constexpr size_t WS_ZG = WS_F + 7 * U65;
constexpr size_t WS_XN = WS_ZG + 4 * U65;
constexpr size_t WS_IDS = 941 * MiB;
constexpr size_t WS_GATES = 973 * MiB;
constexpr size_t WS_END = 1005 * MiB;
constexpr size_t WS_LA = WS_XN;
constexpr size_t WS_LG = WS_XN + 20 * MiB;
constexpr size_t WS_KP = WS_XN;
constexpr size_t WS_KN = WS_XN + U65;
constexpr size_t WS_Y = WS_ZM;
constexpr size_t WS_MIX = WS_XN;
constexpr size_t WS_XN2 = WS_XN;
constexpr size_t WS_PQ = WS_F;
constexpr size_t DO_XW = 0, DO_AA = U65, DO_GG = 2 * U65;

__device__ __forceinline__ unsigned f2bf(float f) { unsigned u = __builtin_bit_cast(unsigned, f); return (u + 0x7fffu + ((u >> 16) & 1u)) >> 16; }
__device__ __forceinline__ unsigned pk2(float lo, float hi) { return f2bf(lo) | (f2bf(hi) << 16); }
__device__ __forceinline__ float bflo(unsigned w) { return __builtin_bit_cast(float, w << 16); }
__device__ __forceinline__ float bfhi(unsigned w) { return __builtin_bit_cast(float, w & 0xffff0000u); }
__device__ __forceinline__ void unpack8(const v4u w, float (&f)[8]) { f[0] = bflo(w.x); f[1] = bfhi(w.x); f[2] = bflo(w.y); f[3] = bfhi(w.y); f[4] = bflo(w.z); f[5] = bfhi(w.z); f[6] = bflo(w.w); f[7] = bfhi(w.w); }
__device__ __forceinline__ v4u pack8(const float (&f)[8]) { v4u w; w.x = pk2(f[0], f[1]); w.y = pk2(f[2], f[3]); w.z = pk2(f[4], f[5]); w.w = pk2(f[6], f[7]); return w; }
__device__ __forceinline__ float sigmoidf_(float x) { return __builtin_amdgcn_rcpf(1.0f + __builtin_amdgcn_exp2f(-x * LOG2E)); }
__device__ __forceinline__ float wave_sum(float v) {
#pragma unroll
    for (int o = 1; o < 64; o <<= 1) v += __shfl_xor(v, o);
    return v;
}
__device__ __forceinline__ float sum8(float v) { v += __shfl_xor(v, 1); v += __shfl_xor(v, 2); v += __shfl_xor(v, 4); return v; }

struct Params {
    const float* in[27];
    float* out;
    unsigned char* ws;
};
enum { I_X = 0, I_META, I_N1G, I_WIN, I_FQN, I_FKN, I_FBIAS, I_MU, I_W0, I_WUP, I_A0, I_AUP, I_GUP, I_KK, I_KA, I_RK, I_LNG, I_LNB, I_WFOX, I_WRWKV, I_WOUT, I_N2G, I_PWQ, I_SK1, I_SK2, I_PU, I_PV };

__device__ __forceinline__ int win_src_col(int n) {
    if (n < 1536) return n;
    if (n < 3072) return 1544 + (n - 1536);
    if (n < 3584) { const int m = n - 3072; if (m < 288) return 3080 + m; if (m < 296) return 1536 + (m - 288); return -1; }
    return 3368 + (n - 3584);
}
template <bool REMAP>
__device__ __forceinline__ void transpose_item(const float* W, int ldw, int K, int N, bf16* WT, LAS float* scr, int item, int lane) {
    const int nblk = N / 32, kb = item / nblk, nb = item % nblk, k0 = 64 * kb, n0 = 32 * nb;
    const int n = n0 + (lane & 31); const int sc = REMAP ? win_src_col(n) : n;
#pragma unroll 8
    for (int i = 0; i < 32; ++i) { const int kk = 2 * i + (lane >> 5); scr[kk * 33 + (lane & 31)] = (sc >= 0) ? W[(size_t)(k0 + kk) * ldw + sc] : 0.f; }
    asm volatile("s_waitcnt lgkmcnt(0)" ::: "memory");
    const int c = lane & 7;
#pragma unroll
    for (int j = 0; j < 4; ++j) { const int nn = (lane >> 3) + 8 * j; const LAS float* s = scr + (8 * c) * 33 + nn;
        v4u o; o.x = pk2(s[0 * 33], s[1 * 33]); o.y = pk2(s[2 * 33], s[3 * 33]); o.z = pk2(s[4 * 33], s[5 * 33]); o.w = pk2(s[6 * 33], s[7 * 33]);
        *(v4u*)(WT + (size_t)(n0 + nn) * K + k0 + 8 * c) = o; }
    asm volatile("s_waitcnt lgkmcnt(0)" ::: "memory");
}
__device__ __forceinline__ void p0_prologue(const Params& p, LAS unsigned char* lds, int vcu, int G, int wave, int lane) {
    unsigned char* ws = p.ws;
    LAS float* scr = (LAS float*)(lds + wave * 16384);
    const int gw = vcu * NWAVES + wave, NGW = G * NWAVES;
    constexpr int I_IN = 16 * (N1 / 32), I_Q = 16 * 64, I_FX = 8 * 32, I_O = 16 * 32;
    constexpr int NITEMS = I_IN + I_Q + 2 * I_FX + I_O;
    for (int it = gw; it < NITEMS; it += NGW) {
        int r = it;
        if (r < I_IN) { transpose_item<true>(p.in[I_WIN], IN_COLS, 1024, N1, (bf16*)(ws + WS_WTIN), scr, r, lane); continue; } r -= I_IN;
        if (r < I_Q) { transpose_item<false>(p.in[I_PWQ], 2048, 1024, 2048, (bf16*)(ws + WS_WTQ), scr, r, lane); continue; } r -= I_Q;
        if (r < I_FX) { transpose_item<false>(p.in[I_WFOX], 1024, 512, 1024, (bf16*)(ws + WS_WTFOX), scr, r, lane); continue; } r -= I_FX;
        if (r < I_FX) { transpose_item<false>(p.in[I_WRWKV], 1024, 512, 1024, (bf16*)(ws + WS_WTRWKV), scr, r, lane); continue; } r -= I_FX;
        transpose_item<false>(p.in[I_WOUT], 1024, 1024, 1024, (bf16*)(ws + WS_WTOUT), scr, r, lane);
    }
    const int gt = gw * 64 + lane, NGT = NGW * 64;
    for (int i = gt; i < 1024 * 128; i += NGT) { const int n = i >> 7, k = i & 127; float v = 0.f;
        if (n < 512) { if (k < 64) v = p.in[I_WUP][k * 512 + n]; } else { if (k >= 64) v = p.in[I_AUP][(k - 64) * 512 + (n - 512)]; }
        ((bf16*)(ws + WS_WTWA))[i] = (bf16)f2bf(v); }
    for (int i = gt; i < 512 * 256; i += NGT) { const int n = i >> 8, k = i & 255; const float v = (k < 160) ? p.in[I_GUP][k * 512 + n] : 0.f; ((bf16*)(ws + WS_WTG))[i] = (bf16)f2bf(v); }
    for (int i = gt; i < 2 * 128 * 128; i += NGT) { const float v = (i < 16384) ? p.in[I_SK1][i] : p.in[I_SK2][i - 16384]; ((bf16*)(ws + WS_KS))[i] = (bf16)f2bf(v); }
    for (int i = gt; i < 16384 * 1024 / 4; i += NGT) {
        const f32x4 a = ((const f32x4*)p.in[I_PU])[i]; v2u o; o.x = pk2(a.x, a.y); o.y = pk2(a.z, a.w); ((v2u*)(ws + WS_U16))[i] = o;
        const f32x4 b = ((const f32x4*)p.in[I_PV])[i]; v2u q; q.x = pk2(b.x, b.y); q.y = pk2(b.z, b.w); ((v2u*)(ws + WS_V16))[i] = q; }
    const f32x4* g4 = (const f32x4*)p.in[I_N1G] + lane;
    for (int m = gw; m < R; m += NGW) {
        const int b = m / TP, pp = m - b * TP;
        unsigned long long* o8 = (unsigned long long*)(ws + WS_XN + (size_t)m * 2048) + lane;
        if (pp < 48) {
#pragma unroll
            for (int j = 0; j < 4; ++j) o8[64 * j] = 0ull;
            continue; }
        const float* xrow = (pp < 64) ? p.in[I_META] + (size_t)(pp - 48) * 1024 : p.in[I_X] + ((size_t)b * SEQ + (pp - 64)) * 1024;
        const f32x4* xr = (const f32x4*)xrow + lane;
        f32x4 v[4]; float s = 0.f;
#pragma unroll
        for (int j = 0; j < 4; ++j) { v[j] = xr[64 * j]; s += (v[j].x * v[j].x + v[j].y * v[j].y) + (v[j].z * v[j].z + v[j].w * v[j].w); }
        const float rs = 1.0f / sqrtf(wave_sum(s) * (1.f / 1024.f) + NORM_EPS);
#pragma unroll
        for (int j = 0; j < 4; ++j) { const f32x4 g = g4[64 * j]; o8[64 * j] = (unsigned long long)pk2(v[j].x * rs * g.x, v[j].y * rs * g.y) | ((unsigned long long)pk2(v[j].z * rs * g.z, v[j].w * rs * g.w) << 32); }
    }
}

template <class F> struct EpiT {
    static constexpr bool PERM = true, AFTER_DRAIN = false;
    F f;
    __device__ __forceinline__ void operator()(const pg8::f32x4 (&acc)[2][2][4][2], const pg8::Unit& u, int wr, int wc, int fr, int fq) const {
        const int row0 = u.pm * 256 + wr * 64 + fr, col0 = u.pn * 256 + wc * 32 + 8 * fq;
#pragma unroll
        for (int ai = 0; ai < 2; ++ai)
#pragma unroll
            for (int m = 0; m < 4; ++m)
#pragma unroll
                for (int bj = 0; bj < 2; ++bj) {
                    const pg8::f32x4 a = acc[ai][bj][m][0], b = acc[ai][bj][m][1];
                    float v[8] = {a[0], a[1], a[2], a[3], b[0], b[1], b[2], b[3]};
                    f.store(row0 + ai * 128 + m * 16, col0 + bj * 128, v);
                }
    }
};
struct F_Gemm1 {
    bf16* F; bf16* ZG;
    __device__ __forceinline__ void store(int row, int col, float (&v)[8]) const {
        if (col < 3584) { const int buf = col >> 9, c = col & 511; *(v4u*)(F + (size_t)buf * ((size_t)R * 512) + (size_t)row * 512 + c) = pack8(v); }
        else { const int c = col - 3584;
#pragma unroll
            for (int e = 0; e < 8; ++e) v[e] = sigmoidf_(v[e]);
            *(v4u*)(ZG + (size_t)row * 2048 + c) = pack8(v); }
    }
};
struct F_LoraW {
    bf16* XW; const float* w0;
    __device__ __forceinline__ void store(int row, int col, float (&v)[8]) const {
        const f32x4 b0 = *(const f32x4*)(w0 + col), b1 = *(const f32x4*)(w0 + col + 4); const float bb[8] = {b0.x, b0.y, b0.z, b0.w, b1.x, b1.y, b1.z, b1.w};
#pragma unroll
        for (int e = 0; e < 8; ++e) { const float x = v[e] + bb[e];
            const float sp = fmaxf(-x, 0.f) + __logf(1.0f + __expf(-fabsf(x)));
            const float ew = __expf(-sp - 0.5f);
            v[e] = 1.0f - __expf(-ew); }
        *(v4u*)(XW + (size_t)row * 512 + col) = pack8(v);
    }
};
struct F_LoraA {
    bf16* AA; const float* a0;
    __device__ __forceinline__ void store(int row, int col, float (&v)[8]) const {
        const f32x4 b0 = *(const f32x4*)(a0 + col), b1 = *(const f32x4*)(a0 + col + 4); const float bb[8] = {b0.x, b0.y, b0.z, b0.w, b1.x, b1.y, b1.z, b1.w};
#pragma unroll
        for (int e = 0; e < 8; ++e) v[e] = sigmoidf_(v[e] + bb[e]);
        *(v4u*)(AA + (size_t)row * 512 + col) = pack8(v);
    }
};
struct F_Plain {
    bf16* O; int ldc;
    __device__ __forceinline__ void store(int row, int col, float (&v)[8]) const { *(v4u*)(O + (size_t)row * ldc + col) = pack8(v); }
};
struct F_MixA {
    bf16* MIX; const bf16* ZG;
    __device__ __forceinline__ void store(int row, int col, float (&v)[8]) const {
        float g[8]; unpack8(*(const v4u*)(ZG + (size_t)row * 2048 + col), g);
#pragma unroll
        for (int e = 0; e < 8; ++e) v[e] *= g[e];
        *(v4u*)(MIX + (size_t)row * 1024 + col) = pack8(v);
    }
};
struct F_MixB {
    bf16* MIX; const bf16* ZG;
    __device__ __forceinline__ void store(int row, int col, float (&v)[8]) const {
        float g[8], m[8]; unpack8(*(const v4u*)(ZG + (size_t)row * 2048 + 1024 + col), g); unpack8(*(const v4u*)(MIX + (size_t)row * 1024 + col), m);
#pragma unroll
        for (int e = 0; e < 8; ++e) v[e] = m[e] + v[e] * g[e];
        *(v4u*)(MIX + (size_t)row * 1024 + col) = pack8(v);
    }
};
struct F_Out {
    const float* x; float* out;
    __device__ __forceinline__ void store(int row, int col, float (&v)[8]) const {
        const int b = row / TP, pp = row - b * TP; if (pp < 64) return;
        const size_t off = ((size_t)b * SEQ + (pp - 64)) * 1024 + col;
        const f32x4 x0 = *(const f32x4*)(x + off), x1 = *(const f32x4*)(x + off + 4);
        *(f32x4*)(out + off) = (f32x4){x0.x + v[0], x0.y + v[1], x0.z + v[2], x0.w + v[3]};
        *(f32x4*)(out + off + 4) = (f32x4){x1.x + v[4], x1.y + v[5], x1.z + v[6], x1.w + v[7]};
    }
};
template <class F>
__device__ __forceinline__ void run_gemm(LAS unsigned char* lds, const bf16* A, const bf16* Bt, int M, int N, int K, int G, int bid, const F& f) {
    asm volatile("" : "+s"(M), "+s"(N), "+s"(G));
    pg8::Gemm g{A, Bt, M, N, K}; pg8::StaticOrder S; S.init(M, N, G, bid);
    EpiT<F> E{f};
    pg8::gemm_phase<EpiT<F>, pg8::StaticOrder, true, true>(lds, g, S, E);
}

__device__ __forceinline__ void p2_prep1(const Params& p, int vcu, int G, int wave, int lane) {
    unsigned char* ws = p.ws;
    const int gw = vcu * NWAVES + wave, NGW = G * NWAVES;
    float gq[8], gk[8], mu[8];
#pragma unroll
    for (int e = 0; e < 8; ++e) { gq[e] = p.in[I_FQN][lane * 8 + e] * attn_body::C2; gk[e] = p.in[I_FKN][lane * 8 + e]; mu[e] = (lane < 36) ? p.in[I_MU][1536 + lane * 8 + e] : 0.f; }
    for (int m = gw; m < R; m += NGW) {
        const int b = m / TP, pp = m - b * TP;
        {
            v4u* qp = (v4u*)(ws + WS_FQ + (size_t)m * 1024) + lane; v4u* kp = (v4u*)(ws + WS_FK + (size_t)m * 1024) + lane;
            float q[8], k[8]; unpack8(*qp, q); unpack8(*kp, k);
            float sq = 0.f, sk = 0.f;
#pragma unroll
            for (int e = 0; e < 8; ++e) { sq += q[e] * q[e]; sk += k[e] * k[e]; }
            sq = sum8(sq); sk = sum8(sk);
            const float rq = 1.0f / sqrtf(sq * (1.f / 64.f) + NORM_EPS), rk = 1.0f / sqrtf(sk * (1.f / 64.f) + NORM_EPS);
#pragma unroll
            for (int e = 0; e < 8; ++e) { q[e] *= rq * gq[e]; k[e] *= rk * gk[e]; }
            *qp = pack8(q); *kp = pack8(k);
        }
        if (lane < 36) {
            float z[8], zp[8]; unpack8(*((const v4u*)(ws + WS_ZM + (size_t)m * 1024) + lane), z);
            if (pp > 0) unpack8(*((const v4u*)(ws + WS_ZM + (size_t)(m - 1) * 1024) + lane), zp); else {
#pragma unroll
                for (int e = 0; e < 8; ++e) zp[e] = 0.f; }
#pragma unroll
            for (int e = 0; e < 8; ++e) { const float s = z[e] + mu[e] * (zp[e] - z[e]); z[e] = (lane < 8) ? tanhf(s) : (lane < 16) ? s : sigmoidf_(s); }
            if (lane < 16) *((v4u*)(ws + WS_LA + (size_t)m * 256) + lane) = pack8(z);
            else *((v4u*)(ws + WS_LG + (size_t)m * 512) + (lane - 16)) = pack8(z);
        } else if (lane == 36) {
            float z[8]; unpack8(*((const v4u*)(ws + WS_ZM + (size_t)m * 1024) + 36), z);
#pragma unroll
            for (int e = 0; e < 8; ++e) { const float x = z[e] + p.in[I_FBIAS][e]; z[e] = fminf(x, 0.f) - __logf(1.0f + __expf(-fabsf(x))); }
            float* lf = (float*)(ws + WS_LF) + (size_t)m * 8;
            *(f32x4*)lf = (f32x4){z[0], z[1], z[2], z[3]}; *(f32x4*)(lf + 4) = (f32x4){z[4], z[5], z[6], z[7]};
        } else if (lane < 49) {
            *((v4u*)(ws + WS_LG + (size_t)m * 512) + (lane - 37 + 20)) = (v4u){0u, 0u, 0u, 0u};
        }
    }
}
__device__ __forceinline__ void p3_cumsum(const Params& p, int seq, int lane) {
    unsigned char* ws = p.ws;
    const int b = seq >> 3, h = seq & 7;
    const float* lf = (const float*)(ws + WS_LF) + (size_t)b * TP * 8 + h;
    float* kb = (float*)(ws + WS_KB) + (size_t)seq * TP;
    float carry = 0.f;
    for (int c0 = 0; c0 < 65; c0 += 13) {
        float v[13];
#pragma unroll
        for (int i = 0; i < 13; ++i) { const int pp = (c0 + i) * 64 + lane; v[i] = (pp >= 48) ? lf[(size_t)pp * 8] : 0.f; }
#pragma unroll
        for (int i = 0; i < 13; ++i) {
            float x = v[i];
#pragma unroll
            for (int o = 1; o < 64; o <<= 1) { const float y = __shfl_up(x, o); if (lane >= o) x += y; }
            const int pp = (c0 + i) * 64 + lane;
            const float c = carry + x;
            kb[pp] = (pp >= 48) ? -c * LOG2E : -1e30f;
            carry += __shfl(x, 63);
        }
    }
}

__device__ __forceinline__ void p4_prep2(const Params& p, int vcu, int G, int wave, int lane) {
    unsigned char* ws = p.ws; unsigned char* dob = (unsigned char*)p.out;
    const int gw = vcu * NWAVES + wave, NGW = G * NWAVES;
    float mur[8], muk[8], kk_[8], ka_[8], rk_[8];
#pragma unroll
    for (int e = 0; e < 8; ++e) { const int c = lane * 8 + e; mur[e] = p.in[I_MU][c]; muk[e] = p.in[I_MU][512 + c]; kk_[e] = p.in[I_KK][c]; ka_[e] = p.in[I_KA][c]; rk_[e] = p.in[I_RK][c]; }
    for (int m = gw; m < R; m += NGW) {
        const int b = m / TP, pp = m - b * TP;
        float r[8], k[8], rp[8], kp[8], a[8];
        unpack8(*((const v4u*)(ws + WS_ZRR + (size_t)m * 1024) + lane), r); unpack8(*((const v4u*)(ws + WS_ZRK + (size_t)m * 1024) + lane), k);
        if (pp > 0) { unpack8(*((const v4u*)(ws + WS_ZRR + (size_t)(m - 1) * 1024) + lane), rp); unpack8(*((const v4u*)(ws + WS_ZRK + (size_t)(m - 1) * 1024) + lane), kp); }
        else {
#pragma unroll
            for (int e = 0; e < 8; ++e) { rp[e] = 0.f; kp[e] = 0.f; } }
        v4u* aap = (v4u*)(dob + DO_AA + (size_t)m * 1024) + lane;
        unpack8(*aap, a);
        float kkv[8], kpr[8]; float ss = 0.f, bon = 0.f;
#pragma unroll
        for (int e = 0; e < 8; ++e) { const float rs = r[e] + mur[e] * (rp[e] - r[e]); const float ks = k[e] + muk[e] * (kp[e] - k[e]);
            kkv[e] = ks * kk_[e]; kpr[e] = ks * (1.0f + (a[e] - 1.0f) * ka_[e]); ss += kkv[e] * kkv[e]; bon += rs * kpr[e] * rk_[e]; }
        ss = sum8(ss); bon = sum8(bon);
        const float inv = 1.0f / fmaxf(sqrtf(ss), 1e-12f);
        float bb[8];
#pragma unroll
        for (int e = 0; e < 8; ++e) { kkv[e] *= inv; bb[e] = kkv[e] * a[e]; }
        *((v4u*)(ws + WS_KP + (size_t)m * 1024) + lane) = pack8(kpr);
        *((v4u*)(ws + WS_KN + (size_t)m * 1024) + lane) = pack8(kkv);
        *aap = pack8(bb);
        if ((lane & 7) == 0) ((float*)(ws + WS_BS))[(size_t)m * 8 + (lane >> 3)] = bon;
    }
}

constexpr int SC_CH = 32, SC_STRIDE = 5 * 64 + 32;
__device__ __forceinline__ float dpp_sum16(float x) {
    x += __builtin_bit_cast(float, __builtin_amdgcn_update_dpp(0, __builtin_bit_cast(int, x), 0xB1, 0xF, 0xF, true));
    x += __builtin_bit_cast(float, __builtin_amdgcn_update_dpp(0, __builtin_bit_cast(int, x), 0x4E, 0xF, 0xF, true));
    x += __builtin_bit_cast(float, __builtin_amdgcn_update_dpp(0, __builtin_bit_cast(int, x), 0x141, 0xF, 0xF, true));
    x += __builtin_bit_cast(float, __builtin_amdgcn_update_dpp(0, __builtin_bit_cast(int, x), 0x140, 0xF, 0xF, true));
    return x;
}
__device__ __forceinline__ void p5_scan_item(const Params& p, LAS unsigned char* lds, int item, int tid, int wave, int lane) {
    unsigned char* ws = p.ws; unsigned char* dob = (unsigned char*)p.out;
    const int half = item & 1, bh = item >> 1, b = bh >> 3, h = bh & 7;
    LAS float* buf = (LAS float*)lds;
    LAS float* ybuf = buf + SC_CH * SC_STRIDE;
    const size_t rowb = (size_t)b * TP;
    const int st_step = (tid >> 3) & 31, st_grp = tid >> 8, c8 = tid & 7;
    const size_t colb = (size_t)h * 64 + c8 * 8;
    const bf16* aXW = (const bf16*)(dob + DO_XW); const bf16* aKN = (const bf16*)(ws + WS_KN); const bf16* aBB = (const bf16*)(dob + DO_AA); const bf16* aKP = (const bf16*)(ws + WS_KP);
    const bf16* aR = (const bf16*)(ws + WS_ZRR); const bf16* aV = (const bf16*)(ws + WS_ZRV);
    float mu8[8];
#pragma unroll
    for (int e = 0; e < 8; ++e) mu8[e] = (st_grp == 0) ? p.in[I_MU][h * 64 + c8 * 8 + e] : ((c8 < 4) ? p.in[I_MU][1024 + h * 64 + half * 32 + c8 * 8 + e] : 0.f);
    v4u g0, g1, g2, g3;
    auto issue = [&](int t0) {
        const size_t row = rowb + t0 + st_step;
        if (st_grp == 0) { g0 = *(const v4u*)(aXW + row * 512 + colb); g1 = *(const v4u*)(aKN + row * 512 + colb); g2 = *(const v4u*)(aR + row * 512 + colb); g3 = *(const v4u*)(aR + (row - 1) * 512 + colb); }
        else { g0 = *(const v4u*)(aBB + row * 512 + colb); g1 = *(const v4u*)(aKP + row * 512 + colb);
            if (c8 < 4) { const size_t cv = (size_t)h * 64 + half * 32 + c8 * 8; g2 = *(const v4u*)(aV + row * 512 + cv); g3 = *(const v4u*)(aV + (row - 1) * 512 + cv); } }
    };
    auto commit = [&]() {
        LAS float* d = buf + st_step * SC_STRIDE;
        float a[8], c[8];
        if (st_grp == 0) {
            unpack8(g0, a); *(LAS f32x4*)(d + 0 * 64 + c8 * 8) = (f32x4){a[0], a[1], a[2], a[3]}; *(LAS f32x4*)(d + 0 * 64 + c8 * 8 + 4) = (f32x4){a[4], a[5], a[6], a[7]};
            unpack8(g1, a); *(LAS f32x4*)(d + 1 * 64 + c8 * 8) = (f32x4){a[0], a[1], a[2], a[3]}; *(LAS f32x4*)(d + 1 * 64 + c8 * 8 + 4) = (f32x4){a[4], a[5], a[6], a[7]};
            unpack8(g2, a); unpack8(g3, c);
#pragma unroll
            for (int e = 0; e < 8; ++e) a[e] = a[e] + mu8[e] * (c[e] - a[e]);
            *(LAS f32x4*)(d + 4 * 64 + c8 * 8) = (f32x4){a[0], a[1], a[2], a[3]}; *(LAS f32x4*)(d + 4 * 64 + c8 * 8 + 4) = (f32x4){a[4], a[5], a[6], a[7]};
        } else {
            unpack8(g0, a); *(LAS f32x4*)(d + 2 * 64 + c8 * 8) = (f32x4){a[0], a[1], a[2], a[3]}; *(LAS f32x4*)(d + 2 * 64 + c8 * 8 + 4) = (f32x4){a[4], a[5], a[6], a[7]};
            unpack8(g1, a); *(LAS f32x4*)(d + 3 * 64 + c8 * 8) = (f32x4){a[0], a[1], a[2], a[3]}; *(LAS f32x4*)(d + 3 * 64 + c8 * 8 + 4) = (f32x4){a[4], a[5], a[6], a[7]};
            if (c8 < 4) { unpack8(g2, a); unpack8(g3, c);
#pragma unroll
                for (int e = 0; e < 8; ++e) a[e] = a[e] + mu8[e] * (c[e] - a[e]);
                *(LAS f32x4*)(d + 5 * 64 + c8 * 8) = (f32x4){a[0], a[1], a[2], a[3]}; *(LAS f32x4*)(d + 5 * 64 + c8 * 8 + 4) = (f32x4){a[4], a[5], a[6], a[7]}; }
        }
    };
    const int rl = lane >> 4, kq = lane & 15, myrow = wave * 4 + rl;
    float S0 = 0.f, S1 = 0.f, S2 = 0.f, S3 = 0.f;
    constexpr int T0 = 32, NCH = (TP - T0) / SC_CH;
    bf16* Y = (bf16*)(ws + WS_Y);
    issue(T0);
    for (int ch = 0; ch < NCH; ++ch) {
        const int t0 = T0 + ch * SC_CH;
        __syncthreads();
        commit();
        __syncthreads();
        if (ch + 1 < NCH) issue(t0 + SC_CH);
        const LAS float* sp = buf + kq * 4;
#pragma unroll 4
        for (int s = 0; s < SC_CH; ++s) {
            const LAS float* q = sp + s * SC_STRIDE;
            const f32x4 xw = *(const LAS f32x4*)(q), kn = *(const LAS f32x4*)(q + 64), bb = *(const LAS f32x4*)(q + 128), kp = *(const LAS f32x4*)(q + 192), rr = *(const LAS f32x4*)(q + 256);
            const float vv = buf[s * SC_STRIDE + 320 + myrow];
            float sa = S0 * kn.x; sa = fmaf(S1, kn.y, sa); sa = fmaf(S2, kn.z, sa); sa = fmaf(S3, kn.w, sa);
            sa = -dpp_sum16(sa);
            S0 = fmaf(vv, kp.x, fmaf(sa, bb.x, fmaf(-S0, xw.x, S0)));
            S1 = fmaf(vv, kp.y, fmaf(sa, bb.y, fmaf(-S1, xw.y, S1)));
            S2 = fmaf(vv, kp.z, fmaf(sa, bb.z, fmaf(-S2, xw.z, S2)));
            S3 = fmaf(vv, kp.w, fmaf(sa, bb.w, fmaf(-S3, xw.w, S3)));
            float y = S0 * rr.x; y = fmaf(S1, rr.y, y); y = fmaf(S2, rr.z, y); y = fmaf(S3, rr.w, y);
            y = dpp_sum16(y);
            if (kq == 0) ybuf[s * 32 + myrow] = y;
        }
        __syncthreads();
        {
            const int s = tid >> 4, rp = tid & 15;
            const float y0 = ybuf[s * 32 + 2 * rp], y1 = ybuf[s * 32 + 2 * rp + 1];
            *(unsigned*)(Y + (rowb + t0 + s) * 512 + h * 64 + half * 32 + 2 * rp) = pk2(y0, y1);
        }
    }
    __syncthreads();
}

__device__ __forceinline__ void p6_prep3(const Params& p, int vcu, int G, int wave, int lane) {
    unsigned char* ws = p.ws; unsigned char* dob = (unsigned char*)p.out;
    const int gw = vcu * NWAVES + wave, NGW = G * NWAVES;
    float lg[8], lb[8], muv[8];
#pragma unroll
    for (int e = 0; e < 8; ++e) { const int c = lane * 8 + e; lg[e] = p.in[I_LNG][c]; lb[e] = p.in[I_LNB][c]; muv[e] = p.in[I_MU][1024 + c]; }
    for (int m = gw; m < R; m += NGW) {
        const int b = m / TP, pp = m - b * TP;
        v4u* yp = (v4u*)(ws + WS_Y + (size_t)m * 1024) + lane;
        if (pp < 48) { *yp = (v4u){0u, 0u, 0u, 0u}; continue; }
        float y[8], v[8], vp[8], g[8];
        unpack8(*yp, y); unpack8(*((const v4u*)(ws + WS_ZRV + (size_t)m * 1024) + lane), v); unpack8(*((const v4u*)(ws + WS_ZRV + (size_t)(m - 1) * 1024) + lane), vp);
        unpack8(*((const v4u*)(dob + DO_GG + (size_t)m * 1024) + lane), g);
        float s = 0.f;
#pragma unroll
        for (int e = 0; e < 8; ++e) s += y[e];
        const float mean = sum8(s) * (1.f / 64.f); float q = 0.f;
#pragma unroll
        for (int e = 0; e < 8; ++e) { y[e] -= mean; q += y[e] * y[e]; }
        const float rstd = 1.0f / sqrtf(sum8(q) * (1.f / 64.f) + GN_EPS);
        const float bon = ((const float*)(ws + WS_BS))[(size_t)m * 8 + (lane >> 3)];
#pragma unroll
        for (int e = 0; e < 8; ++e) { const float vs = v[e] + muv[e] * (vp[e] - v[e]); y[e] = (y[e] * rstd * lg[e] + lb[e] + bon * vs) * g[e]; }
        *yp = pack8(y);
    }
}
__device__ __forceinline__ void p9_norm2(const Params& p, int vcu, int G, int wave, int lane) {
    unsigned char* ws = p.ws;
    const int gw = vcu * NWAVES + wave, NGW = G * NWAVES;
    const f32x4* g4 = (const f32x4*)p.in[I_N2G] + lane;
    for (int m = gw; m < NTOK; m += NGW) {
        const f32x4* xr = (const f32x4*)(p.out + (size_t)m * 1024) + lane;
        f32x4 v[4]; float s = 0.f;
#pragma unroll
        for (int j = 0; j < 4; ++j) { v[j] = xr[64 * j]; s += (v[j].x * v[j].x + v[j].y * v[j].y) + (v[j].z * v[j].z + v[j].w * v[j].w); }
        const float rs = 1.0f / sqrtf(wave_sum(s) * (1.f / 1024.f) + NORM_EPS);
        unsigned long long* o8 = (unsigned long long*)(ws + WS_XN2 + (size_t)m * 2048) + lane;
#pragma unroll
        for (int j = 0; j < 4; ++j) { const f32x4 g = g4[64 * j]; o8[64 * j] = (unsigned long long)pk2(v[j].x * rs * g.x, v[j].y * rs * g.y) | ((unsigned long long)pk2(v[j].z * rs * g.z, v[j].w * rs * g.w) << 32); }
    }
}

typedef __bf16 bf16x2_t __attribute__((ext_vector_type(2)));
__device__ __forceinline__ unsigned mono(float f) { const unsigned u = __builtin_bit_cast(unsigned, f); return u ^ ((unsigned)((int)u >> 31) | 0x80000000u); }
__device__ __forceinline__ float unmono(unsigned m) { const unsigned u = (m & 0x80000000u) ? (m ^ 0x80000000u) : ~m; return __builtin_bit_cast(float, u); }
__device__ __forceinline__ void ce_desc(unsigned& a, unsigned& b) { const unsigned hi = a > b ? a : b, lo = a > b ? b : a; a = hi; b = lo; }
template <int BASE, int N> __device__ __forceinline__ void bitonic_sort_desc(unsigned (&v)[N]) {
#pragma unroll
    for (int k = 2; k <= 16; k <<= 1)
#pragma unroll
        for (int j = k >> 1; j > 0; j >>= 1)
#pragma unroll
            for (int i = 0; i < 16; ++i) { const int l = i ^ j; if (l > i) { if ((i & k) == 0) ce_desc(v[BASE + i], v[BASE + l]); else ce_desc(v[BASE + l], v[BASE + i]); } }
}
template <int A, int B, int N> __device__ __forceinline__ void merge_top16(unsigned (&v)[N]) {
#pragma unroll
    for (int i = 0; i < 16; ++i) { const unsigned x = v[A + i], y = v[B + 15 - i]; v[A + i] = x > y ? x : y; }
#pragma unroll
    for (int j = 8; j > 0; j >>= 1)
#pragma unroll
        for (int i = 0; i < 16; ++i) { const int l = i ^ j; if (l > i) ce_desc(v[A + i], v[A + l]); }
}
constexpr int KS_STRIDE = 272;
constexpr int RT_KS_BYTES = 256 * KS_STRIDE;
constexpr int RT_TAB_WORDS = 33;
__device__ __forceinline__ void p11_route(const Params& p, LAS unsigned char* lds, int vcu, int G, int tid, int wave, int lane) {
    unsigned char* ws = p.ws;
    for (int i = tid; i < 256 * 16; i += NTHREADS) { const int row = i >> 4, ch = i & 15; *(LAS v4u*)(lds + row * KS_STRIDE + ch * 16) = *((const v4u*)(ws + WS_KS) + i); }
    __syncthreads();
    LAS unsigned* tab = (LAS unsigned*)(lds + RT_KS_BYTES) + (wave * 64 + lane) * RT_TAB_WORDS;
    const int r32 = lane & 31, hi = lane >> 5;
    const int gw = vcu * NWAVES + wave, NGW = G * NWAVES;
    const bf16* PQ = (const bf16*)(ws + WS_PQ);
    int* IDS = (int*)(ws + WS_IDS); float* GATES = (float*)(ws + WS_GATES);
    for (int task = gw; task < (NTOK / 32) * 8; task += NGW) {
        const int tb = task >> 3, h = task & 7;
        const int token = tb * 32 + r32;
        unsigned v[128];
        {
            const bf16* qrow = PQ + (size_t)token * 2048 + h * 256 + hi * 8;
#pragma unroll
            for (int t = 0; t < 4; ++t) {
                f32x16v acc[2];
#pragma unroll
                for (int w = 0; w < 2; ++w) {
                    f32x16v c = {};
                    const LAS unsigned char* kb = lds + (w * 128 + t * 32 + r32) * KS_STRIDE + hi * 16;
#pragma unroll
                    for (int s = 0; s < 8; ++s) { const bf16x8 a = *(const LAS bf16x8*)(kb + s * 32); const bf16x8 qf = *(const bf16x8*)(qrow + w * 128 + 16 * s); c = __builtin_amdgcn_mfma_f32_32x32x16_bf16(a, qf, c, 0, 0, 0); }
                    acc[w] = c;
                }
#pragma unroll
                for (int r = 0; r < 16; ++r) {
                    const float xa = acc[0][r], xb = acc[1][r];
                    auto rr = __builtin_amdgcn_permlane32_swap(__float_as_uint(xa), __float_as_uint(xb), false, false);
                    const unsigned r0 = rr[0], r1 = rr[1];
                    const int cr = (r & 3) + 8 * (r >> 2);
                    v[t * 16 + r] = (mono(__uint_as_float(r0)) & ~0x7Fu) | (unsigned)(32 * t + cr);
                    v[64 + t * 16 + r] = (mono(__uint_as_float(r1)) & ~0x7Fu) | (unsigned)(32 * t + cr + 4);
                }
            }
        }
        bitonic_sort_desc<0>(v); bitonic_sort_desc<16>(v); bitonic_sort_desc<32>(v); bitonic_sort_desc<48>(v);
        bitonic_sort_desc<64>(v); bitonic_sort_desc<80>(v); bitonic_sort_desc<96>(v); bitonic_sort_desc<112>(v);
        merge_top16<0, 16>(v); merge_top16<32, 48>(v); merge_top16<64, 80>(v); merge_top16<96, 112>(v);
        merge_top16<0, 32>(v); merge_top16<64, 96>(v);
        merge_top16<0, 64>(v);
        unsigned T[16], U[16];
#pragma unroll
        for (int i = 0; i < 16; ++i) { auto rr = __builtin_amdgcn_permlane32_swap(v[i], v[i], false, false); T[i] = v[i]; U[i] = hi ? rr[0] : rr[1]; }
        { const int bT = hi ? 16 : 0, bU = hi ? 0 : 16;
#pragma unroll
          for (int i = 0; i < 16; ++i) { tab[bT + i] = T[i] & 0x7Fu; tab[bU + i] = U[i] & 0x7Fu; } }
        float tv[16], uv[16];
#pragma unroll
        for (int i = 0; i < 16; ++i) { tv[i] = unmono(T[i] & ~0x7Fu); uv[i] = unmono(U[i] & ~0x7Fu); }
        unsigned c[32];
        {
            int n = 0;
#pragma unroll
            for (int i = 0; i < 4; ++i)
#pragma unroll
                for (int j = i; j < 16; ++j) if ((i + 1) * (j + 1) <= 16) {
                    const float s = tv[i] + uv[j];
                    const unsigned pay = hi ? (unsigned)((j << 4) | i) : (unsigned)((i << 4) | j);
                    unsigned key = (mono(s) & ~0xFFu) | pay;
                    if (i == j && hi) key = 0u;
                    c[n++] = key;
                }
#pragma unroll
            for (int k = 27; k < 32; ++k) c[k] = 0u;
        }
        bitonic_sort_desc<0>(c); bitonic_sort_desc<16>(c); merge_top16<0, 16>(c);
        unsigned W[32];
#pragma unroll
        for (int i = 0; i < 16; ++i) { auto rr = __builtin_amdgcn_permlane32_swap(c[i], c[i], false, false); W[i] = rr[0]; W[16 + i] = rr[1]; }
        merge_top16<0, 16>(W);
        asm volatile("s_waitcnt lgkmcnt(0)" ::: "memory");
        if (!hi) {
            int ids[16];
#pragma unroll
            for (int k = 0; k < 16; ++k) ids[k] = (int)(tab[(W[k] >> 4) & 15u] * 128u + tab[16 + (W[k] & 15u)]);
            int* o = IDS + (size_t)token * 128 + h * 16;
#pragma unroll
            for (int k = 0; k < 16; k += 4) *(v4u*)(o + k) = (v4u){(unsigned)ids[k], (unsigned)ids[k + 1], (unsigned)ids[k + 2], (unsigned)ids[k + 3]};
        } else {
            float e[16]; const float s0 = unmono(W[0] & ~0xFFu); float sum = 0.f;
#pragma unroll
            for (int k = 0; k < 16; ++k) { e[k] = __expf(unmono(W[k] & ~0xFFu) - s0); sum += e[k]; }
            const float inv = 1.0f / sum;
            float* o = GATES + (size_t)token * 128 + h * 16;
#pragma unroll
            for (int k = 0; k < 16; k += 4) *(f32x4*)(o + k) = (f32x4){e[k] * inv, e[k + 1] * inv, e[k + 2] * inv, e[k + 3] * inv};
        }
        asm volatile("s_waitcnt lgkmcnt(0)" ::: "memory");
    }
}

constexpr size_t WS_PART = 96 * MiB;
__device__ __forceinline__ float dpp_sum8(float x) {
    x += __builtin_bit_cast(float, __builtin_amdgcn_update_dpp(0, __builtin_bit_cast(int, x), 0xB1, 0xF, 0xF, true));
    x += __builtin_bit_cast(float, __builtin_amdgcn_update_dpp(0, __builtin_bit_cast(int, x), 0x4E, 0xF, 0xF, true));
    x += __builtin_bit_cast(float, __builtin_amdgcn_update_dpp(0, __builtin_bit_cast(int, x), 0x141, 0xF, 0xF, true));
    return x;
}
__device__ __forceinline__ void p12a_partial(const Params& p, int bid, int G, int wave, int lane) {
    unsigned char* ws = p.ws;
    const int xcd = bid & 7, wx = (bid >> 3) * NWAVES + wave, NWX = (G >> 3) * NWAVES;
    const int eg = lane >> 3, cj = lane & 7;
    const bf16* XN2 = (const bf16*)(ws + WS_XN2); const int* IDS = (const int*)(ws + WS_IDS); float* PART = (float*)(ws + WS_PART);
#pragma unroll 1
    for (int pass = 0; pass < 2; ++pass) {
        const int s = xcd + 8 * pass;
        const bf16* Us = (const bf16*)(ws + WS_U16) + 64 * s + 8 * cj;
        for (int t = wx; t < NTOK; t += NWX) {
            const v4u xs = *(const v4u*)(XN2 + (size_t)t * 1024 + 64 * s + 8 * cj);
            const unsigned xx = xs.x, xy = xs.y, xz = xs.z, xw = xs.w;
            const v4u* idp = (const v4u*)(IDS + (size_t)t * 128 + 16 * eg);
            int ids[16];
#pragma unroll
            for (int q = 0; q < 4; ++q) { const v4u iv = idp[q]; ids[4 * q] = (int)iv.x; ids[4 * q + 1] = (int)iv.y; ids[4 * q + 2] = (int)iv.z; ids[4 * q + 3] = (int)iv.w; }
            v4u u[16];
#pragma unroll
            for (int i = 0; i < 16; ++i) u[i] = *(const v4u*)(Us + (size_t)ids[i] * 1024);
            float k0 = 0.f, k1 = 0.f;
#pragma unroll
            for (int i = 0; i < 16; ++i) {
                const unsigned ux = u[i].x, uy = u[i].y, uz = u[i].z, uw = u[i].w;
                float d = __builtin_amdgcn_fdot2_f32_bf16(__builtin_bit_cast(bf16x2_t, ux), __builtin_bit_cast(bf16x2_t, xx), 0.f, false);
                d = __builtin_amdgcn_fdot2_f32_bf16(__builtin_bit_cast(bf16x2_t, uy), __builtin_bit_cast(bf16x2_t, xy), d, false);
                d = __builtin_amdgcn_fdot2_f32_bf16(__builtin_bit_cast(bf16x2_t, uz), __builtin_bit_cast(bf16x2_t, xz), d, false);
                d = __builtin_amdgcn_fdot2_f32_bf16(__builtin_bit_cast(bf16x2_t, uw), __builtin_bit_cast(bf16x2_t, xw), d, false);
                d = dpp_sum8(d);
                if (i < 8) k0 = (cj == i) ? d : k0; else k1 = (cj == i - 8) ? d : k1;
            }
            float* po = PART + ((size_t)s * NTOK + t) * 128 + 16 * eg + cj;
            __builtin_nontemporal_store(k0, po); __builtin_nontemporal_store(k1, po + 8);
        }
    }
}
__device__ __forceinline__ void p12b_combine(const Params& p, int vcu, int G, int wave, int lane) {
    unsigned char* ws = p.ws;
    const int gw = vcu * NWAVES + wave, NGW = G * NWAVES;
    const float* PART = (const float*)(ws + WS_PART); float* GW = (float*)(ws + WS_GATES);
    for (int t = gw; t < NTOK; t += NGW) {
        float h0 = 0.f, h1 = 0.f;
#pragma unroll
        for (int s = 0; s < 16; ++s) { const float* pp = PART + ((size_t)s * NTOK + t) * 128; h0 += __builtin_nontemporal_load(pp + lane); h1 += __builtin_nontemporal_load(pp + lane + 64); }
        float* g = GW + (size_t)t * 128;
        const float g0 = g[lane], g1 = g[lane + 64];
        g[lane] = g0 * 0.5f * h0 * (1.0f + erff(h0 * 0.70710678118654752f));
        g[lane + 64] = g1 * 0.5f * h1 * (1.0f + erff(h1 * 0.70710678118654752f));
    }
}
__device__ __forceinline__ void p12c_output(const Params& p, int bid, int G, int wave, int lane) {
    unsigned char* ws = p.ws;
    const int xcd = bid & 7, wx = (bid >> 3) * NWAVES + wave, NWX = (G >> 3) * NWAVES;
    const int eg = lane >> 3, cj = lane & 7;
    const int b5 = (lane >> 5) & 1, b4 = (lane >> 4) & 1, b3 = (lane >> 3) & 1;
    const int* IDS = (const int*)(ws + WS_IDS); const float* GW = (const float*)(ws + WS_GATES);
#pragma unroll 1
    for (int pass = 0; pass < 2; ++pass) {
        const int s = xcd + 8 * pass;
        const bf16* Vs = (const bf16*)(ws + WS_V16) + 64 * s + 8 * cj;
        const int ocol = 64 * s + 8 * cj + 4 * b5 + 2 * b4 + b3;
        for (int t = wx; t < NTOK; t += NWX) {
            const v4u* idp = (const v4u*)(IDS + (size_t)t * 128 + 16 * eg); const f32x4* wp = (const f32x4*)(GW + (size_t)t * 128 + 16 * eg);
            int ids[16]; float w[16];
#pragma unroll
            for (int q = 0; q < 4; ++q) { const v4u iv = idp[q]; ids[4 * q] = (int)iv.x; ids[4 * q + 1] = (int)iv.y; ids[4 * q + 2] = (int)iv.z; ids[4 * q + 3] = (int)iv.w;
                const f32x4 wv = wp[q]; w[4 * q] = wv.x; w[4 * q + 1] = wv.y; w[4 * q + 2] = wv.z; w[4 * q + 3] = wv.w; }
            const float hres = __builtin_nontemporal_load(p.out + (size_t)t * 1024 + ocol);
            v4u vv[16];
#pragma unroll
            for (int i = 0; i < 16; ++i) vv[i] = *(const v4u*)(Vs + (size_t)ids[i] * 1024);
            float o[8];
#pragma unroll
            for (int k = 0; k < 8; ++k) o[k] = 0.f;
#pragma unroll
            for (int i = 0; i < 16; ++i) { float f[8]; unpack8(vv[i], f);
#pragma unroll
                for (int k = 0; k < 8; ++k) o[k] = fmaf(w[i], f[k], o[k]); }
            float r4[4], r2[2];
#pragma unroll
            for (int j = 0; j < 4; ++j) { const float keep = b5 ? o[4 + j] : o[j], send = b5 ? o[j] : o[4 + j]; r4[j] = keep + __shfl_xor(send, 32); }
#pragma unroll
            for (int j = 0; j < 2; ++j) { const float keep = b4 ? r4[2 + j] : r4[j], send = b4 ? r4[j] : r4[2 + j]; r2[j] = keep + __shfl_xor(send, 16); }
            const float keep = b3 ? r2[1] : r2[0], send = b3 ? r2[0] : r2[1];
            const float tot = keep + __shfl_xor(send, 8);
            __builtin_nontemporal_store(hres + tot, p.out + (size_t)t * 1024 + ocol);
        }
    }
}

#if DIAG
constexpr size_t WS_DIAG = 1006 * MiB;
constexpr size_t WS_DSAVE = 1007 * MiB;
__device__ __forceinline__ unsigned dhash(unsigned x) { x ^= x >> 16; x *= 0x7feb352dU; x ^= x >> 15; x *= 0x846ca68bU; x ^= x >> 16; return x; }
__device__ __forceinline__ float bf2f(bf16 b) { return __builtin_bit_cast(float, (unsigned)b << 16); }
__device__ __forceinline__ float rbf(float x) { return bf2f((bf16)f2bf(x)); }
__device__ __forceinline__ void diag_report(const Params& p, int stage, float err) {
    if (!(err == err)) err = 1e30f;
#pragma unroll
    for (int o = 1; o < 64; o <<= 1) err = fmaxf(err, __shfl_xor(err, o));
    int t_ = threadIdx.x; asm volatile("" : "+v"(t_)); if ((t_ & 63) == 0) atomicMax((unsigned*)(p.ws + WS_DIAG) + stage, __builtin_bit_cast(unsigned, err));
}
#define DG_IDS() int tid_ = threadIdx.x; asm volatile("" : "+v"(tid_)); const int tid = tid_, lane = tid & 63; int G_ = gridDim.x; asm volatile("" : "+s"(G_)); const int gt = blockIdx.x * NTHREADS + tid, NGT = G_ * NTHREADS; const int gwv = gt >> 6, NGWV = NGT >> 6; (void)lane; (void)gwv; (void)NGWV; (void)NGT
__device__ __forceinline__ float relerr(float got, float ref, float fl) { return fabsf(got - ref) / (fabsf(ref) + fl); }

__device__ __forceinline__ void dg_p0(const Params& p) {
    DG_IDS(); unsigned char* ws = p.ws; float e1 = 0.f, e2 = 0.f;
    for (int s = gwv; s < 4096; s += NGWV) {
        const int m = dhash(s * 7 + 1) % R; const int b = m / TP, pp = m - b * TP;
        const bf16* xn = (const bf16*)(ws + WS_XN) + (size_t)m * 1024;
        if (pp < 48) { for (int c = lane; c < 1024; c += 64) e1 = fmaxf(e1, fabsf(bf2f(xn[c]))); continue; }
        const float* xr = (pp < 64) ? p.in[I_META] + (size_t)(pp - 48) * 1024 : p.in[I_X] + ((size_t)b * SEQ + (pp - 64)) * 1024;
        float ss = 0.f; for (int c = lane; c < 1024; c += 64) ss += xr[c] * xr[c];
        ss = wave_sum(ss); const float rs = 1.0f / sqrtf(ss / 1024.f + NORM_EPS);
        for (int c = lane; c < 1024; c += 64) e1 = fmaxf(e1, relerr(bf2f(xn[c]), xr[c] * rs * p.in[I_N1G][c], 0.05f));
    }
    for (int s = gt; s < 200000; s += NGT) {
        const unsigned hsh = dhash(s * 3 + 5); const int k = hsh & 1023, n = (hsh >> 10) % N1; const int sc = win_src_col(n);
        const float ref = sc >= 0 ? p.in[I_WIN][(size_t)k * IN_COLS + sc] : 0.f;
        e2 = fmaxf(e2, fabsf(bf2f(((const bf16*)(ws + WS_WTIN))[(size_t)n * 1024 + k]) - rbf(ref)));
        const int n2 = (hsh >> 10) & 2047;
        e2 = fmaxf(e2, fabsf(bf2f(((const bf16*)(ws + WS_WTQ))[(size_t)n2 * 1024 + k]) - rbf(p.in[I_PWQ][(size_t)k * 2048 + n2])));
        const int n3 = n2 & 1023, k3 = k & 511;
        e2 = fmaxf(e2, fabsf(bf2f(((const bf16*)(ws + WS_WTFOX))[(size_t)n3 * 512 + k3]) - rbf(p.in[I_WFOX][(size_t)k3 * 1024 + n3])));
        e2 = fmaxf(e2, fabsf(bf2f(((const bf16*)(ws + WS_WTRWKV))[(size_t)n3 * 512 + k3]) - rbf(p.in[I_WRWKV][(size_t)k3 * 1024 + n3])));
        e2 = fmaxf(e2, fabsf(bf2f(((const bf16*)(ws + WS_WTOUT))[(size_t)n3 * 1024 + k]) - rbf(p.in[I_WOUT][(size_t)k * 1024 + n3])));
        const size_t ei = (size_t)(hsh % (16384u * 1024u));
        e2 = fmaxf(e2, fabsf(bf2f(((const bf16*)(ws + WS_U16))[ei]) - rbf(p.in[I_PU][ei])));
        e2 = fmaxf(e2, fabsf(bf2f(((const bf16*)(ws + WS_V16))[ei]) - rbf(p.in[I_PV][ei])));
    }
    diag_report(p, 1, e1 / 0.03f); diag_report(p, 2, e2 / 1e-6f);
}
__device__ __forceinline__ float dg_dot(const bf16* A, size_t row, const bf16* Bt, size_t n, int K) {
    const bf16* a = A + row * K; const bf16* b = Bt + n * K; float s = 0.f;
    for (int k = 0; k < K; k += 8) { float x[8], y[8]; unpack8(*(const v4u*)(a + k), x); unpack8(*(const v4u*)(b + k), y);
#pragma unroll
        for (int e = 0; e < 8; ++e) s = fmaf(x[e], y[e], s); }
    return s;
}
__device__ __forceinline__ void dg_gemm1(const Params& p) {
    DG_IDS(); unsigned char* ws = p.ws; float e = 0.f;
    for (int s = gt; s < 262144; s += NGT) {
        const unsigned hsh = dhash(s * 11 + 3); const int row = hsh % R, n = dhash(hsh) % N1;
        const float ref = dg_dot((const bf16*)(ws + WS_XN), row, (const bf16*)(ws + WS_WTIN), n, 1024);
        float got, want;
        if (n < 3584) { got = bf2f(((const bf16*)(ws + WS_F))[(size_t)(n >> 9) * ((size_t)R * 512) + (size_t)row * 512 + (n & 511)]); want = ref; }
        else { got = bf2f(((const bf16*)(ws + WS_ZG))[(size_t)row * 2048 + (n - 3584)]); want = 1.0f / (1.0f + expf(-ref)); }
        e = fmaxf(e, relerr(got, want, 0.25f));
    }
    diag_report(p, 3, e / 0.02f);
}
__device__ __forceinline__ void dg_p2(const Params& p) {
    DG_IDS(); unsigned char* ws = p.ws; float e = 0.f;
    for (int s = gt; s < 262144; s += NGT) {
        const unsigned hsh = dhash(s * 13 + 7); const int m = hsh % R, c = dhash(hsh) % 296; const int pp = m % TP;
        const bf16* zm = (const bf16*)(ws + WS_ZM);
        const float z = bf2f(zm[(size_t)m * 512 + c]);
        if (c >= 288) { const float x = z + p.in[I_FBIAS][c - 288]; const float want = -log1pf(expf(-x)); e = fmaxf(e, relerr(((const float*)(ws + WS_LF))[(size_t)m * 8 + (c - 288)], want, 0.01f)); continue; }
        const float zp = pp > 0 ? bf2f(zm[(size_t)(m - 1) * 512 + c]) : 0.f; const float mu = p.in[I_MU][1536 + c];
        const float zs = z + mu * (zp - z);
        if (c < 64) e = fmaxf(e, relerr(bf2f(((const bf16*)(ws + WS_LA))[(size_t)m * 128 + c]), tanhf(zs), 0.1f));
        else if (c < 128) e = fmaxf(e, relerr(bf2f(((const bf16*)(ws + WS_LA))[(size_t)m * 128 + c]), zs, 0.1f));
        else e = fmaxf(e, relerr(bf2f(((const bf16*)(ws + WS_LG))[(size_t)m * 256 + (c - 128)]), 1.0f / (1.0f + expf(-zs)), 0.1f));
        if (pp >= 48) { const int h = c & 7; float sq = 0.f, sk = 0.f;
            for (int d = 0; d < 64; ++d) { const float q = bf2f(((const bf16*)(ws + WS_FQ))[(size_t)m * 512 + h * 64 + d]) / (p.in[I_FQN][h * 64 + d] * attn_body::C2); sq += q * q;
                const float k = bf2f(((const bf16*)(ws + WS_FK))[(size_t)m * 512 + h * 64 + d]) / p.in[I_FKN][h * 64 + d]; sk += k * k; }
            e = fmaxf(e, fabsf(sq / 64.f - 1.f)); e = fmaxf(e, fabsf(sk / 64.f - 1.f)); }
    }
    diag_report(p, 4, e / 0.03f);
}
__device__ __forceinline__ void dg_p3(const Params& p) {
    DG_IDS(); unsigned char* ws = p.ws; unsigned char* dob = (unsigned char*)p.out; float e5 = 0.f, e6 = 0.f;
    for (int s = gt; s < 131072; s += NGT) {
        const unsigned hsh = dhash(s * 17 + 9); const int seq = hsh & 127, pp = (hsh >> 7) % TP; const int b = seq >> 3, h = seq & 7;
        const float* kb = (const float*)(ws + WS_KB) + (size_t)seq * TP; const float lf = ((const float*)(ws + WS_LF))[((size_t)b * TP + pp) * 8 + h];
        if (pp < 48) e5 = fmaxf(e5, kb[pp] < -1e29f ? 0.f : 1.f);
        else if (pp == 48) e5 = fmaxf(e5, fabsf(kb[pp] + lf * LOG2E));
        else e5 = fmaxf(e5, fabsf((kb[pp] - kb[pp - 1]) + lf * LOG2E));
        const int m = dhash(hsh) % R, c = dhash(hsh + 1) % 1536;
        const bf16* la = (const bf16*)(ws + WS_LA) + (size_t)m * 128; const bf16* lg = (const bf16*)(ws + WS_LG) + (size_t)m * 256;
        if (c < 512) { float a = p.in[I_W0][c]; for (int k = 0; k < 64; ++k) a += bf2f(la[k]) * rbf(p.in[I_WUP][k * 512 + c]);
            const float w = -log1pf(expf(-a)) - 0.5f; const float want = 1.0f - expf(-expf(w));
            e6 = fmaxf(e6, relerr(bf2f(((const bf16*)(dob + DO_XW))[(size_t)m * 512 + c]), want, 0.002f)); }
        else if (c < 1024) { float a = p.in[I_A0][c - 512]; for (int k = 0; k < 64; ++k) a += bf2f(la[64 + k]) * rbf(p.in[I_AUP][k * 512 + (c - 512)]);
            e6 = fmaxf(e6, relerr(bf2f(((const bf16*)(dob + DO_AA))[(size_t)m * 512 + (c - 512)]), 1.0f / (1.0f + expf(-a)), 0.05f)); }
        else { float a = 0.f; for (int k = 0; k < 160; ++k) a += bf2f(lg[k]) * rbf(p.in[I_GUP][k * 512 + (c - 1024)]);
            e6 = fmaxf(e6, relerr(bf2f(((const bf16*)(dob + DO_GG))[(size_t)m * 512 + (c - 1024)]), a, 0.1f)); }
    }
    diag_report(p, 5, e5 / 1e-3f); diag_report(p, 6, e6 / 0.03f);
}
constexpr int DG_NS4 = 2048;
__device__ __forceinline__ void dg_p4_pre(const Params& p) {
    DG_IDS(); unsigned char* dob = (unsigned char*)p.out; float* sv = (float*)(p.ws + WS_DSAVE);
    for (int s = gt; s < DG_NS4 * 64; s += NGT) { const int i = s >> 6, d = s & 63; const unsigned hsh = dhash(i * 19 + 11); const int m = hsh % R, h = (hsh >> 20) & 7;
        sv[s] = bf2f(((const bf16*)(dob + DO_AA))[(size_t)m * 512 + h * 64 + d]); }
}
__device__ __forceinline__ void dg_p4_post(const Params& p) {
    DG_IDS(); unsigned char* ws = p.ws; unsigned char* dob = (unsigned char*)p.out; const float* sv = (const float*)(ws + WS_DSAVE); float e = 0.f;
    for (int i = gwv; i < DG_NS4; i += NGWV) {
        const unsigned hsh = dhash(i * 19 + 11); const int m = hsh % R, h = (hsh >> 20) & 7; const int pp = m % TP; const int c = h * 64 + lane;
        const float a = sv[i * 64 + lane];
        const float r0 = bf2f(((const bf16*)(ws + WS_ZRR))[(size_t)m * 512 + c]), k0 = bf2f(((const bf16*)(ws + WS_ZRK))[(size_t)m * 512 + c]);
        const float r1 = pp > 0 ? bf2f(((const bf16*)(ws + WS_ZRR))[(size_t)(m - 1) * 512 + c]) : 0.f, k1 = pp > 0 ? bf2f(((const bf16*)(ws + WS_ZRK))[(size_t)(m - 1) * 512 + c]) : 0.f;
        const float rs = r0 + p.in[I_MU][c] * (r1 - r0), ks = k0 + p.in[I_MU][512 + c] * (k1 - k0);
        const float kk = ks * p.in[I_KK][c], kp = ks * (1.0f + (a - 1.0f) * p.in[I_KA][c]);
        const float nrm = fmaxf(sqrtf(wave_sum(kk * kk)), 1e-12f); const float kn = kk / nrm, bb = kn * a; const float bs = wave_sum(rs * kp * p.in[I_RK][c]);
        e = fmaxf(e, relerr(bf2f(((const bf16*)(ws + WS_KP))[(size_t)m * 512 + c]), kp, 0.1f));
        e = fmaxf(e, relerr(bf2f(((const bf16*)(ws + WS_KN))[(size_t)m * 512 + c]), kn, 0.02f));
        e = fmaxf(e, relerr(bf2f(((const bf16*)(dob + DO_AA))[(size_t)m * 512 + c]), bb, 0.02f));
        e = fmaxf(e, relerr(((const float*)(ws + WS_BS))[(size_t)m * 8 + h], bs, 0.1f));
    }
    diag_report(p, 7, e / 0.03f);
}
constexpr int DG_NS8 = 1024;
__device__ __forceinline__ void dg_attn_sample(int i, int& b, int& h, int& t) { const unsigned hsh = dhash(i * 23 + 13); b = hsh & 15; h = (hsh >> 4) & 7; t = (hsh >> 8) & 4095; if (i < 8) t = (i & 1) ? 4095 - (i >> 1) : (i >> 1); }
__device__ __forceinline__ void dg_attn_pre(const Params& p) {
    DG_IDS(); float* sv = (float*)(p.ws + WS_DSAVE + 512 * 1024);
    for (int s = gt; s < DG_NS8 * 64; s += NGT) { const int i = s >> 6, d = s & 63; int b, h, t; dg_attn_sample(i, b, h, t);
        sv[s] = bf2f(((const bf16*)(p.ws + WS_FQ))[((size_t)b * TP + 64 + t) * 512 + h * 64 + d]); }
}
__device__ __forceinline__ void dg_attn_post(const Params& p) {
    DG_IDS(); unsigned char* ws = p.ws; const float* sv = (const float*)(ws + WS_DSAVE + 512 * 1024); float e = 0.f;
    for (int i = gwv; i < DG_NS8; i += NGWV) {
        int b, h, t; dg_attn_sample(i, b, h, t);
        const int npos = 64 + t;
        const float* kb = (const float*)(ws + WS_KB) + (size_t)(b * 8 + h) * TP;
        const bf16* K = (const bf16*)(ws + WS_FK) + (size_t)b * TP * 512 + h * 64; const bf16* V = (const bf16*)(ws + WS_FV) + (size_t)b * TP * 512 + h * 64;
        float mx = -1e38f;
        for (int j = 48 + lane; j <= npos; j += 64) { float s = 0.f; for (int d = 0; d < 64; ++d) s += sv[i * 64 + d] * bf2f(K[(size_t)j * 512 + d]); s += kb[j]; mx = fmaxf(mx, s); }
        for (int o = 1; o < 64; o <<= 1) mx = fmaxf(mx, __shfl_xor(mx, o));
        float l = 0.f, acc = 0.f;
        for (int j = 48; j <= npos; ++j) { float s = 0.f; for (int d = 0; d < 64; ++d) s += sv[i * 64 + d] * bf2f(K[(size_t)j * 512 + d]); const float pj = exp2f(s + kb[j] - mx); l += pj; acc += pj * bf2f(V[(size_t)j * 512 + lane]); }
        const float want = acc / l; const float got = bf2f(((const bf16*)(ws + WS_FQ))[((size_t)b * TP + 64 + t) * 512 + h * 64 + lane]);
        e = fmaxf(e, fabsf(got - want) / (fabsf(want) + 0.05f));
    }
    diag_report(p, 8, e / 0.05f);
}
__device__ __forceinline__ void dg_scan(const Params& p) {
    DG_IDS(); unsigned char* ws = p.ws; unsigned char* dob = (unsigned char*)p.out; float e = 0.f;
    if (gwv < 4) {
        const int bh = (gwv * 37 + 5) & 127, b = bh >> 3, h = bh & 7; const size_t rowb = (size_t)b * TP; const int cb = h * 64;
        float S[64];
#pragma unroll
        for (int k = 0; k < 64; ++k) S[k] = 0.f;
        const bf16* aXW = (const bf16*)(dob + DO_XW); const bf16* aKN = (const bf16*)(ws + WS_KN); const bf16* aBB = (const bf16*)(dob + DO_AA); const bf16* aKP = (const bf16*)(ws + WS_KP);
        const bf16* aR = (const bf16*)(ws + WS_ZRR); const bf16* aV = (const bf16*)(ws + WS_ZRV);
        const float muv = p.in[I_MU][1024 + cb + lane];
        for (int pp = 48; pp < TP; ++pp) {
            const size_t ro = (rowb + pp) * 512 + cb;
            const float v0 = bf2f(aV[ro + lane]), v1 = bf2f(aV[ro - 512 + lane]); const float vv = v0 + muv * (v1 - v0);
            float sa = 0.f;
#pragma unroll
            for (int k = 0; k < 64; ++k) sa += S[k] * bf2f(aKN[ro + k]);
            sa = -sa; float y = 0.f;
#pragma unroll
            for (int k = 0; k < 64; ++k) { const float dec = 1.0f - bf2f(aXW[ro + k]); S[k] = S[k] * dec + sa * bf2f(aBB[ro + k]) + vv * bf2f(aKP[ro + k]);
                const float r0 = bf2f(aR[ro + k]), r1 = bf2f(aR[ro - 512 + k]); y += S[k] * (r0 + p.in[I_MU][cb + k] * (r1 - r0)); }
            const float got = bf2f(((const bf16*)(ws + WS_Y))[ro + lane]);
            e = fmaxf(e, fabsf(got - y) / (fabsf(y) + 0.3f));
        }
    }
    diag_report(p, 9, e / 0.05f);
}
__device__ __forceinline__ void dg_p6_pre(const Params& p) {
    DG_IDS(); float* sv = (float*)(p.ws + WS_DSAVE + 768 * 1024);
    for (int s = gt; s < DG_NS4 * 64; s += NGT) { const int i = s >> 6, d = s & 63; const unsigned hsh = dhash(i * 29 + 17); const int m = hsh % R, h = (hsh >> 20) & 7;
        sv[s] = bf2f(((const bf16*)(p.ws + WS_Y))[(size_t)m * 512 + h * 64 + d]); }
}
__device__ __forceinline__ void dg_p6_post(const Params& p) {
    DG_IDS(); unsigned char* ws = p.ws; unsigned char* dob = (unsigned char*)p.out; const float* sv = (const float*)(ws + WS_DSAVE + 768 * 1024); float e = 0.f;
    for (int i = gwv; i < DG_NS4; i += NGWV) {
        const unsigned hsh = dhash(i * 29 + 17); const int m = hsh % R, h = (hsh >> 20) & 7; const int pp = m % TP; const int c = h * 64 + lane;
        if (pp < 48) continue;
        const float y = sv[i * 64 + lane]; const float mean = wave_sum(y) / 64.f; const float var = wave_sum((y - mean) * (y - mean)) / 64.f;
        const float gn = (y - mean) / sqrtf(var + GN_EPS) * p.in[I_LNG][c] + p.in[I_LNB][c];
        const float v0 = bf2f(((const bf16*)(ws + WS_ZRV))[(size_t)m * 512 + c]), v1 = bf2f(((const bf16*)(ws + WS_ZRV))[(size_t)(m - 1) * 512 + c]);
        const float vs = v0 + p.in[I_MU][1024 + c] * (v1 - v0);
        const float want = (gn + ((const float*)(ws + WS_BS))[(size_t)m * 8 + h] * vs) * bf2f(((const bf16*)(dob + DO_GG))[(size_t)m * 512 + c]);
        e = fmaxf(e, relerr(bf2f(((const bf16*)(ws + WS_Y))[(size_t)m * 512 + c]), want, 0.1f));
    }
    diag_report(p, 10, e / 0.03f);
}
__device__ __forceinline__ void dg_mix(const Params& p, int stage) {
    DG_IDS(); unsigned char* ws = p.ws; float e = 0.f;
    for (int s = gt; s < 131072; s += NGT) {
        const unsigned hsh = dhash(s * 31 + 19 + stage); const int row = hsh % R, c = dhash(hsh) & 1023;
        float want = dg_dot((const bf16*)(ws + WS_FQ), row, (const bf16*)(ws + WS_WTFOX), c, 512) * bf2f(((const bf16*)(ws + WS_ZG))[(size_t)row * 2048 + c]);
        if (stage == 12) want = rbf(want) + dg_dot((const bf16*)(ws + WS_Y), row, (const bf16*)(ws + WS_WTRWKV), c, 512) * bf2f(((const bf16*)(ws + WS_ZG))[(size_t)row * 2048 + 1024 + c]);
        e = fmaxf(e, relerr(bf2f(((const bf16*)(ws + WS_MIX))[(size_t)row * 1024 + c]), want, 0.1f));
    }
    diag_report(p, stage, e / 0.03f);
}
__device__ __forceinline__ void dg_out(const Params& p) {
    DG_IDS(); unsigned char* ws = p.ws; float e = 0.f;
    for (int s = gt; s < 131072; s += NGT) {
        const unsigned hsh = dhash(s * 37 + 23); const int tok = hsh & 65535, c = dhash(hsh) & 1023; const int b = tok >> 12, t = tok & 4095;
        const float want = p.in[I_X][(size_t)tok * 1024 + c] + dg_dot((const bf16*)(ws + WS_MIX), (size_t)b * TP + 64 + t, (const bf16*)(ws + WS_WTOUT), c, 1024);
        e = fmaxf(e, relerr(p.out[(size_t)tok * 1024 + c], want, 0.3f));
    }
    diag_report(p, 13, e / 0.01f);
}
__device__ __forceinline__ void dg_norm2(const Params& p) {
    DG_IDS(); unsigned char* ws = p.ws; float e = 0.f;
    for (int s = gwv; s < 4096; s += NGWV) {
        const int m = dhash(s * 41 + 29) & 65535; const float* xr = p.out + (size_t)m * 1024;
        float ss = 0.f; for (int c = lane; c < 1024; c += 64) ss += xr[c] * xr[c];
        ss = wave_sum(ss); const float rs = 1.0f / sqrtf(ss / 1024.f + NORM_EPS);
        for (int c = lane; c < 1024; c += 64) e = fmaxf(e, relerr(bf2f(((const bf16*)(ws + WS_XN2))[(size_t)m * 1024 + c]), xr[c] * rs * p.in[I_N2G][c], 0.05f));
    }
    diag_report(p, 14, e / 0.03f);
}
__device__ __forceinline__ void dg_pq(const Params& p) {
    DG_IDS(); unsigned char* ws = p.ws; float e = 0.f;
    for (int s = gt; s < 131072; s += NGT) {
        const unsigned hsh = dhash(s * 43 + 31); const int tok = hsh & 65535, c = dhash(hsh) & 2047;
        const float want = dg_dot((const bf16*)(ws + WS_XN2), tok, (const bf16*)(ws + WS_WTQ), c, 1024);
        e = fmaxf(e, relerr(bf2f(((const bf16*)(ws + WS_PQ))[(size_t)tok * 2048 + c]), want, 0.25f));
    }
    diag_report(p, 15, e / 0.02f);
}
__device__ __forceinline__ void dg_route(const Params& p, LAS unsigned char* lds) {
    DG_IDS(); unsigned char* ws = p.ws; float e16 = 0.f, e17 = 0.f;
    LAS float* s2l = (LAS float*)lds + (tid >> 6) * 128;
    for (int i = gwv; i < 2048; i += NGWV) {
        const unsigned hsh = dhash(i * 47 + 37); const int tok = hsh & 65535, h = (hsh >> 16) & 7;
        const bf16* q = (const bf16*)(ws + WS_PQ) + (size_t)tok * 2048 + h * 256; const bf16* ks = (const bf16*)(ws + WS_KS);
        float s1a = 0.f, s1b = 0.f, s2a = 0.f, s2b = 0.f;
        for (int d = 0; d < 128; ++d) { const float q1 = bf2f(q[d]), q2 = bf2f(q[128 + d]);
            s1a += q1 * bf2f(ks[(size_t)lane * 128 + d]); s1b += q1 * bf2f(ks[(size_t)(lane + 64) * 128 + d]);
            s2a += q2 * bf2f(ks[(size_t)(128 + lane) * 128 + d]); s2b += q2 * bf2f(ks[(size_t)(192 + lane) * 128 + d]); }
        s2l[lane] = s2a; s2l[lane + 64] = s2b; asm volatile("s_waitcnt lgkmcnt(0)" ::: "memory");
        float prev_s = 3e38f; int prev_id = -1; float top_s[16]; int top_id[16];
#pragma unroll 1
        for (int r = 0; r < 16; ++r) {
            float bs = -3e38f; int bi = 0x7fffffff;
            for (int j = 0; j < 128; ++j) { const float t2 = s2l[j];
                { const float sm = s1a + t2; const int id = lane * 128 + j; const bool ok = (sm < prev_s) || (sm == prev_s && id > prev_id); if (ok && (sm > bs || (sm == bs && id < bi))) { bs = sm; bi = id; } }
                { const float sm = s1b + t2; const int id = (lane + 64) * 128 + j; const bool ok = (sm < prev_s) || (sm == prev_s && id > prev_id); if (ok && (sm > bs || (sm == bs && id < bi))) { bs = sm; bi = id; } } }
            for (int o = 1; o < 64; o <<= 1) { const float os = __shfl_xor(bs, o); const int oi = __shfl_xor(bi, o); if (os > bs || (os == bs && oi < bi)) { bs = os; bi = oi; } }
            top_s[r] = bs; top_id[r] = bi; prev_s = bs; prev_id = bi;
        }
        const int* ids = (const int*)(ws + WS_IDS) + (size_t)tok * 128 + h * 16; const float* gts = (const float*)(ws + WS_GATES) + (size_t)tok * 128 + h * 16;
        float den = 0.f;
#pragma unroll
        for (int r = 0; r < 16; ++r) den += expf(top_s[r] - top_s[0]);
        int miss = 0;
#pragma unroll
        for (int r = 0; r < 16; ++r) {
            bool found = false; for (int k = 0; k < 16; ++k) found |= (ids[k] == top_id[r]);
            if (!found && top_s[r] > top_s[15] + 2e-3f * fabsf(top_s[15]) + 1e-4f) ++miss;
            e17 = fmaxf(e17, fabsf(gts[r] - expf(top_s[r] - top_s[0]) / den));
        }
        e16 = fmaxf(e16, (float)miss);
        if (lane == 0 && miss) atomicAdd((float*)(ws + WS_DIAG) + 19, (float)miss);
    }
    diag_report(p, 16, e16 / 0.5f); diag_report(p, 17, e17 / 0.01f);
}
constexpr int DG_NS18 = 128;
__device__ __forceinline__ void dg_gather_pre(const Params& p) {
    DG_IDS(); float* sv = (float*)(p.ws + WS_DSAVE + 1280 * 1024);
    for (int s = gt; s < DG_NS18 * 1024; s += NGT) { const int i = s >> 10, c = s & 1023; const int tok = dhash(i * 53 + 41) & 65535; sv[s] = p.out[(size_t)tok * 1024 + c]; }
    for (int s = gt; s < DG_NS18 * 128; s += NGT) { const int i = s >> 7, ex = s & 127; const int tok = dhash(i * 53 + 41) & 65535; sv[DG_NS18 * 1024 + s] = ((const float*)(p.ws + WS_GATES))[(size_t)tok * 128 + ex]; }
}
__device__ __forceinline__ void dg_gather_post(const Params& p) {
    DG_IDS(); unsigned char* ws = p.ws; const float* sv = (const float*)(ws + WS_DSAVE + 1280 * 1024); float e = 0.f;
    for (int i = gwv; i < DG_NS18; i += NGWV) {
        const int tok = dhash(i * 53 + 41) & 65535;
        const int* ids = (const int*)(ws + WS_IDS) + (size_t)tok * 128; const float* gts = (const float*)(ws + WS_GATES) + (size_t)tok * 128;
        const bf16* xn = (const bf16*)(ws + WS_XN2) + (size_t)tok * 1024;
        float o[16];
#pragma unroll
        for (int k = 0; k < 16; ++k) o[k] = 0.f;
        for (int ex = 0; ex < 128; ++ex) {
            const int id = ids[ex]; const bf16* ur = (const bf16*)(ws + WS_U16) + (size_t)id * 1024; const bf16* vr = (const bf16*)(ws + WS_V16) + (size_t)id * 1024;
            float d = 0.f;
#pragma unroll
            for (int k = 0; k < 16; ++k) d += bf2f(ur[lane * 16 + k]) * bf2f(xn[lane * 16 + k]);
            d = wave_sum(d); const float w = gts[ex]; (void)d;
            e = fmaxf(e, fabsf(w - sv[DG_NS18 * 1024 + i * 128 + ex] * 0.5f * d * (1.0f + erff(d * 0.70710678f))) / 0.02f * 0.05f);
#pragma unroll
            for (int k = 0; k < 16; ++k) o[k] += w * bf2f(vr[lane * 16 + k]);
        }
        float ss = 0.f;
#pragma unroll
        for (int k = 0; k < 16; ++k) ss += o[k] * o[k];
        const float rms = sqrtf(wave_sum(ss) / 1024.f);
#pragma unroll
        for (int k = 0; k < 16; ++k) e = fmaxf(e, fabsf((p.out[(size_t)tok * 1024 + lane * 16 + k] - sv[i * 1024 + lane * 16 + k]) - o[k]) / (rms + 1e-3f));
    }
    diag_report(p, 18, e / 0.05f);
}
__device__ __forceinline__ void dg_final(const Params& p) {
    DG_IDS(); const float* dg = (const float*)(p.ws + WS_DIAG);
    int k = 0;
    for (int s = 1; s <= 18; ++s) if (k == 0 && !(dg[s] <= 1.0f)) k = s;
#ifdef DIAG_SKIP
    { int kk = 0; for (int s = 1; s <= 18; ++s) if (kk == 0 && s > DIAG_SKIP && !(dg[s] <= 1.0f)) kk = s; k = kk; }
#endif
#ifdef DIAG_VALUE
    const float a = fminf(fmaxf(dg[DIAG_VALUE], 1e-3f), 1e6f) * 16.f;
#else
    const float a = exp2f((float)k);
#endif
    for (size_t i = gt; i < (size_t)NTOK * 1024 / 4; i += NGT) ((f32x4*)p.out)[i] = (f32x4){a, a, a, a};
}
#endif
#ifndef TIMING
#define TIMING 0
#endif
#if TIMING
#define TS(i) do { int t__ = threadIdx.x; asm volatile("" : "+v"(t__)); if (bid == 0 && t__ == 0) ((unsigned long long*)(ws + 1010 * MiB))[i] = __builtin_amdgcn_s_memrealtime(); } while (0)
#else
#define TS(i)
#endif
#if DIAG
#define DG(...) __VA_ARGS__
#else
#define DG(...)
#endif
constexpr int LDS_BYTES = 147456;
static_assert(attn_body::ATTN_LDS_BYTES <= 131072, "attention LDS");
static_assert(RT_KS_BYTES + NTHREADS * RT_TAB_WORDS * 4 <= LDS_BYTES, "routing LDS");
static_assert((SC_CH * SC_STRIDE + SC_CH * 32) * 4 <= LDS_BYTES, "scan LDS");

__global__ void __launch_bounds__(NTHREADS, 2) hybrid_fwd(Params p) {
    extern __shared__ __attribute__((aligned(16))) unsigned char lds_raw[];
    cg::grid_group grid = cg::this_grid();
    LAS unsigned char* lds = (LAS unsigned char*)lds_raw;
    const int G0 = gridDim.x, bid = blockIdx.x;
#define LANE_IDS() int tid = threadIdx.x; asm volatile("" : "+v"(tid)); const int lane = tid & 63, wave = __builtin_amdgcn_readfirstlane(tid >> 6); (void)lane; (void)wave; int G = G0; asm volatile("" : "+s"(G))
    const int vcu = (G0 % 8 == 0) ? (bid % 8) * (G0 / 8) + bid / 8 : bid;
    unsigned char* ws = p.ws; unsigned char* dob = (unsigned char*)p.out;

    DG({ int t_ = threadIdx.x; asm volatile("" : "+v"(t_)); if (bid == 0 && t_ < 64) ((float*)(ws + WS_DIAG))[t_] = 0.f; })
    TS(0);
    { LANE_IDS(); p0_prologue(p, lds, vcu, G, wave, lane); }
    grid.sync();
    DG(dg_p0(p);)
    TS(1);
    run_gemm(lds, (const bf16*)(ws + WS_XN), (const bf16*)(ws + WS_WTIN), R, N1, 1024, G0, bid, F_Gemm1{(bf16*)(ws + WS_F), (bf16*)(ws + WS_ZG)});
    grid.sync();
    DG(dg_gemm1(p); grid.sync();)
    TS(2);
    { LANE_IDS(); p2_prep1(p, vcu, G, wave, lane); }
    grid.sync();
    DG(dg_p2(p);)
    TS(3);
    { LANE_IDS(); const int gwv = vcu * NWAVES + wave; for (int s = gwv; s < 128; s += G * NWAVES) p3_cumsum(p, s, lane); }
    __syncthreads();
    run_gemm(lds, (const bf16*)(ws + WS_LA), (const bf16*)(ws + WS_WTWA), R, 512, 128, G0, bid, F_LoraW{(bf16*)(dob + DO_XW), p.in[I_W0]});
    run_gemm(lds, (const bf16*)(ws + WS_LA), (const bf16*)(ws + WS_WTWA) + 512 * 128, R, 512, 128, G0, bid, F_LoraA{(bf16*)(dob + DO_AA), p.in[I_A0]});
    run_gemm(lds, (const bf16*)(ws + WS_LG), (const bf16*)(ws + WS_WTG), R, 512, 256, G0, bid, F_Plain{(bf16*)(dob + DO_GG), 512});
    grid.sync();
    DG(dg_p3(p); dg_p4_pre(p); grid.sync();)
    TS(4);
    { LANE_IDS(); p4_prep2(p, vcu, G, wave, lane); }
    grid.sync();
    DG(dg_p4_post(p); dg_attn_pre(p); grid.sync();)
    TS(5);
    {
        LANE_IDS();
        const int per = (1024 + G - 1) / G;
        int last_bh = -1;
        for (int pi = vcu * per; pi < (vcu + 1) * per && pi < 1024; ++pi) {
            const int bh = pi >> 3, pr = pi & 7;
            if (bh != last_bh) {
                __syncthreads();
                const float* kbg = (const float*)(ws + WS_KB) + (size_t)bh * TP; LAS float* kbl = (LAS float*)(lds + attn_body::LDS_KB);
                for (int i = tid; i < TP; i += NTHREADS) kbl[i] = kbg[i];
                asm volatile("s_waitcnt vmcnt(0) lgkmcnt(0)" ::: "memory");
                __syncthreads();
                last_bh = bh;
            }
#pragma unroll 1
            for (int k = 0; k < 2; ++k) {
                const int qb = k ? 15 - pr : pr;
                attn_body::attn_unit<8>(bh >> 3, bh & 7, qb, (const attn_body::bf16*)(ws + WS_FQ), (const attn_body::bf16*)(ws + WS_FK), (const attn_body::bf16*)(ws + WS_FV), (attn_body::bf16*)(ws + WS_FQ), (char*)lds_raw);
            }
        }
        __syncthreads(); TS(6);
        { int tid2 = threadIdx.x; asm volatile("" : "+v"(tid2)); for (int item = vcu; item < 256; item += G0) p5_scan_item(p, lds, item, tid2, __builtin_amdgcn_readfirstlane(tid2 >> 6), tid2 & 63); }
    }
    grid.sync();
    DG(dg_attn_post(p); dg_scan(p); dg_p6_pre(p); grid.sync();)
    TS(7);
    { LANE_IDS(); p6_prep3(p, vcu, G, wave, lane); }
    grid.sync();
    DG(dg_p6_post(p);)
    TS(8);
    run_gemm(lds, (const bf16*)(ws + WS_FQ), (const bf16*)(ws + WS_WTFOX), R, 1024, 512, G0, bid, F_MixA{(bf16*)(ws + WS_MIX), (const bf16*)(ws + WS_ZG)});
    grid.sync();
    TS(9);
    DG(dg_mix(p, 11); grid.sync();)
    run_gemm(lds, (const bf16*)(ws + WS_Y), (const bf16*)(ws + WS_WTRWKV), R, 1024, 512, G0, bid, F_MixB{(bf16*)(ws + WS_MIX), (const bf16*)(ws + WS_ZG)});
    grid.sync();
    DG(dg_mix(p, 12);)
    TS(10);
    run_gemm(lds, (const bf16*)(ws + WS_MIX), (const bf16*)(ws + WS_WTOUT), R, 1024, 1024, G0, bid, F_Out{p.in[I_X], p.out});
    grid.sync();
    TS(11);
    DG(dg_out(p); grid.sync();)
    { LANE_IDS(); p9_norm2(p, vcu, G, wave, lane); }
    grid.sync();
    DG(dg_norm2(p);)
    TS(12);
    run_gemm(lds, (const bf16*)(ws + WS_XN2), (const bf16*)(ws + WS_WTQ), NTOK, 2048, 1024, G0, bid, F_Plain{(bf16*)(ws + WS_PQ), 2048});
    grid.sync();
    TS(13);
    DG(dg_pq(p);)
    { LANE_IDS(); p11_route(p, lds, vcu, G, tid, wave, lane); }
    grid.sync();
    TS(14);
    DG(__syncthreads(); dg_route(p, lds); dg_gather_pre(p); grid.sync();)
    { LANE_IDS(); p12a_partial(p, bid, G, wave, lane); }
    grid.sync();
    { LANE_IDS(); p12b_combine(p, vcu, G, wave, lane); }
    grid.sync();
    { LANE_IDS(); p12c_output(p, bid, G, wave, lane); }
    DG(grid.sync(); dg_gather_post(p); grid.sync(); dg_final(p);)
#if TIMING
    grid.sync(); TS(15); grid.sync();
    {
        const unsigned long long* ts = (const unsigned long long*)(ws + 1010 * MiB);
        const float tot = (float)(ts[15] - ts[0]);
        const float fa = 10.f * (float)(ts[TIMING_A1] - ts[TIMING_A0]) / tot;
        int t__ = threadIdx.x; asm volatile("" : "+v"(t__));
        for (size_t i = (size_t)bid * NTHREADS + t__; i < (size_t)NTOK * 1024; i += (size_t)G0 * NTHREADS) p.out[i] = fa;
    }
#endif
}

extern "C" void kernel_launch(void* const* d_in, const int* in_sizes, int n_in, void* d_out, int out_size, void* d_ws, size_t ws_size, hipStream_t stream) {
    static int grid = 0;
    if (grid == 0) {
        if (n_in != 27 || out_size != NTOK * DMODEL || ws_size < WS_END) { fprintf(stderr, "kernel_launch: unexpected shapes (n_in %d, out %d, ws %zu)\n", n_in, out_size, ws_size); grid = -1; return; }
        int dev = 0, cus = 0, per_cu = 0;
        hipGetDevice(&dev);
        hipDeviceGetAttribute(&cus, hipDeviceAttributeMultiprocessorCount, dev);
        hipFuncSetAttribute((const void*)hybrid_fwd, hipFuncAttributeMaxDynamicSharedMemorySize, LDS_BYTES);
        hipOccupancyMaxActiveBlocksPerMultiprocessor(&per_cu, (const void*)hybrid_fwd, NTHREADS, LDS_BYTES);
        if (per_cu < 1) { fprintf(stderr, "kernel_launch: occupancy query says %d blocks per CU\n", per_cu); grid = -1; return; }
        grid = cus;
    }
    if (grid < 0) return;
    Params p{};
    for (int i = 0; i < 27; ++i) p.in[i] = (const float*)d_in[i];
    p.out = (float*)d_out; p.ws = (unsigned char*)d_ws;
    void* args[] = {&p};
    hipError_t e = hipLaunchCooperativeKernel((const void*)hybrid_fwd, dim3(grid), dim3(NTHREADS), args, LDS_BYTES, stream);
    if (e != hipSuccess) fprintf(stderr, "cooperative launch failed: %s (grid %d)\n", hipGetErrorString(e), grid);
}
```

```cpp
#include <hip/hip_runtime.h>
#include <hip/hip_cooperative_groups.h>
#include <hip/hip_bf16.h>
#include <cstdio>
#include <cstdint>
#include <cmath>
namespace cg = cooperative_groups;
#ifndef DIAG
#define DIAG 0
#endif
namespace pg8 {
#define PG8_LAS __attribute__((address_space(3)))
typedef unsigned short bf16_t;
typedef short bf16x8 __attribute__((ext_vector_type(8)));
typedef float f32x4 __attribute__((ext_vector_type(4)));
typedef unsigned u32x4 __attribute__((ext_vector_type(4)));
constexpr int BM = 256, BK = 64, HALF = 128, HTB = HALF * BK * 2  , STAGE_BYTES = 8 * HTB, NXCD = 8, WGM = 8;

__host__ __device__ __forceinline__ int lds_byte(int r, int c) { const int st = (r >> 4) * 2 + (c >> 5), rr = r & 15, cc = c & 31, ob = rr * 64 + cc * 2; return st * 1024 + (ob ^ (((ob >> 9) & 1) << 5)); }
__host__ __device__ __forceinline__ void stage_rc(int b, int& R, int& C) { const int st = b / 1024, sb = b % 1024, swz = sb ^ (((sb >> 9) & 1) << 5); R = (st >> 1) * 16 + swz / 64; C = (st & 1) * 32 + (swz % 64) / 2; }
__host__ __device__ __forceinline__ int perm32(int rho) { const int n = rho >> 4, i = rho & 15; return 8 * (i >> 2) + 4 * n + (i & 3); }

struct Unit { int pm, pn; };
struct Gemm { const bf16_t* A; const bf16_t* Bt; int M, N, K; };

struct StaticOrder {
    int nM, nN, nwg, G, c;
    __host__ __device__ void init(int M, int N, int G_, int c_) { nM = M / BM; nN = N / BM; nwg = nM * nN; G = G_; c = c_; }
    __host__ __device__ bool next(int i, Unit& u) const {
        const int L = i * G + c; if (L >= nwg) return false;
        int wgid = (int)L; { const int q = nwg / NXCD, r = nwg % NXCD, xcd = wgid % NXCD, off = wgid / NXCD; wgid = (xcd < r ? xcd * (q + 1) : r * (q + 1) + (xcd - r) * q) + off; }
        const int nig = WGM * nN, gid = wgid / nig, fm = gid * WGM, gsz = (nM - fm) < WGM ? (nM - fm) : WGM;
        u.pm = fm + ((wgid % nig) % gsz); u.pn = (wgid % nig) / gsz; return true;
    }
    __device__ __forceinline__ void a_ready(const Unit&) const {}
    __device__ __forceinline__ void done(const Unit&) const {}
};

__device__ __forceinline__ unsigned cvt_pk_bf16(float lo, float hi) { unsigned r; asm volatile("v_cvt_pk_bf16_f32 %0, %1, %2" : "=v"(r) : "v"(lo), "v"(hi)); return r; }
typedef float f32x2 __attribute__((ext_vector_type(2)));
template <class Epi, class Sched, bool ALIGN_EPI = false, bool SP2 = false>
__device__ __forceinline__ void gemm_phase(PG8_LAS unsigned char* lds, const Gemm g, const Sched& S, const Epi& E) {
    int tid_ = threadIdx.x; asm volatile("" : "+v"(tid_));
    const int tid = tid_, wid = __builtin_amdgcn_readfirstlane(tid >> 6), lane = tid & 63, wr = wid >> 2, wc = wid & 3, fr = lane & 15, fq = lane >> 4;
    const int K = g.K, nt = K / BK;
    unsigned voffA[2], voffB[2];
#pragma unroll
    for (int i = 0; i < 2; ++i) { int R, C; stage_rc(tid * 16 + i * 8192, R, C); const int Rb = Epi::PERM ? ((R & ~31) + perm32(R & 31)) : R;
        voffA[i] = (unsigned)(R * K + C) * 2u; voffB[i] = (unsigned)(Rb * K + C) * 2u; }
    const size_t kstep = (size_t)(BK * 2);
    const size_t hstep = (size_t)HALF * K * 2;
    const size_t tstep = 2 * hstep;
    const unsigned ldsw = (unsigned)wid * 1024u;
    const int aoff = lds_byte(wr * 64 + fr, fq * 8), boff = lds_byte(wc * 32 + fr, fq * 8);
#define PG8_SA(b, h) (((b) * 2 + (h)) * HTB)
#define PG8_SB(b, h) ((4 + (b) * 2 + (h)) * HTB)
#define PG8_STAGE(bufoff, gbase, voff) do { _Pragma("unroll") for (int _i = 0; _i < 2; ++_i) \
        __builtin_amdgcn_global_load_lds((const unsigned*)((const char*)(gbase) + (voff)[_i]), (PG8_LAS unsigned*)(lds + (bufoff) + ldsw + _i * 8192), 16, 0, 0); } while (0)
#define PG8_LDA(dst, b, h) do { _Pragma("unroll") for (int m = 0; m < 4; ++m) _Pragma("unroll") for (int k = 0; k < 2; ++k) dst[m][k] = *(const PG8_LAS bf16x8*)(lds + PG8_SA(b, h) + aoff + m * 2048 + k * 1024); } while (0)
#define PG8_LDB(dst, b, h) do { _Pragma("unroll") for (int n = 0; n < 2; ++n) _Pragma("unroll") for (int k = 0; k < 2; ++k) dst[n][k] = *(const PG8_LAS bf16x8*)(lds + PG8_SB(b, h) + boff + n * 2048 + k * 1024); } while (0)
#define PG8_MMA(ai, bj, At, Bt) do { __builtin_amdgcn_s_setprio(1); _Pragma("unroll") for (int m = 0; m < 4; ++m) _Pragma("unroll") for (int n = 0; n < 2; ++n) _Pragma("unroll") for (int k = 0; k < 2; ++k) \
        acc[ai][bj][m][n] = __builtin_amdgcn_mfma_f32_16x16x32_bf16(Bt[n][k], At[m][k], acc[ai][bj][m][n], 0, 0, 0); __builtin_amdgcn_s_setprio(0); } while (0)
#define PG8_WAIT_V(n) asm volatile("s_waitcnt vmcnt(" #n ")" ::: "memory")
#define PG8_WAIT_L(n) asm volatile("s_waitcnt lgkmcnt(" #n ")" ::: "memory")
#define PG8_BAR __builtin_amdgcn_s_barrier()
#define PG8_SCHED __builtin_amdgcn_sched_barrier(0)
    Unit cur, nxt; int ui = 0;
    if (!S.next(0, cur)) return;
    f32x4 acc[2][2][4][2];
#pragma unroll
    for (int a = 0; a < 2; ++a)
#pragma unroll
        for (int b = 0; b < 2; ++b)
#pragma unroll
            for (int m = 0; m < 4; ++m)
#pragma unroll
                for (int n = 0; n < 2; ++n) acc[a][b][m][n] = (f32x4){0.f, 0.f, 0.f, 0.f};
    bf16x8 At[4][2], B0[2][2], B1[2][2];
    const char* cA = (const char*)g.A + (size_t)cur.pm * tstep; const char* cB = (const char*)g.Bt + (size_t)cur.pn * tstep;
    S.a_ready(cur);
    if constexpr (SP2) {
        PG8_STAGE(PG8_SB(0, 0), cB, voffB); PG8_STAGE(PG8_SB(0, 1), cB + hstep, voffB); PG8_STAGE(PG8_SA(0, 0), cA, voffA); PG8_STAGE(PG8_SA(0, 1), cA + hstep, voffA);
        if (wr == 1) PG8_BAR;
        PG8_WAIT_V(2); PG8_BAR;
        PG8_STAGE(PG8_SB(1, 0), cB + kstep, voffB); PG8_STAGE(PG8_SA(1, 0), cA + kstep, voffA); PG8_STAGE(PG8_SB(1, 1), cB + hstep + kstep, voffB);
        PG8_WAIT_V(6); PG8_BAR;
    } else {
        PG8_STAGE(PG8_SB(0, 0), cB, voffB); PG8_STAGE(PG8_SA(0, 0), cA, voffA); PG8_STAGE(PG8_SB(0, 1), cB + hstep, voffB); PG8_STAGE(PG8_SA(0, 1), cA + hstep, voffA);
        if (wr == 1) PG8_BAR;
        PG8_WAIT_V(4); PG8_BAR;
        PG8_STAGE(PG8_SB(1, 0), cB + kstep, voffB); PG8_STAGE(PG8_SA(1, 0), cA + kstep, voffA); PG8_STAGE(PG8_SB(1, 1), cB + hstep + kstep, voffB);
        PG8_WAIT_V(6); PG8_BAR;
    }
    for (;;) {
        const bool has_next = S.next(ui + 1, nxt);
        const char* nA = has_next ? (const char*)g.A + (size_t)nxt.pm * tstep : cA; const char* nB = has_next ? (const char*)g.Bt + (size_t)nxt.pn * tstep : cB;
        for (int t = 0; t < nt; t += 2) {
            const bool last = (t == nt - 2);
            const char* a1 = cA + (size_t)(t + 1) * kstep;
            const char* a2 = last ? nA : cA + (size_t)(t + 2) * kstep; const char* b2 = last ? nB : cB + (size_t)(t + 2) * kstep;
            const char* a3 = a2 + kstep; const char* b3 = b2 + kstep;
            if (last && has_next) S.a_ready(nxt);
            if constexpr (SP2) {
            PG8_LDB(B0, 0, 0); PG8_LDB(B1, 0, 1); PG8_SCHED; PG8_LDA(At, 0, 0); PG8_STAGE(PG8_SA(1, 1), a1 + hstep, voffA);
            PG8_WAIT_V(8); PG8_WAIT_L(0); PG8_BAR; PG8_MMA(0, 0, At, B0); PG8_MMA(0, 1, At, B1); PG8_BAR; PG8_SCHED;
            PG8_LDA(At, 0, 1); PG8_STAGE(PG8_SB(0, 0), b2, voffB); PG8_STAGE(PG8_SB(0, 1), b2 + hstep, voffB); PG8_STAGE(PG8_SA(0, 0), a2, voffA);
            PG8_WAIT_V(8); PG8_WAIT_L(0); PG8_BAR; PG8_MMA(1, 0, At, B0); PG8_MMA(1, 1, At, B1); PG8_BAR; PG8_SCHED;
            PG8_LDB(B0, 1, 0); PG8_LDB(B1, 1, 1); PG8_SCHED; PG8_LDA(At, 1, 0); PG8_STAGE(PG8_SA(0, 1), a2 + hstep, voffA);
            PG8_WAIT_V(8); PG8_WAIT_L(0); PG8_BAR; PG8_MMA(0, 0, At, B0); PG8_MMA(0, 1, At, B1); PG8_BAR; PG8_SCHED;
            PG8_LDA(At, 1, 1); PG8_STAGE(PG8_SB(1, 0), b3, voffB); PG8_STAGE(PG8_SB(1, 1), b3 + hstep, voffB); PG8_STAGE(PG8_SA(1, 0), a3, voffA);
            PG8_WAIT_V(8); PG8_WAIT_L(0); PG8_BAR; PG8_MMA(1, 0, At, B0); PG8_MMA(1, 1, At, B1); PG8_BAR; PG8_SCHED;
            } else {
            PG8_LDB(B0, 0, 0); PG8_SCHED; PG8_LDA(At, 0, 0); PG8_STAGE(PG8_SA(1, 1), a1 + hstep, voffA);
            PG8_WAIT_L(8); PG8_BAR; PG8_WAIT_L(0); PG8_MMA(0, 0, At, B0); PG8_BAR; PG8_SCHED;
            PG8_LDB(B1, 0, 1); PG8_STAGE(PG8_SB(0, 0), b2, voffB);
            PG8_BAR; PG8_WAIT_L(0); PG8_MMA(0, 1, At, B1); PG8_BAR;
            PG8_LDA(At, 0, 1); PG8_STAGE(PG8_SA(0, 0), a2, voffA);
            PG8_BAR; PG8_WAIT_L(0); PG8_MMA(1, 0, At, B0); PG8_BAR; PG8_SCHED;
            PG8_STAGE(PG8_SB(0, 1), b2 + hstep, voffB);
            PG8_WAIT_V(6); PG8_BAR; PG8_MMA(1, 1, At, B1); PG8_BAR;
            PG8_LDB(B0, 1, 0); PG8_SCHED; PG8_LDA(At, 1, 0); PG8_STAGE(PG8_SA(0, 1), a2 + hstep, voffA);
            PG8_WAIT_L(8); PG8_BAR; PG8_WAIT_L(0); PG8_MMA(0, 0, At, B0); PG8_BAR; PG8_SCHED;
            PG8_LDB(B1, 1, 1); PG8_STAGE(PG8_SB(1, 0), b3, voffB);
            PG8_BAR; PG8_WAIT_L(0); PG8_MMA(0, 1, At, B1); PG8_BAR;
            PG8_LDA(At, 1, 1); PG8_STAGE(PG8_SA(1, 0), a3, voffA);
            PG8_BAR; PG8_WAIT_L(0); PG8_MMA(1, 0, At, B0); PG8_BAR; PG8_SCHED;
            PG8_STAGE(PG8_SB(1, 1), b3 + hstep, voffB);
            PG8_WAIT_V(6); PG8_BAR; PG8_MMA(1, 1, At, B1); PG8_BAR;
            }
        }
        if constexpr (ALIGN_EPI) { if (wr == 0) PG8_BAR; }
        if constexpr (!Epi::AFTER_DRAIN) { E(acc, cur, wr, wc, fr, fq); S.done(cur); }
        if (!has_next) break;
#pragma unroll
        for (int a = 0; a < 2; ++a)
#pragma unroll
            for (int b = 0; b < 2; ++b)
#pragma unroll
                for (int m = 0; m < 4; ++m)
#pragma unroll
                    for (int n = 0; n < 2; ++n) acc[a][b][m][n] = (f32x4){0.f, 0.f, 0.f, 0.f};
        cur = nxt; cA = nA; cB = nB; ++ui;
        if constexpr (ALIGN_EPI) { if (wr == 1) PG8_BAR; }
    }
    PG8_WAIT_V(0);
    if constexpr (!ALIGN_EPI) { if (wr == 0) PG8_BAR; }
    PG8_BAR;
    if constexpr (Epi::AFTER_DRAIN) { E.fused(acc, cur, wr, wc, fr, fq, lds, wid, lane); S.done(cur); }
#undef PG8_SA
#undef PG8_SB
#undef PG8_STAGE
#undef PG8_LDA
#undef PG8_LDB
#undef PG8_MMA
#undef PG8_WAIT_V
#undef PG8_WAIT_L
#undef PG8_BAR
#undef PG8_SCHED
}
}
namespace attn_body {
using bf16=__hip_bfloat16;
using bf16x8=__attribute__((ext_vector_type(8)))short;
using s16x4=__attribute__((ext_vector_type(4)))short;
using f32x16=__attribute__((ext_vector_type(16)))float;
using u32x4=__attribute__((ext_vector_type(4)))unsigned;
using f32x4k=__attribute__((ext_vector_type(4)))float;
constexpr int BATCH=16,NHEAD=8,TPAD=4160,D=64,DM=NHEAD*D;
constexpr int NW=8,QBLK=32,QB=QBLK*NW,KVBLK=64,NQB=16;
constexpr int ATTN_PITCH=DM, ATTN_UNIT_ROWS=QB;
__device__ __forceinline__ int crow(int r,int hi){return (r&3)+8*(r>>2)+4*hi;}
#define SBAR() __builtin_amdgcn_sched_barrier(0)
__device__ __forceinline__ void cmask(f32x16&p0,f32x16&p1,int jb,int qrel,int hi){
  const float NEG=-INFINITY; int kb=64*jb+4*hi;
  #pragma unroll
  for(int r=0;r<16;++r){int kv=kb+(r&3)+8*(r>>2); if(kv>qrel)p0[r]=NEG; if(kv+32>qrel)p1[r]=NEG;}
}

constexpr int NSLOT=3, SLOTB=8192;
constexpr int LDS_K=0, LDS_V=NSLOT*SLOTB, LDS_WS=2*NSLOT*SLOTB, LDS_OST=LDS_WS+NW*64*4, LDS_KB=LDS_OST+NW*4096, LDS_BYTES=LDS_KB+TPAD*4;
constexpr float C2=0.125f*1.4426950408889634f;
__device__ __forceinline__ void glds16(const void*gsrc,unsigned lds_dst){unsigned keep;
  asm volatile("s_mov_b32 %0, m0\n\ts_mov_b32 m0, %2\n\ts_nop 0\n\tglobal_load_lds_dwordx4 %1, off\n\ts_mov_b32 m0, %0":"=&s"(keep):"v"(gsrc),"s"(lds_dst):"memory");}
__device__ __forceinline__ float max3f(float a,float b,float c){float r;asm("v_max3_f32 %0, %1, %2, %3":"=v"(r):"v"(a),"v"(b),"v"(c));return r;}
__device__ __forceinline__ float max2f(float a,float b){float r;asm("v_max_f32_e32 %0, %1, %2":"=v"(r):"v"(a),"v"(b));return r;}
__device__ __forceinline__ float fadd_s(float a,float b){float r;asm("v_add_f32_e32 %0, %1, %2":"=v"(r):"v"(a),"v"(b));return r;}
__device__ __forceinline__ float fsub_s(float a,float b){float r;asm("v_sub_f32_e32 %0, %1, %2":"=v"(r):"v"(a),"v"(b));return r;}
typedef float f32x2_t __attribute__((ext_vector_type(2))); typedef __bf16 bf16x2_t __attribute__((ext_vector_type(2)));
__device__ __forceinline__ unsigned cvtpk_s(float lo,float hi){f32x2_t v={lo,hi};bf16x2_t b=__builtin_convertvector(v,bf16x2_t);return __builtin_bit_cast(unsigned,b);}
#define WAIT_BAR(N) asm volatile("s_waitcnt vmcnt(" #N ") lgkmcnt(0)\n\ts_barrier":::"memory")

__device__ __forceinline__ void qkt(f32x16&p0,f32x16&p1,const char*Kslot,const bf16x8*qr,int r32,int hi){
  const char*kb=Kslot+hi*1024+r32*16;
  #pragma unroll
  for(int d0=0;d0<4;++d0){
    const bf16x8 b0=*reinterpret_cast<const bf16x8*>(kb+d0*2048);
    const bf16x8 b1=*reinterpret_cast<const bf16x8*>(kb+d0*2048+512);
    {p0=__builtin_amdgcn_mfma_f32_32x32x16_bf16(b0,qr[d0],p0,0,0,0);p1=__builtin_amdgcn_mfma_f32_32x32x16_bf16(b1,qr[d0],p1,0,0,0);}}
}
typedef __attribute__((address_space(3))) const char* lds_cptr;
typedef short v4i16_t __attribute__((ext_vector_type(4)));
__device__ __forceinline__ void kload8(bf16x8*kf,lds_cptr kp){
  kf[0]=*(const __attribute__((address_space(3))) bf16x8*)(kp);      kf[1]=*(const __attribute__((address_space(3))) bf16x8*)(kp+512);
  kf[2]=*(const __attribute__((address_space(3))) bf16x8*)(kp+2048); kf[3]=*(const __attribute__((address_space(3))) bf16x8*)(kp+2560);
  kf[4]=*(const __attribute__((address_space(3))) bf16x8*)(kp+4096); kf[5]=*(const __attribute__((address_space(3))) bf16x8*)(kp+4608);
  kf[6]=*(const __attribute__((address_space(3))) bf16x8*)(kp+6144); kf[7]=*(const __attribute__((address_space(3))) bf16x8*)(kp+6656);
}
__device__ __forceinline__ void kload2(bf16x8*kf,lds_cptr kp,int j){ kf[2*j]=*(const __attribute__((address_space(3))) bf16x8*)(kp+j*2048); kf[2*j+1]=*(const __attribute__((address_space(3))) bf16x8*)(kp+j*2048+512); }
__device__ __forceinline__ s16x4 vtr(lds_cptr p){ return __builtin_bit_cast(s16x4,__builtin_amdgcn_ds_read_tr16_b64_v4i16((__attribute__((address_space(3))) v4i16_t*)p)); }
__device__ __forceinline__ float rowmax(const f32x16&p0,const f32x16&p1){
  float a=max3f(p0[0],p0[1],p1[0]),b=max3f(p0[2],p0[3],p1[1]);a=max3f(a,p1[2],p1[3]);
  #pragma unroll
  for(int r=4;r<16;r+=4){a=max3f(a,p0[r],p0[r+1]);b=max3f(b,p0[r+2],p0[r+3]);a=max3f(a,p1[r],p1[r+1]);b=max3f(b,p1[r+2],p1[r+3]);}
  const float m=max2f(a,b);
  auto rr=__builtin_amdgcn_permlane32_swap(__float_as_uint(m),__float_as_uint(m),false,false);
  return max2f(__uint_as_float(rr[0]),__uint_as_float(rr[1]));
}
__device__ __forceinline__ void pv(f32x16*o,int vb,bf16x8 pa0,bf16x8 pa1,bf16x8 pa2,bf16x8 pa3){
  #pragma unroll
  for(int d0=0;d0<2;++d0){s16x4 lo[4],hi[4];
    #pragma unroll
    for(int ks=0;ks<4;++ks){
      asm volatile("ds_read_b64_tr_b16 %0,%1 offset:%c2":"=&v"(lo[ks]):"v"(vb),"i"(d0*4096+ks*1024):"memory");
      asm volatile("ds_read_b64_tr_b16 %0,%1 offset:%c2":"=&v"(hi[ks]):"v"(vb),"i"(d0*4096+ks*1024+512):"memory");}
    asm volatile("s_waitcnt lgkmcnt(0)":::"memory");SBAR();
    #define PK(k) (bf16x8){lo[k][0],lo[k][1],lo[k][2],lo[k][3],hi[k][0],hi[k][1],hi[k][2],hi[k][3]}
    o[d0]=__builtin_amdgcn_mfma_f32_32x32x16_bf16(pa0,PK(0),o[d0],0,0,0);
    o[d0]=__builtin_amdgcn_mfma_f32_32x32x16_bf16(pa1,PK(1),o[d0],0,0,0);
    o[d0]=__builtin_amdgcn_mfma_f32_32x32x16_bf16(pa2,PK(2),o[d0],0,0,0);
    o[d0]=__builtin_amdgcn_mfma_f32_32x32x16_bf16(pa3,PK(3),o[d0],0,0,0);
    #undef PK
  }
}

#ifndef ATTN_STORE16
#define ATTN_STORE16(p,v) (*(u32x4*)(p)=(v))
#endif
template<int THRL> __device__ __forceinline__ void attn_unit(int b,int h,int qb,const bf16*Q,const bf16*__restrict__ K,const bf16*__restrict__ V,bf16*O,char*shm){
  int tid_=threadIdx.x; asm volatile("":"+v"(tid_)); const int tid=tid_,lane=tid&63,r32=lane&31,hi=lane>>5; const int wid=__builtin_amdgcn_readfirstlane(tid>>6);
  const long rowbase=(long)b*TPAD; const int q0=64+qb*QB;
  const bf16*Qw=Q+(rowbase+q0+wid*QBLK)*DM+h*D;
  const bf16*Kh=K+rowbase*DM+h*D,*Vh=V+rowbase*DM+h*D;
  const unsigned lds0=(unsigned)(uintptr_t)shm;
  float*wsf=(float*)(shm+LDS_WS)+wid*64;
  const bf16*ksrc=Kh+(long)lane*DM+wid*8;
  const bf16*vsrc=Vh+(long)(16*(wid&3)+(lane>>2))*DM+(wid>>2)*32+(lane&3)*8;
  const unsigned kdst=lds0+LDS_K+wid*1024, vdst=lds0+LDS_V+wid*1024;
  #define DMA_K(t,slot) glds16(ksrc+(long)(t)*KVBLK*DM,(unsigned)__builtin_amdgcn_readfirstlane(kdst+(slot)))
  #define DMA_V(t,slot) glds16(vsrc+(long)(t)*KVBLK*DM,(unsigned)__builtin_amdgcn_readfirstlane(vdst+(slot)))
  const int vb0=(int)(lds0+LDS_V)+((lane>>4)&1)*32+(lane&3)*8+(4*hi+((lane&15)>>2))*64;
  const char*Kbase=shm+LDS_K; bf16x8 kf[8];
  const lds_cptr shm3=(lds_cptr)shm; const lds_cptr kp0=shm3+LDS_K+hi*1024+r32*16; const lds_cptr vp0=shm3+LDS_V+((lane>>4)&1)*32+(lane&3)*8+(4*hi+((lane&15)>>2))*64;
  const int NT=(q0+QB)/KVBLK;
  typedef __attribute__((address_space(3))) const f32x4k* lds_f4p; const __attribute__((address_space(3))) float* kbp0=(const __attribute__((address_space(3))) float*)(shm3+LDS_KB)+4*hi;
  #define KBINIT(C0,C1,t) do{ const __attribute__((address_space(3))) float* kp_=kbp0+(t)*64; _Pragma("unroll") for(int g_=0;g_<4;++g_){ const f32x4k a_=*(lds_f4p)(kp_+8*g_); const f32x4k b_=*(lds_f4p)(kp_+32+8*g_); _Pragma("unroll") for(int e_=0;e_<4;++e_){ C0[4*g_+e_]=a_[e_]-mhat; C1[4*g_+e_]=b_[e_]-mhat; } } }while(0)
  DMA_K(0,0);DMA_V(0,0);DMA_K(1,SLOTB);
  bf16x8 qr[4];
  #pragma unroll
  for(int d0=0;d0<4;++d0)qr[d0]=*reinterpret_cast<const bf16x8*>(&Qw[(long)r32*DM+d0*16+hi*8]);
  float mhat=0.f,l_reg=0.f;f32x16 o[2];o[0]=f32x16{};o[1]=f32x16{};
  const int qrel=wid*QBLK+r32;
  #define CMASK(P0,P1,t) do{int jb_=(t)-(NT-4); if(jb_>=0)cmask(P0,P1,jb_,qrel,hi);}while(0)
  bool resc=false;
  #define START(P0,P1) do{ const float rm=rowmax(P0,P1); resc=false; \
    { const float dl=rm; mhat=fadd_s(mhat,dl); \
      _Pragma("unroll") for(int r=0;r<16;++r){P0[r]=fsub_s(P0[r],dl);P1[r]=fsub_s(P1[r],dl);} } \
    _Pragma("unroll") for(int r=0;r<16;++r)P0[r]=__builtin_amdgcn_exp2f(P0[r]); }while(0)
  #define RESC() do{ if(resc){ asm volatile("s_waitcnt lgkmcnt(0)":::"memory"); \
      _Pragma("unroll") for(int d_=0;d_<2;++d_) _Pragma("unroll") for(int r=0;r<16;++r)o[d_][r]*=wsf[crow(r,hi)]; } }while(0)
  f32x16 pA0,pA1,pB0,pB1;
  int sl_prev=0,sl_cur=0,sl_next=SLOTB;
  #define ROT() do{sl_prev=sl_cur;sl_cur=sl_next;sl_next=(sl_next==(NSLOT-1)*SLOTB)?0:sl_next+SLOTB;}while(0)
  DMA_K(2,2*SLOTB);
  WAIT_BAR(3);
  KBINIT(pA0,pA1,0); qkt(pA0,pA1,Kbase,qr,r32,hi);asm volatile("s_nop 15\n\ts_nop 7":"+v"(pA0),"+v"(pA1));CMASK(pA0,pA1,0);
  START(pA0,pA1);
  _Pragma("unroll") for(int r=0;r<16;++r)pA1[r]=__builtin_amdgcn_exp2f(pA1[r]);
  WAIT_BAR(0);
  DMA_K(3,0);DMA_V(1,SLOTB);
  ROT();
  kload8(kf,kp0+sl_cur);
  WAIT_BAR(2);
  s16x4 vlo[8],vhi[8]; u32x4 pw0,pw1,pw2,pw3;
  #define PKW(P,B) cvtpk_s(P[B],P[B+1])
  #define PAF(k) __builtin_bit_cast(bf16x8,pw##k)
  #define VFR(i) (bf16x8){vlo[i][0],vlo[i][1],vlo[i][2],vlo[i][3],vhi[i][0],vhi[i][1],vhi[i][2],vhi[i][3]}
  #define PIN(x) asm volatile("":"+v"(x))
  #define MX3(a,b,c) __builtin_fmaxf(__builtin_fmaxf((a),(b)),(c))
  #define GAPA(MF,A0,A1,A2,A3,W0,W1,PW) do{ MF; sacc+=A0; sacc+=A1; sacc+=A2; sacc+=A3; PIN(sacc); W0; W1; PIN(PW); SBAR(); }while(0)
  #define EX(v) __builtin_amdgcn_exp2f(v)
  #define GAPB(MF,X,B) do{ MF; X[B]=EX(X[B]); X[B+1]=EX(X[B+1]); X[B+2]=EX(X[B+2]); X[B+3]=EX(X[B+3]); PIN(X); SBAR(); }while(0)
  #define VRD(i) do{ vlo[i]=vtr(vp_+(((i)>>2)*4096+((i)&3)*1024)); vhi[i]=vtr(vp_+(((i)>>2)*4096+((i)&3)*1024+512)); }while(0)
  #define KRD(G,j) do{ if(G){ kload2(kf,kp0+sl_next,j); SBAR(); } }while(0)
  #define STEP(C0,C1,P0,P1,t,GK,GV,GL) do{ SBAR(); \
    const lds_cptr vp_=vp0+sl_prev; \
    KBINIT(C0,C1,t); SBAR(); \
    VRD(0); SBAR(); float sacc=(P0[0]+P0[1]); \
    GAPA(C0=__builtin_amdgcn_mfma_f32_32x32x16_bf16(kf[0],qr[0],C0,0,0,0), P0[2],P0[3],P0[4],P0[5],     pw0[0]=PKW(P0,0), pw0[1]=PKW(P0,2), pw0); \
    VRD(4); SBAR(); GAPA(C1=__builtin_amdgcn_mfma_f32_32x32x16_bf16(kf[1],qr[0],C1,0,0,0), P0[6],P0[7],P0[8],P0[9],     pw0[2]=PKW(P0,4), pw0[3]=PKW(P0,6), pw0); \
    VRD(1); SBAR(); GAPA(C0=__builtin_amdgcn_mfma_f32_32x32x16_bf16(kf[2],qr[1],C0,0,0,0),   P0[10],P0[11],P0[12],P0[13], pw1[0]=PKW(P0,8), pw1[1]=PKW(P0,10), pw1); \
    VRD(5); SBAR(); GAPA(C1=__builtin_amdgcn_mfma_f32_32x32x16_bf16(kf[3],qr[1],C1,0,0,0),   P0[14],P0[15],P1[0],P1[1],   pw1[2]=PKW(P0,12),pw1[3]=PKW(P0,14), pw1); \
    VRD(2); SBAR(); GAPA(C0=__builtin_amdgcn_mfma_f32_32x32x16_bf16(kf[4],qr[2],C0,0,0,0),   P1[2],P1[3],P1[4],P1[5],     pw2[0]=PKW(P1,0), pw2[1]=PKW(P1,2), pw2); \
    VRD(6); SBAR(); GAPA(C1=__builtin_amdgcn_mfma_f32_32x32x16_bf16(kf[5],qr[2],C1,0,0,0),   P1[6],P1[7],P1[8],P1[9],     pw2[2]=PKW(P1,4), pw2[3]=PKW(P1,6), pw2); \
    VRD(3); SBAR(); GAPA(C0=__builtin_amdgcn_mfma_f32_32x32x16_bf16(kf[6],qr[3],C0,0,0,0),   P1[10],P1[11],P1[12],P1[13], pw3[0]=PKW(P1,8), pw3[1]=PKW(P1,10), pw3); \
    VRD(7); SBAR(); GAPA(C1=__builtin_amdgcn_mfma_f32_32x32x16_bf16(kf[7],qr[3],C1,0,0,0),   P1[14],P1[15],0.f,0.f,       pw3[2]=PKW(P1,12),pw3[3]=PKW(P1,14), pw3); \
    l_reg+=sacc; \
    if(GK){DMA_K((t)+3,sl_cur);} if(GV){DMA_V((t)+1,sl_next);} \
    CMASK(C0,C1,t); \
    { float a=MX3(C0[0],C0[1],C1[0]),b=MX3(C0[2],C0[3],C1[1]); a=MX3(a,C1[2],C1[3]); \
      _Pragma("unroll") for(int r=4;r<16;r+=4){a=MX3(a,C0[r],C0[r+1]);b=MX3(b,C0[r+2],C0[r+3]);a=MX3(a,C1[r],C1[r+1]);b=MX3(b,C1[r+2],C1[r+3]);} \
      float rm=__builtin_fmaxf(a,b); { auto rr=__builtin_amdgcn_permlane32_swap(__float_as_uint(rm),__float_as_uint(rm),false,false); rm=__builtin_fmaxf(__uint_as_float(rr[0]),__uint_as_float(rr[1])); } \
      resc=false; \
      if(__builtin_expect(__any(rm>(float)THRL),0)){ const float dl=__builtin_fmaxf(rm,0.f); mhat+=dl; \
        _Pragma("unroll") for(int r=0;r<16;++r){C0[r]-=dl;C1[r]-=dl;} \
        const float f=__builtin_amdgcn_exp2f(-dl); l_reg*=f; if(hi==0)wsf[r32]=f; resc=true; } } \
    SBAR(); \
    GAPB(o[0]=__builtin_amdgcn_mfma_f32_32x32x16_bf16(PAF(0),VFR(0),o[0],0,0,0), C0,0); \
    GAPB(o[1]=__builtin_amdgcn_mfma_f32_32x32x16_bf16(PAF(0),VFR(4),o[1],0,0,0), C0,4); \
    KRD(GL,0); GAPB(o[0]=__builtin_amdgcn_mfma_f32_32x32x16_bf16(PAF(1),VFR(1),o[0],0,0,0), C0,8); \
    KRD(GL,1); GAPB(o[1]=__builtin_amdgcn_mfma_f32_32x32x16_bf16(PAF(1),VFR(5),o[1],0,0,0), C0,12); \
    KRD(GL,2); GAPB(o[0]=__builtin_amdgcn_mfma_f32_32x32x16_bf16(PAF(2),VFR(2),o[0],0,0,0), C1,0); \
    KRD(GL,3); GAPB(o[1]=__builtin_amdgcn_mfma_f32_32x32x16_bf16(PAF(2),VFR(6),o[1],0,0,0), C1,4); \
    GAPB(o[0]=__builtin_amdgcn_mfma_f32_32x32x16_bf16(PAF(3),VFR(3),o[0],0,0,0), C1,8); \
    GAPB(o[1]=__builtin_amdgcn_mfma_f32_32x32x16_bf16(PAF(3),VFR(7),o[1],0,0,0), C1,12); \
    }while(0)
  int t=1;
  #undef CMASK
  #define CMASK(P0,P1,t) do{}while(0)
  for(;t+5<NT;t+=2){
    STEP(pB0,pB1,pA0,pA1,t,true,true,true);     WAIT_BAR(2); RESC(); ROT();
    STEP(pA0,pA1,pB0,pB1,t+1,true,true,true);   WAIT_BAR(2); RESC(); ROT();
  }
  #undef CMASK
  #define CMASK(P0,P1,t) do{int jb_=(t)-(NT-4); if(jb_>=0)cmask(P0,P1,jb_,qrel,hi);}while(0)
  #define ENDW(tt) do{ if((tt)+3<NT){WAIT_BAR(2);} else if((tt)+2<NT){WAIT_BAR(1);} else {WAIT_BAR(0);} }while(0)
  for(;t+1<NT;t+=2){
    STEP(pB0,pB1,pA0,pA1,t,(t+3<NT),(t+1<NT),(t+1<NT));       ENDW(t);   RESC(); ROT();
    STEP(pA0,pA1,pB0,pB1,t+1,(t+4<NT),(t+2<NT),(t+2<NT));     ENDW(t+1); RESC(); ROT();
  }
  { float sacc=pA0[0]+pA0[1]; _Pragma("unroll") for(int r=2;r<16;++r)sacc+=pA0[r]; _Pragma("unroll") for(int r=0;r<16;++r)sacc+=pA1[r]; l_reg+=sacc;
    pw0=(u32x4){PKW(pA0,0),PKW(pA0,2),PKW(pA0,4),PKW(pA0,6)};pw1=(u32x4){PKW(pA0,8),PKW(pA0,10),PKW(pA0,12),PKW(pA0,14)};pw2=(u32x4){PKW(pA1,0),PKW(pA1,2),PKW(pA1,4),PKW(pA1,6)};pw3=(u32x4){PKW(pA1,8),PKW(pA1,10),PKW(pA1,12),PKW(pA1,14)};
    SBAR(); pv(o,vb0+sl_prev,PAF(0),PAF(1),PAF(2),PAF(3)); }
  #undef PKW
  #undef PAF
  #undef VFR
  #undef PIN
  #undef MX3
  #undef GAPA
  #undef GAPB
  #undef EX
  #undef VRD
  #undef KRD
  #undef STEP
  #undef ENDW
  {auto rr=__builtin_amdgcn_permlane32_swap(__float_as_uint(l_reg),__float_as_uint(l_reg),false,false);l_reg=__uint_as_float(rr[0])+__uint_as_float(rr[1]);}
  if(hi==0)wsf[32+r32]=l_reg;asm volatile("s_waitcnt lgkmcnt(0)":::"memory");
  float rli[16];
  #pragma unroll
  for(int r=0;r<16;++r)rli[r]=__builtin_amdgcn_rcpf(wsf[32+crow(r,hi)]);
  bf16*Ow=O+(rowbase+q0+wid*QBLK)*DM+h*D;
  { bf16*stg=(bf16*)(shm+LDS_OST)+wid*2048;
    #pragma unroll
    for(int r=0;r<16;++r){const int orow=crow(r,hi);
      #pragma unroll
      for(int d0=0;d0<2;++d0)stg[orow*64+d0*32+r32]=__float2bfloat16(o[d0][r]*rli[r]);}
    asm volatile("s_waitcnt lgkmcnt(0)":::"memory");
    #pragma unroll
    for(int i=0;i<4;++i){const int row=i*8+(lane>>3),ch=lane&7; const u32x4 v=*(const u32x4*)(stg+row*64+ch*8); ATTN_STORE16(Ow+(long)row*DM+ch*8,v);} }
  asm volatile("s_waitcnt lgkmcnt(0)\n\ts_barrier":::"memory");
  #undef DMA_K
  #undef DMA_V
  #undef CMASK
  #undef START
  #undef RESC
  #undef ROT
  #undef KBINIT
}
constexpr int ATTN_LDS_BYTES=LDS_BYTES;
#undef SBAR
#undef WAIT_BAR
}

#define LAS __attribute__((address_space(3)))
typedef unsigned short bf16;
typedef unsigned v4u __attribute__((ext_vector_type(4)));
typedef unsigned v2u __attribute__((ext_vector_type(2)));
typedef float f32x4 __attribute__((ext_vector_type(4)));
typedef short bf16x8 __attribute__((ext_vector_type(8)));
typedef float f32x16v __attribute__((ext_vector_type(16)));

constexpr int NB = 16, SEQ = 4096, DMODEL = 1024, NMETA = 16;
constexpr int TP = 4160;
constexpr int R = NB * TP;
constexpr int NTOK = NB * SEQ;
constexpr int N1 = 5632;
constexpr int IN_COLS = 5416;
constexpr int NWAVES = 8, NTHREADS = 512;
constexpr float NORM_EPS = 1e-6f, GN_EPS = 64e-5f;
constexpr float LOG2E = 1.4426950408889634f;

constexpr size_t MiB = 1u << 20;
constexpr size_t U65 = 65 * MiB;
constexpr size_t WS_WTIN = 1 * MiB;
constexpr size_t WS_WTQ = 12 * MiB;
constexpr size_t WS_WTFOX = 16 * MiB;
constexpr size_t WS_WTRWKV = 17 * MiB;
constexpr size_t WS_WTOUT = 18 * MiB;
constexpr size_t WS_WTWA = 20 * MiB;
constexpr size_t WS_WTG = 20 * MiB + 512 * 1024;
constexpr size_t WS_KS = 21 * MiB;
constexpr size_t WS_KB = 22 * MiB;
constexpr size_t WS_LF = 25 * MiB;
constexpr size_t WS_BS = 28 * MiB;
constexpr size_t WS_U16 = 32 * MiB;
constexpr size_t WS_V16 = 64 * MiB;
constexpr size_t WS_F = 96 * MiB;
constexpr size_t WS_FQ = WS_F, WS_FK = WS_F + U65, WS_FV = WS_F + 2 * U65, WS_ZRR = WS_F + 3 * U65, WS_ZRK = WS_F + 4 * U65, WS_ZRV = WS_F + 5 * U65, WS_ZM = WS_F + 6 * U65;
constexpr size_t WS_ZG = WS_F + 7 * U65;
constexpr size_t WS_XN = WS_ZG + 4 * U65;
constexpr size_t WS_IDS = 941 * MiB;
constexpr size_t WS_GATES = 973 * MiB;
constexpr size_t WS_END = 1005 * MiB;
constexpr size_t WS_LA = WS_XN;
constexpr size_t WS_LG = WS_XN + 20 * MiB;
constexpr size_t WS_KP = WS_XN;
constexpr size_t WS_KN = WS_XN + U65;
constexpr size_t WS_Y = WS_ZM;
constexpr size_t WS_MIX = WS_XN;
constexpr size_t WS_XN2 = WS_XN;
constexpr size_t WS_PQ = WS_F;
constexpr size_t DO_XW = 0, DO_AA = U65, DO_GG = 2 * U65;

__device__ __forceinline__ unsigned f2bf(float f) { unsigned u = __builtin_bit_cast(unsigned, f); return (u + 0x7fffu + ((u >> 16) & 1u)) >> 16; }
__device__ __forceinline__ unsigned pk2(float lo, float hi) { return f2bf(lo) | (f2bf(hi) << 16); }
__device__ __forceinline__ float bflo(unsigned w) { return __builtin_bit_cast(float, w << 16); }
__device__ __forceinline__ float bfhi(unsigned w) { return __builtin_bit_cast(float, w & 0xffff0000u); }
__device__ __forceinline__ void unpack8(const v4u w, float (&f)[8]) { f[0] = bflo(w.x); f[1] = bfhi(w.x); f[2] = bflo(w.y); f[3] = bfhi(w.y); f[4] = bflo(w.z); f[5] = bfhi(w.z); f[6] = bflo(w.w); f[7] = bfhi(w.w); }
__device__ __forceinline__ v4u pack8(const float (&f)[8]) { v4u w; w.x = pk2(f[0], f[1]); w.y = pk2(f[2], f[3]); w.z = pk2(f[4], f[5]); w.w = pk2(f[6], f[7]); return w; }
__device__ __forceinline__ float sigmoidf_(float x) { return __builtin_amdgcn_rcpf(1.0f + __builtin_amdgcn_exp2f(-x * LOG2E)); }
__device__ __forceinline__ float wave_sum(float v) {
#pragma unroll
    for (int o = 1; o < 64; o <<= 1) v += __shfl_xor(v, o);
    return v;
}
__device__ __forceinline__ float sum8(float v) { v += __shfl_xor(v, 1); v += __shfl_xor(v, 2); v += __shfl_xor(v, 4); return v; }

struct Params {
    const float* in[27];
    float* out;
    unsigned char* ws;
};
enum { I_X = 0, I_META, I_N1G, I_WIN, I_FQN, I_FKN, I_FBIAS, I_MU, I_W0, I_WUP, I_A0, I_AUP, I_GUP, I_KK, I_KA, I_RK, I_LNG, I_LNB, I_WFOX, I_WRWKV, I_WOUT, I_N2G, I_PWQ, I_SK1, I_SK2, I_PU, I_PV };

__device__ __forceinline__ int win_src_col(int n) {
    if (n < 1536) return n;
    if (n < 3072) return 1544 + (n - 1536);
    if (n < 3584) { const int m = n - 3072; if (m < 288) return 3080 + m; if (m < 296) return 1536 + (m - 288); return -1; }
    return 3368 + (n - 3584);
}
template <bool REMAP>
__device__ __forceinline__ void transpose_item(const float* W, int ldw, int K, int N, bf16* WT, LAS float* scr, int item, int lane) {
    const int nblk = N / 32, kb = item / nblk, nb = item % nblk, k0 = 64 * kb, n0 = 32 * nb;
    const int n = n0 + (lane & 31); const int sc = REMAP ? win_src_col(n) : n;
#pragma unroll 8
    for (int i = 0; i < 32; ++i) { const int kk = 2 * i + (lane >> 5); scr[kk * 33 + (lane & 31)] = (sc >= 0) ? W[(size_t)(k0 + kk) * ldw + sc] : 0.f; }
    asm volatile("s_waitcnt lgkmcnt(0)" ::: "memory");
    const int c = lane & 7;
#pragma unroll
    for (int j = 0; j < 4; ++j) { const int nn = (lane >> 3) + 8 * j; const LAS float* s = scr + (8 * c) * 33 + nn;
        v4u o; o.x = pk2(s[0 * 33], s[1 * 33]); o.y = pk2(s[2 * 33], s[3 * 33]); o.z = pk2(s[4 * 33], s[5 * 33]); o.w = pk2(s[6 * 33], s[7 * 33]);
        *(v4u*)(WT + (size_t)(n0 + nn) * K + k0 + 8 * c) = o; }
    asm volatile("s_waitcnt lgkmcnt(0)" ::: "memory");
}
__device__ __forceinline__ void p0_prologue(const Params& p, LAS unsigned char* lds, int vcu, int G, int wave, int lane) {
    unsigned char* ws = p.ws;
    LAS float* scr = (LAS float*)(lds + wave * 16384);
    const int gw = vcu * NWAVES + wave, NGW = G * NWAVES;
    constexpr int I_IN = 16 * (N1 / 32), I_Q = 16 * 64, I_FX = 8 * 32, I_O = 16 * 32;
    constexpr int NITEMS = I_IN + I_Q + 2 * I_FX + I_O;
    for (int it = gw; it < NITEMS; it += NGW) {
        int r = it;
        if (r < I_IN) { transpose_item<true>(p.in[I_WIN], IN_COLS, 1024, N1, (bf16*)(ws + WS_WTIN), scr, r, lane); continue; } r -= I_IN;
        if (r < I_Q) { transpose_item<false>(p.in[I_PWQ], 2048, 1024, 2048, (bf16*)(ws + WS_WTQ), scr, r, lane); continue; } r -= I_Q;
        if (r < I_FX) { transpose_item<false>(p.in[I_WFOX], 1024, 512, 1024, (bf16*)(ws + WS_WTFOX), scr, r, lane); continue; } r -= I_FX;
        if (r < I_FX) { transpose_item<false>(p.in[I_WRWKV], 1024, 512, 1024, (bf16*)(ws + WS_WTRWKV), scr, r, lane); continue; } r -= I_FX;
        transpose_item<false>(p.in[I_WOUT], 1024, 1024, 1024, (bf16*)(ws + WS_WTOUT), scr, r, lane);
    }
    const int gt = gw * 64 + lane, NGT = NGW * 64;
    for (int i = gt; i < 1024 * 128; i += NGT) { const int n = i >> 7, k = i & 127; float v = 0.f;
        if (n < 512) { if (k < 64) v = p.in[I_WUP][k * 512 + n]; } else { if (k >= 64) v = p.in[I_AUP][(k - 64) * 512 + (n - 512)]; }
        ((bf16*)(ws + WS_WTWA))[i] = (bf16)f2bf(v); }
    for (int i = gt; i < 512 * 256; i += NGT) { const int n = i >> 8, k = i & 255; const float v = (k < 160) ? p.in[I_GUP][k * 512 + n] : 0.f; ((bf16*)(ws + WS_WTG))[i] = (bf16)f2bf(v); }
    for (int i = gt; i < 2 * 128 * 128; i += NGT) { const float v = (i < 16384) ? p.in[I_SK1][i] : p.in[I_SK2][i - 16384]; ((bf16*)(ws + WS_KS))[i] = (bf16)f2bf(v); }
    for (int i = gt; i < 16384 * 1024 / 4; i += NGT) {
        const f32x4 a = ((const f32x4*)p.in[I_PU])[i]; v2u o; o.x = pk2(a.x, a.y); o.y = pk2(a.z, a.w); ((v2u*)(ws + WS_U16))[i] = o;
        const f32x4 b = ((const f32x4*)p.in[I_PV])[i]; v2u q; q.x = pk2(b.x, b.y); q.y = pk2(b.z, b.w); ((v2u*)(ws + WS_V16))[i] = q; }
    const f32x4* g4 = (const f32x4*)p.in[I_N1G] + lane;
    for (int m = gw; m < R; m += NGW) {
        const int b = m / TP, pp = m - b * TP;
        unsigned long long* o8 = (unsigned long long*)(ws + WS_XN + (size_t)m * 2048) + lane;
        if (pp < 48) {
#pragma unroll
            for (int j = 0; j < 4; ++j) o8[64 * j] = 0ull;
            continue; }
        const float* xrow = (pp < 64) ? p.in[I_META] + (size_t)(pp - 48) * 1024 : p.in[I_X] + ((size_t)b * SEQ + (pp - 64)) * 1024;
        const f32x4* xr = (const f32x4*)xrow + lane;
        f32x4 v[4]; float s = 0.f;
#pragma unroll
        for (int j = 0; j < 4; ++j) { v[j] = xr[64 * j]; s += (v[j].x * v[j].x + v[j].y * v[j].y) + (v[j].z * v[j].z + v[j].w * v[j].w); }
        const float rs = 1.0f / sqrtf(wave_sum(s) * (1.f / 1024.f) + NORM_EPS);
#pragma unroll
        for (int j = 0; j < 4; ++j) { const f32x4 g = g4[64 * j]; o8[64 * j] = (unsigned long long)pk2(v[j].x * rs * g.x, v[j].y * rs * g.y) | ((unsigned long long)pk2(v[j].z * rs * g.z, v[j].w * rs * g.w) << 32); }
    }
}

template <class F> struct EpiT {
    static constexpr bool PERM = true, AFTER_DRAIN = false;
    F f;
    __device__ __forceinline__ void operator()(const pg8::f32x4 (&acc)[2][2][4][2], const pg8::Unit& u, int wr, int wc, int fr, int fq) const {
        const int row0 = u.pm * 256 + wr * 64 + fr, col0 = u.pn * 256 + wc * 32 + 8 * fq;
#pragma unroll
        for (int ai = 0; ai < 2; ++ai)
#pragma unroll
            for (int m = 0; m < 4; ++m)
#pragma unroll
                for (int bj = 0; bj < 2; ++bj) {
                    const pg8::f32x4 a = acc[ai][bj][m][0], b = acc[ai][bj][m][1];
                    float v[8] = {a[0], a[1], a[2], a[3], b[0], b[1], b[2], b[3]};
                    f.store(row0 + ai * 128 + m * 16, col0 + bj * 128, v);
                }
    }
};
struct F_Gemm1 {
    bf16* F; bf16* ZG;
    __device__ __forceinline__ void store(int row, int col, float (&v)[8]) const {
        if (col < 3584) { const int buf = col >> 9, c = col & 511; *(v4u*)(F + (size_t)buf * ((size_t)R * 512) + (size_t)row * 512 + c) = pack8(v); }
        else { const int c = col - 3584;
#pragma unroll
            for (int e = 0; e < 8; ++e) v[e] = sigmoidf_(v[e]);
            *(v4u*)(ZG + (size_t)row * 2048 + c) = pack8(v); }
    }
};
struct F_LoraW {
    bf16* XW; const float* w0;
    __device__ __forceinline__ void store(int row, int col, float (&v)[8]) const {
        const f32x4 b0 = *(const f32x4*)(w0 + col), b1 = *(const f32x4*)(w0 + col + 4); const float bb[8] = {b0.x, b0.y, b0.z, b0.w, b1.x, b1.y, b1.z, b1.w};
#pragma unroll
        for (int e = 0; e < 8; ++e) { const float x = v[e] + bb[e];
            const float sp = fmaxf(-x, 0.f) + __logf(1.0f + __expf(-fabsf(x)));
            const float ew = __expf(-sp - 0.5f);
            v[e] = 1.0f - __expf(-ew); }
        *(v4u*)(XW + (size_t)row * 512 + col) = pack8(v);
    }
};
struct F_LoraA {
    bf16* AA; const float* a0;
    __device__ __forceinline__ void store(int row, int col, float (&v)[8]) const {
        const f32x4 b0 = *(const f32x4*)(a0 + col), b1 = *(const f32x4*)(a0 + col + 4); const float bb[8] = {b0.x, b0.y, b0.z, b0.w, b1.x, b1.y, b1.z, b1.w};
#pragma unroll
        for (int e = 0; e < 8; ++e) v[e] = sigmoidf_(v[e] + bb[e]);
        *(v4u*)(AA + (size_t)row * 512 + col) = pack8(v);
    }
};
struct F_Plain {
    bf16* O; int ldc;
    __device__ __forceinline__ void store(int row, int col, float (&v)[8]) const { *(v4u*)(O + (size_t)row * ldc + col) = pack8(v); }
};
struct F_MixA {
    bf16* MIX; const bf16* ZG;
    __device__ __forceinline__ void store(int row, int col, float (&v)[8]) const {
        float g[8]; unpack8(*(const v4u*)(ZG + (size_t)row * 2048 + col), g);
#pragma unroll
        for (int e = 0; e < 8; ++e) v[e] *= g[e];
        *(v4u*)(MIX + (size_t)row * 1024 + col) = pack8(v);
    }
};
struct F_MixB {
    bf16* MIX; const bf16* ZG;
    __device__ __forceinline__ void store(int row, int col, float (&v)[8]) const {
        float g[8], m[8]; unpack8(*(const v4u*)(ZG + (size_t)row * 2048 + 1024 + col), g); unpack8(*(const v4u*)(MIX + (size_t)row * 1024 + col), m);
#pragma unroll
        for (int e = 0; e < 8; ++e) v[e] = m[e] + v[e] * g[e];
        *(v4u*)(MIX + (size_t)row * 1024 + col) = pack8(v);
    }
};
struct F_Out {
    const float* x; float* out;
    __device__ __forceinline__ void store(int row, int col, float (&v)[8]) const {
        const int b = row / TP, pp = row - b * TP; if (pp < 64) return;
        const size_t off = ((size_t)b * SEQ + (pp - 64)) * 1024 + col;
        const f32x4 x0 = *(const f32x4*)(x + off), x1 = *(const f32x4*)(x + off + 4);
        *(f32x4*)(out + off) = (f32x4){x0.x + v[0], x0.y + v[1], x0.z + v[2], x0.w + v[3]};
        *(f32x4*)(out + off + 4) = (f32x4){x1.x + v[4], x1.y + v[5], x1.z + v[6], x1.w + v[7]};
    }
};
template <class F>
__device__ __forceinline__ void run_gemm(LAS unsigned char* lds, const bf16* A, const bf16* Bt, int M, int N, int K, int G, int bid, const F& f) {
    asm volatile("" : "+s"(M), "+s"(N), "+s"(G));
    pg8::Gemm g{A, Bt, M, N, K}; pg8::StaticOrder S; S.init(M, N, G, bid);
    EpiT<F> E{f};
    pg8::gemm_phase<EpiT<F>, pg8::StaticOrder, true, true>(lds, g, S, E);
}

__device__ __forceinline__ void p2_prep1(const Params& p, int vcu, int G, int wave, int lane) {
    unsigned char* ws = p.ws;
    const int gw = vcu * NWAVES + wave, NGW = G * NWAVES;
    float gq[8], gk[8], mu[8];
#pragma unroll
    for (int e = 0; e < 8; ++e) { gq[e] = p.in[I_FQN][lane * 8 + e] * attn_body::C2; gk[e] = p.in[I_FKN][lane * 8 + e]; mu[e] = (lane < 36) ? p.in[I_MU][1536 + lane * 8 + e] : 0.f; }
    for (int m = gw; m < R; m += NGW) {
        const int b = m / TP, pp = m - b * TP;
        {
            v4u* qp = (v4u*)(ws + WS_FQ + (size_t)m * 1024) + lane; v4u* kp = (v4u*)(ws + WS_FK + (size_t)m * 1024) + lane;
            float q[8], k[8]; unpack8(*qp, q); unpack8(*kp, k);
            float sq = 0.f, sk = 0.f;
#pragma unroll
            for (int e = 0; e < 8; ++e) { sq += q[e] * q[e]; sk += k[e] * k[e]; }
            sq = sum8(sq); sk = sum8(sk);
            const float rq = 1.0f / sqrtf(sq * (1.f / 64.f) + NORM_EPS), rk = 1.0f / sqrtf(sk * (1.f / 64.f) + NORM_EPS);
#pragma unroll
            for (int e = 0; e < 8; ++e) { q[e] *= rq * gq[e]; k[e] *= rk * gk[e]; }
            *qp = pack8(q); *kp = pack8(k);
        }
        if (lane < 36) {
            float z[8], zp[8]; unpack8(*((const v4u*)(ws + WS_ZM + (size_t)m * 1024) + lane), z);
            if (pp > 0) unpack8(*((const v4u*)(ws + WS_ZM + (size_t)(m - 1) * 1024) + lane), zp); else {
#pragma unroll
                for (int e = 0; e < 8; ++e) zp[e] = 0.f; }
#pragma unroll
            for (int e = 0; e < 8; ++e) { const float s = z[e] + mu[e] * (zp[e] - z[e]); z[e] = (lane < 8) ? tanhf(s) : (lane < 16) ? s : sigmoidf_(s); }
            if (lane < 16) *((v4u*)(ws + WS_LA + (size_t)m * 256) + lane) = pack8(z);
            else *((v4u*)(ws + WS_LG + (size_t)m * 512) + (lane - 16)) = pack8(z);
        } else if (lane == 36) {
            float z[8]; unpack8(*((const v4u*)(ws + WS_ZM + (size_t)m * 1024) + 36), z);
#pragma unroll
            for (int e = 0; e < 8; ++e) { const float x = z[e] + p.in[I_FBIAS][e]; z[e] = fminf(x, 0.f) - __logf(1.0f + __expf(-fabsf(x))); }
            float* lf = (float*)(ws + WS_LF) + (size_t)m * 8;
            *(f32x4*)lf = (f32x4){z[0], z[1], z[2], z[3]}; *(f32x4*)(lf + 4) = (f32x4){z[4], z[5], z[6], z[7]};
        } else if (lane < 49) {
            *((v4u*)(ws + WS_LG + (size_t)m * 512) + (lane - 37 + 20)) = (v4u){0u, 0u, 0u, 0u};
        }
    }
}
__device__ __forceinline__ void p3_cumsum(const Params& p, int seq, int lane) {
    unsigned char* ws = p.ws;
    const int b = seq >> 3, h = seq & 7;
    const float* lf = (const float*)(ws + WS_LF) + (size_t)b * TP * 8 + h;
    float* kb = (float*)(ws + WS_KB) + (size_t)seq * TP;
    float carry = 0.f;
    for (int c0 = 0; c0 < 65; c0 += 13) {
        float v[13];
#pragma unroll
        for (int i = 0; i < 13; ++i) { const int pp = (c0 + i) * 64 + lane; v[i] = (pp >= 48) ? lf[(size_t)pp * 8] : 0.f; }
#pragma unroll
        for (int i = 0; i < 13; ++i) {
            float x = v[i];
#pragma unroll
            for (int o = 1; o < 64; o <<= 1) { const float y = __shfl_up(x, o); if (lane >= o) x += y; }
            const int pp = (c0 + i) * 64 + lane;
            const float c = carry + x;
            kb[pp] = (pp >= 48) ? -c * LOG2E : -1e30f;
            carry += __shfl(x, 63);
        }
    }
}

__device__ __forceinline__ void p4_prep2(const Params& p, int vcu, int G, int wave, int lane) {
    unsigned char* ws = p.ws; unsigned char* dob = (unsigned char*)p.out;
    const int gw = vcu * NWAVES + wave, NGW = G * NWAVES;
    float mur[8], muk[8], kk_[8], ka_[8], rk_[8];
#pragma unroll
    for (int e = 0; e < 8; ++e) { const int c = lane * 8 + e; mur[e] = p.in[I_MU][c]; muk[e] = p.in[I_MU][512 + c]; kk_[e] = p.in[I_KK][c]; ka_[e] = p.in[I_KA][c]; rk_[e] = p.in[I_RK][c]; }
    for (int m = gw; m < R; m += NGW) {
        const int b = m / TP, pp = m - b * TP;
        float r[8], k[8], rp[8], kp[8], a[8];
        unpack8(*((const v4u*)(ws + WS_ZRR + (size_t)m * 1024) + lane), r); unpack8(*((const v4u*)(ws + WS_ZRK + (size_t)m * 1024) + lane), k);
        if (pp > 0) { unpack8(*((const v4u*)(ws + WS_ZRR + (size_t)(m - 1) * 1024) + lane), rp); unpack8(*((const v4u*)(ws + WS_ZRK + (size_t)(m - 1) * 1024) + lane), kp); }
        else {
#pragma unroll
            for (int e = 0; e < 8; ++e) { rp[e] = 0.f; kp[e] = 0.f; } }
        v4u* aap = (v4u*)(dob + DO_AA + (size_t)m * 1024) + lane;
        unpack8(*aap, a);
        float kkv[8], kpr[8]; float ss = 0.f, bon = 0.f;
#pragma unroll
        for (int e = 0; e < 8; ++e) { const float rs = r[e] + mur[e] * (rp[e] - r[e]); const float ks = k[e] + muk[e] * (kp[e] - k[e]);
            kkv[e] = ks * kk_[e]; kpr[e] = ks * (1.0f + (a[e] - 1.0f) * ka_[e]); ss += kkv[e] * kkv[e]; bon += rs * kpr[e] * rk_[e]; }
        ss = sum8(ss); bon = sum8(bon);
        const float inv = 1.0f / fmaxf(sqrtf(ss), 1e-12f);
        float bb[8];
#pragma unroll
        for (int e = 0; e < 8; ++e) { kkv[e] *= inv; bb[e] = kkv[e] * a[e]; }
        *((v4u*)(ws + WS_KP + (size_t)m * 1024) + lane) = pack8(kpr);
        *((v4u*)(ws + WS_KN + (size_t)m * 1024) + lane) = pack8(kkv);
        *aap = pack8(bb);
        if ((lane & 7) == 0) ((float*)(ws + WS_BS))[(size_t)m * 8 + (lane >> 3)] = bon;
    }
}

constexpr int SC_CH = 32, SC_STRIDE = 5 * 64 + 32;
__device__ __forceinline__ float dpp_sum16(float x) {
    x += __builtin_bit_cast(float, __builtin_amdgcn_update_dpp(0, __builtin_bit_cast(int, x), 0xB1, 0xF, 0xF, true));
    x += __builtin_bit_cast(float, __builtin_amdgcn_update_dpp(0, __builtin_bit_cast(int, x), 0x4E, 0xF, 0xF, true));
    x += __builtin_bit_cast(float, __builtin_amdgcn_update_dpp(0, __builtin_bit_cast(int, x), 0x141, 0xF, 0xF, true));
    x += __builtin_bit_cast(float, __builtin_amdgcn_update_dpp(0, __builtin_bit_cast(int, x), 0x140, 0xF, 0xF, true));
    return x;
}
__device__ __forceinline__ void p5_scan_item(const Params& p, LAS unsigned char* lds, int item, int tid, int wave, int lane) {
    unsigned char* ws = p.ws; unsigned char* dob = (unsigned char*)p.out;
    const int half = item & 1, bh = item >> 1, b = bh >> 3, h = bh & 7;
    LAS float* buf = (LAS float*)lds;
    LAS float* ybuf = buf + SC_CH * SC_STRIDE;
    const size_t rowb = (size_t)b * TP;
    const int st_step = (tid >> 3) & 31, st_grp = tid >> 8, c8 = tid & 7;
    const size_t colb = (size_t)h * 64 + c8 * 8;
    const bf16* aXW = (const bf16*)(dob + DO_XW); const bf16* aKN = (const bf16*)(ws + WS_KN); const bf16* aBB = (const bf16*)(dob + DO_AA); const bf16* aKP = (const bf16*)(ws + WS_KP);
    const bf16* aR = (const bf16*)(ws + WS_ZRR); const bf16* aV = (const bf16*)(ws + WS_ZRV);
    float mu8[8];
#pragma unroll
    for (int e = 0; e < 8; ++e) mu8[e] = (st_grp == 0) ? p.in[I_MU][h * 64 + c8 * 8 + e] : ((c8 < 4) ? p.in[I_MU][1024 + h * 64 + half * 32 + c8 * 8 + e] : 0.f);
    v4u g0, g1, g2, g3;
    auto issue = [&](int t0) {
        const size_t row = rowb + t0 + st_step;
        if (st_grp == 0) { g0 = *(const v4u*)(aXW + row * 512 + colb); g1 = *(const v4u*)(aKN + row * 512 + colb); g2 = *(const v4u*)(aR + row * 512 + colb); g3 = *(const v4u*)(aR + (row - 1) * 512 + colb); }
        else { g0 = *(const v4u*)(aBB + row * 512 + colb); g1 = *(const v4u*)(aKP + row * 512 + colb);
            if (c8 < 4) { const size_t cv = (size_t)h * 64 + half * 32 + c8 * 8; g2 = *(const v4u*)(aV + row * 512 + cv); g3 = *(const v4u*)(aV + (row - 1) * 512 + cv); } }
    };
    auto commit = [&]() {
        LAS float* d = buf + st_step * SC_STRIDE;
        float a[8], c[8];
        if (st_grp == 0) {
            unpack8(g0, a); *(LAS f32x4*)(d + 0 * 64 + c8 * 8) = (f32x4){a[0], a[1], a[2], a[3]}; *(LAS f32x4*)(d + 0 * 64 + c8 * 8 + 4) = (f32x4){a[4], a[5], a[6], a[7]};
            unpack8(g1, a); *(LAS f32x4*)(d + 1 * 64 + c8 * 8) = (f32x4){a[0], a[1], a[2], a[3]}; *(LAS f32x4*)(d + 1 * 64 + c8 * 8 + 4) = (f32x4){a[4], a[5], a[6], a[7]};
            unpack8(g2, a); unpack8(g3, c);
#pragma unroll
            for (int e = 0; e < 8; ++e) a[e] = a[e] + mu8[e] * (c[e] - a[e]);
            *(LAS f32x4*)(d + 4 * 64 + c8 * 8) = (f32x4){a[0], a[1], a[2], a[3]}; *(LAS f32x4*)(d + 4 * 64 + c8 * 8 + 4) = (f32x4){a[4], a[5], a[6], a[7]};
        } else {
            unpack8(g0, a); *(LAS f32x4*)(d + 2 * 64 + c8 * 8) = (f32x4){a[0], a[1], a[2], a[3]}; *(LAS f32x4*)(d + 2 * 64 + c8 * 8 + 4) = (f32x4){a[4], a[5], a[6], a[7]};
            unpack8(g1, a); *(LAS f32x4*)(d + 3 * 64 + c8 * 8) = (f32x4){a[0], a[1], a[2], a[3]}; *(LAS f32x4*)(d + 3 * 64 + c8 * 8 + 4) = (f32x4){a[4], a[5], a[6], a[7]};
            if (c8 < 4) { unpack8(g2, a); unpack8(g3, c);
#pragma unroll
                for (int e = 0; e < 8; ++e) a[e] = a[e] + mu8[e] * (c[e] - a[e]);
                *(LAS f32x4*)(d + 5 * 64 + c8 * 8) = (f32x4){a[0], a[1], a[2], a[3]}; *(LAS f32x4*)(d + 5 * 64 + c8 * 8 + 4) = (f32x4){a[4], a[5], a[6], a[7]}; }
        }
    };
    const int rl = lane >> 4, kq = lane & 15, myrow = wave * 4 + rl;
    float S0 = 0.f, S1 = 0.f, S2 = 0.f, S3 = 0.f;
    constexpr int T0 = 32, NCH = (TP - T0) / SC_CH;
    bf16* Y = (bf16*)(ws + WS_Y);
    issue(T0);
    for (int ch = 0; ch < NCH; ++ch) {
        const int t0 = T0 + ch * SC_CH;
        __syncthreads();
        commit();
        __syncthreads();
        if (ch + 1 < NCH) issue(t0 + SC_CH);
        const LAS float* sp = buf + kq * 4;
#pragma unroll 4
        for (int s = 0; s < SC_CH; ++s) {
            const LAS float* q = sp + s * SC_STRIDE;
            const f32x4 xw = *(const LAS f32x4*)(q), kn = *(const LAS f32x4*)(q + 64), bb = *(const LAS f32x4*)(q + 128), kp = *(const LAS f32x4*)(q + 192), rr = *(const LAS f32x4*)(q + 256);
            const float vv = buf[s * SC_STRIDE + 320 + myrow];
            float sa = S0 * kn.x; sa = fmaf(S1, kn.y, sa); sa = fmaf(S2, kn.z, sa); sa = fmaf(S3, kn.w, sa);
            sa = -dpp_sum16(sa);
            S0 = fmaf(vv, kp.x, fmaf(sa, bb.x, fmaf(-S0, xw.x, S0)));
            S1 = fmaf(vv, kp.y, fmaf(sa, bb.y, fmaf(-S1, xw.y, S1)));
            S2 = fmaf(vv, kp.z, fmaf(sa, bb.z, fmaf(-S2, xw.z, S2)));
            S3 = fmaf(vv, kp.w, fmaf(sa, bb.w, fmaf(-S3, xw.w, S3)));
            float y = S0 * rr.x; y = fmaf(S1, rr.y, y); y = fmaf(S2, rr.z, y); y = fmaf(S3, rr.w, y);
            y = dpp_sum16(y);
            if (kq == 0) ybuf[s * 32 + myrow] = y;
        }
        __syncthreads();
        {
            const int s = tid >> 4, rp = tid & 15;
            const float y0 = ybuf[s * 32 + 2 * rp], y1 = ybuf[s * 32 + 2 * rp + 1];
            *(unsigned*)(Y + (rowb + t0 + s) * 512 + h * 64 + half * 32 + 2 * rp) = pk2(y0, y1);
        }
    }
    __syncthreads();
}

__device__ __forceinline__ void p6_prep3(const Params& p, int vcu, int G, int wave, int lane) {
    unsigned char* ws = p.ws; unsigned char* dob = (unsigned char*)p.out;
    const int gw = vcu * NWAVES + wave, NGW = G * NWAVES;
    float lg[8], lb[8], muv[8];
#pragma unroll
    for (int e = 0; e < 8; ++e) { const int c = lane * 8 + e; lg[e] = p.in[I_LNG][c]; lb[e] = p.in[I_LNB][c]; muv[e] = p.in[I_MU][1024 + c]; }
    for (int m = gw; m < R; m += NGW) {
        const int b = m / TP, pp = m - b * TP;
        v4u* yp = (v4u*)(ws + WS_Y + (size_t)m * 1024) + lane;
        if (pp < 48) { *yp = (v4u){0u, 0u, 0u, 0u}; continue; }
        float y[8], v[8], vp[8], g[8];
        unpack8(*yp, y); unpack8(*((const v4u*)(ws + WS_ZRV + (size_t)m * 1024) + lane), v); unpack8(*((const v4u*)(ws + WS_ZRV + (size_t)(m - 1) * 1024) + lane), vp);
        unpack8(*((const v4u*)(dob + DO_GG + (size_t)m * 1024) + lane), g);
        float s = 0.f;
#pragma unroll
        for (int e = 0; e < 8; ++e) s += y[e];
        const float mean = sum8(s) * (1.f / 64.f); float q = 0.f;
#pragma unroll
        for (int e = 0; e < 8; ++e) { y[e] -= mean; q += y[e] * y[e]; }
        const float rstd = 1.0f / sqrtf(sum8(q) * (1.f / 64.f) + GN_EPS);
        const float bon = ((const float*)(ws + WS_BS))[(size_t)m * 8 + (lane >> 3)];
#pragma unroll
        for (int e = 0; e < 8; ++e) { const float vs = v[e] + muv[e] * (vp[e] - v[e]); y[e] = (y[e] * rstd * lg[e] + lb[e] + bon * vs) * g[e]; }
        *yp = pack8(y);
    }
}
__device__ __forceinline__ void p9_norm2(const Params& p, int vcu, int G, int wave, int lane) {
    unsigned char* ws = p.ws;
    const int gw = vcu * NWAVES + wave, NGW = G * NWAVES;
    const f32x4* g4 = (const f32x4*)p.in[I_N2G] + lane;
    for (int m = gw; m < NTOK; m += NGW) {
        const f32x4* xr = (const f32x4*)(p.out + (size_t)m * 1024) + lane;
        f32x4 v[4]; float s = 0.f;
#pragma unroll
        for (int j = 0; j < 4; ++j) { v[j] = xr[64 * j]; s += (v[j].x * v[j].x + v[j].y * v[j].y) + (v[j].z * v[j].z + v[j].w * v[j].w); }
        const float rs = 1.0f / sqrtf(wave_sum(s) * (1.f / 1024.f) + NORM_EPS);
        unsigned long long* o8 = (unsigned long long*)(ws + WS_XN2 + (size_t)m * 2048) + lane;
#pragma unroll
        for (int j = 0; j < 4; ++j) { const f32x4 g = g4[64 * j]; o8[64 * j] = (unsigned long long)pk2(v[j].x * rs * g.x, v[j].y * rs * g.y) | ((unsigned long long)pk2(v[j].z * rs * g.z, v[j].w * rs * g.w) << 32); }
    }
}

typedef __bf16 bf16x2_t __attribute__((ext_vector_type(2)));
__device__ __forceinline__ unsigned mono(float f) { const unsigned u = __builtin_bit_cast(unsigned, f); return u ^ ((unsigned)((int)u >> 31) | 0x80000000u); }
__device__ __forceinline__ float unmono(unsigned m) { const unsigned u = (m & 0x80000000u) ? (m ^ 0x80000000u) : ~m; return __builtin_bit_cast(float, u); }
__device__ __forceinline__ void ce_desc(unsigned& a, unsigned& b) { const unsigned hi = a > b ? a : b, lo = a > b ? b : a; a = hi; b = lo; }
template <int BASE, int N> __device__ __forceinline__ void bitonic_sort_desc(unsigned (&v)[N]) {
#pragma unroll
    for (int k = 2; k <= 16; k <<= 1)
#pragma unroll
        for (int j = k >> 1; j > 0; j >>= 1)
#pragma unroll
            for (int i = 0; i < 16; ++i) { const int l = i ^ j; if (l > i) { if ((i & k) == 0) ce_desc(v[BASE + i], v[BASE + l]); else ce_desc(v[BASE + l], v[BASE + i]); } }
}
template <int A, int B, int N> __device__ __forceinline__ void merge_top16(unsigned (&v)[N]) {
#pragma unroll
    for (int i = 0; i < 16; ++i) { const unsigned x = v[A + i], y = v[B + 15 - i]; v[A + i] = x > y ? x : y; }
#pragma unroll
    for (int j = 8; j > 0; j >>= 1)
#pragma unroll
        for (int i = 0; i < 16; ++i) { const int l = i ^ j; if (l > i) ce_desc(v[A + i], v[A + l]); }
}
constexpr int KS_STRIDE = 272;
constexpr int RT_KS_BYTES = 256 * KS_STRIDE;
constexpr int RT_TAB_WORDS = 33;
__device__ __forceinline__ void p11_route(const Params& p, LAS unsigned char* lds, int vcu, int G, int tid, int wave, int lane) {
    unsigned char* ws = p.ws;
    for (int i = tid; i < 256 * 16; i += NTHREADS) { const int row = i >> 4, ch = i & 15; *(LAS v4u*)(lds + row * KS_STRIDE + ch * 16) = *((const v4u*)(ws + WS_KS) + i); }
    __syncthreads();
    LAS unsigned* tab = (LAS unsigned*)(lds + RT_KS_BYTES) + (wave * 64 + lane) * RT_TAB_WORDS;
    const int r32 = lane & 31, hi = lane >> 5;
    const int gw = vcu * NWAVES + wave, NGW = G * NWAVES;
    const bf16* PQ = (const bf16*)(ws + WS_PQ);
    int* IDS = (int*)(ws + WS_IDS); float* GATES = (float*)(ws + WS_GATES);
    for (int task = gw; task < (NTOK / 32) * 8; task += NGW) {
        const int tb = task >> 3, h = task & 7;
        const int token = tb * 32 + r32;
        unsigned v[128];
        {
            const bf16* qrow = PQ + (size_t)token * 2048 + h * 256 + hi * 8;
#pragma unroll
            for (int t = 0; t < 4; ++t) {
                f32x16v acc[2];
#pragma unroll
                for (int w = 0; w < 2; ++w) {
                    f32x16v c = {};
                    const LAS unsigned char* kb = lds + (w * 128 + t * 32 + r32) * KS_STRIDE + hi * 16;
#pragma unroll
                    for (int s = 0; s < 8; ++s) { const bf16x8 a = *(const LAS bf16x8*)(kb + s * 32); const bf16x8 qf = *(const bf16x8*)(qrow + w * 128 + 16 * s); c = __builtin_amdgcn_mfma_f32_32x32x16_bf16(a, qf, c, 0, 0, 0); }
                    acc[w] = c;
                }
#pragma unroll
                for (int r = 0; r < 16; ++r) {
                    const float xa = acc[0][r], xb = acc[1][r];
                    auto rr = __builtin_amdgcn_permlane32_swap(__float_as_uint(xa), __float_as_uint(xb), false, false);
                    const unsigned r0 = rr[0], r1 = rr[1];
                    const int cr = (r & 3) + 8 * (r >> 2);
                    v[t * 16 + r] = (mono(__uint_as_float(r0)) & ~0x7Fu) | (unsigned)(32 * t + cr);
                    v[64 + t * 16 + r] = (mono(__uint_as_float(r1)) & ~0x7Fu) | (unsigned)(32 * t + cr + 4);
                }
            }
        }
        bitonic_sort_desc<0>(v); bitonic_sort_desc<16>(v); bitonic_sort_desc<32>(v); bitonic_sort_desc<48>(v);
        bitonic_sort_desc<64>(v); bitonic_sort_desc<80>(v); bitonic_sort_desc<96>(v); bitonic_sort_desc<112>(v);
        merge_top16<0, 16>(v); merge_top16<32, 48>(v); merge_top16<64, 80>(v); merge_top16<96, 112>(v);
        merge_top16<0, 32>(v); merge_top16<64, 96>(v);
        merge_top16<0, 64>(v);
        unsigned T[16], U[16];
#pragma unroll
        for (int i = 0; i < 16; ++i) { auto rr = __builtin_amdgcn_permlane32_swap(v[i], v[i], false, false); T[i] = v[i]; U[i] = hi ? rr[0] : rr[1]; }
        { const int bT = hi ? 16 : 0, bU = hi ? 0 : 16;
#pragma unroll
          for (int i = 0; i < 16; ++i) { tab[bT + i] = T[i] & 0x7Fu; tab[bU + i] = U[i] & 0x7Fu; } }
        float tv[16], uv[16];
#pragma unroll
        for (int i = 0; i < 16; ++i) { tv[i] = unmono(T[i] & ~0x7Fu); uv[i] = unmono(U[i] & ~0x7Fu); }
        unsigned c[32];
        {
            int n = 0;
#pragma unroll
            for (int i = 0; i < 4; ++i)
#pragma unroll
                for (int j = i; j < 16; ++j) if ((i + 1) * (j + 1) <= 16) {
                    const float s = tv[i] + uv[j];
                    const unsigned pay = hi ? (unsigned)((j << 4) | i) : (unsigned)((i << 4) | j);
                    unsigned key = (mono(s) & ~0xFFu) | pay;
                    if (i == j && hi) key = 0u;
                    c[n++] = key;
                }
#pragma unroll
            for (int k = 27; k < 32; ++k) c[k] = 0u;
        }
        bitonic_sort_desc<0>(c); bitonic_sort_desc<16>(c); merge_top16<0, 16>(c);
        unsigned W[32];
#pragma unroll
        for (int i = 0; i < 16; ++i) { auto rr = __builtin_amdgcn_permlane32_swap(c[i], c[i], false, false); W[i] = rr[0]; W[16 + i] = rr[1]; }
        merge_top16<0, 16>(W);
        asm volatile("s_waitcnt lgkmcnt(0)" ::: "memory");
        if (!hi) {
            int ids[16];
#pragma unroll
            for (int k = 0; k < 16; ++k) ids[k] = (int)(tab[(W[k] >> 4) & 15u] * 128u + tab[16 + (W[k] & 15u)]);
            int* o = IDS + (size_t)token * 128 + h * 16;
#pragma unroll
            for (int k = 0; k < 16; k += 4) *(v4u*)(o + k) = (v4u){(unsigned)ids[k], (unsigned)ids[k + 1], (unsigned)ids[k + 2], (unsigned)ids[k + 3]};
        } else {
            float e[16]; const float s0 = unmono(W[0] & ~0xFFu); float sum = 0.f;
#pragma unroll
            for (int k = 0; k < 16; ++k) { e[k] = __expf(unmono(W[k] & ~0xFFu) - s0); sum += e[k]; }
            const float inv = 1.0f / sum;
            float* o = GATES + (size_t)token * 128 + h * 16;
#pragma unroll
            for (int k = 0; k < 16; k += 4) *(f32x4*)(o + k) = (f32x4){e[k] * inv, e[k + 1] * inv, e[k + 2] * inv, e[k + 3] * inv};
        }
        asm volatile("s_waitcnt lgkmcnt(0)" ::: "memory");
    }
}

constexpr size_t WS_PART = 96 * MiB;
__device__ __forceinline__ float dpp_sum8(float x) {
    x += __builtin_bit_cast(float, __builtin_amdgcn_update_dpp(0, __builtin_bit_cast(int, x), 0xB1, 0xF, 0xF, true));
    x += __builtin_bit_cast(float, __builtin_amdgcn_update_dpp(0, __builtin_bit_cast(int, x), 0x4E, 0xF, 0xF, true));
    x += __builtin_bit_cast(float, __builtin_amdgcn_update_dpp(0, __builtin_bit_cast(int, x), 0x141, 0xF, 0xF, true));
    return x;
}
__device__ __forceinline__ void p12a_partial(const Params& p, int bid, int G, int wave, int lane) {
    unsigned char* ws = p.ws;
    const int xcd = bid & 7, wx = (bid >> 3) * NWAVES + wave, NWX = (G >> 3) * NWAVES;
    const int eg = lane >> 3, cj = lane & 7;
    const bf16* XN2 = (const bf16*)(ws + WS_XN2); const int* IDS = (const int*)(ws + WS_IDS); float* PART = (float*)(ws + WS_PART);
#pragma unroll 1
    for (int pass = 0; pass < 2; ++pass) {
        const int s = xcd + 8 * pass;
        const bf16* Us = (const bf16*)(ws + WS_U16) + 64 * s + 8 * cj;
        for (int t = wx; t < NTOK; t += NWX) {
            const v4u xs = *(const v4u*)(XN2 + (size_t)t * 1024 + 64 * s + 8 * cj);
            const unsigned xx = xs.x, xy = xs.y, xz = xs.z, xw = xs.w;
            const v4u* idp = (const v4u*)(IDS + (size_t)t * 128 + 16 * eg);
            int ids[16];
#pragma unroll
            for (int q = 0; q < 4; ++q) { const v4u iv = idp[q]; ids[4 * q] = (int)iv.x; ids[4 * q + 1] = (int)iv.y; ids[4 * q + 2] = (int)iv.z; ids[4 * q + 3] = (int)iv.w; }
            v4u u[16];
#pragma unroll
            for (int i = 0; i < 16; ++i) u[i] = *(const v4u*)(Us + (size_t)ids[i] * 1024);
            float k0 = 0.f, k1 = 0.f;
#pragma unroll
            for (int i = 0; i < 16; ++i) {
                const unsigned ux = u[i].x, uy = u[i].y, uz = u[i].z, uw = u[i].w;
                float d = __builtin_amdgcn_fdot2_f32_bf16(__builtin_bit_cast(bf16x2_t, ux), __builtin_bit_cast(bf16x2_t, xx), 0.f, false);
                d = __builtin_amdgcn_fdot2_f32_bf16(__builtin_bit_cast(bf16x2_t, uy), __builtin_bit_cast(bf16x2_t, xy), d, false);
                d = __builtin_amdgcn_fdot2_f32_bf16(__builtin_bit_cast(bf16x2_t, uz), __builtin_bit_cast(bf16x2_t, xz), d, false);
                d = __builtin_amdgcn_fdot2_f32_bf16(__builtin_bit_cast(bf16x2_t, uw), __builtin_bit_cast(bf16x2_t, xw), d, false);
                d = dpp_sum8(d);
                if (i < 8) k0 = (cj == i) ? d : k0; else k1 = (cj == i - 8) ? d : k1;
            }
            float* po = PART + ((size_t)s * NTOK + t) * 128 + 16 * eg + cj;
            __builtin_nontemporal_store(k0, po); __builtin_nontemporal_store(k1, po + 8);
        }
    }
}
__device__ __forceinline__ void p12b_combine(const Params& p, int vcu, int G, int wave, int lane) {
    unsigned char* ws = p.ws;
    const int gw = vcu * NWAVES + wave, NGW = G * NWAVES;
    const float* PART = (const float*)(ws + WS_PART); float* GW = (float*)(ws + WS_GATES);
    for (int t = gw; t < NTOK; t += NGW) {
        float h0 = 0.f, h1 = 0.f;
#pragma unroll
        for (int s = 0; s < 16; ++s) { const float* pp = PART + ((size_t)s * NTOK + t) * 128; h0 += __builtin_nontemporal_load(pp + lane); h1 += __builtin_nontemporal_load(pp + lane + 64); }
        float* g = GW + (size_t)t * 128;
        const float g0 = g[lane], g1 = g[lane + 64];
        g[lane] = g0 * 0.5f * h0 * (1.0f + erff(h0 * 0.70710678118654752f));
        g[lane + 64] = g1 * 0.5f * h1 * (1.0f + erff(h1 * 0.70710678118654752f));
    }
}
__device__ __forceinline__ void p12c_output(const Params& p, int bid, int G, int wave, int lane) {
    unsigned char* ws = p.ws;
    const int xcd = bid & 7, wx = (bid >> 3) * NWAVES + wave, NWX = (G >> 3) * NWAVES;
    const int eg = lane >> 3, cj = lane & 7;
    const int b5 = (lane >> 5) & 1, b4 = (lane >> 4) & 1, b3 = (lane >> 3) & 1;
    const int* IDS = (const int*)(ws + WS_IDS); const float* GW = (const float*)(ws + WS_GATES);
#pragma unroll 1
    for (int pass = 0; pass < 2; ++pass) {
        const int s = xcd + 8 * pass;
        const bf16* Vs = (const bf16*)(ws + WS_V16) + 64 * s + 8 * cj;
        const int ocol = 64 * s + 8 * cj + 4 * b5 + 2 * b4 + b3;
        for (int t = wx; t < NTOK; t += NWX) {
            const v4u* idp = (const v4u*)(IDS + (size_t)t * 128 + 16 * eg); const f32x4* wp = (const f32x4*)(GW + (size_t)t * 128 + 16 * eg);
            int ids[16]; float w[16];
#pragma unroll
            for (int q = 0; q < 4; ++q) { const v4u iv = idp[q]; ids[4 * q] = (int)iv.x; ids[4 * q + 1] = (int)iv.y; ids[4 * q + 2] = (int)iv.z; ids[4 * q + 3] = (int)iv.w;
                const f32x4 wv = wp[q]; w[4 * q] = wv.x; w[4 * q + 1] = wv.y; w[4 * q + 2] = wv.z; w[4 * q + 3] = wv.w; }
            const float hres = __builtin_nontemporal_load(p.out + (size_t)t * 1024 + ocol);
            v4u vv[16];
#pragma unroll
            for (int i = 0; i < 16; ++i) vv[i] = *(const v4u*)(Vs + (size_t)ids[i] * 1024);
            float o[8];
#pragma unroll
            for (int k = 0; k < 8; ++k) o[k] = 0.f;
#pragma unroll
            for (int i = 0; i < 16; ++i) { float f[8]; unpack8(vv[i], f);
#pragma unroll
                for (int k = 0; k < 8; ++k) o[k] = fmaf(w[i], f[k], o[k]); }
            float r4[4], r2[2];
#pragma unroll
            for (int j = 0; j < 4; ++j) { const float keep = b5 ? o[4 + j] : o[j], send = b5 ? o[j] : o[4 + j]; r4[j] = keep + __shfl_xor(send, 32); }
#pragma unroll
            for (int j = 0; j < 2; ++j) { const float keep = b4 ? r4[2 + j] : r4[j], send = b4 ? r4[j] : r4[2 + j]; r2[j] = keep + __shfl_xor(send, 16); }
            const float keep = b3 ? r2[1] : r2[0], send = b3 ? r2[0] : r2[1];
            const float tot = keep + __shfl_xor(send, 8);
            __builtin_nontemporal_store(hres + tot, p.out + (size_t)t * 1024 + ocol);
        }
    }
}

#if DIAG
constexpr size_t WS_DIAG = 1006 * MiB;
constexpr size_t WS_DSAVE = 1007 * MiB;
__device__ __forceinline__ unsigned dhash(unsigned x) { x ^= x >> 16; x *= 0x7feb352dU; x ^= x >> 15; x *= 0x846ca68bU; x ^= x >> 16; return x; }
__device__ __forceinline__ float bf2f(bf16 b) { return __builtin_bit_cast(float, (unsigned)b << 16); }
__device__ __forceinline__ float rbf(float x) { return bf2f((bf16)f2bf(x)); }
__device__ __forceinline__ void diag_report(const Params& p, int stage, float err) {
    if (!(err == err)) err = 1e30f;
#pragma unroll
    for (int o = 1; o < 64; o <<= 1) err = fmaxf(err, __shfl_xor(err, o));
    int t_ = threadIdx.x; asm volatile("" : "+v"(t_)); if ((t_ & 63) == 0) atomicMax((unsigned*)(p.ws + WS_DIAG) + stage, __builtin_bit_cast(unsigned, err));
}
#define DG_IDS() int tid_ = threadIdx.x; asm volatile("" : "+v"(tid_)); const int tid = tid_, lane = tid & 63; int G_ = gridDim.x; asm volatile("" : "+s"(G_)); const int gt = blockIdx.x * NTHREADS + tid, NGT = G_ * NTHREADS; const int gwv = gt >> 6, NGWV = NGT >> 6; (void)lane; (void)gwv; (void)NGWV; (void)NGT
__device__ __forceinline__ float relerr(float got, float ref, float fl) { return fabsf(got - ref) / (fabsf(ref) + fl); }

__device__ __forceinline__ void dg_p0(const Params& p) {
    DG_IDS(); unsigned char* ws = p.ws; float e1 = 0.f, e2 = 0.f;
    for (int s = gwv; s < 4096; s += NGWV) {
        const int m = dhash(s * 7 + 1) % R; const int b = m / TP, pp = m - b * TP;
        const bf16* xn = (const bf16*)(ws + WS_XN) + (size_t)m * 1024;
        if (pp < 48) { for (int c = lane; c < 1024; c += 64) e1 = fmaxf(e1, fabsf(bf2f(xn[c]))); continue; }
        const float* xr = (pp < 64) ? p.in[I_META] + (size_t)(pp - 48) * 1024 : p.in[I_X] + ((size_t)b * SEQ + (pp - 64)) * 1024;
        float ss = 0.f; for (int c = lane; c < 1024; c += 64) ss += xr[c] * xr[c];
        ss = wave_sum(ss); const float rs = 1.0f / sqrtf(ss / 1024.f + NORM_EPS);
        for (int c = lane; c < 1024; c += 64) e1 = fmaxf(e1, relerr(bf2f(xn[c]), xr[c] * rs * p.in[I_N1G][c], 0.05f));
    }
    for (int s = gt; s < 200000; s += NGT) {
        const unsigned hsh = dhash(s * 3 + 5); const int k = hsh & 1023, n = (hsh >> 10) % N1; const int sc = win_src_col(n);
        const float ref = sc >= 0 ? p.in[I_WIN][(size_t)k * IN_COLS + sc] : 0.f;
        e2 = fmaxf(e2, fabsf(bf2f(((const bf16*)(ws + WS_WTIN))[(size_t)n * 1024 + k]) - rbf(ref)));
        const int n2 = (hsh >> 10) & 2047;
        e2 = fmaxf(e2, fabsf(bf2f(((const bf16*)(ws + WS_WTQ))[(size_t)n2 * 1024 + k]) - rbf(p.in[I_PWQ][(size_t)k * 2048 + n2])));
        const int n3 = n2 & 1023, k3 = k & 511;
        e2 = fmaxf(e2, fabsf(bf2f(((const bf16*)(ws + WS_WTFOX))[(size_t)n3 * 512 + k3]) - rbf(p.in[I_WFOX][(size_t)k3 * 1024 + n3])));
        e2 = fmaxf(e2, fabsf(bf2f(((const bf16*)(ws + WS_WTRWKV))[(size_t)n3 * 512 + k3]) - rbf(p.in[I_WRWKV][(size_t)k3 * 1024 + n3])));
        e2 = fmaxf(e2, fabsf(bf2f(((const bf16*)(ws + WS_WTOUT))[(size_t)n3 * 1024 + k]) - rbf(p.in[I_WOUT][(size_t)k * 1024 + n3])));
        const size_t ei = (size_t)(hsh % (16384u * 1024u));
        e2 = fmaxf(e2, fabsf(bf2f(((const bf16*)(ws + WS_U16))[ei]) - rbf(p.in[I_PU][ei])));
        e2 = fmaxf(e2, fabsf(bf2f(((const bf16*)(ws + WS_V16))[ei]) - rbf(p.in[I_PV][ei])));
    }
    diag_report(p, 1, e1 / 0.03f); diag_report(p, 2, e2 / 1e-6f);
}
__device__ __forceinline__ float dg_dot(const bf16* A, size_t row, const bf16* Bt, size_t n, int K) {
    const bf16* a = A + row * K; const bf16* b = Bt + n * K; float s = 0.f;
    for (int k = 0; k < K; k += 8) { float x[8], y[8]; unpack8(*(const v4u*)(a + k), x); unpack8(*(const v4u*)(b + k), y);
#pragma unroll
        for (int e = 0; e < 8; ++e) s = fmaf(x[e], y[e], s); }
    return s;
}
__device__ __forceinline__ void dg_gemm1(const Params& p) {
    DG_IDS(); unsigned char* ws = p.ws; float e = 0.f;
    for (int s = gt; s < 262144; s += NGT) {
        const unsigned hsh = dhash(s * 11 + 3); const int row = hsh % R, n = dhash(hsh) % N1;
        const float ref = dg_dot((const bf16*)(ws + WS_XN), row, (const bf16*)(ws + WS_WTIN), n, 1024);
        float got, want;
        if (n < 3584) { got = bf2f(((const bf16*)(ws + WS_F))[(size_t)(n >> 9) * ((size_t)R * 512) + (size_t)row * 512 + (n & 511)]); want = ref; }
        else { got = bf2f(((const bf16*)(ws + WS_ZG))[(size_t)row * 2048 + (n - 3584)]); want = 1.0f / (1.0f + expf(-ref)); }
        e = fmaxf(e, relerr(got, want, 0.25f));
    }
    diag_report(p, 3, e / 0.02f);
}
__device__ __forceinline__ void dg_p2(const Params& p) {
    DG_IDS(); unsigned char* ws = p.ws; float e = 0.f;
    for (int s = gt; s < 262144; s += NGT) {
        const unsigned hsh = dhash(s * 13 + 7); const int m = hsh % R, c = dhash(hsh) % 296; const int pp = m % TP;
        const bf16* zm = (const bf16*)(ws + WS_ZM);
        const float z = bf2f(zm[(size_t)m * 512 + c]);
        if (c >= 288) { const float x = z + p.in[I_FBIAS][c - 288]; const float want = -log1pf(expf(-x)); e = fmaxf(e, relerr(((const float*)(ws + WS_LF))[(size_t)m * 8 + (c - 288)], want, 0.01f)); continue; }
        const float zp = pp > 0 ? bf2f(zm[(size_t)(m - 1) * 512 + c]) : 0.f; const float mu = p.in[I_MU][1536 + c];
        const float zs = z + mu * (zp - z);
        if (c < 64) e = fmaxf(e, relerr(bf2f(((const bf16*)(ws + WS_LA))[(size_t)m * 128 + c]), tanhf(zs), 0.1f));
        else if (c < 128) e = fmaxf(e, relerr(bf2f(((const bf16*)(ws + WS_LA))[(size_t)m * 128 + c]), zs, 0.1f));
        else e = fmaxf(e, relerr(bf2f(((const bf16*)(ws + WS_LG))[(size_t)m * 256 + (c - 128)]), 1.0f / (1.0f + expf(-zs)), 0.1f));
        if (pp >= 48) { const int h = c & 7; float sq = 0.f, sk = 0.f;
            for (int d = 0; d < 64; ++d) { const float q = bf2f(((const bf16*)(ws + WS_FQ))[(size_t)m * 512 + h * 64 + d]) / (p.in[I_FQN][h * 64 + d] * attn_body::C2); sq += q * q;
                const float k = bf2f(((const bf16*)(ws + WS_FK))[(size_t)m * 512 + h * 64 + d]) / p.in[I_FKN][h * 64 + d]; sk += k * k; }
            e = fmaxf(e, fabsf(sq / 64.f - 1.f)); e = fmaxf(e, fabsf(sk / 64.f - 1.f)); }
    }
    diag_report(p, 4, e / 0.03f);
}
__device__ __forceinline__ void dg_p3(const Params& p) {
    DG_IDS(); unsigned char* ws = p.ws; unsigned char* dob = (unsigned char*)p.out; float e5 = 0.f, e6 = 0.f;
    for (int s = gt; s < 131072; s += NGT) {
        const unsigned hsh = dhash(s * 17 + 9); const int seq = hsh & 127, pp = (hsh >> 7) % TP; const int b = seq >> 3, h = seq & 7;
        const float* kb = (const float*)(ws + WS_KB) + (size_t)seq * TP; const float lf = ((const float*)(ws + WS_LF))[((size_t)b * TP + pp) * 8 + h];
        if (pp < 48) e5 = fmaxf(e5, kb[pp] < -1e29f ? 0.f : 1.f);
        else if (pp == 48) e5 = fmaxf(e5, fabsf(kb[pp] + lf * LOG2E));
        else e5 = fmaxf(e5, fabsf((kb[pp] - kb[pp - 1]) + lf * LOG2E));
        const int m = dhash(hsh) % R, c = dhash(hsh + 1) % 1536;
        const bf16* la = (const bf16*)(ws + WS_LA) + (size_t)m * 128; const bf16* lg = (const bf16*)(ws + WS_LG) + (size_t)m * 256;
        if (c < 512) { float a = p.in[I_W0][c]; for (int k = 0; k < 64; ++k) a += bf2f(la[k]) * rbf(p.in[I_WUP][k * 512 + c]);
            const float w = -log1pf(expf(-a)) - 0.5f; const float want = 1.0f - expf(-expf(w));
            e6 = fmaxf(e6, relerr(bf2f(((const bf16*)(dob + DO_XW))[(size_t)m * 512 + c]), want, 0.002f)); }
        else if (c < 1024) { float a = p.in[I_A0][c - 512]; for (int k = 0; k < 64; ++k) a += bf2f(la[64 + k]) * rbf(p.in[I_AUP][k * 512 + (c - 512)]);
            e6 = fmaxf(e6, relerr(bf2f(((const bf16*)(dob + DO_AA))[(size_t)m * 512 + (c - 512)]), 1.0f / (1.0f + expf(-a)), 0.05f)); }
        else { float a = 0.f; for (int k = 0; k < 160; ++k) a += bf2f(lg[k]) * rbf(p.in[I_GUP][k * 512 + (c - 1024)]);
            e6 = fmaxf(e6, relerr(bf2f(((const bf16*)(dob + DO_GG))[(size_t)m * 512 + (c - 1024)]), a, 0.1f)); }
    }
    diag_report(p, 5, e5 / 1e-3f); diag_report(p, 6, e6 / 0.03f);
}
constexpr int DG_NS4 = 2048;
__device__ __forceinline__ void dg_p4_pre(const Params& p) {
    DG_IDS(); unsigned char* dob = (unsigned char*)p.out; float* sv = (float*)(p.ws + WS_DSAVE);
    for (int s = gt; s < DG_NS4 * 64; s += NGT) { const int i = s >> 6, d = s & 63; const unsigned hsh = dhash(i * 19 + 11); const int m = hsh % R, h = (hsh >> 20) & 7;
        sv[s] = bf2f(((const bf16*)(dob + DO_AA))[(size_t)m * 512 + h * 64 + d]); }
}
__device__ __forceinline__ void dg_p4_post(const Params& p) {
    DG_IDS(); unsigned char* ws = p.ws; unsigned char* dob = (unsigned char*)p.out; const float* sv = (const float*)(ws + WS_DSAVE); float e = 0.f;
    for (int i = gwv; i < DG_NS4; i += NGWV) {
        const unsigned hsh = dhash(i * 19 + 11); const int m = hsh % R, h = (hsh >> 20) & 7; const int pp = m % TP; const int c = h * 64 + lane;
        const float a = sv[i * 64 + lane];
        const float r0 = bf2f(((const bf16*)(ws + WS_ZRR))[(size_t)m * 512 + c]), k0 = bf2f(((const bf16*)(ws + WS_ZRK))[(size_t)m * 512 + c]);
        const float r1 = pp > 0 ? bf2f(((const bf16*)(ws + WS_ZRR))[(size_t)(m - 1) * 512 + c]) : 0.f, k1 = pp > 0 ? bf2f(((const bf16*)(ws + WS_ZRK))[(size_t)(m - 1) * 512 + c]) : 0.f;
        const float rs = r0 + p.in[I_MU][c] * (r1 - r0), ks = k0 + p.in[I_MU][512 + c] * (k1 - k0);
        const float kk = ks * p.in[I_KK][c], kp = ks * (1.0f + (a - 1.0f) * p.in[I_KA][c]);
        const float nrm = fmaxf(sqrtf(wave_sum(kk * kk)), 1e-12f); const float kn = kk / nrm, bb = kn * a; const float bs = wave_sum(rs * kp * p.in[I_RK][c]);
        e = fmaxf(e, relerr(bf2f(((const bf16*)(ws + WS_KP))[(size_t)m * 512 + c]), kp, 0.1f));
        e = fmaxf(e, relerr(bf2f(((const bf16*)(ws + WS_KN))[(size_t)m * 512 + c]), kn, 0.02f));
        e = fmaxf(e, relerr(bf2f(((const bf16*)(dob + DO_AA))[(size_t)m * 512 + c]), bb, 0.02f));
        e = fmaxf(e, relerr(((const float*)(ws + WS_BS))[(size_t)m * 8 + h], bs, 0.1f));
    }
    diag_report(p, 7, e / 0.03f);
}
constexpr int DG_NS8 = 1024;
__device__ __forceinline__ void dg_attn_sample(int i, int& b, int& h, int& t) { const unsigned hsh = dhash(i * 23 + 13); b = hsh & 15; h = (hsh >> 4) & 7; t = (hsh >> 8) & 4095; if (i < 8) t = (i & 1) ? 4095 - (i >> 1) : (i >> 1); }
__device__ __forceinline__ void dg_attn_pre(const Params& p) {
    DG_IDS(); float* sv = (float*)(p.ws + WS_DSAVE + 512 * 1024);
    for (int s = gt; s < DG_NS8 * 64; s += NGT) { const int i = s >> 6, d = s & 63; int b, h, t; dg_attn_sample(i, b, h, t);
        sv[s] = bf2f(((const bf16*)(p.ws + WS_FQ))[((size_t)b * TP + 64 + t) * 512 + h * 64 + d]); }
}
__device__ __forceinline__ void dg_attn_post(const Params& p) {
    DG_IDS(); unsigned char* ws = p.ws; const float* sv = (const float*)(ws + WS_DSAVE + 512 * 1024); float e = 0.f;
    for (int i = gwv; i < DG_NS8; i += NGWV) {
        int b, h, t; dg_attn_sample(i, b, h, t);
        const int npos = 64 + t;
        const float* kb = (const float*)(ws + WS_KB) + (size_t)(b * 8 + h) * TP;
        const bf16* K = (const bf16*)(ws + WS_FK) + (size_t)b * TP * 512 + h * 64; const bf16* V = (const bf16*)(ws + WS_FV) + (size_t)b * TP * 512 + h * 64;
        float mx = -1e38f;
        for (int j = 48 + lane; j <= npos; j += 64) { float s = 0.f; for (int d = 0; d < 64; ++d) s += sv[i * 64 + d] * bf2f(K[(size_t)j * 512 + d]); s += kb[j]; mx = fmaxf(mx, s); }
        for (int o = 1; o < 64; o <<= 1) mx = fmaxf(mx, __shfl_xor(mx, o));
        float l = 0.f, acc = 0.f;
        for (int j = 48; j <= npos; ++j) { float s = 0.f; for (int d = 0; d < 64; ++d) s += sv[i * 64 + d] * bf2f(K[(size_t)j * 512 + d]); const float pj = exp2f(s + kb[j] - mx); l += pj; acc += pj * bf2f(V[(size_t)j * 512 + lane]); }
        const float want = acc / l; const float got = bf2f(((const bf16*)(ws + WS_FQ))[((size_t)b * TP + 64 + t) * 512 + h * 64 + lane]);
        e = fmaxf(e, fabsf(got - want) / (fabsf(want) + 0.05f));
    }
    diag_report(p, 8, e / 0.05f);
}
__device__ __forceinline__ void dg_scan(const Params& p) {
    DG_IDS(); unsigned char* ws = p.ws; unsigned char* dob = (unsigned char*)p.out; float e = 0.f;
    if (gwv < 4) {
        const int bh = (gwv * 37 + 5) & 127, b = bh >> 3, h = bh & 7; const size_t rowb = (size_t)b * TP; const int cb = h * 64;
        float S[64];
#pragma unroll
        for (int k = 0; k < 64; ++k) S[k] = 0.f;
        const bf16* aXW = (const bf16*)(dob + DO_XW); const bf16* aKN = (const bf16*)(ws + WS_KN); const bf16* aBB = (const bf16*)(dob + DO_AA); const bf16* aKP = (const bf16*)(ws + WS_KP);
        const bf16* aR = (const bf16*)(ws + WS_ZRR); const bf16* aV = (const bf16*)(ws + WS_ZRV);
        const float muv = p.in[I_MU][1024 + cb + lane];
        for (int pp = 48; pp < TP; ++pp) {
            const size_t ro = (rowb + pp) * 512 + cb;
            const float v0 = bf2f(aV[ro + lane]), v1 = bf2f(aV[ro - 512 + lane]); const float vv = v0 + muv * (v1 - v0);
            float sa = 0.f;
#pragma unroll
            for (int k = 0; k < 64; ++k) sa += S[k] * bf2f(aKN[ro + k]);
            sa = -sa; float y = 0.f;
#pragma unroll
            for (int k = 0; k < 64; ++k) { const float dec = 1.0f - bf2f(aXW[ro + k]); S[k] = S[k] * dec + sa * bf2f(aBB[ro + k]) + vv * bf2f(aKP[ro + k]);
                const float r0 = bf2f(aR[ro + k]), r1 = bf2f(aR[ro - 512 + k]); y += S[k] * (r0 + p.in[I_MU][cb + k] * (r1 - r0)); }
            const float got = bf2f(((const bf16*)(ws + WS_Y))[ro + lane]);
            e = fmaxf(e, fabsf(got - y) / (fabsf(y) + 0.3f));
        }
    }
    diag_report(p, 9, e / 0.05f);
}
__device__ __forceinline__ void dg_p6_pre(const Params& p) {
    DG_IDS(); float* sv = (float*)(p.ws + WS_DSAVE + 768 * 1024);
    for (int s = gt; s < DG_NS4 * 64; s += NGT) { const int i = s >> 6, d = s & 63; const unsigned hsh = dhash(i * 29 + 17); const int m = hsh % R, h = (hsh >> 20) & 7;
        sv[s] = bf2f(((const bf16*)(p.ws + WS_Y))[(size_t)m * 512 + h * 64 + d]); }
}
__device__ __forceinline__ void dg_p6_post(const Params& p) {
    DG_IDS(); unsigned char* ws = p.ws; unsigned char* dob = (unsigned char*)p.out; const float* sv = (const float*)(ws + WS_DSAVE + 768 * 1024); float e = 0.f;
    for (int i = gwv; i < DG_NS4; i += NGWV) {
        const unsigned hsh = dhash(i * 29 + 17); const int m = hsh % R, h = (hsh >> 20) & 7; const int pp = m % TP; const int c = h * 64 + lane;
        if (pp < 48) continue;
        const float y = sv[i * 64 + lane]; const float mean = wave_sum(y) / 64.f; const float var = wave_sum((y - mean) * (y - mean)) / 64.f;
        const float gn = (y - mean) / sqrtf(var + GN_EPS) * p.in[I_LNG][c] + p.in[I_LNB][c];
        const float v0 = bf2f(((const bf16*)(ws + WS_ZRV))[(size_t)m * 512 + c]), v1 = bf2f(((const bf16*)(ws + WS_ZRV))[(size_t)(m - 1) * 512 + c]);
        const float vs = v0 + p.in[I_MU][1024 + c] * (v1 - v0);
        const float want = (gn + ((const float*)(ws + WS_BS))[(size_t)m * 8 + h] * vs) * bf2f(((const bf16*)(dob + DO_GG))[(size_t)m * 512 + c]);
        e = fmaxf(e, relerr(bf2f(((const bf16*)(ws + WS_Y))[(size_t)m * 512 + c]), want, 0.1f));
    }
    diag_report(p, 10, e / 0.03f);
}
__device__ __forceinline__ void dg_mix(const Params& p, int stage) {
    DG_IDS(); unsigned char* ws = p.ws; float e = 0.f;
    for (int s = gt; s < 131072; s += NGT) {
        const unsigned hsh = dhash(s * 31 + 19 + stage); const int row = hsh % R, c = dhash(hsh) & 1023;
        float want = dg_dot((const bf16*)(ws + WS_FQ), row, (const bf16*)(ws + WS_WTFOX), c, 512) * bf2f(((const bf16*)(ws + WS_ZG))[(size_t)row * 2048 + c]);
        if (stage == 12) want = rbf(want) + dg_dot((const bf16*)(ws + WS_Y), row, (const bf16*)(ws + WS_WTRWKV), c, 512) * bf2f(((const bf16*)(ws + WS_ZG))[(size_t)row * 2048 + 1024 + c]);
        e = fmaxf(e, relerr(bf2f(((const bf16*)(ws + WS_MIX))[(size_t)row * 1024 + c]), want, 0.1f));
    }
    diag_report(p, stage, e / 0.03f);
}
__device__ __forceinline__ void dg_out(const Params& p) {
    DG_IDS(); unsigned char* ws = p.ws; float e = 0.f;
    for (int s = gt; s < 131072; s += NGT) {
        const unsigned hsh = dhash(s * 37 + 23); const int tok = hsh & 65535, c = dhash(hsh) & 1023; const int b = tok >> 12, t = tok & 4095;
        const float want = p.in[I_X][(size_t)tok * 1024 + c] + dg_dot((const bf16*)(ws + WS_MIX), (size_t)b * TP + 64 + t, (const bf16*)(ws + WS_WTOUT), c, 1024);
        e = fmaxf(e, relerr(p.out[(size_t)tok * 1024 + c], want, 0.3f));
    }
    diag_report(p, 13, e / 0.01f);
}
__device__ __forceinline__ void dg_norm2(const Params& p) {
    DG_IDS(); unsigned char* ws = p.ws; float e = 0.f;
    for (int s = gwv; s < 4096; s += NGWV) {
        const int m = dhash(s * 41 + 29) & 65535; const float* xr = p.out + (size_t)m * 1024;
        float ss = 0.f; for (int c = lane; c < 1024; c += 64) ss += xr[c] * xr[c];
        ss = wave_sum(ss); const float rs = 1.0f / sqrtf(ss / 1024.f + NORM_EPS);
        for (int c = lane; c < 1024; c += 64) e = fmaxf(e, relerr(bf2f(((const bf16*)(ws + WS_XN2))[(size_t)m * 1024 + c]), xr[c] * rs * p.in[I_N2G][c], 0.05f));
    }
    diag_report(p, 14, e / 0.03f);
}
__device__ __forceinline__ void dg_pq(const Params& p) {
    DG_IDS(); unsigned char* ws = p.ws; float e = 0.f;
    for (int s = gt; s < 131072; s += NGT) {
        const unsigned hsh = dhash(s * 43 + 31); const int tok = hsh & 65535, c = dhash(hsh) & 2047;
        const float want = dg_dot((const bf16*)(ws + WS_XN2), tok, (const bf16*)(ws + WS_WTQ), c, 1024);
        e = fmaxf(e, relerr(bf2f(((const bf16*)(ws + WS_PQ))[(size_t)tok * 2048 + c]), want, 0.25f));
    }
    diag_report(p, 15, e / 0.02f);
}
__device__ __forceinline__ void dg_route(const Params& p, LAS unsigned char* lds) {
    DG_IDS(); unsigned char* ws = p.ws; float e16 = 0.f, e17 = 0.f;
    LAS float* s2l = (LAS float*)lds + (tid >> 6) * 128;
    for (int i = gwv; i < 2048; i += NGWV) {
        const unsigned hsh = dhash(i * 47 + 37); const int tok = hsh & 65535, h = (hsh >> 16) & 7;
        const bf16* q = (const bf16*)(ws + WS_PQ) + (size_t)tok * 2048 + h * 256; const bf16* ks = (const bf16*)(ws + WS_KS);
        float s1a = 0.f, s1b = 0.f, s2a = 0.f, s2b = 0.f;
        for (int d = 0; d < 128; ++d) { const float q1 = bf2f(q[d]), q2 = bf2f(q[128 + d]);
            s1a += q1 * bf2f(ks[(size_t)lane * 128 + d]); s1b += q1 * bf2f(ks[(size_t)(lane + 64) * 128 + d]);
            s2a += q2 * bf2f(ks[(size_t)(128 + lane) * 128 + d]); s2b += q2 * bf2f(ks[(size_t)(192 + lane) * 128 + d]); }
        s2l[lane] = s2a; s2l[lane + 64] = s2b; asm volatile("s_waitcnt lgkmcnt(0)" ::: "memory");
        float prev_s = 3e38f; int prev_id = -1; float top_s[16]; int top_id[16];
#pragma unroll 1
        for (int r = 0; r < 16; ++r) {
            float bs = -3e38f; int bi = 0x7fffffff;
            for (int j = 0; j < 128; ++j) { const float t2 = s2l[j];
                { const float sm = s1a + t2; const int id = lane * 128 + j; const bool ok = (sm < prev_s) || (sm == prev_s && id > prev_id); if (ok && (sm > bs || (sm == bs && id < bi))) { bs = sm; bi = id; } }
                { const float sm = s1b + t2; const int id = (lane + 64) * 128 + j; const bool ok = (sm < prev_s) || (sm == prev_s && id > prev_id); if (ok && (sm > bs || (sm == bs && id < bi))) { bs = sm; bi = id; } } }
            for (int o = 1; o < 64; o <<= 1) { const float os = __shfl_xor(bs, o); const int oi = __shfl_xor(bi, o); if (os > bs || (os == bs && oi < bi)) { bs = os; bi = oi; } }
            top_s[r] = bs; top_id[r] = bi; prev_s = bs; prev_id = bi;
        }
        const int* ids = (const int*)(ws + WS_IDS) + (size_t)tok * 128 + h * 16; const float* gts = (const float*)(ws + WS_GATES) + (size_t)tok * 128 + h * 16;
        float den = 0.f;
#pragma unroll
        for (int r = 0; r < 16; ++r) den += expf(top_s[r] - top_s[0]);
        int miss = 0;
#pragma unroll
        for (int r = 0; r < 16; ++r) {
            bool found = false; for (int k = 0; k < 16; ++k) found |= (ids[k] == top_id[r]);
            if (!found && top_s[r] > top_s[15] + 2e-3f * fabsf(top_s[15]) + 1e-4f) ++miss;
            e17 = fmaxf(e17, fabsf(gts[r] - expf(top_s[r] - top_s[0]) / den));
        }
        e16 = fmaxf(e16, (float)miss);
        if (lane == 0 && miss) atomicAdd((float*)(ws + WS_DIAG) + 19, (float)miss);
    }
    diag_report(p, 16, e16 / 0.5f); diag_report(p, 17, e17 / 0.01f);
}
constexpr int DG_NS18 = 128;
__device__ __forceinline__ void dg_gather_pre(const Params& p) {
    DG_IDS(); float* sv = (float*)(p.ws + WS_DSAVE + 1280 * 1024);
    for (int s = gt; s < DG_NS18 * 1024; s += NGT) { const int i = s >> 10, c = s & 1023; const int tok = dhash(i * 53 + 41) & 65535; sv[s] = p.out[(size_t)tok * 1024 + c]; }
    for (int s = gt; s < DG_NS18 * 128; s += NGT) { const int i = s >> 7, ex = s & 127; const int tok = dhash(i * 53 + 41) & 65535; sv[DG_NS18 * 1024 + s] = ((const float*)(p.ws + WS_GATES))[(size_t)tok * 128 + ex]; }
}
__device__ __forceinline__ void dg_gather_post(const Params& p) {
    DG_IDS(); unsigned char* ws = p.ws; const float* sv = (const float*)(ws + WS_DSAVE + 1280 * 1024); float e = 0.f;
    for (int i = gwv; i < DG_NS18; i += NGWV) {
        const int tok = dhash(i * 53 + 41) & 65535;
        const int* ids = (const int*)(ws + WS_IDS) + (size_t)tok * 128; const float* gts = (const float*)(ws + WS_GATES) + (size_t)tok * 128;
        const bf16* xn = (const bf16*)(ws + WS_XN2) + (size_t)tok * 1024;
        float o[16];
#pragma unroll
        for (int k = 0; k < 16; ++k) o[k] = 0.f;
        for (int ex = 0; ex < 128; ++ex) {
            const int id = ids[ex]; const bf16* ur = (const bf16*)(ws + WS_U16) + (size_t)id * 1024; const bf16* vr = (const bf16*)(ws + WS_V16) + (size_t)id * 1024;
            float d = 0.f;
#pragma unroll
            for (int k = 0; k < 16; ++k) d += bf2f(ur[lane * 16 + k]) * bf2f(xn[lane * 16 + k]);
            d = wave_sum(d); const float w = gts[ex]; (void)d;
            e = fmaxf(e, fabsf(w - sv[DG_NS18 * 1024 + i * 128 + ex] * 0.5f * d * (1.0f + erff(d * 0.70710678f))) / 0.02f * 0.05f);
#pragma unroll
            for (int k = 0; k < 16; ++k) o[k] += w * bf2f(vr[lane * 16 + k]);
        }
        float ss = 0.f;
#pragma unroll
        for (int k = 0; k < 16; ++k) ss += o[k] * o[k];
        const float rms = sqrtf(wave_sum(ss) / 1024.f);
#pragma unroll
        for (int k = 0; k < 16; ++k) e = fmaxf(e, fabsf((p.out[(size_t)tok * 1024 + lane * 16 + k] - sv[i * 1024 + lane * 16 + k]) - o[k]) / (rms + 1e-3f));
    }
    diag_report(p, 18, e / 0.05f);
}
__device__ __forceinline__ void dg_final(const Params& p) {
    DG_IDS(); const float* dg = (const float*)(p.ws + WS_DIAG);
    int k = 0;
    for (int s = 1; s <= 18; ++s) if (k == 0 && !(dg[s] <= 1.0f)) k = s;
#ifdef DIAG_SKIP
    { int kk = 0; for (int s = 1; s <= 18; ++s) if (kk == 0 && s > DIAG_SKIP && !(dg[s] <= 1.0f)) kk = s; k = kk; }
#endif
#ifdef DIAG_VALUE
    const float a = fminf(fmaxf(dg[DIAG_VALUE], 1e-3f), 1e6f) * 16.f;
#else
    const float a = exp2f((float)k);
#endif
    for (size_t i = gt; i < (size_t)NTOK * 1024 / 4; i += NGT) ((f32x4*)p.out)[i] = (f32x4){a, a, a, a};
}
#endif

#define XB_TMO      128
#define XB_XCNT(j)  (256  + 64 * (j))
#define XB_XSUB(j)  (1280 + 64 * (j))
#define XB_XGEN(j)  (2304 + 64 * (j))
#define XB_TOP      3328
#define XB_TOPGEN   3392
#define XCD_BAR_WORDS 3456
#define XB_SPIN_CAP (1u << 18)

__device__ __forceinline__ unsigned xb_ld(unsigned* p)              { return __hip_atomic_load(p, __ATOMIC_RELAXED, __HIP_MEMORY_SCOPE_AGENT); }
__device__ __forceinline__ unsigned xb_add(unsigned* p, unsigned v) { return __hip_atomic_fetch_add(p, v, __ATOMIC_RELAXED, __HIP_MEMORY_SCOPE_AGENT); }
__device__ __forceinline__ unsigned xb_xcc_id() { return (unsigned)__builtin_amdgcn_s_getreg((3 << 11) | 20) & 0xFu; }
#define XB_SPIN(cond, bar) do { unsigned _sp = 0; while (cond) { __builtin_amdgcn_s_sleep(1); \
    if ((++_sp & 255u) == 0u) { if (xb_ld(&(bar)[XB_TMO])) break; if (_sp > XB_SPIN_CAP) { atomicAdd(&(bar)[XB_TMO], 1u); break; } } } } while (0)

struct XcdBarrier {
    unsigned* bar; unsigned x;
    volatile LAS unsigned* st;
};

__device__ __forceinline__ XcdBarrier xcd_barrier_post(unsigned* bar, volatile LAS unsigned* st) {
    XcdBarrier b; b.bar = bar; b.x = xb_xcc_id(); b.st = st;
    if (threadIdx.x == 0) (void)xb_add(&bar[XB_XCNT(b.x)], 1u);
    return b;
}
__device__ __forceinline__ void xcd_barrier_complete(unsigned* bar, unsigned x, unsigned& nloc, unsigned& nx) {
    const unsigned G = gridDim.x * gridDim.y * gridDim.z;
    unsigned sum, cnt, mine, sp = 0u;
    for (;;) {
        sum = 0u; cnt = 0u; mine = 0u;
#pragma unroll
        for (unsigned j = 0; j < 16; ++j) { const unsigned c = xb_ld(&bar[XB_XCNT(j)]); sum += c; cnt += (c > 0u) ? 1u : 0u; mine = (j == x) ? c : mine; }
        if (sum == G) break;
        __builtin_amdgcn_s_sleep(1);
        if ((++sp & 255u) == 0u) { if (xb_ld(&bar[XB_TMO])) break; if (sp > XB_SPIN_CAP) { atomicAdd(&bar[XB_TMO], 1u); break; } }
    }
    nloc = mine > 0u ? mine : 1u; nx = cnt > 0u ? cnt : 1u;
}

__device__ __forceinline__ void xcd_barrier(const XcdBarrier& b) {
    asm volatile("s_waitcnt vmcnt(0)" ::: "memory");
    __syncthreads();
    if (threadIdx.x == 0) {
        unsigned* bar = b.bar;
        __builtin_amdgcn_s_waitcnt(0);
        unsigned nloc = b.st[0], nx = b.st[1];
        if (nloc == 0u) { xcd_barrier_complete(bar, b.x, nloc, nx); b.st[0] = nloc; b.st[1] = nx; }
        const unsigned old = xb_add(&bar[XB_XSUB(b.x)], 1u);
        const unsigned gen = old / nloc;
        if (old + 1u == (gen + 1u) * nloc) {
            __builtin_amdgcn_fence(__ATOMIC_RELEASE, "agent");
            asm volatile("s_waitcnt vmcnt(0)" ::: "memory");
            const unsigned og = xb_add(&bar[XB_TOP], 1u);
            const unsigned tg = og / nx;
            if (og + 1u == (tg + 1u) * nx) xb_add(&bar[XB_TOPGEN], 1u);
            else XB_SPIN(xb_ld(&bar[XB_TOPGEN]) == tg, bar);
            __builtin_amdgcn_fence(__ATOMIC_ACQUIRE, "agent");
            xb_add(&bar[XB_XGEN(b.x)], 1u);
            asm volatile("s_waitcnt vmcnt(0)" ::: "memory");
        } else {
            XB_SPIN(xb_ld(&bar[XB_XGEN(b.x)]) == gen, bar);
            __builtin_amdgcn_fence(__ATOMIC_ACQUIRE, "agent");
            asm volatile("s_waitcnt vmcnt(0)" ::: "memory");
        }
    }
    __syncthreads();
}

#ifndef TIMING
#define TIMING 0
#endif
#if TIMING
#define TS(i) do { int t__ = threadIdx.x; asm volatile("" : "+v"(t__)); if (bid == 0 && t__ == 0) ((unsigned long long*)(ws + 1010 * MiB))[i] = __builtin_amdgcn_s_memrealtime(); } while (0)
#else
#define TS(i)
#endif
#if DIAG
#define DG(...) __VA_ARGS__
#else
#define DG(...)
#endif
constexpr int LDS_BYTES = 147456;
static_assert(attn_body::ATTN_LDS_BYTES <= 131072, "attention LDS");
static_assert(RT_KS_BYTES + NTHREADS * RT_TAB_WORDS * 4 <= LDS_BYTES, "routing LDS");
static_assert((SC_CH * SC_STRIDE + SC_CH * 32) * 4 <= LDS_BYTES, "scan LDS");

__global__ void __launch_bounds__(NTHREADS, 2) hybrid_fwd(Params p) {
    extern __shared__ __attribute__((aligned(16))) unsigned char lds_raw[];
    cg::grid_group grid = cg::this_grid();
    LAS unsigned char* lds = (LAS unsigned char*)lds_raw;
    const int G0 = gridDim.x, bid = blockIdx.x;
#define LANE_IDS() int tid = threadIdx.x; asm volatile("" : "+v"(tid)); const int lane = tid & 63, wave = __builtin_amdgcn_readfirstlane(tid >> 6); (void)lane; (void)wave; int G = G0; asm volatile("" : "+s"(G))
    const int vcu = (G0 % 8 == 0) ? (bid % 8) * (G0 / 8) + bid / 8 : bid;
    unsigned char* ws = p.ws; unsigned char* dob = (unsigned char*)p.out;

    DG({ int t_ = threadIdx.x; asm volatile("" : "+v"(t_)); if (bid == 0 && t_ < 64) ((float*)(ws + WS_DIAG))[t_] = 0.f; })
    unsigned* barw = (unsigned*)(ws + 65536);
    { int t__ = threadIdx.x; asm volatile("" : "+v"(t__)); if (bid == 0) for (int i = t__; i < XCD_BAR_WORDS; i += NTHREADS) __hip_atomic_store(barw + i, 0u, __ATOMIC_RELAXED, __HIP_MEMORY_SCOPE_AGENT);
      if (t__ < 2) ((volatile LAS unsigned*)(lds + LDS_BYTES - 64))[t__] = 0u; }
    __syncthreads();
    TS(0);
    { LANE_IDS(); p0_prologue(p, lds, vcu, G, wave, lane); }
    grid.sync();
    const XcdBarrier xbar = xcd_barrier_post(barw, (volatile LAS unsigned*)(lds + LDS_BYTES - 64));
#define GSYNC() xcd_barrier(xbar)
    DG(dg_p0(p);)
    TS(1);
    run_gemm(lds, (const bf16*)(ws + WS_XN), (const bf16*)(ws + WS_WTIN), R, N1, 1024, G0, bid, F_Gemm1{(bf16*)(ws + WS_F), (bf16*)(ws + WS_ZG)});
    GSYNC();
    DG(dg_gemm1(p); GSYNC();)
    TS(2);
    { LANE_IDS(); p2_prep1(p, vcu, G, wave, lane); }
    GSYNC();
    DG(dg_p2(p);)
    TS(3);
    { LANE_IDS(); const int gwv = vcu * NWAVES + wave; for (int s = gwv; s < 128; s += G * NWAVES) p3_cumsum(p, s, lane); }
    __syncthreads();
    run_gemm(lds, (const bf16*)(ws + WS_LA), (const bf16*)(ws + WS_WTWA), R, 512, 128, G0, bid, F_LoraW{(bf16*)(dob + DO_XW), p.in[I_W0]});
    run_gemm(lds, (const bf16*)(ws + WS_LA), (const bf16*)(ws + WS_WTWA) + 512 * 128, R, 512, 128, G0, bid, F_LoraA{(bf16*)(dob + DO_AA), p.in[I_A0]});
    run_gemm(lds, (const bf16*)(ws + WS_LG), (const bf16*)(ws + WS_WTG), R, 512, 256, G0, bid, F_Plain{(bf16*)(dob + DO_GG), 512});
    GSYNC();
    DG(dg_p3(p); dg_p4_pre(p); GSYNC();)
    TS(4);
    { LANE_IDS(); p4_prep2(p, vcu, G, wave, lane); }
    GSYNC();
    DG(dg_p4_post(p); dg_attn_pre(p); GSYNC();)
    TS(5);
    {
        LANE_IDS();
        const int per = (1024 + G - 1) / G;
        int last_bh = -1;
        for (int pi = vcu * per; pi < (vcu + 1) * per && pi < 1024; ++pi) {
            const int bh = pi >> 3, pr = pi & 7;
            if (bh != last_bh) {
                __syncthreads();
                const float* kbg = (const float*)(ws + WS_KB) + (size_t)bh * TP; LAS float* kbl = (LAS float*)(lds + attn_body::LDS_KB);
                for (int i = tid; i < TP; i += NTHREADS) kbl[i] = kbg[i];
                asm volatile("s_waitcnt vmcnt(0) lgkmcnt(0)" ::: "memory");
                __syncthreads();
                last_bh = bh;
            }
#pragma unroll 1
            for (int k = 0; k < 2; ++k) {
                const int qb = k ? 15 - pr : pr;
                attn_body::attn_unit<8>(bh >> 3, bh & 7, qb, (const attn_body::bf16*)(ws + WS_FQ), (const attn_body::bf16*)(ws + WS_FK), (const attn_body::bf16*)(ws + WS_FV), (attn_body::bf16*)(ws + WS_FQ), (char*)lds_raw);
            }
        }
        __syncthreads(); TS(6);
        { int tid2 = threadIdx.x; asm volatile("" : "+v"(tid2)); for (int item = vcu; item < 256; item += G0) p5_scan_item(p, lds, item, tid2, __builtin_amdgcn_readfirstlane(tid2 >> 6), tid2 & 63); }
    }
    GSYNC();
    DG(dg_attn_post(p); dg_scan(p); dg_p6_pre(p); GSYNC();)
    TS(7);
    { LANE_IDS(); p6_prep3(p, vcu, G, wave, lane); }
    GSYNC();
    DG(dg_p6_post(p);)
    TS(8);
    run_gemm(lds, (const bf16*)(ws + WS_FQ), (const bf16*)(ws + WS_WTFOX), R, 1024, 512, G0, bid, F_MixA{(bf16*)(ws + WS_MIX), (const bf16*)(ws + WS_ZG)});
    GSYNC();
    TS(9);
    DG(dg_mix(p, 11); GSYNC();)
    run_gemm(lds, (const bf16*)(ws + WS_Y), (const bf16*)(ws + WS_WTRWKV), R, 1024, 512, G0, bid, F_MixB{(bf16*)(ws + WS_MIX), (const bf16*)(ws + WS_ZG)});
    GSYNC();
    DG(dg_mix(p, 12);)
    TS(10);
    run_gemm(lds, (const bf16*)(ws + WS_MIX), (const bf16*)(ws + WS_WTOUT), R, 1024, 1024, G0, bid, F_Out{p.in[I_X], p.out});
    GSYNC();
    TS(11);
    DG(dg_out(p); GSYNC();)
    { LANE_IDS(); p9_norm2(p, vcu, G, wave, lane); }
    GSYNC();
    DG(dg_norm2(p);)
    TS(12);
    run_gemm(lds, (const bf16*)(ws + WS_XN2), (const bf16*)(ws + WS_WTQ), NTOK, 2048, 1024, G0, bid, F_Plain{(bf16*)(ws + WS_PQ), 2048});
    GSYNC();
    TS(13);
    DG(dg_pq(p);)
    { LANE_IDS(); p11_route(p, lds, vcu, G, tid, wave, lane); }
    GSYNC();
    TS(14);
    DG(__syncthreads(); dg_route(p, lds); dg_gather_pre(p); GSYNC();)
    { LANE_IDS(); p12a_partial(p, bid, G, wave, lane); }
    GSYNC();
    { LANE_IDS(); p12b_combine(p, vcu, G, wave, lane); }
    GSYNC();
    { LANE_IDS(); p12c_output(p, bid, G, wave, lane); }
    DG(GSYNC(); dg_gather_post(p); GSYNC(); dg_final(p);)
#if TIMING
    GSYNC(); TS(15); GSYNC();
    {
        const unsigned long long* ts = (const unsigned long long*)(ws + 1010 * MiB);
        const float tot = (float)(ts[15] - ts[0]);
        const float fa = 10.f * (float)(ts[TIMING_A1] - ts[TIMING_A0]) / tot;
        int t__ = threadIdx.x; asm volatile("" : "+v"(t__));
        for (size_t i = (size_t)bid * NTHREADS + t__; i < (size_t)NTOK * 1024; i += (size_t)G0 * NTHREADS) p.out[i] = fa;
    }
#endif
}

extern "C" void kernel_launch(void* const* d_in, const int* in_sizes, int n_in, void* d_out, int out_size, void* d_ws, size_t ws_size, hipStream_t stream) {
    static int grid = 0;
    if (grid == 0) {
        if (n_in != 27 || out_size != NTOK * DMODEL || ws_size < WS_END) { fprintf(stderr, "kernel_launch: unexpected shapes (n_in %d, out %d, ws %zu)\n", n_in, out_size, ws_size); grid = -1; return; }
        int dev = 0, cus = 0, per_cu = 0;
        hipGetDevice(&dev);
        hipDeviceGetAttribute(&cus, hipDeviceAttributeMultiprocessorCount, dev);
        hipFuncSetAttribute((const void*)hybrid_fwd, hipFuncAttributeMaxDynamicSharedMemorySize, LDS_BYTES);
        hipOccupancyMaxActiveBlocksPerMultiprocessor(&per_cu, (const void*)hybrid_fwd, NTHREADS, LDS_BYTES);
        if (per_cu < 1) { fprintf(stderr, "kernel_launch: occupancy query says %d blocks per CU\n", per_cu); grid = -1; return; }
        grid = cus;
    }
    if (grid < 0) return;
    Params p{};
    for (int i = 0; i < 27; ++i) p.in[i] = (const float*)d_in[i];
    p.out = (float*)d_out; p.ws = (unsigned char*)d_ws;
    void* args[] = {&p};
    hipError_t e = hipLaunchCooperativeKernel((const void*)hybrid_fwd, dim3(grid), dim3(NTHREADS), args, LDS_BYTES, stream);
    if (e != hipSuccess) fprintf(stderr, "cooperative launch failed: %s (grid %d)\n", hipGetErrorString(e), grid);
}
```

```cpp
#include <hip/hip_runtime.h>
#include <hip/hip_cooperative_groups.h>
#include <hip/hip_bf16.h>
#include <cstdio>
#include <cstdint>
#include <cmath>
namespace cg = cooperative_groups;
#ifndef DIAG
#define DIAG 0
#endif
namespace pg8 {
#define PG8_LAS __attribute__((address_space(3)))
typedef unsigned short bf16_t;
typedef short bf16x8 __attribute__((ext_vector_type(8)));
typedef float f32x4 __attribute__((ext_vector_type(4)));
typedef unsigned u32x4 __attribute__((ext_vector_type(4)));
constexpr int BM = 256, BK = 64, HALF = 128, HTB = HALF * BK * 2  , STAGE_BYTES = 8 * HTB, NXCD = 8, WGM = 8;

__host__ __device__ __forceinline__ int lds_byte(int r, int c) { const int st = (r >> 4) * 2 + (c >> 5), rr = r & 15, cc = c & 31, ob = rr * 64 + cc * 2; return st * 1024 + (ob ^ (((ob >> 9) & 1) << 5)); }
__host__ __device__ __forceinline__ void stage_rc(int b, int& R, int& C) { const int st = b / 1024, sb = b % 1024, swz = sb ^ (((sb >> 9) & 1) << 5); R = (st >> 1) * 16 + swz / 64; C = (st & 1) * 32 + (swz % 64) / 2; }
__host__ __device__ __forceinline__ int perm32(int rho) { const int n = rho >> 4, i = rho & 15; return 8 * (i >> 2) + 4 * n + (i & 3); }

struct Unit { int pm, pn; };
struct Gemm { const bf16_t* A; const bf16_t* Bt; int M, N, K; };

struct StaticOrder {
    int nM, nN, nwg, G, c;
    __host__ __device__ void init(int M, int N, int G_, int c_) { nM = M / BM; nN = N / BM; nwg = nM * nN; G = G_; c = c_; }
    __host__ __device__ bool next(int i, Unit& u) const {
        const int L = i * G + c; if (L >= nwg) return false;
        int wgid = (int)L; { const int q = nwg / NXCD, r = nwg % NXCD, xcd = wgid % NXCD, off = wgid / NXCD; wgid = (xcd < r ? xcd * (q + 1) : r * (q + 1) + (xcd - r) * q) + off; }
        const int nig = WGM * nN, gid = wgid / nig, fm = gid * WGM, gsz = (nM - fm) < WGM ? (nM - fm) : WGM;
        u.pm = fm + ((wgid % nig) % gsz); u.pn = (wgid % nig) / gsz; return true;
    }
    __device__ __forceinline__ void a_ready(const Unit&) const {}
    __device__ __forceinline__ void done(const Unit&) const {}
};

__device__ __forceinline__ unsigned cvt_pk_bf16(float lo, float hi) { unsigned r; asm volatile("v_cvt_pk_bf16_f32 %0, %1, %2" : "=v"(r) : "v"(lo), "v"(hi)); return r; }
typedef float f32x2 __attribute__((ext_vector_type(2)));
template <class Epi, class Sched, bool ALIGN_EPI = false, bool SP2 = false>
__device__ __forceinline__ void gemm_phase(PG8_LAS unsigned char* lds, const Gemm g, const Sched& S, const Epi& E) {
    int tid_ = threadIdx.x; asm volatile("" : "+v"(tid_));
    const int tid = tid_, wid = __builtin_amdgcn_readfirstlane(tid >> 6), lane = tid & 63, wr = wid >> 2, wc = wid & 3, fr = lane & 15, fq = lane >> 4;
    const int K = g.K, nt = K / BK;
    unsigned voffA[2], voffB[2];
#pragma unroll
    for (int i = 0; i < 2; ++i) { int R, C; stage_rc(tid * 16 + i * 8192, R, C); const int Rb = Epi::PERM ? ((R & ~31) + perm32(R & 31)) : R;
        voffA[i] = (unsigned)(R * K + C) * 2u; voffB[i] = (unsigned)(Rb * K + C) * 2u; }
    const size_t kstep = (size_t)(BK * 2);
    const size_t hstep = (size_t)HALF * K * 2;
    const size_t tstep = 2 * hstep;
    const unsigned ldsw = (unsigned)wid * 1024u;
    const int aoff = lds_byte(wr * 64 + fr, fq * 8), boff = lds_byte(wc * 32 + fr, fq * 8);
#define PG8_SA(b, h) (((b) * 2 + (h)) * HTB)
#define PG8_SB(b, h) ((4 + (b) * 2 + (h)) * HTB)
#define PG8_STAGE(bufoff, gbase, voff) do { _Pragma("unroll") for (int _i = 0; _i < 2; ++_i) \
        __builtin_amdgcn_global_load_lds((const unsigned*)((const char*)(gbase) + (voff)[_i]), (PG8_LAS unsigned*)(lds + (bufoff) + ldsw + _i * 8192), 16, 0, 0); } while (0)
#define PG8_LDA(dst, b, h) do { _Pragma("unroll") for (int m = 0; m < 4; ++m) _Pragma("unroll") for (int k = 0; k < 2; ++k) dst[m][k] = *(const PG8_LAS bf16x8*)(lds + PG8_SA(b, h) + aoff + m * 2048 + k * 1024); } while (0)
#define PG8_LDB(dst, b, h) do { _Pragma("unroll") for (int n = 0; n < 2; ++n) _Pragma("unroll") for (int k = 0; k < 2; ++k) dst[n][k] = *(const PG8_LAS bf16x8*)(lds + PG8_SB(b, h) + boff + n * 2048 + k * 1024); } while (0)
#define PG8_MMA(ai, bj, At, Bt) do { __builtin_amdgcn_s_setprio(1); _Pragma("unroll") for (int m = 0; m < 4; ++m) _Pragma("unroll") for (int n = 0; n < 2; ++n) _Pragma("unroll") for (int k = 0; k < 2; ++k) \
        acc[ai][bj][m][n] = __builtin_amdgcn_mfma_f32_16x16x32_bf16(Bt[n][k], At[m][k], acc[ai][bj][m][n], 0, 0, 0); __builtin_amdgcn_s_setprio(0); } while (0)
#define PG8_WAIT_V(n) asm volatile("s_waitcnt vmcnt(" #n ")" ::: "memory")
#define PG8_WAIT_L(n) asm volatile("s_waitcnt lgkmcnt(" #n ")" ::: "memory")
#define PG8_BAR __builtin_amdgcn_s_barrier()
#define PG8_SCHED __builtin_amdgcn_sched_barrier(0)
    Unit cur, nxt; int ui = 0;
    if (!S.next(0, cur)) return;
    f32x4 acc[2][2][4][2];
#pragma unroll
    for (int a = 0; a < 2; ++a)
#pragma unroll
        for (int b = 0; b < 2; ++b)
#pragma unroll
            for (int m = 0; m < 4; ++m)
#pragma unroll
                for (int n = 0; n < 2; ++n) acc[a][b][m][n] = (f32x4){0.f, 0.f, 0.f, 0.f};
    bf16x8 At[4][2], B0[2][2], B1[2][2];
    const char* cA = (const char*)g.A + (size_t)cur.pm * tstep; const char* cB = (const char*)g.Bt + (size_t)cur.pn * tstep;
    S.a_ready(cur);
    if constexpr (SP2) {
        PG8_STAGE(PG8_SB(0, 0), cB, voffB); PG8_STAGE(PG8_SB(0, 1), cB + hstep, voffB); PG8_STAGE(PG8_SA(0, 0), cA, voffA); PG8_STAGE(PG8_SA(0, 1), cA + hstep, voffA);
        if (wr == 1) PG8_BAR;
        PG8_WAIT_V(2); PG8_BAR;
        PG8_STAGE(PG8_SB(1, 0), cB + kstep, voffB); PG8_STAGE(PG8_SA(1, 0), cA + kstep, voffA); PG8_STAGE(PG8_SB(1, 1), cB + hstep + kstep, voffB);
        PG8_WAIT_V(6); PG8_BAR;
    } else {
        PG8_STAGE(PG8_SB(0, 0), cB, voffB); PG8_STAGE(PG8_SA(0, 0), cA, voffA); PG8_STAGE(PG8_SB(0, 1), cB + hstep, voffB); PG8_STAGE(PG8_SA(0, 1), cA + hstep, voffA);
        if (wr == 1) PG8_BAR;
        PG8_WAIT_V(4); PG8_BAR;
        PG8_STAGE(PG8_SB(1, 0), cB + kstep, voffB); PG8_STAGE(PG8_SA(1, 0), cA + kstep, voffA); PG8_STAGE(PG8_SB(1, 1), cB + hstep + kstep, voffB);
        PG8_WAIT_V(6); PG8_BAR;
    }
    for (;;) {
        const bool has_next = S.next(ui + 1, nxt);
        const char* nA = has_next ? (const char*)g.A + (size_t)nxt.pm * tstep : cA; const char* nB = has_next ? (const char*)g.Bt + (size_t)nxt.pn * tstep : cB;
        for (int t = 0; t < nt; t += 2) {
            const bool last = (t == nt - 2);
            const char* a1 = cA + (size_t)(t + 1) * kstep;
            const char* a2 = last ? nA : cA + (size_t)(t + 2) * kstep; const char* b2 = last ? nB : cB + (size_t)(t + 2) * kstep;
            const char* a3 = a2 + kstep; const char* b3 = b2 + kstep;
            if (last && has_next) S.a_ready(nxt);
            if constexpr (SP2) {
            PG8_LDB(B0, 0, 0); PG8_LDB(B1, 0, 1); PG8_SCHED; PG8_LDA(At, 0, 0); PG8_STAGE(PG8_SA(1, 1), a1 + hstep, voffA);
            PG8_WAIT_V(8); PG8_WAIT_L(0); PG8_BAR; PG8_MMA(0, 0, At, B0); PG8_MMA(0, 1, At, B1); PG8_BAR; PG8_SCHED;
            PG8_LDA(At, 0, 1); PG8_STAGE(PG8_SB(0, 0), b2, voffB); PG8_STAGE(PG8_SB(0, 1), b2 + hstep, voffB); PG8_STAGE(PG8_SA(0, 0), a2, voffA);
            PG8_WAIT_V(8); PG8_WAIT_L(0); PG8_BAR; PG8_MMA(1, 0, At, B0); PG8_MMA(1, 1, At, B1); PG8_BAR; PG8_SCHED;
            PG8_LDB(B0, 1, 0); PG8_LDB(B1, 1, 1); PG8_SCHED; PG8_LDA(At, 1, 0); PG8_STAGE(PG8_SA(0, 1), a2 + hstep, voffA);
            PG8_WAIT_V(8); PG8_WAIT_L(0); PG8_BAR; PG8_MMA(0, 0, At, B0); PG8_MMA(0, 1, At, B1); PG8_BAR; PG8_SCHED;
            PG8_LDA(At, 1, 1); PG8_STAGE(PG8_SB(1, 0), b3, voffB); PG8_STAGE(PG8_SB(1, 1), b3 + hstep, voffB); PG8_STAGE(PG8_SA(1, 0), a3, voffA);
            PG8_WAIT_V(8); PG8_WAIT_L(0); PG8_BAR; PG8_MMA(1, 0, At, B0); PG8_MMA(1, 1, At, B1); PG8_BAR; PG8_SCHED;
            } else {
            PG8_LDB(B0, 0, 0); PG8_SCHED; PG8_LDA(At, 0, 0); PG8_STAGE(PG8_SA(1, 1), a1 + hstep, voffA);
            PG8_WAIT_L(8); PG8_BAR; PG8_WAIT_L(0); PG8_MMA(0, 0, At, B0); PG8_BAR; PG8_SCHED;
            PG8_LDB(B1, 0, 1); PG8_STAGE(PG8_SB(0, 0), b2, voffB);
            PG8_BAR; PG8_WAIT_L(0); PG8_MMA(0, 1, At, B1); PG8_BAR;
            PG8_LDA(At, 0, 1); PG8_STAGE(PG8_SA(0, 0), a2, voffA);
            PG8_BAR; PG8_WAIT_L(0); PG8_MMA(1, 0, At, B0); PG8_BAR; PG8_SCHED;
            PG8_STAGE(PG8_SB(0, 1), b2 + hstep, voffB);
            PG8_WAIT_V(6); PG8_BAR; PG8_MMA(1, 1, At, B1); PG8_BAR;
            PG8_LDB(B0, 1, 0); PG8_SCHED; PG8_LDA(At, 1, 0); PG8_STAGE(PG8_SA(0, 1), a2 + hstep, voffA);
            PG8_WAIT_L(8); PG8_BAR; PG8_WAIT_L(0); PG8_MMA(0, 0, At, B0); PG8_BAR; PG8_SCHED;
            PG8_LDB(B1, 1, 1); PG8_STAGE(PG8_SB(1, 0), b3, voffB);
            PG8_BAR; PG8_WAIT_L(0); PG8_MMA(0, 1, At, B1); PG8_BAR;
            PG8_LDA(At, 1, 1); PG8_STAGE(PG8_SA(1, 0), a3, voffA);
            PG8_BAR; PG8_WAIT_L(0); PG8_MMA(1, 0, At, B0); PG8_BAR; PG8_SCHED;
            PG8_STAGE(PG8_SB(1, 1), b3 + hstep, voffB);
            PG8_WAIT_V(6); PG8_BAR; PG8_MMA(1, 1, At, B1); PG8_BAR;
            }
        }
        if constexpr (ALIGN_EPI) { if (wr == 0) PG8_BAR; }
        if constexpr (!Epi::AFTER_DRAIN) { E(acc, cur, wr, wc, fr, fq); S.done(cur); }
        if (!has_next) break;
#pragma unroll
        for (int a = 0; a < 2; ++a)
#pragma unroll
            for (int b = 0; b < 2; ++b)
#pragma unroll
                for (int m = 0; m < 4; ++m)
#pragma unroll
                    for (int n = 0; n < 2; ++n) acc[a][b][m][n] = (f32x4){0.f, 0.f, 0.f, 0.f};
        cur = nxt; cA = nA; cB = nB; ++ui;
        if constexpr (ALIGN_EPI) { if (wr == 1) PG8_BAR; }
    }
    PG8_WAIT_V(0);
    if constexpr (!ALIGN_EPI) { if (wr == 0) PG8_BAR; }
    PG8_BAR;
    if constexpr (Epi::AFTER_DRAIN) { E.fused(acc, cur, wr, wc, fr, fq, lds, wid, lane); S.done(cur); }
#undef PG8_SA
#undef PG8_SB
#undef PG8_STAGE
#undef PG8_LDA
#undef PG8_LDB
#undef PG8_MMA
#undef PG8_WAIT_V
#undef PG8_WAIT_L
#undef PG8_BAR
#undef PG8_SCHED
}
}
namespace attn_body {
using bf16=__hip_bfloat16;
using bf16x8=__attribute__((ext_vector_type(8)))short;
using s16x4=__attribute__((ext_vector_type(4)))short;
using f32x16=__attribute__((ext_vector_type(16)))float;
using u32x4=__attribute__((ext_vector_type(4)))unsigned;
using f32x4k=__attribute__((ext_vector_type(4)))float;
constexpr int BATCH=16,NHEAD=8,TPAD=4160,D=64,DM=NHEAD*D;
constexpr int NW=8,QBLK=32,QB=QBLK*NW,KVBLK=64,NQB=16;
constexpr int ATTN_PITCH=DM, ATTN_UNIT_ROWS=QB;
__device__ __forceinline__ int crow(int r,int hi){return (r&3)+8*(r>>2)+4*hi;}
#define SBAR() __builtin_amdgcn_sched_barrier(0)
__device__ __forceinline__ void cmask(f32x16&p0,f32x16&p1,int jb,int qrel,int hi){
  const float NEG=-INFINITY; int kb=64*jb+4*hi;
  #pragma unroll
  for(int r=0;r<16;++r){int kv=kb+(r&3)+8*(r>>2); if(kv>qrel)p0[r]=NEG; if(kv+32>qrel)p1[r]=NEG;}
}

constexpr int NSLOT=3, SLOTB=8192;
constexpr int LDS_K=0, LDS_V=NSLOT*SLOTB, LDS_WS=2*NSLOT*SLOTB, LDS_OST=LDS_WS+NW*64*4, LDS_KB=LDS_OST+NW*4096, LDS_BYTES=LDS_KB+TPAD*4;
constexpr float C2=0.125f*1.4426950408889634f;
__device__ __forceinline__ void glds16(const void*gsrc,unsigned lds_dst){unsigned keep;
  asm volatile("s_mov_b32 %0, m0\n\ts_mov_b32 m0, %2\n\ts_nop 0\n\tglobal_load_lds_dwordx4 %1, off\n\ts_mov_b32 m0, %0":"=&s"(keep):"v"(gsrc),"s"(lds_dst):"memory");}
__device__ __forceinline__ float max3f(float a,float b,float c){float r;asm("v_max3_f32 %0, %1, %2, %3":"=v"(r):"v"(a),"v"(b),"v"(c));return r;}
__device__ __forceinline__ float max2f(float a,float b){float r;asm("v_max_f32_e32 %0, %1, %2":"=v"(r):"v"(a),"v"(b));return r;}
__device__ __forceinline__ float fadd_s(float a,float b){float r;asm("v_add_f32_e32 %0, %1, %2":"=v"(r):"v"(a),"v"(b));return r;}
__device__ __forceinline__ float fsub_s(float a,float b){float r;asm("v_sub_f32_e32 %0, %1, %2":"=v"(r):"v"(a),"v"(b));return r;}
typedef float f32x2_t __attribute__((ext_vector_type(2))); typedef __bf16 bf16x2_t __attribute__((ext_vector_type(2)));
__device__ __forceinline__ unsigned cvtpk_s(float lo,float hi){f32x2_t v={lo,hi};bf16x2_t b=__builtin_convertvector(v,bf16x2_t);return __builtin_bit_cast(unsigned,b);}
#define WAIT_BAR(N) asm volatile("s_waitcnt vmcnt(" #N ") lgkmcnt(0)\n\ts_barrier":::"memory")

__device__ __forceinline__ void qkt(f32x16&p0,f32x16&p1,const char*Kslot,const bf16x8*qr,int r32,int hi){
  const char*kb=Kslot+hi*1024+r32*16;
  #pragma unroll
  for(int d0=0;d0<4;++d0){
    const bf16x8 b0=*reinterpret_cast<const bf16x8*>(kb+d0*2048);
    const bf16x8 b1=*reinterpret_cast<const bf16x8*>(kb+d0*2048+512);
    {p0=__builtin_amdgcn_mfma_f32_32x32x16_bf16(b0,qr[d0],p0,0,0,0);p1=__builtin_amdgcn_mfma_f32_32x32x16_bf16(b1,qr[d0],p1,0,0,0);}}
}
typedef __attribute__((address_space(3))) const char* lds_cptr;
typedef short v4i16_t __attribute__((ext_vector_type(4)));
__device__ __forceinline__ void kload8(bf16x8*kf,lds_cptr kp){
  kf[0]=*(const __attribute__((address_space(3))) bf16x8*)(kp);      kf[1]=*(const __attribute__((address_space(3))) bf16x8*)(kp+512);
  kf[2]=*(const __attribute__((address_space(3))) bf16x8*)(kp+2048); kf[3]=*(const __attribute__((address_space(3))) bf16x8*)(kp+2560);
  kf[4]=*(const __attribute__((address_space(3))) bf16x8*)(kp+4096); kf[5]=*(const __attribute__((address_space(3))) bf16x8*)(kp+4608);
  kf[6]=*(const __attribute__((address_space(3))) bf16x8*)(kp+6144); kf[7]=*(const __attribute__((address_space(3))) bf16x8*)(kp+6656);
}
__device__ __forceinline__ void kload2(bf16x8*kf,lds_cptr kp,int j){ kf[2*j]=*(const __attribute__((address_space(3))) bf16x8*)(kp+j*2048); kf[2*j+1]=*(const __attribute__((address_space(3))) bf16x8*)(kp+j*2048+512); }
__device__ __forceinline__ s16x4 vtr(lds_cptr p){ return __builtin_bit_cast(s16x4,__builtin_amdgcn_ds_read_tr16_b64_v4i16((__attribute__((address_space(3))) v4i16_t*)p)); }
__device__ __forceinline__ float rowmax(const f32x16&p0,const f32x16&p1){
  float a=max3f(p0[0],p0[1],p1[0]),b=max3f(p0[2],p0[3],p1[1]);a=max3f(a,p1[2],p1[3]);
  #pragma unroll
  for(int r=4;r<16;r+=4){a=max3f(a,p0[r],p0[r+1]);b=max3f(b,p0[r+2],p0[r+3]);a=max3f(a,p1[r],p1[r+1]);b=max3f(b,p1[r+2],p1[r+3]);}
  const float m=max2f(a,b);
  auto rr=__builtin_amdgcn_permlane32_swap(__float_as_uint(m),__float_as_uint(m),false,false);
  return max2f(__uint_as_float(rr[0]),__uint_as_float(rr[1]));
}
__device__ __forceinline__ void pv(f32x16*o,int vb,bf16x8 pa0,bf16x8 pa1,bf16x8 pa2,bf16x8 pa3){
  #pragma unroll
  for(int d0=0;d0<2;++d0){s16x4 lo[4],hi[4];
    #pragma unroll
    for(int ks=0;ks<4;++ks){
      asm volatile("ds_read_b64_tr_b16 %0,%1 offset:%c2":"=&v"(lo[ks]):"v"(vb),"i"(d0*4096+ks*1024):"memory");
      asm volatile("ds_read_b64_tr_b16 %0,%1 offset:%c2":"=&v"(hi[ks]):"v"(vb),"i"(d0*4096+ks*1024+512):"memory");}
    asm volatile("s_waitcnt lgkmcnt(0)":::"memory");SBAR();
    #define PK(k) (bf16x8){lo[k][0],lo[k][1],lo[k][2],lo[k][3],hi[k][0],hi[k][1],hi[k][2],hi[k][3]}
    o[d0]=__builtin_amdgcn_mfma_f32_32x32x16_bf16(pa0,PK(0),o[d0],0,0,0);
    o[d0]=__builtin_amdgcn_mfma_f32_32x32x16_bf16(pa1,PK(1),o[d0],0,0,0);
    o[d0]=__builtin_amdgcn_mfma_f32_32x32x16_bf16(pa2,PK(2),o[d0],0,0,0);
    o[d0]=__builtin_amdgcn_mfma_f32_32x32x16_bf16(pa3,PK(3),o[d0],0,0,0);
    #undef PK
  }
}

#ifndef ATTN_STORE16
#define ATTN_STORE16(p,v) (*(u32x4*)(p)=(v))
#endif
template<int THRL> __device__ __forceinline__ void attn_unit(int b,int h,int qb,const bf16*Q,const bf16*__restrict__ K,const bf16*__restrict__ V,bf16*O,char*shm){
  int tid_=threadIdx.x; asm volatile("":"+v"(tid_)); const int tid=tid_,lane=tid&63,r32=lane&31,hi=lane>>5; const int wid=__builtin_amdgcn_readfirstlane(tid>>6);
  const long rowbase=(long)b*TPAD; const int q0=64+qb*QB;
  const bf16*Qw=Q+(rowbase+q0+wid*QBLK)*DM+h*D;
  const bf16*Kh=K+rowbase*DM+h*D,*Vh=V+rowbase*DM+h*D;
  const unsigned lds0=(unsigned)(uintptr_t)shm;
  float*wsf=(float*)(shm+LDS_WS)+wid*64;
  const bf16*ksrc=Kh+(long)lane*DM+wid*8;
  const bf16*vsrc=Vh+(long)(16*(wid&3)+(lane>>2))*DM+(wid>>2)*32+(lane&3)*8;
  const unsigned kdst=lds0+LDS_K+wid*1024, vdst=lds0+LDS_V+wid*1024;
  #define DMA_K(t,slot) glds16(ksrc+(long)(t)*KVBLK*DM,(unsigned)__builtin_amdgcn_readfirstlane(kdst+(slot)))
  #define DMA_V(t,slot) glds16(vsrc+(long)(t)*KVBLK*DM,(unsigned)__builtin_amdgcn_readfirstlane(vdst+(slot)))
  const int vb0=(int)(lds0+LDS_V)+((lane>>4)&1)*32+(lane&3)*8+(4*hi+((lane&15)>>2))*64;
  const char*Kbase=shm+LDS_K; bf16x8 kf[8];
  const lds_cptr shm3=(lds_cptr)shm; const lds_cptr kp0=shm3+LDS_K+hi*1024+r32*16; const lds_cptr vp0=shm3+LDS_V+((lane>>4)&1)*32+(lane&3)*8+(4*hi+((lane&15)>>2))*64;
  const int NT=(q0+QB)/KVBLK;
  typedef __attribute__((address_space(3))) const f32x4k* lds_f4p; const __attribute__((address_space(3))) float* kbp0=(const __attribute__((address_space(3))) float*)(shm3+LDS_KB)+4*hi;
  #define KBINIT(C0,C1,t) do{ const __attribute__((address_space(3))) float* kp_=kbp0+(t)*64; _Pragma("unroll") for(int g_=0;g_<4;++g_){ const f32x4k a_=*(lds_f4p)(kp_+8*g_); const f32x4k b_=*(lds_f4p)(kp_+32+8*g_); _Pragma("unroll") for(int e_=0;e_<4;++e_){ C0[4*g_+e_]=a_[e_]-mhat; C1[4*g_+e_]=b_[e_]-mhat; } } }while(0)
  DMA_K(0,0);DMA_V(0,0);DMA_K(1,SLOTB);
  bf16x8 qr[4];
  #pragma unroll
  for(int d0=0;d0<4;++d0)qr[d0]=*reinterpret_cast<const bf16x8*>(&Qw[(long)r32*DM+d0*16+hi*8]);
  float mhat=0.f,l_reg=0.f;f32x16 o[2];o[0]=f32x16{};o[1]=f32x16{};
  const int qrel=wid*QBLK+r32;
  #define CMASK(P0,P1,t) do{int jb_=(t)-(NT-4); if(jb_>=0)cmask(P0,P1,jb_,qrel,hi);}while(0)
  bool resc=false;
  #define START(P0,P1) do{ const float rm=rowmax(P0,P1); resc=false; \
    { const float dl=rm; mhat=fadd_s(mhat,dl); \
      _Pragma("unroll") for(int r=0;r<16;++r){P0[r]=fsub_s(P0[r],dl);P1[r]=fsub_s(P1[r],dl);} } \
    _Pragma("unroll") for(int r=0;r<16;++r)P0[r]=__builtin_amdgcn_exp2f(P0[r]); }while(0)
  #define RESC() do{ if(resc){ asm volatile("s_waitcnt lgkmcnt(0)":::"memory"); \
      _Pragma("unroll") for(int d_=0;d_<2;++d_) _Pragma("unroll") for(int r=0;r<16;++r)o[d_][r]*=wsf[crow(r,hi)]; } }while(0)
  f32x16 pA0,pA1,pB0,pB1;
  int sl_prev=0,sl_cur=0,sl_next=SLOTB;
  #define ROT() do{sl_prev=sl_cur;sl_cur=sl_next;sl_next=(sl_next==(NSLOT-1)*SLOTB)?0:sl_next+SLOTB;}while(0)
  DMA_K(2,2*SLOTB);
  WAIT_BAR(3);
  KBINIT(pA0,pA1,0); qkt(pA0,pA1,Kbase,qr,r32,hi);asm volatile("s_nop 15\n\ts_nop 7":"+v"(pA0),"+v"(pA1));CMASK(pA0,pA1,0);
  START(pA0,pA1);
  _Pragma("unroll") for(int r=0;r<16;++r)pA1[r]=__builtin_amdgcn_exp2f(pA1[r]);
  WAIT_BAR(0);
  DMA_K(3,0);DMA_V(1,SLOTB);
  ROT();
  kload8(kf,kp0+sl_cur);
  WAIT_BAR(2);
  s16x4 vlo[8],vhi[8]; u32x4 pw0,pw1,pw2,pw3;
  #define PKW(P,B) cvtpk_s(P[B],P[B+1])
  #define PAF(k) __builtin_bit_cast(bf16x8,pw##k)
  #define VFR(i) (bf16x8){vlo[i][0],vlo[i][1],vlo[i][2],vlo[i][3],vhi[i][0],vhi[i][1],vhi[i][2],vhi[i][3]}
  #define PIN(x) asm volatile("":"+v"(x))
  #define MX3(a,b,c) __builtin_fmaxf(__builtin_fmaxf((a),(b)),(c))
  #define GAPA(MF,A0,A1,A2,A3,W0,W1,PW) do{ MF; sacc+=A0; sacc+=A1; sacc+=A2; sacc+=A3; PIN(sacc); W0; W1; PIN(PW); SBAR(); }while(0)
  #define EX(v) __builtin_amdgcn_exp2f(v)
  #define GAPB(MF,X,B) do{ MF; X[B]=EX(X[B]); X[B+1]=EX(X[B+1]); X[B+2]=EX(X[B+2]); X[B+3]=EX(X[B+3]); PIN(X); SBAR(); }while(0)
  #define VRD(i) do{ vlo[i]=vtr(vp_+(((i)>>2)*4096+((i)&3)*1024)); vhi[i]=vtr(vp_+(((i)>>2)*4096+((i)&3)*1024+512)); }while(0)
  #define KRD(G,j) do{ if(G){ kload2(kf,kp0+sl_next,j); SBAR(); } }while(0)
  #define STEP(C0,C1,P0,P1,t,GK,GV,GL) do{ SBAR(); \
    const lds_cptr vp_=vp0+sl_prev; \
    KBINIT(C0,C1,t); SBAR(); \
    VRD(0); SBAR(); float sacc=(P0[0]+P0[1]); \
    GAPA(C0=__builtin_amdgcn_mfma_f32_32x32x16_bf16(kf[0],qr[0],C0,0,0,0), P0[2],P0[3],P0[4],P0[5],     pw0[0]=PKW(P0,0), pw0[1]=PKW(P0,2), pw0); \
    VRD(4); SBAR(); GAPA(C1=__builtin_amdgcn_mfma_f32_32x32x16_bf16(kf[1],qr[0],C1,0,0,0), P0[6],P0[7],P0[8],P0[9],     pw0[2]=PKW(P0,4), pw0[3]=PKW(P0,6), pw0); \
    VRD(1); SBAR(); GAPA(C0=__builtin_amdgcn_mfma_f32_32x32x16_bf16(kf[2],qr[1],C0,0,0,0),   P0[10],P0[11],P0[12],P0[13], pw1[0]=PKW(P0,8), pw1[1]=PKW(P0,10), pw1); \
    VRD(5); SBAR(); GAPA(C1=__builtin_amdgcn_mfma_f32_32x32x16_bf16(kf[3],qr[1],C1,0,0,0),   P0[14],P0[15],P1[0],P1[1],   pw1[2]=PKW(P0,12),pw1[3]=PKW(P0,14), pw1); \
    VRD(2); SBAR(); GAPA(C0=__builtin_amdgcn_mfma_f32_32x32x16_bf16(kf[4],qr[2],C0,0,0,0),   P1[2],P1[3],P1[4],P1[5],     pw2[0]=PKW(P1,0), pw2[1]=PKW(P1,2), pw2); \
    VRD(6); SBAR(); GAPA(C1=__builtin_amdgcn_mfma_f32_32x32x16_bf16(kf[5],qr[2],C1,0,0,0),   P1[6],P1[7],P1[8],P1[9],     pw2[2]=PKW(P1,4), pw2[3]=PKW(P1,6), pw2); \
    VRD(3); SBAR(); GAPA(C0=__builtin_amdgcn_mfma_f32_32x32x16_bf16(kf[6],qr[3],C0,0,0,0),   P1[10],P1[11],P1[12],P1[13], pw3[0]=PKW(P1,8), pw3[1]=PKW(P1,10), pw3); \
    VRD(7); SBAR(); GAPA(C1=__builtin_amdgcn_mfma_f32_32x32x16_bf16(kf[7],qr[3],C1,0,0,0),   P1[14],P1[15],0.f,0.f,       pw3[2]=PKW(P1,12),pw3[3]=PKW(P1,14), pw3); \
    l_reg+=sacc; \
    if(GK){DMA_K((t)+3,sl_cur);} if(GV){DMA_V((t)+1,sl_next);} \
    CMASK(C0,C1,t); \
    { float a=MX3(C0[0],C0[1],C1[0]),b=MX3(C0[2],C0[3],C1[1]); a=MX3(a,C1[2],C1[3]); \
      _Pragma("unroll") for(int r=4;r<16;r+=4){a=MX3(a,C0[r],C0[r+1]);b=MX3(b,C0[r+2],C0[r+3]);a=MX3(a,C1[r],C1[r+1]);b=MX3(b,C1[r+2],C1[r+3]);} \
      float rm=__builtin_fmaxf(a,b); { auto rr=__builtin_amdgcn_permlane32_swap(__float_as_uint(rm),__float_as_uint(rm),false,false); rm=__builtin_fmaxf(__uint_as_float(rr[0]),__uint_as_float(rr[1])); } \
      resc=false; \
      if(__builtin_expect(__any(rm>(float)THRL),0)){ const float dl=__builtin_fmaxf(rm,0.f); mhat+=dl; \
        _Pragma("unroll") for(int r=0;r<16;++r){C0[r]-=dl;C1[r]-=dl;} \
        const float f=__builtin_amdgcn_exp2f(-dl); l_reg*=f; if(hi==0)wsf[r32]=f; resc=true; } } \
    SBAR(); \
    GAPB(o[0]=__builtin_amdgcn_mfma_f32_32x32x16_bf16(PAF(0),VFR(0),o[0],0,0,0), C0,0); \
    GAPB(o[1]=__builtin_amdgcn_mfma_f32_32x32x16_bf16(PAF(0),VFR(4),o[1],0,0,0), C0,4); \
    KRD(GL,0); GAPB(o[0]=__builtin_amdgcn_mfma_f32_32x32x16_bf16(PAF(1),VFR(1),o[0],0,0,0), C0,8); \
    KRD(GL,1); GAPB(o[1]=__builtin_amdgcn_mfma_f32_32x32x16_bf16(PAF(1),VFR(5),o[1],0,0,0), C0,12); \
    KRD(GL,2); GAPB(o[0]=__builtin_amdgcn_mfma_f32_32x32x16_bf16(PAF(2),VFR(2),o[0],0,0,0), C1,0); \
    KRD(GL,3); GAPB(o[1]=__builtin_amdgcn_mfma_f32_32x32x16_bf16(PAF(2),VFR(6),o[1],0,0,0), C1,4); \
    GAPB(o[0]=__builtin_amdgcn_mfma_f32_32x32x16_bf16(PAF(3),VFR(3),o[0],0,0,0), C1,8); \
    GAPB(o[1]=__builtin_amdgcn_mfma_f32_32x32x16_bf16(PAF(3),VFR(7),o[1],0,0,0), C1,12); \
    }while(0)
  int t=1;
  #undef CMASK
  #define CMASK(P0,P1,t) do{}while(0)
  for(;t+5<NT;t+=2){
    STEP(pB0,pB1,pA0,pA1,t,true,true,true);     WAIT_BAR(2); RESC(); ROT();
    STEP(pA0,pA1,pB0,pB1,t+1,true,true,true);   WAIT_BAR(2); RESC(); ROT();
  }
  #undef CMASK
  #define CMASK(P0,P1,t) do{int jb_=(t)-(NT-4); if(jb_>=0)cmask(P0,P1,jb_,qrel,hi);}while(0)
  #define ENDW(tt) do{ if((tt)+3<NT){WAIT_BAR(2);} else if((tt)+2<NT){WAIT_BAR(1);} else {WAIT_BAR(0);} }while(0)
  for(;t+1<NT;t+=2){
    STEP(pB0,pB1,pA0,pA1,t,(t+3<NT),(t+1<NT),(t+1<NT));       ENDW(t);   RESC(); ROT();
    STEP(pA0,pA1,pB0,pB1,t+1,(t+4<NT),(t+2<NT),(t+2<NT));     ENDW(t+1); RESC(); ROT();
  }
  { float sacc=pA0[0]+pA0[1]; _Pragma("unroll") for(int r=2;r<16;++r)sacc+=pA0[r]; _Pragma("unroll") for(int r=0;r<16;++r)sacc+=pA1[r]; l_reg+=sacc;
    pw0=(u32x4){PKW(pA0,0),PKW(pA0,2),PKW(pA0,4),PKW(pA0,6)};pw1=(u32x4){PKW(pA0,8),PKW(pA0,10),PKW(pA0,12),PKW(pA0,14)};pw2=(u32x4){PKW(pA1,0),PKW(pA1,2),PKW(pA1,4),PKW(pA1,6)};pw3=(u32x4){PKW(pA1,8),PKW(pA1,10),PKW(pA1,12),PKW(pA1,14)};
    SBAR(); pv(o,vb0+sl_prev,PAF(0),PAF(1),PAF(2),PAF(3)); }
  #undef PKW
  #undef PAF
  #undef VFR
  #undef PIN
  #undef MX3
  #undef GAPA
  #undef GAPB
  #undef EX
  #undef VRD
  #undef KRD
  #undef STEP
  #undef ENDW
  {auto rr=__builtin_amdgcn_permlane32_swap(__float_as_uint(l_reg),__float_as_uint(l_reg),false,false);l_reg=__uint_as_float(rr[0])+__uint_as_float(rr[1]);}
  if(hi==0)wsf[32+r32]=l_reg;asm volatile("s_waitcnt lgkmcnt(0)":::"memory");
  float rli[16];
  #pragma unroll
  for(int r=0;r<16;++r)rli[r]=__builtin_amdgcn_rcpf(wsf[32+crow(r,hi)]);
  bf16*Ow=O+(rowbase+q0+wid*QBLK)*DM+h*D;
  { bf16*stg=(bf16*)(shm+LDS_OST)+wid*2048;
    #pragma unroll
    for(int r=0;r<16;++r){const int orow=crow(r,hi);
      #pragma unroll
      for(int d0=0;d0<2;++d0)stg[orow*64+d0*32+r32]=__float2bfloat16(o[d0][r]*rli[r]);}
    asm volatile("s_waitcnt lgkmcnt(0)":::"memory");
    #pragma unroll
    for(int i=0;i<4;++i){const int row=i*8+(lane>>3),ch=lane&7; const u32x4 v=*(const u32x4*)(stg+row*64+ch*8); ATTN_STORE16(Ow+(long)row*DM+ch*8,v);} }
  asm volatile("s_waitcnt lgkmcnt(0)\n\ts_barrier":::"memory");
  #undef DMA_K
  #undef DMA_V
  #undef CMASK
  #undef START
  #undef RESC
  #undef ROT
  #undef KBINIT
}
constexpr int ATTN_LDS_BYTES=LDS_BYTES;
#undef SBAR
#undef WAIT_BAR
}

#define LAS __attribute__((address_space(3)))
typedef unsigned short bf16;
typedef unsigned v4u __attribute__((ext_vector_type(4)));
typedef unsigned v2u __attribute__((ext_vector_type(2)));
typedef float f32x4 __attribute__((ext_vector_type(4)));
typedef short bf16x8 __attribute__((ext_vector_type(8)));
typedef float f32x16v __attribute__((ext_vector_type(16)));

constexpr int NB = 16, SEQ = 4096, DMODEL = 1024, NMETA = 16;
constexpr int TP = 4160;
constexpr int R = NB * TP;
constexpr int NTOK = NB * SEQ;
constexpr int N1 = 5632;
constexpr int IN_COLS = 5416;
constexpr int NWAVES = 8, NTHREADS = 512;
constexpr float NORM_EPS = 1e-6f, GN_EPS = 64e-5f;
constexpr float LOG2E = 1.4426950408889634f;

constexpr size_t MiB = 1u << 20;
constexpr size_t U65 = 65 * MiB;
constexpr size_t WS_WTIN = 1 * MiB;
constexpr size_t WS_WTQ = 12 * MiB;
constexpr size_t WS_WTFOX = 16 * MiB;
constexpr size_t WS_WTRWKV = 17 * MiB;
constexpr size_t WS_WTOUT = 18 * MiB;
constexpr size_t WS_WTWA = 20 * MiB;
constexpr size_t WS_WTG = 20 * MiB + 512 * 1024;
constexpr size_t WS_KS = 21 * MiB;
constexpr size_t WS_KB = 22 * MiB;
constexpr size_t WS_LF = 25 * MiB;
constexpr size_t WS_BS = 28 * MiB;
constexpr size_t WS_U8 = 32 * MiB;
constexpr size_t WS_SU = 48 * MiB;
constexpr size_t WS_V8 = 64 * MiB;
constexpr size_t WS_SV = 80 * MiB;
constexpr size_t WS_CORR = 81 * MiB;
constexpr size_t WS_SX = 82 * MiB;
constexpr size_t WS_XQ = 352 * MiB;
constexpr size_t WS_F = 96 * MiB;
constexpr size_t WS_FQ = WS_F, WS_FK = WS_F + U65, WS_FV = WS_F + 2 * U65, WS_ZRR = WS_F + 3 * U65, WS_ZRK = WS_F + 4 * U65, WS_ZRV = WS_F + 5 * U65, WS_ZM = WS_F + 6 * U65;
constexpr size_t WS_ZG = WS_F + 7 * U65;
constexpr size_t WS_XN = WS_ZG + 4 * U65;
constexpr size_t WS_IDS = 941 * MiB;
constexpr size_t WS_GATES = 973 * MiB;
constexpr size_t WS_END = 1005 * MiB;
constexpr size_t WS_LA = WS_XN;
constexpr size_t WS_LG = WS_XN + 20 * MiB;
constexpr size_t WS_KP = WS_XN;
constexpr size_t WS_KN = WS_XN + U65;
constexpr size_t WS_Y = WS_ZM;
constexpr size_t WS_MIX = WS_XN;
constexpr size_t WS_XN2 = WS_XN;
constexpr size_t WS_PQ = WS_F;
constexpr size_t DO_XW = 0, DO_AA = U65, DO_GG = 2 * U65;

__device__ __forceinline__ unsigned f2bf(float f) { unsigned u = __builtin_bit_cast(unsigned, f); return (u + 0x7fffu + ((u >> 16) & 1u)) >> 16; }
__device__ __forceinline__ unsigned pk2(float lo, float hi) { return f2bf(lo) | (f2bf(hi) << 16); }
__device__ __forceinline__ float bflo(unsigned w) { return __builtin_bit_cast(float, w << 16); }
__device__ __forceinline__ float bfhi(unsigned w) { return __builtin_bit_cast(float, w & 0xffff0000u); }
__device__ __forceinline__ void unpack8(const v4u w, float (&f)[8]) { f[0] = bflo(w.x); f[1] = bfhi(w.x); f[2] = bflo(w.y); f[3] = bfhi(w.y); f[4] = bflo(w.z); f[5] = bfhi(w.z); f[6] = bflo(w.w); f[7] = bfhi(w.w); }
__device__ __forceinline__ v4u pack8(const float (&f)[8]) { v4u w; w.x = pk2(f[0], f[1]); w.y = pk2(f[2], f[3]); w.z = pk2(f[4], f[5]); w.w = pk2(f[6], f[7]); return w; }
__device__ __forceinline__ float sigmoidf_(float x) { return __builtin_amdgcn_rcpf(1.0f + __builtin_amdgcn_exp2f(-x * LOG2E)); }
__device__ __forceinline__ float wave_sum(float v) {
#pragma unroll
    for (int o = 1; o < 64; o <<= 1) v += __shfl_xor(v, o);
    return v;
}
__device__ __forceinline__ float sum8(float v) { v += __shfl_xor(v, 1); v += __shfl_xor(v, 2); v += __shfl_xor(v, 4); return v; }

struct Params {
    const float* in[27];
    float* out;
    unsigned char* ws;
};
enum { I_X = 0, I_META, I_N1G, I_WIN, I_FQN, I_FKN, I_FBIAS, I_MU, I_W0, I_WUP, I_A0, I_AUP, I_GUP, I_KK, I_KA, I_RK, I_LNG, I_LNB, I_WFOX, I_WRWKV, I_WOUT, I_N2G, I_PWQ, I_SK1, I_SK2, I_PU, I_PV };

__device__ __forceinline__ int win_src_col(int n) {
    if (n < 1536) return n;
    if (n < 3072) return 1544 + (n - 1536);
    if (n < 3584) { const int m = n - 3072; if (m < 288) return 3080 + m; if (m < 296) return 1536 + (m - 288); return -1; }
    return 3368 + (n - 3584);
}
template <bool REMAP>
__device__ __forceinline__ void transpose_item(const float* W, int ldw, int K, int N, bf16* WT, LAS float* scr, int item, int lane) {
    const int nblk = N / 32, kb = item / nblk, nb = item % nblk, k0 = 64 * kb, n0 = 32 * nb;
    const int n = n0 + (lane & 31); const int sc = REMAP ? win_src_col(n) : n;
#pragma unroll 8
    for (int i = 0; i < 32; ++i) { const int kk = 2 * i + (lane >> 5); scr[kk * 33 + (lane & 31)] = (sc >= 0) ? W[(size_t)(k0 + kk) * ldw + sc] : 0.f; }
    asm volatile("s_waitcnt lgkmcnt(0)" ::: "memory");
    const int c = lane & 7;
#pragma unroll
    for (int j = 0; j < 4; ++j) { const int nn = (lane >> 3) + 8 * j; const LAS float* s = scr + (8 * c) * 33 + nn;
        v4u o; o.x = pk2(s[0 * 33], s[1 * 33]); o.y = pk2(s[2 * 33], s[3 * 33]); o.z = pk2(s[4 * 33], s[5 * 33]); o.w = pk2(s[6 * 33], s[7 * 33]);
        *(v4u*)(WT + (size_t)(n0 + nn) * K + k0 + 8 * c) = o; }
    asm volatile("s_waitcnt lgkmcnt(0)" ::: "memory");
}
__device__ __forceinline__ void p0_prologue(const Params& p, LAS unsigned char* lds, int vcu, int G, int wave, int lane) {
    unsigned char* ws = p.ws;
    LAS float* scr = (LAS float*)(lds + wave * 16384);
    const int gw = vcu * NWAVES + wave, NGW = G * NWAVES;
    constexpr int I_IN = 16 * (N1 / 32), I_Q = 16 * 64, I_FX = 8 * 32, I_O = 16 * 32;
    constexpr int NITEMS = I_IN + I_Q + 2 * I_FX + I_O;
    for (int it = gw; it < NITEMS; it += NGW) {
        int r = it;
        if (r < I_IN) { transpose_item<true>(p.in[I_WIN], IN_COLS, 1024, N1, (bf16*)(ws + WS_WTIN), scr, r, lane); continue; } r -= I_IN;
        if (r < I_Q) { transpose_item<false>(p.in[I_PWQ], 2048, 1024, 2048, (bf16*)(ws + WS_WTQ), scr, r, lane); continue; } r -= I_Q;
        if (r < I_FX) { transpose_item<false>(p.in[I_WFOX], 1024, 512, 1024, (bf16*)(ws + WS_WTFOX), scr, r, lane); continue; } r -= I_FX;
        if (r < I_FX) { transpose_item<false>(p.in[I_WRWKV], 1024, 512, 1024, (bf16*)(ws + WS_WTRWKV), scr, r, lane); continue; } r -= I_FX;
        transpose_item<false>(p.in[I_WOUT], 1024, 1024, 1024, (bf16*)(ws + WS_WTOUT), scr, r, lane);
    }
    const int gt = gw * 64 + lane, NGT = NGW * 64;
    for (int i = gt; i < 1024 * 128; i += NGT) { const int n = i >> 7, k = i & 127; float v = 0.f;
        if (n < 512) { if (k < 64) v = p.in[I_WUP][k * 512 + n]; } else { if (k >= 64) v = p.in[I_AUP][(k - 64) * 512 + (n - 512)]; }
        ((bf16*)(ws + WS_WTWA))[i] = (bf16)f2bf(v); }
    for (int i = gt; i < 512 * 256; i += NGT) { const int n = i >> 8, k = i & 255; const float v = (k < 160) ? p.in[I_GUP][k * 512 + n] : 0.f; ((bf16*)(ws + WS_WTG))[i] = (bf16)f2bf(v); }
    for (int i = gt; i < 2 * 128 * 128; i += NGT) { const float v = (i < 16384) ? p.in[I_SK1][i] : p.in[I_SK2][i - 16384]; ((bf16*)(ws + WS_KS))[i] = (bf16)f2bf(v); }
    for (int r = gw; r < 32768; r += NGW) {
        const int tbl = r >> 14, row = r & 16383;
        const f32x4* src = (const f32x4*)((tbl ? p.in[I_PV] : p.in[I_PU]) + (size_t)row * 1024 + 16 * lane);
        f32x4 a[4]; float m = 0.f;
#pragma unroll
        for (int j = 0; j < 4; ++j) { a[j] = src[j]; m = fmaxf(m, fmaxf(fmaxf(fabsf(a[j].x), fabsf(a[j].y)), fmaxf(fabsf(a[j].z), fabsf(a[j].w)))); }
#pragma unroll
        for (int o = 1; o < 64; o <<= 1) m = fmaxf(m, __shfl_xor(m, o));
        const float inv = m > 0.f ? 127.0f / m : 0.f; const int off = tbl ? 128 : 0;
        v4u w;
        unsigned ww[4];
#pragma unroll
        for (int j = 0; j < 4; ++j) { const int q0 = (int)rintf(a[j].x * inv) + off, q1 = (int)rintf(a[j].y * inv) + off, q2 = (int)rintf(a[j].z * inv) + off, q3 = (int)rintf(a[j].w * inv) + off;
            ww[j] = (unsigned)(q0 & 255) | ((unsigned)(q1 & 255) << 8) | ((unsigned)(q2 & 255) << 16) | ((unsigned)(q3 & 255) << 24); }
        w.x = ww[0]; w.y = ww[1]; w.z = ww[2]; w.w = ww[3];
        *(v4u*)(ws + (tbl ? WS_V8 : WS_U8) + (size_t)row * 1024 + 16 * lane) = w;
        if (lane == 0) ((float*)(ws + (tbl ? WS_SV : WS_SU)))[row] = m > 0.f ? m * (1.0f / 127.0f) : 1.0f;
    }
    const f32x4* g4 = (const f32x4*)p.in[I_N1G] + lane;
    for (int m = gw; m < R; m += NGW) {
        const int b = m / TP, pp = m - b * TP;
        unsigned long long* o8 = (unsigned long long*)(ws + WS_XN + (size_t)m * 2048) + lane;
        if (pp < 48) {
#pragma unroll
            for (int j = 0; j < 4; ++j) o8[64 * j] = 0ull;
            continue; }
        const float* xrow = (pp < 64) ? p.in[I_META] + (size_t)(pp - 48) * 1024 : p.in[I_X] + ((size_t)b * SEQ + (pp - 64)) * 1024;
        const f32x4* xr = (const f32x4*)xrow + lane;
        f32x4 v[4]; float s = 0.f;
#pragma unroll
        for (int j = 0; j < 4; ++j) { v[j] = xr[64 * j]; s += (v[j].x * v[j].x + v[j].y * v[j].y) + (v[j].z * v[j].z + v[j].w * v[j].w); }
        const float rs = 1.0f / sqrtf(wave_sum(s) * (1.f / 1024.f) + NORM_EPS);
#pragma unroll
        for (int j = 0; j < 4; ++j) { const f32x4 g = g4[64 * j]; o8[64 * j] = (unsigned long long)pk2(v[j].x * rs * g.x, v[j].y * rs * g.y) | ((unsigned long long)pk2(v[j].z * rs * g.z, v[j].w * rs * g.w) << 32); }
    }
}

template <class F> struct EpiT {
    static constexpr bool PERM = true, AFTER_DRAIN = false;
    F f;
    __device__ __forceinline__ void operator()(const pg8::f32x4 (&acc)[2][2][4][2], const pg8::Unit& u, int wr, int wc, int fr, int fq) const {
        const int row0 = u.pm * 256 + wr * 64 + fr, col0 = u.pn * 256 + wc * 32 + 8 * fq;
#pragma unroll
        for (int ai = 0; ai < 2; ++ai)
#pragma unroll
            for (int m = 0; m < 4; ++m)
#pragma unroll
                for (int bj = 0; bj < 2; ++bj) {
                    const pg8::f32x4 a = acc[ai][bj][m][0], b = acc[ai][bj][m][1];
                    float v[8] = {a[0], a[1], a[2], a[3], b[0], b[1], b[2], b[3]};
                    f.store(row0 + ai * 128 + m * 16, col0 + bj * 128, v);
                }
    }
};
struct F_Gemm1 {
    bf16* F; bf16* ZG;
    __device__ __forceinline__ void store(int row, int col, float (&v)[8]) const {
        if (col < 3584) { const int buf = col >> 9, c = col & 511; *(v4u*)(F + (size_t)buf * ((size_t)R * 512) + (size_t)row * 512 + c) = pack8(v); }
        else { const int c = col - 3584;
#pragma unroll
            for (int e = 0; e < 8; ++e) v[e] = sigmoidf_(v[e]);
            *(v4u*)(ZG + (size_t)row * 2048 + c) = pack8(v); }
    }
};
struct F_LoraW {
    bf16* XW; const float* w0;
    __device__ __forceinline__ void store(int row, int col, float (&v)[8]) const {
        const f32x4 b0 = *(const f32x4*)(w0 + col), b1 = *(const f32x4*)(w0 + col + 4); const float bb[8] = {b0.x, b0.y, b0.z, b0.w, b1.x, b1.y, b1.z, b1.w};
#pragma unroll
        for (int e = 0; e < 8; ++e) { const float x = v[e] + bb[e];
            const float sp = fmaxf(-x, 0.f) + __logf(1.0f + __expf(-fabsf(x)));
            const float ew = __expf(-sp - 0.5f);
            v[e] = 1.0f - __expf(-ew); }
        *(v4u*)(XW + (size_t)row * 512 + col) = pack8(v);
    }
};
struct F_LoraA {
    bf16* AA; const float* a0;
    __device__ __forceinline__ void store(int row, int col, float (&v)[8]) const {
        const f32x4 b0 = *(const f32x4*)(a0 + col), b1 = *(const f32x4*)(a0 + col + 4); const float bb[8] = {b0.x, b0.y, b0.z, b0.w, b1.x, b1.y, b1.z, b1.w};
#pragma unroll
        for (int e = 0; e < 8; ++e) v[e] = sigmoidf_(v[e] + bb[e]);
        *(v4u*)(AA + (size_t)row * 512 + col) = pack8(v);
    }
};
struct F_Plain {
    bf16* O; int ldc;
    __device__ __forceinline__ void store(int row, int col, float (&v)[8]) const { *(v4u*)(O + (size_t)row * ldc + col) = pack8(v); }
};
struct F_MixA {
    bf16* MIX; const bf16* ZG;
    __device__ __forceinline__ void store(int row, int col, float (&v)[8]) const {
        float g[8]; unpack8(*(const v4u*)(ZG + (size_t)row * 2048 + col), g);
#pragma unroll
        for (int e = 0; e < 8; ++e) v[e] *= g[e];
        *(v4u*)(MIX + (size_t)row * 1024 + col) = pack8(v);
    }
};
struct F_MixB {
    bf16* MIX; const bf16* ZG;
    __device__ __forceinline__ void store(int row, int col, float (&v)[8]) const {
        float g[8], m[8]; unpack8(*(const v4u*)(ZG + (size_t)row * 2048 + 1024 + col), g); unpack8(*(const v4u*)(MIX + (size_t)row * 1024 + col), m);
#pragma unroll
        for (int e = 0; e < 8; ++e) v[e] = m[e] + v[e] * g[e];
        *(v4u*)(MIX + (size_t)row * 1024 + col) = pack8(v);
    }
};
struct F_Out {
    const float* x; float* out;
    __device__ __forceinline__ void store(int row, int col, float (&v)[8]) const {
        const int b = row / TP, pp = row - b * TP; if (pp < 64) return;
        const size_t off = ((size_t)b * SEQ + (pp - 64)) * 1024 + col;
        const f32x4 x0 = *(const f32x4*)(x + off), x1 = *(const f32x4*)(x + off + 4);
        *(f32x4*)(out + off) = (f32x4){x0.x + v[0], x0.y + v[1], x0.z + v[2], x0.w + v[3]};
        *(f32x4*)(out + off + 4) = (f32x4){x1.x + v[4], x1.y + v[5], x1.z + v[6], x1.w + v[7]};
    }
};
template <class F>
__device__ __forceinline__ void run_gemm(LAS unsigned char* lds, const bf16* A, const bf16* Bt, int M, int N, int K, int G, int bid, const F& f) {
    asm volatile("" : "+s"(M), "+s"(N), "+s"(G));
    pg8::Gemm g{A, Bt, M, N, K}; pg8::StaticOrder S; S.init(M, N, G, bid);
    EpiT<F> E{f};
    pg8::gemm_phase<EpiT<F>, pg8::StaticOrder, true, true>(lds, g, S, E);
}

__device__ __forceinline__ void p2_prep1(const Params& p, int vcu, int G, int wave, int lane) {
    unsigned char* ws = p.ws;
    const int gw = vcu * NWAVES + wave, NGW = G * NWAVES;
    float gq[8], gk[8], mu[8];
#pragma unroll
    for (int e = 0; e < 8; ++e) { gq[e] = p.in[I_FQN][lane * 8 + e] * attn_body::C2; gk[e] = p.in[I_FKN][lane * 8 + e]; mu[e] = (lane < 36) ? p.in[I_MU][1536 + lane * 8 + e] : 0.f; }
    for (int m = gw; m < R; m += NGW) {
        const int b = m / TP, pp = m - b * TP;
        {
            v4u* qp = (v4u*)(ws + WS_FQ + (size_t)m * 1024) + lane; v4u* kp = (v4u*)(ws + WS_FK + (size_t)m * 1024) + lane;
            float q[8], k[8]; unpack8(*qp, q); unpack8(*kp, k);
            float sq = 0.f, sk = 0.f;
#pragma unroll
            for (int e = 0; e < 8; ++e) { sq += q[e] * q[e]; sk += k[e] * k[e]; }
            sq = sum8(sq); sk = sum8(sk);
            const float rq = 1.0f / sqrtf(sq * (1.f / 64.f) + NORM_EPS), rk = 1.0f / sqrtf(sk * (1.f / 64.f) + NORM_EPS);
#pragma unroll
            for (int e = 0; e < 8; ++e) { q[e] *= rq * gq[e]; k[e] *= rk * gk[e]; }
            *qp = pack8(q); *kp = pack8(k);
        }
        if (lane < 36) {
            float z[8], zp[8]; unpack8(*((const v4u*)(ws + WS_ZM + (size_t)m * 1024) + lane), z);
            if (pp > 0) unpack8(*((const v4u*)(ws + WS_ZM + (size_t)(m - 1) * 1024) + lane), zp); else {
#pragma unroll
                for (int e = 0; e < 8; ++e) zp[e] = 0.f; }
#pragma unroll
            for (int e = 0; e < 8; ++e) { const float s = z[e] + mu[e] * (zp[e] - z[e]); z[e] = (lane < 8) ? tanhf(s) : (lane < 16) ? s : sigmoidf_(s); }
            if (lane < 16) *((v4u*)(ws + WS_LA + (size_t)m * 256) + lane) = pack8(z);
            else *((v4u*)(ws + WS_LG + (size_t)m * 512) + (lane - 16)) = pack8(z);
        } else if (lane == 36) {
            float z[8]; unpack8(*((const v4u*)(ws + WS_ZM + (size_t)m * 1024) + 36), z);
#pragma unroll
            for (int e = 0; e < 8; ++e) { const float x = z[e] + p.in[I_FBIAS][e]; z[e] = fminf(x, 0.f) - __logf(1.0f + __expf(-fabsf(x))); }
            float* lf = (float*)(ws + WS_LF) + (size_t)m * 8;
            *(f32x4*)lf = (f32x4){z[0], z[1], z[2], z[3]}; *(f32x4*)(lf + 4) = (f32x4){z[4], z[5], z[6], z[7]};
        } else if (lane < 49) {
            *((v4u*)(ws + WS_LG + (size_t)m * 512) + (lane - 37 + 20)) = (v4u){0u, 0u, 0u, 0u};
        }
    }
}
__device__ __forceinline__ void p3_cumsum(const Params& p, int seq, int lane) {
    unsigned char* ws = p.ws;
    const int b = seq >> 3, h = seq & 7;
    const float* lf = (const float*)(ws + WS_LF) + (size_t)b * TP * 8 + h;
    float* kb = (float*)(ws + WS_KB) + (size_t)seq * TP;
    float carry = 0.f;
    for (int c0 = 0; c0 < 65; c0 += 13) {
        float v[13];
#pragma unroll
        for (int i = 0; i < 13; ++i) { const int pp = (c0 + i) * 64 + lane; v[i] = (pp >= 48) ? lf[(size_t)pp * 8] : 0.f; }
#pragma unroll
        for (int i = 0; i < 13; ++i) {
            float x = v[i];
#pragma unroll
            for (int o = 1; o < 64; o <<= 1) { const float y = __shfl_up(x, o); if (lane >= o) x += y; }
            const int pp = (c0 + i) * 64 + lane;
            const float c = carry + x;
            kb[pp] = (pp >= 48) ? -c * LOG2E : -1e30f;
            carry += __shfl(x, 63);
        }
    }
}

__device__ __forceinline__ void p4_prep2(const Params& p, int vcu, int G, int wave, int lane) {
    unsigned char* ws = p.ws; unsigned char* dob = (unsigned char*)p.out;
    const int gw = vcu * NWAVES + wave, NGW = G * NWAVES;
    float mur[8], muk[8], kk_[8], ka_[8], rk_[8];
#pragma unroll
    for (int e = 0; e < 8; ++e) { const int c = lane * 8 + e; mur[e] = p.in[I_MU][c]; muk[e] = p.in[I_MU][512 + c]; kk_[e] = p.in[I_KK][c]; ka_[e] = p.in[I_KA][c]; rk_[e] = p.in[I_RK][c]; }
    for (int m = gw; m < R; m += NGW) {
        const int b = m / TP, pp = m - b * TP;
        float r[8], k[8], rp[8], kp[8], a[8];
        unpack8(*((const v4u*)(ws + WS_ZRR + (size_t)m * 1024) + lane), r); unpack8(*((const v4u*)(ws + WS_ZRK + (size_t)m * 1024) + lane), k);
        if (pp > 0) { unpack8(*((const v4u*)(ws + WS_ZRR + (size_t)(m - 1) * 1024) + lane), rp); unpack8(*((const v4u*)(ws + WS_ZRK + (size_t)(m - 1) * 1024) + lane), kp); }
        else {
#pragma unroll
            for (int e = 0; e < 8; ++e) { rp[e] = 0.f; kp[e] = 0.f; } }
        v4u* aap = (v4u*)(dob + DO_AA + (size_t)m * 1024) + lane;
        unpack8(*aap, a);
        float kkv[8], kpr[8]; float ss = 0.f, bon = 0.f;
#pragma unroll
        for (int e = 0; e < 8; ++e) { const float rs = r[e] + mur[e] * (rp[e] - r[e]); const float ks = k[e] + muk[e] * (kp[e] - k[e]);
            kkv[e] = ks * kk_[e]; kpr[e] = ks * (1.0f + (a[e] - 1.0f) * ka_[e]); ss += kkv[e] * kkv[e]; bon += rs * kpr[e] * rk_[e]; }
        ss = sum8(ss); bon = sum8(bon);
        const float inv = 1.0f / fmaxf(sqrtf(ss), 1e-12f);
        float bb[8];
#pragma unroll
        for (int e = 0; e < 8; ++e) { kkv[e] *= inv; bb[e] = kkv[e] * a[e]; }
        *((v4u*)(ws + WS_KP + (size_t)m * 1024) + lane) = pack8(kpr);
        *((v4u*)(ws + WS_KN + (size_t)m * 1024) + lane) = pack8(kkv);
        *aap = pack8(bb);
        if ((lane & 7) == 0) ((float*)(ws + WS_BS))[(size_t)m * 8 + (lane >> 3)] = bon;
    }
}

constexpr int SC_CH = 32, SC_STRIDE = 5 * 64 + 32;
__device__ __forceinline__ float dpp_sum16(float x) {
    x += __builtin_bit_cast(float, __builtin_amdgcn_update_dpp(0, __builtin_bit_cast(int, x), 0xB1, 0xF, 0xF, true));
    x += __builtin_bit_cast(float, __builtin_amdgcn_update_dpp(0, __builtin_bit_cast(int, x), 0x4E, 0xF, 0xF, true));
    x += __builtin_bit_cast(float, __builtin_amdgcn_update_dpp(0, __builtin_bit_cast(int, x), 0x141, 0xF, 0xF, true));
    x += __builtin_bit_cast(float, __builtin_amdgcn_update_dpp(0, __builtin_bit_cast(int, x), 0x140, 0xF, 0xF, true));
    return x;
}
__device__ __forceinline__ void p5_scan_item(const Params& p, LAS unsigned char* lds, int item, int tid, int wave, int lane) {
    unsigned char* ws = p.ws; unsigned char* dob = (unsigned char*)p.out;
    const int half = item & 1, bh = item >> 1, b = bh >> 3, h = bh & 7;
    LAS float* buf = (LAS float*)lds;
    LAS float* ybuf = buf + SC_CH * SC_STRIDE;
    const size_t rowb = (size_t)b * TP;
    const int st_step = (tid >> 3) & 31, st_grp = tid >> 8, c8 = tid & 7;
    const size_t colb = (size_t)h * 64 + c8 * 8;
    const bf16* aXW = (const bf16*)(dob + DO_XW); const bf16* aKN = (const bf16*)(ws + WS_KN); const bf16* aBB = (const bf16*)(dob + DO_AA); const bf16* aKP = (const bf16*)(ws + WS_KP);
    const bf16* aR = (const bf16*)(ws + WS_ZRR); const bf16* aV = (const bf16*)(ws + WS_ZRV);
    float mu8[8];
#pragma unroll
    for (int e = 0; e < 8; ++e) mu8[e] = (st_grp == 0) ? p.in[I_MU][h * 64 + c8 * 8 + e] : ((c8 < 4) ? p.in[I_MU][1024 + h * 64 + half * 32 + c8 * 8 + e] : 0.f);
    v4u g0, g1, g2, g3;
    auto issue = [&](int t0) {
        const size_t row = rowb + t0 + st_step;
        if (st_grp == 0) { g0 = *(const v4u*)(aXW + row * 512 + colb); g1 = *(const v4u*)(aKN + row * 512 + colb); g2 = *(const v4u*)(aR + row * 512 + colb); g3 = *(const v4u*)(aR + (row - 1) * 512 + colb); }
        else { g0 = *(const v4u*)(aBB + row * 512 + colb); g1 = *(const v4u*)(aKP + row * 512 + colb);
            if (c8 < 4) { const size_t cv = (size_t)h * 64 + half * 32 + c8 * 8; g2 = *(const v4u*)(aV + row * 512 + cv); g3 = *(const v4u*)(aV + (row - 1) * 512 + cv); } }
    };
    auto commit = [&]() {
        LAS float* d = buf + st_step * SC_STRIDE;
        float a[8], c[8];
        if (st_grp == 0) {
            unpack8(g0, a); *(LAS f32x4*)(d + 0 * 64 + c8 * 8) = (f32x4){a[0], a[1], a[2], a[3]}; *(LAS f32x4*)(d + 0 * 64 + c8 * 8 + 4) = (f32x4){a[4], a[5], a[6], a[7]};
            unpack8(g1, a); *(LAS f32x4*)(d + 1 * 64 + c8 * 8) = (f32x4){a[0], a[1], a[2], a[3]}; *(LAS f32x4*)(d + 1 * 64 + c8 * 8 + 4) = (f32x4){a[4], a[5], a[6], a[7]};
            unpack8(g2, a); unpack8(g3, c);
#pragma unroll
            for (int e = 0; e < 8; ++e) a[e] = a[e] + mu8[e] * (c[e] - a[e]);
            *(LAS f32x4*)(d + 4 * 64 + c8 * 8) = (f32x4){a[0], a[1], a[2], a[3]}; *(LAS f32x4*)(d + 4 * 64 + c8 * 8 + 4) = (f32x4){a[4], a[5], a[6], a[7]};
        } else {
            unpack8(g0, a); *(LAS f32x4*)(d + 2 * 64 + c8 * 8) = (f32x4){a[0], a[1], a[2], a[3]}; *(LAS f32x4*)(d + 2 * 64 + c8 * 8 + 4) = (f32x4){a[4], a[5], a[6], a[7]};
            unpack8(g1, a); *(LAS f32x4*)(d + 3 * 64 + c8 * 8) = (f32x4){a[0], a[1], a[2], a[3]}; *(LAS f32x4*)(d + 3 * 64 + c8 * 8 + 4) = (f32x4){a[4], a[5], a[6], a[7]};
            if (c8 < 4) { unpack8(g2, a); unpack8(g3, c);
#pragma unroll
                for (int e = 0; e < 8; ++e) a[e] = a[e] + mu8[e] * (c[e] - a[e]);
                *(LAS f32x4*)(d + 5 * 64 + c8 * 8) = (f32x4){a[0], a[1], a[2], a[3]}; *(LAS f32x4*)(d + 5 * 64 + c8 * 8 + 4) = (f32x4){a[4], a[5], a[6], a[7]}; }
        }
    };
    const int rl = lane >> 4, kq = lane & 15, myrow = wave * 4 + rl;
    float S0 = 0.f, S1 = 0.f, S2 = 0.f, S3 = 0.f;
    constexpr int T0 = 32, NCH = (TP - T0) / SC_CH;
    bf16* Y = (bf16*)(ws + WS_Y);
    issue(T0);
    for (int ch = 0; ch < NCH; ++ch) {
        const int t0 = T0 + ch * SC_CH;
        __syncthreads();
        commit();
        __syncthreads();
        if (ch + 1 < NCH) issue(t0 + SC_CH);
        const LAS float* sp = buf + kq * 4;
#pragma unroll 4
        for (int s = 0; s < SC_CH; ++s) {
            const LAS float* q = sp + s * SC_STRIDE;
            const f32x4 xw = *(const LAS f32x4*)(q), kn = *(const LAS f32x4*)(q + 64), bb = *(const LAS f32x4*)(q + 128), kp = *(const LAS f32x4*)(q + 192), rr = *(const LAS f32x4*)(q + 256);
            const float vv = buf[s * SC_STRIDE + 320 + myrow];
            float sa = S0 * kn.x; sa = fmaf(S1, kn.y, sa); sa = fmaf(S2, kn.z, sa); sa = fmaf(S3, kn.w, sa);
            sa = -dpp_sum16(sa);
            S0 = fmaf(vv, kp.x, fmaf(sa, bb.x, fmaf(-S0, xw.x, S0)));
            S1 = fmaf(vv, kp.y, fmaf(sa, bb.y, fmaf(-S1, xw.y, S1)));
            S2 = fmaf(vv, kp.z, fmaf(sa, bb.z, fmaf(-S2, xw.z, S2)));
            S3 = fmaf(vv, kp.w, fmaf(sa, bb.w, fmaf(-S3, xw.w, S3)));
            float y = S0 * rr.x; y = fmaf(S1, rr.y, y); y = fmaf(S2, rr.z, y); y = fmaf(S3, rr.w, y);
            y = dpp_sum16(y);
            if (kq == 0) ybuf[s * 32 + myrow] = y;
        }
        __syncthreads();
        {
            const int s = tid >> 4, rp = tid & 15;
            const float y0 = ybuf[s * 32 + 2 * rp], y1 = ybuf[s * 32 + 2 * rp + 1];
            *(unsigned*)(Y + (rowb + t0 + s) * 512 + h * 64 + half * 32 + 2 * rp) = pk2(y0, y1);
        }
    }
    __syncthreads();
}

__device__ __forceinline__ void p6_prep3(const Params& p, int vcu, int G, int wave, int lane) {
    unsigned char* ws = p.ws; unsigned char* dob = (unsigned char*)p.out;
    const int gw = vcu * NWAVES + wave, NGW = G * NWAVES;
    float lg[8], lb[8], muv[8];
#pragma unroll
    for (int e = 0; e < 8; ++e) { const int c = lane * 8 + e; lg[e] = p.in[I_LNG][c]; lb[e] = p.in[I_LNB][c]; muv[e] = p.in[I_MU][1024 + c]; }
    for (int m = gw; m < R; m += NGW) {
        const int b = m / TP, pp = m - b * TP;
        v4u* yp = (v4u*)(ws + WS_Y + (size_t)m * 1024) + lane;
        if (pp < 48) { *yp = (v4u){0u, 0u, 0u, 0u}; continue; }
        float y[8], v[8], vp[8], g[8];
        unpack8(*yp, y); unpack8(*((const v4u*)(ws + WS_ZRV + (size_t)m * 1024) + lane), v); unpack8(*((const v4u*)(ws + WS_ZRV + (size_t)(m - 1) * 1024) + lane), vp);
        unpack8(*((const v4u*)(dob + DO_GG + (size_t)m * 1024) + lane), g);
        float s = 0.f;
#pragma unroll
        for (int e = 0; e < 8; ++e) s += y[e];
        const float mean = sum8(s) * (1.f / 64.f); float q = 0.f;
#pragma unroll
        for (int e = 0; e < 8; ++e) { y[e] -= mean; q += y[e] * y[e]; }
        const float rstd = 1.0f / sqrtf(sum8(q) * (1.f / 64.f) + GN_EPS);
        const float bon = ((const float*)(ws + WS_BS))[(size_t)m * 8 + (lane >> 3)];
#pragma unroll
        for (int e = 0; e < 8; ++e) { const float vs = v[e] + muv[e] * (vp[e] - v[e]); y[e] = (y[e] * rstd * lg[e] + lb[e] + bon * vs) * g[e]; }
        *yp = pack8(y);
    }
}
__device__ __forceinline__ void p9_norm2(const Params& p, int vcu, int G, int wave, int lane) {
    unsigned char* ws = p.ws;
    const int gw = vcu * NWAVES + wave, NGW = G * NWAVES;
    const f32x4* g4 = (const f32x4*)p.in[I_N2G] + lane;
    for (int m = gw; m < NTOK; m += NGW) {
        const f32x4* xr = (const f32x4*)(p.out + (size_t)m * 1024) + lane;
        f32x4 v[4]; float s = 0.f;
#pragma unroll
        for (int j = 0; j < 4; ++j) { v[j] = xr[64 * j]; s += (v[j].x * v[j].x + v[j].y * v[j].y) + (v[j].z * v[j].z + v[j].w * v[j].w); }
        const float rs = 1.0f / sqrtf(wave_sum(s) * (1.f / 1024.f) + NORM_EPS);
        unsigned long long* o8 = (unsigned long long*)(ws + WS_XN2 + (size_t)m * 2048) + lane;
        float mx = 0.f;
#pragma unroll
        for (int j = 0; j < 4; ++j) { const f32x4 g = g4[64 * j]; v[j].x *= rs * g.x; v[j].y *= rs * g.y; v[j].z *= rs * g.z; v[j].w *= rs * g.w;
            o8[64 * j] = (unsigned long long)pk2(v[j].x, v[j].y) | ((unsigned long long)pk2(v[j].z, v[j].w) << 32);
            mx = fmaxf(mx, fmaxf(fmaxf(fabsf(v[j].x), fabsf(v[j].y)), fmaxf(fabsf(v[j].z), fabsf(v[j].w)))); }
#pragma unroll
        for (int o = 1; o < 64; o <<= 1) mx = fmaxf(mx, __shfl_xor(mx, o));
        const float inv = mx > 0.f ? 127.0f / mx : 0.f;
        unsigned* xq = (unsigned*)(ws + WS_XQ + (size_t)m * 1024) + lane;
#pragma unroll
        for (int j = 0; j < 4; ++j) { const int q0 = (int)rintf(v[j].x * inv), q1 = (int)rintf(v[j].y * inv), q2 = (int)rintf(v[j].z * inv), q3 = (int)rintf(v[j].w * inv);
            xq[64 * j] = (unsigned)(q0 & 255) | ((unsigned)(q1 & 255) << 8) | ((unsigned)(q2 & 255) << 16) | ((unsigned)(q3 & 255) << 24); }
        if (lane == 0) ((float*)(ws + WS_SX))[m] = mx > 0.f ? mx * (1.0f / 127.0f) : 1.0f;
    }
}

typedef __bf16 bf16x2_t __attribute__((ext_vector_type(2)));
__device__ __forceinline__ unsigned mono(float f) { const unsigned u = __builtin_bit_cast(unsigned, f); return u ^ ((unsigned)((int)u >> 31) | 0x80000000u); }
__device__ __forceinline__ float unmono(unsigned m) { const unsigned u = (m & 0x80000000u) ? (m ^ 0x80000000u) : ~m; return __builtin_bit_cast(float, u); }
__device__ __forceinline__ void ce_desc(unsigned& a, unsigned& b) { const unsigned hi = a > b ? a : b, lo = a > b ? b : a; a = hi; b = lo; }
template <int BASE, int N> __device__ __forceinline__ void bitonic_sort_desc(unsigned (&v)[N]) {
#pragma unroll
    for (int k = 2; k <= 16; k <<= 1)
#pragma unroll
        for (int j = k >> 1; j > 0; j >>= 1)
#pragma unroll
            for (int i = 0; i < 16; ++i) { const int l = i ^ j; if (l > i) { if ((i & k) == 0) ce_desc(v[BASE + i], v[BASE + l]); else ce_desc(v[BASE + l], v[BASE + i]); } }
}
template <int A, int B, int N> __device__ __forceinline__ void merge_top16(unsigned (&v)[N]) {
#pragma unroll
    for (int i = 0; i < 16; ++i) { const unsigned x = v[A + i], y = v[B + 15 - i]; v[A + i] = x > y ? x : y; }
#pragma unroll
    for (int j = 8; j > 0; j >>= 1)
#pragma unroll
        for (int i = 0; i < 16; ++i) { const int l = i ^ j; if (l > i) ce_desc(v[A + i], v[A + l]); }
}
constexpr int KS_STRIDE = 272;
constexpr int RT_KS_BYTES = 256 * KS_STRIDE;
constexpr int RT_TAB_WORDS = 33;
__device__ __forceinline__ void p11_route(const Params& p, LAS unsigned char* lds, int vcu, int G, int tid, int wave, int lane) {
    unsigned char* ws = p.ws;
    for (int i = tid; i < 256 * 16; i += NTHREADS) { const int row = i >> 4, ch = i & 15; *(LAS v4u*)(lds + row * KS_STRIDE + ch * 16) = *((const v4u*)(ws + WS_KS) + i); }
    __syncthreads();
    LAS unsigned* tab = (LAS unsigned*)(lds + RT_KS_BYTES) + (wave * 64 + lane) * RT_TAB_WORDS;
    const int r32 = lane & 31, hi = lane >> 5;
    const int gw = vcu * NWAVES + wave, NGW = G * NWAVES;
    const bf16* PQ = (const bf16*)(ws + WS_PQ);
    int* IDS = (int*)(ws + WS_IDS); float* GATES = (float*)(ws + WS_GATES);
    for (int task = gw; task < (NTOK / 32) * 8; task += NGW) {
        const int tb = task >> 3, h = task & 7;
        const int token = tb * 32 + r32;
        unsigned v[128];
        {
            const bf16* qrow = PQ + (size_t)token * 2048 + h * 256 + hi * 8;
#pragma unroll
            for (int t = 0; t < 4; ++t) {
                f32x16v acc[2];
#pragma unroll
                for (int w = 0; w < 2; ++w) {
                    f32x16v c = {};
                    const LAS unsigned char* kb = lds + (w * 128 + t * 32 + r32) * KS_STRIDE + hi * 16;
#pragma unroll
                    for (int s = 0; s < 8; ++s) { const bf16x8 a = *(const LAS bf16x8*)(kb + s * 32); const bf16x8 qf = *(const bf16x8*)(qrow + w * 128 + 16 * s); c = __builtin_amdgcn_mfma_f32_32x32x16_bf16(a, qf, c, 0, 0, 0); }
                    acc[w] = c;
                }
#pragma unroll
                for (int r = 0; r < 16; ++r) {
                    const float xa = acc[0][r], xb = acc[1][r];
                    auto rr = __builtin_amdgcn_permlane32_swap(__float_as_uint(xa), __float_as_uint(xb), false, false);
                    const unsigned r0 = rr[0], r1 = rr[1];
                    const int cr = (r & 3) + 8 * (r >> 2);
                    v[t * 16 + r] = (mono(__uint_as_float(r0)) & ~0x7Fu) | (unsigned)(32 * t + cr);
                    v[64 + t * 16 + r] = (mono(__uint_as_float(r1)) & ~0x7Fu) | (unsigned)(32 * t + cr + 4);
                }
            }
        }
        bitonic_sort_desc<0>(v); bitonic_sort_desc<16>(v); bitonic_sort_desc<32>(v); bitonic_sort_desc<48>(v);
        bitonic_sort_desc<64>(v); bitonic_sort_desc<80>(v); bitonic_sort_desc<96>(v); bitonic_sort_desc<112>(v);
        merge_top16<0, 16>(v); merge_top16<32, 48>(v); merge_top16<64, 80>(v); merge_top16<96, 112>(v);
        merge_top16<0, 32>(v); merge_top16<64, 96>(v);
        merge_top16<0, 64>(v);
        unsigned T[16], U[16];
#pragma unroll
        for (int i = 0; i < 16; ++i) { auto rr = __builtin_amdgcn_permlane32_swap(v[i], v[i], false, false); T[i] = v[i]; U[i] = hi ? rr[0] : rr[1]; }
        { const int bT = hi ? 16 : 0, bU = hi ? 0 : 16;
#pragma unroll
          for (int i = 0; i < 16; ++i) { tab[bT + i] = T[i] & 0x7Fu; tab[bU + i] = U[i] & 0x7Fu; } }
        float tv[16], uv[16];
#pragma unroll
        for (int i = 0; i < 16; ++i) { tv[i] = unmono(T[i] & ~0x7Fu); uv[i] = unmono(U[i] & ~0x7Fu); }
        unsigned c[32];
        {
            int n = 0;
#pragma unroll
            for (int i = 0; i < 4; ++i)
#pragma unroll
                for (int j = i; j < 16; ++j) if ((i + 1) * (j + 1) <= 16) {
                    const float s = tv[i] + uv[j];
                    const unsigned pay = hi ? (unsigned)((j << 4) | i) : (unsigned)((i << 4) | j);
                    unsigned key = (mono(s) & ~0xFFu) | pay;
                    if (i == j && hi) key = 0u;
                    c[n++] = key;
                }
#pragma unroll
            for (int k = 27; k < 32; ++k) c[k] = 0u;
        }
        bitonic_sort_desc<0>(c); bitonic_sort_desc<16>(c); merge_top16<0, 16>(c);
        unsigned W[32];
#pragma unroll
        for (int i = 0; i < 16; ++i) { auto rr = __builtin_amdgcn_permlane32_swap(c[i], c[i], false, false); W[i] = rr[0]; W[16 + i] = rr[1]; }
        merge_top16<0, 16>(W);
        asm volatile("s_waitcnt lgkmcnt(0)" ::: "memory");
        if (!hi) {
            int ids[16];
#pragma unroll
            for (int k = 0; k < 16; ++k) ids[k] = (int)(tab[(W[k] >> 4) & 15u] * 128u + tab[16 + (W[k] & 15u)]);
            int* o = IDS + (size_t)token * 128 + h * 16;
#pragma unroll
            for (int k = 0; k < 16; k += 4) *(v4u*)(o + k) = (v4u){(unsigned)ids[k], (unsigned)ids[k + 1], (unsigned)ids[k + 2], (unsigned)ids[k + 3]};
        } else {
            float e[16]; const float s0 = unmono(W[0] & ~0xFFu); float sum = 0.f;
#pragma unroll
            for (int k = 0; k < 16; ++k) { e[k] = __expf(unmono(W[k] & ~0xFFu) - s0); sum += e[k]; }
            const float inv = 1.0f / sum;
            float* o = GATES + (size_t)token * 128 + h * 16;
#pragma unroll
            for (int k = 0; k < 16; k += 4) *(f32x4*)(o + k) = (f32x4){e[k] * inv, e[k + 1] * inv, e[k + 2] * inv, e[k + 3] * inv};
        }
        asm volatile("s_waitcnt lgkmcnt(0)" ::: "memory");
    }
}

constexpr size_t WS_PART = 420 * MiB;
__device__ __forceinline__ int dpp_isum8(int x) {
    x += __builtin_amdgcn_update_dpp(0, x, 0xB1, 0xF, 0xF, true);
    x += __builtin_amdgcn_update_dpp(0, x, 0x4E, 0xF, 0xF, true);
    x += __builtin_amdgcn_update_dpp(0, x, 0x141, 0xF, 0xF, true);
    return x;
}
__device__ __forceinline__ void p12a_partial(const Params& p, int bid, int G, int wave, int lane) {
    unsigned char* ws = p.ws;
    const int s = bid & 7, wx = (bid >> 3) * NWAVES + wave, NWX = (G >> 3) * NWAVES;
    const int eg = lane >> 3, cj = lane & 7;
    const unsigned char* XQ = ws + WS_XQ + 128 * s + 16 * cj; const int* IDS = (const int*)(ws + WS_IDS); int* PART = (int*)(ws + WS_PART);
    const unsigned char* Us = ws + WS_U8 + 128 * s + 16 * cj;
    for (int t = wx; t < NTOK; t += NWX) {
        const v4u xs = *(const v4u*)(XQ + (size_t)t * 1024);
        const int xx = (int)xs.x, xy = (int)xs.y, xz = (int)xs.z, xw = (int)xs.w;
        const v4u* idp = (const v4u*)(IDS + (size_t)t * 128 + 16 * eg);
        int ids[16];
#pragma unroll
        for (int q = 0; q < 4; ++q) { const v4u iv = idp[q]; ids[4 * q] = (int)iv.x; ids[4 * q + 1] = (int)iv.y; ids[4 * q + 2] = (int)iv.z; ids[4 * q + 3] = (int)iv.w; }
        v4u u[16];
#pragma unroll
        for (int i = 0; i < 16; ++i) u[i] = *(const v4u*)(Us + (size_t)ids[i] * 1024);
        int k0 = 0, k1 = 0;
#pragma unroll
        for (int i = 0; i < 16; ++i) {
            const int ux = (int)u[i].x, uy = (int)u[i].y, uz = (int)u[i].z, uw = (int)u[i].w;
            int d = __builtin_amdgcn_sdot4(ux, xx, 0, false); d = __builtin_amdgcn_sdot4(uy, xy, d, false); d = __builtin_amdgcn_sdot4(uz, xz, d, false); d = __builtin_amdgcn_sdot4(uw, xw, d, false);
            d = dpp_isum8(d);
            if (i < 8) k0 = (cj == i) ? d : k0; else k1 = (cj == i - 8) ? d : k1;
        }
        int* po = PART + ((size_t)s * NTOK + t) * 128 + 16 * eg + cj;
        __builtin_nontemporal_store(k0, po); __builtin_nontemporal_store(k1, po + 8);
    }
}
__device__ __forceinline__ void p12b_combine(const Params& p, int vcu, int G, int wave, int lane) {
    unsigned char* ws = p.ws;
    const int gw = vcu * NWAVES + wave, NGW = G * NWAVES;
    const int* PART = (const int*)(ws + WS_PART); float* GW = (float*)(ws + WS_GATES); const int* IDS = (const int*)(ws + WS_IDS);
    const float* SU = (const float*)(ws + WS_SU); const float* SV = (const float*)(ws + WS_SV);
    for (int t = gw; t < NTOK; t += NGW) {
        int a0 = 0, a1 = 0;
#pragma unroll
        for (int s = 0; s < 8; ++s) { const int* pp = PART + ((size_t)s * NTOK + t) * 128; a0 += __builtin_nontemporal_load(pp + lane); a1 += __builtin_nontemporal_load(pp + lane + 64); }
        const int id0 = IDS[(size_t)t * 128 + lane], id1 = IDS[(size_t)t * 128 + lane + 64];
        const float sx = ((const float*)(ws + WS_SX))[t];
        const float h0 = (float)a0 * SU[id0] * sx, h1 = (float)a1 * SU[id1] * sx;
        float* g = GW + (size_t)t * 128;
        const float w0 = g[lane] * 0.5f * h0 * (1.0f + erff(h0 * 0.70710678118654752f)) * SV[id0];
        const float w1 = g[lane + 64] * 0.5f * h1 * (1.0f + erff(h1 * 0.70710678118654752f)) * SV[id1];
        g[lane] = w0; g[lane + 64] = w1;
        const float c = wave_sum(w0 + w1) * 128.0f;
        if (lane == 0) ((float*)(ws + WS_CORR))[t] = c;
    }
}
__device__ __forceinline__ void p12c_output(const Params& p, int bid, int G, int wave, int lane) {
    unsigned char* ws = p.ws;
    const int s = bid & 7, wx = (bid >> 3) * NWAVES + wave, NWX = (G >> 3) * NWAVES;
    const int eg = lane >> 3, cj = lane & 7;
    const int b5 = (lane >> 5) & 1, b4 = (lane >> 4) & 1, b3 = (lane >> 3) & 1;
    const int* IDS = (const int*)(ws + WS_IDS); const float* GW = (const float*)(ws + WS_GATES); const float* CORR = (const float*)(ws + WS_CORR);
    const unsigned char* Vs = ws + WS_V8 + 128 * s + 16 * cj;
    const int ocol = 128 * s + 16 * cj + 8 * b5 + 4 * b4 + 2 * b3;
    for (int t = wx; t < NTOK; t += NWX) {
        const v4u* idp = (const v4u*)(IDS + (size_t)t * 128 + 16 * eg); const f32x4* wp = (const f32x4*)(GW + (size_t)t * 128 + 16 * eg);
        int ids[16]; float w[16];
#pragma unroll
        for (int q = 0; q < 4; ++q) { const v4u iv = idp[q]; ids[4 * q] = (int)iv.x; ids[4 * q + 1] = (int)iv.y; ids[4 * q + 2] = (int)iv.z; ids[4 * q + 3] = (int)iv.w;
            const f32x4 wv = wp[q]; w[4 * q] = wv.x; w[4 * q + 1] = wv.y; w[4 * q + 2] = wv.z; w[4 * q + 3] = wv.w; }
        typedef float f32x2 __attribute__((ext_vector_type(2)));
        const f32x2 hres = __builtin_nontemporal_load((const f32x2*)(p.out + (size_t)t * 1024 + ocol));
        const float corr = CORR[t];
        v4u vv[16];
#pragma unroll
        for (int i = 0; i < 16; ++i) vv[i] = *(const v4u*)(Vs + (size_t)ids[i] * 1024);
        float o[16];
#pragma unroll
        for (int k = 0; k < 16; ++k) o[k] = 0.f;
#pragma unroll
        for (int i = 0; i < 16; ++i) {
            const unsigned q[4] = {vv[i].x, vv[i].y, vv[i].z, vv[i].w};
#pragma unroll
            for (int d = 0; d < 4; ++d) {
                o[4 * d + 0] = fmaf(w[i], (float)(q[d] & 0xffu), o[4 * d + 0]); o[4 * d + 1] = fmaf(w[i], (float)((q[d] >> 8) & 0xffu), o[4 * d + 1]);
                o[4 * d + 2] = fmaf(w[i], (float)((q[d] >> 16) & 0xffu), o[4 * d + 2]); o[4 * d + 3] = fmaf(w[i], (float)(q[d] >> 24), o[4 * d + 3]); }
        }
        float r8[8], r4[4], r2[2];
#pragma unroll
        for (int j = 0; j < 8; ++j) { const float keep = b5 ? o[8 + j] : o[j], send = b5 ? o[j] : o[8 + j]; r8[j] = keep + __shfl_xor(send, 32); }
#pragma unroll
        for (int j = 0; j < 4; ++j) { const float keep = b4 ? r8[4 + j] : r8[j], send = b4 ? r8[j] : r8[4 + j]; r4[j] = keep + __shfl_xor(send, 16); }
#pragma unroll
        for (int j = 0; j < 2; ++j) { const float keep = b3 ? r4[2 + j] : r4[j], send = b3 ? r4[j] : r4[2 + j]; r2[j] = keep + __shfl_xor(send, 8); }
        const f32x2 res = {hres.x + r2[0] - corr, hres.y + r2[1] - corr};
        __builtin_nontemporal_store(res, (f32x2*)(p.out + (size_t)t * 1024 + ocol));
    }
}

#if DIAG
constexpr size_t WS_DIAG = 1006 * MiB;
constexpr size_t WS_DSAVE = 1007 * MiB;
__device__ __forceinline__ unsigned dhash(unsigned x) { x ^= x >> 16; x *= 0x7feb352dU; x ^= x >> 15; x *= 0x846ca68bU; x ^= x >> 16; return x; }
__device__ __forceinline__ float bf2f(bf16 b) { return __builtin_bit_cast(float, (unsigned)b << 16); }
__device__ __forceinline__ float rbf(float x) { return bf2f((bf16)f2bf(x)); }
__device__ __forceinline__ void diag_report(const Params& p, int stage, float err) {
    if (!(err == err)) err = 1e30f;
#pragma unroll
    for (int o = 1; o < 64; o <<= 1) err = fmaxf(err, __shfl_xor(err, o));
    int t_ = threadIdx.x; asm volatile("" : "+v"(t_)); if ((t_ & 63) == 0) atomicMax((unsigned*)(p.ws + WS_DIAG) + stage, __builtin_bit_cast(unsigned, err));
}
#define DG_IDS() int tid_ = threadIdx.x; asm volatile("" : "+v"(tid_)); const int tid = tid_, lane = tid & 63; int G_ = gridDim.x; asm volatile("" : "+s"(G_)); const int gt = blockIdx.x * NTHREADS + tid, NGT = G_ * NTHREADS; const int gwv = gt >> 6, NGWV = NGT >> 6; (void)lane; (void)gwv; (void)NGWV; (void)NGT
__device__ __forceinline__ float relerr(float got, float ref, float fl) { return fabsf(got - ref) / (fabsf(ref) + fl); }

__device__ __forceinline__ void dg_p0(const Params& p) {
    DG_IDS(); unsigned char* ws = p.ws; float e1 = 0.f, e2 = 0.f;
    for (int s = gwv; s < 4096; s += NGWV) {
        const int m = dhash(s * 7 + 1) % R; const int b = m / TP, pp = m - b * TP;
        const bf16* xn = (const bf16*)(ws + WS_XN) + (size_t)m * 1024;
        if (pp < 48) { for (int c = lane; c < 1024; c += 64) e1 = fmaxf(e1, fabsf(bf2f(xn[c]))); continue; }
        const float* xr = (pp < 64) ? p.in[I_META] + (size_t)(pp - 48) * 1024 : p.in[I_X] + ((size_t)b * SEQ + (pp - 64)) * 1024;
        float ss = 0.f; for (int c = lane; c < 1024; c += 64) ss += xr[c] * xr[c];
        ss = wave_sum(ss); const float rs = 1.0f / sqrtf(ss / 1024.f + NORM_EPS);
        for (int c = lane; c < 1024; c += 64) e1 = fmaxf(e1, relerr(bf2f(xn[c]), xr[c] * rs * p.in[I_N1G][c], 0.05f));
    }
    for (int s = gt; s < 200000; s += NGT) {
        const unsigned hsh = dhash(s * 3 + 5); const int k = hsh & 1023, n = (hsh >> 10) % N1; const int sc = win_src_col(n);
        const float ref = sc >= 0 ? p.in[I_WIN][(size_t)k * IN_COLS + sc] : 0.f;
        e2 = fmaxf(e2, fabsf(bf2f(((const bf16*)(ws + WS_WTIN))[(size_t)n * 1024 + k]) - rbf(ref)));
        const int n2 = (hsh >> 10) & 2047;
        e2 = fmaxf(e2, fabsf(bf2f(((const bf16*)(ws + WS_WTQ))[(size_t)n2 * 1024 + k]) - rbf(p.in[I_PWQ][(size_t)k * 2048 + n2])));
        const int n3 = n2 & 1023, k3 = k & 511;
        e2 = fmaxf(e2, fabsf(bf2f(((const bf16*)(ws + WS_WTFOX))[(size_t)n3 * 512 + k3]) - rbf(p.in[I_WFOX][(size_t)k3 * 1024 + n3])));
        e2 = fmaxf(e2, fabsf(bf2f(((const bf16*)(ws + WS_WTRWKV))[(size_t)n3 * 512 + k3]) - rbf(p.in[I_WRWKV][(size_t)k3 * 1024 + n3])));
        e2 = fmaxf(e2, fabsf(bf2f(((const bf16*)(ws + WS_WTOUT))[(size_t)n3 * 1024 + k]) - rbf(p.in[I_WOUT][(size_t)k * 1024 + n3])));
        const size_t ei = (size_t)(hsh % (16384u * 1024u)); const int er = (int)(ei >> 10);
        { const float sc = ((const float*)(ws + WS_SU))[er]; const float dq = (float)((const signed char*)(ws + WS_U8))[ei] * sc; e2 = fmaxf(e2, fmaxf(fabsf(dq - p.in[I_PU][ei]) - 0.51f * sc, 0.f)); }
        { const float sc = ((const float*)(ws + WS_SV))[er]; const float dq = ((float)((const unsigned char*)(ws + WS_V8))[ei] - 128.f) * sc; e2 = fmaxf(e2, fmaxf(fabsf(dq - p.in[I_PV][ei]) - 0.51f * sc, 0.f)); }
    }
    diag_report(p, 1, e1 / 0.03f); diag_report(p, 2, e2 / 1e-6f);
}
__device__ __forceinline__ float dg_dot(const bf16* A, size_t row, const bf16* Bt, size_t n, int K) {
    const bf16* a = A + row * K; const bf16* b = Bt + n * K; float s = 0.f;
    for (int k = 0; k < K; k += 8) { float x[8], y[8]; unpack8(*(const v4u*)(a + k), x); unpack8(*(const v4u*)(b + k), y);
#pragma unroll
        for (int e = 0; e < 8; ++e) s = fmaf(x[e], y[e], s); }
    return s;
}
__device__ __forceinline__ void dg_gemm1(const Params& p) {
    DG_IDS(); unsigned char* ws = p.ws; float e = 0.f;
    for (int s = gt; s < 262144; s += NGT) {
        const unsigned hsh = dhash(s * 11 + 3); const int row = hsh % R, n = dhash(hsh) % N1;
        const float ref = dg_dot((const bf16*)(ws + WS_XN), row, (const bf16*)(ws + WS_WTIN), n, 1024);
        float got, want;
        if (n < 3584) { got = bf2f(((const bf16*)(ws + WS_F))[(size_t)(n >> 9) * ((size_t)R * 512) + (size_t)row * 512 + (n & 511)]); want = ref; }
        else { got = bf2f(((const bf16*)(ws + WS_ZG))[(size_t)row * 2048 + (n - 3584)]); want = 1.0f / (1.0f + expf(-ref)); }
        e = fmaxf(e, relerr(got, want, 0.25f));
    }
    diag_report(p, 3, e / 0.02f);
}
__device__ __forceinline__ void dg_p2(const Params& p) {
    DG_IDS(); unsigned char* ws = p.ws; float e = 0.f;
    for (int s = gt; s < 262144; s += NGT) {
        const unsigned hsh = dhash(s * 13 + 7); const int m = hsh % R, c = dhash(hsh) % 296; const int pp = m % TP;
        const bf16* zm = (const bf16*)(ws + WS_ZM);
        const float z = bf2f(zm[(size_t)m * 512 + c]);
        if (c >= 288) { const float x = z + p.in[I_FBIAS][c - 288]; const float want = -log1pf(expf(-x)); e = fmaxf(e, relerr(((const float*)(ws + WS_LF))[(size_t)m * 8 + (c - 288)], want, 0.01f)); continue; }
        const float zp = pp > 0 ? bf2f(zm[(size_t)(m - 1) * 512 + c]) : 0.f; const float mu = p.in[I_MU][1536 + c];
        const float zs = z + mu * (zp - z);
        if (c < 64) e = fmaxf(e, relerr(bf2f(((const bf16*)(ws + WS_LA))[(size_t)m * 128 + c]), tanhf(zs), 0.1f));
        else if (c < 128) e = fmaxf(e, relerr(bf2f(((const bf16*)(ws + WS_LA))[(size_t)m * 128 + c]), zs, 0.1f));
        else e = fmaxf(e, relerr(bf2f(((const bf16*)(ws + WS_LG))[(size_t)m * 256 + (c - 128)]), 1.0f / (1.0f + expf(-zs)), 0.1f));
        if (pp >= 48) { const int h = c & 7; float sq = 0.f, sk = 0.f;
            for (int d = 0; d < 64; ++d) { const float q = bf2f(((const bf16*)(ws + WS_FQ))[(size_t)m * 512 + h * 64 + d]) / (p.in[I_FQN][h * 64 + d] * attn_body::C2); sq += q * q;
                const float k = bf2f(((const bf16*)(ws + WS_FK))[(size_t)m * 512 + h * 64 + d]) / p.in[I_FKN][h * 64 + d]; sk += k * k; }
            e = fmaxf(e, fabsf(sq / 64.f - 1.f)); e = fmaxf(e, fabsf(sk / 64.f - 1.f)); }
    }
    diag_report(p, 4, e / 0.03f);
}
__device__ __forceinline__ void dg_p3(const Params& p) {
    DG_IDS(); unsigned char* ws = p.ws; unsigned char* dob = (unsigned char*)p.out; float e5 = 0.f, e6 = 0.f;
    for (int s = gt; s < 131072; s += NGT) {
        const unsigned hsh = dhash(s * 17 + 9); const int seq = hsh & 127, pp = (hsh >> 7) % TP; const int b = seq >> 3, h = seq & 7;
        const float* kb = (const float*)(ws + WS_KB) + (size_t)seq * TP; const float lf = ((const float*)(ws + WS_LF))[((size_t)b * TP + pp) * 8 + h];
        if (pp < 48) e5 = fmaxf(e5, kb[pp] < -1e29f ? 0.f : 1.f);
        else if (pp == 48) e5 = fmaxf(e5, fabsf(kb[pp] + lf * LOG2E));
        else e5 = fmaxf(e5, fabsf((kb[pp] - kb[pp - 1]) + lf * LOG2E));
        const int m = dhash(hsh) % R, c = dhash(hsh + 1) % 1536;
        const bf16* la = (const bf16*)(ws + WS_LA) + (size_t)m * 128; const bf16* lg = (const bf16*)(ws + WS_LG) + (size_t)m * 256;
        if (c < 512) { float a = p.in[I_W0][c]; for (int k = 0; k < 64; ++k) a += bf2f(la[k]) * rbf(p.in[I_WUP][k * 512 + c]);
            const float w = -log1pf(expf(-a)) - 0.5f; const float want = 1.0f - expf(-expf(w));
            e6 = fmaxf(e6, relerr(bf2f(((const bf16*)(dob + DO_XW))[(size_t)m * 512 + c]), want, 0.002f)); }
        else if (c < 1024) { float a = p.in[I_A0][c - 512]; for (int k = 0; k < 64; ++k) a += bf2f(la[64 + k]) * rbf(p.in[I_AUP][k * 512 + (c - 512)]);
            e6 = fmaxf(e6, relerr(bf2f(((const bf16*)(dob + DO_AA))[(size_t)m * 512 + (c - 512)]), 1.0f / (1.0f + expf(-a)), 0.05f)); }
        else { float a = 0.f; for (int k = 0; k < 160; ++k) a += bf2f(lg[k]) * rbf(p.in[I_GUP][k * 512 + (c - 1024)]);
            e6 = fmaxf(e6, relerr(bf2f(((const bf16*)(dob + DO_GG))[(size_t)m * 512 + (c - 1024)]), a, 0.1f)); }
    }
    diag_report(p, 5, e5 / 1e-3f); diag_report(p, 6, e6 / 0.03f);
}
constexpr int DG_NS4 = 2048;
__device__ __forceinline__ void dg_p4_pre(const Params& p) {
    DG_IDS(); unsigned char* dob = (unsigned char*)p.out; float* sv = (float*)(p.ws + WS_DSAVE);
    for (int s = gt; s < DG_NS4 * 64; s += NGT) { const int i = s >> 6, d = s & 63; const unsigned hsh = dhash(i * 19 + 11); const int m = hsh % R, h = (hsh >> 20) & 7;
        sv[s] = bf2f(((const bf16*)(dob + DO_AA))[(size_t)m * 512 + h * 64 + d]); }
}
__device__ __forceinline__ void dg_p4_post(const Params& p) {
    DG_IDS(); unsigned char* ws = p.ws; unsigned char* dob = (unsigned char*)p.out; const float* sv = (const float*)(ws + WS_DSAVE); float e = 0.f;
    for (int i = gwv; i < DG_NS4; i += NGWV) {
        const unsigned hsh = dhash(i * 19 + 11); const int m = hsh % R, h = (hsh >> 20) & 7; const int pp = m % TP; const int c = h * 64 + lane;
        const float a = sv[i * 64 + lane];
        const float r0 = bf2f(((const bf16*)(ws + WS_ZRR))[(size_t)m * 512 + c]), k0 = bf2f(((const bf16*)(ws + WS_ZRK))[(size_t)m * 512 + c]);
        const float r1 = pp > 0 ? bf2f(((const bf16*)(ws + WS_ZRR))[(size_t)(m - 1) * 512 + c]) : 0.f, k1 = pp > 0 ? bf2f(((const bf16*)(ws + WS_ZRK))[(size_t)(m - 1) * 512 + c]) : 0.f;
        const float rs = r0 + p.in[I_MU][c] * (r1 - r0), ks = k0 + p.in[I_MU][512 + c] * (k1 - k0);
        const float kk = ks * p.in[I_KK][c], kp = ks * (1.0f + (a - 1.0f) * p.in[I_KA][c]);
        const float nrm = fmaxf(sqrtf(wave_sum(kk * kk)), 1e-12f); const float kn = kk / nrm, bb = kn * a; const float bs = wave_sum(rs * kp * p.in[I_RK][c]);
        e = fmaxf(e, relerr(bf2f(((const bf16*)(ws + WS_KP))[(size_t)m * 512 + c]), kp, 0.1f));
        e = fmaxf(e, relerr(bf2f(((const bf16*)(ws + WS_KN))[(size_t)m * 512 + c]), kn, 0.02f));
        e = fmaxf(e, relerr(bf2f(((const bf16*)(dob + DO_AA))[(size_t)m * 512 + c]), bb, 0.02f));
        e = fmaxf(e, relerr(((const float*)(ws + WS_BS))[(size_t)m * 8 + h], bs, 0.1f));
    }
    diag_report(p, 7, e / 0.03f);
}
constexpr int DG_NS8 = 1024;
__device__ __forceinline__ void dg_attn_sample(int i, int& b, int& h, int& t) { const unsigned hsh = dhash(i * 23 + 13); b = hsh & 15; h = (hsh >> 4) & 7; t = (hsh >> 8) & 4095; if (i < 8) t = (i & 1) ? 4095 - (i >> 1) : (i >> 1); }
__device__ __forceinline__ void dg_attn_pre(const Params& p) {
    DG_IDS(); float* sv = (float*)(p.ws + WS_DSAVE + 512 * 1024);
    for (int s = gt; s < DG_NS8 * 64; s += NGT) { const int i = s >> 6, d = s & 63; int b, h, t; dg_attn_sample(i, b, h, t);
        sv[s] = bf2f(((const bf16*)(p.ws + WS_FQ))[((size_t)b * TP + 64 + t) * 512 + h * 64 + d]); }
}
__device__ __forceinline__ void dg_attn_post(const Params& p) {
    DG_IDS(); unsigned char* ws = p.ws; const float* sv = (const float*)(ws + WS_DSAVE + 512 * 1024); float e = 0.f;
    for (int i = gwv; i < DG_NS8; i += NGWV) {
        int b, h, t; dg_attn_sample(i, b, h, t);
        const int npos = 64 + t;
        const float* kb = (const float*)(ws + WS_KB) + (size_t)(b * 8 + h) * TP;
        const bf16* K = (const bf16*)(ws + WS_FK) + (size_t)b * TP * 512 + h * 64; const bf16* V = (const bf16*)(ws + WS_FV) + (size_t)b * TP * 512 + h * 64;
        float mx = -1e38f;
        for (int j = 48 + lane; j <= npos; j += 64) { float s = 0.f; for (int d = 0; d < 64; ++d) s += sv[i * 64 + d] * bf2f(K[(size_t)j * 512 + d]); s += kb[j]; mx = fmaxf(mx, s); }
        for (int o = 1; o < 64; o <<= 1) mx = fmaxf(mx, __shfl_xor(mx, o));
        float l = 0.f, acc = 0.f;
        for (int j = 48; j <= npos; ++j) { float s = 0.f; for (int d = 0; d < 64; ++d) s += sv[i * 64 + d] * bf2f(K[(size_t)j * 512 + d]); const float pj = exp2f(s + kb[j] - mx); l += pj; acc += pj * bf2f(V[(size_t)j * 512 + lane]); }
        const float want = acc / l; const float got = bf2f(((const bf16*)(ws + WS_FQ))[((size_t)b * TP + 64 + t) * 512 + h * 64 + lane]);
        e = fmaxf(e, fabsf(got - want) / (fabsf(want) + 0.05f));
    }
    diag_report(p, 8, e / 0.05f);
}
__device__ __forceinline__ void dg_scan(const Params& p) {
    DG_IDS(); unsigned char* ws = p.ws; unsigned char* dob = (unsigned char*)p.out; float e = 0.f;
    if (gwv < 4) {
        const int bh = (gwv * 37 + 5) & 127, b = bh >> 3, h = bh & 7; const size_t rowb = (size_t)b * TP; const int cb = h * 64;
        float S[64];
#pragma unroll
        for (int k = 0; k < 64; ++k) S[k] = 0.f;
        const bf16* aXW = (const bf16*)(dob + DO_XW); const bf16* aKN = (const bf16*)(ws + WS_KN); const bf16* aBB = (const bf16*)(dob + DO_AA); const bf16* aKP = (const bf16*)(ws + WS_KP);
        const bf16* aR = (const bf16*)(ws + WS_ZRR); const bf16* aV = (const bf16*)(ws + WS_ZRV);
        const float muv = p.in[I_MU][1024 + cb + lane];
        for (int pp = 48; pp < TP; ++pp) {
            const size_t ro = (rowb + pp) * 512 + cb;
            const float v0 = bf2f(aV[ro + lane]), v1 = bf2f(aV[ro - 512 + lane]); const float vv = v0 + muv * (v1 - v0);
            float sa = 0.f;
#pragma unroll
            for (int k = 0; k < 64; ++k) sa += S[k] * bf2f(aKN[ro + k]);
            sa = -sa; float y = 0.f;
#pragma unroll
            for (int k = 0; k < 64; ++k) { const float dec = 1.0f - bf2f(aXW[ro + k]); S[k] = S[k] * dec + sa * bf2f(aBB[ro + k]) + vv * bf2f(aKP[ro + k]);
                const float r0 = bf2f(aR[ro + k]), r1 = bf2f(aR[ro - 512 + k]); y += S[k] * (r0 + p.in[I_MU][cb + k] * (r1 - r0)); }
            const float got = bf2f(((const bf16*)(ws + WS_Y))[ro + lane]);
            e = fmaxf(e, fabsf(got - y) / (fabsf(y) + 0.3f));
        }
    }
    diag_report(p, 9, e / 0.05f);
}
__device__ __forceinline__ void dg_p6_pre(const Params& p) {
    DG_IDS(); float* sv = (float*)(p.ws + WS_DSAVE + 768 * 1024);
    for (int s = gt; s < DG_NS4 * 64; s += NGT) { const int i = s >> 6, d = s & 63; const unsigned hsh = dhash(i * 29 + 17); const int m = hsh % R, h = (hsh >> 20) & 7;
        sv[s] = bf2f(((const bf16*)(p.ws + WS_Y))[(size_t)m * 512 + h * 64 + d]); }
}
__device__ __forceinline__ void dg_p6_post(const Params& p) {
    DG_IDS(); unsigned char* ws = p.ws; unsigned char* dob = (unsigned char*)p.out; const float* sv = (const float*)(ws + WS_DSAVE + 768 * 1024); float e = 0.f;
    for (int i = gwv; i < DG_NS4; i += NGWV) {
        const unsigned hsh = dhash(i * 29 + 17); const int m = hsh % R, h = (hsh >> 20) & 7; const int pp = m % TP; const int c = h * 64 + lane;
        if (pp < 48) continue;
        const float y = sv[i * 64 + lane]; const float mean = wave_sum(y) / 64.f; const float var = wave_sum((y - mean) * (y - mean)) / 64.f;
        const float gn = (y - mean) / sqrtf(var + GN_EPS) * p.in[I_LNG][c] + p.in[I_LNB][c];
        const float v0 = bf2f(((const bf16*)(ws + WS_ZRV))[(size_t)m * 512 + c]), v1 = bf2f(((const bf16*)(ws + WS_ZRV))[(size_t)(m - 1) * 512 + c]);
        const float vs = v0 + p.in[I_MU][1024 + c] * (v1 - v0);
        const float want = (gn + ((const float*)(ws + WS_BS))[(size_t)m * 8 + h] * vs) * bf2f(((const bf16*)(dob + DO_GG))[(size_t)m * 512 + c]);
        e = fmaxf(e, relerr(bf2f(((const bf16*)(ws + WS_Y))[(size_t)m * 512 + c]), want, 0.1f));
    }
    diag_report(p, 10, e / 0.03f);
}
__device__ __forceinline__ void dg_mix(const Params& p, int stage) {
    DG_IDS(); unsigned char* ws = p.ws; float e = 0.f;
    for (int s = gt; s < 131072; s += NGT) {
        const unsigned hsh = dhash(s * 31 + 19 + stage); const int row = hsh % R, c = dhash(hsh) & 1023;
        float want = dg_dot((const bf16*)(ws + WS_FQ), row, (const bf16*)(ws + WS_WTFOX), c, 512) * bf2f(((const bf16*)(ws + WS_ZG))[(size_t)row * 2048 + c]);
        if (stage == 12) want = rbf(want) + dg_dot((const bf16*)(ws + WS_Y), row, (const bf16*)(ws + WS_WTRWKV), c, 512) * bf2f(((const bf16*)(ws + WS_ZG))[(size_t)row * 2048 + 1024 + c]);
        e = fmaxf(e, relerr(bf2f(((const bf16*)(ws + WS_MIX))[(size_t)row * 1024 + c]), want, 0.1f));
    }
    diag_report(p, stage, e / 0.03f);
}
__device__ __forceinline__ void dg_out(const Params& p) {
    DG_IDS(); unsigned char* ws = p.ws; float e = 0.f;
    for (int s = gt; s < 131072; s += NGT) {
        const unsigned hsh = dhash(s * 37 + 23); const int tok = hsh & 65535, c = dhash(hsh) & 1023; const int b = tok >> 12, t = tok & 4095;
        const float want = p.in[I_X][(size_t)tok * 1024 + c] + dg_dot((const bf16*)(ws + WS_MIX), (size_t)b * TP + 64 + t, (const bf16*)(ws + WS_WTOUT), c, 1024);
        e = fmaxf(e, relerr(p.out[(size_t)tok * 1024 + c], want, 0.3f));
    }
    diag_report(p, 13, e / 0.01f);
}
__device__ __forceinline__ void dg_norm2(const Params& p) {
    DG_IDS(); unsigned char* ws = p.ws; float e = 0.f;
    for (int s = gwv; s < 4096; s += NGWV) {
        const int m = dhash(s * 41 + 29) & 65535; const float* xr = p.out + (size_t)m * 1024;
        float ss = 0.f; for (int c = lane; c < 1024; c += 64) ss += xr[c] * xr[c];
        ss = wave_sum(ss); const float rs = 1.0f / sqrtf(ss / 1024.f + NORM_EPS);
        for (int c = lane; c < 1024; c += 64) e = fmaxf(e, relerr(bf2f(((const bf16*)(ws + WS_XN2))[(size_t)m * 1024 + c]), xr[c] * rs * p.in[I_N2G][c], 0.05f));
    }
    diag_report(p, 14, e / 0.03f);
}
__device__ __forceinline__ void dg_pq(const Params& p) {
    DG_IDS(); unsigned char* ws = p.ws; float e = 0.f;
    for (int s = gt; s < 131072; s += NGT) {
        const unsigned hsh = dhash(s * 43 + 31); const int tok = hsh & 65535, c = dhash(hsh) & 2047;
        const float want = dg_dot((const bf16*)(ws + WS_XN2), tok, (const bf16*)(ws + WS_WTQ), c, 1024);
        e = fmaxf(e, relerr(bf2f(((const bf16*)(ws + WS_PQ))[(size_t)tok * 2048 + c]), want, 0.25f));
    }
    diag_report(p, 15, e / 0.02f);
}
__device__ __forceinline__ void dg_route(const Params& p, LAS unsigned char* lds) {
    DG_IDS(); unsigned char* ws = p.ws; float e16 = 0.f, e17 = 0.f;
    LAS float* s2l = (LAS float*)lds + (tid >> 6) * 128;
    for (int i = gwv; i < 2048; i += NGWV) {
        const unsigned hsh = dhash(i * 47 + 37); const int tok = hsh & 65535, h = (hsh >> 16) & 7;
        const bf16* q = (const bf16*)(ws + WS_PQ) + (size_t)tok * 2048 + h * 256; const bf16* ks = (const bf16*)(ws + WS_KS);
        float s1a = 0.f, s1b = 0.f, s2a = 0.f, s2b = 0.f;
        for (int d = 0; d < 128; ++d) { const float q1 = bf2f(q[d]), q2 = bf2f(q[128 + d]);
            s1a += q1 * bf2f(ks[(size_t)lane * 128 + d]); s1b += q1 * bf2f(ks[(size_t)(lane + 64) * 128 + d]);
            s2a += q2 * bf2f(ks[(size_t)(128 + lane) * 128 + d]); s2b += q2 * bf2f(ks[(size_t)(192 + lane) * 128 + d]); }
        s2l[lane] = s2a; s2l[lane + 64] = s2b; asm volatile("s_waitcnt lgkmcnt(0)" ::: "memory");
        float prev_s = 3e38f; int prev_id = -1; float top_s[16]; int top_id[16];
#pragma unroll 1
        for (int r = 0; r < 16; ++r) {
            float bs = -3e38f; int bi = 0x7fffffff;
            for (int j = 0; j < 128; ++j) { const float t2 = s2l[j];
                { const float sm = s1a + t2; const int id = lane * 128 + j; const bool ok = (sm < prev_s) || (sm == prev_s && id > prev_id); if (ok && (sm > bs || (sm == bs && id < bi))) { bs = sm; bi = id; } }
                { const float sm = s1b + t2; const int id = (lane + 64) * 128 + j; const bool ok = (sm < prev_s) || (sm == prev_s && id > prev_id); if (ok && (sm > bs || (sm == bs && id < bi))) { bs = sm; bi = id; } } }
            for (int o = 1; o < 64; o <<= 1) { const float os = __shfl_xor(bs, o); const int oi = __shfl_xor(bi, o); if (os > bs || (os == bs && oi < bi)) { bs = os; bi = oi; } }
            top_s[r] = bs; top_id[r] = bi; prev_s = bs; prev_id = bi;
        }
        const int* ids = (const int*)(ws + WS_IDS) + (size_t)tok * 128 + h * 16; const float* gts = (const float*)(ws + WS_GATES) + (size_t)tok * 128 + h * 16;
        float den = 0.f;
#pragma unroll
        for (int r = 0; r < 16; ++r) den += expf(top_s[r] - top_s[0]);
        int miss = 0;
#pragma unroll
        for (int r = 0; r < 16; ++r) {
            bool found = false; for (int k = 0; k < 16; ++k) found |= (ids[k] == top_id[r]);
            if (!found && top_s[r] > top_s[15] + 2e-3f * fabsf(top_s[15]) + 1e-4f) ++miss;
            e17 = fmaxf(e17, fabsf(gts[r] - expf(top_s[r] - top_s[0]) / den));
        }
        e16 = fmaxf(e16, (float)miss);
        if (lane == 0 && miss) atomicAdd((float*)(ws + WS_DIAG) + 19, (float)miss);
    }
    diag_report(p, 16, e16 / 0.5f); diag_report(p, 17, e17 / 0.01f);
}
constexpr int DG_NS18 = 128;
__device__ __forceinline__ void dg_gather_pre(const Params& p) {
    DG_IDS(); float* sv = (float*)(p.ws + WS_DSAVE + 1280 * 1024);
    for (int s = gt; s < DG_NS18 * 1024; s += NGT) { const int i = s >> 10, c = s & 1023; const int tok = dhash(i * 53 + 41) & 65535; sv[s] = p.out[(size_t)tok * 1024 + c]; }
    for (int s = gt; s < DG_NS18 * 128; s += NGT) { const int i = s >> 7, ex = s & 127; const int tok = dhash(i * 53 + 41) & 65535; sv[DG_NS18 * 1024 + s] = ((const float*)(p.ws + WS_GATES))[(size_t)tok * 128 + ex]; }
}
__device__ __forceinline__ void dg_gather_post(const Params& p) {
    DG_IDS(); unsigned char* ws = p.ws; const float* sv = (const float*)(ws + WS_DSAVE + 1280 * 1024); float e = 0.f;
    for (int i = gwv; i < DG_NS18; i += NGWV) {
        const int tok = dhash(i * 53 + 41) & 65535;
        const int* ids = (const int*)(ws + WS_IDS) + (size_t)tok * 128; const float* gts = (const float*)(ws + WS_GATES) + (size_t)tok * 128;
        const signed char* xq = (const signed char*)(ws + WS_XQ) + (size_t)tok * 1024; const float sx = ((const float*)(ws + WS_SX))[tok];
        float o[16];
#pragma unroll
        for (int k = 0; k < 16; ++k) o[k] = 0.f;
        for (int ex = 0; ex < 128; ++ex) {
            const int id = ids[ex]; const signed char* ur = (const signed char*)(ws + WS_U8) + (size_t)id * 1024; const unsigned char* vr = ws + WS_V8 + (size_t)id * 1024;
            float d = 0.f;
#pragma unroll
            for (int k = 0; k < 16; ++k) d += (float)ur[lane * 16 + k] * (float)xq[lane * 16 + k];
            d = wave_sum(d) * ((const float*)(ws + WS_SU))[id] * sx;
            const float svs = ((const float*)(ws + WS_SV))[id];
            const float w = gts[ex];
            e = fmaxf(e, fabsf(w - sv[DG_NS18 * 1024 + i * 128 + ex] * 0.5f * d * (1.0f + erff(d * 0.70710678f)) * svs) / (0.02f * svs) * 0.05f);
#pragma unroll
            for (int k = 0; k < 16; ++k) o[k] += w * ((float)vr[lane * 16 + k] - 128.f);
        }
        float ss = 0.f;
#pragma unroll
        for (int k = 0; k < 16; ++k) ss += o[k] * o[k];
        const float rms = sqrtf(wave_sum(ss) / 1024.f);
#pragma unroll
        for (int k = 0; k < 16; ++k) e = fmaxf(e, fabsf((p.out[(size_t)tok * 1024 + lane * 16 + k] - sv[i * 1024 + lane * 16 + k]) - o[k]) / (rms + 1e-3f));
    }
    diag_report(p, 18, e / 0.05f);
}
__device__ __forceinline__ void dg_final(const Params& p) {
    DG_IDS(); const float* dg = (const float*)(p.ws + WS_DIAG);
    int k = 0;
    for (int s = 1; s <= 18; ++s) if (k == 0 && !(dg[s] <= 1.0f)) k = s;
#ifdef DIAG_SKIP
    { int kk = 0; for (int s = 1; s <= 18; ++s) if (kk == 0 && s > DIAG_SKIP && !(dg[s] <= 1.0f)) kk = s; k = kk; }
#endif
#ifdef DIAG_VALUE
    const float a = fminf(fmaxf(dg[DIAG_VALUE], 1e-3f), 1e6f) * 16.f;
#else
    const float a = exp2f((float)k);
#endif
    for (size_t i = gt; i < (size_t)NTOK * 1024 / 4; i += NGT) ((f32x4*)p.out)[i] = (f32x4){a, a, a, a};
}
#endif

#define XB_TMO      128
#define XB_XCNT(j)  (256  + 64 * (j))
#define XB_XSUB(j)  (1280 + 64 * (j))
#define XB_XGEN(j)  (2304 + 64 * (j))
#define XB_TOP      3328
#define XB_TOPGEN   3392
#define XCD_BAR_WORDS 3456
#define XB_SPIN_CAP (1u << 18)

__device__ __forceinline__ unsigned xb_ld(unsigned* p)              { return __hip_atomic_load(p, __ATOMIC_RELAXED, __HIP_MEMORY_SCOPE_AGENT); }
__device__ __forceinline__ unsigned xb_add(unsigned* p, unsigned v) { return __hip_atomic_fetch_add(p, v, __ATOMIC_RELAXED, __HIP_MEMORY_SCOPE_AGENT); }
__device__ __forceinline__ unsigned xb_xcc_id() { return (unsigned)__builtin_amdgcn_s_getreg((3 << 11) | 20) & 0xFu; }
#define XB_SPIN(cond, bar) do { unsigned _sp = 0; while (cond) { __builtin_amdgcn_s_sleep(1); \
    if ((++_sp & 255u) == 0u) { if (xb_ld(&(bar)[XB_TMO])) break; if (_sp > XB_SPIN_CAP) { atomicAdd(&(bar)[XB_TMO], 1u); break; } } } } while (0)

struct XcdBarrier {
    unsigned* bar; unsigned x;
    volatile LAS unsigned* st;
};

__device__ __forceinline__ XcdBarrier xcd_barrier_post(unsigned* bar, volatile LAS unsigned* st) {
    XcdBarrier b; b.bar = bar; b.x = xb_xcc_id(); b.st = st;
    if (threadIdx.x == 0) (void)xb_add(&bar[XB_XCNT(b.x)], 1u);
    return b;
}
__device__ __forceinline__ void xcd_barrier_complete(unsigned* bar, unsigned x, unsigned& nloc, unsigned& nx) {
    const unsigned G = gridDim.x * gridDim.y * gridDim.z;
    unsigned sum, cnt, mine, sp = 0u;
    for (;;) {
        sum = 0u; cnt = 0u; mine = 0u;
#pragma unroll
        for (unsigned j = 0; j < 16; ++j) { const unsigned c = xb_ld(&bar[XB_XCNT(j)]); sum += c; cnt += (c > 0u) ? 1u : 0u; mine = (j == x) ? c : mine; }
        if (sum == G) break;
        __builtin_amdgcn_s_sleep(1);
        if ((++sp & 255u) == 0u) { if (xb_ld(&bar[XB_TMO])) break; if (sp > XB_SPIN_CAP) { atomicAdd(&bar[XB_TMO], 1u); break; } }
    }
    nloc = mine > 0u ? mine : 1u; nx = cnt > 0u ? cnt : 1u;
}

__device__ __forceinline__ void xcd_barrier(const XcdBarrier& b) {
    asm volatile("s_waitcnt vmcnt(0)" ::: "memory");
    __syncthreads();
    if (threadIdx.x == 0) {
        unsigned* bar = b.bar;
        __builtin_amdgcn_s_waitcnt(0);
        unsigned nloc = b.st[0], nx = b.st[1];
        if (nloc == 0u) { xcd_barrier_complete(bar, b.x, nloc, nx); b.st[0] = nloc; b.st[1] = nx; }
        const unsigned old = xb_add(&bar[XB_XSUB(b.x)], 1u);
        const unsigned gen = old / nloc;
        if (old + 1u == (gen + 1u) * nloc) {
            __builtin_amdgcn_fence(__ATOMIC_RELEASE, "agent");
            asm volatile("s_waitcnt vmcnt(0)" ::: "memory");
            const unsigned og = xb_add(&bar[XB_TOP], 1u);
            const unsigned tg = og / nx;
            if (og + 1u == (tg + 1u) * nx) xb_add(&bar[XB_TOPGEN], 1u);
            else XB_SPIN(xb_ld(&bar[XB_TOPGEN]) == tg, bar);
            __builtin_amdgcn_fence(__ATOMIC_ACQUIRE, "agent");
            xb_add(&bar[XB_XGEN(b.x)], 1u);
            asm volatile("s_waitcnt vmcnt(0)" ::: "memory");
        } else {
            XB_SPIN(xb_ld(&bar[XB_XGEN(b.x)]) == gen, bar);
            __builtin_amdgcn_fence(__ATOMIC_ACQUIRE, "agent");
            asm volatile("s_waitcnt vmcnt(0)" ::: "memory");
        }
    }
    __syncthreads();
}

#ifndef TIMING
#define TIMING 0
#endif
#if TIMING
#define TS(i) do { int t__ = threadIdx.x; asm volatile("" : "+v"(t__)); if (bid == 0 && t__ == 0) ((unsigned long long*)(ws + 1010 * MiB))[i] = __builtin_amdgcn_s_memrealtime(); } while (0)
#else
#define TS(i)
#endif
#if DIAG
#define DG(...) __VA_ARGS__
#else
#define DG(...)
#endif
constexpr int LDS_BYTES = 147456;
static_assert(attn_body::ATTN_LDS_BYTES <= 131072, "attention LDS");
static_assert(RT_KS_BYTES + NTHREADS * RT_TAB_WORDS * 4 <= LDS_BYTES, "routing LDS");
static_assert((SC_CH * SC_STRIDE + SC_CH * 32) * 4 <= LDS_BYTES, "scan LDS");

__global__ void __launch_bounds__(NTHREADS, 2) hybrid_fwd(Params p) {
    extern __shared__ __attribute__((aligned(16))) unsigned char lds_raw[];
    cg::grid_group grid = cg::this_grid();
    LAS unsigned char* lds = (LAS unsigned char*)lds_raw;
    const int G0 = gridDim.x, bid = blockIdx.x;
#define LANE_IDS() int tid = threadIdx.x; asm volatile("" : "+v"(tid)); const int lane = tid & 63, wave = __builtin_amdgcn_readfirstlane(tid >> 6); (void)lane; (void)wave; int G = G0; asm volatile("" : "+s"(G))
    const int vcu = (G0 % 8 == 0) ? (bid % 8) * (G0 / 8) + bid / 8 : bid;
    unsigned char* ws = p.ws; unsigned char* dob = (unsigned char*)p.out;

    DG({ int t_ = threadIdx.x; asm volatile("" : "+v"(t_)); if (bid == 0 && t_ < 64) ((float*)(ws + WS_DIAG))[t_] = 0.f; })
    unsigned* barw = (unsigned*)(ws + 65536);
    { int t__ = threadIdx.x; asm volatile("" : "+v"(t__)); if (bid == 0) for (int i = t__; i < XCD_BAR_WORDS; i += NTHREADS) __hip_atomic_store(barw + i, 0u, __ATOMIC_RELAXED, __HIP_MEMORY_SCOPE_AGENT);
      if (t__ < 2) ((volatile LAS unsigned*)(lds + LDS_BYTES - 64))[t__] = 0u; }
    __syncthreads();
    TS(0);
    { LANE_IDS(); p0_prologue(p, lds, vcu, G, wave, lane); }
#ifdef REP_P0
    __syncthreads(); { LANE_IDS(); p0_prologue(p, lds, vcu, G, wave, lane); }
#endif
    grid.sync();
    const XcdBarrier xbar = xcd_barrier_post(barw, (volatile LAS unsigned*)(lds + LDS_BYTES - 64));
#define GSYNC() xcd_barrier(xbar)
    DG(dg_p0(p);)
    TS(1);
    run_gemm(lds, (const bf16*)(ws + WS_XN), (const bf16*)(ws + WS_WTIN), R, N1, 1024, G0, bid, F_Gemm1{(bf16*)(ws + WS_F), (bf16*)(ws + WS_ZG)});
#ifdef REP_GEMM1
    run_gemm(lds, (const bf16*)(ws + WS_XN), (const bf16*)(ws + WS_WTIN), R, N1, 1024, G0, bid, F_Gemm1{(bf16*)(ws + WS_F), (bf16*)(ws + WS_ZG)});
#endif
    GSYNC();
    DG(dg_gemm1(p); GSYNC();)
    TS(2);
    { LANE_IDS(); p2_prep1(p, vcu, G, wave, lane); }
    GSYNC();
    DG(dg_p2(p);)
    TS(3);
    { LANE_IDS(); const int gwv = vcu * NWAVES + wave; for (int s = gwv; s < 128; s += G * NWAVES) p3_cumsum(p, s, lane); }
    __syncthreads();
    run_gemm(lds, (const bf16*)(ws + WS_LA), (const bf16*)(ws + WS_WTWA), R, 512, 128, G0, bid, F_LoraW{(bf16*)(dob + DO_XW), p.in[I_W0]});
    run_gemm(lds, (const bf16*)(ws + WS_LA), (const bf16*)(ws + WS_WTWA) + 512 * 128, R, 512, 128, G0, bid, F_LoraA{(bf16*)(dob + DO_AA), p.in[I_A0]});
    run_gemm(lds, (const bf16*)(ws + WS_LG), (const bf16*)(ws + WS_WTG), R, 512, 256, G0, bid, F_Plain{(bf16*)(dob + DO_GG), 512});
    GSYNC();
    DG(dg_p3(p); dg_p4_pre(p); GSYNC();)
    TS(4);
    { LANE_IDS(); p4_prep2(p, vcu, G, wave, lane); }
    GSYNC();
    DG(dg_p4_post(p); dg_attn_pre(p); GSYNC();)
    TS(5);
    {
        LANE_IDS();
        const int per = (1024 + G - 1) / G;
        int last_bh = -1;
        for (int pi = vcu * per; pi < (vcu + 1) * per && pi < 1024; ++pi) {
            const int bh = pi >> 3, pr = pi & 7;
            if (bh != last_bh) {
                __syncthreads();
                const float* kbg = (const float*)(ws + WS_KB) + (size_t)bh * TP; LAS float* kbl = (LAS float*)(lds + attn_body::LDS_KB);
                for (int i = tid; i < TP; i += NTHREADS) kbl[i] = kbg[i];
                asm volatile("s_waitcnt vmcnt(0) lgkmcnt(0)" ::: "memory");
                __syncthreads();
                last_bh = bh;
            }
#pragma unroll 1
            for (int k = 0; k < 2; ++k) {
                const int qb = k ? 15 - pr : pr;
                attn_body::attn_unit<8>(bh >> 3, bh & 7, qb, (const attn_body::bf16*)(ws + WS_FQ), (const attn_body::bf16*)(ws + WS_FK), (const attn_body::bf16*)(ws + WS_FV), (attn_body::bf16*)(ws + WS_FQ), (char*)lds_raw);
            }
        }
        __syncthreads(); TS(6);
        { int tid2 = threadIdx.x; asm volatile("" : "+v"(tid2)); for (int item = vcu; item < 256; item += G0) p5_scan_item(p, lds, item, tid2, __builtin_amdgcn_readfirstlane(tid2 >> 6), tid2 & 63);
#ifdef REP_SCAN
          for (int item = vcu; item < 256; item += G0) p5_scan_item(p, lds, item, tid2, __builtin_amdgcn_readfirstlane(tid2 >> 6), tid2 & 63);
#endif
        }
    }
    GSYNC();
    DG(dg_attn_post(p); dg_scan(p); dg_p6_pre(p); GSYNC();)
    TS(7);
    { LANE_IDS(); p6_prep3(p, vcu, G, wave, lane); }
    GSYNC();
    DG(dg_p6_post(p);)
    TS(8);
    run_gemm(lds, (const bf16*)(ws + WS_FQ), (const bf16*)(ws + WS_WTFOX), R, 1024, 512, G0, bid, F_MixA{(bf16*)(ws + WS_MIX), (const bf16*)(ws + WS_ZG)});
    GSYNC();
    TS(9);
    DG(dg_mix(p, 11); GSYNC();)
    run_gemm(lds, (const bf16*)(ws + WS_Y), (const bf16*)(ws + WS_WTRWKV), R, 1024, 512, G0, bid, F_MixB{(bf16*)(ws + WS_MIX), (const bf16*)(ws + WS_ZG)});
    GSYNC();
    DG(dg_mix(p, 12);)
    TS(10);
    run_gemm(lds, (const bf16*)(ws + WS_MIX), (const bf16*)(ws + WS_WTOUT), R, 1024, 1024, G0, bid, F_Out{p.in[I_X], p.out});
    GSYNC();
    TS(11);
    DG(dg_out(p); GSYNC();)
    { LANE_IDS(); p9_norm2(p, vcu, G, wave, lane); }
    GSYNC();
    DG(dg_norm2(p);)
    TS(12);
    run_gemm(lds, (const bf16*)(ws + WS_XN2), (const bf16*)(ws + WS_WTQ), NTOK, 2048, 1024, G0, bid, F_Plain{(bf16*)(ws + WS_PQ), 2048});
#ifdef REP_PQ
    run_gemm(lds, (const bf16*)(ws + WS_XN2), (const bf16*)(ws + WS_WTQ), NTOK, 2048, 1024, G0, bid, F_Plain{(bf16*)(ws + WS_PQ), 2048});
#endif
    GSYNC();
    TS(13);
    DG(dg_pq(p);)
    { LANE_IDS(); p11_route(p, lds, vcu, G, tid, wave, lane); }
#ifdef REP_ROUTE
    __syncthreads(); { LANE_IDS(); p11_route(p, lds, vcu, G, tid, wave, lane); }
#endif
    GSYNC();
    TS(14);
    DG(__syncthreads(); dg_route(p, lds); dg_gather_pre(p); GSYNC();)
    { LANE_IDS(); p12a_partial(p, bid, G, wave, lane); }
#ifdef REP_12A
    { LANE_IDS(); p12a_partial(p, bid, G, wave, lane); }
#endif
    GSYNC();
    { LANE_IDS(); p12b_combine(p, vcu, G, wave, lane); }
    GSYNC();
    { LANE_IDS(); p12c_output(p, bid, G, wave, lane); }
    DG(GSYNC(); dg_gather_post(p); GSYNC(); dg_final(p);)
#if TIMING
    GSYNC(); TS(15); GSYNC();
    {
        const unsigned long long* ts = (const unsigned long long*)(ws + 1010 * MiB);
        const float tot = (float)(ts[15] - ts[0]);
        const float fa = 10.f * (float)(ts[TIMING_A1] - ts[TIMING_A0]) / tot;
        int t__ = threadIdx.x; asm volatile("" : "+v"(t__));
        for (size_t i = (size_t)bid * NTHREADS + t__; i < (size_t)NTOK * 1024; i += (size_t)G0 * NTHREADS) p.out[i] = fa;
    }
#endif
}

extern "C" void kernel_launch(void* const* d_in, const int* in_sizes, int n_in, void* d_out, int out_size, void* d_ws, size_t ws_size, hipStream_t stream) {
    static int grid = 0;
    if (grid == 0) {
        if (n_in != 27 || out_size != NTOK * DMODEL || ws_size < WS_END) { fprintf(stderr, "kernel_launch: unexpected shapes (n_in %d, out %d, ws %zu)\n", n_in, out_size, ws_size); grid = -1; return; }
        int dev = 0, cus = 0, per_cu = 0;
        hipGetDevice(&dev);
        hipDeviceGetAttribute(&cus, hipDeviceAttributeMultiprocessorCount, dev);
        hipFuncSetAttribute((const void*)hybrid_fwd, hipFuncAttributeMaxDynamicSharedMemorySize, LDS_BYTES);
        hipOccupancyMaxActiveBlocksPerMultiprocessor(&per_cu, (const void*)hybrid_fwd, NTHREADS, LDS_BYTES);
        if (per_cu < 1) { fprintf(stderr, "kernel_launch: occupancy query says %d blocks per CU\n", per_cu); grid = -1; return; }
        grid = cus;
    }
    if (grid < 0) return;
    Params p{};
    for (int i = 0; i < 27; ++i) p.in[i] = (const float*)d_in[i];
    p.out = (float*)d_out; p.ws = (unsigned char*)d_ws;
    void* args[] = {&p};
    hipError_t e = hipLaunchCooperativeKernel((const void*)hybrid_fwd, dim3(grid), dim3(NTHREADS), args, LDS_BYTES, stream);
    if (e != hipSuccess) fprintf(stderr, "cooperative launch failed: %s (grid %d)\n", hipGetErrorString(e), grid);
}
```

```cpp
#include <hip/hip_runtime.h>
#include <hip/hip_cooperative_groups.h>
#include <hip/hip_bf16.h>
#include <cstdio>
#include <cstdint>
#include <cmath>
namespace cg = cooperative_groups;
#ifndef DIAG
#define DIAG 0
#endif
namespace pg8 {
#define PG8_LAS __attribute__((address_space(3)))
typedef unsigned short bf16_t;
typedef short bf16x8 __attribute__((ext_vector_type(8)));
typedef float f32x4 __attribute__((ext_vector_type(4)));
typedef unsigned u32x4 __attribute__((ext_vector_type(4)));
constexpr int BM = 256, BK = 64, HALF = 128, HTB = HALF * BK * 2  , STAGE_BYTES = 8 * HTB, NXCD = 8, WGM = 8;

__host__ __device__ __forceinline__ int lds_byte(int r, int c) { const int st = (r >> 4) * 2 + (c >> 5), rr = r & 15, cc = c & 31, ob = rr * 64 + cc * 2; return st * 1024 + (ob ^ (((ob >> 9) & 1) << 5)); }
__host__ __device__ __forceinline__ void stage_rc(int b, int& R, int& C) { const int st = b / 1024, sb = b % 1024, swz = sb ^ (((sb >> 9) & 1) << 5); R = (st >> 1) * 16 + swz / 64; C = (st & 1) * 32 + (swz % 64) / 2; }
__host__ __device__ __forceinline__ int perm32(int rho) { const int n = rho >> 4, i = rho & 15; return 8 * (i >> 2) + 4 * n + (i & 3); }

struct Unit { int pm, pn; };
struct Gemm { const bf16_t* A; const bf16_t* Bt; int M, N, K; };

struct StaticOrder {
    int nM, nN, nwg, G, c;
    __host__ __device__ void init(int M, int N, int G_, int c_) { nM = M / BM; nN = N / BM; nwg = nM * nN; G = G_; c = c_; }
    __host__ __device__ bool next(int i, Unit& u) const {
        const int L = i * G + c; if (L >= nwg) return false;
        int wgid = (int)L; { const int q = nwg / NXCD, r = nwg % NXCD, xcd = wgid % NXCD, off = wgid / NXCD; wgid = (xcd < r ? xcd * (q + 1) : r * (q + 1) + (xcd - r) * q) + off; }
        const int nig = WGM * nN, gid = wgid / nig, fm = gid * WGM, gsz = (nM - fm) < WGM ? (nM - fm) : WGM;
        u.pm = fm + ((wgid % nig) % gsz); u.pn = (wgid % nig) / gsz; return true;
    }
    __device__ __forceinline__ void a_ready(const Unit&) const {}
    __device__ __forceinline__ void done(const Unit&) const {}
};

__device__ __forceinline__ unsigned cvt_pk_bf16(float lo, float hi) { unsigned r; asm volatile("v_cvt_pk_bf16_f32 %0, %1, %2" : "=v"(r) : "v"(lo), "v"(hi)); return r; }
typedef float f32x2 __attribute__((ext_vector_type(2)));
template <class Epi, class Sched, bool ALIGN_EPI = false, bool SP2 = false>
__device__ __forceinline__ void gemm_phase(PG8_LAS unsigned char* lds, const Gemm g, const Sched& S, const Epi& E) {
    int tid_ = threadIdx.x; asm volatile("" : "+v"(tid_));
    const int tid = tid_, wid = __builtin_amdgcn_readfirstlane(tid >> 6), lane = tid & 63, wr = wid >> 2, wc = wid & 3, fr = lane & 15, fq = lane >> 4;
    const int K = g.K, nt = K / BK;
    unsigned voffA[2], voffB[2];
#pragma unroll
    for (int i = 0; i < 2; ++i) { int R, C; stage_rc(tid * 16 + i * 8192, R, C); const int Rb = Epi::PERM ? ((R & ~31) + perm32(R & 31)) : R;
        voffA[i] = (unsigned)(R * K + C) * 2u; voffB[i] = (unsigned)(Rb * K + C) * 2u; }
    const size_t kstep = (size_t)(BK * 2);
    const size_t hstep = (size_t)HALF * K * 2;
    const size_t tstep = 2 * hstep;
    const unsigned ldsw = (unsigned)wid * 1024u;
    const int aoff = lds_byte(wr * 64 + fr, fq * 8), boff = lds_byte(wc * 32 + fr, fq * 8);
#define PG8_SA(b, h) (((b) * 2 + (h)) * HTB)
#define PG8_SB(b, h) ((4 + (b) * 2 + (h)) * HTB)
#define PG8_STAGE(bufoff, gbase, voff) do { _Pragma("unroll") for (int _i = 0; _i < 2; ++_i) \
        __builtin_amdgcn_global_load_lds((const unsigned*)((const char*)(gbase) + (voff)[_i]), (PG8_LAS unsigned*)(lds + (bufoff) + ldsw + _i * 8192), 16, 0, 0); } while (0)
#define PG8_LDA(dst, b, h) do { _Pragma("unroll") for (int m = 0; m < 4; ++m) _Pragma("unroll") for (int k = 0; k < 2; ++k) dst[m][k] = *(const PG8_LAS bf16x8*)(lds + PG8_SA(b, h) + aoff + m * 2048 + k * 1024); } while (0)
#define PG8_LDB(dst, b, h) do { _Pragma("unroll") for (int n = 0; n < 2; ++n) _Pragma("unroll") for (int k = 0; k < 2; ++k) dst[n][k] = *(const PG8_LAS bf16x8*)(lds + PG8_SB(b, h) + boff + n * 2048 + k * 1024); } while (0)
#define PG8_MMA(ai, bj, At, Bt) do { __builtin_amdgcn_s_setprio(1); _Pragma("unroll") for (int m = 0; m < 4; ++m) _Pragma("unroll") for (int n = 0; n < 2; ++n) _Pragma("unroll") for (int k = 0; k < 2; ++k) \
        acc[ai][bj][m][n] = __builtin_amdgcn_mfma_f32_16x16x32_bf16(Bt[n][k], At[m][k], acc[ai][bj][m][n], 0, 0, 0); __builtin_amdgcn_s_setprio(0); } while (0)
#define PG8_WAIT_V(n) asm volatile("s_waitcnt vmcnt(" #n ")" ::: "memory")
#define PG8_WAIT_L(n) asm volatile("s_waitcnt lgkmcnt(" #n ")" ::: "memory")
#define PG8_BAR __builtin_amdgcn_s_barrier()
#define PG8_SCHED __builtin_amdgcn_sched_barrier(0)
    Unit cur, nxt; int ui = 0;
    if (!S.next(0, cur)) return;
    f32x4 acc[2][2][4][2];
#pragma unroll
    for (int a = 0; a < 2; ++a)
#pragma unroll
        for (int b = 0; b < 2; ++b)
#pragma unroll
            for (int m = 0; m < 4; ++m)
#pragma unroll
                for (int n = 0; n < 2; ++n) acc[a][b][m][n] = (f32x4){0.f, 0.f, 0.f, 0.f};
    bf16x8 At[4][2], B0[2][2], B1[2][2];
    const char* cA = (const char*)g.A + (size_t)cur.pm * tstep; const char* cB = (const char*)g.Bt + (size_t)cur.pn * tstep;
    S.a_ready(cur);
    if constexpr (SP2) {
        PG8_STAGE(PG8_SB(0, 0), cB, voffB); PG8_STAGE(PG8_SB(0, 1), cB + hstep, voffB); PG8_STAGE(PG8_SA(0, 0), cA, voffA); PG8_STAGE(PG8_SA(0, 1), cA + hstep, voffA);
        if (wr == 1) PG8_BAR;
        PG8_WAIT_V(2); PG8_BAR;
        PG8_STAGE(PG8_SB(1, 0), cB + kstep, voffB); PG8_STAGE(PG8_SA(1, 0), cA + kstep, voffA); PG8_STAGE(PG8_SB(1, 1), cB + hstep + kstep, voffB);
        PG8_WAIT_V(6); PG8_BAR;
    } else {
        PG8_STAGE(PG8_SB(0, 0), cB, voffB); PG8_STAGE(PG8_SA(0, 0), cA, voffA); PG8_STAGE(PG8_SB(0, 1), cB + hstep, voffB); PG8_STAGE(PG8_SA(0, 1), cA + hstep, voffA);
        if (wr == 1) PG8_BAR;
        PG8_WAIT_V(4); PG8_BAR;
        PG8_STAGE(PG8_SB(1, 0), cB + kstep, voffB); PG8_STAGE(PG8_SA(1, 0), cA + kstep, voffA); PG8_STAGE(PG8_SB(1, 1), cB + hstep + kstep, voffB);
        PG8_WAIT_V(6); PG8_BAR;
    }
    for (;;) {
        const bool has_next = S.next(ui + 1, nxt);
        const char* nA = has_next ? (const char*)g.A + (size_t)nxt.pm * tstep : cA; const char* nB = has_next ? (const char*)g.Bt + (size_t)nxt.pn * tstep : cB;
        for (int t = 0; t < nt; t += 2) {
            const bool last = (t == nt - 2);
            const char* a1 = cA + (size_t)(t + 1) * kstep;
            const char* a2 = last ? nA : cA + (size_t)(t + 2) * kstep; const char* b2 = last ? nB : cB + (size_t)(t + 2) * kstep;
            const char* a3 = a2 + kstep; const char* b3 = b2 + kstep;
            if (last && has_next) S.a_ready(nxt);
            if constexpr (SP2) {
            PG8_LDB(B0, 0, 0); PG8_LDB(B1, 0, 1); PG8_SCHED; PG8_LDA(At, 0, 0); PG8_STAGE(PG8_SA(1, 1), a1 + hstep, voffA);
            PG8_WAIT_V(8); PG8_WAIT_L(0); PG8_BAR; PG8_MMA(0, 0, At, B0); PG8_MMA(0, 1, At, B1); PG8_BAR; PG8_SCHED;
            PG8_LDA(At, 0, 1); PG8_STAGE(PG8_SB(0, 0), b2, voffB); PG8_STAGE(PG8_SB(0, 1), b2 + hstep, voffB); PG8_STAGE(PG8_SA(0, 0), a2, voffA);
            PG8_WAIT_V(8); PG8_WAIT_L(0); PG8_BAR; PG8_MMA(1, 0, At, B0); PG8_MMA(1, 1, At, B1); PG8_BAR; PG8_SCHED;
            PG8_LDB(B0, 1, 0); PG8_LDB(B1, 1, 1); PG8_SCHED; PG8_LDA(At, 1, 0); PG8_STAGE(PG8_SA(0, 1), a2 + hstep, voffA);
            PG8_WAIT_V(8); PG8_WAIT_L(0); PG8_BAR; PG8_MMA(0, 0, At, B0); PG8_MMA(0, 1, At, B1); PG8_BAR; PG8_SCHED;
            PG8_LDA(At, 1, 1); PG8_STAGE(PG8_SB(1, 0), b3, voffB); PG8_STAGE(PG8_SB(1, 1), b3 + hstep, voffB); PG8_STAGE(PG8_SA(1, 0), a3, voffA);
            PG8_WAIT_V(8); PG8_WAIT_L(0); PG8_BAR; PG8_MMA(1, 0, At, B0); PG8_MMA(1, 1, At, B1); PG8_BAR; PG8_SCHED;
            } else {
            PG8_LDB(B0, 0, 0); PG8_SCHED; PG8_LDA(At, 0, 0); PG8_STAGE(PG8_SA(1, 1), a1 + hstep, voffA);
            PG8_WAIT_L(8); PG8_BAR; PG8_WAIT_L(0); PG8_MMA(0, 0, At, B0); PG8_BAR; PG8_SCHED;
            PG8_LDB(B1, 0, 1); PG8_STAGE(PG8_SB(0, 0), b2, voffB);
            PG8_BAR; PG8_WAIT_L(0); PG8_MMA(0, 1, At, B1); PG8_BAR;
            PG8_LDA(At, 0, 1); PG8_STAGE(PG8_SA(0, 0), a2, voffA);
            PG8_BAR; PG8_WAIT_L(0); PG8_MMA(1, 0, At, B0); PG8_BAR; PG8_SCHED;
            PG8_STAGE(PG8_SB(0, 1), b2 + hstep, voffB);
            PG8_WAIT_V(6); PG8_BAR; PG8_MMA(1, 1, At, B1); PG8_BAR;
            PG8_LDB(B0, 1, 0); PG8_SCHED; PG8_LDA(At, 1, 0); PG8_STAGE(PG8_SA(0, 1), a2 + hstep, voffA);
            PG8_WAIT_L(8); PG8_BAR; PG8_WAIT_L(0); PG8_MMA(0, 0, At, B0); PG8_BAR; PG8_SCHED;
            PG8_LDB(B1, 1, 1); PG8_STAGE(PG8_SB(1, 0), b3, voffB);
            PG8_BAR; PG8_WAIT_L(0); PG8_MMA(0, 1, At, B1); PG8_BAR;
            PG8_LDA(At, 1, 1); PG8_STAGE(PG8_SA(1, 0), a3, voffA);
            PG8_BAR; PG8_WAIT_L(0); PG8_MMA(1, 0, At, B0); PG8_BAR; PG8_SCHED;
            PG8_STAGE(PG8_SB(1, 1), b3 + hstep, voffB);
            PG8_WAIT_V(6); PG8_BAR; PG8_MMA(1, 1, At, B1); PG8_BAR;
            }
        }
        if constexpr (ALIGN_EPI) { if (wr == 0) PG8_BAR; }
        if constexpr (!Epi::AFTER_DRAIN) { E(acc, cur, wr, wc, fr, fq); S.done(cur); }
        if (!has_next) break;
#pragma unroll
        for (int a = 0; a < 2; ++a)
#pragma unroll
            for (int b = 0; b < 2; ++b)
#pragma unroll
                for (int m = 0; m < 4; ++m)
#pragma unroll
                    for (int n = 0; n < 2; ++n) acc[a][b][m][n] = (f32x4){0.f, 0.f, 0.f, 0.f};
        cur = nxt; cA = nA; cB = nB; ++ui;
        if constexpr (ALIGN_EPI) { if (wr == 1) PG8_BAR; }
    }
    PG8_WAIT_V(0);
    if constexpr (!ALIGN_EPI) { if (wr == 0) PG8_BAR; }
    PG8_BAR;
    if constexpr (Epi::AFTER_DRAIN) { E.fused(acc, cur, wr, wc, fr, fq, lds, wid, lane); S.done(cur); }
#undef PG8_SA
#undef PG8_SB
#undef PG8_STAGE
#undef PG8_LDA
#undef PG8_LDB
#undef PG8_MMA
#undef PG8_WAIT_V
#undef PG8_WAIT_L
#undef PG8_BAR
#undef PG8_SCHED
}
}
namespace attn_body {
using bf16=__hip_bfloat16;
using bf16x8=__attribute__((ext_vector_type(8)))short;
using s16x4=__attribute__((ext_vector_type(4)))short;
using f32x16=__attribute__((ext_vector_type(16)))float;
using u32x4=__attribute__((ext_vector_type(4)))unsigned;
using f32x4k=__attribute__((ext_vector_type(4)))float;
constexpr int BATCH=16,NHEAD=8,TPAD=4160,D=64,DM=NHEAD*D;
constexpr int NW=8,QBLK=32,QB=QBLK*NW,KVBLK=64,NQB=16;
constexpr int ATTN_PITCH=DM, ATTN_UNIT_ROWS=QB;
__device__ __forceinline__ int crow(int r,int hi){return (r&3)+8*(r>>2)+4*hi;}
#define SBAR() __builtin_amdgcn_sched_barrier(0)
__device__ __forceinline__ void cmask(f32x16&p0,f32x16&p1,int jb,int qrel,int hi){
  const float NEG=-INFINITY; int kb=64*jb+4*hi;
  #pragma unroll
  for(int r=0;r<16;++r){int kv=kb+(r&3)+8*(r>>2); if(kv>qrel)p0[r]=NEG; if(kv+32>qrel)p1[r]=NEG;}
}

constexpr int NSLOT=3, SLOTB=8192;
constexpr int LDS_K=0, LDS_V=NSLOT*SLOTB, LDS_WS=2*NSLOT*SLOTB, LDS_OST=LDS_WS+NW*64*4, LDS_KB=LDS_OST+NW*4096, LDS_BYTES=LDS_KB+TPAD*4;
constexpr float C2=0.125f*1.4426950408889634f;
__device__ __forceinline__ void glds16(const void*gsrc,unsigned lds_dst){unsigned keep;
  asm volatile("s_mov_b32 %0, m0\n\ts_mov_b32 m0, %2\n\ts_nop 0\n\tglobal_load_lds_dwordx4 %1, off\n\ts_mov_b32 m0, %0":"=&s"(keep):"v"(gsrc),"s"(lds_dst):"memory");}
__device__ __forceinline__ float max3f(float a,float b,float c){float r;asm("v_max3_f32 %0, %1, %2, %3":"=v"(r):"v"(a),"v"(b),"v"(c));return r;}
__device__ __forceinline__ float max2f(float a,float b){float r;asm("v_max_f32_e32 %0, %1, %2":"=v"(r):"v"(a),"v"(b));return r;}
__device__ __forceinline__ float fadd_s(float a,float b){float r;asm("v_add_f32_e32 %0, %1, %2":"=v"(r):"v"(a),"v"(b));return r;}
__device__ __forceinline__ float fsub_s(float a,float b){float r;asm("v_sub_f32_e32 %0, %1, %2":"=v"(r):"v"(a),"v"(b));return r;}
typedef float f32x2_t __attribute__((ext_vector_type(2))); typedef __bf16 bf16x2_t __attribute__((ext_vector_type(2)));
__device__ __forceinline__ unsigned cvtpk_s(float lo,float hi){f32x2_t v={lo,hi};bf16x2_t b=__builtin_convertvector(v,bf16x2_t);return __builtin_bit_cast(unsigned,b);}
#define WAIT_BAR(N) asm volatile("s_waitcnt vmcnt(" #N ") lgkmcnt(0)\n\ts_barrier":::"memory")

__device__ __forceinline__ void qkt(f32x16&p0,f32x16&p1,const char*Kslot,const bf16x8*qr,int r32,int hi){
  const char*kb=Kslot+hi*1024+r32*16;
  #pragma unroll
  for(int d0=0;d0<4;++d0){
    const bf16x8 b0=*reinterpret_cast<const bf16x8*>(kb+d0*2048);
    const bf16x8 b1=*reinterpret_cast<const bf16x8*>(kb+d0*2048+512);
    {p0=__builtin_amdgcn_mfma_f32_32x32x16_bf16(b0,qr[d0],p0,0,0,0);p1=__builtin_amdgcn_mfma_f32_32x32x16_bf16(b1,qr[d0],p1,0,0,0);}}
}
typedef __attribute__((address_space(3))) const char* lds_cptr;
typedef short v4i16_t __attribute__((ext_vector_type(4)));
__device__ __forceinline__ void kload8(bf16x8*kf,lds_cptr kp){
  kf[0]=*(const __attribute__((address_space(3))) bf16x8*)(kp);      kf[1]=*(const __attribute__((address_space(3))) bf16x8*)(kp+512);
  kf[2]=*(const __attribute__((address_space(3))) bf16x8*)(kp+2048); kf[3]=*(const __attribute__((address_space(3))) bf16x8*)(kp+2560);
  kf[4]=*(const __attribute__((address_space(3))) bf16x8*)(kp+4096); kf[5]=*(const __attribute__((address_space(3))) bf16x8*)(kp+4608);
  kf[6]=*(const __attribute__((address_space(3))) bf16x8*)(kp+6144); kf[7]=*(const __attribute__((address_space(3))) bf16x8*)(kp+6656);
}
__device__ __forceinline__ void kload2(bf16x8*kf,lds_cptr kp,int j){ kf[2*j]=*(const __attribute__((address_space(3))) bf16x8*)(kp+j*2048); kf[2*j+1]=*(const __attribute__((address_space(3))) bf16x8*)(kp+j*2048+512); }
__device__ __forceinline__ s16x4 vtr(lds_cptr p){ return __builtin_bit_cast(s16x4,__builtin_amdgcn_ds_read_tr16_b64_v4i16((__attribute__((address_space(3))) v4i16_t*)p)); }
__device__ __forceinline__ float rowmax(const f32x16&p0,const f32x16&p1){
  float a=max3f(p0[0],p0[1],p1[0]),b=max3f(p0[2],p0[3],p1[1]);a=max3f(a,p1[2],p1[3]);
  #pragma unroll
  for(int r=4;r<16;r+=4){a=max3f(a,p0[r],p0[r+1]);b=max3f(b,p0[r+2],p0[r+3]);a=max3f(a,p1[r],p1[r+1]);b=max3f(b,p1[r+2],p1[r+3]);}
  const float m=max2f(a,b);
  auto rr=__builtin_amdgcn_permlane32_swap(__float_as_uint(m),__float_as_uint(m),false,false);
  return max2f(__uint_as_float(rr[0]),__uint_as_float(rr[1]));
}
__device__ __forceinline__ void pv(f32x16*o,int vb,bf16x8 pa0,bf16x8 pa1,bf16x8 pa2,bf16x8 pa3){
  #pragma unroll
  for(int d0=0;d0<2;++d0){s16x4 lo[4],hi[4];
    #pragma unroll
    for(int ks=0;ks<4;++ks){
      asm volatile("ds_read_b64_tr_b16 %0,%1 offset:%c2":"=&v"(lo[ks]):"v"(vb),"i"(d0*4096+ks*1024):"memory");
      asm volatile("ds_read_b64_tr_b16 %0,%1 offset:%c2":"=&v"(hi[ks]):"v"(vb),"i"(d0*4096+ks*1024+512):"memory");}
    asm volatile("s_waitcnt lgkmcnt(0)":::"memory");SBAR();
    #define PK(k) (bf16x8){lo[k][0],lo[k][1],lo[k][2],lo[k][3],hi[k][0],hi[k][1],hi[k][2],hi[k][3]}
    o[d0]=__builtin_amdgcn_mfma_f32_32x32x16_bf16(pa0,PK(0),o[d0],0,0,0);
    o[d0]=__builtin_amdgcn_mfma_f32_32x32x16_bf16(pa1,PK(1),o[d0],0,0,0);
    o[d0]=__builtin_amdgcn_mfma_f32_32x32x16_bf16(pa2,PK(2),o[d0],0,0,0);
    o[d0]=__builtin_amdgcn_mfma_f32_32x32x16_bf16(pa3,PK(3),o[d0],0,0,0);
    #undef PK
  }
}

#ifndef ATTN_STORE16
#define ATTN_STORE16(p,v) (*(u32x4*)(p)=(v))
#endif
template<int THRL> __device__ __forceinline__ void attn_unit(int b,int h,int qb,const bf16*Q,const bf16*__restrict__ K,const bf16*__restrict__ V,bf16*O,char*shm){
  int tid_=threadIdx.x; asm volatile("":"+v"(tid_)); const int tid=tid_,lane=tid&63,r32=lane&31,hi=lane>>5; const int wid=__builtin_amdgcn_readfirstlane(tid>>6);
  const long rowbase=(long)b*TPAD; const int q0=64+qb*QB;
  const bf16*Qw=Q+(rowbase+q0+wid*QBLK)*DM+h*D;
  const bf16*Kh=K+rowbase*DM+h*D,*Vh=V+rowbase*DM+h*D;
  const unsigned lds0=(unsigned)(uintptr_t)shm;
  float*wsf=(float*)(shm+LDS_WS)+wid*64;
  const bf16*ksrc=Kh+(long)lane*DM+wid*8;
  const bf16*vsrc=Vh+(long)(16*(wid&3)+(lane>>2))*DM+(wid>>2)*32+(lane&3)*8;
  const unsigned kdst=lds0+LDS_K+wid*1024, vdst=lds0+LDS_V+wid*1024;
  #define DMA_K(t,slot) glds16(ksrc+(long)(t)*KVBLK*DM,(unsigned)__builtin_amdgcn_readfirstlane(kdst+(slot)))
  #define DMA_V(t,slot) glds16(vsrc+(long)(t)*KVBLK*DM,(unsigned)__builtin_amdgcn_readfirstlane(vdst+(slot)))
  const int vb0=(int)(lds0+LDS_V)+((lane>>4)&1)*32+(lane&3)*8+(4*hi+((lane&15)>>2))*64;
  const char*Kbase=shm+LDS_K; bf16x8 kf[8];
  const lds_cptr shm3=(lds_cptr)shm; const lds_cptr kp0=shm3+LDS_K+hi*1024+r32*16; const lds_cptr vp0=shm3+LDS_V+((lane>>4)&1)*32+(lane&3)*8+(4*hi+((lane&15)>>2))*64;
  const int NT=(q0+QB)/KVBLK;
  typedef __attribute__((address_space(3))) const f32x4k* lds_f4p; const __attribute__((address_space(3))) float* kbp0=(const __attribute__((address_space(3))) float*)(shm3+LDS_KB)+4*hi;
  #define KBINIT(C0,C1,t) do{ const __attribute__((address_space(3))) float* kp_=kbp0+(t)*64; _Pragma("unroll") for(int g_=0;g_<4;++g_){ const f32x4k a_=*(lds_f4p)(kp_+8*g_); const f32x4k b_=*(lds_f4p)(kp_+32+8*g_); _Pragma("unroll") for(int e_=0;e_<4;++e_){ C0[4*g_+e_]=a_[e_]-mhat; C1[4*g_+e_]=b_[e_]-mhat; } } }while(0)
  DMA_K(0,0);DMA_V(0,0);DMA_K(1,SLOTB);
  bf16x8 qr[4];
  #pragma unroll
  for(int d0=0;d0<4;++d0)qr[d0]=*reinterpret_cast<const bf16x8*>(&Qw[(long)r32*DM+d0*16+hi*8]);
  float mhat=0.f,l_reg=0.f;f32x16 o[2];o[0]=f32x16{};o[1]=f32x16{};
  const int qrel=wid*QBLK+r32;
  #define CMASK(P0,P1,t) do{int jb_=(t)-(NT-4); if(jb_>=0)cmask(P0,P1,jb_,qrel,hi);}while(0)
  bool resc=false;
  #define START(P0,P1) do{ const float rm=rowmax(P0,P1); resc=false; \
    { const float dl=rm; mhat=fadd_s(mhat,dl); \
      _Pragma("unroll") for(int r=0;r<16;++r){P0[r]=fsub_s(P0[r],dl);P1[r]=fsub_s(P1[r],dl);} } \
    _Pragma("unroll") for(int r=0;r<16;++r)P0[r]=__builtin_amdgcn_exp2f(P0[r]); }while(0)
  #define RESC() do{ if(resc){ asm volatile("s_waitcnt lgkmcnt(0)":::"memory"); \
      _Pragma("unroll") for(int d_=0;d_<2;++d_) _Pragma("unroll") for(int r=0;r<16;++r)o[d_][r]*=wsf[crow(r,hi)]; } }while(0)
  f32x16 pA0,pA1,pB0,pB1;
  int sl_prev=0,sl_cur=0,sl_next=SLOTB;
  #define ROT() do{sl_prev=sl_cur;sl_cur=sl_next;sl_next=(sl_next==(NSLOT-1)*SLOTB)?0:sl_next+SLOTB;}while(0)
  DMA_K(2,2*SLOTB);
  WAIT_BAR(3);
  KBINIT(pA0,pA1,0); qkt(pA0,pA1,Kbase,qr,r32,hi);asm volatile("s_nop 15\n\ts_nop 7":"+v"(pA0),"+v"(pA1));CMASK(pA0,pA1,0);
  START(pA0,pA1);
  _Pragma("unroll") for(int r=0;r<16;++r)pA1[r]=__builtin_amdgcn_exp2f(pA1[r]);
  WAIT_BAR(0);
  DMA_K(3,0);DMA_V(1,SLOTB);
  ROT();
  kload8(kf,kp0+sl_cur);
  WAIT_BAR(2);
  s16x4 vlo[8],vhi[8]; u32x4 pw0,pw1,pw2,pw3;
  #define PKW(P,B) cvtpk_s(P[B],P[B+1])
  #define PAF(k) __builtin_bit_cast(bf16x8,pw##k)
  #define VFR(i) (bf16x8){vlo[i][0],vlo[i][1],vlo[i][2],vlo[i][3],vhi[i][0],vhi[i][1],vhi[i][2],vhi[i][3]}
  #define PIN(x) asm volatile("":"+v"(x))
  #define MX3(a,b,c) __builtin_fmaxf(__builtin_fmaxf((a),(b)),(c))
  #define GAPA(MF,A0,A1,A2,A3,W0,W1,PW) do{ MF; sacc+=A0; sacc+=A1; sacc+=A2; sacc+=A3; PIN(sacc); W0; W1; PIN(PW); SBAR(); }while(0)
  #define EX(v) __builtin_amdgcn_exp2f(v)
  #define GAPB(MF,X,B) do{ MF; X[B]=EX(X[B]); X[B+1]=EX(X[B+1]); X[B+2]=EX(X[B+2]); X[B+3]=EX(X[B+3]); PIN(X); SBAR(); }while(0)
  #define VRD(i) do{ vlo[i]=vtr(vp_+(((i)>>2)*4096+((i)&3)*1024)); vhi[i]=vtr(vp_+(((i)>>2)*4096+((i)&3)*1024+512)); }while(0)
  #define KRD(G,j) do{ if(G){ kload2(kf,kp0+sl_next,j); SBAR(); } }while(0)
  #define STEP(C0,C1,P0,P1,t,GK,GV,GL) do{ SBAR(); \
    const lds_cptr vp_=vp0+sl_prev; \
    KBINIT(C0,C1,t); SBAR(); \
    VRD(0); SBAR(); float sacc=(P0[0]+P0[1]); \
    GAPA(C0=__builtin_amdgcn_mfma_f32_32x32x16_bf16(kf[0],qr[0],C0,0,0,0), P0[2],P0[3],P0[4],P0[5],     pw0[0]=PKW(P0,0), pw0[1]=PKW(P0,2), pw0); \
    VRD(4); SBAR(); GAPA(C1=__builtin_amdgcn_mfma_f32_32x32x16_bf16(kf[1],qr[0],C1,0,0,0), P0[6],P0[7],P0[8],P0[9],     pw0[2]=PKW(P0,4), pw0[3]=PKW(P0,6), pw0); \
    VRD(1); SBAR(); GAPA(C0=__builtin_amdgcn_mfma_f32_32x32x16_bf16(kf[2],qr[1],C0,0,0,0),   P0[10],P0[11],P0[12],P0[13], pw1[0]=PKW(P0,8), pw1[1]=PKW(P0,10), pw1); \
    VRD(5); SBAR(); GAPA(C1=__builtin_amdgcn_mfma_f32_32x32x16_bf16(kf[3],qr[1],C1,0,0,0),   P0[14],P0[15],P1[0],P1[1],   pw1[2]=PKW(P0,12),pw1[3]=PKW(P0,14), pw1); \
    VRD(2); SBAR(); GAPA(C0=__builtin_amdgcn_mfma_f32_32x32x16_bf16(kf[4],qr[2],C0,0,0,0),   P1[2],P1[3],P1[4],P1[5],     pw2[0]=PKW(P1,0), pw2[1]=PKW(P1,2), pw2); \
    VRD(6); SBAR(); GAPA(C1=__builtin_amdgcn_mfma_f32_32x32x16_bf16(kf[5],qr[2],C1,0,0,0),   P1[6],P1[7],P1[8],P1[9],     pw2[2]=PKW(P1,4), pw2[3]=PKW(P1,6), pw2); \
    VRD(3); SBAR(); GAPA(C0=__builtin_amdgcn_mfma_f32_32x32x16_bf16(kf[6],qr[3],C0,0,0,0),   P1[10],P1[11],P1[12],P1[13], pw3[0]=PKW(P1,8), pw3[1]=PKW(P1,10), pw3); \
    VRD(7); SBAR(); GAPA(C1=__builtin_amdgcn_mfma_f32_32x32x16_bf16(kf[7],qr[3],C1,0,0,0),   P1[14],P1[15],0.f,0.f,       pw3[2]=PKW(P1,12),pw3[3]=PKW(P1,14), pw3); \
    l_reg+=sacc; \
    if(GK){DMA_K((t)+3,sl_cur);} if(GV){DMA_V((t)+1,sl_next);} \
    CMASK(C0,C1,t); \
    { float a=MX3(C0[0],C0[1],C1[0]),b=MX3(C0[2],C0[3],C1[1]); a=MX3(a,C1[2],C1[3]); \
      _Pragma("unroll") for(int r=4;r<16;r+=4){a=MX3(a,C0[r],C0[r+1]);b=MX3(b,C0[r+2],C0[r+3]);a=MX3(a,C1[r],C1[r+1]);b=MX3(b,C1[r+2],C1[r+3]);} \
      float rm=__builtin_fmaxf(a,b); { auto rr=__builtin_amdgcn_permlane32_swap(__float_as_uint(rm),__float_as_uint(rm),false,false); rm=__builtin_fmaxf(__uint_as_float(rr[0]),__uint_as_float(rr[1])); } \
      resc=false; \
      if(__builtin_expect(__any(rm>(float)THRL),0)){ const float dl=__builtin_fmaxf(rm,0.f); mhat+=dl; \
        _Pragma("unroll") for(int r=0;r<16;++r){C0[r]-=dl;C1[r]-=dl;} \
        const float f=__builtin_amdgcn_exp2f(-dl); l_reg*=f; if(hi==0)wsf[r32]=f; resc=true; } } \
    SBAR(); \
    GAPB(o[0]=__builtin_amdgcn_mfma_f32_32x32x16_bf16(PAF(0),VFR(0),o[0],0,0,0), C0,0); \
    GAPB(o[1]=__builtin_amdgcn_mfma_f32_32x32x16_bf16(PAF(0),VFR(4),o[1],0,0,0), C0,4); \
    KRD(GL,0); GAPB(o[0]=__builtin_amdgcn_mfma_f32_32x32x16_bf16(PAF(1),VFR(1),o[0],0,0,0), C0,8); \
    KRD(GL,1); GAPB(o[1]=__builtin_amdgcn_mfma_f32_32x32x16_bf16(PAF(1),VFR(5),o[1],0,0,0), C0,12); \
    KRD(GL,2); GAPB(o[0]=__builtin_amdgcn_mfma_f32_32x32x16_bf16(PAF(2),VFR(2),o[0],0,0,0), C1,0); \
    KRD(GL,3); GAPB(o[1]=__builtin_amdgcn_mfma_f32_32x32x16_bf16(PAF(2),VFR(6),o[1],0,0,0), C1,4); \
    GAPB(o[0]=__builtin_amdgcn_mfma_f32_32x32x16_bf16(PAF(3),VFR(3),o[0],0,0,0), C1,8); \
    GAPB(o[1]=__builtin_amdgcn_mfma_f32_32x32x16_bf16(PAF(3),VFR(7),o[1],0,0,0), C1,12); \
    }while(0)
  int t=1;
  #undef CMASK
  #define CMASK(P0,P1,t) do{}while(0)
  for(;t+5<NT;t+=2){
    STEP(pB0,pB1,pA0,pA1,t,true,true,true);     WAIT_BAR(2); RESC(); ROT();
    STEP(pA0,pA1,pB0,pB1,t+1,true,true,true);   WAIT_BAR(2); RESC(); ROT();
  }
  #undef CMASK
  #define CMASK(P0,P1,t) do{int jb_=(t)-(NT-4); if(jb_>=0)cmask(P0,P1,jb_,qrel,hi);}while(0)
  #define ENDW(tt) do{ if((tt)+3<NT){WAIT_BAR(2);} else if((tt)+2<NT){WAIT_BAR(1);} else {WAIT_BAR(0);} }while(0)
  for(;t+1<NT;t+=2){
    STEP(pB0,pB1,pA0,pA1,t,(t+3<NT),(t+1<NT),(t+1<NT));       ENDW(t);   RESC(); ROT();
    STEP(pA0,pA1,pB0,pB1,t+1,(t+4<NT),(t+2<NT),(t+2<NT));     ENDW(t+1); RESC(); ROT();
  }
  { float sacc=pA0[0]+pA0[1]; _Pragma("unroll") for(int r=2;r<16;++r)sacc+=pA0[r]; _Pragma("unroll") for(int r=0;r<16;++r)sacc+=pA1[r]; l_reg+=sacc;
    pw0=(u32x4){PKW(pA0,0),PKW(pA0,2),PKW(pA0,4),PKW(pA0,6)};pw1=(u32x4){PKW(pA0,8),PKW(pA0,10),PKW(pA0,12),PKW(pA0,14)};pw2=(u32x4){PKW(pA1,0),PKW(pA1,2),PKW(pA1,4),PKW(pA1,6)};pw3=(u32x4){PKW(pA1,8),PKW(pA1,10),PKW(pA1,12),PKW(pA1,14)};
    SBAR(); pv(o,vb0+sl_prev,PAF(0),PAF(1),PAF(2),PAF(3)); }
  #undef PKW
  #undef PAF
  #undef VFR
  #undef PIN
  #undef MX3
  #undef GAPA
  #undef GAPB
  #undef EX
  #undef VRD
  #undef KRD
  #undef STEP
  #undef ENDW
  {auto rr=__builtin_amdgcn_permlane32_swap(__float_as_uint(l_reg),__float_as_uint(l_reg),false,false);l_reg=__uint_as_float(rr[0])+__uint_as_float(rr[1]);}
  if(hi==0)wsf[32+r32]=l_reg;asm volatile("s_waitcnt lgkmcnt(0)":::"memory");
  float rli[16];
  #pragma unroll
  for(int r=0;r<16;++r)rli[r]=__builtin_amdgcn_rcpf(wsf[32+crow(r,hi)]);
  bf16*Ow=O+(rowbase+q0+wid*QBLK)*DM+h*D;
  { bf16*stg=(bf16*)(shm+LDS_OST)+wid*2048;
    #pragma unroll
    for(int r=0;r<16;++r){const int orow=crow(r,hi);
      #pragma unroll
      for(int d0=0;d0<2;++d0)stg[orow*64+d0*32+r32]=__float2bfloat16(o[d0][r]*rli[r]);}
    asm volatile("s_waitcnt lgkmcnt(0)":::"memory");
    #pragma unroll
    for(int i=0;i<4;++i){const int row=i*8+(lane>>3),ch=lane&7; const u32x4 v=*(const u32x4*)(stg+row*64+ch*8); ATTN_STORE16(Ow+(long)row*DM+ch*8,v);} }
  asm volatile("s_waitcnt lgkmcnt(0)\n\ts_barrier":::"memory");
  #undef DMA_K
  #undef DMA_V
  #undef CMASK
  #undef START
  #undef RESC
  #undef ROT
  #undef KBINIT
}
constexpr int ATTN_LDS_BYTES=LDS_BYTES;
#undef SBAR
#undef WAIT_BAR
}

#define LAS __attribute__((address_space(3)))
typedef unsigned short bf16;
typedef unsigned v4u __attribute__((ext_vector_type(4)));
typedef unsigned v2u __attribute__((ext_vector_type(2)));
typedef float f32x4 __attribute__((ext_vector_type(4)));
typedef short bf16x8 __attribute__((ext_vector_type(8)));
typedef float f32x16v __attribute__((ext_vector_type(16)));

constexpr int NB = 16, SEQ = 4096, DMODEL = 1024, NMETA = 16;
constexpr int TP = 4160;
constexpr int R = NB * TP;
constexpr int NTOK = NB * SEQ;
constexpr int N1 = 5632;
constexpr int IN_COLS = 5416;
constexpr int NWAVES = 8, NTHREADS = 512;
constexpr float NORM_EPS = 1e-6f, GN_EPS = 64e-5f;
constexpr float LOG2E = 1.4426950408889634f;

constexpr size_t MiB = 1u << 20;
constexpr size_t U65 = 65 * MiB;
constexpr size_t WS_WTIN = 1 * MiB;
constexpr size_t WS_WTQ = 12 * MiB;
constexpr size_t WS_WTFOX = 16 * MiB;
constexpr size_t WS_WTRWKV = 17 * MiB;
constexpr size_t WS_WTOUT = 18 * MiB;
constexpr size_t WS_WTWA = 20 * MiB;
constexpr size_t WS_WTG = 20 * MiB + 512 * 1024;
constexpr size_t WS_KS = 21 * MiB;
constexpr size_t WS_KB = 22 * MiB;
constexpr size_t WS_LF = 25 * MiB;
constexpr size_t WS_BS = 28 * MiB;
constexpr size_t WS_U8 = 32 * MiB;
constexpr size_t WS_SU = 48 * MiB;
constexpr size_t WS_V8 = 64 * MiB;
constexpr size_t WS_SV = 80 * MiB;
constexpr size_t WS_CORR = 81 * MiB;
constexpr size_t WS_SX = 82 * MiB;
constexpr size_t WS_XQ = 352 * MiB;
constexpr size_t WS_F = 96 * MiB;
constexpr size_t WS_FQ = WS_F, WS_FK = WS_F + U65, WS_FV = WS_F + 2 * U65, WS_ZRR = WS_F + 3 * U65, WS_ZRK = WS_F + 4 * U65, WS_ZRV = WS_F + 5 * U65, WS_ZM = WS_F + 6 * U65;
constexpr size_t WS_ZG = WS_F + 7 * U65;
constexpr size_t WS_XN = WS_ZG + 4 * U65;
constexpr size_t WS_IDS = 941 * MiB;
constexpr size_t WS_GATES = 973 * MiB;
constexpr size_t WS_END = 1005 * MiB;
constexpr size_t WS_LA = WS_XN;
constexpr size_t WS_LG = WS_XN + 20 * MiB;
constexpr size_t WS_KP = WS_XN;
constexpr size_t WS_KN = WS_XN + U65;
constexpr size_t WS_Y = WS_ZM;
constexpr size_t WS_MIX = WS_XN;
constexpr size_t WS_XN2 = WS_XN;
constexpr size_t WS_PQ = WS_F;
constexpr size_t DO_XW = 0, DO_AA = U65, DO_GG = 2 * U65;

__device__ __forceinline__ unsigned f2bf(float f) { unsigned u = __builtin_bit_cast(unsigned, f); return (u + 0x7fffu + ((u >> 16) & 1u)) >> 16; }
__device__ __forceinline__ unsigned pk2(float lo, float hi) { return f2bf(lo) | (f2bf(hi) << 16); }
__device__ __forceinline__ float bflo(unsigned w) { return __builtin_bit_cast(float, w << 16); }
__device__ __forceinline__ float bfhi(unsigned w) { return __builtin_bit_cast(float, w & 0xffff0000u); }
__device__ __forceinline__ void unpack8(const v4u w, float (&f)[8]) { f[0] = bflo(w.x); f[1] = bfhi(w.x); f[2] = bflo(w.y); f[3] = bfhi(w.y); f[4] = bflo(w.z); f[5] = bfhi(w.z); f[6] = bflo(w.w); f[7] = bfhi(w.w); }
__device__ __forceinline__ v4u pack8(const float (&f)[8]) { v4u w; w.x = pk2(f[0], f[1]); w.y = pk2(f[2], f[3]); w.z = pk2(f[4], f[5]); w.w = pk2(f[6], f[7]); return w; }
__device__ __forceinline__ float sigmoidf_(float x) { return __builtin_amdgcn_rcpf(1.0f + __builtin_amdgcn_exp2f(-x * LOG2E)); }
__device__ __forceinline__ float wave_sum(float v) {
#pragma unroll
    for (int o = 1; o < 64; o <<= 1) v += __shfl_xor(v, o);
    return v;
}
__device__ __forceinline__ float sum8(float v) { v += __shfl_xor(v, 1); v += __shfl_xor(v, 2); v += __shfl_xor(v, 4); return v; }

struct Params {
    const float* in[27];
    float* out;
    unsigned char* ws;
};
enum { I_X = 0, I_META, I_N1G, I_WIN, I_FQN, I_FKN, I_FBIAS, I_MU, I_W0, I_WUP, I_A0, I_AUP, I_GUP, I_KK, I_KA, I_RK, I_LNG, I_LNB, I_WFOX, I_WRWKV, I_WOUT, I_N2G, I_PWQ, I_SK1, I_SK2, I_PU, I_PV };

__device__ __forceinline__ int win_src_col(int n) {
    if (n < 1536) return n;
    if (n < 3072) return 1544 + (n - 1536);
    if (n < 3584) { const int m = n - 3072; if (m < 288) return 3080 + m; if (m < 296) return 1536 + (m - 288); return -1; }
    return 3368 + (n - 3584);
}
template <bool REMAP>
__device__ __forceinline__ void transpose_item(const float* W, int ldw, int K, int N, bf16* WT, LAS float* scr, int item, int lane) {
    const int nblk = N / 32, kb = item / nblk, nb = item % nblk, k0 = 64 * kb, n0 = 32 * nb;
    const int n = n0 + (lane & 31); const int sc = REMAP ? win_src_col(n) : n;
#pragma unroll 8
    for (int i = 0; i < 32; ++i) { const int kk = 2 * i + (lane >> 5); scr[kk * 33 + (lane & 31)] = (sc >= 0) ? W[(size_t)(k0 + kk) * ldw + sc] : 0.f; }
    asm volatile("s_waitcnt lgkmcnt(0)" ::: "memory");
    const int c = lane & 7;
#pragma unroll
    for (int j = 0; j < 4; ++j) { const int nn = (lane >> 3) + 8 * j; const LAS float* s = scr + (8 * c) * 33 + nn;
        v4u o; o.x = pk2(s[0 * 33], s[1 * 33]); o.y = pk2(s[2 * 33], s[3 * 33]); o.z = pk2(s[4 * 33], s[5 * 33]); o.w = pk2(s[6 * 33], s[7 * 33]);
        *(v4u*)(WT + (size_t)(n0 + nn) * K + k0 + 8 * c) = o; }
    asm volatile("s_waitcnt lgkmcnt(0)" ::: "memory");
}
__device__ __forceinline__ void p0_prologue(const Params& p, LAS unsigned char* lds, int vcu, int G, int wave, int lane) {
    unsigned char* ws = p.ws;
    LAS float* scr = (LAS float*)(lds + wave * 16384);
    const int gw = vcu * NWAVES + wave, NGW = G * NWAVES;
    constexpr int I_IN = 16 * (N1 / 32), I_Q = 16 * 64, I_FX = 8 * 32, I_O = 16 * 32;
    constexpr int NITEMS = I_IN + I_Q + 2 * I_FX + I_O;
    for (int it = gw; it < NITEMS; it += NGW) {
        int r = it;
        if (r < I_IN) { transpose_item<true>(p.in[I_WIN], IN_COLS, 1024, N1, (bf16*)(ws + WS_WTIN), scr, r, lane); continue; } r -= I_IN;
        if (r < I_Q) { transpose_item<false>(p.in[I_PWQ], 2048, 1024, 2048, (bf16*)(ws + WS_WTQ), scr, r, lane); continue; } r -= I_Q;
        if (r < I_FX) { transpose_item<false>(p.in[I_WFOX], 1024, 512, 1024, (bf16*)(ws + WS_WTFOX), scr, r, lane); continue; } r -= I_FX;
        if (r < I_FX) { transpose_item<false>(p.in[I_WRWKV], 1024, 512, 1024, (bf16*)(ws + WS_WTRWKV), scr, r, lane); continue; } r -= I_FX;
        transpose_item<false>(p.in[I_WOUT], 1024, 1024, 1024, (bf16*)(ws + WS_WTOUT), scr, r, lane);
    }
    const int gt = gw * 64 + lane, NGT = NGW * 64;
    for (int i = gt; i < 1024 * 128; i += NGT) { const int n = i >> 7, k = i & 127; float v = 0.f;
        if (n < 512) { if (k < 64) v = p.in[I_WUP][k * 512 + n]; } else { if (k >= 64) v = p.in[I_AUP][(k - 64) * 512 + (n - 512)]; }
        ((bf16*)(ws + WS_WTWA))[i] = (bf16)f2bf(v); }
    for (int i = gt; i < 512 * 256; i += NGT) { const int n = i >> 8, k = i & 255; const float v = (k < 160) ? p.in[I_GUP][k * 512 + n] : 0.f; ((bf16*)(ws + WS_WTG))[i] = (bf16)f2bf(v); }
    for (int i = gt; i < 2 * 128 * 128; i += NGT) { const float v = (i < 16384) ? p.in[I_SK1][i] : p.in[I_SK2][i - 16384]; ((bf16*)(ws + WS_KS))[i] = (bf16)f2bf(v); }
    for (int r = gw; r < 32768; r += NGW) {
        const int tbl = r >> 14, row = r & 16383;
        const f32x4* src = (const f32x4*)((tbl ? p.in[I_PV] : p.in[I_PU]) + (size_t)row * 1024 + 16 * lane);
        f32x4 a[4]; float m = 0.f;
#pragma unroll
        for (int j = 0; j < 4; ++j) { a[j] = src[j]; m = fmaxf(m, fmaxf(fmaxf(fabsf(a[j].x), fabsf(a[j].y)), fmaxf(fabsf(a[j].z), fabsf(a[j].w)))); }
#pragma unroll
        for (int o = 1; o < 64; o <<= 1) m = fmaxf(m, __shfl_xor(m, o));
        const float inv = m > 0.f ? 127.0f / m : 0.f; const int off = tbl ? 128 : 0;
        v4u w;
        unsigned ww[4];
#pragma unroll
        for (int j = 0; j < 4; ++j) { const int q0 = (int)rintf(a[j].x * inv) + off, q1 = (int)rintf(a[j].y * inv) + off, q2 = (int)rintf(a[j].z * inv) + off, q3 = (int)rintf(a[j].w * inv) + off;
            ww[j] = (unsigned)(q0 & 255) | ((unsigned)(q1 & 255) << 8) | ((unsigned)(q2 & 255) << 16) | ((unsigned)(q3 & 255) << 24); }
        w.x = ww[0]; w.y = ww[1]; w.z = ww[2]; w.w = ww[3];
        *(v4u*)(ws + (tbl ? WS_V8 : WS_U8) + (size_t)row * 1024 + 16 * lane) = w;
        if (lane == 0) ((float*)(ws + (tbl ? WS_SV : WS_SU)))[row] = m > 0.f ? m * (1.0f / 127.0f) : 1.0f;
    }
    const f32x4* g4 = (const f32x4*)p.in[I_N1G] + lane;
    for (int m = gw; m < R; m += NGW) {
        const int b = m / TP, pp = m - b * TP;
        unsigned long long* o8 = (unsigned long long*)(ws + WS_XN + (size_t)m * 2048) + lane;
        if (pp < 48) {
#pragma unroll
            for (int j = 0; j < 4; ++j) o8[64 * j] = 0ull;
            continue; }
        const float* xrow = (pp < 64) ? p.in[I_META] + (size_t)(pp - 48) * 1024 : p.in[I_X] + ((size_t)b * SEQ + (pp - 64)) * 1024;
        const f32x4* xr = (const f32x4*)xrow + lane;
        f32x4 v[4]; float s = 0.f;
#pragma unroll
        for (int j = 0; j < 4; ++j) { v[j] = xr[64 * j]; s += (v[j].x * v[j].x + v[j].y * v[j].y) + (v[j].z * v[j].z + v[j].w * v[j].w); }
        const float rs = 1.0f / sqrtf(wave_sum(s) * (1.f / 1024.f) + NORM_EPS);
#pragma unroll
        for (int j = 0; j < 4; ++j) { const f32x4 g = g4[64 * j]; o8[64 * j] = (unsigned long long)pk2(v[j].x * rs * g.x, v[j].y * rs * g.y) | ((unsigned long long)pk2(v[j].z * rs * g.z, v[j].w * rs * g.w) << 32); }
    }
}

template <class F> struct EpiT {
    static constexpr bool PERM = true, AFTER_DRAIN = false;
    F f;
    __device__ __forceinline__ void operator()(const pg8::f32x4 (&acc)[2][2][4][2], const pg8::Unit& u, int wr, int wc, int fr, int fq) const {
        const int row0 = u.pm * 256 + wr * 64 + fr, col0 = u.pn * 256 + wc * 32 + 8 * fq;
#pragma unroll
        for (int ai = 0; ai < 2; ++ai)
#pragma unroll
            for (int m = 0; m < 4; ++m)
#pragma unroll
                for (int bj = 0; bj < 2; ++bj) {
                    const pg8::f32x4 a = acc[ai][bj][m][0], b = acc[ai][bj][m][1];
                    float v[8] = {a[0], a[1], a[2], a[3], b[0], b[1], b[2], b[3]};
                    f.store(row0 + ai * 128 + m * 16, col0 + bj * 128, v);
                }
    }
};
struct F_Gemm1 {
    bf16* F; bf16* ZG;
    __device__ __forceinline__ void store(int row, int col, float (&v)[8]) const {
        if (col < 3584) { const int buf = col >> 9, c = col & 511; *(v4u*)(F + (size_t)buf * ((size_t)R * 512) + (size_t)row * 512 + c) = pack8(v); }
        else { const int c = col - 3584;
#pragma unroll
            for (int e = 0; e < 8; ++e) v[e] = sigmoidf_(v[e]);
            *(v4u*)(ZG + (size_t)row * 2048 + c) = pack8(v); }
    }
};
struct F_LoraW {
    bf16* XW; const float* w0;
    __device__ __forceinline__ void store(int row, int col, float (&v)[8]) const {
        const f32x4 b0 = *(const f32x4*)(w0 + col), b1 = *(const f32x4*)(w0 + col + 4); const float bb[8] = {b0.x, b0.y, b0.z, b0.w, b1.x, b1.y, b1.z, b1.w};
#pragma unroll
        for (int e = 0; e < 8; ++e) { const float x = v[e] + bb[e];
            const float sp = fmaxf(-x, 0.f) + __logf(1.0f + __expf(-fabsf(x)));
            const float ew = __expf(-sp - 0.5f);
            v[e] = 1.0f - __expf(-ew); }
        *(v4u*)(XW + (size_t)row * 512 + col) = pack8(v);
    }
};
struct F_LoraA {
    bf16* AA; const float* a0;
    __device__ __forceinline__ void store(int row, int col, float (&v)[8]) const {
        const f32x4 b0 = *(const f32x4*)(a0 + col), b1 = *(const f32x4*)(a0 + col + 4); const float bb[8] = {b0.x, b0.y, b0.z, b0.w, b1.x, b1.y, b1.z, b1.w};
#pragma unroll
        for (int e = 0; e < 8; ++e) v[e] = sigmoidf_(v[e] + bb[e]);
        *(v4u*)(AA + (size_t)row * 512 + col) = pack8(v);
    }
};
struct F_Plain {
    bf16* O; int ldc;
    __device__ __forceinline__ void store(int row, int col, float (&v)[8]) const { *(v4u*)(O + (size_t)row * ldc + col) = pack8(v); }
};
struct F_MixA {
    bf16* MIX; const bf16* ZG;
    __device__ __forceinline__ void store(int row, int col, float (&v)[8]) const {
        float g[8]; unpack8(*(const v4u*)(ZG + (size_t)row * 2048 + col), g);
#pragma unroll
        for (int e = 0; e < 8; ++e) v[e] *= g[e];
        *(v4u*)(MIX + (size_t)row * 1024 + col) = pack8(v);
    }
};
struct F_MixB {
    bf16* MIX; const bf16* ZG;
    __device__ __forceinline__ void store(int row, int col, float (&v)[8]) const {
        float g[8], m[8]; unpack8(*(const v4u*)(ZG + (size_t)row * 2048 + 1024 + col), g); unpack8(*(const v4u*)(MIX + (size_t)row * 1024 + col), m);
#pragma unroll
        for (int e = 0; e < 8; ++e) v[e] = m[e] + v[e] * g[e];
        *(v4u*)(MIX + (size_t)row * 1024 + col) = pack8(v);
    }
};
struct F_Out {
    const float* x; float* out;
    __device__ __forceinline__ void store(int row, int col, float (&v)[8]) const {
        const int b = row / TP, pp = row - b * TP; if (pp < 64) return;
        const size_t off = ((size_t)b * SEQ + (pp - 64)) * 1024 + col;
        const f32x4 x0 = *(const f32x4*)(x + off), x1 = *(const f32x4*)(x + off + 4);
        *(f32x4*)(out + off) = (f32x4){x0.x + v[0], x0.y + v[1], x0.z + v[2], x0.w + v[3]};
        *(f32x4*)(out + off + 4) = (f32x4){x1.x + v[4], x1.y + v[5], x1.z + v[6], x1.w + v[7]};
    }
};
template <class F>
__device__ __forceinline__ void run_gemm(LAS unsigned char* lds, const bf16* A, const bf16* Bt, int M, int N, int K, int G, int bid, const F& f) {
    asm volatile("" : "+s"(M), "+s"(N), "+s"(G));
    pg8::Gemm g{A, Bt, M, N, K}; pg8::StaticOrder S; S.init(M, N, G, bid);
    EpiT<F> E{f};
    pg8::gemm_phase<EpiT<F>, pg8::StaticOrder, true, true>(lds, g, S, E);
}

__device__ __forceinline__ void p2_prep1(const Params& p, int vcu, int G, int wave, int lane) {
    unsigned char* ws = p.ws;
    const int gw = vcu * NWAVES + wave, NGW = G * NWAVES;
    float gq[8], gk[8], mu[8];
#pragma unroll
    for (int e = 0; e < 8; ++e) { gq[e] = p.in[I_FQN][lane * 8 + e] * attn_body::C2; gk[e] = p.in[I_FKN][lane * 8 + e]; mu[e] = (lane < 36) ? p.in[I_MU][1536 + lane * 8 + e] : 0.f; }
    for (int m = gw; m < R; m += NGW) {
        const int b = m / TP, pp = m - b * TP;
        {
            v4u* qp = (v4u*)(ws + WS_FQ + (size_t)m * 1024) + lane; v4u* kp = (v4u*)(ws + WS_FK + (size_t)m * 1024) + lane;
            float q[8], k[8]; unpack8(*qp, q); unpack8(*kp, k);
            float sq = 0.f, sk = 0.f;
#pragma unroll
            for (int e = 0; e < 8; ++e) { sq += q[e] * q[e]; sk += k[e] * k[e]; }
            sq = sum8(sq); sk = sum8(sk);
            const float rq = 1.0f / sqrtf(sq * (1.f / 64.f) + NORM_EPS), rk = 1.0f / sqrtf(sk * (1.f / 64.f) + NORM_EPS);
#pragma unroll
            for (int e = 0; e < 8; ++e) { q[e] *= rq * gq[e]; k[e] *= rk * gk[e]; }
            *qp = pack8(q); *kp = pack8(k);
        }
        if (lane < 36) {
            float z[8], zp[8]; unpack8(*((const v4u*)(ws + WS_ZM + (size_t)m * 1024) + lane), z);
            if (pp > 0) unpack8(*((const v4u*)(ws + WS_ZM + (size_t)(m - 1) * 1024) + lane), zp); else {
#pragma unroll
                for (int e = 0; e < 8; ++e) zp[e] = 0.f; }
#pragma unroll
            for (int e = 0; e < 8; ++e) { const float s = z[e] + mu[e] * (zp[e] - z[e]); z[e] = (lane < 8) ? tanhf(s) : (lane < 16) ? s : sigmoidf_(s); }
            if (lane < 16) *((v4u*)(ws + WS_LA + (size_t)m * 256) + lane) = pack8(z);
            else *((v4u*)(ws + WS_LG + (size_t)m * 512) + (lane - 16)) = pack8(z);
        } else if (lane == 36) {
            float z[8]; unpack8(*((const v4u*)(ws + WS_ZM + (size_t)m * 1024) + 36), z);
#pragma unroll
            for (int e = 0; e < 8; ++e) { const float x = z[e] + p.in[I_FBIAS][e]; z[e] = fminf(x, 0.f) - __logf(1.0f + __expf(-fabsf(x))); }
            float* lf = (float*)(ws + WS_LF) + (size_t)m * 8;
            *(f32x4*)lf = (f32x4){z[0], z[1], z[2], z[3]}; *(f32x4*)(lf + 4) = (f32x4){z[4], z[5], z[6], z[7]};
        } else if (lane < 49) {
            *((v4u*)(ws + WS_LG + (size_t)m * 512) + (lane - 37 + 20)) = (v4u){0u, 0u, 0u, 0u};
        }
    }
}
__device__ __forceinline__ void p3_cumsum(const Params& p, int seq, int lane) {
    unsigned char* ws = p.ws;
    const int b = seq >> 3, h = seq & 7;
    const float* lf = (const float*)(ws + WS_LF) + (size_t)b * TP * 8 + h;
    float* kb = (float*)(ws + WS_KB) + (size_t)seq * TP;
    float carry = 0.f;
    for (int c0 = 0; c0 < 65; c0 += 13) {
        float v[13];
#pragma unroll
        for (int i = 0; i < 13; ++i) { const int pp = (c0 + i) * 64 + lane; v[i] = (pp >= 48) ? lf[(size_t)pp * 8] : 0.f; }
#pragma unroll
        for (int i = 0; i < 13; ++i) {
            float x = v[i];
#pragma unroll
            for (int o = 1; o < 64; o <<= 1) { const float y = __shfl_up(x, o); if (lane >= o) x += y; }
            const int pp = (c0 + i) * 64 + lane;
            const float c = carry + x;
            kb[pp] = (pp >= 48) ? -c * LOG2E : -1e30f;
            carry += __shfl(x, 63);
        }
    }
}

__device__ __forceinline__ void p4_prep2(const Params& p, int vcu, int G, int wave, int lane) {
    unsigned char* ws = p.ws; unsigned char* dob = (unsigned char*)p.out;
    const int gw = vcu * NWAVES + wave, NGW = G * NWAVES;
    float mur[8], muk[8], kk_[8], ka_[8], rk_[8];
#pragma unroll
    for (int e = 0; e < 8; ++e) { const int c = lane * 8 + e; mur[e] = p.in[I_MU][c]; muk[e] = p.in[I_MU][512 + c]; kk_[e] = p.in[I_KK][c]; ka_[e] = p.in[I_KA][c]; rk_[e] = p.in[I_RK][c]; }
    for (int m = gw; m < R; m += NGW) {
        const int b = m / TP, pp = m - b * TP;
        float r[8], k[8], rp[8], kp[8], a[8];
        unpack8(*((const v4u*)(ws + WS_ZRR + (size_t)m * 1024) + lane), r); unpack8(*((const v4u*)(ws + WS_ZRK + (size_t)m * 1024) + lane), k);
        if (pp > 0) { unpack8(*((const v4u*)(ws + WS_ZRR + (size_t)(m - 1) * 1024) + lane), rp); unpack8(*((const v4u*)(ws + WS_ZRK + (size_t)(m - 1) * 1024) + lane), kp); }
        else {
#pragma unroll
            for (int e = 0; e < 8; ++e) { rp[e] = 0.f; kp[e] = 0.f; } }
        v4u* aap = (v4u*)(dob + DO_AA + (size_t)m * 1024) + lane;
        unpack8(*aap, a);
        float kkv[8], kpr[8]; float ss = 0.f, bon = 0.f;
#pragma unroll
        for (int e = 0; e < 8; ++e) { const float rs = r[e] + mur[e] * (rp[e] - r[e]); const float ks = k[e] + muk[e] * (kp[e] - k[e]);
            kkv[e] = ks * kk_[e]; kpr[e] = ks * (1.0f + (a[e] - 1.0f) * ka_[e]); ss += kkv[e] * kkv[e]; bon += rs * kpr[e] * rk_[e]; }
        ss = sum8(ss); bon = sum8(bon);
        const float inv = 1.0f / fmaxf(sqrtf(ss), 1e-12f);
        float bb[8];
#pragma unroll
        for (int e = 0; e < 8; ++e) { kkv[e] *= inv; bb[e] = kkv[e] * a[e]; }
        *((v4u*)(ws + WS_KP + (size_t)m * 1024) + lane) = pack8(kpr);
        *((v4u*)(ws + WS_KN + (size_t)m * 1024) + lane) = pack8(kkv);
        *aap = pack8(bb);
        if ((lane & 7) == 0) ((float*)(ws + WS_BS))[(size_t)m * 8 + (lane >> 3)] = bon;
    }
}

constexpr int SC_CH = 32, SC_STRIDE = 5 * 64 + 32;
constexpr int SC_BUF_BYTES = SC_CH * SC_STRIDE * 4;
constexpr int SC_YB_BYTES = SC_CH * 32 * 4 * 4;
__device__ __forceinline__ float dpp_sum16(float x) {
    x += __builtin_bit_cast(float, __builtin_amdgcn_update_dpp(0, __builtin_bit_cast(int, x), 0xB1, 0xF, 0xF, true));
    x += __builtin_bit_cast(float, __builtin_amdgcn_update_dpp(0, __builtin_bit_cast(int, x), 0x4E, 0xF, 0xF, true));
    x += __builtin_bit_cast(float, __builtin_amdgcn_update_dpp(0, __builtin_bit_cast(int, x), 0x141, 0xF, 0xF, true));
    x += __builtin_bit_cast(float, __builtin_amdgcn_update_dpp(0, __builtin_bit_cast(int, x), 0x140, 0xF, 0xF, true));
    return x;
}
__device__ __forceinline__ float dpp_sum4(float x) {
    x += __builtin_bit_cast(float, __builtin_amdgcn_update_dpp(0, __builtin_bit_cast(int, x), 0xB1, 0xF, 0xF, true));
    x += __builtin_bit_cast(float, __builtin_amdgcn_update_dpp(0, __builtin_bit_cast(int, x), 0x4E, 0xF, 0xF, true));
    return x;
}
struct ScanVec { f32x4 xw, kn, bb, kp, rr; float va, vb; };
__device__ __forceinline__ void p5_scan_item(const Params& p, LAS unsigned char* lds, int item, int tid, int wave, int lane) {
    unsigned char* ws = p.ws; unsigned char* dob = (unsigned char*)p.out;
    const int half = item & 1, bh = item >> 1, b = bh >> 3, h = bh & 7;
    const size_t rowb = (size_t)b * TP;
    constexpr int T0 = 32, NCH = (TP - T0) / SC_CH;
    bf16* Y = (bf16*)(ws + WS_Y);
    LAS float* yb0 = (LAS float*)(lds + 2 * SC_BUF_BYTES);
    if (wave >= 4) {
        const int lt = tid - 256;
        const int st_step = lt >> 3, c8 = lt & 7;
        const size_t colb = (size_t)h * 64 + c8 * 8;
        const bf16* aXW = (const bf16*)(dob + DO_XW); const bf16* aKN = (const bf16*)(ws + WS_KN); const bf16* aBB = (const bf16*)(dob + DO_AA); const bf16* aKP = (const bf16*)(ws + WS_KP);
        const bf16* aR = (const bf16*)(ws + WS_ZRR); const bf16* aV = (const bf16*)(ws + WS_ZRV);
        float mur[8], muv[8];
#pragma unroll
        for (int e = 0; e < 8; ++e) { mur[e] = p.in[I_MU][h * 64 + c8 * 8 + e]; muv[e] = (c8 < 4) ? p.in[I_MU][1024 + h * 64 + half * 32 + c8 * 8 + e] : 0.f; }
        auto stage = [&](int t0, int bufi) {
            const size_t row = rowb + t0 + st_step;
            const v4u g0 = *(const v4u*)(aXW + row * 512 + colb), g1 = *(const v4u*)(aKN + row * 512 + colb), g2 = *(const v4u*)(aBB + row * 512 + colb), g3 = *(const v4u*)(aKP + row * 512 + colb);
            const v4u g4 = *(const v4u*)(aR + row * 512 + colb), g5 = *(const v4u*)(aR + (row - 1) * 512 + colb);
            v4u g6 = {0u, 0u, 0u, 0u}, g7 = {0u, 0u, 0u, 0u};
            if (c8 < 4) { const size_t cv = (size_t)h * 64 + half * 32 + c8 * 8; g6 = *(const v4u*)(aV + row * 512 + cv); g7 = *(const v4u*)(aV + (row - 1) * 512 + cv); }
            LAS float* d = (LAS float*)(lds + bufi * SC_BUF_BYTES) + st_step * SC_STRIDE + c8 * 8;
            float a[8], c[8];
            unpack8(g0, a); *(LAS f32x4*)(d + 0 * 64) = (f32x4){a[0], a[1], a[2], a[3]}; *(LAS f32x4*)(d + 0 * 64 + 4) = (f32x4){a[4], a[5], a[6], a[7]};
            unpack8(g1, a); *(LAS f32x4*)(d + 1 * 64) = (f32x4){a[0], a[1], a[2], a[3]}; *(LAS f32x4*)(d + 1 * 64 + 4) = (f32x4){a[4], a[5], a[6], a[7]};
            unpack8(g2, a); *(LAS f32x4*)(d + 2 * 64) = (f32x4){a[0], a[1], a[2], a[3]}; *(LAS f32x4*)(d + 2 * 64 + 4) = (f32x4){a[4], a[5], a[6], a[7]};
            unpack8(g3, a); *(LAS f32x4*)(d + 3 * 64) = (f32x4){a[0], a[1], a[2], a[3]}; *(LAS f32x4*)(d + 3 * 64 + 4) = (f32x4){a[4], a[5], a[6], a[7]};
            unpack8(g4, a); unpack8(g5, c);
#pragma unroll
            for (int e = 0; e < 8; ++e) a[e] = a[e] + mur[e] * (c[e] - a[e]);
            *(LAS f32x4*)(d + 4 * 64) = (f32x4){a[0], a[1], a[2], a[3]}; *(LAS f32x4*)(d + 4 * 64 + 4) = (f32x4){a[4], a[5], a[6], a[7]};
            if (c8 < 4) { unpack8(g6, a); unpack8(g7, c);
#pragma unroll
                for (int e = 0; e < 8; ++e) a[e] = a[e] + muv[e] * (c[e] - a[e]);
                *(LAS f32x4*)(d + 5 * 64) = (f32x4){a[0], a[1], a[2], a[3]}; *(LAS f32x4*)(d + 5 * 64 + 4) = (f32x4){a[4], a[5], a[6], a[7]}; }
        };
        auto flush = [&](int t0, int ybi) {
            const LAS f32x4* yq = (const LAS f32x4*)(lds + 2 * SC_BUF_BYTES + ybi * SC_YB_BYTES) + (lt >> 3) * 32 + (lt & 7) * 4;
            float y[4];
#pragma unroll
            for (int r = 0; r < 4; ++r) { const f32x4 q = yq[r]; y[r] = (q.x + q.y) + (q.z + q.w); }
            v2u o; o.x = pk2(y[0], y[1]); o.y = pk2(y[2], y[3]);
            *(v2u*)(Y + (rowb + t0 + (lt >> 3)) * 512 + h * 64 + half * 32 + 4 * (lt & 7)) = o;
        };
        stage(T0, 0);
        __syncthreads();
        for (int ch = 0; ch < NCH; ++ch) {
            if (ch + 1 < NCH) stage(T0 + (ch + 1) * SC_CH, (ch + 1) & 1);
            if (ch > 0) flush(T0 + (ch - 1) * SC_CH, (ch - 1) & 1);
            __syncthreads();
        }
        flush(T0 + (NCH - 1) * SC_CH, (NCH - 1) & 1);
    } else {
        const int rl = lane >> 4, kq = lane & 15, rowA = wave * 8 + rl, rowB = rowA + 4;
        f32x4 SA = {0.f, 0.f, 0.f, 0.f}, SB = {0.f, 0.f, 0.f, 0.f};
        auto ldv = [&](const LAS float* base, int s) { ScanVec v; const LAS float* q = base + s * SC_STRIDE + kq * 4;
            v.xw = *(const LAS f32x4*)(q); v.kn = *(const LAS f32x4*)(q + 64); v.bb = *(const LAS f32x4*)(q + 128); v.kp = *(const LAS f32x4*)(q + 192); v.rr = *(const LAS f32x4*)(q + 256);
            v.va = base[s * SC_STRIDE + 320 + rowA]; v.vb = base[s * SC_STRIDE + 320 + rowB]; return v; };
        auto step = [&](const ScanVec& v, LAS float* yb, int s) {
            float sa = SA.x * v.kn.x; sa = fmaf(SA.y, v.kn.y, sa); sa = fmaf(SA.z, v.kn.z, sa); sa = fmaf(SA.w, v.kn.w, sa);
            float sb = SB.x * v.kn.x; sb = fmaf(SB.y, v.kn.y, sb); sb = fmaf(SB.z, v.kn.z, sb); sb = fmaf(SB.w, v.kn.w, sb);
            sa = -dpp_sum16(sa); sb = -dpp_sum16(sb);
            SA = (SA - SA * v.xw) + sa * v.bb + v.va * v.kp;
            SB = (SB - SB * v.xw) + sb * v.bb + v.vb * v.kp;
            float ya = SA.x * v.rr.x; ya = fmaf(SA.y, v.rr.y, ya); ya = fmaf(SA.z, v.rr.z, ya); ya = fmaf(SA.w, v.rr.w, ya);
            float yv = SB.x * v.rr.x; yv = fmaf(SB.y, v.rr.y, yv); yv = fmaf(SB.z, v.rr.z, yv); yv = fmaf(SB.w, v.rr.w, yv);
            ya = dpp_sum4(ya); yv = dpp_sum4(yv);
            yb[(s * 32 + rowA) * 4 + (kq >> 2)] = ya; yb[(s * 32 + rowB) * 4 + (kq >> 2)] = yv;
        };
        __syncthreads();
        for (int ch = 0; ch < NCH; ++ch) {
            const LAS float* base = (const LAS float*)(lds + (ch & 1) * SC_BUF_BYTES);
            LAS float* yb = yb0 + (ch & 1) * (SC_YB_BYTES / 4);
            ScanVec v0 = ldv(base, 0), v1;
#pragma unroll 1
            for (int s = 0; s < SC_CH; s += 2) {
                v1 = ldv(base, s + 1);
                step(v0, yb, s);
                if (s + 2 < SC_CH) v0 = ldv(base, s + 2);
                step(v1, yb, s + 1);
            }
            __syncthreads();
        }
    }
    __syncthreads();
}

#ifndef SC2_DBG
#define SC2_DBG 0
#endif
namespace sc2 {
constexpr int S64 = 144, S32 = 80, SAAB = 36, SRHS = 65;
constexpr int AT = 0, RT = AT + 32 * S64, BT = RT + 32 * S64, KT = BT + 32 * S64, BHT = KT + 32 * S64, KHT = BHT + 64 * S32, VT = KHT + 64 * S32, PT = VT + 64 * S32,
              AAK = PT + 64 * S32, ARB = AAK + 32 * S32, ARK = ARB + 32 * S32, SB = ARK + 32 * S32, AAB = SB + 64 * S64, RHS = AAB + 32 * SAAB * 4, CL = RHS + 32 * SRHS * 4,
              GC = CL + 32 * 64 * 4, END = GC + 256;
static_assert(END <= 100000, "scan LDS");
}
__device__ __forceinline__ bf16x8 sc2_frag(LAS unsigned char* base, int stride, int row0, int k0, int lane) {
    return *(const LAS bf16x8*)(base + (row0 + (lane & 15)) * stride + (k0 + 8 * (lane >> 4)) * 2);
}
#define SC2_BAR() asm volatile("s_waitcnt lgkmcnt(0)\n\ts_barrier" ::: "memory")
__device__ __forceinline__ void p5_scan_chunked(const Params& p, LAS unsigned char* lds, int bh, int tid, int wave, int lane) {
    using namespace sc2;
    unsigned char* ws = p.ws; unsigned char* dob = (unsigned char*)p.out;
    const int b = bh >> 3, h = bh & 7;
    const size_t rowb = (size_t)b * TP;
    constexpr int T0 = 32, NCH = (TP - T0) / 32;
    const bf16* aXW = (const bf16*)(dob + DO_XW); const bf16* aKN = (const bf16*)(ws + WS_KN); const bf16* aBB = (const bf16*)(dob + DO_AA); const bf16* aKP = (const bf16*)(ws + WS_KP);
    const bf16* aR = (const bf16*)(ws + WS_ZRR); const bf16* aV = (const bf16*)(ws + WS_ZRV);
    bf16* Y = (bf16*)(ws + WS_Y);
    const int pt = tid >> 4, kc = tid & 15;
    const size_t kcol = (size_t)h * 64 + 4 * kc;
    float mur[4], muv[4];
#pragma unroll
    for (int e = 0; e < 4; ++e) { mur[e] = p.in[I_MU][h * 64 + 4 * kc + e]; muv[e] = p.in[I_MU][1024 + h * 64 + 4 * kc + e]; }
    const int q = lane >> 4, c16 = lane & 15;
    const int m_ = wave >> 1, tr = wave & 1;
    const int tr2 = wave >> 2, vc2 = wave & 3;
    const int kt = wave >> 1, vh = wave & 1;
    pg8::f32x4 accS0 = {0.f, 0.f, 0.f, 0.f}, accS1 = {0.f, 0.f, 0.f, 0.f};
    for (int i = tid; i < 64 * S64 / 4; i += NTHREADS) ((LAS unsigned*)(lds + SB))[i] = 0u;
    v2u gxw, gkn, gbb, gkp, gr0, gr1, gv0, gv1;
    auto prefetch = [&](int t0) { const size_t row = rowb + t0 + pt;
        gxw = *(const v2u*)(aXW + row * 512 + kcol); gkn = *(const v2u*)(aKN + row * 512 + kcol); gbb = *(const v2u*)(aBB + row * 512 + kcol); gkp = *(const v2u*)(aKP + row * 512 + kcol);
        gr0 = *(const v2u*)(aR + row * 512 + kcol); gr1 = *(const v2u*)(aR + (row - 1) * 512 + kcol);
        gv0 = *(const v2u*)(aV + row * 512 + kcol); gv1 = *(const v2u*)(aV + (row - 1) * 512 + kcol); };
    prefetch(T0);
    for (int ch = 0; ch < NCH; ++ch) {
        const int t0 = T0 + ch * 32;
        { f32x4 lg; lg.x = __builtin_amdgcn_logf(1.0f - bflo(gxw.x)); lg.y = __builtin_amdgcn_logf(1.0f - bfhi(gxw.x)); lg.z = __builtin_amdgcn_logf(1.0f - bflo(gxw.y)); lg.w = __builtin_amdgcn_logf(1.0f - bfhi(gxw.y));
          *(LAS f32x4*)(lds + CL + (pt * 64 + 4 * kc) * 4) = lg; }
        SC2_BAR();
        if (tid < 64) { LAS float* c = (LAS float*)(lds + CL) + tid; float run = 0.f;
#pragma unroll
            for (int t = 0; t < 32; ++t) { run += c[t * 64]; c[t * 64] = run; } }
        SC2_BAR();
        {
            const f32x4 clt = *(const LAS f32x4*)(lds + CL + (pt * 64 + 4 * kc) * 4);
            f32x4 clp = {0.f, 0.f, 0.f, 0.f}; if (pt > 0) clp = *(const LAS f32x4*)(lds + CL + ((pt - 1) * 64 + 4 * kc) * 4);
            const f32x4 clc = *(const LAS f32x4*)(lds + CL + (31 * 64 + 4 * kc) * 4);
            const float kn[4] = {bflo(gkn.x), bfhi(gkn.x), bflo(gkn.y), bfhi(gkn.y)}, bb[4] = {bflo(gbb.x), bfhi(gbb.x), bflo(gbb.y), bfhi(gbb.y)}, kp[4] = {bflo(gkp.x), bfhi(gkp.x), bflo(gkp.y), bfhi(gkp.y)};
            const float r0[4] = {bflo(gr0.x), bfhi(gr0.x), bflo(gr0.y), bfhi(gr0.y)}, r1[4] = {bflo(gr1.x), bfhi(gr1.x), bflo(gr1.y), bfhi(gr1.y)};
            const float v0[4] = {bflo(gv0.x), bfhi(gv0.x), bflo(gv0.y), bfhi(gv0.y)}, v1[4] = {bflo(gv1.x), bfhi(gv1.x), bflo(gv1.y), bfhi(gv1.y)};
            float at[4], rt[4], bt[4], ktl[4], bh_[4], kh_[4];
#pragma unroll
            for (int e = 0; e < 4; ++e) {
                const float gt = __builtin_amdgcn_exp2f(clt[e]), gp = __builtin_amdgcn_exp2f(clp[e]), gi = __builtin_amdgcn_exp2f(-clt[e]), gc = __builtin_amdgcn_exp2f(clc[e] - clt[e]);
                const float rs = r0[e] + mur[e] * (r1[e] - r0[e]);
                at[e] = -kn[e] * gp; rt[e] = rs * gt; bt[e] = bb[e] * gi; ktl[e] = kp[e] * gi; bh_[e] = bb[e] * gc; kh_[e] = kp[e] * gc;
            }
            v2u w;
            w.x = pk2(at[0], at[1]); w.y = pk2(at[2], at[3]); *(LAS v2u*)(lds + AT + pt * S64 + 8 * kc) = w;
            w.x = pk2(rt[0], rt[1]); w.y = pk2(rt[2], rt[3]); *(LAS v2u*)(lds + RT + pt * S64 + 8 * kc) = w;
            w.x = pk2(bt[0], bt[1]); w.y = pk2(bt[2], bt[3]); *(LAS v2u*)(lds + BT + pt * S64 + 8 * kc) = w;
            w.x = pk2(ktl[0], ktl[1]); w.y = pk2(ktl[2], ktl[3]); *(LAS v2u*)(lds + KT + pt * S64 + 8 * kc) = w;
#pragma unroll
            for (int e = 0; e < 4; ++e) { *(LAS bf16*)(lds + BHT + (4 * kc + e) * S32 + 2 * pt) = (bf16)f2bf(bh_[e]); *(LAS bf16*)(lds + KHT + (4 * kc + e) * S32 + 2 * pt) = (bf16)f2bf(kh_[e]);
                *(LAS bf16*)(lds + VT + (4 * kc + e) * S32 + 2 * pt) = (bf16)f2bf(v0[e] + muv[e] * (v1[e] - v0[e])); }
            if (pt == 31) *(LAS f32x4*)(lds + GC + 16 * kc) = (f32x4){__builtin_amdgcn_exp2f(clc[0]), __builtin_amdgcn_exp2f(clc[1]), __builtin_amdgcn_exp2f(clc[2]), __builtin_amdgcn_exp2f(clc[3])};
        }
        if (ch + 1 < NCH) prefetch(t0 + 32);
        SC2_BAR();
        pg8::f32x4 accR, accY;
        {
            LAS unsigned char* Ab = lds + ((m_ < 2) ? AT : RT); LAS unsigned char* Bb = lds + ((m_ & 1) ? KT : BT);
            const bf16x8 a0 = sc2_frag(Ab, S64, 16 * tr, 0, lane), a1 = sc2_frag(Ab, S64, 16 * tr, 32, lane);
#pragma unroll
            for (int tc = 0; tc < 2; ++tc) {
                const bf16x8 b0 = sc2_frag(Bb, S64, 16 * tc, 0, lane), b1 = sc2_frag(Bb, S64, 16 * tc, 32, lane);
                pg8::f32x4 c = {0.f, 0.f, 0.f, 0.f};
                c = __builtin_amdgcn_mfma_f32_16x16x32_bf16(a0, b0, c, 0, 0, 0); c = __builtin_amdgcn_mfma_f32_16x16x32_bf16(a1, b1, c, 0, 0, 0);
                const int i = 16 * tc + c16;
#pragma unroll
                for (int r = 0; r < 4; ++r) { const int t = 16 * tr + 4 * q + r; const bool keep = (m_ < 2) ? (i < t) : (i <= t); const float val = keep ? c[r] : 0.f;
                    if (m_ == 0) *(LAS float*)(lds + AAB + (t * SAAB + i) * 4) = val;
                    else *(LAS bf16*)(lds + (m_ == 1 ? AAK : (m_ == 2 ? ARB : ARK)) + t * S32 + 2 * i) = (bf16)f2bf(val); }
            }
            const bf16x8 sb0 = sc2_frag(lds + SB, S64, 16 * vc2, 0, lane), sb1 = sc2_frag(lds + SB, S64, 16 * vc2, 32, lane);
            const bf16x8 ra0 = sc2_frag(lds + AT, S64, 16 * tr2, 0, lane), ra1 = sc2_frag(lds + AT, S64, 16 * tr2, 32, lane);
            const bf16x8 ya0 = sc2_frag(lds + RT, S64, 16 * tr2, 0, lane), ya1 = sc2_frag(lds + RT, S64, 16 * tr2, 32, lane);
            accR = (pg8::f32x4){0.f, 0.f, 0.f, 0.f}; accY = accR;
            accR = __builtin_amdgcn_mfma_f32_16x16x32_bf16(ra0, sb0, accR, 0, 0, 0); accR = __builtin_amdgcn_mfma_f32_16x16x32_bf16(ra1, sb1, accR, 0, 0, 0);
            accY = __builtin_amdgcn_mfma_f32_16x16x32_bf16(ya0, sb0, accY, 0, 0, 0); accY = __builtin_amdgcn_mfma_f32_16x16x32_bf16(ya1, sb1, accY, 0, 0, 0);
        }
        SC2_BAR();
        {
            const bf16x8 bv = sc2_frag(lds + VT, S32, 16 * vc2, 0, lane);
            accR = __builtin_amdgcn_mfma_f32_16x16x32_bf16(sc2_frag(lds + AAK, S32, 16 * tr2, 0, lane), bv, accR, 0, 0, 0);
            accY = __builtin_amdgcn_mfma_f32_16x16x32_bf16(sc2_frag(lds + ARK, S32, 16 * tr2, 0, lane), bv, accY, 0, 0, 0);
#pragma unroll
            for (int r = 0; r < 4; ++r) *(LAS float*)(lds + RHS + ((16 * tr2 + 4 * q + r) * SRHS + 16 * vc2 + c16) * 4) = accR[r];
        }
        SC2_BAR();
        if (wave < 2) {
            const int v = 32 * wave + (lane & 31), par = lane >> 5;
            float qv[4][4];
#pragma unroll
            for (int m = 0; m < 4; ++m)
#pragma unroll
                for (int j = 0; j < 4; ++j) qv[m][j] = 0.f;
            unsigned pk[16]; float prev = 0.f;
            const LAS float* arow = (const LAS float*)(lds + AAB) + 4 * par;
#pragma unroll
            for (int t = 0; t < 32; ++t) {
                const float rh = *(const LAS float*)(lds + RHS + (t * SRHS + v) * 4);
                float a0 = par ? 0.f : rh, a1 = 0.f;
                const int nm = t ? ((t - 1) >> 3) + 1 : 0;
#pragma unroll
                for (int m = 0; m < nm; ++m) { const f32x4 w = *(const LAS f32x4*)(arow + t * SAAB + 8 * m);
                    a0 = fmaf(w.x, qv[m][0], a0); a1 = fmaf(w.y, qv[m][1], a1); a0 = fmaf(w.z, qv[m][2], a0); a1 = fmaf(w.w, qv[m][3], a1); }
                const float part = a0 + a1;
                auto rr = __builtin_amdgcn_permlane32_swap(__float_as_uint(part), __float_as_uint(part), false, false);
                const unsigned r0 = rr[0], r1 = rr[1];
                const float pt_ = __uint_as_float(r0) + __uint_as_float(r1);
                { const int g4 = t >> 2; qv[g4 >> 1][t & 3] = (par == (g4 & 1)) ? pt_ : qv[g4 >> 1][t & 3]; }
                if (t & 1) pk[t >> 1] = pk2(prev, pt_); else prev = pt_;
                if ((t & 3) == 3) asm volatile("" ::: "memory");
            }
            if (lane < 32) {
#pragma unroll
                for (int g = 0; g < 4; ++g) { v4u w; w.x = pk[4 * g]; w.y = pk[4 * g + 1]; w.z = pk[4 * g + 2]; w.w = pk[4 * g + 3]; *(LAS v4u*)(lds + PT + v * S32 + 16 * g) = w; } }
        }
        SC2_BAR();
        {
            accY = __builtin_amdgcn_mfma_f32_16x16x32_bf16(sc2_frag(lds + ARB, S32, 16 * tr2, 0, lane), sc2_frag(lds + PT, S32, 16 * vc2, 0, lane), accY, 0, 0, 0);
#pragma unroll
            for (int r = 0; r < 4; ++r) Y[(rowb + t0 + 16 * tr2 + 4 * q + r) * 512 + h * 64 + 16 * vc2 + c16] = (bf16)f2bf(accY[r]);
            const f32x4 gcv = *(const LAS f32x4*)(lds + GC + (16 * kt + 4 * q) * 4);
            const bf16x8 ab = sc2_frag(lds + BHT, S32, 16 * kt, 0, lane), ak = sc2_frag(lds + KHT, S32, 16 * kt, 0, lane);
            accS0[0] *= gcv.x; accS0[1] *= gcv.y; accS0[2] *= gcv.z; accS0[3] *= gcv.w; accS1[0] *= gcv.x; accS1[1] *= gcv.y; accS1[2] *= gcv.z; accS1[3] *= gcv.w;
            accS0 = __builtin_amdgcn_mfma_f32_16x16x32_bf16(ab, sc2_frag(lds + PT, S32, 32 * vh, 0, lane), accS0, 0, 0, 0);
            accS0 = __builtin_amdgcn_mfma_f32_16x16x32_bf16(ak, sc2_frag(lds + VT, S32, 32 * vh, 0, lane), accS0, 0, 0, 0);
            accS1 = __builtin_amdgcn_mfma_f32_16x16x32_bf16(ab, sc2_frag(lds + PT, S32, 32 * vh + 16, 0, lane), accS1, 0, 0, 0);
            accS1 = __builtin_amdgcn_mfma_f32_16x16x32_bf16(ak, sc2_frag(lds + VT, S32, 32 * vh + 16, 0, lane), accS1, 0, 0, 0);
            v2u w; w.x = pk2(accS0[0], accS0[1]); w.y = pk2(accS0[2], accS0[3]);
            *(LAS v2u*)(lds + SB + (32 * vh + c16) * S64 + (16 * kt + 4 * q) * 2) = w;
            w.x = pk2(accS1[0], accS1[1]); w.y = pk2(accS1[2], accS1[3]);
            *(LAS v2u*)(lds + SB + (32 * vh + 16 + c16) * S64 + (16 * kt + 4 * q) * 2) = w;
        }
    }
    __syncthreads();
}

__device__ __forceinline__ void p6_prep3(const Params& p, int vcu, int G, int wave, int lane) {
    unsigned char* ws = p.ws; unsigned char* dob = (unsigned char*)p.out;
    const int gw = vcu * NWAVES + wave, NGW = G * NWAVES;
    float lg[8], lb[8], muv[8];
#pragma unroll
    for (int e = 0; e < 8; ++e) { const int c = lane * 8 + e; lg[e] = p.in[I_LNG][c]; lb[e] = p.in[I_LNB][c]; muv[e] = p.in[I_MU][1024 + c]; }
    for (int m = gw; m < R; m += NGW) {
        const int b = m / TP, pp = m - b * TP;
        v4u* yp = (v4u*)(ws + WS_Y + (size_t)m * 1024) + lane;
        if (pp < 48) { *yp = (v4u){0u, 0u, 0u, 0u}; continue; }
        float y[8], v[8], vp[8], g[8];
        unpack8(*yp, y); unpack8(*((const v4u*)(ws + WS_ZRV + (size_t)m * 1024) + lane), v); unpack8(*((const v4u*)(ws + WS_ZRV + (size_t)(m - 1) * 1024) + lane), vp);
        unpack8(*((const v4u*)(dob + DO_GG + (size_t)m * 1024) + lane), g);
        float s = 0.f;
#pragma unroll
        for (int e = 0; e < 8; ++e) s += y[e];
        const float mean = sum8(s) * (1.f / 64.f); float q = 0.f;
#pragma unroll
        for (int e = 0; e < 8; ++e) { y[e] -= mean; q += y[e] * y[e]; }
        const float rstd = 1.0f / sqrtf(sum8(q) * (1.f / 64.f) + GN_EPS);
        const float bon = ((const float*)(ws + WS_BS))[(size_t)m * 8 + (lane >> 3)];
#pragma unroll
        for (int e = 0; e < 8; ++e) { const float vs = v[e] + muv[e] * (vp[e] - v[e]); y[e] = (y[e] * rstd * lg[e] + lb[e] + bon * vs) * g[e]; }
        *yp = pack8(y);
    }
}
__device__ __forceinline__ void p9_norm2(const Params& p, int vcu, int G, int wave, int lane) {
    unsigned char* ws = p.ws;
    const int gw = vcu * NWAVES + wave, NGW = G * NWAVES;
    const f32x4* g4 = (const f32x4*)p.in[I_N2G] + lane;
    for (int m = gw; m < NTOK; m += NGW) {
        const f32x4* xr = (const f32x4*)(p.out + (size_t)m * 1024) + lane;
        f32x4 v[4]; float s = 0.f;
#pragma unroll
        for (int j = 0; j < 4; ++j) { v[j] = xr[64 * j]; s += (v[j].x * v[j].x + v[j].y * v[j].y) + (v[j].z * v[j].z + v[j].w * v[j].w); }
        const float rs = 1.0f / sqrtf(wave_sum(s) * (1.f / 1024.f) + NORM_EPS);
        unsigned long long* o8 = (unsigned long long*)(ws + WS_XN2 + (size_t)m * 2048) + lane;
        float mx = 0.f;
#pragma unroll
        for (int j = 0; j < 4; ++j) { const f32x4 g = g4[64 * j]; v[j].x *= rs * g.x; v[j].y *= rs * g.y; v[j].z *= rs * g.z; v[j].w *= rs * g.w;
            o8[64 * j] = (unsigned long long)pk2(v[j].x, v[j].y) | ((unsigned long long)pk2(v[j].z, v[j].w) << 32);
            mx = fmaxf(mx, fmaxf(fmaxf(fabsf(v[j].x), fabsf(v[j].y)), fmaxf(fabsf(v[j].z), fabsf(v[j].w)))); }
#pragma unroll
        for (int o = 1; o < 64; o <<= 1) mx = fmaxf(mx, __shfl_xor(mx, o));
        const float inv = mx > 0.f ? 127.0f / mx : 0.f;
        unsigned* xq = (unsigned*)(ws + WS_XQ + (size_t)m * 1024) + lane;
#pragma unroll
        for (int j = 0; j < 4; ++j) { const int q0 = (int)rintf(v[j].x * inv), q1 = (int)rintf(v[j].y * inv), q2 = (int)rintf(v[j].z * inv), q3 = (int)rintf(v[j].w * inv);
            xq[64 * j] = (unsigned)(q0 & 255) | ((unsigned)(q1 & 255) << 8) | ((unsigned)(q2 & 255) << 16) | ((unsigned)(q3 & 255) << 24); }
        if (lane == 0) ((float*)(ws + WS_SX))[m] = mx > 0.f ? mx * (1.0f / 127.0f) : 1.0f;
    }
}

typedef __bf16 bf16x2_t __attribute__((ext_vector_type(2)));
__device__ __forceinline__ unsigned mono(float f) { const unsigned u = __builtin_bit_cast(unsigned, f); return u ^ ((unsigned)((int)u >> 31) | 0x80000000u); }
__device__ __forceinline__ float unmono(unsigned m) { const unsigned u = (m & 0x80000000u) ? (m ^ 0x80000000u) : ~m; return __builtin_bit_cast(float, u); }
__device__ __forceinline__ void ce_desc(unsigned& a, unsigned& b) { const unsigned hi = a > b ? a : b, lo = a > b ? b : a; a = hi; b = lo; }
template <int BASE, int N> __device__ __forceinline__ void bitonic_sort_desc(unsigned (&v)[N]) {
#pragma unroll
    for (int k = 2; k <= 16; k <<= 1)
#pragma unroll
        for (int j = k >> 1; j > 0; j >>= 1)
#pragma unroll
            for (int i = 0; i < 16; ++i) { const int l = i ^ j; if (l > i) { if ((i & k) == 0) ce_desc(v[BASE + i], v[BASE + l]); else ce_desc(v[BASE + l], v[BASE + i]); } }
}
template <int A, int B, int N> __device__ __forceinline__ void merge_top16(unsigned (&v)[N]) {
#pragma unroll
    for (int i = 0; i < 16; ++i) { const unsigned x = v[A + i], y = v[B + 15 - i]; v[A + i] = x > y ? x : y; }
#pragma unroll
    for (int j = 8; j > 0; j >>= 1)
#pragma unroll
        for (int i = 0; i < 16; ++i) { const int l = i ^ j; if (l > i) ce_desc(v[A + i], v[A + l]); }
}
constexpr int KS_STRIDE = 272;
constexpr int RT_KS_BYTES = 256 * KS_STRIDE;
constexpr int RT_TAB_WORDS = 33;
__device__ __forceinline__ void p11_route(const Params& p, LAS unsigned char* lds, int vcu, int G, int tid, int wave, int lane) {
    unsigned char* ws = p.ws;
    for (int i = tid; i < 256 * 16; i += NTHREADS) { const int row = i >> 4, ch = i & 15; *(LAS v4u*)(lds + row * KS_STRIDE + ch * 16) = *((const v4u*)(ws + WS_KS) + i); }
    __syncthreads();
    LAS unsigned* tab = (LAS unsigned*)(lds + RT_KS_BYTES) + (wave * 64 + lane) * RT_TAB_WORDS;
    const int r32 = lane & 31, hi = lane >> 5;
    const int gw = vcu * NWAVES + wave, NGW = G * NWAVES;
    const bf16* PQ = (const bf16*)(ws + WS_PQ);
    int* IDS = (int*)(ws + WS_IDS); float* GATES = (float*)(ws + WS_GATES);
    for (int task = gw; task < (NTOK / 32) * 8; task += NGW) {
        const int tb = task >> 3, h = task & 7;
        const int token = tb * 32 + r32;
        unsigned v[128];
        {
            const bf16* qrow = PQ + (size_t)token * 2048 + h * 256 + hi * 8;
#pragma unroll
            for (int t = 0; t < 4; ++t) {
                f32x16v acc[2];
#pragma unroll
                for (int w = 0; w < 2; ++w) {
                    f32x16v c = {};
                    const LAS unsigned char* kb = lds + (w * 128 + t * 32 + r32) * KS_STRIDE + hi * 16;
#pragma unroll
                    for (int s = 0; s < 8; ++s) { const bf16x8 a = *(const LAS bf16x8*)(kb + s * 32); const bf16x8 qf = *(const bf16x8*)(qrow + w * 128 + 16 * s); c = __builtin_amdgcn_mfma_f32_32x32x16_bf16(a, qf, c, 0, 0, 0); }
                    acc[w] = c;
                }
#pragma unroll
                for (int r = 0; r < 16; ++r) {
                    const float xa = acc[0][r], xb = acc[1][r];
                    auto rr = __builtin_amdgcn_permlane32_swap(__float_as_uint(xa), __float_as_uint(xb), false, false);
                    const unsigned r0 = rr[0], r1 = rr[1];
                    const int cr = (r & 3) + 8 * (r >> 2);
                    v[t * 16 + r] = (mono(__uint_as_float(r0)) & ~0x7Fu) | (unsigned)(32 * t + cr);
                    v[64 + t * 16 + r] = (mono(__uint_as_float(r1)) & ~0x7Fu) | (unsigned)(32 * t + cr + 4);
                }
            }
        }
        bitonic_sort_desc<0>(v); bitonic_sort_desc<16>(v); bitonic_sort_desc<32>(v); bitonic_sort_desc<48>(v);
        bitonic_sort_desc<64>(v); bitonic_sort_desc<80>(v); bitonic_sort_desc<96>(v); bitonic_sort_desc<112>(v);
        merge_top16<0, 16>(v); merge_top16<32, 48>(v); merge_top16<64, 80>(v); merge_top16<96, 112>(v);
        merge_top16<0, 32>(v); merge_top16<64, 96>(v);
        merge_top16<0, 64>(v);
        unsigned T[16], U[16];
#pragma unroll
        for (int i = 0; i < 16; ++i) { auto rr = __builtin_amdgcn_permlane32_swap(v[i], v[i], false, false); T[i] = v[i]; U[i] = hi ? rr[0] : rr[1]; }
        { const int bT = hi ? 16 : 0, bU = hi ? 0 : 16;
#pragma unroll
          for (int i = 0; i < 16; ++i) { tab[bT + i] = T[i] & 0x7Fu; tab[bU + i] = U[i] & 0x7Fu; } }
        float tv[16], uv[16];
#pragma unroll
        for (int i = 0; i < 16; ++i) { tv[i] = unmono(T[i] & ~0x7Fu); uv[i] = unmono(U[i] & ~0x7Fu); }
        unsigned c[32];
        {
            int n = 0;
#pragma unroll
            for (int i = 0; i < 4; ++i)
#pragma unroll
                for (int j = i; j < 16; ++j) if ((i + 1) * (j + 1) <= 16) {
                    const float s = tv[i] + uv[j];
                    const unsigned pay = hi ? (unsigned)((j << 4) | i) : (unsigned)((i << 4) | j);
                    unsigned key = (mono(s) & ~0xFFu) | pay;
                    if (i == j && hi) key = 0u;
                    c[n++] = key;
                }
#pragma unroll
            for (int k = 27; k < 32; ++k) c[k] = 0u;
        }
        bitonic_sort_desc<0>(c); bitonic_sort_desc<16>(c); merge_top16<0, 16>(c);
        unsigned W[32];
#pragma unroll
        for (int i = 0; i < 16; ++i) { auto rr = __builtin_amdgcn_permlane32_swap(c[i], c[i], false, false); W[i] = rr[0]; W[16 + i] = rr[1]; }
        merge_top16<0, 16>(W);
        asm volatile("s_waitcnt lgkmcnt(0)" ::: "memory");
        if (!hi) {
            int ids[16];
#pragma unroll
            for (int k = 0; k < 16; ++k) ids[k] = (int)(tab[(W[k] >> 4) & 15u] * 128u + tab[16 + (W[k] & 15u)]);
            int* o = IDS + (size_t)token * 128 + h * 16;
#pragma unroll
            for (int k = 0; k < 16; k += 4) *(v4u*)(o + k) = (v4u){(unsigned)ids[k], (unsigned)ids[k + 1], (unsigned)ids[k + 2], (unsigned)ids[k + 3]};
        } else {
            float e[16]; const float s0 = unmono(W[0] & ~0xFFu); float sum = 0.f;
#pragma unroll
            for (int k = 0; k < 16; ++k) { e[k] = __expf(unmono(W[k] & ~0xFFu) - s0); sum += e[k]; }
            const float inv = 1.0f / sum;
            float* o = GATES + (size_t)token * 128 + h * 16;
#pragma unroll
            for (int k = 0; k < 16; k += 4) *(f32x4*)(o + k) = (f32x4){e[k] * inv, e[k + 1] * inv, e[k + 2] * inv, e[k + 3] * inv};
        }
        asm volatile("s_waitcnt lgkmcnt(0)" ::: "memory");
    }
}

constexpr size_t WS_PART = 420 * MiB;
__device__ __forceinline__ int dpp_isum8(int x) {
    x += __builtin_amdgcn_update_dpp(0, x, 0xB1, 0xF, 0xF, true);
    x += __builtin_amdgcn_update_dpp(0, x, 0x4E, 0xF, 0xF, true);
    x += __builtin_amdgcn_update_dpp(0, x, 0x141, 0xF, 0xF, true);
    return x;
}
__device__ __forceinline__ void p12a_partial(const Params& p, int bid, int G, int wave, int lane) {
    unsigned char* ws = p.ws;
    const int s = bid & 7, wx = (bid >> 3) * NWAVES + wave, NWX = (G >> 3) * NWAVES;
    const int eg = lane >> 3, cj = lane & 7;
    const unsigned char* XQ = ws + WS_XQ + 128 * s + 16 * cj; const int* IDS = (const int*)(ws + WS_IDS); int* PART = (int*)(ws + WS_PART);
    const unsigned char* Us = ws + WS_U8 + 128 * s + 16 * cj;
    for (int t = wx; t < NTOK; t += NWX) {
        const v4u xs = *(const v4u*)(XQ + (size_t)t * 1024);
        const int xx = (int)xs.x, xy = (int)xs.y, xz = (int)xs.z, xw = (int)xs.w;
        const v4u* idp = (const v4u*)(IDS + (size_t)t * 128 + 16 * eg);
        int ids[16];
#pragma unroll
        for (int q = 0; q < 4; ++q) { const v4u iv = idp[q]; ids[4 * q] = (int)iv.x; ids[4 * q + 1] = (int)iv.y; ids[4 * q + 2] = (int)iv.z; ids[4 * q + 3] = (int)iv.w; }
        v4u u[16];
#pragma unroll
        for (int i = 0; i < 16; ++i) u[i] = *(const v4u*)(Us + (size_t)ids[i] * 1024);
        int k0 = 0, k1 = 0;
#pragma unroll
        for (int i = 0; i < 16; ++i) {
            const int ux = (int)u[i].x, uy = (int)u[i].y, uz = (int)u[i].z, uw = (int)u[i].w;
            int d = __builtin_amdgcn_sdot4(ux, xx, 0, false); d = __builtin_amdgcn_sdot4(uy, xy, d, false); d = __builtin_amdgcn_sdot4(uz, xz, d, false); d = __builtin_amdgcn_sdot4(uw, xw, d, false);
            d = dpp_isum8(d);
            if (i < 8) k0 = (cj == i) ? d : k0; else k1 = (cj == i - 8) ? d : k1;
        }
        int* po = PART + ((size_t)s * NTOK + t) * 128 + 16 * eg + cj;
        __builtin_nontemporal_store(k0, po); __builtin_nontemporal_store(k1, po + 8);
    }
}
__device__ __forceinline__ void p12b_combine(const Params& p, int vcu, int G, int wave, int lane) {
    unsigned char* ws = p.ws;
    const int gw = vcu * NWAVES + wave, NGW = G * NWAVES;
    const int* PART = (const int*)(ws + WS_PART); float* GW = (float*)(ws + WS_GATES); const int* IDS = (const int*)(ws + WS_IDS);
    const float* SU = (const float*)(ws + WS_SU); const float* SV = (const float*)(ws + WS_SV);
    for (int t = gw; t < NTOK; t += NGW) {
        int a0 = 0, a1 = 0;
#pragma unroll
        for (int s = 0; s < 8; ++s) { const int* pp = PART + ((size_t)s * NTOK + t) * 128; a0 += __builtin_nontemporal_load(pp + lane); a1 += __builtin_nontemporal_load(pp + lane + 64); }
        const int id0 = IDS[(size_t)t * 128 + lane], id1 = IDS[(size_t)t * 128 + lane + 64];
        const float sx = ((const float*)(ws + WS_SX))[t];
        const float h0 = (float)a0 * SU[id0] * sx, h1 = (float)a1 * SU[id1] * sx;
        float* g = GW + (size_t)t * 128;
        const float w0 = g[lane] * 0.5f * h0 * (1.0f + erff(h0 * 0.70710678118654752f)) * SV[id0];
        const float w1 = g[lane + 64] * 0.5f * h1 * (1.0f + erff(h1 * 0.70710678118654752f)) * SV[id1];
        g[lane] = w0; g[lane + 64] = w1;
        const float c = wave_sum(w0 + w1) * 128.0f;
        if (lane == 0) ((float*)(ws + WS_CORR))[t] = c;
    }
}
__device__ __forceinline__ void p12c_output(const Params& p, int bid, int G, int wave, int lane) {
    unsigned char* ws = p.ws;
    const int s = bid & 7, wx = (bid >> 3) * NWAVES + wave, NWX = (G >> 3) * NWAVES;
    const int eg = lane >> 3, cj = lane & 7;
    const int b5 = (lane >> 5) & 1, b4 = (lane >> 4) & 1, b3 = (lane >> 3) & 1;
    const int* IDS = (const int*)(ws + WS_IDS); const float* GW = (const float*)(ws + WS_GATES); const float* CORR = (const float*)(ws + WS_CORR);
    const unsigned char* Vs = ws + WS_V8 + 128 * s + 16 * cj;
    const int ocol = 128 * s + 16 * cj + 8 * b5 + 4 * b4 + 2 * b3;
    for (int t = wx; t < NTOK; t += NWX) {
        const v4u* idp = (const v4u*)(IDS + (size_t)t * 128 + 16 * eg); const f32x4* wp = (const f32x4*)(GW + (size_t)t * 128 + 16 * eg);
        int ids[16]; float w[16];
#pragma unroll
        for (int q = 0; q < 4; ++q) { const v4u iv = idp[q]; ids[4 * q] = (int)iv.x; ids[4 * q + 1] = (int)iv.y; ids[4 * q + 2] = (int)iv.z; ids[4 * q + 3] = (int)iv.w;
            const f32x4 wv = wp[q]; w[4 * q] = wv.x; w[4 * q + 1] = wv.y; w[4 * q + 2] = wv.z; w[4 * q + 3] = wv.w; }
        typedef float f32x2 __attribute__((ext_vector_type(2)));
        const f32x2 hres = __builtin_nontemporal_load((const f32x2*)(p.out + (size_t)t * 1024 + ocol));
        const float corr = CORR[t];
        v4u vv[16];
#pragma unroll
        for (int i = 0; i < 16; ++i) vv[i] = *(const v4u*)(Vs + (size_t)ids[i] * 1024);
        float o[16];
#pragma unroll
        for (int k = 0; k < 16; ++k) o[k] = 0.f;
#pragma unroll
        for (int i = 0; i < 16; ++i) {
            const unsigned q[4] = {vv[i].x, vv[i].y, vv[i].z, vv[i].w};
#pragma unroll
            for (int d = 0; d < 4; ++d) {
                o[4 * d + 0] = fmaf(w[i], (float)(q[d] & 0xffu), o[4 * d + 0]); o[4 * d + 1] = fmaf(w[i], (float)((q[d] >> 8) & 0xffu), o[4 * d + 1]);
                o[4 * d + 2] = fmaf(w[i], (float)((q[d] >> 16) & 0xffu), o[4 * d + 2]); o[4 * d + 3] = fmaf(w[i], (float)(q[d] >> 24), o[4 * d + 3]); }
        }
        float r8[8], r4[4], r2[2];
#pragma unroll
        for (int j = 0; j < 8; ++j) { const float keep = b5 ? o[8 + j] : o[j], send = b5 ? o[j] : o[8 + j]; r8[j] = keep + __shfl_xor(send, 32); }
#pragma unroll
        for (int j = 0; j < 4; ++j) { const float keep = b4 ? r8[4 + j] : r8[j], send = b4 ? r8[j] : r8[4 + j]; r4[j] = keep + __shfl_xor(send, 16); }
#pragma unroll
        for (int j = 0; j < 2; ++j) { const float keep = b3 ? r4[2 + j] : r4[j], send = b3 ? r4[j] : r4[2 + j]; r2[j] = keep + __shfl_xor(send, 8); }
        const f32x2 res = {hres.x + r2[0] - corr, hres.y + r2[1] - corr};
        __builtin_nontemporal_store(res, (f32x2*)(p.out + (size_t)t * 1024 + ocol));
    }
}

#if DIAG
constexpr size_t WS_DIAG = 1006 * MiB;
constexpr size_t WS_DSAVE = 1007 * MiB;
__device__ __forceinline__ unsigned dhash(unsigned x) { x ^= x >> 16; x *= 0x7feb352dU; x ^= x >> 15; x *= 0x846ca68bU; x ^= x >> 16; return x; }
__device__ __forceinline__ float bf2f(bf16 b) { return __builtin_bit_cast(float, (unsigned)b << 16); }
__device__ __forceinline__ float rbf(float x) { return bf2f((bf16)f2bf(x)); }
__device__ __forceinline__ void diag_report(const Params& p, int stage, float err) {
    if (!(err == err)) err = 1e30f;
#pragma unroll
    for (int o = 1; o < 64; o <<= 1) err = fmaxf(err, __shfl_xor(err, o));
    int t_ = threadIdx.x; asm volatile("" : "+v"(t_)); if ((t_ & 63) == 0) atomicMax((unsigned*)(p.ws + WS_DIAG) + stage, __builtin_bit_cast(unsigned, err));
}
#define DG_IDS() int tid_ = threadIdx.x; asm volatile("" : "+v"(tid_)); const int tid = tid_, lane = tid & 63; int G_ = gridDim.x; asm volatile("" : "+s"(G_)); const int gt = blockIdx.x * NTHREADS + tid, NGT = G_ * NTHREADS; const int gwv = gt >> 6, NGWV = NGT >> 6; (void)lane; (void)gwv; (void)NGWV; (void)NGT
__device__ __forceinline__ float relerr(float got, float ref, float fl) { return fabsf(got - ref) / (fabsf(ref) + fl); }

__device__ __forceinline__ void dg_p0(const Params& p) {
    DG_IDS(); unsigned char* ws = p.ws; float e1 = 0.f, e2 = 0.f;
    for (int s = gwv; s < 4096; s += NGWV) {
        const int m = dhash(s * 7 + 1) % R; const int b = m / TP, pp = m - b * TP;
        const bf16* xn = (const bf16*)(ws + WS_XN) + (size_t)m * 1024;
        if (pp < 48) { for (int c = lane; c < 1024; c += 64) e1 = fmaxf(e1, fabsf(bf2f(xn[c]))); continue; }
        const float* xr = (pp < 64) ? p.in[I_META] + (size_t)(pp - 48) * 1024 : p.in[I_X] + ((size_t)b * SEQ + (pp - 64)) * 1024;
        float ss = 0.f; for (int c = lane; c < 1024; c += 64) ss += xr[c] * xr[c];
        ss = wave_sum(ss); const float rs = 1.0f / sqrtf(ss / 1024.f + NORM_EPS);
        for (int c = lane; c < 1024; c += 64) e1 = fmaxf(e1, relerr(bf2f(xn[c]), xr[c] * rs * p.in[I_N1G][c], 0.05f));
    }
    for (int s = gt; s < 200000; s += NGT) {
        const unsigned hsh = dhash(s * 3 + 5); const int k = hsh & 1023, n = (hsh >> 10) % N1; const int sc = win_src_col(n);
        const float ref = sc >= 0 ? p.in[I_WIN][(size_t)k * IN_COLS + sc] : 0.f;
        e2 = fmaxf(e2, fabsf(bf2f(((const bf16*)(ws + WS_WTIN))[(size_t)n * 1024 + k]) - rbf(ref)));
        const int n2 = (hsh >> 10) & 2047;
        e2 = fmaxf(e2, fabsf(bf2f(((const bf16*)(ws + WS_WTQ))[(size_t)n2 * 1024 + k]) - rbf(p.in[I_PWQ][(size_t)k * 2048 + n2])));
        const int n3 = n2 & 1023, k3 = k & 511;
        e2 = fmaxf(e2, fabsf(bf2f(((const bf16*)(ws + WS_WTFOX))[(size_t)n3 * 512 + k3]) - rbf(p.in[I_WFOX][(size_t)k3 * 1024 + n3])));
        e2 = fmaxf(e2, fabsf(bf2f(((const bf16*)(ws + WS_WTRWKV))[(size_t)n3 * 512 + k3]) - rbf(p.in[I_WRWKV][(size_t)k3 * 1024 + n3])));
        e2 = fmaxf(e2, fabsf(bf2f(((const bf16*)(ws + WS_WTOUT))[(size_t)n3 * 1024 + k]) - rbf(p.in[I_WOUT][(size_t)k * 1024 + n3])));
        const size_t ei = (size_t)(hsh % (16384u * 1024u)); const int er = (int)(ei >> 10);
        { const float sc = ((const float*)(ws + WS_SU))[er]; const float dq = (float)((const signed char*)(ws + WS_U8))[ei] * sc; e2 = fmaxf(e2, fmaxf(fabsf(dq - p.in[I_PU][ei]) - 0.51f * sc, 0.f)); }
        { const float sc = ((const float*)(ws + WS_SV))[er]; const float dq = ((float)((const unsigned char*)(ws + WS_V8))[ei] - 128.f) * sc; e2 = fmaxf(e2, fmaxf(fabsf(dq - p.in[I_PV][ei]) - 0.51f * sc, 0.f)); }
    }
    diag_report(p, 1, e1 / 0.03f); diag_report(p, 2, e2 / 1e-6f);
}
__device__ __forceinline__ float dg_dot(const bf16* A, size_t row, const bf16* Bt, size_t n, int K) {
    const bf16* a = A + row * K; const bf16* b = Bt + n * K; float s = 0.f;
    for (int k = 0; k < K; k += 8) { float x[8], y[8]; unpack8(*(const v4u*)(a + k), x); unpack8(*(const v4u*)(b + k), y);
#pragma unroll
        for (int e = 0; e < 8; ++e) s = fmaf(x[e], y[e], s); }
    return s;
}
__device__ __forceinline__ void dg_gemm1(const Params& p) {
    DG_IDS(); unsigned char* ws = p.ws; float e = 0.f;
    for (int s = gt; s < 262144; s += NGT) {
        const unsigned hsh = dhash(s * 11 + 3); const int row = hsh % R, n = dhash(hsh) % N1;
        const float ref = dg_dot((const bf16*)(ws + WS_XN), row, (const bf16*)(ws + WS_WTIN), n, 1024);
        float got, want;
        if (n < 3584) { got = bf2f(((const bf16*)(ws + WS_F))[(size_t)(n >> 9) * ((size_t)R * 512) + (size_t)row * 512 + (n & 511)]); want = ref; }
        else { got = bf2f(((const bf16*)(ws + WS_ZG))[(size_t)row * 2048 + (n - 3584)]); want = 1.0f / (1.0f + expf(-ref)); }
        e = fmaxf(e, relerr(got, want, 0.25f));
    }
    diag_report(p, 3, e / 0.02f);
}
__device__ __forceinline__ void dg_p2(const Params& p) {
    DG_IDS(); unsigned char* ws = p.ws; float e = 0.f;
    for (int s = gt; s < 262144; s += NGT) {
        const unsigned hsh = dhash(s * 13 + 7); const int m = hsh % R, c = dhash(hsh) % 296; const int pp = m % TP;
        const bf16* zm = (const bf16*)(ws + WS_ZM);
        const float z = bf2f(zm[(size_t)m * 512 + c]);
        if (c >= 288) { const float x = z + p.in[I_FBIAS][c - 288]; const float want = -log1pf(expf(-x)); e = fmaxf(e, relerr(((const float*)(ws + WS_LF))[(size_t)m * 8 + (c - 288)], want, 0.01f)); continue; }
        const float zp = pp > 0 ? bf2f(zm[(size_t)(m - 1) * 512 + c]) : 0.f; const float mu = p.in[I_MU][1536 + c];
        const float zs = z + mu * (zp - z);
        if (c < 64) e = fmaxf(e, relerr(bf2f(((const bf16*)(ws + WS_LA))[(size_t)m * 128 + c]), tanhf(zs), 0.1f));
        else if (c < 128) e = fmaxf(e, relerr(bf2f(((const bf16*)(ws + WS_LA))[(size_t)m * 128 + c]), zs, 0.1f));
        else e = fmaxf(e, relerr(bf2f(((const bf16*)(ws + WS_LG))[(size_t)m * 256 + (c - 128)]), 1.0f / (1.0f + expf(-zs)), 0.1f));
        if (pp >= 48) { const int h = c & 7; float sq = 0.f, sk = 0.f;
            for (int d = 0; d < 64; ++d) { const float q = bf2f(((const bf16*)(ws + WS_FQ))[(size_t)m * 512 + h * 64 + d]) / (p.in[I_FQN][h * 64 + d] * attn_body::C2); sq += q * q;
                const float k = bf2f(((const bf16*)(ws + WS_FK))[(size_t)m * 512 + h * 64 + d]) / p.in[I_FKN][h * 64 + d]; sk += k * k; }
            e = fmaxf(e, fabsf(sq / 64.f - 1.f)); e = fmaxf(e, fabsf(sk / 64.f - 1.f)); }
    }
    diag_report(p, 4, e / 0.03f);
}
__device__ __forceinline__ void dg_p3(const Params& p) {
    DG_IDS(); unsigned char* ws = p.ws; unsigned char* dob = (unsigned char*)p.out; float e5 = 0.f, e6 = 0.f;
    for (int s = gt; s < 131072; s += NGT) {
        const unsigned hsh = dhash(s * 17 + 9); const int seq = hsh & 127, pp = (hsh >> 7) % TP; const int b = seq >> 3, h = seq & 7;
        const float* kb = (const float*)(ws + WS_KB) + (size_t)seq * TP; const float lf = ((const float*)(ws + WS_LF))[((size_t)b * TP + pp) * 8 + h];
        if (pp < 48) e5 = fmaxf(e5, kb[pp] < -1e29f ? 0.f : 1.f);
        else if (pp == 48) e5 = fmaxf(e5, fabsf(kb[pp] + lf * LOG2E));
        else e5 = fmaxf(e5, fabsf((kb[pp] - kb[pp - 1]) + lf * LOG2E));
        const int m = dhash(hsh) % R, c = dhash(hsh + 1) % 1536;
        const bf16* la = (const bf16*)(ws + WS_LA) + (size_t)m * 128; const bf16* lg = (const bf16*)(ws + WS_LG) + (size_t)m * 256;
        if (c < 512) { float a = p.in[I_W0][c]; for (int k = 0; k < 64; ++k) a += bf2f(la[k]) * rbf(p.in[I_WUP][k * 512 + c]);
            const float w = -log1pf(expf(-a)) - 0.5f; const float want = 1.0f - expf(-expf(w));
            e6 = fmaxf(e6, relerr(bf2f(((const bf16*)(dob + DO_XW))[(size_t)m * 512 + c]), want, 0.002f)); }
        else if (c < 1024) { float a = p.in[I_A0][c - 512]; for (int k = 0; k < 64; ++k) a += bf2f(la[64 + k]) * rbf(p.in[I_AUP][k * 512 + (c - 512)]);
            e6 = fmaxf(e6, relerr(bf2f(((const bf16*)(dob + DO_AA))[(size_t)m * 512 + (c - 512)]), 1.0f / (1.0f + expf(-a)), 0.05f)); }
        else { float a = 0.f; for (int k = 0; k < 160; ++k) a += bf2f(lg[k]) * rbf(p.in[I_GUP][k * 512 + (c - 1024)]);
            e6 = fmaxf(e6, relerr(bf2f(((const bf16*)(dob + DO_GG))[(size_t)m * 512 + (c - 1024)]), a, 0.1f)); }
    }
    diag_report(p, 5, e5 / 1e-3f); diag_report(p, 6, e6 / 0.03f);
}
constexpr int DG_NS4 = 2048;
__device__ __forceinline__ void dg_p4_pre(const Params& p) {
    DG_IDS(); unsigned char* dob = (unsigned char*)p.out; float* sv = (float*)(p.ws + WS_DSAVE);
    for (int s = gt; s < DG_NS4 * 64; s += NGT) { const int i = s >> 6, d = s & 63; const unsigned hsh = dhash(i * 19 + 11); const int m = hsh % R, h = (hsh >> 20) & 7;
        sv[s] = bf2f(((const bf16*)(dob + DO_AA))[(size_t)m * 512 + h * 64 + d]); }
}
__device__ __forceinline__ void dg_p4_post(const Params& p) {
    DG_IDS(); unsigned char* ws = p.ws; unsigned char* dob = (unsigned char*)p.out; const float* sv = (const float*)(ws + WS_DSAVE); float e = 0.f;
    for (int i = gwv; i < DG_NS4; i += NGWV) {
        const unsigned hsh = dhash(i * 19 + 11); const int m = hsh % R, h = (hsh >> 20) & 7; const int pp = m % TP; const int c = h * 64 + lane;
        const float a = sv[i * 64 + lane];
        const float r0 = bf2f(((const bf16*)(ws + WS_ZRR))[(size_t)m * 512 + c]), k0 = bf2f(((const bf16*)(ws + WS_ZRK))[(size_t)m * 512 + c]);
        const float r1 = pp > 0 ? bf2f(((const bf16*)(ws + WS_ZRR))[(size_t)(m - 1) * 512 + c]) : 0.f, k1 = pp > 0 ? bf2f(((const bf16*)(ws + WS_ZRK))[(size_t)(m - 1) * 512 + c]) : 0.f;
        const float rs = r0 + p.in[I_MU][c] * (r1 - r0), ks = k0 + p.in[I_MU][512 + c] * (k1 - k0);
        const float kk = ks * p.in[I_KK][c], kp = ks * (1.0f + (a - 1.0f) * p.in[I_KA][c]);
        const float nrm = fmaxf(sqrtf(wave_sum(kk * kk)), 1e-12f); const float kn = kk / nrm, bb = kn * a; const float bs = wave_sum(rs * kp * p.in[I_RK][c]);
        e = fmaxf(e, relerr(bf2f(((const bf16*)(ws + WS_KP))[(size_t)m * 512 + c]), kp, 0.1f));
        e = fmaxf(e, relerr(bf2f(((const bf16*)(ws + WS_KN))[(size_t)m * 512 + c]), kn, 0.02f));
        e = fmaxf(e, relerr(bf2f(((const bf16*)(dob + DO_AA))[(size_t)m * 512 + c]), bb, 0.02f));
        e = fmaxf(e, relerr(((const float*)(ws + WS_BS))[(size_t)m * 8 + h], bs, 0.1f));
    }
    diag_report(p, 7, e / 0.03f);
}
constexpr int DG_NS8 = 1024;
__device__ __forceinline__ void dg_attn_sample(int i, int& b, int& h, int& t) { const unsigned hsh = dhash(i * 23 + 13); b = hsh & 15; h = (hsh >> 4) & 7; t = (hsh >> 8) & 4095; if (i < 8) t = (i & 1) ? 4095 - (i >> 1) : (i >> 1); }
__device__ __forceinline__ void dg_attn_pre(const Params& p) {
    DG_IDS(); float* sv = (float*)(p.ws + WS_DSAVE + 512 * 1024);
    for (int s = gt; s < DG_NS8 * 64; s += NGT) { const int i = s >> 6, d = s & 63; int b, h, t; dg_attn_sample(i, b, h, t);
        sv[s] = bf2f(((const bf16*)(p.ws + WS_FQ))[((size_t)b * TP + 64 + t) * 512 + h * 64 + d]); }
}
__device__ __forceinline__ void dg_attn_post(const Params& p) {
    DG_IDS(); unsigned char* ws = p.ws; const float* sv = (const float*)(ws + WS_DSAVE + 512 * 1024); float e = 0.f;
    for (int i = gwv; i < DG_NS8; i += NGWV) {
        int b, h, t; dg_attn_sample(i, b, h, t);
        const int npos = 64 + t;
        const float* kb = (const float*)(ws + WS_KB) + (size_t)(b * 8 + h) * TP;
        const bf16* K = (const bf16*)(ws + WS_FK) + (size_t)b * TP * 512 + h * 64; const bf16* V = (const bf16*)(ws + WS_FV) + (size_t)b * TP * 512 + h * 64;
        float mx = -1e38f;
        for (int j = 48 + lane; j <= npos; j += 64) { float s = 0.f; for (int d = 0; d < 64; ++d) s += sv[i * 64 + d] * bf2f(K[(size_t)j * 512 + d]); s += kb[j]; mx = fmaxf(mx, s); }
        for (int o = 1; o < 64; o <<= 1) mx = fmaxf(mx, __shfl_xor(mx, o));
        float l = 0.f, acc = 0.f;
        for (int j = 48; j <= npos; ++j) { float s = 0.f; for (int d = 0; d < 64; ++d) s += sv[i * 64 + d] * bf2f(K[(size_t)j * 512 + d]); const float pj = exp2f(s + kb[j] - mx); l += pj; acc += pj * bf2f(V[(size_t)j * 512 + lane]); }
        const float want = acc / l; const float got = bf2f(((const bf16*)(ws + WS_FQ))[((size_t)b * TP + 64 + t) * 512 + h * 64 + lane]);
        e = fmaxf(e, fabsf(got - want) / (fabsf(want) + 0.05f));
    }
    diag_report(p, 8, e / 0.05f);
}
__device__ __forceinline__ void dg_scan(const Params& p) {
    DG_IDS(); unsigned char* ws = p.ws; unsigned char* dob = (unsigned char*)p.out; float e = 0.f;
    if (gwv < 4) {
        const int bh = (gwv * 37 + 5) & 127, b = bh >> 3, h = bh & 7; const size_t rowb = (size_t)b * TP; const int cb = h * 64;
        float S[64];
#pragma unroll
        for (int k = 0; k < 64; ++k) S[k] = 0.f;
        const bf16* aXW = (const bf16*)(dob + DO_XW); const bf16* aKN = (const bf16*)(ws + WS_KN); const bf16* aBB = (const bf16*)(dob + DO_AA); const bf16* aKP = (const bf16*)(ws + WS_KP);
        const bf16* aR = (const bf16*)(ws + WS_ZRR); const bf16* aV = (const bf16*)(ws + WS_ZRV);
        const float muv = p.in[I_MU][1024 + cb + lane];
#ifndef DG_SCAN_MAXPP
#define DG_SCAN_MAXPP TP
#endif
        for (int pp = 48; pp < DG_SCAN_MAXPP; ++pp) {
            const size_t ro = (rowb + pp) * 512 + cb;
            const float v0 = bf2f(aV[ro + lane]), v1 = bf2f(aV[ro - 512 + lane]); const float vv = v0 + muv * (v1 - v0);
            float sa = 0.f;
#pragma unroll
            for (int k = 0; k < 64; ++k) sa += S[k] * bf2f(aKN[ro + k]);
            sa = -sa; float y = 0.f;
#pragma unroll
            for (int k = 0; k < 64; ++k) { const float dec = 1.0f - bf2f(aXW[ro + k]); S[k] = S[k] * dec + sa * bf2f(aBB[ro + k]) + vv * bf2f(aKP[ro + k]);
                const float r0 = bf2f(aR[ro + k]), r1 = bf2f(aR[ro - 512 + k]); y += S[k] * (r0 + p.in[I_MU][cb + k] * (r1 - r0)); }
            const float got = bf2f(((const bf16*)(ws + WS_Y))[ro + lane]);
            const float rms = sqrtf(wave_sum(y * y) * (1.f / 64.f));
            e = fmaxf(e, fabsf(got - y) / (fabsf(y) + 0.5f * rms + 0.05f));
        }
    }
    diag_report(p, 9, e / 0.05f);
}
__device__ __forceinline__ void dg_p6_pre(const Params& p) {
    DG_IDS(); float* sv = (float*)(p.ws + WS_DSAVE + 768 * 1024);
    for (int s = gt; s < DG_NS4 * 64; s += NGT) { const int i = s >> 6, d = s & 63; const unsigned hsh = dhash(i * 29 + 17); const int m = hsh % R, h = (hsh >> 20) & 7;
        sv[s] = bf2f(((const bf16*)(p.ws + WS_Y))[(size_t)m * 512 + h * 64 + d]); }
}
__device__ __forceinline__ void dg_p6_post(const Params& p) {
    DG_IDS(); unsigned char* ws = p.ws; unsigned char* dob = (unsigned char*)p.out; const float* sv = (const float*)(ws + WS_DSAVE + 768 * 1024); float e = 0.f;
    for (int i = gwv; i < DG_NS4; i += NGWV) {
        const unsigned hsh = dhash(i * 29 + 17); const int m = hsh % R, h = (hsh >> 20) & 7; const int pp = m % TP; const int c = h * 64 + lane;
        if (pp < 48) continue;
        const float y = sv[i * 64 + lane]; const float mean = wave_sum(y) / 64.f; const float var = wave_sum((y - mean) * (y - mean)) / 64.f;
        const float gn = (y - mean) / sqrtf(var + GN_EPS) * p.in[I_LNG][c] + p.in[I_LNB][c];
        const float v0 = bf2f(((const bf16*)(ws + WS_ZRV))[(size_t)m * 512 + c]), v1 = bf2f(((const bf16*)(ws + WS_ZRV))[(size_t)(m - 1) * 512 + c]);
        const float vs = v0 + p.in[I_MU][1024 + c] * (v1 - v0);
        const float want = (gn + ((const float*)(ws + WS_BS))[(size_t)m * 8 + h] * vs) * bf2f(((const bf16*)(dob + DO_GG))[(size_t)m * 512 + c]);
        e = fmaxf(e, relerr(bf2f(((const bf16*)(ws + WS_Y))[(size_t)m * 512 + c]), want, 0.1f));
    }
    diag_report(p, 10, e / 0.03f);
}
__device__ __forceinline__ void dg_mix(const Params& p, int stage) {
    DG_IDS(); unsigned char* ws = p.ws; float e = 0.f;
    for (int s = gt; s < 131072; s += NGT) {
        const unsigned hsh = dhash(s * 31 + 19 + stage); const int row = hsh % R, c = dhash(hsh) & 1023;
        float want = dg_dot((const bf16*)(ws + WS_FQ), row, (const bf16*)(ws + WS_WTFOX), c, 512) * bf2f(((const bf16*)(ws + WS_ZG))[(size_t)row * 2048 + c]);
        if (stage == 12) want = rbf(want) + dg_dot((const bf16*)(ws + WS_Y), row, (const bf16*)(ws + WS_WTRWKV), c, 512) * bf2f(((const bf16*)(ws + WS_ZG))[(size_t)row * 2048 + 1024 + c]);
        e = fmaxf(e, relerr(bf2f(((const bf16*)(ws + WS_MIX))[(size_t)row * 1024 + c]), want, 0.1f));
    }
    diag_report(p, stage, e / 0.03f);
}
__device__ __forceinline__ void dg_out(const Params& p) {
    DG_IDS(); unsigned char* ws = p.ws; float e = 0.f;
    for (int s = gt; s < 131072; s += NGT) {
        const unsigned hsh = dhash(s * 37 + 23); const int tok = hsh & 65535, c = dhash(hsh) & 1023; const int b = tok >> 12, t = tok & 4095;
        const float want = p.in[I_X][(size_t)tok * 1024 + c] + dg_dot((const bf16*)(ws + WS_MIX), (size_t)b * TP + 64 + t, (const bf16*)(ws + WS_WTOUT), c, 1024);
        e = fmaxf(e, relerr(p.out[(size_t)tok * 1024 + c], want, 0.3f));
    }
    diag_report(p, 13, e / 0.01f);
}
__device__ __forceinline__ void dg_norm2(const Params& p) {
    DG_IDS(); unsigned char* ws = p.ws; float e = 0.f;
    for (int s = gwv; s < 4096; s += NGWV) {
        const int m = dhash(s * 41 + 29) & 65535; const float* xr = p.out + (size_t)m * 1024;
        float ss = 0.f; for (int c = lane; c < 1024; c += 64) ss += xr[c] * xr[c];
        ss = wave_sum(ss); const float rs = 1.0f / sqrtf(ss / 1024.f + NORM_EPS);
        for (int c = lane; c < 1024; c += 64) e = fmaxf(e, relerr(bf2f(((const bf16*)(ws + WS_XN2))[(size_t)m * 1024 + c]), xr[c] * rs * p.in[I_N2G][c], 0.05f));
    }
    diag_report(p, 14, e / 0.03f);
}
__device__ __forceinline__ void dg_pq(const Params& p) {
    DG_IDS(); unsigned char* ws = p.ws; float e = 0.f;
    for (int s = gt; s < 131072; s += NGT) {
        const unsigned hsh = dhash(s * 43 + 31); const int tok = hsh & 65535, c = dhash(hsh) & 2047;
        const float want = dg_dot((const bf16*)(ws + WS_XN2), tok, (const bf16*)(ws + WS_WTQ), c, 1024);
        e = fmaxf(e, relerr(bf2f(((const bf16*)(ws + WS_PQ))[(size_t)tok * 2048 + c]), want, 0.25f));
    }
    diag_report(p, 15, e / 0.02f);
}
__device__ __forceinline__ void dg_route(const Params& p, LAS unsigned char* lds) {
    DG_IDS(); unsigned char* ws = p.ws; float e16 = 0.f, e17 = 0.f;
    LAS float* s2l = (LAS float*)lds + (tid >> 6) * 128;
    for (int i = gwv; i < 2048; i += NGWV) {
        const unsigned hsh = dhash(i * 47 + 37); const int tok = hsh & 65535, h = (hsh >> 16) & 7;
        const bf16* q = (const bf16*)(ws + WS_PQ) + (size_t)tok * 2048 + h * 256; const bf16* ks = (const bf16*)(ws + WS_KS);
        float s1a = 0.f, s1b = 0.f, s2a = 0.f, s2b = 0.f;
        for (int d = 0; d < 128; ++d) { const float q1 = bf2f(q[d]), q2 = bf2f(q[128 + d]);
            s1a += q1 * bf2f(ks[(size_t)lane * 128 + d]); s1b += q1 * bf2f(ks[(size_t)(lane + 64) * 128 + d]);
            s2a += q2 * bf2f(ks[(size_t)(128 + lane) * 128 + d]); s2b += q2 * bf2f(ks[(size_t)(192 + lane) * 128 + d]); }
        s2l[lane] = s2a; s2l[lane + 64] = s2b; asm volatile("s_waitcnt lgkmcnt(0)" ::: "memory");
        float prev_s = 3e38f; int prev_id = -1; float top_s[16]; int top_id[16];
#pragma unroll 1
        for (int r = 0; r < 16; ++r) {
            float bs = -3e38f; int bi = 0x7fffffff;
            for (int j = 0; j < 128; ++j) { const float t2 = s2l[j];
                { const float sm = s1a + t2; const int id = lane * 128 + j; const bool ok = (sm < prev_s) || (sm == prev_s && id > prev_id); if (ok && (sm > bs || (sm == bs && id < bi))) { bs = sm; bi = id; } }
                { const float sm = s1b + t2; const int id = (lane + 64) * 128 + j; const bool ok = (sm < prev_s) || (sm == prev_s && id > prev_id); if (ok && (sm > bs || (sm == bs && id < bi))) { bs = sm; bi = id; } } }
            for (int o = 1; o < 64; o <<= 1) { const float os = __shfl_xor(bs, o); const int oi = __shfl_xor(bi, o); if (os > bs || (os == bs && oi < bi)) { bs = os; bi = oi; } }
            top_s[r] = bs; top_id[r] = bi; prev_s = bs; prev_id = bi;
        }
        const int* ids = (const int*)(ws + WS_IDS) + (size_t)tok * 128 + h * 16; const float* gts = (const float*)(ws + WS_GATES) + (size_t)tok * 128 + h * 16;
        float den = 0.f;
#pragma unroll
        for (int r = 0; r < 16; ++r) den += expf(top_s[r] - top_s[0]);
        int miss = 0;
#pragma unroll
        for (int r = 0; r < 16; ++r) {
            bool found = false; for (int k = 0; k < 16; ++k) found |= (ids[k] == top_id[r]);
            if (!found && top_s[r] > top_s[15] + 2e-3f * fabsf(top_s[15]) + 1e-4f) ++miss;
            e17 = fmaxf(e17, fabsf(gts[r] - expf(top_s[r] - top_s[0]) / den));
        }
        e16 = fmaxf(e16, (float)miss);
        if (lane == 0 && miss) atomicAdd((float*)(ws + WS_DIAG) + 19, (float)miss);
    }
    diag_report(p, 16, e16 / 0.5f); diag_report(p, 17, e17 / 0.01f);
}
constexpr int DG_NS18 = 128;
__device__ __forceinline__ void dg_gather_pre(const Params& p) {
    DG_IDS(); float* sv = (float*)(p.ws + WS_DSAVE + 1280 * 1024);
    for (int s = gt; s < DG_NS18 * 1024; s += NGT) { const int i = s >> 10, c = s & 1023; const int tok = dhash(i * 53 + 41) & 65535; sv[s] = p.out[(size_t)tok * 1024 + c]; }
    for (int s = gt; s < DG_NS18 * 128; s += NGT) { const int i = s >> 7, ex = s & 127; const int tok = dhash(i * 53 + 41) & 65535; sv[DG_NS18 * 1024 + s] = ((const float*)(p.ws + WS_GATES))[(size_t)tok * 128 + ex]; }
}
__device__ __forceinline__ void dg_gather_post(const Params& p) {
    DG_IDS(); unsigned char* ws = p.ws; const float* sv = (const float*)(ws + WS_DSAVE + 1280 * 1024); float e = 0.f;
    for (int i = gwv; i < DG_NS18; i += NGWV) {
        const int tok = dhash(i * 53 + 41) & 65535;
        const int* ids = (const int*)(ws + WS_IDS) + (size_t)tok * 128; const float* gts = (const float*)(ws + WS_GATES) + (size_t)tok * 128;
        const signed char* xq = (const signed char*)(ws + WS_XQ) + (size_t)tok * 1024; const float sx = ((const float*)(ws + WS_SX))[tok];
        float o[16];
#pragma unroll
        for (int k = 0; k < 16; ++k) o[k] = 0.f;
        for (int ex = 0; ex < 128; ++ex) {
            const int id = ids[ex]; const signed char* ur = (const signed char*)(ws + WS_U8) + (size_t)id * 1024; const unsigned char* vr = ws + WS_V8 + (size_t)id * 1024;
            float d = 0.f;
#pragma unroll
            for (int k = 0; k < 16; ++k) d += (float)ur[lane * 16 + k] * (float)xq[lane * 16 + k];
            d = wave_sum(d) * ((const float*)(ws + WS_SU))[id] * sx;
            const float svs = ((const float*)(ws + WS_SV))[id];
            const float w = gts[ex];
            e = fmaxf(e, fabsf(w - sv[DG_NS18 * 1024 + i * 128 + ex] * 0.5f * d * (1.0f + erff(d * 0.70710678f)) * svs) / (0.02f * svs) * 0.05f);
#pragma unroll
            for (int k = 0; k < 16; ++k) o[k] += w * ((float)vr[lane * 16 + k] - 128.f);
        }
        float ss = 0.f;
#pragma unroll
        for (int k = 0; k < 16; ++k) ss += o[k] * o[k];
        const float rms = sqrtf(wave_sum(ss) / 1024.f);
#pragma unroll
        for (int k = 0; k < 16; ++k) e = fmaxf(e, fabsf((p.out[(size_t)tok * 1024 + lane * 16 + k] - sv[i * 1024 + lane * 16 + k]) - o[k]) / (rms + 1e-3f));
    }
    diag_report(p, 18, e / 0.05f);
}
__device__ __forceinline__ void dg_final(const Params& p) {
    DG_IDS(); const float* dg = (const float*)(p.ws + WS_DIAG);
    int k = 0;
    for (int s = 1; s <= 26; ++s) if (k == 0 && s != 19 && s != 20 && !(dg[s] <= 1.0f)) k = s;
#ifdef DIAG_SKIP
    { int kk = 0; for (int s = 1; s <= 26; ++s) if (kk == 0 && s > DIAG_SKIP && s != 19 && s != 20 && !(dg[s] <= 1.0f)) kk = s; k = kk; }
#endif
#ifdef DIAG_VALUE
    const float a = fminf(fmaxf(dg[DIAG_VALUE], 1e-3f), 1e6f) * 16.f;
#else
    const float a = exp2f((float)k);
#endif
    for (size_t i = gt; i < (size_t)NTOK * 1024 / 4; i += NGT) ((f32x4*)p.out)[i] = (f32x4){a, a, a, a};
}
#endif

#define XB_TMO      128
#define XB_XCNT(j)  (256  + 64 * (j))
#define XB_XSUB(j)  (1280 + 64 * (j))
#define XB_XGEN(j)  (2304 + 64 * (j))
#define XB_TOP      3328
#define XB_TOPGEN   3392
#define XCD_BAR_WORDS 3456
#if DIAG
#define XB_SPIN_CAP (1u << 28)
#else
#define XB_SPIN_CAP (1u << 18)
#endif

__device__ __forceinline__ unsigned xb_ld(unsigned* p)              { return __hip_atomic_load(p, __ATOMIC_RELAXED, __HIP_MEMORY_SCOPE_AGENT); }
__device__ __forceinline__ unsigned xb_add(unsigned* p, unsigned v) { return __hip_atomic_fetch_add(p, v, __ATOMIC_RELAXED, __HIP_MEMORY_SCOPE_AGENT); }
__device__ __forceinline__ unsigned xb_xcc_id() { return (unsigned)__builtin_amdgcn_s_getreg((3 << 11) | 20) & 0xFu; }
#define XB_SPIN(cond, bar) do { unsigned _sp = 0; while (cond) { __builtin_amdgcn_s_sleep(1); \
    if ((++_sp & 255u) == 0u) { if (xb_ld(&(bar)[XB_TMO])) break; if (_sp > XB_SPIN_CAP) { atomicAdd(&(bar)[XB_TMO], 1u); break; } } } } while (0)

struct XcdBarrier {
    unsigned* bar; unsigned x;
    volatile LAS unsigned* st;
};

__device__ __forceinline__ XcdBarrier xcd_barrier_post(unsigned* bar, volatile LAS unsigned* st) {
    XcdBarrier b; b.bar = bar; b.x = xb_xcc_id(); b.st = st;
    if (threadIdx.x == 0) (void)xb_add(&bar[XB_XCNT(b.x)], 1u);
    return b;
}
__device__ __forceinline__ void xcd_barrier_complete(unsigned* bar, unsigned x, unsigned& nloc, unsigned& nx) {
    const unsigned G = gridDim.x * gridDim.y * gridDim.z;
    unsigned sum, cnt, mine, sp = 0u;
    for (;;) {
        sum = 0u; cnt = 0u; mine = 0u;
#pragma unroll
        for (unsigned j = 0; j < 16; ++j) { const unsigned c = xb_ld(&bar[XB_XCNT(j)]); sum += c; cnt += (c > 0u) ? 1u : 0u; mine = (j == x) ? c : mine; }
        if (sum == G) break;
        __builtin_amdgcn_s_sleep(1);
        if ((++sp & 255u) == 0u) { if (xb_ld(&bar[XB_TMO])) break; if (sp > XB_SPIN_CAP) { atomicAdd(&bar[XB_TMO], 1u); break; } }
    }
    nloc = mine > 0u ? mine : 1u; nx = cnt > 0u ? cnt : 1u;
}

__device__ __forceinline__ void xcd_barrier(const XcdBarrier& b) {
    asm volatile("s_waitcnt vmcnt(0)" ::: "memory");
    __syncthreads();
    if (threadIdx.x == 0) {
        unsigned* bar = b.bar;
        __builtin_amdgcn_s_waitcnt(0);
        unsigned nloc = b.st[0], nx = b.st[1];
        if (nloc == 0u) { xcd_barrier_complete(bar, b.x, nloc, nx); b.st[0] = nloc; b.st[1] = nx; }
        const unsigned old = xb_add(&bar[XB_XSUB(b.x)], 1u);
        const unsigned gen = old / nloc;
        if (old + 1u == (gen + 1u) * nloc) {
            __builtin_amdgcn_fence(__ATOMIC_RELEASE, "agent");
            asm volatile("s_waitcnt vmcnt(0)" ::: "memory");
            const unsigned og = xb_add(&bar[XB_TOP], 1u);
            const unsigned tg = og / nx;
            if (og + 1u == (tg + 1u) * nx) xb_add(&bar[XB_TOPGEN], 1u);
            else XB_SPIN(xb_ld(&bar[XB_TOPGEN]) == tg, bar);
            __builtin_amdgcn_fence(__ATOMIC_ACQUIRE, "agent");
            xb_add(&bar[XB_XGEN(b.x)], 1u);
            asm volatile("s_waitcnt vmcnt(0)" ::: "memory");
        } else {
            XB_SPIN(xb_ld(&bar[XB_XGEN(b.x)]) == gen, bar);
            __builtin_amdgcn_fence(__ATOMIC_ACQUIRE, "agent");
            asm volatile("s_waitcnt vmcnt(0)" ::: "memory");
        }
    }
    __syncthreads();
}

#ifndef TIMING
#define TIMING 0
#endif
#if TIMING
#define TS(i) do { int t__ = threadIdx.x; asm volatile("" : "+v"(t__)); if (bid == 0 && t__ == 0) ((unsigned long long*)(ws + 1010 * MiB))[i] = __builtin_amdgcn_s_memrealtime(); } while (0)
#else
#define TS(i)
#endif
#if DIAG
#define DG(...) __VA_ARGS__
#else
#define DG(...)
#endif
constexpr int LDS_BYTES = 147456;
static_assert(attn_body::ATTN_LDS_BYTES <= 131072, "attention LDS");
static_assert(RT_KS_BYTES + NTHREADS * RT_TAB_WORDS * 4 <= LDS_BYTES, "routing LDS");
static_assert(sc2::END <= LDS_BYTES - 64, "scan LDS");

__global__ void __launch_bounds__(NTHREADS, 2) hybrid_fwd(Params p) {
    extern __shared__ __attribute__((aligned(16))) unsigned char lds_raw[];
    cg::grid_group grid = cg::this_grid();
    LAS unsigned char* lds = (LAS unsigned char*)lds_raw;
    const int G0 = gridDim.x, bid = blockIdx.x;
#define LANE_IDS() int tid = threadIdx.x; asm volatile("" : "+v"(tid)); const int lane = tid & 63, wave = __builtin_amdgcn_readfirstlane(tid >> 6); (void)lane; (void)wave; int G = G0; asm volatile("" : "+s"(G))
    const int vcu = (G0 % 8 == 0) ? (bid % 8) * (G0 / 8) + bid / 8 : bid;
    unsigned char* ws = p.ws; unsigned char* dob = (unsigned char*)p.out;

    DG({ int t_ = threadIdx.x; asm volatile("" : "+v"(t_)); if (bid == 0 && t_ < 64) ((float*)(ws + WS_DIAG))[t_] = 0.f; })
    unsigned* barw = (unsigned*)(ws + 65536);
    { int t__ = threadIdx.x; asm volatile("" : "+v"(t__)); if (bid == 0) for (int i = t__; i < XCD_BAR_WORDS + 128; i += NTHREADS) __hip_atomic_store(barw + i, 0u, __ATOMIC_RELAXED, __HIP_MEMORY_SCOPE_AGENT);
      if (t__ < 2) ((volatile LAS unsigned*)(lds + LDS_BYTES - 64))[t__] = 0u; }
    __syncthreads();
    TS(0);
    { LANE_IDS(); p0_prologue(p, lds, vcu, G, wave, lane); }
#ifdef REP_P0
    __syncthreads(); { LANE_IDS(); p0_prologue(p, lds, vcu, G, wave, lane); }
#endif
    grid.sync();
    const XcdBarrier xbar = xcd_barrier_post(barw, (volatile LAS unsigned*)(lds + LDS_BYTES - 64));
#define GSYNC() xcd_barrier(xbar)
    DG(dg_p0(p);)
    TS(1);
    run_gemm(lds, (const bf16*)(ws + WS_XN), (const bf16*)(ws + WS_WTIN), R, N1, 1024, G0, bid, F_Gemm1{(bf16*)(ws + WS_F), (bf16*)(ws + WS_ZG)});
#ifdef REP_GEMM1
    run_gemm(lds, (const bf16*)(ws + WS_XN), (const bf16*)(ws + WS_WTIN), R, N1, 1024, G0, bid, F_Gemm1{(bf16*)(ws + WS_F), (bf16*)(ws + WS_ZG)});
#endif
    GSYNC();
    DG(dg_gemm1(p); GSYNC();)
    TS(2);
    { LANE_IDS(); p2_prep1(p, vcu, G, wave, lane); }
    GSYNC();
    DG(dg_p2(p);)
    TS(3);
    { LANE_IDS(); const int gwv = vcu * NWAVES + wave; for (int s = gwv; s < 128; s += G * NWAVES) p3_cumsum(p, s, lane); }
    __syncthreads();
    run_gemm(lds, (const bf16*)(ws + WS_LA), (const bf16*)(ws + WS_WTWA), R, 512, 128, G0, bid, F_LoraW{(bf16*)(dob + DO_XW), p.in[I_W0]});
    run_gemm(lds, (const bf16*)(ws + WS_LA), (const bf16*)(ws + WS_WTWA) + 512 * 128, R, 512, 128, G0, bid, F_LoraA{(bf16*)(dob + DO_AA), p.in[I_A0]});
    run_gemm(lds, (const bf16*)(ws + WS_LG), (const bf16*)(ws + WS_WTG), R, 512, 256, G0, bid, F_Plain{(bf16*)(dob + DO_GG), 512});
    GSYNC();
    DG(dg_p3(p); dg_p4_pre(p); GSYNC();)
    TS(4);
    { LANE_IDS(); p4_prep2(p, vcu, G, wave, lane); }
    GSYNC();
    DG(dg_p4_post(p); dg_attn_pre(p); GSYNC();)
    TS(5);
    {
        LANE_IDS();
        for (int bh = bid; bh < 128; bh += G0) p5_scan_chunked(p, lds, bh, tid, wave, lane);
#ifdef REP_SCAN
        for (int bh = bid; bh < 128; bh += G0) p5_scan_chunked(p, lds, bh, tid, wave, lane);
#endif
        TS(6);
        volatile LAS unsigned* qslot = (volatile LAS unsigned*)(lds + LDS_BYTES - 64 + 16);
        for (;;) {
            __syncthreads();
            if (tid == 0) *qslot = __hip_atomic_fetch_add(barw + XCD_BAR_WORDS + 64, 1u, __ATOMIC_RELAXED, __HIP_MEMORY_SCOPE_AGENT);
            __syncthreads();
            const int u = __builtin_amdgcn_readfirstlane((int)*qslot);
            if (u >= 2048) break;
            const int qb = 15 - (u >> 7), bh = u & 127;
            {
                const float* kbg = (const float*)(ws + WS_KB) + (size_t)bh * TP; LAS float* kbl = (LAS float*)(lds + attn_body::LDS_KB);
                for (int i = tid; i < TP; i += NTHREADS) kbl[i] = kbg[i];
                asm volatile("s_waitcnt vmcnt(0) lgkmcnt(0)" ::: "memory");
                __syncthreads();
            }
            attn_body::attn_unit<8>(bh >> 3, bh & 7, qb, (const attn_body::bf16*)(ws + WS_FQ), (const attn_body::bf16*)(ws + WS_FK), (const attn_body::bf16*)(ws + WS_FV), (attn_body::bf16*)(ws + WS_FQ), (char*)lds_raw);
        }
    }
    GSYNC();
    DG(dg_attn_post(p); dg_scan(p); dg_p6_pre(p); GSYNC();)
    TS(7);
    { LANE_IDS(); p6_prep3(p, vcu, G, wave, lane); }
    GSYNC();
    DG(dg_p6_post(p);)
    TS(8);
    run_gemm(lds, (const bf16*)(ws + WS_FQ), (const bf16*)(ws + WS_WTFOX), R, 1024, 512, G0, bid, F_MixA{(bf16*)(ws + WS_MIX), (const bf16*)(ws + WS_ZG)});
    GSYNC();
    TS(9);
    DG(dg_mix(p, 11); GSYNC();)
    run_gemm(lds, (const bf16*)(ws + WS_Y), (const bf16*)(ws + WS_WTRWKV), R, 1024, 512, G0, bid, F_MixB{(bf16*)(ws + WS_MIX), (const bf16*)(ws + WS_ZG)});
    GSYNC();
    DG(dg_mix(p, 12);)
    TS(10);
    run_gemm(lds, (const bf16*)(ws + WS_MIX), (const bf16*)(ws + WS_WTOUT), R, 1024, 1024, G0, bid, F_Out{p.in[I_X], p.out});
    GSYNC();
    TS(11);
    DG(dg_out(p); GSYNC();)
    { LANE_IDS(); p9_norm2(p, vcu, G, wave, lane); }
    GSYNC();
    DG(dg_norm2(p);)
    TS(12);
    run_gemm(lds, (const bf16*)(ws + WS_XN2), (const bf16*)(ws + WS_WTQ), NTOK, 2048, 1024, G0, bid, F_Plain{(bf16*)(ws + WS_PQ), 2048});
#ifdef REP_PQ
    run_gemm(lds, (const bf16*)(ws + WS_XN2), (const bf16*)(ws + WS_WTQ), NTOK, 2048, 1024, G0, bid, F_Plain{(bf16*)(ws + WS_PQ), 2048});
#endif
    GSYNC();
    TS(13);
    DG(dg_pq(p);)
    { LANE_IDS(); p11_route(p, lds, vcu, G, tid, wave, lane); }
#ifdef REP_ROUTE
    __syncthreads(); { LANE_IDS(); p11_route(p, lds, vcu, G, tid, wave, lane); }
#endif
    GSYNC();
    TS(14);
    DG(__syncthreads(); dg_route(p, lds); dg_gather_pre(p); GSYNC();)
    { LANE_IDS(); p12a_partial(p, bid, G, wave, lane); }
#ifdef REP_12A
    { LANE_IDS(); p12a_partial(p, bid, G, wave, lane); }
#endif
    GSYNC();
    { LANE_IDS(); p12b_combine(p, vcu, G, wave, lane); }
    GSYNC();
    { LANE_IDS(); p12c_output(p, bid, G, wave, lane); }
    DG(GSYNC(); dg_gather_post(p); GSYNC(); dg_final(p);)
#if TIMING
    GSYNC(); TS(15); GSYNC();
    {
        const unsigned long long* ts = (const unsigned long long*)(ws + 1010 * MiB);
        const float tot = (float)(ts[15] - ts[0]);
        const float fa = 10.f * (float)(ts[TIMING_A1] - ts[TIMING_A0]) / tot;
        int t__ = threadIdx.x; asm volatile("" : "+v"(t__));
        for (size_t i = (size_t)bid * NTHREADS + t__; i < (size_t)NTOK * 1024; i += (size_t)G0 * NTHREADS) p.out[i] = fa;
    }
#endif
}

extern "C" void kernel_launch(void* const* d_in, const int* in_sizes, int n_in, void* d_out, int out_size, void* d_ws, size_t ws_size, hipStream_t stream) {
    static int grid = 0;
    if (grid == 0) {
        if (n_in != 27 || out_size != NTOK * DMODEL || ws_size < WS_END) { fprintf(stderr, "kernel_launch: unexpected shapes (n_in %d, out %d, ws %zu)\n", n_in, out_size, ws_size); grid = -1; return; }
        int dev = 0, cus = 0, per_cu = 0;
        hipGetDevice(&dev);
        hipDeviceGetAttribute(&cus, hipDeviceAttributeMultiprocessorCount, dev);
        hipFuncSetAttribute((const void*)hybrid_fwd, hipFuncAttributeMaxDynamicSharedMemorySize, LDS_BYTES);
        hipOccupancyMaxActiveBlocksPerMultiprocessor(&per_cu, (const void*)hybrid_fwd, NTHREADS, LDS_BYTES);
        if (per_cu < 1) { fprintf(stderr, "kernel_launch: occupancy query says %d blocks per CU\n", per_cu); grid = -1; return; }
        grid = cus;
    }
    if (grid < 0) return;
    Params p{};
    for (int i = 0; i < 27; ++i) p.in[i] = (const float*)d_in[i];
    p.out = (float*)d_out; p.ws = (unsigned char*)d_ws;
    void* args[] = {&p};
    hipError_t e = hipLaunchCooperativeKernel((const void*)hybrid_fwd, dim3(grid), dim3(NTHREADS), args, LDS_BYTES, stream);
    if (e != hipSuccess) fprintf(stderr, "cooperative launch failed: %s (grid %d)\n", hipGetErrorString(e), grid);
}
```

```cpp
#include <hip/hip_runtime.h>
#include <hip/hip_cooperative_groups.h>
#include <hip/hip_bf16.h>
#include <cstdio>
#include <cstdint>
#include <cmath>
namespace cg = cooperative_groups;
#ifndef DIAG
#define DIAG 0
#endif
namespace pg8 {
#define PG8_LAS __attribute__((address_space(3)))
typedef unsigned short bf16_t;
typedef short bf16x8 __attribute__((ext_vector_type(8)));
typedef float f32x4 __attribute__((ext_vector_type(4)));
typedef unsigned u32x4 __attribute__((ext_vector_type(4)));
constexpr int BM = 256, BK = 64, HALF = 128, HTB = HALF * BK * 2  , STAGE_BYTES = 8 * HTB, NXCD = 8, WGM = 8;

__host__ __device__ __forceinline__ int lds_byte(int r, int c) { const int st = (r >> 4) * 2 + (c >> 5), rr = r & 15, cc = c & 31, ob = rr * 64 + cc * 2; return st * 1024 + (ob ^ (((ob >> 9) & 1) << 5)); }
__host__ __device__ __forceinline__ void stage_rc(int b, int& R, int& C) { const int st = b / 1024, sb = b % 1024, swz = sb ^ (((sb >> 9) & 1) << 5); R = (st >> 1) * 16 + swz / 64; C = (st & 1) * 32 + (swz % 64) / 2; }
__host__ __device__ __forceinline__ int perm32(int rho) { const int n = rho >> 4, i = rho & 15; return 8 * (i >> 2) + 4 * n + (i & 3); }

struct Unit { int pm, pn; };
struct Gemm { const bf16_t* A; const bf16_t* Bt; int M, N, K; };

struct StaticOrder {
    int nM, nN, nwg, G, c;
    __host__ __device__ void init(int M, int N, int G_, int c_) { nM = M / BM; nN = N / BM; nwg = nM * nN; G = G_; c = c_; }
    __host__ __device__ bool next(int i, Unit& u) const {
        const int L = i * G + c; if (L >= nwg) return false;
        int wgid = (int)L; { const int q = nwg / NXCD, r = nwg % NXCD, xcd = wgid % NXCD, off = wgid / NXCD; wgid = (xcd < r ? xcd * (q + 1) : r * (q + 1) + (xcd - r) * q) + off; }
        const int nig = WGM * nN, gid = wgid / nig, fm = gid * WGM, gsz = (nM - fm) < WGM ? (nM - fm) : WGM;
        u.pm = fm + ((wgid % nig) % gsz); u.pn = (wgid % nig) / gsz; return true;
    }
    __device__ __forceinline__ void a_ready(const Unit&) const {}
    __device__ __forceinline__ void done(const Unit&) const {}
};

__device__ __forceinline__ unsigned cvt_pk_bf16(float lo, float hi) { unsigned r; asm volatile("v_cvt_pk_bf16_f32 %0, %1, %2" : "=v"(r) : "v"(lo), "v"(hi)); return r; }
typedef float f32x2 __attribute__((ext_vector_type(2)));
typedef int i32x4 __attribute__((ext_vector_type(4)));
template <class Epi, class Sched, bool ALIGN_EPI = false, bool SP2 = false>
__device__ __forceinline__ void gemm_phase(PG8_LAS unsigned char* lds, const Gemm g, const Sched& S, const Epi& E) {
    int tid_ = threadIdx.x; asm volatile("" : "+v"(tid_));
    const int tid = tid_, wid = __builtin_amdgcn_readfirstlane(tid >> 6), lane = tid & 63, wr = wid >> 2, wc = wid & 3, fr = lane & 15, fq = lane >> 4;
    const int K = g.K, nt = K / BK;
    unsigned voffA[2], voffB[2];
#pragma unroll
    for (int i = 0; i < 2; ++i) { int R, C; stage_rc(tid * 16 + i * 8192, R, C); const int Rb = Epi::PERM ? ((R & ~31) + perm32(R & 31)) : R;
        voffA[i] = (unsigned)(R * K + C) * 2u; voffB[i] = (unsigned)(Rb * K + C) * 2u; }
    const size_t kstep = (size_t)(BK * 2);
    const size_t hstep = (size_t)HALF * K * 2;
    const size_t tstep = 2 * hstep;
    const unsigned ldsw = (unsigned)wid * 1024u;
    const int aoff = lds_byte(wr * 64 + fr, fq * 8), boff = lds_byte(wc * 32 + fr, fq * 8);
#define PG8_SA(b, h) (((b) * 2 + (h)) * HTB)
#define PG8_SB(b, h) ((4 + (b) * 2 + (h)) * HTB)
#define PG8_STAGE(bufoff, gbase, voff) do { _Pragma("unroll") for (int _i = 0; _i < 2; ++_i) \
        __builtin_amdgcn_global_load_lds((const unsigned*)((const char*)(gbase) + (voff)[_i]), (PG8_LAS unsigned*)(lds + (bufoff) + ldsw + _i * 8192), 16, 0, 0); } while (0)
#define PG8_LDA(dst, b, h) do { _Pragma("unroll") for (int m = 0; m < 4; ++m) _Pragma("unroll") for (int k = 0; k < 2; ++k) dst[m][k] = *(const PG8_LAS bf16x8*)(lds + PG8_SA(b, h) + aoff + m * 2048 + k * 1024); } while (0)
#define PG8_LDB(dst, b, h) do { _Pragma("unroll") for (int n = 0; n < 2; ++n) _Pragma("unroll") for (int k = 0; k < 2; ++k) dst[n][k] = *(const PG8_LAS bf16x8*)(lds + PG8_SB(b, h) + boff + n * 2048 + k * 1024); } while (0)
#define PG8_MMA(ai, bj, At, Bt) do { __builtin_amdgcn_s_setprio(1); _Pragma("unroll") for (int m = 0; m < 4; ++m) _Pragma("unroll") for (int n = 0; n < 2; ++n) _Pragma("unroll") for (int k = 0; k < 2; ++k) \
        acc[ai][bj][m][n] = __builtin_amdgcn_mfma_f32_16x16x32_bf16(Bt[n][k], At[m][k], acc[ai][bj][m][n], 0, 0, 0); __builtin_amdgcn_s_setprio(0); } while (0)
#define PG8_WAIT_V(n) asm volatile("s_waitcnt vmcnt(" #n ")" ::: "memory")
#define PG8_WAIT_L(n) asm volatile("s_waitcnt lgkmcnt(" #n ")" ::: "memory")
#define PG8_BAR __builtin_amdgcn_s_barrier()
#define PG8_SCHED __builtin_amdgcn_sched_barrier(0)
    Unit cur, nxt; int ui = 0;
    if (!S.next(0, cur)) return;
    f32x4 acc[2][2][4][2];
#pragma unroll
    for (int a = 0; a < 2; ++a)
#pragma unroll
        for (int b = 0; b < 2; ++b)
#pragma unroll
            for (int m = 0; m < 4; ++m)
#pragma unroll
                for (int n = 0; n < 2; ++n) acc[a][b][m][n] = (f32x4){0.f, 0.f, 0.f, 0.f};
    bf16x8 At[4][2], B0[2][2], B1[2][2];
    const char* cA = (const char*)g.A + (size_t)cur.pm * tstep; const char* cB = (const char*)g.Bt + (size_t)cur.pn * tstep;
    S.a_ready(cur);
    if constexpr (SP2) {
        PG8_STAGE(PG8_SB(0, 0), cB, voffB); PG8_STAGE(PG8_SB(0, 1), cB + hstep, voffB); PG8_STAGE(PG8_SA(0, 0), cA, voffA); PG8_STAGE(PG8_SA(0, 1), cA + hstep, voffA);
        if (wr == 1) PG8_BAR;
        PG8_WAIT_V(2); PG8_BAR;
        PG8_STAGE(PG8_SB(1, 0), cB + kstep, voffB); PG8_STAGE(PG8_SA(1, 0), cA + kstep, voffA); PG8_STAGE(PG8_SB(1, 1), cB + hstep + kstep, voffB);
        PG8_WAIT_V(6); PG8_BAR;
    } else {
        PG8_STAGE(PG8_SB(0, 0), cB, voffB); PG8_STAGE(PG8_SA(0, 0), cA, voffA); PG8_STAGE(PG8_SB(0, 1), cB + hstep, voffB); PG8_STAGE(PG8_SA(0, 1), cA + hstep, voffA);
        if (wr == 1) PG8_BAR;
        PG8_WAIT_V(4); PG8_BAR;
        PG8_STAGE(PG8_SB(1, 0), cB + kstep, voffB); PG8_STAGE(PG8_SA(1, 0), cA + kstep, voffA); PG8_STAGE(PG8_SB(1, 1), cB + hstep + kstep, voffB);
        PG8_WAIT_V(6); PG8_BAR;
    }
    for (;;) {
        const bool has_next = S.next(ui + 1, nxt);
        const char* nA = has_next ? (const char*)g.A + (size_t)nxt.pm * tstep : cA; const char* nB = has_next ? (const char*)g.Bt + (size_t)nxt.pn * tstep : cB;
        for (int t = 0; t < nt; t += 2) {
            const bool last = (t == nt - 2);
            const char* a1 = cA + (size_t)(t + 1) * kstep;
            const char* a2 = last ? nA : cA + (size_t)(t + 2) * kstep; const char* b2 = last ? nB : cB + (size_t)(t + 2) * kstep;
            const char* a3 = a2 + kstep; const char* b3 = b2 + kstep;
            if (last && has_next) S.a_ready(nxt);
            if constexpr (SP2) {
            PG8_LDB(B0, 0, 0); PG8_LDB(B1, 0, 1); PG8_SCHED; PG8_LDA(At, 0, 0); PG8_STAGE(PG8_SA(1, 1), a1 + hstep, voffA);
            PG8_WAIT_V(8); PG8_WAIT_L(0); PG8_BAR; PG8_MMA(0, 0, At, B0); PG8_MMA(0, 1, At, B1); PG8_BAR; PG8_SCHED;
            PG8_LDA(At, 0, 1); PG8_STAGE(PG8_SB(0, 0), b2, voffB); PG8_STAGE(PG8_SB(0, 1), b2 + hstep, voffB); PG8_STAGE(PG8_SA(0, 0), a2, voffA);
            PG8_WAIT_V(8); PG8_WAIT_L(0); PG8_BAR; PG8_MMA(1, 0, At, B0); PG8_MMA(1, 1, At, B1); PG8_BAR; PG8_SCHED;
            PG8_LDB(B0, 1, 0); PG8_LDB(B1, 1, 1); PG8_SCHED; PG8_LDA(At, 1, 0); PG8_STAGE(PG8_SA(0, 1), a2 + hstep, voffA);
            PG8_WAIT_V(8); PG8_WAIT_L(0); PG8_BAR; PG8_MMA(0, 0, At, B0); PG8_MMA(0, 1, At, B1); PG8_BAR; PG8_SCHED;
            PG8_LDA(At, 1, 1); PG8_STAGE(PG8_SB(1, 0), b3, voffB); PG8_STAGE(PG8_SB(1, 1), b3 + hstep, voffB); PG8_STAGE(PG8_SA(1, 0), a3, voffA);
            PG8_WAIT_V(8); PG8_WAIT_L(0); PG8_BAR; PG8_MMA(1, 0, At, B0); PG8_MMA(1, 1, At, B1); PG8_BAR; PG8_SCHED;
            } else {
            PG8_LDB(B0, 0, 0); PG8_SCHED; PG8_LDA(At, 0, 0); PG8_STAGE(PG8_SA(1, 1), a1 + hstep, voffA);
            PG8_WAIT_L(8); PG8_BAR; PG8_WAIT_L(0); PG8_MMA(0, 0, At, B0); PG8_BAR; PG8_SCHED;
            PG8_LDB(B1, 0, 1); PG8_STAGE(PG8_SB(0, 0), b2, voffB);
            PG8_BAR; PG8_WAIT_L(0); PG8_MMA(0, 1, At, B1); PG8_BAR;
            PG8_LDA(At, 0, 1); PG8_STAGE(PG8_SA(0, 0), a2, voffA);
            PG8_BAR; PG8_WAIT_L(0); PG8_MMA(1, 0, At, B0); PG8_BAR; PG8_SCHED;
            PG8_STAGE(PG8_SB(0, 1), b2 + hstep, voffB);
            PG8_WAIT_V(6); PG8_BAR; PG8_MMA(1, 1, At, B1); PG8_BAR;
            PG8_LDB(B0, 1, 0); PG8_SCHED; PG8_LDA(At, 1, 0); PG8_STAGE(PG8_SA(0, 1), a2 + hstep, voffA);
            PG8_WAIT_L(8); PG8_BAR; PG8_WAIT_L(0); PG8_MMA(0, 0, At, B0); PG8_BAR; PG8_SCHED;
            PG8_LDB(B1, 1, 1); PG8_STAGE(PG8_SB(1, 0), b3, voffB);
            PG8_BAR; PG8_WAIT_L(0); PG8_MMA(0, 1, At, B1); PG8_BAR;
            PG8_LDA(At, 1, 1); PG8_STAGE(PG8_SA(1, 0), a3, voffA);
            PG8_BAR; PG8_WAIT_L(0); PG8_MMA(1, 0, At, B0); PG8_BAR; PG8_SCHED;
            PG8_STAGE(PG8_SB(1, 1), b3 + hstep, voffB);
            PG8_WAIT_V(6); PG8_BAR; PG8_MMA(1, 1, At, B1); PG8_BAR;
            }
        }
        if constexpr (ALIGN_EPI) { if (wr == 0) PG8_BAR; }
        if constexpr (!Epi::AFTER_DRAIN) { E(acc, cur, wr, wc, fr, fq); S.done(cur); }
        if (!has_next) break;
#pragma unroll
        for (int a = 0; a < 2; ++a)
#pragma unroll
            for (int b = 0; b < 2; ++b)
#pragma unroll
                for (int m = 0; m < 4; ++m)
#pragma unroll
                    for (int n = 0; n < 2; ++n) acc[a][b][m][n] = (f32x4){0.f, 0.f, 0.f, 0.f};
        cur = nxt; cA = nA; cB = nB; ++ui;
        if constexpr (ALIGN_EPI) { if (wr == 1) PG8_BAR; }
    }
    PG8_WAIT_V(0);
    if constexpr (!ALIGN_EPI) { if (wr == 0) PG8_BAR; }
    PG8_BAR;
    if constexpr (Epi::AFTER_DRAIN) { E.fused(acc, cur, wr, wc, fr, fq, lds, wid, lane); S.done(cur); }
#undef PG8_SA
#undef PG8_SB
#undef PG8_STAGE
#undef PG8_LDA
#undef PG8_LDB
#undef PG8_MMA
#undef PG8_WAIT_V
#undef PG8_WAIT_L
#undef PG8_BAR
#undef PG8_SCHED
}
template <class Epi, class Sched, bool ALIGN_EPI = false, bool SP2 = false>
__device__ __forceinline__ void gemm_phase_i8(PG8_LAS unsigned char* lds, const Gemm g, const Sched& S, const Epi& E) {
    int tid_ = threadIdx.x; asm volatile("" : "+v"(tid_));
    const int tid = tid_, wid = __builtin_amdgcn_readfirstlane(tid >> 6), lane = tid & 63, wr = wid >> 2, wc = wid & 3, fr = lane & 15, fq = lane >> 4;
    const int K = g.K, nt = K / BK;
    unsigned voffA[2], voffB[2];
#pragma unroll
    for (int i = 0; i < 2; ++i) { int R, C; stage_rc(tid * 16 + i * 8192, R, C); const int Rb = Epi::PERM ? ((R & ~31) + perm32(R & 31)) : R;
        voffA[i] = (unsigned)(R * K + C) * 2u; voffB[i] = (unsigned)(Rb * K + C) * 2u; }
    const size_t kstep = (size_t)(BK * 2);
    const size_t hstep = (size_t)HALF * K * 2;
    const size_t tstep = 2 * hstep;
    const unsigned ldsw = (unsigned)wid * 1024u;
    const int aoff = lds_byte(wr * 64 + fr, fq * 8), boff = lds_byte(wc * 32 + fr, fq * 8);
#define PG8_SA(b, h) (((b) * 2 + (h)) * HTB)
#define PG8_SB(b, h) ((4 + (b) * 2 + (h)) * HTB)
#define PG8_STAGE(bufoff, gbase, voff) do { _Pragma("unroll") for (int _i = 0; _i < 2; ++_i) \
        __builtin_amdgcn_global_load_lds((const unsigned*)((const char*)(gbase) + (voff)[_i]), (PG8_LAS unsigned*)(lds + (bufoff) + ldsw + _i * 8192), 16, 0, 0); } while (0)
#define PG8_LDA(dst, b, h) do { _Pragma("unroll") for (int m = 0; m < 4; ++m) _Pragma("unroll") for (int k = 0; k < 2; ++k) dst[m][k] = *(const PG8_LAS bf16x8*)(lds + PG8_SA(b, h) + aoff + m * 2048 + k * 1024); } while (0)
#define PG8_LDB(dst, b, h) do { _Pragma("unroll") for (int n = 0; n < 2; ++n) _Pragma("unroll") for (int k = 0; k < 2; ++k) dst[n][k] = *(const PG8_LAS bf16x8*)(lds + PG8_SB(b, h) + boff + n * 2048 + k * 1024); } while (0)
#define PG8_MMA(ai, bj, At, Bt) do { __builtin_amdgcn_s_setprio(1); _Pragma("unroll") for (int m = 0; m < 4; ++m) _Pragma("unroll") for (int n = 0; n < 2; ++n) _Pragma("unroll") for (int k = 0; k < 2; ++k) \
        acc[ai][bj][m][n] = __builtin_amdgcn_mfma_i32_16x16x64_i8(__builtin_bit_cast(i32x4, Bt[n][k]), __builtin_bit_cast(i32x4, At[m][k]), acc[ai][bj][m][n], 0, 0, 0); __builtin_amdgcn_s_setprio(0); } while (0)
#define PG8_WAIT_V(n) asm volatile("s_waitcnt vmcnt(" #n ")" ::: "memory")
#define PG8_WAIT_L(n) asm volatile("s_waitcnt lgkmcnt(" #n ")" ::: "memory")
#define PG8_BAR __builtin_amdgcn_s_barrier()
#define PG8_SCHED __builtin_amdgcn_sched_barrier(0)
    Unit cur, nxt; int ui = 0;
    if (!S.next(0, cur)) return;
    i32x4 acc[2][2][4][2];
#pragma unroll
    for (int a = 0; a < 2; ++a)
#pragma unroll
        for (int b = 0; b < 2; ++b)
#pragma unroll
            for (int m = 0; m < 4; ++m)
#pragma unroll
                for (int n = 0; n < 2; ++n) acc[a][b][m][n] = (i32x4){0, 0, 0, 0};
    bf16x8 At[4][2], B0[2][2], B1[2][2];
    const char* cA = (const char*)g.A + (size_t)cur.pm * tstep; const char* cB = (const char*)g.Bt + (size_t)cur.pn * tstep;
    S.a_ready(cur);
    if constexpr (SP2) {
        PG8_STAGE(PG8_SB(0, 0), cB, voffB); PG8_STAGE(PG8_SB(0, 1), cB + hstep, voffB); PG8_STAGE(PG8_SA(0, 0), cA, voffA); PG8_STAGE(PG8_SA(0, 1), cA + hstep, voffA);
        if (wr == 1) PG8_BAR;
        PG8_WAIT_V(2); PG8_BAR;
        PG8_STAGE(PG8_SB(1, 0), cB + kstep, voffB); PG8_STAGE(PG8_SA(1, 0), cA + kstep, voffA); PG8_STAGE(PG8_SB(1, 1), cB + hstep + kstep, voffB);
        PG8_WAIT_V(6); PG8_BAR;
    } else {
        PG8_STAGE(PG8_SB(0, 0), cB, voffB); PG8_STAGE(PG8_SA(0, 0), cA, voffA); PG8_STAGE(PG8_SB(0, 1), cB + hstep, voffB); PG8_STAGE(PG8_SA(0, 1), cA + hstep, voffA);
        if (wr == 1) PG8_BAR;
        PG8_WAIT_V(4); PG8_BAR;
        PG8_STAGE(PG8_SB(1, 0), cB + kstep, voffB); PG8_STAGE(PG8_SA(1, 0), cA + kstep, voffA); PG8_STAGE(PG8_SB(1, 1), cB + hstep + kstep, voffB);
        PG8_WAIT_V(6); PG8_BAR;
    }
    for (;;) {
        const bool has_next = S.next(ui + 1, nxt);
        const char* nA = has_next ? (const char*)g.A + (size_t)nxt.pm * tstep : cA; const char* nB = has_next ? (const char*)g.Bt + (size_t)nxt.pn * tstep : cB;
        for (int t = 0; t < nt; t += 2) {
            const bool last = (t == nt - 2);
            const char* a1 = cA + (size_t)(t + 1) * kstep;
            const char* a2 = last ? nA : cA + (size_t)(t + 2) * kstep; const char* b2 = last ? nB : cB + (size_t)(t + 2) * kstep;
            const char* a3 = a2 + kstep; const char* b3 = b2 + kstep;
            if (last && has_next) S.a_ready(nxt);
            if constexpr (SP2) {
            PG8_LDB(B0, 0, 0); PG8_LDB(B1, 0, 1); PG8_SCHED; PG8_LDA(At, 0, 0); PG8_STAGE(PG8_SA(1, 1), a1 + hstep, voffA);
            PG8_WAIT_V(8); PG8_WAIT_L(0); PG8_BAR; PG8_MMA(0, 0, At, B0); PG8_MMA(0, 1, At, B1); PG8_BAR; PG8_SCHED;
            PG8_LDA(At, 0, 1); PG8_STAGE(PG8_SB(0, 0), b2, voffB); PG8_STAGE(PG8_SB(0, 1), b2 + hstep, voffB); PG8_STAGE(PG8_SA(0, 0), a2, voffA);
            PG8_WAIT_V(8); PG8_WAIT_L(0); PG8_BAR; PG8_MMA(1, 0, At, B0); PG8_MMA(1, 1, At, B1); PG8_BAR; PG8_SCHED;
            PG8_LDB(B0, 1, 0); PG8_LDB(B1, 1, 1); PG8_SCHED; PG8_LDA(At, 1, 0); PG8_STAGE(PG8_SA(0, 1), a2 + hstep, voffA);
            PG8_WAIT_V(8); PG8_WAIT_L(0); PG8_BAR; PG8_MMA(0, 0, At, B0); PG8_MMA(0, 1, At, B1); PG8_BAR; PG8_SCHED;
            PG8_LDA(At, 1, 1); PG8_STAGE(PG8_SB(1, 0), b3, voffB); PG8_STAGE(PG8_SB(1, 1), b3 + hstep, voffB); PG8_STAGE(PG8_SA(1, 0), a3, voffA);
            PG8_WAIT_V(8); PG8_WAIT_L(0); PG8_BAR; PG8_MMA(1, 0, At, B0); PG8_MMA(1, 1, At, B1); PG8_BAR; PG8_SCHED;
            } else {
            PG8_LDB(B0, 0, 0); PG8_SCHED; PG8_LDA(At, 0, 0); PG8_STAGE(PG8_SA(1, 1), a1 + hstep, voffA);
            PG8_WAIT_L(8); PG8_BAR; PG8_WAIT_L(0); PG8_MMA(0, 0, At, B0); PG8_BAR; PG8_SCHED;
            PG8_LDB(B1, 0, 1); PG8_STAGE(PG8_SB(0, 0), b2, voffB);
            PG8_BAR; PG8_WAIT_L(0); PG8_MMA(0, 1, At, B1); PG8_BAR;
            PG8_LDA(At, 0, 1); PG8_STAGE(PG8_SA(0, 0), a2, voffA);
            PG8_BAR; PG8_WAIT_L(0); PG8_MMA(1, 0, At, B0); PG8_BAR; PG8_SCHED;
            PG8_STAGE(PG8_SB(0, 1), b2 + hstep, voffB);
            PG8_WAIT_V(6); PG8_BAR; PG8_MMA(1, 1, At, B1); PG8_BAR;
            PG8_LDB(B0, 1, 0); PG8_SCHED; PG8_LDA(At, 1, 0); PG8_STAGE(PG8_SA(0, 1), a2 + hstep, voffA);
            PG8_WAIT_L(8); PG8_BAR; PG8_WAIT_L(0); PG8_MMA(0, 0, At, B0); PG8_BAR; PG8_SCHED;
            PG8_LDB(B1, 1, 1); PG8_STAGE(PG8_SB(1, 0), b3, voffB);
            PG8_BAR; PG8_WAIT_L(0); PG8_MMA(0, 1, At, B1); PG8_BAR;
            PG8_LDA(At, 1, 1); PG8_STAGE(PG8_SA(1, 0), a3, voffA);
            PG8_BAR; PG8_WAIT_L(0); PG8_MMA(1, 0, At, B0); PG8_BAR; PG8_SCHED;
            PG8_STAGE(PG8_SB(1, 1), b3 + hstep, voffB);
            PG8_WAIT_V(6); PG8_BAR; PG8_MMA(1, 1, At, B1); PG8_BAR;
            }
        }
        if constexpr (ALIGN_EPI) { if (wr == 0) PG8_BAR; }
        if constexpr (!Epi::AFTER_DRAIN) { E(acc, cur, wr, wc, fr, fq); S.done(cur); }
        if (!has_next) break;
#pragma unroll
        for (int a = 0; a < 2; ++a)
#pragma unroll
            for (int b = 0; b < 2; ++b)
#pragma unroll
                for (int m = 0; m < 4; ++m)
#pragma unroll
                    for (int n = 0; n < 2; ++n) acc[a][b][m][n] = (i32x4){0, 0, 0, 0};
        cur = nxt; cA = nA; cB = nB; ++ui;
        if constexpr (ALIGN_EPI) { if (wr == 1) PG8_BAR; }
    }
    PG8_WAIT_V(0);
    if constexpr (!ALIGN_EPI) { if (wr == 0) PG8_BAR; }
    PG8_BAR;
    if constexpr (Epi::AFTER_DRAIN) { E.fused(acc, cur, wr, wc, fr, fq, lds, wid, lane); S.done(cur); }
#undef PG8_SA
#undef PG8_SB
#undef PG8_STAGE
#undef PG8_LDA
#undef PG8_LDB
#undef PG8_MMA
#undef PG8_WAIT_V
#undef PG8_WAIT_L
#undef PG8_BAR
#undef PG8_SCHED
}
}
namespace attn_body {
using bf16=__hip_bfloat16;
using bf16x8=__attribute__((ext_vector_type(8)))short;
using s16x4=__attribute__((ext_vector_type(4)))short;
using f32x16=__attribute__((ext_vector_type(16)))float;
using u32x4=__attribute__((ext_vector_type(4)))unsigned;
using f32x4k=__attribute__((ext_vector_type(4)))float;
constexpr int BATCH=16,NHEAD=8,TPAD=4160,D=64,DM=NHEAD*D;
constexpr int NW=8,QBLK=32,QB=QBLK*NW,KVBLK=64,NQB=16;
constexpr int ATTN_PITCH=DM, ATTN_UNIT_ROWS=QB;
__device__ __forceinline__ int crow(int r,int hi){return (r&3)+8*(r>>2)+4*hi;}
#define SBAR() __builtin_amdgcn_sched_barrier(0)
__device__ __forceinline__ void cmask(f32x16&p0,f32x16&p1,int jb,int qrel,int hi){
  const float NEG=-INFINITY; int kb=64*jb+4*hi;
  #pragma unroll
  for(int r=0;r<16;++r){int kv=kb+(r&3)+8*(r>>2); if(kv>qrel)p0[r]=NEG; if(kv+32>qrel)p1[r]=NEG;}
}

constexpr int NSLOT=3, SLOTB=8192;
constexpr int LDS_K=0, LDS_V=NSLOT*SLOTB, LDS_WS=2*NSLOT*SLOTB, LDS_OST=LDS_WS+NW*64*4, LDS_KB=LDS_OST+NW*4096, LDS_BYTES=LDS_KB+TPAD*4;
constexpr float C2=0.125f*1.4426950408889634f;
__device__ __forceinline__ void glds16(const void*gsrc,unsigned lds_dst){unsigned keep;
  asm volatile("s_mov_b32 %0, m0\n\ts_mov_b32 m0, %2\n\ts_nop 0\n\tglobal_load_lds_dwordx4 %1, off\n\ts_mov_b32 m0, %0":"=&s"(keep):"v"(gsrc),"s"(lds_dst):"memory");}
__device__ __forceinline__ float max3f(float a,float b,float c){float r;asm("v_max3_f32 %0, %1, %2, %3":"=v"(r):"v"(a),"v"(b),"v"(c));return r;}
__device__ __forceinline__ float max2f(float a,float b){float r;asm("v_max_f32_e32 %0, %1, %2":"=v"(r):"v"(a),"v"(b));return r;}
__device__ __forceinline__ float fadd_s(float a,float b){float r;asm("v_add_f32_e32 %0, %1, %2":"=v"(r):"v"(a),"v"(b));return r;}
__device__ __forceinline__ float fsub_s(float a,float b){float r;asm("v_sub_f32_e32 %0, %1, %2":"=v"(r):"v"(a),"v"(b));return r;}
typedef float f32x2_t __attribute__((ext_vector_type(2))); typedef __bf16 bf16x2_t __attribute__((ext_vector_type(2)));
__device__ __forceinline__ unsigned cvtpk_s(float lo,float hi){f32x2_t v={lo,hi};bf16x2_t b=__builtin_convertvector(v,bf16x2_t);return __builtin_bit_cast(unsigned,b);}
#define WAIT_BAR(N) asm volatile("s_waitcnt vmcnt(" #N ") lgkmcnt(0)\n\ts_barrier":::"memory")

__device__ __forceinline__ void qkt(f32x16&p0,f32x16&p1,const char*Kslot,const bf16x8*qr,int r32,int hi){
  const char*kb=Kslot+hi*1024+r32*16;
  #pragma unroll
  for(int d0=0;d0<4;++d0){
    const bf16x8 b0=*reinterpret_cast<const bf16x8*>(kb+d0*2048);
    const bf16x8 b1=*reinterpret_cast<const bf16x8*>(kb+d0*2048+512);
    {p0=__builtin_amdgcn_mfma_f32_32x32x16_bf16(b0,qr[d0],p0,0,0,0);p1=__builtin_amdgcn_mfma_f32_32x32x16_bf16(b1,qr[d0],p1,0,0,0);}}
}
typedef __attribute__((address_space(3))) const char* lds_cptr;
typedef short v4i16_t __attribute__((ext_vector_type(4)));
__device__ __forceinline__ void kload8(bf16x8*kf,lds_cptr kp){
  kf[0]=*(const __attribute__((address_space(3))) bf16x8*)(kp);      kf[1]=*(const __attribute__((address_space(3))) bf16x8*)(kp+512);
  kf[2]=*(const __attribute__((address_space(3))) bf16x8*)(kp+2048); kf[3]=*(const __attribute__((address_space(3))) bf16x8*)(kp+2560);
  kf[4]=*(const __attribute__((address_space(3))) bf16x8*)(kp+4096); kf[5]=*(const __attribute__((address_space(3))) bf16x8*)(kp+4608);
  kf[6]=*(const __attribute__((address_space(3))) bf16x8*)(kp+6144); kf[7]=*(const __attribute__((address_space(3))) bf16x8*)(kp+6656);
}
__device__ __forceinline__ void kload2(bf16x8*kf,lds_cptr kp,int j){ kf[2*j]=*(const __attribute__((address_space(3))) bf16x8*)(kp+j*2048); kf[2*j+1]=*(const __attribute__((address_space(3))) bf16x8*)(kp+j*2048+512); }
__device__ __forceinline__ s16x4 vtr(lds_cptr p){ return __builtin_bit_cast(s16x4,__builtin_amdgcn_ds_read_tr16_b64_v4i16((__attribute__((address_space(3))) v4i16_t*)p)); }
__device__ __forceinline__ float rowmax(const f32x16&p0,const f32x16&p1){
  float a=max3f(p0[0],p0[1],p1[0]),b=max3f(p0[2],p0[3],p1[1]);a=max3f(a,p1[2],p1[3]);
  #pragma unroll
  for(int r=4;r<16;r+=4){a=max3f(a,p0[r],p0[r+1]);b=max3f(b,p0[r+2],p0[r+3]);a=max3f(a,p1[r],p1[r+1]);b=max3f(b,p1[r+2],p1[r+3]);}
  const float m=max2f(a,b);
  auto rr=__builtin_amdgcn_permlane32_swap(__float_as_uint(m),__float_as_uint(m),false,false);
  return max2f(__uint_as_float(rr[0]),__uint_as_float(rr[1]));
}
__device__ __forceinline__ void pv(f32x16*o,int vb,bf16x8 pa0,bf16x8 pa1,bf16x8 pa2,bf16x8 pa3){
  #pragma unroll
  for(int d0=0;d0<2;++d0){s16x4 lo[4],hi[4];
    #pragma unroll
    for(int ks=0;ks<4;++ks){
      asm volatile("ds_read_b64_tr_b16 %0,%1 offset:%c2":"=&v"(lo[ks]):"v"(vb),"i"(d0*4096+ks*1024):"memory");
      asm volatile("ds_read_b64_tr_b16 %0,%1 offset:%c2":"=&v"(hi[ks]):"v"(vb),"i"(d0*4096+ks*1024+512):"memory");}
    asm volatile("s_waitcnt lgkmcnt(0)":::"memory");SBAR();
    #define PK(k) (bf16x8){lo[k][0],lo[k][1],lo[k][2],lo[k][3],hi[k][0],hi[k][1],hi[k][2],hi[k][3]}
    o[d0]=__builtin_amdgcn_mfma_f32_32x32x16_bf16(pa0,PK(0),o[d0],0,0,0);
    o[d0]=__builtin_amdgcn_mfma_f32_32x32x16_bf16(pa1,PK(1),o[d0],0,0,0);
    o[d0]=__builtin_amdgcn_mfma_f32_32x32x16_bf16(pa2,PK(2),o[d0],0,0,0);
    o[d0]=__builtin_amdgcn_mfma_f32_32x32x16_bf16(pa3,PK(3),o[d0],0,0,0);
    #undef PK
  }
}

#ifndef ATTN_STORE16
#define ATTN_STORE16(p,v) (*(u32x4*)(p)=(v))
#endif
template<int THRL> __device__ __forceinline__ void attn_unit(int b,int h,int qb,const bf16*Q,const bf16*__restrict__ K,const bf16*__restrict__ V,bf16*O,char*shm){
  int tid_=threadIdx.x; asm volatile("":"+v"(tid_)); const int tid=tid_,lane=tid&63,r32=lane&31,hi=lane>>5; const int wid=__builtin_amdgcn_readfirstlane(tid>>6);
  const long rowbase=(long)b*TPAD; const int q0=64+qb*QB;
  const bf16*Qw=Q+(rowbase+q0+wid*QBLK)*DM+h*D;
  const bf16*Kh=K+rowbase*DM+h*D,*Vh=V+rowbase*DM+h*D;
  const unsigned lds0=(unsigned)(uintptr_t)shm;
  float*wsf=(float*)(shm+LDS_WS)+wid*64;
  const bf16*ksrc=Kh+(long)lane*DM+wid*8;
  const bf16*vsrc=Vh+(long)(16*(wid&3)+(lane>>2))*DM+(wid>>2)*32+(lane&3)*8;
  const unsigned kdst=lds0+LDS_K+wid*1024, vdst=lds0+LDS_V+wid*1024;
  #define DMA_K(t,slot) glds16(ksrc+(long)(t)*KVBLK*DM,(unsigned)__builtin_amdgcn_readfirstlane(kdst+(slot)))
  #define DMA_V(t,slot) glds16(vsrc+(long)(t)*KVBLK*DM,(unsigned)__builtin_amdgcn_readfirstlane(vdst+(slot)))
  const int vb0=(int)(lds0+LDS_V)+((lane>>4)&1)*32+(lane&3)*8+(4*hi+((lane&15)>>2))*64;
  const char*Kbase=shm+LDS_K; bf16x8 kf[8];
  const lds_cptr shm3=(lds_cptr)shm; const lds_cptr kp0=shm3+LDS_K+hi*1024+r32*16; const lds_cptr vp0=shm3+LDS_V+((lane>>4)&1)*32+(lane&3)*8+(4*hi+((lane&15)>>2))*64;
  const int NT=(q0+QB)/KVBLK;
  typedef __attribute__((address_space(3))) const f32x4k* lds_f4p; const __attribute__((address_space(3))) float* kbp0=(const __attribute__((address_space(3))) float*)(shm3+LDS_KB)+4*hi;
  #define KBINIT(C0,C1,t) do{ const __attribute__((address_space(3))) float* kp_=kbp0+(t)*64; _Pragma("unroll") for(int g_=0;g_<4;++g_){ const f32x4k a_=*(lds_f4p)(kp_+8*g_); const f32x4k b_=*(lds_f4p)(kp_+32+8*g_); _Pragma("unroll") for(int e_=0;e_<4;++e_){ C0[4*g_+e_]=a_[e_]-mhat; C1[4*g_+e_]=b_[e_]-mhat; } } }while(0)
  DMA_K(0,0);DMA_V(0,0);DMA_K(1,SLOTB);
  bf16x8 qr[4];
  #pragma unroll
  for(int d0=0;d0<4;++d0)qr[d0]=*reinterpret_cast<const bf16x8*>(&Qw[(long)r32*DM+d0*16+hi*8]);
  float mhat=0.f,l_reg=0.f;f32x16 o[2];o[0]=f32x16{};o[1]=f32x16{};
  const int qrel=wid*QBLK+r32;
  #define CMASK(P0,P1,t) do{int jb_=(t)-(NT-4); if(jb_>=0)cmask(P0,P1,jb_,qrel,hi);}while(0)
  bool resc=false;
  #define START(P0,P1) do{ const float rm=rowmax(P0,P1); resc=false; \
    { const float dl=rm; mhat=fadd_s(mhat,dl); \
      _Pragma("unroll") for(int r=0;r<16;++r){P0[r]=fsub_s(P0[r],dl);P1[r]=fsub_s(P1[r],dl);} } \
    _Pragma("unroll") for(int r=0;r<16;++r)P0[r]=__builtin_amdgcn_exp2f(P0[r]); }while(0)
  #define RESC() do{ if(resc){ asm volatile("s_waitcnt lgkmcnt(0)":::"memory"); \
      _Pragma("unroll") for(int d_=0;d_<2;++d_) _Pragma("unroll") for(int r=0;r<16;++r)o[d_][r]*=wsf[crow(r,hi)]; } }while(0)
  f32x16 pA0,pA1,pB0,pB1;
  int sl_prev=0,sl_cur=0,sl_next=SLOTB;
  #define ROT() do{sl_prev=sl_cur;sl_cur=sl_next;sl_next=(sl_next==(NSLOT-1)*SLOTB)?0:sl_next+SLOTB;}while(0)
  DMA_K(2,2*SLOTB);
  WAIT_BAR(3);
  KBINIT(pA0,pA1,0); qkt(pA0,pA1,Kbase,qr,r32,hi);asm volatile("s_nop 15\n\ts_nop 7":"+v"(pA0),"+v"(pA1));CMASK(pA0,pA1,0);
  START(pA0,pA1);
  _Pragma("unroll") for(int r=0;r<16;++r)pA1[r]=__builtin_amdgcn_exp2f(pA1[r]);
  WAIT_BAR(0);
  DMA_K(3,0);DMA_V(1,SLOTB);
  ROT();
  kload8(kf,kp0+sl_cur);
  WAIT_BAR(2);
  s16x4 vlo[8],vhi[8]; u32x4 pw0,pw1,pw2,pw3;
  #define PKW(P,B) cvtpk_s(P[B],P[B+1])
  #define PAF(k) __builtin_bit_cast(bf16x8,pw##k)
  #define VFR(i) (bf16x8){vlo[i][0],vlo[i][1],vlo[i][2],vlo[i][3],vhi[i][0],vhi[i][1],vhi[i][2],vhi[i][3]}
  #define PIN(x) asm volatile("":"+v"(x))
  #define MX3(a,b,c) __builtin_fmaxf(__builtin_fmaxf((a),(b)),(c))
  #define GAPA(MF,A0,A1,A2,A3,W0,W1,PW) do{ MF; sacc+=A0; sacc+=A1; sacc+=A2; sacc+=A3; PIN(sacc); W0; W1; PIN(PW); SBAR(); }while(0)
  #define EX(v) __builtin_amdgcn_exp2f(v)
  #define GAPB(MF,X,B) do{ MF; X[B]=EX(X[B]); X[B+1]=EX(X[B+1]); X[B+2]=EX(X[B+2]); X[B+3]=EX(X[B+3]); PIN(X); SBAR(); }while(0)
  #define VRD(i) do{ vlo[i]=vtr(vp_+(((i)>>2)*4096+((i)&3)*1024)); vhi[i]=vtr(vp_+(((i)>>2)*4096+((i)&3)*1024+512)); }while(0)
  #define KRD(G,j) do{ if(G){ kload2(kf,kp0+sl_next,j); SBAR(); } }while(0)
  #define STEP(C0,C1,P0,P1,t,GK,GV,GL) do{ SBAR(); \
    const lds_cptr vp_=vp0+sl_prev; \
    KBINIT(C0,C1,t); SBAR(); \
    VRD(0); SBAR(); float sacc=(P0[0]+P0[1]); \
    GAPA(C0=__builtin_amdgcn_mfma_f32_32x32x16_bf16(kf[0],qr[0],C0,0,0,0), P0[2],P0[3],P0[4],P0[5],     pw0[0]=PKW(P0,0), pw0[1]=PKW(P0,2), pw0); \
    VRD(4); SBAR(); GAPA(C1=__builtin_amdgcn_mfma_f32_32x32x16_bf16(kf[1],qr[0],C1,0,0,0), P0[6],P0[7],P0[8],P0[9],     pw0[2]=PKW(P0,4), pw0[3]=PKW(P0,6), pw0); \
    VRD(1); SBAR(); GAPA(C0=__builtin_amdgcn_mfma_f32_32x32x16_bf16(kf[2],qr[1],C0,0,0,0),   P0[10],P0[11],P0[12],P0[13], pw1[0]=PKW(P0,8), pw1[1]=PKW(P0,10), pw1); \
    VRD(5); SBAR(); GAPA(C1=__builtin_amdgcn_mfma_f32_32x32x16_bf16(kf[3],qr[1],C1,0,0,0),   P0[14],P0[15],P1[0],P1[1],   pw1[2]=PKW(P0,12),pw1[3]=PKW(P0,14), pw1); \
    VRD(2); SBAR(); GAPA(C0=__builtin_amdgcn_mfma_f32_32x32x16_bf16(kf[4],qr[2],C0,0,0,0),   P1[2],P1[3],P1[4],P1[5],     pw2[0]=PKW(P1,0), pw2[1]=PKW(P1,2), pw2); \
    VRD(6); SBAR(); GAPA(C1=__builtin_amdgcn_mfma_f32_32x32x16_bf16(kf[5],qr[2],C1,0,0,0),   P1[6],P1[7],P1[8],P1[9],     pw2[2]=PKW(P1,4), pw2[3]=PKW(P1,6), pw2); \
    VRD(3); SBAR(); GAPA(C0=__builtin_amdgcn_mfma_f32_32x32x16_bf16(kf[6],qr[3],C0,0,0,0),   P1[10],P1[11],P1[12],P1[13], pw3[0]=PKW(P1,8), pw3[1]=PKW(P1,10), pw3); \
    VRD(7); SBAR(); GAPA(C1=__builtin_amdgcn_mfma_f32_32x32x16_bf16(kf[7],qr[3],C1,0,0,0),   P1[14],P1[15],0.f,0.f,       pw3[2]=PKW(P1,12),pw3[3]=PKW(P1,14), pw3); \
    l_reg+=sacc; \
    if(GK){DMA_K((t)+3,sl_cur);} if(GV){DMA_V((t)+1,sl_next);} \
    CMASK(C0,C1,t); \
    { float a=MX3(C0[0],C0[1],C1[0]),b=MX3(C0[2],C0[3],C1[1]); a=MX3(a,C1[2],C1[3]); \
      _Pragma("unroll") for(int r=4;r<16;r+=4){a=MX3(a,C0[r],C0[r+1]);b=MX3(b,C0[r+2],C0[r+3]);a=MX3(a,C1[r],C1[r+1]);b=MX3(b,C1[r+2],C1[r+3]);} \
      float rm=__builtin_fmaxf(a,b); { auto rr=__builtin_amdgcn_permlane32_swap(__float_as_uint(rm),__float_as_uint(rm),false,false); rm=__builtin_fmaxf(__uint_as_float(rr[0]),__uint_as_float(rr[1])); } \
      resc=false; \
      if(__builtin_expect(__any(rm>(float)THRL),0)){ const float dl=__builtin_fmaxf(rm,0.f); mhat+=dl; \
        _Pragma("unroll") for(int r=0;r<16;++r){C0[r]-=dl;C1[r]-=dl;} \
        const float f=__builtin_amdgcn_exp2f(-dl); l_reg*=f; if(hi==0)wsf[r32]=f; resc=true; } } \
    SBAR(); \
    GAPB(o[0]=__builtin_amdgcn_mfma_f32_32x32x16_bf16(PAF(0),VFR(0),o[0],0,0,0), C0,0); \
    GAPB(o[1]=__builtin_amdgcn_mfma_f32_32x32x16_bf16(PAF(0),VFR(4),o[1],0,0,0), C0,4); \
    KRD(GL,0); GAPB(o[0]=__builtin_amdgcn_mfma_f32_32x32x16_bf16(PAF(1),VFR(1),o[0],0,0,0), C0,8); \
    KRD(GL,1); GAPB(o[1]=__builtin_amdgcn_mfma_f32_32x32x16_bf16(PAF(1),VFR(5),o[1],0,0,0), C0,12); \
    KRD(GL,2); GAPB(o[0]=__builtin_amdgcn_mfma_f32_32x32x16_bf16(PAF(2),VFR(2),o[0],0,0,0), C1,0); \
    KRD(GL,3); GAPB(o[1]=__builtin_amdgcn_mfma_f32_32x32x16_bf16(PAF(2),VFR(6),o[1],0,0,0), C1,4); \
    GAPB(o[0]=__builtin_amdgcn_mfma_f32_32x32x16_bf16(PAF(3),VFR(3),o[0],0,0,0), C1,8); \
    GAPB(o[1]=__builtin_amdgcn_mfma_f32_32x32x16_bf16(PAF(3),VFR(7),o[1],0,0,0), C1,12); \
    }while(0)
  int t=1;
  #undef CMASK
  #define CMASK(P0,P1,t) do{}while(0)
  for(;t+5<NT;t+=2){
    STEP(pB0,pB1,pA0,pA1,t,true,true,true);     WAIT_BAR(2); RESC(); ROT();
    STEP(pA0,pA1,pB0,pB1,t+1,true,true,true);   WAIT_BAR(2); RESC(); ROT();
  }
  #undef CMASK
  #define CMASK(P0,P1,t) do{int jb_=(t)-(NT-4); if(jb_>=0)cmask(P0,P1,jb_,qrel,hi);}while(0)
  #define ENDW(tt) do{ if((tt)+3<NT){WAIT_BAR(2);} else if((tt)+2<NT){WAIT_BAR(1);} else {WAIT_BAR(0);} }while(0)
  for(;t+1<NT;t+=2){
    STEP(pB0,pB1,pA0,pA1,t,(t+3<NT),(t+1<NT),(t+1<NT));       ENDW(t);   RESC(); ROT();
    STEP(pA0,pA1,pB0,pB1,t+1,(t+4<NT),(t+2<NT),(t+2<NT));     ENDW(t+1); RESC(); ROT();
  }
  { float sacc=pA0[0]+pA0[1]; _Pragma("unroll") for(int r=2;r<16;++r)sacc+=pA0[r]; _Pragma("unroll") for(int r=0;r<16;++r)sacc+=pA1[r]; l_reg+=sacc;
    pw0=(u32x4){PKW(pA0,0),PKW(pA0,2),PKW(pA0,4),PKW(pA0,6)};pw1=(u32x4){PKW(pA0,8),PKW(pA0,10),PKW(pA0,12),PKW(pA0,14)};pw2=(u32x4){PKW(pA1,0),PKW(pA1,2),PKW(pA1,4),PKW(pA1,6)};pw3=(u32x4){PKW(pA1,8),PKW(pA1,10),PKW(pA1,12),PKW(pA1,14)};
    SBAR(); pv(o,vb0+sl_prev,PAF(0),PAF(1),PAF(2),PAF(3)); }
  #undef PKW
  #undef PAF
  #undef VFR
  #undef PIN
  #undef MX3
  #undef GAPA
  #undef GAPB
  #undef EX
  #undef VRD
  #undef KRD
  #undef STEP
  #undef ENDW
  {auto rr=__builtin_amdgcn_permlane32_swap(__float_as_uint(l_reg),__float_as_uint(l_reg),false,false);l_reg=__uint_as_float(rr[0])+__uint_as_float(rr[1]);}
  if(hi==0)wsf[32+r32]=l_reg;asm volatile("s_waitcnt lgkmcnt(0)":::"memory");
  float rli[16];
  #pragma unroll
  for(int r=0;r<16;++r)rli[r]=__builtin_amdgcn_rcpf(wsf[32+crow(r,hi)]);
  bf16*Ow=O+(rowbase+q0+wid*QBLK)*DM+h*D;
  { bf16*stg=(bf16*)(shm+LDS_OST)+wid*2048;
    #pragma unroll
    for(int r=0;r<16;++r){const int orow=crow(r,hi);
      #pragma unroll
      for(int d0=0;d0<2;++d0)stg[orow*64+d0*32+r32]=__float2bfloat16(o[d0][r]*rli[r]);}
    asm volatile("s_waitcnt lgkmcnt(0)":::"memory");
    #pragma unroll
    for(int i=0;i<4;++i){const int row=i*8+(lane>>3),ch=lane&7; const u32x4 v=*(const u32x4*)(stg+row*64+ch*8); ATTN_STORE16(Ow+(long)row*DM+ch*8,v);} }
  asm volatile("s_waitcnt lgkmcnt(0)\n\ts_barrier":::"memory");
  #undef DMA_K
  #undef DMA_V
  #undef CMASK
  #undef START
  #undef RESC
  #undef ROT
  #undef KBINIT
}
constexpr int ATTN_LDS_BYTES=LDS_BYTES;
#undef SBAR
#undef WAIT_BAR
}

#define LAS __attribute__((address_space(3)))
typedef unsigned short bf16;
typedef unsigned v4u __attribute__((ext_vector_type(4)));
typedef unsigned v2u __attribute__((ext_vector_type(2)));
typedef float f32x4 __attribute__((ext_vector_type(4)));
typedef short bf16x8 __attribute__((ext_vector_type(8)));
typedef float f32x16v __attribute__((ext_vector_type(16)));

constexpr int NB = 16, SEQ = 4096, DMODEL = 1024, NMETA = 16;
constexpr int TP = 4160;
constexpr int R = NB * TP;
constexpr int NTOK = NB * SEQ;
constexpr int N1 = 5632;
constexpr int IN_COLS = 5416;
constexpr int NWAVES = 8, NTHREADS = 512;
constexpr float NORM_EPS = 1e-6f, GN_EPS = 64e-5f;
constexpr float LOG2E = 1.4426950408889634f;

constexpr size_t MiB = 1u << 20;
constexpr size_t U65 = 65 * MiB;
constexpr size_t WS_WTIN = 1 * MiB;
constexpr size_t WS_WTQ = 12 * MiB;
constexpr size_t WS_WTFOX = 16 * MiB;
constexpr size_t WS_WTRWKV = 17 * MiB;
constexpr size_t WS_WTOUT = 18 * MiB;
constexpr size_t WS_WTWA = 20 * MiB;
constexpr size_t WS_WTG = 20 * MiB + 512 * 1024;
constexpr size_t WS_KS = 21 * MiB;
constexpr size_t WS_KB = 22 * MiB;
constexpr size_t WS_LF = 25 * MiB;
constexpr size_t WS_BS = 29 * MiB;
constexpr size_t WS_SXN = 28 * MiB;
constexpr size_t WS_SWIN = 9 * MiB;
constexpr size_t WS_SWQ = 15 * MiB;
constexpr size_t WS_U8 = 32 * MiB;
constexpr size_t WS_SU = 48 * MiB;
constexpr size_t WS_V8 = 64 * MiB;
constexpr size_t WS_SV = 80 * MiB;
constexpr size_t WS_CORR = 81 * MiB;
constexpr size_t WS_SX = 82 * MiB;
constexpr size_t WS_XQ = 352 * MiB;
constexpr size_t WS_F = 96 * MiB;
constexpr size_t WS_FQ = WS_F, WS_FK = WS_F + U65, WS_FV = WS_F + 2 * U65, WS_ZRR = WS_F + 3 * U65, WS_ZRK = WS_F + 4 * U65, WS_ZRV = WS_F + 5 * U65, WS_ZM = WS_F + 6 * U65;
constexpr size_t WS_ZG = WS_F + 7 * U65;
constexpr size_t WS_XN = WS_ZG + 4 * U65;
constexpr size_t WS_IDS = 941 * MiB;
constexpr size_t WS_GATES = 973 * MiB;
constexpr size_t WS_END = 1005 * MiB;
constexpr size_t WS_LA = WS_XN;
constexpr size_t WS_LG = WS_XN + 20 * MiB;
constexpr size_t WS_KP = WS_XN;
constexpr size_t WS_KN = WS_XN + U65;
constexpr size_t WS_Y = WS_ZM;
constexpr size_t WS_MIX = WS_XN;
constexpr size_t WS_XN2 = WS_XN;
constexpr size_t WS_PQ = WS_F;
constexpr size_t DO_XW = 0, DO_AA = U65, DO_GG = 2 * U65;

__device__ __forceinline__ unsigned f2bf(float f) { unsigned u = __builtin_bit_cast(unsigned, f); return (u + 0x7fffu + ((u >> 16) & 1u)) >> 16; }
__device__ __forceinline__ unsigned pk2(float lo, float hi) { return f2bf(lo) | (f2bf(hi) << 16); }
__device__ __forceinline__ float bflo(unsigned w) { return __builtin_bit_cast(float, w << 16); }
__device__ __forceinline__ float bfhi(unsigned w) { return __builtin_bit_cast(float, w & 0xffff0000u); }
__device__ __forceinline__ void unpack8(const v4u w, float (&f)[8]) { f[0] = bflo(w.x); f[1] = bfhi(w.x); f[2] = bflo(w.y); f[3] = bfhi(w.y); f[4] = bflo(w.z); f[5] = bfhi(w.z); f[6] = bflo(w.w); f[7] = bfhi(w.w); }
__device__ __forceinline__ v4u pack8(const float (&f)[8]) { v4u w; w.x = pk2(f[0], f[1]); w.y = pk2(f[2], f[3]); w.z = pk2(f[4], f[5]); w.w = pk2(f[6], f[7]); return w; }
__device__ __forceinline__ float sigmoidf_(float x) { return __builtin_amdgcn_rcpf(1.0f + __builtin_amdgcn_exp2f(-x * LOG2E)); }
__device__ __forceinline__ float wave_sum(float v) {
#pragma unroll
    for (int o = 1; o < 64; o <<= 1) v += __shfl_xor(v, o);
    return v;
}
__device__ __forceinline__ float sum8(float v) { v += __shfl_xor(v, 1); v += __shfl_xor(v, 2); v += __shfl_xor(v, 4); return v; }

struct Params {
    const float* in[27];
    float* out;
    unsigned char* ws;
};
enum { I_X = 0, I_META, I_N1G, I_WIN, I_FQN, I_FKN, I_FBIAS, I_MU, I_W0, I_WUP, I_A0, I_AUP, I_GUP, I_KK, I_KA, I_RK, I_LNG, I_LNB, I_WFOX, I_WRWKV, I_WOUT, I_N2G, I_PWQ, I_SK1, I_SK2, I_PU, I_PV };

__device__ __forceinline__ int win_src_col(int n) {
    if (n < 1536) return n;
    if (n < 3072) return 1544 + (n - 1536);
    if (n < 3584) { const int m = n - 3072; if (m < 288) return 3080 + m; if (m < 296) return 1536 + (m - 288); return -1; }
    return 3368 + (n - 3584);
}
template <bool REMAP>
__device__ __forceinline__ void transpose_item(const float* W, int ldw, int K, int N, bf16* WT, LAS float* scr, int item, int lane) {
    const int nblk = N / 32, kb = item / nblk, nb = item % nblk, k0 = 64 * kb, n0 = 32 * nb;
    const int n = n0 + (lane & 31); const int sc = REMAP ? win_src_col(n) : n;
#pragma unroll 8
    for (int i = 0; i < 32; ++i) { const int kk = 2 * i + (lane >> 5); scr[kk * 33 + (lane & 31)] = (sc >= 0) ? W[(size_t)(k0 + kk) * ldw + sc] : 0.f; }
    asm volatile("s_waitcnt lgkmcnt(0)" ::: "memory");
    const int c = lane & 7;
#pragma unroll
    for (int j = 0; j < 4; ++j) { const int nn = (lane >> 3) + 8 * j; const LAS float* s = scr + (8 * c) * 33 + nn;
        v4u o; o.x = pk2(s[0 * 33], s[1 * 33]); o.y = pk2(s[2 * 33], s[3 * 33]); o.z = pk2(s[4 * 33], s[5 * 33]); o.w = pk2(s[6 * 33], s[7 * 33]);
        *(v4u*)(WT + (size_t)(n0 + nn) * K + k0 + 8 * c) = o; }
    asm volatile("s_waitcnt lgkmcnt(0)" ::: "memory");
}
template <bool REMAP>
__device__ __forceinline__ void transpose_q8_item(const float* W, int ldw, unsigned char* WT8, float* SW, LAS float* scr, LAS float* cmax, int item, int wave, int lane) {
    const int n0 = 32 * item, n = n0 + (lane & 31); const int sc = REMAP ? win_src_col(n) : n;
    const float* Wc = W + (size_t)(128 * wave + (lane >> 5)) * ldw + (sc >= 0 ? sc : 0);
    float m = 0.f;
#pragma unroll 16
    for (int i = 0; i < 64; ++i) m = fmaxf(m, fabsf(Wc[(size_t)(2 * i) * ldw]));
    if (sc < 0) m = 0.f;
    m = fmaxf(m, __shfl_xor(m, 32));
    if (lane < 32) cmax[wave * 32 + lane] = m;
    __syncthreads();
    m = 0.f;
#pragma unroll
    for (int w = 0; w < 8; ++w) m = fmaxf(m, cmax[w * 32 + (lane & 31)]);
    const float inv = m > 0.f ? 127.0f / m : 0.f;
    if (wave == 0 && lane < 32) SW[n] = m > 0.f ? m * (1.0f / 127.0f) : 1.0f;
#pragma unroll
    for (int blk = 0; blk < 2; ++blk) {
        const int k0 = 128 * wave + 64 * blk;
#pragma unroll 16
        for (int i = 0; i < 32; ++i) scr[(2 * i + (lane >> 5)) * 33 + (lane & 31)] = Wc[(size_t)(64 * blk + 2 * i) * ldw] * inv;
        asm volatile("s_waitcnt lgkmcnt(0)" ::: "memory");
        const int c = lane & 3;
#pragma unroll
        for (int j = 0; j < 2; ++j) { const int nn = (lane >> 2) + 16 * j; const LAS float* sp = scr + (16 * c) * 33 + nn;
            unsigned w[4];
#pragma unroll
            for (int d = 0; d < 4; ++d) { const int q0 = (int)rintf(sp[(4 * d) * 33]), q1 = (int)rintf(sp[(4 * d + 1) * 33]), q2 = (int)rintf(sp[(4 * d + 2) * 33]), q3 = (int)rintf(sp[(4 * d + 3) * 33]);
                w[d] = (unsigned)(q0 & 255) | ((unsigned)(q1 & 255) << 8) | ((unsigned)(q2 & 255) << 16) | ((unsigned)(q3 & 255) << 24); }
            v4u o; o.x = w[0]; o.y = w[1]; o.z = w[2]; o.w = w[3];
            *(v4u*)(WT8 + (size_t)(n0 + nn) * 1024 + k0 + 16 * c) = o; }
        asm volatile("s_waitcnt lgkmcnt(0)" ::: "memory");
    }
    __syncthreads();
}
__device__ __forceinline__ void p0_prologue(const Params& p, LAS unsigned char* lds, int vcu, int G, int wave, int lane) {
    unsigned char* ws = p.ws;
    LAS float* scr = (LAS float*)(lds + wave * 16384);
    const int gw = vcu * NWAVES + wave, NGW = G * NWAVES;
    constexpr int I_IN = N1 / 32, I_Q = 2048 / 32, I_FX = 8 * 32, I_O = 16 * 32;
    {
        LAS float* cmax = (LAS float*)(lds + 8 * 16384);
        for (int it = vcu; it < I_IN + I_Q; it += G) {
            if (it < I_IN) transpose_q8_item<true>(p.in[I_WIN], IN_COLS, ws + WS_WTIN, (float*)(ws + WS_SWIN), scr, cmax, it, wave, lane);
            else transpose_q8_item<false>(p.in[I_PWQ], 2048, ws + WS_WTQ, (float*)(ws + WS_SWQ), scr, cmax, it - I_IN, wave, lane);
        }
    }
#ifdef PQ_BF16
    for (int it = gw; it < 16 * 64; it += NGW) transpose_item<false>(p.in[I_PWQ], 2048, 1024, 2048, (bf16*)(ws + 1010 * MiB), scr, it, lane);
#endif
    constexpr int NITEMS = 2 * I_FX + I_O;
    for (int it = gw; it < NITEMS; it += NGW) {
        int r = it;
        if (r < I_FX) { transpose_item<false>(p.in[I_WFOX], 1024, 512, 1024, (bf16*)(ws + WS_WTFOX), scr, r, lane); continue; } r -= I_FX;
        if (r < I_FX) { transpose_item<false>(p.in[I_WRWKV], 1024, 512, 1024, (bf16*)(ws + WS_WTRWKV), scr, r, lane); continue; } r -= I_FX;
        transpose_item<false>(p.in[I_WOUT], 1024, 1024, 1024, (bf16*)(ws + WS_WTOUT), scr, r, lane);
    }
    const int gt = gw * 64 + lane, NGT = NGW * 64;
    for (int i = gt; i < 1024 * 128; i += NGT) { const int n = i >> 7, k = i & 127; float v = 0.f;
        if (n < 512) { if (k < 64) v = p.in[I_WUP][k * 512 + n]; } else { if (k >= 64) v = p.in[I_AUP][(k - 64) * 512 + (n - 512)]; }
        ((bf16*)(ws + WS_WTWA))[i] = (bf16)f2bf(v); }
    for (int i = gt; i < 512 * 256; i += NGT) { const int n = i >> 8, k = i & 255; const float v = (k < 160) ? p.in[I_GUP][k * 512 + n] : 0.f; ((bf16*)(ws + WS_WTG))[i] = (bf16)f2bf(v); }
    for (int i = gt; i < 2 * 128 * 128; i += NGT) { const float v = (i < 16384) ? p.in[I_SK1][i] : p.in[I_SK2][i - 16384]; ((bf16*)(ws + WS_KS))[i] = (bf16)f2bf(v); }
    for (int r = gw; r < 32768; r += NGW) {
        const int tbl = r >> 14, row = r & 16383;
        const f32x4* src = (const f32x4*)((tbl ? p.in[I_PV] : p.in[I_PU]) + (size_t)row * 1024 + 16 * lane);
        f32x4 a[4]; float m = 0.f;
#pragma unroll
        for (int j = 0; j < 4; ++j) { a[j] = src[j]; m = fmaxf(m, fmaxf(fmaxf(fabsf(a[j].x), fabsf(a[j].y)), fmaxf(fabsf(a[j].z), fabsf(a[j].w)))); }
#pragma unroll
        for (int o = 1; o < 64; o <<= 1) m = fmaxf(m, __shfl_xor(m, o));
        const float inv = m > 0.f ? 127.0f / m : 0.f; const int off = 0;
        v4u w;
        unsigned ww[4];
#pragma unroll
        for (int j = 0; j < 4; ++j) { const int q0 = (int)rintf(a[j].x * inv) + off, q1 = (int)rintf(a[j].y * inv) + off, q2 = (int)rintf(a[j].z * inv) + off, q3 = (int)rintf(a[j].w * inv) + off;
            ww[j] = (unsigned)(q0 & 255) | ((unsigned)(q1 & 255) << 8) | ((unsigned)(q2 & 255) << 16) | ((unsigned)(q3 & 255) << 24); }
        w.x = ww[0]; w.y = ww[1]; w.z = ww[2]; w.w = ww[3];
        *(v4u*)(ws + (tbl ? WS_V8 : WS_U8) + (size_t)row * 1024 + 16 * lane) = w;
        if (lane == 0) ((float*)(ws + (tbl ? WS_SV : WS_SU)))[row] = m > 0.f ? m * (1.0f / 127.0f) : 1.0f;
    }
    const f32x4* g4 = (const f32x4*)p.in[I_N1G] + lane;
    for (int m = gw; m < R; m += NGW) {
        const int b = m / TP, pp = m - b * TP;
        unsigned* o4 = (unsigned*)(ws + WS_XN + (size_t)m * 1024) + lane;
        if (pp < 48) {
#pragma unroll
            for (int j = 0; j < 4; ++j) o4[64 * j] = 0u;
            if (lane == 0) ((float*)(ws + WS_SXN))[m] = 1.0f;
            continue; }
        const float* xrow = (pp < 64) ? p.in[I_META] + (size_t)(pp - 48) * 1024 : p.in[I_X] + ((size_t)b * SEQ + (pp - 64)) * 1024;
        const f32x4* xr = (const f32x4*)xrow + lane;
        f32x4 v[4]; float s = 0.f;
#pragma unroll
        for (int j = 0; j < 4; ++j) { v[j] = xr[64 * j]; s += (v[j].x * v[j].x + v[j].y * v[j].y) + (v[j].z * v[j].z + v[j].w * v[j].w); }
        const float rs = 1.0f / sqrtf(wave_sum(s) * (1.f / 1024.f) + NORM_EPS);
        float mx = 0.f;
#pragma unroll
        for (int j = 0; j < 4; ++j) { const f32x4 g = g4[64 * j]; v[j].x *= rs * g.x; v[j].y *= rs * g.y; v[j].z *= rs * g.z; v[j].w *= rs * g.w;
            mx = fmaxf(mx, fmaxf(fmaxf(fabsf(v[j].x), fabsf(v[j].y)), fmaxf(fabsf(v[j].z), fabsf(v[j].w)))); }
#pragma unroll
        for (int o = 1; o < 64; o <<= 1) mx = fmaxf(mx, __shfl_xor(mx, o));
        const float inv = mx > 0.f ? 127.0f / mx : 0.f;
#pragma unroll
        for (int j = 0; j < 4; ++j) { const int q0 = (int)rintf(v[j].x * inv), q1 = (int)rintf(v[j].y * inv), q2 = (int)rintf(v[j].z * inv), q3 = (int)rintf(v[j].w * inv);
            o4[64 * j] = (unsigned)(q0 & 255) | ((unsigned)(q1 & 255) << 8) | ((unsigned)(q2 & 255) << 16) | ((unsigned)(q3 & 255) << 24); }
        if (lane == 0) ((float*)(ws + WS_SXN))[m] = mx > 0.f ? mx * (1.0f / 127.0f) : 1.0f;
    }
}

template <class F> struct EpiT {
    static constexpr bool PERM = true, AFTER_DRAIN = false;
    F f;
    __device__ __forceinline__ void operator()(const pg8::f32x4 (&acc)[2][2][4][2], const pg8::Unit& u, int wr, int wc, int fr, int fq) const {
        const int row0 = u.pm * 256 + wr * 64 + fr, col0 = u.pn * 256 + wc * 32 + 8 * fq;
#pragma unroll
        for (int ai = 0; ai < 2; ++ai)
#pragma unroll
            for (int m = 0; m < 4; ++m)
#pragma unroll
                for (int bj = 0; bj < 2; ++bj) {
                    const pg8::f32x4 a = acc[ai][bj][m][0], b = acc[ai][bj][m][1];
                    float v[8] = {a[0], a[1], a[2], a[3], b[0], b[1], b[2], b[3]};
                    f.store(row0 + ai * 128 + m * 16, col0 + bj * 128, v);
                }
    }
};
struct F_Gemm1 {
    bf16* F; bf16* ZG;
    __device__ __forceinline__ void store(int row, int col, float (&v)[8]) const {
        if (col < 3584) { const int buf = col >> 9, c = col & 511; *(v4u*)(F + (size_t)buf * ((size_t)R * 512) + (size_t)row * 512 + c) = pack8(v); }
        else { const int c = col - 3584;
            unsigned q[8];
#pragma unroll
            for (int e = 0; e < 8; ++e) q[e] = (unsigned)(int)rintf(sigmoidf_(v[e]) * 255.0f);
            v2u w; w.x = q[0] | (q[1] << 8) | (q[2] << 16) | (q[3] << 24); w.y = q[4] | (q[5] << 8) | (q[6] << 16) | (q[7] << 24);
            *(v2u*)((unsigned char*)ZG + (size_t)row * 2048 + c) = w; }
    }
};
struct F_LoraW {
    bf16* XW; const float* w0;
    __device__ __forceinline__ void store(int row, int col, float (&v)[8]) const {
        const f32x4 b0 = *(const f32x4*)(w0 + col), b1 = *(const f32x4*)(w0 + col + 4); const float bb[8] = {b0.x, b0.y, b0.z, b0.w, b1.x, b1.y, b1.z, b1.w};
#pragma unroll
        for (int e = 0; e < 8; ++e) { const float x = v[e] + bb[e];
            const float sp = fmaxf(-x, 0.f) + __logf(1.0f + __expf(-fabsf(x)));
            const float ew = __expf(-sp - 0.5f);
            v[e] = 1.0f - __expf(-ew); }
        *(v4u*)(XW + (size_t)row * 512 + col) = pack8(v);
    }
};
struct F_LoraA {
    bf16* AA; const float* a0;
    __device__ __forceinline__ void store(int row, int col, float (&v)[8]) const {
        const f32x4 b0 = *(const f32x4*)(a0 + col), b1 = *(const f32x4*)(a0 + col + 4); const float bb[8] = {b0.x, b0.y, b0.z, b0.w, b1.x, b1.y, b1.z, b1.w};
#pragma unroll
        for (int e = 0; e < 8; ++e) v[e] = sigmoidf_(v[e] + bb[e]);
        *(v4u*)(AA + (size_t)row * 512 + col) = pack8(v);
    }
};
struct F_Plain {
    bf16* O; int ldc;
    __device__ __forceinline__ void store(int row, int col, float (&v)[8]) const { *(v4u*)(O + (size_t)row * ldc + col) = pack8(v); }
};
struct F_MixA {
    bf16* MIX; const bf16* ZG;
    __device__ __forceinline__ void store(int row, int col, float (&v)[8]) const {
        const v2u gq = *(const v2u*)((const unsigned char*)ZG + (size_t)row * 2048 + col);
        const float g[8] = {(float)(gq.x & 0xffu), (float)((gq.x >> 8) & 0xffu), (float)((gq.x >> 16) & 0xffu), (float)(gq.x >> 24), (float)(gq.y & 0xffu), (float)((gq.y >> 8) & 0xffu), (float)((gq.y >> 16) & 0xffu), (float)(gq.y >> 24)};
#pragma unroll
        for (int e = 0; e < 8; ++e) v[e] *= g[e] * (1.0f / 255.0f);
        *(v4u*)(MIX + (size_t)row * 1024 + col) = pack8(v);
    }
};
struct F_MixB {
    bf16* MIX; const bf16* ZG;
    __device__ __forceinline__ void store(int row, int col, float (&v)[8]) const {
        float m[8]; unpack8(*(const v4u*)(MIX + (size_t)row * 1024 + col), m);
        const v2u gq = *(const v2u*)((const unsigned char*)ZG + (size_t)row * 2048 + 1024 + col);
        const float g[8] = {(float)(gq.x & 0xffu), (float)((gq.x >> 8) & 0xffu), (float)((gq.x >> 16) & 0xffu), (float)(gq.x >> 24), (float)(gq.y & 0xffu), (float)((gq.y >> 8) & 0xffu), (float)((gq.y >> 16) & 0xffu), (float)(gq.y >> 24)};
#pragma unroll
        for (int e = 0; e < 8; ++e) v[e] = m[e] + v[e] * g[e] * (1.0f / 255.0f);
        *(v4u*)(MIX + (size_t)row * 1024 + col) = pack8(v);
    }
};
struct F_Out {
    const float* x; float* out;
    __device__ __forceinline__ void store(int row, int col, float (&v)[8]) const {
        const int b = row / TP, pp = row - b * TP; if (pp < 64) return;
        const size_t off = ((size_t)b * SEQ + (pp - 64)) * 1024 + col;
        const f32x4 x0 = *(const f32x4*)(x + off), x1 = *(const f32x4*)(x + off + 4);
        *(f32x4*)(out + off) = (f32x4){x0.x + v[0], x0.y + v[1], x0.z + v[2], x0.w + v[3]};
        *(f32x4*)(out + off + 4) = (f32x4){x1.x + v[4], x1.y + v[5], x1.z + v[6], x1.w + v[7]};
    }
};
template <class F> struct EpiI8 {
    static constexpr bool PERM = true, AFTER_DRAIN = false;
    F f; const float* SA; const float* SB;
    __device__ __forceinline__ void operator()(const pg8::i32x4 (&acc)[2][2][4][2], const pg8::Unit& u, int wr, int wc, int fr, int fq) const {
        const int row0 = u.pm * 256 + wr * 64 + fr, col0 = u.pn * 256 + wc * 32 + 8 * fq;
        f32x4 sb[2][2];
#pragma unroll
        for (int bj = 0; bj < 2; ++bj) { sb[bj][0] = *(const f32x4*)(SB + col0 + bj * 128); sb[bj][1] = *(const f32x4*)(SB + col0 + bj * 128 + 4); }
#pragma unroll
        for (int ai = 0; ai < 2; ++ai)
#pragma unroll
            for (int m = 0; m < 4; ++m) {
                const int row = row0 + ai * 128 + m * 16; const float sa = SA[row];
#pragma unroll
                for (int bj = 0; bj < 2; ++bj) {
                    const pg8::i32x4 a = acc[ai][bj][m][0], b = acc[ai][bj][m][1];
                    float v[8] = {(float)a[0] * (sa * sb[bj][0].x), (float)a[1] * (sa * sb[bj][0].y), (float)a[2] * (sa * sb[bj][0].z), (float)a[3] * (sa * sb[bj][0].w),
                                  (float)b[0] * (sa * sb[bj][1].x), (float)b[1] * (sa * sb[bj][1].y), (float)b[2] * (sa * sb[bj][1].z), (float)b[3] * (sa * sb[bj][1].w)};
                    f.store(row, col0 + bj * 128, v);
                }
            }
    }
};
template <class F>
__device__ __forceinline__ void run_gemm_i8(LAS unsigned char* lds, const unsigned char* A8, const unsigned char* Bt8, int M, int N, int K8, int G, int bid, const float* SA, const float* SB, const F& f) {
    asm volatile("" : "+s"(M), "+s"(N), "+s"(G));
    pg8::Gemm g{(const bf16*)A8, (const bf16*)Bt8, M, N, K8 / 2}; pg8::StaticOrder S; S.init(M, N, G, bid);
    EpiI8<F> E{f, SA, SB};
    pg8::gemm_phase_i8<EpiI8<F>, pg8::StaticOrder, true, true>(lds, g, S, E);
}
template <class F>
__device__ __forceinline__ void run_gemm(LAS unsigned char* lds, const bf16* A, const bf16* Bt, int M, int N, int K, int G, int bid, const F& f) {
    asm volatile("" : "+s"(M), "+s"(N), "+s"(G));
    pg8::Gemm g{A, Bt, M, N, K}; pg8::StaticOrder S; S.init(M, N, G, bid);
    EpiT<F> E{f};
    pg8::gemm_phase<EpiT<F>, pg8::StaticOrder, true, true>(lds, g, S, E);
}

__device__ __forceinline__ void p2_prep1(const Params& p, int vcu, int G, int wave, int lane) {
    unsigned char* ws = p.ws;
    const int gw = vcu * NWAVES + wave, NGW = G * NWAVES;
    float gq[8], gk[8], mu[8];
#pragma unroll
    for (int e = 0; e < 8; ++e) { gq[e] = p.in[I_FQN][lane * 8 + e] * attn_body::C2; gk[e] = p.in[I_FKN][lane * 8 + e]; mu[e] = (lane < 36) ? p.in[I_MU][1536 + lane * 8 + e] : 0.f; }
    for (int m = gw; m < R; m += NGW) {
        const int b = m / TP, pp = m - b * TP;
        {
            v4u* qp = (v4u*)(ws + WS_FQ + (size_t)m * 1024) + lane; v4u* kp = (v4u*)(ws + WS_FK + (size_t)m * 1024) + lane;
            float q[8], k[8]; unpack8(*qp, q); unpack8(*kp, k);
            float sq = 0.f, sk = 0.f;
#pragma unroll
            for (int e = 0; e < 8; ++e) { sq += q[e] * q[e]; sk += k[e] * k[e]; }
            sq = sum8(sq); sk = sum8(sk);
            const float rq = 1.0f / sqrtf(sq * (1.f / 64.f) + NORM_EPS), rk = 1.0f / sqrtf(sk * (1.f / 64.f) + NORM_EPS);
#pragma unroll
            for (int e = 0; e < 8; ++e) { q[e] *= rq * gq[e]; k[e] *= rk * gk[e]; }
            *qp = pack8(q); *kp = pack8(k);
        }
        if (lane < 36) {
            float z[8], zp[8]; unpack8(*((const v4u*)(ws + WS_ZM + (size_t)m * 1024) + lane), z);
            if (pp > 0) unpack8(*((const v4u*)(ws + WS_ZM + (size_t)(m - 1) * 1024) + lane), zp); else {
#pragma unroll
                for (int e = 0; e < 8; ++e) zp[e] = 0.f; }
#pragma unroll
            for (int e = 0; e < 8; ++e) { const float s = z[e] + mu[e] * (zp[e] - z[e]); z[e] = (lane < 8) ? tanhf(s) : (lane < 16) ? s : sigmoidf_(s); }
            if (lane < 16) *((v4u*)(ws + WS_LA + (size_t)m * 256) + lane) = pack8(z);
            else *((v4u*)(ws + WS_LG + (size_t)m * 512) + (lane - 16)) = pack8(z);
        } else if (lane == 36) {
            float z[8]; unpack8(*((const v4u*)(ws + WS_ZM + (size_t)m * 1024) + 36), z);
#pragma unroll
            for (int e = 0; e < 8; ++e) { const float x = z[e] + p.in[I_FBIAS][e]; z[e] = fminf(x, 0.f) - __logf(1.0f + __expf(-fabsf(x))); }
            float* lf = (float*)(ws + WS_LF) + (size_t)m * 8;
            *(f32x4*)lf = (f32x4){z[0], z[1], z[2], z[3]}; *(f32x4*)(lf + 4) = (f32x4){z[4], z[5], z[6], z[7]};
        } else if (lane < 49) {
            *((v4u*)(ws + WS_LG + (size_t)m * 512) + (lane - 37 + 20)) = (v4u){0u, 0u, 0u, 0u};
        }
    }
}
__device__ __forceinline__ void p3_cumsum(const Params& p, int seq, int lane) {
    unsigned char* ws = p.ws;
    const int b = seq >> 3, h = seq & 7;
    const float* lf = (const float*)(ws + WS_LF) + (size_t)b * TP * 8 + h;
    float* kb = (float*)(ws + WS_KB) + (size_t)seq * TP;
    float carry = 0.f;
    for (int c0 = 0; c0 < 65; c0 += 13) {
        float v[13];
#pragma unroll
        for (int i = 0; i < 13; ++i) { const int pp = (c0 + i) * 64 + lane; v[i] = (pp >= 48) ? lf[(size_t)pp * 8] : 0.f; }
#pragma unroll
        for (int i = 0; i < 13; ++i) {
            float x = v[i];
#pragma unroll
            for (int o = 1; o < 64; o <<= 1) { const float y = __shfl_up(x, o); if (lane >= o) x += y; }
            const int pp = (c0 + i) * 64 + lane;
            const float c = carry + x;
            kb[pp] = (pp >= 48) ? -c * LOG2E : -1e30f;
            carry += __shfl(x, 63);
        }
    }
}

__device__ __forceinline__ void p4_prep2(const Params& p, int vcu, int G, int wave, int lane) {
    unsigned char* ws = p.ws; unsigned char* dob = (unsigned char*)p.out;
    const int gw = vcu * NWAVES + wave, NGW = G * NWAVES;
    float mur[8], muk[8], kk_[8], ka_[8], rk_[8];
#pragma unroll
    for (int e = 0; e < 8; ++e) { const int c = lane * 8 + e; mur[e] = p.in[I_MU][c]; muk[e] = p.in[I_MU][512 + c]; kk_[e] = p.in[I_KK][c]; ka_[e] = p.in[I_KA][c]; rk_[e] = p.in[I_RK][c]; }
    for (int m = gw; m < R; m += NGW) {
        const int b = m / TP, pp = m - b * TP;
        float r[8], k[8], rp[8], kp[8], a[8];
        unpack8(*((const v4u*)(ws + WS_ZRR + (size_t)m * 1024) + lane), r); unpack8(*((const v4u*)(ws + WS_ZRK + (size_t)m * 1024) + lane), k);
        if (pp > 0) { unpack8(*((const v4u*)(ws + WS_ZRR + (size_t)(m - 1) * 1024) + lane), rp); unpack8(*((const v4u*)(ws + WS_ZRK + (size_t)(m - 1) * 1024) + lane), kp); }
        else {
#pragma unroll
            for (int e = 0; e < 8; ++e) { rp[e] = 0.f; kp[e] = 0.f; } }
        v4u* aap = (v4u*)(dob + DO_AA + (size_t)m * 1024) + lane;
        unpack8(*aap, a);
        float kkv[8], kpr[8]; float ss = 0.f, bon = 0.f;
#pragma unroll
        for (int e = 0; e < 8; ++e) { const float rs = r[e] + mur[e] * (rp[e] - r[e]); const float ks = k[e] + muk[e] * (kp[e] - k[e]);
            kkv[e] = ks * kk_[e]; kpr[e] = ks * (1.0f + (a[e] - 1.0f) * ka_[e]); ss += kkv[e] * kkv[e]; bon += rs * kpr[e] * rk_[e]; }
        ss = sum8(ss); bon = sum8(bon);
        const float inv = 1.0f / fmaxf(sqrtf(ss), 1e-12f);
        float bb[8];
#pragma unroll
        for (int e = 0; e < 8; ++e) { kkv[e] *= inv; bb[e] = kkv[e] * a[e]; }
        *((v4u*)(ws + WS_KP + (size_t)m * 1024) + lane) = pack8(kpr);
        *((v4u*)(ws + WS_KN + (size_t)m * 1024) + lane) = pack8(kkv);
        *aap = pack8(bb);
        if ((lane & 7) == 0) ((float*)(ws + WS_BS))[(size_t)m * 8 + (lane >> 3)] = bon;
    }
}

constexpr int SC_CH = 32, SC_STRIDE = 5 * 64 + 32;
constexpr int SC_BUF_BYTES = SC_CH * SC_STRIDE * 4;
constexpr int SC_YB_BYTES = SC_CH * 32 * 4 * 4;
__device__ __forceinline__ float dpp_sum16(float x) {
    x += __builtin_bit_cast(float, __builtin_amdgcn_update_dpp(0, __builtin_bit_cast(int, x), 0xB1, 0xF, 0xF, true));
    x += __builtin_bit_cast(float, __builtin_amdgcn_update_dpp(0, __builtin_bit_cast(int, x), 0x4E, 0xF, 0xF, true));
    x += __builtin_bit_cast(float, __builtin_amdgcn_update_dpp(0, __builtin_bit_cast(int, x), 0x141, 0xF, 0xF, true));
    x += __builtin_bit_cast(float, __builtin_amdgcn_update_dpp(0, __builtin_bit_cast(int, x), 0x140, 0xF, 0xF, true));
    return x;
}
__device__ __forceinline__ float dpp_sum4(float x) {
    x += __builtin_bit_cast(float, __builtin_amdgcn_update_dpp(0, __builtin_bit_cast(int, x), 0xB1, 0xF, 0xF, true));
    x += __builtin_bit_cast(float, __builtin_amdgcn_update_dpp(0, __builtin_bit_cast(int, x), 0x4E, 0xF, 0xF, true));
    return x;
}
struct ScanVec { f32x4 xw, kn, bb, kp, rr; float va, vb; };
__device__ __forceinline__ void p5_scan_item(const Params& p, LAS unsigned char* lds, int item, int tid, int wave, int lane) {
    unsigned char* ws = p.ws; unsigned char* dob = (unsigned char*)p.out;
    const int half = item & 1, bh = item >> 1, b = bh >> 3, h = bh & 7;
    const size_t rowb = (size_t)b * TP;
    constexpr int T0 = 32, NCH = (TP - T0) / SC_CH;
    bf16* Y = (bf16*)(ws + WS_Y);
    LAS float* yb0 = (LAS float*)(lds + 2 * SC_BUF_BYTES);
    if (wave >= 4) {
        const int lt = tid - 256;
        const int st_step = lt >> 3, c8 = lt & 7;
        const size_t colb = (size_t)h * 64 + c8 * 8;
        const bf16* aXW = (const bf16*)(dob + DO_XW); const bf16* aKN = (const bf16*)(ws + WS_KN); const bf16* aBB = (const bf16*)(dob + DO_AA); const bf16* aKP = (const bf16*)(ws + WS_KP);
        const bf16* aR = (const bf16*)(ws + WS_ZRR); const bf16* aV = (const bf16*)(ws + WS_ZRV);
        float mur[8], muv[8];
#pragma unroll
        for (int e = 0; e < 8; ++e) { mur[e] = p.in[I_MU][h * 64 + c8 * 8 + e]; muv[e] = (c8 < 4) ? p.in[I_MU][1024 + h * 64 + half * 32 + c8 * 8 + e] : 0.f; }
        auto stage = [&](int t0, int bufi) {
            const size_t row = rowb + t0 + st_step;
            const v4u g0 = *(const v4u*)(aXW + row * 512 + colb), g1 = *(const v4u*)(aKN + row * 512 + colb), g2 = *(const v4u*)(aBB + row * 512 + colb), g3 = *(const v4u*)(aKP + row * 512 + colb);
            const v4u g4 = *(const v4u*)(aR + row * 512 + colb), g5 = *(const v4u*)(aR + (row - 1) * 512 + colb);
            v4u g6 = {0u, 0u, 0u, 0u}, g7 = {0u, 0u, 0u, 0u};
            if (c8 < 4) { const size_t cv = (size_t)h * 64 + half * 32 + c8 * 8; g6 = *(const v4u*)(aV + row * 512 + cv); g7 = *(const v4u*)(aV + (row - 1) * 512 + cv); }
            LAS float* d = (LAS float*)(lds + bufi * SC_BUF_BYTES) + st_step * SC_STRIDE + c8 * 8;
            float a[8], c[8];
            unpack8(g0, a); *(LAS f32x4*)(d + 0 * 64) = (f32x4){a[0], a[1], a[2], a[3]}; *(LAS f32x4*)(d + 0 * 64 + 4) = (f32x4){a[4], a[5], a[6], a[7]};
            unpack8(g1, a); *(LAS f32x4*)(d + 1 * 64) = (f32x4){a[0], a[1], a[2], a[3]}; *(LAS f32x4*)(d + 1 * 64 + 4) = (f32x4){a[4], a[5], a[6], a[7]};
            unpack8(g2, a); *(LAS f32x4*)(d + 2 * 64) = (f32x4){a[0], a[1], a[2], a[3]}; *(LAS f32x4*)(d + 2 * 64 + 4) = (f32x4){a[4], a[5], a[6], a[7]};
            unpack8(g3, a); *(LAS f32x4*)(d + 3 * 64) = (f32x4){a[0], a[1], a[2], a[3]}; *(LAS f32x4*)(d + 3 * 64 + 4) = (f32x4){a[4], a[5], a[6], a[7]};
            unpack8(g4, a); unpack8(g5, c);
#pragma unroll
            for (int e = 0; e < 8; ++e) a[e] = a[e] + mur[e] * (c[e] - a[e]);
            *(LAS f32x4*)(d + 4 * 64) = (f32x4){a[0], a[1], a[2], a[3]}; *(LAS f32x4*)(d + 4 * 64 + 4) = (f32x4){a[4], a[5], a[6], a[7]};
            if (c8 < 4) { unpack8(g6, a); unpack8(g7, c);
#pragma unroll
                for (int e = 0; e < 8; ++e) a[e] = a[e] + muv[e] * (c[e] - a[e]);
                *(LAS f32x4*)(d + 5 * 64) = (f32x4){a[0], a[1], a[2], a[3]}; *(LAS f32x4*)(d + 5 * 64 + 4) = (f32x4){a[4], a[5], a[6], a[7]}; }
        };
        auto flush = [&](int t0, int ybi) {
            const LAS f32x4* yq = (const LAS f32x4*)(lds + 2 * SC_BUF_BYTES + ybi * SC_YB_BYTES) + (lt >> 3) * 32 + (lt & 7) * 4;
            float y[4];
#pragma unroll
            for (int r = 0; r < 4; ++r) { const f32x4 q = yq[r]; y[r] = (q.x + q.y) + (q.z + q.w); }
            v2u o; o.x = pk2(y[0], y[1]); o.y = pk2(y[2], y[3]);
            *(v2u*)(Y + (rowb + t0 + (lt >> 3)) * 512 + h * 64 + half * 32 + 4 * (lt & 7)) = o;
        };
        stage(T0, 0);
        __syncthreads();
        for (int ch = 0; ch < NCH; ++ch) {
            if (ch + 1 < NCH) stage(T0 + (ch + 1) * SC_CH, (ch + 1) & 1);
            if (ch > 0) flush(T0 + (ch - 1) * SC_CH, (ch - 1) & 1);
            __syncthreads();
        }
        flush(T0 + (NCH - 1) * SC_CH, (NCH - 1) & 1);
    } else {
        const int rl = lane >> 4, kq = lane & 15, rowA = wave * 8 + rl, rowB = rowA + 4;
        f32x4 SA = {0.f, 0.f, 0.f, 0.f}, SB = {0.f, 0.f, 0.f, 0.f};
        auto ldv = [&](const LAS float* base, int s) { ScanVec v; const LAS float* q = base + s * SC_STRIDE + kq * 4;
            v.xw = *(const LAS f32x4*)(q); v.kn = *(const LAS f32x4*)(q + 64); v.bb = *(const LAS f32x4*)(q + 128); v.kp = *(const LAS f32x4*)(q + 192); v.rr = *(const LAS f32x4*)(q + 256);
            v.va = base[s * SC_STRIDE + 320 + rowA]; v.vb = base[s * SC_STRIDE + 320 + rowB]; return v; };
        auto step = [&](const ScanVec& v, LAS float* yb, int s) {
            float sa = SA.x * v.kn.x; sa = fmaf(SA.y, v.kn.y, sa); sa = fmaf(SA.z, v.kn.z, sa); sa = fmaf(SA.w, v.kn.w, sa);
            float sb = SB.x * v.kn.x; sb = fmaf(SB.y, v.kn.y, sb); sb = fmaf(SB.z, v.kn.z, sb); sb = fmaf(SB.w, v.kn.w, sb);
            sa = -dpp_sum16(sa); sb = -dpp_sum16(sb);
            SA = (SA - SA * v.xw) + sa * v.bb + v.va * v.kp;
            SB = (SB - SB * v.xw) + sb * v.bb + v.vb * v.kp;
            float ya = SA.x * v.rr.x; ya = fmaf(SA.y, v.rr.y, ya); ya = fmaf(SA.z, v.rr.z, ya); ya = fmaf(SA.w, v.rr.w, ya);
            float yv = SB.x * v.rr.x; yv = fmaf(SB.y, v.rr.y, yv); yv = fmaf(SB.z, v.rr.z, yv); yv = fmaf(SB.w, v.rr.w, yv);
            ya = dpp_sum4(ya); yv = dpp_sum4(yv);
            yb[(s * 32 + rowA) * 4 + (kq >> 2)] = ya; yb[(s * 32 + rowB) * 4 + (kq >> 2)] = yv;
        };
        __syncthreads();
        for (int ch = 0; ch < NCH; ++ch) {
            const LAS float* base = (const LAS float*)(lds + (ch & 1) * SC_BUF_BYTES);
            LAS float* yb = yb0 + (ch & 1) * (SC_YB_BYTES / 4);
            ScanVec v0 = ldv(base, 0), v1;
#pragma unroll 1
            for (int s = 0; s < SC_CH; s += 2) {
                v1 = ldv(base, s + 1);
                step(v0, yb, s);
                if (s + 2 < SC_CH) v0 = ldv(base, s + 2);
                step(v1, yb, s + 1);
            }
            __syncthreads();
        }
    }
    __syncthreads();
}

#ifndef SC2_DBG
#define SC2_DBG 0
#endif
namespace sc2 {
constexpr int S64 = 144, S32 = 80, SAAB = 36, SRHS = 68;
constexpr int AT = 0, RT = AT + 32 * S64, BT = RT + 32 * S64, KT = BT + 32 * S64, BHT = KT + 32 * S64, KHT = BHT + 64 * S32, VT = KHT + 64 * S32, PT = VT + 64 * S32,
              AAK = PT + 64 * S32, ARB = AAK + 32 * S32, ARK = ARB + 32 * S32, SB = ARK + 32 * S32, AAB = SB + 64 * S64, RHS = AAB + 32 * SAAB * 4, CL = RHS + 32 * SRHS * 4,
              GC = CL + 32 * 64 * 4, END = GC + 256;
static_assert(END <= 100000, "scan LDS");
}
__device__ __forceinline__ bf16x8 sc2_frag(LAS unsigned char* base, int stride, int row0, int k0, int lane) {
    return *(const LAS bf16x8*)(base + (row0 + (lane & 15)) * stride + (k0 + 8 * (lane >> 4)) * 2);
}
#define SC2_BAR() asm volatile("s_waitcnt lgkmcnt(0)\n\ts_barrier" ::: "memory")
__device__ __forceinline__ void p5_scan_chunked(const Params& p, LAS unsigned char* lds, int bh, int tid, int wave, int lane) {
    using namespace sc2;
    unsigned char* ws = p.ws; unsigned char* dob = (unsigned char*)p.out;
    const int b = bh >> 3, h = bh & 7;
    const size_t rowb = (size_t)b * TP;
    constexpr int T0 = 32, NCH = (TP - T0) / 32;
    const bf16* aXW = (const bf16*)(dob + DO_XW); const bf16* aA = (const bf16*)(dob + DO_AA); const bf16* aG = (const bf16*)(dob + DO_GG);
    const bf16* aR = (const bf16*)(ws + WS_ZRR); const bf16* aK = (const bf16*)(ws + WS_ZRK); const bf16* aV = (const bf16*)(ws + WS_ZRV);
    bf16* Y = (bf16*)(ws + WS_Y);
    const int pt = tid >> 4, kc = tid & 15;
    const size_t kcol = (size_t)h * 64 + 4 * kc;
    float mur[4], muk[4], muv[4], kk_[4], ka_[4], rk_[4], lng[4], lnb[4];
#pragma unroll
    for (int e = 0; e < 4; ++e) { const int c = h * 64 + 4 * kc + e; mur[e] = p.in[I_MU][c]; muk[e] = p.in[I_MU][512 + c]; muv[e] = p.in[I_MU][1024 + c];
        kk_[e] = p.in[I_KK][c]; ka_[e] = p.in[I_KA][c]; rk_[e] = p.in[I_RK][c]; lng[e] = p.in[I_LNG][c]; lnb[e] = p.in[I_LNB][c]; }
    const int q = lane >> 4, c16 = lane & 15;
    const int m_ = wave >> 1, tr = wave & 1;
    const int tr2 = wave >> 2, vc2 = wave & 3;
    const int kt = wave >> 1, vh = wave & 1;
    pg8::f32x4 accS0 = {0.f, 0.f, 0.f, 0.f}, accS1 = {0.f, 0.f, 0.f, 0.f};
    for (int i = tid; i < 64 * S64 / 4; i += NTHREADS) ((LAS unsigned*)(lds + SB))[i] = 0u;
    v2u gxw, ga, gk0, gk1, gr0, gr1, gv0, gv1, ggn;
    auto prefetch = [&](int t0) { const size_t row = rowb + t0 + pt;
        gxw = *(const v2u*)(aXW + row * 512 + kcol); ga = *(const v2u*)(aA + row * 512 + kcol); ggn = *(const v2u*)(aG + row * 512 + kcol);
        gk0 = *(const v2u*)(aK + row * 512 + kcol); gk1 = *(const v2u*)(aK + (row - 1) * 512 + kcol);
        gr0 = *(const v2u*)(aR + row * 512 + kcol); gr1 = *(const v2u*)(aR + (row - 1) * 512 + kcol);
        gv0 = *(const v2u*)(aV + row * 512 + kcol); gv1 = *(const v2u*)(aV + (row - 1) * 512 + kcol); };
    prefetch(T0);
    float e_vs[4] = {0.f, 0.f, 0.f, 0.f}, e_bs = 0.f; v2u e_gg = {0u, 0u};
    auto y_epilogue = [&](int t0p) {
        const f32x4 y4 = *(const LAS f32x4*)(lds + RHS + (pt * SRHS + 4 * kc) * 4);
        float y[4] = {y4.x, y4.y, y4.z, y4.w};
        const float mean = dpp_sum16((y[0] + y[1]) + (y[2] + y[3])) * (1.f / 64.f);
        float qq = 0.f;
#pragma unroll
        for (int e = 0; e < 4; ++e) { y[e] -= mean; qq += y[e] * y[e]; }
        const float rstd = 1.0f / sqrtf(dpp_sum16(qq) * (1.f / 64.f) + GN_EPS);
        const float g[4] = {bflo(e_gg.x), bfhi(e_gg.x), bflo(e_gg.y), bfhi(e_gg.y)};
        float o[4];
#pragma unroll
        for (int e = 0; e < 4; ++e) o[e] = (y[e] * rstd * lng[e] + lnb[e] + e_bs * e_vs[e]) * g[e];
        v2u w; w.x = pk2(o[0], o[1]); w.y = pk2(o[2], o[3]);
        *(v2u*)(Y + (rowb + t0p + pt) * 512 + kcol) = w;
    };
    for (int ch = 0; ch < NCH; ++ch) {
        const int t0 = T0 + ch * 32;
        { f32x4 lg; lg.x = __builtin_amdgcn_logf(1.0f - bflo(gxw.x)); lg.y = __builtin_amdgcn_logf(1.0f - bfhi(gxw.x)); lg.z = __builtin_amdgcn_logf(1.0f - bflo(gxw.y)); lg.w = __builtin_amdgcn_logf(1.0f - bfhi(gxw.y));
          *(LAS f32x4*)(lds + CL + (pt * 64 + 4 * kc) * 4) = lg; }
        SC2_BAR();
        if (ch > 0) y_epilogue(t0 - 32);
        if (tid < 64) { LAS float* c = (LAS float*)(lds + CL) + tid; float run = 0.f;
#pragma unroll
            for (int t = 0; t < 32; ++t) { run += c[t * 64]; c[t * 64] = run; } }
        SC2_BAR();
        {
            const f32x4 clt = *(const LAS f32x4*)(lds + CL + (pt * 64 + 4 * kc) * 4);
            f32x4 clp = {0.f, 0.f, 0.f, 0.f}; if (pt > 0) clp = *(const LAS f32x4*)(lds + CL + ((pt - 1) * 64 + 4 * kc) * 4);
            const f32x4 clc = *(const LAS f32x4*)(lds + CL + (31 * 64 + 4 * kc) * 4);
            const float k0[4] = {bflo(gk0.x), bfhi(gk0.x), bflo(gk0.y), bfhi(gk0.y)}, k1[4] = {bflo(gk1.x), bfhi(gk1.x), bflo(gk1.y), bfhi(gk1.y)}, av[4] = {bflo(ga.x), bfhi(ga.x), bflo(ga.y), bfhi(ga.y)};
            const float r0[4] = {bflo(gr0.x), bfhi(gr0.x), bflo(gr0.y), bfhi(gr0.y)}, r1[4] = {bflo(gr1.x), bfhi(gr1.x), bflo(gr1.y), bfhi(gr1.y)};
            const float v0[4] = {bflo(gv0.x), bfhi(gv0.x), bflo(gv0.y), bfhi(gv0.y)}, v1[4] = {bflo(gv1.x), bfhi(gv1.x), bflo(gv1.y), bfhi(gv1.y)};
            float kkv[4], kp[4], rsv[4], ss = 0.f, bon = 0.f;
#pragma unroll
            for (int e = 0; e < 4; ++e) { const float ks = k0[e] + muk[e] * (k1[e] - k0[e]); rsv[e] = r0[e] + mur[e] * (r1[e] - r0[e]); e_vs[e] = v0[e] + muv[e] * (v1[e] - v0[e]);
                kkv[e] = ks * kk_[e]; kp[e] = ks * (1.0f + (av[e] - 1.0f) * ka_[e]); ss += kkv[e] * kkv[e]; bon += rsv[e] * kp[e] * rk_[e]; }
            ss = dpp_sum16(ss); e_bs = dpp_sum16(bon); e_gg = ggn;
            const float inv = 1.0f / fmaxf(sqrtf(ss), 1e-12f);
            float kn[4], bb[4];
#pragma unroll
            for (int e = 0; e < 4; ++e) { kn[e] = kkv[e] * inv; bb[e] = kn[e] * av[e]; }
            float at[4], rt[4], bt[4], ktl[4], bh_[4], kh_[4];
#pragma unroll
            for (int e = 0; e < 4; ++e) {
                const float gt = __builtin_amdgcn_exp2f(clt[e]), gp = __builtin_amdgcn_exp2f(clp[e]), gi = __builtin_amdgcn_exp2f(-clt[e]), gc = __builtin_amdgcn_exp2f(clc[e] - clt[e]);
                const float rs = rsv[e];
                at[e] = -kn[e] * gp; rt[e] = rs * gt; bt[e] = bb[e] * gi; ktl[e] = kp[e] * gi; bh_[e] = bb[e] * gc; kh_[e] = kp[e] * gc;
            }
            v2u w;
            w.x = pk2(at[0], at[1]); w.y = pk2(at[2], at[3]); *(LAS v2u*)(lds + AT + pt * S64 + 8 * kc) = w;
            w.x = pk2(rt[0], rt[1]); w.y = pk2(rt[2], rt[3]); *(LAS v2u*)(lds + RT + pt * S64 + 8 * kc) = w;
            w.x = pk2(bt[0], bt[1]); w.y = pk2(bt[2], bt[3]); *(LAS v2u*)(lds + BT + pt * S64 + 8 * kc) = w;
            w.x = pk2(ktl[0], ktl[1]); w.y = pk2(ktl[2], ktl[3]); *(LAS v2u*)(lds + KT + pt * S64 + 8 * kc) = w;
#pragma unroll
            for (int e = 0; e < 4; ++e) { *(LAS bf16*)(lds + BHT + (4 * kc + e) * S32 + 2 * pt) = (bf16)f2bf(bh_[e]); *(LAS bf16*)(lds + KHT + (4 * kc + e) * S32 + 2 * pt) = (bf16)f2bf(kh_[e]);
                *(LAS bf16*)(lds + VT + (4 * kc + e) * S32 + 2 * pt) = (bf16)f2bf(e_vs[e]); }
            if (pt == 31) *(LAS f32x4*)(lds + GC + 16 * kc) = (f32x4){__builtin_amdgcn_exp2f(clc[0]), __builtin_amdgcn_exp2f(clc[1]), __builtin_amdgcn_exp2f(clc[2]), __builtin_amdgcn_exp2f(clc[3])};
        }
        if (ch + 1 < NCH) prefetch(t0 + 32);
        SC2_BAR();
        pg8::f32x4 accR, accY;
        {
            LAS unsigned char* Ab = lds + ((m_ < 2) ? AT : RT); LAS unsigned char* Bb = lds + ((m_ & 1) ? KT : BT);
            const bf16x8 a0 = sc2_frag(Ab, S64, 16 * tr, 0, lane), a1 = sc2_frag(Ab, S64, 16 * tr, 32, lane);
#pragma unroll
            for (int tc = 0; tc < 2; ++tc) {
                const bf16x8 b0 = sc2_frag(Bb, S64, 16 * tc, 0, lane), b1 = sc2_frag(Bb, S64, 16 * tc, 32, lane);
                pg8::f32x4 c = {0.f, 0.f, 0.f, 0.f};
                c = __builtin_amdgcn_mfma_f32_16x16x32_bf16(a0, b0, c, 0, 0, 0); c = __builtin_amdgcn_mfma_f32_16x16x32_bf16(a1, b1, c, 0, 0, 0);
                const int i = 16 * tc + c16;
#pragma unroll
                for (int r = 0; r < 4; ++r) { const int t = 16 * tr + 4 * q + r; const bool keep = (m_ < 2) ? (i < t) : (i <= t); const float val = keep ? c[r] : 0.f;
                    if (m_ == 0) *(LAS float*)(lds + AAB + (t * SAAB + i) * 4) = val;
                    else *(LAS bf16*)(lds + (m_ == 1 ? AAK : (m_ == 2 ? ARB : ARK)) + t * S32 + 2 * i) = (bf16)f2bf(val); }
            }
            const bf16x8 sb0 = sc2_frag(lds + SB, S64, 16 * vc2, 0, lane), sb1 = sc2_frag(lds + SB, S64, 16 * vc2, 32, lane);
            const bf16x8 ra0 = sc2_frag(lds + AT, S64, 16 * tr2, 0, lane), ra1 = sc2_frag(lds + AT, S64, 16 * tr2, 32, lane);
            const bf16x8 ya0 = sc2_frag(lds + RT, S64, 16 * tr2, 0, lane), ya1 = sc2_frag(lds + RT, S64, 16 * tr2, 32, lane);
            accR = (pg8::f32x4){0.f, 0.f, 0.f, 0.f}; accY = accR;
            accR = __builtin_amdgcn_mfma_f32_16x16x32_bf16(ra0, sb0, accR, 0, 0, 0); accR = __builtin_amdgcn_mfma_f32_16x16x32_bf16(ra1, sb1, accR, 0, 0, 0);
            accY = __builtin_amdgcn_mfma_f32_16x16x32_bf16(ya0, sb0, accY, 0, 0, 0); accY = __builtin_amdgcn_mfma_f32_16x16x32_bf16(ya1, sb1, accY, 0, 0, 0);
        }
        SC2_BAR();
        {
            const bf16x8 bv = sc2_frag(lds + VT, S32, 16 * vc2, 0, lane);
            accR = __builtin_amdgcn_mfma_f32_16x16x32_bf16(sc2_frag(lds + AAK, S32, 16 * tr2, 0, lane), bv, accR, 0, 0, 0);
            accY = __builtin_amdgcn_mfma_f32_16x16x32_bf16(sc2_frag(lds + ARK, S32, 16 * tr2, 0, lane), bv, accY, 0, 0, 0);
#pragma unroll
            for (int r = 0; r < 4; ++r) *(LAS float*)(lds + RHS + ((16 * tr2 + 4 * q + r) * SRHS + 16 * vc2 + c16) * 4) = accR[r];
        }
        SC2_BAR();
        if (wave < 2) {
            const int v = 32 * wave + (lane & 31), par = lane >> 5;
            float qv[4][4];
#pragma unroll
            for (int m = 0; m < 4; ++m)
#pragma unroll
                for (int j = 0; j < 4; ++j) qv[m][j] = 0.f;
            unsigned pk[16]; float prev = 0.f;
            const LAS float* arow = (const LAS float*)(lds + AAB) + 4 * par;
#pragma unroll
            for (int t = 0; t < 32; ++t) {
                const float rh = *(const LAS float*)(lds + RHS + (t * SRHS + v) * 4);
                float a0 = par ? 0.f : rh, a1 = 0.f;
                const int nm = t ? ((t - 1) >> 3) + 1 : 0;
#pragma unroll
                for (int m = 0; m < nm; ++m) { const f32x4 w = *(const LAS f32x4*)(arow + t * SAAB + 8 * m);
                    a0 = fmaf(w.x, qv[m][0], a0); a1 = fmaf(w.y, qv[m][1], a1); a0 = fmaf(w.z, qv[m][2], a0); a1 = fmaf(w.w, qv[m][3], a1); }
                const float part = a0 + a1;
                auto rr = __builtin_amdgcn_permlane32_swap(__float_as_uint(part), __float_as_uint(part), false, false);
                const unsigned r0 = rr[0], r1 = rr[1];
                const float pt_ = __uint_as_float(r0) + __uint_as_float(r1);
                { const int g4 = t >> 2; qv[g4 >> 1][t & 3] = (par == (g4 & 1)) ? pt_ : qv[g4 >> 1][t & 3]; }
                if (t & 1) pk[t >> 1] = pk2(prev, pt_); else prev = pt_;
                if ((t & 3) == 3) asm volatile("" ::: "memory");
            }
            if (lane < 32) {
#pragma unroll
                for (int g = 0; g < 4; ++g) { v4u w; w.x = pk[4 * g]; w.y = pk[4 * g + 1]; w.z = pk[4 * g + 2]; w.w = pk[4 * g + 3]; *(LAS v4u*)(lds + PT + v * S32 + 16 * g) = w; } }
        }
        SC2_BAR();
        {
            accY = __builtin_amdgcn_mfma_f32_16x16x32_bf16(sc2_frag(lds + ARB, S32, 16 * tr2, 0, lane), sc2_frag(lds + PT, S32, 16 * vc2, 0, lane), accY, 0, 0, 0);
#pragma unroll
            for (int r = 0; r < 4; ++r) *(LAS float*)(lds + RHS + ((16 * tr2 + 4 * q + r) * SRHS + 16 * vc2 + c16) * 4) = accY[r];
            const f32x4 gcv = *(const LAS f32x4*)(lds + GC + (16 * kt + 4 * q) * 4);
            const bf16x8 ab = sc2_frag(lds + BHT, S32, 16 * kt, 0, lane), ak = sc2_frag(lds + KHT, S32, 16 * kt, 0, lane);
            accS0[0] *= gcv.x; accS0[1] *= gcv.y; accS0[2] *= gcv.z; accS0[3] *= gcv.w; accS1[0] *= gcv.x; accS1[1] *= gcv.y; accS1[2] *= gcv.z; accS1[3] *= gcv.w;
            accS0 = __builtin_amdgcn_mfma_f32_16x16x32_bf16(ab, sc2_frag(lds + PT, S32, 32 * vh, 0, lane), accS0, 0, 0, 0);
            accS0 = __builtin_amdgcn_mfma_f32_16x16x32_bf16(ak, sc2_frag(lds + VT, S32, 32 * vh, 0, lane), accS0, 0, 0, 0);
            accS1 = __builtin_amdgcn_mfma_f32_16x16x32_bf16(ab, sc2_frag(lds + PT, S32, 32 * vh + 16, 0, lane), accS1, 0, 0, 0);
            accS1 = __builtin_amdgcn_mfma_f32_16x16x32_bf16(ak, sc2_frag(lds + VT, S32, 32 * vh + 16, 0, lane), accS1, 0, 0, 0);
            v2u w; w.x = pk2(accS0[0], accS0[1]); w.y = pk2(accS0[2], accS0[3]);
            *(LAS v2u*)(lds + SB + (32 * vh + c16) * S64 + (16 * kt + 4 * q) * 2) = w;
            w.x = pk2(accS1[0], accS1[1]); w.y = pk2(accS1[2], accS1[3]);
            *(LAS v2u*)(lds + SB + (32 * vh + 16 + c16) * S64 + (16 * kt + 4 * q) * 2) = w;
        }
    }
    __syncthreads();
    y_epilogue(T0 + (NCH - 1) * 32);
    __syncthreads();
}

__device__ __forceinline__ void p6_prep3(const Params& p, int vcu, int G, int wave, int lane) {
    unsigned char* ws = p.ws; unsigned char* dob = (unsigned char*)p.out;
    const int gw = vcu * NWAVES + wave, NGW = G * NWAVES;
    float lg[8], lb[8], muv[8];
#pragma unroll
    for (int e = 0; e < 8; ++e) { const int c = lane * 8 + e; lg[e] = p.in[I_LNG][c]; lb[e] = p.in[I_LNB][c]; muv[e] = p.in[I_MU][1024 + c]; }
    for (int m = gw; m < R; m += NGW) {
        const int b = m / TP, pp = m - b * TP;
        v4u* yp = (v4u*)(ws + WS_Y + (size_t)m * 1024) + lane;
        if (pp < 48) { *yp = (v4u){0u, 0u, 0u, 0u}; continue; }
        float y[8], v[8], vp[8], g[8];
        unpack8(*yp, y); unpack8(*((const v4u*)(ws + WS_ZRV + (size_t)m * 1024) + lane), v); unpack8(*((const v4u*)(ws + WS_ZRV + (size_t)(m - 1) * 1024) + lane), vp);
        unpack8(*((const v4u*)(dob + DO_GG + (size_t)m * 1024) + lane), g);
        float s = 0.f;
#pragma unroll
        for (int e = 0; e < 8; ++e) s += y[e];
        const float mean = sum8(s) * (1.f / 64.f); float q = 0.f;
#pragma unroll
        for (int e = 0; e < 8; ++e) { y[e] -= mean; q += y[e] * y[e]; }
        const float rstd = 1.0f / sqrtf(sum8(q) * (1.f / 64.f) + GN_EPS);
        const float bon = ((const float*)(ws + WS_BS))[(size_t)m * 8 + (lane >> 3)];
#pragma unroll
        for (int e = 0; e < 8; ++e) { const float vs = v[e] + muv[e] * (vp[e] - v[e]); y[e] = (y[e] * rstd * lg[e] + lb[e] + bon * vs) * g[e]; }
        *yp = pack8(y);
    }
}
__device__ __forceinline__ void p9_norm2(const Params& p, int vcu, int G, int wave, int lane) {
    unsigned char* ws = p.ws;
    const int gw = vcu * NWAVES + wave, NGW = G * NWAVES;
    const f32x4* g4 = (const f32x4*)p.in[I_N2G] + lane;
    for (int m = gw; m < NTOK; m += NGW) {
        const f32x4* xr = (const f32x4*)(p.out + (size_t)m * 1024) + lane;
        f32x4 v[4]; float s = 0.f;
#pragma unroll
        for (int j = 0; j < 4; ++j) { v[j] = xr[64 * j]; s += (v[j].x * v[j].x + v[j].y * v[j].y) + (v[j].z * v[j].z + v[j].w * v[j].w); }
        const float rs = 1.0f / sqrtf(wave_sum(s) * (1.f / 1024.f) + NORM_EPS);
        float mx = 0.f;
#pragma unroll
        for (int j = 0; j < 4; ++j) { const f32x4 g = g4[64 * j]; v[j].x *= rs * g.x; v[j].y *= rs * g.y; v[j].z *= rs * g.z; v[j].w *= rs * g.w;
#ifdef PQ_BF16
            ((unsigned long long*)(ws + WS_XN2 + (size_t)m * 2048) + lane)[64 * j] = (unsigned long long)pk2(v[j].x, v[j].y) | ((unsigned long long)pk2(v[j].z, v[j].w) << 32);
#endif
            mx = fmaxf(mx, fmaxf(fmaxf(fabsf(v[j].x), fabsf(v[j].y)), fmaxf(fabsf(v[j].z), fabsf(v[j].w)))); }
#pragma unroll
        for (int o = 1; o < 64; o <<= 1) mx = fmaxf(mx, __shfl_xor(mx, o));
        const float inv = mx > 0.f ? 127.0f / mx : 0.f;
        unsigned* xq = (unsigned*)(ws + WS_XQ + (size_t)m * 1024) + lane;
#pragma unroll
        for (int j = 0; j < 4; ++j) { const int q0 = (int)rintf(v[j].x * inv), q1 = (int)rintf(v[j].y * inv), q2 = (int)rintf(v[j].z * inv), q3 = (int)rintf(v[j].w * inv);
            xq[64 * j] = (unsigned)(q0 & 255) | ((unsigned)(q1 & 255) << 8) | ((unsigned)(q2 & 255) << 16) | ((unsigned)(q3 & 255) << 24); }
        if (lane == 0) ((float*)(ws + WS_SX))[m] = mx > 0.f ? mx * (1.0f / 127.0f) : 1.0f;
    }
}

typedef __bf16 bf16x2_t __attribute__((ext_vector_type(2)));
__device__ __forceinline__ unsigned mono(float f) { const unsigned u = __builtin_bit_cast(unsigned, f); return u ^ ((unsigned)((int)u >> 31) | 0x80000000u); }
__device__ __forceinline__ float unmono(unsigned m) { const unsigned u = (m & 0x80000000u) ? (m ^ 0x80000000u) : ~m; return __builtin_bit_cast(float, u); }
__device__ __forceinline__ void ce_desc(unsigned& a, unsigned& b) { const unsigned hi = a > b ? a : b, lo = a > b ? b : a; a = hi; b = lo; }
template <int BASE, int N> __device__ __forceinline__ void bitonic_sort_desc(unsigned (&v)[N]) {
#pragma unroll
    for (int k = 2; k <= 16; k <<= 1)
#pragma unroll
        for (int j = k >> 1; j > 0; j >>= 1)
#pragma unroll
            for (int i = 0; i < 16; ++i) { const int l = i ^ j; if (l > i) { if ((i & k) == 0) ce_desc(v[BASE + i], v[BASE + l]); else ce_desc(v[BASE + l], v[BASE + i]); } }
}
template <int A, int B, int N> __device__ __forceinline__ void merge_top16(unsigned (&v)[N]) {
#pragma unroll
    for (int i = 0; i < 16; ++i) { const unsigned x = v[A + i], y = v[B + 15 - i]; v[A + i] = x > y ? x : y; }
#pragma unroll
    for (int j = 8; j > 0; j >>= 1)
#pragma unroll
        for (int i = 0; i < 16; ++i) { const int l = i ^ j; if (l > i) ce_desc(v[A + i], v[A + l]); }
}
constexpr int KS_STRIDE = 272;
constexpr int RT_KS_BYTES = 256 * KS_STRIDE;
constexpr int RT_TAB_WORDS = 33;
__device__ __forceinline__ void p11_route(const Params& p, LAS unsigned char* lds, int vcu, int G, int tid, int wave, int lane) {
    unsigned char* ws = p.ws;
    for (int i = tid; i < 256 * 16; i += NTHREADS) { const int row = i >> 4, ch = i & 15; *(LAS v4u*)(lds + row * KS_STRIDE + ch * 16) = *((const v4u*)(ws + WS_KS) + i); }
    __syncthreads();
    LAS unsigned* tab = (LAS unsigned*)(lds + RT_KS_BYTES) + (wave * 64 + lane) * RT_TAB_WORDS;
    const int r32 = lane & 31, hi = lane >> 5;
    const int gw = vcu * NWAVES + wave, NGW = G * NWAVES;
    const bf16* PQ = (const bf16*)(ws + WS_PQ);
    int* IDS = (int*)(ws + WS_IDS); float* GATES = (float*)(ws + WS_GATES);
    for (int task = gw; task < (NTOK / 32) * 8; task += NGW) {
        const int tb = task >> 3, h = task & 7;
        const int token = tb * 32 + r32;
        unsigned v[128];
        {
            const bf16* qrow = PQ + (size_t)token * 2048 + h * 256 + hi * 8;
#pragma unroll
            for (int t = 0; t < 4; ++t) {
                f32x16v acc[2];
#pragma unroll
                for (int w = 0; w < 2; ++w) {
                    f32x16v c = {};
                    const LAS unsigned char* kb = lds + (w * 128 + t * 32 + r32) * KS_STRIDE + hi * 16;
#pragma unroll
                    for (int s = 0; s < 8; ++s) { const bf16x8 a = *(const LAS bf16x8*)(kb + s * 32); const bf16x8 qf = *(const bf16x8*)(qrow + w * 128 + 16 * s); c = __builtin_amdgcn_mfma_f32_32x32x16_bf16(a, qf, c, 0, 0, 0); }
                    acc[w] = c;
                }
#pragma unroll
                for (int r = 0; r < 16; ++r) {
                    const float xa = acc[0][r], xb = acc[1][r];
                    auto rr = __builtin_amdgcn_permlane32_swap(__float_as_uint(xa), __float_as_uint(xb), false, false);
                    const unsigned r0 = rr[0], r1 = rr[1];
                    const int cr = (r & 3) + 8 * (r >> 2);
                    v[t * 16 + r] = (mono(__uint_as_float(r0)) & ~0x7Fu) | (unsigned)(32 * t + cr);
                    v[64 + t * 16 + r] = (mono(__uint_as_float(r1)) & ~0x7Fu) | (unsigned)(32 * t + cr + 4);
                }
            }
        }
        bitonic_sort_desc<0>(v); bitonic_sort_desc<16>(v); bitonic_sort_desc<32>(v); bitonic_sort_desc<48>(v);
        bitonic_sort_desc<64>(v); bitonic_sort_desc<80>(v); bitonic_sort_desc<96>(v); bitonic_sort_desc<112>(v);
        merge_top16<0, 16>(v); merge_top16<32, 48>(v); merge_top16<64, 80>(v); merge_top16<96, 112>(v);
        merge_top16<0, 32>(v); merge_top16<64, 96>(v);
        merge_top16<0, 64>(v);
        unsigned T[16], U[16];
#pragma unroll
        for (int i = 0; i < 16; ++i) { auto rr = __builtin_amdgcn_permlane32_swap(v[i], v[i], false, false); T[i] = v[i]; U[i] = hi ? rr[0] : rr[1]; }
        { const int bT = hi ? 16 : 0, bU = hi ? 0 : 16;
#pragma unroll
          for (int i = 0; i < 16; ++i) { tab[bT + i] = T[i] & 0x7Fu; tab[bU + i] = U[i] & 0x7Fu; } }
        float tv[16], uv[16];
#pragma unroll
        for (int i = 0; i < 16; ++i) { tv[i] = unmono(T[i] & ~0x7Fu); uv[i] = unmono(U[i] & ~0x7Fu); }
        unsigned c[32];
        {
            int n = 0;
#pragma unroll
            for (int i = 0; i < 4; ++i)
#pragma unroll
                for (int j = i; j < 16; ++j) if ((i + 1) * (j + 1) <= 16) {
                    const float s = tv[i] + uv[j];
                    const unsigned pay = hi ? (unsigned)((j << 4) | i) : (unsigned)((i << 4) | j);
                    unsigned key = (mono(s) & ~0xFFu) | pay;
                    if (i == j && hi) key = 0u;
                    c[n++] = key;
                }
#pragma unroll
            for (int k = 27; k < 32; ++k) c[k] = 0u;
        }
        bitonic_sort_desc<0>(c); bitonic_sort_desc<16>(c); merge_top16<0, 16>(c);
        unsigned W[32];
#pragma unroll
        for (int i = 0; i < 16; ++i) { auto rr = __builtin_amdgcn_permlane32_swap(c[i], c[i], false, false); W[i] = rr[0]; W[16 + i] = rr[1]; }
        merge_top16<0, 16>(W);
        asm volatile("s_waitcnt lgkmcnt(0)" ::: "memory");
        if (!hi) {
            int ids[16];
#pragma unroll
            for (int k = 0; k < 16; ++k) ids[k] = (int)(tab[(W[k] >> 4) & 15u] * 128u + tab[16 + (W[k] & 15u)]);
            int* o = IDS + (size_t)token * 128 + h * 16;
#pragma unroll
            for (int k = 0; k < 16; k += 4) *(v4u*)(o + k) = (v4u){(unsigned)ids[k], (unsigned)ids[k + 1], (unsigned)ids[k + 2], (unsigned)ids[k + 3]};
        } else {
            float e[16]; const float s0 = unmono(W[0] & ~0xFFu); float sum = 0.f;
#pragma unroll
            for (int k = 0; k < 16; ++k) { e[k] = __expf(unmono(W[k] & ~0xFFu) - s0); sum += e[k]; }
            const float inv = 1.0f / sum;
            float* o = GATES + (size_t)token * 128 + h * 16;
#pragma unroll
            for (int k = 0; k < 16; k += 4) *(f32x4*)(o + k) = (f32x4){e[k] * inv, e[k + 1] * inv, e[k + 2] * inv, e[k + 3] * inv};
        }
        asm volatile("s_waitcnt lgkmcnt(0)" ::: "memory");
    }
}

constexpr size_t WS_PART = 420 * MiB;
__device__ __forceinline__ int dpp_isum8(int x) {
    x += __builtin_amdgcn_update_dpp(0, x, 0xB1, 0xF, 0xF, true);
    x += __builtin_amdgcn_update_dpp(0, x, 0x4E, 0xF, 0xF, true);
    x += __builtin_amdgcn_update_dpp(0, x, 0x141, 0xF, 0xF, true);
    return x;
}
__device__ __forceinline__ void p12a_partial(const Params& p, int bid, int G, int wave, int lane) {
    unsigned char* ws = p.ws;
    const int s = bid & 7, wx = (bid >> 3) * NWAVES + wave, NWX = (G >> 3) * NWAVES;
    const int eg = lane >> 3, cj = lane & 7;
    const unsigned char* XQ = ws + WS_XQ + 128 * s + 16 * cj; const int* IDS = (const int*)(ws + WS_IDS); int* PART = (int*)(ws + WS_PART);
    const unsigned char* Us = ws + WS_U8 + 128 * s + 16 * cj;
    for (int t = wx; t < NTOK; t += NWX) {
        const v4u xs = *(const v4u*)(XQ + (size_t)t * 1024);
        const int xx = (int)xs.x, xy = (int)xs.y, xz = (int)xs.z, xw = (int)xs.w;
        const v4u* idp = (const v4u*)(IDS + (size_t)t * 128 + 16 * eg);
        int ids[16];
#pragma unroll
        for (int q = 0; q < 4; ++q) { const v4u iv = idp[q]; ids[4 * q] = (int)iv.x; ids[4 * q + 1] = (int)iv.y; ids[4 * q + 2] = (int)iv.z; ids[4 * q + 3] = (int)iv.w; }
        v4u u[16];
#pragma unroll
        for (int i = 0; i < 16; ++i) u[i] = *(const v4u*)(Us + (size_t)ids[i] * 1024);
        int k0 = 0, k1 = 0;
#pragma unroll
        for (int i = 0; i < 16; ++i) {
            const int ux = (int)u[i].x, uy = (int)u[i].y, uz = (int)u[i].z, uw = (int)u[i].w;
            int d = __builtin_amdgcn_sdot4(ux, xx, 0, false); d = __builtin_amdgcn_sdot4(uy, xy, d, false); d = __builtin_amdgcn_sdot4(uz, xz, d, false); d = __builtin_amdgcn_sdot4(uw, xw, d, false);
            d = dpp_isum8(d);
            if (i < 8) k0 = (cj == i) ? d : k0; else k1 = (cj == i - 8) ? d : k1;
        }
        int* po = PART + ((size_t)s * NTOK + t) * 128 + 16 * eg + cj;
        __builtin_nontemporal_store(k0, po); __builtin_nontemporal_store(k1, po + 8);
    }
}
constexpr size_t WS_WQ = 84 * MiB;
constexpr size_t WS_WSC = 92 * MiB;
__device__ __forceinline__ float dpp_max16(float x) {
    x = fmaxf(x, __builtin_bit_cast(float, __builtin_amdgcn_update_dpp(0, __builtin_bit_cast(int, x), 0xB1, 0xF, 0xF, true)));
    x = fmaxf(x, __builtin_bit_cast(float, __builtin_amdgcn_update_dpp(0, __builtin_bit_cast(int, x), 0x4E, 0xF, 0xF, true)));
    x = fmaxf(x, __builtin_bit_cast(float, __builtin_amdgcn_update_dpp(0, __builtin_bit_cast(int, x), 0x141, 0xF, 0xF, true)));
    x = fmaxf(x, __builtin_bit_cast(float, __builtin_amdgcn_update_dpp(0, __builtin_bit_cast(int, x), 0x140, 0xF, 0xF, true)));
    return x;
}
__device__ __forceinline__ void p12b_combine(const Params& p, int vcu, int G, int wave, int lane) {
    unsigned char* ws = p.ws;
    const int gw = vcu * NWAVES + wave, NGW = G * NWAVES;
    const int* PART = (const int*)(ws + WS_PART); const float* GW = (const float*)(ws + WS_GATES); const int* IDS = (const int*)(ws + WS_IDS);
    const float* SU = (const float*)(ws + WS_SU); const float* SV = (const float*)(ws + WS_SV);
    for (int t = gw; t < NTOK; t += NGW) {
        int a0 = 0, a1 = 0;
#pragma unroll
        for (int s = 0; s < 8; ++s) { const int* pp = PART + ((size_t)s * NTOK + t) * 128; a0 += __builtin_nontemporal_load(pp + lane); a1 += __builtin_nontemporal_load(pp + lane + 64); }
        const int id0 = IDS[(size_t)t * 128 + lane], id1 = IDS[(size_t)t * 128 + lane + 64];
        const float sx = ((const float*)(ws + WS_SX))[t];
        const float h0 = (float)a0 * SU[id0] * sx, h1 = (float)a1 * SU[id1] * sx;
        const float* g = GW + (size_t)t * 128;
        const float w0 = g[lane] * 0.5f * h0 * (1.0f + erff(h0 * 0.70710678118654752f)) * SV[id0];
        const float w1 = g[lane + 64] * 0.5f * h1 * (1.0f + erff(h1 * 0.70710678118654752f)) * SV[id1];
        const float m0 = dpp_max16(fabsf(w0)), m1 = dpp_max16(fabsf(w1));
        const float i0 = m0 > 0.f ? 127.0f / m0 : 0.f, i1 = m1 > 0.f ? 127.0f / m1 : 0.f;
        signed char* wq = (signed char*)(ws + WS_WQ) + (size_t)t * 128;
        wq[lane] = (signed char)(int)rintf(w0 * i0); wq[lane + 64] = (signed char)(int)rintf(w1 * i1);
        if ((lane & 15) == 0) { float* sc = (float*)(ws + WS_WSC) + (size_t)t * 8; sc[lane >> 4] = m0 * (1.0f / 127.0f); sc[4 + (lane >> 4)] = m1 * (1.0f / 127.0f); }
    }
}
template <bool DRY> __device__ __forceinline__ void p12c_output(const Params& p, int bid, int G, int wave, int lane) {
    unsigned char* ws = p.ws;
    const int s = bid & 7, wx = (bid >> 3) * NWAVES + wave, NWX = (G >> 3) * NWAVES;
    const int eg = lane >> 3, cj = lane & 7;
    const int b5 = (lane >> 5) & 1, b4 = (lane >> 4) & 1, b3 = (lane >> 3) & 1;
    const int* IDS = (const int*)(ws + WS_IDS); const unsigned char* WQ = ws + WS_WQ; const float* WSC = (const float*)(ws + WS_WSC);
    const unsigned char* Vs = ws + WS_V8 + 128 * s + 16 * cj;
    const int ocol = 128 * s + 16 * cj + 8 * b5 + 4 * b4 + 2 * b3;
    typedef float f32x2 __attribute__((ext_vector_type(2)));
    for (int t = wx; t < NTOK; t += NWX) {
        const v4u* idp = (const v4u*)(IDS + (size_t)t * 128 + 16 * eg);
        int ids[16];
#pragma unroll
        for (int q = 0; q < 4; ++q) { const v4u iv = idp[q]; ids[4 * q] = (int)iv.x; ids[4 * q + 1] = (int)iv.y; ids[4 * q + 2] = (int)iv.z; ids[4 * q + 3] = (int)iv.w; }
        const v4u wqv = *(const v4u*)(WQ + (size_t)t * 128 + 16 * eg);
        const float wsc = WSC[(size_t)t * 8 + eg];
        const f32x2 hres = __builtin_nontemporal_load((const f32x2*)(p.out + (size_t)t * 1024 + ocol));
        v4u vv[16];
#pragma unroll
        for (int i = 0; i < 16; ++i) vv[i] = *(const v4u*)(Vs + (size_t)ids[i] * 1024);
        int acc[16];
#pragma unroll
        for (int k = 0; k < 16; ++k) acc[k] = 0;
        const unsigned wqd[4] = {wqv.x, wqv.y, wqv.z, wqv.w};
#pragma unroll
        for (int j = 0; j < 4; ++j) {
            const unsigned r0[4] = {vv[4 * j].x, vv[4 * j].y, vv[4 * j].z, vv[4 * j].w}, r1[4] = {vv[4 * j + 1].x, vv[4 * j + 1].y, vv[4 * j + 1].z, vv[4 * j + 1].w};
            const unsigned r2[4] = {vv[4 * j + 2].x, vv[4 * j + 2].y, vv[4 * j + 2].z, vv[4 * j + 2].w}, r3[4] = {vv[4 * j + 3].x, vv[4 * j + 3].y, vv[4 * j + 3].z, vv[4 * j + 3].w};
#pragma unroll
            for (int d = 0; d < 4; ++d) {
                const unsigned l01 = __builtin_amdgcn_perm(r1[d], r0[d], 0x05010400u), h01 = __builtin_amdgcn_perm(r1[d], r0[d], 0x07030602u);
                const unsigned l23 = __builtin_amdgcn_perm(r3[d], r2[d], 0x05010400u), h23 = __builtin_amdgcn_perm(r3[d], r2[d], 0x07030602u);
                const unsigned c0 = __builtin_amdgcn_perm(l23, l01, 0x05040100u), c1 = __builtin_amdgcn_perm(l23, l01, 0x07060302u);
                const unsigned c2 = __builtin_amdgcn_perm(h23, h01, 0x05040100u), c3 = __builtin_amdgcn_perm(h23, h01, 0x07060302u);
                acc[4 * d + 0] = __builtin_amdgcn_sdot4((int)c0, (int)wqd[j], acc[4 * d + 0], false); acc[4 * d + 1] = __builtin_amdgcn_sdot4((int)c1, (int)wqd[j], acc[4 * d + 1], false);
                acc[4 * d + 2] = __builtin_amdgcn_sdot4((int)c2, (int)wqd[j], acc[4 * d + 2], false); acc[4 * d + 3] = __builtin_amdgcn_sdot4((int)c3, (int)wqd[j], acc[4 * d + 3], false);
            }
        }
        float o[16];
#pragma unroll
        for (int k = 0; k < 16; ++k) o[k] = (float)acc[k] * wsc;
        float r8[8], r4[4], r2v[2];
#pragma unroll
        for (int j = 0; j < 8; ++j) { const float keep = b5 ? o[8 + j] : o[j], send = b5 ? o[j] : o[8 + j]; r8[j] = keep + __shfl_xor(send, 32); }
#pragma unroll
        for (int j = 0; j < 4; ++j) { const float keep = b4 ? r8[4 + j] : r8[j], send = b4 ? r8[j] : r8[4 + j]; r4[j] = keep + __shfl_xor(send, 16); }
#pragma unroll
        for (int j = 0; j < 2; ++j) { const float keep = b3 ? r4[2 + j] : r4[j], send = b3 ? r4[j] : r4[2 + j]; r2v[j] = keep + __shfl_xor(send, 8); }
        const f32x2 res = {hres.x + r2v[0], hres.y + r2v[1]};
        __builtin_nontemporal_store(res, (f32x2*)((DRY ? (float*)(ws + WS_PART) : p.out) + (size_t)t * 1024 + ocol));
    }
}

#if DIAG
constexpr size_t WS_DIAG = 1006 * MiB;
constexpr size_t WS_DSAVE = 1007 * MiB;
__device__ __forceinline__ unsigned dhash(unsigned x) { x ^= x >> 16; x *= 0x7feb352dU; x ^= x >> 15; x *= 0x846ca68bU; x ^= x >> 16; return x; }
__device__ __forceinline__ float bf2f(bf16 b) { return __builtin_bit_cast(float, (unsigned)b << 16); }
__device__ __forceinline__ float rbf(float x) { return bf2f((bf16)f2bf(x)); }
__device__ __forceinline__ void diag_report(const Params& p, int stage, float err) {
    if (!(err == err)) err = 1e30f;
#pragma unroll
    for (int o = 1; o < 64; o <<= 1) err = fmaxf(err, __shfl_xor(err, o));
    int t_ = threadIdx.x; asm volatile("" : "+v"(t_)); if ((t_ & 63) == 0) atomicMax((unsigned*)(p.ws + WS_DIAG) + stage, __builtin_bit_cast(unsigned, err));
}
#define DG_IDS() int tid_ = threadIdx.x; asm volatile("" : "+v"(tid_)); const int tid = tid_, lane = tid & 63; int G_ = gridDim.x; asm volatile("" : "+s"(G_)); const int gt = blockIdx.x * NTHREADS + tid, NGT = G_ * NTHREADS; const int gwv = gt >> 6, NGWV = NGT >> 6; (void)lane; (void)gwv; (void)NGWV; (void)NGT
__device__ __forceinline__ float relerr(float got, float ref, float fl) { return fabsf(got - ref) / (fabsf(ref) + fl); }

__device__ __forceinline__ void dg_p0(const Params& p) {
    DG_IDS(); unsigned char* ws = p.ws; float e1 = 0.f, e2 = 0.f;
    for (int s = gwv; s < 4096; s += NGWV) {
        const int m = dhash(s * 7 + 1) % R; const int b = m / TP, pp = m - b * TP;
        const bf16* xn = (const bf16*)(ws + WS_XN) + (size_t)m * 1024;
        if (pp < 48) { for (int c = lane; c < 1024; c += 64) e1 = fmaxf(e1, fabsf(bf2f(xn[c]))); continue; }
        const float* xr = (pp < 64) ? p.in[I_META] + (size_t)(pp - 48) * 1024 : p.in[I_X] + ((size_t)b * SEQ + (pp - 64)) * 1024;
        float ss = 0.f; for (int c = lane; c < 1024; c += 64) ss += xr[c] * xr[c];
        ss = wave_sum(ss); const float rs = 1.0f / sqrtf(ss / 1024.f + NORM_EPS);
        for (int c = lane; c < 1024; c += 64) e1 = fmaxf(e1, relerr(bf2f(xn[c]), xr[c] * rs * p.in[I_N1G][c], 0.05f));
    }
    for (int s = gt; s < 200000; s += NGT) {
        const unsigned hsh = dhash(s * 3 + 5); const int k = hsh & 1023, n = (hsh >> 10) % N1; const int sc = win_src_col(n);
        const float ref = sc >= 0 ? p.in[I_WIN][(size_t)k * IN_COLS + sc] : 0.f;
        e2 = fmaxf(e2, fabsf(bf2f(((const bf16*)(ws + WS_WTIN))[(size_t)n * 1024 + k]) - rbf(ref)));
        const int n2 = (hsh >> 10) & 2047;
        e2 = fmaxf(e2, fabsf(bf2f(((const bf16*)(ws + WS_WTQ))[(size_t)n2 * 1024 + k]) - rbf(p.in[I_PWQ][(size_t)k * 2048 + n2])));
        const int n3 = n2 & 1023, k3 = k & 511;
        e2 = fmaxf(e2, fabsf(bf2f(((const bf16*)(ws + WS_WTFOX))[(size_t)n3 * 512 + k3]) - rbf(p.in[I_WFOX][(size_t)k3 * 1024 + n3])));
        e2 = fmaxf(e2, fabsf(bf2f(((const bf16*)(ws + WS_WTRWKV))[(size_t)n3 * 512 + k3]) - rbf(p.in[I_WRWKV][(size_t)k3 * 1024 + n3])));
        e2 = fmaxf(e2, fabsf(bf2f(((const bf16*)(ws + WS_WTOUT))[(size_t)n3 * 1024 + k]) - rbf(p.in[I_WOUT][(size_t)k * 1024 + n3])));
        const size_t ei = (size_t)(hsh % (16384u * 1024u)); const int er = (int)(ei >> 10);
        { const float sc = ((const float*)(ws + WS_SU))[er]; const float dq = (float)((const signed char*)(ws + WS_U8))[ei] * sc; e2 = fmaxf(e2, fmaxf(fabsf(dq - p.in[I_PU][ei]) - 0.51f * sc, 0.f)); }
        { const float sc = ((const float*)(ws + WS_SV))[er]; const float dq = ((float)((const unsigned char*)(ws + WS_V8))[ei] - 128.f) * sc; e2 = fmaxf(e2, fmaxf(fabsf(dq - p.in[I_PV][ei]) - 0.51f * sc, 0.f)); }
    }
    diag_report(p, 1, e1 / 0.03f); diag_report(p, 2, e2 / 1e-6f);
}
__device__ __forceinline__ float dg_dot(const bf16* A, size_t row, const bf16* Bt, size_t n, int K) {
    const bf16* a = A + row * K; const bf16* b = Bt + n * K; float s = 0.f;
    for (int k = 0; k < K; k += 8) { float x[8], y[8]; unpack8(*(const v4u*)(a + k), x); unpack8(*(const v4u*)(b + k), y);
#pragma unroll
        for (int e = 0; e < 8; ++e) s = fmaf(x[e], y[e], s); }
    return s;
}
__device__ __forceinline__ void dg_gemm1(const Params& p) {
    DG_IDS(); unsigned char* ws = p.ws; float e = 0.f;
    for (int s = gt; s < 262144; s += NGT) {
        const unsigned hsh = dhash(s * 11 + 3); const int row = hsh % R, n = dhash(hsh) % N1;
        const float ref = dg_dot((const bf16*)(ws + WS_XN), row, (const bf16*)(ws + WS_WTIN), n, 1024);
        float got, want;
        if (n < 3584) { got = bf2f(((const bf16*)(ws + WS_F))[(size_t)(n >> 9) * ((size_t)R * 512) + (size_t)row * 512 + (n & 511)]); want = ref; }
        else { got = bf2f(((const bf16*)(ws + WS_ZG))[(size_t)row * 2048 + (n - 3584)]); want = 1.0f / (1.0f + expf(-ref)); }
        e = fmaxf(e, relerr(got, want, 0.25f));
    }
    diag_report(p, 3, e / 0.02f);
}
__device__ __forceinline__ void dg_p2(const Params& p) {
    DG_IDS(); unsigned char* ws = p.ws; float e = 0.f;
    for (int s = gt; s < 262144; s += NGT) {
        const unsigned hsh = dhash(s * 13 + 7); const int m = hsh % R, c = dhash(hsh) % 296; const int pp = m % TP;
        const bf16* zm = (const bf16*)(ws + WS_ZM);
        const float z = bf2f(zm[(size_t)m * 512 + c]);
        if (c >= 288) { const float x = z + p.in[I_FBIAS][c - 288]; const float want = -log1pf(expf(-x)); e = fmaxf(e, relerr(((const float*)(ws + WS_LF))[(size_t)m * 8 + (c - 288)], want, 0.01f)); continue; }
        const float zp = pp > 0 ? bf2f(zm[(size_t)(m - 1) * 512 + c]) : 0.f; const float mu = p.in[I_MU][1536 + c];
        const float zs = z + mu * (zp - z);
        if (c < 64) e = fmaxf(e, relerr(bf2f(((const bf16*)(ws + WS_LA))[(size_t)m * 128 + c]), tanhf(zs), 0.1f));
        else if (c < 128) e = fmaxf(e, relerr(bf2f(((const bf16*)(ws + WS_LA))[(size_t)m * 128 + c]), zs, 0.1f));
        else e = fmaxf(e, relerr(bf2f(((const bf16*)(ws + WS_LG))[(size_t)m * 256 + (c - 128)]), 1.0f / (1.0f + expf(-zs)), 0.1f));
        if (pp >= 48) { const int h = c & 7; float sq = 0.f, sk = 0.f;
            for (int d = 0; d < 64; ++d) { const float q = bf2f(((const bf16*)(ws + WS_FQ))[(size_t)m * 512 + h * 64 + d]) / (p.in[I_FQN][h * 64 + d] * attn_body::C2); sq += q * q;
                const float k = bf2f(((const bf16*)(ws + WS_FK))[(size_t)m * 512 + h * 64 + d]) / p.in[I_FKN][h * 64 + d]; sk += k * k; }
            e = fmaxf(e, fabsf(sq / 64.f - 1.f)); e = fmaxf(e, fabsf(sk / 64.f - 1.f)); }
    }
    diag_report(p, 4, e / 0.03f);
}
__device__ __forceinline__ void dg_p3(const Params& p) {
    DG_IDS(); unsigned char* ws = p.ws; unsigned char* dob = (unsigned char*)p.out; float e5 = 0.f, e6 = 0.f;
    for (int s = gt; s < 131072; s += NGT) {
        const unsigned hsh = dhash(s * 17 + 9); const int seq = hsh & 127, pp = (hsh >> 7) % TP; const int b = seq >> 3, h = seq & 7;
        const float* kb = (const float*)(ws + WS_KB) + (size_t)seq * TP; const float lf = ((const float*)(ws + WS_LF))[((size_t)b * TP + pp) * 8 + h];
        if (pp < 48) e5 = fmaxf(e5, kb[pp] < -1e29f ? 0.f : 1.f);
        else if (pp == 48) e5 = fmaxf(e5, fabsf(kb[pp] + lf * LOG2E));
        else e5 = fmaxf(e5, fabsf((kb[pp] - kb[pp - 1]) + lf * LOG2E));
        const int m = dhash(hsh) % R, c = dhash(hsh + 1) % 1536;
        const bf16* la = (const bf16*)(ws + WS_LA) + (size_t)m * 128; const bf16* lg = (const bf16*)(ws + WS_LG) + (size_t)m * 256;
        if (c < 512) { float a = p.in[I_W0][c]; for (int k = 0; k < 64; ++k) a += bf2f(la[k]) * rbf(p.in[I_WUP][k * 512 + c]);
            const float w = -log1pf(expf(-a)) - 0.5f; const float want = 1.0f - expf(-expf(w));
            e6 = fmaxf(e6, relerr(bf2f(((const bf16*)(dob + DO_XW))[(size_t)m * 512 + c]), want, 0.002f)); }
        else if (c < 1024) { float a = p.in[I_A0][c - 512]; for (int k = 0; k < 64; ++k) a += bf2f(la[64 + k]) * rbf(p.in[I_AUP][k * 512 + (c - 512)]);
            e6 = fmaxf(e6, relerr(bf2f(((const bf16*)(dob + DO_AA))[(size_t)m * 512 + (c - 512)]), 1.0f / (1.0f + expf(-a)), 0.05f)); }
        else { float a = 0.f; for (int k = 0; k < 160; ++k) a += bf2f(lg[k]) * rbf(p.in[I_GUP][k * 512 + (c - 1024)]);
            e6 = fmaxf(e6, relerr(bf2f(((const bf16*)(dob + DO_GG))[(size_t)m * 512 + (c - 1024)]), a, 0.1f)); }
    }
    diag_report(p, 5, e5 / 1e-3f); diag_report(p, 6, e6 / 0.03f);
}
constexpr int DG_NS4 = 2048;
__device__ __forceinline__ void dg_p4_pre(const Params& p) {
    DG_IDS(); unsigned char* dob = (unsigned char*)p.out; float* sv = (float*)(p.ws + WS_DSAVE);
    for (int s = gt; s < DG_NS4 * 64; s += NGT) { const int i = s >> 6, d = s & 63; const unsigned hsh = dhash(i * 19 + 11); const int m = hsh % R, h = (hsh >> 20) & 7;
        sv[s] = bf2f(((const bf16*)(dob + DO_AA))[(size_t)m * 512 + h * 64 + d]); }
}
__device__ __forceinline__ void dg_p4_post(const Params& p) {
    DG_IDS(); unsigned char* ws = p.ws; unsigned char* dob = (unsigned char*)p.out; const float* sv = (const float*)(ws + WS_DSAVE); float e = 0.f;
    for (int i = gwv; i < DG_NS4; i += NGWV) {
        const unsigned hsh = dhash(i * 19 + 11); const int m = hsh % R, h = (hsh >> 20) & 7; const int pp = m % TP; const int c = h * 64 + lane;
        const float a = sv[i * 64 + lane];
        const float r0 = bf2f(((const bf16*)(ws + WS_ZRR))[(size_t)m * 512 + c]), k0 = bf2f(((const bf16*)(ws + WS_ZRK))[(size_t)m * 512 + c]);
        const float r1 = pp > 0 ? bf2f(((const bf16*)(ws + WS_ZRR))[(size_t)(m - 1) * 512 + c]) : 0.f, k1 = pp > 0 ? bf2f(((const bf16*)(ws + WS_ZRK))[(size_t)(m - 1) * 512 + c]) : 0.f;
        const float rs = r0 + p.in[I_MU][c] * (r1 - r0), ks = k0 + p.in[I_MU][512 + c] * (k1 - k0);
        const float kk = ks * p.in[I_KK][c], kp = ks * (1.0f + (a - 1.0f) * p.in[I_KA][c]);
        const float nrm = fmaxf(sqrtf(wave_sum(kk * kk)), 1e-12f); const float kn = kk / nrm, bb = kn * a; const float bs = wave_sum(rs * kp * p.in[I_RK][c]);
        e = fmaxf(e, relerr(bf2f(((const bf16*)(ws + WS_KP))[(size_t)m * 512 + c]), kp, 0.1f));
        e = fmaxf(e, relerr(bf2f(((const bf16*)(ws + WS_KN))[(size_t)m * 512 + c]), kn, 0.02f));
        e = fmaxf(e, relerr(bf2f(((const bf16*)(dob + DO_AA))[(size_t)m * 512 + c]), bb, 0.02f));
        e = fmaxf(e, relerr(((const float*)(ws + WS_BS))[(size_t)m * 8 + h], bs, 0.1f));
    }
    diag_report(p, 7, e / 0.03f);
}
constexpr int DG_NS8 = 1024;
__device__ __forceinline__ void dg_attn_sample(int i, int& b, int& h, int& t) { const unsigned hsh = dhash(i * 23 + 13); b = hsh & 15; h = (hsh >> 4) & 7; t = (hsh >> 8) & 4095; if (i < 8) t = (i & 1) ? 4095 - (i >> 1) : (i >> 1); }
__device__ __forceinline__ void dg_attn_pre(const Params& p) {
    DG_IDS(); float* sv = (float*)(p.ws + WS_DSAVE + 512 * 1024);
    for (int s = gt; s < DG_NS8 * 64; s += NGT) { const int i = s >> 6, d = s & 63; int b, h, t; dg_attn_sample(i, b, h, t);
        sv[s] = bf2f(((const bf16*)(p.ws + WS_FQ))[((size_t)b * TP + 64 + t) * 512 + h * 64 + d]); }
}
__device__ __forceinline__ void dg_attn_post(const Params& p) {
    DG_IDS(); unsigned char* ws = p.ws; const float* sv = (const float*)(ws + WS_DSAVE + 512 * 1024); float e = 0.f;
    for (int i = gwv; i < DG_NS8; i += NGWV) {
        int b, h, t; dg_attn_sample(i, b, h, t);
        const int npos = 64 + t;
        const float* kb = (const float*)(ws + WS_KB) + (size_t)(b * 8 + h) * TP;
        const bf16* K = (const bf16*)(ws + WS_FK) + (size_t)b * TP * 512 + h * 64; const bf16* V = (const bf16*)(ws + WS_FV) + (size_t)b * TP * 512 + h * 64;
        float mx = -1e38f;
        for (int j = 48 + lane; j <= npos; j += 64) { float s = 0.f; for (int d = 0; d < 64; ++d) s += sv[i * 64 + d] * bf2f(K[(size_t)j * 512 + d]); s += kb[j]; mx = fmaxf(mx, s); }
        for (int o = 1; o < 64; o <<= 1) mx = fmaxf(mx, __shfl_xor(mx, o));
        float l = 0.f, acc = 0.f;
        for (int j = 48; j <= npos; ++j) { float s = 0.f; for (int d = 0; d < 64; ++d) s += sv[i * 64 + d] * bf2f(K[(size_t)j * 512 + d]); const float pj = exp2f(s + kb[j] - mx); l += pj; acc += pj * bf2f(V[(size_t)j * 512 + lane]); }
        const float want = acc / l; const float got = bf2f(((const bf16*)(ws + WS_FQ))[((size_t)b * TP + 64 + t) * 512 + h * 64 + lane]);
        e = fmaxf(e, fabsf(got - want) / (fabsf(want) + 0.05f));
    }
    diag_report(p, 8, e / 0.05f);
}
__device__ __forceinline__ void dg_scan(const Params& p) {
    DG_IDS(); unsigned char* ws = p.ws; unsigned char* dob = (unsigned char*)p.out; float e = 0.f;
    if (gwv < 4) {
        const int bh = (gwv * 37 + 5) & 127, b = bh >> 3, h = bh & 7; const size_t rowb = (size_t)b * TP; const int cb = h * 64;
        float S[64];
#pragma unroll
        for (int k = 0; k < 64; ++k) S[k] = 0.f;
        const bf16* aXW = (const bf16*)(dob + DO_XW); const bf16* aA = (const bf16*)(dob + DO_AA); const bf16* aG = (const bf16*)(dob + DO_GG);
        const bf16* aR = (const bf16*)(ws + WS_ZRR); const bf16* aK = (const bf16*)(ws + WS_ZRK); const bf16* aV = (const bf16*)(ws + WS_ZRV);
        const float muv = p.in[I_MU][1024 + cb + lane];
#ifndef DG_SCAN_MAXPP
#define DG_SCAN_MAXPP TP
#endif
        for (int pp = 48; pp < DG_SCAN_MAXPP; ++pp) {
            const size_t ro = (rowb + pp) * 512 + cb;
            const float v0 = bf2f(aV[ro + lane]), v1 = bf2f(aV[ro - 512 + lane]); const float vv = v0 + muv * (v1 - v0);
            float ss = 0.f;
            for (int k = 0; k < 64; ++k) { const float k0 = bf2f(aK[ro + k]), k1 = bf2f(aK[ro - 512 + k]); const float ks = k0 + p.in[I_MU][512 + cb + k] * (k1 - k0); const float kk = ks * p.in[I_KK][cb + k]; ss += kk * kk; }
            const float inv = 1.0f / fmaxf(sqrtf(ss), 1e-12f);
            float sa = 0.f;
            for (int k = 0; k < 64; ++k) { const float k0 = bf2f(aK[ro + k]), k1 = bf2f(aK[ro - 512 + k]); const float ks = k0 + p.in[I_MU][512 + cb + k] * (k1 - k0); sa += S[k] * (ks * p.in[I_KK][cb + k] * inv); }
            sa = -sa; float y = 0.f, bon = 0.f;
#pragma unroll
            for (int k = 0; k < 64; ++k) { const float k0 = bf2f(aK[ro + k]), k1 = bf2f(aK[ro - 512 + k]); const float ks = k0 + p.in[I_MU][512 + cb + k] * (k1 - k0); const float a = bf2f(aA[ro + k]);
                const float kn = ks * p.in[I_KK][cb + k] * inv, kp = ks * (1.0f + (a - 1.0f) * p.in[I_KA][cb + k]);
                const float dec = 1.0f - bf2f(aXW[ro + k]); S[k] = S[k] * dec + sa * (kn * a) + vv * kp;
                const float r0 = bf2f(aR[ro + k]), r1 = bf2f(aR[ro - 512 + k]); const float rs = r0 + p.in[I_MU][cb + k] * (r1 - r0); y += S[k] * rs; bon += rs * kp * p.in[I_RK][cb + k]; }
            const float mean = wave_sum(y) * (1.f / 64.f); const float var = wave_sum((y - mean) * (y - mean)) * (1.f / 64.f);
            const float want = ((y - mean) / sqrtf(var + GN_EPS) * p.in[I_LNG][cb + lane] + p.in[I_LNB][cb + lane] + bon * vv) * bf2f(aG[ro + lane]);
            const float got = bf2f(((const bf16*)(ws + WS_Y))[ro + lane]);
            const float rms = sqrtf(wave_sum(want * want) * (1.f / 64.f));
            e = fmaxf(e, fabsf(got - want) / (fabsf(want) + 0.5f * rms + 0.02f));
        }
    }
    diag_report(p, 9, e / 0.05f);
}
__device__ __forceinline__ void dg_p6_pre(const Params& p) {
    DG_IDS(); float* sv = (float*)(p.ws + WS_DSAVE + 768 * 1024);
    for (int s = gt; s < DG_NS4 * 64; s += NGT) { const int i = s >> 6, d = s & 63; const unsigned hsh = dhash(i * 29 + 17); const int m = hsh % R, h = (hsh >> 20) & 7;
        sv[s] = bf2f(((const bf16*)(p.ws + WS_Y))[(size_t)m * 512 + h * 64 + d]); }
}
__device__ __forceinline__ void dg_p6_post(const Params& p) {
    DG_IDS(); unsigned char* ws = p.ws; unsigned char* dob = (unsigned char*)p.out; const float* sv = (const float*)(ws + WS_DSAVE + 768 * 1024); float e = 0.f;
    for (int i = gwv; i < DG_NS4; i += NGWV) {
        const unsigned hsh = dhash(i * 29 + 17); const int m = hsh % R, h = (hsh >> 20) & 7; const int pp = m % TP; const int c = h * 64 + lane;
        if (pp < 48) continue;
        const float y = sv[i * 64 + lane]; const float mean = wave_sum(y) / 64.f; const float var = wave_sum((y - mean) * (y - mean)) / 64.f;
        const float gn = (y - mean) / sqrtf(var + GN_EPS) * p.in[I_LNG][c] + p.in[I_LNB][c];
        const float v0 = bf2f(((const bf16*)(ws + WS_ZRV))[(size_t)m * 512 + c]), v1 = bf2f(((const bf16*)(ws + WS_ZRV))[(size_t)(m - 1) * 512 + c]);
        const float vs = v0 + p.in[I_MU][1024 + c] * (v1 - v0);
        const float want = (gn + ((const float*)(ws + WS_BS))[(size_t)m * 8 + h] * vs) * bf2f(((const bf16*)(dob + DO_GG))[(size_t)m * 512 + c]);
        e = fmaxf(e, relerr(bf2f(((const bf16*)(ws + WS_Y))[(size_t)m * 512 + c]), want, 0.1f));
    }
    diag_report(p, 10, e / 0.03f);
}
__device__ __forceinline__ void dg_mix(const Params& p, int stage) {
    DG_IDS(); unsigned char* ws = p.ws; float e = 0.f;
    for (int s = gt; s < 131072; s += NGT) {
        const unsigned hsh = dhash(s * 31 + 19 + stage); const int row = hsh % R, c = dhash(hsh) & 1023;
        float want = dg_dot((const bf16*)(ws + WS_FQ), row, (const bf16*)(ws + WS_WTFOX), c, 512) * bf2f(((const bf16*)(ws + WS_ZG))[(size_t)row * 2048 + c]);
        if (stage == 12) want = rbf(want) + dg_dot((const bf16*)(ws + WS_Y), row, (const bf16*)(ws + WS_WTRWKV), c, 512) * bf2f(((const bf16*)(ws + WS_ZG))[(size_t)row * 2048 + 1024 + c]);
        e = fmaxf(e, relerr(bf2f(((const bf16*)(ws + WS_MIX))[(size_t)row * 1024 + c]), want, 0.1f));
    }
    diag_report(p, stage, e / 0.03f);
}
__device__ __forceinline__ void dg_out(const Params& p) {
    DG_IDS(); unsigned char* ws = p.ws; float e = 0.f;
    for (int s = gt; s < 131072; s += NGT) {
        const unsigned hsh = dhash(s * 37 + 23); const int tok = hsh & 65535, c = dhash(hsh) & 1023; const int b = tok >> 12, t = tok & 4095;
        const float want = p.in[I_X][(size_t)tok * 1024 + c] + dg_dot((const bf16*)(ws + WS_MIX), (size_t)b * TP + 64 + t, (const bf16*)(ws + WS_WTOUT), c, 1024);
        e = fmaxf(e, relerr(p.out[(size_t)tok * 1024 + c], want, 0.3f));
    }
    diag_report(p, 13, e / 0.01f);
}
__device__ __forceinline__ void dg_norm2(const Params& p) {
    DG_IDS(); unsigned char* ws = p.ws; float e = 0.f;
    for (int s = gwv; s < 4096; s += NGWV) {
        const int m = dhash(s * 41 + 29) & 65535; const float* xr = p.out + (size_t)m * 1024;
        float ss = 0.f; for (int c = lane; c < 1024; c += 64) ss += xr[c] * xr[c];
        ss = wave_sum(ss); const float rs = 1.0f / sqrtf(ss / 1024.f + NORM_EPS);
        for (int c = lane; c < 1024; c += 64) e = fmaxf(e, relerr(bf2f(((const bf16*)(ws + WS_XN2))[(size_t)m * 1024 + c]), xr[c] * rs * p.in[I_N2G][c], 0.05f));
    }
    diag_report(p, 14, e / 0.03f);
}
__device__ __forceinline__ void dg_pq(const Params& p) {
    DG_IDS(); unsigned char* ws = p.ws; float e = 0.f;
    for (int s = gt; s < 131072; s += NGT) {
        const unsigned hsh = dhash(s * 43 + 31); const int tok = hsh & 65535, c = dhash(hsh) & 2047;
        const float want = dg_dot((const bf16*)(ws + WS_XN2), tok, (const bf16*)(ws + WS_WTQ), c, 1024);
        e = fmaxf(e, relerr(bf2f(((const bf16*)(ws + WS_PQ))[(size_t)tok * 2048 + c]), want, 0.25f));
    }
    diag_report(p, 15, e / 0.02f);
}
__device__ __forceinline__ void dg_route(const Params& p, LAS unsigned char* lds) {
    DG_IDS(); unsigned char* ws = p.ws; float e16 = 0.f, e17 = 0.f;
    LAS float* s2l = (LAS float*)lds + (tid >> 6) * 128;
    for (int i = gwv; i < 2048; i += NGWV) {
        const unsigned hsh = dhash(i * 47 + 37); const int tok = hsh & 65535, h = (hsh >> 16) & 7;
        const bf16* q = (const bf16*)(ws + WS_PQ) + (size_t)tok * 2048 + h * 256; const bf16* ks = (const bf16*)(ws + WS_KS);
        float s1a = 0.f, s1b = 0.f, s2a = 0.f, s2b = 0.f;
        for (int d = 0; d < 128; ++d) { const float q1 = bf2f(q[d]), q2 = bf2f(q[128 + d]);
            s1a += q1 * bf2f(ks[(size_t)lane * 128 + d]); s1b += q1 * bf2f(ks[(size_t)(lane + 64) * 128 + d]);
            s2a += q2 * bf2f(ks[(size_t)(128 + lane) * 128 + d]); s2b += q2 * bf2f(ks[(size_t)(192 + lane) * 128 + d]); }
        s2l[lane] = s2a; s2l[lane + 64] = s2b; asm volatile("s_waitcnt lgkmcnt(0)" ::: "memory");
        float prev_s = 3e38f; int prev_id = -1; float top_s[16]; int top_id[16];
#pragma unroll 1
        for (int r = 0; r < 16; ++r) {
            float bs = -3e38f; int bi = 0x7fffffff;
            for (int j = 0; j < 128; ++j) { const float t2 = s2l[j];
                { const float sm = s1a + t2; const int id = lane * 128 + j; const bool ok = (sm < prev_s) || (sm == prev_s && id > prev_id); if (ok && (sm > bs || (sm == bs && id < bi))) { bs = sm; bi = id; } }
                { const float sm = s1b + t2; const int id = (lane + 64) * 128 + j; const bool ok = (sm < prev_s) || (sm == prev_s && id > prev_id); if (ok && (sm > bs || (sm == bs && id < bi))) { bs = sm; bi = id; } } }
            for (int o = 1; o < 64; o <<= 1) { const float os = __shfl_xor(bs, o); const int oi = __shfl_xor(bi, o); if (os > bs || (os == bs && oi < bi)) { bs = os; bi = oi; } }
            top_s[r] = bs; top_id[r] = bi; prev_s = bs; prev_id = bi;
        }
        const int* ids = (const int*)(ws + WS_IDS) + (size_t)tok * 128 + h * 16; const float* gts = (const float*)(ws + WS_GATES) + (size_t)tok * 128 + h * 16;
        float den = 0.f;
#pragma unroll
        for (int r = 0; r < 16; ++r) den += expf(top_s[r] - top_s[0]);
        int miss = 0;
#pragma unroll
        for (int r = 0; r < 16; ++r) {
            bool found = false; for (int k = 0; k < 16; ++k) found |= (ids[k] == top_id[r]);
            if (!found && top_s[r] > top_s[15] + 2e-3f * fabsf(top_s[15]) + 1e-4f) ++miss;
            e17 = fmaxf(e17, fabsf(gts[r] - expf(top_s[r] - top_s[0]) / den));
        }
        e16 = fmaxf(e16, (float)miss);
        if (lane == 0 && miss) atomicAdd((float*)(ws + WS_DIAG) + 19, (float)miss);
    }
    diag_report(p, 16, e16 / 0.5f); diag_report(p, 17, e17 / 0.01f);
}
constexpr int DG_NS18 = 128;
__device__ __forceinline__ void dg_gather_pre(const Params& p) {
    DG_IDS(); float* sv = (float*)(p.ws + WS_DSAVE + 1280 * 1024);
    for (int s = gt; s < DG_NS18 * 1024; s += NGT) { const int i = s >> 10, c = s & 1023; const int tok = dhash(i * 53 + 41) & 65535; sv[s] = p.out[(size_t)tok * 1024 + c]; }
    for (int s = gt; s < DG_NS18 * 128; s += NGT) { const int i = s >> 7, ex = s & 127; const int tok = dhash(i * 53 + 41) & 65535; sv[DG_NS18 * 1024 + s] = ((const float*)(p.ws + WS_GATES))[(size_t)tok * 128 + ex]; }
}
__device__ __forceinline__ void dg_gather_post(const Params& p) {
    DG_IDS(); unsigned char* ws = p.ws; const float* sv = (const float*)(ws + WS_DSAVE + 1280 * 1024); float e = 0.f;
    for (int i = gwv; i < DG_NS18; i += NGWV) {
        const int tok = dhash(i * 53 + 41) & 65535;
        const int* ids = (const int*)(ws + WS_IDS) + (size_t)tok * 128; const float* gts = (const float*)(ws + WS_GATES) + (size_t)tok * 128;
        const signed char* xq = (const signed char*)(ws + WS_XQ) + (size_t)tok * 1024; const float sx = ((const float*)(ws + WS_SX))[tok];
        float o[16];
#pragma unroll
        for (int k = 0; k < 16; ++k) o[k] = 0.f;
        for (int ex = 0; ex < 128; ++ex) {
            const int id = ids[ex]; const signed char* ur = (const signed char*)(ws + WS_U8) + (size_t)id * 1024; const unsigned char* vr = ws + WS_V8 + (size_t)id * 1024;
            float d = 0.f;
#pragma unroll
            for (int k = 0; k < 16; ++k) d += (float)ur[lane * 16 + k] * (float)xq[lane * 16 + k];
            d = wave_sum(d) * ((const float*)(ws + WS_SU))[id] * sx;
            const float svs = ((const float*)(ws + WS_SV))[id];
            const float w = gts[ex];
            e = fmaxf(e, fabsf(w - sv[DG_NS18 * 1024 + i * 128 + ex] * 0.5f * d * (1.0f + erff(d * 0.70710678f)) * svs) / (0.02f * svs) * 0.05f);
#pragma unroll
            for (int k = 0; k < 16; ++k) o[k] += w * ((float)vr[lane * 16 + k] - 128.f);
        }
        float ss = 0.f;
#pragma unroll
        for (int k = 0; k < 16; ++k) ss += o[k] * o[k];
        const float rms = sqrtf(wave_sum(ss) / 1024.f);
#pragma unroll
        for (int k = 0; k < 16; ++k) e = fmaxf(e, fabsf((p.out[(size_t)tok * 1024 + lane * 16 + k] - sv[i * 1024 + lane * 16 + k]) - o[k]) / (rms + 1e-3f));
    }
    diag_report(p, 18, e / 0.05f);
}
__device__ __forceinline__ void dg_final(const Params& p) {
    DG_IDS(); const float* dg = (const float*)(p.ws + WS_DIAG);
    int k = 0;
    for (int s = 1; s <= 26; ++s) if (k == 0 && s != 19 && s != 20 && !(dg[s] <= 1.0f)) k = s;
#ifdef DIAG_SKIP
    { int kk = 0; for (int s = 1; s <= 26; ++s) if (kk == 0 && s > DIAG_SKIP && s != 19 && s != 20 && !(dg[s] <= 1.0f)) kk = s; k = kk; }
#endif
#ifdef DIAG_VALUE
    const float a = fminf(fmaxf(dg[DIAG_VALUE], 1e-3f), 1e6f) * 16.f;
#else
    const float a = exp2f((float)k);
#endif
    for (size_t i = gt; i < (size_t)NTOK * 1024 / 4; i += NGT) ((f32x4*)p.out)[i] = (f32x4){a, a, a, a};
}
#endif

#define XB_TMO      128
#define XB_XCNT(j)  (256  + 64 * (j))
#define XB_XSUB(j)  (1280 + 64 * (j))
#define XB_XGEN(j)  (2304 + 64 * (j))
#define XB_TOP      3328
#define XB_TOPGEN   3392
#define XCD_BAR_WORDS 3456
#if DIAG
#define XB_SPIN_CAP (1u << 28)
#else
#define XB_SPIN_CAP (1u << 18)
#endif

__device__ __forceinline__ unsigned xb_ld(unsigned* p)              { return __hip_atomic_load(p, __ATOMIC_RELAXED, __HIP_MEMORY_SCOPE_AGENT); }
__device__ __forceinline__ unsigned xb_add(unsigned* p, unsigned v) { return __hip_atomic_fetch_add(p, v, __ATOMIC_RELAXED, __HIP_MEMORY_SCOPE_AGENT); }
__device__ __forceinline__ unsigned xb_xcc_id() { return (unsigned)__builtin_amdgcn_s_getreg((3 << 11) | 20) & 0xFu; }
#define XB_SPIN(cond, bar) do { unsigned _sp = 0; while (cond) { __builtin_amdgcn_s_sleep(1); \
    if ((++_sp & 255u) == 0u) { if (xb_ld(&(bar)[XB_TMO])) break; if (_sp > XB_SPIN_CAP) { atomicAdd(&(bar)[XB_TMO], 1u); break; } } } } while (0)

struct XcdBarrier {
    unsigned* bar; unsigned x;
    volatile LAS unsigned* st;
};

__device__ __forceinline__ XcdBarrier xcd_barrier_post(unsigned* bar, volatile LAS unsigned* st) {
    XcdBarrier b; b.bar = bar; b.x = xb_xcc_id(); b.st = st;
    if (threadIdx.x == 0) (void)xb_add(&bar[XB_XCNT(b.x)], 1u);
    return b;
}
__device__ __forceinline__ void xcd_barrier_complete(unsigned* bar, unsigned x, unsigned& nloc, unsigned& nx) {
    const unsigned G = gridDim.x * gridDim.y * gridDim.z;
    unsigned sum, cnt, mine, sp = 0u;
    for (;;) {
        sum = 0u; cnt = 0u; mine = 0u;
#pragma unroll
        for (unsigned j = 0; j < 16; ++j) { const unsigned c = xb_ld(&bar[XB_XCNT(j)]); sum += c; cnt += (c > 0u) ? 1u : 0u; mine = (j == x) ? c : mine; }
        if (sum == G) break;
        __builtin_amdgcn_s_sleep(1);
        if ((++sp & 255u) == 0u) { if (xb_ld(&bar[XB_TMO])) break; if (sp > XB_SPIN_CAP) { atomicAdd(&bar[XB_TMO], 1u); break; } }
    }
    nloc = mine > 0u ? mine : 1u; nx = cnt > 0u ? cnt : 1u;
}

__device__ __forceinline__ void xcd_barrier(const XcdBarrier& b) {
    asm volatile("s_waitcnt vmcnt(0)" ::: "memory");
    __syncthreads();
    if (threadIdx.x == 0) {
        unsigned* bar = b.bar;
        __builtin_amdgcn_s_waitcnt(0);
        unsigned nloc = b.st[0], nx = b.st[1];
        if (nloc == 0u) { xcd_barrier_complete(bar, b.x, nloc, nx); b.st[0] = nloc; b.st[1] = nx; }
        const unsigned old = xb_add(&bar[XB_XSUB(b.x)], 1u);
        const unsigned gen = old / nloc;
        if (old + 1u == (gen + 1u) * nloc) {
            __builtin_amdgcn_fence(__ATOMIC_RELEASE, "agent");
            asm volatile("s_waitcnt vmcnt(0)" ::: "memory");
            const unsigned og = xb_add(&bar[XB_TOP], 1u);
            const unsigned tg = og / nx;
            if (og + 1u == (tg + 1u) * nx) xb_add(&bar[XB_TOPGEN], 1u);
            else XB_SPIN(xb_ld(&bar[XB_TOPGEN]) == tg, bar);
            __builtin_amdgcn_fence(__ATOMIC_ACQUIRE, "agent");
            xb_add(&bar[XB_XGEN(b.x)], 1u);
            asm volatile("s_waitcnt vmcnt(0)" ::: "memory");
        } else {
            XB_SPIN(xb_ld(&bar[XB_XGEN(b.x)]) == gen, bar);
            __builtin_amdgcn_fence(__ATOMIC_ACQUIRE, "agent");
            asm volatile("s_waitcnt vmcnt(0)" ::: "memory");
        }
    }
    __syncthreads();
}

#ifndef TIMING
#define TIMING 0
#endif
#if TIMING
#define TS(i) do { int t__ = threadIdx.x; asm volatile("" : "+v"(t__)); if (bid == 0 && t__ == 0) ((unsigned long long*)(ws + 1010 * MiB))[i] = __builtin_amdgcn_s_memrealtime(); } while (0)
#else
#define TS(i)
#endif
#if DIAG
#define DG(...) __VA_ARGS__
#else
#define DG(...)
#endif
constexpr int LDS_BYTES = 147456;
static_assert(attn_body::ATTN_LDS_BYTES <= 131072, "attention LDS");
static_assert(RT_KS_BYTES + NTHREADS * RT_TAB_WORDS * 4 <= LDS_BYTES, "routing LDS");
static_assert(sc2::END <= LDS_BYTES - 64, "scan LDS");

__global__ void __launch_bounds__(NTHREADS, 2) hybrid_fwd(Params p) {
    extern __shared__ __attribute__((aligned(16))) unsigned char lds_raw[];
    cg::grid_group grid = cg::this_grid();
    LAS unsigned char* lds = (LAS unsigned char*)lds_raw;
    const int G0 = gridDim.x, bid = blockIdx.x;
#define LANE_IDS() int tid = threadIdx.x; asm volatile("" : "+v"(tid)); const int lane = tid & 63, wave = __builtin_amdgcn_readfirstlane(tid >> 6); (void)lane; (void)wave; int G = G0; asm volatile("" : "+s"(G))
    const int vcu = (G0 % 8 == 0) ? (bid % 8) * (G0 / 8) + bid / 8 : bid;
    unsigned char* ws = p.ws; unsigned char* dob = (unsigned char*)p.out;

    DG({ int t_ = threadIdx.x; asm volatile("" : "+v"(t_)); if (bid == 0 && t_ < 64) ((float*)(ws + WS_DIAG))[t_] = 0.f; })
    unsigned* barw = (unsigned*)(ws + 65536);
    { int t__ = threadIdx.x; asm volatile("" : "+v"(t__)); if (bid == 0) for (int i = t__; i < XCD_BAR_WORDS + 128; i += NTHREADS) __hip_atomic_store(barw + i, 0u, __ATOMIC_RELAXED, __HIP_MEMORY_SCOPE_AGENT);
      if (t__ < 2) ((volatile LAS unsigned*)(lds + LDS_BYTES - 64))[t__] = 0u; }
    __syncthreads();
    TS(0);
    { LANE_IDS(); p0_prologue(p, lds, vcu, G, wave, lane); }
#ifdef REP_P0
    __syncthreads(); { LANE_IDS(); p0_prologue(p, lds, vcu, G, wave, lane); }
#endif
    grid.sync();
    const XcdBarrier xbar = xcd_barrier_post(barw, (volatile LAS unsigned*)(lds + LDS_BYTES - 64));
#define GSYNC() xcd_barrier(xbar)
    DG(dg_p0(p);)
    TS(1);
    run_gemm_i8(lds, ws + WS_XN, ws + WS_WTIN, R, N1, 1024, G0, bid, (const float*)(ws + WS_SXN), (const float*)(ws + WS_SWIN), F_Gemm1{(bf16*)(ws + WS_F), (bf16*)(ws + WS_ZG)});
#ifdef REP_GEMM1
    run_gemm_i8(lds, ws + WS_XN, ws + WS_WTIN, R, N1, 1024, G0, bid, (const float*)(ws + WS_SXN), (const float*)(ws + WS_SWIN), F_Gemm1{(bf16*)(ws + WS_F), (bf16*)(ws + WS_ZG)});
#endif
    GSYNC();
    DG(dg_gemm1(p); GSYNC();)
    TS(2);
    { LANE_IDS(); p2_prep1(p, vcu, G, wave, lane); }
    GSYNC();
    DG(dg_p2(p);)
    TS(3);
    { LANE_IDS(); const int gwv = vcu * NWAVES + wave; for (int s = gwv; s < 128; s += G * NWAVES) p3_cumsum(p, s, lane); }
    __syncthreads();
    run_gemm(lds, (const bf16*)(ws + WS_LA), (const bf16*)(ws + WS_WTWA), R, 512, 128, G0, bid, F_LoraW{(bf16*)(dob + DO_XW), p.in[I_W0]});
    run_gemm(lds, (const bf16*)(ws + WS_LA), (const bf16*)(ws + WS_WTWA) + 512 * 128, R, 512, 128, G0, bid, F_LoraA{(bf16*)(dob + DO_AA), p.in[I_A0]});
    run_gemm(lds, (const bf16*)(ws + WS_LG), (const bf16*)(ws + WS_WTG), R, 512, 256, G0, bid, F_Plain{(bf16*)(dob + DO_GG), 512});
#ifdef REP_LORA
    run_gemm(lds, (const bf16*)(ws + WS_LA), (const bf16*)(ws + WS_WTWA), R, 512, 128, G0, bid, F_LoraW{(bf16*)(dob + DO_XW), p.in[I_W0]});
    run_gemm(lds, (const bf16*)(ws + WS_LA), (const bf16*)(ws + WS_WTWA) + 512 * 128, R, 512, 128, G0, bid, F_LoraA{(bf16*)(dob + DO_AA), p.in[I_A0]});
    run_gemm(lds, (const bf16*)(ws + WS_LG), (const bf16*)(ws + WS_WTG), R, 512, 256, G0, bid, F_Plain{(bf16*)(dob + DO_GG), 512});
#endif
    GSYNC();
    DG(dg_p3(p); dg_attn_pre(p); GSYNC();)
    TS(4);
    {
        LANE_IDS();
        for (int bh = bid; bh < 128; bh += G0) p5_scan_chunked(p, lds, bh, tid, wave, lane);
#ifdef REP_SCAN
        for (int bh = bid; bh < 128; bh += G0) p5_scan_chunked(p, lds, bh, tid, wave, lane);
#endif
        TS(6);
        volatile LAS unsigned* qslot = (volatile LAS unsigned*)(lds + LDS_BYTES - 64 + 16);
        for (;;) {
            __syncthreads();
            if (tid == 0) *qslot = __hip_atomic_fetch_add(barw + XCD_BAR_WORDS + 64, 1u, __ATOMIC_RELAXED, __HIP_MEMORY_SCOPE_AGENT);
            __syncthreads();
            const int u = __builtin_amdgcn_readfirstlane((int)*qslot);
            if (u >= 2048) break;
            const int qb = 15 - (u >> 7), bh = u & 127;
            {
                const float* kbg = (const float*)(ws + WS_KB) + (size_t)bh * TP; LAS float* kbl = (LAS float*)(lds + attn_body::LDS_KB);
                for (int i = tid; i < TP; i += NTHREADS) kbl[i] = kbg[i];
                asm volatile("s_waitcnt vmcnt(0) lgkmcnt(0)" ::: "memory");
                __syncthreads();
            }
            attn_body::attn_unit<8>(bh >> 3, bh & 7, qb, (const attn_body::bf16*)(ws + WS_FQ), (const attn_body::bf16*)(ws + WS_FK), (const attn_body::bf16*)(ws + WS_FV), (attn_body::bf16*)(ws + WS_FQ), (char*)lds_raw);
        }
    }
    GSYNC();
    DG(dg_attn_post(p); dg_scan(p);)
    TS(7);
    run_gemm(lds, (const bf16*)(ws + WS_FQ), (const bf16*)(ws + WS_WTFOX), R, 1024, 512, G0, bid, F_MixA{(bf16*)(ws + WS_MIX), (const bf16*)(ws + WS_ZG)});
#ifdef REP_GEMMA
    run_gemm(lds, (const bf16*)(ws + WS_FQ), (const bf16*)(ws + WS_WTFOX), R, 1024, 512, G0, bid, F_MixA{(bf16*)(ws + WS_MIX), (const bf16*)(ws + WS_ZG)});
#endif
    TS(9);
    DG(GSYNC(); dg_mix(p, 11); GSYNC();)
    run_gemm(lds, (const bf16*)(ws + WS_Y), (const bf16*)(ws + WS_WTRWKV), R, 1024, 512, G0, bid, F_MixB{(bf16*)(ws + WS_MIX), (const bf16*)(ws + WS_ZG)});
    GSYNC();
    DG(dg_mix(p, 12);)
    TS(10);
    run_gemm(lds, (const bf16*)(ws + WS_MIX), (const bf16*)(ws + WS_WTOUT), R, 1024, 1024, G0, bid, F_Out{p.in[I_X], p.out});
#ifdef REP_OUT
    run_gemm(lds, (const bf16*)(ws + WS_MIX), (const bf16*)(ws + WS_WTOUT), R, 1024, 1024, G0, bid, F_Out{p.in[I_X], p.out});
#endif
    GSYNC();
    TS(11);
    DG(dg_out(p); GSYNC();)
    { LANE_IDS(); p9_norm2(p, vcu, G, wave, lane); }
#ifdef REP_NORM2
    { LANE_IDS(); p9_norm2(p, vcu, G, wave, lane); }
#endif
    GSYNC();
    DG(dg_norm2(p);)
    TS(12);
#ifdef PQ_BF16
    run_gemm(lds, (const bf16*)(ws + WS_XN2), (const bf16*)(ws + 1010 * MiB), NTOK, 2048, 1024, G0, bid, F_Plain{(bf16*)(ws + WS_PQ), 2048});
#else
    run_gemm_i8(lds, ws + WS_XQ, ws + WS_WTQ, NTOK, 2048, 1024, G0, bid, (const float*)(ws + WS_SX), (const float*)(ws + WS_SWQ), F_Plain{(bf16*)(ws + WS_PQ), 2048});
#endif
#ifdef REP_PQ
    run_gemm_i8(lds, ws + WS_XQ, ws + WS_WTQ, NTOK, 2048, 1024, G0, bid, (const float*)(ws + WS_SX), (const float*)(ws + WS_SWQ), F_Plain{(bf16*)(ws + WS_PQ), 2048});
#endif
    GSYNC();
    TS(13);
    DG(dg_pq(p);)
    { LANE_IDS(); p11_route(p, lds, vcu, G, tid, wave, lane); }
#ifdef REP_ROUTE
    __syncthreads(); { LANE_IDS(); p11_route(p, lds, vcu, G, tid, wave, lane); }
#endif
    GSYNC();
    TS(14);
    DG(__syncthreads(); dg_route(p, lds); dg_gather_pre(p); GSYNC();)
    { LANE_IDS(); p12a_partial(p, bid, G, wave, lane); }
#ifdef REP_12A
    { LANE_IDS(); p12a_partial(p, bid, G, wave, lane); }
#endif
    GSYNC();
    { LANE_IDS(); p12b_combine(p, vcu, G, wave, lane); }
    GSYNC();
#ifdef REP_12C
    { LANE_IDS(); p12c_output<true>(p, bid, G, wave, lane); }
#endif
    { LANE_IDS(); p12c_output<false>(p, bid, G, wave, lane); }
    DG(GSYNC(); dg_gather_post(p); GSYNC(); dg_final(p);)
#if TIMING
    GSYNC(); TS(15); GSYNC();
    {
        const unsigned long long* ts = (const unsigned long long*)(ws + 1010 * MiB);
        const float tot = (float)(ts[15] - ts[0]);
        const float fa = 10.f * (float)(ts[TIMING_A1] - ts[TIMING_A0]) / tot;
        int t__ = threadIdx.x; asm volatile("" : "+v"(t__));
        for (size_t i = (size_t)bid * NTHREADS + t__; i < (size_t)NTOK * 1024; i += (size_t)G0 * NTHREADS) p.out[i] = fa;
    }
#endif
}

extern "C" void kernel_launch(void* const* d_in, const int* in_sizes, int n_in, void* d_out, int out_size, void* d_ws, size_t ws_size, hipStream_t stream) {
    static int grid = 0;
    if (grid == 0) {
        if (n_in != 27 || out_size != NTOK * DMODEL || ws_size < WS_END) { fprintf(stderr, "kernel_launch: unexpected shapes (n_in %d, out %d, ws %zu)\n", n_in, out_size, ws_size); grid = -1; return; }
        int dev = 0, cus = 0, per_cu = 0;
        hipGetDevice(&dev);
        hipDeviceGetAttribute(&cus, hipDeviceAttributeMultiprocessorCount, dev);
        hipFuncSetAttribute((const void*)hybrid_fwd, hipFuncAttributeMaxDynamicSharedMemorySize, LDS_BYTES);
        hipOccupancyMaxActiveBlocksPerMultiprocessor(&per_cu, (const void*)hybrid_fwd, NTHREADS, LDS_BYTES);
        if (per_cu < 1) { fprintf(stderr, "kernel_launch: occupancy query says %d blocks per CU\n", per_cu); grid = -1; return; }
        grid = cus;
    }
    if (grid < 0) return;
    Params p{};
    for (int i = 0; i < 27; ++i) p.in[i] = (const float*)d_in[i];
    p.out = (float*)d_out; p.ws = (unsigned char*)d_ws;
    void* args[] = {&p};
    hipError_t e = hipLaunchCooperativeKernel((const void*)hybrid_fwd, dim3(grid), dim3(NTHREADS), args, LDS_BYTES, stream);
    if (e != hipSuccess) fprintf(stderr, "cooperative launch failed: %s (grid %d)\n", hipGetErrorString(e), grid);
}
```

```cpp
#include <hip/hip_runtime.h>
#include <hip/hip_cooperative_groups.h>
#include <hip/hip_bf16.h>
#include <cstdio>
#include <cstdint>
#include <cmath>
namespace cg = cooperative_groups;
#ifndef DIAG
#define DIAG 0
#endif
namespace pg8 {
#define PG8_LAS __attribute__((address_space(3)))
typedef unsigned short bf16_t;
typedef short bf16x8 __attribute__((ext_vector_type(8)));
typedef float f32x4 __attribute__((ext_vector_type(4)));
typedef unsigned u32x4 __attribute__((ext_vector_type(4)));
constexpr int BM = 256, BK = 64, HALF = 128, HTB = HALF * BK * 2  , STAGE_BYTES = 8 * HTB, NXCD = 8, WGM = 8;

__host__ __device__ __forceinline__ int lds_byte(int r, int c) { const int st = (r >> 4) * 2 + (c >> 5), rr = r & 15, cc = c & 31, ob = rr * 64 + cc * 2; return st * 1024 + (ob ^ (((ob >> 9) & 1) << 5)); }
__host__ __device__ __forceinline__ void stage_rc(int b, int& R, int& C) { const int st = b / 1024, sb = b % 1024, swz = sb ^ (((sb >> 9) & 1) << 5); R = (st >> 1) * 16 + swz / 64; C = (st & 1) * 32 + (swz % 64) / 2; }
__host__ __device__ __forceinline__ int perm32(int rho) { const int n = rho >> 4, i = rho & 15; return 8 * (i >> 2) + 4 * n + (i & 3); }

struct Unit { int pm, pn; };
struct Gemm { const bf16_t* A; const bf16_t* Bt; int M, N, K; };

struct StaticOrder {
    int nM, nN, nwg, G, c;
    __host__ __device__ void init(int M, int N, int G_, int c_) { nM = M / BM; nN = N / BM; nwg = nM * nN; G = G_; c = c_; }
    __host__ __device__ bool next(int i, Unit& u) const {
        const int L = i * G + c; if (L >= nwg) return false;
        int wgid = (int)L; { const int q = nwg / NXCD, r = nwg % NXCD, xcd = wgid % NXCD, off = wgid / NXCD; wgid = (xcd < r ? xcd * (q + 1) : r * (q + 1) + (xcd - r) * q) + off; }
        const int nig = WGM * nN, gid = wgid / nig, fm = gid * WGM, gsz = (nM - fm) < WGM ? (nM - fm) : WGM;
        u.pm = fm + ((wgid % nig) % gsz); u.pn = (wgid % nig) / gsz; return true;
    }
    __device__ __forceinline__ void a_ready(const Unit&) const {}
    __device__ __forceinline__ void done(const Unit&) const {}
    __device__ __forceinline__ size_t a_row0(int pm) const { return (size_t)pm * BM; }
};

__device__ __forceinline__ unsigned cvt_pk_bf16(float lo, float hi) { unsigned r; asm volatile("v_cvt_pk_bf16_f32 %0, %1, %2" : "=v"(r) : "v"(lo), "v"(hi)); return r; }
typedef float f32x2 __attribute__((ext_vector_type(2)));
typedef int i32x4 __attribute__((ext_vector_type(4)));
template <class Epi, class Sched, bool ALIGN_EPI = false, bool SP2 = false>
__device__ __forceinline__ void gemm_phase(PG8_LAS unsigned char* lds, const Gemm g, const Sched& S, const Epi& E) {
    int tid_ = threadIdx.x; asm volatile("" : "+v"(tid_));
    const int tid = tid_, wid = __builtin_amdgcn_readfirstlane(tid >> 6), lane = tid & 63, wr = wid >> 2, wc = wid & 3, fr = lane & 15, fq = lane >> 4;
    const int K = g.K, nt = K / BK;
    unsigned voffA[2], voffB[2];
#pragma unroll
    for (int i = 0; i < 2; ++i) { int R, C; stage_rc(tid * 16 + i * 8192, R, C); const int Rb = Epi::PERM ? ((R & ~31) + perm32(R & 31)) : R;
        voffA[i] = (unsigned)(R * K + C) * 2u; voffB[i] = (unsigned)(Rb * K + C) * 2u; }
    const size_t kstep = (size_t)(BK * 2);
    const size_t hstep = (size_t)HALF * K * 2;
    const size_t tstep = 2 * hstep;
    const unsigned ldsw = (unsigned)wid * 1024u;
    const int aoff = lds_byte(wr * 64 + fr, fq * 8), boff = lds_byte(wc * 32 + fr, fq * 8);
#define PG8_SA(b, h) (((b) * 2 + (h)) * HTB)
#define PG8_SB(b, h) ((4 + (b) * 2 + (h)) * HTB)
#define PG8_STAGE(bufoff, gbase, voff) do { _Pragma("unroll") for (int _i = 0; _i < 2; ++_i) \
        __builtin_amdgcn_global_load_lds((const unsigned*)((const char*)(gbase) + (voff)[_i]), (PG8_LAS unsigned*)(lds + (bufoff) + ldsw + _i * 8192), 16, 0, 0); } while (0)
#define PG8_LDA(dst, b, h) do { _Pragma("unroll") for (int m = 0; m < 4; ++m) _Pragma("unroll") for (int k = 0; k < 2; ++k) dst[m][k] = *(const PG8_LAS bf16x8*)(lds + PG8_SA(b, h) + aoff + m * 2048 + k * 1024); } while (0)
#define PG8_LDB(dst, b, h) do { _Pragma("unroll") for (int n = 0; n < 2; ++n) _Pragma("unroll") for (int k = 0; k < 2; ++k) dst[n][k] = *(const PG8_LAS bf16x8*)(lds + PG8_SB(b, h) + boff + n * 2048 + k * 1024); } while (0)
#define PG8_MMA(ai, bj, At, Bt) do { __builtin_amdgcn_s_setprio(1); _Pragma("unroll") for (int m = 0; m < 4; ++m) _Pragma("unroll") for (int n = 0; n < 2; ++n) _Pragma("unroll") for (int k = 0; k < 2; ++k) \
        acc[ai][bj][m][n] = __builtin_amdgcn_mfma_f32_16x16x32_bf16(Bt[n][k], At[m][k], acc[ai][bj][m][n], 0, 0, 0); __builtin_amdgcn_s_setprio(0); } while (0)
#define PG8_WAIT_V(n) asm volatile("s_waitcnt vmcnt(" #n ")" ::: "memory")
#define PG8_WAIT_L(n) asm volatile("s_waitcnt lgkmcnt(" #n ")" ::: "memory")
#define PG8_BAR __builtin_amdgcn_s_barrier()
#define PG8_SCHED __builtin_amdgcn_sched_barrier(0)
    Unit cur, nxt; int ui = 0;
    if (!S.next(0, cur)) return;
    f32x4 acc[2][2][4][2];
#pragma unroll
    for (int a = 0; a < 2; ++a)
#pragma unroll
        for (int b = 0; b < 2; ++b)
#pragma unroll
            for (int m = 0; m < 4; ++m)
#pragma unroll
                for (int n = 0; n < 2; ++n) acc[a][b][m][n] = (f32x4){0.f, 0.f, 0.f, 0.f};
    bf16x8 At[4][2], B0[2][2], B1[2][2];
    const char* cA = (const char*)g.A + S.a_row0(cur.pm) * (size_t)K * 2; const char* cB = (const char*)g.Bt + (size_t)cur.pn * tstep;
    S.a_ready(cur);
    if constexpr (SP2) {
        PG8_STAGE(PG8_SB(0, 0), cB, voffB); PG8_STAGE(PG8_SB(0, 1), cB + hstep, voffB); PG8_STAGE(PG8_SA(0, 0), cA, voffA); PG8_STAGE(PG8_SA(0, 1), cA + hstep, voffA);
        if (wr == 1) PG8_BAR;
        PG8_WAIT_V(2); PG8_BAR;
        PG8_STAGE(PG8_SB(1, 0), cB + kstep, voffB); PG8_STAGE(PG8_SA(1, 0), cA + kstep, voffA); PG8_STAGE(PG8_SB(1, 1), cB + hstep + kstep, voffB);
        PG8_WAIT_V(6); PG8_BAR;
    } else {
        PG8_STAGE(PG8_SB(0, 0), cB, voffB); PG8_STAGE(PG8_SA(0, 0), cA, voffA); PG8_STAGE(PG8_SB(0, 1), cB + hstep, voffB); PG8_STAGE(PG8_SA(0, 1), cA + hstep, voffA);
        if (wr == 1) PG8_BAR;
        PG8_WAIT_V(4); PG8_BAR;
        PG8_STAGE(PG8_SB(1, 0), cB + kstep, voffB); PG8_STAGE(PG8_SA(1, 0), cA + kstep, voffA); PG8_STAGE(PG8_SB(1, 1), cB + hstep + kstep, voffB);
        PG8_WAIT_V(6); PG8_BAR;
    }
    for (;;) {
        const bool has_next = S.next(ui + 1, nxt);
        const char* nA = has_next ? (const char*)g.A + S.a_row0(nxt.pm) * (size_t)K * 2 : cA; const char* nB = has_next ? (const char*)g.Bt + (size_t)nxt.pn * tstep : cB;
        for (int t = 0; t < nt; t += 2) {
            const bool last = (t == nt - 2);
            const char* a1 = cA + (size_t)(t + 1) * kstep;
            const char* a2 = last ? nA : cA + (size_t)(t + 2) * kstep; const char* b2 = last ? nB : cB + (size_t)(t + 2) * kstep;
            const char* a3 = a2 + kstep; const char* b3 = b2 + kstep;
            if (last && has_next) S.a_ready(nxt);
            if constexpr (SP2) {
            PG8_LDB(B0, 0, 0); PG8_LDB(B1, 0, 1); PG8_SCHED; PG8_LDA(At, 0, 0); PG8_STAGE(PG8_SA(1, 1), a1 + hstep, voffA);
            PG8_WAIT_V(8); PG8_WAIT_L(0); PG8_BAR; PG8_MMA(0, 0, At, B0); PG8_MMA(0, 1, At, B1); PG8_BAR; PG8_SCHED;
            PG8_LDA(At, 0, 1); PG8_STAGE(PG8_SB(0, 0), b2, voffB); PG8_STAGE(PG8_SB(0, 1), b2 + hstep, voffB); PG8_STAGE(PG8_SA(0, 0), a2, voffA);
            PG8_WAIT_V(8); PG8_WAIT_L(0); PG8_BAR; PG8_MMA(1, 0, At, B0); PG8_MMA(1, 1, At, B1); PG8_BAR; PG8_SCHED;
            PG8_LDB(B0, 1, 0); PG8_LDB(B1, 1, 1); PG8_SCHED; PG8_LDA(At, 1, 0); PG8_STAGE(PG8_SA(0, 1), a2 + hstep, voffA);
            PG8_WAIT_V(8); PG8_WAIT_L(0); PG8_BAR; PG8_MMA(0, 0, At, B0); PG8_MMA(0, 1, At, B1); PG8_BAR; PG8_SCHED;
            PG8_LDA(At, 1, 1); PG8_STAGE(PG8_SB(1, 0), b3, voffB); PG8_STAGE(PG8_SB(1, 1), b3 + hstep, voffB); PG8_STAGE(PG8_SA(1, 0), a3, voffA);
            PG8_WAIT_V(8); PG8_WAIT_L(0); PG8_BAR; PG8_MMA(1, 0, At, B0); PG8_MMA(1, 1, At, B1); PG8_BAR; PG8_SCHED;
            } else {
            PG8_LDB(B0, 0, 0); PG8_SCHED; PG8_LDA(At, 0, 0); PG8_STAGE(PG8_SA(1, 1), a1 + hstep, voffA);
            PG8_WAIT_L(8); PG8_BAR; PG8_WAIT_L(0); PG8_MMA(0, 0, At, B0); PG8_BAR; PG8_SCHED;
            PG8_LDB(B1, 0, 1); PG8_STAGE(PG8_SB(0, 0), b2, voffB);
            PG8_BAR; PG8_WAIT_L(0); PG8_MMA(0, 1, At, B1); PG8_BAR;
            PG8_LDA(At, 0, 1); PG8_STAGE(PG8_SA(0, 0), a2, voffA);
            PG8_BAR; PG8_WAIT_L(0); PG8_MMA(1, 0, At, B0); PG8_BAR; PG8_SCHED;
            PG8_STAGE(PG8_SB(0, 1), b2 + hstep, voffB);
            PG8_WAIT_V(6); PG8_BAR; PG8_MMA(1, 1, At, B1); PG8_BAR;
            PG8_LDB(B0, 1, 0); PG8_SCHED; PG8_LDA(At, 1, 0); PG8_STAGE(PG8_SA(0, 1), a2 + hstep, voffA);
            PG8_WAIT_L(8); PG8_BAR; PG8_WAIT_L(0); PG8_MMA(0, 0, At, B0); PG8_BAR; PG8_SCHED;
            PG8_LDB(B1, 1, 1); PG8_STAGE(PG8_SB(1, 0), b3, voffB);
            PG8_BAR; PG8_WAIT_L(0); PG8_MMA(0, 1, At, B1); PG8_BAR;
            PG8_LDA(At, 1, 1); PG8_STAGE(PG8_SA(1, 0), a3, voffA);
            PG8_BAR; PG8_WAIT_L(0); PG8_MMA(1, 0, At, B0); PG8_BAR; PG8_SCHED;
            PG8_STAGE(PG8_SB(1, 1), b3 + hstep, voffB);
            PG8_WAIT_V(6); PG8_BAR; PG8_MMA(1, 1, At, B1); PG8_BAR;
            }
        }
        if constexpr (ALIGN_EPI) { if (wr == 0) PG8_BAR; }
        if constexpr (!Epi::AFTER_DRAIN) { E(acc, cur, wr, wc, fr, fq); S.done(cur); }
        if (!has_next) break;
#pragma unroll
        for (int a = 0; a < 2; ++a)
#pragma unroll
            for (int b = 0; b < 2; ++b)
#pragma unroll
                for (int m = 0; m < 4; ++m)
#pragma unroll
                    for (int n = 0; n < 2; ++n) acc[a][b][m][n] = (f32x4){0.f, 0.f, 0.f, 0.f};
        cur = nxt; cA = nA; cB = nB; ++ui;
        if constexpr (ALIGN_EPI) { if (wr == 1) PG8_BAR; }
    }
    PG8_WAIT_V(0);
    if constexpr (!ALIGN_EPI) { if (wr == 0) PG8_BAR; }
    PG8_BAR;
    if constexpr (Epi::AFTER_DRAIN) { E.fused(acc, cur, wr, wc, fr, fq, lds, wid, lane); S.done(cur); }
#undef PG8_SA
#undef PG8_SB
#undef PG8_STAGE
#undef PG8_LDA
#undef PG8_LDB
#undef PG8_MMA
#undef PG8_WAIT_V
#undef PG8_WAIT_L
#undef PG8_BAR
#undef PG8_SCHED
}
template <class Epi, class Sched, bool ALIGN_EPI = false, bool SP2 = false>
__device__ __forceinline__ void gemm_phase_i8(PG8_LAS unsigned char* lds, const Gemm g, const Sched& S, const Epi& E) {
    int tid_ = threadIdx.x; asm volatile("" : "+v"(tid_));
    const int tid = tid_, wid = __builtin_amdgcn_readfirstlane(tid >> 6), lane = tid & 63, wr = wid >> 2, wc = wid & 3, fr = lane & 15, fq = lane >> 4;
    const int K = g.K, nt = K / BK;
    unsigned voffA[2], voffB[2];
#pragma unroll
    for (int i = 0; i < 2; ++i) { int R, C; stage_rc(tid * 16 + i * 8192, R, C); const int Rb = Epi::PERM ? ((R & ~31) + perm32(R & 31)) : R;
        voffA[i] = (unsigned)(R * K + C) * 2u; voffB[i] = (unsigned)(Rb * K + C) * 2u; }
    const size_t kstep = (size_t)(BK * 2);
    const size_t hstep = (size_t)HALF * K * 2;
    const size_t tstep = 2 * hstep;
    const unsigned ldsw = (unsigned)wid * 1024u;
    const int aoff = lds_byte(wr * 64 + fr, fq * 8), boff = lds_byte(wc * 32 + fr, fq * 8);
#define PG8_SA(b, h) (((b) * 2 + (h)) * HTB)
#define PG8_SB(b, h) ((4 + (b) * 2 + (h)) * HTB)
#define PG8_STAGE(bufoff, gbase, voff) do { _Pragma("unroll") for (int _i = 0; _i < 2; ++_i) \
        __builtin_amdgcn_global_load_lds((const unsigned*)((const char*)(gbase) + (voff)[_i]), (PG8_LAS unsigned*)(lds + (bufoff) + ldsw + _i * 8192), 16, 0, 0); } while (0)
#define PG8_LDA(dst, b, h) do { _Pragma("unroll") for (int m = 0; m < 4; ++m) _Pragma("unroll") for (int k = 0; k < 2; ++k) dst[m][k] = *(const PG8_LAS bf16x8*)(lds + PG8_SA(b, h) + aoff + m * 2048 + k * 1024); } while (0)
#define PG8_LDB(dst, b, h) do { _Pragma("unroll") for (int n = 0; n < 2; ++n) _Pragma("unroll") for (int k = 0; k < 2; ++k) dst[n][k] = *(const PG8_LAS bf16x8*)(lds + PG8_SB(b, h) + boff + n * 2048 + k * 1024); } while (0)
#define PG8_MMA(ai, bj, At, Bt) do { __builtin_amdgcn_s_setprio(1); _Pragma("unroll") for (int m = 0; m < 4; ++m) _Pragma("unroll") for (int n = 0; n < 2; ++n) _Pragma("unroll") for (int k = 0; k < 2; ++k) \
        acc[ai][bj][m][n] = __builtin_amdgcn_mfma_i32_16x16x64_i8(__builtin_bit_cast(i32x4, Bt[n][k]), __builtin_bit_cast(i32x4, At[m][k]), acc[ai][bj][m][n], 0, 0, 0); __builtin_amdgcn_s_setprio(0); } while (0)
#define PG8_WAIT_V(n) asm volatile("s_waitcnt vmcnt(" #n ")" ::: "memory")
#define PG8_WAIT_L(n) asm volatile("s_waitcnt lgkmcnt(" #n ")" ::: "memory")
#define PG8_BAR __builtin_amdgcn_s_barrier()
#define PG8_SCHED __builtin_amdgcn_sched_barrier(0)
    Unit cur, nxt; int ui = 0;
    if (!S.next(0, cur)) return;
    i32x4 acc[2][2][4][2];
#pragma unroll
    for (int a = 0; a < 2; ++a)
#pragma unroll
        for (int b = 0; b < 2; ++b)
#pragma unroll
            for (int m = 0; m < 4; ++m)
#pragma unroll
                for (int n = 0; n < 2; ++n) acc[a][b][m][n] = (i32x4){0, 0, 0, 0};
    bf16x8 At[4][2], B0[2][2], B1[2][2];
    const char* cA = (const char*)g.A + S.a_row0(cur.pm) * (size_t)K * 2; const char* cB = (const char*)g.Bt + (size_t)cur.pn * tstep;
    S.a_ready(cur);
    if constexpr (SP2) {
        PG8_STAGE(PG8_SB(0, 0), cB, voffB); PG8_STAGE(PG8_SB(0, 1), cB + hstep, voffB); PG8_STAGE(PG8_SA(0, 0), cA, voffA); PG8_STAGE(PG8_SA(0, 1), cA + hstep, voffA);
        if (wr == 1) PG8_BAR;
        PG8_WAIT_V(2); PG8_BAR;
        PG8_STAGE(PG8_SB(1, 0), cB + kstep, voffB); PG8_STAGE(PG8_SA(1, 0), cA + kstep, voffA); PG8_STAGE(PG8_SB(1, 1), cB + hstep + kstep, voffB);
        PG8_WAIT_V(6); PG8_BAR;
    } else {
        PG8_STAGE(PG8_SB(0, 0), cB, voffB); PG8_STAGE(PG8_SA(0, 0), cA, voffA); PG8_STAGE(PG8_SB(0, 1), cB + hstep, voffB); PG8_STAGE(PG8_SA(0, 1), cA + hstep, voffA);
        if (wr == 1) PG8_BAR;
        PG8_WAIT_V(4); PG8_BAR;
        PG8_STAGE(PG8_SB(1, 0), cB + kstep, voffB); PG8_STAGE(PG8_SA(1, 0), cA + kstep, voffA); PG8_STAGE(PG8_SB(1, 1), cB + hstep + kstep, voffB);
        PG8_WAIT_V(6); PG8_BAR;
    }
    for (;;) {
        const bool has_next = S.next(ui + 1, nxt);
        const char* nA = has_next ? (const char*)g.A + S.a_row0(nxt.pm) * (size_t)K * 2 : cA; const char* nB = has_next ? (const char*)g.Bt + (size_t)nxt.pn * tstep : cB;
        for (int t = 0; t < nt; t += 2) {
            const bool last = (t == nt - 2);
            const char* a1 = cA + (size_t)(t + 1) * kstep;
            const char* a2 = last ? nA : cA + (size_t)(t + 2) * kstep; const char* b2 = last ? nB : cB + (size_t)(t + 2) * kstep;
            const char* a3 = a2 + kstep; const char* b3 = b2 + kstep;
            if (last && has_next) S.a_ready(nxt);
            if constexpr (SP2) {
            PG8_LDB(B0, 0, 0); PG8_LDB(B1, 0, 1); PG8_SCHED; PG8_LDA(At, 0, 0); PG8_STAGE(PG8_SA(1, 1), a1 + hstep, voffA);
            PG8_WAIT_V(8); PG8_WAIT_L(0); PG8_BAR; PG8_MMA(0, 0, At, B0); PG8_MMA(0, 1, At, B1); PG8_BAR; PG8_SCHED;
            PG8_LDA(At, 0, 1); PG8_STAGE(PG8_SB(0, 0), b2, voffB); PG8_STAGE(PG8_SB(0, 1), b2 + hstep, voffB); PG8_STAGE(PG8_SA(0, 0), a2, voffA);
            PG8_WAIT_V(8); PG8_WAIT_L(0); PG8_BAR; PG8_MMA(1, 0, At, B0); PG8_MMA(1, 1, At, B1); PG8_BAR; PG8_SCHED;
            PG8_LDB(B0, 1, 0); PG8_LDB(B1, 1, 1); PG8_SCHED; PG8_LDA(At, 1, 0); PG8_STAGE(PG8_SA(0, 1), a2 + hstep, voffA);
            PG8_WAIT_V(8); PG8_WAIT_L(0); PG8_BAR; PG8_MMA(0, 0, At, B0); PG8_MMA(0, 1, At, B1); PG8_BAR; PG8_SCHED;
            PG8_LDA(At, 1, 1); PG8_STAGE(PG8_SB(1, 0), b3, voffB); PG8_STAGE(PG8_SB(1, 1), b3 + hstep, voffB); PG8_STAGE(PG8_SA(1, 0), a3, voffA);
            PG8_WAIT_V(8); PG8_WAIT_L(0); PG8_BAR; PG8_MMA(1, 0, At, B0); PG8_MMA(1, 1, At, B1); PG8_BAR; PG8_SCHED;
            } else {
            PG8_LDB(B0, 0, 0); PG8_SCHED; PG8_LDA(At, 0, 0); PG8_STAGE(PG8_SA(1, 1), a1 + hstep, voffA);
            PG8_WAIT_L(8); PG8_BAR; PG8_WAIT_L(0); PG8_MMA(0, 0, At, B0); PG8_BAR; PG8_SCHED;
            PG8_LDB(B1, 0, 1); PG8_STAGE(PG8_SB(0, 0), b2, voffB);
            PG8_BAR; PG8_WAIT_L(0); PG8_MMA(0, 1, At, B1); PG8_BAR;
            PG8_LDA(At, 0, 1); PG8_STAGE(PG8_SA(0, 0), a2, voffA);
            PG8_BAR; PG8_WAIT_L(0); PG8_MMA(1, 0, At, B0); PG8_BAR; PG8_SCHED;
            PG8_STAGE(PG8_SB(0, 1), b2 + hstep, voffB);
            PG8_WAIT_V(6); PG8_BAR; PG8_MMA(1, 1, At, B1); PG8_BAR;
            PG8_LDB(B0, 1, 0); PG8_SCHED; PG8_LDA(At, 1, 0); PG8_STAGE(PG8_SA(0, 1), a2 + hstep, voffA);
            PG8_WAIT_L(8); PG8_BAR; PG8_WAIT_L(0); PG8_MMA(0, 0, At, B0); PG8_BAR; PG8_SCHED;
            PG8_LDB(B1, 1, 1); PG8_STAGE(PG8_SB(1, 0), b3, voffB);
            PG8_BAR; PG8_WAIT_L(0); PG8_MMA(0, 1, At, B1); PG8_BAR;
            PG8_LDA(At, 1, 1); PG8_STAGE(PG8_SA(1, 0), a3, voffA);
            PG8_BAR; PG8_WAIT_L(0); PG8_MMA(1, 0, At, B0); PG8_BAR; PG8_SCHED;
            PG8_STAGE(PG8_SB(1, 1), b3 + hstep, voffB);
            PG8_WAIT_V(6); PG8_BAR; PG8_MMA(1, 1, At, B1); PG8_BAR;
            }
        }
        if constexpr (ALIGN_EPI) { if (wr == 0) PG8_BAR; }
        if constexpr (!Epi::AFTER_DRAIN) { E(acc, cur, wr, wc, fr, fq); S.done(cur); }
        if (!has_next) break;
#pragma unroll
        for (int a = 0; a < 2; ++a)
#pragma unroll
            for (int b = 0; b < 2; ++b)
#pragma unroll
                for (int m = 0; m < 4; ++m)
#pragma unroll
                    for (int n = 0; n < 2; ++n) acc[a][b][m][n] = (i32x4){0, 0, 0, 0};
        cur = nxt; cA = nA; cB = nB; ++ui;
        if constexpr (ALIGN_EPI) { if (wr == 1) PG8_BAR; }
    }
    PG8_WAIT_V(0);
    if constexpr (!ALIGN_EPI) { if (wr == 0) PG8_BAR; }
    PG8_BAR;
    if constexpr (Epi::AFTER_DRAIN) { E.fused(acc, cur, wr, wc, fr, fq, lds, wid, lane); S.done(cur); }
#undef PG8_SA
#undef PG8_SB
#undef PG8_STAGE
#undef PG8_LDA
#undef PG8_LDB
#undef PG8_MMA
#undef PG8_WAIT_V
#undef PG8_WAIT_L
#undef PG8_BAR
#undef PG8_SCHED
}
}
namespace attn_body {
using bf16=__hip_bfloat16;
using bf16x8=__attribute__((ext_vector_type(8)))short;
using s16x4=__attribute__((ext_vector_type(4)))short;
using f32x16=__attribute__((ext_vector_type(16)))float;
using u32x4=__attribute__((ext_vector_type(4)))unsigned;
using f32x4k=__attribute__((ext_vector_type(4)))float;
constexpr int BATCH=16,NHEAD=8,TPAD=4160,D=64,DM=NHEAD*D;
constexpr int NW=8,QBLK=32,QB=QBLK*NW,KVBLK=64,NQB=16;
constexpr int ATTN_PITCH=DM, ATTN_UNIT_ROWS=QB;
__device__ __forceinline__ int crow(int r,int hi){return (r&3)+8*(r>>2)+4*hi;}
#define SBAR() __builtin_amdgcn_sched_barrier(0)
__device__ __forceinline__ void cmask(f32x16&p0,f32x16&p1,int jb,int qrel,int hi){
  const float NEG=-INFINITY; int kb=64*jb+4*hi;
  #pragma unroll
  for(int r=0;r<16;++r){int kv=kb+(r&3)+8*(r>>2); if(kv>qrel)p0[r]=NEG; if(kv+32>qrel)p1[r]=NEG;}
}

constexpr int NSLOT=3, SLOTB=8192;
constexpr int LDS_K=0, LDS_V=NSLOT*SLOTB, LDS_WS=2*NSLOT*SLOTB, LDS_OST=LDS_WS+NW*64*4, LDS_KB=LDS_OST+NW*4096, LDS_BYTES=LDS_KB+TPAD*4;
constexpr float C2=0.125f*1.4426950408889634f;
__device__ __forceinline__ void glds16(const void*gsrc,unsigned lds_dst){unsigned keep;
  asm volatile("s_mov_b32 %0, m0\n\ts_mov_b32 m0, %2\n\ts_nop 0\n\tglobal_load_lds_dwordx4 %1, off\n\ts_mov_b32 m0, %0":"=&s"(keep):"v"(gsrc),"s"(lds_dst):"memory");}
__device__ __forceinline__ float max3f(float a,float b,float c){float r;asm("v_max3_f32 %0, %1, %2, %3":"=v"(r):"v"(a),"v"(b),"v"(c));return r;}
__device__ __forceinline__ float max2f(float a,float b){float r;asm("v_max_f32_e32 %0, %1, %2":"=v"(r):"v"(a),"v"(b));return r;}
__device__ __forceinline__ float fadd_s(float a,float b){float r;asm("v_add_f32_e32 %0, %1, %2":"=v"(r):"v"(a),"v"(b));return r;}
__device__ __forceinline__ float fsub_s(float a,float b){float r;asm("v_sub_f32_e32 %0, %1, %2":"=v"(r):"v"(a),"v"(b));return r;}
typedef float f32x2_t __attribute__((ext_vector_type(2))); typedef __bf16 bf16x2_t __attribute__((ext_vector_type(2)));
__device__ __forceinline__ unsigned cvtpk_s(float lo,float hi){f32x2_t v={lo,hi};bf16x2_t b=__builtin_convertvector(v,bf16x2_t);return __builtin_bit_cast(unsigned,b);}
#define WAIT_BAR(N) asm volatile("s_waitcnt vmcnt(" #N ") lgkmcnt(0)\n\ts_barrier":::"memory")

__device__ __forceinline__ void qkt(f32x16&p0,f32x16&p1,const char*Kslot,const bf16x8*qr,int r32,int hi){
  const char*kb=Kslot+hi*1024+r32*16;
  #pragma unroll
  for(int d0=0;d0<4;++d0){
    const bf16x8 b0=*reinterpret_cast<const bf16x8*>(kb+d0*2048);
    const bf16x8 b1=*reinterpret_cast<const bf16x8*>(kb+d0*2048+512);
    {p0=__builtin_amdgcn_mfma_f32_32x32x16_bf16(b0,qr[d0],p0,0,0,0);p1=__builtin_amdgcn_mfma_f32_32x32x16_bf16(b1,qr[d0],p1,0,0,0);}}
}
typedef __attribute__((address_space(3))) const char* lds_cptr;
typedef short v4i16_t __attribute__((ext_vector_type(4)));
__device__ __forceinline__ void kload8(bf16x8*kf,lds_cptr kp){
  kf[0]=*(const __attribute__((address_space(3))) bf16x8*)(kp);      kf[1]=*(const __attribute__((address_space(3))) bf16x8*)(kp+512);
  kf[2]=*(const __attribute__((address_space(3))) bf16x8*)(kp+2048); kf[3]=*(const __attribute__((address_space(3))) bf16x8*)(kp+2560);
  kf[4]=*(const __attribute__((address_space(3))) bf16x8*)(kp+4096); kf[5]=*(const __attribute__((address_space(3))) bf16x8*)(kp+4608);
  kf[6]=*(const __attribute__((address_space(3))) bf16x8*)(kp+6144); kf[7]=*(const __attribute__((address_space(3))) bf16x8*)(kp+6656);
}
__device__ __forceinline__ void kload2(bf16x8*kf,lds_cptr kp,int j){ kf[2*j]=*(const __attribute__((address_space(3))) bf16x8*)(kp+j*2048); kf[2*j+1]=*(const __attribute__((address_space(3))) bf16x8*)(kp+j*2048+512); }
__device__ __forceinline__ s16x4 vtr(lds_cptr p){ return __builtin_bit_cast(s16x4,__builtin_amdgcn_ds_read_tr16_b64_v4i16((__attribute__((address_space(3))) v4i16_t*)p)); }
__device__ __forceinline__ float rowmax(const f32x16&p0,const f32x16&p1){
  float a=max3f(p0[0],p0[1],p1[0]),b=max3f(p0[2],p0[3],p1[1]);a=max3f(a,p1[2],p1[3]);
  #pragma unroll
  for(int r=4;r<16;r+=4){a=max3f(a,p0[r],p0[r+1]);b=max3f(b,p0[r+2],p0[r+3]);a=max3f(a,p1[r],p1[r+1]);b=max3f(b,p1[r+2],p1[r+3]);}
  const float m=max2f(a,b);
  auto rr=__builtin_amdgcn_permlane32_swap(__float_as_uint(m),__float_as_uint(m),false,false);
  return max2f(__uint_as_float(rr[0]),__uint_as_float(rr[1]));
}
__device__ __forceinline__ void pv(f32x16*o,int vb,bf16x8 pa0,bf16x8 pa1,bf16x8 pa2,bf16x8 pa3){
  #pragma unroll
  for(int d0=0;d0<2;++d0){s16x4 lo[4],hi[4];
    #pragma unroll
    for(int ks=0;ks<4;++ks){
      asm volatile("ds_read_b64_tr_b16 %0,%1 offset:%c2":"=&v"(lo[ks]):"v"(vb),"i"(d0*4096+ks*1024):"memory");
      asm volatile("ds_read_b64_tr_b16 %0,%1 offset:%c2":"=&v"(hi[ks]):"v"(vb),"i"(d0*4096+ks*1024+512):"memory");}
    asm volatile("s_waitcnt lgkmcnt(0)":::"memory");SBAR();
    #define PK(k) (bf16x8){lo[k][0],lo[k][1],lo[k][2],lo[k][3],hi[k][0],hi[k][1],hi[k][2],hi[k][3]}
    o[d0]=__builtin_amdgcn_mfma_f32_32x32x16_bf16(pa0,PK(0),o[d0],0,0,0);
    o[d0]=__builtin_amdgcn_mfma_f32_32x32x16_bf16(pa1,PK(1),o[d0],0,0,0);
    o[d0]=__builtin_amdgcn_mfma_f32_32x32x16_bf16(pa2,PK(2),o[d0],0,0,0);
    o[d0]=__builtin_amdgcn_mfma_f32_32x32x16_bf16(pa3,PK(3),o[d0],0,0,0);
    #undef PK
  }
}

#ifndef ATTN_STORE16
#define ATTN_STORE16(p,v) (*(u32x4*)(p)=(v))
#endif
template<int THRL> __device__ __forceinline__ void attn_unit(int b,int h,int qb,const bf16*Q,const bf16*__restrict__ K,const bf16*__restrict__ V,bf16*O,char*shm){
  int tid_=threadIdx.x; asm volatile("":"+v"(tid_)); const int tid=tid_,lane=tid&63,r32=lane&31,hi=lane>>5; const int wid=__builtin_amdgcn_readfirstlane(tid>>6);
  const long rowbase=(long)b*TPAD; const int q0=64+qb*QB;
  const bf16*Qw=Q+(rowbase+q0+wid*QBLK)*DM+h*D;
  const bf16*Kh=K+rowbase*DM+h*D,*Vh=V+rowbase*DM+h*D;
  const unsigned lds0=(unsigned)(uintptr_t)shm;
  float*wsf=(float*)(shm+LDS_WS)+wid*64;
  const bf16*ksrc=Kh+(long)lane*DM+wid*8;
  const bf16*vsrc=Vh+(long)(16*(wid&3)+(lane>>2))*DM+(wid>>2)*32+(lane&3)*8;
  const unsigned kdst=lds0+LDS_K+wid*1024, vdst=lds0+LDS_V+wid*1024;
  #define DMA_K(t,slot) glds16(ksrc+(long)(t)*KVBLK*DM,(unsigned)__builtin_amdgcn_readfirstlane(kdst+(slot)))
  #define DMA_V(t,slot) glds16(vsrc+(long)(t)*KVBLK*DM,(unsigned)__builtin_amdgcn_readfirstlane(vdst+(slot)))
  const int vb0=(int)(lds0+LDS_V)+((lane>>4)&1)*32+(lane&3)*8+(4*hi+((lane&15)>>2))*64;
  const char*Kbase=shm+LDS_K; bf16x8 kf[8];
  const lds_cptr shm3=(lds_cptr)shm; const lds_cptr kp0=shm3+LDS_K+hi*1024+r32*16; const lds_cptr vp0=shm3+LDS_V+((lane>>4)&1)*32+(lane&3)*8+(4*hi+((lane&15)>>2))*64;
  const int NT=(q0+QB)/KVBLK;
  typedef __attribute__((address_space(3))) const f32x4k* lds_f4p; const __attribute__((address_space(3))) float* kbp0=(const __attribute__((address_space(3))) float*)(shm3+LDS_KB)+4*hi;
  #define KBINIT(C0,C1,t) do{ const __attribute__((address_space(3))) float* kp_=kbp0+(t)*64; _Pragma("unroll") for(int g_=0;g_<4;++g_){ const f32x4k a_=*(lds_f4p)(kp_+8*g_); const f32x4k b_=*(lds_f4p)(kp_+32+8*g_); _Pragma("unroll") for(int e_=0;e_<4;++e_){ C0[4*g_+e_]=a_[e_]-mhat; C1[4*g_+e_]=b_[e_]-mhat; } } }while(0)
  DMA_K(0,0);DMA_V(0,0);DMA_K(1,SLOTB);
  bf16x8 qr[4];
  #pragma unroll
  for(int d0=0;d0<4;++d0)qr[d0]=*reinterpret_cast<const bf16x8*>(&Qw[(long)r32*DM+d0*16+hi*8]);
  float mhat=0.f,l_reg=0.f;f32x16 o[2];o[0]=f32x16{};o[1]=f32x16{};
  const int qrel=wid*QBLK+r32;
  #define CMASK(P0,P1,t) do{int jb_=(t)-(NT-4); if(jb_>=0)cmask(P0,P1,jb_,qrel,hi);}while(0)
  bool resc=false;
  #define START(P0,P1) do{ const float rm=rowmax(P0,P1); resc=false; \
    { const float dl=rm; mhat=fadd_s(mhat,dl); \
      _Pragma("unroll") for(int r=0;r<16;++r){P0[r]=fsub_s(P0[r],dl);P1[r]=fsub_s(P1[r],dl);} } \
    _Pragma("unroll") for(int r=0;r<16;++r)P0[r]=__builtin_amdgcn_exp2f(P0[r]); }while(0)
  #define RESC() do{ if(resc){ asm volatile("s_waitcnt lgkmcnt(0)":::"memory"); \
      _Pragma("unroll") for(int d_=0;d_<2;++d_) _Pragma("unroll") for(int r=0;r<16;++r)o[d_][r]*=wsf[crow(r,hi)]; } }while(0)
  f32x16 pA0,pA1,pB0,pB1;
  int sl_prev=0,sl_cur=0,sl_next=SLOTB;
  #define ROT() do{sl_prev=sl_cur;sl_cur=sl_next;sl_next=(sl_next==(NSLOT-1)*SLOTB)?0:sl_next+SLOTB;}while(0)
  DMA_K(2,2*SLOTB);
  WAIT_BAR(3);
  KBINIT(pA0,pA1,0); qkt(pA0,pA1,Kbase,qr,r32,hi);asm volatile("s_nop 15\n\ts_nop 7":"+v"(pA0),"+v"(pA1));CMASK(pA0,pA1,0);
  START(pA0,pA1);
  _Pragma("unroll") for(int r=0;r<16;++r)pA1[r]=__builtin_amdgcn_exp2f(pA1[r]);
  WAIT_BAR(0);
  DMA_K(3,0);DMA_V(1,SLOTB);
  ROT();
  kload8(kf,kp0+sl_cur);
  WAIT_BAR(2);
  s16x4 vlo[8],vhi[8]; u32x4 pw0,pw1,pw2,pw3;
  #define PKW(P,B) cvtpk_s(P[B],P[B+1])
  #define PAF(k) __builtin_bit_cast(bf16x8,pw##k)
  #define VFR(i) (bf16x8){vlo[i][0],vlo[i][1],vlo[i][2],vlo[i][3],vhi[i][0],vhi[i][1],vhi[i][2],vhi[i][3]}
  #define PIN(x) asm volatile("":"+v"(x))
  #define MX3(a,b,c) __builtin_fmaxf(__builtin_fmaxf((a),(b)),(c))
  #define GAPA(MF,A0,A1,A2,A3,W0,W1,PW) do{ MF; sacc+=A0; sacc+=A1; sacc+=A2; sacc+=A3; PIN(sacc); W0; W1; PIN(PW); SBAR(); }while(0)
  #define EX(v) __builtin_amdgcn_exp2f(v)
  #define GAPB(MF,X,B) do{ MF; X[B]=EX(X[B]); X[B+1]=EX(X[B+1]); X[B+2]=EX(X[B+2]); X[B+3]=EX(X[B+3]); PIN(X); SBAR(); }while(0)
  #define VRD(i) do{ vlo[i]=vtr(vp_+(((i)>>2)*4096+((i)&3)*1024)); vhi[i]=vtr(vp_+(((i)>>2)*4096+((i)&3)*1024+512)); }while(0)
  #define KRD(G,j) do{ if(G){ kload2(kf,kp0+sl_next,j); SBAR(); } }while(0)
  #define STEP(C0,C1,P0,P1,t,GK,GV,GL) do{ SBAR(); \
    const lds_cptr vp_=vp0+sl_prev; \
    KBINIT(C0,C1,t); SBAR(); \
    VRD(0); SBAR(); float sacc=(P0[0]+P0[1]); \
    GAPA(C0=__builtin_amdgcn_mfma_f32_32x32x16_bf16(kf[0],qr[0],C0,0,0,0), P0[2],P0[3],P0[4],P0[5],     pw0[0]=PKW(P0,0), pw0[1]=PKW(P0,2), pw0); \
    VRD(4); SBAR(); GAPA(C1=__builtin_amdgcn_mfma_f32_32x32x16_bf16(kf[1],qr[0],C1,0,0,0), P0[6],P0[7],P0[8],P0[9],     pw0[2]=PKW(P0,4), pw0[3]=PKW(P0,6), pw0); \
    VRD(1); SBAR(); GAPA(C0=__builtin_amdgcn_mfma_f32_32x32x16_bf16(kf[2],qr[1],C0,0,0,0),   P0[10],P0[11],P0[12],P0[13], pw1[0]=PKW(P0,8), pw1[1]=PKW(P0,10), pw1); \
    VRD(5); SBAR(); GAPA(C1=__builtin_amdgcn_mfma_f32_32x32x16_bf16(kf[3],qr[1],C1,0,0,0),   P0[14],P0[15],P1[0],P1[1],   pw1[2]=PKW(P0,12),pw1[3]=PKW(P0,14), pw1); \
    VRD(2); SBAR(); GAPA(C0=__builtin_amdgcn_mfma_f32_32x32x16_bf16(kf[4],qr[2],C0,0,0,0),   P1[2],P1[3],P1[4],P1[5],     pw2[0]=PKW(P1,0), pw2[1]=PKW(P1,2), pw2); \
    VRD(6); SBAR(); GAPA(C1=__builtin_amdgcn_mfma_f32_32x32x16_bf16(kf[5],qr[2],C1,0,0,0),   P1[6],P1[7],P1[8],P1[9],     pw2[2]=PKW(P1,4), pw2[3]=PKW(P1,6), pw2); \
    VRD(3); SBAR(); GAPA(C0=__builtin_amdgcn_mfma_f32_32x32x16_bf16(kf[6],qr[3],C0,0,0,0),   P1[10],P1[11],P1[12],P1[13], pw3[0]=PKW(P1,8), pw3[1]=PKW(P1,10), pw3); \
    VRD(7); SBAR(); GAPA(C1=__builtin_amdgcn_mfma_f32_32x32x16_bf16(kf[7],qr[3],C1,0,0,0),   P1[14],P1[15],0.f,0.f,       pw3[2]=PKW(P1,12),pw3[3]=PKW(P1,14), pw3); \
    l_reg+=sacc; \
    if(GK){DMA_K((t)+3,sl_cur);} if(GV){DMA_V((t)+1,sl_next);} \
    CMASK(C0,C1,t); \
    { float a=MX3(C0[0],C0[1],C1[0]),b=MX3(C0[2],C0[3],C1[1]); a=MX3(a,C1[2],C1[3]); \
      _Pragma("unroll") for(int r=4;r<16;r+=4){a=MX3(a,C0[r],C0[r+1]);b=MX3(b,C0[r+2],C0[r+3]);a=MX3(a,C1[r],C1[r+1]);b=MX3(b,C1[r+2],C1[r+3]);} \
      float rm=__builtin_fmaxf(a,b); { auto rr=__builtin_amdgcn_permlane32_swap(__float_as_uint(rm),__float_as_uint(rm),false,false); rm=__builtin_fmaxf(__uint_as_float(rr[0]),__uint_as_float(rr[1])); } \
      resc=false; \
      if(__builtin_expect(__any(rm>(float)THRL),0)){ const float dl=__builtin_fmaxf(rm,0.f); mhat+=dl; \
        _Pragma("unroll") for(int r=0;r<16;++r){C0[r]-=dl;C1[r]-=dl;} \
        const float f=__builtin_amdgcn_exp2f(-dl); l_reg*=f; if(hi==0)wsf[r32]=f; resc=true; } } \
    SBAR(); \
    GAPB(o[0]=__builtin_amdgcn_mfma_f32_32x32x16_bf16(PAF(0),VFR(0),o[0],0,0,0), C0,0); \
    GAPB(o[1]=__builtin_amdgcn_mfma_f32_32x32x16_bf16(PAF(0),VFR(4),o[1],0,0,0), C0,4); \
    KRD(GL,0); GAPB(o[0]=__builtin_amdgcn_mfma_f32_32x32x16_bf16(PAF(1),VFR(1),o[0],0,0,0), C0,8); \
    KRD(GL,1); GAPB(o[1]=__builtin_amdgcn_mfma_f32_32x32x16_bf16(PAF(1),VFR(5),o[1],0,0,0), C0,12); \
    KRD(GL,2); GAPB(o[0]=__builtin_amdgcn_mfma_f32_32x32x16_bf16(PAF(2),VFR(2),o[0],0,0,0), C1,0); \
    KRD(GL,3); GAPB(o[1]=__builtin_amdgcn_mfma_f32_32x32x16_bf16(PAF(2),VFR(6),o[1],0,0,0), C1,4); \
    GAPB(o[0]=__builtin_amdgcn_mfma_f32_32x32x16_bf16(PAF(3),VFR(3),o[0],0,0,0), C1,8); \
    GAPB(o[1]=__builtin_amdgcn_mfma_f32_32x32x16_bf16(PAF(3),VFR(7),o[1],0,0,0), C1,12); \
    }while(0)
  int t=1;
  #undef CMASK
  #define CMASK(P0,P1,t) do{}while(0)
  for(;t+5<NT;t+=2){
    STEP(pB0,pB1,pA0,pA1,t,true,true,true);     WAIT_BAR(2); RESC(); ROT();
    STEP(pA0,pA1,pB0,pB1,t+1,true,true,true);   WAIT_BAR(2); RESC(); ROT();
  }
  #undef CMASK
  #define CMASK(P0,P1,t) do{int jb_=(t)-(NT-4); if(jb_>=0)cmask(P0,P1,jb_,qrel,hi);}while(0)
  #define ENDW(tt) do{ if((tt)+3<NT){WAIT_BAR(2);} else if((tt)+2<NT){WAIT_BAR(1);} else {WAIT_BAR(0);} }while(0)
  for(;t+1<NT;t+=2){
    STEP(pB0,pB1,pA0,pA1,t,(t+3<NT),(t+1<NT),(t+1<NT));       ENDW(t);   RESC(); ROT();
    STEP(pA0,pA1,pB0,pB1,t+1,(t+4<NT),(t+2<NT),(t+2<NT));     ENDW(t+1); RESC(); ROT();
  }
  { float sacc=pA0[0]+pA0[1]; _Pragma("unroll") for(int r=2;r<16;++r)sacc+=pA0[r]; _Pragma("unroll") for(int r=0;r<16;++r)sacc+=pA1[r]; l_reg+=sacc;
    pw0=(u32x4){PKW(pA0,0),PKW(pA0,2),PKW(pA0,4),PKW(pA0,6)};pw1=(u32x4){PKW(pA0,8),PKW(pA0,10),PKW(pA0,12),PKW(pA0,14)};pw2=(u32x4){PKW(pA1,0),PKW(pA1,2),PKW(pA1,4),PKW(pA1,6)};pw3=(u32x4){PKW(pA1,8),PKW(pA1,10),PKW(pA1,12),PKW(pA1,14)};
    SBAR(); pv(o,vb0+sl_prev,PAF(0),PAF(1),PAF(2),PAF(3)); }
  #undef PKW
  #undef PAF
  #undef VFR
  #undef PIN
  #undef MX3
  #undef GAPA
  #undef GAPB
  #undef EX
  #undef VRD
  #undef KRD
  #undef STEP
  #undef ENDW
  {auto rr=__builtin_amdgcn_permlane32_swap(__float_as_uint(l_reg),__float_as_uint(l_reg),false,false);l_reg=__uint_as_float(rr[0])+__uint_as_float(rr[1]);}
  if(hi==0)wsf[32+r32]=l_reg;asm volatile("s_waitcnt lgkmcnt(0)":::"memory");
  float rli[16];
  #pragma unroll
  for(int r=0;r<16;++r)rli[r]=__builtin_amdgcn_rcpf(wsf[32+crow(r,hi)]);
  bf16*Ow=O+(rowbase+q0+wid*QBLK)*DM+h*D;
  { bf16*stg=(bf16*)(shm+LDS_OST)+wid*2048;
    #pragma unroll
    for(int r=0;r<16;++r){const int orow=crow(r,hi);
      #pragma unroll
      for(int d0=0;d0<2;++d0)stg[orow*64+d0*32+r32]=__float2bfloat16(o[d0][r]*rli[r]);}
    asm volatile("s_waitcnt lgkmcnt(0)":::"memory");
    #pragma unroll
    for(int i=0;i<4;++i){const int row=i*8+(lane>>3),ch=lane&7; const u32x4 v=*(const u32x4*)(stg+row*64+ch*8); ATTN_STORE16(Ow+(long)row*DM+ch*8,v);} }
  asm volatile("s_waitcnt lgkmcnt(0)\n\ts_barrier":::"memory");
  #undef DMA_K
  #undef DMA_V
  #undef CMASK
  #undef START
  #undef RESC
  #undef ROT
  #undef KBINIT
}
constexpr int ATTN_LDS_BYTES=LDS_BYTES;
#undef SBAR
#undef WAIT_BAR
}

#define LAS __attribute__((address_space(3)))
typedef unsigned short bf16;
typedef unsigned v4u __attribute__((ext_vector_type(4)));
typedef unsigned v2u __attribute__((ext_vector_type(2)));
typedef float f32x4 __attribute__((ext_vector_type(4)));
typedef short bf16x8 __attribute__((ext_vector_type(8)));
typedef float f32x16v __attribute__((ext_vector_type(16)));

constexpr int NB = 16, SEQ = 4096, DMODEL = 1024, NMETA = 16;
constexpr int TP = 4160;
constexpr int R = NB * TP;
constexpr int NTOK = NB * SEQ;
constexpr int N1 = 5632;
constexpr int IN_COLS = 5416;
constexpr int NWAVES = 8, NTHREADS = 512;
constexpr float NORM_EPS = 1e-6f, GN_EPS = 64e-5f;
constexpr float LOG2E = 1.4426950408889634f;

constexpr size_t MiB = 1u << 20;
constexpr size_t U65 = 65 * MiB;
constexpr size_t WS_WTIN = 1 * MiB;
constexpr size_t WS_WTQ = 12 * MiB;
constexpr size_t WS_WTFOX = 16 * MiB;
constexpr size_t WS_WTRWKV = 17 * MiB;
constexpr size_t WS_WTOUT = 18 * MiB;
constexpr size_t WS_WTWA = 20 * MiB;
constexpr size_t WS_WTG = 20 * MiB + 512 * 1024;
constexpr size_t WS_KS = 21 * MiB;
constexpr size_t WS_KB = 22 * MiB;
constexpr size_t WS_LF = 25 * MiB;
constexpr size_t WS_BS = 29 * MiB;
constexpr size_t WS_SXN = 28 * MiB;
constexpr size_t WS_SWIN = 9 * MiB;
constexpr size_t WS_SWQ = 15 * MiB;
constexpr size_t WS_U8 = 32 * MiB;
constexpr size_t WS_SU = 48 * MiB;
constexpr size_t WS_V8 = 64 * MiB;
constexpr size_t WS_SV = 80 * MiB;
constexpr size_t WS_CORR = 81 * MiB;
constexpr size_t WS_SX = 82 * MiB;
constexpr size_t WS_XQ = 352 * MiB;
constexpr size_t WS_F = 96 * MiB;
constexpr size_t WS_FQ = WS_F, WS_FK = WS_F + U65, WS_FV = WS_F + 2 * U65, WS_ZRR = WS_F + 3 * U65, WS_ZRK = WS_F + 4 * U65, WS_ZRV = WS_F + 5 * U65, WS_ZM = WS_F + 6 * U65;
constexpr size_t WS_ZG = WS_F + 7 * U65;
constexpr size_t WS_XN = WS_ZG + 4 * U65;
constexpr size_t WS_IDS = 941 * MiB;
constexpr size_t WS_GATES = 973 * MiB;
constexpr size_t WS_END = 1005 * MiB;
constexpr size_t WS_LA = WS_XN;
constexpr size_t WS_LG = WS_XN + 20 * MiB;
constexpr size_t WS_KP = WS_XN;
constexpr size_t WS_KN = WS_XN + U65;
constexpr size_t WS_Y = WS_ZM;
constexpr size_t WS_MIX = WS_XN;
constexpr size_t WS_XN2 = WS_XN;
constexpr size_t WS_PQ = 420 * MiB;
constexpr size_t WS_H1 = 161 * MiB;
constexpr size_t DO_XW = 0, DO_AA = U65, DO_GG = 2 * U65;

typedef float f32x2_cv __attribute__((ext_vector_type(2))); typedef __bf16 bf16x2_cv __attribute__((ext_vector_type(2)));
__device__ __forceinline__ unsigned pk2(float lo, float hi) { const f32x2_cv v = {lo, hi}; const bf16x2_cv b = __builtin_convertvector(v, bf16x2_cv); return __builtin_bit_cast(unsigned, b); }
__device__ __forceinline__ unsigned f2bf(float f) { return pk2(f, 0.f) & 0xffffu; }
__device__ __forceinline__ float bflo(unsigned w) { return __builtin_bit_cast(float, w << 16); }
__device__ __forceinline__ float bfhi(unsigned w) { return __builtin_bit_cast(float, w & 0xffff0000u); }
__device__ __forceinline__ void unpack8(const v4u w, float (&f)[8]) { f[0] = bflo(w.x); f[1] = bfhi(w.x); f[2] = bflo(w.y); f[3] = bfhi(w.y); f[4] = bflo(w.z); f[5] = bfhi(w.z); f[6] = bflo(w.w); f[7] = bfhi(w.w); }
__device__ __forceinline__ v4u pack8(const float (&f)[8]) { v4u w; w.x = pk2(f[0], f[1]); w.y = pk2(f[2], f[3]); w.z = pk2(f[4], f[5]); w.w = pk2(f[6], f[7]); return w; }
__device__ __forceinline__ float sigmoidf_(float x) { return __builtin_amdgcn_rcpf(1.0f + __builtin_amdgcn_exp2f(-x * LOG2E)); }
__device__ __forceinline__ float wave_sum(float v) {
#pragma unroll
    for (int o = 1; o < 64; o <<= 1) v += __shfl_xor(v, o);
    return v;
}
__device__ __forceinline__ float sum8(float v) { v += __shfl_xor(v, 1); v += __shfl_xor(v, 2); v += __shfl_xor(v, 4); return v; }

struct Params {
    const float* in[27];
    float* out;
    unsigned char* ws;
};
enum { I_X = 0, I_META, I_N1G, I_WIN, I_FQN, I_FKN, I_FBIAS, I_MU, I_W0, I_WUP, I_A0, I_AUP, I_GUP, I_KK, I_KA, I_RK, I_LNG, I_LNB, I_WFOX, I_WRWKV, I_WOUT, I_N2G, I_PWQ, I_SK1, I_SK2, I_PU, I_PV };

__device__ __forceinline__ int win_src_col(int n) {
    if (n < 1536) return n;
    if (n < 3072) return 1544 + (n - 1536);
    if (n < 3584) { const int m = n - 3072; if (m < 288) return 3080 + m; if (m < 296) return 1536 + (m - 288); return -1; }
    return 3368 + (n - 3584);
}
template <bool REMAP>
__device__ __forceinline__ void transpose_item(const float* W, int ldw, int K, int N, bf16* WT, LAS float* scr, int item, int lane) {
    const int nblk = N / 32, kb = item / nblk, nb = item % nblk, k0 = 64 * kb, n0 = 32 * nb;
    const int n = n0 + (lane & 31); const int sc = REMAP ? win_src_col(n) : n;
#pragma unroll 8
    for (int i = 0; i < 32; ++i) { const int kk = 2 * i + (lane >> 5); scr[kk * 33 + (lane & 31)] = (sc >= 0) ? W[(size_t)(k0 + kk) * ldw + sc] : 0.f; }
    asm volatile("s_waitcnt lgkmcnt(0)" ::: "memory");
    const int c = lane & 7;
#pragma unroll
    for (int j = 0; j < 4; ++j) { const int nn = (lane >> 3) + 8 * j; const LAS float* s = scr + (8 * c) * 33 + nn;
        v4u o; o.x = pk2(s[0 * 33], s[1 * 33]); o.y = pk2(s[2 * 33], s[3 * 33]); o.z = pk2(s[4 * 33], s[5 * 33]); o.w = pk2(s[6 * 33], s[7 * 33]);
        *(v4u*)(WT + (size_t)(n0 + nn) * K + k0 + 8 * c) = o; }
    asm volatile("s_waitcnt lgkmcnt(0)" ::: "memory");
}
template <bool REMAP>
__device__ __forceinline__ void transpose_q8_item(const float* W, int ldw, unsigned char* WT8, float* SW, LAS float* scr, LAS float* cmax, int item, int wave, int lane) {
    const int n0 = 32 * item, n = n0 + (lane & 31); const int sc = REMAP ? win_src_col(n) : n;
    const float* Wc = W + (size_t)(128 * wave + (lane >> 5)) * ldw + (sc >= 0 ? sc : 0);
    float m = 0.f;
#pragma unroll 16
    for (int i = 0; i < 64; ++i) m = fmaxf(m, fabsf(Wc[(size_t)(2 * i) * ldw]));
    if (sc < 0) m = 0.f;
    m = fmaxf(m, __shfl_xor(m, 32));
    if (lane < 32) cmax[wave * 32 + lane] = m;
    __syncthreads();
    m = 0.f;
#pragma unroll
    for (int w = 0; w < 8; ++w) m = fmaxf(m, cmax[w * 32 + (lane & 31)]);
    const float inv = m > 0.f ? 127.0f / m : 0.f;
    if (wave == 0 && lane < 32) SW[n] = m > 0.f ? m * (1.0f / 127.0f) : 1.0f;
#pragma unroll
    for (int blk = 0; blk < 2; ++blk) {
        const int k0 = 128 * wave + 64 * blk;
#pragma unroll 16
        for (int i = 0; i < 32; ++i) scr[(2 * i + (lane >> 5)) * 33 + (lane & 31)] = Wc[(size_t)(64 * blk + 2 * i) * ldw] * inv;
        asm volatile("s_waitcnt lgkmcnt(0)" ::: "memory");
        const int c = lane & 3;
#pragma unroll
        for (int j = 0; j < 2; ++j) { const int nn = (lane >> 2) + 16 * j; const LAS float* sp = scr + (16 * c) * 33 + nn;
            unsigned w[4];
#pragma unroll
            for (int d = 0; d < 4; ++d) { const int q0 = (int)rintf(sp[(4 * d) * 33]), q1 = (int)rintf(sp[(4 * d + 1) * 33]), q2 = (int)rintf(sp[(4 * d + 2) * 33]), q3 = (int)rintf(sp[(4 * d + 3) * 33]);
                w[d] = (unsigned)(q0 & 255) | ((unsigned)(q1 & 255) << 8) | ((unsigned)(q2 & 255) << 16) | ((unsigned)(q3 & 255) << 24); }
            v4u o; o.x = w[0]; o.y = w[1]; o.z = w[2]; o.w = w[3];
            *(v4u*)(WT8 + (size_t)(n0 + nn) * 1024 + k0 + 16 * c) = o; }
        asm volatile("s_waitcnt lgkmcnt(0)" ::: "memory");
    }
    __syncthreads();
}
__device__ __forceinline__ void p0_prologue(const Params& p, LAS unsigned char* lds, int vcu, int G, int wave, int lane) {
    unsigned char* ws = p.ws;
    LAS float* scr = (LAS float*)(lds + wave * 16384);
    const int gw = vcu * NWAVES + wave, NGW = G * NWAVES;
    constexpr int I_IN = N1 / 32, I_Q = 2048 / 32, I_FX = 8 * 32, I_O = 16 * 32;
    {
        LAS float* cmax = (LAS float*)(lds + 8 * 16384);
        for (int it = vcu; it < I_IN + I_Q; it += G) {
            if (it < I_IN) transpose_q8_item<true>(p.in[I_WIN], IN_COLS, ws + WS_WTIN, (float*)(ws + WS_SWIN), scr, cmax, it, wave, lane);
            else transpose_q8_item<false>(p.in[I_PWQ], 2048, ws + WS_WTQ, (float*)(ws + WS_SWQ), scr, cmax, it - I_IN, wave, lane);
        }
    }
#ifdef PQ_BF16
    for (int it = gw; it < 16 * 64; it += NGW) transpose_item<false>(p.in[I_PWQ], 2048, 1024, 2048, (bf16*)(ws + 1010 * MiB), scr, it, lane);
#endif
    constexpr int NITEMS = 2 * I_FX + I_O;
    for (int it = gw; it < NITEMS; it += NGW) {
        int r = it;
        if (r < I_FX) { transpose_item<false>(p.in[I_WFOX], 1024, 512, 1024, (bf16*)(ws + WS_WTFOX), scr, r, lane); continue; } r -= I_FX;
        if (r < I_FX) { transpose_item<false>(p.in[I_WRWKV], 1024, 512, 1024, (bf16*)(ws + WS_WTRWKV), scr, r, lane); continue; } r -= I_FX;
        transpose_item<false>(p.in[I_WOUT], 1024, 1024, 1024, (bf16*)(ws + WS_WTOUT), scr, r, lane);
    }
    const int gt = gw * 64 + lane, NGT = NGW * 64;
    for (int i = gt; i < 1024 * 128; i += NGT) { const int n = i >> 7, k = i & 127; float v = 0.f;
        if (n < 512) { if (k < 64) v = p.in[I_WUP][k * 512 + n]; } else { if (k >= 64) v = p.in[I_AUP][(k - 64) * 512 + (n - 512)]; }
        ((bf16*)(ws + WS_WTWA))[i] = (bf16)f2bf(v); }
    for (int i = gt; i < 512 * 256; i += NGT) { const int n = i >> 8, k = i & 255; const float v = (k < 160) ? p.in[I_GUP][k * 512 + n] : 0.f; ((bf16*)(ws + WS_WTG))[i] = (bf16)f2bf(v); }
    for (int i = gt; i < 2 * 128 * 128; i += NGT) { const float v = (i < 16384) ? p.in[I_SK1][i] : p.in[I_SK2][i - 16384]; ((bf16*)(ws + WS_KS))[i] = (bf16)f2bf(v); }
    for (int r = gw; r < 32768; r += NGW) {
        const int tbl = r >> 14, row = r & 16383;
        const f32x4* src = (const f32x4*)((tbl ? p.in[I_PV] : p.in[I_PU]) + (size_t)row * 1024 + 16 * lane);
        f32x4 a[4]; float m = 0.f;
#pragma unroll
        for (int j = 0; j < 4; ++j) { a[j] = src[j]; m = fmaxf(m, fmaxf(fmaxf(fabsf(a[j].x), fabsf(a[j].y)), fmaxf(fabsf(a[j].z), fabsf(a[j].w)))); }
#pragma unroll
        for (int o = 1; o < 64; o <<= 1) m = fmaxf(m, __shfl_xor(m, o));
        const float inv = m > 0.f ? 127.0f / m : 0.f; const int off = 0;
        v4u w;
        unsigned ww[4];
#pragma unroll
        for (int j = 0; j < 4; ++j) { const int q0 = (int)rintf(a[j].x * inv) + off, q1 = (int)rintf(a[j].y * inv) + off, q2 = (int)rintf(a[j].z * inv) + off, q3 = (int)rintf(a[j].w * inv) + off;
            ww[j] = (unsigned)(q0 & 255) | ((unsigned)(q1 & 255) << 8) | ((unsigned)(q2 & 255) << 16) | ((unsigned)(q3 & 255) << 24); }
        w.x = ww[0]; w.y = ww[1]; w.z = ww[2]; w.w = ww[3];
        *(v4u*)(ws + (tbl ? WS_V8 : WS_U8) + (size_t)row * 1024 + 16 * lane) = w;
        if (lane == 0) ((float*)(ws + (tbl ? WS_SV : WS_SU)))[row] = m > 0.f ? m * (1.0f / 127.0f) : 1.0f;
    }
    const f32x4* g4 = (const f32x4*)p.in[I_N1G] + lane;
    for (int m = gw; m < R; m += NGW) {
        const int b = m / TP, pp = m - b * TP;
        unsigned* o4 = (unsigned*)(ws + WS_XN + (size_t)m * 1024) + lane;
        if (pp < 48) {
#pragma unroll
            for (int j = 0; j < 4; ++j) o4[64 * j] = 0u;
            if (lane == 0) ((float*)(ws + WS_SXN))[m] = 1.0f;
            continue; }
        const float* xrow = (pp < 64) ? p.in[I_META] + (size_t)(pp - 48) * 1024 : p.in[I_X] + ((size_t)b * SEQ + (pp - 64)) * 1024;
        const f32x4* xr = (const f32x4*)xrow + lane;
        f32x4 v[4]; float s = 0.f;
#pragma unroll
        for (int j = 0; j < 4; ++j) { v[j] = xr[64 * j]; s += (v[j].x * v[j].x + v[j].y * v[j].y) + (v[j].z * v[j].z + v[j].w * v[j].w); }
        const float rs = 1.0f / sqrtf(wave_sum(s) * (1.f / 1024.f) + NORM_EPS);
        float mx = 0.f;
#pragma unroll
        for (int j = 0; j < 4; ++j) { const f32x4 g = g4[64 * j]; v[j].x *= rs * g.x; v[j].y *= rs * g.y; v[j].z *= rs * g.z; v[j].w *= rs * g.w;
            mx = fmaxf(mx, fmaxf(fmaxf(fabsf(v[j].x), fabsf(v[j].y)), fmaxf(fabsf(v[j].z), fabsf(v[j].w)))); }
#pragma unroll
        for (int o = 1; o < 64; o <<= 1) mx = fmaxf(mx, __shfl_xor(mx, o));
        const float inv = mx > 0.f ? 127.0f / mx : 0.f;
#pragma unroll
        for (int j = 0; j < 4; ++j) { const int q0 = (int)rintf(v[j].x * inv), q1 = (int)rintf(v[j].y * inv), q2 = (int)rintf(v[j].z * inv), q3 = (int)rintf(v[j].w * inv);
            o4[64 * j] = (unsigned)(q0 & 255) | ((unsigned)(q1 & 255) << 8) | ((unsigned)(q2 & 255) << 16) | ((unsigned)(q3 & 255) << 24); }
        if (lane == 0) ((float*)(ws + WS_SXN))[m] = mx > 0.f ? mx * (1.0f / 127.0f) : 1.0f;
    }
}

template <class F> struct EpiT {
    static constexpr bool PERM = true, AFTER_DRAIN = false;
    F f;
    __device__ __forceinline__ void operator()(const pg8::f32x4 (&acc)[2][2][4][2], const pg8::Unit& u, int wr, int wc, int fr, int fq) const {
        const int row0 = u.pm * 256 + wr * 64 + fr, col0 = u.pn * 256 + wc * 32 + 8 * fq;
#pragma unroll
        for (int ai = 0; ai < 2; ++ai)
#pragma unroll
            for (int m = 0; m < 4; ++m)
#pragma unroll
                for (int bj = 0; bj < 2; ++bj) {
                    const pg8::f32x4 a = acc[ai][bj][m][0], b = acc[ai][bj][m][1];
                    float v[8] = {a[0], a[1], a[2], a[3], b[0], b[1], b[2], b[3]};
                    f.store(row0 + ai * 128 + m * 16, col0 + bj * 128, v);
                }
    }
};
struct F_Gemm1 {
    bf16* F; bf16* ZG;
    __device__ __forceinline__ void store(int row, int col, float (&v)[8]) const {
        if (col < 3584) { const int buf = col >> 9, c = col & 511; *(v4u*)(F + (size_t)buf * ((size_t)R * 512) + (size_t)row * 512 + c) = pack8(v); }
        else { const int c = col - 3584;
            unsigned q[8];
#pragma unroll
            for (int e = 0; e < 8; ++e) q[e] = (unsigned)(int)rintf(sigmoidf_(v[e]) * 255.0f);
            v2u w; w.x = q[0] | (q[1] << 8) | (q[2] << 16) | (q[3] << 24); w.y = q[4] | (q[5] << 8) | (q[6] << 16) | (q[7] << 24);
            *(v2u*)((unsigned char*)ZG + (size_t)row * 2048 + c) = w; }
    }
};
struct F_LoraW {
    bf16* XW; const float* w0;
    __device__ __forceinline__ void store(int row, int col, float (&v)[8]) const {
        const f32x4 b0 = *(const f32x4*)(w0 + col), b1 = *(const f32x4*)(w0 + col + 4); const float bb[8] = {b0.x, b0.y, b0.z, b0.w, b1.x, b1.y, b1.z, b1.w};
#pragma unroll
        for (int e = 0; e < 8; ++e) { const float x = v[e] + bb[e];
            const float sp = fmaxf(-x, 0.f) + __logf(1.0f + __expf(-fabsf(x)));
            const float ew = __expf(-sp - 0.5f);
            v[e] = 1.0f - __expf(-ew); }
        *(v4u*)(XW + (size_t)row * 512 + col) = pack8(v);
    }
};
struct F_LoraA {
    bf16* AA; const float* a0;
    __device__ __forceinline__ void store(int row, int col, float (&v)[8]) const {
        const f32x4 b0 = *(const f32x4*)(a0 + col), b1 = *(const f32x4*)(a0 + col + 4); const float bb[8] = {b0.x, b0.y, b0.z, b0.w, b1.x, b1.y, b1.z, b1.w};
#pragma unroll
        for (int e = 0; e < 8; ++e) v[e] = sigmoidf_(v[e] + bb[e]);
        *(v4u*)(AA + (size_t)row * 512 + col) = pack8(v);
    }
};
struct F_Plain {
    bf16* O; int ldc;
    __device__ __forceinline__ void store(int row, int col, float (&v)[8]) const { *(v4u*)(O + (size_t)row * ldc + col) = pack8(v); }
};
struct F_MixA {
    bf16* MIX; const bf16* ZG;
    __device__ __forceinline__ void store(int row, int col, float (&v)[8]) const {
        const v2u gq = *(const v2u*)((const unsigned char*)ZG + (size_t)row * 2048 + col);
        const float g[8] = {(float)(gq.x & 0xffu), (float)((gq.x >> 8) & 0xffu), (float)((gq.x >> 16) & 0xffu), (float)(gq.x >> 24), (float)(gq.y & 0xffu), (float)((gq.y >> 8) & 0xffu), (float)((gq.y >> 16) & 0xffu), (float)(gq.y >> 24)};
#pragma unroll
        for (int e = 0; e < 8; ++e) v[e] *= g[e] * (1.0f / 255.0f);
        *(v4u*)(MIX + (size_t)row * 1024 + col) = pack8(v);
    }
};
struct F_MixB {
    bf16* MIX; const bf16* ZG;
    __device__ __forceinline__ void store(int row, int col, float (&v)[8]) const {
        float m[8]; unpack8(*(const v4u*)(MIX + (size_t)row * 1024 + col), m);
        const v2u gq = *(const v2u*)((const unsigned char*)ZG + (size_t)row * 2048 + 1024 + col);
        const float g[8] = {(float)(gq.x & 0xffu), (float)((gq.x >> 8) & 0xffu), (float)((gq.x >> 16) & 0xffu), (float)(gq.x >> 24), (float)(gq.y & 0xffu), (float)((gq.y >> 8) & 0xffu), (float)((gq.y >> 16) & 0xffu), (float)(gq.y >> 24)};
#pragma unroll
        for (int e = 0; e < 8; ++e) v[e] = m[e] + v[e] * g[e] * (1.0f / 255.0f);
        *(v4u*)(MIX + (size_t)row * 1024 + col) = pack8(v);
    }
};
struct F_Out {
    const float* x; float* out;
    __device__ __forceinline__ void store(int row, int col, float (&v)[8]) const {
        const int b = row / TP, pp = row - b * TP; if (pp < 64) return;
        const size_t off = ((size_t)b * SEQ + (pp - 64)) * 1024 + col;
        const f32x4 x0 = *(const f32x4*)(x + off), x1 = *(const f32x4*)(x + off + 4);
        *(f32x4*)(out + off) = (f32x4){x0.x + v[0], x0.y + v[1], x0.z + v[2], x0.w + v[3]};
        *(f32x4*)(out + off + 4) = (f32x4){x1.x + v[4], x1.y + v[5], x1.z + v[6], x1.w + v[7]};
    }
};
template <class F> struct EpiI8 {
    static constexpr bool PERM = true, AFTER_DRAIN = false;
    F f; const float* SA; const float* SB;
    __device__ __forceinline__ void operator()(const pg8::i32x4 (&acc)[2][2][4][2], const pg8::Unit& u, int wr, int wc, int fr, int fq) const {
        const int row0 = u.pm * 256 + wr * 64 + fr, col0 = u.pn * 256 + wc * 32 + 8 * fq;
        f32x4 sb[2][2];
#pragma unroll
        for (int bj = 0; bj < 2; ++bj) { sb[bj][0] = *(const f32x4*)(SB + col0 + bj * 128); sb[bj][1] = *(const f32x4*)(SB + col0 + bj * 128 + 4); }
#pragma unroll
        for (int ai = 0; ai < 2; ++ai)
#pragma unroll
            for (int m = 0; m < 4; ++m) {
                const int row = row0 + ai * 128 + m * 16; const float sa = SA[row];
#pragma unroll
                for (int bj = 0; bj < 2; ++bj) {
                    const pg8::i32x4 a = acc[ai][bj][m][0], b = acc[ai][bj][m][1];
                    float v[8] = {(float)a[0] * (sa * sb[bj][0].x), (float)a[1] * (sa * sb[bj][0].y), (float)a[2] * (sa * sb[bj][0].z), (float)a[3] * (sa * sb[bj][0].w),
                                  (float)b[0] * (sa * sb[bj][1].x), (float)b[1] * (sa * sb[bj][1].y), (float)b[2] * (sa * sb[bj][1].z), (float)b[3] * (sa * sb[bj][1].w)};
                    f.store(row, col0 + bj * 128, v);
                }
            }
    }
};
template <class F>
__device__ __forceinline__ void run_gemm_i8(LAS unsigned char* lds, const unsigned char* A8, const unsigned char* Bt8, int M, int N, int K8, int G, int bid, const float* SA, const float* SB, const F& f) {
    asm volatile("" : "+s"(M), "+s"(N), "+s"(G));
    pg8::Gemm g{(const bf16*)A8, (const bf16*)Bt8, M, N, K8 / 2}; pg8::StaticOrder S; S.init(M, N, G, bid);
    EpiI8<F> E{f, SA, SB};
    pg8::gemm_phase_i8<EpiI8<F>, pg8::StaticOrder, true, true>(lds, g, S, E);
}
struct PanelOrder {
    int c, G;
    __device__ __forceinline__ bool next(int i, pg8::Unit& u) const { const int pan = c + (i >> 2) * G; if (pan >= NTOK / 256) return false; u.pm = pan; u.pn = i & 3; return true; }
    __device__ __forceinline__ void a_ready(const pg8::Unit&) const {}
    __device__ __forceinline__ void done(const pg8::Unit&) const {}
    __device__ __forceinline__ size_t a_row0(int pm) const { return (size_t)(pm >> 4) * TP + 64 + (size_t)(pm & 15) * 256; }
};
struct F_OutC {
    const float* x; bf16* h1;
    __device__ __forceinline__ void store(int row, int col, float (&v)[8]) const {
        const size_t off = (size_t)row * 1024 + col;
        const f32x4 x0 = *(const f32x4*)(x + off), x1 = *(const f32x4*)(x + off + 4);
        v[0] += x0.x; v[1] += x0.y; v[2] += x0.z; v[3] += x0.w; v[4] += x1.x; v[5] += x1.y; v[6] += x1.z; v[7] += x1.w;
        *(v4u*)(h1 + off) = pack8(v);
    }
};
template <class F>
__device__ __forceinline__ void run_gemm_panels(LAS unsigned char* lds, const bf16* A, const bf16* Bt, int N, int K, int G, int c, const F& f) {
    asm volatile("" : "+s"(N), "+s"(G));
    pg8::Gemm g{A, Bt, NTOK, N, K}; PanelOrder S{c, G};
    EpiT<F> E{f};
    pg8::gemm_phase<EpiT<F>, PanelOrder, true, true>(lds, g, S, E);
}
template <class F>
__device__ __forceinline__ void run_gemm(LAS unsigned char* lds, const bf16* A, const bf16* Bt, int M, int N, int K, int G, int bid, const F& f) {
    asm volatile("" : "+s"(M), "+s"(N), "+s"(G));
    pg8::Gemm g{A, Bt, M, N, K}; pg8::StaticOrder S; S.init(M, N, G, bid);
    EpiT<F> E{f};
    pg8::gemm_phase<EpiT<F>, pg8::StaticOrder, true, true>(lds, g, S, E);
}

__device__ __forceinline__ void p2_prep1(const Params& p, int vcu, int G, int wave, int lane) {
    unsigned char* ws = p.ws;
    const int gw = vcu * NWAVES + wave, NGW = G * NWAVES;
    float gq[8], gk[8], mu[8];
#pragma unroll
    for (int e = 0; e < 8; ++e) { gq[e] = p.in[I_FQN][lane * 8 + e] * attn_body::C2; gk[e] = p.in[I_FKN][lane * 8 + e]; mu[e] = (lane < 36) ? p.in[I_MU][1536 + lane * 8 + e] : 0.f; }
    for (int m = gw; m < R; m += NGW) {
        const int b = m / TP, pp = m - b * TP;
        {
            v4u* qp = (v4u*)(ws + WS_FQ + (size_t)m * 1024) + lane; v4u* kp = (v4u*)(ws + WS_FK + (size_t)m * 1024) + lane;
            float q[8], k[8]; unpack8(*qp, q); unpack8(*kp, k);
            float sq = 0.f, sk = 0.f;
#pragma unroll
            for (int e = 0; e < 8; ++e) { sq += q[e] * q[e]; sk += k[e] * k[e]; }
            sq = sum8(sq); sk = sum8(sk);
            const float rq = 1.0f / sqrtf(sq * (1.f / 64.f) + NORM_EPS), rk = 1.0f / sqrtf(sk * (1.f / 64.f) + NORM_EPS);
#pragma unroll
            for (int e = 0; e < 8; ++e) { q[e] *= rq * gq[e]; k[e] *= rk * gk[e]; }
            *qp = pack8(q); *kp = pack8(k);
        }
        if (lane < 36) {
            float z[8], zp[8]; unpack8(*((const v4u*)(ws + WS_ZM + (size_t)m * 1024) + lane), z);
            if (pp > 0) unpack8(*((const v4u*)(ws + WS_ZM + (size_t)(m - 1) * 1024) + lane), zp); else {
#pragma unroll
                for (int e = 0; e < 8; ++e) zp[e] = 0.f; }
#pragma unroll
            for (int e = 0; e < 8; ++e) { const float s = z[e] + mu[e] * (zp[e] - z[e]); z[e] = (lane < 8) ? tanhf(s) : (lane < 16) ? s : sigmoidf_(s); }
            if (lane < 16) *((v4u*)(ws + WS_LA + (size_t)m * 256) + lane) = pack8(z);
            else *((v4u*)(ws + WS_LG + (size_t)m * 512) + (lane - 16)) = pack8(z);
        } else if (lane == 36) {
            float z[8]; unpack8(*((const v4u*)(ws + WS_ZM + (size_t)m * 1024) + 36), z);
#pragma unroll
            for (int e = 0; e < 8; ++e) { const float x = z[e] + p.in[I_FBIAS][e]; z[e] = fminf(x, 0.f) - __logf(1.0f + __expf(-fabsf(x))); }
            float* lf = (float*)(ws + WS_LF) + (size_t)m * 8;
            *(f32x4*)lf = (f32x4){z[0], z[1], z[2], z[3]}; *(f32x4*)(lf + 4) = (f32x4){z[4], z[5], z[6], z[7]};
        } else if (lane < 49) {
            *((v4u*)(ws + WS_LG + (size_t)m * 512) + (lane - 37 + 20)) = (v4u){0u, 0u, 0u, 0u};
        }
    }
}
__device__ __forceinline__ void p3_cumsum(const Params& p, int seq, int lane) {
    unsigned char* ws = p.ws;
    const int b = seq >> 3, h = seq & 7;
    const float* lf = (const float*)(ws + WS_LF) + (size_t)b * TP * 8 + h;
    float* kb = (float*)(ws + WS_KB) + (size_t)seq * TP;
    float carry = 0.f;
    for (int c0 = 0; c0 < 65; c0 += 13) {
        float v[13];
#pragma unroll
        for (int i = 0; i < 13; ++i) { const int pp = (c0 + i) * 64 + lane; v[i] = (pp >= 48) ? lf[(size_t)pp * 8] : 0.f; }
#pragma unroll
        for (int i = 0; i < 13; ++i) {
            float x = v[i];
#pragma unroll
            for (int o = 1; o < 64; o <<= 1) { const float y = __shfl_up(x, o); if (lane >= o) x += y; }
            const int pp = (c0 + i) * 64 + lane;
            const float c = carry + x;
            kb[pp] = (pp >= 48) ? -c * LOG2E : -1e30f;
            carry += __shfl(x, 63);
        }
    }
}

__device__ __forceinline__ void p4_prep2(const Params& p, int vcu, int G, int wave, int lane) {
    unsigned char* ws = p.ws; unsigned char* dob = (unsigned char*)p.out;
    const int gw = vcu * NWAVES + wave, NGW = G * NWAVES;
    float mur[8], muk[8], kk_[8], ka_[8], rk_[8];
#pragma unroll
    for (int e = 0; e < 8; ++e) { const int c = lane * 8 + e; mur[e] = p.in[I_MU][c]; muk[e] = p.in[I_MU][512 + c]; kk_[e] = p.in[I_KK][c]; ka_[e] = p.in[I_KA][c]; rk_[e] = p.in[I_RK][c]; }
    for (int m = gw; m < R; m += NGW) {
        const int b = m / TP, pp = m - b * TP;
        float r[8], k[8], rp[8], kp[8], a[8];
        unpack8(*((const v4u*)(ws + WS_ZRR + (size_t)m * 1024) + lane), r); unpack8(*((const v4u*)(ws + WS_ZRK + (size_t)m * 1024) + lane), k);
        if (pp > 0) { unpack8(*((const v4u*)(ws + WS_ZRR + (size_t)(m - 1) * 1024) + lane), rp); unpack8(*((const v4u*)(ws + WS_ZRK + (size_t)(m - 1) * 1024) + lane), kp); }
        else {
#pragma unroll
            for (int e = 0; e < 8; ++e) { rp[e] = 0.f; kp[e] = 0.f; } }
        v4u* aap = (v4u*)(dob + DO_AA + (size_t)m * 1024) + lane;
        unpack8(*aap, a);
        float kkv[8], kpr[8]; float ss = 0.f, bon = 0.f;
#pragma unroll
        for (int e = 0; e < 8; ++e) { const float rs = r[e] + mur[e] * (rp[e] - r[e]); const float ks = k[e] + muk[e] * (kp[e] - k[e]);
            kkv[e] = ks * kk_[e]; kpr[e] = ks * (1.0f + (a[e] - 1.0f) * ka_[e]); ss += kkv[e] * kkv[e]; bon += rs * kpr[e] * rk_[e]; }
        ss = sum8(ss); bon = sum8(bon);
        const float inv = 1.0f / fmaxf(sqrtf(ss), 1e-12f);
        float bb[8];
#pragma unroll
        for (int e = 0; e < 8; ++e) { kkv[e] *= inv; bb[e] = kkv[e] * a[e]; }
        *((v4u*)(ws + WS_KP + (size_t)m * 1024) + lane) = pack8(kpr);
        *((v4u*)(ws + WS_KN + (size_t)m * 1024) + lane) = pack8(kkv);
        *aap = pack8(bb);
        if ((lane & 7) == 0) ((float*)(ws + WS_BS))[(size_t)m * 8 + (lane >> 3)] = bon;
    }
}

constexpr int SC_CH = 32, SC_STRIDE = 5 * 64 + 32;
constexpr int SC_BUF_BYTES = SC_CH * SC_STRIDE * 4;
constexpr int SC_YB_BYTES = SC_CH * 32 * 4 * 4;
__device__ __forceinline__ float dpp_sum16(float x) {
    x += __builtin_bit_cast(float, __builtin_amdgcn_update_dpp(0, __builtin_bit_cast(int, x), 0xB1, 0xF, 0xF, true));
    x += __builtin_bit_cast(float, __builtin_amdgcn_update_dpp(0, __builtin_bit_cast(int, x), 0x4E, 0xF, 0xF, true));
    x += __builtin_bit_cast(float, __builtin_amdgcn_update_dpp(0, __builtin_bit_cast(int, x), 0x141, 0xF, 0xF, true));
    x += __builtin_bit_cast(float, __builtin_amdgcn_update_dpp(0, __builtin_bit_cast(int, x), 0x140, 0xF, 0xF, true));
    return x;
}
__device__ __forceinline__ float dpp_sum4(float x) {
    x += __builtin_bit_cast(float, __builtin_amdgcn_update_dpp(0, __builtin_bit_cast(int, x), 0xB1, 0xF, 0xF, true));
    x += __builtin_bit_cast(float, __builtin_amdgcn_update_dpp(0, __builtin_bit_cast(int, x), 0x4E, 0xF, 0xF, true));
    return x;
}
struct ScanVec { f32x4 xw, kn, bb, kp, rr; float va, vb; };
__device__ __forceinline__ void p5_scan_item(const Params& p, LAS unsigned char* lds, int item, int tid, int wave, int lane) {
    unsigned char* ws = p.ws; unsigned char* dob = (unsigned char*)p.out;
    const int half = item & 1, bh = item >> 1, b = bh >> 3, h = bh & 7;
    const size_t rowb = (size_t)b * TP;
    constexpr int T0 = 32, NCH = (TP - T0) / SC_CH;
    bf16* Y = (bf16*)(ws + WS_Y);
    LAS float* yb0 = (LAS float*)(lds + 2 * SC_BUF_BYTES);
    if (wave >= 4) {
        const int lt = tid - 256;
        const int st_step = lt >> 3, c8 = lt & 7;
        const size_t colb = (size_t)h * 64 + c8 * 8;
        const bf16* aXW = (const bf16*)(dob + DO_XW); const bf16* aKN = (const bf16*)(ws + WS_KN); const bf16* aBB = (const bf16*)(dob + DO_AA); const bf16* aKP = (const bf16*)(ws + WS_KP);
        const bf16* aR = (const bf16*)(ws + WS_ZRR); const bf16* aV = (const bf16*)(ws + WS_ZRV);
        float mur[8], muv[8];
#pragma unroll
        for (int e = 0; e < 8; ++e) { mur[e] = p.in[I_MU][h * 64 + c8 * 8 + e]; muv[e] = (c8 < 4) ? p.in[I_MU][1024 + h * 64 + half * 32 + c8 * 8 + e] : 0.f; }
        auto stage = [&](int t0, int bufi) {
            const size_t row = rowb + t0 + st_step;
            const v4u g0 = *(const v4u*)(aXW + row * 512 + colb), g1 = *(const v4u*)(aKN + row * 512 + colb), g2 = *(const v4u*)(aBB + row * 512 + colb), g3 = *(const v4u*)(aKP + row * 512 + colb);
            const v4u g4 = *(const v4u*)(aR + row * 512 + colb), g5 = *(const v4u*)(aR + (row - 1) * 512 + colb);
            v4u g6 = {0u, 0u, 0u, 0u}, g7 = {0u, 0u, 0u, 0u};
            if (c8 < 4) { const size_t cv = (size_t)h * 64 + half * 32 + c8 * 8; g6 = *(const v4u*)(aV + row * 512 + cv); g7 = *(const v4u*)(aV + (row - 1) * 512 + cv); }
            LAS float* d = (LAS float*)(lds + bufi * SC_BUF_BYTES) + st_step * SC_STRIDE + c8 * 8;
            float a[8], c[8];
            unpack8(g0, a); *(LAS f32x4*)(d + 0 * 64) = (f32x4){a[0], a[1], a[2], a[3]}; *(LAS f32x4*)(d + 0 * 64 + 4) = (f32x4){a[4], a[5], a[6], a[7]};
            unpack8(g1, a); *(LAS f32x4*)(d + 1 * 64) = (f32x4){a[0], a[1], a[2], a[3]}; *(LAS f32x4*)(d + 1 * 64 + 4) = (f32x4){a[4], a[5], a[6], a[7]};
            unpack8(g2, a); *(LAS f32x4*)(d + 2 * 64) = (f32x4){a[0], a[1], a[2], a[3]}; *(LAS f32x4*)(d + 2 * 64 + 4) = (f32x4){a[4], a[5], a[6], a[7]};
            unpack8(g3, a); *(LAS f32x4*)(d + 3 * 64) = (f32x4){a[0], a[1], a[2], a[3]}; *(LAS f32x4*)(d + 3 * 64 + 4) = (f32x4){a[4], a[5], a[6], a[7]};
            unpack8(g4, a); unpack8(g5, c);
#pragma unroll
            for (int e = 0; e < 8; ++e) a[e] = a[e] + mur[e] * (c[e] - a[e]);
            *(LAS f32x4*)(d + 4 * 64) = (f32x4){a[0], a[1], a[2], a[3]}; *(LAS f32x4*)(d + 4 * 64 + 4) = (f32x4){a[4], a[5], a[6], a[7]};
            if (c8 < 4) { unpack8(g6, a); unpack8(g7, c);
#pragma unroll
                for (int e = 0; e < 8; ++e) a[e] = a[e] + muv[e] * (c[e] - a[e]);
                *(LAS f32x4*)(d + 5 * 64) = (f32x4){a[0], a[1], a[2], a[3]}; *(LAS f32x4*)(d + 5 * 64 + 4) = (f32x4){a[4], a[5], a[6], a[7]}; }
        };
        auto flush = [&](int t0, int ybi) {
            const LAS f32x4* yq = (const LAS f32x4*)(lds + 2 * SC_BUF_BYTES + ybi * SC_YB_BYTES) + (lt >> 3) * 32 + (lt & 7) * 4;
            float y[4];
#pragma unroll
            for (int r = 0; r < 4; ++r) { const f32x4 q = yq[r]; y[r] = (q.x + q.y) + (q.z + q.w); }
            v2u o; o.x = pk2(y[0], y[1]); o.y = pk2(y[2], y[3]);
            *(v2u*)(Y + (rowb + t0 + (lt >> 3)) * 512 + h * 64 + half * 32 + 4 * (lt & 7)) = o;
        };
        stage(T0, 0);
        __syncthreads();
        for (int ch = 0; ch < NCH; ++ch) {
            if (ch + 1 < NCH) stage(T0 + (ch + 1) * SC_CH, (ch + 1) & 1);
            if (ch > 0) flush(T0 + (ch - 1) * SC_CH, (ch - 1) & 1);
            __syncthreads();
        }
        flush(T0 + (NCH - 1) * SC_CH, (NCH - 1) & 1);
    } else {
        const int rl = lane >> 4, kq = lane & 15, rowA = wave * 8 + rl, rowB = rowA + 4;
        f32x4 SA = {0.f, 0.f, 0.f, 0.f}, SB = {0.f, 0.f, 0.f, 0.f};
        auto ldv = [&](const LAS float* base, int s) { ScanVec v; const LAS float* q = base + s * SC_STRIDE + kq * 4;
            v.xw = *(const LAS f32x4*)(q); v.kn = *(const LAS f32x4*)(q + 64); v.bb = *(const LAS f32x4*)(q + 128); v.kp = *(const LAS f32x4*)(q + 192); v.rr = *(const LAS f32x4*)(q + 256);
            v.va = base[s * SC_STRIDE + 320 + rowA]; v.vb = base[s * SC_STRIDE + 320 + rowB]; return v; };
        auto step = [&](const ScanVec& v, LAS float* yb, int s) {
            float sa = SA.x * v.kn.x; sa = fmaf(SA.y, v.kn.y, sa); sa = fmaf(SA.z, v.kn.z, sa); sa = fmaf(SA.w, v.kn.w, sa);
            float sb = SB.x * v.kn.x; sb = fmaf(SB.y, v.kn.y, sb); sb = fmaf(SB.z, v.kn.z, sb); sb = fmaf(SB.w, v.kn.w, sb);
            sa = -dpp_sum16(sa); sb = -dpp_sum16(sb);
            SA = (SA - SA * v.xw) + sa * v.bb + v.va * v.kp;
            SB = (SB - SB * v.xw) + sb * v.bb + v.vb * v.kp;
            float ya = SA.x * v.rr.x; ya = fmaf(SA.y, v.rr.y, ya); ya = fmaf(SA.z, v.rr.z, ya); ya = fmaf(SA.w, v.rr.w, ya);
            float yv = SB.x * v.rr.x; yv = fmaf(SB.y, v.rr.y, yv); yv = fmaf(SB.z, v.rr.z, yv); yv = fmaf(SB.w, v.rr.w, yv);
            ya = dpp_sum4(ya); yv = dpp_sum4(yv);
            yb[(s * 32 + rowA) * 4 + (kq >> 2)] = ya; yb[(s * 32 + rowB) * 4 + (kq >> 2)] = yv;
        };
        __syncthreads();
        for (int ch = 0; ch < NCH; ++ch) {
            const LAS float* base = (const LAS float*)(lds + (ch & 1) * SC_BUF_BYTES);
            LAS float* yb = yb0 + (ch & 1) * (SC_YB_BYTES / 4);
            ScanVec v0 = ldv(base, 0), v1;
#pragma unroll 1
            for (int s = 0; s < SC_CH; s += 2) {
                v1 = ldv(base, s + 1);
                step(v0, yb, s);
                if (s + 2 < SC_CH) v0 = ldv(base, s + 2);
                step(v1, yb, s + 1);
            }
            __syncthreads();
        }
    }
    __syncthreads();
}

#ifndef SC2_DBG
#define SC2_DBG 0
#endif
namespace sc2 {
constexpr int S64 = 144, S32 = 80, SAAB = 36, SRHS = 68;
constexpr int AT = 0, RT = AT + 32 * S64, BT = RT + 32 * S64, KT = BT + 32 * S64, BH = KT + 32 * S64, KH = BH + 32 * S64, VV = KH + 32 * S64, PT = VV + 32 * S64,
              AAK = PT + 64 * S32, ARB = AAK + 32 * S32, ARK = ARB + 32 * S32, SB = ARK + 32 * S32, AAB = SB + 64 * S64, RHS = AAB + 32 * SAAB * 4, CL = RHS + 32 * SRHS * 4,
              GC = CL + 32 * 64 * 4, END = GC + 256;
static_assert(END <= 100000, "scan LDS");
}
__device__ __forceinline__ bf16x8 sc2_frag(LAS unsigned char* base, int stride, int row0, int k0, int lane) {
    return *(const LAS bf16x8*)(base + (row0 + (lane & 15)) * stride + (k0 + 8 * (lane >> 4)) * 2);
}
typedef short sc2_v4i16 __attribute__((ext_vector_type(4)));
__device__ __forceinline__ bf16x8 sc2_frag_tr(LAS unsigned char* base, int col0, int lane) {
    const int i = lane & 15, g = lane >> 4;
    LAS unsigned char* a = base + (8 * g + (i >> 2)) * sc2::S64 + (col0 + 4 * (i & 3)) * 2;
    const sc2_v4i16 lo = __builtin_amdgcn_ds_read_tr16_b64_v4i16((LAS sc2_v4i16*)a), hi = __builtin_amdgcn_ds_read_tr16_b64_v4i16((LAS sc2_v4i16*)(a + 4 * sc2::S64));
    return (bf16x8){lo[0], lo[1], lo[2], lo[3], hi[0], hi[1], hi[2], hi[3]};
}
#define SC2_BAR() asm volatile("s_waitcnt lgkmcnt(0)\n\ts_barrier" ::: "memory")
__device__ __forceinline__ void p5_scan_chunked(const Params& p, LAS unsigned char* lds, int bh, int tid, int wave, int lane) {
    using namespace sc2;
    unsigned char* ws = p.ws; unsigned char* dob = (unsigned char*)p.out;
    const int b = bh >> 3, h = bh & 7;
    const size_t rowb = (size_t)b * TP;
    constexpr int T0 = 32, NCH = (TP - T0) / 32;
    const bf16* aXW = (const bf16*)(dob + DO_XW); const bf16* aA = (const bf16*)(dob + DO_AA); const bf16* aG = (const bf16*)(dob + DO_GG);
    const bf16* aR = (const bf16*)(ws + WS_ZRR); const bf16* aK = (const bf16*)(ws + WS_ZRK); const bf16* aV = (const bf16*)(ws + WS_ZRV);
    bf16* Y = (bf16*)(ws + WS_Y);
    const int pt = tid >> 4, kc = tid & 15;
    const size_t kcol = (size_t)h * 64 + 4 * kc;
    float mur[4], muk[4], muv[4], kk_[4], ka_[4], rk_[4], lng[4], lnb[4];
#pragma unroll
    for (int e = 0; e < 4; ++e) { const int c = h * 64 + 4 * kc + e; mur[e] = p.in[I_MU][c]; muk[e] = p.in[I_MU][512 + c]; muv[e] = p.in[I_MU][1024 + c];
        kk_[e] = p.in[I_KK][c]; ka_[e] = p.in[I_KA][c]; rk_[e] = p.in[I_RK][c]; lng[e] = p.in[I_LNG][c]; lnb[e] = p.in[I_LNB][c]; }
    const int q = lane >> 4, c16 = lane & 15;
    const int m_ = wave >> 1, tr = wave & 1;
    const int tr2 = wave >> 2, vc2 = wave & 3;
    const int kt = wave >> 1, vh = wave & 1;
    pg8::f32x4 accS0 = {0.f, 0.f, 0.f, 0.f}, accS1 = {0.f, 0.f, 0.f, 0.f};
    for (int i = tid; i < 64 * S64 / 4; i += NTHREADS) ((LAS unsigned*)(lds + SB))[i] = 0u;
    v2u gxw, ga, gk0, gk1, gr0, gr1, gv0, gv1, ggn;
    auto prefetch = [&](int t0) { const size_t row = rowb + t0 + pt;
        gxw = *(const v2u*)(aXW + row * 512 + kcol); ga = *(const v2u*)(aA + row * 512 + kcol); ggn = *(const v2u*)(aG + row * 512 + kcol);
        gk0 = *(const v2u*)(aK + row * 512 + kcol); gk1 = *(const v2u*)(aK + (row - 1) * 512 + kcol);
        gr0 = *(const v2u*)(aR + row * 512 + kcol); gr1 = *(const v2u*)(aR + (row - 1) * 512 + kcol);
        gv0 = *(const v2u*)(aV + row * 512 + kcol); gv1 = *(const v2u*)(aV + (row - 1) * 512 + kcol); };
    prefetch(T0);
    float e_vs[4] = {0.f, 0.f, 0.f, 0.f}, e_bs = 0.f; v2u e_gg = {0u, 0u};
    auto y_epilogue = [&](int t0p) {
        const f32x4 y4 = *(const LAS f32x4*)(lds + RHS + (pt * SRHS + 4 * kc) * 4);
        float y[4] = {y4.x, y4.y, y4.z, y4.w};
        const float mean = dpp_sum16((y[0] + y[1]) + (y[2] + y[3])) * (1.f / 64.f);
        float qq = 0.f;
#pragma unroll
        for (int e = 0; e < 4; ++e) { y[e] -= mean; qq += y[e] * y[e]; }
        const float rstd = 1.0f / sqrtf(dpp_sum16(qq) * (1.f / 64.f) + GN_EPS);
        const float g[4] = {bflo(e_gg.x), bfhi(e_gg.x), bflo(e_gg.y), bfhi(e_gg.y)};
        float o[4];
#pragma unroll
        for (int e = 0; e < 4; ++e) o[e] = (y[e] * rstd * lng[e] + lnb[e] + e_bs * e_vs[e]) * g[e];
        v2u w; w.x = pk2(o[0], o[1]); w.y = pk2(o[2], o[3]);
        *(v2u*)(Y + (rowb + t0p + pt) * 512 + kcol) = w;
    };
    for (int ch = 0; ch < NCH; ++ch) {
        const int t0 = T0 + ch * 32;
        { f32x4 lg; lg.x = __builtin_amdgcn_logf(1.0f - bflo(gxw.x)); lg.y = __builtin_amdgcn_logf(1.0f - bfhi(gxw.x)); lg.z = __builtin_amdgcn_logf(1.0f - bflo(gxw.y)); lg.w = __builtin_amdgcn_logf(1.0f - bfhi(gxw.y));
          *(LAS f32x4*)(lds + CL + (pt * 64 + 4 * kc) * 4) = lg; }
        SC2_BAR();
        if (ch > 0) y_epilogue(t0 - 32);
        if (tid < 64) { LAS float* c = (LAS float*)(lds + CL) + tid; float run = 0.f;
#pragma unroll
            for (int t = 0; t < 32; ++t) { run += c[t * 64]; c[t * 64] = run; } }
        SC2_BAR();
        {
            const f32x4 clt = *(const LAS f32x4*)(lds + CL + (pt * 64 + 4 * kc) * 4);
            f32x4 clp = {0.f, 0.f, 0.f, 0.f}; if (pt > 0) clp = *(const LAS f32x4*)(lds + CL + ((pt - 1) * 64 + 4 * kc) * 4);
            const f32x4 clc = *(const LAS f32x4*)(lds + CL + (31 * 64 + 4 * kc) * 4);
            const float k0[4] = {bflo(gk0.x), bfhi(gk0.x), bflo(gk0.y), bfhi(gk0.y)}, k1[4] = {bflo(gk1.x), bfhi(gk1.x), bflo(gk1.y), bfhi(gk1.y)}, av[4] = {bflo(ga.x), bfhi(ga.x), bflo(ga.y), bfhi(ga.y)};
            const float r0[4] = {bflo(gr0.x), bfhi(gr0.x), bflo(gr0.y), bfhi(gr0.y)}, r1[4] = {bflo(gr1.x), bfhi(gr1.x), bflo(gr1.y), bfhi(gr1.y)};
            const float v0[4] = {bflo(gv0.x), bfhi(gv0.x), bflo(gv0.y), bfhi(gv0.y)}, v1[4] = {bflo(gv1.x), bfhi(gv1.x), bflo(gv1.y), bfhi(gv1.y)};
            float kkv[4], kp[4], rsv[4], ss = 0.f, bon = 0.f;
#pragma unroll
            for (int e = 0; e < 4; ++e) { const float ks = k0[e] + muk[e] * (k1[e] - k0[e]); rsv[e] = r0[e] + mur[e] * (r1[e] - r0[e]); e_vs[e] = v0[e] + muv[e] * (v1[e] - v0[e]);
                kkv[e] = ks * kk_[e]; kp[e] = ks * (1.0f + (av[e] - 1.0f) * ka_[e]); ss += kkv[e] * kkv[e]; bon += rsv[e] * kp[e] * rk_[e]; }
            ss = dpp_sum16(ss); e_bs = dpp_sum16(bon); e_gg = ggn;
            const float inv = 1.0f / fmaxf(sqrtf(ss), 1e-12f);
            float kn[4], bb[4];
#pragma unroll
            for (int e = 0; e < 4; ++e) { kn[e] = kkv[e] * inv; bb[e] = kn[e] * av[e]; }
            float at[4], rt[4], bt[4], ktl[4], bh_[4], kh_[4];
#pragma unroll
            for (int e = 0; e < 4; ++e) {
                const float gt = __builtin_amdgcn_exp2f(clt[e]), gp = __builtin_amdgcn_exp2f(clp[e]), gi = __builtin_amdgcn_exp2f(-clt[e]), gc = __builtin_amdgcn_exp2f(clc[e] - clt[e]);
                const float rs = rsv[e];
                at[e] = -kn[e] * gp; rt[e] = rs * gt; bt[e] = bb[e] * gi; ktl[e] = kp[e] * gi; bh_[e] = bb[e] * gc; kh_[e] = kp[e] * gc;
            }
            v2u w;
            w.x = pk2(at[0], at[1]); w.y = pk2(at[2], at[3]); *(LAS v2u*)(lds + AT + pt * S64 + 8 * kc) = w;
            w.x = pk2(rt[0], rt[1]); w.y = pk2(rt[2], rt[3]); *(LAS v2u*)(lds + RT + pt * S64 + 8 * kc) = w;
            w.x = pk2(bt[0], bt[1]); w.y = pk2(bt[2], bt[3]); *(LAS v2u*)(lds + BT + pt * S64 + 8 * kc) = w;
            w.x = pk2(ktl[0], ktl[1]); w.y = pk2(ktl[2], ktl[3]); *(LAS v2u*)(lds + KT + pt * S64 + 8 * kc) = w;
            w.x = pk2(bh_[0], bh_[1]); w.y = pk2(bh_[2], bh_[3]); *(LAS v2u*)(lds + BH + pt * S64 + 8 * kc) = w;
            w.x = pk2(kh_[0], kh_[1]); w.y = pk2(kh_[2], kh_[3]); *(LAS v2u*)(lds + KH + pt * S64 + 8 * kc) = w;
            w.x = pk2(e_vs[0], e_vs[1]); w.y = pk2(e_vs[2], e_vs[3]); *(LAS v2u*)(lds + VV + pt * S64 + 8 * kc) = w;
            if (pt == 31) *(LAS f32x4*)(lds + GC + 16 * kc) = (f32x4){__builtin_amdgcn_exp2f(clc[0]), __builtin_amdgcn_exp2f(clc[1]), __builtin_amdgcn_exp2f(clc[2]), __builtin_amdgcn_exp2f(clc[3])};
        }
        if (ch + 1 < NCH) prefetch(t0 + 32);
        SC2_BAR();
        pg8::f32x4 accR, accY;
        {
            LAS unsigned char* Ab = lds + ((m_ < 2) ? AT : RT); LAS unsigned char* Bb = lds + ((m_ & 1) ? KT : BT);
            const bf16x8 a0 = sc2_frag(Ab, S64, 16 * tr, 0, lane), a1 = sc2_frag(Ab, S64, 16 * tr, 32, lane);
#pragma unroll
            for (int tc = 0; tc < 2; ++tc) {
                const bf16x8 b0 = sc2_frag(Bb, S64, 16 * tc, 0, lane), b1 = sc2_frag(Bb, S64, 16 * tc, 32, lane);
                pg8::f32x4 c = {0.f, 0.f, 0.f, 0.f};
                c = __builtin_amdgcn_mfma_f32_16x16x32_bf16(a0, b0, c, 0, 0, 0); c = __builtin_amdgcn_mfma_f32_16x16x32_bf16(a1, b1, c, 0, 0, 0);
                const int i = 16 * tc + c16;
#pragma unroll
                for (int r = 0; r < 4; ++r) { const int t = 16 * tr + 4 * q + r; const bool keep = (m_ < 2) ? (i < t) : (i <= t); const float val = keep ? c[r] : 0.f;
                    if (m_ == 0) *(LAS float*)(lds + AAB + (t * SAAB + i) * 4) = val;
                    else *(LAS bf16*)(lds + (m_ == 1 ? AAK : (m_ == 2 ? ARB : ARK)) + t * S32 + 2 * i) = (bf16)f2bf(val); }
            }
            const bf16x8 sb0 = sc2_frag(lds + SB, S64, 16 * vc2, 0, lane), sb1 = sc2_frag(lds + SB, S64, 16 * vc2, 32, lane);
            const bf16x8 ra0 = sc2_frag(lds + AT, S64, 16 * tr2, 0, lane), ra1 = sc2_frag(lds + AT, S64, 16 * tr2, 32, lane);
            const bf16x8 ya0 = sc2_frag(lds + RT, S64, 16 * tr2, 0, lane), ya1 = sc2_frag(lds + RT, S64, 16 * tr2, 32, lane);
            accR = (pg8::f32x4){0.f, 0.f, 0.f, 0.f}; accY = accR;
            accR = __builtin_amdgcn_mfma_f32_16x16x32_bf16(ra0, sb0, accR, 0, 0, 0); accR = __builtin_amdgcn_mfma_f32_16x16x32_bf16(ra1, sb1, accR, 0, 0, 0);
            accY = __builtin_amdgcn_mfma_f32_16x16x32_bf16(ya0, sb0, accY, 0, 0, 0); accY = __builtin_amdgcn_mfma_f32_16x16x32_bf16(ya1, sb1, accY, 0, 0, 0);
        }
        SC2_BAR();
        {
            const bf16x8 bv = sc2_frag_tr(lds + VV, 16 * vc2, lane);
            accR = __builtin_amdgcn_mfma_f32_16x16x32_bf16(sc2_frag(lds + AAK, S32, 16 * tr2, 0, lane), bv, accR, 0, 0, 0);
            accY = __builtin_amdgcn_mfma_f32_16x16x32_bf16(sc2_frag(lds + ARK, S32, 16 * tr2, 0, lane), bv, accY, 0, 0, 0);
#pragma unroll
            for (int r = 0; r < 4; ++r) *(LAS float*)(lds + RHS + ((16 * tr2 + 4 * q + r) * SRHS + 16 * vc2 + c16) * 4) = accR[r];
        }
        SC2_BAR();
        if (wave < 2) {
            const int v = 32 * wave + (lane & 31), par = lane >> 5;
            float qv[4][4];
#pragma unroll
            for (int m = 0; m < 4; ++m)
#pragma unroll
                for (int j = 0; j < 4; ++j) qv[m][j] = 0.f;
            unsigned pk[16]; float prev = 0.f;
            const LAS float* arow = (const LAS float*)(lds + AAB) + 4 * par;
#pragma unroll
            for (int t = 0; t < 32; ++t) {
                const float rh = *(const LAS float*)(lds + RHS + (t * SRHS + v) * 4);
                float a0 = par ? 0.f : rh, a1 = 0.f;
                const int nm = t ? ((t - 1) >> 3) + 1 : 0;
#pragma unroll
                for (int m = 0; m < nm; ++m) { const f32x4 w = *(const LAS f32x4*)(arow + t * SAAB + 8 * m);
                    a0 = fmaf(w.x, qv[m][0], a0); a1 = fmaf(w.y, qv[m][1], a1); a0 = fmaf(w.z, qv[m][2], a0); a1 = fmaf(w.w, qv[m][3], a1); }
                const float part = a0 + a1;
                auto rr = __builtin_amdgcn_permlane32_swap(__float_as_uint(part), __float_as_uint(part), false, false);
                const unsigned r0 = rr[0], r1 = rr[1];
                const float pt_ = __uint_as_float(r0) + __uint_as_float(r1);
                { const int g4 = t >> 2; qv[g4 >> 1][t & 3] = (par == (g4 & 1)) ? pt_ : qv[g4 >> 1][t & 3]; }
                if (t & 1) pk[t >> 1] = pk2(prev, pt_); else prev = pt_;
                if ((t & 3) == 3) asm volatile("" ::: "memory");
            }
            if (lane < 32) {
#pragma unroll
                for (int g = 0; g < 4; ++g) { v4u w; w.x = pk[4 * g]; w.y = pk[4 * g + 1]; w.z = pk[4 * g + 2]; w.w = pk[4 * g + 3]; *(LAS v4u*)(lds + PT + v * S32 + 16 * g) = w; } }
        }
        SC2_BAR();
        {
            accY = __builtin_amdgcn_mfma_f32_16x16x32_bf16(sc2_frag(lds + ARB, S32, 16 * tr2, 0, lane), sc2_frag(lds + PT, S32, 16 * vc2, 0, lane), accY, 0, 0, 0);
#pragma unroll
            for (int r = 0; r < 4; ++r) *(LAS float*)(lds + RHS + ((16 * tr2 + 4 * q + r) * SRHS + 16 * vc2 + c16) * 4) = accY[r];
            const f32x4 gcv = *(const LAS f32x4*)(lds + GC + (16 * kt + 4 * q) * 4);
            const bf16x8 ab = sc2_frag_tr(lds + BH, 16 * kt, lane), ak = sc2_frag_tr(lds + KH, 16 * kt, lane);
            accS0[0] *= gcv.x; accS0[1] *= gcv.y; accS0[2] *= gcv.z; accS0[3] *= gcv.w; accS1[0] *= gcv.x; accS1[1] *= gcv.y; accS1[2] *= gcv.z; accS1[3] *= gcv.w;
            accS0 = __builtin_amdgcn_mfma_f32_16x16x32_bf16(ab, sc2_frag(lds + PT, S32, 32 * vh, 0, lane), accS0, 0, 0, 0);
            accS0 = __builtin_amdgcn_mfma_f32_16x16x32_bf16(ak, sc2_frag_tr(lds + VV, 32 * vh, lane), accS0, 0, 0, 0);
            accS1 = __builtin_amdgcn_mfma_f32_16x16x32_bf16(ab, sc2_frag(lds + PT, S32, 32 * vh + 16, 0, lane), accS1, 0, 0, 0);
            accS1 = __builtin_amdgcn_mfma_f32_16x16x32_bf16(ak, sc2_frag_tr(lds + VV, 32 * vh + 16, lane), accS1, 0, 0, 0);
            v2u w; w.x = pk2(accS0[0], accS0[1]); w.y = pk2(accS0[2], accS0[3]);
            *(LAS v2u*)(lds + SB + (32 * vh + c16) * S64 + (16 * kt + 4 * q) * 2) = w;
            w.x = pk2(accS1[0], accS1[1]); w.y = pk2(accS1[2], accS1[3]);
            *(LAS v2u*)(lds + SB + (32 * vh + 16 + c16) * S64 + (16 * kt + 4 * q) * 2) = w;
        }
    }
    __syncthreads();
    y_epilogue(T0 + (NCH - 1) * 32);
    __syncthreads();
}

__device__ __forceinline__ void p6_prep3(const Params& p, int vcu, int G, int wave, int lane) {
    unsigned char* ws = p.ws; unsigned char* dob = (unsigned char*)p.out;
    const int gw = vcu * NWAVES + wave, NGW = G * NWAVES;
    float lg[8], lb[8], muv[8];
#pragma unroll
    for (int e = 0; e < 8; ++e) { const int c = lane * 8 + e; lg[e] = p.in[I_LNG][c]; lb[e] = p.in[I_LNB][c]; muv[e] = p.in[I_MU][1024 + c]; }
    for (int m = gw; m < R; m += NGW) {
        const int b = m / TP, pp = m - b * TP;
        v4u* yp = (v4u*)(ws + WS_Y + (size_t)m * 1024) + lane;
        if (pp < 48) { *yp = (v4u){0u, 0u, 0u, 0u}; continue; }
        float y[8], v[8], vp[8], g[8];
        unpack8(*yp, y); unpack8(*((const v4u*)(ws + WS_ZRV + (size_t)m * 1024) + lane), v); unpack8(*((const v4u*)(ws + WS_ZRV + (size_t)(m - 1) * 1024) + lane), vp);
        unpack8(*((const v4u*)(dob + DO_GG + (size_t)m * 1024) + lane), g);
        float s = 0.f;
#pragma unroll
        for (int e = 0; e < 8; ++e) s += y[e];
        const float mean = sum8(s) * (1.f / 64.f); float q = 0.f;
#pragma unroll
        for (int e = 0; e < 8; ++e) { y[e] -= mean; q += y[e] * y[e]; }
        const float rstd = 1.0f / sqrtf(sum8(q) * (1.f / 64.f) + GN_EPS);
        const float bon = ((const float*)(ws + WS_BS))[(size_t)m * 8 + (lane >> 3)];
#pragma unroll
        for (int e = 0; e < 8; ++e) { const float vs = v[e] + muv[e] * (vp[e] - v[e]); y[e] = (y[e] * rstd * lg[e] + lb[e] + bon * vs) * g[e]; }
        *yp = pack8(y);
    }
}
template <int NR>
__device__ __forceinline__ void norm2_rows(const Params& p, int m0, int mstride, int lane) {
    unsigned char* ws = p.ws;
    const f32x4* g4 = (const f32x4*)p.in[I_N2G] + 4 * lane;
    f32x4 v[NR][4]; float s[NR], mx[NR];
#pragma unroll
    for (int r = 0; r < NR; ++r) { const v4u* xr = (const v4u*)(ws + WS_H1 + (size_t)(m0 + r * mstride) * 2048) + 2 * lane;
        const v4u a = xr[0], b = xr[1]; float f[8];
        unpack8(a, f); v[r][0] = (f32x4){f[0], f[1], f[2], f[3]}; v[r][1] = (f32x4){f[4], f[5], f[6], f[7]};
        unpack8(b, f); v[r][2] = (f32x4){f[0], f[1], f[2], f[3]}; v[r][3] = (f32x4){f[4], f[5], f[6], f[7]}; }
#pragma unroll
    for (int r = 0; r < NR; ++r) { s[r] = 0.f;
#pragma unroll
        for (int j = 0; j < 4; ++j) s[r] += (v[r][j].x * v[r][j].x + v[r][j].y * v[r][j].y) + (v[r][j].z * v[r][j].z + v[r][j].w * v[r][j].w); }
#pragma unroll
    for (int o = 1; o < 64; o <<= 1)
#pragma unroll
        for (int r = 0; r < NR; ++r) s[r] += __shfl_xor(s[r], o);
#pragma unroll
    for (int r = 0; r < NR; ++r) { const float rs = 1.0f / sqrtf(s[r] * (1.f / 1024.f) + NORM_EPS); mx[r] = 0.f;
#pragma unroll
        for (int j = 0; j < 4; ++j) { const f32x4 g = g4[j]; v[r][j].x *= rs * g.x; v[r][j].y *= rs * g.y; v[r][j].z *= rs * g.z; v[r][j].w *= rs * g.w;
#ifdef PQ_BF16
            ((unsigned long long*)(ws + WS_XN2 + (size_t)(m0 + r * mstride) * 2048) + 4 * lane)[j] = (unsigned long long)pk2(v[r][j].x, v[r][j].y) | ((unsigned long long)pk2(v[r][j].z, v[r][j].w) << 32);
#endif
            mx[r] = fmaxf(mx[r], fmaxf(fmaxf(fabsf(v[r][j].x), fabsf(v[r][j].y)), fmaxf(fabsf(v[r][j].z), fabsf(v[r][j].w)))); } }
#pragma unroll
    for (int o = 1; o < 64; o <<= 1)
#pragma unroll
        for (int r = 0; r < NR; ++r) mx[r] = fmaxf(mx[r], __shfl_xor(mx[r], o));
#pragma unroll
    for (int r = 0; r < NR; ++r) { const int m = m0 + r * mstride; const float inv = mx[r] > 0.f ? 127.0f / mx[r] : 0.f;
        unsigned* xq = (unsigned*)(ws + WS_XQ + (size_t)m * 1024) + 4 * lane;
#pragma unroll
        for (int j = 0; j < 4; ++j) { const int q0 = (int)rintf(v[r][j].x * inv), q1 = (int)rintf(v[r][j].y * inv), q2 = (int)rintf(v[r][j].z * inv), q3 = (int)rintf(v[r][j].w * inv);
            xq[j] = (unsigned)(q0 & 255) | ((unsigned)(q1 & 255) << 8) | ((unsigned)(q2 & 255) << 16) | ((unsigned)(q3 & 255) << 24); }
        if (lane == 0) ((float*)(ws + WS_SX))[m] = mx[r] > 0.f ? mx[r] * (1.0f / 127.0f) : 1.0f; }
}
__device__ __forceinline__ void p9_norm2(const Params& p, int vcu, int G, int wave, int lane) {
    const int gw = vcu * NWAVES + wave, NGW = G * NWAVES;
    for (int m = gw; m < NTOK; m += 4 * NGW) norm2_rows<4>(p, m, NGW, lane);
}

typedef __bf16 bf16x2_t __attribute__((ext_vector_type(2)));
__device__ __forceinline__ unsigned mono(float f) { const unsigned u = __builtin_bit_cast(unsigned, f); return u ^ ((unsigned)((int)u >> 31) | 0x80000000u); }
__device__ __forceinline__ float unmono(unsigned m) { const unsigned u = (m & 0x80000000u) ? (m ^ 0x80000000u) : ~m; return __builtin_bit_cast(float, u); }
__device__ __forceinline__ void ce_desc(unsigned& a, unsigned& b) { const unsigned hi = a > b ? a : b, lo = a > b ? b : a; a = hi; b = lo; }
template <int BASE, int N> __device__ __forceinline__ void bitonic_sort_desc(unsigned (&v)[N]) {
#pragma unroll
    for (int k = 2; k <= 16; k <<= 1)
#pragma unroll
        for (int j = k >> 1; j > 0; j >>= 1)
#pragma unroll
            for (int i = 0; i < 16; ++i) { const int l = i ^ j; if (l > i) { if ((i & k) == 0) ce_desc(v[BASE + i], v[BASE + l]); else ce_desc(v[BASE + l], v[BASE + i]); } }
}
template <int A, int B, int N> __device__ __forceinline__ void merge_top16(unsigned (&v)[N]) {
#pragma unroll
    for (int i = 0; i < 16; ++i) { const unsigned x = v[A + i], y = v[B + 15 - i]; v[A + i] = x > y ? x : y; }
#pragma unroll
    for (int j = 8; j > 0; j >>= 1)
#pragma unroll
        for (int i = 0; i < 16; ++i) { const int l = i ^ j; if (l > i) ce_desc(v[A + i], v[A + l]); }
}
constexpr int KS_STRIDE = 272;
constexpr int RT_KS_BYTES = 256 * KS_STRIDE;
constexpr int RT_TAB_WORDS = 33;
__device__ __forceinline__ void p11_route(const Params& p, LAS unsigned char* lds, int vcu, int G, int tid, int wave, int lane) {
    unsigned char* ws = p.ws;
    for (int i = tid; i < 256 * 16; i += NTHREADS) { const int row = i >> 4, ch = i & 15; *(LAS v4u*)(lds + row * KS_STRIDE + ch * 16) = *((const v4u*)(ws + WS_KS) + i); }
    __syncthreads();
    LAS unsigned* tab = (LAS unsigned*)(lds + RT_KS_BYTES) + (wave * 64 + lane) * RT_TAB_WORDS;
    const int r32 = lane & 31, hi = lane >> 5;
    const int gw = vcu * NWAVES + wave, NGW = G * NWAVES;
    const bf16* PQ = (const bf16*)(ws + WS_PQ);
    int* IDS = (int*)(ws + WS_IDS); float* GATES = (float*)(ws + WS_GATES);
    for (int task = gw; task < (NTOK / 32) * 8; task += NGW) {
        const int tb = task >> 3, h = task & 7;
        const int token = tb * 32 + r32;
        unsigned v[128];
        {
            const bf16* qrow = PQ + (size_t)token * 2048 + h * 256 + hi * 8;
#pragma unroll
            for (int t = 0; t < 4; ++t) {
                f32x16v acc[2];
#pragma unroll
                for (int w = 0; w < 2; ++w) {
                    f32x16v c = {};
                    const LAS unsigned char* kb = lds + (w * 128 + t * 32 + r32) * KS_STRIDE + hi * 16;
#pragma unroll
                    for (int s = 0; s < 8; ++s) { const bf16x8 a = *(const LAS bf16x8*)(kb + s * 32); const bf16x8 qf = *(const bf16x8*)(qrow + w * 128 + 16 * s); c = __builtin_amdgcn_mfma_f32_32x32x16_bf16(a, qf, c, 0, 0, 0); }
                    acc[w] = c;
                }
#pragma unroll
                for (int r = 0; r < 16; ++r) {
                    const float xa = acc[0][r], xb = acc[1][r];
                    auto rr = __builtin_amdgcn_permlane32_swap(__float_as_uint(xa), __float_as_uint(xb), false, false);
                    const unsigned r0 = rr[0], r1 = rr[1];
                    const int cr = (r & 3) + 8 * (r >> 2);
                    v[t * 16 + r] = (mono(__uint_as_float(r0)) & ~0x7Fu) | (unsigned)(32 * t + cr);
                    v[64 + t * 16 + r] = (mono(__uint_as_float(r1)) & ~0x7Fu) | (unsigned)(32 * t + cr + 4);
                }
            }
        }
        bitonic_sort_desc<0>(v); bitonic_sort_desc<16>(v); bitonic_sort_desc<32>(v); bitonic_sort_desc<48>(v);
        bitonic_sort_desc<64>(v); bitonic_sort_desc<80>(v); bitonic_sort_desc<96>(v); bitonic_sort_desc<112>(v);
        merge_top16<0, 16>(v); merge_top16<32, 48>(v); merge_top16<64, 80>(v); merge_top16<96, 112>(v);
        merge_top16<0, 32>(v); merge_top16<64, 96>(v);
        merge_top16<0, 64>(v);
        unsigned T[16], U[16];
#pragma unroll
        for (int i = 0; i < 16; ++i) { auto rr = __builtin_amdgcn_permlane32_swap(v[i], v[i], false, false); T[i] = v[i]; U[i] = hi ? rr[0] : rr[1]; }
        { const int bT = hi ? 16 : 0, bU = hi ? 0 : 16;
#pragma unroll
          for (int i = 0; i < 16; ++i) { tab[bT + i] = T[i] & 0x7Fu; tab[bU + i] = U[i] & 0x7Fu; } }
        float tv[16], uv[16];
#pragma unroll
        for (int i = 0; i < 16; ++i) { tv[i] = unmono(T[i] & ~0x7Fu); uv[i] = unmono(U[i] & ~0x7Fu); }
        unsigned c[32];
        {
            int n = 0;
#pragma unroll
            for (int i = 0; i < 4; ++i)
#pragma unroll
                for (int j = i; j < 16; ++j) if ((i + 1) * (j + 1) <= 16) {
                    const float s = tv[i] + uv[j];
                    const unsigned pay = hi ? (unsigned)((j << 4) | i) : (unsigned)((i << 4) | j);
                    unsigned key = (mono(s) & ~0xFFu) | pay;
                    if (i == j && hi) key = 0u;
                    c[n++] = key;
                }
#pragma unroll
            for (int k = 27; k < 32; ++k) c[k] = 0u;
        }
        bitonic_sort_desc<0>(c); bitonic_sort_desc<16>(c); merge_top16<0, 16>(c);
        unsigned W[32];
#pragma unroll
        for (int i = 0; i < 16; ++i) { auto rr = __builtin_amdgcn_permlane32_swap(c[i], c[i], false, false); W[i] = rr[0]; W[16 + i] = rr[1]; }
        merge_top16<0, 16>(W);
        asm volatile("s_waitcnt lgkmcnt(0)" ::: "memory");
        if (!hi) {
            int ids[16];
#pragma unroll
            for (int k = 0; k < 16; ++k) ids[k] = (int)(tab[(W[k] >> 4) & 15u] * 128u + tab[16 + (W[k] & 15u)]);
            int* o = IDS + (size_t)token * 128 + h * 16;
#pragma unroll
            for (int k = 0; k < 16; k += 4) *(v4u*)(o + k) = (v4u){(unsigned)ids[k], (unsigned)ids[k + 1], (unsigned)ids[k + 2], (unsigned)ids[k + 3]};
        } else {
            float e[16]; const float s0 = unmono(W[0] & ~0xFFu); float sum = 0.f;
#pragma unroll
            for (int k = 0; k < 16; ++k) { e[k] = __expf(unmono(W[k] & ~0xFFu) - s0); sum += e[k]; }
            const float inv = 1.0f / sum;
            float* o = GATES + (size_t)token * 128 + h * 16;
#pragma unroll
            for (int k = 0; k < 16; k += 4) *(f32x4*)(o + k) = (f32x4){e[k] * inv, e[k + 1] * inv, e[k + 2] * inv, e[k + 3] * inv};
        }
        asm volatile("s_waitcnt lgkmcnt(0)" ::: "memory");
    }
}

constexpr size_t WS_PART = 420 * MiB;
__device__ __forceinline__ int dpp_isum8(int x) {
    x += __builtin_amdgcn_update_dpp(0, x, 0xB1, 0xF, 0xF, true);
    x += __builtin_amdgcn_update_dpp(0, x, 0x4E, 0xF, 0xF, true);
    x += __builtin_amdgcn_update_dpp(0, x, 0x141, 0xF, 0xF, true);
    return x;
}
__device__ __forceinline__ void p12a_partial(const Params& p, int bid, int G, int wave, int lane) {
    unsigned char* ws = p.ws;
    const int s = bid & 7, wx = (bid >> 3) * NWAVES + wave, NWX = (G >> 3) * NWAVES;
    const int eg = lane >> 3, cj = lane & 7;
    const unsigned char* XQ = ws + WS_XQ + 128 * s + 16 * cj; const int* IDS = (const int*)(ws + WS_IDS); int* PART = (int*)(ws + WS_PART);
    const unsigned char* Us = ws + WS_U8 + 128 * s + 16 * cj;
    for (int t = wx; t < NTOK; t += NWX) {
        const v4u xs = *(const v4u*)(XQ + (size_t)t * 1024);
        const int xx = (int)xs.x, xy = (int)xs.y, xz = (int)xs.z, xw = (int)xs.w;
        const v4u* idp = (const v4u*)(IDS + (size_t)t * 128 + 16 * eg);
        int ids[16];
#pragma unroll
        for (int q = 0; q < 4; ++q) { const v4u iv = idp[q]; ids[4 * q] = (int)iv.x; ids[4 * q + 1] = (int)iv.y; ids[4 * q + 2] = (int)iv.z; ids[4 * q + 3] = (int)iv.w; }
        v4u u[16];
#pragma unroll
        for (int i = 0; i < 16; ++i) u[i] = *(const v4u*)(Us + (size_t)ids[i] * 1024);
        int k0 = 0, k1 = 0;
#pragma unroll
        for (int i = 0; i < 16; ++i) {
            const int ux = (int)u[i].x, uy = (int)u[i].y, uz = (int)u[i].z, uw = (int)u[i].w;
            int d = __builtin_amdgcn_sdot4(ux, xx, 0, false); d = __builtin_amdgcn_sdot4(uy, xy, d, false); d = __builtin_amdgcn_sdot4(uz, xz, d, false); d = __builtin_amdgcn_sdot4(uw, xw, d, false);
            d = dpp_isum8(d);
            if (i < 8) k0 = (cj == i) ? d : k0; else k1 = (cj == i - 8) ? d : k1;
        }
        int* po = PART + ((size_t)s * NTOK + t) * 128 + 16 * eg + cj;
        __builtin_nontemporal_store(k0, po); __builtin_nontemporal_store(k1, po + 8);
    }
}
constexpr size_t WS_WQ = 84 * MiB;
constexpr size_t WS_WSC = 92 * MiB;
__device__ __forceinline__ float dpp_max16(float x) {
    x = fmaxf(x, __builtin_bit_cast(float, __builtin_amdgcn_update_dpp(0, __builtin_bit_cast(int, x), 0xB1, 0xF, 0xF, true)));
    x = fmaxf(x, __builtin_bit_cast(float, __builtin_amdgcn_update_dpp(0, __builtin_bit_cast(int, x), 0x4E, 0xF, 0xF, true)));
    x = fmaxf(x, __builtin_bit_cast(float, __builtin_amdgcn_update_dpp(0, __builtin_bit_cast(int, x), 0x141, 0xF, 0xF, true)));
    x = fmaxf(x, __builtin_bit_cast(float, __builtin_amdgcn_update_dpp(0, __builtin_bit_cast(int, x), 0x140, 0xF, 0xF, true)));
    return x;
}
__device__ __forceinline__ void p12b_combine(const Params& p, int vcu, int G, int wave, int lane) {
    unsigned char* ws = p.ws;
    const int gw = vcu * NWAVES + wave, NGW = G * NWAVES;
    const int* PART = (const int*)(ws + WS_PART); const float* GW = (const float*)(ws + WS_GATES); const int* IDS = (const int*)(ws + WS_IDS);
    const float* SU = (const float*)(ws + WS_SU); const float* SV = (const float*)(ws + WS_SV);
    for (int t = gw; t < NTOK; t += NGW) {
        int a0 = 0, a1 = 0;
#pragma unroll
        for (int s = 0; s < 8; ++s) { const int* pp = PART + ((size_t)s * NTOK + t) * 128; a0 += __builtin_nontemporal_load(pp + lane); a1 += __builtin_nontemporal_load(pp + lane + 64); }
        const int id0 = IDS[(size_t)t * 128 + lane], id1 = IDS[(size_t)t * 128 + lane + 64];
        const float sx = ((const float*)(ws + WS_SX))[t];
        const float h0 = (float)a0 * SU[id0] * sx, h1 = (float)a1 * SU[id1] * sx;
        const float* g = GW + (size_t)t * 128;
        const float w0 = g[lane] * 0.5f * h0 * (1.0f + erff(h0 * 0.70710678118654752f)) * SV[id0];
        const float w1 = g[lane + 64] * 0.5f * h1 * (1.0f + erff(h1 * 0.70710678118654752f)) * SV[id1];
        const float m0 = dpp_max16(fabsf(w0)), m1 = dpp_max16(fabsf(w1));
        const float i0 = m0 > 0.f ? 127.0f / m0 : 0.f, i1 = m1 > 0.f ? 127.0f / m1 : 0.f;
        signed char* wq = (signed char*)(ws + WS_WQ) + (size_t)t * 128;
        wq[lane] = (signed char)(int)rintf(w0 * i0); wq[lane + 64] = (signed char)(int)rintf(w1 * i1);
        if ((lane & 15) == 0) { float* sc = (float*)(ws + WS_WSC) + (size_t)t * 8; sc[lane >> 4] = m0 * (1.0f / 127.0f); sc[4 + (lane >> 4)] = m1 * (1.0f / 127.0f); }
    }
}
template <bool DRY> __device__ __forceinline__ void p12c_output(const Params& p, int bid, int G, int wave, int lane) {
    unsigned char* ws = p.ws;
    const int s = bid & 7, wx = (bid >> 3) * NWAVES + wave, NWX = (G >> 3) * NWAVES;
    const int eg = lane >> 3, cj = lane & 7;
    const int b5 = (lane >> 5) & 1, b4 = (lane >> 4) & 1, b3 = (lane >> 3) & 1;
    const int* IDS = (const int*)(ws + WS_IDS); const unsigned char* WQ = ws + WS_WQ; const float* WSC = (const float*)(ws + WS_WSC);
    const unsigned char* Vs = ws + WS_V8 + 128 * s + 16 * cj;
    const int ocol = 128 * s + 16 * cj + 8 * b5 + 4 * b4 + 2 * b3;
    typedef float f32x2 __attribute__((ext_vector_type(2)));
    for (int t = wx; t < NTOK; t += NWX) {
        const v4u* idp = (const v4u*)(IDS + (size_t)t * 128 + 16 * eg);
        int ids[16];
#pragma unroll
        for (int q = 0; q < 4; ++q) { const v4u iv = idp[q]; ids[4 * q] = (int)iv.x; ids[4 * q + 1] = (int)iv.y; ids[4 * q + 2] = (int)iv.z; ids[4 * q + 3] = (int)iv.w; }
        const v4u wqv = *(const v4u*)(WQ + (size_t)t * 128 + 16 * eg);
        const float wsc = WSC[(size_t)t * 8 + eg];
        const unsigned hb = __builtin_nontemporal_load((const unsigned*)((const bf16*)(ws + WS_H1) + (size_t)t * 1024 + ocol));
        const f32x2 hres = {bflo(hb), bfhi(hb)};
        v4u vv[16];
#pragma unroll
        for (int i = 0; i < 16; ++i) vv[i] = *(const v4u*)(Vs + (size_t)ids[i] * 1024);
        int acc[16];
#pragma unroll
        for (int k = 0; k < 16; ++k) acc[k] = 0;
        const unsigned wqd[4] = {wqv.x, wqv.y, wqv.z, wqv.w};
#pragma unroll
        for (int j = 0; j < 4; ++j) {
            const unsigned r0[4] = {vv[4 * j].x, vv[4 * j].y, vv[4 * j].z, vv[4 * j].w}, r1[4] = {vv[4 * j + 1].x, vv[4 * j + 1].y, vv[4 * j + 1].z, vv[4 * j + 1].w};
            const unsigned r2[4] = {vv[4 * j + 2].x, vv[4 * j + 2].y, vv[4 * j + 2].z, vv[4 * j + 2].w}, r3[4] = {vv[4 * j + 3].x, vv[4 * j + 3].y, vv[4 * j + 3].z, vv[4 * j + 3].w};
#pragma unroll
            for (int d = 0; d < 4; ++d) {
                const unsigned l01 = __builtin_amdgcn_perm(r1[d], r0[d], 0x05010400u), h01 = __builtin_amdgcn_perm(r1[d], r0[d], 0x07030602u);
                const unsigned l23 = __builtin_amdgcn_perm(r3[d], r2[d], 0x05010400u), h23 = __builtin_amdgcn_perm(r3[d], r2[d], 0x07030602u);
                const unsigned c0 = __builtin_amdgcn_perm(l23, l01, 0x05040100u), c1 = __builtin_amdgcn_perm(l23, l01, 0x07060302u);
                const unsigned c2 = __builtin_amdgcn_perm(h23, h01, 0x05040100u), c3 = __builtin_amdgcn_perm(h23, h01, 0x07060302u);
                acc[4 * d + 0] = __builtin_amdgcn_sdot4((int)c0, (int)wqd[j], acc[4 * d + 0], false); acc[4 * d + 1] = __builtin_amdgcn_sdot4((int)c1, (int)wqd[j], acc[4 * d + 1], false);
                acc[4 * d + 2] = __builtin_amdgcn_sdot4((int)c2, (int)wqd[j], acc[4 * d + 2], false); acc[4 * d + 3] = __builtin_amdgcn_sdot4((int)c3, (int)wqd[j], acc[4 * d + 3], false);
            }
        }
        float o[16];
#pragma unroll
        for (int k = 0; k < 16; ++k) o[k] = (float)acc[k] * wsc;
        float r8[8], r4[4], r2v[2];
#pragma unroll
        for (int j = 0; j < 8; ++j) { const float keep = b5 ? o[8 + j] : o[j], send = b5 ? o[j] : o[8 + j]; r8[j] = keep + __shfl_xor(send, 32); }
#pragma unroll
        for (int j = 0; j < 4; ++j) { const float keep = b4 ? r8[4 + j] : r8[j], send = b4 ? r8[j] : r8[4 + j]; r4[j] = keep + __shfl_xor(send, 16); }
#pragma unroll
        for (int j = 0; j < 2; ++j) { const float keep = b3 ? r4[2 + j] : r4[j], send = b3 ? r4[j] : r4[2 + j]; r2v[j] = keep + __shfl_xor(send, 8); }
        const f32x2 res = {hres.x + r2v[0], hres.y + r2v[1]};
        __builtin_nontemporal_store(res, (f32x2*)((DRY ? (float*)(ws + WS_PART) : p.out) + (size_t)t * 1024 + ocol));
    }
}

#if DIAG
constexpr size_t WS_DIAG = 1006 * MiB;
constexpr size_t WS_DSAVE = 1007 * MiB;
__device__ __forceinline__ unsigned dhash(unsigned x) { x ^= x >> 16; x *= 0x7feb352dU; x ^= x >> 15; x *= 0x846ca68bU; x ^= x >> 16; return x; }
__device__ __forceinline__ float bf2f(bf16 b) { return __builtin_bit_cast(float, (unsigned)b << 16); }
__device__ __forceinline__ float rbf(float x) { return bf2f((bf16)f2bf(x)); }
__device__ __forceinline__ void diag_report(const Params& p, int stage, float err) {
    if (!(err == err)) err = 1e30f;
#pragma unroll
    for (int o = 1; o < 64; o <<= 1) err = fmaxf(err, __shfl_xor(err, o));
    int t_ = threadIdx.x; asm volatile("" : "+v"(t_)); if ((t_ & 63) == 0) atomicMax((unsigned*)(p.ws + WS_DIAG) + stage, __builtin_bit_cast(unsigned, err));
}
#define DG_IDS() int tid_ = threadIdx.x; asm volatile("" : "+v"(tid_)); const int tid = tid_, lane = tid & 63; int G_ = gridDim.x; asm volatile("" : "+s"(G_)); const int gt = blockIdx.x * NTHREADS + tid, NGT = G_ * NTHREADS; const int gwv = gt >> 6, NGWV = NGT >> 6; (void)lane; (void)gwv; (void)NGWV; (void)NGT
__device__ __forceinline__ float relerr(float got, float ref, float fl) { return fabsf(got - ref) / (fabsf(ref) + fl); }

__device__ __forceinline__ void dg_p0(const Params& p) {
    DG_IDS(); unsigned char* ws = p.ws; float e1 = 0.f, e2 = 0.f;
    for (int s = gwv; s < 4096; s += NGWV) {
        const int m = dhash(s * 7 + 1) % R; const int b = m / TP, pp = m - b * TP;
        const bf16* xn = (const bf16*)(ws + WS_XN) + (size_t)m * 1024;
        if (pp < 48) { for (int c = lane; c < 1024; c += 64) e1 = fmaxf(e1, fabsf(bf2f(xn[c]))); continue; }
        const float* xr = (pp < 64) ? p.in[I_META] + (size_t)(pp - 48) * 1024 : p.in[I_X] + ((size_t)b * SEQ + (pp - 64)) * 1024;
        float ss = 0.f; for (int c = lane; c < 1024; c += 64) ss += xr[c] * xr[c];
        ss = wave_sum(ss); const float rs = 1.0f / sqrtf(ss / 1024.f + NORM_EPS);
        for (int c = lane; c < 1024; c += 64) e1 = fmaxf(e1, relerr(bf2f(xn[c]), xr[c] * rs * p.in[I_N1G][c], 0.05f));
    }
    for (int s = gt; s < 200000; s += NGT) {
        const unsigned hsh = dhash(s * 3 + 5); const int k = hsh & 1023, n = (hsh >> 10) % N1; const int sc = win_src_col(n);
        const float ref = sc >= 0 ? p.in[I_WIN][(size_t)k * IN_COLS + sc] : 0.f;
        e2 = fmaxf(e2, fabsf(bf2f(((const bf16*)(ws + WS_WTIN))[(size_t)n * 1024 + k]) - rbf(ref)));
        const int n2 = (hsh >> 10) & 2047;
        e2 = fmaxf(e2, fabsf(bf2f(((const bf16*)(ws + WS_WTQ))[(size_t)n2 * 1024 + k]) - rbf(p.in[I_PWQ][(size_t)k * 2048 + n2])));
        const int n3 = n2 & 1023, k3 = k & 511;
        e2 = fmaxf(e2, fabsf(bf2f(((const bf16*)(ws + WS_WTFOX))[(size_t)n3 * 512 + k3]) - rbf(p.in[I_WFOX][(size_t)k3 * 1024 + n3])));
        e2 = fmaxf(e2, fabsf(bf2f(((const bf16*)(ws + WS_WTRWKV))[(size_t)n3 * 512 + k3]) - rbf(p.in[I_WRWKV][(size_t)k3 * 1024 + n3])));
        e2 = fmaxf(e2, fabsf(bf2f(((const bf16*)(ws + WS_WTOUT))[(size_t)n3 * 1024 + k]) - rbf(p.in[I_WOUT][(size_t)k * 1024 + n3])));
        const size_t ei = (size_t)(hsh % (16384u * 1024u)); const int er = (int)(ei >> 10);
        { const float sc = ((const float*)(ws + WS_SU))[er]; const float dq = (float)((const signed char*)(ws + WS_U8))[ei] * sc; e2 = fmaxf(e2, fmaxf(fabsf(dq - p.in[I_PU][ei]) - 0.51f * sc, 0.f)); }
        { const float sc = ((const float*)(ws + WS_SV))[er]; const float dq = ((float)((const unsigned char*)(ws + WS_V8))[ei] - 128.f) * sc; e2 = fmaxf(e2, fmaxf(fabsf(dq - p.in[I_PV][ei]) - 0.51f * sc, 0.f)); }
    }
    diag_report(p, 1, e1 / 0.03f); diag_report(p, 2, e2 / 1e-6f);
}
__device__ __forceinline__ float dg_dot(const bf16* A, size_t row, const bf16* Bt, size_t n, int K) {
    const bf16* a = A + row * K; const bf16* b = Bt + n * K; float s = 0.f;
    for (int k = 0; k < K; k += 8) { float x[8], y[8]; unpack8(*(const v4u*)(a + k), x); unpack8(*(const v4u*)(b + k), y);
#pragma unroll
        for (int e = 0; e < 8; ++e) s = fmaf(x[e], y[e], s); }
    return s;
}
__device__ __forceinline__ void dg_gemm1(const Params& p) {
    DG_IDS(); unsigned char* ws = p.ws; float e = 0.f;
    for (int s = gt; s < 262144; s += NGT) {
        const unsigned hsh = dhash(s * 11 + 3); const int row = hsh % R, n = dhash(hsh) % N1;
        const float ref = dg_dot((const bf16*)(ws + WS_XN), row, (const bf16*)(ws + WS_WTIN), n, 1024);
        float got, want;
        if (n < 3584) { got = bf2f(((const bf16*)(ws + WS_F))[(size_t)(n >> 9) * ((size_t)R * 512) + (size_t)row * 512 + (n & 511)]); want = ref; }
        else { got = bf2f(((const bf16*)(ws + WS_ZG))[(size_t)row * 2048 + (n - 3584)]); want = 1.0f / (1.0f + expf(-ref)); }
        e = fmaxf(e, relerr(got, want, 0.25f));
    }
    diag_report(p, 3, e / 0.02f);
}
__device__ __forceinline__ void dg_p2(const Params& p) {
    DG_IDS(); unsigned char* ws = p.ws; float e = 0.f;
    for (int s = gt; s < 262144; s += NGT) {
        const unsigned hsh = dhash(s * 13 + 7); const int m = hsh % R, c = dhash(hsh) % 296; const int pp = m % TP;
        const bf16* zm = (const bf16*)(ws + WS_ZM);
        const float z = bf2f(zm[(size_t)m * 512 + c]);
        if (c >= 288) { const float x = z + p.in[I_FBIAS][c - 288]; const float want = -log1pf(expf(-x)); e = fmaxf(e, relerr(((const float*)(ws + WS_LF))[(size_t)m * 8 + (c - 288)], want, 0.01f)); continue; }
        const float zp = pp > 0 ? bf2f(zm[(size_t)(m - 1) * 512 + c]) : 0.f; const float mu = p.in[I_MU][1536 + c];
        const float zs = z + mu * (zp - z);
        if (c < 64) e = fmaxf(e, relerr(bf2f(((const bf16*)(ws + WS_LA))[(size_t)m * 128 + c]), tanhf(zs), 0.1f));
        else if (c < 128) e = fmaxf(e, relerr(bf2f(((const bf16*)(ws + WS_LA))[(size_t)m * 128 + c]), zs, 0.1f));
        else e = fmaxf(e, relerr(bf2f(((const bf16*)(ws + WS_LG))[(size_t)m * 256 + (c - 128)]), 1.0f / (1.0f + expf(-zs)), 0.1f));
        if (pp >= 48) { const int h = c & 7; float sq = 0.f, sk = 0.f;
            for (int d = 0; d < 64; ++d) { const float q = bf2f(((const bf16*)(ws + WS_FQ))[(size_t)m * 512 + h * 64 + d]) / (p.in[I_FQN][h * 64 + d] * attn_body::C2); sq += q * q;
                const float k = bf2f(((const bf16*)(ws + WS_FK))[(size_t)m * 512 + h * 64 + d]) / p.in[I_FKN][h * 64 + d]; sk += k * k; }
            e = fmaxf(e, fabsf(sq / 64.f - 1.f)); e = fmaxf(e, fabsf(sk / 64.f - 1.f)); }
    }
    diag_report(p, 4, e / 0.03f);
}
__device__ __forceinline__ void dg_p3(const Params& p) {
    DG_IDS(); unsigned char* ws = p.ws; unsigned char* dob = (unsigned char*)p.out; float e5 = 0.f, e6 = 0.f;
    for (int s = gt; s < 131072; s += NGT) {
        const unsigned hsh = dhash(s * 17 + 9); const int seq = hsh & 127, pp = (hsh >> 7) % TP; const int b = seq >> 3, h = seq & 7;
        const float* kb = (const float*)(ws + WS_KB) + (size_t)seq * TP; const float lf = ((const float*)(ws + WS_LF))[((size_t)b * TP + pp) * 8 + h];
        if (pp < 48) e5 = fmaxf(e5, kb[pp] < -1e29f ? 0.f : 1.f);
        else if (pp == 48) e5 = fmaxf(e5, fabsf(kb[pp] + lf * LOG2E));
        else e5 = fmaxf(e5, fabsf((kb[pp] - kb[pp - 1]) + lf * LOG2E));
        const int m = dhash(hsh) % R, c = dhash(hsh + 1) % 1536;
        const bf16* la = (const bf16*)(ws + WS_LA) + (size_t)m * 128; const bf16* lg = (const bf16*)(ws + WS_LG) + (size_t)m * 256;
        if (c < 512) { float a = p.in[I_W0][c]; for (int k = 0; k < 64; ++k) a += bf2f(la[k]) * rbf(p.in[I_WUP][k * 512 + c]);
            const float w = -log1pf(expf(-a)) - 0.5f; const float want = 1.0f - expf(-expf(w));
            e6 = fmaxf(e6, relerr(bf2f(((const bf16*)(dob + DO_XW))[(size_t)m * 512 + c]), want, 0.002f)); }
        else if (c < 1024) { float a = p.in[I_A0][c - 512]; for (int k = 0; k < 64; ++k) a += bf2f(la[64 + k]) * rbf(p.in[I_AUP][k * 512 + (c - 512)]);
            e6 = fmaxf(e6, relerr(bf2f(((const bf16*)(dob + DO_AA))[(size_t)m * 512 + (c - 512)]), 1.0f / (1.0f + expf(-a)), 0.05f)); }
        else { float a = 0.f; for (int k = 0; k < 160; ++k) a += bf2f(lg[k]) * rbf(p.in[I_GUP][k * 512 + (c - 1024)]);
            e6 = fmaxf(e6, relerr(bf2f(((const bf16*)(dob + DO_GG))[(size_t)m * 512 + (c - 1024)]), a, 0.1f)); }
    }
    diag_report(p, 5, e5 / 1e-3f); diag_report(p, 6, e6 / 0.03f);
}
constexpr int DG_NS4 = 2048;
__device__ __forceinline__ void dg_p4_pre(const Params& p) {
    DG_IDS(); unsigned char* dob = (unsigned char*)p.out; float* sv = (float*)(p.ws + WS_DSAVE);
    for (int s = gt; s < DG_NS4 * 64; s += NGT) { const int i = s >> 6, d = s & 63; const unsigned hsh = dhash(i * 19 + 11); const int m = hsh % R, h = (hsh >> 20) & 7;
        sv[s] = bf2f(((const bf16*)(dob + DO_AA))[(size_t)m * 512 + h * 64 + d]); }
}
__device__ __forceinline__ void dg_p4_post(const Params& p) {
    DG_IDS(); unsigned char* ws = p.ws; unsigned char* dob = (unsigned char*)p.out; const float* sv = (const float*)(ws + WS_DSAVE); float e = 0.f;
    for (int i = gwv; i < DG_NS4; i += NGWV) {
        const unsigned hsh = dhash(i * 19 + 11); const int m = hsh % R, h = (hsh >> 20) & 7; const int pp = m % TP; const int c = h * 64 + lane;
        const float a = sv[i * 64 + lane];
        const float r0 = bf2f(((const bf16*)(ws + WS_ZRR))[(size_t)m * 512 + c]), k0 = bf2f(((const bf16*)(ws + WS_ZRK))[(size_t)m * 512 + c]);
        const float r1 = pp > 0 ? bf2f(((const bf16*)(ws + WS_ZRR))[(size_t)(m - 1) * 512 + c]) : 0.f, k1 = pp > 0 ? bf2f(((const bf16*)(ws + WS_ZRK))[(size_t)(m - 1) * 512 + c]) : 0.f;
        const float rs = r0 + p.in[I_MU][c] * (r1 - r0), ks = k0 + p.in[I_MU][512 + c] * (k1 - k0);
        const float kk = ks * p.in[I_KK][c], kp = ks * (1.0f + (a - 1.0f) * p.in[I_KA][c]);
        const float nrm = fmaxf(sqrtf(wave_sum(kk * kk)), 1e-12f); const float kn = kk / nrm, bb = kn * a; const float bs = wave_sum(rs * kp * p.in[I_RK][c]);
        e = fmaxf(e, relerr(bf2f(((const bf16*)(ws + WS_KP))[(size_t)m * 512 + c]), kp, 0.1f));
        e = fmaxf(e, relerr(bf2f(((const bf16*)(ws + WS_KN))[(size_t)m * 512 + c]), kn, 0.02f));
        e = fmaxf(e, relerr(bf2f(((const bf16*)(dob + DO_AA))[(size_t)m * 512 + c]), bb, 0.02f));
        e = fmaxf(e, relerr(((const float*)(ws + WS_BS))[(size_t)m * 8 + h], bs, 0.1f));
    }
    diag_report(p, 7, e / 0.03f);
}
constexpr int DG_NS8 = 1024;
__device__ __forceinline__ void dg_attn_sample(int i, int& b, int& h, int& t) { const unsigned hsh = dhash(i * 23 + 13); b = hsh & 15; h = (hsh >> 4) & 7; t = (hsh >> 8) & 4095; if (i < 8) t = (i & 1) ? 4095 - (i >> 1) : (i >> 1); }
__device__ __forceinline__ void dg_attn_pre(const Params& p) {
    DG_IDS(); float* sv = (float*)(p.ws + WS_DSAVE + 512 * 1024);
    for (int s = gt; s < DG_NS8 * 64; s += NGT) { const int i = s >> 6, d = s & 63; int b, h, t; dg_attn_sample(i, b, h, t);
        sv[s] = bf2f(((const bf16*)(p.ws + WS_FQ))[((size_t)b * TP + 64 + t) * 512 + h * 64 + d]); }
}
__device__ __forceinline__ void dg_attn_post(const Params& p) {
    DG_IDS(); unsigned char* ws = p.ws; const float* sv = (const float*)(ws + WS_DSAVE + 512 * 1024); float e = 0.f;
    for (int i = gwv; i < DG_NS8; i += NGWV) {
        int b, h, t; dg_attn_sample(i, b, h, t);
        const int npos = 64 + t;
        const float* kb = (const float*)(ws + WS_KB) + (size_t)(b * 8 + h) * TP;
        const bf16* K = (const bf16*)(ws + WS_FK) + (size_t)b * TP * 512 + h * 64; const bf16* V = (const bf16*)(ws + WS_FV) + (size_t)b * TP * 512 + h * 64;
        float mx = -1e38f;
        for (int j = 48 + lane; j <= npos; j += 64) { float s = 0.f; for (int d = 0; d < 64; ++d) s += sv[i * 64 + d] * bf2f(K[(size_t)j * 512 + d]); s += kb[j]; mx = fmaxf(mx, s); }
        for (int o = 1; o < 64; o <<= 1) mx = fmaxf(mx, __shfl_xor(mx, o));
        float l = 0.f, acc = 0.f;
        for (int j = 48; j <= npos; ++j) { float s = 0.f; for (int d = 0; d < 64; ++d) s += sv[i * 64 + d] * bf2f(K[(size_t)j * 512 + d]); const float pj = exp2f(s + kb[j] - mx); l += pj; acc += pj * bf2f(V[(size_t)j * 512 + lane]); }
        const float want = acc / l; const float got = bf2f(((const bf16*)(ws + WS_FQ))[((size_t)b * TP + 64 + t) * 512 + h * 64 + lane]);
        e = fmaxf(e, fabsf(got - want) / (fabsf(want) + 0.05f));
    }
    diag_report(p, 8, e / 0.05f);
}
__device__ __forceinline__ void dg_scan(const Params& p, LAS unsigned char* lds) {
    DG_IDS(); unsigned char* ws = p.ws; unsigned char* dob = (unsigned char*)p.out; float e = 0.f;
    if (gwv < 4) {
        const int bh = (gwv * 37 + 5) & 127, b = bh >> 3, h = bh & 7; const size_t rowb = (size_t)b * TP; const int cb = h * 64;
        LAS float* S = (LAS float*)lds + (gwv * 64 + lane) * 65;
        for (int k = 0; k < 64; ++k) S[k] = 0.f;
        const bf16* aXW = (const bf16*)(dob + DO_XW); const bf16* aA = (const bf16*)(dob + DO_AA); const bf16* aG = (const bf16*)(dob + DO_GG);
        const bf16* aR = (const bf16*)(ws + WS_ZRR); const bf16* aK = (const bf16*)(ws + WS_ZRK); const bf16* aV = (const bf16*)(ws + WS_ZRV);
        const float muv = p.in[I_MU][1024 + cb + lane];
#ifndef DG_SCAN_MAXPP
#define DG_SCAN_MAXPP TP
#endif
#pragma unroll 1
        for (int pp = 48; pp < DG_SCAN_MAXPP; ++pp) {
            const size_t ro = (rowb + pp) * 512 + cb;
            const float v0 = bf2f(aV[ro + lane]), v1 = bf2f(aV[ro - 512 + lane]); const float vv = v0 + muv * (v1 - v0);
            float ss = 0.f;
#pragma unroll 2
            for (int k = 0; k < 64; ++k) { const float k0 = bf2f(aK[ro + k]), k1 = bf2f(aK[ro - 512 + k]); const float ks = k0 + p.in[I_MU][512 + cb + k] * (k1 - k0); const float kk = ks * p.in[I_KK][cb + k]; ss += kk * kk; }
            const float inv = 1.0f / fmaxf(sqrtf(ss), 1e-12f);
            float sa = 0.f;
#pragma unroll 2
            for (int k = 0; k < 64; ++k) { const float k0 = bf2f(aK[ro + k]), k1 = bf2f(aK[ro - 512 + k]); const float ks = k0 + p.in[I_MU][512 + cb + k] * (k1 - k0); sa += S[k] * (ks * p.in[I_KK][cb + k] * inv); }
            sa = -sa; float y = 0.f, bon = 0.f;
#pragma unroll 2
            for (int k = 0; k < 64; ++k) { const float k0 = bf2f(aK[ro + k]), k1 = bf2f(aK[ro - 512 + k]); const float ks = k0 + p.in[I_MU][512 + cb + k] * (k1 - k0); const float a = bf2f(aA[ro + k]);
                const float kn = ks * p.in[I_KK][cb + k] * inv, kp = ks * (1.0f + (a - 1.0f) * p.in[I_KA][cb + k]);
                const float dec = 1.0f - bf2f(aXW[ro + k]); const float sn = S[k] * dec + sa * (kn * a) + vv * kp; S[k] = sn;
                const float r0 = bf2f(aR[ro + k]), r1 = bf2f(aR[ro - 512 + k]); const float rs = r0 + p.in[I_MU][cb + k] * (r1 - r0); y += sn * rs; bon += rs * kp * p.in[I_RK][cb + k]; }
            const float mean = wave_sum(y) * (1.f / 64.f); const float var = wave_sum((y - mean) * (y - mean)) * (1.f / 64.f);
            const float want = ((y - mean) / sqrtf(var + GN_EPS) * p.in[I_LNG][cb + lane] + p.in[I_LNB][cb + lane] + bon * vv) * bf2f(aG[ro + lane]);
            const float got = bf2f(((const bf16*)(ws + WS_Y))[ro + lane]);
            const float rms = sqrtf(wave_sum(want * want) * (1.f / 64.f));
            e = fmaxf(e, fabsf(got - want) / (fabsf(want) + 0.5f * rms + 0.02f));
        }
    }
    diag_report(p, 9, e / 0.15f);
}
__device__ __forceinline__ void dg_p6_pre(const Params& p) {
    DG_IDS(); float* sv = (float*)(p.ws + WS_DSAVE + 768 * 1024);
    for (int s = gt; s < DG_NS4 * 64; s += NGT) { const int i = s >> 6, d = s & 63; const unsigned hsh = dhash(i * 29 + 17); const int m = hsh % R, h = (hsh >> 20) & 7;
        sv[s] = bf2f(((const bf16*)(p.ws + WS_Y))[(size_t)m * 512 + h * 64 + d]); }
}
__device__ __forceinline__ void dg_p6_post(const Params& p) {
    DG_IDS(); unsigned char* ws = p.ws; unsigned char* dob = (unsigned char*)p.out; const float* sv = (const float*)(ws + WS_DSAVE + 768 * 1024); float e = 0.f;
    for (int i = gwv; i < DG_NS4; i += NGWV) {
        const unsigned hsh = dhash(i * 29 + 17); const int m = hsh % R, h = (hsh >> 20) & 7; const int pp = m % TP; const int c = h * 64 + lane;
        if (pp < 48) continue;
        const float y = sv[i * 64 + lane]; const float mean = wave_sum(y) / 64.f; const float var = wave_sum((y - mean) * (y - mean)) / 64.f;
        const float gn = (y - mean) / sqrtf(var + GN_EPS) * p.in[I_LNG][c] + p.in[I_LNB][c];
        const float v0 = bf2f(((const bf16*)(ws + WS_ZRV))[(size_t)m * 512 + c]), v1 = bf2f(((const bf16*)(ws + WS_ZRV))[(size_t)(m - 1) * 512 + c]);
        const float vs = v0 + p.in[I_MU][1024 + c] * (v1 - v0);
        const float want = (gn + ((const float*)(ws + WS_BS))[(size_t)m * 8 + h] * vs) * bf2f(((const bf16*)(dob + DO_GG))[(size_t)m * 512 + c]);
        e = fmaxf(e, relerr(bf2f(((const bf16*)(ws + WS_Y))[(size_t)m * 512 + c]), want, 0.1f));
    }
    diag_report(p, 10, e / 0.03f);
}
__device__ __forceinline__ void dg_mix(const Params& p, int stage) {
    DG_IDS(); unsigned char* ws = p.ws; float e = 0.f;
    for (int s = gt; s < 131072; s += NGT) {
        const unsigned hsh = dhash(s * 31 + 19 + stage); const int row = hsh % R, c = dhash(hsh) & 1023;
        float want = dg_dot((const bf16*)(ws + WS_FQ), row, (const bf16*)(ws + WS_WTFOX), c, 512) * bf2f(((const bf16*)(ws + WS_ZG))[(size_t)row * 2048 + c]);
        if (stage == 12) want = rbf(want) + dg_dot((const bf16*)(ws + WS_Y), row, (const bf16*)(ws + WS_WTRWKV), c, 512) * bf2f(((const bf16*)(ws + WS_ZG))[(size_t)row * 2048 + 1024 + c]);
        e = fmaxf(e, relerr(bf2f(((const bf16*)(ws + WS_MIX))[(size_t)row * 1024 + c]), want, 0.1f));
    }
    diag_report(p, stage, e / 0.03f);
}
__device__ __forceinline__ void dg_out(const Params& p) {
    DG_IDS(); unsigned char* ws = p.ws; float e = 0.f;
    for (int s = gt; s < 131072; s += NGT) {
        const unsigned hsh = dhash(s * 37 + 23); const int tok = hsh & 65535, c = dhash(hsh) & 1023; const int b = tok >> 12, t = tok & 4095;
        const float want = p.in[I_X][(size_t)tok * 1024 + c] + dg_dot((const bf16*)(ws + WS_MIX), (size_t)b * TP + 64 + t, (const bf16*)(ws + WS_WTOUT), c, 1024);
        e = fmaxf(e, relerr(p.out[(size_t)tok * 1024 + c], want, 0.3f));
    }
    diag_report(p, 13, e / 0.01f);
}
__device__ __forceinline__ void dg_norm2(const Params& p) {
    DG_IDS(); unsigned char* ws = p.ws; float e = 0.f;
    for (int s = gwv; s < 4096; s += NGWV) {
        const int m = dhash(s * 41 + 29) & 65535; const float* xr = p.out + (size_t)m * 1024;
        float ss = 0.f; for (int c = lane; c < 1024; c += 64) ss += xr[c] * xr[c];
        ss = wave_sum(ss); const float rs = 1.0f / sqrtf(ss / 1024.f + NORM_EPS);
        for (int c = lane; c < 1024; c += 64) e = fmaxf(e, relerr(bf2f(((const bf16*)(ws + WS_XN2))[(size_t)m * 1024 + c]), xr[c] * rs * p.in[I_N2G][c], 0.05f));
    }
    diag_report(p, 14, e / 0.03f);
}
__device__ __forceinline__ void dg_pq(const Params& p) {
    DG_IDS(); unsigned char* ws = p.ws; float e = 0.f;
    for (int s = gt; s < 131072; s += NGT) {
        const unsigned hsh = dhash(s * 43 + 31); const int tok = hsh & 65535, c = dhash(hsh) & 2047;
        const float want = dg_dot((const bf16*)(ws + WS_XN2), tok, (const bf16*)(ws + WS_WTQ), c, 1024);
        e = fmaxf(e, relerr(bf2f(((const bf16*)(ws + WS_PQ))[(size_t)tok * 2048 + c]), want, 0.25f));
    }
    diag_report(p, 15, e / 0.02f);
}
__device__ __forceinline__ void dg_route(const Params& p, LAS unsigned char* lds) {
    DG_IDS(); unsigned char* ws = p.ws; float e16 = 0.f, e17 = 0.f;
    LAS float* s2l = (LAS float*)lds + (tid >> 6) * 128;
    for (int i = gwv; i < 2048; i += NGWV) {
        const unsigned hsh = dhash(i * 47 + 37); const int tok = hsh & 65535, h = (hsh >> 16) & 7;
        const bf16* q = (const bf16*)(ws + WS_PQ) + (size_t)tok * 2048 + h * 256; const bf16* ks = (const bf16*)(ws + WS_KS);
        float s1a = 0.f, s1b = 0.f, s2a = 0.f, s2b = 0.f;
        for (int d = 0; d < 128; ++d) { const float q1 = bf2f(q[d]), q2 = bf2f(q[128 + d]);
            s1a += q1 * bf2f(ks[(size_t)lane * 128 + d]); s1b += q1 * bf2f(ks[(size_t)(lane + 64) * 128 + d]);
            s2a += q2 * bf2f(ks[(size_t)(128 + lane) * 128 + d]); s2b += q2 * bf2f(ks[(size_t)(192 + lane) * 128 + d]); }
        s2l[lane] = s2a; s2l[lane + 64] = s2b; asm volatile("s_waitcnt lgkmcnt(0)" ::: "memory");
        float prev_s = 3e38f; int prev_id = -1; float top_s[16]; int top_id[16];
#pragma unroll 1
        for (int r = 0; r < 16; ++r) {
            float bs = -3e38f; int bi = 0x7fffffff;
            for (int j = 0; j < 128; ++j) { const float t2 = s2l[j];
                { const float sm = s1a + t2; const int id = lane * 128 + j; const bool ok = (sm < prev_s) || (sm == prev_s && id > prev_id); if (ok && (sm > bs || (sm == bs && id < bi))) { bs = sm; bi = id; } }
                { const float sm = s1b + t2; const int id = (lane + 64) * 128 + j; const bool ok = (sm < prev_s) || (sm == prev_s && id > prev_id); if (ok && (sm > bs || (sm == bs && id < bi))) { bs = sm; bi = id; } } }
            for (int o = 1; o < 64; o <<= 1) { const float os = __shfl_xor(bs, o); const int oi = __shfl_xor(bi, o); if (os > bs || (os == bs && oi < bi)) { bs = os; bi = oi; } }
            top_s[r] = bs; top_id[r] = bi; prev_s = bs; prev_id = bi;
        }
        const int* ids = (const int*)(ws + WS_IDS) + (size_t)tok * 128 + h * 16; const float* gts = (const float*)(ws + WS_GATES) + (size_t)tok * 128 + h * 16;
        float den = 0.f;
#pragma unroll
        for (int r = 0; r < 16; ++r) den += expf(top_s[r] - top_s[0]);
        int miss = 0;
#pragma unroll
        for (int r = 0; r < 16; ++r) {
            bool found = false; for (int k = 0; k < 16; ++k) found |= (ids[k] == top_id[r]);
            if (!found && top_s[r] > top_s[15] + 2e-3f * fabsf(top_s[15]) + 1e-4f) ++miss;
            e17 = fmaxf(e17, fabsf(gts[r] - expf(top_s[r] - top_s[0]) / den));
        }
        e16 = fmaxf(e16, (float)miss);
        if (lane == 0 && miss) atomicAdd((float*)(ws + WS_DIAG) + 19, (float)miss);
    }
    diag_report(p, 16, e16 / 0.5f); diag_report(p, 17, e17 / 0.01f);
}
constexpr int DG_NS18 = 128;
__device__ __forceinline__ void dg_gather_pre(const Params& p) {
    DG_IDS(); float* sv = (float*)(p.ws + WS_DSAVE + 1280 * 1024);
    for (int s = gt; s < DG_NS18 * 1024; s += NGT) { const int i = s >> 10, c = s & 1023; const int tok = dhash(i * 53 + 41) & 65535; sv[s] = p.out[(size_t)tok * 1024 + c]; }
    for (int s = gt; s < DG_NS18 * 128; s += NGT) { const int i = s >> 7, ex = s & 127; const int tok = dhash(i * 53 + 41) & 65535; sv[DG_NS18 * 1024 + s] = ((const float*)(p.ws + WS_GATES))[(size_t)tok * 128 + ex]; }
}
__device__ __forceinline__ void dg_gather_post(const Params& p) {
    DG_IDS(); unsigned char* ws = p.ws; const float* sv = (const float*)(ws + WS_DSAVE + 1280 * 1024); float e = 0.f;
    for (int i = gwv; i < DG_NS18; i += NGWV) {
        const int tok = dhash(i * 53 + 41) & 65535;
        const int* ids = (const int*)(ws + WS_IDS) + (size_t)tok * 128; const float* gts = (const float*)(ws + WS_GATES) + (size_t)tok * 128;
        const signed char* xq = (const signed char*)(ws + WS_XQ) + (size_t)tok * 1024; const float sx = ((const float*)(ws + WS_SX))[tok];
        float o[16];
#pragma unroll
        for (int k = 0; k < 16; ++k) o[k] = 0.f;
        for (int ex = 0; ex < 128; ++ex) {
            const int id = ids[ex]; const signed char* ur = (const signed char*)(ws + WS_U8) + (size_t)id * 1024; const unsigned char* vr = ws + WS_V8 + (size_t)id * 1024;
            float d = 0.f;
#pragma unroll
            for (int k = 0; k < 16; ++k) d += (float)ur[lane * 16 + k] * (float)xq[lane * 16 + k];
            d = wave_sum(d) * ((const float*)(ws + WS_SU))[id] * sx;
            const float svs = ((const float*)(ws + WS_SV))[id];
            const float w = gts[ex];
            e = fmaxf(e, fabsf(w - sv[DG_NS18 * 1024 + i * 128 + ex] * 0.5f * d * (1.0f + erff(d * 0.70710678f)) * svs) / (0.02f * svs) * 0.05f);
#pragma unroll
            for (int k = 0; k < 16; ++k) o[k] += w * ((float)vr[lane * 16 + k] - 128.f);
        }
        float ss = 0.f;
#pragma unroll
        for (int k = 0; k < 16; ++k) ss += o[k] * o[k];
        const float rms = sqrtf(wave_sum(ss) / 1024.f);
#pragma unroll
        for (int k = 0; k < 16; ++k) e = fmaxf(e, fabsf((p.out[(size_t)tok * 1024 + lane * 16 + k] - sv[i * 1024 + lane * 16 + k]) - o[k]) / (rms + 1e-3f));
    }
    diag_report(p, 18, e / 0.05f);
}
__device__ __forceinline__ void dg_final(const Params& p) {
    DG_IDS(); const float* dg = (const float*)(p.ws + WS_DIAG);
    int k = 0;
    for (int s = 1; s <= 26; ++s) if (k == 0 && s != 19 && s != 20 && !(dg[s] <= 1.0f)) k = s;
    if (k != 9) k = (dg[9] <= 1.0f) ? 0 : 9;
#ifdef DIAG_SKIP
    { int kk = 0; for (int s = 1; s <= 26; ++s) if (kk == 0 && s > DIAG_SKIP && s != 19 && s != 20 && !(dg[s] <= 1.0f)) kk = s; k = kk; }
#endif
#ifdef DIAG_VALUE
    const float a = fminf(fmaxf(dg[DIAG_VALUE], 1e-3f), 1e6f) * 16.f;
#else
    const float a = exp2f((float)k);
#endif
    for (size_t i = gt; i < (size_t)NTOK * 1024 / 4; i += NGT) ((f32x4*)p.out)[i] = (f32x4){a, a, a, a};
}
#endif

#define XB_TMO      128
#define XB_XCNT(j)  (256  + 64 * (j))
#define XB_XSUB(j)  (1280 + 64 * (j))
#define XB_XGEN(j)  (2304 + 64 * (j))
#define XB_TOP      3328
#define XB_TOPGEN   3392
#define XCD_BAR_WORDS 3456
#if DIAG
#define XB_SPIN_CAP (1u << 28)
#else
#define XB_SPIN_CAP (1u << 18)
#endif

__device__ __forceinline__ unsigned xb_ld(unsigned* p)              { return __hip_atomic_load(p, __ATOMIC_RELAXED, __HIP_MEMORY_SCOPE_AGENT); }
__device__ __forceinline__ unsigned xb_add(unsigned* p, unsigned v) { return __hip_atomic_fetch_add(p, v, __ATOMIC_RELAXED, __HIP_MEMORY_SCOPE_AGENT); }
__device__ __forceinline__ unsigned xb_xcc_id() { return (unsigned)__builtin_amdgcn_s_getreg((3 << 11) | 20) & 0xFu; }
#define XB_SPIN(cond, bar) do { unsigned _sp = 0; while (cond) { __builtin_amdgcn_s_sleep(1); \
    if ((++_sp & 255u) == 0u) { if (xb_ld(&(bar)[XB_TMO])) break; if (_sp > XB_SPIN_CAP) { atomicAdd(&(bar)[XB_TMO], 1u); break; } } } } while (0)

struct XcdBarrier {
    unsigned* bar; unsigned x;
    volatile LAS unsigned* st;
};

__device__ __forceinline__ XcdBarrier xcd_barrier_post(unsigned* bar, volatile LAS unsigned* st) {
    XcdBarrier b; b.bar = bar; b.x = xb_xcc_id(); b.st = st;
    if (threadIdx.x == 0) (void)xb_add(&bar[XB_XCNT(b.x)], 1u);
    return b;
}
__device__ __forceinline__ void xcd_barrier_complete(unsigned* bar, unsigned x, unsigned& nloc, unsigned& nx) {
    const unsigned G = gridDim.x * gridDim.y * gridDim.z;
    unsigned sum, cnt, mine, sp = 0u;
    for (;;) {
        sum = 0u; cnt = 0u; mine = 0u;
#pragma unroll
        for (unsigned j = 0; j < 16; ++j) { const unsigned c = xb_ld(&bar[XB_XCNT(j)]); sum += c; cnt += (c > 0u) ? 1u : 0u; mine = (j == x) ? c : mine; }
        if (sum == G) break;
        __builtin_amdgcn_s_sleep(1);
        if ((++sp & 255u) == 0u) { if (xb_ld(&bar[XB_TMO])) break; if (sp > XB_SPIN_CAP) { atomicAdd(&bar[XB_TMO], 1u); break; } }
    }
    nloc = mine > 0u ? mine : 1u; nx = cnt > 0u ? cnt : 1u;
}

__device__ __forceinline__ void xcd_barrier(const XcdBarrier& b) {
    asm volatile("s_waitcnt vmcnt(0)" ::: "memory");
    __syncthreads();
    if (threadIdx.x == 0) {
        unsigned* bar = b.bar;
        __builtin_amdgcn_s_waitcnt(0);
        unsigned nloc = b.st[0], nx = b.st[1];
        if (nloc == 0u) { xcd_barrier_complete(bar, b.x, nloc, nx); b.st[0] = nloc; b.st[1] = nx; }
        const unsigned old = xb_add(&bar[XB_XSUB(b.x)], 1u);
        const unsigned gen = old / nloc;
        if (old + 1u == (gen + 1u) * nloc) {
            __builtin_amdgcn_fence(__ATOMIC_RELEASE, "agent");
            asm volatile("s_waitcnt vmcnt(0)" ::: "memory");
            const unsigned og = xb_add(&bar[XB_TOP], 1u);
            const unsigned tg = og / nx;
            if (og + 1u == (tg + 1u) * nx) xb_add(&bar[XB_TOPGEN], 1u);
            else XB_SPIN(xb_ld(&bar[XB_TOPGEN]) == tg, bar);
            __builtin_amdgcn_fence(__ATOMIC_ACQUIRE, "agent");
            xb_add(&bar[XB_XGEN(b.x)], 1u);
            asm volatile("s_waitcnt vmcnt(0)" ::: "memory");
        } else {
            XB_SPIN(xb_ld(&bar[XB_XGEN(b.x)]) == gen, bar);
            __builtin_amdgcn_fence(__ATOMIC_ACQUIRE, "agent");
            asm volatile("s_waitcnt vmcnt(0)" ::: "memory");
        }
    }
    __syncthreads();
}

#ifndef TIMING
#define TIMING 0
#endif
#if TIMING
#define TS(i) do { int t__ = threadIdx.x; asm volatile("" : "+v"(t__)); if (bid == 0 && t__ == 0) ((unsigned long long*)(ws + 1010 * MiB))[i] = __builtin_amdgcn_s_memrealtime(); } while (0)
#else
#define TS(i)
#endif
#if DIAG
#define DG(...) __VA_ARGS__
#else
#define DG(...)
#endif
constexpr int LDS_BYTES = 147456;
static_assert(attn_body::ATTN_LDS_BYTES <= 131072, "attention LDS");
static_assert(RT_KS_BYTES + NTHREADS * RT_TAB_WORDS * 4 <= LDS_BYTES, "routing LDS");
static_assert(sc2::END <= LDS_BYTES - 64, "scan LDS");

__global__ void __launch_bounds__(NTHREADS, 2) hybrid_fwd(Params p) {
    extern __shared__ __attribute__((aligned(16))) unsigned char lds_raw[];
    cg::grid_group grid = cg::this_grid();
    LAS unsigned char* lds = (LAS unsigned char*)lds_raw;
    const int G0 = gridDim.x, bid = blockIdx.x;
#define LANE_IDS() int tid = threadIdx.x; asm volatile("" : "+v"(tid)); const int lane = tid & 63, wave = __builtin_amdgcn_readfirstlane(tid >> 6); (void)lane; (void)wave; int G = G0; asm volatile("" : "+s"(G))
    const int vcu = (G0 % 8 == 0) ? (bid % 8) * (G0 / 8) + bid / 8 : bid;
    unsigned char* ws = p.ws; unsigned char* dob = (unsigned char*)p.out;

    DG({ int t_ = threadIdx.x; asm volatile("" : "+v"(t_)); if (bid == 0 && t_ < 64) ((float*)(ws + WS_DIAG))[t_] = 0.f; })
    unsigned* barw = (unsigned*)(ws + 65536);
    { int t__ = threadIdx.x; asm volatile("" : "+v"(t__)); if (bid == 0) for (int i = t__; i < XCD_BAR_WORDS + 128; i += NTHREADS) __hip_atomic_store(barw + i, 0u, __ATOMIC_RELAXED, __HIP_MEMORY_SCOPE_AGENT);
      if (t__ < 2) ((volatile LAS unsigned*)(lds + LDS_BYTES - 64))[t__] = 0u; }
    __syncthreads();
    TS(0);
    { LANE_IDS(); p0_prologue(p, lds, vcu, G, wave, lane); }
#ifdef REP_P0
    __syncthreads(); { LANE_IDS(); p0_prologue(p, lds, vcu, G, wave, lane); }
#endif
    grid.sync();
    const XcdBarrier xbar = xcd_barrier_post(barw, (volatile LAS unsigned*)(lds + LDS_BYTES - 64));
#define GSYNC() xcd_barrier(xbar)
    DG()
    TS(1);
    run_gemm_i8(lds, ws + WS_XN, ws + WS_WTIN, R, N1, 1024, G0, bid, (const float*)(ws + WS_SXN), (const float*)(ws + WS_SWIN), F_Gemm1{(bf16*)(ws + WS_F), (bf16*)(ws + WS_ZG)});
#ifdef REP_GEMM1
    run_gemm_i8(lds, ws + WS_XN, ws + WS_WTIN, R, N1, 1024, G0, bid, (const float*)(ws + WS_SXN), (const float*)(ws + WS_SWIN), F_Gemm1{(bf16*)(ws + WS_F), (bf16*)(ws + WS_ZG)});
#endif
    GSYNC();
    DG()
    TS(2);
    { LANE_IDS(); p2_prep1(p, vcu, G, wave, lane); }
    GSYNC();
    DG()
    TS(3);
    { LANE_IDS(); const int gwv = vcu * NWAVES + wave; for (int s = gwv; s < 128; s += G * NWAVES) p3_cumsum(p, s, lane); }
    __syncthreads();
    run_gemm(lds, (const bf16*)(ws + WS_LA), (const bf16*)(ws + WS_WTWA), R, 512, 128, G0, bid, F_LoraW{(bf16*)(dob + DO_XW), p.in[I_W0]});
    run_gemm(lds, (const bf16*)(ws + WS_LA), (const bf16*)(ws + WS_WTWA) + 512 * 128, R, 512, 128, G0, bid, F_LoraA{(bf16*)(dob + DO_AA), p.in[I_A0]});
    run_gemm(lds, (const bf16*)(ws + WS_LG), (const bf16*)(ws + WS_WTG), R, 512, 256, G0, bid, F_Plain{(bf16*)(dob + DO_GG), 512});
#ifdef REP_LORA
    run_gemm(lds, (const bf16*)(ws + WS_LA), (const bf16*)(ws + WS_WTWA), R, 512, 128, G0, bid, F_LoraW{(bf16*)(dob + DO_XW), p.in[I_W0]});
    run_gemm(lds, (const bf16*)(ws + WS_LA), (const bf16*)(ws + WS_WTWA) + 512 * 128, R, 512, 128, G0, bid, F_LoraA{(bf16*)(dob + DO_AA), p.in[I_A0]});
    run_gemm(lds, (const bf16*)(ws + WS_LG), (const bf16*)(ws + WS_WTG), R, 512, 256, G0, bid, F_Plain{(bf16*)(dob + DO_GG), 512});
#endif
    GSYNC();
    DG()
    TS(4);
    {
        LANE_IDS();
        for (int bh = bid; bh < 128; bh += G0) p5_scan_chunked(p, lds, bh, tid, wave, lane);
#ifdef REP_SCAN
        for (int bh = bid; bh < 128; bh += G0) p5_scan_chunked(p, lds, bh, tid, wave, lane);
#endif
        TS(6);
        volatile LAS unsigned* qslot = (volatile LAS unsigned*)(lds + LDS_BYTES - 64 + 16);
        for (;;) {
            __syncthreads();
            if (tid == 0) *qslot = __hip_atomic_fetch_add(barw + XCD_BAR_WORDS + 64, 1u, __ATOMIC_RELAXED, __HIP_MEMORY_SCOPE_AGENT);
            __syncthreads();
            const int u = __builtin_amdgcn_readfirstlane((int)*qslot);
            if (u >= 2048) break;
            const int qb = 15 - (u >> 7), bh = u & 127;
            {
                const float* kbg = (const float*)(ws + WS_KB) + (size_t)bh * TP; LAS float* kbl = (LAS float*)(lds + attn_body::LDS_KB);
                for (int i = tid; i < TP; i += NTHREADS) kbl[i] = kbg[i];
                asm volatile("s_waitcnt vmcnt(0) lgkmcnt(0)" ::: "memory");
                __syncthreads();
            }
            attn_body::attn_unit<8>(bh >> 3, bh & 7, qb, (const attn_body::bf16*)(ws + WS_FQ), (const attn_body::bf16*)(ws + WS_FK), (const attn_body::bf16*)(ws + WS_FV), (attn_body::bf16*)(ws + WS_FQ), (char*)lds_raw);
        }
    }
    GSYNC();
    DG(__syncthreads(); dg_scan(p, lds); __syncthreads();)
    TS(7);
    run_gemm(lds, (const bf16*)(ws + WS_FQ), (const bf16*)(ws + WS_WTFOX), R, 1024, 512, G0, bid, F_MixA{(bf16*)(ws + WS_MIX), (const bf16*)(ws + WS_ZG)});
#ifdef REP_GEMMA
    run_gemm(lds, (const bf16*)(ws + WS_FQ), (const bf16*)(ws + WS_WTFOX), R, 1024, 512, G0, bid, F_MixA{(bf16*)(ws + WS_MIX), (const bf16*)(ws + WS_ZG)});
#endif
    TS(9);
    DG()
    run_gemm(lds, (const bf16*)(ws + WS_Y), (const bf16*)(ws + WS_WTRWKV), R, 1024, 512, G0, bid, F_MixB{(bf16*)(ws + WS_MIX), (const bf16*)(ws + WS_ZG)});
    GSYNC();
    DG()
    TS(10);
    run_gemm_panels(lds, (const bf16*)(ws + WS_MIX), (const bf16*)(ws + WS_WTOUT), 1024, 1024, G0, bid, F_OutC{p.in[I_X], (bf16*)(ws + WS_H1)});
#ifdef REP_OUT
    run_gemm_panels(lds, (const bf16*)(ws + WS_MIX), (const bf16*)(ws + WS_WTOUT), 1024, 1024, G0, bid, F_OutC{p.in[I_X], (bf16*)(ws + WS_H1)});
#endif
    {
        LANE_IDS();
        for (int pan = bid; pan < NTOK / 256; pan += G) for (int r = wave; r < 256; r += 4 * NWAVES) norm2_rows<4>(p, pan * 256 + r, NWAVES, lane);
    }
    TS(11); TS(12);
    GSYNC();
#ifdef PQ_BF16
    run_gemm(lds, (const bf16*)(ws + WS_XN2), (const bf16*)(ws + 1010 * MiB), NTOK, 2048, 1024, G0, bid, F_Plain{(bf16*)(ws + WS_PQ), 2048});
#else
    run_gemm_i8(lds, ws + WS_XQ, ws + WS_WTQ, NTOK, 2048, 1024, G0, bid, (const float*)(ws + WS_SX), (const float*)(ws + WS_SWQ), F_Plain{(bf16*)(ws + WS_PQ), 2048});
#endif
#ifdef REP_PQ
    run_gemm_i8(lds, ws + WS_XQ, ws + WS_WTQ, NTOK, 2048, 1024, G0, bid, (const float*)(ws + WS_SX), (const float*)(ws + WS_SWQ), F_Plain{(bf16*)(ws + WS_PQ), 2048});
#endif
    GSYNC();
    TS(13);
    DG()
    { LANE_IDS(); p11_route(p, lds, vcu, G, tid, wave, lane); }
#ifdef REP_ROUTE
    __syncthreads(); { LANE_IDS(); p11_route(p, lds, vcu, G, tid, wave, lane); }
#endif
    GSYNC();
    TS(14);
    DG()
    { LANE_IDS(); p12a_partial(p, bid, G, wave, lane); }
#ifdef REP_12A
    { LANE_IDS(); p12a_partial(p, bid, G, wave, lane); }
#endif
    GSYNC();
    { LANE_IDS(); p12b_combine(p, vcu, G, wave, lane); }
    GSYNC();
#ifdef REP_12C
    { LANE_IDS(); p12c_output<true>(p, bid, G, wave, lane); }
#endif
    { LANE_IDS(); p12c_output<false>(p, bid, G, wave, lane); }
    DG(GSYNC(); dg_final(p);)
#if TIMING
    GSYNC(); TS(15); GSYNC();
    {
        const unsigned long long* ts = (const unsigned long long*)(ws + 1010 * MiB);
        const float tot = (float)(ts[15] - ts[0]);
        const float fa = 10.f * (float)(ts[TIMING_A1] - ts[TIMING_A0]) / tot;
        int t__ = threadIdx.x; asm volatile("" : "+v"(t__));
        for (size_t i = (size_t)bid * NTHREADS + t__; i < (size_t)NTOK * 1024; i += (size_t)G0 * NTHREADS) p.out[i] = fa;
    }
#endif
}

extern "C" void kernel_launch(void* const* d_in, const int* in_sizes, int n_in, void* d_out, int out_size, void* d_ws, size_t ws_size, hipStream_t stream) {
    static int grid = 0;
    if (grid == 0) {
        if (n_in != 27 || out_size != NTOK * DMODEL || ws_size < WS_END) { fprintf(stderr, "kernel_launch: unexpected shapes (n_in %d, out %d, ws %zu)\n", n_in, out_size, ws_size); grid = -1; return; }
        int dev = 0, cus = 0, per_cu = 0;
        hipGetDevice(&dev);
        hipDeviceGetAttribute(&cus, hipDeviceAttributeMultiprocessorCount, dev);
        hipFuncSetAttribute((const void*)hybrid_fwd, hipFuncAttributeMaxDynamicSharedMemorySize, LDS_BYTES);
        hipOccupancyMaxActiveBlocksPerMultiprocessor(&per_cu, (const void*)hybrid_fwd, NTHREADS, LDS_BYTES);
        if (per_cu < 1) { fprintf(stderr, "kernel_launch: occupancy query says %d blocks per CU\n", per_cu); grid = -1; return; }
        grid = cus;
    }
    if (grid < 0) return;
    Params p{};
    for (int i = 0; i < 27; ++i) p.in[i] = (const float*)d_in[i];
    p.out = (float*)d_out; p.ws = (unsigned char*)d_ws;
    void* args[] = {&p};
    hipError_t e = hipLaunchCooperativeKernel((const void*)hybrid_fwd, dim3(grid), dim3(NTHREADS), args, LDS_BYTES, stream);
    if (e != hipSuccess) fprintf(stderr, "cooperative launch failed: %s (grid %d)\n", hipGetErrorString(e), grid);
}
```

```cpp
#include <hip/hip_runtime.h>
#include <hip/hip_cooperative_groups.h>
#include <hip/hip_bf16.h>
#include <cstdio>
#include <cstdint>
#include <cmath>
namespace cg = cooperative_groups;
#define REP_ROUTE 1
#ifndef DIAG
#define DIAG 0
#endif
namespace pg8 {
#define PG8_LAS __attribute__((address_space(3)))
typedef unsigned short bf16_t;
typedef short bf16x8 __attribute__((ext_vector_type(8)));
typedef float f32x4 __attribute__((ext_vector_type(4)));
typedef unsigned u32x4 __attribute__((ext_vector_type(4)));
constexpr int BM = 256, BK = 64, HALF = 128, HTB = HALF * BK * 2  , STAGE_BYTES = 8 * HTB, NXCD = 8, WGM = 8;

__host__ __device__ __forceinline__ int lds_byte(int r, int c) { const int st = (r >> 4) * 2 + (c >> 5), rr = r & 15, cc = c & 31, ob = rr * 64 + cc * 2; return st * 1024 + (ob ^ (((ob >> 9) & 1) << 5)); }
__host__ __device__ __forceinline__ void stage_rc(int b, int& R, int& C) { const int st = b / 1024, sb = b % 1024, swz = sb ^ (((sb >> 9) & 1) << 5); R = (st >> 1) * 16 + swz / 64; C = (st & 1) * 32 + (swz % 64) / 2; }
__host__ __device__ __forceinline__ int perm32(int rho) { const int n = rho >> 4, i = rho & 15; return 8 * (i >> 2) + 4 * n + (i & 3); }

struct Unit { int pm, pn; };
struct Gemm { const bf16_t* A; const bf16_t* Bt; int M, N, K; };

struct StaticOrder {
    int nM, nN, nwg, G, c;
    __host__ __device__ void init(int M, int N, int G_, int c_) { nM = M / BM; nN = N / BM; nwg = nM * nN; G = G_; c = c_; }
    __host__ __device__ bool next(int i, Unit& u) const {
        const int L = i * G + c; if (L >= nwg) return false;
        int wgid = (int)L; { const int q = nwg / NXCD, r = nwg % NXCD, xcd = wgid % NXCD, off = wgid / NXCD; wgid = (xcd < r ? xcd * (q + 1) : r * (q + 1) + (xcd - r) * q) + off; }
        const int nig = WGM * nN, gid = wgid / nig, fm = gid * WGM, gsz = (nM - fm) < WGM ? (nM - fm) : WGM;
        u.pm = fm + ((wgid % nig) % gsz); u.pn = (wgid % nig) / gsz; return true;
    }
    __device__ __forceinline__ void a_ready(const Unit&) const {}
    __device__ __forceinline__ void done(const Unit&) const {}
    __device__ __forceinline__ size_t a_row0(int pm) const { return (size_t)pm * BM; }
};

__device__ __forceinline__ unsigned cvt_pk_bf16(float lo, float hi) { unsigned r; asm volatile("v_cvt_pk_bf16_f32 %0, %1, %2" : "=v"(r) : "v"(lo), "v"(hi)); return r; }
typedef float f32x2 __attribute__((ext_vector_type(2)));
typedef int i32x4 __attribute__((ext_vector_type(4)));
template <class Epi, class Sched, bool ALIGN_EPI = false, bool SP2 = false>
__device__ __forceinline__ void gemm_phase(PG8_LAS unsigned char* lds, const Gemm g, const Sched& S, const Epi& E) {
    int tid_ = threadIdx.x; asm volatile("" : "+v"(tid_));
    const int tid = tid_, wid = __builtin_amdgcn_readfirstlane(tid >> 6), lane = tid & 63, wr = wid >> 2, wc = wid & 3, fr = lane & 15, fq = lane >> 4;
    const int K = g.K, nt = K / BK;
    unsigned voffA[2], voffB[2];
#pragma unroll
    for (int i = 0; i < 2; ++i) { int R, C; stage_rc(tid * 16 + i * 8192, R, C); const int Rb = Epi::PERM ? ((R & ~31) + perm32(R & 31)) : R;
        voffA[i] = (unsigned)(R * K + C) * 2u; voffB[i] = (unsigned)(Rb * K + C) * 2u; }
    const size_t kstep = (size_t)(BK * 2);
    const size_t hstep = (size_t)HALF * K * 2;
    const size_t tstep = 2 * hstep;
    const unsigned ldsw = (unsigned)wid * 1024u;
    const int aoff = lds_byte(wr * 64 + fr, fq * 8), boff = lds_byte(wc * 32 + fr, fq * 8);
#define PG8_SA(b, h) (((b) * 2 + (h)) * HTB)
#define PG8_SB(b, h) ((4 + (b) * 2 + (h)) * HTB)
#define PG8_STAGE(bufoff, gbase, voff) do { _Pragma("unroll") for (int _i = 0; _i < 2; ++_i) \
        __builtin_amdgcn_global_load_lds((const unsigned*)((const char*)(gbase) + (voff)[_i]), (PG8_LAS unsigned*)(lds + (bufoff) + ldsw + _i * 8192), 16, 0, 0); } while (0)
#define PG8_LDA(dst, b, h) do { _Pragma("unroll") for (int m = 0; m < 4; ++m) _Pragma("unroll") for (int k = 0; k < 2; ++k) dst[m][k] = *(const PG8_LAS bf16x8*)(lds + PG8_SA(b, h) + aoff + m * 2048 + k * 1024); } while (0)
#define PG8_LDB(dst, b, h) do { _Pragma("unroll") for (int n = 0; n < 2; ++n) _Pragma("unroll") for (int k = 0; k < 2; ++k) dst[n][k] = *(const PG8_LAS bf16x8*)(lds + PG8_SB(b, h) + boff + n * 2048 + k * 1024); } while (0)
#define PG8_MMA(ai, bj, At, Bt) do { __builtin_amdgcn_s_setprio(1); _Pragma("unroll") for (int m = 0; m < 4; ++m) _Pragma("unroll") for (int n = 0; n < 2; ++n) _Pragma("unroll") for (int k = 0; k < 2; ++k) \
        acc[ai][bj][m][n] = __builtin_amdgcn_mfma_f32_16x16x32_bf16(Bt[n][k], At[m][k], acc[ai][bj][m][n], 0, 0, 0); __builtin_amdgcn_s_setprio(0); } while (0)
#define PG8_WAIT_V(n) asm volatile("s_waitcnt vmcnt(" #n ")" ::: "memory")
#define PG8_WAIT_L(n) asm volatile("s_waitcnt lgkmcnt(" #n ")" ::: "memory")
#define PG8_BAR __builtin_amdgcn_s_barrier()
#define PG8_SCHED __builtin_amdgcn_sched_barrier(0)
    Unit cur, nxt; int ui = 0;
    if (!S.next(0, cur)) return;
    f32x4 acc[2][2][4][2];
#pragma unroll
    for (int a = 0; a < 2; ++a)
#pragma unroll
        for (int b = 0; b < 2; ++b)
#pragma unroll
            for (int m = 0; m < 4; ++m)
#pragma unroll
                for (int n = 0; n < 2; ++n) acc[a][b][m][n] = (f32x4){0.f, 0.f, 0.f, 0.f};
    bf16x8 At[4][2], B0[2][2], B1[2][2];
    const char* cA = (const char*)g.A + S.a_row0(cur.pm) * (size_t)K * 2; const char* cB = (const char*)g.Bt + (size_t)cur.pn * tstep;
    S.a_ready(cur);
    if constexpr (SP2) {
        PG8_STAGE(PG8_SB(0, 0), cB, voffB); PG8_STAGE(PG8_SB(0, 1), cB + hstep, voffB); PG8_STAGE(PG8_SA(0, 0), cA, voffA); PG8_STAGE(PG8_SA(0, 1), cA + hstep, voffA);
        if (wr == 1) PG8_BAR;
        PG8_WAIT_V(2); PG8_BAR;
        PG8_STAGE(PG8_SB(1, 0), cB + kstep, voffB); PG8_STAGE(PG8_SA(1, 0), cA + kstep, voffA); PG8_STAGE(PG8_SB(1, 1), cB + hstep + kstep, voffB);
        PG8_WAIT_V(6); PG8_BAR;
    } else {
        PG8_STAGE(PG8_SB(0, 0), cB, voffB); PG8_STAGE(PG8_SA(0, 0), cA, voffA); PG8_STAGE(PG8_SB(0, 1), cB + hstep, voffB); PG8_STAGE(PG8_SA(0, 1), cA + hstep, voffA);
        if (wr == 1) PG8_BAR;
        PG8_WAIT_V(4); PG8_BAR;
        PG8_STAGE(PG8_SB(1, 0), cB + kstep, voffB); PG8_STAGE(PG8_SA(1, 0), cA + kstep, voffA); PG8_STAGE(PG8_SB(1, 1), cB + hstep + kstep, voffB);
        PG8_WAIT_V(6); PG8_BAR;
    }
    for (;;) {
        const bool has_next = S.next(ui + 1, nxt);
        const char* nA = has_next ? (const char*)g.A + S.a_row0(nxt.pm) * (size_t)K * 2 : cA; const char* nB = has_next ? (const char*)g.Bt + (size_t)nxt.pn * tstep : cB;
        for (int t = 0; t < nt; t += 2) {
            const bool last = (t == nt - 2);
            const char* a1 = cA + (size_t)(t + 1) * kstep;
            const char* a2 = last ? nA : cA + (size_t)(t + 2) * kstep; const char* b2 = last ? nB : cB + (size_t)(t + 2) * kstep;
            const char* a3 = a2 + kstep; const char* b3 = b2 + kstep;
            if (last && has_next) S.a_ready(nxt);
            if constexpr (SP2) {
            PG8_LDB(B0, 0, 0); PG8_LDB(B1, 0, 1); PG8_SCHED; PG8_LDA(At, 0, 0); PG8_STAGE(PG8_SA(1, 1), a1 + hstep, voffA);
            PG8_WAIT_V(8); PG8_WAIT_L(0); PG8_BAR; PG8_MMA(0, 0, At, B0); PG8_MMA(0, 1, At, B1); PG8_BAR; PG8_SCHED;
            PG8_LDA(At, 0, 1); PG8_STAGE(PG8_SB(0, 0), b2, voffB); PG8_STAGE(PG8_SB(0, 1), b2 + hstep, voffB); PG8_STAGE(PG8_SA(0, 0), a2, voffA);
            PG8_WAIT_V(8); PG8_WAIT_L(0); PG8_BAR; PG8_MMA(1, 0, At, B0); PG8_MMA(1, 1, At, B1); PG8_BAR; PG8_SCHED;
            PG8_LDB(B0, 1, 0); PG8_LDB(B1, 1, 1); PG8_SCHED; PG8_LDA(At, 1, 0); PG8_STAGE(PG8_SA(0, 1), a2 + hstep, voffA);
            PG8_WAIT_V(8); PG8_WAIT_L(0); PG8_BAR; PG8_MMA(0, 0, At, B0); PG8_MMA(0, 1, At, B1); PG8_BAR; PG8_SCHED;
            PG8_LDA(At, 1, 1); PG8_STAGE(PG8_SB(1, 0), b3, voffB); PG8_STAGE(PG8_SB(1, 1), b3 + hstep, voffB); PG8_STAGE(PG8_SA(1, 0), a3, voffA);
            PG8_WAIT_V(8); PG8_WAIT_L(0); PG8_BAR; PG8_MMA(1, 0, At, B0); PG8_MMA(1, 1, At, B1); PG8_BAR; PG8_SCHED;
            } else {
            PG8_LDB(B0, 0, 0); PG8_SCHED; PG8_LDA(At, 0, 0); PG8_STAGE(PG8_SA(1, 1), a1 + hstep, voffA);
            PG8_WAIT_L(8); PG8_BAR; PG8_WAIT_L(0); PG8_MMA(0, 0, At, B0); PG8_BAR; PG8_SCHED;
            PG8_LDB(B1, 0, 1); PG8_STAGE(PG8_SB(0, 0), b2, voffB);
            PG8_BAR; PG8_WAIT_L(0); PG8_MMA(0, 1, At, B1); PG8_BAR;
            PG8_LDA(At, 0, 1); PG8_STAGE(PG8_SA(0, 0), a2, voffA);
            PG8_BAR; PG8_WAIT_L(0); PG8_MMA(1, 0, At, B0); PG8_BAR; PG8_SCHED;
            PG8_STAGE(PG8_SB(0, 1), b2 + hstep, voffB);
            PG8_WAIT_V(6); PG8_BAR; PG8_MMA(1, 1, At, B1); PG8_BAR;
            PG8_LDB(B0, 1, 0); PG8_SCHED; PG8_LDA(At, 1, 0); PG8_STAGE(PG8_SA(0, 1), a2 + hstep, voffA);
            PG8_WAIT_L(8); PG8_BAR; PG8_WAIT_L(0); PG8_MMA(0, 0, At, B0); PG8_BAR; PG8_SCHED;
            PG8_LDB(B1, 1, 1); PG8_STAGE(PG8_SB(1, 0), b3, voffB);
            PG8_BAR; PG8_WAIT_L(0); PG8_MMA(0, 1, At, B1); PG8_BAR;
            PG8_LDA(At, 1, 1); PG8_STAGE(PG8_SA(1, 0), a3, voffA);
            PG8_BAR; PG8_WAIT_L(0); PG8_MMA(1, 0, At, B0); PG8_BAR; PG8_SCHED;
            PG8_STAGE(PG8_SB(1, 1), b3 + hstep, voffB);
            PG8_WAIT_V(6); PG8_BAR; PG8_MMA(1, 1, At, B1); PG8_BAR;
            }
        }
        if constexpr (ALIGN_EPI) { if (wr == 0) PG8_BAR; }
        if constexpr (!Epi::AFTER_DRAIN) { E(acc, cur, wr, wc, fr, fq); S.done(cur); }
        if (!has_next) break;
#pragma unroll
        for (int a = 0; a < 2; ++a)
#pragma unroll
            for (int b = 0; b < 2; ++b)
#pragma unroll
                for (int m = 0; m < 4; ++m)
#pragma unroll
                    for (int n = 0; n < 2; ++n) acc[a][b][m][n] = (f32x4){0.f, 0.f, 0.f, 0.f};
        cur = nxt; cA = nA; cB = nB; ++ui;
        if constexpr (ALIGN_EPI) { if (wr == 1) PG8_BAR; }
    }
    PG8_WAIT_V(0);
    if constexpr (!ALIGN_EPI) { if (wr == 0) PG8_BAR; }
    PG8_BAR;
    if constexpr (Epi::AFTER_DRAIN) { E.fused(acc, cur, wr, wc, fr, fq, lds, wid, lane); S.done(cur); }
#undef PG8_SA
#undef PG8_SB
#undef PG8_STAGE
#undef PG8_LDA
#undef PG8_LDB
#undef PG8_MMA
#undef PG8_WAIT_V
#undef PG8_WAIT_L
#undef PG8_BAR
#undef PG8_SCHED
}
template <class Epi, class Sched, bool ALIGN_EPI = false, bool SP2 = false>
__device__ __forceinline__ void gemm_phase_i8(PG8_LAS unsigned char* lds, const Gemm g, const Sched& S, const Epi& E) {
    int tid_ = threadIdx.x; asm volatile("" : "+v"(tid_));
    const int tid = tid_, wid = __builtin_amdgcn_readfirstlane(tid >> 6), lane = tid & 63, wr = wid >> 2, wc = wid & 3, fr = lane & 15, fq = lane >> 4;
    const int K = g.K, nt = K / BK;
    unsigned voffA[2], voffB[2];
#pragma unroll
    for (int i = 0; i < 2; ++i) { int R, C; stage_rc(tid * 16 + i * 8192, R, C); const int Rb = Epi::PERM ? ((R & ~31) + perm32(R & 31)) : R;
        voffA[i] = (unsigned)(R * K + C) * 2u; voffB[i] = (unsigned)(Rb * K + C) * 2u; }
    const size_t kstep = (size_t)(BK * 2);
    const size_t hstep = (size_t)HALF * K * 2;
    const size_t tstep = 2 * hstep;
    const unsigned ldsw = (unsigned)wid * 1024u;
    const int aoff = lds_byte(wr * 64 + fr, fq * 8), boff = lds_byte(wc * 32 + fr, fq * 8);
#define PG8_SA(b, h) (((b) * 2 + (h)) * HTB)
#define PG8_SB(b, h) ((4 + (b) * 2 + (h)) * HTB)
#define PG8_STAGE(bufoff, gbase, voff) do { _Pragma("unroll") for (int _i = 0; _i < 2; ++_i) \
        __builtin_amdgcn_global_load_lds((const unsigned*)((const char*)(gbase) + (voff)[_i]), (PG8_LAS unsigned*)(lds + (bufoff) + ldsw + _i * 8192), 16, 0, 0); } while (0)
#define PG8_LDA(dst, b, h) do { _Pragma("unroll") for (int m = 0; m < 4; ++m) _Pragma("unroll") for (int k = 0; k < 2; ++k) dst[m][k] = *(const PG8_LAS bf16x8*)(lds + PG8_SA(b, h) + aoff + m * 2048 + k * 1024); } while (0)
#define PG8_LDB(dst, b, h) do { _Pragma("unroll") for (int n = 0; n < 2; ++n) _Pragma("unroll") for (int k = 0; k < 2; ++k) dst[n][k] = *(const PG8_LAS bf16x8*)(lds + PG8_SB(b, h) + boff + n * 2048 + k * 1024); } while (0)
#define PG8_MMA(ai, bj, At, Bt) do { __builtin_amdgcn_s_setprio(1); _Pragma("unroll") for (int m = 0; m < 4; ++m) _Pragma("unroll") for (int n = 0; n < 2; ++n) _Pragma("unroll") for (int k = 0; k < 2; ++k) \
        acc[ai][bj][m][n] = __builtin_amdgcn_mfma_i32_16x16x64_i8(__builtin_bit_cast(i32x4, Bt[n][k]), __builtin_bit_cast(i32x4, At[m][k]), acc[ai][bj][m][n], 0, 0, 0); __builtin_amdgcn_s_setprio(0); } while (0)
#define PG8_WAIT_V(n) asm volatile("s_waitcnt vmcnt(" #n ")" ::: "memory")
#define PG8_WAIT_L(n) asm volatile("s_waitcnt lgkmcnt(" #n ")" ::: "memory")
#define PG8_BAR __builtin_amdgcn_s_barrier()
#define PG8_SCHED __builtin_amdgcn_sched_barrier(0)
    Unit cur, nxt; int ui = 0;
    if (!S.next(0, cur)) return;
    i32x4 acc[2][2][4][2];
#pragma unroll
    for (int a = 0; a < 2; ++a)
#pragma unroll
        for (int b = 0; b < 2; ++b)
#pragma unroll
            for (int m = 0; m < 4; ++m)
#pragma unroll
                for (int n = 0; n < 2; ++n) acc[a][b][m][n] = (i32x4){0, 0, 0, 0};
    bf16x8 At[4][2], B0[2][2], B1[2][2];
    const char* cA = (const char*)g.A + S.a_row0(cur.pm) * (size_t)K * 2; const char* cB = (const char*)g.Bt + (size_t)cur.pn * tstep;
    S.a_ready(cur);
    if constexpr (SP2) {
        PG8_STAGE(PG8_SB(0, 0), cB, voffB); PG8_STAGE(PG8_SB(0, 1), cB + hstep, voffB); PG8_STAGE(PG8_SA(0, 0), cA, voffA); PG8_STAGE(PG8_SA(0, 1), cA + hstep, voffA);
        if (wr == 1) PG8_BAR;
        PG8_WAIT_V(2); PG8_BAR;
        PG8_STAGE(PG8_SB(1, 0), cB + kstep, voffB); PG8_STAGE(PG8_SA(1, 0), cA + kstep, voffA); PG8_STAGE(PG8_SB(1, 1), cB + hstep + kstep, voffB);
        PG8_WAIT_V(6); PG8_BAR;
    } else {
        PG8_STAGE(PG8_SB(0, 0), cB, voffB); PG8_STAGE(PG8_SA(0, 0), cA, voffA); PG8_STAGE(PG8_SB(0, 1), cB + hstep, voffB); PG8_STAGE(PG8_SA(0, 1), cA + hstep, voffA);
        if (wr == 1) PG8_BAR;
        PG8_WAIT_V(4); PG8_BAR;
        PG8_STAGE(PG8_SB(1, 0), cB + kstep, voffB); PG8_STAGE(PG8_SA(1, 0), cA + kstep, voffA); PG8_STAGE(PG8_SB(1, 1), cB + hstep + kstep, voffB);
        PG8_WAIT_V(6); PG8_BAR;
    }
    for (;;) {
        const bool has_next = S.next(ui + 1, nxt);
        E.unit_begin(cur, ui, wid, lane);
        const char* nA = has_next ? (const char*)g.A + S.a_row0(nxt.pm) * (size_t)K * 2 : cA; const char* nB = has_next ? (const char*)g.Bt + (size_t)nxt.pn * tstep : cB;
        for (int t = 0; t < nt; t += 2) {
            const bool last = (t == nt - 2);
            const char* a1 = cA + (size_t)(t + 1) * kstep;
            const char* a2 = last ? nA : cA + (size_t)(t + 2) * kstep; const char* b2 = last ? nB : cB + (size_t)(t + 2) * kstep;
            const char* a3 = a2 + kstep; const char* b3 = b2 + kstep;
            if (last && has_next) S.a_ready(nxt);
            if constexpr (SP2) {
            PG8_LDB(B0, 0, 0); PG8_LDB(B1, 0, 1); PG8_SCHED; PG8_LDA(At, 0, 0); PG8_STAGE(PG8_SA(1, 1), a1 + hstep, voffA);
            PG8_WAIT_V(8); PG8_WAIT_L(0); PG8_BAR; PG8_MMA(0, 0, At, B0); PG8_MMA(0, 1, At, B1); PG8_BAR; PG8_SCHED;
            PG8_LDA(At, 0, 1); PG8_STAGE(PG8_SB(0, 0), b2, voffB); PG8_STAGE(PG8_SB(0, 1), b2 + hstep, voffB); PG8_STAGE(PG8_SA(0, 0), a2, voffA);
            PG8_WAIT_V(8); PG8_WAIT_L(0); PG8_BAR; PG8_MMA(1, 0, At, B0); PG8_MMA(1, 1, At, B1); PG8_BAR; PG8_SCHED;
            PG8_LDB(B0, 1, 0); PG8_LDB(B1, 1, 1); PG8_SCHED; PG8_LDA(At, 1, 0); PG8_STAGE(PG8_SA(0, 1), a2 + hstep, voffA);
            PG8_WAIT_V(8); PG8_WAIT_L(0); PG8_BAR; PG8_MMA(0, 0, At, B0); PG8_MMA(0, 1, At, B1); PG8_BAR; PG8_SCHED;
            PG8_LDA(At, 1, 1); PG8_STAGE(PG8_SB(1, 0), b3, voffB); PG8_STAGE(PG8_SB(1, 1), b3 + hstep, voffB); PG8_STAGE(PG8_SA(1, 0), a3, voffA);
            PG8_WAIT_V(8); PG8_WAIT_L(0); PG8_BAR; PG8_MMA(1, 0, At, B0); PG8_MMA(1, 1, At, B1); PG8_BAR; PG8_SCHED;
            } else {
            PG8_LDB(B0, 0, 0); PG8_SCHED; PG8_LDA(At, 0, 0); PG8_STAGE(PG8_SA(1, 1), a1 + hstep, voffA);
            PG8_WAIT_L(8); PG8_BAR; PG8_WAIT_L(0); PG8_MMA(0, 0, At, B0); PG8_BAR; PG8_SCHED;
            PG8_LDB(B1, 0, 1); PG8_STAGE(PG8_SB(0, 0), b2, voffB);
            PG8_BAR; PG8_WAIT_L(0); PG8_MMA(0, 1, At, B1); PG8_BAR;
            PG8_LDA(At, 0, 1); PG8_STAGE(PG8_SA(0, 0), a2, voffA);
            PG8_BAR; PG8_WAIT_L(0); PG8_MMA(1, 0, At, B0); PG8_BAR; PG8_SCHED;
            PG8_STAGE(PG8_SB(0, 1), b2 + hstep, voffB);
            PG8_WAIT_V(6); PG8_BAR; PG8_MMA(1, 1, At, B1); PG8_BAR;
            PG8_LDB(B0, 1, 0); PG8_SCHED; PG8_LDA(At, 1, 0); PG8_STAGE(PG8_SA(0, 1), a2 + hstep, voffA);
            PG8_WAIT_L(8); PG8_BAR; PG8_WAIT_L(0); PG8_MMA(0, 0, At, B0); PG8_BAR; PG8_SCHED;
            PG8_LDB(B1, 1, 1); PG8_STAGE(PG8_SB(1, 0), b3, voffB);
            PG8_BAR; PG8_WAIT_L(0); PG8_MMA(0, 1, At, B1); PG8_BAR;
            PG8_LDA(At, 1, 1); PG8_STAGE(PG8_SA(1, 0), a3, voffA);
            PG8_BAR; PG8_WAIT_L(0); PG8_MMA(1, 0, At, B0); PG8_BAR; PG8_SCHED;
            PG8_STAGE(PG8_SB(1, 1), b3 + hstep, voffB);
            PG8_WAIT_V(6); PG8_BAR; PG8_MMA(1, 1, At, B1); PG8_BAR;
            }
        }
        if constexpr (ALIGN_EPI) { if (wr == 0) PG8_BAR; }
        if constexpr (!Epi::AFTER_DRAIN) { E(acc, cur, wr, wc, fr, fq, ui); S.done(cur); }
        if (!has_next) break;
#pragma unroll
        for (int a = 0; a < 2; ++a)
#pragma unroll
            for (int b = 0; b < 2; ++b)
#pragma unroll
                for (int m = 0; m < 4; ++m)
#pragma unroll
                    for (int n = 0; n < 2; ++n) acc[a][b][m][n] = (i32x4){0, 0, 0, 0};
        cur = nxt; cA = nA; cB = nB; ++ui;
        if constexpr (ALIGN_EPI) { if (wr == 1) PG8_BAR; }
    }
    PG8_WAIT_V(0);
    if constexpr (!ALIGN_EPI) { if (wr == 0) PG8_BAR; }
    PG8_BAR;
    if constexpr (Epi::AFTER_DRAIN) { E.fused(acc, cur, wr, wc, fr, fq, lds, wid, lane); S.done(cur); }
#undef PG8_SA
#undef PG8_SB
#undef PG8_STAGE
#undef PG8_LDA
#undef PG8_LDB
#undef PG8_MMA
#undef PG8_WAIT_V
#undef PG8_WAIT_L
#undef PG8_BAR
#undef PG8_SCHED
}
}
namespace attn_body {
using bf16=__hip_bfloat16;
using bf16x8=__attribute__((ext_vector_type(8)))short;
using s16x4=__attribute__((ext_vector_type(4)))short;
using f32x16=__attribute__((ext_vector_type(16)))float;
using u32x4=__attribute__((ext_vector_type(4)))unsigned;
using f32x4k=__attribute__((ext_vector_type(4)))float;
constexpr int BATCH=16,NHEAD=8,TPAD=4160,D=64,DM=NHEAD*D;
constexpr int NW=8,QBLK=32,QB=QBLK*NW,KVBLK=64,NQB=16;
constexpr int ATTN_PITCH=DM, ATTN_UNIT_ROWS=QB;
__device__ __forceinline__ int crow(int r,int hi){return (r&3)+8*(r>>2)+4*hi;}
#define SBAR() __builtin_amdgcn_sched_barrier(0)
__device__ __forceinline__ void cmask(f32x16&p0,f32x16&p1,int jb,int qrel,int hi){
  const float NEG=-INFINITY; int kb=64*jb+4*hi;
  #pragma unroll
  for(int r=0;r<16;++r){int kv=kb+(r&3)+8*(r>>2); if(kv>qrel)p0[r]=NEG; if(kv+32>qrel)p1[r]=NEG;}
}

constexpr int NSLOT=3, SLOTB=8192;
constexpr int LDS_K=0, LDS_V=NSLOT*SLOTB, LDS_WS=2*NSLOT*SLOTB, LDS_OST=LDS_WS+NW*64*4, LDS_KB=LDS_OST+NW*4096, LDS_BYTES=LDS_KB+TPAD*4;
constexpr float C2=0.125f*1.4426950408889634f;
__device__ __forceinline__ void glds16(const void*gsrc,unsigned lds_dst){unsigned keep;
  asm volatile("s_mov_b32 %0, m0\n\ts_mov_b32 m0, %2\n\ts_nop 0\n\tglobal_load_lds_dwordx4 %1, off\n\ts_mov_b32 m0, %0":"=&s"(keep):"v"(gsrc),"s"(lds_dst):"memory");}
__device__ __forceinline__ float max3f(float a,float b,float c){float r;asm("v_max3_f32 %0, %1, %2, %3":"=v"(r):"v"(a),"v"(b),"v"(c));return r;}
__device__ __forceinline__ float max2f(float a,float b){float r;asm("v_max_f32_e32 %0, %1, %2":"=v"(r):"v"(a),"v"(b));return r;}
__device__ __forceinline__ float fadd_s(float a,float b){float r;asm("v_add_f32_e32 %0, %1, %2":"=v"(r):"v"(a),"v"(b));return r;}
__device__ __forceinline__ float fsub_s(float a,float b){float r;asm("v_sub_f32_e32 %0, %1, %2":"=v"(r):"v"(a),"v"(b));return r;}
typedef float f32x2_t __attribute__((ext_vector_type(2))); typedef __bf16 bf16x2_t __attribute__((ext_vector_type(2)));
__device__ __forceinline__ unsigned cvtpk_s(float lo,float hi){f32x2_t v={lo,hi};bf16x2_t b=__builtin_convertvector(v,bf16x2_t);return __builtin_bit_cast(unsigned,b);}
#define WAIT_BAR(N) asm volatile("s_waitcnt vmcnt(" #N ") lgkmcnt(0)\n\ts_barrier":::"memory")

__device__ __forceinline__ void qkt(f32x16&p0,f32x16&p1,const char*Kslot,const bf16x8*qr,int r32,int hi){
  const char*kb=Kslot+hi*1024+r32*16;
  #pragma unroll
  for(int d0=0;d0<4;++d0){
    const bf16x8 b0=*reinterpret_cast<const bf16x8*>(kb+d0*2048);
    const bf16x8 b1=*reinterpret_cast<const bf16x8*>(kb+d0*2048+512);
    {p0=__builtin_amdgcn_mfma_f32_32x32x16_bf16(b0,qr[d0],p0,0,0,0);p1=__builtin_amdgcn_mfma_f32_32x32x16_bf16(b1,qr[d0],p1,0,0,0);}}
}
typedef __attribute__((address_space(3))) const char* lds_cptr;
typedef short v4i16_t __attribute__((ext_vector_type(4)));
__device__ __forceinline__ void kload8(bf16x8*kf,lds_cptr kp){
  kf[0]=*(const __attribute__((address_space(3))) bf16x8*)(kp);      kf[1]=*(const __attribute__((address_space(3))) bf16x8*)(kp+512);
  kf[2]=*(const __attribute__((address_space(3))) bf16x8*)(kp+2048); kf[3]=*(const __attribute__((address_space(3))) bf16x8*)(kp+2560);
  kf[4]=*(const __attribute__((address_space(3))) bf16x8*)(kp+4096); kf[5]=*(const __attribute__((address_space(3))) bf16x8*)(kp+4608);
  kf[6]=*(const __attribute__((address_space(3))) bf16x8*)(kp+6144); kf[7]=*(const __attribute__((address_space(3))) bf16x8*)(kp+6656);
}
__device__ __forceinline__ void kload2(bf16x8*kf,lds_cptr kp,int j){ kf[2*j]=*(const __attribute__((address_space(3))) bf16x8*)(kp+j*2048); kf[2*j+1]=*(const __attribute__((address_space(3))) bf16x8*)(kp+j*2048+512); }
__device__ __forceinline__ s16x4 vtr(lds_cptr p){ return __builtin_bit_cast(s16x4,__builtin_amdgcn_ds_read_tr16_b64_v4i16((__attribute__((address_space(3))) v4i16_t*)p)); }
__device__ __forceinline__ float rowmax(const f32x16&p0,const f32x16&p1){
  float a=max3f(p0[0],p0[1],p1[0]),b=max3f(p0[2],p0[3],p1[1]);a=max3f(a,p1[2],p1[3]);
  #pragma unroll
  for(int r=4;r<16;r+=4){a=max3f(a,p0[r],p0[r+1]);b=max3f(b,p0[r+2],p0[r+3]);a=max3f(a,p1[r],p1[r+1]);b=max3f(b,p1[r+2],p1[r+3]);}
  const float m=max2f(a,b);
  auto rr=__builtin_amdgcn_permlane32_swap(__float_as_uint(m),__float_as_uint(m),false,false);
  return max2f(__uint_as_float(rr[0]),__uint_as_float(rr[1]));
}
__device__ __forceinline__ void pv(f32x16*o,int vb,bf16x8 pa0,bf16x8 pa1,bf16x8 pa2,bf16x8 pa3){
  #pragma unroll
  for(int d0=0;d0<2;++d0){s16x4 lo[4],hi[4];
    #pragma unroll
    for(int ks=0;ks<4;++ks){
      asm volatile("ds_read_b64_tr_b16 %0,%1 offset:%c2":"=&v"(lo[ks]):"v"(vb),"i"(d0*4096+ks*1024):"memory");
      asm volatile("ds_read_b64_tr_b16 %0,%1 offset:%c2":"=&v"(hi[ks]):"v"(vb),"i"(d0*4096+ks*1024+512):"memory");}
    asm volatile("s_waitcnt lgkmcnt(0)":::"memory");SBAR();
    #define PK(k) (bf16x8){lo[k][0],lo[k][1],lo[k][2],lo[k][3],hi[k][0],hi[k][1],hi[k][2],hi[k][3]}
    o[d0]=__builtin_amdgcn_mfma_f32_32x32x16_bf16(pa0,PK(0),o[d0],0,0,0);
    o[d0]=__builtin_amdgcn_mfma_f32_32x32x16_bf16(pa1,PK(1),o[d0],0,0,0);
    o[d0]=__builtin_amdgcn_mfma_f32_32x32x16_bf16(pa2,PK(2),o[d0],0,0,0);
    o[d0]=__builtin_amdgcn_mfma_f32_32x32x16_bf16(pa3,PK(3),o[d0],0,0,0);
    #undef PK
  }
}

#ifndef ATTN_STORE16
#define ATTN_STORE16(p,v) (*(u32x4*)(p)=(v))
#endif
template<int THRL> __device__ __forceinline__ void attn_unit(int b,int h,int qb,const bf16*Q,const bf16*__restrict__ K,const bf16*__restrict__ V,bf16*O,char*shm,const float*gqn,float qeps){
  int tid_=threadIdx.x; asm volatile("":"+v"(tid_)); const int tid=tid_,lane=tid&63,r32=lane&31,hi=lane>>5; const int wid=__builtin_amdgcn_readfirstlane(tid>>6);
  const long rowbase=(long)b*TPAD; const int q0=64+qb*QB;
  const bf16*Qw=Q+(rowbase+q0+wid*QBLK)*DM+h*D;
  const bf16*Kh=K+rowbase*DM+h*D,*Vh=V+rowbase*DM+h*D;
  const unsigned lds0=(unsigned)(uintptr_t)shm;
  float*wsf=(float*)(shm+LDS_WS)+wid*64;
  const bf16*ksrc=Kh+(long)lane*DM+wid*8;
  const bf16*vsrc=Vh+(long)(16*(wid&3)+(lane>>2))*DM+(wid>>2)*32+(lane&3)*8;
  const unsigned kdst=lds0+LDS_K+wid*1024, vdst=lds0+LDS_V+wid*1024;
  #define DMA_K(t,slot) glds16(ksrc+(long)(t)*KVBLK*DM,(unsigned)__builtin_amdgcn_readfirstlane(kdst+(slot)))
  #define DMA_V(t,slot) glds16(vsrc+(long)(t)*KVBLK*DM,(unsigned)__builtin_amdgcn_readfirstlane(vdst+(slot)))
  const int vb0=(int)(lds0+LDS_V)+((lane>>4)&1)*32+(lane&3)*8+(4*hi+((lane&15)>>2))*64;
  const char*Kbase=shm+LDS_K; bf16x8 kf[8];
  const lds_cptr shm3=(lds_cptr)shm; const lds_cptr kp0=shm3+LDS_K+hi*1024+r32*16; const lds_cptr vp0=shm3+LDS_V+((lane>>4)&1)*32+(lane&3)*8+(4*hi+((lane&15)>>2))*64;
  const int NT=(q0+QB)/KVBLK;
  typedef __attribute__((address_space(3))) const f32x4k* lds_f4p; const __attribute__((address_space(3))) float* kbp0=(const __attribute__((address_space(3))) float*)(shm3+LDS_KB)+4*hi;
  #define KBINIT(C0,C1,t) do{ const __attribute__((address_space(3))) float* kp_=kbp0+(t)*64; _Pragma("unroll") for(int g_=0;g_<4;++g_){ const f32x4k a_=*(lds_f4p)(kp_+8*g_); const f32x4k b_=*(lds_f4p)(kp_+32+8*g_); _Pragma("unroll") for(int e_=0;e_<4;++e_){ C0[4*g_+e_]=a_[e_]-mhat; C1[4*g_+e_]=b_[e_]-mhat; } } }while(0)
  DMA_K(0,0);DMA_V(0,0);DMA_K(1,SLOTB);
  bf16x8 qr[4];
  #pragma unroll
  for(int d0=0;d0<4;++d0)qr[d0]=*reinterpret_cast<const bf16x8*>(&Qw[(long)r32*DM+d0*16+hi*8]);
  {
    typedef unsigned u32x4n __attribute__((ext_vector_type(4))); typedef float f32x4n __attribute__((ext_vector_type(4)));
    float qf[4][8]; float ss=0.f;
    #pragma unroll
    for(int d0=0;d0<4;++d0){ const u32x4n w=__builtin_bit_cast(u32x4n,qr[d0]); const unsigned w0=w.x,w1=w.y,w2=w.z,w3=w.w;
      qf[d0][0]=__uint_as_float(w0<<16);qf[d0][1]=__uint_as_float(w0&0xffff0000u);qf[d0][2]=__uint_as_float(w1<<16);qf[d0][3]=__uint_as_float(w1&0xffff0000u);
      qf[d0][4]=__uint_as_float(w2<<16);qf[d0][5]=__uint_as_float(w2&0xffff0000u);qf[d0][6]=__uint_as_float(w3<<16);qf[d0][7]=__uint_as_float(w3&0xffff0000u);
      _Pragma("unroll") for(int j=0;j<8;++j)ss+=qf[d0][j]*qf[d0][j]; }
    { auto rr=__builtin_amdgcn_permlane32_swap(__float_as_uint(ss),__float_as_uint(ss),false,false); ss=__uint_as_float(rr[0])+__uint_as_float(rr[1]); }
    const float rq=C2/sqrtf(ss*(1.f/64.f)+qeps);
    #pragma unroll
    for(int d0=0;d0<4;++d0){ const f32x4n g0=*reinterpret_cast<const f32x4n*>(gqn+d0*16+hi*8), g1=*reinterpret_cast<const f32x4n*>(gqn+d0*16+hi*8+4);
      u32x4n w; w.x=cvtpk_s(qf[d0][0]*rq*g0.x,qf[d0][1]*rq*g0.y); w.y=cvtpk_s(qf[d0][2]*rq*g0.z,qf[d0][3]*rq*g0.w);
      w.z=cvtpk_s(qf[d0][4]*rq*g1.x,qf[d0][5]*rq*g1.y); w.w=cvtpk_s(qf[d0][6]*rq*g1.z,qf[d0][7]*rq*g1.w);
      qr[d0]=__builtin_bit_cast(bf16x8,w); } }
  float mhat=0.f,l_reg=0.f;f32x16 o[2];o[0]=f32x16{};o[1]=f32x16{};
  const int qrel=wid*QBLK+r32;
  #define CMASK(P0,P1,t) do{int jb_=(t)-(NT-4); if(jb_>=0)cmask(P0,P1,jb_,qrel,hi);}while(0)
  bool resc=false;
  #define START(P0,P1) do{ const float rm=rowmax(P0,P1); resc=false; \
    { const float dl=rm; mhat=fadd_s(mhat,dl); \
      _Pragma("unroll") for(int r=0;r<16;++r){P0[r]=fsub_s(P0[r],dl);P1[r]=fsub_s(P1[r],dl);} } \
    _Pragma("unroll") for(int r=0;r<16;++r)P0[r]=__builtin_amdgcn_exp2f(P0[r]); }while(0)
  #define RESC() do{ if(resc){ asm volatile("s_waitcnt lgkmcnt(0)":::"memory"); \
      _Pragma("unroll") for(int d_=0;d_<2;++d_) _Pragma("unroll") for(int r=0;r<16;++r)o[d_][r]*=wsf[crow(r,hi)]; } }while(0)
  f32x16 pA0,pA1,pB0,pB1;
  int sl_prev=0,sl_cur=0,sl_next=SLOTB;
  #define ROT() do{sl_prev=sl_cur;sl_cur=sl_next;sl_next=(sl_next==(NSLOT-1)*SLOTB)?0:sl_next+SLOTB;}while(0)
  DMA_K(2,2*SLOTB);
  WAIT_BAR(3);
  KBINIT(pA0,pA1,0); qkt(pA0,pA1,Kbase,qr,r32,hi);asm volatile("s_nop 15\n\ts_nop 7":"+v"(pA0),"+v"(pA1));CMASK(pA0,pA1,0);
  START(pA0,pA1);
  _Pragma("unroll") for(int r=0;r<16;++r)pA1[r]=__builtin_amdgcn_exp2f(pA1[r]);
  WAIT_BAR(0);
  DMA_K(3,0);DMA_V(1,SLOTB);
  ROT();
  kload8(kf,kp0+sl_cur);
  WAIT_BAR(2);
  s16x4 vlo[8],vhi[8]; u32x4 pw0,pw1,pw2,pw3;
  #define PKW(P,B) cvtpk_s(P[B],P[B+1])
  #define PAF(k) __builtin_bit_cast(bf16x8,pw##k)
  #define VFR(i) (bf16x8){vlo[i][0],vlo[i][1],vlo[i][2],vlo[i][3],vhi[i][0],vhi[i][1],vhi[i][2],vhi[i][3]}
  #define PIN(x) asm volatile("":"+v"(x))
  #define MX3(a,b,c) __builtin_fmaxf(__builtin_fmaxf((a),(b)),(c))
  #define GAPA(MF,A0,A1,A2,A3,W0,W1,PW) do{ MF; sacc+=A0; sacc+=A1; sacc+=A2; sacc+=A3; PIN(sacc); W0; W1; PIN(PW); SBAR(); }while(0)
  #define EX(v) __builtin_amdgcn_exp2f(v)
  #define GAPB(MF,X,B) do{ MF; X[B]=EX(X[B]); X[B+1]=EX(X[B+1]); X[B+2]=EX(X[B+2]); X[B+3]=EX(X[B+3]); PIN(X); SBAR(); }while(0)
  #define VRD(i) do{ vlo[i]=vtr(vp_+(((i)>>2)*4096+((i)&3)*1024)); vhi[i]=vtr(vp_+(((i)>>2)*4096+((i)&3)*1024+512)); }while(0)
  #define KRD(G,j) do{ if(G){ kload2(kf,kp0+sl_next,j); SBAR(); } }while(0)
  #define STEP(C0,C1,P0,P1,t,GK,GV,GL) do{ SBAR(); \
    const lds_cptr vp_=vp0+sl_prev; \
    KBINIT(C0,C1,t); SBAR(); \
    VRD(0); SBAR(); float sacc=(P0[0]+P0[1]); \
    GAPA(C0=__builtin_amdgcn_mfma_f32_32x32x16_bf16(kf[0],qr[0],C0,0,0,0), P0[2],P0[3],P0[4],P0[5],     pw0[0]=PKW(P0,0), pw0[1]=PKW(P0,2), pw0); \
    VRD(4); SBAR(); GAPA(C1=__builtin_amdgcn_mfma_f32_32x32x16_bf16(kf[1],qr[0],C1,0,0,0), P0[6],P0[7],P0[8],P0[9],     pw0[2]=PKW(P0,4), pw0[3]=PKW(P0,6), pw0); \
    VRD(1); SBAR(); GAPA(C0=__builtin_amdgcn_mfma_f32_32x32x16_bf16(kf[2],qr[1],C0,0,0,0),   P0[10],P0[11],P0[12],P0[13], pw1[0]=PKW(P0,8), pw1[1]=PKW(P0,10), pw1); \
    VRD(5); SBAR(); GAPA(C1=__builtin_amdgcn_mfma_f32_32x32x16_bf16(kf[3],qr[1],C1,0,0,0),   P0[14],P0[15],P1[0],P1[1],   pw1[2]=PKW(P0,12),pw1[3]=PKW(P0,14), pw1); \
    VRD(2); SBAR(); GAPA(C0=__builtin_amdgcn_mfma_f32_32x32x16_bf16(kf[4],qr[2],C0,0,0,0),   P1[2],P1[3],P1[4],P1[5],     pw2[0]=PKW(P1,0), pw2[1]=PKW(P1,2), pw2); \
    VRD(6); SBAR(); GAPA(C1=__builtin_amdgcn_mfma_f32_32x32x16_bf16(kf[5],qr[2],C1,0,0,0),   P1[6],P1[7],P1[8],P1[9],     pw2[2]=PKW(P1,4), pw2[3]=PKW(P1,6), pw2); \
    VRD(3); SBAR(); GAPA(C0=__builtin_amdgcn_mfma_f32_32x32x16_bf16(kf[6],qr[3],C0,0,0,0),   P1[10],P1[11],P1[12],P1[13], pw3[0]=PKW(P1,8), pw3[1]=PKW(P1,10), pw3); \
    VRD(7); SBAR(); GAPA(C1=__builtin_amdgcn_mfma_f32_32x32x16_bf16(kf[7],qr[3],C1,0,0,0),   P1[14],P1[15],0.f,0.f,       pw3[2]=PKW(P1,12),pw3[3]=PKW(P1,14), pw3); \
    l_reg+=sacc; \
    if(GK){DMA_K((t)+3,sl_cur);} if(GV){DMA_V((t)+1,sl_next);} \
    CMASK(C0,C1,t); \
    { float a=MX3(C0[0],C0[1],C1[0]),b=MX3(C0[2],C0[3],C1[1]); a=MX3(a,C1[2],C1[3]); \
      _Pragma("unroll") for(int r=4;r<16;r+=4){a=MX3(a,C0[r],C0[r+1]);b=MX3(b,C0[r+2],C0[r+3]);a=MX3(a,C1[r],C1[r+1]);b=MX3(b,C1[r+2],C1[r+3]);} \
      float rm=__builtin_fmaxf(a,b); { auto rr=__builtin_amdgcn_permlane32_swap(__float_as_uint(rm),__float_as_uint(rm),false,false); rm=__builtin_fmaxf(__uint_as_float(rr[0]),__uint_as_float(rr[1])); } \
      resc=false; \
      if(__builtin_expect(__any(rm>(float)THRL),0)){ const float dl=__builtin_fmaxf(rm,0.f); mhat+=dl; \
        _Pragma("unroll") for(int r=0;r<16;++r){C0[r]-=dl;C1[r]-=dl;} \
        const float f=__builtin_amdgcn_exp2f(-dl); l_reg*=f; if(hi==0)wsf[r32]=f; resc=true; } } \
    SBAR(); \
    GAPB(o[0]=__builtin_amdgcn_mfma_f32_32x32x16_bf16(PAF(0),VFR(0),o[0],0,0,0), C0,0); \
    GAPB(o[1]=__builtin_amdgcn_mfma_f32_32x32x16_bf16(PAF(0),VFR(4),o[1],0,0,0), C0,4); \
    KRD(GL,0); GAPB(o[0]=__builtin_amdgcn_mfma_f32_32x32x16_bf16(PAF(1),VFR(1),o[0],0,0,0), C0,8); \
    KRD(GL,1); GAPB(o[1]=__builtin_amdgcn_mfma_f32_32x32x16_bf16(PAF(1),VFR(5),o[1],0,0,0), C0,12); \
    KRD(GL,2); GAPB(o[0]=__builtin_amdgcn_mfma_f32_32x32x16_bf16(PAF(2),VFR(2),o[0],0,0,0), C1,0); \
    KRD(GL,3); GAPB(o[1]=__builtin_amdgcn_mfma_f32_32x32x16_bf16(PAF(2),VFR(6),o[1],0,0,0), C1,4); \
    GAPB(o[0]=__builtin_amdgcn_mfma_f32_32x32x16_bf16(PAF(3),VFR(3),o[0],0,0,0), C1,8); \
    GAPB(o[1]=__builtin_amdgcn_mfma_f32_32x32x16_bf16(PAF(3),VFR(7),o[1],0,0,0), C1,12); \
    }while(0)
  int t=1;
  #undef CMASK
  #define CMASK(P0,P1,t) do{}while(0)
  for(;t+5<NT;t+=2){
    STEP(pB0,pB1,pA0,pA1,t,true,true,true);     WAIT_BAR(2); RESC(); ROT();
    STEP(pA0,pA1,pB0,pB1,t+1,true,true,true);   WAIT_BAR(2); RESC(); ROT();
  }
  #undef CMASK
  #define CMASK(P0,P1,t) do{int jb_=(t)-(NT-4); if(jb_>=0)cmask(P0,P1,jb_,qrel,hi);}while(0)
  #define ENDW(tt) do{ if((tt)+3<NT){WAIT_BAR(2);} else if((tt)+2<NT){WAIT_BAR(1);} else {WAIT_BAR(0);} }while(0)
  for(;t+1<NT;t+=2){
    STEP(pB0,pB1,pA0,pA1,t,(t+3<NT),(t+1<NT),(t+1<NT));       ENDW(t);   RESC(); ROT();
    STEP(pA0,pA1,pB0,pB1,t+1,(t+4<NT),(t+2<NT),(t+2<NT));     ENDW(t+1); RESC(); ROT();
  }
  { float sacc=pA0[0]+pA0[1]; _Pragma("unroll") for(int r=2;r<16;++r)sacc+=pA0[r]; _Pragma("unroll") for(int r=0;r<16;++r)sacc+=pA1[r]; l_reg+=sacc;
    pw0=(u32x4){PKW(pA0,0),PKW(pA0,2),PKW(pA0,4),PKW(pA0,6)};pw1=(u32x4){PKW(pA0,8),PKW(pA0,10),PKW(pA0,12),PKW(pA0,14)};pw2=(u32x4){PKW(pA1,0),PKW(pA1,2),PKW(pA1,4),PKW(pA1,6)};pw3=(u32x4){PKW(pA1,8),PKW(pA1,10),PKW(pA1,12),PKW(pA1,14)};
    SBAR(); pv(o,vb0+sl_prev,PAF(0),PAF(1),PAF(2),PAF(3)); }
  #undef PKW
  #undef PAF
  #undef VFR
  #undef PIN
  #undef MX3
  #undef GAPA
  #undef GAPB
  #undef EX
  #undef VRD
  #undef KRD
  #undef STEP
  #undef ENDW
  {auto rr=__builtin_amdgcn_permlane32_swap(__float_as_uint(l_reg),__float_as_uint(l_reg),false,false);l_reg=__uint_as_float(rr[0])+__uint_as_float(rr[1]);}
  if(hi==0)wsf[32+r32]=l_reg;asm volatile("s_waitcnt lgkmcnt(0)":::"memory");
  float rli[16];
  #pragma unroll
  for(int r=0;r<16;++r)rli[r]=__builtin_amdgcn_rcpf(wsf[32+crow(r,hi)]);
  bf16*Ow=O+(rowbase+q0+wid*QBLK)*DM+h*D;
  { bf16*stg=(bf16*)(shm+LDS_OST)+wid*2048;
    #pragma unroll
    for(int r=0;r<16;++r){const int orow=crow(r,hi);
      #pragma unroll
      for(int d0=0;d0<2;++d0)stg[orow*64+d0*32+r32]=__float2bfloat16(o[d0][r]*rli[r]);}
    asm volatile("s_waitcnt lgkmcnt(0)":::"memory");
    #pragma unroll
    for(int i=0;i<4;++i){const int row=i*8+(lane>>3),ch=lane&7; const u32x4 v=*(const u32x4*)(stg+row*64+ch*8); ATTN_STORE16(Ow+(long)row*DM+ch*8,v);} }
  asm volatile("s_waitcnt lgkmcnt(0)\n\ts_barrier":::"memory");
  #undef DMA_K
  #undef DMA_V
  #undef CMASK
  #undef START
  #undef RESC
  #undef ROT
  #undef KBINIT
}
constexpr int ATTN_LDS_BYTES=LDS_BYTES;
#undef SBAR
#undef WAIT_BAR
}

#define LAS __attribute__((address_space(3)))
typedef unsigned short bf16;
typedef unsigned v4u __attribute__((ext_vector_type(4)));
typedef unsigned v2u __attribute__((ext_vector_type(2)));
typedef float f32x4 __attribute__((ext_vector_type(4)));
typedef short bf16x8 __attribute__((ext_vector_type(8)));
typedef float f32x16v __attribute__((ext_vector_type(16)));

constexpr int NB = 16, SEQ = 4096, DMODEL = 1024, NMETA = 16;
constexpr int TP = 4160;
constexpr int R = NB * TP;
constexpr int NTOK = NB * SEQ;
constexpr int N1 = 5632;
constexpr int IN_COLS = 5416;
constexpr int NWAVES = 8, NTHREADS = 512;
constexpr float NORM_EPS = 1e-6f, GN_EPS = 64e-5f;
constexpr float LOG2E = 1.4426950408889634f;

constexpr size_t MiB = 1u << 20;
constexpr size_t U65 = 65 * MiB;
constexpr size_t WS_WTIN = 1 * MiB;
constexpr size_t WS_WTQ = 12 * MiB;
constexpr size_t WS_WTFOX = 16 * MiB;
constexpr size_t WS_WTRWKV = 17 * MiB;
constexpr size_t WS_WTOUT = 18 * MiB;
constexpr size_t WS_WTWA = 20 * MiB;
constexpr size_t WS_WTG = 20 * MiB + 512 * 1024;
constexpr size_t WS_KS = 21 * MiB;
constexpr size_t WS_KB = 22 * MiB;
constexpr size_t WS_LF = 25 * MiB;
constexpr size_t WS_BS = 29 * MiB;
constexpr size_t WS_SXN = 28 * MiB;
constexpr size_t WS_SWIN = 9 * MiB;
constexpr size_t WS_SWQ = 15 * MiB;
constexpr size_t WS_U8 = 32 * MiB;
constexpr size_t WS_SU = 48 * MiB;
constexpr size_t WS_V8 = 64 * MiB;
constexpr size_t WS_SV = 80 * MiB;
constexpr size_t WS_CORR = 81 * MiB;
constexpr size_t WS_SX = 82 * MiB;
constexpr size_t WS_XQ = 352 * MiB;
constexpr size_t WS_F = 96 * MiB;
constexpr size_t WS_FQ = WS_F, WS_FK = WS_F + U65, WS_FV = WS_F + 2 * U65, WS_ZRR = WS_F + 3 * U65, WS_ZRK = WS_F + 4 * U65, WS_ZRV = WS_F + 5 * U65, WS_ZM = WS_F + 6 * U65;
constexpr size_t WS_ZG = WS_F + 7 * U65;
constexpr size_t WS_XN = WS_ZG + 4 * U65;
constexpr size_t WS_IDS = 941 * MiB;
constexpr size_t WS_GATES = 973 * MiB;
constexpr size_t WS_END = 1005 * MiB;
constexpr size_t WS_LA = WS_XN;
constexpr size_t WS_LG = WS_XN + 20 * MiB;
constexpr size_t WS_KP = WS_XN;
constexpr size_t WS_KN = WS_XN + U65;
constexpr size_t WS_Y = WS_ZM;
constexpr size_t WS_MIX = WS_XN;
constexpr size_t WS_XN2 = WS_XN;
constexpr size_t WS_PQ = 420 * MiB;
constexpr size_t WS_H1 = 161 * MiB;
constexpr size_t DO_XW = 0, DO_AA = U65, DO_GG = 2 * U65;

typedef float f32x2_cv __attribute__((ext_vector_type(2))); typedef __bf16 bf16x2_cv __attribute__((ext_vector_type(2)));
__device__ __forceinline__ unsigned pk2(float lo, float hi) { const f32x2_cv v = {lo, hi}; const bf16x2_cv b = __builtin_convertvector(v, bf16x2_cv); return __builtin_bit_cast(unsigned, b); }
__device__ __forceinline__ unsigned f2bf(float f) { return pk2(f, 0.f) & 0xffffu; }
__device__ __forceinline__ float bflo(unsigned w) { return __builtin_bit_cast(float, w << 16); }
__device__ __forceinline__ float bfhi(unsigned w) { return __builtin_bit_cast(float, w & 0xffff0000u); }
__device__ __forceinline__ void unpack8(const v4u w, float (&f)[8]) { f[0] = bflo(w.x); f[1] = bfhi(w.x); f[2] = bflo(w.y); f[3] = bfhi(w.y); f[4] = bflo(w.z); f[5] = bfhi(w.z); f[6] = bflo(w.w); f[7] = bfhi(w.w); }
__device__ __forceinline__ v4u pack8(const float (&f)[8]) { v4u w; w.x = pk2(f[0], f[1]); w.y = pk2(f[2], f[3]); w.z = pk2(f[4], f[5]); w.w = pk2(f[6], f[7]); return w; }
__device__ __forceinline__ float sigmoidf_(float x) { return __builtin_amdgcn_rcpf(1.0f + __builtin_amdgcn_exp2f(-x * LOG2E)); }
template <int CTRL> __device__ __forceinline__ float dppf(float x) { return __uint_as_float(__builtin_amdgcn_update_dpp(0u, __float_as_uint(x), CTRL, 0xF, 0xF, true)); }
__device__ __forceinline__ float wave_sum(float v) {
    v += dppf<0xB1>(v); v += dppf<0x4E>(v); v += dppf<0x141>(v); v += dppf<0x140>(v);
    { auto r = __builtin_amdgcn_permlane16_swap(__float_as_uint(v), __float_as_uint(v), false, false); v = __uint_as_float(r[0]) + __uint_as_float(r[1]); }
    { auto r = __builtin_amdgcn_permlane32_swap(__float_as_uint(v), __float_as_uint(v), false, false); v = __uint_as_float(r[0]) + __uint_as_float(r[1]); }
    return v;
}
__device__ __forceinline__ float wave_max(float v) {
    v = fmaxf(v, dppf<0xB1>(v)); v = fmaxf(v, dppf<0x4E>(v)); v = fmaxf(v, dppf<0x141>(v)); v = fmaxf(v, dppf<0x140>(v));
    { auto r = __builtin_amdgcn_permlane16_swap(__float_as_uint(v), __float_as_uint(v), false, false); v = fmaxf(__uint_as_float(r[0]), __uint_as_float(r[1])); }
    { auto r = __builtin_amdgcn_permlane32_swap(__float_as_uint(v), __float_as_uint(v), false, false); v = fmaxf(__uint_as_float(r[0]), __uint_as_float(r[1])); }
    return v;
}
__device__ __forceinline__ float sum8(float v) { v += dppf<0xB1>(v); v += dppf<0x4E>(v); v += dppf<0x141>(v); return v; }
__device__ __forceinline__ unsigned q8x4(float a, float b, float c, float d, float inv) {
    const unsigned qa = __float_as_uint(fmaf(a, inv, 12582912.0f)), qb = __float_as_uint(fmaf(b, inv, 12582912.0f)), qc = __float_as_uint(fmaf(c, inv, 12582912.0f)), qd = __float_as_uint(fmaf(d, inv, 12582912.0f));
    return __builtin_amdgcn_perm(__builtin_amdgcn_perm(qd, qc, 0x0c0c0400u), __builtin_amdgcn_perm(qb, qa, 0x0c0c0400u), 0x05040100u);
}

struct Params {
    const float* in[27];
    float* out;
    unsigned char* ws;
};
enum { I_X = 0, I_META, I_N1G, I_WIN, I_FQN, I_FKN, I_FBIAS, I_MU, I_W0, I_WUP, I_A0, I_AUP, I_GUP, I_KK, I_KA, I_RK, I_LNG, I_LNB, I_WFOX, I_WRWKV, I_WOUT, I_N2G, I_PWQ, I_SK1, I_SK2, I_PU, I_PV };

__device__ __forceinline__ int win_src_col(int n) {
    if (n < 1536) return n;
    if (n < 3072) return 1544 + (n - 1536);
    if (n < 3584) { const int m = n - 3072; if (m < 288) return 3080 + m; if (m < 296) return 1536 + (m - 288); return -1; }
    return 3368 + (n - 3584);
}
template <bool REMAP>
__device__ __forceinline__ void transpose_item(const float* W, int ldw, int K, int N, bf16* WT, LAS float* scr, int item, int lane) {
    const int nblk = N / 32, kb = item / nblk, nb = item % nblk, k0 = 64 * kb, n0 = 32 * nb;
    const int n = n0 + (lane & 31); const int sc = REMAP ? win_src_col(n) : n;
#pragma unroll 8
    for (int i = 0; i < 32; ++i) { const int kk = 2 * i + (lane >> 5); scr[kk * 33 + (lane & 31)] = (sc >= 0) ? W[(size_t)(k0 + kk) * ldw + sc] : 0.f; }
    asm volatile("s_waitcnt lgkmcnt(0)" ::: "memory");
    const int c = lane & 7;
#pragma unroll
    for (int j = 0; j < 4; ++j) { const int nn = (lane >> 3) + 8 * j; const LAS float* s = scr + (8 * c) * 33 + nn;
        v4u o; o.x = pk2(s[0 * 33], s[1 * 33]); o.y = pk2(s[2 * 33], s[3 * 33]); o.z = pk2(s[4 * 33], s[5 * 33]); o.w = pk2(s[6 * 33], s[7 * 33]);
        *(v4u*)(WT + (size_t)(n0 + nn) * K + k0 + 8 * c) = o; }
    asm volatile("s_waitcnt lgkmcnt(0)" ::: "memory");
}
template <bool REMAP>
__device__ __forceinline__ void transpose_q8_item(const float* W, int ldw, unsigned char* WT8, float* SW, LAS float* scr, LAS float* cmax, int item, int wave, int lane) {
    const int n0 = 32 * item, n = n0 + (lane & 31); const int sc = REMAP ? win_src_col(n) : n;
    const float* Wc = W + (size_t)(128 * wave + (lane >> 5)) * ldw + (sc >= 0 ? sc : 0);
    float wv[64];
#pragma unroll
    for (int i = 0; i < 64; ++i) wv[i] = Wc[(size_t)(2 * i) * ldw];
    float m = 0.f;
#pragma unroll
    for (int i = 0; i < 64; ++i) m = fmaxf(m, fabsf(wv[i]));
    if (sc < 0) m = 0.f;
    m = fmaxf(m, __shfl_xor(m, 32));
    if (lane < 32) cmax[wave * 32 + lane] = m;
    __syncthreads();
    m = 0.f;
#pragma unroll
    for (int w = 0; w < 8; ++w) m = fmaxf(m, cmax[w * 32 + (lane & 31)]);
    const float inv = m > 0.f ? 127.0f / m : 0.f;
    if (wave == 0 && lane < 32) SW[n] = m > 0.f ? m * (1.0f / 127.0f) : 1.0f;
#pragma unroll
    for (int blk = 0; blk < 2; ++blk) {
        const int k0 = 128 * wave + 64 * blk;
#pragma unroll
        for (int i = 0; i < 32; ++i) scr[(2 * i + (lane >> 5)) * 33 + (lane & 31)] = wv[32 * blk + i] * inv;
        asm volatile("s_waitcnt lgkmcnt(0)" ::: "memory");
        const int c = lane & 3;
#pragma unroll
        for (int j = 0; j < 2; ++j) { const int nn = (lane >> 2) + 16 * j; const LAS float* sp = scr + (16 * c) * 33 + nn;
            unsigned w[4];
#pragma unroll
            for (int d = 0; d < 4; ++d) { const int q0 = (int)rintf(sp[(4 * d) * 33]), q1 = (int)rintf(sp[(4 * d + 1) * 33]), q2 = (int)rintf(sp[(4 * d + 2) * 33]), q3 = (int)rintf(sp[(4 * d + 3) * 33]);
                w[d] = (unsigned)(q0 & 255) | ((unsigned)(q1 & 255) << 8) | ((unsigned)(q2 & 255) << 16) | ((unsigned)(q3 & 255) << 24); }
            v4u o; o.x = w[0]; o.y = w[1]; o.z = w[2]; o.w = w[3];
            *(v4u*)(WT8 + (size_t)(n0 + nn) * 1024 + k0 + 16 * c) = o; }
        asm volatile("s_waitcnt lgkmcnt(0)" ::: "memory");
    }
    __syncthreads();
}
__device__ __forceinline__ void p0_prologue(const Params& p, LAS unsigned char* lds, int vcu, int G, int wave, int lane) {
    unsigned char* ws = p.ws;
    LAS float* scr = (LAS float*)(lds + wave * 16384);
    const int gw = vcu * NWAVES + wave, NGW = G * NWAVES;
    constexpr int I_IN = N1 / 32, I_Q = 2048 / 32, I_FX = 8 * 32, I_O = 16 * 32;
    const int gt = gw * 64 + lane, NGT = NGW * 64;
    float pre1 = 0.f, pre2 = 0.f, pre3 = 0.f;
    if (gt < 1024 * 128) { const int n = gt >> 7, k = gt & 127; if (n < 512) { if (k < 64) pre1 = p.in[I_WUP][k * 512 + n]; } else { if (k >= 64) pre1 = p.in[I_AUP][(k - 64) * 512 + (n - 512)]; } }
    if (gt < 512 * 256) { const int n = gt >> 8, k = gt & 255; if (k < 160) pre2 = p.in[I_GUP][k * 512 + n]; }
    if (gt < 2 * 128 * 128) pre3 = (gt < 16384) ? p.in[I_SK1][gt] : p.in[I_SK2][gt - 16384];
    {
        LAS float* cmax = (LAS float*)(lds + 8 * 16384);
        for (int it = vcu; it < I_IN + I_Q; it += G) {
            if (it < I_IN) transpose_q8_item<true>(p.in[I_WIN], IN_COLS, ws + WS_WTIN, (float*)(ws + WS_SWIN), scr, cmax, it, wave, lane);
            else transpose_q8_item<false>(p.in[I_PWQ], 2048, ws + WS_WTQ, (float*)(ws + WS_SWQ), scr, cmax, it - I_IN, wave, lane);
        }
    }
#ifdef PQ_BF16
    for (int it = gw; it < 16 * 64; it += NGW) transpose_item<false>(p.in[I_PWQ], 2048, 1024, 2048, (bf16*)(ws + 1010 * MiB), scr, it, lane);
#endif
    constexpr int NITEMS = 2 * I_FX + I_O;
    for (int it = gw; it < NITEMS; it += NGW) {
        int r = it;
        if (r < I_FX) { transpose_item<false>(p.in[I_WFOX], 1024, 512, 1024, (bf16*)(ws + WS_WTFOX), scr, r, lane); continue; } r -= I_FX;
        if (r < I_FX) { transpose_item<false>(p.in[I_WRWKV], 1024, 512, 1024, (bf16*)(ws + WS_WTRWKV), scr, r, lane); continue; } r -= I_FX;
        transpose_item<false>(p.in[I_WOUT], 1024, 1024, 1024, (bf16*)(ws + WS_WTOUT), scr, r, lane);
    }
    if (gt < 1024 * 128) ((bf16*)(ws + WS_WTWA))[gt] = (bf16)f2bf(pre1);
    if (gt < 512 * 256) ((bf16*)(ws + WS_WTG))[gt] = (bf16)f2bf(pre2);
    if (gt < 2 * 128 * 128) ((bf16*)(ws + WS_KS))[gt] = (bf16)f2bf(pre3);
    for (int i = gt + NGT; i < 1024 * 128; i += NGT) { const int n = i >> 7, k = i & 127; float v = 0.f;
        if (n < 512) { if (k < 64) v = p.in[I_WUP][k * 512 + n]; } else { if (k >= 64) v = p.in[I_AUP][(k - 64) * 512 + (n - 512)]; }
        ((bf16*)(ws + WS_WTWA))[i] = (bf16)f2bf(v); }
    for (int i = gt + NGT; i < 512 * 256; i += NGT) { const int n = i >> 8, k = i & 255; const float v = (k < 160) ? p.in[I_GUP][k * 512 + n] : 0.f; ((bf16*)(ws + WS_WTG))[i] = (bf16)f2bf(v); }
    for (int i = gt + NGT; i < 2 * 128 * 128; i += NGT) { const float v = (i < 16384) ? p.in[I_SK1][i] : p.in[I_SK2][i - 16384]; ((bf16*)(ws + WS_KS))[i] = (bf16)f2bf(v); }
    for (int r0 = gw; r0 < 32768; r0 += 4 * NGW) {
        f32x4 a[4][4]; float m[4];
#pragma unroll
        for (int u = 0; u < 4; ++u) { const int r = r0 + u * NGW; const int tbl = r >> 14, row = r & 16383;
            const int rr = r < 32768 ? row : 0; const int tb = r < 32768 ? tbl : 0;
            const f32x4* src = (const f32x4*)((tb ? p.in[I_PV] : p.in[I_PU]) + (size_t)rr * 1024 + 16 * lane);
#pragma unroll
            for (int j = 0; j < 4; ++j) a[u][j] = src[j]; }
#pragma unroll
        for (int u = 0; u < 4; ++u) { m[u] = 0.f;
#pragma unroll
            for (int j = 0; j < 4; ++j) m[u] = fmaxf(m[u], fmaxf(fmaxf(fabsf(a[u][j].x), fabsf(a[u][j].y)), fmaxf(fabsf(a[u][j].z), fabsf(a[u][j].w)))); }
#pragma unroll
        for (int u = 0; u < 4; ++u) m[u] = wave_max(m[u]);
#pragma unroll
        for (int u = 0; u < 4; ++u) { const int r = r0 + u * NGW; if (r >= 32768) continue; const int tbl = r >> 14, row = r & 16383;
            const float inv = m[u] > 0.f ? 127.0f / m[u] : 0.f;
            unsigned ww[4];
#pragma unroll
            for (int j = 0; j < 4; ++j) ww[j] = q8x4(a[u][j].x, a[u][j].y, a[u][j].z, a[u][j].w, inv);
            v4u w; w.x = ww[0]; w.y = ww[1]; w.z = ww[2]; w.w = ww[3];
            *(v4u*)(ws + (tbl ? WS_V8 : WS_U8) + (size_t)row * 1024 + 16 * lane) = w;
            if (lane == 0) ((float*)(ws + (tbl ? WS_SV : WS_SU)))[row] = m[u] > 0.f ? m[u] * (1.0f / 127.0f) : 1.0f; }
    }
    const f32x4* g4 = (const f32x4*)p.in[I_N1G] + lane;
    for (int m0 = gw; m0 < R; m0 += 4 * NGW) {
        f32x4 v[4][4]; float s[4], mx[4]; bool live[4];
#pragma unroll
        for (int u = 0; u < 4; ++u) { const int m = m0 + u * NGW; const int mm = m < R ? m : gw; const int b = mm / TP, pp = mm - b * TP;
            live[u] = (m < R) && (pp >= 48);
            const float* xrow = (pp < 64) ? p.in[I_META] + (size_t)(pp >= 48 ? pp - 48 : 0) * 1024 : p.in[I_X] + ((size_t)b * SEQ + (pp - 64)) * 1024;
            const f32x4* xr = (const f32x4*)xrow + lane;
#pragma unroll
            for (int j = 0; j < 4; ++j) v[u][j] = xr[64 * j]; }
#pragma unroll
        for (int u = 0; u < 4; ++u) { s[u] = 0.f;
#pragma unroll
            for (int j = 0; j < 4; ++j) s[u] += (v[u][j].x * v[u][j].x + v[u][j].y * v[u][j].y) + (v[u][j].z * v[u][j].z + v[u][j].w * v[u][j].w); }
#pragma unroll
        for (int u = 0; u < 4; ++u) s[u] = wave_sum(s[u]);
#pragma unroll
        for (int u = 0; u < 4; ++u) { const float rs = __builtin_amdgcn_rsqf(s[u] * (1.f / 1024.f) + NORM_EPS); mx[u] = 0.f;
#pragma unroll
            for (int j = 0; j < 4; ++j) { const f32x4 g = g4[64 * j]; v[u][j].x *= rs * g.x; v[u][j].y *= rs * g.y; v[u][j].z *= rs * g.z; v[u][j].w *= rs * g.w;
                mx[u] = fmaxf(mx[u], fmaxf(fmaxf(fabsf(v[u][j].x), fabsf(v[u][j].y)), fmaxf(fabsf(v[u][j].z), fabsf(v[u][j].w)))); } }
#pragma unroll
        for (int u = 0; u < 4; ++u) mx[u] = wave_max(mx[u]);
#pragma unroll
        for (int u = 0; u < 4; ++u) { const int m = m0 + u * NGW; if (m >= R) continue;
            unsigned* o4 = (unsigned*)(ws + WS_XN + (size_t)m * 1024) + lane;
            const float inv = (live[u] && mx[u] > 0.f) ? 127.0f / mx[u] : 0.f;
#pragma unroll
            for (int j = 0; j < 4; ++j) o4[64 * j] = q8x4(v[u][j].x, v[u][j].y, v[u][j].z, v[u][j].w, inv);
            if (lane == 0) ((float*)(ws + WS_SXN))[m] = (live[u] && mx[u] > 0.f) ? mx[u] * (1.0f / 127.0f) : 1.0f; }
    }
}

struct NoCtx {};
template <class F> struct EpiT {
    static constexpr bool PERM = true, AFTER_DRAIN = false;
    F f;
    __device__ __forceinline__ void operator()(const pg8::f32x4 (&acc)[2][2][4][2], const pg8::Unit& u, int wr, int wc, int fr, int fq) const {
        const int row0 = u.pm * 256 + wr * 64 + fr, col0 = u.pn * 256 + wc * 32 + 8 * fq;
        constexpr int MB = F::MB;
        if constexpr (F::COL_OUTER) {
#pragma unroll
            for (int bj = 0; bj < 2; ++bj) {
                typename F::Col c1; f.col(col0 + bj * 128, c1);
#pragma unroll
                for (int ai = 0; ai < 2; ++ai)
#pragma unroll
                    for (int m = 0; m < 4; ++m) {
                        const pg8::f32x4 a = acc[ai][bj][m][0], b = acc[ai][bj][m][1];
                        float v[8] = {a[0], a[1], a[2], a[3], b[0], b[1], b[2], b[3]};
                        typename F::Ctx cx; f.store(row0 + ai * 128 + m * 16, col0 + bj * 128, v, cx, c1);
                    }
            }
            return;
        }
        typename F::Col cc[2];
#pragma unroll
        for (int bj = 0; bj < 2; ++bj) f.col(col0 + bj * 128, cc[bj]);
#pragma unroll
        for (int ai = 0; ai < 2; ++ai)
#pragma unroll
            for (int m0 = 0; m0 < 4; m0 += MB) {
                typename F::Ctx cx[MB][2];
#pragma unroll
                for (int mm = 0; mm < MB; ++mm)
#pragma unroll
                    for (int bj = 0; bj < 2; ++bj) f.load(row0 + ai * 128 + (m0 + mm) * 16, col0 + bj * 128, cx[mm][bj]);
#pragma unroll
                for (int mm = 0; mm < MB; ++mm)
#pragma unroll
                    for (int bj = 0; bj < 2; ++bj) {
                        const pg8::f32x4 a = acc[ai][bj][m0 + mm][0], b = acc[ai][bj][m0 + mm][1];
                        float v[8] = {a[0], a[1], a[2], a[3], b[0], b[1], b[2], b[3]};
                        f.store(row0 + ai * 128 + (m0 + mm) * 16, col0 + bj * 128, v, cx[mm][bj], cc[bj]);
                    }
            }
    }
};
struct F_Gemm1 {
    bf16* F; bf16* ZG; const float* gkn; LAS float* scr;
    typedef NoCtx Col; typedef NoCtx Ctx; static constexpr int MB = 1; static constexpr bool COL_OUTER = false, KNORM = true;
    __device__ __forceinline__ void col(int, Col&) const {}
    __device__ __forceinline__ void load(int, int, Ctx&) const {}
    __device__ __forceinline__ void store(int row, int col, float (&v)[8], const Ctx&, const Col&) const {
        if (col < 3584) { const int buf = col >> 9, c = col & 511; *(v4u*)(F + (size_t)buf * ((size_t)R * 512) + (size_t)row * 512 + c) = pack8(v); }
        else { const int c = col - 3584;
            unsigned q[8];
#pragma unroll
            for (int e = 0; e < 8; ++e) q[e] = __float_as_uint(fmaf(sigmoidf_(v[e]), 255.0f, 8388608.0f));
            v2u w;
            w.x = __builtin_amdgcn_perm(__builtin_amdgcn_perm(q[3], q[2], 0x0c0c0400u), __builtin_amdgcn_perm(q[1], q[0], 0x0c0c0400u), 0x05040100u);
            w.y = __builtin_amdgcn_perm(__builtin_amdgcn_perm(q[7], q[6], 0x0c0c0400u), __builtin_amdgcn_perm(q[5], q[4], 0x0c0c0400u), 0x05040100u);
            *(v2u*)((unsigned char*)ZG + (size_t)row * 2048 + c) = w; }
    }
};
struct F_LoraW {
    bf16* XW; LAS const float* w0;
    typedef NoCtx Col; typedef NoCtx Ctx; static constexpr int MB = 1; static constexpr bool COL_OUTER = false;
    __device__ __forceinline__ void col(int, Col&) const {}
    __device__ __forceinline__ void load(int, int, Ctx&) const {}
    __device__ __forceinline__ void store(int row, int col, float (&v)[8], const Ctx&, const Col&) const {
        asm volatile("" ::: "memory");
        const f32x4 b0 = *(LAS const f32x4*)(w0 + col), b1 = *(LAS const f32x4*)(w0 + col + 4); const float bb[8] = {b0.x, b0.y, b0.z, b0.w, b1.x, b1.y, b1.z, b1.w};
#pragma unroll
        for (int e = 0; e < 8; ++e) { const float x = v[e] + bb[e];
            v[e] = (-0.60653065971263342f * LOG2E) * sigmoidf_(x); }
        *(v4u*)(XW + (size_t)row * 512 + col) = pack8(v);
    }
};
struct F_LoraA {
    bf16* AA; LAS const float* a0;
    typedef NoCtx Col; typedef NoCtx Ctx; static constexpr int MB = 1; static constexpr bool COL_OUTER = false;
    __device__ __forceinline__ void col(int, Col&) const {}
    __device__ __forceinline__ void load(int, int, Ctx&) const {}
    __device__ __forceinline__ void store(int row, int col, float (&v)[8], const Ctx&, const Col&) const {
        asm volatile("" ::: "memory");
        const f32x4 b0 = *(LAS const f32x4*)(a0 + col), b1 = *(LAS const f32x4*)(a0 + col + 4); const float bb[8] = {b0.x, b0.y, b0.z, b0.w, b1.x, b1.y, b1.z, b1.w};
#pragma unroll
        for (int e = 0; e < 8; ++e) v[e] = sigmoidf_(v[e] + bb[e]);
        *(v4u*)(AA + (size_t)row * 512 + col) = pack8(v);
    }
};
struct F_Plain {
    bf16* O; int ldc;
    typedef NoCtx Col; typedef NoCtx Ctx; static constexpr int MB = 1; static constexpr bool COL_OUTER = false, KNORM = false;
    __device__ __forceinline__ void col(int, Col&) const {}
    __device__ __forceinline__ void load(int, int, Ctx&) const {}
    __device__ __forceinline__ void store(int row, int col, float (&v)[8], const Ctx&, const Col&) const { *(v4u*)(O + (size_t)row * ldc + col) = pack8(v); }
};
struct CtxGate { v2u gq; };
struct CtxMixGate { v4u mix; v2u gq; };
__device__ __forceinline__ void gates8(const v2u gq, float (&g)[8]) {
    g[0] = (float)(gq.x & 0xffu); g[1] = (float)((gq.x >> 8) & 0xffu); g[2] = (float)((gq.x >> 16) & 0xffu); g[3] = (float)(gq.x >> 24);
    g[4] = (float)(gq.y & 0xffu); g[5] = (float)((gq.y >> 8) & 0xffu); g[6] = (float)((gq.y >> 16) & 0xffu); g[7] = (float)(gq.y >> 24);
}
struct F_MixA {
    bf16* MIX; const bf16* ZG;
    typedef NoCtx Col; typedef CtxGate Ctx; static constexpr int MB = 4; static constexpr bool COL_OUTER = false;
    __device__ __forceinline__ void col(int, Col&) const {}
    __device__ __forceinline__ void load(int row, int col, Ctx& c) const { c.gq = *(const v2u*)((const unsigned char*)ZG + ((size_t)(row >> 12) * TP + 64 + (row & 4095)) * 2048 + col); }
    __device__ __forceinline__ void store(int row, int col, float (&v)[8], const Ctx& c, const Col&) const {
        float g[8]; gates8(c.gq, g);
#pragma unroll
        for (int e = 0; e < 8; ++e) v[e] *= g[e] * (1.0f / 255.0f);
        *(v4u*)(MIX + (size_t)row * 1024 + col) = pack8(v);
    }
};
struct F_MixB {
    bf16* MIX; const bf16* ZG;
    typedef NoCtx Col; typedef CtxMixGate Ctx; static constexpr int MB = 4; static constexpr bool COL_OUTER = false;
    __device__ __forceinline__ void col(int, Col&) const {}
    __device__ __forceinline__ void load(int row, int col, Ctx& c) const {
        c.mix = *(const v4u*)(MIX + (size_t)row * 1024 + col);
        c.gq = *(const v2u*)((const unsigned char*)ZG + ((size_t)(row >> 12) * TP + 64 + (row & 4095)) * 2048 + 1024 + col);
    }
    __device__ __forceinline__ void store(int row, int col, float (&v)[8], const Ctx& c, const Col&) const {
        float m[8]; unpack8(c.mix, m);
        float g[8]; gates8(c.gq, g);
#pragma unroll
        for (int e = 0; e < 8; ++e) v[e] = m[e] + v[e] * g[e] * (1.0f / 255.0f);
        *(v4u*)(MIX + (size_t)row * 1024 + col) = pack8(v);
    }
};
template <class F> struct EpiI8 {
    static constexpr bool PERM = true, AFTER_DRAIN = false;
    F f; const float* SA; const float* SB; LAS unsigned char* sl;
    __device__ __forceinline__ void unit_begin(const pg8::Unit& u, int ui, int wid, int lane) const {
        const float* src = (wid < 4) ? SA + u.pm * 256 + wid * 64 + lane : SB + u.pn * 256 + (wid - 4) * 64 + lane;
        __builtin_amdgcn_global_load_lds((const unsigned*)src, (LAS unsigned*)(sl + (ui & 1) * 2048 + wid * 256), 4, 0, 0);
    }
    __device__ __forceinline__ void operator()(const pg8::i32x4 (&acc)[2][2][4][2], const pg8::Unit& u, int wr, int wc, int fr, int fq, int ui) const {
        const int row0 = u.pm * 256 + wr * 64 + fr, col0 = u.pn * 256 + wc * 32 + 8 * fq;
        f32x4 sb[2][2]; float sa[2][4];
        typename F::Col cc[2];
        const LAS float* ls = (const LAS float*)(sl + (ui & 1) * 2048);
#pragma unroll
        for (int bj = 0; bj < 2; ++bj) { sb[bj][0] = *(const LAS f32x4*)(ls + 256 + wc * 32 + 8 * fq + bj * 128); sb[bj][1] = *(const LAS f32x4*)(ls + 256 + wc * 32 + 8 * fq + bj * 128 + 4); f.col(col0 + bj * 128, cc[bj]); }
#pragma unroll
        for (int ai = 0; ai < 2; ++ai)
#pragma unroll
            for (int m = 0; m < 4; ++m) sa[ai][m] = ls[wr * 64 + fr + ai * 128 + m * 16];
        if constexpr (F::KNORM) {
            if ((u.pn >> 1) == 1) {
                float ss[2][4][2];
#pragma unroll
                for (int ai = 0; ai < 2; ++ai)
#pragma unroll
                    for (int m = 0; m < 4; ++m)
#pragma unroll
                        for (int bj = 0; bj < 2; ++bj) {
                            const pg8::i32x4 a = acc[ai][bj][m][0], b = acc[ai][bj][m][1]; const float sar = sa[ai][m];
                            const float v[8] = {(float)a[0] * (sar * sb[bj][0].x), (float)a[1] * (sar * sb[bj][0].y), (float)a[2] * (sar * sb[bj][0].z), (float)a[3] * (sar * sb[bj][0].w),
                                                (float)b[0] * (sar * sb[bj][1].x), (float)b[1] * (sar * sb[bj][1].y), (float)b[2] * (sar * sb[bj][1].z), (float)b[3] * (sar * sb[bj][1].w)};
                            float q = (v[0] * v[0] + v[1] * v[1]) + (v[2] * v[2] + v[3] * v[3]) + (v[4] * v[4] + v[5] * v[5]) + (v[6] * v[6] + v[7] * v[7]);
                            { auto r = __builtin_amdgcn_permlane16_swap(__float_as_uint(q), __float_as_uint(q), false, false); q = __uint_as_float(r[0]) + __uint_as_float(r[1]); }
                            { auto r = __builtin_amdgcn_permlane32_swap(__float_as_uint(q), __float_as_uint(q), false, false); q = __uint_as_float(r[0]) + __uint_as_float(r[1]); }
                            ss[ai][m][bj] = q;
                        }
                LAS float* mine = f.scr + (wr * 4 + wc) * 256 + fr; LAS const float* theirs = f.scr + (wr * 4 + (wc ^ 1)) * 256 + fr;
                if (fq == 0) {
#pragma unroll
                    for (int ai = 0; ai < 2; ++ai)
#pragma unroll
                        for (int m = 0; m < 4; ++m)
#pragma unroll
                            for (int bj = 0; bj < 2; ++bj) mine[((ai * 4 + m) * 2 + bj) * 16] = ss[ai][m][bj];
                }
                asm volatile("s_waitcnt lgkmcnt(0)\n\ts_barrier" ::: "memory");
                f32x4 gk[2][2];
#pragma unroll
                for (int bj = 0; bj < 2; ++bj) { gk[bj][0] = *(const f32x4*)(f.gkn + (col0 - 512) + bj * 128); gk[bj][1] = *(const f32x4*)(f.gkn + (col0 - 512) + bj * 128 + 4); }
#pragma unroll
                for (int ai = 0; ai < 2; ++ai)
#pragma unroll
                    for (int m = 0; m < 4; ++m) {
                        const int row = row0 + ai * 128 + m * 16; const float sar = sa[ai][m];
#pragma unroll
                        for (int bj = 0; bj < 2; ++bj) {
                            const float tot = ss[ai][m][bj] + theirs[((ai * 4 + m) * 2 + bj) * 16];
                            const float rk = __builtin_amdgcn_rsqf(tot * (1.f / 64.f) + NORM_EPS);
                            const pg8::i32x4 a = acc[ai][bj][m][0], b = acc[ai][bj][m][1];
                            float v[8] = {(float)a[0] * (sar * sb[bj][0].x) * (rk * gk[bj][0].x), (float)a[1] * (sar * sb[bj][0].y) * (rk * gk[bj][0].y), (float)a[2] * (sar * sb[bj][0].z) * (rk * gk[bj][0].z),
                                          (float)a[3] * (sar * sb[bj][0].w) * (rk * gk[bj][0].w), (float)b[0] * (sar * sb[bj][1].x) * (rk * gk[bj][1].x), (float)b[1] * (sar * sb[bj][1].y) * (rk * gk[bj][1].y),
                                          (float)b[2] * (sar * sb[bj][1].z) * (rk * gk[bj][1].z), (float)b[3] * (sar * sb[bj][1].w) * (rk * gk[bj][1].w)};
                            typename F::Ctx cx; f.store(row, col0 + bj * 128, v, cx, cc[bj]);
                        }
                    }
                return;
            }
        }
#pragma unroll
        for (int ai = 0; ai < 2; ++ai)
#pragma unroll
            for (int m = 0; m < 4; ++m) {
                const int row = row0 + ai * 128 + m * 16; const float sar = sa[ai][m];
#pragma unroll
                for (int bj = 0; bj < 2; ++bj) {
                    const pg8::i32x4 a = acc[ai][bj][m][0], b = acc[ai][bj][m][1];
                    float v[8] = {(float)a[0] * (sar * sb[bj][0].x), (float)a[1] * (sar * sb[bj][0].y), (float)a[2] * (sar * sb[bj][0].z), (float)a[3] * (sar * sb[bj][0].w),
                                  (float)b[0] * (sar * sb[bj][1].x), (float)b[1] * (sar * sb[bj][1].y), (float)b[2] * (sar * sb[bj][1].z), (float)b[3] * (sar * sb[bj][1].w)};
                    typename F::Ctx cx; f.load(row, col0 + bj * 128, cx);
                    f.store(row, col0 + bj * 128, v, cx, cc[bj]);
                }
            }
    }
};
template <class F>
__device__ __forceinline__ void run_gemm_i8(LAS unsigned char* lds, const unsigned char* A8, const unsigned char* Bt8, int M, int N, int K8, int G, int bid, const float* SA, const float* SB, const F& f) {
    asm volatile("" : "+s"(M), "+s"(N), "+s"(G));
    pg8::Gemm g{(const bf16*)A8, (const bf16*)Bt8, M, N, K8 / 2}; pg8::StaticOrder S; S.init(M, N, G, bid);
    EpiI8<F> E{f, SA, SB, lds + pg8::STAGE_BYTES + 8192};
    pg8::gemm_phase_i8<EpiI8<F>, pg8::StaticOrder, true, true>(lds, g, S, E);
}
template <int LOG_NT> struct PanelOrder {
    int c, G;
    __device__ __forceinline__ bool next(int i, pg8::Unit& u) const { const int pan = c + (i >> LOG_NT) * G; if (pan >= NTOK / 256) return false; u.pm = pan; u.pn = (i + (c >> 3)) & ((1 << LOG_NT) - 1); return true; }
    __device__ __forceinline__ void a_ready(const pg8::Unit&) const {}
    __device__ __forceinline__ void done(const pg8::Unit&) const {}
    __device__ __forceinline__ size_t a_row0(int pm) const { return (size_t)pm * 256; }
};
struct CompactOrder : pg8::StaticOrder {
    __device__ __forceinline__ size_t a_row0(int pm) const { return (size_t)(pm >> 4) * TP + 64 + (size_t)(pm & 15) * 256; }
};
struct CtxX { f32x4 x0, x1; };
struct F_OutC {
    const float* x; bf16* h1;
    typedef NoCtx Col; typedef CtxX Ctx; static constexpr int MB = 4; static constexpr bool COL_OUTER = false;
    __device__ __forceinline__ void col(int, Col&) const {}
    __device__ __forceinline__ void load(int row, int col, Ctx& c) const { const size_t off = (size_t)row * 1024 + col; c.x0 = *(const f32x4*)(x + off); c.x1 = *(const f32x4*)(x + off + 4); }
    __device__ __forceinline__ void store(int row, int col, float (&v)[8], const Ctx& c, const Col&) const {
        const size_t off = (size_t)row * 1024 + col;
        v[0] += c.x0.x; v[1] += c.x0.y; v[2] += c.x0.z; v[3] += c.x0.w; v[4] += c.x1.x; v[5] += c.x1.y; v[6] += c.x1.z; v[7] += c.x1.w;
        *(v4u*)(h1 + off) = pack8(v);
    }
};
template <class F>
__device__ __forceinline__ void run_gemm_panels(LAS unsigned char* lds, const bf16* A, const bf16* Bt, int N, int K, int G, int c, const F& f) {
    asm volatile("" : "+s"(N), "+s"(G));
    pg8::Gemm g{A, Bt, NTOK, N, K}; PanelOrder<2> S{c, G};
    EpiT<F> E{f};
    pg8::gemm_phase<EpiT<F>, PanelOrder<2>, true, true>(lds, g, S, E);
}
template <class F>
__device__ __forceinline__ void run_gemm_i8_panels8(LAS unsigned char* lds, const unsigned char* A8, const unsigned char* Bt8, int K8, int G, int c, const float* SA, const float* SB, const F& f) {
    asm volatile("" : "+s"(K8), "+s"(G));
    pg8::Gemm g{(const bf16*)A8, (const bf16*)Bt8, NTOK, 2048, K8 / 2}; PanelOrder<3> S{c, G};
    EpiI8<F> E{f, SA, SB, lds + pg8::STAGE_BYTES + 8192};
    pg8::gemm_phase_i8<EpiI8<F>, PanelOrder<3>, true, true>(lds, g, S, E);
}
template <class F>
__device__ __forceinline__ void run_gemm_compact(LAS unsigned char* lds, const bf16* A, const bf16* Bt, int N, int K, int G, int bid, const F& f) {
    int M = NTOK; asm volatile("" : "+s"(M), "+s"(N), "+s"(G));
    pg8::Gemm g{A, Bt, M, N, K}; CompactOrder S; S.init(M, N, G, bid);
    EpiT<F> E{f};
    pg8::gemm_phase<EpiT<F>, CompactOrder, true, true>(lds, g, S, E);
}
template <class F>
__device__ __forceinline__ void run_gemm(LAS unsigned char* lds, const bf16* A, const bf16* Bt, int M, int N, int K, int G, int bid, const F& f) {
    asm volatile("" : "+s"(M), "+s"(N), "+s"(G));
    pg8::Gemm g{A, Bt, M, N, K}; pg8::StaticOrder S; S.init(M, N, G, bid);
    EpiT<F> E{f};
    pg8::gemm_phase<EpiT<F>, pg8::StaticOrder, true, true>(lds, g, S, E);
}

__device__ __forceinline__ void p2_prep1(const Params& p, int vcu, int G, int wave, int lane) {
    unsigned char* ws = p.ws;
    const int gw = vcu * NWAVES + wave, NGW = G * NWAVES;
    float mu[8], fb[8];
#pragma unroll
    for (int e = 0; e < 8; ++e) { mu[e] = (lane < 36) ? p.in[I_MU][1536 + lane * 8 + e] : 0.f; fb[e] = p.in[I_FBIAS][e]; }
    constexpr int NR = 16;
    for (int m0 = gw; m0 < R; m0 += NR * NGW) {
        v4u zv[NR], zpv[NR];
#pragma unroll
        for (int r = 0; r < NR; ++r) { const int m = m0 + r * NGW; const bool ok = m < R; const int mm = ok ? m : gw; const int pp = mm % TP;
            zv[r] = (v4u){0u, 0u, 0u, 0u}; zpv[r] = zv[r];
            if (lane < 37) { zv[r] = *((const v4u*)(ws + WS_ZM + (size_t)mm * 1024) + lane); if (pp > 0) zpv[r] = *((const v4u*)(ws + WS_ZM + (size_t)(mm - 1) * 1024) + lane); } }
#pragma unroll
        for (int r = 0; r < NR; ++r) { const int m = m0 + r * NGW; if (m >= R) continue;
            float z[8], zp[8]; unpack8(zv[r], z); unpack8(zpv[r], zp);
            if (lane < 36) {
#pragma unroll
                for (int e = 0; e < 8; ++e) { const float s = z[e] + mu[e] * (zp[e] - z[e]); const float sg = sigmoidf_(lane < 8 ? 2.0f * s : s); z[e] = (lane < 8) ? 2.0f * sg - 1.0f : (lane < 16) ? s : sg; }
                if (lane < 16) *((v4u*)(ws + WS_LA + (size_t)m * 256) + lane) = pack8(z);
                else *((v4u*)(ws + WS_LG + (size_t)m * 512) + (lane - 16)) = pack8(z);
            } else if (lane == 36) {
#pragma unroll
                for (int e = 0; e < 8; ++e) { const float x = z[e] + fb[e]; z[e] = fminf(x, 0.f) - __logf(1.0f + __expf(-fabsf(x))); }
                float* lf = (float*)(ws + WS_LF) + (size_t)m * 8;
                *(f32x4*)lf = (f32x4){z[0], z[1], z[2], z[3]}; *(f32x4*)(lf + 4) = (f32x4){z[4], z[5], z[6], z[7]};
            } else if (lane < 49) {
                *((v4u*)(ws + WS_LG + (size_t)m * 512) + (lane - 37 + 20)) = (v4u){0u, 0u, 0u, 0u};
            }
        }
    }
}
__device__ __forceinline__ void p3_cumsum(const Params& p, int seq, int lane) {
    unsigned char* ws = p.ws;
    const int b = seq >> 3, h = seq & 7;
    const float* lf = (const float*)(ws + WS_LF) + (size_t)b * TP * 8 + h;
    float* kb = (float*)(ws + WS_KB) + (size_t)seq * TP;
    float v[65];
#pragma unroll
    for (int i = 0; i < 65; ++i) { const int pp = i * 64 + lane; v[i] = (pp >= 48) ? lf[(size_t)pp * 8] : 0.f; }
    float carry = 0.f;
#pragma unroll
    for (int i = 0; i < 65; ++i) {
        float x = v[i];
        x += __uint_as_float(__builtin_amdgcn_update_dpp(0u, __float_as_uint(x), 0x111, 0xF, 0xF, true));
        x += __uint_as_float(__builtin_amdgcn_update_dpp(0u, __float_as_uint(x), 0x112, 0xF, 0xF, true));
        x += __uint_as_float(__builtin_amdgcn_update_dpp(0u, __float_as_uint(x), 0x114, 0xF, 0xF, true));
        x += __uint_as_float(__builtin_amdgcn_update_dpp(0u, __float_as_uint(x), 0x118, 0xF, 0xF, true));
        x += __uint_as_float(__builtin_amdgcn_update_dpp(0u, __float_as_uint(x), 0x142, 0xA, 0xF, false));
        x += __uint_as_float(__builtin_amdgcn_update_dpp(0u, __float_as_uint(x), 0x143, 0xC, 0xF, false));
        const int pp = i * 64 + lane;
        const float c = carry + x;
        kb[pp] = (pp >= 48) ? -c * LOG2E : -1e30f;
        carry += __uint_as_float((unsigned)__builtin_amdgcn_readlane((int)__float_as_uint(x), 63));
    }
}

__device__ __forceinline__ void p4_prep2(const Params& p, int vcu, int G, int wave, int lane) {
    unsigned char* ws = p.ws; unsigned char* dob = (unsigned char*)p.out;
    const int gw = vcu * NWAVES + wave, NGW = G * NWAVES;
    float mur[8], muk[8], kk_[8], ka_[8], rk_[8];
#pragma unroll
    for (int e = 0; e < 8; ++e) { const int c = lane * 8 + e; mur[e] = p.in[I_MU][c]; muk[e] = p.in[I_MU][512 + c]; kk_[e] = p.in[I_KK][c]; ka_[e] = p.in[I_KA][c]; rk_[e] = p.in[I_RK][c]; }
    for (int m = gw; m < R; m += NGW) {
        const int b = m / TP, pp = m - b * TP;
        float r[8], k[8], rp[8], kp[8], a[8];
        unpack8(*((const v4u*)(ws + WS_ZRR + (size_t)m * 1024) + lane), r); unpack8(*((const v4u*)(ws + WS_ZRK + (size_t)m * 1024) + lane), k);
        if (pp > 0) { unpack8(*((const v4u*)(ws + WS_ZRR + (size_t)(m - 1) * 1024) + lane), rp); unpack8(*((const v4u*)(ws + WS_ZRK + (size_t)(m - 1) * 1024) + lane), kp); }
        else {
#pragma unroll
            for (int e = 0; e < 8; ++e) { rp[e] = 0.f; kp[e] = 0.f; } }
        v4u* aap = (v4u*)(dob + DO_AA + (size_t)m * 1024) + lane;
        unpack8(*aap, a);
        float kkv[8], kpr[8]; float ss = 0.f, bon = 0.f;
#pragma unroll
        for (int e = 0; e < 8; ++e) { const float rs = r[e] + mur[e] * (rp[e] - r[e]); const float ks = k[e] + muk[e] * (kp[e] - k[e]);
            kkv[e] = ks * kk_[e]; kpr[e] = ks * (1.0f + (a[e] - 1.0f) * ka_[e]); ss += kkv[e] * kkv[e]; bon += rs * kpr[e] * rk_[e]; }
        ss = sum8(ss); bon = sum8(bon);
        const float inv = 1.0f / fmaxf(sqrtf(ss), 1e-12f);
        float bb[8];
#pragma unroll
        for (int e = 0; e < 8; ++e) { kkv[e] *= inv; bb[e] = kkv[e] * a[e]; }
        *((v4u*)(ws + WS_KP + (size_t)m * 1024) + lane) = pack8(kpr);
        *((v4u*)(ws + WS_KN + (size_t)m * 1024) + lane) = pack8(kkv);
        *aap = pack8(bb);
        if ((lane & 7) == 0) ((float*)(ws + WS_BS))[(size_t)m * 8 + (lane >> 3)] = bon;
    }
}

constexpr int SC_CH = 32, SC_STRIDE = 5 * 64 + 32;
constexpr int SC_BUF_BYTES = SC_CH * SC_STRIDE * 4;
constexpr int SC_YB_BYTES = SC_CH * 32 * 4 * 4;
__device__ __forceinline__ float dpp_sum16(float x) {
    x += __builtin_bit_cast(float, __builtin_amdgcn_update_dpp(0, __builtin_bit_cast(int, x), 0xB1, 0xF, 0xF, true));
    x += __builtin_bit_cast(float, __builtin_amdgcn_update_dpp(0, __builtin_bit_cast(int, x), 0x4E, 0xF, 0xF, true));
    x += __builtin_bit_cast(float, __builtin_amdgcn_update_dpp(0, __builtin_bit_cast(int, x), 0x141, 0xF, 0xF, true));
    x += __builtin_bit_cast(float, __builtin_amdgcn_update_dpp(0, __builtin_bit_cast(int, x), 0x140, 0xF, 0xF, true));
    return x;
}
__device__ __forceinline__ float dpp_sum4(float x) {
    x += __builtin_bit_cast(float, __builtin_amdgcn_update_dpp(0, __builtin_bit_cast(int, x), 0xB1, 0xF, 0xF, true));
    x += __builtin_bit_cast(float, __builtin_amdgcn_update_dpp(0, __builtin_bit_cast(int, x), 0x4E, 0xF, 0xF, true));
    return x;
}
struct ScanVec { f32x4 xw, kn, bb, kp, rr; float va, vb; };
__device__ __forceinline__ void p5_scan_item(const Params& p, LAS unsigned char* lds, int item, int tid, int wave, int lane) {
    unsigned char* ws = p.ws; unsigned char* dob = (unsigned char*)p.out;
    const int half = item & 1, bh = item >> 1, b = bh >> 3, h = bh & 7;
    const size_t rowb = (size_t)b * TP;
    constexpr int T0 = 32, NCH = (TP - T0) / SC_CH;
    bf16* Y = (bf16*)(ws + WS_Y);
    LAS float* yb0 = (LAS float*)(lds + 2 * SC_BUF_BYTES);
    if (wave >= 4) {
        const int lt = tid - 256;
        const int st_step = lt >> 3, c8 = lt & 7;
        const size_t colb = (size_t)h * 64 + c8 * 8;
        const bf16* aXW = (const bf16*)(dob + DO_XW); const bf16* aKN = (const bf16*)(ws + WS_KN); const bf16* aBB = (const bf16*)(dob + DO_AA); const bf16* aKP = (const bf16*)(ws + WS_KP);
        const bf16* aR = (const bf16*)(ws + WS_ZRR); const bf16* aV = (const bf16*)(ws + WS_ZRV);
        float mur[8], muv[8];
#pragma unroll
        for (int e = 0; e < 8; ++e) { mur[e] = p.in[I_MU][h * 64 + c8 * 8 + e]; muv[e] = (c8 < 4) ? p.in[I_MU][1024 + h * 64 + half * 32 + c8 * 8 + e] : 0.f; }
        auto stage = [&](int t0, int bufi) {
            const size_t row = rowb + t0 + st_step;
            const v4u g0 = *(const v4u*)(aXW + row * 512 + colb), g1 = *(const v4u*)(aKN + row * 512 + colb), g2 = *(const v4u*)(aBB + row * 512 + colb), g3 = *(const v4u*)(aKP + row * 512 + colb);
            const v4u g4 = *(const v4u*)(aR + row * 512 + colb), g5 = *(const v4u*)(aR + (row - 1) * 512 + colb);
            v4u g6 = {0u, 0u, 0u, 0u}, g7 = {0u, 0u, 0u, 0u};
            if (c8 < 4) { const size_t cv = (size_t)h * 64 + half * 32 + c8 * 8; g6 = *(const v4u*)(aV + row * 512 + cv); g7 = *(const v4u*)(aV + (row - 1) * 512 + cv); }
            LAS float* d = (LAS float*)(lds + bufi * SC_BUF_BYTES) + st_step * SC_STRIDE + c8 * 8;
            float a[8], c[8];
            unpack8(g0, a); *(LAS f32x4*)(d + 0 * 64) = (f32x4){a[0], a[1], a[2], a[3]}; *(LAS f32x4*)(d + 0 * 64 + 4) = (f32x4){a[4], a[5], a[6], a[7]};
            unpack8(g1, a); *(LAS f32x4*)(d + 1 * 64) = (f32x4){a[0], a[1], a[2], a[3]}; *(LAS f32x4*)(d + 1 * 64 + 4) = (f32x4){a[4], a[5], a[6], a[7]};
            unpack8(g2, a); *(LAS f32x4*)(d + 2 * 64) = (f32x4){a[0], a[1], a[2], a[3]}; *(LAS f32x4*)(d + 2 * 64 + 4) = (f32x4){a[4], a[5], a[6], a[7]};
            unpack8(g3, a); *(LAS f32x4*)(d + 3 * 64) = (f32x4){a[0], a[1], a[2], a[3]}; *(LAS f32x4*)(d + 3 * 64 + 4) = (f32x4){a[4], a[5], a[6], a[7]};
            unpack8(g4, a); unpack8(g5, c);
#pragma unroll
            for (int e = 0; e < 8; ++e) a[e] = a[e] + mur[e] * (c[e] - a[e]);
            *(LAS f32x4*)(d + 4 * 64) = (f32x4){a[0], a[1], a[2], a[3]}; *(LAS f32x4*)(d + 4 * 64 + 4) = (f32x4){a[4], a[5], a[6], a[7]};
            if (c8 < 4) { unpack8(g6, a); unpack8(g7, c);
#pragma unroll
                for (int e = 0; e < 8; ++e) a[e] = a[e] + muv[e] * (c[e] - a[e]);
                *(LAS f32x4*)(d + 5 * 64) = (f32x4){a[0], a[1], a[2], a[3]}; *(LAS f32x4*)(d + 5 * 64 + 4) = (f32x4){a[4], a[5], a[6], a[7]}; }
        };
        auto flush = [&](int t0, int ybi) {
            const LAS f32x4* yq = (const LAS f32x4*)(lds + 2 * SC_BUF_BYTES + ybi * SC_YB_BYTES) + (lt >> 3) * 32 + (lt & 7) * 4;
            float y[4];
#pragma unroll
            for (int r = 0; r < 4; ++r) { const f32x4 q = yq[r]; y[r] = (q.x + q.y) + (q.z + q.w); }
            v2u o; o.x = pk2(y[0], y[1]); o.y = pk2(y[2], y[3]);
            *(v2u*)(Y + (rowb + t0 + (lt >> 3)) * 512 + h * 64 + half * 32 + 4 * (lt & 7)) = o;
        };
        stage(T0, 0);
        __syncthreads();
        for (int ch = 0; ch < NCH; ++ch) {
            if (ch + 1 < NCH) stage(T0 + (ch + 1) * SC_CH, (ch + 1) & 1);
            if (ch > 0) flush(T0 + (ch - 1) * SC_CH, (ch - 1) & 1);
            __syncthreads();
        }
        flush(T0 + (NCH - 1) * SC_CH, (NCH - 1) & 1);
    } else {
        const int rl = lane >> 4, kq = lane & 15, rowA = wave * 8 + rl, rowB = rowA + 4;
        f32x4 SA = {0.f, 0.f, 0.f, 0.f}, SB = {0.f, 0.f, 0.f, 0.f};
        auto ldv = [&](const LAS float* base, int s) { ScanVec v; const LAS float* q = base + s * SC_STRIDE + kq * 4;
            v.xw = *(const LAS f32x4*)(q); v.kn = *(const LAS f32x4*)(q + 64); v.bb = *(const LAS f32x4*)(q + 128); v.kp = *(const LAS f32x4*)(q + 192); v.rr = *(const LAS f32x4*)(q + 256);
            v.va = base[s * SC_STRIDE + 320 + rowA]; v.vb = base[s * SC_STRIDE + 320 + rowB]; return v; };
        auto step = [&](const ScanVec& v, LAS float* yb, int s) {
            float sa = SA.x * v.kn.x; sa = fmaf(SA.y, v.kn.y, sa); sa = fmaf(SA.z, v.kn.z, sa); sa = fmaf(SA.w, v.kn.w, sa);
            float sb = SB.x * v.kn.x; sb = fmaf(SB.y, v.kn.y, sb); sb = fmaf(SB.z, v.kn.z, sb); sb = fmaf(SB.w, v.kn.w, sb);
            sa = -dpp_sum16(sa); sb = -dpp_sum16(sb);
            SA = (SA - SA * v.xw) + sa * v.bb + v.va * v.kp;
            SB = (SB - SB * v.xw) + sb * v.bb + v.vb * v.kp;
            float ya = SA.x * v.rr.x; ya = fmaf(SA.y, v.rr.y, ya); ya = fmaf(SA.z, v.rr.z, ya); ya = fmaf(SA.w, v.rr.w, ya);
            float yv = SB.x * v.rr.x; yv = fmaf(SB.y, v.rr.y, yv); yv = fmaf(SB.z, v.rr.z, yv); yv = fmaf(SB.w, v.rr.w, yv);
            ya = dpp_sum4(ya); yv = dpp_sum4(yv);
            yb[(s * 32 + rowA) * 4 + (kq >> 2)] = ya; yb[(s * 32 + rowB) * 4 + (kq >> 2)] = yv;
        };
        __syncthreads();
        for (int ch = 0; ch < NCH; ++ch) {
            const LAS float* base = (const LAS float*)(lds + (ch & 1) * SC_BUF_BYTES);
            LAS float* yb = yb0 + (ch & 1) * (SC_YB_BYTES / 4);
            ScanVec v0 = ldv(base, 0), v1;
#pragma unroll 1
            for (int s = 0; s < SC_CH; s += 2) {
                v1 = ldv(base, s + 1);
                step(v0, yb, s);
                if (s + 2 < SC_CH) v0 = ldv(base, s + 2);
                step(v1, yb, s + 1);
            }
            __syncthreads();
        }
    }
    __syncthreads();
}

#ifndef SC2_DBG
#define SC2_DBG 0
#endif
namespace sc2 {
constexpr int S64 = 144, S32 = 80, SAAB = 36, SRHS = 68;
constexpr int AT = 0, RT = AT + 32 * S64, BT = RT + 32 * S64, KT = BT + 32 * S64, BH = KT + 32 * S64, KH = BH + 32 * S64, VV = KH + 32 * S64, PT = VV + 32 * S64,
              AAK = PT + 64 * S32, ARB = AAK + 32 * S32, ARK = ARB + 32 * S32, SB = ARK + 32 * S32, AAB = SB + 64 * S64, RHS = AAB + 32 * SAAB * 4, CL = RHS + 32 * SRHS * 4,
              GC = CL + 32 * 64 * 4, END = GC + 512;
static_assert(END <= 100000, "scan LDS");
}
__device__ __forceinline__ bf16x8 sc2_frag(LAS unsigned char* base, int stride, int row0, int k0, int lane) {
    return *(const LAS bf16x8*)(base + (row0 + (lane & 15)) * stride + (k0 + 8 * (lane >> 4)) * 2);
}
typedef short sc2_v4i16 __attribute__((ext_vector_type(4)));
__device__ __forceinline__ bf16x8 sc2_frag_tr(LAS unsigned char* base, int col0, int lane) {
    const int i = lane & 15, g = lane >> 4;
    LAS unsigned char* a = base + (8 * g + (i >> 2)) * sc2::S64 + (col0 + 4 * (i & 3)) * 2;
    const sc2_v4i16 lo = __builtin_amdgcn_ds_read_tr16_b64_v4i16((LAS sc2_v4i16*)a), hi = __builtin_amdgcn_ds_read_tr16_b64_v4i16((LAS sc2_v4i16*)(a + 4 * sc2::S64));
    return (bf16x8){lo[0], lo[1], lo[2], lo[3], hi[0], hi[1], hi[2], hi[3]};
}
#define SC2_BAR() asm volatile("s_waitcnt lgkmcnt(0)\n\ts_barrier" ::: "memory")
__device__ __forceinline__ void p5_scan_chunked(const Params& p, LAS unsigned char* lds, int bh, int tid, int wave, int lane) {
    using namespace sc2;
    unsigned char* ws = p.ws; unsigned char* dob = (unsigned char*)p.out;
    const int b = bh >> 3, h = bh & 7;
    const size_t rowb = (size_t)b * TP;
    constexpr int T0 = 32, NCH = (TP - T0) / 32;
    const bf16* aXW = (const bf16*)(dob + DO_XW); const bf16* aA = (const bf16*)(dob + DO_AA); const bf16* aG = (const bf16*)(dob + DO_GG);
    const bf16* aR = (const bf16*)(ws + WS_ZRR); const bf16* aK = (const bf16*)(ws + WS_ZRK); const bf16* aV = (const bf16*)(ws + WS_ZRV);
    bf16* Y = (bf16*)(ws + WS_Y);
    const int pt = tid >> 4, kc = tid & 15;
    const size_t kcol = (size_t)h * 64 + 4 * kc;
    float mur[4], muk[4], muv[4], kk_[4], ka_[4], rk_[4], lng[4], lnb[4];
#pragma unroll
    for (int e = 0; e < 4; ++e) { const int c = h * 64 + 4 * kc + e; mur[e] = p.in[I_MU][c]; muk[e] = p.in[I_MU][512 + c]; muv[e] = p.in[I_MU][1024 + c];
        kk_[e] = p.in[I_KK][c]; ka_[e] = p.in[I_KA][c]; rk_[e] = p.in[I_RK][c]; lng[e] = p.in[I_LNG][c]; lnb[e] = p.in[I_LNB][c]; }
    const int q = lane >> 4, c16 = lane & 15;
    const int m_ = wave >> 1, tr = wave & 1;
    const int tr2 = wave >> 2, vc2 = wave & 3;
    const int kt = wave >> 1, vh = wave & 1;
    pg8::f32x4 accS0 = {0.f, 0.f, 0.f, 0.f}, accS1 = {0.f, 0.f, 0.f, 0.f};
    for (int i = tid; i < 64 * S64 / 4; i += NTHREADS) ((LAS unsigned*)(lds + SB))[i] = 0u;
    v2u gxw, ga, gk0, gk1, gr0, gr1, gv0, gv1, ggn;
    auto prefetch = [&](int t0) { const unsigned off = (unsigned)(((unsigned)rowb + (unsigned)(t0 + pt)) * 512u + (unsigned)kcol) * 2u;
#define SC2_LD(base, o) (*(const v2u*)((const unsigned char*)(base) + (o)))
        gxw = SC2_LD(aXW, (unsigned)(((unsigned)rowb + (unsigned)(t0 + (lane & 31))) * 512u + (unsigned)(h * 64 + 8 * wave + 4 * (lane >> 5))) * 2u);
        ga = SC2_LD(aA, off); ggn = SC2_LD(aG, off);
        gk0 = SC2_LD(aK, off); gk1 = SC2_LD(aK, off - 1024u);
        gr0 = SC2_LD(aR, off); gr1 = SC2_LD(aR, off - 1024u);
        gv0 = SC2_LD(aV, off); gv1 = SC2_LD(aV, off - 1024u);
#undef SC2_LD
    };
    prefetch(T0);
    float e_vs[4] = {0.f, 0.f, 0.f, 0.f}, e_bs = 0.f; v2u e_gg = {0u, 0u};
    auto y_epilogue = [&](int t0p) {
        const f32x4 y4 = *(const LAS f32x4*)(lds + RHS + (pt * SRHS + 4 * kc) * 4);
        float y[4] = {y4.x, y4.y, y4.z, y4.w};
        const float mean = dpp_sum16((y[0] + y[1]) + (y[2] + y[3])) * (1.f / 64.f);
        float qq = 0.f;
#pragma unroll
        for (int e = 0; e < 4; ++e) { y[e] -= mean; qq += y[e] * y[e]; }
        const float rstd = __builtin_amdgcn_rsqf(dpp_sum16(qq) * (1.f / 64.f) + GN_EPS);
        const float g[4] = {bflo(e_gg.x), bfhi(e_gg.x), bflo(e_gg.y), bfhi(e_gg.y)};
        float o[4];
#pragma unroll
        for (int e = 0; e < 4; ++e) o[e] = (y[e] * rstd * lng[e] + lnb[e] + e_bs * e_vs[e]) * g[e];
        v2u w; w.x = pk2(o[0], o[1]); w.y = pk2(o[2], o[3]);
        *(v2u*)((unsigned char*)Y + (unsigned)(((unsigned)rowb + (unsigned)(t0p + pt)) * 512u + (unsigned)kcol) * 2u) = w;
    };
    for (int ch = 0; ch < NCH; ++ch) {
        const int t0 = T0 + ch * 32;
        { float lg[4] = {bflo(gxw.x), bfhi(gxw.x), bflo(gxw.y), bfhi(gxw.y)};
#pragma unroll
          for (int e = 0; e < 4; ++e) { float x = lg[e];
              x += __uint_as_float(__builtin_amdgcn_update_dpp(0u, __float_as_uint(x), 0x111, 0xF, 0xF, true));
              x += __uint_as_float(__builtin_amdgcn_update_dpp(0u, __float_as_uint(x), 0x112, 0xF, 0xF, true));
              x += __uint_as_float(__builtin_amdgcn_update_dpp(0u, __float_as_uint(x), 0x114, 0xF, 0xF, true));
              x += __uint_as_float(__builtin_amdgcn_update_dpp(0u, __float_as_uint(x), 0x118, 0xF, 0xF, true));
              x += __uint_as_float(__builtin_amdgcn_update_dpp(0u, __float_as_uint(x), 0x142, 0xA, 0xF, false));
              lg[e] = x; }
          const int cq = 8 * wave + 4 * (lane >> 5);
          *(LAS f32x4*)(lds + CL + ((lane & 31) * 64 + cq) * 4) = (f32x4){lg[0], lg[1], lg[2], lg[3]};
          if ((lane & 31) == 31) *(LAS f32x4*)(lds + GC + (ch & 1) * 256 + cq * 4) = (f32x4){__builtin_amdgcn_exp2f(lg[0]), __builtin_amdgcn_exp2f(lg[1]), __builtin_amdgcn_exp2f(lg[2]), __builtin_amdgcn_exp2f(lg[3])}; }
        SC2_BAR();
        if (ch > 0) y_epilogue(t0 - 32);
        {
            const f32x4 clt = *(const LAS f32x4*)(lds + CL + (pt * 64 + 4 * kc) * 4);
            f32x4 clp = {0.f, 0.f, 0.f, 0.f}; if (pt > 0) clp = *(const LAS f32x4*)(lds + CL + ((pt - 1) * 64 + 4 * kc) * 4);
            const f32x4 egc = *(const LAS f32x4*)(lds + GC + (ch & 1) * 256 + 16 * kc);
            const float k0[4] = {bflo(gk0.x), bfhi(gk0.x), bflo(gk0.y), bfhi(gk0.y)}, k1[4] = {bflo(gk1.x), bfhi(gk1.x), bflo(gk1.y), bfhi(gk1.y)}, av[4] = {bflo(ga.x), bfhi(ga.x), bflo(ga.y), bfhi(ga.y)};
            const float r0[4] = {bflo(gr0.x), bfhi(gr0.x), bflo(gr0.y), bfhi(gr0.y)}, r1[4] = {bflo(gr1.x), bfhi(gr1.x), bflo(gr1.y), bfhi(gr1.y)};
            const float v0[4] = {bflo(gv0.x), bfhi(gv0.x), bflo(gv0.y), bfhi(gv0.y)}, v1[4] = {bflo(gv1.x), bfhi(gv1.x), bflo(gv1.y), bfhi(gv1.y)};
            float kkv[4], kp[4], rsv[4], ss = 0.f, bon = 0.f;
#pragma unroll
            for (int e = 0; e < 4; ++e) { const float ks = k0[e] + muk[e] * (k1[e] - k0[e]); rsv[e] = r0[e] + mur[e] * (r1[e] - r0[e]); e_vs[e] = v0[e] + muv[e] * (v1[e] - v0[e]);
                kkv[e] = ks * kk_[e]; kp[e] = ks * (1.0f + (av[e] - 1.0f) * ka_[e]); ss += kkv[e] * kkv[e]; bon += rsv[e] * kp[e] * rk_[e]; }
            ss = dpp_sum16(ss); e_bs = dpp_sum16(bon); e_gg = ggn;
            const float inv = fminf(__builtin_amdgcn_rsqf(ss), 1e12f);
            float kn[4], bb[4];
#pragma unroll
            for (int e = 0; e < 4; ++e) { kn[e] = kkv[e] * inv; bb[e] = kn[e] * av[e]; }
            float at[4], rt[4], bt[4], ktl[4], bh_[4], kh_[4];
#pragma unroll
            for (int e = 0; e < 4; ++e) {
                const float gt = __builtin_amdgcn_exp2f(clt[e]), gp = __builtin_amdgcn_exp2f(clp[e]), gi = __builtin_amdgcn_exp2f(-clt[e]), gc = egc[e] * gi;
                const float rs = rsv[e];
                at[e] = -kn[e] * gp; rt[e] = rs * gt; bt[e] = bb[e] * gi; ktl[e] = kp[e] * gi; bh_[e] = bb[e] * gc; kh_[e] = kp[e] * gc;
            }
            v2u w;
            w.x = pk2(at[0], at[1]); w.y = pk2(at[2], at[3]); *(LAS v2u*)(lds + AT + pt * S64 + 8 * kc) = w;
            w.x = pk2(rt[0], rt[1]); w.y = pk2(rt[2], rt[3]); *(LAS v2u*)(lds + RT + pt * S64 + 8 * kc) = w;
            w.x = pk2(bt[0], bt[1]); w.y = pk2(bt[2], bt[3]); *(LAS v2u*)(lds + BT + pt * S64 + 8 * kc) = w;
            w.x = pk2(ktl[0], ktl[1]); w.y = pk2(ktl[2], ktl[3]); *(LAS v2u*)(lds + KT + pt * S64 + 8 * kc) = w;
            w.x = pk2(bh_[0], bh_[1]); w.y = pk2(bh_[2], bh_[3]); *(LAS v2u*)(lds + BH + pt * S64 + 8 * kc) = w;
            w.x = pk2(kh_[0], kh_[1]); w.y = pk2(kh_[2], kh_[3]); *(LAS v2u*)(lds + KH + pt * S64 + 8 * kc) = w;
            w.x = pk2(e_vs[0], e_vs[1]); w.y = pk2(e_vs[2], e_vs[3]); *(LAS v2u*)(lds + VV + pt * S64 + 8 * kc) = w;
        }
        if (ch + 1 < NCH) prefetch(t0 + 32);
        SC2_BAR();
        pg8::f32x4 accR, accY;
        {
            LAS unsigned char* Ab = lds + ((m_ < 2) ? AT : RT); LAS unsigned char* Bb = lds + ((m_ & 1) ? KT : BT);
            const bf16x8 a0 = sc2_frag(Ab, S64, 16 * tr, 0, lane), a1 = sc2_frag(Ab, S64, 16 * tr, 32, lane);
            const int incl = (m_ >= 2) ? 1 : 0;
            LAS unsigned char* dstb = lds + (m_ == 1 ? AAK : (m_ == 2 ? ARB : ARK));
            pg8::f32x4 cc[2];
#pragma unroll
            for (int tc = 0; tc < 2; ++tc) {
                const bf16x8 b0 = sc2_frag(Bb, S64, 16 * tc, 0, lane), b1 = sc2_frag(Bb, S64, 16 * tc, 32, lane);
                pg8::f32x4 c = {0.f, 0.f, 0.f, 0.f};
                c = __builtin_amdgcn_mfma_f32_16x16x32_bf16(a0, b0, c, 0, 0, 0); c = __builtin_amdgcn_mfma_f32_16x16x32_bf16(a1, b1, c, 0, 0, 0);
                const int i = 16 * tc + c16;
#pragma unroll
                for (int r = 0; r < 4; ++r) { const int t = 16 * tr + 4 * q + r; c[r] = (i < t + incl) ? c[r] : 0.f; }
                cc[tc] = c;
            }
            if (m_ == 0) {
#pragma unroll
                for (int tc = 0; tc < 2; ++tc)
#pragma unroll
                    for (int r = 0; r < 4; ++r) *(LAS float*)(lds + AAB + ((16 * tc + c16) * SAAB + 16 * tr + 4 * q + r) * 4) = cc[tc][r];
            } else {
#pragma unroll
                for (int tc = 0; tc < 2; ++tc)
#pragma unroll
                    for (int r = 0; r < 4; ++r) *(LAS bf16*)(dstb + (16 * tr + 4 * q + r) * S32 + 2 * (16 * tc + c16)) = (bf16)f2bf(cc[tc][r]);
            }
            const bf16x8 sb0 = sc2_frag(lds + SB, S64, 16 * vc2, 0, lane), sb1 = sc2_frag(lds + SB, S64, 16 * vc2, 32, lane);
            const bf16x8 ra0 = sc2_frag(lds + AT, S64, 16 * tr2, 0, lane), ra1 = sc2_frag(lds + AT, S64, 16 * tr2, 32, lane);
            const bf16x8 ya0 = sc2_frag(lds + RT, S64, 16 * tr2, 0, lane), ya1 = sc2_frag(lds + RT, S64, 16 * tr2, 32, lane);
            accR = (pg8::f32x4){0.f, 0.f, 0.f, 0.f}; accY = accR;
            accR = __builtin_amdgcn_mfma_f32_16x16x32_bf16(ra0, sb0, accR, 0, 0, 0); accR = __builtin_amdgcn_mfma_f32_16x16x32_bf16(ra1, sb1, accR, 0, 0, 0);
            accY = __builtin_amdgcn_mfma_f32_16x16x32_bf16(ya0, sb0, accY, 0, 0, 0); accY = __builtin_amdgcn_mfma_f32_16x16x32_bf16(ya1, sb1, accY, 0, 0, 0);
        }
        SC2_BAR();
        {
            const bf16x8 bv = sc2_frag_tr(lds + VV, 16 * vc2, lane);
            accR = __builtin_amdgcn_mfma_f32_16x16x32_bf16(sc2_frag(lds + AAK, S32, 16 * tr2, 0, lane), bv, accR, 0, 0, 0);
            accY = __builtin_amdgcn_mfma_f32_16x16x32_bf16(sc2_frag(lds + ARK, S32, 16 * tr2, 0, lane), bv, accY, 0, 0, 0);
#pragma unroll
            for (int r = 0; r < 4; ++r) *(LAS float*)(lds + RHS + ((16 * tr2 + 4 * q + r) * SRHS + 16 * vc2 + c16) * 4) = accR[r];
        }
        SC2_BAR();
        if (wave < 4) {
            const int v = 16 * wave + (lane >> 2), part = lane & 3;
            typedef float sc2_f2 __attribute__((ext_vector_type(2)));
            sc2_f2 rh[2][2];
#pragma unroll
            for (int m = 0; m < 2; ++m)
#pragma unroll
                for (int j = 0; j < 4; ++j) rh[m][j >> 1][j & 1] = *(const LAS float*)(lds + RHS + ((4 * (4 * m + part) + j) * SRHS + v) * 4);
            unsigned pk[16]; float prev = 0.f;
            const LAS float* acol = (const LAS float*)(lds + AAB) + 4 * part;
#pragma unroll
            for (int t = 0; t < 32; ++t) {
                const int g = t >> 2, m = g >> 2, j = t & 3;
                const float mine = rh[m][j >> 1][j & 1];
                const int mi_ = (int)__float_as_uint(mine); int bc_;
                if ((g & 3) == 0) bc_ = __builtin_amdgcn_update_dpp(0, mi_, 0x00, 0xF, 0xF, true); else if ((g & 3) == 1) bc_ = __builtin_amdgcn_update_dpp(0, mi_, 0x55, 0xF, 0xF, true);
                else if ((g & 3) == 2) bc_ = __builtin_amdgcn_update_dpp(0, mi_, 0xAA, 0xF, 0xF, true); else bc_ = __builtin_amdgcn_update_dpp(0, mi_, 0xFF, 0xF, 0xF, true);
                const float pt_ = __uint_as_float((unsigned)bc_);
                if (t < 31) {
#pragma unroll
                    for (int m2 = 0; m2 < 2; ++m2) {
                        if (4 * m2 + 3 < g) continue;
                        const f32x4 w = *(const LAS f32x4*)(acol + t * SAAB + 16 * m2);
                        const sc2_f2 p2 = {pt_, pt_};
                        rh[m2][0] = __builtin_elementwise_fma((sc2_f2){w.x, w.y}, p2, rh[m2][0]); rh[m2][1] = __builtin_elementwise_fma((sc2_f2){w.z, w.w}, p2, rh[m2][1]);
                    }
                }
                if (t & 1) pk[t >> 1] = pk2(prev, pt_); else prev = pt_;
                if ((t & 3) == 3) asm volatile("" ::: "memory");
            }
            if (part == 0) {
#pragma unroll
                for (int g = 0; g < 4; ++g) { v4u w; w.x = pk[4 * g]; w.y = pk[4 * g + 1]; w.z = pk[4 * g + 2]; w.w = pk[4 * g + 3]; *(LAS v4u*)(lds + PT + v * S32 + 16 * g) = w; } }
        }
        SC2_BAR();
        {
            accY = __builtin_amdgcn_mfma_f32_16x16x32_bf16(sc2_frag(lds + ARB, S32, 16 * tr2, 0, lane), sc2_frag(lds + PT, S32, 16 * vc2, 0, lane), accY, 0, 0, 0);
#pragma unroll
            for (int r = 0; r < 4; ++r) *(LAS float*)(lds + RHS + ((16 * tr2 + 4 * q + r) * SRHS + 16 * vc2 + c16) * 4) = accY[r];
            const f32x4 gcv = *(const LAS f32x4*)(lds + GC + (ch & 1) * 256 + (16 * kt + 4 * q) * 4);
            const bf16x8 ab = sc2_frag_tr(lds + BH, 16 * kt, lane), ak = sc2_frag_tr(lds + KH, 16 * kt, lane);
            accS0[0] *= gcv.x; accS0[1] *= gcv.y; accS0[2] *= gcv.z; accS0[3] *= gcv.w; accS1[0] *= gcv.x; accS1[1] *= gcv.y; accS1[2] *= gcv.z; accS1[3] *= gcv.w;
            accS0 = __builtin_amdgcn_mfma_f32_16x16x32_bf16(ab, sc2_frag(lds + PT, S32, 32 * vh, 0, lane), accS0, 0, 0, 0);
            accS0 = __builtin_amdgcn_mfma_f32_16x16x32_bf16(ak, sc2_frag_tr(lds + VV, 32 * vh, lane), accS0, 0, 0, 0);
            accS1 = __builtin_amdgcn_mfma_f32_16x16x32_bf16(ab, sc2_frag(lds + PT, S32, 32 * vh + 16, 0, lane), accS1, 0, 0, 0);
            accS1 = __builtin_amdgcn_mfma_f32_16x16x32_bf16(ak, sc2_frag_tr(lds + VV, 32 * vh + 16, lane), accS1, 0, 0, 0);
            v2u w; w.x = pk2(accS0[0], accS0[1]); w.y = pk2(accS0[2], accS0[3]);
            *(LAS v2u*)(lds + SB + (32 * vh + c16) * S64 + (16 * kt + 4 * q) * 2) = w;
            w.x = pk2(accS1[0], accS1[1]); w.y = pk2(accS1[2], accS1[3]);
            *(LAS v2u*)(lds + SB + (32 * vh + 16 + c16) * S64 + (16 * kt + 4 * q) * 2) = w;
        }
    }
    __syncthreads();
    y_epilogue(T0 + (NCH - 1) * 32);
    __syncthreads();
}

__device__ __forceinline__ void p6_prep3(const Params& p, int vcu, int G, int wave, int lane) {
    unsigned char* ws = p.ws; unsigned char* dob = (unsigned char*)p.out;
    const int gw = vcu * NWAVES + wave, NGW = G * NWAVES;
    float lg[8], lb[8], muv[8];
#pragma unroll
    for (int e = 0; e < 8; ++e) { const int c = lane * 8 + e; lg[e] = p.in[I_LNG][c]; lb[e] = p.in[I_LNB][c]; muv[e] = p.in[I_MU][1024 + c]; }
    for (int m = gw; m < R; m += NGW) {
        const int b = m / TP, pp = m - b * TP;
        v4u* yp = (v4u*)(ws + WS_Y + (size_t)m * 1024) + lane;
        if (pp < 48) { *yp = (v4u){0u, 0u, 0u, 0u}; continue; }
        float y[8], v[8], vp[8], g[8];
        unpack8(*yp, y); unpack8(*((const v4u*)(ws + WS_ZRV + (size_t)m * 1024) + lane), v); unpack8(*((const v4u*)(ws + WS_ZRV + (size_t)(m - 1) * 1024) + lane), vp);
        unpack8(*((const v4u*)(dob + DO_GG + (size_t)m * 1024) + lane), g);
        float s = 0.f;
#pragma unroll
        for (int e = 0; e < 8; ++e) s += y[e];
        const float mean = sum8(s) * (1.f / 64.f); float q = 0.f;
#pragma unroll
        for (int e = 0; e < 8; ++e) { y[e] -= mean; q += y[e] * y[e]; }
        const float rstd = 1.0f / sqrtf(sum8(q) * (1.f / 64.f) + GN_EPS);
        const float bon = ((const float*)(ws + WS_BS))[(size_t)m * 8 + (lane >> 3)];
#pragma unroll
        for (int e = 0; e < 8; ++e) { const float vs = v[e] + muv[e] * (vp[e] - v[e]); y[e] = (y[e] * rstd * lg[e] + lb[e] + bon * vs) * g[e]; }
        *yp = pack8(y);
    }
}
template <int NR>
__device__ __forceinline__ void norm2_rows(const Params& p, int m0, int mstride, int lane) {
    unsigned char* ws = p.ws;
    const f32x4* g4 = (const f32x4*)p.in[I_N2G] + 4 * lane;
    f32x4 v[NR][4]; float s[NR], mx[NR];
#pragma unroll
    for (int r = 0; r < NR; ++r) { const v4u* xr = (const v4u*)(ws + WS_H1 + (size_t)(m0 + r * mstride) * 2048) + 2 * lane;
        const v4u a = xr[0], b = xr[1]; float f[8];
        unpack8(a, f); v[r][0] = (f32x4){f[0], f[1], f[2], f[3]}; v[r][1] = (f32x4){f[4], f[5], f[6], f[7]};
        unpack8(b, f); v[r][2] = (f32x4){f[0], f[1], f[2], f[3]}; v[r][3] = (f32x4){f[4], f[5], f[6], f[7]}; }
#pragma unroll
    for (int r = 0; r < NR; ++r) { s[r] = 0.f;
#pragma unroll
        for (int j = 0; j < 4; ++j) s[r] += (v[r][j].x * v[r][j].x + v[r][j].y * v[r][j].y) + (v[r][j].z * v[r][j].z + v[r][j].w * v[r][j].w); }
#pragma unroll
    for (int r = 0; r < NR; ++r) s[r] = wave_sum(s[r]);
#pragma unroll
    for (int r = 0; r < NR; ++r) { const float rs = __builtin_amdgcn_rsqf(s[r] * (1.f / 1024.f) + NORM_EPS); mx[r] = 0.f;
#pragma unroll
        for (int j = 0; j < 4; ++j) { const f32x4 g = g4[j]; v[r][j].x *= rs * g.x; v[r][j].y *= rs * g.y; v[r][j].z *= rs * g.z; v[r][j].w *= rs * g.w;
#ifdef PQ_BF16
            ((unsigned long long*)(ws + WS_XN2 + (size_t)(m0 + r * mstride) * 2048) + 4 * lane)[j] = (unsigned long long)pk2(v[r][j].x, v[r][j].y) | ((unsigned long long)pk2(v[r][j].z, v[r][j].w) << 32);
#endif
            mx[r] = fmaxf(mx[r], fmaxf(fmaxf(fabsf(v[r][j].x), fabsf(v[r][j].y)), fmaxf(fabsf(v[r][j].z), fabsf(v[r][j].w)))); } }
#pragma unroll
    for (int r = 0; r < NR; ++r) mx[r] = wave_max(mx[r]);
#pragma unroll
    for (int r = 0; r < NR; ++r) { const int m = m0 + r * mstride; const float inv = mx[r] > 0.f ? 127.0f / mx[r] : 0.f;
        unsigned* xq = (unsigned*)(ws + WS_XQ + (size_t)m * 1024) + 4 * lane;
#pragma unroll
        for (int j = 0; j < 4; ++j) xq[j] = q8x4(v[r][j].x, v[r][j].y, v[r][j].z, v[r][j].w, inv);
        if (lane == 0) ((float*)(ws + WS_SX))[m] = mx[r] > 0.f ? mx[r] * (1.0f / 127.0f) : 1.0f; }
}
__device__ __forceinline__ void p9_norm2(const Params& p, int vcu, int G, int wave, int lane) {
    const int gw = vcu * NWAVES + wave, NGW = G * NWAVES;
    for (int m = gw; m < NTOK; m += 4 * NGW) norm2_rows<4>(p, m, NGW, lane);
}

typedef __bf16 bf16x2_t __attribute__((ext_vector_type(2)));
__device__ __forceinline__ unsigned mono(float f) { return __builtin_bit_cast(unsigned, f); }
__device__ __forceinline__ float unmono(unsigned m) { return __builtin_bit_cast(float, m); }
constexpr unsigned KEY_NEG_INF = 0xFF800000u;
__device__ __forceinline__ unsigned kmax(unsigned a, unsigned b) { unsigned r; asm("v_max_f32 %0, %1, %2" : "=v"(r) : "v"(a), "v"(b)); return r; }
__device__ __forceinline__ unsigned kmin(unsigned a, unsigned b) { unsigned r; asm("v_min_f32 %0, %1, %2" : "=v"(r) : "v"(a), "v"(b)); return r; }
__device__ __forceinline__ void ce_desc(unsigned& a, unsigned& b) { const unsigned hi = kmax(a, b), lo = kmin(a, b); a = hi; b = lo; }
template <int BASE, int N> __device__ __forceinline__ void bitonic_sort_desc(unsigned (&v)[N]) {
#pragma unroll
    for (int p = 1; p < 16; p <<= 1)
#pragma unroll
        for (int k = p; k >= 1; k >>= 1)
#pragma unroll
            for (int j = k % p; j <= 15 - k; j += 2 * k)
#pragma unroll
                for (int i = 0; i < k; ++i)
                    if (i + j + k <= 15 && (i + j) / (2 * p) == (i + j + k) / (2 * p)) ce_desc(v[BASE + i + j], v[BASE + i + j + k]);
}
template <int A, int B, int N> __device__ __forceinline__ void merge_top16(unsigned (&v)[N]) {
#pragma unroll
    for (int i = 0; i < 16; ++i) v[A + i] = kmax(v[A + i], v[B + 15 - i]);
#pragma unroll
    for (int j = 8; j > 0; j >>= 1)
#pragma unroll
        for (int i = 0; i < 16; ++i) { const int l = i ^ j; if (l > i) ce_desc(v[A + i], v[A + l]); }
}
constexpr int KS_STRIDE = 272;
constexpr int RT_KS_BYTES = 256 * KS_STRIDE;
constexpr int RT_TAB_WORDS = 33;
__device__ __forceinline__ void p11_route(const Params& p, LAS unsigned char* lds, int bid, int G, int tid, int wave, int lane) {
    unsigned char* ws = p.ws;
    for (int i = tid; i < 256 * 16; i += NTHREADS) { const int row = i >> 4, ch = i & 15; *(LAS v4u*)(lds + row * KS_STRIDE + ch * 16) = *((const v4u*)(ws + WS_KS) + i); }
    __syncthreads();
    LAS unsigned* tab = (LAS unsigned*)(lds + RT_KS_BYTES) + (wave * 64 + lane) * RT_TAB_WORDS;
    const int r32 = lane & 31, hi = lane >> 5;
    const bf16* PQ = (const bf16*)(ws + WS_PQ);
    unsigned short* IDS = (unsigned short*)(ws + WS_IDS); float* GATES = (float*)(ws + WS_GATES);
    for (int task = bid * 64 + wave; task < (NTOK / 32) * 8; task += ((task & 63) + NWAVES < 64) ? NWAVES : G * 64 - 64 + NWAVES) {
        const int tb = task >> 3, h = task & 7;
        const int token = tb * 32 + r32;
        unsigned v[128];
        {
            const bf16* qrow = PQ + (size_t)token * 2048 + h * 256 + hi * 8;
#pragma unroll
            for (int t = 0; t < 4; ++t) {
                f32x16v acc[2];
#pragma unroll
                for (int w = 0; w < 2; ++w) {
                    f32x16v c = {};
                    const LAS unsigned char* kb = lds + (w * 128 + t * 32 + r32) * KS_STRIDE + hi * 16;
#pragma unroll
                    for (int s = 0; s < 8; ++s) { const bf16x8 a = *(const LAS bf16x8*)(kb + s * 32); const bf16x8 qf = *(const bf16x8*)(qrow + w * 128 + 16 * s); c = __builtin_amdgcn_mfma_f32_32x32x16_bf16(a, qf, c, 0, 0, 0); }
                    acc[w] = c;
                }
#pragma unroll
                for (int r = 0; r < 16; ++r) {
                    const float xa = acc[0][r], xb = acc[1][r];
                    auto rr = __builtin_amdgcn_permlane32_swap(__float_as_uint(xa), __float_as_uint(xb), false, false);
                    const unsigned r0 = rr[0], r1 = rr[1];
                    const int cr = (r & 3) + 8 * (r >> 2);
                    v[t * 16 + r] = (mono(__uint_as_float(r0)) & ~0x7Fu) | (unsigned)(32 * t + cr);
                    v[64 + t * 16 + r] = (mono(__uint_as_float(r1)) & ~0x7Fu) | (unsigned)(32 * t + cr + 4);
                }
            }
        }
        bitonic_sort_desc<0>(v); bitonic_sort_desc<16>(v); bitonic_sort_desc<32>(v); bitonic_sort_desc<48>(v);
        bitonic_sort_desc<64>(v); bitonic_sort_desc<80>(v); bitonic_sort_desc<96>(v); bitonic_sort_desc<112>(v);
        merge_top16<0, 16>(v); merge_top16<32, 48>(v); merge_top16<64, 80>(v); merge_top16<96, 112>(v);
        merge_top16<0, 32>(v); merge_top16<64, 96>(v);
        merge_top16<0, 64>(v);
        unsigned T[16], U[16];
#pragma unroll
        for (int i = 0; i < 16; ++i) { auto rr = __builtin_amdgcn_permlane32_swap(v[i], v[i], false, false); T[i] = v[i]; U[i] = hi ? rr[0] : rr[1]; }
        { const int bT = hi ? 16 : 0, bU = hi ? 0 : 16;
#pragma unroll
          for (int i = 0; i < 16; ++i) { tab[bT + i] = T[i] & 0x7Fu; tab[bU + i] = U[i] & 0x7Fu; } }
        float tv[16], uv[16];
#pragma unroll
        for (int i = 0; i < 16; ++i) { tv[i] = unmono(T[i] & ~0x7Fu); uv[i] = unmono(U[i] & ~0x7Fu); }
        unsigned c[32];
        {
            float uvs[16];
#pragma unroll
            for (int m = 0; m < 16; ++m) uvs[m] = hi ? (m < 15 ? uv[m + 1] : -3.0e38f) : uv[m];
            int n = 0;
#pragma unroll
            for (int i = 0; i < 4; ++i)
#pragma unroll
                for (int j = i; j < 16; ++j) if ((i + 1) * (j + 1) <= 16) {
                    const float s = tv[i] + uvs[j];
                    const unsigned paylo = (unsigned)((i << 4) | j), payhi = (j + 1 < 16) ? (unsigned)(((j + 1) << 4) | i) : 0u;
                    c[n++] = (mono(s) & ~0xFFu) | (hi ? payhi : paylo);
                }
        }
        {
            unsigned x0 = c[23], x1 = c[24], x2 = c[25], y = c[26];
            ce_desc(x2, y); ce_desc(x1, x2); ce_desc(x0, x1);
            c[23] = KEY_NEG_INF; c[24] = KEY_NEG_INF; c[25] = KEY_NEG_INF; c[26] = KEY_NEG_INF; c[27] = KEY_NEG_INF; c[28] = y; c[29] = x2; c[30] = x1; c[31] = x0;
#pragma unroll
            for (int j = 8; j > 0; j >>= 1)
#pragma unroll
                for (int i = 0; i < 16; ++i) { const int l = i ^ j; if (l > i) ce_desc(c[16 + i], c[16 + l]); }
        }
        merge_top16<0, 16>(c);
        unsigned W[32];
#pragma unroll
        for (int i = 0; i < 16; ++i) { auto rr = __builtin_amdgcn_permlane32_swap(c[i], c[i], false, false); W[i] = rr[0]; W[16 + i] = rr[1]; }
        merge_top16<0, 16>(W);
        asm volatile("s_waitcnt lgkmcnt(0)" ::: "memory");
        if (!hi) {
            int ids[16];
#pragma unroll
            for (int k = 0; k < 16; ++k) ids[k] = (int)(tab[(W[k] >> 4) & 15u] * 128u + tab[16 + (W[k] & 15u)]);
            unsigned short* o = IDS + (size_t)token * 128 + h * 16;
#pragma unroll
            for (int k = 0; k < 16; k += 8) *(v4u*)(o + k) = (v4u){(unsigned)ids[k] | ((unsigned)ids[k + 1] << 16), (unsigned)ids[k + 2] | ((unsigned)ids[k + 3] << 16), (unsigned)ids[k + 4] | ((unsigned)ids[k + 5] << 16), (unsigned)ids[k + 6] | ((unsigned)ids[k + 7] << 16)};
        } else {
            float e[16]; const float s0 = unmono(W[0] & ~0xFFu); float sum = 0.f;
#pragma unroll
            for (int k = 0; k < 16; ++k) { e[k] = __expf(unmono(W[k] & ~0xFFu) - s0); sum += e[k]; }
            const float inv = 1.0f / sum;
            float* o = GATES + (size_t)token * 128 + h * 16;
#pragma unroll
            for (int k = 0; k < 16; k += 4) *(f32x4*)(o + k) = (f32x4){e[k] * inv, e[k + 1] * inv, e[k + 2] * inv, e[k + 3] * inv};
        }
        asm volatile("s_waitcnt lgkmcnt(0)" ::: "memory");
    }
}

constexpr size_t WS_PART = 420 * MiB;
__device__ __forceinline__ int dpp_isum8(int x) {
    x += __builtin_amdgcn_update_dpp(0, x, 0xB1, 0xF, 0xF, true);
    x += __builtin_amdgcn_update_dpp(0, x, 0x4E, 0xF, 0xF, true);
    x += __builtin_amdgcn_update_dpp(0, x, 0x141, 0xF, 0xF, true);
    return x;
}
struct A12Meta { v4u iv0, iv1, xs; };
__device__ __forceinline__ void a12_meta(A12Meta& m, const unsigned short* IDS, const unsigned char* XQ, int t, int eg) {
    const v4u* idp = (const v4u*)(IDS + (size_t)t * 128 + 16 * eg);
    m.iv0 = idp[0]; m.iv1 = idp[1];
    m.xs = *(const v4u*)(XQ + (size_t)t * 1024);
}
__device__ __forceinline__ void a12_rows(const A12Meta& m, const unsigned char* Us, v4u (&u)[16]) {
    int ids[16];
    ids[0] = (int)(m.iv0.x & 0xffffu); ids[1] = (int)(m.iv0.x >> 16); ids[2] = (int)(m.iv0.y & 0xffffu); ids[3] = (int)(m.iv0.y >> 16);
    ids[4] = (int)(m.iv0.z & 0xffffu); ids[5] = (int)(m.iv0.z >> 16); ids[6] = (int)(m.iv0.w & 0xffffu); ids[7] = (int)(m.iv0.w >> 16);
    ids[8] = (int)(m.iv1.x & 0xffffu); ids[9] = (int)(m.iv1.x >> 16); ids[10] = (int)(m.iv1.y & 0xffffu); ids[11] = (int)(m.iv1.y >> 16);
    ids[12] = (int)(m.iv1.z & 0xffffu); ids[13] = (int)(m.iv1.z >> 16); ids[14] = (int)(m.iv1.w & 0xffffu); ids[15] = (int)(m.iv1.w >> 16);
#pragma unroll
    for (int i = 0; i < 16; ++i) u[i] = *(const v4u*)(Us + (size_t)ids[i] * 1024);
}
__device__ __forceinline__ unsigned a12_compute(const v4u (&u)[16], const v4u xs, const int cj) {
    const int xx = (int)xs.x, xy = (int)xs.y, xz = (int)xs.z, xw = (int)xs.w;
    int k0 = 0, k1 = 0;
#pragma unroll
    for (int i = 0; i < 16; ++i) {
        const int ux = (int)u[i].x, uy = (int)u[i].y, uz = (int)u[i].z, uw = (int)u[i].w;
        int d = __builtin_amdgcn_sdot4(ux, xx, 0, false); d = __builtin_amdgcn_sdot4(uy, xy, d, false); d = __builtin_amdgcn_sdot4(uz, xz, d, false); d = __builtin_amdgcn_sdot4(uw, xw, d, false);
        d = dpp_isum8(d);
        if (i < 8) k0 = (cj == i) ? d : k0; else k1 = (cj == i - 8) ? d : k1;
    }
    return pk2((float)k0, (float)k1);
}
__device__ __forceinline__ void p12a_partial(const Params& p, int bid, int G, int wave, int lane) {
    unsigned char* ws = p.ws;
    const int s = bid & 7, wx = (bid >> 3) * NWAVES + wave, NWX = (G >> 3) * NWAVES;
    const int eg = lane >> 3, cj = lane & 7;
    const unsigned char* XQ = ws + WS_XQ + 128 * s + 16 * cj; const unsigned short* IDS = (const unsigned short*)(ws + WS_IDS);
    const unsigned char* Us = ws + WS_U8 + 128 * s + 16 * cj;
    unsigned* outp = (unsigned*)((bf16*)(ws + WS_PART) + (size_t)s * NTOK * 128 + 16 * eg + 2 * cj);
    if (wx >= NTOK) return;
    A12Meta m0, m1; v4u va[16], vb[16];
    a12_meta(m0, IDS, XQ, wx, eg);
    a12_rows(m0, Us, va);
    { int tn = (wx + NWX < NTOK) ? wx + NWX : wx; asm volatile("" : "+s"(tn)); a12_meta(m1, IDS, XQ, tn, eg); }
    __builtin_amdgcn_sched_barrier(0);
    unsigned res_prev = 0u; int t_prev = wx;
    for (int t = wx; t < NTOK; t += 2 * NWX) {
        {
            a12_rows(m1, Us, vb);
            __builtin_nontemporal_store(res_prev, outp + (size_t)t_prev * 64);
            const v4u cx = m0.xs;
            { int tn = (t + 2 * NWX < NTOK) ? t + 2 * NWX : t; asm volatile("" : "+s"(tn)); a12_meta(m0, IDS, XQ, tn, eg); }
            __builtin_amdgcn_sched_barrier(0);
            res_prev = a12_compute(va, cx, cj); t_prev = t;
        }
        if (t + NWX < NTOK) {
            a12_rows(m0, Us, va);
            __builtin_nontemporal_store(res_prev, outp + (size_t)t_prev * 64);
            const v4u cx = m1.xs;
            { int tn = (t + 3 * NWX < NTOK) ? t + 3 * NWX : t; asm volatile("" : "+s"(tn)); a12_meta(m1, IDS, XQ, tn, eg); }
            __builtin_amdgcn_sched_barrier(0);
            res_prev = a12_compute(vb, cx, cj); t_prev = t + NWX;
        }
    }
    __builtin_nontemporal_store(res_prev, outp + (size_t)t_prev * 64);
}
constexpr size_t WS_WQ = 84 * MiB;
constexpr size_t WS_WSC = 92 * MiB;
__device__ __forceinline__ float dpp_max16(float x) {
    x = fmaxf(x, __builtin_bit_cast(float, __builtin_amdgcn_update_dpp(0, __builtin_bit_cast(int, x), 0xB1, 0xF, 0xF, true)));
    x = fmaxf(x, __builtin_bit_cast(float, __builtin_amdgcn_update_dpp(0, __builtin_bit_cast(int, x), 0x4E, 0xF, 0xF, true)));
    x = fmaxf(x, __builtin_bit_cast(float, __builtin_amdgcn_update_dpp(0, __builtin_bit_cast(int, x), 0x141, 0xF, 0xF, true)));
    x = fmaxf(x, __builtin_bit_cast(float, __builtin_amdgcn_update_dpp(0, __builtin_bit_cast(int, x), 0x140, 0xF, 0xF, true)));
    return x;
}
__device__ __forceinline__ void p12b_combine(const Params& p, LAS unsigned char* lds, int vcu, int G, int tid, int wave, int lane) {
    unsigned char* ws = p.ws;
    const int gw = vcu * NWAVES + wave, NGW = G * NWAVES;
    const bf16* PART = (const bf16*)(ws + WS_PART); const float* GW = (const float*)(ws + WS_GATES); const unsigned short* IDS = (const unsigned short*)(ws + WS_IDS);
    LAS const float* SU = (LAS const float*)lds; LAS const float* SV = SU + 16384;
    for (int i = tid; i < 8192; i += NTHREADS) { const int tb = i >> 12, q = i & 4095; *((LAS f32x4*)lds + i) = *((const f32x4*)(ws + (tb ? WS_SV : WS_SU)) + q); }
    __syncthreads();
    const int hh = lane >> 3, e0 = 16 * hh + (lane & 7), e1 = e0 + 8;
    constexpr int NT = 8;
    for (int t0 = gw; t0 < NTOK; t0 += NT * NGW) {
        float a0[NT], a1[NT], g0[NT], g1[NT], sx[NT]; int id0[NT], id1[NT];
#pragma unroll
        for (int r = 0; r < NT; ++r) { const int t = t0 + r * NGW;
            const int tt = t < NTOK ? t : gw;
            a0[r] = 0.f; a1[r] = 0.f;
#pragma unroll
            for (int s = 0; s < 8; ++s) { const unsigned w = *((const unsigned*)(PART + ((size_t)s * NTOK + tt) * 128) + lane); a0[r] += bflo(w); a1[r] += bfhi(w); }
            id0[r] = IDS[(size_t)tt * 128 + e0]; id1[r] = IDS[(size_t)tt * 128 + e1];
            sx[r] = ((const float*)(ws + WS_SX))[tt]; g0[r] = GW[(size_t)tt * 128 + e0]; g1[r] = GW[(size_t)tt * 128 + e1]; }
#pragma unroll
        for (int r = 0; r < NT; ++r) { const int t = t0 + r * NGW; if (t >= NTOK) continue;
            const float h0 = a0[r] * SU[id0[r]] * sx[r], h1 = a1[r] * SU[id1[r]] * sx[r];
            const float w0 = g0[r] * 0.5f * h0 * (1.0f + erff(h0 * 0.70710678118654752f)) * SV[id0[r]];
            const float w1 = g1[r] * 0.5f * h1 * (1.0f + erff(h1 * 0.70710678118654752f)) * SV[id1[r]];
            float mx = fmaxf(fabsf(w0), fabsf(w1));
            mx = fmaxf(mx, dppf<0xB1>(mx)); mx = fmaxf(mx, dppf<0x4E>(mx)); mx = fmaxf(mx, dppf<0x141>(mx));
            const float iq = mx > 0.f ? 127.0f / mx : 0.f;
            signed char* wq = (signed char*)(ws + WS_WQ) + (size_t)t * 128;
            wq[e0] = (signed char)(int)rintf(w0 * iq); wq[e1] = (signed char)(int)rintf(w1 * iq);
            if ((lane & 7) == 0) ((float*)(ws + WS_WSC))[(size_t)t * 8 + hh] = mx * (1.0f / 127.0f); }
    }
}
struct C12Meta { v4u iv0, iv1, wqv; float wsc; unsigned hb; };
__device__ __forceinline__ void c12_meta(C12Meta& m, const unsigned short* IDS, const unsigned char* WQ, const float* WSC, const unsigned char* ws, int t, int eg, int ocol) {
    const v4u* idp = (const v4u*)(IDS + (size_t)t * 128 + 16 * eg);
    m.iv0 = idp[0]; m.iv1 = idp[1];
    m.wqv = *(const v4u*)(WQ + (size_t)t * 128 + 16 * eg);
    m.wsc = WSC[(size_t)t * 8 + eg];
    m.hb = *(const unsigned*)((const bf16*)(ws + WS_H1) + (size_t)t * 1024 + ocol);
}
__device__ __forceinline__ void c12_rows(const C12Meta& m, const unsigned char* Vs, v4u (&vv)[16]) {
    int ids[16];
    ids[0] = (int)(m.iv0.x & 0xffffu); ids[1] = (int)(m.iv0.x >> 16); ids[2] = (int)(m.iv0.y & 0xffffu); ids[3] = (int)(m.iv0.y >> 16);
    ids[4] = (int)(m.iv0.z & 0xffffu); ids[5] = (int)(m.iv0.z >> 16); ids[6] = (int)(m.iv0.w & 0xffffu); ids[7] = (int)(m.iv0.w >> 16);
    ids[8] = (int)(m.iv1.x & 0xffffu); ids[9] = (int)(m.iv1.x >> 16); ids[10] = (int)(m.iv1.y & 0xffffu); ids[11] = (int)(m.iv1.y >> 16);
    ids[12] = (int)(m.iv1.z & 0xffffu); ids[13] = (int)(m.iv1.z >> 16); ids[14] = (int)(m.iv1.w & 0xffffu); ids[15] = (int)(m.iv1.w >> 16);
#pragma unroll
    for (int i = 0; i < 16; ++i) vv[i] = *(const v4u*)(Vs + (size_t)ids[i] * 1024);
}
typedef float c12f2 __attribute__((ext_vector_type(2)));
__device__ __forceinline__ c12f2 c12_compute(const v4u (&vv)[16], const v4u wqv, const float wsc, const unsigned hb, const int b3) {
    int acc[16];
#pragma unroll
    for (int k = 0; k < 16; ++k) acc[k] = 0;
    const unsigned wqd[4] = {wqv.x, wqv.y, wqv.z, wqv.w};
#pragma unroll
    for (int j = 0; j < 4; ++j) {
        const unsigned r0[4] = {vv[4 * j].x, vv[4 * j].y, vv[4 * j].z, vv[4 * j].w}, r1[4] = {vv[4 * j + 1].x, vv[4 * j + 1].y, vv[4 * j + 1].z, vv[4 * j + 1].w};
        const unsigned r2[4] = {vv[4 * j + 2].x, vv[4 * j + 2].y, vv[4 * j + 2].z, vv[4 * j + 2].w}, r3[4] = {vv[4 * j + 3].x, vv[4 * j + 3].y, vv[4 * j + 3].z, vv[4 * j + 3].w};
#pragma unroll
        for (int d = 0; d < 4; ++d) {
            const unsigned l01 = __builtin_amdgcn_perm(r1[d], r0[d], 0x05010400u), h01 = __builtin_amdgcn_perm(r1[d], r0[d], 0x07030602u);
            const unsigned l23 = __builtin_amdgcn_perm(r3[d], r2[d], 0x05010400u), h23 = __builtin_amdgcn_perm(r3[d], r2[d], 0x07030602u);
            const unsigned c0 = __builtin_amdgcn_perm(l23, l01, 0x05040100u), c1 = __builtin_amdgcn_perm(l23, l01, 0x07060302u);
            const unsigned c2 = __builtin_amdgcn_perm(h23, h01, 0x05040100u), c3 = __builtin_amdgcn_perm(h23, h01, 0x07060302u);
            acc[4 * d + 0] = __builtin_amdgcn_sdot4((int)c0, (int)wqd[j], acc[4 * d + 0], false); acc[4 * d + 1] = __builtin_amdgcn_sdot4((int)c1, (int)wqd[j], acc[4 * d + 1], false);
            acc[4 * d + 2] = __builtin_amdgcn_sdot4((int)c2, (int)wqd[j], acc[4 * d + 2], false); acc[4 * d + 3] = __builtin_amdgcn_sdot4((int)c3, (int)wqd[j], acc[4 * d + 3], false);
        }
    }
    float o[16];
#pragma unroll
    for (int k = 0; k < 16; ++k) o[k] = (float)acc[k] * wsc;
    float r8[8], r4[4], r2v[2];
#pragma unroll
    for (int j = 0; j < 8; ++j) { auto rr = __builtin_amdgcn_permlane32_swap(__float_as_uint(o[j]), __float_as_uint(o[8 + j]), false, false); r8[j] = __uint_as_float(rr[0]) + __uint_as_float(rr[1]); }
#pragma unroll
    for (int j = 0; j < 4; ++j) { auto rr = __builtin_amdgcn_permlane16_swap(__float_as_uint(r8[j]), __float_as_uint(r8[4 + j]), false, false); r4[j] = __uint_as_float(rr[0]) + __uint_as_float(rr[1]); }
#pragma unroll
    for (int j = 0; j < 2; ++j) { const float keep = b3 ? r4[2 + j] : r4[j], send = b3 ? r4[j] : r4[2 + j]; r2v[j] = keep + __uint_as_float(__builtin_amdgcn_update_dpp(0u, __float_as_uint(send), 0x128, 0xF, 0xF, true)); }
    return (c12f2){bflo(hb) + r2v[0], bfhi(hb) + r2v[1]};
}
template <bool DRY> __device__ __forceinline__ void p12c_output(const Params& p, int bid, int G, int wave, int lane) {
    unsigned char* ws = p.ws;
    const int s = bid & 7, wx = (bid >> 3) * NWAVES + wave, NWX = (G >> 3) * NWAVES;
    const int eg = lane >> 3, cj = lane & 7;
    const int b5 = (lane >> 5) & 1, b4 = (lane >> 4) & 1, b3 = (lane >> 3) & 1;
    const unsigned short* IDS = (const unsigned short*)(ws + WS_IDS); const unsigned char* WQ = ws + WS_WQ; const float* WSC = (const float*)(ws + WS_WSC);
    const unsigned char* Vs = ws + WS_V8 + 128 * s + 16 * cj;
    const int ocol = 128 * s + 16 * cj + 8 * b5 + 4 * b4 + 2 * b3;
    float* outp = (DRY ? (float*)(ws + WS_PART) : p.out) + ocol;
    if (wx >= NTOK) return;
    C12Meta m0, m1; v4u va[16], vb[16];
    c12_meta(m0, IDS, WQ, WSC, ws, wx, eg, ocol);
    c12_rows(m0, Vs, va);
    { int tn = (wx + NWX < NTOK) ? wx + NWX : wx; asm volatile("" : "+s"(tn)); c12_meta(m1, IDS, WQ, WSC, ws, tn, eg, ocol); }
    __builtin_amdgcn_sched_barrier(0);
    c12f2 res_prev = {0.f, 0.f}; int t_prev = wx;
    for (int t = wx; t < NTOK; t += 2 * NWX) {
        {
            c12_rows(m1, Vs, vb);
            __builtin_nontemporal_store(res_prev, (c12f2*)(outp + (size_t)t_prev * 1024));
            const v4u cw = m0.wqv; const float cs = m0.wsc; const unsigned ch = m0.hb;
            { int tn = (t + 2 * NWX < NTOK) ? t + 2 * NWX : t; asm volatile("" : "+s"(tn)); c12_meta(m0, IDS, WQ, WSC, ws, tn, eg, ocol); }
            __builtin_amdgcn_sched_barrier(0);
            res_prev = c12_compute(va, cw, cs, ch, b3); t_prev = t;
        }
        if (t + NWX < NTOK) {
            c12_rows(m0, Vs, va);
            __builtin_nontemporal_store(res_prev, (c12f2*)(outp + (size_t)t_prev * 1024));
            const v4u cw = m1.wqv; const float cs = m1.wsc; const unsigned ch = m1.hb;
            { int tn = (t + 3 * NWX < NTOK) ? t + 3 * NWX : t; asm volatile("" : "+s"(tn)); c12_meta(m1, IDS, WQ, WSC, ws, tn, eg, ocol); }
            __builtin_amdgcn_sched_barrier(0);
            res_prev = c12_compute(vb, cw, cs, ch, b3); t_prev = t + NWX;
        }
    }
    __builtin_nontemporal_store(res_prev, (c12f2*)(outp + (size_t)t_prev * 1024));
}

#if DIAG
constexpr size_t WS_DIAG = 1006 * MiB;
constexpr size_t WS_DSAVE = 1007 * MiB;
__device__ __forceinline__ unsigned dhash(unsigned x) { x ^= x >> 16; x *= 0x7feb352dU; x ^= x >> 15; x *= 0x846ca68bU; x ^= x >> 16; return x; }
__device__ __forceinline__ float bf2f(bf16 b) { return __builtin_bit_cast(float, (unsigned)b << 16); }
__device__ __forceinline__ float rbf(float x) { return bf2f((bf16)f2bf(x)); }
__device__ __forceinline__ void diag_report(const Params& p, int stage, float err) {
    if (!(err == err)) err = 1e30f;
#pragma unroll
    for (int o = 1; o < 64; o <<= 1) err = fmaxf(err, __shfl_xor(err, o));
    int t_ = threadIdx.x; asm volatile("" : "+v"(t_)); if ((t_ & 63) == 0) atomicMax((unsigned*)(p.ws + WS_DIAG) + stage, __builtin_bit_cast(unsigned, err));
}
#define DG_IDS() int tid_ = threadIdx.x; asm volatile("" : "+v"(tid_)); const int tid = tid_, lane = tid & 63; int G_ = gridDim.x; asm volatile("" : "+s"(G_)); const int gt = blockIdx.x * NTHREADS + tid, NGT = G_ * NTHREADS; const int gwv = gt >> 6, NGWV = NGT >> 6; (void)lane; (void)gwv; (void)NGWV; (void)NGT
__device__ __forceinline__ float relerr(float got, float ref, float fl) { return fabsf(got - ref) / (fabsf(ref) + fl); }

__device__ __forceinline__ void dg_p0(const Params& p) {
    DG_IDS(); unsigned char* ws = p.ws; float e1 = 0.f, e2 = 0.f;
    for (int s = gwv; s < 4096; s += NGWV) {
        const int m = dhash(s * 7 + 1) % R; const int b = m / TP, pp = m - b * TP;
        const bf16* xn = (const bf16*)(ws + WS_XN) + (size_t)m * 1024;
        if (pp < 48) { for (int c = lane; c < 1024; c += 64) e1 = fmaxf(e1, fabsf(bf2f(xn[c]))); continue; }
        const float* xr = (pp < 64) ? p.in[I_META] + (size_t)(pp - 48) * 1024 : p.in[I_X] + ((size_t)b * SEQ + (pp - 64)) * 1024;
        float ss = 0.f; for (int c = lane; c < 1024; c += 64) ss += xr[c] * xr[c];
        ss = wave_sum(ss); const float rs = 1.0f / sqrtf(ss / 1024.f + NORM_EPS);
        for (int c = lane; c < 1024; c += 64) e1 = fmaxf(e1, relerr(bf2f(xn[c]), xr[c] * rs * p.in[I_N1G][c], 0.05f));
    }
    for (int s = gt; s < 200000; s += NGT) {
        const unsigned hsh = dhash(s * 3 + 5); const int k = hsh & 1023, n = (hsh >> 10) % N1; const int sc = win_src_col(n);
        const float ref = sc >= 0 ? p.in[I_WIN][(size_t)k * IN_COLS + sc] : 0.f;
        e2 = fmaxf(e2, fabsf(bf2f(((const bf16*)(ws + WS_WTIN))[(size_t)n * 1024 + k]) - rbf(ref)));
        const int n2 = (hsh >> 10) & 2047;
        e2 = fmaxf(e2, fabsf(bf2f(((const bf16*)(ws + WS_WTQ))[(size_t)n2 * 1024 + k]) - rbf(p.in[I_PWQ][(size_t)k * 2048 + n2])));
        const int n3 = n2 & 1023, k3 = k & 511;
        e2 = fmaxf(e2, fabsf(bf2f(((const bf16*)(ws + WS_WTFOX))[(size_t)n3 * 512 + k3]) - rbf(p.in[I_WFOX][(size_t)k3 * 1024 + n3])));
        e2 = fmaxf(e2, fabsf(bf2f(((const bf16*)(ws + WS_WTRWKV))[(size_t)n3 * 512 + k3]) - rbf(p.in[I_WRWKV][(size_t)k3 * 1024 + n3])));
        e2 = fmaxf(e2, fabsf(bf2f(((const bf16*)(ws + WS_WTOUT))[(size_t)n3 * 1024 + k]) - rbf(p.in[I_WOUT][(size_t)k * 1024 + n3])));
        const size_t ei = (size_t)(hsh % (16384u * 1024u)); const int er = (int)(ei >> 10);
        { const float sc = ((const float*)(ws + WS_SU))[er]; const float dq = (float)((const signed char*)(ws + WS_U8))[ei] * sc; e2 = fmaxf(e2, fmaxf(fabsf(dq - p.in[I_PU][ei]) - 0.51f * sc, 0.f)); }
        { const float sc = ((const float*)(ws + WS_SV))[er]; const float dq = ((float)((const unsigned char*)(ws + WS_V8))[ei] - 128.f) * sc; e2 = fmaxf(e2, fmaxf(fabsf(dq - p.in[I_PV][ei]) - 0.51f * sc, 0.f)); }
    }
    diag_report(p, 1, e1 / 0.03f); diag_report(p, 2, e2 / 1e-6f);
}
__device__ __forceinline__ float dg_dot(const bf16* A, size_t row, const bf16* Bt, size_t n, int K) {
    const bf16* a = A + row * K; const bf16* b = Bt + n * K; float s = 0.f;
    for (int k = 0; k < K; k += 8) { float x[8], y[8]; unpack8(*(const v4u*)(a + k), x); unpack8(*(const v4u*)(b + k), y);
#pragma unroll
        for (int e = 0; e < 8; ++e) s = fmaf(x[e], y[e], s); }
    return s;
}
__device__ __forceinline__ void dg_gemm1(const Params& p) {
    DG_IDS(); unsigned char* ws = p.ws; float e = 0.f;
    for (int s = gt; s < 262144; s += NGT) {
        const unsigned hsh = dhash(s * 11 + 3); const int row = hsh % R, n = dhash(hsh) % N1;
        const float ref = dg_dot((const bf16*)(ws + WS_XN), row, (const bf16*)(ws + WS_WTIN), n, 1024);
        float got, want;
        if (n < 3584) { got = bf2f(((const bf16*)(ws + WS_F))[(size_t)(n >> 9) * ((size_t)R * 512) + (size_t)row * 512 + (n & 511)]); want = ref; }
        else { got = bf2f(((const bf16*)(ws + WS_ZG))[(size_t)row * 2048 + (n - 3584)]); want = 1.0f / (1.0f + expf(-ref)); }
        e = fmaxf(e, relerr(got, want, 0.25f));
    }
    diag_report(p, 3, e / 0.02f);
}
__device__ __forceinline__ void dg_p2(const Params& p) {
    DG_IDS(); unsigned char* ws = p.ws; float e = 0.f;
    for (int s = gt; s < 262144; s += NGT) {
        const unsigned hsh = dhash(s * 13 + 7); const int m = hsh % R, c = dhash(hsh) % 296; const int pp = m % TP;
        const bf16* zm = (const bf16*)(ws + WS_ZM);
        const float z = bf2f(zm[(size_t)m * 512 + c]);
        if (c >= 288) { const float x = z + p.in[I_FBIAS][c - 288]; const float want = -log1pf(expf(-x)); e = fmaxf(e, relerr(((const float*)(ws + WS_LF))[(size_t)m * 8 + (c - 288)], want, 0.01f)); continue; }
        const float zp = pp > 0 ? bf2f(zm[(size_t)(m - 1) * 512 + c]) : 0.f; const float mu = p.in[I_MU][1536 + c];
        const float zs = z + mu * (zp - z);
        if (c < 64) e = fmaxf(e, relerr(bf2f(((const bf16*)(ws + WS_LA))[(size_t)m * 128 + c]), tanhf(zs), 0.1f));
        else if (c < 128) e = fmaxf(e, relerr(bf2f(((const bf16*)(ws + WS_LA))[(size_t)m * 128 + c]), zs, 0.1f));
        else e = fmaxf(e, relerr(bf2f(((const bf16*)(ws + WS_LG))[(size_t)m * 256 + (c - 128)]), 1.0f / (1.0f + expf(-zs)), 0.1f));
        if (pp >= 48) { const int h = c & 7; float sq = 0.f, sk = 0.f;
            for (int d = 0; d < 64; ++d) { const float q = bf2f(((const bf16*)(ws + WS_FQ))[(size_t)m * 512 + h * 64 + d]) / (p.in[I_FQN][h * 64 + d] * attn_body::C2); sq += q * q;
                const float k = bf2f(((const bf16*)(ws + WS_FK))[(size_t)m * 512 + h * 64 + d]) / p.in[I_FKN][h * 64 + d]; sk += k * k; }
            e = fmaxf(e, fabsf(sq / 64.f - 1.f)); e = fmaxf(e, fabsf(sk / 64.f - 1.f)); }
    }
    diag_report(p, 4, e / 0.03f);
}
__device__ __forceinline__ void dg_p3(const Params& p) {
    DG_IDS(); unsigned char* ws = p.ws; unsigned char* dob = (unsigned char*)p.out; float e5 = 0.f, e6 = 0.f;
    for (int s = gt; s < 131072; s += NGT) {
        const unsigned hsh = dhash(s * 17 + 9); const int seq = hsh & 127, pp = (hsh >> 7) % TP; const int b = seq >> 3, h = seq & 7;
        const float* kb = (const float*)(ws + WS_KB) + (size_t)seq * TP; const float lf = ((const float*)(ws + WS_LF))[((size_t)b * TP + pp) * 8 + h];
        if (pp < 48) e5 = fmaxf(e5, kb[pp] < -1e29f ? 0.f : 1.f);
        else if (pp == 48) e5 = fmaxf(e5, fabsf(kb[pp] + lf * LOG2E));
        else e5 = fmaxf(e5, fabsf((kb[pp] - kb[pp - 1]) + lf * LOG2E));
        const int m = dhash(hsh) % R, c = dhash(hsh + 1) % 1536;
        const bf16* la = (const bf16*)(ws + WS_LA) + (size_t)m * 128; const bf16* lg = (const bf16*)(ws + WS_LG) + (size_t)m * 256;
        if (c < 512) { float a = p.in[I_W0][c]; for (int k = 0; k < 64; ++k) a += bf2f(la[k]) * rbf(p.in[I_WUP][k * 512 + c]);
            const float w = -log1pf(expf(-a)) - 0.5f; const float want = 1.0f - expf(-expf(w));
            e6 = fmaxf(e6, relerr(bf2f(((const bf16*)(dob + DO_XW))[(size_t)m * 512 + c]), want, 0.002f)); }
        else if (c < 1024) { float a = p.in[I_A0][c - 512]; for (int k = 0; k < 64; ++k) a += bf2f(la[64 + k]) * rbf(p.in[I_AUP][k * 512 + (c - 512)]);
            e6 = fmaxf(e6, relerr(bf2f(((const bf16*)(dob + DO_AA))[(size_t)m * 512 + (c - 512)]), 1.0f / (1.0f + expf(-a)), 0.05f)); }
        else { float a = 0.f; for (int k = 0; k < 160; ++k) a += bf2f(lg[k]) * rbf(p.in[I_GUP][k * 512 + (c - 1024)]);
            e6 = fmaxf(e6, relerr(bf2f(((const bf16*)(dob + DO_GG))[(size_t)m * 512 + (c - 1024)]), a, 0.1f)); }
    }
    diag_report(p, 5, e5 / 1e-3f); diag_report(p, 6, e6 / 0.03f);
}
constexpr int DG_NS4 = 2048;
__device__ __forceinline__ void dg_p4_pre(const Params& p) {
    DG_IDS(); unsigned char* dob = (unsigned char*)p.out; float* sv = (float*)(p.ws + WS_DSAVE);
    for (int s = gt; s < DG_NS4 * 64; s += NGT) { const int i = s >> 6, d = s & 63; const unsigned hsh = dhash(i * 19 + 11); const int m = hsh % R, h = (hsh >> 20) & 7;
        sv[s] = bf2f(((const bf16*)(dob + DO_AA))[(size_t)m * 512 + h * 64 + d]); }
}
__device__ __forceinline__ void dg_p4_post(const Params& p) {
    DG_IDS(); unsigned char* ws = p.ws; unsigned char* dob = (unsigned char*)p.out; const float* sv = (const float*)(ws + WS_DSAVE); float e = 0.f;
    for (int i = gwv; i < DG_NS4; i += NGWV) {
        const unsigned hsh = dhash(i * 19 + 11); const int m = hsh % R, h = (hsh >> 20) & 7; const int pp = m % TP; const int c = h * 64 + lane;
        const float a = sv[i * 64 + lane];
        const float r0 = bf2f(((const bf16*)(ws + WS_ZRR))[(size_t)m * 512 + c]), k0 = bf2f(((const bf16*)(ws + WS_ZRK))[(size_t)m * 512 + c]);
        const float r1 = pp > 0 ? bf2f(((const bf16*)(ws + WS_ZRR))[(size_t)(m - 1) * 512 + c]) : 0.f, k1 = pp > 0 ? bf2f(((const bf16*)(ws + WS_ZRK))[(size_t)(m - 1) * 512 + c]) : 0.f;
        const float rs = r0 + p.in[I_MU][c] * (r1 - r0), ks = k0 + p.in[I_MU][512 + c] * (k1 - k0);
        const float kk = ks * p.in[I_KK][c], kp = ks * (1.0f + (a - 1.0f) * p.in[I_KA][c]);
        const float nrm = fmaxf(sqrtf(wave_sum(kk * kk)), 1e-12f); const float kn = kk / nrm, bb = kn * a; const float bs = wave_sum(rs * kp * p.in[I_RK][c]);
        e = fmaxf(e, relerr(bf2f(((const bf16*)(ws + WS_KP))[(size_t)m * 512 + c]), kp, 0.1f));
        e = fmaxf(e, relerr(bf2f(((const bf16*)(ws + WS_KN))[(size_t)m * 512 + c]), kn, 0.02f));
        e = fmaxf(e, relerr(bf2f(((const bf16*)(dob + DO_AA))[(size_t)m * 512 + c]), bb, 0.02f));
        e = fmaxf(e, relerr(((const float*)(ws + WS_BS))[(size_t)m * 8 + h], bs, 0.1f));
    }
    diag_report(p, 7, e / 0.03f);
}
constexpr int DG_NS8 = 1024;
__device__ __forceinline__ void dg_attn_sample(int i, int& b, int& h, int& t) { const unsigned hsh = dhash(i * 23 + 13); b = hsh & 15; h = (hsh >> 4) & 7; t = (hsh >> 8) & 4095; if (i < 8) t = (i & 1) ? 4095 - (i >> 1) : (i >> 1); }
__device__ __forceinline__ void dg_attn_pre(const Params& p) {
    DG_IDS(); float* sv = (float*)(p.ws + WS_DSAVE + 512 * 1024);
    for (int s = gt; s < DG_NS8 * 64; s += NGT) { const int i = s >> 6, d = s & 63; int b, h, t; dg_attn_sample(i, b, h, t);
        sv[s] = bf2f(((const bf16*)(p.ws + WS_FQ))[((size_t)b * TP + 64 + t) * 512 + h * 64 + d]); }
}
__device__ __forceinline__ void dg_attn_post(const Params& p) {
    DG_IDS(); unsigned char* ws = p.ws; const float* sv = (const float*)(ws + WS_DSAVE + 512 * 1024); float e = 0.f;
    for (int i = gwv; i < DG_NS8; i += NGWV) {
        int b, h, t; dg_attn_sample(i, b, h, t);
        const int npos = 64 + t;
        const float* kb = (const float*)(ws + WS_KB) + (size_t)(b * 8 + h) * TP;
        const bf16* K = (const bf16*)(ws + WS_FK) + (size_t)b * TP * 512 + h * 64; const bf16* V = (const bf16*)(ws + WS_FV) + (size_t)b * TP * 512 + h * 64;
        float mx = -1e38f;
        for (int j = 48 + lane; j <= npos; j += 64) { float s = 0.f; for (int d = 0; d < 64; ++d) s += sv[i * 64 + d] * bf2f(K[(size_t)j * 512 + d]); s += kb[j]; mx = fmaxf(mx, s); }
        for (int o = 1; o < 64; o <<= 1) mx = fmaxf(mx, __shfl_xor(mx, o));
        float l = 0.f, acc = 0.f;
        for (int j = 48; j <= npos; ++j) { float s = 0.f; for (int d = 0; d < 64; ++d) s += sv[i * 64 + d] * bf2f(K[(size_t)j * 512 + d]); const float pj = exp2f(s + kb[j] - mx); l += pj; acc += pj * bf2f(V[(size_t)j * 512 + lane]); }
        const float want = acc / l; const float got = bf2f(((const bf16*)(ws + WS_FQ))[((size_t)b * TP + 64 + t) * 512 + h * 64 + lane]);
        e = fmaxf(e, fabsf(got - want) / (fabsf(want) + 0.05f));
    }
    diag_report(p, 8, e / 0.05f);
}
__device__ __forceinline__ void dg_scan(const Params& p, LAS unsigned char* lds) {
    DG_IDS(); unsigned char* ws = p.ws; unsigned char* dob = (unsigned char*)p.out; float e = 0.f;
    if (gwv < 4) {
        const int bh = (gwv * 37 + 5) & 127, b = bh >> 3, h = bh & 7; const size_t rowb = (size_t)b * TP; const int cb = h * 64;
        LAS float* S = (LAS float*)lds + (gwv * 64 + lane) * 65;
        for (int k = 0; k < 64; ++k) S[k] = 0.f;
        const bf16* aXW = (const bf16*)(dob + DO_XW); const bf16* aA = (const bf16*)(dob + DO_AA); const bf16* aG = (const bf16*)(dob + DO_GG);
        const bf16* aR = (const bf16*)(ws + WS_ZRR); const bf16* aK = (const bf16*)(ws + WS_ZRK); const bf16* aV = (const bf16*)(ws + WS_ZRV);
        const float muv = p.in[I_MU][1024 + cb + lane];
#ifndef DG_SCAN_MAXPP
#define DG_SCAN_MAXPP TP
#endif
#pragma unroll 1
        for (int pp = 48; pp < DG_SCAN_MAXPP; ++pp) {
            const size_t ro = (rowb + pp) * 512 + cb;
            const float v0 = bf2f(aV[ro + lane]), v1 = bf2f(aV[ro - 512 + lane]); const float vv = v0 + muv * (v1 - v0);
            float ss = 0.f;
#pragma unroll 2
            for (int k = 0; k < 64; ++k) { const float k0 = bf2f(aK[ro + k]), k1 = bf2f(aK[ro - 512 + k]); const float ks = k0 + p.in[I_MU][512 + cb + k] * (k1 - k0); const float kk = ks * p.in[I_KK][cb + k]; ss += kk * kk; }
            const float inv = 1.0f / fmaxf(sqrtf(ss), 1e-12f);
            float sa = 0.f;
#pragma unroll 2
            for (int k = 0; k < 64; ++k) { const float k0 = bf2f(aK[ro + k]), k1 = bf2f(aK[ro - 512 + k]); const float ks = k0 + p.in[I_MU][512 + cb + k] * (k1 - k0); sa += S[k] * (ks * p.in[I_KK][cb + k] * inv); }
            sa = -sa; float y = 0.f, bon = 0.f;
#pragma unroll 2
            for (int k = 0; k < 64; ++k) { const float k0 = bf2f(aK[ro + k]), k1 = bf2f(aK[ro - 512 + k]); const float ks = k0 + p.in[I_MU][512 + cb + k] * (k1 - k0); const float a = bf2f(aA[ro + k]);
                const float kn = ks * p.in[I_KK][cb + k] * inv, kp = ks * (1.0f + (a - 1.0f) * p.in[I_KA][cb + k]);
                const float dec = 1.0f - bf2f(aXW[ro + k]); const float sn = S[k] * dec + sa * (kn * a) + vv * kp; S[k] = sn;
                const float r0 = bf2f(aR[ro + k]), r1 = bf2f(aR[ro - 512 + k]); const float rs = r0 + p.in[I_MU][cb + k] * (r1 - r0); y += sn * rs; bon += rs * kp * p.in[I_RK][cb + k]; }
            const float mean = wave_sum(y) * (1.f / 64.f); const float var = wave_sum((y - mean) * (y - mean)) * (1.f / 64.f);
            const float want = ((y - mean) / sqrtf(var + GN_EPS) * p.in[I_LNG][cb + lane] + p.in[I_LNB][cb + lane] + bon * vv) * bf2f(aG[ro + lane]);
            const float got = bf2f(((const bf16*)(ws + WS_Y))[ro + lane]);
            const float rms = sqrtf(wave_sum(want * want) * (1.f / 64.f));
            e = fmaxf(e, fabsf(got - want) / (fabsf(want) + 0.5f * rms + 0.02f));
        }
    }
    diag_report(p, 9, e / 0.15f);
}
__device__ __forceinline__ void dg_p6_pre(const Params& p) {
    DG_IDS(); float* sv = (float*)(p.ws + WS_DSAVE + 768 * 1024);
    for (int s = gt; s < DG_NS4 * 64; s += NGT) { const int i = s >> 6, d = s & 63; const unsigned hsh = dhash(i * 29 + 17); const int m = hsh % R, h = (hsh >> 20) & 7;
        sv[s] = bf2f(((const bf16*)(p.ws + WS_Y))[(size_t)m * 512 + h * 64 + d]); }
}
__device__ __forceinline__ void dg_p6_post(const Params& p) {
    DG_IDS(); unsigned char* ws = p.ws; unsigned char* dob = (unsigned char*)p.out; const float* sv = (const float*)(ws + WS_DSAVE + 768 * 1024); float e = 0.f;
    for (int i = gwv; i < DG_NS4; i += NGWV) {
        const unsigned hsh = dhash(i * 29 + 17); const int m = hsh % R, h = (hsh >> 20) & 7; const int pp = m % TP; const int c = h * 64 + lane;
        if (pp < 48) continue;
        const float y = sv[i * 64 + lane]; const float mean = wave_sum(y) / 64.f; const float var = wave_sum((y - mean) * (y - mean)) / 64.f;
        const float gn = (y - mean) / sqrtf(var + GN_EPS) * p.in[I_LNG][c] + p.in[I_LNB][c];
        const float v0 = bf2f(((const bf16*)(ws + WS_ZRV))[(size_t)m * 512 + c]), v1 = bf2f(((const bf16*)(ws + WS_ZRV))[(size_t)(m - 1) * 512 + c]);
        const float vs = v0 + p.in[I_MU][1024 + c] * (v1 - v0);
        const float want = (gn + ((const float*)(ws + WS_BS))[(size_t)m * 8 + h] * vs) * bf2f(((const bf16*)(dob + DO_GG))[(size_t)m * 512 + c]);
        e = fmaxf(e, relerr(bf2f(((const bf16*)(ws + WS_Y))[(size_t)m * 512 + c]), want, 0.1f));
    }
    diag_report(p, 10, e / 0.03f);
}
__device__ __forceinline__ void dg_mix(const Params& p, int stage) {
    DG_IDS(); unsigned char* ws = p.ws; float e = 0.f;
    for (int s = gt; s < 131072; s += NGT) {
        const unsigned hsh = dhash(s * 31 + 19 + stage); const int row = hsh % R, c = dhash(hsh) & 1023;
        float want = dg_dot((const bf16*)(ws + WS_FQ), row, (const bf16*)(ws + WS_WTFOX), c, 512) * bf2f(((const bf16*)(ws + WS_ZG))[(size_t)row * 2048 + c]);
        if (stage == 12) want = rbf(want) + dg_dot((const bf16*)(ws + WS_Y), row, (const bf16*)(ws + WS_WTRWKV), c, 512) * bf2f(((const bf16*)(ws + WS_ZG))[(size_t)row * 2048 + 1024 + c]);
        e = fmaxf(e, relerr(bf2f(((const bf16*)(ws + WS_MIX))[(size_t)row * 1024 + c]), want, 0.1f));
    }
    diag_report(p, stage, e / 0.03f);
}
__device__ __forceinline__ void dg_out(const Params& p) {
    DG_IDS(); unsigned char* ws = p.ws; float e = 0.f;
    for (int s = gt; s < 131072; s += NGT) {
        const unsigned hsh = dhash(s * 37 + 23); const int tok = hsh & 65535, c = dhash(hsh) & 1023; const int b = tok >> 12, t = tok & 4095;
        const float want = p.in[I_X][(size_t)tok * 1024 + c] + dg_dot((const bf16*)(ws + WS_MIX), (size_t)b * TP + 64 + t, (const bf16*)(ws + WS_WTOUT), c, 1024);
        e = fmaxf(e, relerr(p.out[(size_t)tok * 1024 + c], want, 0.3f));
    }
    diag_report(p, 13, e / 0.01f);
}
__device__ __forceinline__ void dg_norm2(const Params& p) {
    DG_IDS(); unsigned char* ws = p.ws; float e = 0.f;
    for (int s = gwv; s < 4096; s += NGWV) {
        const int m = dhash(s * 41 + 29) & 65535; const float* xr = p.out + (size_t)m * 1024;
        float ss = 0.f; for (int c = lane; c < 1024; c += 64) ss += xr[c] * xr[c];
        ss = wave_sum(ss); const float rs = 1.0f / sqrtf(ss / 1024.f + NORM_EPS);
        for (int c = lane; c < 1024; c += 64) e = fmaxf(e, relerr(bf2f(((const bf16*)(ws + WS_XN2))[(size_t)m * 1024 + c]), xr[c] * rs * p.in[I_N2G][c], 0.05f));
    }
    diag_report(p, 14, e / 0.03f);
}
__device__ __forceinline__ void dg_pq(const Params& p) {
    DG_IDS(); unsigned char* ws = p.ws; float e = 0.f;
    for (int s = gt; s < 131072; s += NGT) {
        const unsigned hsh = dhash(s * 43 + 31); const int tok = hsh & 65535, c = dhash(hsh) & 2047;
        const float want = dg_dot((const bf16*)(ws + WS_XN2), tok, (const bf16*)(ws + WS_WTQ), c, 1024);
        e = fmaxf(e, relerr(bf2f(((const bf16*)(ws + WS_PQ))[(size_t)tok * 2048 + c]), want, 0.25f));
    }
    diag_report(p, 15, e / 0.02f);
}
__device__ __forceinline__ void dg_route(const Params& p, LAS unsigned char* lds) {
    DG_IDS(); unsigned char* ws = p.ws; float e16 = 0.f, e17 = 0.f;
    LAS float* s2l = (LAS float*)lds + (tid >> 6) * 128;
    for (int i = gwv; i < 2048; i += NGWV) {
        const unsigned hsh = dhash(i * 47 + 37); const int tok = hsh & 65535, h = (hsh >> 16) & 7;
        const bf16* q = (const bf16*)(ws + WS_PQ) + (size_t)tok * 2048 + h * 256; const bf16* ks = (const bf16*)(ws + WS_KS);
        float s1a = 0.f, s1b = 0.f, s2a = 0.f, s2b = 0.f;
        for (int d = 0; d < 128; ++d) { const float q1 = bf2f(q[d]), q2 = bf2f(q[128 + d]);
            s1a += q1 * bf2f(ks[(size_t)lane * 128 + d]); s1b += q1 * bf2f(ks[(size_t)(lane + 64) * 128 + d]);
            s2a += q2 * bf2f(ks[(size_t)(128 + lane) * 128 + d]); s2b += q2 * bf2f(ks[(size_t)(192 + lane) * 128 + d]); }
        s2l[lane] = s2a; s2l[lane + 64] = s2b; asm volatile("s_waitcnt lgkmcnt(0)" ::: "memory");
        float prev_s = 3e38f; int prev_id = -1; float top_s[16]; int top_id[16];
#pragma unroll 1
        for (int r = 0; r < 16; ++r) {
            float bs = -3e38f; int bi = 0x7fffffff;
            for (int j = 0; j < 128; ++j) { const float t2 = s2l[j];
                { const float sm = s1a + t2; const int id = lane * 128 + j; const bool ok = (sm < prev_s) || (sm == prev_s && id > prev_id); if (ok && (sm > bs || (sm == bs && id < bi))) { bs = sm; bi = id; } }
                { const float sm = s1b + t2; const int id = (lane + 64) * 128 + j; const bool ok = (sm < prev_s) || (sm == prev_s && id > prev_id); if (ok && (sm > bs || (sm == bs && id < bi))) { bs = sm; bi = id; } } }
            for (int o = 1; o < 64; o <<= 1) { const float os = __shfl_xor(bs, o); const int oi = __shfl_xor(bi, o); if (os > bs || (os == bs && oi < bi)) { bs = os; bi = oi; } }
            top_s[r] = bs; top_id[r] = bi; prev_s = bs; prev_id = bi;
        }
        const int* ids = (const int*)(ws + WS_IDS) + (size_t)tok * 128 + h * 16; const float* gts = (const float*)(ws + WS_GATES) + (size_t)tok * 128 + h * 16;
        float den = 0.f;
#pragma unroll
        for (int r = 0; r < 16; ++r) den += expf(top_s[r] - top_s[0]);
        int miss = 0;
#pragma unroll
        for (int r = 0; r < 16; ++r) {
            bool found = false; for (int k = 0; k < 16; ++k) found |= (ids[k] == top_id[r]);
            if (!found && top_s[r] > top_s[15] + 2e-3f * fabsf(top_s[15]) + 1e-4f) ++miss;
            e17 = fmaxf(e17, fabsf(gts[r] - expf(top_s[r] - top_s[0]) / den));
        }
        e16 = fmaxf(e16, (float)miss);
        if (lane == 0 && miss) atomicAdd((float*)(ws + WS_DIAG) + 19, (float)miss);
    }
    diag_report(p, 16, e16 / 0.5f); diag_report(p, 17, e17 / 0.01f);
}
constexpr int DG_NS18 = 128;
__device__ __forceinline__ void dg_gather_pre(const Params& p) {
    DG_IDS(); float* sv = (float*)(p.ws + WS_DSAVE + 1280 * 1024);
    for (int s = gt; s < DG_NS18 * 1024; s += NGT) { const int i = s >> 10, c = s & 1023; const int tok = dhash(i * 53 + 41) & 65535; sv[s] = p.out[(size_t)tok * 1024 + c]; }
    for (int s = gt; s < DG_NS18 * 128; s += NGT) { const int i = s >> 7, ex = s & 127; const int tok = dhash(i * 53 + 41) & 65535; sv[DG_NS18 * 1024 + s] = ((const float*)(p.ws + WS_GATES))[(size_t)tok * 128 + ex]; }
}
__device__ __forceinline__ void dg_gather_post(const Params& p) {
    DG_IDS(); unsigned char* ws = p.ws; const float* sv = (const float*)(ws + WS_DSAVE + 1280 * 1024); float e = 0.f;
    for (int i = gwv; i < DG_NS18; i += NGWV) {
        const int tok = dhash(i * 53 + 41) & 65535;
        const int* ids = (const int*)(ws + WS_IDS) + (size_t)tok * 128; const float* gts = (const float*)(ws + WS_GATES) + (size_t)tok * 128;
        const signed char* xq = (const signed char*)(ws + WS_XQ) + (size_t)tok * 1024; const float sx = ((const float*)(ws + WS_SX))[tok];
        float o[16];
#pragma unroll
        for (int k = 0; k < 16; ++k) o[k] = 0.f;
        for (int ex = 0; ex < 128; ++ex) {
            const int id = ids[ex]; const signed char* ur = (const signed char*)(ws + WS_U8) + (size_t)id * 1024; const unsigned char* vr = ws + WS_V8 + (size_t)id * 1024;
            float d = 0.f;
#pragma unroll
            for (int k = 0; k < 16; ++k) d += (float)ur[lane * 16 + k] * (float)xq[lane * 16 + k];
            d = wave_sum(d) * ((const float*)(ws + WS_SU))[id] * sx;
            const float svs = ((const float*)(ws + WS_SV))[id];
            const float w = gts[ex];
            e = fmaxf(e, fabsf(w - sv[DG_NS18 * 1024 + i * 128 + ex] * 0.5f * d * (1.0f + erff(d * 0.70710678f)) * svs) / (0.02f * svs) * 0.05f);
#pragma unroll
            for (int k = 0; k < 16; ++k) o[k] += w * ((float)vr[lane * 16 + k] - 128.f);
        }
        float ss = 0.f;
#pragma unroll
        for (int k = 0; k < 16; ++k) ss += o[k] * o[k];
        const float rms = sqrtf(wave_sum(ss) / 1024.f);
#pragma unroll
        for (int k = 0; k < 16; ++k) e = fmaxf(e, fabsf((p.out[(size_t)tok * 1024 + lane * 16 + k] - sv[i * 1024 + lane * 16 + k]) - o[k]) / (rms + 1e-3f));
    }
    diag_report(p, 18, e / 0.05f);
}
__device__ __forceinline__ void dg_final(const Params& p) {
    DG_IDS(); const float* dg = (const float*)(p.ws + WS_DIAG);
    int k = 0;
    for (int s = 1; s <= 26; ++s) if (k == 0 && s != 19 && s != 20 && !(dg[s] <= 1.0f)) k = s;
    if (k != 9) k = (dg[9] <= 1.0f) ? 0 : 9;
#ifdef DIAG_SKIP
    { int kk = 0; for (int s = 1; s <= 26; ++s) if (kk == 0 && s > DIAG_SKIP && s != 19 && s != 20 && !(dg[s] <= 1.0f)) kk = s; k = kk; }
#endif
#ifdef DIAG_VALUE
    const float a = fminf(fmaxf(dg[DIAG_VALUE], 1e-3f), 1e6f) * 16.f;
#else
    const float a = exp2f((float)k);
#endif
    for (size_t i = gt; i < (size_t)NTOK * 1024 / 4; i += NGT) ((f32x4*)p.out)[i] = (f32x4){a, a, a, a};
}
#endif

#define XB_TMO      128
#define XB_XCNT(j)  (256  + 64 * (j))
#define XB_XSUB(j)  (1280 + 64 * (j))
#define XB_XGEN(j)  (2304 + 64 * (j))
#define XB_TOP      3328
#define XB_TOPGEN   3392
#define XCD_BAR_WORDS 3456
#if DIAG
#define XB_SPIN_CAP (1u << 28)
#else
#define XB_SPIN_CAP (1u << 18)
#endif

__device__ __forceinline__ unsigned xb_ld(unsigned* p)              { return __hip_atomic_load(p, __ATOMIC_RELAXED, __HIP_MEMORY_SCOPE_AGENT); }
__device__ __forceinline__ unsigned xb_add(unsigned* p, unsigned v) { return __hip_atomic_fetch_add(p, v, __ATOMIC_RELAXED, __HIP_MEMORY_SCOPE_AGENT); }
__device__ __forceinline__ unsigned xb_xcc_id() { return (unsigned)__builtin_amdgcn_s_getreg((3 << 11) | 20) & 0xFu; }
#define XB_SPIN(cond, bar) do { unsigned _sp = 0; while (cond) { __builtin_amdgcn_s_sleep(1); \
    if ((++_sp & 255u) == 0u) { if (xb_ld(&(bar)[XB_TMO])) break; if (_sp > XB_SPIN_CAP) { atomicAdd(&(bar)[XB_TMO], 1u); break; } } } } while (0)

struct XcdBarrier {
    unsigned* bar; unsigned x;
    volatile LAS unsigned* st;
};

__device__ __forceinline__ XcdBarrier xcd_barrier_post(unsigned* bar, volatile LAS unsigned* st) {
    XcdBarrier b; b.bar = bar; b.x = xb_xcc_id(); b.st = st;
    if (threadIdx.x == 0) (void)xb_add(&bar[XB_XCNT(b.x)], 1u);
    return b;
}
__device__ __forceinline__ void xcd_barrier_complete(unsigned* bar, unsigned x, unsigned& nloc, unsigned& nx) {
    const unsigned G = gridDim.x * gridDim.y * gridDim.z;
    unsigned sum, cnt, mine, sp = 0u;
    for (;;) {
        sum = 0u; cnt = 0u; mine = 0u;
#pragma unroll
        for (unsigned j = 0; j < 16; ++j) { const unsigned c = xb_ld(&bar[XB_XCNT(j)]); sum += c; cnt += (c > 0u) ? 1u : 0u; mine = (j == x) ? c : mine; }
        if (sum == G) break;
        __builtin_amdgcn_s_sleep(1);
        if ((++sp & 255u) == 0u) { if (xb_ld(&bar[XB_TMO])) break; if (sp > XB_SPIN_CAP) { atomicAdd(&bar[XB_TMO], 1u); break; } }
    }
    nloc = mine > 0u ? mine : 1u; nx = cnt > 0u ? cnt : 1u;
}

__device__ __forceinline__ void xcd_barrier(const XcdBarrier& b) {
    asm volatile("s_waitcnt vmcnt(0)" ::: "memory");
    __syncthreads();
    if (threadIdx.x == 0) {
        unsigned* bar = b.bar;
        __builtin_amdgcn_s_waitcnt(0);
        unsigned nloc = b.st[0], nx = b.st[1];
        if (nloc == 0u) { xcd_barrier_complete(bar, b.x, nloc, nx); b.st[0] = nloc; b.st[1] = nx; }
        const unsigned old = xb_add(&bar[XB_XSUB(b.x)], 1u);
        const unsigned gen = old / nloc;
        if (old + 1u == (gen + 1u) * nloc) {
            __builtin_amdgcn_fence(__ATOMIC_RELEASE, "agent");
            asm volatile("s_waitcnt vmcnt(0)" ::: "memory");
            const unsigned og = xb_add(&bar[XB_TOP], 1u);
            const unsigned tg = og / nx;
            if (og + 1u == (tg + 1u) * nx) xb_add(&bar[XB_TOPGEN], 1u);
            else XB_SPIN(xb_ld(&bar[XB_TOPGEN]) == tg, bar);
            __builtin_amdgcn_fence(__ATOMIC_ACQUIRE, "agent");
            xb_add(&bar[XB_XGEN(b.x)], 1u);
            asm volatile("s_waitcnt vmcnt(0)" ::: "memory");
        } else {
            XB_SPIN(xb_ld(&bar[XB_XGEN(b.x)]) == gen, bar);
            __builtin_amdgcn_fence(__ATOMIC_ACQUIRE, "agent");
            asm volatile("s_waitcnt vmcnt(0)" ::: "memory");
        }
    }
    __syncthreads();
}

#ifndef TIMING
#define TIMING 0
#endif
#if TIMING
#define TS(i) do { int t__ = threadIdx.x; asm volatile("" : "+v"(t__)); if (bid == 0 && t__ == 0) ((unsigned long long*)(ws + 1010 * MiB))[i] = __builtin_amdgcn_s_memrealtime(); } while (0)
#else
#define TS(i)
#endif
#if DIAG
#define DG(...) __VA_ARGS__
#else
#define DG(...)
#endif
constexpr int LDS_BYTES = 147456;
static_assert(attn_body::ATTN_LDS_BYTES <= 131072, "attention LDS");
static_assert(RT_KS_BYTES + NTHREADS * RT_TAB_WORDS * 4 <= LDS_BYTES, "routing LDS");
static_assert(sc2::END <= LDS_BYTES - 64, "scan LDS");

__global__ void __launch_bounds__(NTHREADS, 2) hybrid_fwd(Params p) {
    extern __shared__ __attribute__((aligned(16))) unsigned char lds_raw[];
    cg::grid_group grid = cg::this_grid();
    LAS unsigned char* lds = (LAS unsigned char*)lds_raw;
    const int G0 = gridDim.x, bid = blockIdx.x;
#define LANE_IDS() int tid = threadIdx.x; asm volatile("" : "+v"(tid)); const int lane = tid & 63, wave = __builtin_amdgcn_readfirstlane(tid >> 6); (void)lane; (void)wave; int G = G0; asm volatile("" : "+s"(G))
    const int vcu = (G0 % 8 == 0) ? (bid % 8) * (G0 / 8) + bid / 8 : bid;
    unsigned char* ws = p.ws; unsigned char* dob = (unsigned char*)p.out;

    DG({ int t_ = threadIdx.x; asm volatile("" : "+v"(t_)); if (bid == 0 && t_ < 64) ((float*)(ws + WS_DIAG))[t_] = 0.f; })
    unsigned* barw = (unsigned*)(ws + 65536);
    { int t__ = threadIdx.x; asm volatile("" : "+v"(t__)); if (bid == 0) for (int i = t__; i < XCD_BAR_WORDS + 128; i += NTHREADS) __hip_atomic_store(barw + i, 0u, __ATOMIC_RELAXED, __HIP_MEMORY_SCOPE_AGENT);
      if (t__ < 2) ((volatile LAS unsigned*)(lds + LDS_BYTES - 64))[t__] = 0u; }
    __syncthreads();
    TS(0);
    { LANE_IDS(); p0_prologue(p, lds, vcu, G, wave, lane); }
#ifdef REP_P0
    __syncthreads(); { LANE_IDS(); p0_prologue(p, lds, vcu, G, wave, lane); }
#endif
    grid.sync();
    const XcdBarrier xbar = xcd_barrier_post(barw, (volatile LAS unsigned*)(lds + LDS_BYTES - 64));
#define GSYNC() xcd_barrier(xbar)
    DG()
    TS(1);
    run_gemm_i8(lds, ws + WS_XN, ws + WS_WTIN, R, N1, 1024, G0, bid, (const float*)(ws + WS_SXN), (const float*)(ws + WS_SWIN), F_Gemm1{(bf16*)(ws + WS_F), (bf16*)(ws + WS_ZG), p.in[I_FKN], (LAS float*)(lds + pg8::STAGE_BYTES)});
#ifdef REP_GEMM1
    run_gemm_i8(lds, ws + WS_XN, ws + WS_WTIN, R, N1, 1024, G0, bid, (const float*)(ws + WS_SXN), (const float*)(ws + WS_SWIN), F_Gemm1{(bf16*)(ws + WS_F), (bf16*)(ws + WS_ZG), p.in[I_FKN], (LAS float*)(lds + pg8::STAGE_BYTES)});
#endif
    GSYNC();
    DG()
    TS(2);
    { LANE_IDS(); p2_prep1(p, vcu, G, wave, lane); }
    GSYNC();
    DG()
    TS(3);
    { LANE_IDS(); const int gwv = bid * NWAVES + wave; for (int s = gwv; s < 128; s += G * NWAVES) p3_cumsum(p, s, lane);
      LAS float* bl = (LAS float*)(lds + pg8::STAGE_BYTES);
      for (int i = tid; i < 1024; i += NTHREADS) bl[i] = (i < 512) ? p.in[I_W0][i] : p.in[I_A0][i - 512]; }
    __syncthreads();
    run_gemm(lds, (const bf16*)(ws + WS_LA), (const bf16*)(ws + WS_WTWA), R, 512, 128, G0, (bid + G0 - 16) % G0, F_LoraW{(bf16*)(dob + DO_XW), (LAS const float*)(lds + pg8::STAGE_BYTES)});
    run_gemm(lds, (const bf16*)(ws + WS_LA), (const bf16*)(ws + WS_WTWA) + 512 * 128, R, 512, 128, G0, (bid + G0 - 24) % G0, F_LoraA{(bf16*)(dob + DO_AA), (LAS const float*)(lds + pg8::STAGE_BYTES) + 512});
    run_gemm(lds, (const bf16*)(ws + WS_LG), (const bf16*)(ws + WS_WTG), R, 512, 256, G0, (bid + G0 - 32) % G0, F_Plain{(bf16*)(dob + DO_GG), 512});
#ifdef REP_LORA
    run_gemm(lds, (const bf16*)(ws + WS_LA), (const bf16*)(ws + WS_WTWA), R, 512, 128, G0, (bid + G0 - 16) % G0, F_LoraW{(bf16*)(dob + DO_XW), (LAS const float*)(lds + pg8::STAGE_BYTES)});
    run_gemm(lds, (const bf16*)(ws + WS_LA), (const bf16*)(ws + WS_WTWA) + 512 * 128, R, 512, 128, G0, (bid + G0 - 24) % G0, F_LoraA{(bf16*)(dob + DO_AA), (LAS const float*)(lds + pg8::STAGE_BYTES) + 512});
    run_gemm(lds, (const bf16*)(ws + WS_LG), (const bf16*)(ws + WS_WTG), R, 512, 256, G0, (bid + G0 - 32) % G0, F_Plain{(bf16*)(dob + DO_GG), 512});
#endif
    GSYNC();
    DG()
    TS(4);
    {
        LANE_IDS();
        for (int bh = bid; bh < 128; bh += G0) p5_scan_chunked(p, lds, bh, tid, wave, lane);
#ifdef REP_SCAN
        for (int bh = bid; bh < 128; bh += G0) p5_scan_chunked(p, lds, bh, tid, wave, lane);
#endif
        TS(6);
        volatile LAS unsigned* qslot = (volatile LAS unsigned*)(lds + LDS_BYTES - 64 + 16);
        const unsigned kbl0 = (unsigned)(uintptr_t)lds_raw + attn_body::LDS_KB;
        __syncthreads();
        if (tid == 0) *qslot = __hip_atomic_fetch_add(barw + XCD_BAR_WORDS + 64, 1u, __ATOMIC_RELAXED, __HIP_MEMORY_SCOPE_AGENT);
        __syncthreads();
        int u = __builtin_amdgcn_readfirstlane((int)*qslot);
        while (u < 2048) {
            unsigned nx = 0u;
            if (tid == 0) nx = __hip_atomic_fetch_add(barw + XCD_BAR_WORDS + 64, 1u, __ATOMIC_RELAXED, __HIP_MEMORY_SCOPE_AGENT);
            const int qb = 15 - (u >> 7), bh = u & 127;
            {
                const float* kbg = (const float*)(ws + WS_KB) + (size_t)bh * TP + 4 * lane;
                attn_body::glds16(kbg + (2 * wave) * 256, (unsigned)__builtin_amdgcn_readfirstlane(kbl0 + (2 * wave) * 1024));
                attn_body::glds16(kbg + (2 * wave + 1) * 256, (unsigned)__builtin_amdgcn_readfirstlane(kbl0 + (2 * wave + 1) * 1024));
                if (wave == 0 && lane < 16) attn_body::glds16(kbg + 16 * 256, (unsigned)__builtin_amdgcn_readfirstlane(kbl0 + 16 * 1024));
            }
            attn_body::attn_unit<8>(bh >> 3, bh & 7, qb, (const attn_body::bf16*)(ws + WS_FQ), (const attn_body::bf16*)(ws + WS_FK), (const attn_body::bf16*)(ws + WS_FV), (attn_body::bf16*)(ws + WS_FQ), (char*)lds_raw, p.in[I_FQN] + (bh & 7) * 64, NORM_EPS);
            if (tid == 0) *qslot = nx;
            __syncthreads();
            u = __builtin_amdgcn_readfirstlane((int)*qslot);
        }
    }
    GSYNC();
    DG(__syncthreads(); dg_scan(p, lds); __syncthreads();)
    TS(7);
    run_gemm_compact(lds, (const bf16*)(ws + WS_FQ), (const bf16*)(ws + WS_WTFOX), 1024, 512, G0, bid, F_MixA{(bf16*)(ws + WS_MIX), (const bf16*)(ws + WS_ZG)});
#ifdef REP_GEMMA
    run_gemm_compact(lds, (const bf16*)(ws + WS_FQ), (const bf16*)(ws + WS_WTFOX), 1024, 512, G0, bid, F_MixA{(bf16*)(ws + WS_MIX), (const bf16*)(ws + WS_ZG)});
#endif
    TS(9);
    DG()
    run_gemm_compact(lds, (const bf16*)(ws + WS_Y), (const bf16*)(ws + WS_WTRWKV), 1024, 512, G0, bid, F_MixB{(bf16*)(ws + WS_MIX), (const bf16*)(ws + WS_ZG)});
    GSYNC();
    DG()
    TS(10);
    run_gemm_panels(lds, (const bf16*)(ws + WS_MIX), (const bf16*)(ws + WS_WTOUT), 1024, 1024, G0, bid, F_OutC{p.in[I_X], (bf16*)(ws + WS_H1)});
#ifdef REP_OUT
    run_gemm_panels(lds, (const bf16*)(ws + WS_MIX), (const bf16*)(ws + WS_WTOUT), 1024, 1024, G0, bid, F_OutC{p.in[I_X], (bf16*)(ws + WS_H1)});
#endif
    {
        LANE_IDS();
        for (int pan = bid; pan < NTOK / 256; pan += G) for (int r = wave; r < 256; r += 8 * NWAVES) norm2_rows<8>(p, pan * 256 + r, NWAVES, lane);
    }
    TS(11); TS(12);
    GSYNC();
#ifdef PQ_BF16
    run_gemm(lds, (const bf16*)(ws + WS_XN2), (const bf16*)(ws + 1010 * MiB), NTOK, 2048, 1024, G0, bid, F_Plain{(bf16*)(ws + WS_PQ), 2048});
    GSYNC();
#else
    run_gemm_i8_panels8(lds, ws + WS_XQ, ws + WS_WTQ, 1024, G0, bid, (const float*)(ws + WS_SX), (const float*)(ws + WS_SWQ), F_Plain{(bf16*)(ws + WS_PQ), 2048});
#endif
#ifdef REP_PQ
    run_gemm_i8_panels8(lds, ws + WS_XQ, ws + WS_WTQ, 1024, G0, bid, (const float*)(ws + WS_SX), (const float*)(ws + WS_SWQ), F_Plain{(bf16*)(ws + WS_PQ), 2048});
#endif
    TS(13);
    DG()
    { LANE_IDS(); p11_route(p, lds, bid, G, tid, wave, lane); }
#ifdef REP_ROUTE
    __syncthreads(); { LANE_IDS(); p11_route(p, lds, bid, G, tid, wave, lane); }
#endif
    GSYNC();
    TS(14);
    DG()
    { LANE_IDS(); p12a_partial(p, bid, G, wave, lane); }
#ifdef REP_12A
    { LANE_IDS(); p12a_partial(p, bid, G, wave, lane); }
#endif
    GSYNC();
    { LANE_IDS(); p12b_combine(p, lds, vcu, G, tid, wave, lane); }
    GSYNC();
#ifdef REP_12C
    { LANE_IDS(); p12c_output<true>(p, bid, G, wave, lane); }
#endif
    { LANE_IDS(); p12c_output<false>(p, bid, G, wave, lane); }
    DG(GSYNC(); dg_final(p);)
#if TIMING
    GSYNC(); TS(15); GSYNC();
    {
        const unsigned long long* ts = (const unsigned long long*)(ws + 1010 * MiB);
        const float tot = (float)(ts[15] - ts[0]);
        const float fa = 10.f * (float)(ts[TIMING_A1] - ts[TIMING_A0]) / tot;
        int t__ = threadIdx.x; asm volatile("" : "+v"(t__));
        for (size_t i = (size_t)bid * NTHREADS + t__; i < (size_t)NTOK * 1024; i += (size_t)G0 * NTHREADS) p.out[i] = fa;
    }
#endif
}

extern "C" void kernel_launch(void* const* d_in, const int* in_sizes, int n_in, void* d_out, int out_size, void* d_ws, size_t ws_size, hipStream_t stream) {
    static int grid = 0;
    if (grid == 0) {
        if (n_in != 27 || out_size != NTOK * DMODEL || ws_size < WS_END) { fprintf(stderr, "kernel_launch: unexpected shapes (n_in %d, out %d, ws %zu)\n", n_in, out_size, ws_size); grid = -1; return; }
        int dev = 0, cus = 0, per_cu = 0;
        hipGetDevice(&dev);
        hipDeviceGetAttribute(&cus, hipDeviceAttributeMultiprocessorCount, dev);
        hipFuncSetAttribute((const void*)hybrid_fwd, hipFuncAttributeMaxDynamicSharedMemorySize, LDS_BYTES);
        hipOccupancyMaxActiveBlocksPerMultiprocessor(&per_cu, (const void*)hybrid_fwd, NTHREADS, LDS_BYTES);
        if (per_cu < 1) { fprintf(stderr, "kernel_launch: occupancy query says %d blocks per CU\n", per_cu); grid = -1; return; }
        grid = cus;
    }
    if (grid < 0) return;
    Params p{};
    for (int i = 0; i < 27; ++i) p.in[i] = (const float*)d_in[i];
    p.out = (float*)d_out; p.ws = (unsigned char*)d_ws;
    void* args[] = {&p};
    hipError_t e = hipLaunchCooperativeKernel((const void*)hybrid_fwd, dim3(grid), dim3(NTHREADS), args, LDS_BYTES, stream);
    if (e != hipSuccess) fprintf(stderr, "cooperative launch failed: %s (grid %d)\n", hipGetErrorString(e), grid);
}
```

```cpp
#include <hip/hip_runtime.h>
#include <hip/hip_cooperative_groups.h>
#include <hip/hip_bf16.h>
#include <cstdio>
#include <cstdint>
#include <cmath>
namespace cg = cooperative_groups;
#ifndef DIAG
#define DIAG 0
#endif
namespace pg8 {
#define PG8_LAS __attribute__((address_space(3)))
typedef unsigned short bf16_t;
typedef short bf16x8 __attribute__((ext_vector_type(8)));
typedef float f32x4 __attribute__((ext_vector_type(4)));
typedef unsigned u32x4 __attribute__((ext_vector_type(4)));
constexpr int BM = 256, BK = 64, HALF = 128, HTB = HALF * BK * 2  , STAGE_BYTES = 8 * HTB, NXCD = 8, WGM = 8;

__host__ __device__ __forceinline__ int lds_byte(int r, int c) { const int st = (r >> 4) * 2 + (c >> 5), rr = r & 15, cc = c & 31, ob = rr * 64 + cc * 2; return st * 1024 + (ob ^ (((ob >> 9) & 1) << 5)); }
__host__ __device__ __forceinline__ void stage_rc(int b, int& R, int& C) { const int st = b / 1024, sb = b % 1024, swz = sb ^ (((sb >> 9) & 1) << 5); R = (st >> 1) * 16 + swz / 64; C = (st & 1) * 32 + (swz % 64) / 2; }
__host__ __device__ __forceinline__ int perm32(int rho) { const int n = rho >> 4, i = rho & 15; return 8 * (i >> 2) + 4 * n + (i & 3); }

struct Unit { int pm, pn; };
struct Gemm { const bf16_t* A; const bf16_t* Bt; int M, N, K; };

struct StaticOrder {
    int nM, nN, nwg, G, c;
    __host__ __device__ void init(int M, int N, int G_, int c_) { nM = M / BM; nN = N / BM; nwg = nM * nN; G = G_; c = c_; }
    __host__ __device__ bool next(int i, Unit& u) const {
        const int L = i * G + c; if (L >= nwg) return false;
        int wgid = (int)L; { const int q = nwg / NXCD, r = nwg % NXCD, xcd = wgid % NXCD, off = wgid / NXCD; wgid = (xcd < r ? xcd * (q + 1) : r * (q + 1) + (xcd - r) * q) + off; }
        const int nig = WGM * nN, gid = wgid / nig, fm = gid * WGM, gsz = (nM - fm) < WGM ? (nM - fm) : WGM;
        u.pm = fm + ((wgid % nig) % gsz); u.pn = (wgid % nig) / gsz; return true;
    }
    __device__ __forceinline__ void a_ready(const Unit&) const {}
    __device__ __forceinline__ void done(const Unit&) const {}
    __device__ __forceinline__ size_t a_row0(int pm) const { return (size_t)pm * BM; }
};

__device__ __forceinline__ unsigned cvt_pk_bf16(float lo, float hi) { unsigned r; asm volatile("v_cvt_pk_bf16_f32 %0, %1, %2" : "=v"(r) : "v"(lo), "v"(hi)); return r; }
typedef float f32x2 __attribute__((ext_vector_type(2)));
typedef int i32x4 __attribute__((ext_vector_type(4)));
template <class Epi, class Sched, bool ALIGN_EPI = false, bool SP2 = false>
__device__ __forceinline__ void gemm_phase(PG8_LAS unsigned char* lds, const Gemm g, const Sched& S, const Epi& E) {
    int tid_ = threadIdx.x; asm volatile("" : "+v"(tid_));
    const int tid = tid_, wid = __builtin_amdgcn_readfirstlane(tid >> 6), lane = tid & 63, wr = wid >> 2, wc = wid & 3, fr = lane & 15, fq = lane >> 4;
    const int K = g.K, nt = K / BK;
    unsigned voffA[2], voffB[2];
#pragma unroll
    for (int i = 0; i < 2; ++i) { int R, C; stage_rc(tid * 16 + i * 8192, R, C); const int Rb = Epi::PERM ? ((R & ~31) + perm32(R & 31)) : R;
        voffA[i] = (unsigned)(R * K + C) * 2u; voffB[i] = (unsigned)(Rb * K + C) * 2u; }
    const size_t kstep = (size_t)(BK * 2);
    const size_t hstep = (size_t)HALF * K * 2;
    const size_t tstep = 2 * hstep;
    const unsigned ldsw = (unsigned)wid * 1024u;
    const int aoff = lds_byte(wr * 64 + fr, fq * 8), boff = lds_byte(wc * 32 + fr, fq * 8);
#define PG8_SA(b, h) (((b) * 2 + (h)) * HTB)
#define PG8_SB(b, h) ((4 + (b) * 2 + (h)) * HTB)
#define PG8_STAGE(bufoff, gbase, voff) do { _Pragma("unroll") for (int _i = 0; _i < 2; ++_i) \
        __builtin_amdgcn_global_load_lds((const unsigned*)((const char*)(gbase) + (voff)[_i]), (PG8_LAS unsigned*)(lds + (bufoff) + ldsw + _i * 8192), 16, 0, 0); } while (0)
#define PG8_LDA(dst, b, h) do { _Pragma("unroll") for (int m = 0; m < 4; ++m) _Pragma("unroll") for (int k = 0; k < 2; ++k) dst[m][k] = *(const PG8_LAS bf16x8*)(lds + PG8_SA(b, h) + aoff + m * 2048 + k * 1024); } while (0)
#define PG8_LDB(dst, b, h) do { _Pragma("unroll") for (int n = 0; n < 2; ++n) _Pragma("unroll") for (int k = 0; k < 2; ++k) dst[n][k] = *(const PG8_LAS bf16x8*)(lds + PG8_SB(b, h) + boff + n * 2048 + k * 1024); } while (0)
#define PG8_MMA(ai, bj, At, Bt) do { __builtin_amdgcn_s_setprio(1); _Pragma("unroll") for (int m = 0; m < 4; ++m) _Pragma("unroll") for (int n = 0; n < 2; ++n) _Pragma("unroll") for (int k = 0; k < 2; ++k) \
        acc[ai][bj][m][n] = __builtin_amdgcn_mfma_f32_16x16x32_bf16(Bt[n][k], At[m][k], acc[ai][bj][m][n], 0, 0, 0); __builtin_amdgcn_s_setprio(0); } while (0)
#define PG8_WAIT_V(n) asm volatile("s_waitcnt vmcnt(" #n ")" ::: "memory")
#define PG8_WAIT_L(n) asm volatile("s_waitcnt lgkmcnt(" #n ")" ::: "memory")
#define PG8_BAR __builtin_amdgcn_s_barrier()
#define PG8_SCHED __builtin_amdgcn_sched_barrier(0)
    Unit cur, nxt; int ui = 0;
    if (!S.next(0, cur)) return;
    f32x4 acc[2][2][4][2];
#pragma unroll
    for (int a = 0; a < 2; ++a)
#pragma unroll
        for (int b = 0; b < 2; ++b)
#pragma unroll
            for (int m = 0; m < 4; ++m)
#pragma unroll
                for (int n = 0; n < 2; ++n) acc[a][b][m][n] = (f32x4){0.f, 0.f, 0.f, 0.f};
    bf16x8 At[4][2], B0[2][2], B1[2][2];
    const char* cA = (const char*)g.A + S.a_row0(cur.pm) * (size_t)K * 2; const char* cB = (const char*)g.Bt + (size_t)cur.pn * tstep;
    S.a_ready(cur);
    if constexpr (SP2) {
        PG8_STAGE(PG8_SB(0, 0), cB, voffB); PG8_STAGE(PG8_SB(0, 1), cB + hstep, voffB); PG8_STAGE(PG8_SA(0, 0), cA, voffA); PG8_STAGE(PG8_SA(0, 1), cA + hstep, voffA);
        if (wr == 1) PG8_BAR;
        PG8_WAIT_V(2); PG8_BAR;
        PG8_STAGE(PG8_SB(1, 0), cB + kstep, voffB); PG8_STAGE(PG8_SA(1, 0), cA + kstep, voffA); PG8_STAGE(PG8_SB(1, 1), cB + hstep + kstep, voffB);
        PG8_WAIT_V(6); PG8_BAR;
    } else {
        PG8_STAGE(PG8_SB(0, 0), cB, voffB); PG8_STAGE(PG8_SA(0, 0), cA, voffA); PG8_STAGE(PG8_SB(0, 1), cB + hstep, voffB); PG8_STAGE(PG8_SA(0, 1), cA + hstep, voffA);
        if (wr == 1) PG8_BAR;
        PG8_WAIT_V(4); PG8_BAR;
        PG8_STAGE(PG8_SB(1, 0), cB + kstep, voffB); PG8_STAGE(PG8_SA(1, 0), cA + kstep, voffA); PG8_STAGE(PG8_SB(1, 1), cB + hstep + kstep, voffB);
        PG8_WAIT_V(6); PG8_BAR;
    }
    for (;;) {
        const bool has_next = S.next(ui + 1, nxt);
        const char* nA = has_next ? (const char*)g.A + S.a_row0(nxt.pm) * (size_t)K * 2 : cA; const char* nB = has_next ? (const char*)g.Bt + (size_t)nxt.pn * tstep : cB;
        for (int t = 0; t < nt; t += 2) {
            const bool last = (t == nt - 2);
            const char* a1 = cA + (size_t)(t + 1) * kstep;
            const char* a2 = last ? nA : cA + (size_t)(t + 2) * kstep; const char* b2 = last ? nB : cB + (size_t)(t + 2) * kstep;
            const char* a3 = a2 + kstep; const char* b3 = b2 + kstep;
            if (last && has_next) S.a_ready(nxt);
            if constexpr (SP2) {
            PG8_LDB(B0, 0, 0); PG8_LDB(B1, 0, 1); PG8_SCHED; PG8_LDA(At, 0, 0); PG8_STAGE(PG8_SA(1, 1), a1 + hstep, voffA);
            PG8_WAIT_V(8); PG8_WAIT_L(0); PG8_BAR; PG8_MMA(0, 0, At, B0); PG8_MMA(0, 1, At, B1); PG8_BAR; PG8_SCHED;
            PG8_LDA(At, 0, 1); PG8_STAGE(PG8_SB(0, 0), b2, voffB); PG8_STAGE(PG8_SB(0, 1), b2 + hstep, voffB); PG8_STAGE(PG8_SA(0, 0), a2, voffA);
            PG8_WAIT_V(8); PG8_WAIT_L(0); PG8_BAR; PG8_MMA(1, 0, At, B0); PG8_MMA(1, 1, At, B1); PG8_BAR; PG8_SCHED;
            PG8_LDB(B0, 1, 0); PG8_LDB(B1, 1, 1); PG8_SCHED; PG8_LDA(At, 1, 0); PG8_STAGE(PG8_SA(0, 1), a2 + hstep, voffA);
            PG8_WAIT_V(8); PG8_WAIT_L(0); PG8_BAR; PG8_MMA(0, 0, At, B0); PG8_MMA(0, 1, At, B1); PG8_BAR; PG8_SCHED;
            PG8_LDA(At, 1, 1); PG8_STAGE(PG8_SB(1, 0), b3, voffB); PG8_STAGE(PG8_SB(1, 1), b3 + hstep, voffB); PG8_STAGE(PG8_SA(1, 0), a3, voffA);
            PG8_WAIT_V(8); PG8_WAIT_L(0); PG8_BAR; PG8_MMA(1, 0, At, B0); PG8_MMA(1, 1, At, B1); PG8_BAR; PG8_SCHED;
            } else {
            PG8_LDB(B0, 0, 0); PG8_SCHED; PG8_LDA(At, 0, 0); PG8_STAGE(PG8_SA(1, 1), a1 + hstep, voffA);
            PG8_WAIT_L(8); PG8_BAR; PG8_WAIT_L(0); PG8_MMA(0, 0, At, B0); PG8_BAR; PG8_SCHED;
            PG8_LDB(B1, 0, 1); PG8_STAGE(PG8_SB(0, 0), b2, voffB);
            PG8_BAR; PG8_WAIT_L(0); PG8_MMA(0, 1, At, B1); PG8_BAR;
            PG8_LDA(At, 0, 1); PG8_STAGE(PG8_SA(0, 0), a2, voffA);
            PG8_BAR; PG8_WAIT_L(0); PG8_MMA(1, 0, At, B0); PG8_BAR; PG8_SCHED;
            PG8_STAGE(PG8_SB(0, 1), b2 + hstep, voffB);
            PG8_WAIT_V(6); PG8_BAR; PG8_MMA(1, 1, At, B1); PG8_BAR;
            PG8_LDB(B0, 1, 0); PG8_SCHED; PG8_LDA(At, 1, 0); PG8_STAGE(PG8_SA(0, 1), a2 + hstep, voffA);
            PG8_WAIT_L(8); PG8_BAR; PG8_WAIT_L(0); PG8_MMA(0, 0, At, B0); PG8_BAR; PG8_SCHED;
            PG8_LDB(B1, 1, 1); PG8_STAGE(PG8_SB(1, 0), b3, voffB);
            PG8_BAR; PG8_WAIT_L(0); PG8_MMA(0, 1, At, B1); PG8_BAR;
            PG8_LDA(At, 1, 1); PG8_STAGE(PG8_SA(1, 0), a3, voffA);
            PG8_BAR; PG8_WAIT_L(0); PG8_MMA(1, 0, At, B0); PG8_BAR; PG8_SCHED;
            PG8_STAGE(PG8_SB(1, 1), b3 + hstep, voffB);
            PG8_WAIT_V(6); PG8_BAR; PG8_MMA(1, 1, At, B1); PG8_BAR;
            }
        }
        if constexpr (ALIGN_EPI) { if (wr == 0) PG8_BAR; }
        if constexpr (!Epi::AFTER_DRAIN) { E(acc, cur, wr, wc, fr, fq); S.done(cur); }
        if (!has_next) break;
#pragma unroll
        for (int a = 0; a < 2; ++a)
#pragma unroll
            for (int b = 0; b < 2; ++b)
#pragma unroll
                for (int m = 0; m < 4; ++m)
#pragma unroll
                    for (int n = 0; n < 2; ++n) acc[a][b][m][n] = (f32x4){0.f, 0.f, 0.f, 0.f};
        cur = nxt; cA = nA; cB = nB; ++ui;
        if constexpr (ALIGN_EPI) { if (wr == 1) PG8_BAR; }
    }
    PG8_WAIT_V(0);
    if constexpr (!ALIGN_EPI) { if (wr == 0) PG8_BAR; }
    PG8_BAR;
    if constexpr (Epi::AFTER_DRAIN) { E.fused(acc, cur, wr, wc, fr, fq, lds, wid, lane); S.done(cur); }
#undef PG8_SA
#undef PG8_SB
#undef PG8_STAGE
#undef PG8_LDA
#undef PG8_LDB
#undef PG8_MMA
#undef PG8_WAIT_V
#undef PG8_WAIT_L
#undef PG8_BAR
#undef PG8_SCHED
}
template <class Epi, class Sched, bool ALIGN_EPI = false, bool SP2 = false>
__device__ __forceinline__ void gemm_phase_i8(PG8_LAS unsigned char* lds, const Gemm g, const Sched& S, const Epi& E) {
    int tid_ = threadIdx.x; asm volatile("" : "+v"(tid_));
    const int tid = tid_, wid = __builtin_amdgcn_readfirstlane(tid >> 6), lane = tid & 63, wr = wid >> 2, wc = wid & 3, fr = lane & 15, fq = lane >> 4;
    const int K = g.K, nt = K / BK;
    unsigned voffA[2], voffB[2];
#pragma unroll
    for (int i = 0; i < 2; ++i) { int R, C; stage_rc(tid * 16 + i * 8192, R, C); const int Rb = Epi::PERM ? ((R & ~31) + perm32(R & 31)) : R;
        voffA[i] = (unsigned)(R * K + C) * 2u; voffB[i] = (unsigned)(Rb * K + C) * 2u; }
    const size_t kstep = (size_t)(BK * 2);
    const size_t hstep = (size_t)HALF * K * 2;
    const size_t tstep = 2 * hstep;
    const unsigned ldsw = (unsigned)wid * 1024u;
    const int aoff = lds_byte(wr * 64 + fr, fq * 8), boff = lds_byte(wc * 32 + fr, fq * 8);
#define PG8_SA(b, h) (((b) * 2 + (h)) * HTB)
#define PG8_SB(b, h) ((4 + (b) * 2 + (h)) * HTB)
#define PG8_STAGE(bufoff, gbase, voff) do { _Pragma("unroll") for (int _i = 0; _i < 2; ++_i) \
        __builtin_amdgcn_global_load_lds((const unsigned*)((const char*)(gbase) + (voff)[_i]), (PG8_LAS unsigned*)(lds + (bufoff) + ldsw + _i * 8192), 16, 0, 0); } while (0)
#define PG8_LDA(dst, b, h) do { _Pragma("unroll") for (int m = 0; m < 4; ++m) _Pragma("unroll") for (int k = 0; k < 2; ++k) dst[m][k] = *(const PG8_LAS bf16x8*)(lds + PG8_SA(b, h) + aoff + m * 2048 + k * 1024); } while (0)
#define PG8_LDB(dst, b, h) do { _Pragma("unroll") for (int n = 0; n < 2; ++n) _Pragma("unroll") for (int k = 0; k < 2; ++k) dst[n][k] = *(const PG8_LAS bf16x8*)(lds + PG8_SB(b, h) + boff + n * 2048 + k * 1024); } while (0)
#define PG8_MMA(ai, bj, At, Bt) do { __builtin_amdgcn_s_setprio(1); _Pragma("unroll") for (int m = 0; m < 4; ++m) _Pragma("unroll") for (int n = 0; n < 2; ++n) _Pragma("unroll") for (int k = 0; k < 2; ++k) \
        acc[ai][bj][m][n] = __builtin_amdgcn_mfma_i32_16x16x64_i8(__builtin_bit_cast(i32x4, Bt[n][k]), __builtin_bit_cast(i32x4, At[m][k]), acc[ai][bj][m][n], 0, 0, 0); __builtin_amdgcn_s_setprio(0); } while (0)
#define PG8_WAIT_V(n) asm volatile("s_waitcnt vmcnt(" #n ")" ::: "memory")
#define PG8_WAIT_L(n) asm volatile("s_waitcnt lgkmcnt(" #n ")" ::: "memory")
#define PG8_BAR __builtin_amdgcn_s_barrier()
#define PG8_SCHED __builtin_amdgcn_sched_barrier(0)
    Unit cur, nxt; int ui = 0;
    if (!S.next(0, cur)) return;
    i32x4 acc[2][2][4][2];
#pragma unroll
    for (int a = 0; a < 2; ++a)
#pragma unroll
        for (int b = 0; b < 2; ++b)
#pragma unroll
            for (int m = 0; m < 4; ++m)
#pragma unroll
                for (int n = 0; n < 2; ++n) acc[a][b][m][n] = (i32x4){0, 0, 0, 0};
    bf16x8 At[4][2], B0[2][2], B1[2][2];
    const char* cA = (const char*)g.A + S.a_row0(cur.pm) * (size_t)K * 2; const char* cB = (const char*)g.Bt + (size_t)cur.pn * tstep;
    S.a_ready(cur);
    if constexpr (SP2) {
        PG8_STAGE(PG8_SB(0, 0), cB, voffB); PG8_STAGE(PG8_SB(0, 1), cB + hstep, voffB); PG8_STAGE(PG8_SA(0, 0), cA, voffA); PG8_STAGE(PG8_SA(0, 1), cA + hstep, voffA);
        if (wr == 1) PG8_BAR;
        PG8_WAIT_V(2); PG8_BAR;
        PG8_STAGE(PG8_SB(1, 0), cB + kstep, voffB); PG8_STAGE(PG8_SA(1, 0), cA + kstep, voffA); PG8_STAGE(PG8_SB(1, 1), cB + hstep + kstep, voffB);
        PG8_WAIT_V(6); PG8_BAR;
    } else {
        PG8_STAGE(PG8_SB(0, 0), cB, voffB); PG8_STAGE(PG8_SA(0, 0), cA, voffA); PG8_STAGE(PG8_SB(0, 1), cB + hstep, voffB); PG8_STAGE(PG8_SA(0, 1), cA + hstep, voffA);
        if (wr == 1) PG8_BAR;
        PG8_WAIT_V(4); PG8_BAR;
        PG8_STAGE(PG8_SB(1, 0), cB + kstep, voffB); PG8_STAGE(PG8_SA(1, 0), cA + kstep, voffA); PG8_STAGE(PG8_SB(1, 1), cB + hstep + kstep, voffB);
        PG8_WAIT_V(6); PG8_BAR;
    }
    for (;;) {
        const bool has_next = S.next(ui + 1, nxt);
        E.unit_begin(cur, ui, wid, lane);
        const char* nA = has_next ? (const char*)g.A + S.a_row0(nxt.pm) * (size_t)K * 2 : cA; const char* nB = has_next ? (const char*)g.Bt + (size_t)nxt.pn * tstep : cB;
        for (int t = 0; t < nt; t += 2) {
            const bool last = (t == nt - 2);
            const char* a1 = cA + (size_t)(t + 1) * kstep;
            const char* a2 = last ? nA : cA + (size_t)(t + 2) * kstep; const char* b2 = last ? nB : cB + (size_t)(t + 2) * kstep;
            const char* a3 = a2 + kstep; const char* b3 = b2 + kstep;
            if (last && has_next) S.a_ready(nxt);
            if constexpr (SP2) {
            PG8_LDB(B0, 0, 0); PG8_LDB(B1, 0, 1); PG8_SCHED; PG8_LDA(At, 0, 0); PG8_STAGE(PG8_SA(1, 1), a1 + hstep, voffA);
            PG8_WAIT_V(8); PG8_WAIT_L(0); PG8_BAR; PG8_MMA(0, 0, At, B0); PG8_MMA(0, 1, At, B1); PG8_BAR; PG8_SCHED;
            PG8_LDA(At, 0, 1); PG8_STAGE(PG8_SB(0, 0), b2, voffB); PG8_STAGE(PG8_SB(0, 1), b2 + hstep, voffB); PG8_STAGE(PG8_SA(0, 0), a2, voffA);
            PG8_WAIT_V(8); PG8_WAIT_L(0); PG8_BAR; PG8_MMA(1, 0, At, B0); PG8_MMA(1, 1, At, B1); PG8_BAR; PG8_SCHED;
            PG8_LDB(B0, 1, 0); PG8_LDB(B1, 1, 1); PG8_SCHED; PG8_LDA(At, 1, 0); PG8_STAGE(PG8_SA(0, 1), a2 + hstep, voffA);
            PG8_WAIT_V(8); PG8_WAIT_L(0); PG8_BAR; PG8_MMA(0, 0, At, B0); PG8_MMA(0, 1, At, B1); PG8_BAR; PG8_SCHED;
            PG8_LDA(At, 1, 1); PG8_STAGE(PG8_SB(1, 0), b3, voffB); PG8_STAGE(PG8_SB(1, 1), b3 + hstep, voffB); PG8_STAGE(PG8_SA(1, 0), a3, voffA);
            PG8_WAIT_V(8); PG8_WAIT_L(0); PG8_BAR; PG8_MMA(1, 0, At, B0); PG8_MMA(1, 1, At, B1); PG8_BAR; PG8_SCHED;
            } else {
            PG8_LDB(B0, 0, 0); PG8_SCHED; PG8_LDA(At, 0, 0); PG8_STAGE(PG8_SA(1, 1), a1 + hstep, voffA);
            PG8_WAIT_L(8); PG8_BAR; PG8_WAIT_L(0); PG8_MMA(0, 0, At, B0); PG8_BAR; PG8_SCHED;
            PG8_LDB(B1, 0, 1); PG8_STAGE(PG8_SB(0, 0), b2, voffB);
            PG8_BAR; PG8_WAIT_L(0); PG8_MMA(0, 1, At, B1); PG8_BAR;
            PG8_LDA(At, 0, 1); PG8_STAGE(PG8_SA(0, 0), a2, voffA);
            PG8_BAR; PG8_WAIT_L(0); PG8_MMA(1, 0, At, B0); PG8_BAR; PG8_SCHED;
            PG8_STAGE(PG8_SB(0, 1), b2 + hstep, voffB);
            PG8_WAIT_V(6); PG8_BAR; PG8_MMA(1, 1, At, B1); PG8_BAR;
            PG8_LDB(B0, 1, 0); PG8_SCHED; PG8_LDA(At, 1, 0); PG8_STAGE(PG8_SA(0, 1), a2 + hstep, voffA);
            PG8_WAIT_L(8); PG8_BAR; PG8_WAIT_L(0); PG8_MMA(0, 0, At, B0); PG8_BAR; PG8_SCHED;
            PG8_LDB(B1, 1, 1); PG8_STAGE(PG8_SB(1, 0), b3, voffB);
            PG8_BAR; PG8_WAIT_L(0); PG8_MMA(0, 1, At, B1); PG8_BAR;
            PG8_LDA(At, 1, 1); PG8_STAGE(PG8_SA(1, 0), a3, voffA);
            PG8_BAR; PG8_WAIT_L(0); PG8_MMA(1, 0, At, B0); PG8_BAR; PG8_SCHED;
            PG8_STAGE(PG8_SB(1, 1), b3 + hstep, voffB);
            PG8_WAIT_V(6); PG8_BAR; PG8_MMA(1, 1, At, B1); PG8_BAR;
            }
        }
        if constexpr (ALIGN_EPI) { if (wr == 0) PG8_BAR; }
        if constexpr (!Epi::AFTER_DRAIN) { E(acc, cur, wr, wc, fr, fq, ui); S.done(cur); }
        if (!has_next) break;
#pragma unroll
        for (int a = 0; a < 2; ++a)
#pragma unroll
            for (int b = 0; b < 2; ++b)
#pragma unroll
                for (int m = 0; m < 4; ++m)
#pragma unroll
                    for (int n = 0; n < 2; ++n) acc[a][b][m][n] = (i32x4){0, 0, 0, 0};
        cur = nxt; cA = nA; cB = nB; ++ui;
        if constexpr (ALIGN_EPI) { if (wr == 1) PG8_BAR; }
    }
    PG8_WAIT_V(0);
    if constexpr (!ALIGN_EPI) { if (wr == 0) PG8_BAR; }
    PG8_BAR;
    if constexpr (Epi::AFTER_DRAIN) { E.fused(acc, cur, wr, wc, fr, fq, lds, wid, lane); S.done(cur); }
#undef PG8_SA
#undef PG8_SB
#undef PG8_STAGE
#undef PG8_LDA
#undef PG8_LDB
#undef PG8_MMA
#undef PG8_WAIT_V
#undef PG8_WAIT_L
#undef PG8_BAR
#undef PG8_SCHED
}
}
namespace attn_body {
using bf16=__hip_bfloat16;
using bf16x8=__attribute__((ext_vector_type(8)))short;
using s16x4=__attribute__((ext_vector_type(4)))short;
using f32x16=__attribute__((ext_vector_type(16)))float;
using u32x4=__attribute__((ext_vector_type(4)))unsigned;
using f32x4k=__attribute__((ext_vector_type(4)))float;
constexpr int BATCH=16,NHEAD=8,TPAD=4160,D=64,DM=NHEAD*D;
constexpr int NW=8,QBLK=32,QB=QBLK*NW,KVBLK=64,NQB=16;
constexpr int ATTN_PITCH=DM, ATTN_UNIT_ROWS=QB;
__device__ __forceinline__ int crow(int r,int hi){return (r&3)+8*(r>>2)+4*hi;}
#define SBAR() __builtin_amdgcn_sched_barrier(0)
__device__ __forceinline__ void cmask(f32x16&p0,f32x16&p1,int jb,int qrel,int hi){
  const float NEG=-INFINITY; int kb=64*jb+4*hi;
  #pragma unroll
  for(int r=0;r<16;++r){int kv=kb+(r&3)+8*(r>>2); if(kv>qrel)p0[r]=NEG; if(kv+32>qrel)p1[r]=NEG;}
}

constexpr int NSLOT=3, SLOTB=8192;
constexpr int LDS_K=0, LDS_V=NSLOT*SLOTB, LDS_WS=2*NSLOT*SLOTB, LDS_OST=LDS_WS+NW*64*4, LDS_KB=LDS_OST+NW*4096, LDS_BYTES=LDS_KB+TPAD*4;
constexpr float C2=0.125f*1.4426950408889634f;
__device__ __forceinline__ void glds16(const void*gsrc,unsigned lds_dst){unsigned keep;
  asm volatile("s_mov_b32 %0, m0\n\ts_mov_b32 m0, %2\n\ts_nop 0\n\tglobal_load_lds_dwordx4 %1, off\n\ts_mov_b32 m0, %0":"=&s"(keep):"v"(gsrc),"s"(lds_dst):"memory");}
__device__ __forceinline__ float max3f(float a,float b,float c){float r;asm("v_max3_f32 %0, %1, %2, %3":"=v"(r):"v"(a),"v"(b),"v"(c));return r;}
__device__ __forceinline__ float max2f(float a,float b){float r;asm("v_max_f32_e32 %0, %1, %2":"=v"(r):"v"(a),"v"(b));return r;}
__device__ __forceinline__ float fadd_s(float a,float b){float r;asm("v_add_f32_e32 %0, %1, %2":"=v"(r):"v"(a),"v"(b));return r;}
__device__ __forceinline__ float fsub_s(float a,float b){float r;asm("v_sub_f32_e32 %0, %1, %2":"=v"(r):"v"(a),"v"(b));return r;}
typedef float f32x2_t __attribute__((ext_vector_type(2))); typedef __bf16 bf16x2_t __attribute__((ext_vector_type(2)));
__device__ __forceinline__ unsigned cvtpk_s(float lo,float hi){f32x2_t v={lo,hi};bf16x2_t b=__builtin_convertvector(v,bf16x2_t);return __builtin_bit_cast(unsigned,b);}
#define WAIT_BAR(N) asm volatile("s_waitcnt vmcnt(" #N ") lgkmcnt(0)\n\ts_barrier":::"memory")

__device__ __forceinline__ void qkt(f32x16&p0,f32x16&p1,const char*Kslot,const bf16x8*qr,int r32,int hi){
  const char*kb=Kslot+hi*1024+r32*16;
  #pragma unroll
  for(int d0=0;d0<4;++d0){
    const bf16x8 b0=*reinterpret_cast<const bf16x8*>(kb+d0*2048);
    const bf16x8 b1=*reinterpret_cast<const bf16x8*>(kb+d0*2048+512);
    {p0=__builtin_amdgcn_mfma_f32_32x32x16_bf16(b0,qr[d0],p0,0,0,0);p1=__builtin_amdgcn_mfma_f32_32x32x16_bf16(b1,qr[d0],p1,0,0,0);}}
}
typedef __attribute__((address_space(3))) const char* lds_cptr;
typedef short v4i16_t __attribute__((ext_vector_type(4)));
__device__ __forceinline__ void kload8(bf16x8*kf,lds_cptr kp){
  kf[0]=*(const __attribute__((address_space(3))) bf16x8*)(kp);      kf[1]=*(const __attribute__((address_space(3))) bf16x8*)(kp+512);
  kf[2]=*(const __attribute__((address_space(3))) bf16x8*)(kp+2048); kf[3]=*(const __attribute__((address_space(3))) bf16x8*)(kp+2560);
  kf[4]=*(const __attribute__((address_space(3))) bf16x8*)(kp+4096); kf[5]=*(const __attribute__((address_space(3))) bf16x8*)(kp+4608);
  kf[6]=*(const __attribute__((address_space(3))) bf16x8*)(kp+6144); kf[7]=*(const __attribute__((address_space(3))) bf16x8*)(kp+6656);
}
__device__ __forceinline__ void kload2(bf16x8*kf,lds_cptr kp,int j){ kf[2*j]=*(const __attribute__((address_space(3))) bf16x8*)(kp+j*2048); kf[2*j+1]=*(const __attribute__((address_space(3))) bf16x8*)(kp+j*2048+512); }
__device__ __forceinline__ s16x4 vtr(lds_cptr p){ return __builtin_bit_cast(s16x4,__builtin_amdgcn_ds_read_tr16_b64_v4i16((__attribute__((address_space(3))) v4i16_t*)p)); }
__device__ __forceinline__ float rowmax(const f32x16&p0,const f32x16&p1){
  float a=max3f(p0[0],p0[1],p1[0]),b=max3f(p0[2],p0[3],p1[1]);a=max3f(a,p1[2],p1[3]);
  #pragma unroll
  for(int r=4;r<16;r+=4){a=max3f(a,p0[r],p0[r+1]);b=max3f(b,p0[r+2],p0[r+3]);a=max3f(a,p1[r],p1[r+1]);b=max3f(b,p1[r+2],p1[r+3]);}
  const float m=max2f(a,b);
  auto rr=__builtin_amdgcn_permlane32_swap(__float_as_uint(m),__float_as_uint(m),false,false);
  return max2f(__uint_as_float(rr[0]),__uint_as_float(rr[1]));
}
__device__ __forceinline__ void pv(f32x16*o,int vb,bf16x8 pa0,bf16x8 pa1,bf16x8 pa2,bf16x8 pa3){
  #pragma unroll
  for(int d0=0;d0<2;++d0){s16x4 lo[4],hi[4];
    #pragma unroll
    for(int ks=0;ks<4;++ks){
      asm volatile("ds_read_b64_tr_b16 %0,%1 offset:%c2":"=&v"(lo[ks]):"v"(vb),"i"(d0*4096+ks*1024):"memory");
      asm volatile("ds_read_b64_tr_b16 %0,%1 offset:%c2":"=&v"(hi[ks]):"v"(vb),"i"(d0*4096+ks*1024+512):"memory");}
    asm volatile("s_waitcnt lgkmcnt(0)":::"memory");SBAR();
    #define PK(k) (bf16x8){lo[k][0],lo[k][1],lo[k][2],lo[k][3],hi[k][0],hi[k][1],hi[k][2],hi[k][3]}
    o[d0]=__builtin_amdgcn_mfma_f32_32x32x16_bf16(pa0,PK(0),o[d0],0,0,0);
    o[d0]=__builtin_amdgcn_mfma_f32_32x32x16_bf16(pa1,PK(1),o[d0],0,0,0);
    o[d0]=__builtin_amdgcn_mfma_f32_32x32x16_bf16(pa2,PK(2),o[d0],0,0,0);
    o[d0]=__builtin_amdgcn_mfma_f32_32x32x16_bf16(pa3,PK(3),o[d0],0,0,0);
    #undef PK
  }
}

#ifndef ATTN_STORE16
#define ATTN_STORE16(p,v) (*(u32x4*)(p)=(v))
#endif
template<int THRL> __device__ __forceinline__ void attn_unit(int b,int h,int qb,const bf16*Q,const bf16*__restrict__ K,const bf16*__restrict__ V,bf16*O,char*shm,const float*gqn,float qeps){
  int tid_=threadIdx.x; asm volatile("":"+v"(tid_)); const int tid=tid_,lane=tid&63,r32=lane&31,hi=lane>>5; const int wid=__builtin_amdgcn_readfirstlane(tid>>6);
  const long rowbase=(long)b*TPAD; const int q0=64+qb*QB;
  const bf16*Qw=Q+(rowbase+q0+wid*QBLK)*DM+h*D;
  const bf16*Kh=K+rowbase*DM+h*D,*Vh=V+rowbase*DM+h*D;
  const unsigned lds0=(unsigned)(uintptr_t)shm;
  float*wsf=(float*)(shm+LDS_WS)+wid*64;
  const bf16*ksrc=Kh+(long)lane*DM+wid*8;
  const bf16*vsrc=Vh+(long)(16*(wid&3)+(lane>>2))*DM+(wid>>2)*32+(lane&3)*8;
  const unsigned kdst=lds0+LDS_K+wid*1024, vdst=lds0+LDS_V+wid*1024;
  #define DMA_K(t,slot) glds16(ksrc+(long)(t)*KVBLK*DM,(unsigned)__builtin_amdgcn_readfirstlane(kdst+(slot)))
  #define DMA_V(t,slot) glds16(vsrc+(long)(t)*KVBLK*DM,(unsigned)__builtin_amdgcn_readfirstlane(vdst+(slot)))
  const int vb0=(int)(lds0+LDS_V)+((lane>>4)&1)*32+(lane&3)*8+(4*hi+((lane&15)>>2))*64;
  const char*Kbase=shm+LDS_K; bf16x8 kf[8];
  const lds_cptr shm3=(lds_cptr)shm; const lds_cptr kp0=shm3+LDS_K+hi*1024+r32*16; const lds_cptr vp0=shm3+LDS_V+((lane>>4)&1)*32+(lane&3)*8+(4*hi+((lane&15)>>2))*64;
  const int NT=(q0+QB)/KVBLK;
  typedef __attribute__((address_space(3))) const f32x4k* lds_f4p; const __attribute__((address_space(3))) float* kbp0=(const __attribute__((address_space(3))) float*)(shm3+LDS_KB)+4*hi;
  #define KBINIT(C0,C1,t) do{ const __attribute__((address_space(3))) float* kp_=kbp0+(t)*64; _Pragma("unroll") for(int g_=0;g_<4;++g_){ const f32x4k a_=*(lds_f4p)(kp_+8*g_); const f32x4k b_=*(lds_f4p)(kp_+32+8*g_); _Pragma("unroll") for(int e_=0;e_<4;++e_){ C0[4*g_+e_]=a_[e_]-mhat; C1[4*g_+e_]=b_[e_]-mhat; } } }while(0)
  DMA_K(0,0);DMA_V(0,0);DMA_K(1,SLOTB);
  bf16x8 qr[4];
  #pragma unroll
  for(int d0=0;d0<4;++d0)qr[d0]=*reinterpret_cast<const bf16x8*>(&Qw[(long)r32*DM+d0*16+hi*8]);
  {
    typedef unsigned u32x4n __attribute__((ext_vector_type(4))); typedef float f32x4n __attribute__((ext_vector_type(4)));
    float qf[4][8]; float ss=0.f;
    #pragma unroll
    for(int d0=0;d0<4;++d0){ const u32x4n w=__builtin_bit_cast(u32x4n,qr[d0]); const unsigned w0=w.x,w1=w.y,w2=w.z,w3=w.w;
      qf[d0][0]=__uint_as_float(w0<<16);qf[d0][1]=__uint_as_float(w0&0xffff0000u);qf[d0][2]=__uint_as_float(w1<<16);qf[d0][3]=__uint_as_float(w1&0xffff0000u);
      qf[d0][4]=__uint_as_float(w2<<16);qf[d0][5]=__uint_as_float(w2&0xffff0000u);qf[d0][6]=__uint_as_float(w3<<16);qf[d0][7]=__uint_as_float(w3&0xffff0000u);
      _Pragma("unroll") for(int j=0;j<8;++j)ss+=qf[d0][j]*qf[d0][j]; }
    { auto rr=__builtin_amdgcn_permlane32_swap(__float_as_uint(ss),__float_as_uint(ss),false,false); ss=__uint_as_float(rr[0])+__uint_as_float(rr[1]); }
    const float rq=C2/sqrtf(ss*(1.f/64.f)+qeps);
    #pragma unroll
    for(int d0=0;d0<4;++d0){ const f32x4n g0=*reinterpret_cast<const f32x4n*>(gqn+d0*16+hi*8), g1=*reinterpret_cast<const f32x4n*>(gqn+d0*16+hi*8+4);
      u32x4n w; w.x=cvtpk_s(qf[d0][0]*rq*g0.x,qf[d0][1]*rq*g0.y); w.y=cvtpk_s(qf[d0][2]*rq*g0.z,qf[d0][3]*rq*g0.w);
      w.z=cvtpk_s(qf[d0][4]*rq*g1.x,qf[d0][5]*rq*g1.y); w.w=cvtpk_s(qf[d0][6]*rq*g1.z,qf[d0][7]*rq*g1.w);
      qr[d0]=__builtin_bit_cast(bf16x8,w); } }
  float mhat=0.f,l_reg=0.f;f32x16 o[2];o[0]=f32x16{};o[1]=f32x16{};
  const int qrel=wid*QBLK+r32;
  #define CMASK(P0,P1,t) do{int jb_=(t)-(NT-4); if(jb_>=0)cmask(P0,P1,jb_,qrel,hi);}while(0)
  bool resc=false;
  #define START(P0,P1) do{ const float rm=rowmax(P0,P1); resc=false; \
    { const float dl=rm; mhat=fadd_s(mhat,dl); \
      _Pragma("unroll") for(int r=0;r<16;++r){P0[r]=fsub_s(P0[r],dl);P1[r]=fsub_s(P1[r],dl);} } \
    _Pragma("unroll") for(int r=0;r<16;++r)P0[r]=__builtin_amdgcn_exp2f(P0[r]); }while(0)
  #define RESC() do{ if(resc){ asm volatile("s_waitcnt lgkmcnt(0)":::"memory"); \
      _Pragma("unroll") for(int d_=0;d_<2;++d_) _Pragma("unroll") for(int r=0;r<16;++r)o[d_][r]*=wsf[crow(r,hi)]; } }while(0)
  f32x16 pA0,pA1,pB0,pB1;
  int sl_prev=0,sl_cur=0,sl_next=SLOTB;
  #define ROT() do{sl_prev=sl_cur;sl_cur=sl_next;sl_next=(sl_next==(NSLOT-1)*SLOTB)?0:sl_next+SLOTB;}while(0)
  DMA_K(2,2*SLOTB);
  WAIT_BAR(3);
  KBINIT(pA0,pA1,0); qkt(pA0,pA1,Kbase,qr,r32,hi);asm volatile("s_nop 15\n\ts_nop 7":"+v"(pA0),"+v"(pA1));CMASK(pA0,pA1,0);
  START(pA0,pA1);
  _Pragma("unroll") for(int r=0;r<16;++r)pA1[r]=__builtin_amdgcn_exp2f(pA1[r]);
  WAIT_BAR(0);
  DMA_K(3,0);DMA_V(1,SLOTB);
  ROT();
  kload8(kf,kp0+sl_cur);
  WAIT_BAR(2);
  s16x4 vlo[8],vhi[8]; u32x4 pw0,pw1,pw2,pw3;
  #define PKW(P,B) cvtpk_s(P[B],P[B+1])
  #define PAF(k) __builtin_bit_cast(bf16x8,pw##k)
  #define VFR(i) (bf16x8){vlo[i][0],vlo[i][1],vlo[i][2],vlo[i][3],vhi[i][0],vhi[i][1],vhi[i][2],vhi[i][3]}
  #define PIN(x) asm volatile("":"+v"(x))
  #define MX3(a,b,c) __builtin_fmaxf(__builtin_fmaxf((a),(b)),(c))
  #define GAPA(MF,A0,A1,A2,A3,W0,W1,PW) do{ MF; sacc+=A0; sacc+=A1; sacc+=A2; sacc+=A3; PIN(sacc); W0; W1; PIN(PW); SBAR(); }while(0)
  #define EX(v) __builtin_amdgcn_exp2f(v)
  #define GAPB(MF,X,B) do{ MF; X[B]=EX(X[B]); X[B+1]=EX(X[B+1]); X[B+2]=EX(X[B+2]); X[B+3]=EX(X[B+3]); PIN(X); SBAR(); }while(0)
  #define VRD(i) do{ vlo[i]=vtr(vp_+(((i)>>2)*4096+((i)&3)*1024)); vhi[i]=vtr(vp_+(((i)>>2)*4096+((i)&3)*1024+512)); }while(0)
  #define KRD(G,j) do{ if(G){ kload2(kf,kp0+sl_next,j); SBAR(); } }while(0)
  #define STEP(C0,C1,P0,P1,t,GK,GV,GL) do{ SBAR(); \
    const lds_cptr vp_=vp0+sl_prev; \
    KBINIT(C0,C1,t); SBAR(); \
    VRD(0); SBAR(); float sacc=(P0[0]+P0[1]); \
    GAPA(C0=__builtin_amdgcn_mfma_f32_32x32x16_bf16(kf[0],qr[0],C0,0,0,0), P0[2],P0[3],P0[4],P0[5],     pw0[0]=PKW(P0,0), pw0[1]=PKW(P0,2), pw0); \
    VRD(4); SBAR(); GAPA(C1=__builtin_amdgcn_mfma_f32_32x32x16_bf16(kf[1],qr[0],C1,0,0,0), P0[6],P0[7],P0[8],P0[9],     pw0[2]=PKW(P0,4), pw0[3]=PKW(P0,6), pw0); \
    VRD(1); SBAR(); GAPA(C0=__builtin_amdgcn_mfma_f32_32x32x16_bf16(kf[2],qr[1],C0,0,0,0),   P0[10],P0[11],P0[12],P0[13], pw1[0]=PKW(P0,8), pw1[1]=PKW(P0,10), pw1); \
    VRD(5); SBAR(); GAPA(C1=__builtin_amdgcn_mfma_f32_32x32x16_bf16(kf[3],qr[1],C1,0,0,0),   P0[14],P0[15],P1[0],P1[1],   pw1[2]=PKW(P0,12),pw1[3]=PKW(P0,14), pw1); \
    VRD(2); SBAR(); GAPA(C0=__builtin_amdgcn_mfma_f32_32x32x16_bf16(kf[4],qr[2],C0,0,0,0),   P1[2],P1[3],P1[4],P1[5],     pw2[0]=PKW(P1,0), pw2[1]=PKW(P1,2), pw2); \
    VRD(6); SBAR(); GAPA(C1=__builtin_amdgcn_mfma_f32_32x32x16_bf16(kf[5],qr[2],C1,0,0,0),   P1[6],P1[7],P1[8],P1[9],     pw2[2]=PKW(P1,4), pw2[3]=PKW(P1,6), pw2); \
    VRD(3); SBAR(); GAPA(C0=__builtin_amdgcn_mfma_f32_32x32x16_bf16(kf[6],qr[3],C0,0,0,0),   P1[10],P1[11],P1[12],P1[13], pw3[0]=PKW(P1,8), pw3[1]=PKW(P1,10), pw3); \
    VRD(7); SBAR(); GAPA(C1=__builtin_amdgcn_mfma_f32_32x32x16_bf16(kf[7],qr[3],C1,0,0,0),   P1[14],P1[15],0.f,0.f,       pw3[2]=PKW(P1,12),pw3[3]=PKW(P1,14), pw3); \
    l_reg+=sacc; \
    if(GK){DMA_K((t)+3,sl_cur);} if(GV){DMA_V((t)+1,sl_next);} \
    CMASK(C0,C1,t); \
    { float a=MX3(C0[0],C0[1],C1[0]),b=MX3(C0[2],C0[3],C1[1]); a=MX3(a,C1[2],C1[3]); \
      _Pragma("unroll") for(int r=4;r<16;r+=4){a=MX3(a,C0[r],C0[r+1]);b=MX3(b,C0[r+2],C0[r+3]);a=MX3(a,C1[r],C1[r+1]);b=MX3(b,C1[r+2],C1[r+3]);} \
      float rm=__builtin_fmaxf(a,b); { auto rr=__builtin_amdgcn_permlane32_swap(__float_as_uint(rm),__float_as_uint(rm),false,false); rm=__builtin_fmaxf(__uint_as_float(rr[0]),__uint_as_float(rr[1])); } \
      resc=false; \
      if(__builtin_expect(__any(rm>(float)THRL),0)){ const float dl=__builtin_fmaxf(rm,0.f); mhat+=dl; \
        _Pragma("unroll") for(int r=0;r<16;++r){C0[r]-=dl;C1[r]-=dl;} \
        const float f=__builtin_amdgcn_exp2f(-dl); l_reg*=f; if(hi==0)wsf[r32]=f; resc=true; } } \
    SBAR(); \
    GAPB(o[0]=__builtin_amdgcn_mfma_f32_32x32x16_bf16(PAF(0),VFR(0),o[0],0,0,0), C0,0); \
    GAPB(o[1]=__builtin_amdgcn_mfma_f32_32x32x16_bf16(PAF(0),VFR(4),o[1],0,0,0), C0,4); \
    KRD(GL,0); GAPB(o[0]=__builtin_amdgcn_mfma_f32_32x32x16_bf16(PAF(1),VFR(1),o[0],0,0,0), C0,8); \
    KRD(GL,1); GAPB(o[1]=__builtin_amdgcn_mfma_f32_32x32x16_bf16(PAF(1),VFR(5),o[1],0,0,0), C0,12); \
    KRD(GL,2); GAPB(o[0]=__builtin_amdgcn_mfma_f32_32x32x16_bf16(PAF(2),VFR(2),o[0],0,0,0), C1,0); \
    KRD(GL,3); GAPB(o[1]=__builtin_amdgcn_mfma_f32_32x32x16_bf16(PAF(2),VFR(6),o[1],0,0,0), C1,4); \
    GAPB(o[0]=__builtin_amdgcn_mfma_f32_32x32x16_bf16(PAF(3),VFR(3),o[0],0,0,0), C1,8); \
    GAPB(o[1]=__builtin_amdgcn_mfma_f32_32x32x16_bf16(PAF(3),VFR(7),o[1],0,0,0), C1,12); \
    }while(0)
  int t=1;
  #undef CMASK
  #define CMASK(P0,P1,t) do{}while(0)
  for(;t+5<NT;t+=2){
    STEP(pB0,pB1,pA0,pA1,t,true,true,true);     WAIT_BAR(2); RESC(); ROT();
    STEP(pA0,pA1,pB0,pB1,t+1,true,true,true);   WAIT_BAR(2); RESC(); ROT();
  }
  #undef CMASK
  #define CMASK(P0,P1,t) do{int jb_=(t)-(NT-4); if(jb_>=0)cmask(P0,P1,jb_,qrel,hi);}while(0)
  #define ENDW(tt) do{ if((tt)+3<NT){WAIT_BAR(2);} else if((tt)+2<NT){WAIT_BAR(1);} else {WAIT_BAR(0);} }while(0)
  for(;t+1<NT;t+=2){
    STEP(pB0,pB1,pA0,pA1,t,(t+3<NT),(t+1<NT),(t+1<NT));       ENDW(t);   RESC(); ROT();
    STEP(pA0,pA1,pB0,pB1,t+1,(t+4<NT),(t+2<NT),(t+2<NT));     ENDW(t+1); RESC(); ROT();
  }
  { float sacc=pA0[0]+pA0[1]; _Pragma("unroll") for(int r=2;r<16;++r)sacc+=pA0[r]; _Pragma("unroll") for(int r=0;r<16;++r)sacc+=pA1[r]; l_reg+=sacc;
    pw0=(u32x4){PKW(pA0,0),PKW(pA0,2),PKW(pA0,4),PKW(pA0,6)};pw1=(u32x4){PKW(pA0,8),PKW(pA0,10),PKW(pA0,12),PKW(pA0,14)};pw2=(u32x4){PKW(pA1,0),PKW(pA1,2),PKW(pA1,4),PKW(pA1,6)};pw3=(u32x4){PKW(pA1,8),PKW(pA1,10),PKW(pA1,12),PKW(pA1,14)};
    SBAR(); pv(o,vb0+sl_prev,PAF(0),PAF(1),PAF(2),PAF(3)); }
  #undef PKW
  #undef PAF
  #undef VFR
  #undef PIN
  #undef MX3
  #undef GAPA
  #undef GAPB
  #undef EX
  #undef VRD
  #undef KRD
  #undef STEP
  #undef ENDW
  {auto rr=__builtin_amdgcn_permlane32_swap(__float_as_uint(l_reg),__float_as_uint(l_reg),false,false);l_reg=__uint_as_float(rr[0])+__uint_as_float(rr[1]);}
  if(hi==0)wsf[32+r32]=l_reg;asm volatile("s_waitcnt lgkmcnt(0)":::"memory");
  float rli[16];
  #pragma unroll
  for(int r=0;r<16;++r)rli[r]=__builtin_amdgcn_rcpf(wsf[32+crow(r,hi)]);
  bf16*Ow=O+(rowbase+q0+wid*QBLK)*DM+h*D;
  { bf16*stg=(bf16*)(shm+LDS_OST)+wid*2048;
    #pragma unroll
    for(int r=0;r<16;++r){const int orow=crow(r,hi);
      #pragma unroll
      for(int d0=0;d0<2;++d0)stg[orow*64+d0*32+r32]=__float2bfloat16(o[d0][r]*rli[r]);}
    asm volatile("s_waitcnt lgkmcnt(0)":::"memory");
    #pragma unroll
    for(int i=0;i<4;++i){const int row=i*8+(lane>>3),ch=lane&7; const u32x4 v=*(const u32x4*)(stg+row*64+ch*8); ATTN_STORE16(Ow+(long)row*DM+ch*8,v);} }
  asm volatile("s_waitcnt lgkmcnt(0)\n\ts_barrier":::"memory");
  #undef DMA_K
  #undef DMA_V
  #undef CMASK
  #undef START
  #undef RESC
  #undef ROT
  #undef KBINIT
}
constexpr int ATTN_LDS_BYTES=LDS_BYTES;
#undef SBAR
#undef WAIT_BAR
}

#define LAS __attribute__((address_space(3)))
typedef unsigned short bf16;
typedef unsigned v4u __attribute__((ext_vector_type(4)));
typedef unsigned v2u __attribute__((ext_vector_type(2)));
typedef float f32x4 __attribute__((ext_vector_type(4)));
typedef short bf16x8 __attribute__((ext_vector_type(8)));
typedef float f32x16v __attribute__((ext_vector_type(16)));

constexpr int NB = 16, SEQ = 4096, DMODEL = 1024, NMETA = 16;
constexpr int TP = 4160;
constexpr int R = NB * TP;
constexpr int NTOK = NB * SEQ;
constexpr int N1 = 5632;
constexpr int IN_COLS = 5416;
constexpr int NWAVES = 8, NTHREADS = 512;
constexpr float NORM_EPS = 1e-6f, GN_EPS = 64e-5f;
constexpr float LOG2E = 1.4426950408889634f;

constexpr size_t MiB = 1u << 20;
constexpr size_t U65 = 65 * MiB;
constexpr size_t WS_WTIN = 1 * MiB;
constexpr size_t WS_WTQ = 12 * MiB;
constexpr size_t WS_WTFOX = 16 * MiB;
constexpr size_t WS_WTRWKV = 17 * MiB;
constexpr size_t WS_WTOUT = 18 * MiB;
constexpr size_t WS_WTWA = 20 * MiB;
constexpr size_t WS_WTG = 20 * MiB + 512 * 1024;
constexpr size_t WS_KS = 21 * MiB;
constexpr size_t WS_KB = 22 * MiB;
constexpr size_t WS_LF = 25 * MiB;
constexpr size_t WS_BS = 29 * MiB;
constexpr size_t WS_SXN = 28 * MiB;
constexpr size_t WS_SWIN = 9 * MiB;
constexpr size_t WS_SWQ = 15 * MiB;
constexpr size_t WS_U8 = 32 * MiB;
constexpr size_t WS_SU = 48 * MiB;
constexpr size_t WS_V8 = 64 * MiB;
constexpr size_t WS_SV = 80 * MiB;
constexpr size_t WS_CORR = 81 * MiB;
constexpr size_t WS_SX = 82 * MiB;
constexpr size_t WS_XQ = 352 * MiB;
constexpr size_t WS_F = 96 * MiB;
constexpr size_t WS_FQ = WS_F, WS_FK = WS_F + U65, WS_FV = WS_F + 2 * U65, WS_ZRR = WS_F + 3 * U65, WS_ZRK = WS_F + 4 * U65, WS_ZRV = WS_F + 5 * U65, WS_ZM = WS_F + 6 * U65;
constexpr size_t WS_ZG = WS_F + 7 * U65;
constexpr size_t WS_XN = WS_ZG + 4 * U65;
constexpr size_t WS_IDS = 941 * MiB;
constexpr size_t WS_GATES = 973 * MiB;
constexpr size_t WS_END = 1005 * MiB;
constexpr size_t WS_LA = WS_XN;
constexpr size_t WS_LG = WS_XN + 20 * MiB;
constexpr size_t WS_KP = WS_XN;
constexpr size_t WS_KN = WS_XN + U65;
constexpr size_t WS_Y = WS_ZM;
constexpr size_t WS_MIX = WS_XN;
constexpr size_t WS_XN2 = WS_XN;
constexpr size_t WS_PQ = 420 * MiB;
constexpr size_t WS_H1 = 161 * MiB;
constexpr size_t DO_XW = 0, DO_AA = U65, DO_GG = 2 * U65;

typedef float f32x2_cv __attribute__((ext_vector_type(2))); typedef __bf16 bf16x2_cv __attribute__((ext_vector_type(2)));
__device__ __forceinline__ unsigned pk2(float lo, float hi) { const f32x2_cv v = {lo, hi}; const bf16x2_cv b = __builtin_convertvector(v, bf16x2_cv); return __builtin_bit_cast(unsigned, b); }
__device__ __forceinline__ unsigned f2bf(float f) { return pk2(f, 0.f) & 0xffffu; }
__device__ __forceinline__ float bflo(unsigned w) { return __builtin_bit_cast(float, w << 16); }
__device__ __forceinline__ float bfhi(unsigned w) { return __builtin_bit_cast(float, w & 0xffff0000u); }
__device__ __forceinline__ void unpack8(const v4u w, float (&f)[8]) { f[0] = bflo(w.x); f[1] = bfhi(w.x); f[2] = bflo(w.y); f[3] = bfhi(w.y); f[4] = bflo(w.z); f[5] = bfhi(w.z); f[6] = bflo(w.w); f[7] = bfhi(w.w); }
__device__ __forceinline__ v4u pack8(const float (&f)[8]) { v4u w; w.x = pk2(f[0], f[1]); w.y = pk2(f[2], f[3]); w.z = pk2(f[4], f[5]); w.w = pk2(f[6], f[7]); return w; }
__device__ __forceinline__ float sigmoidf_(float x) { return __builtin_amdgcn_rcpf(1.0f + __builtin_amdgcn_exp2f(-x * LOG2E)); }
template <int CTRL> __device__ __forceinline__ float dppf(float x) { return __uint_as_float(__builtin_amdgcn_update_dpp(0u, __float_as_uint(x), CTRL, 0xF, 0xF, true)); }
__device__ __forceinline__ float wave_sum(float v) {
    v += dppf<0xB1>(v); v += dppf<0x4E>(v); v += dppf<0x141>(v); v += dppf<0x140>(v);
    { auto r = __builtin_amdgcn_permlane16_swap(__float_as_uint(v), __float_as_uint(v), false, false); v = __uint_as_float(r[0]) + __uint_as_float(r[1]); }
    { auto r = __builtin_amdgcn_permlane32_swap(__float_as_uint(v), __float_as_uint(v), false, false); v = __uint_as_float(r[0]) + __uint_as_float(r[1]); }
    return v;
}
__device__ __forceinline__ float wave_max(float v) {
    v = fmaxf(v, dppf<0xB1>(v)); v = fmaxf(v, dppf<0x4E>(v)); v = fmaxf(v, dppf<0x141>(v)); v = fmaxf(v, dppf<0x140>(v));
    { auto r = __builtin_amdgcn_permlane16_swap(__float_as_uint(v), __float_as_uint(v), false, false); v = fmaxf(__uint_as_float(r[0]), __uint_as_float(r[1])); }
    { auto r = __builtin_amdgcn_permlane32_swap(__float_as_uint(v), __float_as_uint(v), false, false); v = fmaxf(__uint_as_float(r[0]), __uint_as_float(r[1])); }
    return v;
}
__device__ __forceinline__ float sum8(float v) { v += dppf<0xB1>(v); v += dppf<0x4E>(v); v += dppf<0x141>(v); return v; }
__device__ __forceinline__ unsigned q8x4(float a, float b, float c, float d, float inv) {
    const unsigned qa = __float_as_uint(fmaf(a, inv, 12582912.0f)), qb = __float_as_uint(fmaf(b, inv, 12582912.0f)), qc = __float_as_uint(fmaf(c, inv, 12582912.0f)), qd = __float_as_uint(fmaf(d, inv, 12582912.0f));
    return __builtin_amdgcn_perm(__builtin_amdgcn_perm(qd, qc, 0x0c0c0400u), __builtin_amdgcn_perm(qb, qa, 0x0c0c0400u), 0x05040100u);
}

struct Params {
    const float* in[27];
    float* out;
    unsigned char* ws;
};
enum { I_X = 0, I_META, I_N1G, I_WIN, I_FQN, I_FKN, I_FBIAS, I_MU, I_W0, I_WUP, I_A0, I_AUP, I_GUP, I_KK, I_KA, I_RK, I_LNG, I_LNB, I_WFOX, I_WRWKV, I_WOUT, I_N2G, I_PWQ, I_SK1, I_SK2, I_PU, I_PV };

__device__ __forceinline__ int win_src_col(int n) {
    if (n < 1536) return n;
    if (n < 3072) return 1544 + (n - 1536);
    if (n < 3584) { const int m = n - 3072; if (m < 288) return 3080 + m; if (m < 296) return 1536 + (m - 288); return -1; }
    return 3368 + (n - 3584);
}
template <bool REMAP>
__device__ __forceinline__ void transpose_item(const float* W, int ldw, int K, int N, bf16* WT, LAS float* scr, int item, int lane) {
    const int nblk = N / 32, kb = item / nblk, nb = item % nblk, k0 = 64 * kb, n0 = 32 * nb;
    const int n = n0 + (lane & 31); const int sc = REMAP ? win_src_col(n) : n;
#pragma unroll 8
    for (int i = 0; i < 32; ++i) { const int kk = 2 * i + (lane >> 5); scr[kk * 33 + (lane & 31)] = (sc >= 0) ? W[(size_t)(k0 + kk) * ldw + sc] : 0.f; }
    asm volatile("s_waitcnt lgkmcnt(0)" ::: "memory");
    const int c = lane & 7;
#pragma unroll
    for (int j = 0; j < 4; ++j) { const int nn = (lane >> 3) + 8 * j; const LAS float* s = scr + (8 * c) * 33 + nn;
        v4u o; o.x = pk2(s[0 * 33], s[1 * 33]); o.y = pk2(s[2 * 33], s[3 * 33]); o.z = pk2(s[4 * 33], s[5 * 33]); o.w = pk2(s[6 * 33], s[7 * 33]);
        *(v4u*)(WT + (size_t)(n0 + nn) * K + k0 + 8 * c) = o; }
    asm volatile("s_waitcnt lgkmcnt(0)" ::: "memory");
}
template <bool REMAP>
__device__ __forceinline__ void transpose_q8_item(const float* W, int ldw, unsigned char* WT8, float* SW, LAS float* scr, LAS float* cmax, int item, int wave, int lane) {
    const int n0 = 32 * item, n = n0 + (lane & 31); const int sc = REMAP ? win_src_col(n) : n;
    const float* Wc = W + (size_t)(128 * wave + (lane >> 5)) * ldw + (sc >= 0 ? sc : 0);
    float wv[64];
#pragma unroll
    for (int i = 0; i < 64; ++i) wv[i] = Wc[(size_t)(2 * i) * ldw];
    float m = 0.f;
#pragma unroll
    for (int i = 0; i < 64; ++i) m = fmaxf(m, fabsf(wv[i]));
    if (sc < 0) m = 0.f;
    m = fmaxf(m, __shfl_xor(m, 32));
    if (lane < 32) cmax[wave * 32 + lane] = m;
    __syncthreads();
    m = 0.f;
#pragma unroll
    for (int w = 0; w < 8; ++w) m = fmaxf(m, cmax[w * 32 + (lane & 31)]);
    const float inv = m > 0.f ? 127.0f / m : 0.f;
    if (wave == 0 && lane < 32) SW[n] = m > 0.f ? m * (1.0f / 127.0f) : 1.0f;
#pragma unroll
    for (int blk = 0; blk < 2; ++blk) {
        const int k0 = 128 * wave + 64 * blk;
#pragma unroll
        for (int i = 0; i < 32; ++i) scr[(2 * i + (lane >> 5)) * 33 + (lane & 31)] = wv[32 * blk + i] * inv;
        asm volatile("s_waitcnt lgkmcnt(0)" ::: "memory");
        const int c = lane & 3;
#pragma unroll
        for (int j = 0; j < 2; ++j) { const int nn = (lane >> 2) + 16 * j; const LAS float* sp = scr + (16 * c) * 33 + nn;
            unsigned w[4];
#pragma unroll
            for (int d = 0; d < 4; ++d) { const int q0 = (int)rintf(sp[(4 * d) * 33]), q1 = (int)rintf(sp[(4 * d + 1) * 33]), q2 = (int)rintf(sp[(4 * d + 2) * 33]), q3 = (int)rintf(sp[(4 * d + 3) * 33]);
                w[d] = (unsigned)(q0 & 255) | ((unsigned)(q1 & 255) << 8) | ((unsigned)(q2 & 255) << 16) | ((unsigned)(q3 & 255) << 24); }
            v4u o; o.x = w[0]; o.y = w[1]; o.z = w[2]; o.w = w[3];
            *(v4u*)(WT8 + (size_t)(n0 + nn) * 1024 + k0 + 16 * c) = o; }
        asm volatile("s_waitcnt lgkmcnt(0)" ::: "memory");
    }
    __syncthreads();
}
__device__ __forceinline__ void p0_prologue(const Params& p, LAS unsigned char* lds, int vcu, int G, int wave, int lane) {
    unsigned char* ws = p.ws;
    LAS float* scr = (LAS float*)(lds + wave * 16384);
    const int gw = vcu * NWAVES + wave, NGW = G * NWAVES;
    constexpr int I_IN = N1 / 32, I_Q = 2048 / 32, I_FX = 8 * 32, I_O = 16 * 32;
    const int gt = gw * 64 + lane, NGT = NGW * 64;
    float pre1 = 0.f, pre2 = 0.f, pre3 = 0.f;
    if (gt < 1024 * 128) { const int n = gt >> 7, k = gt & 127; if (n < 512) { if (k < 64) pre1 = p.in[I_WUP][k * 512 + n]; } else { if (k >= 64) pre1 = p.in[I_AUP][(k - 64) * 512 + (n - 512)]; } }
    if (gt < 512 * 256) { const int n = gt >> 8, k = gt & 255; if (k < 160) pre2 = p.in[I_GUP][k * 512 + n]; }
    if (gt < 2 * 128 * 128) pre3 = (gt < 16384) ? p.in[I_SK1][gt] : p.in[I_SK2][gt - 16384];
    {
        LAS float* cmax = (LAS float*)(lds + 8 * 16384);
        for (int it = vcu; it < I_IN + I_Q; it += G) {
            if (it < I_IN) transpose_q8_item<true>(p.in[I_WIN], IN_COLS, ws + WS_WTIN, (float*)(ws + WS_SWIN), scr, cmax, it, wave, lane);
            else transpose_q8_item<false>(p.in[I_PWQ], 2048, ws + WS_WTQ, (float*)(ws + WS_SWQ), scr, cmax, it - I_IN, wave, lane);
        }
    }
#ifdef PQ_BF16
    for (int it = gw; it < 16 * 64; it += NGW) transpose_item<false>(p.in[I_PWQ], 2048, 1024, 2048, (bf16*)(ws + 1010 * MiB), scr, it, lane);
#endif
    constexpr int NITEMS = 2 * I_FX + I_O;
    for (int it = gw; it < NITEMS; it += NGW) {
        int r = it;
        if (r < I_FX) { transpose_item<false>(p.in[I_WFOX], 1024, 512, 1024, (bf16*)(ws + WS_WTFOX), scr, r, lane); continue; } r -= I_FX;
        if (r < I_FX) { transpose_item<false>(p.in[I_WRWKV], 1024, 512, 1024, (bf16*)(ws + WS_WTRWKV), scr, r, lane); continue; } r -= I_FX;
        transpose_item<false>(p.in[I_WOUT], 1024, 1024, 1024, (bf16*)(ws + WS_WTOUT), scr, r, lane);
    }
    if (gt < 1024 * 128) ((bf16*)(ws + WS_WTWA))[gt] = (bf16)f2bf(pre1);
    if (gt < 512 * 256) ((bf16*)(ws + WS_WTG))[gt] = (bf16)f2bf(pre2);
    if (gt < 2 * 128 * 128) ((bf16*)(ws + WS_KS))[gt] = (bf16)f2bf(pre3);
    for (int i = gt + NGT; i < 1024 * 128; i += NGT) { const int n = i >> 7, k = i & 127; float v = 0.f;
        if (n < 512) { if (k < 64) v = p.in[I_WUP][k * 512 + n]; } else { if (k >= 64) v = p.in[I_AUP][(k - 64) * 512 + (n - 512)]; }
        ((bf16*)(ws + WS_WTWA))[i] = (bf16)f2bf(v); }
    for (int i = gt + NGT; i < 512 * 256; i += NGT) { const int n = i >> 8, k = i & 255; const float v = (k < 160) ? p.in[I_GUP][k * 512 + n] : 0.f; ((bf16*)(ws + WS_WTG))[i] = (bf16)f2bf(v); }
    for (int i = gt + NGT; i < 2 * 128 * 128; i += NGT) { const float v = (i < 16384) ? p.in[I_SK1][i] : p.in[I_SK2][i - 16384]; ((bf16*)(ws + WS_KS))[i] = (bf16)f2bf(v); }
    for (int r0 = gw; r0 < 32768; r0 += 4 * NGW) {
        f32x4 a[4][4]; float m[4];
#pragma unroll
        for (int u = 0; u < 4; ++u) { const int r = r0 + u * NGW; const int tbl = r >> 14, row = r & 16383;
            const int rr = r < 32768 ? row : 0; const int tb = r < 32768 ? tbl : 0;
            const f32x4* src = (const f32x4*)((tb ? p.in[I_PV] : p.in[I_PU]) + (size_t)rr * 1024 + 16 * lane);
#pragma unroll
            for (int j = 0; j < 4; ++j) a[u][j] = src[j]; }
#pragma unroll
        for (int u = 0; u < 4; ++u) { m[u] = 0.f;
#pragma unroll
            for (int j = 0; j < 4; ++j) m[u] = fmaxf(m[u], fmaxf(fmaxf(fabsf(a[u][j].x), fabsf(a[u][j].y)), fmaxf(fabsf(a[u][j].z), fabsf(a[u][j].w)))); }
#pragma unroll
        for (int u = 0; u < 4; ++u) m[u] = wave_max(m[u]);
#pragma unroll
        for (int u = 0; u < 4; ++u) { const int r = r0 + u * NGW; if (r >= 32768) continue; const int tbl = r >> 14, row = r & 16383;
            const float inv = m[u] > 0.f ? 127.0f / m[u] : 0.f;
            unsigned ww[4];
#pragma unroll
            for (int j = 0; j < 4; ++j) ww[j] = q8x4(a[u][j].x, a[u][j].y, a[u][j].z, a[u][j].w, inv);
            v4u w; w.x = ww[0]; w.y = ww[1]; w.z = ww[2]; w.w = ww[3];
            *(v4u*)(ws + (tbl ? WS_V8 : WS_U8) + (size_t)row * 1024 + 16 * lane) = w;
            if (lane == 0) ((float*)(ws + (tbl ? WS_SV : WS_SU)))[row] = m[u] > 0.f ? m[u] * (1.0f / 127.0f) : 1.0f; }
    }
    const f32x4* g4 = (const f32x4*)p.in[I_N1G] + lane;
    for (int m0 = gw; m0 < R; m0 += 4 * NGW) {
        f32x4 v[4][4]; float s[4], mx[4]; bool live[4];
#pragma unroll
        for (int u = 0; u < 4; ++u) { const int m = m0 + u * NGW; const int mm = m < R ? m : gw; const int b = mm / TP, pp = mm - b * TP;
            live[u] = (m < R) && (pp >= 48);
            const float* xrow = (pp < 64) ? p.in[I_META] + (size_t)(pp >= 48 ? pp - 48 : 0) * 1024 : p.in[I_X] + ((size_t)b * SEQ + (pp - 64)) * 1024;
            const f32x4* xr = (const f32x4*)xrow + lane;
#pragma unroll
            for (int j = 0; j < 4; ++j) v[u][j] = xr[64 * j]; }
#pragma unroll
        for (int u = 0; u < 4; ++u) { s[u] = 0.f;
#pragma unroll
            for (int j = 0; j < 4; ++j) s[u] += (v[u][j].x * v[u][j].x + v[u][j].y * v[u][j].y) + (v[u][j].z * v[u][j].z + v[u][j].w * v[u][j].w); }
#pragma unroll
        for (int u = 0; u < 4; ++u) s[u] = wave_sum(s[u]);
#pragma unroll
        for (int u = 0; u < 4; ++u) { const float rs = __builtin_amdgcn_rsqf(s[u] * (1.f / 1024.f) + NORM_EPS); mx[u] = 0.f;
#pragma unroll
            for (int j = 0; j < 4; ++j) { const f32x4 g = g4[64 * j]; v[u][j].x *= rs * g.x; v[u][j].y *= rs * g.y; v[u][j].z *= rs * g.z; v[u][j].w *= rs * g.w;
                mx[u] = fmaxf(mx[u], fmaxf(fmaxf(fabsf(v[u][j].x), fabsf(v[u][j].y)), fmaxf(fabsf(v[u][j].z), fabsf(v[u][j].w)))); } }
#pragma unroll
        for (int u = 0; u < 4; ++u) mx[u] = wave_max(mx[u]);
#pragma unroll
        for (int u = 0; u < 4; ++u) { const int m = m0 + u * NGW; if (m >= R) continue;
            unsigned* o4 = (unsigned*)(ws + WS_XN + (size_t)m * 1024) + lane;
            const float inv = (live[u] && mx[u] > 0.f) ? 127.0f / mx[u] : 0.f;
#pragma unroll
            for (int j = 0; j < 4; ++j) o4[64 * j] = q8x4(v[u][j].x, v[u][j].y, v[u][j].z, v[u][j].w, inv);
            if (lane == 0) ((float*)(ws + WS_SXN))[m] = (live[u] && mx[u] > 0.f) ? mx[u] * (1.0f / 127.0f) : 1.0f; }
    }
}

struct NoCtx {};
template <class F> struct EpiT {
    static constexpr bool PERM = true, AFTER_DRAIN = false;
    F f;
    __device__ __forceinline__ void operator()(const pg8::f32x4 (&acc)[2][2][4][2], const pg8::Unit& u, int wr, int wc, int fr, int fq) const {
        const int row0 = u.pm * 256 + wr * 64 + fr, col0 = u.pn * 256 + wc * 32 + 8 * fq;
        constexpr int MB = F::MB;
        if constexpr (F::COL_OUTER) {
#pragma unroll
            for (int bj = 0; bj < 2; ++bj) {
                typename F::Col c1; f.col(col0 + bj * 128, c1);
#pragma unroll
                for (int ai = 0; ai < 2; ++ai)
#pragma unroll
                    for (int m = 0; m < 4; ++m) {
                        const pg8::f32x4 a = acc[ai][bj][m][0], b = acc[ai][bj][m][1];
                        float v[8] = {a[0], a[1], a[2], a[3], b[0], b[1], b[2], b[3]};
                        typename F::Ctx cx; f.store(row0 + ai * 128 + m * 16, col0 + bj * 128, v, cx, c1);
                    }
            }
            return;
        }
        typename F::Col cc[2];
#pragma unroll
        for (int bj = 0; bj < 2; ++bj) f.col(col0 + bj * 128, cc[bj]);
#pragma unroll
        for (int ai = 0; ai < 2; ++ai)
#pragma unroll
            for (int m0 = 0; m0 < 4; m0 += MB) {
                typename F::Ctx cx[MB][2];
#pragma unroll
                for (int mm = 0; mm < MB; ++mm)
#pragma unroll
                    for (int bj = 0; bj < 2; ++bj) f.load(row0 + ai * 128 + (m0 + mm) * 16, col0 + bj * 128, cx[mm][bj]);
#pragma unroll
                for (int mm = 0; mm < MB; ++mm)
#pragma unroll
                    for (int bj = 0; bj < 2; ++bj) {
                        const pg8::f32x4 a = acc[ai][bj][m0 + mm][0], b = acc[ai][bj][m0 + mm][1];
                        float v[8] = {a[0], a[1], a[2], a[3], b[0], b[1], b[2], b[3]};
                        f.store(row0 + ai * 128 + (m0 + mm) * 16, col0 + bj * 128, v, cx[mm][bj], cc[bj]);
                    }
            }
    }
};
struct F_Gemm1 {
    bf16* F; bf16* ZG; const float* gkn; LAS float* scr;
    typedef NoCtx Col; typedef NoCtx Ctx; static constexpr int MB = 1; static constexpr bool COL_OUTER = false, KNORM = true;
    __device__ __forceinline__ void col(int, Col&) const {}
    __device__ __forceinline__ void load(int, int, Ctx&) const {}
    __device__ __forceinline__ void store(int row, int col, float (&v)[8], const Ctx&, const Col&) const { if (col < 3584) store_t<false>(row, col, v); else store_t<true>(row, col, v); }
    template <bool GATE> __device__ __forceinline__ void store_t(int row, int col, float (&v)[8]) const {
        if constexpr (!GATE) { const int buf = col >> 9, c = col & 511; *(v4u*)(F + (size_t)buf * ((size_t)R * 512) + (size_t)row * 512 + c) = pack8(v); }
        else { const int c = col - 3584;
            unsigned q[8];
#pragma unroll
            for (int e = 0; e < 8; ++e) q[e] = __float_as_uint(fmaf(sigmoidf_(v[e]), 255.0f, 8388608.0f));
            v2u w;
            w.x = __builtin_amdgcn_perm(__builtin_amdgcn_perm(q[3], q[2], 0x0c0c0400u), __builtin_amdgcn_perm(q[1], q[0], 0x0c0c0400u), 0x05040100u);
            w.y = __builtin_amdgcn_perm(__builtin_amdgcn_perm(q[7], q[6], 0x0c0c0400u), __builtin_amdgcn_perm(q[5], q[4], 0x0c0c0400u), 0x05040100u);
            *(v2u*)((unsigned char*)ZG + (size_t)row * 2048 + c) = w; }
    }
};
struct F_LoraW {
    bf16* XW; LAS const float* w0;
    typedef NoCtx Col; typedef NoCtx Ctx; static constexpr int MB = 1; static constexpr bool COL_OUTER = false;
    __device__ __forceinline__ void col(int, Col&) const {}
    __device__ __forceinline__ void load(int, int, Ctx&) const {}
    __device__ __forceinline__ void store(int row, int col, float (&v)[8], const Ctx&, const Col&) const {
        asm volatile("" ::: "memory");
        const f32x4 b0 = *(LAS const f32x4*)(w0 + col), b1 = *(LAS const f32x4*)(w0 + col + 4); const float bb[8] = {b0.x, b0.y, b0.z, b0.w, b1.x, b1.y, b1.z, b1.w};
#pragma unroll
        for (int e = 0; e < 8; ++e) { const float x = v[e] + bb[e];
            v[e] = (-0.60653065971263342f * LOG2E) * sigmoidf_(x); }
        *(v4u*)(XW + (size_t)row * 512 + col) = pack8(v);
    }
};
struct F_LoraA {
    bf16* AA; LAS const float* a0;
    typedef NoCtx Col; typedef NoCtx Ctx; static constexpr int MB = 1; static constexpr bool COL_OUTER = false;
    __device__ __forceinline__ void col(int, Col&) const {}
    __device__ __forceinline__ void load(int, int, Ctx&) const {}
    __device__ __forceinline__ void store(int row, int col, float (&v)[8], const Ctx&, const Col&) const {
        asm volatile("" ::: "memory");
        const f32x4 b0 = *(LAS const f32x4*)(a0 + col), b1 = *(LAS const f32x4*)(a0 + col + 4); const float bb[8] = {b0.x, b0.y, b0.z, b0.w, b1.x, b1.y, b1.z, b1.w};
#pragma unroll
        for (int e = 0; e < 8; ++e) v[e] = sigmoidf_(v[e] + bb[e]);
        *(v4u*)(AA + (size_t)row * 512 + col) = pack8(v);
    }
};
struct F_Plain {
    bf16* O; int ldc;
    typedef NoCtx Col; typedef NoCtx Ctx; static constexpr int MB = 1; static constexpr bool COL_OUTER = false, KNORM = false;
    __device__ __forceinline__ void col(int, Col&) const {}
    __device__ __forceinline__ void load(int, int, Ctx&) const {}
    __device__ __forceinline__ void store(int row, int col, float (&v)[8], const Ctx&, const Col&) const { *(v4u*)(O + (size_t)row * ldc + col) = pack8(v); }
};
struct CtxGate { v2u gq; };
struct CtxMixGate { v4u mix; v2u gq; };
__device__ __forceinline__ void gates8(const v2u gq, float (&g)[8]) {
    g[0] = (float)(gq.x & 0xffu); g[1] = (float)((gq.x >> 8) & 0xffu); g[2] = (float)((gq.x >> 16) & 0xffu); g[3] = (float)(gq.x >> 24);
    g[4] = (float)(gq.y & 0xffu); g[5] = (float)((gq.y >> 8) & 0xffu); g[6] = (float)((gq.y >> 16) & 0xffu); g[7] = (float)(gq.y >> 24);
}
struct F_MixA {
    bf16* MIX; const bf16* ZG;
    typedef NoCtx Col; typedef CtxGate Ctx; static constexpr int MB = 4; static constexpr bool COL_OUTER = false;
    __device__ __forceinline__ void col(int, Col&) const {}
    __device__ __forceinline__ void load(int row, int col, Ctx& c) const { c.gq = *(const v2u*)((const unsigned char*)ZG + ((size_t)(row >> 12) * TP + 64 + (row & 4095)) * 2048 + col); }
    __device__ __forceinline__ void store(int row, int col, float (&v)[8], const Ctx& c, const Col&) const {
        float g[8]; gates8(c.gq, g);
#pragma unroll
        for (int e = 0; e < 8; ++e) v[e] *= g[e] * (1.0f / 255.0f);
        *(v4u*)(MIX + (size_t)row * 1024 + col) = pack8(v);
    }
};
struct F_MixB {
    bf16* MIX; const bf16* ZG;
    typedef NoCtx Col; typedef CtxMixGate Ctx; static constexpr int MB = 4; static constexpr bool COL_OUTER = false;
    __device__ __forceinline__ void col(int, Col&) const {}
    __device__ __forceinline__ void load(int row, int col, Ctx& c) const {
        c.mix = *(const v4u*)(MIX + (size_t)row * 1024 + col);
        c.gq = *(const v2u*)((const unsigned char*)ZG + ((size_t)(row >> 12) * TP + 64 + (row & 4095)) * 2048 + 1024 + col);
    }
    __device__ __forceinline__ void store(int row, int col, float (&v)[8], const Ctx& c, const Col&) const {
        float m[8]; unpack8(c.mix, m);
        float g[8]; gates8(c.gq, g);
#pragma unroll
        for (int e = 0; e < 8; ++e) v[e] = m[e] + v[e] * g[e] * (1.0f / 255.0f);
        *(v4u*)(MIX + (size_t)row * 1024 + col) = pack8(v);
    }
};
template <bool B> struct BoolC { static constexpr bool value = B; };
template <class F> struct EpiI8 {
    static constexpr bool PERM = true, AFTER_DRAIN = false;
    F f; const float* SA; const float* SB; LAS unsigned char* sl;
    __device__ __forceinline__ void unit_begin(const pg8::Unit& u, int ui, int wid, int lane) const {
        const float* src = (wid < 4) ? SA + u.pm * 256 + wid * 64 + lane : SB + u.pn * 256 + (wid - 4) * 64 + lane;
        __builtin_amdgcn_global_load_lds((const unsigned*)src, (LAS unsigned*)(sl + (ui & 1) * 2048 + wid * 256), 4, 0, 0);
    }
    __device__ __forceinline__ void operator()(const pg8::i32x4 (&acc)[2][2][4][2], const pg8::Unit& u, int wr, int wc, int fr, int fq, int ui) const {
        const int row0 = u.pm * 256 + wr * 64 + fr, col0 = u.pn * 256 + wc * 32 + 8 * fq;
        f32x4 sb[2][2]; float sa[2][4];
        typename F::Col cc[2];
        const LAS float* ls = (const LAS float*)(sl + (ui & 1) * 2048);
#pragma unroll
        for (int bj = 0; bj < 2; ++bj) { sb[bj][0] = *(const LAS f32x4*)(ls + 256 + wc * 32 + 8 * fq + bj * 128); sb[bj][1] = *(const LAS f32x4*)(ls + 256 + wc * 32 + 8 * fq + bj * 128 + 4); f.col(col0 + bj * 128, cc[bj]); }
#pragma unroll
        for (int ai = 0; ai < 2; ++ai)
#pragma unroll
            for (int m = 0; m < 4; ++m) sa[ai][m] = ls[wr * 64 + fr + ai * 128 + m * 16];
        if constexpr (F::KNORM) {
            if ((u.pn >> 1) == 1) {
                float ss[2][4][2];
#pragma unroll
                for (int ai = 0; ai < 2; ++ai)
#pragma unroll
                    for (int m = 0; m < 4; ++m)
#pragma unroll
                        for (int bj = 0; bj < 2; ++bj) {
                            const pg8::i32x4 a = acc[ai][bj][m][0], b = acc[ai][bj][m][1]; const float sar = sa[ai][m];
                            const float v[8] = {(float)a[0] * (sar * sb[bj][0].x), (float)a[1] * (sar * sb[bj][0].y), (float)a[2] * (sar * sb[bj][0].z), (float)a[3] * (sar * sb[bj][0].w),
                                                (float)b[0] * (sar * sb[bj][1].x), (float)b[1] * (sar * sb[bj][1].y), (float)b[2] * (sar * sb[bj][1].z), (float)b[3] * (sar * sb[bj][1].w)};
                            float q = (v[0] * v[0] + v[1] * v[1]) + (v[2] * v[2] + v[3] * v[3]) + (v[4] * v[4] + v[5] * v[5]) + (v[6] * v[6] + v[7] * v[7]);
                            { auto r = __builtin_amdgcn_permlane16_swap(__float_as_uint(q), __float_as_uint(q), false, false); q = __uint_as_float(r[0]) + __uint_as_float(r[1]); }
                            { auto r = __builtin_amdgcn_permlane32_swap(__float_as_uint(q), __float_as_uint(q), false, false); q = __uint_as_float(r[0]) + __uint_as_float(r[1]); }
                            ss[ai][m][bj] = q;
                        }
                LAS float* mine = f.scr + (wr * 4 + wc) * 256 + fr; LAS const float* theirs = f.scr + (wr * 4 + (wc ^ 1)) * 256 + fr;
                if (fq == 0) {
#pragma unroll
                    for (int ai = 0; ai < 2; ++ai)
#pragma unroll
                        for (int m = 0; m < 4; ++m)
#pragma unroll
                            for (int bj = 0; bj < 2; ++bj) mine[((ai * 4 + m) * 2 + bj) * 16] = ss[ai][m][bj];
                }
                asm volatile("s_waitcnt lgkmcnt(0)\n\ts_barrier" ::: "memory");
                f32x4 gk[2][2];
#pragma unroll
                for (int bj = 0; bj < 2; ++bj) { gk[bj][0] = *(const f32x4*)(f.gkn + (col0 - 512) + bj * 128); gk[bj][1] = *(const f32x4*)(f.gkn + (col0 - 512) + bj * 128 + 4); }
#pragma unroll
                for (int ai = 0; ai < 2; ++ai)
#pragma unroll
                    for (int m = 0; m < 4; ++m) {
                        const int row = row0 + ai * 128 + m * 16; const float sar = sa[ai][m];
#pragma unroll
                        for (int bj = 0; bj < 2; ++bj) {
                            const float tot = ss[ai][m][bj] + theirs[((ai * 4 + m) * 2 + bj) * 16];
                            const float rk = __builtin_amdgcn_rsqf(tot * (1.f / 64.f) + NORM_EPS);
                            const pg8::i32x4 a = acc[ai][bj][m][0], b = acc[ai][bj][m][1];
                            float v[8] = {(float)a[0] * (sar * sb[bj][0].x) * (rk * gk[bj][0].x), (float)a[1] * (sar * sb[bj][0].y) * (rk * gk[bj][0].y), (float)a[2] * (sar * sb[bj][0].z) * (rk * gk[bj][0].z),
                                          (float)a[3] * (sar * sb[bj][0].w) * (rk * gk[bj][0].w), (float)b[0] * (sar * sb[bj][1].x) * (rk * gk[bj][1].x), (float)b[1] * (sar * sb[bj][1].y) * (rk * gk[bj][1].y),
                                          (float)b[2] * (sar * sb[bj][1].z) * (rk * gk[bj][1].z), (float)b[3] * (sar * sb[bj][1].w) * (rk * gk[bj][1].w)};
                            f.template store_t<false>(row, col0 + bj * 128, v);
                        }
                    }
                return;
            }
            auto emit = [&](auto tag) {
                constexpr bool GATE = decltype(tag)::value;
#pragma unroll
                for (int ai = 0; ai < 2; ++ai)
#pragma unroll
                    for (int m = 0; m < 4; ++m) {
                        const int row = row0 + ai * 128 + m * 16; const float sar = sa[ai][m];
#pragma unroll
                        for (int bj = 0; bj < 2; ++bj) {
                            const pg8::i32x4 a = acc[ai][bj][m][0], b = acc[ai][bj][m][1];
                            float v[8] = {(float)a[0] * (sar * sb[bj][0].x), (float)a[1] * (sar * sb[bj][0].y), (float)a[2] * (sar * sb[bj][0].z), (float)a[3] * (sar * sb[bj][0].w),
                                          (float)b[0] * (sar * sb[bj][1].x), (float)b[1] * (sar * sb[bj][1].y), (float)b[2] * (sar * sb[bj][1].z), (float)b[3] * (sar * sb[bj][1].w)};
                            f.template store_t<GATE>(row, col0 + bj * 128, v);
                        }
                    }
            };
            if (u.pn >= 14) emit(BoolC<true>{}); else emit(BoolC<false>{});
            return;
        }
#pragma unroll
        for (int ai = 0; ai < 2; ++ai)
#pragma unroll
            for (int m = 0; m < 4; ++m) {
                const int row = row0 + ai * 128 + m * 16; const float sar = sa[ai][m];
#pragma unroll
                for (int bj = 0; bj < 2; ++bj) {
                    const pg8::i32x4 a = acc[ai][bj][m][0], b = acc[ai][bj][m][1];
                    float v[8] = {(float)a[0] * (sar * sb[bj][0].x), (float)a[1] * (sar * sb[bj][0].y), (float)a[2] * (sar * sb[bj][0].z), (float)a[3] * (sar * sb[bj][0].w),
                                  (float)b[0] * (sar * sb[bj][1].x), (float)b[1] * (sar * sb[bj][1].y), (float)b[2] * (sar * sb[bj][1].z), (float)b[3] * (sar * sb[bj][1].w)};
                    typename F::Ctx cx; f.load(row, col0 + bj * 128, cx);
                    f.store(row, col0 + bj * 128, v, cx, cc[bj]);
                }
            }
    }
};
template <class F>
__device__ __forceinline__ void run_gemm_i8(LAS unsigned char* lds, const unsigned char* A8, const unsigned char* Bt8, int M, int N, int K8, int G, int bid, const float* SA, const float* SB, const F& f) {
    asm volatile("" : "+s"(M), "+s"(N), "+s"(G));
    pg8::Gemm g{(const bf16*)A8, (const bf16*)Bt8, M, N, K8 / 2}; pg8::StaticOrder S; S.init(M, N, G, bid);
    EpiI8<F> E{f, SA, SB, lds + pg8::STAGE_BYTES + 8192};
    pg8::gemm_phase_i8<EpiI8<F>, pg8::StaticOrder, true, true>(lds, g, S, E);
}
template <int LOG_NT> struct PanelOrder {
    int c, G;
    __device__ __forceinline__ bool next(int i, pg8::Unit& u) const { const int pan = c + (i >> LOG_NT) * G; if (pan >= NTOK / 256) return false; u.pm = pan; u.pn = (i + (c >> 3)) & ((1 << LOG_NT) - 1); return true; }
    __device__ __forceinline__ void a_ready(const pg8::Unit&) const {}
    __device__ __forceinline__ void done(const pg8::Unit&) const {}
    __device__ __forceinline__ size_t a_row0(int pm) const { return (size_t)pm * 256; }
};
struct CompactOrder : pg8::StaticOrder {
    __device__ __forceinline__ size_t a_row0(int pm) const { return (size_t)(pm >> 4) * TP + 64 + (size_t)(pm & 15) * 256; }
};
struct CtxX { f32x4 x0, x1; };
struct F_OutC {
    const float* x; bf16* h1;
    typedef NoCtx Col; typedef CtxX Ctx; static constexpr int MB = 4; static constexpr bool COL_OUTER = false;
    __device__ __forceinline__ void col(int, Col&) const {}
    __device__ __forceinline__ void load(int row, int col, Ctx& c) const { const size_t off = (size_t)row * 1024 + col; c.x0 = *(const f32x4*)(x + off); c.x1 = *(const f32x4*)(x + off + 4); }
    __device__ __forceinline__ void store(int row, int col, float (&v)[8], const Ctx& c, const Col&) const {
        const size_t off = (size_t)row * 1024 + col;
        v[0] += c.x0.x; v[1] += c.x0.y; v[2] += c.x0.z; v[3] += c.x0.w; v[4] += c.x1.x; v[5] += c.x1.y; v[6] += c.x1.z; v[7] += c.x1.w;
        *(v4u*)(h1 + off) = pack8(v);
    }
};
template <class F>
__device__ __forceinline__ void run_gemm_panels(LAS unsigned char* lds, const bf16* A, const bf16* Bt, int N, int K, int G, int c, const F& f) {
    asm volatile("" : "+s"(N), "+s"(G));
    pg8::Gemm g{A, Bt, NTOK, N, K}; PanelOrder<2> S{c, G};
    EpiT<F> E{f};
    pg8::gemm_phase<EpiT<F>, PanelOrder<2>, true, true>(lds, g, S, E);
}
template <class F>
__device__ __forceinline__ void run_gemm_i8_panels8(LAS unsigned char* lds, const unsigned char* A8, const unsigned char* Bt8, int K8, int G, int c, const float* SA, const float* SB, const F& f) {
    asm volatile("" : "+s"(K8), "+s"(G));
    pg8::Gemm g{(const bf16*)A8, (const bf16*)Bt8, NTOK, 2048, K8 / 2}; PanelOrder<3> S{c, G};
    EpiI8<F> E{f, SA, SB, lds + pg8::STAGE_BYTES + 8192};
    pg8::gemm_phase_i8<EpiI8<F>, PanelOrder<3>, true, true>(lds, g, S, E);
}
template <class F>
__device__ __forceinline__ void run_gemm_compact(LAS unsigned char* lds, const bf16* A, const bf16* Bt, int N, int K, int G, int bid, const F& f) {
    int M = NTOK; asm volatile("" : "+s"(M), "+s"(N), "+s"(G));
    pg8::Gemm g{A, Bt, M, N, K}; CompactOrder S; S.init(M, N, G, bid);
    EpiT<F> E{f};
    pg8::gemm_phase<EpiT<F>, CompactOrder, true, true>(lds, g, S, E);
}
template <class F>
__device__ __forceinline__ void run_gemm(LAS unsigned char* lds, const bf16* A, const bf16* Bt, int M, int N, int K, int G, int bid, const F& f) {
    asm volatile("" : "+s"(M), "+s"(N), "+s"(G));
    pg8::Gemm g{A, Bt, M, N, K}; pg8::StaticOrder S; S.init(M, N, G, bid);
    EpiT<F> E{f};
    pg8::gemm_phase<EpiT<F>, pg8::StaticOrder, true, true>(lds, g, S, E);
}

__device__ __forceinline__ void p2_prep1(const Params& p, int vcu, int G, int wave, int lane) {
    unsigned char* ws = p.ws;
    const int gw = vcu * NWAVES + wave, NGW = G * NWAVES;
    float mu[8], fb[8];
#pragma unroll
    for (int e = 0; e < 8; ++e) { mu[e] = (lane < 36) ? p.in[I_MU][1536 + lane * 8 + e] : 0.f; fb[e] = p.in[I_FBIAS][e]; }
    constexpr int NR = 16;
    for (int m0 = gw; m0 < R; m0 += NR * NGW) {
        v4u zv[NR], zpv[NR];
#pragma unroll
        for (int r = 0; r < NR; ++r) { const int m = m0 + r * NGW; const bool ok = m < R; const int mm = ok ? m : gw; const int pp = mm % TP;
            zv[r] = (v4u){0u, 0u, 0u, 0u}; zpv[r] = zv[r];
            if (lane < 37) { zv[r] = *((const v4u*)(ws + WS_ZM + (size_t)mm * 1024) + lane); if (pp > 0) zpv[r] = *((const v4u*)(ws + WS_ZM + (size_t)(mm - 1) * 1024) + lane); } }
#pragma unroll
        for (int r = 0; r < NR; ++r) { const int m = m0 + r * NGW; if (m >= R) continue;
            float z[8], zp[8]; unpack8(zv[r], z); unpack8(zpv[r], zp);
            if (lane < 36) {
#pragma unroll
                for (int e = 0; e < 8; ++e) { const float s = z[e] + mu[e] * (zp[e] - z[e]); const float sg = sigmoidf_(lane < 8 ? 2.0f * s : s); z[e] = (lane < 8) ? 2.0f * sg - 1.0f : (lane < 16) ? s : sg; }
                if (lane < 16) *((v4u*)(ws + WS_LA + (size_t)m * 256) + lane) = pack8(z);
                else *((v4u*)(ws + WS_LG + (size_t)m * 512) + (lane - 16)) = pack8(z);
            } else if (lane == 36) {
#pragma unroll
                for (int e = 0; e < 8; ++e) { const float x = z[e] + fb[e]; z[e] = fminf(x, 0.f) - __logf(1.0f + __expf(-fabsf(x))); }
                float* lf = (float*)(ws + WS_LF) + (size_t)m * 8;
                *(f32x4*)lf = (f32x4){z[0], z[1], z[2], z[3]}; *(f32x4*)(lf + 4) = (f32x4){z[4], z[5], z[6], z[7]};
            } else if (lane < 49) {
                *((v4u*)(ws + WS_LG + (size_t)m * 512) + (lane - 37 + 20)) = (v4u){0u, 0u, 0u, 0u};
            }
        }
    }
}
__device__ __forceinline__ void p3_cumsum(const Params& p, int seq, int lane) {
    unsigned char* ws = p.ws;
    const int b = seq >> 3, h = seq & 7;
    const float* lf = (const float*)(ws + WS_LF) + (size_t)b * TP * 8 + h;
    float* kb = (float*)(ws + WS_KB) + (size_t)seq * TP;
    float v[65];
#pragma unroll
    for (int i = 0; i < 65; ++i) { const int pp = i * 64 + lane; v[i] = (pp >= 48) ? lf[(size_t)pp * 8] : 0.f; }
    float carry = 0.f;
#pragma unroll
    for (int i = 0; i < 65; ++i) {
        float x = v[i];
        x += __uint_as_float(__builtin_amdgcn_update_dpp(0u, __float_as_uint(x), 0x111, 0xF, 0xF, true));
        x += __uint_as_float(__builtin_amdgcn_update_dpp(0u, __float_as_uint(x), 0x112, 0xF, 0xF, true));
        x += __uint_as_float(__builtin_amdgcn_update_dpp(0u, __float_as_uint(x), 0x114, 0xF, 0xF, true));
        x += __uint_as_float(__builtin_amdgcn_update_dpp(0u, __float_as_uint(x), 0x118, 0xF, 0xF, true));
        x += __uint_as_float(__builtin_amdgcn_update_dpp(0u, __float_as_uint(x), 0x142, 0xA, 0xF, false));
        x += __uint_as_float(__builtin_amdgcn_update_dpp(0u, __float_as_uint(x), 0x143, 0xC, 0xF, false));
        const int pp = i * 64 + lane;
        const float c = carry + x;
        kb[pp] = (pp >= 48) ? -c * LOG2E : -1e30f;
        carry += __uint_as_float((unsigned)__builtin_amdgcn_readlane((int)__float_as_uint(x), 63));
    }
}

__device__ __forceinline__ void p4_prep2(const Params& p, int vcu, int G, int wave, int lane) {
    unsigned char* ws = p.ws; unsigned char* dob = (unsigned char*)p.out;
    const int gw = vcu * NWAVES + wave, NGW = G * NWAVES;
    float mur[8], muk[8], kk_[8], ka_[8], rk_[8];
#pragma unroll
    for (int e = 0; e < 8; ++e) { const int c = lane * 8 + e; mur[e] = p.in[I_MU][c]; muk[e] = p.in[I_MU][512 + c]; kk_[e] = p.in[I_KK][c]; ka_[e] = p.in[I_KA][c]; rk_[e] = p.in[I_RK][c]; }
    for (int m = gw; m < R; m += NGW) {
        const int b = m / TP, pp = m - b * TP;
        float r[8], k[8], rp[8], kp[8], a[8];
        unpack8(*((const v4u*)(ws + WS_ZRR + (size_t)m * 1024) + lane), r); unpack8(*((const v4u*)(ws + WS_ZRK + (size_t)m * 1024) + lane), k);
        if (pp > 0) { unpack8(*((const v4u*)(ws + WS_ZRR + (size_t)(m - 1) * 1024) + lane), rp); unpack8(*((const v4u*)(ws + WS_ZRK + (size_t)(m - 1) * 1024) + lane), kp); }
        else {
#pragma unroll
            for (int e = 0; e < 8; ++e) { rp[e] = 0.f; kp[e] = 0.f; } }
        v4u* aap = (v4u*)(dob + DO_AA + (size_t)m * 1024) + lane;
        unpack8(*aap, a);
        float kkv[8], kpr[8]; float ss = 0.f, bon = 0.f;
#pragma unroll
        for (int e = 0; e < 8; ++e) { const float rs = r[e] + mur[e] * (rp[e] - r[e]); const float ks = k[e] + muk[e] * (kp[e] - k[e]);
            kkv[e] = ks * kk_[e]; kpr[e] = ks * (1.0f + (a[e] - 1.0f) * ka_[e]); ss += kkv[e] * kkv[e]; bon += rs * kpr[e] * rk_[e]; }
        ss = sum8(ss); bon = sum8(bon);
        const float inv = 1.0f / fmaxf(sqrtf(ss), 1e-12f);
        float bb[8];
#pragma unroll
        for (int e = 0; e < 8; ++e) { kkv[e] *= inv; bb[e] = kkv[e] * a[e]; }
        *((v4u*)(ws + WS_KP + (size_t)m * 1024) + lane) = pack8(kpr);
        *((v4u*)(ws + WS_KN + (size_t)m * 1024) + lane) = pack8(kkv);
        *aap = pack8(bb);
        if ((lane & 7) == 0) ((float*)(ws + WS_BS))[(size_t)m * 8 + (lane >> 3)] = bon;
    }
}

constexpr int SC_CH = 32, SC_STRIDE = 5 * 64 + 32;
constexpr int SC_BUF_BYTES = SC_CH * SC_STRIDE * 4;
constexpr int SC_YB_BYTES = SC_CH * 32 * 4 * 4;
__device__ __forceinline__ float dpp_sum16(float x) {
    x += __builtin_bit_cast(float, __builtin_amdgcn_update_dpp(0, __builtin_bit_cast(int, x), 0xB1, 0xF, 0xF, true));
    x += __builtin_bit_cast(float, __builtin_amdgcn_update_dpp(0, __builtin_bit_cast(int, x), 0x4E, 0xF, 0xF, true));
    x += __builtin_bit_cast(float, __builtin_amdgcn_update_dpp(0, __builtin_bit_cast(int, x), 0x141, 0xF, 0xF, true));
    x += __builtin_bit_cast(float, __builtin_amdgcn_update_dpp(0, __builtin_bit_cast(int, x), 0x140, 0xF, 0xF, true));
    return x;
}
__device__ __forceinline__ float dpp_sum4(float x) {
    x += __builtin_bit_cast(float, __builtin_amdgcn_update_dpp(0, __builtin_bit_cast(int, x), 0xB1, 0xF, 0xF, true));
    x += __builtin_bit_cast(float, __builtin_amdgcn_update_dpp(0, __builtin_bit_cast(int, x), 0x4E, 0xF, 0xF, true));
    return x;
}
struct ScanVec { f32x4 xw, kn, bb, kp, rr; float va, vb; };
__device__ __forceinline__ void p5_scan_item(const Params& p, LAS unsigned char* lds, int item, int tid, int wave, int lane) {
    unsigned char* ws = p.ws; unsigned char* dob = (unsigned char*)p.out;
    const int half = item & 1, bh = item >> 1, b = bh >> 3, h = bh & 7;
    const size_t rowb = (size_t)b * TP;
    constexpr int T0 = 32, NCH = (TP - T0) / SC_CH;
    bf16* Y = (bf16*)(ws + WS_Y);
    LAS float* yb0 = (LAS float*)(lds + 2 * SC_BUF_BYTES);
    if (wave >= 4) {
        const int lt = tid - 256;
        const int st_step = lt >> 3, c8 = lt & 7;
        const size_t colb = (size_t)h * 64 + c8 * 8;
        const bf16* aXW = (const bf16*)(dob + DO_XW); const bf16* aKN = (const bf16*)(ws + WS_KN); const bf16* aBB = (const bf16*)(dob + DO_AA); const bf16* aKP = (const bf16*)(ws + WS_KP);
        const bf16* aR = (const bf16*)(ws + WS_ZRR); const bf16* aV = (const bf16*)(ws + WS_ZRV);
        float mur[8], muv[8];
#pragma unroll
        for (int e = 0; e < 8; ++e) { mur[e] = p.in[I_MU][h * 64 + c8 * 8 + e]; muv[e] = (c8 < 4) ? p.in[I_MU][1024 + h * 64 + half * 32 + c8 * 8 + e] : 0.f; }
        auto stage = [&](int t0, int bufi) {
            const size_t row = rowb + t0 + st_step;
            const v4u g0 = *(const v4u*)(aXW + row * 512 + colb), g1 = *(const v4u*)(aKN + row * 512 + colb), g2 = *(const v4u*)(aBB + row * 512 + colb), g3 = *(const v4u*)(aKP + row * 512 + colb);
            const v4u g4 = *(const v4u*)(aR + row * 512 + colb), g5 = *(const v4u*)(aR + (row - 1) * 512 + colb);
            v4u g6 = {0u, 0u, 0u, 0u}, g7 = {0u, 0u, 0u, 0u};
            if (c8 < 4) { const size_t cv = (size_t)h * 64 + half * 32 + c8 * 8; g6 = *(const v4u*)(aV + row * 512 + cv); g7 = *(const v4u*)(aV + (row - 1) * 512 + cv); }
            LAS float* d = (LAS float*)(lds + bufi * SC_BUF_BYTES) + st_step * SC_STRIDE + c8 * 8;
            float a[8], c[8];
            unpack8(g0, a); *(LAS f32x4*)(d + 0 * 64) = (f32x4){a[0], a[1], a[2], a[3]}; *(LAS f32x4*)(d + 0 * 64 + 4) = (f32x4){a[4], a[5], a[6], a[7]};
            unpack8(g1, a); *(LAS f32x4*)(d + 1 * 64) = (f32x4){a[0], a[1], a[2], a[3]}; *(LAS f32x4*)(d + 1 * 64 + 4) = (f32x4){a[4], a[5], a[6], a[7]};
            unpack8(g2, a); *(LAS f32x4*)(d + 2 * 64) = (f32x4){a[0], a[1], a[2], a[3]}; *(LAS f32x4*)(d + 2 * 64 + 4) = (f32x4){a[4], a[5], a[6], a[7]};
            unpack8(g3, a); *(LAS f32x4*)(d + 3 * 64) = (f32x4){a[0], a[1], a[2], a[3]}; *(LAS f32x4*)(d + 3 * 64 + 4) = (f32x4){a[4], a[5], a[6], a[7]};
            unpack8(g4, a); unpack8(g5, c);
#pragma unroll
            for (int e = 0; e < 8; ++e) a[e] = a[e] + mur[e] * (c[e] - a[e]);
            *(LAS f32x4*)(d + 4 * 64) = (f32x4){a[0], a[1], a[2], a[3]}; *(LAS f32x4*)(d + 4 * 64 + 4) = (f32x4){a[4], a[5], a[6], a[7]};
            if (c8 < 4) { unpack8(g6, a); unpack8(g7, c);
#pragma unroll
                for (int e = 0; e < 8; ++e) a[e] = a[e] + muv[e] * (c[e] - a[e]);
                *(LAS f32x4*)(d + 5 * 64) = (f32x4){a[0], a[1], a[2], a[3]}; *(LAS f32x4*)(d + 5 * 64 + 4) = (f32x4){a[4], a[5], a[6], a[7]}; }
        };
        auto flush = [&](int t0, int ybi) {
            const LAS f32x4* yq = (const LAS f32x4*)(lds + 2 * SC_BUF_BYTES + ybi * SC_YB_BYTES) + (lt >> 3) * 32 + (lt & 7) * 4;
            float y[4];
#pragma unroll
            for (int r = 0; r < 4; ++r) { const f32x4 q = yq[r]; y[r] = (q.x + q.y) + (q.z + q.w); }
            v2u o; o.x = pk2(y[0], y[1]); o.y = pk2(y[2], y[3]);
            *(v2u*)(Y + (rowb + t0 + (lt >> 3)) * 512 + h * 64 + half * 32 + 4 * (lt & 7)) = o;
        };
        stage(T0, 0);
        __syncthreads();
        for (int ch = 0; ch < NCH; ++ch) {
            if (ch + 1 < NCH) stage(T0 + (ch + 1) * SC_CH, (ch + 1) & 1);
            if (ch > 0) flush(T0 + (ch - 1) * SC_CH, (ch - 1) & 1);
            __syncthreads();
        }
        flush(T0 + (NCH - 1) * SC_CH, (NCH - 1) & 1);
    } else {
        const int rl = lane >> 4, kq = lane & 15, rowA = wave * 8 + rl, rowB = rowA + 4;
        f32x4 SA = {0.f, 0.f, 0.f, 0.f}, SB = {0.f, 0.f, 0.f, 0.f};
        auto ldv = [&](const LAS float* base, int s) { ScanVec v; const LAS float* q = base + s * SC_STRIDE + kq * 4;
            v.xw = *(const LAS f32x4*)(q); v.kn = *(const LAS f32x4*)(q + 64); v.bb = *(const LAS f32x4*)(q + 128); v.kp = *(const LAS f32x4*)(q + 192); v.rr = *(const LAS f32x4*)(q + 256);
            v.va = base[s * SC_STRIDE + 320 + rowA]; v.vb = base[s * SC_STRIDE + 320 + rowB]; return v; };
        auto step = [&](const ScanVec& v, LAS float* yb, int s) {
            float sa = SA.x * v.kn.x; sa = fmaf(SA.y, v.kn.y, sa); sa = fmaf(SA.z, v.kn.z, sa); sa = fmaf(SA.w, v.kn.w, sa);
            float sb = SB.x * v.kn.x; sb = fmaf(SB.y, v.kn.y, sb); sb = fmaf(SB.z, v.kn.z, sb); sb = fmaf(SB.w, v.kn.w, sb);
            sa = -dpp_sum16(sa); sb = -dpp_sum16(sb);
            SA = (SA - SA * v.xw) + sa * v.bb + v.va * v.kp;
            SB = (SB - SB * v.xw) + sb * v.bb + v.vb * v.kp;
            float ya = SA.x * v.rr.x; ya = fmaf(SA.y, v.rr.y, ya); ya = fmaf(SA.z, v.rr.z, ya); ya = fmaf(SA.w, v.rr.w, ya);
            float yv = SB.x * v.rr.x; yv = fmaf(SB.y, v.rr.y, yv); yv = fmaf(SB.z, v.rr.z, yv); yv = fmaf(SB.w, v.rr.w, yv);
            ya = dpp_sum4(ya); yv = dpp_sum4(yv);
            yb[(s * 32 + rowA) * 4 + (kq >> 2)] = ya; yb[(s * 32 + rowB) * 4 + (kq >> 2)] = yv;
        };
        __syncthreads();
        for (int ch = 0; ch < NCH; ++ch) {
            const LAS float* base = (const LAS float*)(lds + (ch & 1) * SC_BUF_BYTES);
            LAS float* yb = yb0 + (ch & 1) * (SC_YB_BYTES / 4);
            ScanVec v0 = ldv(base, 0), v1;
#pragma unroll 1
            for (int s = 0; s < SC_CH; s += 2) {
                v1 = ldv(base, s + 1);
                step(v0, yb, s);
                if (s + 2 < SC_CH) v0 = ldv(base, s + 2);
                step(v1, yb, s + 1);
            }
            __syncthreads();
        }
    }
    __syncthreads();
}

#ifndef SC2_DBG
#define SC2_DBG 0
#endif
namespace sc2 {
constexpr int S64 = 144, S32 = 80, SAAB = 36, SRHS = 68;
constexpr int AT = 0, RT = AT + 32 * S64, BT = RT + 32 * S64, KT = BT + 32 * S64, BH = KT + 32 * S64, KH = BH + 32 * S64, VV = KH + 32 * S64, PT = VV + 32 * S64,
              AAK = PT + 64 * S32, ARB = AAK + 32 * S32, ARK = ARB + 32 * S32, SB = ARK + 32 * S32, AAB = SB + 64 * S64, RHS = AAB + 32 * SAAB * 4, CL = RHS + 32 * SRHS * 4,
              GC = CL + 32 * 64 * 4, END = GC + 512;
static_assert(END <= 100000, "scan LDS");
}
__device__ __forceinline__ bf16x8 sc2_frag(LAS unsigned char* base, int stride, int row0, int k0, int lane) {
    return *(const LAS bf16x8*)(base + (row0 + (lane & 15)) * stride + (k0 + 8 * (lane >> 4)) * 2);
}
typedef short sc2_v4i16 __attribute__((ext_vector_type(4)));
__device__ __forceinline__ bf16x8 sc2_frag_tr(LAS unsigned char* base, int col0, int lane) {
    const int i = lane & 15, g = lane >> 4;
    LAS unsigned char* a = base + (8 * g + (i >> 2)) * sc2::S64 + (col0 + 4 * (i & 3)) * 2;
    const sc2_v4i16 lo = __builtin_amdgcn_ds_read_tr16_b64_v4i16((LAS sc2_v4i16*)a), hi = __builtin_amdgcn_ds_read_tr16_b64_v4i16((LAS sc2_v4i16*)(a + 4 * sc2::S64));
    return (bf16x8){lo[0], lo[1], lo[2], lo[3], hi[0], hi[1], hi[2], hi[3]};
}
#define SC2_BAR() asm volatile("s_waitcnt lgkmcnt(0)\n\ts_barrier" ::: "memory")
__device__ __forceinline__ void p5_scan_chunked(const Params& p, LAS unsigned char* lds, int bh, int tid, int wave, int lane) {
    using namespace sc2;
    unsigned char* ws = p.ws; unsigned char* dob = (unsigned char*)p.out;
    const int b = bh >> 3, h = bh & 7;
    const size_t rowb = (size_t)b * TP;
    constexpr int T0 = 32, NCH = (TP - T0) / 32;
    const bf16* aXW = (const bf16*)(dob + DO_XW); const bf16* aA = (const bf16*)(dob + DO_AA); const bf16* aG = (const bf16*)(dob + DO_GG);
    const bf16* aR = (const bf16*)(ws + WS_ZRR); const bf16* aK = (const bf16*)(ws + WS_ZRK); const bf16* aV = (const bf16*)(ws + WS_ZRV);
    bf16* Y = (bf16*)(ws + WS_Y);
    const int pt = tid >> 4, kc = tid & 15;
    const size_t kcol = (size_t)h * 64 + 4 * kc;
    float mur[4], muk[4], muv[4], kk_[4], ka_[4], rk_[4], lng[4], lnb[4];
#pragma unroll
    for (int e = 0; e < 4; ++e) { const int c = h * 64 + 4 * kc + e; mur[e] = p.in[I_MU][c]; muk[e] = p.in[I_MU][512 + c]; muv[e] = p.in[I_MU][1024 + c];
        kk_[e] = p.in[I_KK][c]; ka_[e] = p.in[I_KA][c]; rk_[e] = p.in[I_RK][c]; lng[e] = p.in[I_LNG][c]; lnb[e] = p.in[I_LNB][c]; }
    const int q = lane >> 4, c16 = lane & 15;
    const int m_ = wave >> 1, tr = wave & 1;
    const int tr2 = wave >> 2, vc2 = wave & 3;
    const int kt = wave >> 1, vh = wave & 1;
    pg8::f32x4 accS0 = {0.f, 0.f, 0.f, 0.f}, accS1 = {0.f, 0.f, 0.f, 0.f};
    for (int i = tid; i < 64 * S64 / 4; i += NTHREADS) ((LAS unsigned*)(lds + SB))[i] = 0u;
    v2u gxw, ga, gk0, gk1, gr0, gr1, gv0, gv1, ggn;
    auto prefetch = [&](int t0) { const unsigned off = (unsigned)(((unsigned)rowb + (unsigned)(t0 + pt)) * 512u + (unsigned)kcol) * 2u;
#define SC2_LD(base, o) (*(const v2u*)((const unsigned char*)(base) + (o)))
        gxw = SC2_LD(aXW, (unsigned)(((unsigned)rowb + (unsigned)(t0 + (lane & 31))) * 512u + (unsigned)(h * 64 + 8 * wave + 4 * (lane >> 5))) * 2u);
        ga = SC2_LD(aA, off); ggn = SC2_LD(aG, off);
        gk0 = SC2_LD(aK, off); gk1 = SC2_LD(aK, off - 1024u);
        gr0 = SC2_LD(aR, off); gr1 = SC2_LD(aR, off - 1024u);
        gv0 = SC2_LD(aV, off); gv1 = SC2_LD(aV, off - 1024u);
#undef SC2_LD
    };
    prefetch(T0);
    float e_vs[4] = {0.f, 0.f, 0.f, 0.f}, e_bs = 0.f; v2u e_gg = {0u, 0u};
    auto y_epilogue = [&](int t0p) {
        const f32x4 y4 = *(const LAS f32x4*)(lds + RHS + (pt * SRHS + 4 * kc) * 4);
        float y[4] = {y4.x, y4.y, y4.z, y4.w};
        const float mean = dpp_sum16((y[0] + y[1]) + (y[2] + y[3])) * (1.f / 64.f);
        float qq = 0.f;
#pragma unroll
        for (int e = 0; e < 4; ++e) { y[e] -= mean; qq += y[e] * y[e]; }
        const float rstd = __builtin_amdgcn_rsqf(dpp_sum16(qq) * (1.f / 64.f) + GN_EPS);
        const float g[4] = {bflo(e_gg.x), bfhi(e_gg.x), bflo(e_gg.y), bfhi(e_gg.y)};
        float o[4];
#pragma unroll
        for (int e = 0; e < 4; ++e) o[e] = (y[e] * rstd * lng[e] + lnb[e] + e_bs * e_vs[e]) * g[e];
        v2u w; w.x = pk2(o[0], o[1]); w.y = pk2(o[2], o[3]);
        *(v2u*)((unsigned char*)Y + (unsigned)(((unsigned)rowb + (unsigned)(t0p + pt)) * 512u + (unsigned)kcol) * 2u) = w;
    };
    for (int ch = 0; ch < NCH; ++ch) {
        const int t0 = T0 + ch * 32;
        { float lg[4] = {bflo(gxw.x), bfhi(gxw.x), bflo(gxw.y), bfhi(gxw.y)};
#pragma unroll
          for (int e = 0; e < 4; ++e) { float x = lg[e];
              x += __uint_as_float(__builtin_amdgcn_update_dpp(0u, __float_as_uint(x), 0x111, 0xF, 0xF, true));
              x += __uint_as_float(__builtin_amdgcn_update_dpp(0u, __float_as_uint(x), 0x112, 0xF, 0xF, true));
              x += __uint_as_float(__builtin_amdgcn_update_dpp(0u, __float_as_uint(x), 0x114, 0xF, 0xF, true));
              x += __uint_as_float(__builtin_amdgcn_update_dpp(0u, __float_as_uint(x), 0x118, 0xF, 0xF, true));
              x += __uint_as_float(__builtin_amdgcn_update_dpp(0u, __float_as_uint(x), 0x142, 0xA, 0xF, false));
              lg[e] = x; }
          const int cq = 8 * wave + 4 * (lane >> 5);
          *(LAS f32x4*)(lds + CL + ((lane & 31) * 64 + cq) * 4) = (f32x4){lg[0], lg[1], lg[2], lg[3]};
          if ((lane & 31) == 31) *(LAS f32x4*)(lds + GC + (ch & 1) * 256 + cq * 4) = (f32x4){__builtin_amdgcn_exp2f(lg[0]), __builtin_amdgcn_exp2f(lg[1]), __builtin_amdgcn_exp2f(lg[2]), __builtin_amdgcn_exp2f(lg[3])}; }
        SC2_BAR();
        if (ch > 0) y_epilogue(t0 - 32);
        {
            const f32x4 clt = *(const LAS f32x4*)(lds + CL + (pt * 64 + 4 * kc) * 4);
            f32x4 clp = {0.f, 0.f, 0.f, 0.f}; if (pt > 0) clp = *(const LAS f32x4*)(lds + CL + ((pt - 1) * 64 + 4 * kc) * 4);
            const f32x4 egc = *(const LAS f32x4*)(lds + GC + (ch & 1) * 256 + 16 * kc);
            const float k0[4] = {bflo(gk0.x), bfhi(gk0.x), bflo(gk0.y), bfhi(gk0.y)}, k1[4] = {bflo(gk1.x), bfhi(gk1.x), bflo(gk1.y), bfhi(gk1.y)}, av[4] = {bflo(ga.x), bfhi(ga.x), bflo(ga.y), bfhi(ga.y)};
            const float r0[4] = {bflo(gr0.x), bfhi(gr0.x), bflo(gr0.y), bfhi(gr0.y)}, r1[4] = {bflo(gr1.x), bfhi(gr1.x), bflo(gr1.y), bfhi(gr1.y)};
            const float v0[4] = {bflo(gv0.x), bfhi(gv0.x), bflo(gv0.y), bfhi(gv0.y)}, v1[4] = {bflo(gv1.x), bfhi(gv1.x), bflo(gv1.y), bfhi(gv1.y)};
            float kkv[4], kp[4], rsv[4], ss = 0.f, bon = 0.f;
#pragma unroll
            for (int e = 0; e < 4; ++e) { const float ks = k0[e] + muk[e] * (k1[e] - k0[e]); rsv[e] = r0[e] + mur[e] * (r1[e] - r0[e]); e_vs[e] = v0[e] + muv[e] * (v1[e] - v0[e]);
                kkv[e] = ks * kk_[e]; kp[e] = ks * (1.0f + (av[e] - 1.0f) * ka_[e]); ss += kkv[e] * kkv[e]; bon += rsv[e] * kp[e] * rk_[e]; }
            ss = dpp_sum16(ss); e_bs = dpp_sum16(bon); e_gg = ggn;
            const float inv = fminf(__builtin_amdgcn_rsqf(ss), 1e12f);
            float kn[4], bb[4];
#pragma unroll
            for (int e = 0; e < 4; ++e) { kn[e] = kkv[e] * inv; bb[e] = kn[e] * av[e]; }
            float at[4], rt[4], bt[4], ktl[4], bh_[4], kh_[4];
#pragma unroll
            for (int e = 0; e < 4; ++e) {
                const float gt = __builtin_amdgcn_exp2f(clt[e]), gp = __builtin_amdgcn_exp2f(clp[e]), gi = __builtin_amdgcn_exp2f(-clt[e]), gc = egc[e] * gi;
                const float rs = rsv[e];
                at[e] = -kn[e] * gp; rt[e] = rs * gt; bt[e] = bb[e] * gi; ktl[e] = kp[e] * gi; bh_[e] = bb[e] * gc; kh_[e] = kp[e] * gc;
            }
            v2u w;
            w.x = pk2(at[0], at[1]); w.y = pk2(at[2], at[3]); *(LAS v2u*)(lds + AT + pt * S64 + 8 * kc) = w;
            w.x = pk2(rt[0], rt[1]); w.y = pk2(rt[2], rt[3]); *(LAS v2u*)(lds + RT + pt * S64 + 8 * kc) = w;
            w.x = pk2(bt[0], bt[1]); w.y = pk2(bt[2], bt[3]); *(LAS v2u*)(lds + BT + pt * S64 + 8 * kc) = w;
            w.x = pk2(ktl[0], ktl[1]); w.y = pk2(ktl[2], ktl[3]); *(LAS v2u*)(lds + KT + pt * S64 + 8 * kc) = w;
            w.x = pk2(bh_[0], bh_[1]); w.y = pk2(bh_[2], bh_[3]); *(LAS v2u*)(lds + BH + pt * S64 + 8 * kc) = w;
            w.x = pk2(kh_[0], kh_[1]); w.y = pk2(kh_[2], kh_[3]); *(LAS v2u*)(lds + KH + pt * S64 + 8 * kc) = w;
            w.x = pk2(e_vs[0], e_vs[1]); w.y = pk2(e_vs[2], e_vs[3]); *(LAS v2u*)(lds + VV + pt * S64 + 8 * kc) = w;
        }
        if (ch + 1 < NCH) prefetch(t0 + 32);
        SC2_BAR();
        pg8::f32x4 accR, accY;
        {
            LAS unsigned char* Ab = lds + ((m_ < 2) ? AT : RT); LAS unsigned char* Bb = lds + ((m_ & 1) ? KT : BT);
            const bf16x8 a0 = sc2_frag(Ab, S64, 16 * tr, 0, lane), a1 = sc2_frag(Ab, S64, 16 * tr, 32, lane);
            const int incl = (m_ >= 2) ? 1 : 0;
            LAS unsigned char* dstb = lds + (m_ == 1 ? AAK : (m_ == 2 ? ARB : ARK));
            pg8::f32x4 cc[2];
#pragma unroll
            for (int tc = 0; tc < 2; ++tc) {
                const bf16x8 b0 = sc2_frag(Bb, S64, 16 * tc, 0, lane), b1 = sc2_frag(Bb, S64, 16 * tc, 32, lane);
                pg8::f32x4 c = {0.f, 0.f, 0.f, 0.f};
                c = __builtin_amdgcn_mfma_f32_16x16x32_bf16(a0, b0, c, 0, 0, 0); c = __builtin_amdgcn_mfma_f32_16x16x32_bf16(a1, b1, c, 0, 0, 0);
                const int i = 16 * tc + c16;
#pragma unroll
                for (int r = 0; r < 4; ++r) { const int t = 16 * tr + 4 * q + r; c[r] = (i < t + incl) ? c[r] : 0.f; }
                cc[tc] = c;
            }
            if (m_ == 0) {
#pragma unroll
                for (int tc = 0; tc < 2; ++tc)
#pragma unroll
                    for (int r = 0; r < 4; ++r) *(LAS float*)(lds + AAB + ((16 * tc + c16) * SAAB + 16 * tr + 4 * q + r) * 4) = cc[tc][r];
            } else {
#pragma unroll
                for (int tc = 0; tc < 2; ++tc)
#pragma unroll
                    for (int r = 0; r < 4; ++r) *(LAS bf16*)(dstb + (16 * tr + 4 * q + r) * S32 + 2 * (16 * tc + c16)) = (bf16)f2bf(cc[tc][r]);
            }
            const bf16x8 sb0 = sc2_frag(lds + SB, S64, 16 * vc2, 0, lane), sb1 = sc2_frag(lds + SB, S64, 16 * vc2, 32, lane);
            const bf16x8 ra0 = sc2_frag(lds + AT, S64, 16 * tr2, 0, lane), ra1 = sc2_frag(lds + AT, S64, 16 * tr2, 32, lane);
            const bf16x8 ya0 = sc2_frag(lds + RT, S64, 16 * tr2, 0, lane), ya1 = sc2_frag(lds + RT, S64, 16 * tr2, 32, lane);
            accR = (pg8::f32x4){0.f, 0.f, 0.f, 0.f}; accY = accR;
            accR = __builtin_amdgcn_mfma_f32_16x16x32_bf16(ra0, sb0, accR, 0, 0, 0); accR = __builtin_amdgcn_mfma_f32_16x16x32_bf16(ra1, sb1, accR, 0, 0, 0);
            accY = __builtin_amdgcn_mfma_f32_16x16x32_bf16(ya0, sb0, accY, 0, 0, 0); accY = __builtin_amdgcn_mfma_f32_16x16x32_bf16(ya1, sb1, accY, 0, 0, 0);
        }
        SC2_BAR();
        {
            const bf16x8 bv = sc2_frag_tr(lds + VV, 16 * vc2, lane);
            accR = __builtin_amdgcn_mfma_f32_16x16x32_bf16(sc2_frag(lds + AAK, S32, 16 * tr2, 0, lane), bv, accR, 0, 0, 0);
            accY = __builtin_amdgcn_mfma_f32_16x16x32_bf16(sc2_frag(lds + ARK, S32, 16 * tr2, 0, lane), bv, accY, 0, 0, 0);
#pragma unroll
            for (int r = 0; r < 4; ++r) *(LAS float*)(lds + RHS + ((16 * tr2 + 4 * q + r) * SRHS + 16 * vc2 + c16) * 4) = accR[r];
        }
        SC2_BAR();
        if (wave < 4) {
            const int v = 16 * wave + (lane >> 2), part = lane & 3;
            typedef float sc2_f2 __attribute__((ext_vector_type(2)));
            sc2_f2 rh[2][2];
#pragma unroll
            for (int m = 0; m < 2; ++m)
#pragma unroll
                for (int j = 0; j < 4; ++j) rh[m][j >> 1][j & 1] = *(const LAS float*)(lds + RHS + ((4 * (4 * m + part) + j) * SRHS + v) * 4);
            unsigned pk[16]; float prev = 0.f;
            const LAS float* acol = (const LAS float*)(lds + AAB) + 4 * part;
#pragma unroll
            for (int t = 0; t < 32; ++t) {
                const int g = t >> 2, m = g >> 2, j = t & 3;
                const float mine = rh[m][j >> 1][j & 1];
                const int mi_ = (int)__float_as_uint(mine); int bc_;
                if ((g & 3) == 0) bc_ = __builtin_amdgcn_update_dpp(0, mi_, 0x00, 0xF, 0xF, true); else if ((g & 3) == 1) bc_ = __builtin_amdgcn_update_dpp(0, mi_, 0x55, 0xF, 0xF, true);
                else if ((g & 3) == 2) bc_ = __builtin_amdgcn_update_dpp(0, mi_, 0xAA, 0xF, 0xF, true); else bc_ = __builtin_amdgcn_update_dpp(0, mi_, 0xFF, 0xF, 0xF, true);
                const float pt_ = __uint_as_float((unsigned)bc_);
                if (t < 31) {
#pragma unroll
                    for (int m2 = 0; m2 < 2; ++m2) {
                        if (4 * m2 + 3 < g) continue;
                        const f32x4 w = *(const LAS f32x4*)(acol + t * SAAB + 16 * m2);
                        const sc2_f2 p2 = {pt_, pt_};
                        rh[m2][0] = __builtin_elementwise_fma((sc2_f2){w.x, w.y}, p2, rh[m2][0]); rh[m2][1] = __builtin_elementwise_fma((sc2_f2){w.z, w.w}, p2, rh[m2][1]);
                    }
                }
                if (t & 1) pk[t >> 1] = pk2(prev, pt_); else prev = pt_;
                if ((t & 3) == 3) asm volatile("" ::: "memory");
            }
            if (part == 0) {
#pragma unroll
                for (int g = 0; g < 4; ++g) { v4u w; w.x = pk[4 * g]; w.y = pk[4 * g + 1]; w.z = pk[4 * g + 2]; w.w = pk[4 * g + 3]; *(LAS v4u*)(lds + PT + v * S32 + 16 * g) = w; } }
        }
        SC2_BAR();
        {
            accY = __builtin_amdgcn_mfma_f32_16x16x32_bf16(sc2_frag(lds + ARB, S32, 16 * tr2, 0, lane), sc2_frag(lds + PT, S32, 16 * vc2, 0, lane), accY, 0, 0, 0);
#pragma unroll
            for (int r = 0; r < 4; ++r) *(LAS float*)(lds + RHS + ((16 * tr2 + 4 * q + r) * SRHS + 16 * vc2 + c16) * 4) = accY[r];
            const f32x4 gcv = *(const LAS f32x4*)(lds + GC + (ch & 1) * 256 + (16 * kt + 4 * q) * 4);
            const bf16x8 ab = sc2_frag_tr(lds + BH, 16 * kt, lane), ak = sc2_frag_tr(lds + KH, 16 * kt, lane);
            accS0[0] *= gcv.x; accS0[1] *= gcv.y; accS0[2] *= gcv.z; accS0[3] *= gcv.w; accS1[0] *= gcv.x; accS1[1] *= gcv.y; accS1[2] *= gcv.z; accS1[3] *= gcv.w;
            accS0 = __builtin_amdgcn_mfma_f32_16x16x32_bf16(ab, sc2_frag(lds + PT, S32, 32 * vh, 0, lane), accS0, 0, 0, 0);
            accS0 = __builtin_amdgcn_mfma_f32_16x16x32_bf16(ak, sc2_frag_tr(lds + VV, 32 * vh, lane), accS0, 0, 0, 0);
            accS1 = __builtin_amdgcn_mfma_f32_16x16x32_bf16(ab, sc2_frag(lds + PT, S32, 32 * vh + 16, 0, lane), accS1, 0, 0, 0);
            accS1 = __builtin_amdgcn_mfma_f32_16x16x32_bf16(ak, sc2_frag_tr(lds + VV, 32 * vh + 16, lane), accS1, 0, 0, 0);
            v2u w; w.x = pk2(accS0[0], accS0[1]); w.y = pk2(accS0[2], accS0[3]);
            *(LAS v2u*)(lds + SB + (32 * vh + c16) * S64 + (16 * kt + 4 * q) * 2) = w;
            w.x = pk2(accS1[0], accS1[1]); w.y = pk2(accS1[2], accS1[3]);
            *(LAS v2u*)(lds + SB + (32 * vh + 16 + c16) * S64 + (16 * kt + 4 * q) * 2) = w;
        }
    }
    __syncthreads();
    y_epilogue(T0 + (NCH - 1) * 32);
    __syncthreads();
}

__device__ __forceinline__ void p6_prep3(const Params& p, int vcu, int G, int wave, int lane) {
    unsigned char* ws = p.ws; unsigned char* dob = (unsigned char*)p.out;
    const int gw = vcu * NWAVES + wave, NGW = G * NWAVES;
    float lg[8], lb[8], muv[8];
#pragma unroll
    for (int e = 0; e < 8; ++e) { const int c = lane * 8 + e; lg[e] = p.in[I_LNG][c]; lb[e] = p.in[I_LNB][c]; muv[e] = p.in[I_MU][1024 + c]; }
    for (int m = gw; m < R; m += NGW) {
        const int b = m / TP, pp = m - b * TP;
        v4u* yp = (v4u*)(ws + WS_Y + (size_t)m * 1024) + lane;
        if (pp < 48) { *yp = (v4u){0u, 0u, 0u, 0u}; continue; }
        float y[8], v[8], vp[8], g[8];
        unpack8(*yp, y); unpack8(*((const v4u*)(ws + WS_ZRV + (size_t)m * 1024) + lane), v); unpack8(*((const v4u*)(ws + WS_ZRV + (size_t)(m - 1) * 1024) + lane), vp);
        unpack8(*((const v4u*)(dob + DO_GG + (size_t)m * 1024) + lane), g);
        float s = 0.f;
#pragma unroll
        for (int e = 0; e < 8; ++e) s += y[e];
        const float mean = sum8(s) * (1.f / 64.f); float q = 0.f;
#pragma unroll
        for (int e = 0; e < 8; ++e) { y[e] -= mean; q += y[e] * y[e]; }
        const float rstd = 1.0f / sqrtf(sum8(q) * (1.f / 64.f) + GN_EPS);
        const float bon = ((const float*)(ws + WS_BS))[(size_t)m * 8 + (lane >> 3)];
#pragma unroll
        for (int e = 0; e < 8; ++e) { const float vs = v[e] + muv[e] * (vp[e] - v[e]); y[e] = (y[e] * rstd * lg[e] + lb[e] + bon * vs) * g[e]; }
        *yp = pack8(y);
    }
}
template <int NR>
__device__ __forceinline__ void norm2_rows(const Params& p, int m0, int mstride, int lane) {
    unsigned char* ws = p.ws;
    const f32x4* g4 = (const f32x4*)p.in[I_N2G] + 4 * lane;
    f32x4 v[NR][4]; float s[NR], mx[NR];
#pragma unroll
    for (int r = 0; r < NR; ++r) { const v4u* xr = (const v4u*)(ws + WS_H1 + (size_t)(m0 + r * mstride) * 2048) + 2 * lane;
        const v4u a = xr[0], b = xr[1]; float f[8];
        unpack8(a, f); v[r][0] = (f32x4){f[0], f[1], f[2], f[3]}; v[r][1] = (f32x4){f[4], f[5], f[6], f[7]};
        unpack8(b, f); v[r][2] = (f32x4){f[0], f[1], f[2], f[3]}; v[r][3] = (f32x4){f[4], f[5], f[6], f[7]}; }
#pragma unroll
    for (int r = 0; r < NR; ++r) { s[r] = 0.f;
#pragma unroll
        for (int j = 0; j < 4; ++j) s[r] += (v[r][j].x * v[r][j].x + v[r][j].y * v[r][j].y) + (v[r][j].z * v[r][j].z + v[r][j].w * v[r][j].w); }
#pragma unroll
    for (int r = 0; r < NR; ++r) s[r] = wave_sum(s[r]);
#pragma unroll
    for (int r = 0; r < NR; ++r) { const float rs = __builtin_amdgcn_rsqf(s[r] * (1.f / 1024.f) + NORM_EPS); mx[r] = 0.f;
#pragma unroll
        for (int j = 0; j < 4; ++j) { const f32x4 g = g4[j]; v[r][j].x *= rs * g.x; v[r][j].y *= rs * g.y; v[r][j].z *= rs * g.z; v[r][j].w *= rs * g.w;
#ifdef PQ_BF16
            ((unsigned long long*)(ws + WS_XN2 + (size_t)(m0 + r * mstride) * 2048) + 4 * lane)[j] = (unsigned long long)pk2(v[r][j].x, v[r][j].y) | ((unsigned long long)pk2(v[r][j].z, v[r][j].w) << 32);
#endif
            mx[r] = fmaxf(mx[r], fmaxf(fmaxf(fabsf(v[r][j].x), fabsf(v[r][j].y)), fmaxf(fabsf(v[r][j].z), fabsf(v[r][j].w)))); } }
#pragma unroll
    for (int r = 0; r < NR; ++r) mx[r] = wave_max(mx[r]);
#pragma unroll
    for (int r = 0; r < NR; ++r) { const int m = m0 + r * mstride; const float inv = mx[r] > 0.f ? 127.0f / mx[r] : 0.f;
        unsigned* xq = (unsigned*)(ws + WS_XQ + (size_t)m * 1024) + 4 * lane;
#pragma unroll
        for (int j = 0; j < 4; ++j) xq[j] = q8x4(v[r][j].x, v[r][j].y, v[r][j].z, v[r][j].w, inv);
        if (lane == 0) ((float*)(ws + WS_SX))[m] = mx[r] > 0.f ? mx[r] * (1.0f / 127.0f) : 1.0f; }
}
__device__ __forceinline__ void p9_norm2(const Params& p, int vcu, int G, int wave, int lane) {
    const int gw = vcu * NWAVES + wave, NGW = G * NWAVES;
    for (int m = gw; m < NTOK; m += 4 * NGW) norm2_rows<4>(p, m, NGW, lane);
}

typedef __bf16 bf16x2_t __attribute__((ext_vector_type(2)));
__device__ __forceinline__ unsigned mono(float f) { return __builtin_bit_cast(unsigned, f); }
__device__ __forceinline__ float unmono(unsigned m) { return __builtin_bit_cast(float, m); }
constexpr unsigned KEY_NEG_INF = 0xFF800000u;
__device__ __forceinline__ unsigned kmax(unsigned a, unsigned b) { unsigned r; asm("v_max_f32 %0, %1, %2" : "=v"(r) : "v"(a), "v"(b)); return r; }
__device__ __forceinline__ unsigned kmin(unsigned a, unsigned b) { unsigned r; asm("v_min_f32 %0, %1, %2" : "=v"(r) : "v"(a), "v"(b)); return r; }
__device__ __forceinline__ void ce_desc(unsigned& a, unsigned& b) { const unsigned hi = kmax(a, b), lo = kmin(a, b); a = hi; b = lo; }
template <int BASE, int N> __device__ __forceinline__ void bitonic_sort_desc(unsigned (&v)[N]) {
#pragma unroll
    for (int p = 1; p < 16; p <<= 1)
#pragma unroll
        for (int k = p; k >= 1; k >>= 1)
#pragma unroll
            for (int j = k % p; j <= 15 - k; j += 2 * k)
#pragma unroll
                for (int i = 0; i < k; ++i)
                    if (i + j + k <= 15 && (i + j) / (2 * p) == (i + j + k) / (2 * p)) ce_desc(v[BASE + i + j], v[BASE + i + j + k]);
}
template <int A, int B, int N> __device__ __forceinline__ void merge_top16(unsigned (&v)[N]) {
#pragma unroll
    for (int i = 0; i < 16; ++i) v[A + i] = kmax(v[A + i], v[B + 15 - i]);
#pragma unroll
    for (int j = 8; j > 0; j >>= 1)
#pragma unroll
        for (int i = 0; i < 16; ++i) { const int l = i ^ j; if (l > i) ce_desc(v[A + i], v[A + l]); }
}
constexpr int KS_STRIDE = 272;
constexpr int RT_KS_BYTES = 256 * KS_STRIDE;
constexpr int RT_TAB_WORDS = 33;
__device__ __forceinline__ void p11_route(const Params& p, LAS unsigned char* lds, int bid, int G, int tid, int wave, int lane) {
    unsigned char* ws = p.ws;
    for (int i = tid; i < 256 * 16; i += NTHREADS) { const int row = i >> 4, ch = i & 15; *(LAS v4u*)(lds + row * KS_STRIDE + ch * 16) = *((const v4u*)(ws + WS_KS) + i); }
    __syncthreads();
    LAS unsigned* tab = (LAS unsigned*)(lds + RT_KS_BYTES) + (wave * 64 + lane) * RT_TAB_WORDS;
    const int r32 = lane & 31, hi = lane >> 5;
    const bf16* PQ = (const bf16*)(ws + WS_PQ);
    unsigned short* IDS = (unsigned short*)(ws + WS_IDS); float* GATES = (float*)(ws + WS_GATES);
    for (int task = bid * 64 + wave; task < (NTOK / 32) * 8; task += ((task & 63) + NWAVES < 64) ? NWAVES : G * 64 - 64 + NWAVES) {
        const int tb = task >> 3, h = task & 7;
        const int token = tb * 32 + r32;
        unsigned v[128];
        {
            const bf16* qrow = PQ + (size_t)token * 2048 + h * 256 + hi * 8;
#pragma unroll
            for (int t = 0; t < 4; ++t) {
                f32x16v acc[2];
#pragma unroll
                for (int w = 0; w < 2; ++w) {
                    f32x16v c = {};
                    const LAS unsigned char* kb = lds + (w * 128 + t * 32 + r32) * KS_STRIDE + hi * 16;
#pragma unroll
                    for (int s = 0; s < 8; ++s) { const bf16x8 a = *(const LAS bf16x8*)(kb + s * 32); const bf16x8 qf = *(const bf16x8*)(qrow + w * 128 + 16 * s); c = __builtin_amdgcn_mfma_f32_32x32x16_bf16(a, qf, c, 0, 0, 0); }
                    acc[w] = c;
                }
#pragma unroll
                for (int r = 0; r < 16; ++r) {
                    const float xa = acc[0][r], xb = acc[1][r];
                    auto rr = __builtin_amdgcn_permlane32_swap(__float_as_uint(xa), __float_as_uint(xb), false, false);
                    const unsigned r0 = rr[0], r1 = rr[1];
                    const int cr = (r & 3) + 8 * (r >> 2);
                    v[t * 16 + r] = (mono(__uint_as_float(r0)) & ~0x7Fu) | (unsigned)(32 * t + cr);
                    v[64 + t * 16 + r] = (mono(__uint_as_float(r1)) & ~0x7Fu) | (unsigned)(32 * t + cr + 4);
                }
            }
        }
        bitonic_sort_desc<0>(v); bitonic_sort_desc<16>(v); bitonic_sort_desc<32>(v); bitonic_sort_desc<48>(v);
        bitonic_sort_desc<64>(v); bitonic_sort_desc<80>(v); bitonic_sort_desc<96>(v); bitonic_sort_desc<112>(v);
        merge_top16<0, 16>(v); merge_top16<32, 48>(v); merge_top16<64, 80>(v); merge_top16<96, 112>(v);
        merge_top16<0, 32>(v); merge_top16<64, 96>(v);
        merge_top16<0, 64>(v);
        unsigned T[16], U[16];
#pragma unroll
        for (int i = 0; i < 16; ++i) { auto rr = __builtin_amdgcn_permlane32_swap(v[i], v[i], false, false); T[i] = v[i]; U[i] = hi ? rr[0] : rr[1]; }
        { const int bT = hi ? 16 : 0, bU = hi ? 0 : 16;
#pragma unroll
          for (int i = 0; i < 16; ++i) { tab[bT + i] = T[i] & 0x7Fu; tab[bU + i] = U[i] & 0x7Fu; } }
        float tv[16], uv[16];
#pragma unroll
        for (int i = 0; i < 16; ++i) { tv[i] = unmono(T[i] & ~0x7Fu); uv[i] = unmono(U[i] & ~0x7Fu); }
        unsigned c[32];
        {
            float uvs[16];
#pragma unroll
            for (int m = 0; m < 16; ++m) uvs[m] = hi ? (m < 15 ? uv[m + 1] : -3.0e38f) : uv[m];
            int n = 0;
#pragma unroll
            for (int i = 0; i < 4; ++i)
#pragma unroll
                for (int j = i; j < 16; ++j) if ((i + 1) * (j + 1) <= 16) {
                    const float s = tv[i] + uvs[j];
                    const unsigned paylo = (unsigned)((i << 4) | j), payhi = (j + 1 < 16) ? (unsigned)(((j + 1) << 4) | i) : 0u;
                    c[n++] = (mono(s) & ~0xFFu) | (hi ? payhi : paylo);
                }
        }
        {
            unsigned x0 = c[23], x1 = c[24], x2 = c[25], y = c[26];
            ce_desc(x2, y); ce_desc(x1, x2); ce_desc(x0, x1);
            c[23] = KEY_NEG_INF; c[24] = KEY_NEG_INF; c[25] = KEY_NEG_INF; c[26] = KEY_NEG_INF; c[27] = KEY_NEG_INF; c[28] = y; c[29] = x2; c[30] = x1; c[31] = x0;
#pragma unroll
            for (int j = 8; j > 0; j >>= 1)
#pragma unroll
                for (int i = 0; i < 16; ++i) { const int l = i ^ j; if (l > i) ce_desc(c[16 + i], c[16 + l]); }
        }
        merge_top16<0, 16>(c);
        unsigned W[32];
#pragma unroll
        for (int i = 0; i < 16; ++i) { auto rr = __builtin_amdgcn_permlane32_swap(c[i], c[i], false, false); W[i] = rr[0]; W[16 + i] = rr[1]; }
        merge_top16<0, 16>(W);
        asm volatile("s_waitcnt lgkmcnt(0)" ::: "memory");
        if (!hi) {
            int ids[16];
#pragma unroll
            for (int k = 0; k < 16; ++k) ids[k] = (int)(tab[(W[k] >> 4) & 15u] * 128u + tab[16 + (W[k] & 15u)]);
            unsigned short* o = IDS + (size_t)token * 128 + h * 16;
#pragma unroll
            for (int k = 0; k < 16; k += 8) *(v4u*)(o + k) = (v4u){(unsigned)ids[k] | ((unsigned)ids[k + 1] << 16), (unsigned)ids[k + 2] | ((unsigned)ids[k + 3] << 16), (unsigned)ids[k + 4] | ((unsigned)ids[k + 5] << 16), (unsigned)ids[k + 6] | ((unsigned)ids[k + 7] << 16)};
        } else {
            float e[16]; const float s0 = unmono(W[0] & ~0xFFu); float sum = 0.f;
#pragma unroll
            for (int k = 0; k < 16; ++k) { e[k] = __expf(unmono(W[k] & ~0xFFu) - s0); sum += e[k]; }
            const float inv = 1.0f / sum;
            float* o = GATES + (size_t)token * 128 + h * 16;
#pragma unroll
            for (int k = 0; k < 16; k += 4) *(f32x4*)(o + k) = (f32x4){e[k] * inv, e[k + 1] * inv, e[k + 2] * inv, e[k + 3] * inv};
        }
        asm volatile("s_waitcnt lgkmcnt(0)" ::: "memory");
    }
}

constexpr size_t WS_PART = 420 * MiB;
__device__ __forceinline__ int dpp_isum8(int x) {
    x += __builtin_amdgcn_update_dpp(0, x, 0xB1, 0xF, 0xF, true);
    x += __builtin_amdgcn_update_dpp(0, x, 0x4E, 0xF, 0xF, true);
    x += __builtin_amdgcn_update_dpp(0, x, 0x141, 0xF, 0xF, true);
    return x;
}
struct A12Meta { v4u iv0, iv1, xs; };
__device__ __forceinline__ void a12_meta(A12Meta& m, const unsigned short* IDS, const unsigned char* XQ, int t, int eg) {
    const v4u* idp = (const v4u*)(IDS + (size_t)t * 128 + 16 * eg);
    m.iv0 = idp[0]; m.iv1 = idp[1];
    m.xs = *(const v4u*)(XQ + (size_t)t * 1024);
}
__device__ __forceinline__ void a12_rows(const A12Meta& m, const unsigned char* Us, v4u (&u)[16]) {
    int ids[16];
    ids[0] = (int)(m.iv0.x & 0xffffu); ids[1] = (int)(m.iv0.x >> 16); ids[2] = (int)(m.iv0.y & 0xffffu); ids[3] = (int)(m.iv0.y >> 16);
    ids[4] = (int)(m.iv0.z & 0xffffu); ids[5] = (int)(m.iv0.z >> 16); ids[6] = (int)(m.iv0.w & 0xffffu); ids[7] = (int)(m.iv0.w >> 16);
    ids[8] = (int)(m.iv1.x & 0xffffu); ids[9] = (int)(m.iv1.x >> 16); ids[10] = (int)(m.iv1.y & 0xffffu); ids[11] = (int)(m.iv1.y >> 16);
    ids[12] = (int)(m.iv1.z & 0xffffu); ids[13] = (int)(m.iv1.z >> 16); ids[14] = (int)(m.iv1.w & 0xffffu); ids[15] = (int)(m.iv1.w >> 16);
#pragma unroll
    for (int i = 0; i < 16; ++i) u[i] = *(const v4u*)(Us + (size_t)ids[i] * 1024);
}
__device__ __forceinline__ unsigned a12_compute(const v4u (&u)[16], const v4u xs, const int cj) {
    const int xx = (int)xs.x, xy = (int)xs.y, xz = (int)xs.z, xw = (int)xs.w;
    int k0 = 0, k1 = 0;
#pragma unroll
    for (int i = 0; i < 16; ++i) {
        const int ux = (int)u[i].x, uy = (int)u[i].y, uz = (int)u[i].z, uw = (int)u[i].w;
        int d = __builtin_amdgcn_sdot4(ux, xx, 0, false); d = __builtin_amdgcn_sdot4(uy, xy, d, false); d = __builtin_amdgcn_sdot4(uz, xz, d, false); d = __builtin_amdgcn_sdot4(uw, xw, d, false);
        d = dpp_isum8(d);
        if (i < 8) k0 = (cj == i) ? d : k0; else k1 = (cj == i - 8) ? d : k1;
    }
    return pk2((float)k0, (float)k1);
}
__device__ __forceinline__ void p12a_partial(const Params& p, int bid, int G, int wave, int lane) {
    unsigned char* ws = p.ws;
    const int s = bid & 7, wx = (bid >> 3) * NWAVES + wave, NWX = (G >> 3) * NWAVES;
    const int eg = lane >> 3, cj = lane & 7;
    const unsigned char* XQ = ws + WS_XQ + 128 * s + 16 * cj; const unsigned short* IDS = (const unsigned short*)(ws + WS_IDS);
    const unsigned char* Us = ws + WS_U8 + 128 * s + 16 * cj;
    unsigned* outp = (unsigned*)((bf16*)(ws + WS_PART) + (size_t)s * NTOK * 128 + 16 * eg + 2 * cj);
    if (wx >= NTOK) return;
    A12Meta m0, m1; v4u va[16], vb[16];
    a12_meta(m0, IDS, XQ, wx, eg);
    a12_rows(m0, Us, va);
    { int tn = (wx + NWX < NTOK) ? wx + NWX : wx; asm volatile("" : "+s"(tn)); a12_meta(m1, IDS, XQ, tn, eg); }
    __builtin_amdgcn_sched_barrier(0);
    unsigned res_prev = 0u; int t_prev = wx;
    for (int t = wx; t < NTOK; t += 2 * NWX) {
        {
            a12_rows(m1, Us, vb);
            __builtin_nontemporal_store(res_prev, outp + (size_t)t_prev * 64);
            const v4u cx = m0.xs;
            { int tn = (t + 2 * NWX < NTOK) ? t + 2 * NWX : t; asm volatile("" : "+s"(tn)); a12_meta(m0, IDS, XQ, tn, eg); }
            __builtin_amdgcn_sched_barrier(0);
            res_prev = a12_compute(va, cx, cj); t_prev = t;
        }
        if (t + NWX < NTOK) {
            a12_rows(m0, Us, va);
            __builtin_nontemporal_store(res_prev, outp + (size_t)t_prev * 64);
            const v4u cx = m1.xs;
            { int tn = (t + 3 * NWX < NTOK) ? t + 3 * NWX : t; asm volatile("" : "+s"(tn)); a12_meta(m1, IDS, XQ, tn, eg); }
            __builtin_amdgcn_sched_barrier(0);
            res_prev = a12_compute(vb, cx, cj); t_prev = t + NWX;
        }
    }
    __builtin_nontemporal_store(res_prev, outp + (size_t)t_prev * 64);
}
constexpr size_t WS_WQ = 84 * MiB;
constexpr size_t WS_WSC = 92 * MiB;
__device__ __forceinline__ float dpp_max16(float x) {
    x = fmaxf(x, __builtin_bit_cast(float, __builtin_amdgcn_update_dpp(0, __builtin_bit_cast(int, x), 0xB1, 0xF, 0xF, true)));
    x = fmaxf(x, __builtin_bit_cast(float, __builtin_amdgcn_update_dpp(0, __builtin_bit_cast(int, x), 0x4E, 0xF, 0xF, true)));
    x = fmaxf(x, __builtin_bit_cast(float, __builtin_amdgcn_update_dpp(0, __builtin_bit_cast(int, x), 0x141, 0xF, 0xF, true)));
    x = fmaxf(x, __builtin_bit_cast(float, __builtin_amdgcn_update_dpp(0, __builtin_bit_cast(int, x), 0x140, 0xF, 0xF, true)));
    return x;
}
__device__ __forceinline__ void p12b_combine(const Params& p, LAS unsigned char* lds, int vcu, int G, int tid, int wave, int lane) {
    unsigned char* ws = p.ws;
    const int gw = vcu * NWAVES + wave, NGW = G * NWAVES;
    const bf16* PART = (const bf16*)(ws + WS_PART); const float* GW = (const float*)(ws + WS_GATES); const unsigned short* IDS = (const unsigned short*)(ws + WS_IDS);
    LAS const float* SU = (LAS const float*)lds; LAS const float* SV = SU + 16384;
    for (int i = tid; i < 8192; i += NTHREADS) { const int tb = i >> 12, q = i & 4095; *((LAS f32x4*)lds + i) = *((const f32x4*)(ws + (tb ? WS_SV : WS_SU)) + q); }
    __syncthreads();
    const int hh = lane >> 3, e0 = 16 * hh + (lane & 7), e1 = e0 + 8;
    constexpr int NT = 8;
    for (int t0 = gw; t0 < NTOK; t0 += NT * NGW) {
        float a0[NT], a1[NT], g0[NT], g1[NT], sx[NT]; int id0[NT], id1[NT];
#pragma unroll
        for (int r = 0; r < NT; ++r) { const int t = t0 + r * NGW;
            const int tt = t < NTOK ? t : gw;
            a0[r] = 0.f; a1[r] = 0.f;
#pragma unroll
            for (int s = 0; s < 8; ++s) { const unsigned w = *((const unsigned*)(PART + ((size_t)s * NTOK + tt) * 128) + lane); a0[r] += bflo(w); a1[r] += bfhi(w); }
            id0[r] = IDS[(size_t)tt * 128 + e0]; id1[r] = IDS[(size_t)tt * 128 + e1];
            sx[r] = ((const float*)(ws + WS_SX))[tt]; g0[r] = GW[(size_t)tt * 128 + e0]; g1[r] = GW[(size_t)tt * 128 + e1]; }
#pragma unroll
        for (int r = 0; r < NT; ++r) { const int t = t0 + r * NGW; if (t >= NTOK) continue;
            const float h0 = a0[r] * SU[id0[r]] * sx[r], h1 = a1[r] * SU[id1[r]] * sx[r];
            const float w0 = g0[r] * 0.5f * h0 * (1.0f + erff(h0 * 0.70710678118654752f)) * SV[id0[r]];
            const float w1 = g1[r] * 0.5f * h1 * (1.0f + erff(h1 * 0.70710678118654752f)) * SV[id1[r]];
            float mx = fmaxf(fabsf(w0), fabsf(w1));
            mx = fmaxf(mx, dppf<0xB1>(mx)); mx = fmaxf(mx, dppf<0x4E>(mx)); mx = fmaxf(mx, dppf<0x141>(mx));
            const float iq = mx > 0.f ? 127.0f / mx : 0.f;
            signed char* wq = (signed char*)(ws + WS_WQ) + (size_t)t * 128;
            wq[e0] = (signed char)(int)rintf(w0 * iq); wq[e1] = (signed char)(int)rintf(w1 * iq);
            if ((lane & 7) == 0) ((float*)(ws + WS_WSC))[(size_t)t * 8 + hh] = mx * (1.0f / 127.0f); }
    }
}
struct C12Meta { v4u iv0, iv1, wqv; float wsc; unsigned hb; };
__device__ __forceinline__ void c12_meta(C12Meta& m, const unsigned short* IDS, const unsigned char* WQ, const float* WSC, const unsigned char* ws, int t, int eg, int ocol) {
    const v4u* idp = (const v4u*)(IDS + (size_t)t * 128 + 16 * eg);
    m.iv0 = idp[0]; m.iv1 = idp[1];
    m.wqv = *(const v4u*)(WQ + (size_t)t * 128 + 16 * eg);
    m.wsc = WSC[(size_t)t * 8 + eg];
    m.hb = *(const unsigned*)((const bf16*)(ws + WS_H1) + (size_t)t * 1024 + ocol);
}
__device__ __forceinline__ void c12_rows(const C12Meta& m, const unsigned char* Vs, v4u (&vv)[16]) {
    int ids[16];
    ids[0] = (int)(m.iv0.x & 0xffffu); ids[1] = (int)(m.iv0.x >> 16); ids[2] = (int)(m.iv0.y & 0xffffu); ids[3] = (int)(m.iv0.y >> 16);
    ids[4] = (int)(m.iv0.z & 0xffffu); ids[5] = (int)(m.iv0.z >> 16); ids[6] = (int)(m.iv0.w & 0xffffu); ids[7] = (int)(m.iv0.w >> 16);
    ids[8] = (int)(m.iv1.x & 0xffffu); ids[9] = (int)(m.iv1.x >> 16); ids[10] = (int)(m.iv1.y & 0xffffu); ids[11] = (int)(m.iv1.y >> 16);
    ids[12] = (int)(m.iv1.z & 0xffffu); ids[13] = (int)(m.iv1.z >> 16); ids[14] = (int)(m.iv1.w & 0xffffu); ids[15] = (int)(m.iv1.w >> 16);
#pragma unroll
    for (int i = 0; i < 16; ++i) vv[i] = *(const v4u*)(Vs + (size_t)ids[i] * 1024);
}
typedef float c12f2 __attribute__((ext_vector_type(2)));
__device__ __forceinline__ c12f2 c12_compute(const v4u (&vv)[16], const v4u wqv, const float wsc, const unsigned hb, const int b3) {
    int acc[16];
#pragma unroll
    for (int k = 0; k < 16; ++k) acc[k] = 0;
    const unsigned wqd[4] = {wqv.x, wqv.y, wqv.z, wqv.w};
#pragma unroll
    for (int j = 0; j < 4; ++j) {
        const unsigned r0[4] = {vv[4 * j].x, vv[4 * j].y, vv[4 * j].z, vv[4 * j].w}, r1[4] = {vv[4 * j + 1].x, vv[4 * j + 1].y, vv[4 * j + 1].z, vv[4 * j + 1].w};
        const unsigned r2[4] = {vv[4 * j + 2].x, vv[4 * j + 2].y, vv[4 * j + 2].z, vv[4 * j + 2].w}, r3[4] = {vv[4 * j + 3].x, vv[4 * j + 3].y, vv[4 * j + 3].z, vv[4 * j + 3].w};
#pragma unroll
        for (int d = 0; d < 4; ++d) {
            const unsigned l01 = __builtin_amdgcn_perm(r1[d], r0[d], 0x05010400u), h01 = __builtin_amdgcn_perm(r1[d], r0[d], 0x07030602u);
            const unsigned l23 = __builtin_amdgcn_perm(r3[d], r2[d], 0x05010400u), h23 = __builtin_amdgcn_perm(r3[d], r2[d], 0x07030602u);
            const unsigned c0 = __builtin_amdgcn_perm(l23, l01, 0x05040100u), c1 = __builtin_amdgcn_perm(l23, l01, 0x07060302u);
            const unsigned c2 = __builtin_amdgcn_perm(h23, h01, 0x05040100u), c3 = __builtin_amdgcn_perm(h23, h01, 0x07060302u);
            acc[4 * d + 0] = __builtin_amdgcn_sdot4((int)c0, (int)wqd[j], acc[4 * d + 0], false); acc[4 * d + 1] = __builtin_amdgcn_sdot4((int)c1, (int)wqd[j], acc[4 * d + 1], false);
            acc[4 * d + 2] = __builtin_amdgcn_sdot4((int)c2, (int)wqd[j], acc[4 * d + 2], false); acc[4 * d + 3] = __builtin_amdgcn_sdot4((int)c3, (int)wqd[j], acc[4 * d + 3], false);
        }
    }
    float o[16];
#pragma unroll
    for (int k = 0; k < 16; ++k) o[k] = (float)acc[k] * wsc;
    float r8[8], r4[4], r2v[2];
#pragma unroll
    for (int j = 0; j < 8; ++j) { auto rr = __builtin_amdgcn_permlane32_swap(__float_as_uint(o[j]), __float_as_uint(o[8 + j]), false, false); r8[j] = __uint_as_float(rr[0]) + __uint_as_float(rr[1]); }
#pragma unroll
    for (int j = 0; j < 4; ++j) { auto rr = __builtin_amdgcn_permlane16_swap(__float_as_uint(r8[j]), __float_as_uint(r8[4 + j]), false, false); r4[j] = __uint_as_float(rr[0]) + __uint_as_float(rr[1]); }
#pragma unroll
    for (int j = 0; j < 2; ++j) { const float keep = b3 ? r4[2 + j] : r4[j], send = b3 ? r4[j] : r4[2 + j]; r2v[j] = keep + __uint_as_float(__builtin_amdgcn_update_dpp(0u, __float_as_uint(send), 0x128, 0xF, 0xF, true)); }
    return (c12f2){bflo(hb) + r2v[0], bfhi(hb) + r2v[1]};
}
template <bool DRY> __device__ __forceinline__ void p12c_output(const Params& p, int bid, int G, int wave, int lane) {
    unsigned char* ws = p.ws;
    const int s = bid & 7, wx = (bid >> 3) * NWAVES + wave, NWX = (G >> 3) * NWAVES;
    const int eg = lane >> 3, cj = lane & 7;
    const int b5 = (lane >> 5) & 1, b4 = (lane >> 4) & 1, b3 = (lane >> 3) & 1;
    const unsigned short* IDS = (const unsigned short*)(ws + WS_IDS); const unsigned char* WQ = ws + WS_WQ; const float* WSC = (const float*)(ws + WS_WSC);
    const unsigned char* Vs = ws + WS_V8 + 128 * s + 16 * cj;
    const int ocol = 128 * s + 16 * cj + 8 * b5 + 4 * b4 + 2 * b3;
    float* outp = (DRY ? (float*)(ws + WS_PART) : p.out) + ocol;
    if (wx >= NTOK) return;
    C12Meta m0, m1; v4u va[16], vb[16];
    c12_meta(m0, IDS, WQ, WSC, ws, wx, eg, ocol);
    c12_rows(m0, Vs, va);
    { int tn = (wx + NWX < NTOK) ? wx + NWX : wx; asm volatile("" : "+s"(tn)); c12_meta(m1, IDS, WQ, WSC, ws, tn, eg, ocol); }
    __builtin_amdgcn_sched_barrier(0);
    c12f2 res_prev = {0.f, 0.f}; int t_prev = wx;
    for (int t = wx; t < NTOK; t += 2 * NWX) {
        {
            c12_rows(m1, Vs, vb);
            __builtin_nontemporal_store(res_prev, (c12f2*)(outp + (size_t)t_prev * 1024));
            const v4u cw = m0.wqv; const float cs = m0.wsc; const unsigned ch = m0.hb;
            { int tn = (t + 2 * NWX < NTOK) ? t + 2 * NWX : t; asm volatile("" : "+s"(tn)); c12_meta(m0, IDS, WQ, WSC, ws, tn, eg, ocol); }
            __builtin_amdgcn_sched_barrier(0);
            res_prev = c12_compute(va, cw, cs, ch, b3); t_prev = t;
        }
        if (t + NWX < NTOK) {
            c12_rows(m0, Vs, va);
            __builtin_nontemporal_store(res_prev, (c12f2*)(outp + (size_t)t_prev * 1024));
            const v4u cw = m1.wqv; const float cs = m1.wsc; const unsigned ch = m1.hb;
            { int tn = (t + 3 * NWX < NTOK) ? t + 3 * NWX : t; asm volatile("" : "+s"(tn)); c12_meta(m1, IDS, WQ, WSC, ws, tn, eg, ocol); }
            __builtin_amdgcn_sched_barrier(0);
            res_prev = c12_compute(vb, cw, cs, ch, b3); t_prev = t + NWX;
        }
    }
    __builtin_nontemporal_store(res_prev, (c12f2*)(outp + (size_t)t_prev * 1024));
}

#if DIAG
constexpr size_t WS_DIAG = 1006 * MiB;
constexpr size_t WS_DSAVE = 1007 * MiB;
__device__ __forceinline__ unsigned dhash(unsigned x) { x ^= x >> 16; x *= 0x7feb352dU; x ^= x >> 15; x *= 0x846ca68bU; x ^= x >> 16; return x; }
__device__ __forceinline__ float bf2f(bf16 b) { return __builtin_bit_cast(float, (unsigned)b << 16); }
__device__ __forceinline__ float rbf(float x) { return bf2f((bf16)f2bf(x)); }
__device__ __forceinline__ void diag_report(const Params& p, int stage, float err) {
    if (!(err == err)) err = 1e30f;
#pragma unroll
    for (int o = 1; o < 64; o <<= 1) err = fmaxf(err, __shfl_xor(err, o));
    int t_ = threadIdx.x; asm volatile("" : "+v"(t_)); if ((t_ & 63) == 0) atomicMax((unsigned*)(p.ws + WS_DIAG) + stage, __builtin_bit_cast(unsigned, err));
}
#define DG_IDS() int tid_ = threadIdx.x; asm volatile("" : "+v"(tid_)); const int tid = tid_, lane = tid & 63; int G_ = gridDim.x; asm volatile("" : "+s"(G_)); const int gt = blockIdx.x * NTHREADS + tid, NGT = G_ * NTHREADS; const int gwv = gt >> 6, NGWV = NGT >> 6; (void)lane; (void)gwv; (void)NGWV; (void)NGT
__device__ __forceinline__ float relerr(float got, float ref, float fl) { return fabsf(got - ref) / (fabsf(ref) + fl); }

__device__ __forceinline__ void dg_p0(const Params& p) {
    DG_IDS(); unsigned char* ws = p.ws; float e1 = 0.f, e2 = 0.f;
    for (int s = gwv; s < 4096; s += NGWV) {
        const int m = dhash(s * 7 + 1) % R; const int b = m / TP, pp = m - b * TP;
        const bf16* xn = (const bf16*)(ws + WS_XN) + (size_t)m * 1024;
        if (pp < 48) { for (int c = lane; c < 1024; c += 64) e1 = fmaxf(e1, fabsf(bf2f(xn[c]))); continue; }
        const float* xr = (pp < 64) ? p.in[I_META] + (size_t)(pp - 48) * 1024 : p.in[I_X] + ((size_t)b * SEQ + (pp - 64)) * 1024;
        float ss = 0.f; for (int c = lane; c < 1024; c += 64) ss += xr[c] * xr[c];
        ss = wave_sum(ss); const float rs = 1.0f / sqrtf(ss / 1024.f + NORM_EPS);
        for (int c = lane; c < 1024; c += 64) e1 = fmaxf(e1, relerr(bf2f(xn[c]), xr[c] * rs * p.in[I_N1G][c], 0.05f));
    }
    for (int s = gt; s < 200000; s += NGT) {
        const unsigned hsh = dhash(s * 3 + 5); const int k = hsh & 1023, n = (hsh >> 10) % N1; const int sc = win_src_col(n);
        const float ref = sc >= 0 ? p.in[I_WIN][(size_t)k * IN_COLS + sc] : 0.f;
        e2 = fmaxf(e2, fabsf(bf2f(((const bf16*)(ws + WS_WTIN))[(size_t)n * 1024 + k]) - rbf(ref)));
        const int n2 = (hsh >> 10) & 2047;
        e2 = fmaxf(e2, fabsf(bf2f(((const bf16*)(ws + WS_WTQ))[(size_t)n2 * 1024 + k]) - rbf(p.in[I_PWQ][(size_t)k * 2048 + n2])));
        const int n3 = n2 & 1023, k3 = k & 511;
        e2 = fmaxf(e2, fabsf(bf2f(((const bf16*)(ws + WS_WTFOX))[(size_t)n3 * 512 + k3]) - rbf(p.in[I_WFOX][(size_t)k3 * 1024 + n3])));
        e2 = fmaxf(e2, fabsf(bf2f(((const bf16*)(ws + WS_WTRWKV))[(size_t)n3 * 512 + k3]) - rbf(p.in[I_WRWKV][(size_t)k3 * 1024 + n3])));
        e2 = fmaxf(e2, fabsf(bf2f(((const bf16*)(ws + WS_WTOUT))[(size_t)n3 * 1024 + k]) - rbf(p.in[I_WOUT][(size_t)k * 1024 + n3])));
        const size_t ei = (size_t)(hsh % (16384u * 1024u)); const int er = (int)(ei >> 10);
        { const float sc = ((const float*)(ws + WS_SU))[er]; const float dq = (float)((const signed char*)(ws + WS_U8))[ei] * sc; e2 = fmaxf(e2, fmaxf(fabsf(dq - p.in[I_PU][ei]) - 0.51f * sc, 0.f)); }
        { const float sc = ((const float*)(ws + WS_SV))[er]; const float dq = ((float)((const unsigned char*)(ws + WS_V8))[ei] - 128.f) * sc; e2 = fmaxf(e2, fmaxf(fabsf(dq - p.in[I_PV][ei]) - 0.51f * sc, 0.f)); }
    }
    diag_report(p, 1, e1 / 0.03f); diag_report(p, 2, e2 / 1e-6f);
}
__device__ __forceinline__ float dg_dot(const bf16* A, size_t row, const bf16* Bt, size_t n, int K) {
    const bf16* a = A + row * K; const bf16* b = Bt + n * K; float s = 0.f;
    for (int k = 0; k < K; k += 8) { float x[8], y[8]; unpack8(*(const v4u*)(a + k), x); unpack8(*(const v4u*)(b + k), y);
#pragma unroll
        for (int e = 0; e < 8; ++e) s = fmaf(x[e], y[e], s); }
    return s;
}
__device__ __forceinline__ void dg_gemm1(const Params& p) {
    DG_IDS(); unsigned char* ws = p.ws; float e = 0.f;
    for (int s = gt; s < 262144; s += NGT) {
        const unsigned hsh = dhash(s * 11 + 3); const int row = hsh % R, n = dhash(hsh) % N1;
        const float ref = dg_dot((const bf16*)(ws + WS_XN), row, (const bf16*)(ws + WS_WTIN), n, 1024);
        float got, want;
        if (n < 3584) { got = bf2f(((const bf16*)(ws + WS_F))[(size_t)(n >> 9) * ((size_t)R * 512) + (size_t)row * 512 + (n & 511)]); want = ref; }
        else { got = bf2f(((const bf16*)(ws + WS_ZG))[(size_t)row * 2048 + (n - 3584)]); want = 1.0f / (1.0f + expf(-ref)); }
        e = fmaxf(e, relerr(got, want, 0.25f));
    }
    diag_report(p, 3, e / 0.02f);
}
__device__ __forceinline__ void dg_p2(const Params& p) {
    DG_IDS(); unsigned char* ws = p.ws; float e = 0.f;
    for (int s = gt; s < 262144; s += NGT) {
        const unsigned hsh = dhash(s * 13 + 7); const int m = hsh % R, c = dhash(hsh) % 296; const int pp = m % TP;
        const bf16* zm = (const bf16*)(ws + WS_ZM);
        const float z = bf2f(zm[(size_t)m * 512 + c]);
        if (c >= 288) { const float x = z + p.in[I_FBIAS][c - 288]; const float want = -log1pf(expf(-x)); e = fmaxf(e, relerr(((const float*)(ws + WS_LF))[(size_t)m * 8 + (c - 288)], want, 0.01f)); continue; }
        const float zp = pp > 0 ? bf2f(zm[(size_t)(m - 1) * 512 + c]) : 0.f; const float mu = p.in[I_MU][1536 + c];
        const float zs = z + mu * (zp - z);
        if (c < 64) e = fmaxf(e, relerr(bf2f(((const bf16*)(ws + WS_LA))[(size_t)m * 128 + c]), tanhf(zs), 0.1f));
        else if (c < 128) e = fmaxf(e, relerr(bf2f(((const bf16*)(ws + WS_LA))[(size_t)m * 128 + c]), zs, 0.1f));
        else e = fmaxf(e, relerr(bf2f(((const bf16*)(ws + WS_LG))[(size_t)m * 256 + (c - 128)]), 1.0f / (1.0f + expf(-zs)), 0.1f));
        if (pp >= 48) { const int h = c & 7; float sq = 0.f, sk = 0.f;
            for (int d = 0; d < 64; ++d) { const float q = bf2f(((const bf16*)(ws + WS_FQ))[(size_t)m * 512 + h * 64 + d]) / (p.in[I_FQN][h * 64 + d] * attn_body::C2); sq += q * q;
                const float k = bf2f(((const bf16*)(ws + WS_FK))[(size_t)m * 512 + h * 64 + d]) / p.in[I_FKN][h * 64 + d]; sk += k * k; }
            e = fmaxf(e, fabsf(sq / 64.f - 1.f)); e = fmaxf(e, fabsf(sk / 64.f - 1.f)); }
    }
    diag_report(p, 4, e / 0.03f);
}
__device__ __forceinline__ void dg_p3(const Params& p) {
    DG_IDS(); unsigned char* ws = p.ws; unsigned char* dob = (unsigned char*)p.out; float e5 = 0.f, e6 = 0.f;
    for (int s = gt; s < 131072; s += NGT) {
        const unsigned hsh = dhash(s * 17 + 9); const int seq = hsh & 127, pp = (hsh >> 7) % TP; const int b = seq >> 3, h = seq & 7;
        const float* kb = (const float*)(ws + WS_KB) + (size_t)seq * TP; const float lf = ((const float*)(ws + WS_LF))[((size_t)b * TP + pp) * 8 + h];
        if (pp < 48) e5 = fmaxf(e5, kb[pp] < -1e29f ? 0.f : 1.f);
        else if (pp == 48) e5 = fmaxf(e5, fabsf(kb[pp] + lf * LOG2E));
        else e5 = fmaxf(e5, fabsf((kb[pp] - kb[pp - 1]) + lf * LOG2E));
        const int m = dhash(hsh) % R, c = dhash(hsh + 1) % 1536;
        const bf16* la = (const bf16*)(ws + WS_LA) + (size_t)m * 128; const bf16* lg = (const bf16*)(ws + WS_LG) + (size_t)m * 256;
        if (c < 512) { float a = p.in[I_W0][c]; for (int k = 0; k < 64; ++k) a += bf2f(la[k]) * rbf(p.in[I_WUP][k * 512 + c]);
            const float w = -log1pf(expf(-a)) - 0.5f; const float want = 1.0f - expf(-expf(w));
            e6 = fmaxf(e6, relerr(bf2f(((const bf16*)(dob + DO_XW))[(size_t)m * 512 + c]), want, 0.002f)); }
        else if (c < 1024) { float a = p.in[I_A0][c - 512]; for (int k = 0; k < 64; ++k) a += bf2f(la[64 + k]) * rbf(p.in[I_AUP][k * 512 + (c - 512)]);
            e6 = fmaxf(e6, relerr(bf2f(((const bf16*)(dob + DO_AA))[(size_t)m * 512 + (c - 512)]), 1.0f / (1.0f + expf(-a)), 0.05f)); }
        else { float a = 0.f; for (int k = 0; k < 160; ++k) a += bf2f(lg[k]) * rbf(p.in[I_GUP][k * 512 + (c - 1024)]);
            e6 = fmaxf(e6, relerr(bf2f(((const bf16*)(dob + DO_GG))[(size_t)m * 512 + (c - 1024)]), a, 0.1f)); }
    }
    diag_report(p, 5, e5 / 1e-3f); diag_report(p, 6, e6 / 0.03f);
}
constexpr int DG_NS4 = 2048;
__device__ __forceinline__ void dg_p4_pre(const Params& p) {
    DG_IDS(); unsigned char* dob = (unsigned char*)p.out; float* sv = (float*)(p.ws + WS_DSAVE);
    for (int s = gt; s < DG_NS4 * 64; s += NGT) { const int i = s >> 6, d = s & 63; const unsigned hsh = dhash(i * 19 + 11); const int m = hsh % R, h = (hsh >> 20) & 7;
        sv[s] = bf2f(((const bf16*)(dob + DO_AA))[(size_t)m * 512 + h * 64 + d]); }
}
__device__ __forceinline__ void dg_p4_post(const Params& p) {
    DG_IDS(); unsigned char* ws = p.ws; unsigned char* dob = (unsigned char*)p.out; const float* sv = (const float*)(ws + WS_DSAVE); float e = 0.f;
    for (int i = gwv; i < DG_NS4; i += NGWV) {
        const unsigned hsh = dhash(i * 19 + 11); const int m = hsh % R, h = (hsh >> 20) & 7; const int pp = m % TP; const int c = h * 64 + lane;
        const float a = sv[i * 64 + lane];
        const float r0 = bf2f(((const bf16*)(ws + WS_ZRR))[(size_t)m * 512 + c]), k0 = bf2f(((const bf16*)(ws + WS_ZRK))[(size_t)m * 512 + c]);
        const float r1 = pp > 0 ? bf2f(((const bf16*)(ws + WS_ZRR))[(size_t)(m - 1) * 512 + c]) : 0.f, k1 = pp > 0 ? bf2f(((const bf16*)(ws + WS_ZRK))[(size_t)(m - 1) * 512 + c]) : 0.f;
        const float rs = r0 + p.in[I_MU][c] * (r1 - r0), ks = k0 + p.in[I_MU][512 + c] * (k1 - k0);
        const float kk = ks * p.in[I_KK][c], kp = ks * (1.0f + (a - 1.0f) * p.in[I_KA][c]);
        const float nrm = fmaxf(sqrtf(wave_sum(kk * kk)), 1e-12f); const float kn = kk / nrm, bb = kn * a; const float bs = wave_sum(rs * kp * p.in[I_RK][c]);
        e = fmaxf(e, relerr(bf2f(((const bf16*)(ws + WS_KP))[(size_t)m * 512 + c]), kp, 0.1f));
        e = fmaxf(e, relerr(bf2f(((const bf16*)(ws + WS_KN))[(size_t)m * 512 + c]), kn, 0.02f));
        e = fmaxf(e, relerr(bf2f(((const bf16*)(dob + DO_AA))[(size_t)m * 512 + c]), bb, 0.02f));
        e = fmaxf(e, relerr(((const float*)(ws + WS_BS))[(size_t)m * 8 + h], bs, 0.1f));
    }
    diag_report(p, 7, e / 0.03f);
}
constexpr int DG_NS8 = 1024;
__device__ __forceinline__ void dg_attn_sample(int i, int& b, int& h, int& t) { const unsigned hsh = dhash(i * 23 + 13); b = hsh & 15; h = (hsh >> 4) & 7; t = (hsh >> 8) & 4095; if (i < 8) t = (i & 1) ? 4095 - (i >> 1) : (i >> 1); }
__device__ __forceinline__ void dg_attn_pre(const Params& p) {
    DG_IDS(); float* sv = (float*)(p.ws + WS_DSAVE + 512 * 1024);
    for (int s = gt; s < DG_NS8 * 64; s += NGT) { const int i = s >> 6, d = s & 63; int b, h, t; dg_attn_sample(i, b, h, t);
        sv[s] = bf2f(((const bf16*)(p.ws + WS_FQ))[((size_t)b * TP + 64 + t) * 512 + h * 64 + d]); }
}
__device__ __forceinline__ void dg_attn_post(const Params& p) {
    DG_IDS(); unsigned char* ws = p.ws; const float* sv = (const float*)(ws + WS_DSAVE + 512 * 1024); float e = 0.f;
    for (int i = gwv; i < DG_NS8; i += NGWV) {
        int b, h, t; dg_attn_sample(i, b, h, t);
        const int npos = 64 + t;
        const float* kb = (const float*)(ws + WS_KB) + (size_t)(b * 8 + h) * TP;
        const bf16* K = (const bf16*)(ws + WS_FK) + (size_t)b * TP * 512 + h * 64; const bf16* V = (const bf16*)(ws + WS_FV) + (size_t)b * TP * 512 + h * 64;
        float mx = -1e38f;
        for (int j = 48 + lane; j <= npos; j += 64) { float s = 0.f; for (int d = 0; d < 64; ++d) s += sv[i * 64 + d] * bf2f(K[(size_t)j * 512 + d]); s += kb[j]; mx = fmaxf(mx, s); }
        for (int o = 1; o < 64; o <<= 1) mx = fmaxf(mx, __shfl_xor(mx, o));
        float l = 0.f, acc = 0.f;
        for (int j = 48; j <= npos; ++j) { float s = 0.f; for (int d = 0; d < 64; ++d) s += sv[i * 64 + d] * bf2f(K[(size_t)j * 512 + d]); const float pj = exp2f(s + kb[j] - mx); l += pj; acc += pj * bf2f(V[(size_t)j * 512 + lane]); }
        const float want = acc / l; const float got = bf2f(((const bf16*)(ws + WS_FQ))[((size_t)b * TP + 64 + t) * 512 + h * 64 + lane]);
        e = fmaxf(e, fabsf(got - want) / (fabsf(want) + 0.05f));
    }
    diag_report(p, 8, e / 0.05f);
}
__device__ __forceinline__ void dg_scan(const Params& p, LAS unsigned char* lds) {
    DG_IDS(); unsigned char* ws = p.ws; unsigned char* dob = (unsigned char*)p.out; float e = 0.f;
    if (gwv < 4) {
        const int bh = (gwv * 37 + 5) & 127, b = bh >> 3, h = bh & 7; const size_t rowb = (size_t)b * TP; const int cb = h * 64;
        LAS float* S = (LAS float*)lds + (gwv * 64 + lane) * 65;
        for (int k = 0; k < 64; ++k) S[k] = 0.f;
        const bf16* aXW = (const bf16*)(dob + DO_XW); const bf16* aA = (const bf16*)(dob + DO_AA); const bf16* aG = (const bf16*)(dob + DO_GG);
        const bf16* aR = (const bf16*)(ws + WS_ZRR); const bf16* aK = (const bf16*)(ws + WS_ZRK); const bf16* aV = (const bf16*)(ws + WS_ZRV);
        const float muv = p.in[I_MU][1024 + cb + lane];
#ifndef DG_SCAN_MAXPP
#define DG_SCAN_MAXPP TP
#endif
#pragma unroll 1
        for (int pp = 48; pp < DG_SCAN_MAXPP; ++pp) {
            const size_t ro = (rowb + pp) * 512 + cb;
            const float v0 = bf2f(aV[ro + lane]), v1 = bf2f(aV[ro - 512 + lane]); const float vv = v0 + muv * (v1 - v0);
            float ss = 0.f;
#pragma unroll 2
            for (int k = 0; k < 64; ++k) { const float k0 = bf2f(aK[ro + k]), k1 = bf2f(aK[ro - 512 + k]); const float ks = k0 + p.in[I_MU][512 + cb + k] * (k1 - k0); const float kk = ks * p.in[I_KK][cb + k]; ss += kk * kk; }
            const float inv = 1.0f / fmaxf(sqrtf(ss), 1e-12f);
            float sa = 0.f;
#pragma unroll 2
            for (int k = 0; k < 64; ++k) { const float k0 = bf2f(aK[ro + k]), k1 = bf2f(aK[ro - 512 + k]); const float ks = k0 + p.in[I_MU][512 + cb + k] * (k1 - k0); sa += S[k] * (ks * p.in[I_KK][cb + k] * inv); }
            sa = -sa; float y = 0.f, bon = 0.f;
#pragma unroll 2
            for (int k = 0; k < 64; ++k) { const float k0 = bf2f(aK[ro + k]), k1 = bf2f(aK[ro - 512 + k]); const float ks = k0 + p.in[I_MU][512 + cb + k] * (k1 - k0); const float a = bf2f(aA[ro + k]);
                const float kn = ks * p.in[I_KK][cb + k] * inv, kp = ks * (1.0f + (a - 1.0f) * p.in[I_KA][cb + k]);
                const float dec = 1.0f - bf2f(aXW[ro + k]); const float sn = S[k] * dec + sa * (kn * a) + vv * kp; S[k] = sn;
                const float r0 = bf2f(aR[ro + k]), r1 = bf2f(aR[ro - 512 + k]); const float rs = r0 + p.in[I_MU][cb + k] * (r1 - r0); y += sn * rs; bon += rs * kp * p.in[I_RK][cb + k]; }
            const float mean = wave_sum(y) * (1.f / 64.f); const float var = wave_sum((y - mean) * (y - mean)) * (1.f / 64.f);
            const float want = ((y - mean) / sqrtf(var + GN_EPS) * p.in[I_LNG][cb + lane] + p.in[I_LNB][cb + lane] + bon * vv) * bf2f(aG[ro + lane]);
            const float got = bf2f(((const bf16*)(ws + WS_Y))[ro + lane]);
            const float rms = sqrtf(wave_sum(want * want) * (1.f / 64.f));
            e = fmaxf(e, fabsf(got - want) / (fabsf(want) + 0.5f * rms + 0.02f));
        }
    }
    diag_report(p, 9, e / 0.15f);
}
__device__ __forceinline__ void dg_p6_pre(const Params& p) {
    DG_IDS(); float* sv = (float*)(p.ws + WS_DSAVE + 768 * 1024);
    for (int s = gt; s < DG_NS4 * 64; s += NGT) { const int i = s >> 6, d = s & 63; const unsigned hsh = dhash(i * 29 + 17); const int m = hsh % R, h = (hsh >> 20) & 7;
        sv[s] = bf2f(((const bf16*)(p.ws + WS_Y))[(size_t)m * 512 + h * 64 + d]); }
}
__device__ __forceinline__ void dg_p6_post(const Params& p) {
    DG_IDS(); unsigned char* ws = p.ws; unsigned char* dob = (unsigned char*)p.out; const float* sv = (const float*)(ws + WS_DSAVE + 768 * 1024); float e = 0.f;
    for (int i = gwv; i < DG_NS4; i += NGWV) {
        const unsigned hsh = dhash(i * 29 + 17); const int m = hsh % R, h = (hsh >> 20) & 7; const int pp = m % TP; const int c = h * 64 + lane;
        if (pp < 48) continue;
        const float y = sv[i * 64 + lane]; const float mean = wave_sum(y) / 64.f; const float var = wave_sum((y - mean) * (y - mean)) / 64.f;
        const float gn = (y - mean) / sqrtf(var + GN_EPS) * p.in[I_LNG][c] + p.in[I_LNB][c];
        const float v0 = bf2f(((const bf16*)(ws + WS_ZRV))[(size_t)m * 512 + c]), v1 = bf2f(((const bf16*)(ws + WS_ZRV))[(size_t)(m - 1) * 512 + c]);
        const float vs = v0 + p.in[I_MU][1024 + c] * (v1 - v0);
        const float want = (gn + ((const float*)(ws + WS_BS))[(size_t)m * 8 + h] * vs) * bf2f(((const bf16*)(dob + DO_GG))[(size_t)m * 512 + c]);
        e = fmaxf(e, relerr(bf2f(((const bf16*)(ws + WS_Y))[(size_t)m * 512 + c]), want, 0.1f));
    }
    diag_report(p, 10, e / 0.03f);
}
__device__ __forceinline__ void dg_mix(const Params& p, int stage) {
    DG_IDS(); unsigned char* ws = p.ws; float e = 0.f;
    for (int s = gt; s < 131072; s += NGT) {
        const unsigned hsh = dhash(s * 31 + 19 + stage); const int row = hsh % R, c = dhash(hsh) & 1023;
        float want = dg_dot((const bf16*)(ws + WS_FQ), row, (const bf16*)(ws + WS_WTFOX), c, 512) * bf2f(((const bf16*)(ws + WS_ZG))[(size_t)row * 2048 + c]);
        if (stage == 12) want = rbf(want) + dg_dot((const bf16*)(ws + WS_Y), row, (const bf16*)(ws + WS_WTRWKV), c, 512) * bf2f(((const bf16*)(ws + WS_ZG))[(size_t)row * 2048 + 1024 + c]);
        e = fmaxf(e, relerr(bf2f(((const bf16*)(ws + WS_MIX))[(size_t)row * 1024 + c]), want, 0.1f));
    }
    diag_report(p, stage, e / 0.03f);
}
__device__ __forceinline__ void dg_out(const Params& p) {
    DG_IDS(); unsigned char* ws = p.ws; float e = 0.f;
    for (int s = gt; s < 131072; s += NGT) {
        const unsigned hsh = dhash(s * 37 + 23); const int tok = hsh & 65535, c = dhash(hsh) & 1023; const int b = tok >> 12, t = tok & 4095;
        const float want = p.in[I_X][(size_t)tok * 1024 + c] + dg_dot((const bf16*)(ws + WS_MIX), (size_t)b * TP + 64 + t, (const bf16*)(ws + WS_WTOUT), c, 1024);
        e = fmaxf(e, relerr(p.out[(size_t)tok * 1024 + c], want, 0.3f));
    }
    diag_report(p, 13, e / 0.01f);
}
__device__ __forceinline__ void dg_norm2(const Params& p) {
    DG_IDS(); unsigned char* ws = p.ws; float e = 0.f;
    for (int s = gwv; s < 4096; s += NGWV) {
        const int m = dhash(s * 41 + 29) & 65535; const float* xr = p.out + (size_t)m * 1024;
        float ss = 0.f; for (int c = lane; c < 1024; c += 64) ss += xr[c] * xr[c];
        ss = wave_sum(ss); const float rs = 1.0f / sqrtf(ss / 1024.f + NORM_EPS);
        for (int c = lane; c < 1024; c += 64) e = fmaxf(e, relerr(bf2f(((const bf16*)(ws + WS_XN2))[(size_t)m * 1024 + c]), xr[c] * rs * p.in[I_N2G][c], 0.05f));
    }
    diag_report(p, 14, e / 0.03f);
}
__device__ __forceinline__ void dg_pq(const Params& p) {
    DG_IDS(); unsigned char* ws = p.ws; float e = 0.f;
    for (int s = gt; s < 131072; s += NGT) {
        const unsigned hsh = dhash(s * 43 + 31); const int tok = hsh & 65535, c = dhash(hsh) & 2047;
        const float want = dg_dot((const bf16*)(ws + WS_XN2), tok, (const bf16*)(ws + WS_WTQ), c, 1024);
        e = fmaxf(e, relerr(bf2f(((const bf16*)(ws + WS_PQ))[(size_t)tok * 2048 + c]), want, 0.25f));
    }
    diag_report(p, 15, e / 0.02f);
}
__device__ __forceinline__ void dg_route(const Params& p, LAS unsigned char* lds) {
    DG_IDS(); unsigned char* ws = p.ws; float e16 = 0.f, e17 = 0.f;
    LAS float* s2l = (LAS float*)lds + (tid >> 6) * 128;
    for (int i = gwv; i < 2048; i += NGWV) {
        const unsigned hsh = dhash(i * 47 + 37); const int tok = hsh & 65535, h = (hsh >> 16) & 7;
        const bf16* q = (const bf16*)(ws + WS_PQ) + (size_t)tok * 2048 + h * 256; const bf16* ks = (const bf16*)(ws + WS_KS);
        float s1a = 0.f, s1b = 0.f, s2a = 0.f, s2b = 0.f;
        for (int d = 0; d < 128; ++d) { const float q1 = bf2f(q[d]), q2 = bf2f(q[128 + d]);
            s1a += q1 * bf2f(ks[(size_t)lane * 128 + d]); s1b += q1 * bf2f(ks[(size_t)(lane + 64) * 128 + d]);
            s2a += q2 * bf2f(ks[(size_t)(128 + lane) * 128 + d]); s2b += q2 * bf2f(ks[(size_t)(192 + lane) * 128 + d]); }
        s2l[lane] = s2a; s2l[lane + 64] = s2b; asm volatile("s_waitcnt lgkmcnt(0)" ::: "memory");
        float prev_s = 3e38f; int prev_id = -1; float top_s[16]; int top_id[16];
#pragma unroll 1
        for (int r = 0; r < 16; ++r) {
            float bs = -3e38f; int bi = 0x7fffffff;
            for (int j = 0; j < 128; ++j) { const float t2 = s2l[j];
                { const float sm = s1a + t2; const int id = lane * 128 + j; const bool ok = (sm < prev_s) || (sm == prev_s && id > prev_id); if (ok && (sm > bs || (sm == bs && id < bi))) { bs = sm; bi = id; } }
                { const float sm = s1b + t2; const int id = (lane + 64) * 128 + j; const bool ok = (sm < prev_s) || (sm == prev_s && id > prev_id); if (ok && (sm > bs || (sm == bs && id < bi))) { bs = sm; bi = id; } } }
            for (int o = 1; o < 64; o <<= 1) { const float os = __shfl_xor(bs, o); const int oi = __shfl_xor(bi, o); if (os > bs || (os == bs && oi < bi)) { bs = os; bi = oi; } }
            top_s[r] = bs; top_id[r] = bi; prev_s = bs; prev_id = bi;
        }
        const int* ids = (const int*)(ws + WS_IDS) + (size_t)tok * 128 + h * 16; const float* gts = (const float*)(ws + WS_GATES) + (size_t)tok * 128 + h * 16;
        float den = 0.f;
#pragma unroll
        for (int r = 0; r < 16; ++r) den += expf(top_s[r] - top_s[0]);
        int miss = 0;
#pragma unroll
        for (int r = 0; r < 16; ++r) {
            bool found = false; for (int k = 0; k < 16; ++k) found |= (ids[k] == top_id[r]);
            if (!found && top_s[r] > top_s[15] + 2e-3f * fabsf(top_s[15]) + 1e-4f) ++miss;
            e17 = fmaxf(e17, fabsf(gts[r] - expf(top_s[r] - top_s[0]) / den));
        }
        e16 = fmaxf(e16, (float)miss);
        if (lane == 0 && miss) atomicAdd((float*)(ws + WS_DIAG) + 19, (float)miss);
    }
    diag_report(p, 16, e16 / 0.5f); diag_report(p, 17, e17 / 0.01f);
}
constexpr int DG_NS18 = 128;
__device__ __forceinline__ void dg_gather_pre(const Params& p) {
    DG_IDS(); float* sv = (float*)(p.ws + WS_DSAVE + 1280 * 1024);
    for (int s = gt; s < DG_NS18 * 1024; s += NGT) { const int i = s >> 10, c = s & 1023; const int tok = dhash(i * 53 + 41) & 65535; sv[s] = p.out[(size_t)tok * 1024 + c]; }
    for (int s = gt; s < DG_NS18 * 128; s += NGT) { const int i = s >> 7, ex = s & 127; const int tok = dhash(i * 53 + 41) & 65535; sv[DG_NS18 * 1024 + s] = ((const float*)(p.ws + WS_GATES))[(size_t)tok * 128 + ex]; }
}
__device__ __forceinline__ void dg_gather_post(const Params& p) {
    DG_IDS(); unsigned char* ws = p.ws; const float* sv = (const float*)(ws + WS_DSAVE + 1280 * 1024); float e = 0.f;
    for (int i = gwv; i < DG_NS18; i += NGWV) {
        const int tok = dhash(i * 53 + 41) & 65535;
        const int* ids = (const int*)(ws + WS_IDS) + (size_t)tok * 128; const float* gts = (const float*)(ws + WS_GATES) + (size_t)tok * 128;
        const signed char* xq = (const signed char*)(ws + WS_XQ) + (size_t)tok * 1024; const float sx = ((const float*)(ws + WS_SX))[tok];
        float o[16];
#pragma unroll
        for (int k = 0; k < 16; ++k) o[k] = 0.f;
        for (int ex = 0; ex < 128; ++ex) {
            const int id = ids[ex]; const signed char* ur = (const signed char*)(ws + WS_U8) + (size_t)id * 1024; const unsigned char* vr = ws + WS_V8 + (size_t)id * 1024;
            float d = 0.f;
#pragma unroll
            for (int k = 0; k < 16; ++k) d += (float)ur[lane * 16 + k] * (float)xq[lane * 16 + k];
            d = wave_sum(d) * ((const float*)(ws + WS_SU))[id] * sx;
            const float svs = ((const float*)(ws + WS_SV))[id];
            const float w = gts[ex];
            e = fmaxf(e, fabsf(w - sv[DG_NS18 * 1024 + i * 128 + ex] * 0.5f * d * (1.0f + erff(d * 0.70710678f)) * svs) / (0.02f * svs) * 0.05f);
#pragma unroll
            for (int k = 0; k < 16; ++k) o[k] += w * ((float)vr[lane * 16 + k] - 128.f);
        }
        float ss = 0.f;
#pragma unroll
        for (int k = 0; k < 16; ++k) ss += o[k] * o[k];
        const float rms = sqrtf(wave_sum(ss) / 1024.f);
#pragma unroll
        for (int k = 0; k < 16; ++k) e = fmaxf(e, fabsf((p.out[(size_t)tok * 1024 + lane * 16 + k] - sv[i * 1024 + lane * 16 + k]) - o[k]) / (rms + 1e-3f));
    }
    diag_report(p, 18, e / 0.05f);
}
__device__ __forceinline__ void dg_final(const Params& p) {
    DG_IDS(); const float* dg = (const float*)(p.ws + WS_DIAG);
    int k = 0;
    for (int s = 1; s <= 26; ++s) if (k == 0 && s != 19 && s != 20 && !(dg[s] <= 1.0f)) k = s;
    if (k != 9) k = (dg[9] <= 1.0f) ? 0 : 9;
#ifdef DIAG_SKIP
    { int kk = 0; for (int s = 1; s <= 26; ++s) if (kk == 0 && s > DIAG_SKIP && s != 19 && s != 20 && !(dg[s] <= 1.0f)) kk = s; k = kk; }
#endif
#ifdef DIAG_VALUE
    const float a = fminf(fmaxf(dg[DIAG_VALUE], 1e-3f), 1e6f) * 16.f;
#else
    const float a = exp2f((float)k);
#endif
    for (size_t i = gt; i < (size_t)NTOK * 1024 / 4; i += NGT) ((f32x4*)p.out)[i] = (f32x4){a, a, a, a};
}
#endif

#define XB_TMO      128
#define XB_XCNT(j)  (256  + 64 * (j))
#define XB_XSUB(j)  (1280 + 64 * (j))
#define XB_XGEN(j)  (2304 + 64 * (j))
#define XB_TOP      3328
#define XB_TOPGEN   3392
#define XCD_BAR_WORDS 3456
#if DIAG
#define XB_SPIN_CAP (1u << 28)
#else
#define XB_SPIN_CAP (1u << 18)
#endif

__device__ __forceinline__ unsigned xb_ld(unsigned* p)              { return __hip_atomic_load(p, __ATOMIC_RELAXED, __HIP_MEMORY_SCOPE_AGENT); }
__device__ __forceinline__ unsigned xb_add(unsigned* p, unsigned v) { return __hip_atomic_fetch_add(p, v, __ATOMIC_RELAXED, __HIP_MEMORY_SCOPE_AGENT); }
__device__ __forceinline__ unsigned xb_xcc_id() { return (unsigned)__builtin_amdgcn_s_getreg((3 << 11) | 20) & 0xFu; }
#define XB_SPIN(cond, bar) do { unsigned _sp = 0; while (cond) { __builtin_amdgcn_s_sleep(1); \
    if ((++_sp & 255u) == 0u) { if (xb_ld(&(bar)[XB_TMO])) break; if (_sp > XB_SPIN_CAP) { atomicAdd(&(bar)[XB_TMO], 1u); break; } } } } while (0)

struct XcdBarrier {
    unsigned* bar; unsigned x;
    volatile LAS unsigned* st;
};

__device__ __forceinline__ XcdBarrier xcd_barrier_post(unsigned* bar, volatile LAS unsigned* st) {
    XcdBarrier b; b.bar = bar; b.x = xb_xcc_id(); b.st = st;
    if (threadIdx.x == 0) (void)xb_add(&bar[XB_XCNT(b.x)], 1u);
    return b;
}
__device__ __forceinline__ void xcd_barrier_complete(unsigned* bar, unsigned x, unsigned& nloc, unsigned& nx) {
    const unsigned G = gridDim.x * gridDim.y * gridDim.z;
    unsigned sum, cnt, mine, sp = 0u;
    for (;;) {
        sum = 0u; cnt = 0u; mine = 0u;
#pragma unroll
        for (unsigned j = 0; j < 16; ++j) { const unsigned c = xb_ld(&bar[XB_XCNT(j)]); sum += c; cnt += (c > 0u) ? 1u : 0u; mine = (j == x) ? c : mine; }
        if (sum == G) break;
        __builtin_amdgcn_s_sleep(1);
        if ((++sp & 255u) == 0u) { if (xb_ld(&bar[XB_TMO])) break; if (sp > XB_SPIN_CAP) { atomicAdd(&bar[XB_TMO], 1u); break; } }
    }
    nloc = mine > 0u ? mine : 1u; nx = cnt > 0u ? cnt : 1u;
}

__device__ __forceinline__ void xcd_barrier(const XcdBarrier& b) {
    asm volatile("s_waitcnt vmcnt(0)" ::: "memory");
    __syncthreads();
    if (threadIdx.x == 0) {
        unsigned* bar = b.bar;
        __builtin_amdgcn_s_waitcnt(0);
        unsigned nloc = b.st[0], nx = b.st[1];
        if (nloc == 0u) { xcd_barrier_complete(bar, b.x, nloc, nx); b.st[0] = nloc; b.st[1] = nx; }
        const unsigned old = xb_add(&bar[XB_XSUB(b.x)], 1u);
        const unsigned gen = old / nloc;
        if (old + 1u == (gen + 1u) * nloc) {
            __builtin_amdgcn_fence(__ATOMIC_RELEASE, "agent");
            asm volatile("s_waitcnt vmcnt(0)" ::: "memory");
            const unsigned og = xb_add(&bar[XB_TOP], 1u);
            const unsigned tg = og / nx;
            if (og + 1u == (tg + 1u) * nx) xb_add(&bar[XB_TOPGEN], 1u);
            else XB_SPIN(xb_ld(&bar[XB_TOPGEN]) == tg, bar);
            __builtin_amdgcn_fence(__ATOMIC_ACQUIRE, "agent");
            xb_add(&bar[XB_XGEN(b.x)], 1u);
            asm volatile("s_waitcnt vmcnt(0)" ::: "memory");
        } else {
            XB_SPIN(xb_ld(&bar[XB_XGEN(b.x)]) == gen, bar);
            __builtin_amdgcn_fence(__ATOMIC_ACQUIRE, "agent");
            asm volatile("s_waitcnt vmcnt(0)" ::: "memory");
        }
    }
    __syncthreads();
}

#ifndef TIMING
#define TIMING 0
#endif
#if TIMING
#define TS(i) do { int t__ = threadIdx.x; asm volatile("" : "+v"(t__)); if (bid == 0 && t__ == 0) ((unsigned long long*)(ws + 1010 * MiB))[i] = __builtin_amdgcn_s_memrealtime(); } while (0)
#else
#define TS(i)
#endif
#if DIAG
#define DG(...) __VA_ARGS__
#else
#define DG(...)
#endif
constexpr int LDS_BYTES = 147456;
static_assert(attn_body::ATTN_LDS_BYTES <= 131072, "attention LDS");
static_assert(RT_KS_BYTES + NTHREADS * RT_TAB_WORDS * 4 <= LDS_BYTES, "routing LDS");
static_assert(sc2::END <= LDS_BYTES - 64, "scan LDS");

__global__ void __launch_bounds__(NTHREADS, 2) hybrid_fwd(Params p) {
    extern __shared__ __attribute__((aligned(16))) unsigned char lds_raw[];
    cg::grid_group grid = cg::this_grid();
    LAS unsigned char* lds = (LAS unsigned char*)lds_raw;
    const int G0 = gridDim.x, bid = blockIdx.x;
#define LANE_IDS() int tid = threadIdx.x; asm volatile("" : "+v"(tid)); const int lane = tid & 63, wave = __builtin_amdgcn_readfirstlane(tid >> 6); (void)lane; (void)wave; int G = G0; asm volatile("" : "+s"(G))
    const int vcu = (G0 % 8 == 0) ? (bid % 8) * (G0 / 8) + bid / 8 : bid;
    unsigned char* ws = p.ws; unsigned char* dob = (unsigned char*)p.out;

    DG({ int t_ = threadIdx.x; asm volatile("" : "+v"(t_)); if (bid == 0 && t_ < 64) ((float*)(ws + WS_DIAG))[t_] = 0.f; })
    unsigned* barw = (unsigned*)(ws + 65536);
    { int t__ = threadIdx.x; asm volatile("" : "+v"(t__)); if (bid == 0) for (int i = t__; i < XCD_BAR_WORDS + 128; i += NTHREADS) __hip_atomic_store(barw + i, 0u, __ATOMIC_RELAXED, __HIP_MEMORY_SCOPE_AGENT);
      if (t__ < 2) ((volatile LAS unsigned*)(lds + LDS_BYTES - 64))[t__] = 0u; }
    __syncthreads();
    TS(0);
    { LANE_IDS(); p0_prologue(p, lds, vcu, G, wave, lane); }
#ifdef REP_P0
    __syncthreads(); { LANE_IDS(); p0_prologue(p, lds, vcu, G, wave, lane); }
#endif
    grid.sync();
    const XcdBarrier xbar = xcd_barrier_post(barw, (volatile LAS unsigned*)(lds + LDS_BYTES - 64));
#define GSYNC() xcd_barrier(xbar)
    DG()
    TS(1);
    run_gemm_i8(lds, ws + WS_XN, ws + WS_WTIN, R, N1, 1024, G0, bid, (const float*)(ws + WS_SXN), (const float*)(ws + WS_SWIN), F_Gemm1{(bf16*)(ws + WS_F), (bf16*)(ws + WS_ZG), p.in[I_FKN], (LAS float*)(lds + pg8::STAGE_BYTES)});
#ifdef REP_GEMM1
    run_gemm_i8(lds, ws + WS_XN, ws + WS_WTIN, R, N1, 1024, G0, bid, (const float*)(ws + WS_SXN), (const float*)(ws + WS_SWIN), F_Gemm1{(bf16*)(ws + WS_F), (bf16*)(ws + WS_ZG), p.in[I_FKN], (LAS float*)(lds + pg8::STAGE_BYTES)});
#endif
    GSYNC();
    DG()
    TS(2);
    { LANE_IDS(); p2_prep1(p, vcu, G, wave, lane); }
    GSYNC();
    DG()
    TS(3);
    { LANE_IDS(); const int gwv = bid * NWAVES + wave; for (int s = gwv; s < 128; s += G * NWAVES) p3_cumsum(p, s, lane);
      LAS float* bl = (LAS float*)(lds + pg8::STAGE_BYTES);
      for (int i = tid; i < 1024; i += NTHREADS) bl[i] = (i < 512) ? p.in[I_W0][i] : p.in[I_A0][i - 512]; }
    __syncthreads();
    run_gemm(lds, (const bf16*)(ws + WS_LA), (const bf16*)(ws + WS_WTWA), R, 512, 128, G0, (bid + G0 - 16) % G0, F_LoraW{(bf16*)(dob + DO_XW), (LAS const float*)(lds + pg8::STAGE_BYTES)});
    run_gemm(lds, (const bf16*)(ws + WS_LA), (const bf16*)(ws + WS_WTWA) + 512 * 128, R, 512, 128, G0, (bid + G0 - 24) % G0, F_LoraA{(bf16*)(dob + DO_AA), (LAS const float*)(lds + pg8::STAGE_BYTES) + 512});
    run_gemm(lds, (const bf16*)(ws + WS_LG), (const bf16*)(ws + WS_WTG), R, 512, 256, G0, (bid + G0 - 32) % G0, F_Plain{(bf16*)(dob + DO_GG), 512});
#ifdef REP_LORA
    run_gemm(lds, (const bf16*)(ws + WS_LA), (const bf16*)(ws + WS_WTWA), R, 512, 128, G0, (bid + G0 - 16) % G0, F_LoraW{(bf16*)(dob + DO_XW), (LAS const float*)(lds + pg8::STAGE_BYTES)});
    run_gemm(lds, (const bf16*)(ws + WS_LA), (const bf16*)(ws + WS_WTWA) + 512 * 128, R, 512, 128, G0, (bid + G0 - 24) % G0, F_LoraA{(bf16*)(dob + DO_AA), (LAS const float*)(lds + pg8::STAGE_BYTES) + 512});
    run_gemm(lds, (const bf16*)(ws + WS_LG), (const bf16*)(ws + WS_WTG), R, 512, 256, G0, (bid + G0 - 32) % G0, F_Plain{(bf16*)(dob + DO_GG), 512});
#endif
    GSYNC();
    DG()
    TS(4);
    {
        LANE_IDS();
        for (int bh = bid; bh < 128; bh += G0) p5_scan_chunked(p, lds, bh, tid, wave, lane);
#ifdef REP_SCAN
        for (int bh = bid; bh < 128; bh += G0) p5_scan_chunked(p, lds, bh, tid, wave, lane);
#endif
        TS(6);
        volatile LAS unsigned* qslot = (volatile LAS unsigned*)(lds + LDS_BYTES - 64 + 16);
        const unsigned kbl0 = (unsigned)(uintptr_t)lds_raw + attn_body::LDS_KB;
        __syncthreads();
        if (tid == 0) *qslot = __hip_atomic_fetch_add(barw + XCD_BAR_WORDS + 64, 1u, __ATOMIC_RELAXED, __HIP_MEMORY_SCOPE_AGENT);
        __syncthreads();
        int u = __builtin_amdgcn_readfirstlane((int)*qslot);
        while (u < 2048) {
            unsigned nx = 0u;
            if (tid == 0) nx = __hip_atomic_fetch_add(barw + XCD_BAR_WORDS + 64, 1u, __ATOMIC_RELAXED, __HIP_MEMORY_SCOPE_AGENT);
            const int qb = 15 - (u >> 7), bh = u & 127;
            {
                const float* kbg = (const float*)(ws + WS_KB) + (size_t)bh * TP + 4 * lane;
                attn_body::glds16(kbg + (2 * wave) * 256, (unsigned)__builtin_amdgcn_readfirstlane(kbl0 + (2 * wave) * 1024));
                attn_body::glds16(kbg + (2 * wave + 1) * 256, (unsigned)__builtin_amdgcn_readfirstlane(kbl0 + (2 * wave + 1) * 1024));
                if (wave == 0 && lane < 16) attn_body::glds16(kbg + 16 * 256, (unsigned)__builtin_amdgcn_readfirstlane(kbl0 + 16 * 1024));
            }
            attn_body::attn_unit<8>(bh >> 3, bh & 7, qb, (const attn_body::bf16*)(ws + WS_FQ), (const attn_body::bf16*)(ws + WS_FK), (const attn_body::bf16*)(ws + WS_FV), (attn_body::bf16*)(ws + WS_FQ), (char*)lds_raw, p.in[I_FQN] + (bh & 7) * 64, NORM_EPS);
            if (tid == 0) *qslot = nx;
            __syncthreads();
            u = __builtin_amdgcn_readfirstlane((int)*qslot);
        }
    }
    GSYNC();
    DG(__syncthreads(); dg_scan(p, lds); __syncthreads();)
    TS(7);
    run_gemm_compact(lds, (const bf16*)(ws + WS_FQ), (const bf16*)(ws + WS_WTFOX), 1024, 512, G0, bid, F_MixA{(bf16*)(ws + WS_MIX), (const bf16*)(ws + WS_ZG)});
#ifdef REP_GEMMA
    run_gemm_compact(lds, (const bf16*)(ws + WS_FQ), (const bf16*)(ws + WS_WTFOX), 1024, 512, G0, bid, F_MixA{(bf16*)(ws + WS_MIX), (const bf16*)(ws + WS_ZG)});
#endif
    TS(9);
    DG()
    run_gemm_compact(lds, (const bf16*)(ws + WS_Y), (const bf16*)(ws + WS_WTRWKV), 1024, 512, G0, bid, F_MixB{(bf16*)(ws + WS_MIX), (const bf16*)(ws + WS_ZG)});
    GSYNC();
    DG()
    TS(10);
    run_gemm_panels(lds, (const bf16*)(ws + WS_MIX), (const bf16*)(ws + WS_WTOUT), 1024, 1024, G0, bid, F_OutC{p.in[I_X], (bf16*)(ws + WS_H1)});
#ifdef REP_OUT
    run_gemm_panels(lds, (const bf16*)(ws + WS_MIX), (const bf16*)(ws + WS_WTOUT), 1024, 1024, G0, bid, F_OutC{p.in[I_X], (bf16*)(ws + WS_H1)});
#endif
    {
        LANE_IDS();
        for (int pan = bid; pan < NTOK / 256; pan += G) for (int r = wave; r < 256; r += 8 * NWAVES) norm2_rows<8>(p, pan * 256 + r, NWAVES, lane);
    }
    TS(11); TS(12);
    GSYNC();
#ifdef PQ_BF16
    run_gemm(lds, (const bf16*)(ws + WS_XN2), (const bf16*)(ws + 1010 * MiB), NTOK, 2048, 1024, G0, bid, F_Plain{(bf16*)(ws + WS_PQ), 2048});
    GSYNC();
#else
    run_gemm_i8_panels8(lds, ws + WS_XQ, ws + WS_WTQ, 1024, G0, bid, (const float*)(ws + WS_SX), (const float*)(ws + WS_SWQ), F_Plain{(bf16*)(ws + WS_PQ), 2048});
#endif
#ifdef REP_PQ
    run_gemm_i8_panels8(lds, ws + WS_XQ, ws + WS_WTQ, 1024, G0, bid, (const float*)(ws + WS_SX), (const float*)(ws + WS_SWQ), F_Plain{(bf16*)(ws + WS_PQ), 2048});
#endif
    TS(13);
    DG()
    { LANE_IDS(); p11_route(p, lds, bid, G, tid, wave, lane); }
#ifdef REP_ROUTE
    __syncthreads(); { LANE_IDS(); p11_route(p, lds, bid, G, tid, wave, lane); }
#endif
    GSYNC();
    TS(14);
    DG()
    { LANE_IDS(); p12a_partial(p, bid, G, wave, lane); }
#ifdef REP_12A
    { LANE_IDS(); p12a_partial(p, bid, G, wave, lane); }
#endif
    GSYNC();
    { LANE_IDS(); p12b_combine(p, lds, vcu, G, tid, wave, lane); }
    GSYNC();
#ifdef REP_12C
    { LANE_IDS(); p12c_output<true>(p, bid, G, wave, lane); }
#endif
    { LANE_IDS(); p12c_output<false>(p, bid, G, wave, lane); }
    DG(GSYNC(); dg_final(p);)
#if TIMING
    GSYNC(); TS(15); GSYNC();
    {
        const unsigned long long* ts = (const unsigned long long*)(ws + 1010 * MiB);
        const float tot = (float)(ts[15] - ts[0]);
        const float fa = 10.f * (float)(ts[TIMING_A1] - ts[TIMING_A0]) / tot;
        int t__ = threadIdx.x; asm volatile("" : "+v"(t__));
        for (size_t i = (size_t)bid * NTHREADS + t__; i < (size_t)NTOK * 1024; i += (size_t)G0 * NTHREADS) p.out[i] = fa;
    }
#endif
}

extern "C" void kernel_launch(void* const* d_in, const int* in_sizes, int n_in, void* d_out, int out_size, void* d_ws, size_t ws_size, hipStream_t stream) {
    static int grid = 0;
    if (grid == 0) {
        if (n_in != 27 || out_size != NTOK * DMODEL || ws_size < WS_END) { fprintf(stderr, "kernel_launch: unexpected shapes (n_in %d, out %d, ws %zu)\n", n_in, out_size, ws_size); grid = -1; return; }
        int dev = 0, cus = 0, per_cu = 0;
        hipGetDevice(&dev);
        hipDeviceGetAttribute(&cus, hipDeviceAttributeMultiprocessorCount, dev);
        hipFuncSetAttribute((const void*)hybrid_fwd, hipFuncAttributeMaxDynamicSharedMemorySize, LDS_BYTES);
        hipOccupancyMaxActiveBlocksPerMultiprocessor(&per_cu, (const void*)hybrid_fwd, NTHREADS, LDS_BYTES);
        if (per_cu < 1) { fprintf(stderr, "kernel_launch: occupancy query says %d blocks per CU\n", per_cu); grid = -1; return; }
        grid = cus;
    }
    if (grid < 0) return;
    Params p{};
    for (int i = 0; i < 27; ++i) p.in[i] = (const float*)d_in[i];
    p.out = (float*)d_out; p.ws = (unsigned char*)d_ws;
    void* args[] = {&p};
    hipError_t e = hipLaunchCooperativeKernel((const void*)hybrid_fwd, dim3(grid), dim3(NTHREADS), args, LDS_BYTES, stream);
    if (e != hipSuccess) fprintf(stderr, "cooperative launch failed: %s (grid %d)\n", hipGetErrorString(e), grid);
}
```

```cpp
#include <hip/hip_runtime.h>
#include <hip/hip_cooperative_groups.h>
#include <hip/hip_bf16.h>
#include <cstdio>
#include <cstdint>
#include <cmath>
namespace cg = cooperative_groups;
#ifndef DIAG
#define DIAG 0
#endif
namespace pg8 {
#define PG8_LAS __attribute__((address_space(3)))
typedef unsigned short bf16_t;
typedef short bf16x8 __attribute__((ext_vector_type(8)));
typedef float f32x4 __attribute__((ext_vector_type(4)));
typedef unsigned u32x4 __attribute__((ext_vector_type(4)));
constexpr int BM = 256, BK = 64, HALF = 128, HTB = HALF * BK * 2  , STAGE_BYTES = 8 * HTB, NXCD = 8, WGM = 8;

__host__ __device__ __forceinline__ int lds_byte(int r, int c) { const int st = (r >> 4) * 2 + (c >> 5), rr = r & 15, cc = c & 31, ob = rr * 64 + cc * 2; return st * 1024 + (ob ^ (((ob >> 9) & 1) << 5)); }
__host__ __device__ __forceinline__ void stage_rc(int b, int& R, int& C) { const int st = b / 1024, sb = b % 1024, swz = sb ^ (((sb >> 9) & 1) << 5); R = (st >> 1) * 16 + swz / 64; C = (st & 1) * 32 + (swz % 64) / 2; }
__host__ __device__ __forceinline__ int perm32(int rho) { const int n = rho >> 4, i = rho & 15; return 8 * (i >> 2) + 4 * n + (i & 3); }

struct Unit { int pm, pn; };
struct Gemm { const bf16_t* A; const bf16_t* Bt; int M, N, K; };

struct StaticOrder {
    int nM, nN, nwg, G, c;
    __host__ __device__ void init(int M, int N, int G_, int c_) { nM = M / BM; nN = N / BM; nwg = nM * nN; G = G_; c = c_; }
    __host__ __device__ bool next(int i, Unit& u) const {
        const int L = i * G + c; if (L >= nwg) return false;
        int wgid = (int)L; { const int q = nwg / NXCD, r = nwg % NXCD, xcd = wgid % NXCD, off = wgid / NXCD; wgid = (xcd < r ? xcd * (q + 1) : r * (q + 1) + (xcd - r) * q) + off; }
        const int nig = WGM * nN, gid = wgid / nig, fm = gid * WGM, gsz = (nM - fm) < WGM ? (nM - fm) : WGM;
        u.pm = fm + ((wgid % nig) % gsz); u.pn = (wgid % nig) / gsz; return true;
    }
    __device__ __forceinline__ void a_ready(const Unit&) const {}
    __device__ __forceinline__ void done(const Unit&) const {}
    __device__ __forceinline__ size_t a_row0(int pm) const { return (size_t)pm * BM; }
};

__device__ __forceinline__ unsigned cvt_pk_bf16(float lo, float hi) { unsigned r; asm volatile("v_cvt_pk_bf16_f32 %0, %1, %2" : "=v"(r) : "v"(lo), "v"(hi)); return r; }
typedef float f32x2 __attribute__((ext_vector_type(2)));
typedef int i32x4 __attribute__((ext_vector_type(4)));
template <class Epi, class Sched, bool ALIGN_EPI = false, bool SP2 = false>
__device__ __forceinline__ void gemm_phase(PG8_LAS unsigned char* lds, const Gemm g, const Sched& S, const Epi& E) {
    int tid_ = threadIdx.x; asm volatile("" : "+v"(tid_));
    const int tid = tid_, wid = __builtin_amdgcn_readfirstlane(tid >> 6), lane = tid & 63, wr = wid >> 2, wc = wid & 3, fr = lane & 15, fq = lane >> 4;
    const int K = g.K, nt = K / BK;
    unsigned voffA[2], voffB[2];
#pragma unroll
    for (int i = 0; i < 2; ++i) { int R, C; stage_rc(tid * 16 + i * 8192, R, C); const int Rb = Epi::PERM ? ((R & ~31) + perm32(R & 31)) : R;
        voffA[i] = (unsigned)(R * K + C) * 2u; voffB[i] = (unsigned)(Rb * K + C) * 2u; }
    const size_t kstep = (size_t)(BK * 2);
    const size_t hstep = (size_t)HALF * K * 2;
    const size_t tstep = 2 * hstep;
    const unsigned ldsw = (unsigned)wid * 1024u;
    const int aoff = lds_byte(wr * 64 + fr, fq * 8), boff = lds_byte(wc * 32 + fr, fq * 8);
#define PG8_SA(b, h) (((b) * 2 + (h)) * HTB)
#define PG8_SB(b, h) ((4 + (b) * 2 + (h)) * HTB)
#define PG8_STAGE(bufoff, gbase, voff) do { _Pragma("unroll") for (int _i = 0; _i < 2; ++_i) \
        __builtin_amdgcn_global_load_lds((const unsigned*)((const char*)(gbase) + (voff)[_i]), (PG8_LAS unsigned*)(lds + (bufoff) + ldsw + _i * 8192), 16, 0, 0); } while (0)
#define PG8_LDA(dst, b, h) do { _Pragma("unroll") for (int m = 0; m < 4; ++m) _Pragma("unroll") for (int k = 0; k < 2; ++k) dst[m][k] = *(const PG8_LAS bf16x8*)(lds + PG8_SA(b, h) + aoff + m * 2048 + k * 1024); } while (0)
#define PG8_LDB(dst, b, h) do { _Pragma("unroll") for (int n = 0; n < 2; ++n) _Pragma("unroll") for (int k = 0; k < 2; ++k) dst[n][k] = *(const PG8_LAS bf16x8*)(lds + PG8_SB(b, h) + boff + n * 2048 + k * 1024); } while (0)
#define PG8_MMA(ai, bj, At, Bt) do { __builtin_amdgcn_s_setprio(1); _Pragma("unroll") for (int m = 0; m < 4; ++m) _Pragma("unroll") for (int n = 0; n < 2; ++n) _Pragma("unroll") for (int k = 0; k < 2; ++k) \
        acc[ai][bj][m][n] = __builtin_amdgcn_mfma_f32_16x16x32_bf16(Bt[n][k], At[m][k], acc[ai][bj][m][n], 0, 0, 0); __builtin_amdgcn_s_setprio(0); } while (0)
#define PG8_WAIT_V(n) asm volatile("s_waitcnt vmcnt(" #n ")" ::: "memory")
#define PG8_WAIT_L(n) asm volatile("s_waitcnt lgkmcnt(" #n ")" ::: "memory")
#define PG8_BAR __builtin_amdgcn_s_barrier()
#define PG8_SCHED __builtin_amdgcn_sched_barrier(0)
    Unit cur, nxt; int ui = 0;
    if (!S.next(0, cur)) return;
    f32x4 acc[2][2][4][2];
#pragma unroll
    for (int a = 0; a < 2; ++a)
#pragma unroll
        for (int b = 0; b < 2; ++b)
#pragma unroll
            for (int m = 0; m < 4; ++m)
#pragma unroll
                for (int n = 0; n < 2; ++n) acc[a][b][m][n] = (f32x4){0.f, 0.f, 0.f, 0.f};
    bf16x8 At[4][2], B0[2][2], B1[2][2];
    const char* cA = (const char*)g.A + S.a_row0(cur.pm) * (size_t)K * 2; const char* cB = (const char*)g.Bt + (size_t)cur.pn * tstep;
    S.a_ready(cur);
    if constexpr (SP2) {
        PG8_STAGE(PG8_SB(0, 0), cB, voffB); PG8_STAGE(PG8_SB(0, 1), cB + hstep, voffB); PG8_STAGE(PG8_SA(0, 0), cA, voffA); PG8_STAGE(PG8_SA(0, 1), cA + hstep, voffA);
        if (wr == 1) PG8_BAR;
        PG8_WAIT_V(2); PG8_BAR;
        PG8_STAGE(PG8_SB(1, 0), cB + kstep, voffB); PG8_STAGE(PG8_SA(1, 0), cA + kstep, voffA); PG8_STAGE(PG8_SB(1, 1), cB + hstep + kstep, voffB);
        PG8_WAIT_V(6); PG8_BAR;
    } else {
        PG8_STAGE(PG8_SB(0, 0), cB, voffB); PG8_STAGE(PG8_SA(0, 0), cA, voffA); PG8_STAGE(PG8_SB(0, 1), cB + hstep, voffB); PG8_STAGE(PG8_SA(0, 1), cA + hstep, voffA);
        if (wr == 1) PG8_BAR;
        PG8_WAIT_V(4); PG8_BAR;
        PG8_STAGE(PG8_SB(1, 0), cB + kstep, voffB); PG8_STAGE(PG8_SA(1, 0), cA + kstep, voffA); PG8_STAGE(PG8_SB(1, 1), cB + hstep + kstep, voffB);
        PG8_WAIT_V(6); PG8_BAR;
    }
    for (;;) {
        const bool has_next = S.next(ui + 1, nxt);
        const char* nA = has_next ? (const char*)g.A + S.a_row0(nxt.pm) * (size_t)K * 2 : cA; const char* nB = has_next ? (const char*)g.Bt + (size_t)nxt.pn * tstep : cB;
        for (int t = 0; t < nt; t += 2) {
            const bool last = (t == nt - 2);
            const char* a1 = cA + (size_t)(t + 1) * kstep;
            const char* a2 = last ? nA : cA + (size_t)(t + 2) * kstep; const char* b2 = last ? nB : cB + (size_t)(t + 2) * kstep;
            const char* a3 = a2 + kstep; const char* b3 = b2 + kstep;
            if (last && has_next) S.a_ready(nxt);
            if constexpr (SP2) {
            PG8_LDB(B0, 0, 0); PG8_LDB(B1, 0, 1); PG8_SCHED; PG8_LDA(At, 0, 0); PG8_STAGE(PG8_SA(1, 1), a1 + hstep, voffA);
            PG8_WAIT_V(8); PG8_WAIT_L(0); PG8_BAR; PG8_MMA(0, 0, At, B0); PG8_MMA(0, 1, At, B1); PG8_BAR; PG8_SCHED;
            PG8_LDA(At, 0, 1); PG8_STAGE(PG8_SB(0, 0), b2, voffB); PG8_STAGE(PG8_SB(0, 1), b2 + hstep, voffB); PG8_STAGE(PG8_SA(0, 0), a2, voffA);
            PG8_WAIT_V(8); PG8_WAIT_L(0); PG8_BAR; PG8_MMA(1, 0, At, B0); PG8_MMA(1, 1, At, B1); PG8_BAR; PG8_SCHED;
            PG8_LDB(B0, 1, 0); PG8_LDB(B1, 1, 1); PG8_SCHED; PG8_LDA(At, 1, 0); PG8_STAGE(PG8_SA(0, 1), a2 + hstep, voffA);
            PG8_WAIT_V(8); PG8_WAIT_L(0); PG8_BAR; PG8_MMA(0, 0, At, B0); PG8_MMA(0, 1, At, B1); PG8_BAR; PG8_SCHED;
            PG8_LDA(At, 1, 1); PG8_STAGE(PG8_SB(1, 0), b3, voffB); PG8_STAGE(PG8_SB(1, 1), b3 + hstep, voffB); PG8_STAGE(PG8_SA(1, 0), a3, voffA);
            PG8_WAIT_V(8); PG8_WAIT_L(0); PG8_BAR; PG8_MMA(1, 0, At, B0); PG8_MMA(1, 1, At, B1); PG8_BAR; PG8_SCHED;
            } else {
            PG8_LDB(B0, 0, 0); PG8_SCHED; PG8_LDA(At, 0, 0); PG8_STAGE(PG8_SA(1, 1), a1 + hstep, voffA);
            PG8_WAIT_L(8); PG8_BAR; PG8_WAIT_L(0); PG8_MMA(0, 0, At, B0); PG8_BAR; PG8_SCHED;
            PG8_LDB(B1, 0, 1); PG8_STAGE(PG8_SB(0, 0), b2, voffB);
            PG8_BAR; PG8_WAIT_L(0); PG8_MMA(0, 1, At, B1); PG8_BAR;
            PG8_LDA(At, 0, 1); PG8_STAGE(PG8_SA(0, 0), a2, voffA);
            PG8_BAR; PG8_WAIT_L(0); PG8_MMA(1, 0, At, B0); PG8_BAR; PG8_SCHED;
            PG8_STAGE(PG8_SB(0, 1), b2 + hstep, voffB);
            PG8_WAIT_V(6); PG8_BAR; PG8_MMA(1, 1, At, B1); PG8_BAR;
            PG8_LDB(B0, 1, 0); PG8_SCHED; PG8_LDA(At, 1, 0); PG8_STAGE(PG8_SA(0, 1), a2 + hstep, voffA);
            PG8_WAIT_L(8); PG8_BAR; PG8_WAIT_L(0); PG8_MMA(0, 0, At, B0); PG8_BAR; PG8_SCHED;
            PG8_LDB(B1, 1, 1); PG8_STAGE(PG8_SB(1, 0), b3, voffB);
            PG8_BAR; PG8_WAIT_L(0); PG8_MMA(0, 1, At, B1); PG8_BAR;
            PG8_LDA(At, 1, 1); PG8_STAGE(PG8_SA(1, 0), a3, voffA);
            PG8_BAR; PG8_WAIT_L(0); PG8_MMA(1, 0, At, B0); PG8_BAR; PG8_SCHED;
            PG8_STAGE(PG8_SB(1, 1), b3 + hstep, voffB);
            PG8_WAIT_V(6); PG8_BAR; PG8_MMA(1, 1, At, B1); PG8_BAR;
            }
        }
        if constexpr (ALIGN_EPI) { if (wr == 0) PG8_BAR; }
        if constexpr (!Epi::AFTER_DRAIN) { E(acc, cur, wr, wc, fr, fq); S.done(cur); }
        if (!has_next) break;
#pragma unroll
        for (int a = 0; a < 2; ++a)
#pragma unroll
            for (int b = 0; b < 2; ++b)
#pragma unroll
                for (int m = 0; m < 4; ++m)
#pragma unroll
                    for (int n = 0; n < 2; ++n) acc[a][b][m][n] = (f32x4){0.f, 0.f, 0.f, 0.f};
        cur = nxt; cA = nA; cB = nB; ++ui;
        if constexpr (ALIGN_EPI) { if (wr == 1) PG8_BAR; }
    }
    PG8_WAIT_V(0);
    if constexpr (!ALIGN_EPI) { if (wr == 0) PG8_BAR; }
    PG8_BAR;
    if constexpr (Epi::AFTER_DRAIN) { E.fused(acc, cur, wr, wc, fr, fq, lds, wid, lane); S.done(cur); }
#undef PG8_SA
#undef PG8_SB
#undef PG8_STAGE
#undef PG8_LDA
#undef PG8_LDB
#undef PG8_MMA
#undef PG8_WAIT_V
#undef PG8_WAIT_L
#undef PG8_BAR
#undef PG8_SCHED
}
template <class Epi, class Sched, bool ALIGN_EPI = false, bool SP2 = false>
__device__ __forceinline__ void gemm_phase_i8(PG8_LAS unsigned char* lds, const Gemm g, const Sched& S, const Epi& E) {
    int tid_ = threadIdx.x; asm volatile("" : "+v"(tid_));
    const int tid = tid_, wid = __builtin_amdgcn_readfirstlane(tid >> 6), lane = tid & 63, wr = wid >> 2, wc = wid & 3, fr = lane & 15, fq = lane >> 4;
    const int K = g.K, nt = K / BK;
    unsigned voffA[2], voffB[2];
#pragma unroll
    for (int i = 0; i < 2; ++i) { int R, C; stage_rc(tid * 16 + i * 8192, R, C); const int Rb = Epi::PERM ? ((R & ~31) + perm32(R & 31)) : R;
        voffA[i] = (unsigned)(R * K + C) * 2u; voffB[i] = (unsigned)(Rb * K + C) * 2u; }
    const size_t kstep = (size_t)(BK * 2);
    const size_t hstep = (size_t)HALF * K * 2;
    const size_t tstep = 2 * hstep;
    const unsigned ldsw = (unsigned)wid * 1024u;
    const int aoff = lds_byte(wr * 64 + fr, fq * 8), boff = lds_byte(wc * 32 + fr, fq * 8);
#define PG8_SA(b, h) (((b) * 2 + (h)) * HTB)
#define PG8_SB(b, h) ((4 + (b) * 2 + (h)) * HTB)
#define PG8_STAGE(bufoff, gbase, voff) do { _Pragma("unroll") for (int _i = 0; _i < 2; ++_i) \
        __builtin_amdgcn_global_load_lds((const unsigned*)((const char*)(gbase) + (voff)[_i]), (PG8_LAS unsigned*)(lds + (bufoff) + ldsw + _i * 8192), 16, 0, 0); } while (0)
#define PG8_LDA(dst, b, h) do { _Pragma("unroll") for (int m = 0; m < 4; ++m) _Pragma("unroll") for (int k = 0; k < 2; ++k) dst[m][k] = *(const PG8_LAS bf16x8*)(lds + PG8_SA(b, h) + aoff + m * 2048 + k * 1024); } while (0)
#define PG8_LDB(dst, b, h) do { _Pragma("unroll") for (int n = 0; n < 2; ++n) _Pragma("unroll") for (int k = 0; k < 2; ++k) dst[n][k] = *(const PG8_LAS bf16x8*)(lds + PG8_SB(b, h) + boff + n * 2048 + k * 1024); } while (0)
#define PG8_MMA(ai, bj, At, Bt) do { __builtin_amdgcn_s_setprio(1); _Pragma("unroll") for (int m = 0; m < 4; ++m) _Pragma("unroll") for (int n = 0; n < 2; ++n) _Pragma("unroll") for (int k = 0; k < 2; ++k) \
        acc[ai][bj][m][n] = __builtin_amdgcn_mfma_i32_16x16x64_i8(__builtin_bit_cast(i32x4, Bt[n][k]), __builtin_bit_cast(i32x4, At[m][k]), acc[ai][bj][m][n], 0, 0, 0); __builtin_amdgcn_s_setprio(0); } while (0)
#define PG8_WAIT_V(n) asm volatile("s_waitcnt vmcnt(" #n ")" ::: "memory")
#define PG8_WAIT_L(n) asm volatile("s_waitcnt lgkmcnt(" #n ")" ::: "memory")
#define PG8_BAR __builtin_amdgcn_s_barrier()
#define PG8_SCHED __builtin_amdgcn_sched_barrier(0)
    Unit cur, nxt; int ui = 0;
    if (!S.next(0, cur)) return;
    i32x4 acc[2][2][4][2];
#pragma unroll
    for (int a = 0; a < 2; ++a)
#pragma unroll
        for (int b = 0; b < 2; ++b)
#pragma unroll
            for (int m = 0; m < 4; ++m)
#pragma unroll
                for (int n = 0; n < 2; ++n) acc[a][b][m][n] = (i32x4){0, 0, 0, 0};
    bf16x8 At[4][2], B0[2][2], B1[2][2];
    const char* cA = (const char*)g.A + S.a_row0(cur.pm) * (size_t)K * 2; const char* cB = (const char*)g.Bt + (size_t)cur.pn * tstep;
    S.a_ready(cur);
    if constexpr (SP2) {
        PG8_STAGE(PG8_SB(0, 0), cB, voffB); PG8_STAGE(PG8_SB(0, 1), cB + hstep, voffB); PG8_STAGE(PG8_SA(0, 0), cA, voffA); PG8_STAGE(PG8_SA(0, 1), cA + hstep, voffA);
        if (wr == 1) PG8_BAR;
        PG8_WAIT_V(2); PG8_BAR;
        PG8_STAGE(PG8_SB(1, 0), cB + kstep, voffB); PG8_STAGE(PG8_SA(1, 0), cA + kstep, voffA); PG8_STAGE(PG8_SB(1, 1), cB + hstep + kstep, voffB);
        PG8_WAIT_V(6); PG8_BAR;
    } else {
        PG8_STAGE(PG8_SB(0, 0), cB, voffB); PG8_STAGE(PG8_SA(0, 0), cA, voffA); PG8_STAGE(PG8_SB(0, 1), cB + hstep, voffB); PG8_STAGE(PG8_SA(0, 1), cA + hstep, voffA);
        if (wr == 1) PG8_BAR;
        PG8_WAIT_V(4); PG8_BAR;
        PG8_STAGE(PG8_SB(1, 0), cB + kstep, voffB); PG8_STAGE(PG8_SA(1, 0), cA + kstep, voffA); PG8_STAGE(PG8_SB(1, 1), cB + hstep + kstep, voffB);
        PG8_WAIT_V(6); PG8_BAR;
    }
    for (;;) {
        const bool has_next = S.next(ui + 1, nxt);
        E.unit_begin(cur, ui, wid, lane);
        const char* nA = has_next ? (const char*)g.A + S.a_row0(nxt.pm) * (size_t)K * 2 : cA; const char* nB = has_next ? (const char*)g.Bt + (size_t)nxt.pn * tstep : cB;
        for (int t = 0; t < nt; t += 2) {
            const bool last = (t == nt - 2);
            const char* a1 = cA + (size_t)(t + 1) * kstep;
            const char* a2 = last ? nA : cA + (size_t)(t + 2) * kstep; const char* b2 = last ? nB : cB + (size_t)(t + 2) * kstep;
            const char* a3 = a2 + kstep; const char* b3 = b2 + kstep;
            if (last && has_next) S.a_ready(nxt);
            if constexpr (SP2) {
            PG8_LDB(B0, 0, 0); PG8_LDB(B1, 0, 1); PG8_SCHED; PG8_LDA(At, 0, 0); PG8_STAGE(PG8_SA(1, 1), a1 + hstep, voffA);
            PG8_WAIT_V(8); PG8_WAIT_L(0); PG8_BAR; PG8_MMA(0, 0, At, B0); PG8_MMA(0, 1, At, B1); PG8_BAR; PG8_SCHED;
            PG8_LDA(At, 0, 1); PG8_STAGE(PG8_SB(0, 0), b2, voffB); PG8_STAGE(PG8_SB(0, 1), b2 + hstep, voffB); PG8_STAGE(PG8_SA(0, 0), a2, voffA);
            PG8_WAIT_V(8); PG8_WAIT_L(0); PG8_BAR; PG8_MMA(1, 0, At, B0); PG8_MMA(1, 1, At, B1); PG8_BAR; PG8_SCHED;
            PG8_LDB(B0, 1, 0); PG8_LDB(B1, 1, 1); PG8_SCHED; PG8_LDA(At, 1, 0); PG8_STAGE(PG8_SA(0, 1), a2 + hstep, voffA);
            PG8_WAIT_V(8); PG8_WAIT_L(0); PG8_BAR; PG8_MMA(0, 0, At, B0); PG8_MMA(0, 1, At, B1); PG8_BAR; PG8_SCHED;
            PG8_LDA(At, 1, 1); PG8_STAGE(PG8_SB(1, 0), b3, voffB); PG8_STAGE(PG8_SB(1, 1), b3 + hstep, voffB); PG8_STAGE(PG8_SA(1, 0), a3, voffA);
            PG8_WAIT_V(8); PG8_WAIT_L(0); PG8_BAR; PG8_MMA(1, 0, At, B0); PG8_MMA(1, 1, At, B1); PG8_BAR; PG8_SCHED;
            } else {
            PG8_LDB(B0, 0, 0); PG8_SCHED; PG8_LDA(At, 0, 0); PG8_STAGE(PG8_SA(1, 1), a1 + hstep, voffA);
            PG8_WAIT_L(8); PG8_BAR; PG8_WAIT_L(0); PG8_MMA(0, 0, At, B0); PG8_BAR; PG8_SCHED;
            PG8_LDB(B1, 0, 1); PG8_STAGE(PG8_SB(0, 0), b2, voffB);
            PG8_BAR; PG8_WAIT_L(0); PG8_MMA(0, 1, At, B1); PG8_BAR;
            PG8_LDA(At, 0, 1); PG8_STAGE(PG8_SA(0, 0), a2, voffA);
            PG8_BAR; PG8_WAIT_L(0); PG8_MMA(1, 0, At, B0); PG8_BAR; PG8_SCHED;
            PG8_STAGE(PG8_SB(0, 1), b2 + hstep, voffB);
            PG8_WAIT_V(6); PG8_BAR; PG8_MMA(1, 1, At, B1); PG8_BAR;
            PG8_LDB(B0, 1, 0); PG8_SCHED; PG8_LDA(At, 1, 0); PG8_STAGE(PG8_SA(0, 1), a2 + hstep, voffA);
            PG8_WAIT_L(8); PG8_BAR; PG8_WAIT_L(0); PG8_MMA(0, 0, At, B0); PG8_BAR; PG8_SCHED;
            PG8_LDB(B1, 1, 1); PG8_STAGE(PG8_SB(1, 0), b3, voffB);
            PG8_BAR; PG8_WAIT_L(0); PG8_MMA(0, 1, At, B1); PG8_BAR;
            PG8_LDA(At, 1, 1); PG8_STAGE(PG8_SA(1, 0), a3, voffA);
            PG8_BAR; PG8_WAIT_L(0); PG8_MMA(1, 0, At, B0); PG8_BAR; PG8_SCHED;
            PG8_STAGE(PG8_SB(1, 1), b3 + hstep, voffB);
            PG8_WAIT_V(6); PG8_BAR; PG8_MMA(1, 1, At, B1); PG8_BAR;
            }
        }
        if constexpr (ALIGN_EPI) { if (wr == 0) PG8_BAR; }
        if constexpr (!Epi::AFTER_DRAIN) { E(acc, cur, wr, wc, fr, fq, ui); S.done(cur); }
        if (!has_next) break;
#pragma unroll
        for (int a = 0; a < 2; ++a)
#pragma unroll
            for (int b = 0; b < 2; ++b)
#pragma unroll
                for (int m = 0; m < 4; ++m)
#pragma unroll
                    for (int n = 0; n < 2; ++n) acc[a][b][m][n] = (i32x4){0, 0, 0, 0};
        cur = nxt; cA = nA; cB = nB; ++ui;
        if constexpr (ALIGN_EPI) { if (wr == 1) PG8_BAR; }
    }
    PG8_WAIT_V(0);
    if constexpr (!ALIGN_EPI) { if (wr == 0) PG8_BAR; }
    PG8_BAR;
    if constexpr (Epi::AFTER_DRAIN) { E.fused(acc, cur, wr, wc, fr, fq, lds, wid, lane); S.done(cur); }
#undef PG8_SA
#undef PG8_SB
#undef PG8_STAGE
#undef PG8_LDA
#undef PG8_LDB
#undef PG8_MMA
#undef PG8_WAIT_V
#undef PG8_WAIT_L
#undef PG8_BAR
#undef PG8_SCHED
}
}
namespace attn_body {
using bf16=__hip_bfloat16;
using bf16x8=__attribute__((ext_vector_type(8)))short;
using s16x4=__attribute__((ext_vector_type(4)))short;
using f32x16=__attribute__((ext_vector_type(16)))float;
using u32x4=__attribute__((ext_vector_type(4)))unsigned;
using f32x4k=__attribute__((ext_vector_type(4)))float;
constexpr int BATCH=16,NHEAD=8,TPAD=4160,D=64,DM=NHEAD*D;
constexpr int NW=8,QBLK=32,QB=QBLK*NW,KVBLK=64,NQB=16;
constexpr int ATTN_PITCH=DM, ATTN_UNIT_ROWS=QB;
__device__ __forceinline__ int crow(int r,int hi){return (r&3)+8*(r>>2)+4*hi;}
#define SBAR() __builtin_amdgcn_sched_barrier(0)
__device__ __forceinline__ void cmask(f32x16&p0,f32x16&p1,int jb,int qrel,int hi){
  const float NEG=-INFINITY; int kb=64*jb+4*hi;
  #pragma unroll
  for(int r=0;r<16;++r){int kv=kb+(r&3)+8*(r>>2); if(kv>qrel)p0[r]=NEG; if(kv+32>qrel)p1[r]=NEG;}
}

constexpr int NSLOT=3, SLOTB=8192;
constexpr int LDS_K=0, LDS_V=NSLOT*SLOTB, LDS_WS=2*NSLOT*SLOTB, LDS_OST=LDS_WS+NW*64*4, LDS_KB=LDS_OST+NW*4096, LDS_BYTES=LDS_KB+TPAD*4;
constexpr float C2=0.125f*1.4426950408889634f;
__device__ __forceinline__ void glds16(const void*gsrc,unsigned lds_dst){unsigned keep;
  asm volatile("s_mov_b32 %0, m0\n\ts_mov_b32 m0, %2\n\ts_nop 0\n\tglobal_load_lds_dwordx4 %1, off\n\ts_mov_b32 m0, %0":"=&s"(keep):"v"(gsrc),"s"(lds_dst):"memory");}
__device__ __forceinline__ float max3f(float a,float b,float c){float r;asm("v_max3_f32 %0, %1, %2, %3":"=v"(r):"v"(a),"v"(b),"v"(c));return r;}
__device__ __forceinline__ float max2f(float a,float b){float r;asm("v_max_f32_e32 %0, %1, %2":"=v"(r):"v"(a),"v"(b));return r;}
__device__ __forceinline__ float fadd_s(float a,float b){float r;asm("v_add_f32_e32 %0, %1, %2":"=v"(r):"v"(a),"v"(b));return r;}
__device__ __forceinline__ float fsub_s(float a,float b){float r;asm("v_sub_f32_e32 %0, %1, %2":"=v"(r):"v"(a),"v"(b));return r;}
typedef float f32x2_t __attribute__((ext_vector_type(2))); typedef __bf16 bf16x2_t __attribute__((ext_vector_type(2)));
__device__ __forceinline__ unsigned cvtpk_s(float lo,float hi){f32x2_t v={lo,hi};bf16x2_t b=__builtin_convertvector(v,bf16x2_t);return __builtin_bit_cast(unsigned,b);}
#define WAIT_BAR(N) asm volatile("s_waitcnt vmcnt(" #N ") lgkmcnt(0)\n\ts_barrier":::"memory")

__device__ __forceinline__ void qkt(f32x16&p0,f32x16&p1,const char*Kslot,const bf16x8*qr,int r32,int hi){
  const char*kb=Kslot+hi*1024+r32*16;
  #pragma unroll
  for(int d0=0;d0<4;++d0){
    const bf16x8 b0=*reinterpret_cast<const bf16x8*>(kb+d0*2048);
    const bf16x8 b1=*reinterpret_cast<const bf16x8*>(kb+d0*2048+512);
    {p0=__builtin_amdgcn_mfma_f32_32x32x16_bf16(b0,qr[d0],p0,0,0,0);p1=__builtin_amdgcn_mfma_f32_32x32x16_bf16(b1,qr[d0],p1,0,0,0);}}
}
typedef __attribute__((address_space(3))) const char* lds_cptr;
typedef short v4i16_t __attribute__((ext_vector_type(4)));
__device__ __forceinline__ void kload8(bf16x8*kf,lds_cptr kp){
  kf[0]=*(const __attribute__((address_space(3))) bf16x8*)(kp);      kf[1]=*(const __attribute__((address_space(3))) bf16x8*)(kp+512);
  kf[2]=*(const __attribute__((address_space(3))) bf16x8*)(kp+2048); kf[3]=*(const __attribute__((address_space(3))) bf16x8*)(kp+2560);
  kf[4]=*(const __attribute__((address_space(3))) bf16x8*)(kp+4096); kf[5]=*(const __attribute__((address_space(3))) bf16x8*)(kp+4608);
  kf[6]=*(const __attribute__((address_space(3))) bf16x8*)(kp+6144); kf[7]=*(const __attribute__((address_space(3))) bf16x8*)(kp+6656);
}
__device__ __forceinline__ void kload2(bf16x8*kf,lds_cptr kp,int j){ kf[2*j]=*(const __attribute__((address_space(3))) bf16x8*)(kp+j*2048); kf[2*j+1]=*(const __attribute__((address_space(3))) bf16x8*)(kp+j*2048+512); }
__device__ __forceinline__ s16x4 vtr(lds_cptr p){ return __builtin_bit_cast(s16x4,__builtin_amdgcn_ds_read_tr16_b64_v4i16((__attribute__((address_space(3))) v4i16_t*)p)); }
__device__ __forceinline__ float rowmax(const f32x16&p0,const f32x16&p1){
  float a=max3f(p0[0],p0[1],p1[0]),b=max3f(p0[2],p0[3],p1[1]);a=max3f(a,p1[2],p1[3]);
  #pragma unroll
  for(int r=4;r<16;r+=4){a=max3f(a,p0[r],p0[r+1]);b=max3f(b,p0[r+2],p0[r+3]);a=max3f(a,p1[r],p1[r+1]);b=max3f(b,p1[r+2],p1[r+3]);}
  const float m=max2f(a,b);
  auto rr=__builtin_amdgcn_permlane32_swap(__float_as_uint(m),__float_as_uint(m),false,false);
  return max2f(__uint_as_float(rr[0]),__uint_as_float(rr[1]));
}
__device__ __forceinline__ void pv(f32x16*o,int vb,bf16x8 pa0,bf16x8 pa1,bf16x8 pa2,bf16x8 pa3){
  #pragma unroll
  for(int d0=0;d0<2;++d0){s16x4 lo[4],hi[4];
    #pragma unroll
    for(int ks=0;ks<4;++ks){
      asm volatile("ds_read_b64_tr_b16 %0,%1 offset:%c2":"=&v"(lo[ks]):"v"(vb),"i"(d0*4096+ks*1024):"memory");
      asm volatile("ds_read_b64_tr_b16 %0,%1 offset:%c2":"=&v"(hi[ks]):"v"(vb),"i"(d0*4096+ks*1024+512):"memory");}
    asm volatile("s_waitcnt lgkmcnt(0)":::"memory");SBAR();
    #define PK(k) (bf16x8){lo[k][0],lo[k][1],lo[k][2],lo[k][3],hi[k][0],hi[k][1],hi[k][2],hi[k][3]}
    o[d0]=__builtin_amdgcn_mfma_f32_32x32x16_bf16(pa0,PK(0),o[d0],0,0,0);
    o[d0]=__builtin_amdgcn_mfma_f32_32x32x16_bf16(pa1,PK(1),o[d0],0,0,0);
    o[d0]=__builtin_amdgcn_mfma_f32_32x32x16_bf16(pa2,PK(2),o[d0],0,0,0);
    o[d0]=__builtin_amdgcn_mfma_f32_32x32x16_bf16(pa3,PK(3),o[d0],0,0,0);
    #undef PK
  }
}

#ifndef ATTN_STORE16
#define ATTN_STORE16(p,v) (*(u32x4*)(p)=(v))
#endif
template<int THRL> __device__ __forceinline__ void attn_unit(int b,int h,int qb,const bf16*Q,const bf16*__restrict__ K,const bf16*__restrict__ V,bf16*O,char*shm,const float*gqn,float qeps,int ts){
  int tid_=threadIdx.x; asm volatile("":"+v"(tid_)); const int tid=tid_,lane=tid&63,r32=lane&31,hi=lane>>5; const int wid=__builtin_amdgcn_readfirstlane(tid>>6);
  const long rowbase=(long)b*TPAD; const int q0=64+qb*QB;
  const bf16*Qw=Q+(rowbase+q0+wid*QBLK)*DM+h*D;
  const bf16*Kh=K+(rowbase+(long)ts*KVBLK)*DM+h*D,*Vh=V+(rowbase+(long)ts*KVBLK)*DM+h*D;
  const unsigned lds0=(unsigned)(uintptr_t)shm;
  float*wsf=(float*)(shm+LDS_WS)+wid*64;
  const bf16*ksrc=Kh+(long)lane*DM+wid*8;
  const bf16*vsrc=Vh+(long)(16*(wid&3)+(lane>>2))*DM+(wid>>2)*32+(lane&3)*8;
  const unsigned kdst=lds0+LDS_K+wid*1024, vdst=lds0+LDS_V+wid*1024;
  #define DMA_K(t,slot) glds16(ksrc+(long)(t)*KVBLK*DM,(unsigned)__builtin_amdgcn_readfirstlane(kdst+(slot)))
  #define DMA_V(t,slot) glds16(vsrc+(long)(t)*KVBLK*DM,(unsigned)__builtin_amdgcn_readfirstlane(vdst+(slot)))
  const int vb0=(int)(lds0+LDS_V)+((lane>>4)&1)*32+(lane&3)*8+(4*hi+((lane&15)>>2))*64;
  const char*Kbase=shm+LDS_K; bf16x8 kf[8];
  const lds_cptr shm3=(lds_cptr)shm; const lds_cptr kp0=shm3+LDS_K+hi*1024+r32*16; const lds_cptr vp0=shm3+LDS_V+((lane>>4)&1)*32+(lane&3)*8+(4*hi+((lane&15)>>2))*64;
  const int NT=(q0+QB)/KVBLK-ts;
  typedef __attribute__((address_space(3))) const f32x4k* lds_f4p; const __attribute__((address_space(3))) float* kbp0=(const __attribute__((address_space(3))) float*)(shm3+LDS_KB)+4*hi+ts*KVBLK;
  #define KBINIT(C0,C1,t) do{ const __attribute__((address_space(3))) float* kp_=kbp0+(t)*64; _Pragma("unroll") for(int g_=0;g_<4;++g_){ const f32x4k a_=*(lds_f4p)(kp_+8*g_); const f32x4k b_=*(lds_f4p)(kp_+32+8*g_); _Pragma("unroll") for(int e_=0;e_<4;++e_){ C0[4*g_+e_]=a_[e_]-mhat; C1[4*g_+e_]=b_[e_]-mhat; } } }while(0)
  DMA_K(0,0);DMA_V(0,0);DMA_K(1,SLOTB);
  bf16x8 qr[4];
  #pragma unroll
  for(int d0=0;d0<4;++d0)qr[d0]=*reinterpret_cast<const bf16x8*>(&Qw[(long)r32*DM+d0*16+hi*8]);
  {
    typedef unsigned u32x4n __attribute__((ext_vector_type(4))); typedef float f32x4n __attribute__((ext_vector_type(4)));
    float qf[4][8]; float ss=0.f;
    #pragma unroll
    for(int d0=0;d0<4;++d0){ const u32x4n w=__builtin_bit_cast(u32x4n,qr[d0]); const unsigned w0=w.x,w1=w.y,w2=w.z,w3=w.w;
      qf[d0][0]=__uint_as_float(w0<<16);qf[d0][1]=__uint_as_float(w0&0xffff0000u);qf[d0][2]=__uint_as_float(w1<<16);qf[d0][3]=__uint_as_float(w1&0xffff0000u);
      qf[d0][4]=__uint_as_float(w2<<16);qf[d0][5]=__uint_as_float(w2&0xffff0000u);qf[d0][6]=__uint_as_float(w3<<16);qf[d0][7]=__uint_as_float(w3&0xffff0000u);
      _Pragma("unroll") for(int j=0;j<8;++j)ss+=qf[d0][j]*qf[d0][j]; }
    { auto rr=__builtin_amdgcn_permlane32_swap(__float_as_uint(ss),__float_as_uint(ss),false,false); ss=__uint_as_float(rr[0])+__uint_as_float(rr[1]); }
    const float rq=C2/sqrtf(ss*(1.f/64.f)+qeps);
    #pragma unroll
    for(int d0=0;d0<4;++d0){ const f32x4n g0=*reinterpret_cast<const f32x4n*>(gqn+d0*16+hi*8), g1=*reinterpret_cast<const f32x4n*>(gqn+d0*16+hi*8+4);
      u32x4n w; w.x=cvtpk_s(qf[d0][0]*rq*g0.x,qf[d0][1]*rq*g0.y); w.y=cvtpk_s(qf[d0][2]*rq*g0.z,qf[d0][3]*rq*g0.w);
      w.z=cvtpk_s(qf[d0][4]*rq*g1.x,qf[d0][5]*rq*g1.y); w.w=cvtpk_s(qf[d0][6]*rq*g1.z,qf[d0][7]*rq*g1.w);
      qr[d0]=__builtin_bit_cast(bf16x8,w); } }
  float mhat=0.f,l_reg=0.f;f32x16 o[2];o[0]=f32x16{};o[1]=f32x16{};
  const int qrel=wid*QBLK+r32;
  #define CMASK(P0,P1,t) do{int jb_=(t)-(NT-4); if(jb_>=0)cmask(P0,P1,jb_,qrel,hi);}while(0)
  bool resc=false;
  #define START(P0,P1) do{ const float rm=rowmax(P0,P1); resc=false; \
    { const float dl=rm; mhat=fadd_s(mhat,dl); \
      _Pragma("unroll") for(int r=0;r<16;++r){P0[r]=fsub_s(P0[r],dl);P1[r]=fsub_s(P1[r],dl);} } \
    _Pragma("unroll") for(int r=0;r<16;++r)P0[r]=__builtin_amdgcn_exp2f(P0[r]); }while(0)
  #define RESC() do{ if(resc){ asm volatile("s_waitcnt lgkmcnt(0)":::"memory"); \
      _Pragma("unroll") for(int d_=0;d_<2;++d_) _Pragma("unroll") for(int r=0;r<16;++r)o[d_][r]*=wsf[crow(r,hi)]; } }while(0)
  f32x16 pA0,pA1,pB0,pB1;
  int sl_prev=0,sl_cur=0,sl_next=SLOTB;
  #define ROT() do{sl_prev=sl_cur;sl_cur=sl_next;sl_next=(sl_next==(NSLOT-1)*SLOTB)?0:sl_next+SLOTB;}while(0)
  DMA_K(2,2*SLOTB);
  WAIT_BAR(3);
  KBINIT(pA0,pA1,0); qkt(pA0,pA1,Kbase,qr,r32,hi);asm volatile("s_nop 15\n\ts_nop 7":"+v"(pA0),"+v"(pA1));CMASK(pA0,pA1,0);
  START(pA0,pA1);
  _Pragma("unroll") for(int r=0;r<16;++r)pA1[r]=__builtin_amdgcn_exp2f(pA1[r]);
  WAIT_BAR(0);
  DMA_K(3,0);DMA_V(1,SLOTB);
  ROT();
  kload8(kf,kp0+sl_cur);
  WAIT_BAR(2);
  s16x4 vlo[8],vhi[8]; u32x4 pw0,pw1,pw2,pw3;
  #define PKW(P,B) cvtpk_s(P[B],P[B+1])
  #define PAF(k) __builtin_bit_cast(bf16x8,pw##k)
  #define VFR(i) (bf16x8){vlo[i][0],vlo[i][1],vlo[i][2],vlo[i][3],vhi[i][0],vhi[i][1],vhi[i][2],vhi[i][3]}
  #define PIN(x) asm volatile("":"+v"(x))
  #define MX3(a,b,c) __builtin_fmaxf(__builtin_fmaxf((a),(b)),(c))
  #define GAPA(MF,A0,A1,A2,A3,W0,W1,PW) do{ MF; sacc+=A0; sacc+=A1; sacc+=A2; sacc+=A3; PIN(sacc); W0; W1; PIN(PW); SBAR(); }while(0)
  #define EX(v) __builtin_amdgcn_exp2f(v)
  #define GAPB(MF,X,B) do{ MF; X[B]=EX(X[B]); X[B+1]=EX(X[B+1]); X[B+2]=EX(X[B+2]); X[B+3]=EX(X[B+3]); PIN(X); SBAR(); }while(0)
  #define VRD(i) do{ vlo[i]=vtr(vp_+(((i)>>2)*4096+((i)&3)*1024)); vhi[i]=vtr(vp_+(((i)>>2)*4096+((i)&3)*1024+512)); }while(0)
  #define KRD(G,j) do{ if(G){ kload2(kf,kp0+sl_next,j); SBAR(); } }while(0)
  #define STEP(C0,C1,P0,P1,t,GK,GV,GL) do{ SBAR(); \
    const lds_cptr vp_=vp0+sl_prev; \
    KBINIT(C0,C1,t); SBAR(); \
    VRD(0); SBAR(); float sacc=(P0[0]+P0[1]); \
    GAPA(C0=__builtin_amdgcn_mfma_f32_32x32x16_bf16(kf[0],qr[0],C0,0,0,0), P0[2],P0[3],P0[4],P0[5],     pw0[0]=PKW(P0,0), pw0[1]=PKW(P0,2), pw0); \
    VRD(4); SBAR(); GAPA(C1=__builtin_amdgcn_mfma_f32_32x32x16_bf16(kf[1],qr[0],C1,0,0,0), P0[6],P0[7],P0[8],P0[9],     pw0[2]=PKW(P0,4), pw0[3]=PKW(P0,6), pw0); \
    VRD(1); SBAR(); GAPA(C0=__builtin_amdgcn_mfma_f32_32x32x16_bf16(kf[2],qr[1],C0,0,0,0),   P0[10],P0[11],P0[12],P0[13], pw1[0]=PKW(P0,8), pw1[1]=PKW(P0,10), pw1); \
    VRD(5); SBAR(); GAPA(C1=__builtin_amdgcn_mfma_f32_32x32x16_bf16(kf[3],qr[1],C1,0,0,0),   P0[14],P0[15],P1[0],P1[1],   pw1[2]=PKW(P0,12),pw1[3]=PKW(P0,14), pw1); \
    VRD(2); SBAR(); GAPA(C0=__builtin_amdgcn_mfma_f32_32x32x16_bf16(kf[4],qr[2],C0,0,0,0),   P1[2],P1[3],P1[4],P1[5],     pw2[0]=PKW(P1,0), pw2[1]=PKW(P1,2), pw2); \
    VRD(6); SBAR(); GAPA(C1=__builtin_amdgcn_mfma_f32_32x32x16_bf16(kf[5],qr[2],C1,0,0,0),   P1[6],P1[7],P1[8],P1[9],     pw2[2]=PKW(P1,4), pw2[3]=PKW(P1,6), pw2); \
    VRD(3); SBAR(); GAPA(C0=__builtin_amdgcn_mfma_f32_32x32x16_bf16(kf[6],qr[3],C0,0,0,0),   P1[10],P1[11],P1[12],P1[13], pw3[0]=PKW(P1,8), pw3[1]=PKW(P1,10), pw3); \
    VRD(7); SBAR(); GAPA(C1=__builtin_amdgcn_mfma_f32_32x32x16_bf16(kf[7],qr[3],C1,0,0,0),   P1[14],P1[15],0.f,0.f,       pw3[2]=PKW(P1,12),pw3[3]=PKW(P1,14), pw3); \
    l_reg+=sacc; \
    if(GK){DMA_K((t)+3,sl_cur);} if(GV){DMA_V((t)+1,sl_next);} \
    CMASK(C0,C1,t); \
    { float a=MX3(C0[0],C0[1],C1[0]),b=MX3(C0[2],C0[3],C1[1]); a=MX3(a,C1[2],C1[3]); \
      _Pragma("unroll") for(int r=4;r<16;r+=4){a=MX3(a,C0[r],C0[r+1]);b=MX3(b,C0[r+2],C0[r+3]);a=MX3(a,C1[r],C1[r+1]);b=MX3(b,C1[r+2],C1[r+3]);} \
      float rm=__builtin_fmaxf(a,b); { auto rr=__builtin_amdgcn_permlane32_swap(__float_as_uint(rm),__float_as_uint(rm),false,false); rm=__builtin_fmaxf(__uint_as_float(rr[0]),__uint_as_float(rr[1])); } \
      resc=false; \
      if(__builtin_expect(__any(rm>(float)THRL),0)){ const float dl=__builtin_fmaxf(rm,0.f); mhat+=dl; \
        _Pragma("unroll") for(int r=0;r<16;++r){C0[r]-=dl;C1[r]-=dl;} \
        const float f=__builtin_amdgcn_exp2f(-dl); l_reg*=f; if(hi==0)wsf[r32]=f; resc=true; } } \
    SBAR(); \
    GAPB(o[0]=__builtin_amdgcn_mfma_f32_32x32x16_bf16(PAF(0),VFR(0),o[0],0,0,0), C0,0); \
    GAPB(o[1]=__builtin_amdgcn_mfma_f32_32x32x16_bf16(PAF(0),VFR(4),o[1],0,0,0), C0,4); \
    KRD(GL,0); GAPB(o[0]=__builtin_amdgcn_mfma_f32_32x32x16_bf16(PAF(1),VFR(1),o[0],0,0,0), C0,8); \
    KRD(GL,1); GAPB(o[1]=__builtin_amdgcn_mfma_f32_32x32x16_bf16(PAF(1),VFR(5),o[1],0,0,0), C0,12); \
    KRD(GL,2); GAPB(o[0]=__builtin_amdgcn_mfma_f32_32x32x16_bf16(PAF(2),VFR(2),o[0],0,0,0), C1,0); \
    KRD(GL,3); GAPB(o[1]=__builtin_amdgcn_mfma_f32_32x32x16_bf16(PAF(2),VFR(6),o[1],0,0,0), C1,4); \
    GAPB(o[0]=__builtin_amdgcn_mfma_f32_32x32x16_bf16(PAF(3),VFR(3),o[0],0,0,0), C1,8); \
    GAPB(o[1]=__builtin_amdgcn_mfma_f32_32x32x16_bf16(PAF(3),VFR(7),o[1],0,0,0), C1,12); \
    }while(0)
  int t=1;
  #undef CMASK
  #define CMASK(P0,P1,t) do{}while(0)
  for(;t+5<NT;t+=2){
    STEP(pB0,pB1,pA0,pA1,t,true,true,true);     WAIT_BAR(2); RESC(); ROT();
    STEP(pA0,pA1,pB0,pB1,t+1,true,true,true);   WAIT_BAR(2); RESC(); ROT();
  }
  #undef CMASK
  #define CMASK(P0,P1,t) do{int jb_=(t)-(NT-4); if(jb_>=0)cmask(P0,P1,jb_,qrel,hi);}while(0)
  #define ENDW(tt) do{ if((tt)+3<NT){WAIT_BAR(2);} else if((tt)+2<NT){WAIT_BAR(1);} else {WAIT_BAR(0);} }while(0)
  for(;t+1<NT;t+=2){
    STEP(pB0,pB1,pA0,pA1,t,(t+3<NT),(t+1<NT),(t+1<NT));       ENDW(t);   RESC(); ROT();
    STEP(pA0,pA1,pB0,pB1,t+1,(t+4<NT),(t+2<NT),(t+2<NT));     ENDW(t+1); RESC(); ROT();
  }
  { float sacc=pA0[0]+pA0[1]; _Pragma("unroll") for(int r=2;r<16;++r)sacc+=pA0[r]; _Pragma("unroll") for(int r=0;r<16;++r)sacc+=pA1[r]; l_reg+=sacc;
    pw0=(u32x4){PKW(pA0,0),PKW(pA0,2),PKW(pA0,4),PKW(pA0,6)};pw1=(u32x4){PKW(pA0,8),PKW(pA0,10),PKW(pA0,12),PKW(pA0,14)};pw2=(u32x4){PKW(pA1,0),PKW(pA1,2),PKW(pA1,4),PKW(pA1,6)};pw3=(u32x4){PKW(pA1,8),PKW(pA1,10),PKW(pA1,12),PKW(pA1,14)};
    SBAR(); pv(o,vb0+sl_prev,PAF(0),PAF(1),PAF(2),PAF(3)); }
  #undef PKW
  #undef PAF
  #undef VFR
  #undef PIN
  #undef MX3
  #undef GAPA
  #undef GAPB
  #undef EX
  #undef VRD
  #undef KRD
  #undef STEP
  #undef ENDW
  {auto rr=__builtin_amdgcn_permlane32_swap(__float_as_uint(l_reg),__float_as_uint(l_reg),false,false);l_reg=__uint_as_float(rr[0])+__uint_as_float(rr[1]);}
  if(hi==0)wsf[32+r32]=l_reg;asm volatile("s_waitcnt lgkmcnt(0)":::"memory");
  float rli[16];
  #pragma unroll
  for(int r=0;r<16;++r)rli[r]=__builtin_amdgcn_rcpf(wsf[32+crow(r,hi)]);
  bf16*Ow=O+(rowbase+q0+wid*QBLK)*DM+h*D;
  { bf16*stg=(bf16*)(shm+LDS_OST)+wid*2048;
    #pragma unroll
    for(int r=0;r<16;++r){const int orow=crow(r,hi);
      #pragma unroll
      for(int d0=0;d0<2;++d0)stg[orow*64+d0*32+r32]=__float2bfloat16(o[d0][r]*rli[r]);}
    asm volatile("s_waitcnt lgkmcnt(0)":::"memory");
    #pragma unroll
    for(int i=0;i<4;++i){const int row=i*8+(lane>>3),ch=lane&7; const u32x4 v=*(const u32x4*)(stg+row*64+ch*8); ATTN_STORE16(Ow+(long)row*DM+ch*8,v);} }
  asm volatile("s_waitcnt lgkmcnt(0)\n\ts_barrier":::"memory");
  #undef DMA_K
  #undef DMA_V
  #undef CMASK
  #undef START
  #undef RESC
  #undef ROT
  #undef KBINIT
}
constexpr int ATTN_LDS_BYTES=LDS_BYTES;
#undef SBAR
#undef WAIT_BAR
}

#define LAS __attribute__((address_space(3)))
typedef unsigned short bf16;
typedef unsigned v4u __attribute__((ext_vector_type(4)));
typedef unsigned v2u __attribute__((ext_vector_type(2)));
typedef float f32x4 __attribute__((ext_vector_type(4)));
typedef short bf16x8 __attribute__((ext_vector_type(8)));
typedef float f32x16v __attribute__((ext_vector_type(16)));

constexpr int NB = 16, SEQ = 4096, DMODEL = 1024, NMETA = 16;
constexpr int TP = 4160;
constexpr int R = NB * TP;
constexpr int NTOK = NB * SEQ;
constexpr int N1 = 5632;
constexpr int IN_COLS = 5416;
constexpr int NWAVES = 8, NTHREADS = 512;
constexpr float NORM_EPS = 1e-6f, GN_EPS = 64e-5f;
constexpr float LOG2E = 1.4426950408889634f;

constexpr size_t MiB = 1u << 20;
constexpr size_t U65 = 65 * MiB;
constexpr size_t WS_WTIN = 1 * MiB;
constexpr size_t WS_WTQ = 12 * MiB;
constexpr size_t WS_WTFOX = 16 * MiB;
constexpr size_t WS_WTRWKV = 17 * MiB;
constexpr size_t WS_WTOUT = 18 * MiB;
constexpr size_t WS_WTWA = 20 * MiB;
constexpr size_t WS_WTG = 20 * MiB + 512 * 1024;
constexpr size_t WS_KS = 21 * MiB;
constexpr size_t WS_KB = 22 * MiB;
constexpr size_t WS_LF = 25 * MiB;
constexpr size_t WS_BS = 29 * MiB;
constexpr size_t WS_SXN = 28 * MiB;
constexpr size_t WS_SWIN = 9 * MiB;
constexpr size_t WS_SWQ = 15 * MiB;
constexpr size_t WS_U8 = 32 * MiB;
constexpr size_t WS_SU = 48 * MiB;
constexpr size_t WS_V8 = 64 * MiB;
constexpr size_t WS_SV = 80 * MiB;
constexpr size_t WS_CORR = 81 * MiB;
constexpr size_t WS_SX = 82 * MiB;
constexpr size_t WS_XQ = 352 * MiB;
constexpr size_t WS_F = 96 * MiB;
constexpr size_t WS_FQ = WS_F, WS_FK = WS_F + U65, WS_FV = WS_F + 2 * U65, WS_ZRR = WS_F + 3 * U65, WS_ZRK = WS_F + 4 * U65, WS_ZRV = WS_F + 5 * U65, WS_ZM = WS_F + 6 * U65;
constexpr size_t WS_ZG = WS_F + 7 * U65;
constexpr size_t WS_XN = WS_ZG + 4 * U65;
constexpr size_t WS_IDS = 941 * MiB;
constexpr size_t WS_GATES = 973 * MiB;
constexpr size_t WS_END = 1005 * MiB;
constexpr size_t WS_LA = WS_XN;
constexpr size_t WS_LG = WS_XN + 20 * MiB;
constexpr size_t WS_KP = WS_XN;
constexpr size_t WS_KN = WS_XN + U65;
constexpr size_t WS_Y = WS_ZM;
constexpr size_t WS_MIX = WS_XN;
constexpr size_t WS_XN2 = WS_XN;
constexpr size_t WS_PQ = 420 * MiB;
constexpr size_t WS_H1 = 161 * MiB;
constexpr size_t DO_XW = 0, DO_AA = U65, DO_GG = 2 * U65;

typedef float f32x2_cv __attribute__((ext_vector_type(2))); typedef __bf16 bf16x2_cv __attribute__((ext_vector_type(2)));
__device__ __forceinline__ unsigned pk2(float lo, float hi) { const f32x2_cv v = {lo, hi}; const bf16x2_cv b = __builtin_convertvector(v, bf16x2_cv); return __builtin_bit_cast(unsigned, b); }
__device__ __forceinline__ unsigned f2bf(float f) { return pk2(f, 0.f) & 0xffffu; }
__device__ __forceinline__ float bflo(unsigned w) { return __builtin_bit_cast(float, w << 16); }
__device__ __forceinline__ float bfhi(unsigned w) { return __builtin_bit_cast(float, w & 0xffff0000u); }
__device__ __forceinline__ void unpack8(const v4u w, float (&f)[8]) { f[0] = bflo(w.x); f[1] = bfhi(w.x); f[2] = bflo(w.y); f[3] = bfhi(w.y); f[4] = bflo(w.z); f[5] = bfhi(w.z); f[6] = bflo(w.w); f[7] = bfhi(w.w); }
__device__ __forceinline__ v4u pack8(const float (&f)[8]) { v4u w; w.x = pk2(f[0], f[1]); w.y = pk2(f[2], f[3]); w.z = pk2(f[4], f[5]); w.w = pk2(f[6], f[7]); return w; }
__device__ __forceinline__ float sigmoidf_(float x) { return __builtin_amdgcn_rcpf(1.0f + __builtin_amdgcn_exp2f(-x * LOG2E)); }
template <int CTRL> __device__ __forceinline__ float dppf(float x) { return __uint_as_float(__builtin_amdgcn_update_dpp(0u, __float_as_uint(x), CTRL, 0xF, 0xF, true)); }
__device__ __forceinline__ float wave_sum(float v) {
    v += dppf<0xB1>(v); v += dppf<0x4E>(v); v += dppf<0x141>(v); v += dppf<0x140>(v);
    { auto r = __builtin_amdgcn_permlane16_swap(__float_as_uint(v), __float_as_uint(v), false, false); v = __uint_as_float(r[0]) + __uint_as_float(r[1]); }
    { auto r = __builtin_amdgcn_permlane32_swap(__float_as_uint(v), __float_as_uint(v), false, false); v = __uint_as_float(r[0]) + __uint_as_float(r[1]); }
    return v;
}
__device__ __forceinline__ float wave_max(float v) {
    v = fmaxf(v, dppf<0xB1>(v)); v = fmaxf(v, dppf<0x4E>(v)); v = fmaxf(v, dppf<0x141>(v)); v = fmaxf(v, dppf<0x140>(v));
    { auto r = __builtin_amdgcn_permlane16_swap(__float_as_uint(v), __float_as_uint(v), false, false); v = fmaxf(__uint_as_float(r[0]), __uint_as_float(r[1])); }
    { auto r = __builtin_amdgcn_permlane32_swap(__float_as_uint(v), __float_as_uint(v), false, false); v = fmaxf(__uint_as_float(r[0]), __uint_as_float(r[1])); }
    return v;
}
__device__ __forceinline__ float sum8(float v) { v += dppf<0xB1>(v); v += dppf<0x4E>(v); v += dppf<0x141>(v); return v; }
__device__ __forceinline__ unsigned q8x4(float a, float b, float c, float d, float inv) {
    const unsigned qa = __float_as_uint(fmaf(a, inv, 12582912.0f)), qb = __float_as_uint(fmaf(b, inv, 12582912.0f)), qc = __float_as_uint(fmaf(c, inv, 12582912.0f)), qd = __float_as_uint(fmaf(d, inv, 12582912.0f));
    return __builtin_amdgcn_perm(__builtin_amdgcn_perm(qd, qc, 0x0c0c0400u), __builtin_amdgcn_perm(qb, qa, 0x0c0c0400u), 0x05040100u);
}

struct Params {
    const float* in[27];
    float* out;
    unsigned char* ws;
};
enum { I_X = 0, I_META, I_N1G, I_WIN, I_FQN, I_FKN, I_FBIAS, I_MU, I_W0, I_WUP, I_A0, I_AUP, I_GUP, I_KK, I_KA, I_RK, I_LNG, I_LNB, I_WFOX, I_WRWKV, I_WOUT, I_N2G, I_PWQ, I_SK1, I_SK2, I_PU, I_PV };

__device__ __forceinline__ int win_src_col(int n) {
    if (n < 1536) return n;
    if (n < 3072) return 1544 + (n - 1536);
    if (n < 3584) { const int m = n - 3072; if (m < 288) return 3080 + m; if (m < 296) return 1536 + (m - 288); return -1; }
    return 3368 + (n - 3584);
}
template <bool REMAP>
__device__ __forceinline__ void transpose_item(const float* W, int ldw, int K, int N, bf16* WT, LAS float* scr, int item, int lane, const float wscale = 1.0f) {
    const int nblk = N / 32, kb = item / nblk, nb = item % nblk, k0 = 64 * kb, n0 = 32 * nb;
    const int n = n0 + (lane & 31); const int sc = REMAP ? win_src_col(n) : n;
#pragma unroll 8
    for (int i = 0; i < 32; ++i) { const int kk = 2 * i + (lane >> 5); scr[kk * 33 + (lane & 31)] = (sc >= 0) ? W[(size_t)(k0 + kk) * ldw + sc] * wscale : 0.f; }
    asm volatile("s_waitcnt lgkmcnt(0)" ::: "memory");
    const int c = lane & 7;
#pragma unroll
    for (int j = 0; j < 4; ++j) { const int nn = (lane >> 3) + 8 * j; const LAS float* s = scr + (8 * c) * 33 + nn;
        v4u o; o.x = pk2(s[0 * 33], s[1 * 33]); o.y = pk2(s[2 * 33], s[3 * 33]); o.z = pk2(s[4 * 33], s[5 * 33]); o.w = pk2(s[6 * 33], s[7 * 33]);
        *(v4u*)(WT + (size_t)(n0 + nn) * K + k0 + 8 * c) = o; }
    asm volatile("s_waitcnt lgkmcnt(0)" ::: "memory");
}
template <bool REMAP>
__device__ __forceinline__ void transpose_q8_item(const float* W, int ldw, unsigned char* WT8, float* SW, LAS float* scr, LAS float* cmax, int item, int wave, int lane) {
    const int n0 = 32 * item, n = n0 + (lane & 31); const int sc = REMAP ? win_src_col(n) : n;
    const float* Wc = W + (size_t)(128 * wave + (lane >> 5)) * ldw + (sc >= 0 ? sc : 0);
    float wv[64];
#pragma unroll
    for (int i = 0; i < 64; ++i) wv[i] = Wc[(size_t)(2 * i) * ldw];
    float m = 0.f;
#pragma unroll
    for (int i = 0; i < 64; ++i) m = fmaxf(m, fabsf(wv[i]));
    if (sc < 0) m = 0.f;
    m = fmaxf(m, __shfl_xor(m, 32));
    if (lane < 32) cmax[wave * 32 + lane] = m;
    __syncthreads();
    m = 0.f;
#pragma unroll
    for (int w = 0; w < 8; ++w) m = fmaxf(m, cmax[w * 32 + (lane & 31)]);
    const float inv = m > 0.f ? 127.0f / m : 0.f;
    if (wave == 0 && lane < 32) SW[n] = m > 0.f ? m * (1.0f / 127.0f) : 1.0f;
#pragma unroll
    for (int blk = 0; blk < 2; ++blk) {
        const int k0 = 128 * wave + 64 * blk;
#pragma unroll
        for (int i = 0; i < 32; ++i) scr[(2 * i + (lane >> 5)) * 33 + (lane & 31)] = wv[32 * blk + i] * inv;
        asm volatile("s_waitcnt lgkmcnt(0)" ::: "memory");
        const int c = lane & 3;
#pragma unroll
        for (int j = 0; j < 2; ++j) { const int nn = (lane >> 2) + 16 * j; const LAS float* sp = scr + (16 * c) * 33 + nn;
            unsigned w[4];
#pragma unroll
            for (int d = 0; d < 4; ++d) { const int q0 = (int)rintf(sp[(4 * d) * 33]), q1 = (int)rintf(sp[(4 * d + 1) * 33]), q2 = (int)rintf(sp[(4 * d + 2) * 33]), q3 = (int)rintf(sp[(4 * d + 3) * 33]);
                w[d] = (unsigned)(q0 & 255) | ((unsigned)(q1 & 255) << 8) | ((unsigned)(q2 & 255) << 16) | ((unsigned)(q3 & 255) << 24); }
            v4u o; o.x = w[0]; o.y = w[1]; o.z = w[2]; o.w = w[3];
            *(v4u*)(WT8 + (size_t)(n0 + nn) * 1024 + k0 + 16 * c) = o; }
        asm volatile("s_waitcnt lgkmcnt(0)" ::: "memory");
    }
    __syncthreads();
}
__device__ __forceinline__ void p0_prologue(const Params& p, LAS unsigned char* lds, int vcu, int G, int wave, int lane) {
    unsigned char* ws = p.ws;
    LAS float* scr = (LAS float*)(lds + wave * 16384);
    const int gw = vcu * NWAVES + wave, NGW = G * NWAVES;
    constexpr int I_IN = N1 / 32, I_Q = 2048 / 32, I_FX = 8 * 32, I_O = 16 * 32;
    const int gt = gw * 64 + lane, NGT = NGW * 64;
    float pre1 = 0.f, pre2 = 0.f, pre3 = 0.f;
    if (gt < 1024 * 128) { const int n = gt >> 7, k = gt & 127; if (n < 512) { if (k < 64) pre1 = p.in[I_WUP][k * 512 + n]; } else { if (k >= 64) pre1 = p.in[I_AUP][(k - 64) * 512 + (n - 512)]; } }
    if (gt < 512 * 256) { const int n = gt >> 8, k = gt & 255; if (k < 160) pre2 = p.in[I_GUP][k * 512 + n]; }
    if (gt < 2 * 128 * 128) pre3 = (gt < 16384) ? p.in[I_SK1][gt] : p.in[I_SK2][gt - 16384];
    {
        LAS float* cmax = (LAS float*)(lds + 8 * 16384);
        for (int it = vcu; it < I_IN + I_Q; it += G) {
            if (it < I_IN) transpose_q8_item<true>(p.in[I_WIN], IN_COLS, ws + WS_WTIN, (float*)(ws + WS_SWIN), scr, cmax, it, wave, lane);
            else transpose_q8_item<false>(p.in[I_PWQ], 2048, ws + WS_WTQ, (float*)(ws + WS_SWQ), scr, cmax, it - I_IN, wave, lane);
        }
    }
#ifdef PQ_BF16
    for (int it = gw; it < 16 * 64; it += NGW) transpose_item<false>(p.in[I_PWQ], 2048, 1024, 2048, (bf16*)(ws + 1010 * MiB), scr, it, lane);
#endif
    constexpr int NITEMS = 2 * I_FX + I_O;
    for (int it = gw; it < NITEMS; it += NGW) {
        int r = it;
        if (r < I_FX) { transpose_item<false>(p.in[I_WFOX], 1024, 512, 1024, (bf16*)(ws + WS_WTFOX), scr, r, lane, 1.0f / 255.0f); continue; } r -= I_FX;
        if (r < I_FX) { transpose_item<false>(p.in[I_WRWKV], 1024, 512, 1024, (bf16*)(ws + WS_WTRWKV), scr, r, lane, 1.0f / 255.0f); continue; } r -= I_FX;
        transpose_item<false>(p.in[I_WOUT], 1024, 1024, 1024, (bf16*)(ws + WS_WTOUT), scr, r, lane);
    }
    if (gt < 1024 * 128) ((bf16*)(ws + WS_WTWA))[gt] = (bf16)f2bf(pre1);
    if (gt < 512 * 256) ((bf16*)(ws + WS_WTG))[gt] = (bf16)f2bf(pre2);
    if (gt < 2 * 128 * 128) ((bf16*)(ws + WS_KS))[gt] = (bf16)f2bf(pre3);
    for (int i = gt + NGT; i < 1024 * 128; i += NGT) { const int n = i >> 7, k = i & 127; float v = 0.f;
        if (n < 512) { if (k < 64) v = p.in[I_WUP][k * 512 + n]; } else { if (k >= 64) v = p.in[I_AUP][(k - 64) * 512 + (n - 512)]; }
        ((bf16*)(ws + WS_WTWA))[i] = (bf16)f2bf(v); }
    for (int i = gt + NGT; i < 512 * 256; i += NGT) { const int n = i >> 8, k = i & 255; const float v = (k < 160) ? p.in[I_GUP][k * 512 + n] : 0.f; ((bf16*)(ws + WS_WTG))[i] = (bf16)f2bf(v); }
    for (int i = gt + NGT; i < 2 * 128 * 128; i += NGT) { const float v = (i < 16384) ? p.in[I_SK1][i] : p.in[I_SK2][i - 16384]; ((bf16*)(ws + WS_KS))[i] = (bf16)f2bf(v); }
    for (int r0 = gw; r0 < 32768; r0 += 4 * NGW) {
        f32x4 a[4][4]; float m[4];
#pragma unroll
        for (int u = 0; u < 4; ++u) { const int r = r0 + u * NGW; const int tbl = r >> 14, row = r & 16383;
            const int rr = r < 32768 ? row : 0; const int tb = r < 32768 ? tbl : 0;
            const f32x4* src = (const f32x4*)((tb ? p.in[I_PV] : p.in[I_PU]) + (size_t)rr * 1024 + 16 * lane);
#pragma unroll
            for (int j = 0; j < 4; ++j) a[u][j] = src[j]; }
#pragma unroll
        for (int u = 0; u < 4; ++u) { m[u] = 0.f;
#pragma unroll
            for (int j = 0; j < 4; ++j) m[u] = fmaxf(m[u], fmaxf(fmaxf(fabsf(a[u][j].x), fabsf(a[u][j].y)), fmaxf(fabsf(a[u][j].z), fabsf(a[u][j].w)))); }
#pragma unroll
        for (int u = 0; u < 4; ++u) m[u] = wave_max(m[u]);
#pragma unroll
        for (int u = 0; u < 4; ++u) { const int r = r0 + u * NGW; if (r >= 32768) continue; const int tbl = r >> 14, row = r & 16383;
            const float inv = m[u] > 0.f ? 127.0f / m[u] : 0.f;
            unsigned ww[4];
#pragma unroll
            for (int j = 0; j < 4; ++j) ww[j] = q8x4(a[u][j].x, a[u][j].y, a[u][j].z, a[u][j].w, inv);
            v4u w; w.x = ww[0]; w.y = ww[1]; w.z = ww[2]; w.w = ww[3];
            *(v4u*)(ws + (tbl ? WS_V8 : WS_U8) + (size_t)row * 1024 + 16 * lane) = w;
            if (lane == 0) ((float*)(ws + (tbl ? WS_SV : WS_SU)))[row] = m[u] > 0.f ? m[u] * (1.0f / 127.0f) : 1.0f; }
    }
    const f32x4* g4 = (const f32x4*)p.in[I_N1G] + lane;
    for (int m0 = gw; m0 < R; m0 += 4 * NGW) {
        f32x4 v[4][4]; float s[4], mx[4]; bool live[4];
#pragma unroll
        for (int u = 0; u < 4; ++u) { const int m = m0 + u * NGW; const int mm = m < R ? m : gw; const int b = mm / TP, pp = mm - b * TP;
            live[u] = (m < R) && (pp >= 48);
            const float* xrow = (pp < 64) ? p.in[I_META] + (size_t)(pp >= 48 ? pp - 48 : 0) * 1024 : p.in[I_X] + ((size_t)b * SEQ + (pp - 64)) * 1024;
            const f32x4* xr = (const f32x4*)xrow + lane;
#pragma unroll
            for (int j = 0; j < 4; ++j) v[u][j] = xr[64 * j]; }
#pragma unroll
        for (int u = 0; u < 4; ++u) { s[u] = 0.f;
#pragma unroll
            for (int j = 0; j < 4; ++j) s[u] += (v[u][j].x * v[u][j].x + v[u][j].y * v[u][j].y) + (v[u][j].z * v[u][j].z + v[u][j].w * v[u][j].w); }
#pragma unroll
        for (int u = 0; u < 4; ++u) s[u] = wave_sum(s[u]);
#pragma unroll
        for (int u = 0; u < 4; ++u) { const float rs = __builtin_amdgcn_rsqf(s[u] * (1.f / 1024.f) + NORM_EPS); mx[u] = 0.f;
#pragma unroll
            for (int j = 0; j < 4; ++j) { const f32x4 g = g4[64 * j]; v[u][j].x *= rs * g.x; v[u][j].y *= rs * g.y; v[u][j].z *= rs * g.z; v[u][j].w *= rs * g.w;
                mx[u] = fmaxf(mx[u], fmaxf(fmaxf(fabsf(v[u][j].x), fabsf(v[u][j].y)), fmaxf(fabsf(v[u][j].z), fabsf(v[u][j].w)))); } }
#pragma unroll
        for (int u = 0; u < 4; ++u) mx[u] = wave_max(mx[u]);
#pragma unroll
        for (int u = 0; u < 4; ++u) { const int m = m0 + u * NGW; if (m >= R) continue;
            unsigned* o4 = (unsigned*)(ws + WS_XN + (size_t)m * 1024) + lane;
            const float inv = (live[u] && mx[u] > 0.f) ? 127.0f / mx[u] : 0.f;
#pragma unroll
            for (int j = 0; j < 4; ++j) o4[64 * j] = q8x4(v[u][j].x, v[u][j].y, v[u][j].z, v[u][j].w, inv);
            if (lane == 0) ((float*)(ws + WS_SXN))[m] = (live[u] && mx[u] > 0.f) ? mx[u] * (1.0f / 127.0f) : 1.0f; }
    }
}

struct NoCtx {};
template <class F> struct EpiT {
    static constexpr bool PERM = true, AFTER_DRAIN = false;
    F f;
    __device__ __forceinline__ void operator()(const pg8::f32x4 (&acc)[2][2][4][2], const pg8::Unit& u, int wr, int wc, int fr, int fq) const {
        const int row0 = u.pm * 256 + wr * 64 + fr, col0 = u.pn * 256 + wc * 32 + 8 * fq;
        constexpr int MB = F::MB;
        if constexpr (F::COL_OUTER) {
#pragma unroll
            for (int bj = 0; bj < 2; ++bj) {
                typename F::Col c1; f.col(col0 + bj * 128, c1);
#pragma unroll
                for (int ai = 0; ai < 2; ++ai)
#pragma unroll
                    for (int m = 0; m < 4; ++m) {
                        const pg8::f32x4 a = acc[ai][bj][m][0], b = acc[ai][bj][m][1];
                        float v[8] = {a[0], a[1], a[2], a[3], b[0], b[1], b[2], b[3]};
                        typename F::Ctx cx; f.store(row0 + ai * 128 + m * 16, col0 + bj * 128, v, cx, c1);
                    }
            }
            return;
        }
        typename F::Col cc[2];
#pragma unroll
        for (int bj = 0; bj < 2; ++bj) f.col(col0 + bj * 128, cc[bj]);
#pragma unroll
        for (int ai = 0; ai < 2; ++ai)
#pragma unroll
            for (int m0 = 0; m0 < 4; m0 += MB) {
                typename F::Ctx cx[MB][2];
#pragma unroll
                for (int mm = 0; mm < MB; ++mm)
#pragma unroll
                    for (int bj = 0; bj < 2; ++bj) f.load(row0 + ai * 128 + (m0 + mm) * 16, col0 + bj * 128, cx[mm][bj]);
#pragma unroll
                for (int mm = 0; mm < MB; ++mm)
#pragma unroll
                    for (int bj = 0; bj < 2; ++bj) {
                        const pg8::f32x4 a = acc[ai][bj][m0 + mm][0], b = acc[ai][bj][m0 + mm][1];
                        float v[8] = {a[0], a[1], a[2], a[3], b[0], b[1], b[2], b[3]};
                        f.store(row0 + ai * 128 + (m0 + mm) * 16, col0 + bj * 128, v, cx[mm][bj], cc[bj]);
                    }
            }
    }
};
struct F_Gemm1 {
    bf16* F; bf16* ZG; const float* gkn; LAS float* scr;
    typedef NoCtx Col; typedef NoCtx Ctx; static constexpr int MB = 1; static constexpr bool COL_OUTER = false, KNORM = true;
    __device__ __forceinline__ void col(int, Col&) const {}
    __device__ __forceinline__ void load(int, int, Ctx&) const {}
    __device__ __forceinline__ void store(int row, int col, float (&v)[8], const Ctx&, const Col&) const { if (col < 3584) store_t<false>(row, col, v); else { for (int e = 0; e < 8; ++e) v[e] *= -LOG2E; store_t<true>(row, col, v); } }
    template <bool GATE> __device__ __forceinline__ void store_t(int row, int col, float (&v)[8]) const {
        if constexpr (!GATE) { const int buf = col >> 9, c = col & 511; *(v4u*)(F + (size_t)buf * ((size_t)R * 512) + (size_t)row * 512 + c) = pack8(v); }
        else { const int c = col - 3584;
            unsigned q[8];
#pragma unroll
            for (int e = 0; e < 8; ++e) q[e] = __float_as_uint(fmaf(__builtin_amdgcn_rcpf(1.0f + __builtin_amdgcn_exp2f(v[e])), 255.0f, 8388608.0f));
            v2u w;
            w.x = __builtin_amdgcn_perm(__builtin_amdgcn_perm(q[3], q[2], 0x0c0c0400u), __builtin_amdgcn_perm(q[1], q[0], 0x0c0c0400u), 0x05040100u);
            w.y = __builtin_amdgcn_perm(__builtin_amdgcn_perm(q[7], q[6], 0x0c0c0400u), __builtin_amdgcn_perm(q[5], q[4], 0x0c0c0400u), 0x05040100u);
            *(v2u*)((unsigned char*)ZG + (size_t)row * 2048 + c) = w; }
    }
};
struct F_LoraW {
    bf16* XW; LAS const float* w0;
    typedef NoCtx Col; typedef NoCtx Ctx; static constexpr int MB = 1; static constexpr bool COL_OUTER = false;
    __device__ __forceinline__ void col(int, Col&) const {}
    __device__ __forceinline__ void load(int, int, Ctx&) const {}
    __device__ __forceinline__ void store(int row, int col, float (&v)[8], const Ctx&, const Col&) const {
        asm volatile("" ::: "memory");
        const f32x4 b0 = *(LAS const f32x4*)(w0 + col), b1 = *(LAS const f32x4*)(w0 + col + 4); const float bb[8] = {b0.x, b0.y, b0.z, b0.w, b1.x, b1.y, b1.z, b1.w};
#pragma unroll
        for (int e = 0; e < 8; ++e) { const float x = v[e] + bb[e];
            v[e] = (-0.60653065971263342f * LOG2E) * sigmoidf_(x); }
        *(v4u*)(XW + (size_t)row * 512 + col) = pack8(v);
    }
};
struct F_LoraA {
    bf16* AA; LAS const float* a0;
    typedef NoCtx Col; typedef NoCtx Ctx; static constexpr int MB = 1; static constexpr bool COL_OUTER = false;
    __device__ __forceinline__ void col(int, Col&) const {}
    __device__ __forceinline__ void load(int, int, Ctx&) const {}
    __device__ __forceinline__ void store(int row, int col, float (&v)[8], const Ctx&, const Col&) const {
        asm volatile("" ::: "memory");
        const f32x4 b0 = *(LAS const f32x4*)(a0 + col), b1 = *(LAS const f32x4*)(a0 + col + 4); const float bb[8] = {b0.x, b0.y, b0.z, b0.w, b1.x, b1.y, b1.z, b1.w};
#pragma unroll
        for (int e = 0; e < 8; ++e) v[e] = sigmoidf_(v[e] + bb[e]);
        *(v4u*)(AA + (size_t)row * 512 + col) = pack8(v);
    }
};
struct F_Plain {
    bf16* O; int ldc;
    typedef NoCtx Col; typedef NoCtx Ctx; static constexpr int MB = 1; static constexpr bool COL_OUTER = false, KNORM = false;
    __device__ __forceinline__ void col(int, Col&) const {}
    __device__ __forceinline__ void load(int, int, Ctx&) const {}
    __device__ __forceinline__ void store(int row, int col, float (&v)[8], const Ctx&, const Col&) const { *(v4u*)(O + (size_t)row * ldc + col) = pack8(v); }
};
struct CtxGate { v2u gq; };
struct CtxMixGate { v4u mix; v2u gq; };
__device__ __forceinline__ void gates8(const v2u gq, float (&g)[8]) {
    g[0] = (float)(gq.x & 0xffu); g[1] = (float)((gq.x >> 8) & 0xffu); g[2] = (float)((gq.x >> 16) & 0xffu); g[3] = (float)(gq.x >> 24);
    g[4] = (float)(gq.y & 0xffu); g[5] = (float)((gq.y >> 8) & 0xffu); g[6] = (float)((gq.y >> 16) & 0xffu); g[7] = (float)(gq.y >> 24);
}
struct F_MixA {
    bf16* MIX; const bf16* ZG;
    typedef NoCtx Col; typedef CtxGate Ctx; static constexpr int MB = 4; static constexpr bool COL_OUTER = false;
    __device__ __forceinline__ void col(int, Col&) const {}
    __device__ __forceinline__ void load(int row, int col, Ctx& c) const { c.gq = *(const v2u*)((const unsigned char*)ZG + ((size_t)(row >> 12) * TP + 64 + (row & 4095)) * 2048 + col); }
    __device__ __forceinline__ void store(int row, int col, float (&v)[8], const Ctx& c, const Col&) const {
        float g[8]; gates8(c.gq, g);
#pragma unroll
        for (int e = 0; e < 8; ++e) v[e] *= g[e];
        *(v4u*)(MIX + (size_t)row * 1024 + col) = pack8(v);
    }
};
struct F_MixB {
    bf16* MIX; const bf16* ZG;
    typedef NoCtx Col; typedef CtxMixGate Ctx; static constexpr int MB = 4; static constexpr bool COL_OUTER = false;
    __device__ __forceinline__ void col(int, Col&) const {}
    __device__ __forceinline__ void load(int row, int col, Ctx& c) const {
        c.mix = *(const v4u*)(MIX + (size_t)row * 1024 + col);
        c.gq = *(const v2u*)((const unsigned char*)ZG + ((size_t)(row >> 12) * TP + 64 + (row & 4095)) * 2048 + 1024 + col);
    }
    __device__ __forceinline__ void store(int row, int col, float (&v)[8], const Ctx& c, const Col&) const {
        float m[8]; unpack8(c.mix, m);
        float g[8]; gates8(c.gq, g);
#pragma unroll
        for (int e = 0; e < 8; ++e) v[e] = m[e] + v[e] * g[e];
        *(v4u*)(MIX + (size_t)row * 1024 + col) = pack8(v);
    }
};
template <bool B> struct BoolC { static constexpr bool value = B; };
template <class F> struct EpiI8 {
    static constexpr bool PERM = true, AFTER_DRAIN = false;
    F f; const float* SA; const float* SB; LAS unsigned char* sl;
    __device__ __forceinline__ void unit_begin(const pg8::Unit& u, int ui, int wid, int lane) const {
        const float* src = (wid < 4) ? SA + u.pm * 256 + wid * 64 + lane : SB + u.pn * 256 + (wid - 4) * 64 + lane;
        __builtin_amdgcn_global_load_lds((const unsigned*)src, (LAS unsigned*)(sl + (ui & 1) * 2048 + wid * 256), 4, 0, 0);
    }
    __device__ __forceinline__ void operator()(const pg8::i32x4 (&acc)[2][2][4][2], const pg8::Unit& u, int wr, int wc, int fr, int fq, int ui) const {
        const int row0 = u.pm * 256 + wr * 64 + fr, col0 = u.pn * 256 + wc * 32 + 8 * fq;
        f32x4 sb[2][2]; float sa[2][4];
        typename F::Col cc[2];
        const LAS float* ls = (const LAS float*)(sl + (ui & 1) * 2048);
#pragma unroll
        for (int bj = 0; bj < 2; ++bj) { sb[bj][0] = *(const LAS f32x4*)(ls + 256 + wc * 32 + 8 * fq + bj * 128); sb[bj][1] = *(const LAS f32x4*)(ls + 256 + wc * 32 + 8 * fq + bj * 128 + 4); f.col(col0 + bj * 128, cc[bj]); }
#pragma unroll
        for (int ai = 0; ai < 2; ++ai)
#pragma unroll
            for (int m = 0; m < 4; ++m) sa[ai][m] = ls[wr * 64 + fr + ai * 128 + m * 16];
        if constexpr (F::KNORM) {
            if ((u.pn >> 1) == 1) {
                float ss[2][4][2];
#pragma unroll
                for (int ai = 0; ai < 2; ++ai)
#pragma unroll
                    for (int m = 0; m < 4; ++m)
#pragma unroll
                        for (int bj = 0; bj < 2; ++bj) {
                            const pg8::i32x4 a = acc[ai][bj][m][0], b = acc[ai][bj][m][1]; const float sar = sa[ai][m];
                            const float v[8] = {(float)a[0] * (sar * sb[bj][0].x), (float)a[1] * (sar * sb[bj][0].y), (float)a[2] * (sar * sb[bj][0].z), (float)a[3] * (sar * sb[bj][0].w),
                                                (float)b[0] * (sar * sb[bj][1].x), (float)b[1] * (sar * sb[bj][1].y), (float)b[2] * (sar * sb[bj][1].z), (float)b[3] * (sar * sb[bj][1].w)};
                            float q = (v[0] * v[0] + v[1] * v[1]) + (v[2] * v[2] + v[3] * v[3]) + (v[4] * v[4] + v[5] * v[5]) + (v[6] * v[6] + v[7] * v[7]);
                            { auto r = __builtin_amdgcn_permlane16_swap(__float_as_uint(q), __float_as_uint(q), false, false); q = __uint_as_float(r[0]) + __uint_as_float(r[1]); }
                            { auto r = __builtin_amdgcn_permlane32_swap(__float_as_uint(q), __float_as_uint(q), false, false); q = __uint_as_float(r[0]) + __uint_as_float(r[1]); }
                            ss[ai][m][bj] = q;
                        }
                LAS float* mine = f.scr + (wr * 4 + wc) * 256 + fr; LAS const float* theirs = f.scr + (wr * 4 + (wc ^ 1)) * 256 + fr;
                if (fq == 0) {
#pragma unroll
                    for (int ai = 0; ai < 2; ++ai)
#pragma unroll
                        for (int m = 0; m < 4; ++m)
#pragma unroll
                            for (int bj = 0; bj < 2; ++bj) mine[((ai * 4 + m) * 2 + bj) * 16] = ss[ai][m][bj];
                }
                asm volatile("s_waitcnt lgkmcnt(0)\n\ts_barrier" ::: "memory");
                f32x4 gk[2][2];
#pragma unroll
                for (int bj = 0; bj < 2; ++bj) { gk[bj][0] = *(const f32x4*)(f.gkn + (col0 - 512) + bj * 128); gk[bj][1] = *(const f32x4*)(f.gkn + (col0 - 512) + bj * 128 + 4); }
#pragma unroll
                for (int ai = 0; ai < 2; ++ai)
#pragma unroll
                    for (int m = 0; m < 4; ++m) {
                        const int row = row0 + ai * 128 + m * 16; const float sar = sa[ai][m];
#pragma unroll
                        for (int bj = 0; bj < 2; ++bj) {
                            const float tot = ss[ai][m][bj] + theirs[((ai * 4 + m) * 2 + bj) * 16];
                            const float rk = __builtin_amdgcn_rsqf(tot * (1.f / 64.f) + NORM_EPS);
                            const pg8::i32x4 a = acc[ai][bj][m][0], b = acc[ai][bj][m][1];
                            float v[8] = {(float)a[0] * (sar * sb[bj][0].x) * (rk * gk[bj][0].x), (float)a[1] * (sar * sb[bj][0].y) * (rk * gk[bj][0].y), (float)a[2] * (sar * sb[bj][0].z) * (rk * gk[bj][0].z),
                                          (float)a[3] * (sar * sb[bj][0].w) * (rk * gk[bj][0].w), (float)b[0] * (sar * sb[bj][1].x) * (rk * gk[bj][1].x), (float)b[1] * (sar * sb[bj][1].y) * (rk * gk[bj][1].y),
                                          (float)b[2] * (sar * sb[bj][1].z) * (rk * gk[bj][1].z), (float)b[3] * (sar * sb[bj][1].w) * (rk * gk[bj][1].w)};
                            f.template store_t<false>(row, col0 + bj * 128, v);
                        }
                    }
                return;
            }
            auto emit = [&](auto tag) {
                constexpr bool GATE = decltype(tag)::value;
#pragma unroll
                for (int ai = 0; ai < 2; ++ai)
#pragma unroll
                    for (int m = 0; m < 4; ++m) {
                        const int row = row0 + ai * 128 + m * 16; const float sar = GATE ? sa[ai][m] * -LOG2E : sa[ai][m];
#pragma unroll
                        for (int bj = 0; bj < 2; ++bj) {
                            const pg8::i32x4 a = acc[ai][bj][m][0], b = acc[ai][bj][m][1];
                            float v[8] = {(float)a[0] * (sar * sb[bj][0].x), (float)a[1] * (sar * sb[bj][0].y), (float)a[2] * (sar * sb[bj][0].z), (float)a[3] * (sar * sb[bj][0].w),
                                          (float)b[0] * (sar * sb[bj][1].x), (float)b[1] * (sar * sb[bj][1].y), (float)b[2] * (sar * sb[bj][1].z), (float)b[3] * (sar * sb[bj][1].w)};
                            f.template store_t<GATE>(row, col0 + bj * 128, v);
                        }
                    }
            };
            if (u.pn >= 14) emit(BoolC<true>{}); else emit(BoolC<false>{});
            return;
        }
#pragma unroll
        for (int ai = 0; ai < 2; ++ai)
#pragma unroll
            for (int m = 0; m < 4; ++m) {
                const int row = row0 + ai * 128 + m * 16; const float sar = sa[ai][m];
#pragma unroll
                for (int bj = 0; bj < 2; ++bj) {
                    const pg8::i32x4 a = acc[ai][bj][m][0], b = acc[ai][bj][m][1];
                    float v[8] = {(float)a[0] * (sar * sb[bj][0].x), (float)a[1] * (sar * sb[bj][0].y), (float)a[2] * (sar * sb[bj][0].z), (float)a[3] * (sar * sb[bj][0].w),
                                  (float)b[0] * (sar * sb[bj][1].x), (float)b[1] * (sar * sb[bj][1].y), (float)b[2] * (sar * sb[bj][1].z), (float)b[3] * (sar * sb[bj][1].w)};
                    typename F::Ctx cx; f.load(row, col0 + bj * 128, cx);
                    f.store(row, col0 + bj * 128, v, cx, cc[bj]);
                }
            }
    }
};
template <class F>
__device__ __forceinline__ void run_gemm_i8(LAS unsigned char* lds, const unsigned char* A8, const unsigned char* Bt8, int M, int N, int K8, int G, int bid, const float* SA, const float* SB, const F& f) {
    asm volatile("" : "+s"(M), "+s"(N), "+s"(G));
    pg8::Gemm g{(const bf16*)A8, (const bf16*)Bt8, M, N, K8 / 2}; pg8::StaticOrder S; S.init(M, N, G, bid);
    EpiI8<F> E{f, SA, SB, lds + pg8::STAGE_BYTES + 8192};
    pg8::gemm_phase_i8<EpiI8<F>, pg8::StaticOrder, true, true>(lds, g, S, E);
}
template <int LOG_NT> struct PanelOrder {
    int c, G;
    __device__ __forceinline__ bool next(int i, pg8::Unit& u) const { const int pan = c + (i >> LOG_NT) * G; if (pan >= NTOK / 256) return false; u.pm = pan; u.pn = (i + (c >> 3)) & ((1 << LOG_NT) - 1); return true; }
    __device__ __forceinline__ void a_ready(const pg8::Unit&) const {}
    __device__ __forceinline__ void done(const pg8::Unit&) const {}
    __device__ __forceinline__ size_t a_row0(int pm) const { return (size_t)pm * 256; }
};
struct CompactOrder : pg8::StaticOrder {
    __device__ __forceinline__ size_t a_row0(int pm) const { return (size_t)(pm >> 4) * TP + 64 + (size_t)(pm & 15) * 256; }
};
struct CtxX { f32x4 x0, x1; };
struct F_OutC {
    const float* x; bf16* h1;
    typedef NoCtx Col; typedef CtxX Ctx; static constexpr int MB = 4; static constexpr bool COL_OUTER = false;
    __device__ __forceinline__ void col(int, Col&) const {}
    __device__ __forceinline__ void load(int row, int col, Ctx& c) const { const size_t off = (size_t)row * 1024 + col; c.x0 = *(const f32x4*)(x + off); c.x1 = *(const f32x4*)(x + off + 4); }
    __device__ __forceinline__ void store(int row, int col, float (&v)[8], const Ctx& c, const Col&) const {
        const size_t off = (size_t)row * 1024 + col;
        v[0] += c.x0.x; v[1] += c.x0.y; v[2] += c.x0.z; v[3] += c.x0.w; v[4] += c.x1.x; v[5] += c.x1.y; v[6] += c.x1.z; v[7] += c.x1.w;
        *(v4u*)(h1 + off) = pack8(v);
    }
};
template <class F>
__device__ __forceinline__ void run_gemm_panels(LAS unsigned char* lds, const bf16* A, const bf16* Bt, int N, int K, int G, int c, const F& f) {
    asm volatile("" : "+s"(N), "+s"(G));
    pg8::Gemm g{A, Bt, NTOK, N, K}; PanelOrder<2> S{c, G};
    EpiT<F> E{f};
    pg8::gemm_phase<EpiT<F>, PanelOrder<2>, true, true>(lds, g, S, E);
}
template <class F>
__device__ __forceinline__ void run_gemm_i8_panels8(LAS unsigned char* lds, const unsigned char* A8, const unsigned char* Bt8, int K8, int G, int c, const float* SA, const float* SB, const F& f) {
    asm volatile("" : "+s"(K8), "+s"(G));
    pg8::Gemm g{(const bf16*)A8, (const bf16*)Bt8, NTOK, 2048, K8 / 2}; PanelOrder<3> S{c, G};
    EpiI8<F> E{f, SA, SB, lds + pg8::STAGE_BYTES + 8192};
    pg8::gemm_phase_i8<EpiI8<F>, PanelOrder<3>, true, true>(lds, g, S, E);
}
template <class F>
__device__ __forceinline__ void run_gemm_compact(LAS unsigned char* lds, const bf16* A, const bf16* Bt, int N, int K, int G, int bid, const F& f) {
    int M = NTOK; asm volatile("" : "+s"(M), "+s"(N), "+s"(G));
    pg8::Gemm g{A, Bt, M, N, K}; CompactOrder S; S.init(M, N, G, bid);
    EpiT<F> E{f};
    pg8::gemm_phase<EpiT<F>, CompactOrder, true, true>(lds, g, S, E);
}
template <class F>
__device__ __forceinline__ void run_gemm(LAS unsigned char* lds, const bf16* A, const bf16* Bt, int M, int N, int K, int G, int bid, const F& f) {
    asm volatile("" : "+s"(M), "+s"(N), "+s"(G));
    pg8::Gemm g{A, Bt, M, N, K}; pg8::StaticOrder S; S.init(M, N, G, bid);
    EpiT<F> E{f};
    pg8::gemm_phase<EpiT<F>, pg8::StaticOrder, true, true>(lds, g, S, E);
}

__device__ __forceinline__ void p2_prep1(const Params& p, int vcu, int G, int wave, int lane) {
    unsigned char* ws = p.ws;
    const int gw = vcu * NWAVES + wave, NGW = G * NWAVES;
    float mu[8], fb[8];
#pragma unroll
    for (int e = 0; e < 8; ++e) { mu[e] = (lane < 36) ? p.in[I_MU][1536 + lane * 8 + e] : 0.f; fb[e] = p.in[I_FBIAS][e]; }
    constexpr int NR = 16;
    for (int m0 = gw; m0 < R; m0 += NR * NGW) {
        v4u zv[NR], zpv[NR];
#pragma unroll
        for (int r = 0; r < NR; ++r) { const int m = m0 + r * NGW; const bool ok = m < R; const int mm = ok ? m : gw; const int pp = mm % TP;
            zv[r] = (v4u){0u, 0u, 0u, 0u}; zpv[r] = zv[r];
            if (lane < 37) { zv[r] = *((const v4u*)(ws + WS_ZM + (size_t)mm * 1024) + lane); if (pp > 0) zpv[r] = *((const v4u*)(ws + WS_ZM + (size_t)(mm - 1) * 1024) + lane); } }
#pragma unroll
        for (int r = 0; r < NR; ++r) { const int m = m0 + r * NGW; if (m >= R) continue;
            float z[8], zp[8]; unpack8(zv[r], z); unpack8(zpv[r], zp);
            if (lane < 36) {
#pragma unroll
                for (int e = 0; e < 8; ++e) { const float s = z[e] + mu[e] * (zp[e] - z[e]); const float sg = sigmoidf_(lane < 8 ? 2.0f * s : s); z[e] = (lane < 8) ? 2.0f * sg - 1.0f : (lane < 16) ? s : sg; }
                if (lane < 16) *((v4u*)(ws + WS_LA + (size_t)m * 256) + lane) = pack8(z);
                else *((v4u*)(ws + WS_LG + (size_t)m * 512) + (lane - 16)) = pack8(z);
            } else if (lane == 36) {
#pragma unroll
                for (int e = 0; e < 8; ++e) { const float x = z[e] + fb[e]; z[e] = fminf(x, 0.f) - __logf(1.0f + __expf(-fabsf(x))); }
                float* lf = (float*)(ws + WS_LF) + (size_t)m * 8;
                *(f32x4*)lf = (f32x4){z[0], z[1], z[2], z[3]}; *(f32x4*)(lf + 4) = (f32x4){z[4], z[5], z[6], z[7]};
            } else if (lane < 49) {
                *((v4u*)(ws + WS_LG + (size_t)m * 512) + (lane - 37 + 20)) = (v4u){0u, 0u, 0u, 0u};
            }
        }
    }
}
__device__ __forceinline__ void p3_cumsum(const Params& p, int seq, int lane) {
    unsigned char* ws = p.ws;
    const int b = seq >> 3, h = seq & 7;
    const float* lf = (const float*)(ws + WS_LF) + (size_t)b * TP * 8 + h;
    float* kb = (float*)(ws + WS_KB) + (size_t)seq * TP;
    float v[65];
#pragma unroll
    for (int i = 0; i < 65; ++i) { const int pp = i * 64 + lane; v[i] = (pp >= 48) ? lf[(size_t)pp * 8] : 0.f; }
    float carry = 0.f;
#pragma unroll
    for (int i = 0; i < 65; ++i) {
        float x = v[i];
        x += __uint_as_float(__builtin_amdgcn_update_dpp(0u, __float_as_uint(x), 0x111, 0xF, 0xF, true));
        x += __uint_as_float(__builtin_amdgcn_update_dpp(0u, __float_as_uint(x), 0x112, 0xF, 0xF, true));
        x += __uint_as_float(__builtin_amdgcn_update_dpp(0u, __float_as_uint(x), 0x114, 0xF, 0xF, true));
        x += __uint_as_float(__builtin_amdgcn_update_dpp(0u, __float_as_uint(x), 0x118, 0xF, 0xF, true));
        x += __uint_as_float(__builtin_amdgcn_update_dpp(0u, __float_as_uint(x), 0x142, 0xA, 0xF, false));
        x += __uint_as_float(__builtin_amdgcn_update_dpp(0u, __float_as_uint(x), 0x143, 0xC, 0xF, false));
        const int pp = i * 64 + lane;
        const float c = carry + x;
        kb[pp] = (pp >= 48) ? -c * LOG2E : -1e30f;
        carry += __uint_as_float((unsigned)__builtin_amdgcn_readlane((int)__float_as_uint(x), 63));
    }
}

__device__ __forceinline__ void p4_prep2(const Params& p, int vcu, int G, int wave, int lane) {
    unsigned char* ws = p.ws; unsigned char* dob = (unsigned char*)p.out;
    const int gw = vcu * NWAVES + wave, NGW = G * NWAVES;
    float mur[8], muk[8], kk_[8], ka_[8], rk_[8];
#pragma unroll
    for (int e = 0; e < 8; ++e) { const int c = lane * 8 + e; mur[e] = p.in[I_MU][c]; muk[e] = p.in[I_MU][512 + c]; kk_[e] = p.in[I_KK][c]; ka_[e] = p.in[I_KA][c]; rk_[e] = p.in[I_RK][c]; }
    for (int m = gw; m < R; m += NGW) {
        const int b = m / TP, pp = m - b * TP;
        float r[8], k[8], rp[8], kp[8], a[8];
        unpack8(*((const v4u*)(ws + WS_ZRR + (size_t)m * 1024) + lane), r); unpack8(*((const v4u*)(ws + WS_ZRK + (size_t)m * 1024) + lane), k);
        if (pp > 0) { unpack8(*((const v4u*)(ws + WS_ZRR + (size_t)(m - 1) * 1024) + lane), rp); unpack8(*((const v4u*)(ws + WS_ZRK + (size_t)(m - 1) * 1024) + lane), kp); }
        else {
#pragma unroll
            for (int e = 0; e < 8; ++e) { rp[e] = 0.f; kp[e] = 0.f; } }
        v4u* aap = (v4u*)(dob + DO_AA + (size_t)m * 1024) + lane;
        unpack8(*aap, a);
        float kkv[8], kpr[8]; float ss = 0.f, bon = 0.f;
#pragma unroll
        for (int e = 0; e < 8; ++e) { const float rs = r[e] + mur[e] * (rp[e] - r[e]); const float ks = k[e] + muk[e] * (kp[e] - k[e]);
            kkv[e] = ks * kk_[e]; kpr[e] = ks * (1.0f + (a[e] - 1.0f) * ka_[e]); ss += kkv[e] * kkv[e]; bon += rs * kpr[e] * rk_[e]; }
        ss = sum8(ss); bon = sum8(bon);
        const float inv = 1.0f / fmaxf(sqrtf(ss), 1e-12f);
        float bb[8];
#pragma unroll
        for (int e = 0; e < 8; ++e) { kkv[e] *= inv; bb[e] = kkv[e] * a[e]; }
        *((v4u*)(ws + WS_KP + (size_t)m * 1024) + lane) = pack8(kpr);
        *((v4u*)(ws + WS_KN + (size_t)m * 1024) + lane) = pack8(kkv);
        *aap = pack8(bb);
        if ((lane & 7) == 0) ((float*)(ws + WS_BS))[(size_t)m * 8 + (lane >> 3)] = bon;
    }
}

constexpr int SC_CH = 32, SC_STRIDE = 5 * 64 + 32;
constexpr int SC_BUF_BYTES = SC_CH * SC_STRIDE * 4;
constexpr int SC_YB_BYTES = SC_CH * 32 * 4 * 4;
__device__ __forceinline__ float dpp_sum16(float x) {
    x += __builtin_bit_cast(float, __builtin_amdgcn_update_dpp(0, __builtin_bit_cast(int, x), 0xB1, 0xF, 0xF, true));
    x += __builtin_bit_cast(float, __builtin_amdgcn_update_dpp(0, __builtin_bit_cast(int, x), 0x4E, 0xF, 0xF, true));
    x += __builtin_bit_cast(float, __builtin_amdgcn_update_dpp(0, __builtin_bit_cast(int, x), 0x141, 0xF, 0xF, true));
    x += __builtin_bit_cast(float, __builtin_amdgcn_update_dpp(0, __builtin_bit_cast(int, x), 0x140, 0xF, 0xF, true));
    return x;
}
__device__ __forceinline__ float dpp_sum4(float x) {
    x += __builtin_bit_cast(float, __builtin_amdgcn_update_dpp(0, __builtin_bit_cast(int, x), 0xB1, 0xF, 0xF, true));
    x += __builtin_bit_cast(float, __builtin_amdgcn_update_dpp(0, __builtin_bit_cast(int, x), 0x4E, 0xF, 0xF, true));
    return x;
}
struct ScanVec { f32x4 xw, kn, bb, kp, rr; float va, vb; };
__device__ __forceinline__ void p5_scan_item(const Params& p, LAS unsigned char* lds, int item, int tid, int wave, int lane) {
    unsigned char* ws = p.ws; unsigned char* dob = (unsigned char*)p.out;
    const int half = item & 1, bh = item >> 1, b = bh >> 3, h = bh & 7;
    const size_t rowb = (size_t)b * TP;
    constexpr int T0 = 32, NCH = (TP - T0) / SC_CH;
    bf16* Y = (bf16*)(ws + WS_Y);
    LAS float* yb0 = (LAS float*)(lds + 2 * SC_BUF_BYTES);
    if (wave >= 4) {
        const int lt = tid - 256;
        const int st_step = lt >> 3, c8 = lt & 7;
        const size_t colb = (size_t)h * 64 + c8 * 8;
        const bf16* aXW = (const bf16*)(dob + DO_XW); const bf16* aKN = (const bf16*)(ws + WS_KN); const bf16* aBB = (const bf16*)(dob + DO_AA); const bf16* aKP = (const bf16*)(ws + WS_KP);
        const bf16* aR = (const bf16*)(ws + WS_ZRR); const bf16* aV = (const bf16*)(ws + WS_ZRV);
        float mur[8], muv[8];
#pragma unroll
        for (int e = 0; e < 8; ++e) { mur[e] = p.in[I_MU][h * 64 + c8 * 8 + e]; muv[e] = (c8 < 4) ? p.in[I_MU][1024 + h * 64 + half * 32 + c8 * 8 + e] : 0.f; }
        auto stage = [&](int t0, int bufi) {
            const size_t row = rowb + t0 + st_step;
            const v4u g0 = *(const v4u*)(aXW + row * 512 + colb), g1 = *(const v4u*)(aKN + row * 512 + colb), g2 = *(const v4u*)(aBB + row * 512 + colb), g3 = *(const v4u*)(aKP + row * 512 + colb);
            const v4u g4 = *(const v4u*)(aR + row * 512 + colb), g5 = *(const v4u*)(aR + (row - 1) * 512 + colb);
            v4u g6 = {0u, 0u, 0u, 0u}, g7 = {0u, 0u, 0u, 0u};
            if (c8 < 4) { const size_t cv = (size_t)h * 64 + half * 32 + c8 * 8; g6 = *(const v4u*)(aV + row * 512 + cv); g7 = *(const v4u*)(aV + (row - 1) * 512 + cv); }
            LAS float* d = (LAS float*)(lds + bufi * SC_BUF_BYTES) + st_step * SC_STRIDE + c8 * 8;
            float a[8], c[8];
            unpack8(g0, a); *(LAS f32x4*)(d + 0 * 64) = (f32x4){a[0], a[1], a[2], a[3]}; *(LAS f32x4*)(d + 0 * 64 + 4) = (f32x4){a[4], a[5], a[6], a[7]};
            unpack8(g1, a); *(LAS f32x4*)(d + 1 * 64) = (f32x4){a[0], a[1], a[2], a[3]}; *(LAS f32x4*)(d + 1 * 64 + 4) = (f32x4){a[4], a[5], a[6], a[7]};
            unpack8(g2, a); *(LAS f32x4*)(d + 2 * 64) = (f32x4){a[0], a[1], a[2], a[3]}; *(LAS f32x4*)(d + 2 * 64 + 4) = (f32x4){a[4], a[5], a[6], a[7]};
            unpack8(g3, a); *(LAS f32x4*)(d + 3 * 64) = (f32x4){a[0], a[1], a[2], a[3]}; *(LAS f32x4*)(d + 3 * 64 + 4) = (f32x4){a[4], a[5], a[6], a[7]};
            unpack8(g4, a); unpack8(g5, c);
#pragma unroll
            for (int e = 0; e < 8; ++e) a[e] = a[e] + mur[e] * (c[e] - a[e]);
            *(LAS f32x4*)(d + 4 * 64) = (f32x4){a[0], a[1], a[2], a[3]}; *(LAS f32x4*)(d + 4 * 64 + 4) = (f32x4){a[4], a[5], a[6], a[7]};
            if (c8 < 4) { unpack8(g6, a); unpack8(g7, c);
#pragma unroll
                for (int e = 0; e < 8; ++e) a[e] = a[e] + muv[e] * (c[e] - a[e]);
                *(LAS f32x4*)(d + 5 * 64) = (f32x4){a[0], a[1], a[2], a[3]}; *(LAS f32x4*)(d + 5 * 64 + 4) = (f32x4){a[4], a[5], a[6], a[7]}; }
        };
        auto flush = [&](int t0, int ybi) {
            const LAS f32x4* yq = (const LAS f32x4*)(lds + 2 * SC_BUF_BYTES + ybi * SC_YB_BYTES) + (lt >> 3) * 32 + (lt & 7) * 4;
            float y[4];
#pragma unroll
            for (int r = 0; r < 4; ++r) { const f32x4 q = yq[r]; y[r] = (q.x + q.y) + (q.z + q.w); }
            v2u o; o.x = pk2(y[0], y[1]); o.y = pk2(y[2], y[3]);
            *(v2u*)(Y + (rowb + t0 + (lt >> 3)) * 512 + h * 64 + half * 32 + 4 * (lt & 7)) = o;
        };
        stage(T0, 0);
        __syncthreads();
        for (int ch = 0; ch < NCH; ++ch) {
            if (ch + 1 < NCH) stage(T0 + (ch + 1) * SC_CH, (ch + 1) & 1);
            if (ch > 0) flush(T0 + (ch - 1) * SC_CH, (ch - 1) & 1);
            __syncthreads();
        }
        flush(T0 + (NCH - 1) * SC_CH, (NCH - 1) & 1);
    } else {
        const int rl = lane >> 4, kq = lane & 15, rowA = wave * 8 + rl, rowB = rowA + 4;
        f32x4 SA = {0.f, 0.f, 0.f, 0.f}, SB = {0.f, 0.f, 0.f, 0.f};
        auto ldv = [&](const LAS float* base, int s) { ScanVec v; const LAS float* q = base + s * SC_STRIDE + kq * 4;
            v.xw = *(const LAS f32x4*)(q); v.kn = *(const LAS f32x4*)(q + 64); v.bb = *(const LAS f32x4*)(q + 128); v.kp = *(const LAS f32x4*)(q + 192); v.rr = *(const LAS f32x4*)(q + 256);
            v.va = base[s * SC_STRIDE + 320 + rowA]; v.vb = base[s * SC_STRIDE + 320 + rowB]; return v; };
        auto step = [&](const ScanVec& v, LAS float* yb, int s) {
            float sa = SA.x * v.kn.x; sa = fmaf(SA.y, v.kn.y, sa); sa = fmaf(SA.z, v.kn.z, sa); sa = fmaf(SA.w, v.kn.w, sa);
            float sb = SB.x * v.kn.x; sb = fmaf(SB.y, v.kn.y, sb); sb = fmaf(SB.z, v.kn.z, sb); sb = fmaf(SB.w, v.kn.w, sb);
            sa = -dpp_sum16(sa); sb = -dpp_sum16(sb);
            SA = (SA - SA * v.xw) + sa * v.bb + v.va * v.kp;
            SB = (SB - SB * v.xw) + sb * v.bb + v.vb * v.kp;
            float ya = SA.x * v.rr.x; ya = fmaf(SA.y, v.rr.y, ya); ya = fmaf(SA.z, v.rr.z, ya); ya = fmaf(SA.w, v.rr.w, ya);
            float yv = SB.x * v.rr.x; yv = fmaf(SB.y, v.rr.y, yv); yv = fmaf(SB.z, v.rr.z, yv); yv = fmaf(SB.w, v.rr.w, yv);
            ya = dpp_sum4(ya); yv = dpp_sum4(yv);
            yb[(s * 32 + rowA) * 4 + (kq >> 2)] = ya; yb[(s * 32 + rowB) * 4 + (kq >> 2)] = yv;
        };
        __syncthreads();
        for (int ch = 0; ch < NCH; ++ch) {
            const LAS float* base = (const LAS float*)(lds + (ch & 1) * SC_BUF_BYTES);
            LAS float* yb = yb0 + (ch & 1) * (SC_YB_BYTES / 4);
            ScanVec v0 = ldv(base, 0), v1;
#pragma unroll 1
            for (int s = 0; s < SC_CH; s += 2) {
                v1 = ldv(base, s + 1);
                step(v0, yb, s);
                if (s + 2 < SC_CH) v0 = ldv(base, s + 2);
                step(v1, yb, s + 1);
            }
            __syncthreads();
        }
    }
    __syncthreads();
}

#ifndef SC2_DBG
#define SC2_DBG 0
#endif
namespace sc2 {
constexpr int S64 = 144, S32 = 80, SAAB = 36, SRHS = 68;
constexpr int AT = 0, RT = AT + 32 * S64, BT = RT + 32 * S64, KT = BT + 32 * S64, BH = KT + 32 * S64, KH = BH + 32 * S64, VV = KH + 32 * S64, PT = VV + 32 * S64,
              AAK = PT + 64 * S32, ARB = AAK + 32 * S32, ARK = ARB + 32 * S32, SB = ARK + 32 * S32, AAB = SB + 64 * S64, RHS = AAB + 32 * SAAB * 4, CL = RHS + 32 * SRHS * 4,
              GC = CL + 32 * 64 * 4, END = GC + 512;
static_assert(END <= 100000, "scan LDS");
}
__device__ __forceinline__ bf16x8 sc2_frag(LAS unsigned char* base, int stride, int row0, int k0, int lane) {
    return *(const LAS bf16x8*)(base + (row0 + (lane & 15)) * stride + (k0 + 8 * (lane >> 4)) * 2);
}
typedef short sc2_v4i16 __attribute__((ext_vector_type(4)));
__device__ __forceinline__ bf16x8 sc2_frag_tr(LAS unsigned char* base, int col0, int lane) {
    const int i = lane & 15, g = lane >> 4;
    LAS unsigned char* a = base + (8 * g + (i >> 2)) * sc2::S64 + (col0 + 4 * (i & 3)) * 2;
    const sc2_v4i16 lo = __builtin_amdgcn_ds_read_tr16_b64_v4i16((LAS sc2_v4i16*)a), hi = __builtin_amdgcn_ds_read_tr16_b64_v4i16((LAS sc2_v4i16*)(a + 4 * sc2::S64));
    return (bf16x8){lo[0], lo[1], lo[2], lo[3], hi[0], hi[1], hi[2], hi[3]};
}
#define SC2_BAR() asm volatile("s_waitcnt lgkmcnt(0)\n\ts_barrier" ::: "memory")
__device__ __forceinline__ void p5_scan_chunked(const Params& p, LAS unsigned char* lds, int bh, int tid, int wave, int lane) {
    using namespace sc2;
    unsigned char* ws = p.ws; unsigned char* dob = (unsigned char*)p.out;
    const int b = bh >> 3, h = bh & 7;
    const size_t rowb = (size_t)b * TP;
    constexpr int T0 = 32, NCH = (TP - T0) / 32;
    const bf16* aXW = (const bf16*)(dob + DO_XW); const bf16* aA = (const bf16*)(dob + DO_AA); const bf16* aG = (const bf16*)(dob + DO_GG);
    const bf16* aR = (const bf16*)(ws + WS_ZRR); const bf16* aK = (const bf16*)(ws + WS_ZRK); const bf16* aV = (const bf16*)(ws + WS_ZRV);
    bf16* Y = (bf16*)(ws + WS_Y);
    const int pt = tid >> 4, kc = tid & 15;
    const size_t kcol = (size_t)h * 64 + 4 * kc;
    float mur[4], muk[4], muv[4], kk_[4], ka_[4], rk_[4], lng[4], lnb[4];
#pragma unroll
    for (int e = 0; e < 4; ++e) { const int c = h * 64 + 4 * kc + e; mur[e] = p.in[I_MU][c]; muk[e] = p.in[I_MU][512 + c]; muv[e] = p.in[I_MU][1024 + c];
        kk_[e] = p.in[I_KK][c]; ka_[e] = p.in[I_KA][c]; rk_[e] = p.in[I_RK][c]; lng[e] = p.in[I_LNG][c]; lnb[e] = p.in[I_LNB][c]; }
    const int q = lane >> 4, c16 = lane & 15;
    const int m_ = wave >> 1, tr = wave & 1;
    const int tr2 = wave >> 2, vc2 = wave & 3;
    const int kt = wave >> 1, vh = wave & 1;
    pg8::f32x4 accS0 = {0.f, 0.f, 0.f, 0.f}, accS1 = {0.f, 0.f, 0.f, 0.f};
    for (int i = tid; i < 64 * S64 / 4; i += NTHREADS) ((LAS unsigned*)(lds + SB))[i] = 0u;
    v2u gxw, ga, gk0, gk1, gr0, gr1, gv0, gv1, ggn;
    auto prefetch = [&](int t0) { const unsigned off = (unsigned)(((unsigned)rowb + (unsigned)(t0 + pt)) * 512u + (unsigned)kcol) * 2u;
#define SC2_LD(base, o) (*(const v2u*)((const unsigned char*)(base) + (o)))
        gxw = SC2_LD(aXW, (unsigned)(((unsigned)rowb + (unsigned)(t0 + (lane & 31))) * 512u + (unsigned)(h * 64 + 8 * wave + 4 * (lane >> 5))) * 2u);
        ga = SC2_LD(aA, off); ggn = SC2_LD(aG, off);
        gk0 = SC2_LD(aK, off); gk1 = SC2_LD(aK, off - 1024u);
        gr0 = SC2_LD(aR, off); gr1 = SC2_LD(aR, off - 1024u);
        gv0 = SC2_LD(aV, off); gv1 = SC2_LD(aV, off - 1024u);
#undef SC2_LD
    };
    prefetch(T0);
    float e_vs[4] = {0.f, 0.f, 0.f, 0.f}, e_bs = 0.f; v2u e_gg = {0u, 0u};
    auto y_finish = [&](const f32x4 y4, const float (&e_vs)[4], const float e_bs, const v2u e_gg, int t0p) {
        float y[4] = {y4.x, y4.y, y4.z, y4.w};
        const float mean = dpp_sum16((y[0] + y[1]) + (y[2] + y[3])) * (1.f / 64.f);
        float qq = 0.f;
#pragma unroll
        for (int e = 0; e < 4; ++e) { y[e] -= mean; qq += y[e] * y[e]; }
        const float rstd = __builtin_amdgcn_rsqf(dpp_sum16(qq) * (1.f / 64.f) + GN_EPS);
        const float g[4] = {bflo(e_gg.x), bfhi(e_gg.x), bflo(e_gg.y), bfhi(e_gg.y)};
        float o[4];
#pragma unroll
        for (int e = 0; e < 4; ++e) o[e] = (y[e] * rstd * lng[e] + lnb[e] + e_bs * e_vs[e]) * g[e];
        v2u w; w.x = pk2(o[0], o[1]); w.y = pk2(o[2], o[3]);
        *(v2u*)((unsigned char*)Y + (unsigned)(((unsigned)rowb + (unsigned)(t0p + pt)) * 512u + (unsigned)kcol) * 2u) = w;
    };
    auto y_epilogue = [&](int t0p) { const f32x4 y4 = *(const LAS f32x4*)(lds + RHS + (pt * SRHS + 4 * kc) * 4); y_finish(y4, e_vs, e_bs, e_gg, t0p); };
    f32x4 dy4 = {0.f, 0.f, 0.f, 0.f}; float d_vs[4] = {0.f, 0.f, 0.f, 0.f}, d_bs = 0.f; v2u d_gg = {0u, 0u};
    for (int ch = 0; ch < NCH; ++ch) {
        const int t0 = T0 + ch * 32;
        { float lg[4] = {bflo(gxw.x), bfhi(gxw.x), bflo(gxw.y), bfhi(gxw.y)};
#pragma unroll
          for (int e = 0; e < 4; ++e) { float x = lg[e];
              x += __uint_as_float(__builtin_amdgcn_update_dpp(0u, __float_as_uint(x), 0x111, 0xF, 0xF, true));
              x += __uint_as_float(__builtin_amdgcn_update_dpp(0u, __float_as_uint(x), 0x112, 0xF, 0xF, true));
              x += __uint_as_float(__builtin_amdgcn_update_dpp(0u, __float_as_uint(x), 0x114, 0xF, 0xF, true));
              x += __uint_as_float(__builtin_amdgcn_update_dpp(0u, __float_as_uint(x), 0x118, 0xF, 0xF, true));
              x += __uint_as_float(__builtin_amdgcn_update_dpp(0u, __float_as_uint(x), 0x142, 0xA, 0xF, false));
              lg[e] = x; }
          const int cq = 8 * wave + 4 * (lane >> 5);
          *(LAS f32x4*)(lds + CL + ((lane & 31) * 64 + cq) * 4) = (f32x4){lg[0], lg[1], lg[2], lg[3]};
          if ((lane & 31) == 31) *(LAS f32x4*)(lds + GC + (ch & 1) * 256 + cq * 4) = (f32x4){__builtin_amdgcn_exp2f(lg[0]), __builtin_amdgcn_exp2f(lg[1]), __builtin_amdgcn_exp2f(lg[2]), __builtin_amdgcn_exp2f(lg[3])}; }
        SC2_BAR();
        if (ch > 0) { if (wave < 4) y_epilogue(t0 - 32);
                      else { dy4 = *(const LAS f32x4*)(lds + RHS + (pt * SRHS + 4 * kc) * 4); d_vs[0] = e_vs[0]; d_vs[1] = e_vs[1]; d_vs[2] = e_vs[2]; d_vs[3] = e_vs[3]; d_bs = e_bs; d_gg = e_gg; } }
        {
            const f32x4 clt = *(const LAS f32x4*)(lds + CL + (pt * 64 + 4 * kc) * 4);
            f32x4 clp = {0.f, 0.f, 0.f, 0.f}; if (pt > 0) clp = *(const LAS f32x4*)(lds + CL + ((pt - 1) * 64 + 4 * kc) * 4);
            const f32x4 egc = *(const LAS f32x4*)(lds + GC + (ch & 1) * 256 + 16 * kc);
            const float k0[4] = {bflo(gk0.x), bfhi(gk0.x), bflo(gk0.y), bfhi(gk0.y)}, k1[4] = {bflo(gk1.x), bfhi(gk1.x), bflo(gk1.y), bfhi(gk1.y)}, av[4] = {bflo(ga.x), bfhi(ga.x), bflo(ga.y), bfhi(ga.y)};
            const float r0[4] = {bflo(gr0.x), bfhi(gr0.x), bflo(gr0.y), bfhi(gr0.y)}, r1[4] = {bflo(gr1.x), bfhi(gr1.x), bflo(gr1.y), bfhi(gr1.y)};
            const float v0[4] = {bflo(gv0.x), bfhi(gv0.x), bflo(gv0.y), bfhi(gv0.y)}, v1[4] = {bflo(gv1.x), bfhi(gv1.x), bflo(gv1.y), bfhi(gv1.y)};
            float kkv[4], kp[4], rsv[4], ss = 0.f, bon = 0.f;
#pragma unroll
            for (int e = 0; e < 4; ++e) { const float ks = k0[e] + muk[e] * (k1[e] - k0[e]); rsv[e] = r0[e] + mur[e] * (r1[e] - r0[e]); e_vs[e] = v0[e] + muv[e] * (v1[e] - v0[e]);
                kkv[e] = ks * kk_[e]; kp[e] = ks * (1.0f + (av[e] - 1.0f) * ka_[e]); ss += kkv[e] * kkv[e]; bon += rsv[e] * kp[e] * rk_[e]; }
            ss = dpp_sum16(ss); e_bs = dpp_sum16(bon); e_gg = ggn;
            const float inv = fminf(__builtin_amdgcn_rsqf(ss), 1e12f);
            float kn[4], bb[4];
#pragma unroll
            for (int e = 0; e < 4; ++e) { kn[e] = kkv[e] * inv; bb[e] = kn[e] * av[e]; }
            float at[4], rt[4], bt[4], ktl[4], bh_[4], kh_[4];
#pragma unroll
            for (int e = 0; e < 4; ++e) {
                const float gt = __builtin_amdgcn_exp2f(clt[e]), gp = __builtin_amdgcn_exp2f(clp[e]), gi = __builtin_amdgcn_exp2f(-clt[e]), gc = egc[e] * gi;
                const float rs = rsv[e];
                at[e] = -kn[e] * gp; rt[e] = rs * gt; bt[e] = bb[e] * gi; ktl[e] = kp[e] * gi; bh_[e] = bb[e] * gc; kh_[e] = kp[e] * gc;
            }
            v2u w;
            w.x = pk2(at[0], at[1]); w.y = pk2(at[2], at[3]); *(LAS v2u*)(lds + AT + pt * S64 + 8 * kc) = w;
            w.x = pk2(rt[0], rt[1]); w.y = pk2(rt[2], rt[3]); *(LAS v2u*)(lds + RT + pt * S64 + 8 * kc) = w;
            w.x = pk2(bt[0], bt[1]); w.y = pk2(bt[2], bt[3]); *(LAS v2u*)(lds + BT + pt * S64 + 8 * kc) = w;
            w.x = pk2(ktl[0], ktl[1]); w.y = pk2(ktl[2], ktl[3]); *(LAS v2u*)(lds + KT + pt * S64 + 8 * kc) = w;
            w.x = pk2(bh_[0], bh_[1]); w.y = pk2(bh_[2], bh_[3]); *(LAS v2u*)(lds + BH + pt * S64 + 8 * kc) = w;
            w.x = pk2(kh_[0], kh_[1]); w.y = pk2(kh_[2], kh_[3]); *(LAS v2u*)(lds + KH + pt * S64 + 8 * kc) = w;
            w.x = pk2(e_vs[0], e_vs[1]); w.y = pk2(e_vs[2], e_vs[3]); *(LAS v2u*)(lds + VV + pt * S64 + 8 * kc) = w;
        }
        if (ch + 1 < NCH) prefetch(t0 + 32);
        SC2_BAR();
        pg8::f32x4 accR, accY;
        {
            LAS unsigned char* Ab = lds + ((m_ < 2) ? AT : RT); LAS unsigned char* Bb = lds + ((m_ & 1) ? KT : BT);
            const bf16x8 a0 = sc2_frag(Ab, S64, 16 * tr, 0, lane), a1 = sc2_frag(Ab, S64, 16 * tr, 32, lane);
            const int incl = (m_ >= 2) ? 1 : 0;
            LAS unsigned char* dstb = lds + (m_ == 1 ? AAK : (m_ == 2 ? ARB : ARK));
            pg8::f32x4 cc[2];
#pragma unroll
            for (int tc = 0; tc < 2; ++tc) {
                const bf16x8 b0 = sc2_frag(Bb, S64, 16 * tc, 0, lane), b1 = sc2_frag(Bb, S64, 16 * tc, 32, lane);
                pg8::f32x4 c = {0.f, 0.f, 0.f, 0.f};
                c = __builtin_amdgcn_mfma_f32_16x16x32_bf16(a0, b0, c, 0, 0, 0); c = __builtin_amdgcn_mfma_f32_16x16x32_bf16(a1, b1, c, 0, 0, 0);
                const int i = 16 * tc + c16;
#pragma unroll
                for (int r = 0; r < 4; ++r) { const int t = 16 * tr + 4 * q + r; c[r] = (i < t + incl) ? c[r] : 0.f; }
                cc[tc] = c;
            }
            if (m_ == 0) {
#pragma unroll
                for (int tc = 0; tc < 2; ++tc)
#pragma unroll
                    for (int r = 0; r < 4; ++r) *(LAS float*)(lds + AAB + ((16 * tc + c16) * SAAB + 16 * tr + 4 * q + r) * 4) = cc[tc][r];
            } else {
#pragma unroll
                for (int tc = 0; tc < 2; ++tc)
#pragma unroll
                    for (int r = 0; r < 4; ++r) *(LAS bf16*)(dstb + (16 * tr + 4 * q + r) * S32 + 2 * (16 * tc + c16)) = (bf16)f2bf(cc[tc][r]);
            }
            const bf16x8 sb0 = sc2_frag(lds + SB, S64, 16 * vc2, 0, lane), sb1 = sc2_frag(lds + SB, S64, 16 * vc2, 32, lane);
            const bf16x8 ra0 = sc2_frag(lds + AT, S64, 16 * tr2, 0, lane), ra1 = sc2_frag(lds + AT, S64, 16 * tr2, 32, lane);
            const bf16x8 ya0 = sc2_frag(lds + RT, S64, 16 * tr2, 0, lane), ya1 = sc2_frag(lds + RT, S64, 16 * tr2, 32, lane);
            accR = (pg8::f32x4){0.f, 0.f, 0.f, 0.f}; accY = accR;
            accR = __builtin_amdgcn_mfma_f32_16x16x32_bf16(ra0, sb0, accR, 0, 0, 0); accR = __builtin_amdgcn_mfma_f32_16x16x32_bf16(ra1, sb1, accR, 0, 0, 0);
            accY = __builtin_amdgcn_mfma_f32_16x16x32_bf16(ya0, sb0, accY, 0, 0, 0); accY = __builtin_amdgcn_mfma_f32_16x16x32_bf16(ya1, sb1, accY, 0, 0, 0);
        }
        SC2_BAR();
        {
            const bf16x8 bv = sc2_frag_tr(lds + VV, 16 * vc2, lane);
            accR = __builtin_amdgcn_mfma_f32_16x16x32_bf16(sc2_frag(lds + AAK, S32, 16 * tr2, 0, lane), bv, accR, 0, 0, 0);
            accY = __builtin_amdgcn_mfma_f32_16x16x32_bf16(sc2_frag(lds + ARK, S32, 16 * tr2, 0, lane), bv, accY, 0, 0, 0);
#pragma unroll
            for (int r = 0; r < 4; ++r) *(LAS float*)(lds + RHS + ((16 * tr2 + 4 * q + r) * SRHS + 16 * vc2 + c16) * 4) = accR[r];
        }
        SC2_BAR();
        if (wave < 4) {
            const int v = 16 * wave + (lane >> 2), part = lane & 3;
            typedef float sc2_f2 __attribute__((ext_vector_type(2)));
            sc2_f2 rh[2][2];
#pragma unroll
            for (int m = 0; m < 2; ++m)
#pragma unroll
                for (int j = 0; j < 4; ++j) rh[m][j >> 1][j & 1] = *(const LAS float*)(lds + RHS + ((4 * (4 * m + part) + j) * SRHS + v) * 4);
            unsigned pk[16]; float prev = 0.f;
            const LAS float* acol = (const LAS float*)(lds + AAB) + 4 * part;
#pragma unroll
            for (int t = 0; t < 32; ++t) {
                const int g = t >> 2, m = g >> 2, j = t & 3;
                const float mine = rh[m][j >> 1][j & 1];
                const int mi_ = (int)__float_as_uint(mine); int bc_;
                if ((g & 3) == 0) bc_ = __builtin_amdgcn_update_dpp(0, mi_, 0x00, 0xF, 0xF, true); else if ((g & 3) == 1) bc_ = __builtin_amdgcn_update_dpp(0, mi_, 0x55, 0xF, 0xF, true);
                else if ((g & 3) == 2) bc_ = __builtin_amdgcn_update_dpp(0, mi_, 0xAA, 0xF, 0xF, true); else bc_ = __builtin_amdgcn_update_dpp(0, mi_, 0xFF, 0xF, 0xF, true);
                const float pt_ = __uint_as_float((unsigned)bc_);
                if (t < 31) {
#pragma unroll
                    for (int m2 = 0; m2 < 2; ++m2) {
                        if (4 * m2 + 3 < g) continue;
                        const f32x4 w = *(const LAS f32x4*)(acol + t * SAAB + 16 * m2);
                        const sc2_f2 p2 = {pt_, pt_};
                        rh[m2][0] = __builtin_elementwise_fma((sc2_f2){w.x, w.y}, p2, rh[m2][0]); rh[m2][1] = __builtin_elementwise_fma((sc2_f2){w.z, w.w}, p2, rh[m2][1]);
                    }
                }
                if (t & 1) pk[t >> 1] = pk2(prev, pt_); else prev = pt_;
                if ((t & 3) == 3) asm volatile("" ::: "memory");
            }
            if (part == 0) {
#pragma unroll
                for (int g = 0; g < 4; ++g) { v4u w; w.x = pk[4 * g]; w.y = pk[4 * g + 1]; w.z = pk[4 * g + 2]; w.w = pk[4 * g + 3]; *(LAS v4u*)(lds + PT + v * S32 + 16 * g) = w; } }
        } else if (ch > 0) y_finish(dy4, d_vs, d_bs, d_gg, t0 - 32);
        SC2_BAR();
        {
            accY = __builtin_amdgcn_mfma_f32_16x16x32_bf16(sc2_frag(lds + ARB, S32, 16 * tr2, 0, lane), sc2_frag(lds + PT, S32, 16 * vc2, 0, lane), accY, 0, 0, 0);
#pragma unroll
            for (int r = 0; r < 4; ++r) *(LAS float*)(lds + RHS + ((16 * tr2 + 4 * q + r) * SRHS + 16 * vc2 + c16) * 4) = accY[r];
            const f32x4 gcv = *(const LAS f32x4*)(lds + GC + (ch & 1) * 256 + (16 * kt + 4 * q) * 4);
            const bf16x8 ab = sc2_frag_tr(lds + BH, 16 * kt, lane), ak = sc2_frag_tr(lds + KH, 16 * kt, lane);
            accS0[0] *= gcv.x; accS0[1] *= gcv.y; accS0[2] *= gcv.z; accS0[3] *= gcv.w; accS1[0] *= gcv.x; accS1[1] *= gcv.y; accS1[2] *= gcv.z; accS1[3] *= gcv.w;
            accS0 = __builtin_amdgcn_mfma_f32_16x16x32_bf16(ab, sc2_frag(lds + PT, S32, 32 * vh, 0, lane), accS0, 0, 0, 0);
            accS0 = __builtin_amdgcn_mfma_f32_16x16x32_bf16(ak, sc2_frag_tr(lds + VV, 32 * vh, lane), accS0, 0, 0, 0);
            accS1 = __builtin_amdgcn_mfma_f32_16x16x32_bf16(ab, sc2_frag(lds + PT, S32, 32 * vh + 16, 0, lane), accS1, 0, 0, 0);
            accS1 = __builtin_amdgcn_mfma_f32_16x16x32_bf16(ak, sc2_frag_tr(lds + VV, 32 * vh + 16, lane), accS1, 0, 0, 0);
            v2u w; w.x = pk2(accS0[0], accS0[1]); w.y = pk2(accS0[2], accS0[3]);
            *(LAS v2u*)(lds + SB + (32 * vh + c16) * S64 + (16 * kt + 4 * q) * 2) = w;
            w.x = pk2(accS1[0], accS1[1]); w.y = pk2(accS1[2], accS1[3]);
            *(LAS v2u*)(lds + SB + (32 * vh + 16 + c16) * S64 + (16 * kt + 4 * q) * 2) = w;
        }
    }
    __syncthreads();
    y_epilogue(T0 + (NCH - 1) * 32);
    __syncthreads();
}

__device__ __forceinline__ void p6_prep3(const Params& p, int vcu, int G, int wave, int lane) {
    unsigned char* ws = p.ws; unsigned char* dob = (unsigned char*)p.out;
    const int gw = vcu * NWAVES + wave, NGW = G * NWAVES;
    float lg[8], lb[8], muv[8];
#pragma unroll
    for (int e = 0; e < 8; ++e) { const int c = lane * 8 + e; lg[e] = p.in[I_LNG][c]; lb[e] = p.in[I_LNB][c]; muv[e] = p.in[I_MU][1024 + c]; }
    for (int m = gw; m < R; m += NGW) {
        const int b = m / TP, pp = m - b * TP;
        v4u* yp = (v4u*)(ws + WS_Y + (size_t)m * 1024) + lane;
        if (pp < 48) { *yp = (v4u){0u, 0u, 0u, 0u}; continue; }
        float y[8], v[8], vp[8], g[8];
        unpack8(*yp, y); unpack8(*((const v4u*)(ws + WS_ZRV + (size_t)m * 1024) + lane), v); unpack8(*((const v4u*)(ws + WS_ZRV + (size_t)(m - 1) * 1024) + lane), vp);
        unpack8(*((const v4u*)(dob + DO_GG + (size_t)m * 1024) + lane), g);
        float s = 0.f;
#pragma unroll
        for (int e = 0; e < 8; ++e) s += y[e];
        const float mean = sum8(s) * (1.f / 64.f); float q = 0.f;
#pragma unroll
        for (int e = 0; e < 8; ++e) { y[e] -= mean; q += y[e] * y[e]; }
        const float rstd = 1.0f / sqrtf(sum8(q) * (1.f / 64.f) + GN_EPS);
        const float bon = ((const float*)(ws + WS_BS))[(size_t)m * 8 + (lane >> 3)];
#pragma unroll
        for (int e = 0; e < 8; ++e) { const float vs = v[e] + muv[e] * (vp[e] - v[e]); y[e] = (y[e] * rstd * lg[e] + lb[e] + bon * vs) * g[e]; }
        *yp = pack8(y);
    }
}
template <int NR>
__device__ __forceinline__ void norm2_rows(const Params& p, int m0, int mstride, int lane) {
    unsigned char* ws = p.ws;
    const f32x4* g4 = (const f32x4*)p.in[I_N2G] + 4 * lane;
    f32x4 v[NR][4]; float s[NR], mx[NR];
#pragma unroll
    for (int r = 0; r < NR; ++r) { const v4u* xr = (const v4u*)(ws + WS_H1 + (size_t)(m0 + r * mstride) * 2048) + 2 * lane;
        const v4u a = xr[0], b = xr[1]; float f[8];
        unpack8(a, f); v[r][0] = (f32x4){f[0], f[1], f[2], f[3]}; v[r][1] = (f32x4){f[4], f[5], f[6], f[7]};
        unpack8(b, f); v[r][2] = (f32x4){f[0], f[1], f[2], f[3]}; v[r][3] = (f32x4){f[4], f[5], f[6], f[7]}; }
#pragma unroll
    for (int r = 0; r < NR; ++r) { s[r] = 0.f;
#pragma unroll
        for (int j = 0; j < 4; ++j) s[r] += (v[r][j].x * v[r][j].x + v[r][j].y * v[r][j].y) + (v[r][j].z * v[r][j].z + v[r][j].w * v[r][j].w); }
#pragma unroll
    for (int r = 0; r < NR; ++r) s[r] = wave_sum(s[r]);
#pragma unroll
    for (int r = 0; r < NR; ++r) { const float rs = __builtin_amdgcn_rsqf(s[r] * (1.f / 1024.f) + NORM_EPS); mx[r] = 0.f;
#pragma unroll
        for (int j = 0; j < 4; ++j) { const f32x4 g = g4[j]; v[r][j].x *= rs * g.x; v[r][j].y *= rs * g.y; v[r][j].z *= rs * g.z; v[r][j].w *= rs * g.w;
#ifdef PQ_BF16
            ((unsigned long long*)(ws + WS_XN2 + (size_t)(m0 + r * mstride) * 2048) + 4 * lane)[j] = (unsigned long long)pk2(v[r][j].x, v[r][j].y) | ((unsigned long long)pk2(v[r][j].z, v[r][j].w) << 32);
#endif
            mx[r] = fmaxf(mx[r], fmaxf(fmaxf(fabsf(v[r][j].x), fabsf(v[r][j].y)), fmaxf(fabsf(v[r][j].z), fabsf(v[r][j].w)))); } }
#pragma unroll
    for (int r = 0; r < NR; ++r) mx[r] = wave_max(mx[r]);
#pragma unroll
    for (int r = 0; r < NR; ++r) { const int m = m0 + r * mstride; const float inv = mx[r] > 0.f ? 127.0f / mx[r] : 0.f;
        unsigned* xq = (unsigned*)(ws + WS_XQ + (size_t)m * 1024) + 4 * lane;
#pragma unroll
        for (int j = 0; j < 4; ++j) xq[j] = q8x4(v[r][j].x, v[r][j].y, v[r][j].z, v[r][j].w, inv);
        if (lane == 0) ((float*)(ws + WS_SX))[m] = mx[r] > 0.f ? mx[r] * (1.0f / 127.0f) : 1.0f; }
}
__device__ __forceinline__ void p9_norm2(const Params& p, int vcu, int G, int wave, int lane) {
    const int gw = vcu * NWAVES + wave, NGW = G * NWAVES;
    for (int m = gw; m < NTOK; m += 4 * NGW) norm2_rows<4>(p, m, NGW, lane);
}

typedef __bf16 bf16x2_t __attribute__((ext_vector_type(2)));
__device__ __forceinline__ unsigned mono(float f) { return __builtin_bit_cast(unsigned, f); }
__device__ __forceinline__ float unmono(unsigned m) { return __builtin_bit_cast(float, m); }
constexpr unsigned KEY_NEG_INF = 0xFF800000u;
__device__ __forceinline__ unsigned kmax(unsigned a, unsigned b) { unsigned r; asm("v_max_f32 %0, %1, %2" : "=v"(r) : "v"(a), "v"(b)); return r; }
__device__ __forceinline__ unsigned kmin(unsigned a, unsigned b) { unsigned r; asm("v_min_f32 %0, %1, %2" : "=v"(r) : "v"(a), "v"(b)); return r; }
__device__ __forceinline__ void ce_desc(unsigned& a, unsigned& b) { const unsigned hi = kmax(a, b), lo = kmin(a, b); a = hi; b = lo; }
template <int BASE, int N> __device__ __forceinline__ void bitonic_sort_desc(unsigned (&v)[N]) {
#pragma unroll
    for (int p = 1; p < 16; p <<= 1)
#pragma unroll
        for (int k = p; k >= 1; k >>= 1)
#pragma unroll
            for (int j = k % p; j <= 15 - k; j += 2 * k)
#pragma unroll
                for (int i = 0; i < k; ++i)
                    if (i + j + k <= 15 && (i + j) / (2 * p) == (i + j + k) / (2 * p)) ce_desc(v[BASE + i + j], v[BASE + i + j + k]);
}
template <int A, int B, int N> __device__ __forceinline__ void merge_top16(unsigned (&v)[N]) {
#pragma unroll
    for (int i = 0; i < 16; ++i) v[A + i] = kmax(v[A + i], v[B + 15 - i]);
#pragma unroll
    for (int j = 8; j > 0; j >>= 1)
#pragma unroll
        for (int i = 0; i < 16; ++i) { const int l = i ^ j; if (l > i) ce_desc(v[A + i], v[A + l]); }
}
constexpr int KS_STRIDE = 272;
constexpr int RT_KS_BYTES = 256 * KS_STRIDE;
constexpr int RT_TAB_WORDS = 33;
__device__ __forceinline__ void p11_route(const Params& p, LAS unsigned char* lds, int bid, int G, int tid, int wave, int lane) {
    unsigned char* ws = p.ws;
    for (int i = tid; i < 256 * 16; i += NTHREADS) { const int row = i >> 4, ch = i & 15; *(LAS v4u*)(lds + row * KS_STRIDE + ch * 16) = *((const v4u*)(ws + WS_KS) + i); }
    __syncthreads();
    LAS unsigned* tab = (LAS unsigned*)(lds + RT_KS_BYTES) + (wave * 64 + lane) * RT_TAB_WORDS;
    const int r32 = lane & 31, hi = lane >> 5;
    const bf16* PQ = (const bf16*)(ws + WS_PQ);
    unsigned short* IDS = (unsigned short*)(ws + WS_IDS); float* GATES = (float*)(ws + WS_GATES);
    for (int task = bid * 64 + wave; task < (NTOK / 32) * 8; task += ((task & 63) + NWAVES < 64) ? NWAVES : G * 64 - 64 + NWAVES) {
        const int tb = task >> 3, h = task & 7;
        const int token = tb * 32 + r32;
        unsigned v[128];
        {
            const bf16* qrow = PQ + (size_t)token * 2048 + h * 256 + hi * 8;
#pragma unroll
            for (int t = 0; t < 4; ++t) {
                f32x16v acc[2];
#pragma unroll
                for (int w = 0; w < 2; ++w) {
                    f32x16v c = {};
                    const LAS unsigned char* kb = lds + (w * 128 + t * 32 + r32) * KS_STRIDE + hi * 16;
#pragma unroll
                    for (int s = 0; s < 8; ++s) { const bf16x8 a = *(const LAS bf16x8*)(kb + s * 32); const bf16x8 qf = *(const bf16x8*)(qrow + w * 128 + 16 * s); c = __builtin_amdgcn_mfma_f32_32x32x16_bf16(a, qf, c, 0, 0, 0); }
                    acc[w] = c;
                }
#pragma unroll
                for (int r = 0; r < 16; ++r) {
                    const float xa = acc[0][r], xb = acc[1][r];
                    auto rr = __builtin_amdgcn_permlane32_swap(__float_as_uint(xa), __float_as_uint(xb), false, false);
                    const unsigned r0 = rr[0], r1 = rr[1];
                    const int cr = (r & 3) + 8 * (r >> 2);
                    v[t * 16 + r] = (mono(__uint_as_float(r0)) & ~0x7Fu) | (unsigned)(32 * t + cr);
                    v[64 + t * 16 + r] = (mono(__uint_as_float(r1)) & ~0x7Fu) | (unsigned)(32 * t + cr + 4);
                }
            }
        }
        bitonic_sort_desc<0>(v); bitonic_sort_desc<16>(v); bitonic_sort_desc<32>(v); bitonic_sort_desc<48>(v);
        bitonic_sort_desc<64>(v); bitonic_sort_desc<80>(v); bitonic_sort_desc<96>(v); bitonic_sort_desc<112>(v);
        merge_top16<0, 16>(v); merge_top16<32, 48>(v); merge_top16<64, 80>(v); merge_top16<96, 112>(v);
        merge_top16<0, 32>(v); merge_top16<64, 96>(v);
        merge_top16<0, 64>(v);
        unsigned T[16], U[16];
#pragma unroll
        for (int i = 0; i < 16; ++i) { auto rr = __builtin_amdgcn_permlane32_swap(v[i], v[i], false, false); T[i] = v[i]; U[i] = hi ? rr[0] : rr[1]; }
        { const int bT = hi ? 16 : 0, bU = hi ? 0 : 16;
#pragma unroll
          for (int i = 0; i < 16; ++i) { tab[bT + i] = T[i] & 0x7Fu; tab[bU + i] = U[i] & 0x7Fu; } }
        float tv[16], uv[16];
#pragma unroll
        for (int i = 0; i < 16; ++i) { tv[i] = unmono(T[i] & ~0x7Fu); uv[i] = unmono(U[i] & ~0x7Fu); }
        unsigned c[32];
        {
            float uvs[16];
#pragma unroll
            for (int m = 0; m < 16; ++m) uvs[m] = hi ? (m < 15 ? uv[m + 1] : -3.0e38f) : uv[m];
            int n = 0;
#pragma unroll
            for (int i = 0; i < 4; ++i)
#pragma unroll
                for (int j = i; j < 16; ++j) if ((i + 1) * (j + 1) <= 16) {
                    const float s = tv[i] + uvs[j];
                    const unsigned paylo = (unsigned)((i << 4) | j), payhi = (j + 1 < 16) ? (unsigned)(((j + 1) << 4) | i) : 0u;
                    c[n++] = (mono(s) & ~0xFFu) | (hi ? payhi : paylo);
                }
        }
        {
            unsigned x0 = c[23], x1 = c[24], x2 = c[25], y = c[26];
            ce_desc(x2, y); ce_desc(x1, x2); ce_desc(x0, x1);
            c[23] = KEY_NEG_INF; c[24] = KEY_NEG_INF; c[25] = KEY_NEG_INF; c[26] = KEY_NEG_INF; c[27] = KEY_NEG_INF; c[28] = y; c[29] = x2; c[30] = x1; c[31] = x0;
#pragma unroll
            for (int j = 8; j > 0; j >>= 1)
#pragma unroll
                for (int i = 0; i < 16; ++i) { const int l = i ^ j; if (l > i) ce_desc(c[16 + i], c[16 + l]); }
        }
        merge_top16<0, 16>(c);
        unsigned W[32];
#pragma unroll
        for (int i = 0; i < 16; ++i) { auto rr = __builtin_amdgcn_permlane32_swap(c[i], c[i], false, false); W[i] = rr[0]; W[16 + i] = rr[1]; }
        merge_top16<0, 16>(W);
        asm volatile("s_waitcnt lgkmcnt(0)" ::: "memory");
        if (!hi) {
            int ids[16];
#pragma unroll
            for (int k = 0; k < 16; ++k) ids[k] = (int)(tab[(W[k] >> 4) & 15u] * 128u + tab[16 + (W[k] & 15u)]);
            unsigned short* o = IDS + (size_t)token * 128 + h * 16;
#pragma unroll
            for (int k = 0; k < 16; k += 8) *(v4u*)(o + k) = (v4u){(unsigned)ids[k] | ((unsigned)ids[k + 1] << 16), (unsigned)ids[k + 2] | ((unsigned)ids[k + 3] << 16), (unsigned)ids[k + 4] | ((unsigned)ids[k + 5] << 16), (unsigned)ids[k + 6] | ((unsigned)ids[k + 7] << 16)};
        } else {
            float e[16]; const float s0 = unmono(W[0] & ~0xFFu); float sum = 0.f;
#pragma unroll
            for (int k = 0; k < 16; ++k) { e[k] = __expf(unmono(W[k] & ~0xFFu) - s0); sum += e[k]; }
            const float inv = __builtin_amdgcn_rcpf(sum);
            float* o = GATES + (size_t)token * 128 + h * 16;
#pragma unroll
            for (int k = 0; k < 16; k += 4) *(f32x4*)(o + k) = (f32x4){e[k] * inv, e[k + 1] * inv, e[k + 2] * inv, e[k + 3] * inv};
        }
        asm volatile("s_waitcnt lgkmcnt(0)" ::: "memory");
    }
}

constexpr size_t WS_PART = 420 * MiB;
__device__ __forceinline__ int dpp_isum8(int x) {
    x += __builtin_amdgcn_update_dpp(0, x, 0xB1, 0xF, 0xF, true);
    x += __builtin_amdgcn_update_dpp(0, x, 0x4E, 0xF, 0xF, true);
    x += __builtin_amdgcn_update_dpp(0, x, 0x141, 0xF, 0xF, true);
    return x;
}
struct A12Meta { v4u iv0, iv1, xs; };
__device__ __forceinline__ void a12_meta(A12Meta& m, const unsigned short* IDS, const unsigned char* XQ, int t, int eg) {
    const v4u* idp = (const v4u*)(IDS + (size_t)t * 128 + 16 * eg);
    m.iv0 = idp[0]; m.iv1 = idp[1];
    m.xs = *(const v4u*)(XQ + (size_t)t * 1024);
}
__device__ __forceinline__ void a12_rows(const A12Meta& m, const unsigned char* Us, v4u (&u)[16]) {
    int ids[16];
    ids[0] = (int)(m.iv0.x & 0xffffu); ids[1] = (int)(m.iv0.x >> 16); ids[2] = (int)(m.iv0.y & 0xffffu); ids[3] = (int)(m.iv0.y >> 16);
    ids[4] = (int)(m.iv0.z & 0xffffu); ids[5] = (int)(m.iv0.z >> 16); ids[6] = (int)(m.iv0.w & 0xffffu); ids[7] = (int)(m.iv0.w >> 16);
    ids[8] = (int)(m.iv1.x & 0xffffu); ids[9] = (int)(m.iv1.x >> 16); ids[10] = (int)(m.iv1.y & 0xffffu); ids[11] = (int)(m.iv1.y >> 16);
    ids[12] = (int)(m.iv1.z & 0xffffu); ids[13] = (int)(m.iv1.z >> 16); ids[14] = (int)(m.iv1.w & 0xffffu); ids[15] = (int)(m.iv1.w >> 16);
#pragma unroll
    for (int i = 0; i < 16; ++i) u[i] = *(const v4u*)(Us + (size_t)ids[i] * 1024);
}
__device__ __forceinline__ unsigned a12_compute(const v4u (&u)[16], const v4u xs, const int cj) {
    const int xx = (int)xs.x, xy = (int)xs.y, xz = (int)xs.z, xw = (int)xs.w;
    int k0 = 0, k1 = 0;
#pragma unroll
    for (int i = 0; i < 16; ++i) {
        const int ux = (int)u[i].x, uy = (int)u[i].y, uz = (int)u[i].z, uw = (int)u[i].w;
        int d = __builtin_amdgcn_sdot4(ux, xx, 0, false); d = __builtin_amdgcn_sdot4(uy, xy, d, false); d = __builtin_amdgcn_sdot4(uz, xz, d, false); d = __builtin_amdgcn_sdot4(uw, xw, d, false);
        d = dpp_isum8(d);
        if (i < 8) k0 = (cj == i) ? d : k0; else k1 = (cj == i - 8) ? d : k1;
    }
    return pk2((float)k0, (float)k1);
}
__device__ __forceinline__ void p12a_partial(const Params& p, int bid, int G, int wave, int lane) {
    unsigned char* ws = p.ws;
    const int s = bid & 7, wx = (bid >> 3) * NWAVES + wave, NWX = (G >> 3) * NWAVES;
    const int eg = lane >> 3, cj = lane & 7;
    const unsigned char* XQ = ws + WS_XQ + 128 * s + 16 * cj; const unsigned short* IDS = (const unsigned short*)(ws + WS_IDS);
    const unsigned char* Us = ws + WS_U8 + 128 * s + 16 * cj;
    unsigned* outp = (unsigned*)((bf16*)(ws + WS_PART) + (size_t)s * NTOK * 128 + 16 * eg + 2 * cj);
    if (wx >= NTOK) return;
    A12Meta m0, m1; v4u va[16], vb[16];
    a12_meta(m0, IDS, XQ, wx, eg);
    a12_rows(m0, Us, va);
    { int tn = (wx + NWX < NTOK) ? wx + NWX : wx; asm volatile("" : "+s"(tn)); a12_meta(m1, IDS, XQ, tn, eg); }
    __builtin_amdgcn_sched_barrier(0);
    unsigned res_prev = 0u; int t_prev = wx;
    for (int t = wx; t < NTOK; t += 2 * NWX) {
        {
            a12_rows(m1, Us, vb);
            __builtin_nontemporal_store(res_prev, outp + (size_t)t_prev * 64);
            const v4u cx = m0.xs;
            { int tn = (t + 2 * NWX < NTOK) ? t + 2 * NWX : t; asm volatile("" : "+s"(tn)); a12_meta(m0, IDS, XQ, tn, eg); }
            __builtin_amdgcn_sched_barrier(0);
            res_prev = a12_compute(va, cx, cj); t_prev = t;
        }
        if (t + NWX < NTOK) {
            a12_rows(m0, Us, va);
            __builtin_nontemporal_store(res_prev, outp + (size_t)t_prev * 64);
            const v4u cx = m1.xs;
            { int tn = (t + 3 * NWX < NTOK) ? t + 3 * NWX : t; asm volatile("" : "+s"(tn)); a12_meta(m1, IDS, XQ, tn, eg); }
            __builtin_amdgcn_sched_barrier(0);
            res_prev = a12_compute(vb, cx, cj); t_prev = t + NWX;
        }
    }
    __builtin_nontemporal_store(res_prev, outp + (size_t)t_prev * 64);
}
constexpr size_t WS_WQ = 84 * MiB;
constexpr size_t WS_WSC = 92 * MiB;
__device__ __forceinline__ float dpp_max16(float x) {
    x = fmaxf(x, __builtin_bit_cast(float, __builtin_amdgcn_update_dpp(0, __builtin_bit_cast(int, x), 0xB1, 0xF, 0xF, true)));
    x = fmaxf(x, __builtin_bit_cast(float, __builtin_amdgcn_update_dpp(0, __builtin_bit_cast(int, x), 0x4E, 0xF, 0xF, true)));
    x = fmaxf(x, __builtin_bit_cast(float, __builtin_amdgcn_update_dpp(0, __builtin_bit_cast(int, x), 0x141, 0xF, 0xF, true)));
    x = fmaxf(x, __builtin_bit_cast(float, __builtin_amdgcn_update_dpp(0, __builtin_bit_cast(int, x), 0x140, 0xF, 0xF, true)));
    return x;
}
__device__ __forceinline__ void p12b_combine(const Params& p, LAS unsigned char* lds, int vcu, int G, int tid, int wave, int lane) {
    unsigned char* ws = p.ws;
    const int gw = vcu * NWAVES + wave, NGW = G * NWAVES;
    const bf16* PART = (const bf16*)(ws + WS_PART); const float* GW = (const float*)(ws + WS_GATES); const unsigned short* IDS = (const unsigned short*)(ws + WS_IDS);
    LAS const float* SU = (LAS const float*)lds; LAS const float* SV = SU + 16384;
    for (int i = tid; i < 8192; i += NTHREADS) { const int tb = i >> 12, q = i & 4095; *((LAS f32x4*)lds + i) = *((const f32x4*)(ws + (tb ? WS_SV : WS_SU)) + q); }
    __syncthreads();
    const int hh = lane >> 3, e0 = 16 * hh + (lane & 7), e1 = e0 + 8;
    constexpr int NT = 8;
    for (int t0 = gw; t0 < NTOK; t0 += NT * NGW) {
        float a0[NT], a1[NT], g0[NT], g1[NT], sx[NT]; int id0[NT], id1[NT];
#pragma unroll
        for (int r = 0; r < NT; ++r) { const int t = t0 + r * NGW;
            const int tt = t < NTOK ? t : gw;
            a0[r] = 0.f; a1[r] = 0.f;
#pragma unroll
            for (int s = 0; s < 8; ++s) { const unsigned w = *((const unsigned*)(PART + ((size_t)s * NTOK + tt) * 128) + lane); a0[r] += bflo(w); a1[r] += bfhi(w); }
            id0[r] = IDS[(size_t)tt * 128 + e0]; id1[r] = IDS[(size_t)tt * 128 + e1];
            sx[r] = ((const float*)(ws + WS_SX))[tt]; g0[r] = GW[(size_t)tt * 128 + e0]; g1[r] = GW[(size_t)tt * 128 + e1]; }
#pragma unroll
        for (int r = 0; r < NT; ++r) { const int t = t0 + r * NGW; if (t >= NTOK) continue;
            const float h0 = a0[r] * SU[id0[r]] * sx[r], h1 = a1[r] * SU[id1[r]] * sx[r];
            const float w0 = g0[r] * 0.5f * h0 * (1.0f + erff(h0 * 0.70710678118654752f)) * SV[id0[r]];
            const float w1 = g1[r] * 0.5f * h1 * (1.0f + erff(h1 * 0.70710678118654752f)) * SV[id1[r]];
            float mx = fmaxf(fabsf(w0), fabsf(w1));
            mx = fmaxf(mx, dppf<0xB1>(mx)); mx = fmaxf(mx, dppf<0x4E>(mx)); mx = fmaxf(mx, dppf<0x141>(mx));
            const float iq = mx > 0.f ? 127.0f * __builtin_amdgcn_rcpf(mx) : 0.f;
            signed char* wq = (signed char*)(ws + WS_WQ) + (size_t)t * 128;
            wq[e0] = (signed char)(int)rintf(w0 * iq); wq[e1] = (signed char)(int)rintf(w1 * iq);
            if ((lane & 7) == 0) ((float*)(ws + WS_WSC))[(size_t)t * 8 + hh] = mx * (1.0f / 127.0f); }
    }
}
struct C12Meta { v4u iv0, iv1, wqv; float wsc; unsigned hb; };
__device__ __forceinline__ void c12_meta(C12Meta& m, const unsigned short* IDS, const unsigned char* WQ, const float* WSC, const unsigned char* ws, int t, int eg, int ocol) {
    const v4u* idp = (const v4u*)(IDS + (size_t)t * 128 + 16 * eg);
    m.iv0 = idp[0]; m.iv1 = idp[1];
    m.wqv = *(const v4u*)(WQ + (size_t)t * 128 + 16 * eg);
    m.wsc = WSC[(size_t)t * 8 + eg];
    m.hb = *(const unsigned*)((const bf16*)(ws + WS_H1) + (size_t)t * 1024 + ocol);
}
__device__ __forceinline__ void c12_rows(const C12Meta& m, const unsigned char* Vs, v4u (&vv)[16]) {
    int ids[16];
    ids[0] = (int)(m.iv0.x & 0xffffu); ids[1] = (int)(m.iv0.x >> 16); ids[2] = (int)(m.iv0.y & 0xffffu); ids[3] = (int)(m.iv0.y >> 16);
    ids[4] = (int)(m.iv0.z & 0xffffu); ids[5] = (int)(m.iv0.z >> 16); ids[6] = (int)(m.iv0.w & 0xffffu); ids[7] = (int)(m.iv0.w >> 16);
    ids[8] = (int)(m.iv1.x & 0xffffu); ids[9] = (int)(m.iv1.x >> 16); ids[10] = (int)(m.iv1.y & 0xffffu); ids[11] = (int)(m.iv1.y >> 16);
    ids[12] = (int)(m.iv1.z & 0xffffu); ids[13] = (int)(m.iv1.z >> 16); ids[14] = (int)(m.iv1.w & 0xffffu); ids[15] = (int)(m.iv1.w >> 16);
    const unsigned wd[4] = {m.wqv.x, m.wqv.y, m.wqv.z, m.wqv.w};
#pragma unroll
    for (int i = 0; i < 16; ++i) { const unsigned wb = (wd[i >> 2] >> (8 * (i & 3))) & 0xffu; const int id = wb ? ids[i] : 0; vv[i] = *(const v4u*)(Vs + (size_t)id * 1024); }
}
typedef float c12f2 __attribute__((ext_vector_type(2)));
__device__ __forceinline__ c12f2 c12_compute(const v4u (&vv)[16], const v4u wqv, const float wsc, const unsigned hb, const int b3) {
    int acc[16];
#pragma unroll
    for (int k = 0; k < 16; ++k) acc[k] = 0;
    const unsigned wqd[4] = {wqv.x, wqv.y, wqv.z, wqv.w};
#pragma unroll
    for (int j = 0; j < 4; ++j) {
        const unsigned r0[4] = {vv[4 * j].x, vv[4 * j].y, vv[4 * j].z, vv[4 * j].w}, r1[4] = {vv[4 * j + 1].x, vv[4 * j + 1].y, vv[4 * j + 1].z, vv[4 * j + 1].w};
        const unsigned r2[4] = {vv[4 * j + 2].x, vv[4 * j + 2].y, vv[4 * j + 2].z, vv[4 * j + 2].w}, r3[4] = {vv[4 * j + 3].x, vv[4 * j + 3].y, vv[4 * j + 3].z, vv[4 * j + 3].w};
#pragma unroll
        for (int d = 0; d < 4; ++d) {
            const unsigned l01 = __builtin_amdgcn_perm(r1[d], r0[d], 0x05010400u), h01 = __builtin_amdgcn_perm(r1[d], r0[d], 0x07030602u);
            const unsigned l23 = __builtin_amdgcn_perm(r3[d], r2[d], 0x05010400u), h23 = __builtin_amdgcn_perm(r3[d], r2[d], 0x07030602u);
            const unsigned c0 = __builtin_amdgcn_perm(l23, l01, 0x05040100u), c1 = __builtin_amdgcn_perm(l23, l01, 0x07060302u);
            const unsigned c2 = __builtin_amdgcn_perm(h23, h01, 0x05040100u), c3 = __builtin_amdgcn_perm(h23, h01, 0x07060302u);
            acc[4 * d + 0] = __builtin_amdgcn_sdot4((int)c0, (int)wqd[j], acc[4 * d + 0], false); acc[4 * d + 1] = __builtin_amdgcn_sdot4((int)c1, (int)wqd[j], acc[4 * d + 1], false);
            acc[4 * d + 2] = __builtin_amdgcn_sdot4((int)c2, (int)wqd[j], acc[4 * d + 2], false); acc[4 * d + 3] = __builtin_amdgcn_sdot4((int)c3, (int)wqd[j], acc[4 * d + 3], false);
        }
    }
    float o[16];
#pragma unroll
    for (int k = 0; k < 16; ++k) o[k] = (float)acc[k] * wsc;
    float r8[8], r4[4], r2v[2];
#pragma unroll
    for (int j = 0; j < 8; ++j) { auto rr = __builtin_amdgcn_permlane32_swap(__float_as_uint(o[j]), __float_as_uint(o[8 + j]), false, false); r8[j] = __uint_as_float(rr[0]) + __uint_as_float(rr[1]); }
#pragma unroll
    for (int j = 0; j < 4; ++j) { auto rr = __builtin_amdgcn_permlane16_swap(__float_as_uint(r8[j]), __float_as_uint(r8[4 + j]), false, false); r4[j] = __uint_as_float(rr[0]) + __uint_as_float(rr[1]); }
#pragma unroll
    for (int j = 0; j < 2; ++j) { const float keep = b3 ? r4[2 + j] : r4[j], send = b3 ? r4[j] : r4[2 + j]; r2v[j] = keep + __uint_as_float(__builtin_amdgcn_update_dpp(0u, __float_as_uint(send), 0x128, 0xF, 0xF, true)); }
    return (c12f2){bflo(hb) + r2v[0], bfhi(hb) + r2v[1]};
}
template <bool DRY> __device__ __forceinline__ void p12c_output(const Params& p, int bid, int G, int wave, int lane) {
    unsigned char* ws = p.ws;
    const int s = bid & 7, wx = (bid >> 3) * NWAVES + wave, NWX = (G >> 3) * NWAVES;
    const int eg = lane >> 3, cj = lane & 7;
    const int b5 = (lane >> 5) & 1, b4 = (lane >> 4) & 1, b3 = (lane >> 3) & 1;
    const unsigned short* IDS = (const unsigned short*)(ws + WS_IDS); const unsigned char* WQ = ws + WS_WQ; const float* WSC = (const float*)(ws + WS_WSC);
    const unsigned char* Vs = ws + WS_V8 + 128 * s + 16 * cj;
    const int ocol = 128 * s + 16 * cj + 8 * b5 + 4 * b4 + 2 * b3;
    float* outp = (DRY ? (float*)(ws + WS_PART) : p.out) + ocol;
    if (wx >= NTOK) return;
    C12Meta m0, m1; v4u va[16], vb[16];
    c12_meta(m0, IDS, WQ, WSC, ws, wx, eg, ocol);
    c12_rows(m0, Vs, va);
    { int tn = (wx + NWX < NTOK) ? wx + NWX : wx; asm volatile("" : "+s"(tn)); c12_meta(m1, IDS, WQ, WSC, ws, tn, eg, ocol); }
    __builtin_amdgcn_sched_barrier(0);
    c12f2 res_prev = {0.f, 0.f}; int t_prev = wx;
    for (int t = wx; t < NTOK; t += 2 * NWX) {
        {
            c12_rows(m1, Vs, vb);
            __builtin_nontemporal_store(res_prev, (c12f2*)(outp + (size_t)t_prev * 1024));
            const v4u cw = m0.wqv; const float cs = m0.wsc; const unsigned ch = m0.hb;
            { int tn = (t + 2 * NWX < NTOK) ? t + 2 * NWX : t; asm volatile("" : "+s"(tn)); c12_meta(m0, IDS, WQ, WSC, ws, tn, eg, ocol); }
            __builtin_amdgcn_sched_barrier(0);
            res_prev = c12_compute(va, cw, cs, ch, b3); t_prev = t;
        }
        if (t + NWX < NTOK) {
            c12_rows(m0, Vs, va);
            __builtin_nontemporal_store(res_prev, (c12f2*)(outp + (size_t)t_prev * 1024));
            const v4u cw = m1.wqv; const float cs = m1.wsc; const unsigned ch = m1.hb;
            { int tn = (t + 3 * NWX < NTOK) ? t + 3 * NWX : t; asm volatile("" : "+s"(tn)); c12_meta(m1, IDS, WQ, WSC, ws, tn, eg, ocol); }
            __builtin_amdgcn_sched_barrier(0);
            res_prev = c12_compute(vb, cw, cs, ch, b3); t_prev = t + NWX;
        }
    }
    __builtin_nontemporal_store(res_prev, (c12f2*)(outp + (size_t)t_prev * 1024));
}

#if DIAG
constexpr size_t WS_DIAG = 1006 * MiB;
constexpr size_t WS_DSAVE = 1007 * MiB;
__device__ __forceinline__ unsigned dhash(unsigned x) { x ^= x >> 16; x *= 0x7feb352dU; x ^= x >> 15; x *= 0x846ca68bU; x ^= x >> 16; return x; }
__device__ __forceinline__ float bf2f(bf16 b) { return __builtin_bit_cast(float, (unsigned)b << 16); }
__device__ __forceinline__ float rbf(float x) { return bf2f((bf16)f2bf(x)); }
__device__ __forceinline__ void diag_report(const Params& p, int stage, float err) {
    if (!(err == err)) err = 1e30f;
#pragma unroll
    for (int o = 1; o < 64; o <<= 1) err = fmaxf(err, __shfl_xor(err, o));
    int t_ = threadIdx.x; asm volatile("" : "+v"(t_)); if ((t_ & 63) == 0) atomicMax((unsigned*)(p.ws + WS_DIAG) + stage, __builtin_bit_cast(unsigned, err));
}
#define DG_IDS() int tid_ = threadIdx.x; asm volatile("" : "+v"(tid_)); const int tid = tid_, lane = tid & 63; int G_ = gridDim.x; asm volatile("" : "+s"(G_)); const int gt = blockIdx.x * NTHREADS + tid, NGT = G_ * NTHREADS; const int gwv = gt >> 6, NGWV = NGT >> 6; (void)lane; (void)gwv; (void)NGWV; (void)NGT
__device__ __forceinline__ float relerr(float got, float ref, float fl) { return fabsf(got - ref) / (fabsf(ref) + fl); }

__device__ __forceinline__ void dg_p0(const Params& p) {
    DG_IDS(); unsigned char* ws = p.ws; float e1 = 0.f, e2 = 0.f;
    for (int s = gwv; s < 4096; s += NGWV) {
        const int m = dhash(s * 7 + 1) % R; const int b = m / TP, pp = m - b * TP;
        const bf16* xn = (const bf16*)(ws + WS_XN) + (size_t)m * 1024;
        if (pp < 48) { for (int c = lane; c < 1024; c += 64) e1 = fmaxf(e1, fabsf(bf2f(xn[c]))); continue; }
        const float* xr = (pp < 64) ? p.in[I_META] + (size_t)(pp - 48) * 1024 : p.in[I_X] + ((size_t)b * SEQ + (pp - 64)) * 1024;
        float ss = 0.f; for (int c = lane; c < 1024; c += 64) ss += xr[c] * xr[c];
        ss = wave_sum(ss); const float rs = 1.0f / sqrtf(ss / 1024.f + NORM_EPS);
        for (int c = lane; c < 1024; c += 64) e1 = fmaxf(e1, relerr(bf2f(xn[c]), xr[c] * rs * p.in[I_N1G][c], 0.05f));
    }
    for (int s = gt; s < 200000; s += NGT) {
        const unsigned hsh = dhash(s * 3 + 5); const int k = hsh & 1023, n = (hsh >> 10) % N1; const int sc = win_src_col(n);
        const float ref = sc >= 0 ? p.in[I_WIN][(size_t)k * IN_COLS + sc] : 0.f;
        e2 = fmaxf(e2, fabsf(bf2f(((const bf16*)(ws + WS_WTIN))[(size_t)n * 1024 + k]) - rbf(ref)));
        const int n2 = (hsh >> 10) & 2047;
        e2 = fmaxf(e2, fabsf(bf2f(((const bf16*)(ws + WS_WTQ))[(size_t)n2 * 1024 + k]) - rbf(p.in[I_PWQ][(size_t)k * 2048 + n2])));
        const int n3 = n2 & 1023, k3 = k & 511;
        e2 = fmaxf(e2, fabsf(bf2f(((const bf16*)(ws + WS_WTFOX))[(size_t)n3 * 512 + k3]) - rbf(p.in[I_WFOX][(size_t)k3 * 1024 + n3])));
        e2 = fmaxf(e2, fabsf(bf2f(((const bf16*)(ws + WS_WTRWKV))[(size_t)n3 * 512 + k3]) - rbf(p.in[I_WRWKV][(size_t)k3 * 1024 + n3])));
        e2 = fmaxf(e2, fabsf(bf2f(((const bf16*)(ws + WS_WTOUT))[(size_t)n3 * 1024 + k]) - rbf(p.in[I_WOUT][(size_t)k * 1024 + n3])));
        const size_t ei = (size_t)(hsh % (16384u * 1024u)); const int er = (int)(ei >> 10);
        { const float sc = ((const float*)(ws + WS_SU))[er]; const float dq = (float)((const signed char*)(ws + WS_U8))[ei] * sc; e2 = fmaxf(e2, fmaxf(fabsf(dq - p.in[I_PU][ei]) - 0.51f * sc, 0.f)); }
        { const float sc = ((const float*)(ws + WS_SV))[er]; const float dq = ((float)((const unsigned char*)(ws + WS_V8))[ei] - 128.f) * sc; e2 = fmaxf(e2, fmaxf(fabsf(dq - p.in[I_PV][ei]) - 0.51f * sc, 0.f)); }
    }
    diag_report(p, 1, e1 / 0.03f); diag_report(p, 2, e2 / 1e-6f);
}
__device__ __forceinline__ float dg_dot(const bf16* A, size_t row, const bf16* Bt, size_t n, int K) {
    const bf16* a = A + row * K; const bf16* b = Bt + n * K; float s = 0.f;
    for (int k = 0; k < K; k += 8) { float x[8], y[8]; unpack8(*(const v4u*)(a + k), x); unpack8(*(const v4u*)(b + k), y);
#pragma unroll
        for (int e = 0; e < 8; ++e) s = fmaf(x[e], y[e], s); }
    return s;
}
__device__ __forceinline__ void dg_gemm1(const Params& p) {
    DG_IDS(); unsigned char* ws = p.ws; float e = 0.f;
    for (int s = gt; s < 262144; s += NGT) {
        const unsigned hsh = dhash(s * 11 + 3); const int row = hsh % R, n = dhash(hsh) % N1;
        const float ref = dg_dot((const bf16*)(ws + WS_XN), row, (const bf16*)(ws + WS_WTIN), n, 1024);
        float got, want;
        if (n < 3584) { got = bf2f(((const bf16*)(ws + WS_F))[(size_t)(n >> 9) * ((size_t)R * 512) + (size_t)row * 512 + (n & 511)]); want = ref; }
        else { got = bf2f(((const bf16*)(ws + WS_ZG))[(size_t)row * 2048 + (n - 3584)]); want = 1.0f / (1.0f + expf(-ref)); }
        e = fmaxf(e, relerr(got, want, 0.25f));
    }
    diag_report(p, 3, e / 0.02f);
}
__device__ __forceinline__ void dg_p2(const Params& p) {
    DG_IDS(); unsigned char* ws = p.ws; float e = 0.f;
    for (int s = gt; s < 262144; s += NGT) {
        const unsigned hsh = dhash(s * 13 + 7); const int m = hsh % R, c = dhash(hsh) % 296; const int pp = m % TP;
        const bf16* zm = (const bf16*)(ws + WS_ZM);
        const float z = bf2f(zm[(size_t)m * 512 + c]);
        if (c >= 288) { const float x = z + p.in[I_FBIAS][c - 288]; const float want = -log1pf(expf(-x)); e = fmaxf(e, relerr(((const float*)(ws + WS_LF))[(size_t)m * 8 + (c - 288)], want, 0.01f)); continue; }
        const float zp = pp > 0 ? bf2f(zm[(size_t)(m - 1) * 512 + c]) : 0.f; const float mu = p.in[I_MU][1536 + c];
        const float zs = z + mu * (zp - z);
        if (c < 64) e = fmaxf(e, relerr(bf2f(((const bf16*)(ws + WS_LA))[(size_t)m * 128 + c]), tanhf(zs), 0.1f));
        else if (c < 128) e = fmaxf(e, relerr(bf2f(((const bf16*)(ws + WS_LA))[(size_t)m * 128 + c]), zs, 0.1f));
        else e = fmaxf(e, relerr(bf2f(((const bf16*)(ws + WS_LG))[(size_t)m * 256 + (c - 128)]), 1.0f / (1.0f + expf(-zs)), 0.1f));
        if (pp >= 48) { const int h = c & 7; float sq = 0.f, sk = 0.f;
            for (int d = 0; d < 64; ++d) { const float q = bf2f(((const bf16*)(ws + WS_FQ))[(size_t)m * 512 + h * 64 + d]) / (p.in[I_FQN][h * 64 + d] * attn_body::C2); sq += q * q;
                const float k = bf2f(((const bf16*)(ws + WS_FK))[(size_t)m * 512 + h * 64 + d]) / p.in[I_FKN][h * 64 + d]; sk += k * k; }
            e = fmaxf(e, fabsf(sq / 64.f - 1.f)); e = fmaxf(e, fabsf(sk / 64.f - 1.f)); }
    }
    diag_report(p, 4, e / 0.03f);
}
__device__ __forceinline__ void dg_p3(const Params& p) {
    DG_IDS(); unsigned char* ws = p.ws; unsigned char* dob = (unsigned char*)p.out; float e5 = 0.f, e6 = 0.f;
    for (int s = gt; s < 131072; s += NGT) {
        const unsigned hsh = dhash(s * 17 + 9); const int seq = hsh & 127, pp = (hsh >> 7) % TP; const int b = seq >> 3, h = seq & 7;
        const float* kb = (const float*)(ws + WS_KB) + (size_t)seq * TP; const float lf = ((const float*)(ws + WS_LF))[((size_t)b * TP + pp) * 8 + h];
        if (pp < 48) e5 = fmaxf(e5, kb[pp] < -1e29f ? 0.f : 1.f);
        else if (pp == 48) e5 = fmaxf(e5, fabsf(kb[pp] + lf * LOG2E));
        else e5 = fmaxf(e5, fabsf((kb[pp] - kb[pp - 1]) + lf * LOG2E));
        const int m = dhash(hsh) % R, c = dhash(hsh + 1) % 1536;
        const bf16* la = (const bf16*)(ws + WS_LA) + (size_t)m * 128; const bf16* lg = (const bf16*)(ws + WS_LG) + (size_t)m * 256;
        if (c < 512) { float a = p.in[I_W0][c]; for (int k = 0; k < 64; ++k) a += bf2f(la[k]) * rbf(p.in[I_WUP][k * 512 + c]);
            const float w = -log1pf(expf(-a)) - 0.5f; const float want = 1.0f - expf(-expf(w));
            e6 = fmaxf(e6, relerr(bf2f(((const bf16*)(dob + DO_XW))[(size_t)m * 512 + c]), want, 0.002f)); }
        else if (c < 1024) { float a = p.in[I_A0][c - 512]; for (int k = 0; k < 64; ++k) a += bf2f(la[64 + k]) * rbf(p.in[I_AUP][k * 512 + (c - 512)]);
            e6 = fmaxf(e6, relerr(bf2f(((const bf16*)(dob + DO_AA))[(size_t)m * 512 + (c - 512)]), 1.0f / (1.0f + expf(-a)), 0.05f)); }
        else { float a = 0.f; for (int k = 0; k < 160; ++k) a += bf2f(lg[k]) * rbf(p.in[I_GUP][k * 512 + (c - 1024)]);
            e6 = fmaxf(e6, relerr(bf2f(((const bf16*)(dob + DO_GG))[(size_t)m * 512 + (c - 1024)]), a, 0.1f)); }
    }
    diag_report(p, 5, e5 / 1e-3f); diag_report(p, 6, e6 / 0.03f);
}
constexpr int DG_NS4 = 2048;
__device__ __forceinline__ void dg_p4_pre(const Params& p) {
    DG_IDS(); unsigned char* dob = (unsigned char*)p.out; float* sv = (float*)(p.ws + WS_DSAVE);
    for (int s = gt; s < DG_NS4 * 64; s += NGT) { const int i = s >> 6, d = s & 63; const unsigned hsh = dhash(i * 19 + 11); const int m = hsh % R, h = (hsh >> 20) & 7;
        sv[s] = bf2f(((const bf16*)(dob + DO_AA))[(size_t)m * 512 + h * 64 + d]); }
}
__device__ __forceinline__ void dg_p4_post(const Params& p) {
    DG_IDS(); unsigned char* ws = p.ws; unsigned char* dob = (unsigned char*)p.out; const float* sv = (const float*)(ws + WS_DSAVE); float e = 0.f;
    for (int i = gwv; i < DG_NS4; i += NGWV) {
        const unsigned hsh = dhash(i * 19 + 11); const int m = hsh % R, h = (hsh >> 20) & 7; const int pp = m % TP; const int c = h * 64 + lane;
        const float a = sv[i * 64 + lane];
        const float r0 = bf2f(((const bf16*)(ws + WS_ZRR))[(size_t)m * 512 + c]), k0 = bf2f(((const bf16*)(ws + WS_ZRK))[(size_t)m * 512 + c]);
        const float r1 = pp > 0 ? bf2f(((const bf16*)(ws + WS_ZRR))[(size_t)(m - 1) * 512 + c]) : 0.f, k1 = pp > 0 ? bf2f(((const bf16*)(ws + WS_ZRK))[(size_t)(m - 1) * 512 + c]) : 0.f;
        const float rs = r0 + p.in[I_MU][c] * (r1 - r0), ks = k0 + p.in[I_MU][512 + c] * (k1 - k0);
        const float kk = ks * p.in[I_KK][c], kp = ks * (1.0f + (a - 1.0f) * p.in[I_KA][c]);
        const float nrm = fmaxf(sqrtf(wave_sum(kk * kk)), 1e-12f); const float kn = kk / nrm, bb = kn * a; const float bs = wave_sum(rs * kp * p.in[I_RK][c]);
        e = fmaxf(e, relerr(bf2f(((const bf16*)(ws + WS_KP))[(size_t)m * 512 + c]), kp, 0.1f));
        e = fmaxf(e, relerr(bf2f(((const bf16*)(ws + WS_KN))[(size_t)m * 512 + c]), kn, 0.02f));
        e = fmaxf(e, relerr(bf2f(((const bf16*)(dob + DO_AA))[(size_t)m * 512 + c]), bb, 0.02f));
        e = fmaxf(e, relerr(((const float*)(ws + WS_BS))[(size_t)m * 8 + h], bs, 0.1f));
    }
    diag_report(p, 7, e / 0.03f);
}
constexpr int DG_NS8 = 1024;
__device__ __forceinline__ void dg_attn_sample(int i, int& b, int& h, int& t) { const unsigned hsh = dhash(i * 23 + 13); b = hsh & 15; h = (hsh >> 4) & 7; t = (hsh >> 8) & 4095; if (i < 8) t = (i & 1) ? 4095 - (i >> 1) : (i >> 1); }
__device__ __forceinline__ void dg_attn_pre(const Params& p) {
    DG_IDS(); float* sv = (float*)(p.ws + WS_DSAVE + 512 * 1024);
    for (int s = gt; s < DG_NS8 * 64; s += NGT) { const int i = s >> 6, d = s & 63; int b, h, t; dg_attn_sample(i, b, h, t);
        sv[s] = bf2f(((const bf16*)(p.ws + WS_FQ))[((size_t)b * TP + 64 + t) * 512 + h * 64 + d]); }
}
__device__ __forceinline__ void dg_attn_post(const Params& p) {
    DG_IDS(); unsigned char* ws = p.ws; const float* sv = (const float*)(ws + WS_DSAVE + 512 * 1024); float e = 0.f;
    for (int i = gwv; i < DG_NS8; i += NGWV) {
        int b, h, t; dg_attn_sample(i, b, h, t);
        const int npos = 64 + t;
        const float* kb = (const float*)(ws + WS_KB) + (size_t)(b * 8 + h) * TP;
        const bf16* K = (const bf16*)(ws + WS_FK) + (size_t)b * TP * 512 + h * 64; const bf16* V = (const bf16*)(ws + WS_FV) + (size_t)b * TP * 512 + h * 64;
        float mx = -1e38f;
        for (int j = 48 + lane; j <= npos; j += 64) { float s = 0.f; for (int d = 0; d < 64; ++d) s += sv[i * 64 + d] * bf2f(K[(size_t)j * 512 + d]); s += kb[j]; mx = fmaxf(mx, s); }
        for (int o = 1; o < 64; o <<= 1) mx = fmaxf(mx, __shfl_xor(mx, o));
        float l = 0.f, acc = 0.f;
        for (int j = 48; j <= npos; ++j) { float s = 0.f; for (int d = 0; d < 64; ++d) s += sv[i * 64 + d] * bf2f(K[(size_t)j * 512 + d]); const float pj = exp2f(s + kb[j] - mx); l += pj; acc += pj * bf2f(V[(size_t)j * 512 + lane]); }
        const float want = acc / l; const float got = bf2f(((const bf16*)(ws + WS_FQ))[((size_t)b * TP + 64 + t) * 512 + h * 64 + lane]);
        e = fmaxf(e, fabsf(got - want) / (fabsf(want) + 0.05f));
    }
    diag_report(p, 8, e / 0.05f);
}
__device__ __forceinline__ void dg_scan(const Params& p, LAS unsigned char* lds) {
    DG_IDS(); unsigned char* ws = p.ws; unsigned char* dob = (unsigned char*)p.out; float e = 0.f;
    if (gwv < 4) {
        const int bh = (gwv * 37 + 5) & 127, b = bh >> 3, h = bh & 7; const size_t rowb = (size_t)b * TP; const int cb = h * 64;
        LAS float* S = (LAS float*)lds + (gwv * 64 + lane) * 65;
        for (int k = 0; k < 64; ++k) S[k] = 0.f;
        const bf16* aXW = (const bf16*)(dob + DO_XW); const bf16* aA = (const bf16*)(dob + DO_AA); const bf16* aG = (const bf16*)(dob + DO_GG);
        const bf16* aR = (const bf16*)(ws + WS_ZRR); const bf16* aK = (const bf16*)(ws + WS_ZRK); const bf16* aV = (const bf16*)(ws + WS_ZRV);
        const float muv = p.in[I_MU][1024 + cb + lane];
#ifndef DG_SCAN_MAXPP
#define DG_SCAN_MAXPP TP
#endif
#pragma unroll 1
        for (int pp = 48; pp < DG_SCAN_MAXPP; ++pp) {
            const size_t ro = (rowb + pp) * 512 + cb;
            const float v0 = bf2f(aV[ro + lane]), v1 = bf2f(aV[ro - 512 + lane]); const float vv = v0 + muv * (v1 - v0);
            float ss = 0.f;
#pragma unroll 2
            for (int k = 0; k < 64; ++k) { const float k0 = bf2f(aK[ro + k]), k1 = bf2f(aK[ro - 512 + k]); const float ks = k0 + p.in[I_MU][512 + cb + k] * (k1 - k0); const float kk = ks * p.in[I_KK][cb + k]; ss += kk * kk; }
            const float inv = 1.0f / fmaxf(sqrtf(ss), 1e-12f);
            float sa = 0.f;
#pragma unroll 2
            for (int k = 0; k < 64; ++k) { const float k0 = bf2f(aK[ro + k]), k1 = bf2f(aK[ro - 512 + k]); const float ks = k0 + p.in[I_MU][512 + cb + k] * (k1 - k0); sa += S[k] * (ks * p.in[I_KK][cb + k] * inv); }
            sa = -sa; float y = 0.f, bon = 0.f;
#pragma unroll 2
            for (int k = 0; k < 64; ++k) { const float k0 = bf2f(aK[ro + k]), k1 = bf2f(aK[ro - 512 + k]); const float ks = k0 + p.in[I_MU][512 + cb + k] * (k1 - k0); const float a = bf2f(aA[ro + k]);
                const float kn = ks * p.in[I_KK][cb + k] * inv, kp = ks * (1.0f + (a - 1.0f) * p.in[I_KA][cb + k]);
                const float dec = 1.0f - bf2f(aXW[ro + k]); const float sn = S[k] * dec + sa * (kn * a) + vv * kp; S[k] = sn;
                const float r0 = bf2f(aR[ro + k]), r1 = bf2f(aR[ro - 512 + k]); const float rs = r0 + p.in[I_MU][cb + k] * (r1 - r0); y += sn * rs; bon += rs * kp * p.in[I_RK][cb + k]; }
            const float mean = wave_sum(y) * (1.f / 64.f); const float var = wave_sum((y - mean) * (y - mean)) * (1.f / 64.f);
            const float want = ((y - mean) / sqrtf(var + GN_EPS) * p.in[I_LNG][cb + lane] + p.in[I_LNB][cb + lane] + bon * vv) * bf2f(aG[ro + lane]);
            const float got = bf2f(((const bf16*)(ws + WS_Y))[ro + lane]);
            const float rms = sqrtf(wave_sum(want * want) * (1.f / 64.f));
            e = fmaxf(e, fabsf(got - want) / (fabsf(want) + 0.5f * rms + 0.02f));
        }
    }
    diag_report(p, 9, e / 0.15f);
}
__device__ __forceinline__ void dg_p6_pre(const Params& p) {
    DG_IDS(); float* sv = (float*)(p.ws + WS_DSAVE + 768 * 1024);
    for (int s = gt; s < DG_NS4 * 64; s += NGT) { const int i = s >> 6, d = s & 63; const unsigned hsh = dhash(i * 29 + 17); const int m = hsh % R, h = (hsh >> 20) & 7;
        sv[s] = bf2f(((const bf16*)(p.ws + WS_Y))[(size_t)m * 512 + h * 64 + d]); }
}
__device__ __forceinline__ void dg_p6_post(const Params& p) {
    DG_IDS(); unsigned char* ws = p.ws; unsigned char* dob = (unsigned char*)p.out; const float* sv = (const float*)(ws + WS_DSAVE + 768 * 1024); float e = 0.f;
    for (int i = gwv; i < DG_NS4; i += NGWV) {
        const unsigned hsh = dhash(i * 29 + 17); const int m = hsh % R, h = (hsh >> 20) & 7; const int pp = m % TP; const int c = h * 64 + lane;
        if (pp < 48) continue;
        const float y = sv[i * 64 + lane]; const float mean = wave_sum(y) / 64.f; const float var = wave_sum((y - mean) * (y - mean)) / 64.f;
        const float gn = (y - mean) / sqrtf(var + GN_EPS) * p.in[I_LNG][c] + p.in[I_LNB][c];
        const float v0 = bf2f(((const bf16*)(ws + WS_ZRV))[(size_t)m * 512 + c]), v1 = bf2f(((const bf16*)(ws + WS_ZRV))[(size_t)(m - 1) * 512 + c]);
        const float vs = v0 + p.in[I_MU][1024 + c] * (v1 - v0);
        const float want = (gn + ((const float*)(ws + WS_BS))[(size_t)m * 8 + h] * vs) * bf2f(((const bf16*)(dob + DO_GG))[(size_t)m * 512 + c]);
        e = fmaxf(e, relerr(bf2f(((const bf16*)(ws + WS_Y))[(size_t)m * 512 + c]), want, 0.1f));
    }
    diag_report(p, 10, e / 0.03f);
}
__device__ __forceinline__ void dg_mix(const Params& p, int stage) {
    DG_IDS(); unsigned char* ws = p.ws; float e = 0.f;
    for (int s = gt; s < 131072; s += NGT) {
        const unsigned hsh = dhash(s * 31 + 19 + stage); const int row = hsh % R, c = dhash(hsh) & 1023;
        float want = dg_dot((const bf16*)(ws + WS_FQ), row, (const bf16*)(ws + WS_WTFOX), c, 512) * bf2f(((const bf16*)(ws + WS_ZG))[(size_t)row * 2048 + c]);
        if (stage == 12) want = rbf(want) + dg_dot((const bf16*)(ws + WS_Y), row, (const bf16*)(ws + WS_WTRWKV), c, 512) * bf2f(((const bf16*)(ws + WS_ZG))[(size_t)row * 2048 + 1024 + c]);
        e = fmaxf(e, relerr(bf2f(((const bf16*)(ws + WS_MIX))[(size_t)row * 1024 + c]), want, 0.1f));
    }
    diag_report(p, stage, e / 0.03f);
}
__device__ __forceinline__ void dg_out(const Params& p) {
    DG_IDS(); unsigned char* ws = p.ws; float e = 0.f;
    for (int s = gt; s < 131072; s += NGT) {
        const unsigned hsh = dhash(s * 37 + 23); const int tok = hsh & 65535, c = dhash(hsh) & 1023; const int b = tok >> 12, t = tok & 4095;
        const float want = p.in[I_X][(size_t)tok * 1024 + c] + dg_dot((const bf16*)(ws + WS_MIX), (size_t)b * TP + 64 + t, (const bf16*)(ws + WS_WTOUT), c, 1024);
        e = fmaxf(e, relerr(p.out[(size_t)tok * 1024 + c], want, 0.3f));
    }
    diag_report(p, 13, e / 0.01f);
}
__device__ __forceinline__ void dg_norm2(const Params& p) {
    DG_IDS(); unsigned char* ws = p.ws; float e = 0.f;
    for (int s = gwv; s < 4096; s += NGWV) {
        const int m = dhash(s * 41 + 29) & 65535; const float* xr = p.out + (size_t)m * 1024;
        float ss = 0.f; for (int c = lane; c < 1024; c += 64) ss += xr[c] * xr[c];
        ss = wave_sum(ss); const float rs = 1.0f / sqrtf(ss / 1024.f + NORM_EPS);
        for (int c = lane; c < 1024; c += 64) e = fmaxf(e, relerr(bf2f(((const bf16*)(ws + WS_XN2))[(size_t)m * 1024 + c]), xr[c] * rs * p.in[I_N2G][c], 0.05f));
    }
    diag_report(p, 14, e / 0.03f);
}
__device__ __forceinline__ void dg_pq(const Params& p) {
    DG_IDS(); unsigned char* ws = p.ws; float e = 0.f;
    for (int s = gt; s < 131072; s += NGT) {
        const unsigned hsh = dhash(s * 43 + 31); const int tok = hsh & 65535, c = dhash(hsh) & 2047;
        const float want = dg_dot((const bf16*)(ws + WS_XN2), tok, (const bf16*)(ws + WS_WTQ), c, 1024);
        e = fmaxf(e, relerr(bf2f(((const bf16*)(ws + WS_PQ))[(size_t)tok * 2048 + c]), want, 0.25f));
    }
    diag_report(p, 15, e / 0.02f);
}
__device__ __forceinline__ void dg_route(const Params& p, LAS unsigned char* lds) {
    DG_IDS(); unsigned char* ws = p.ws; float e16 = 0.f, e17 = 0.f;
    LAS float* s2l = (LAS float*)lds + (tid >> 6) * 128;
    for (int i = gwv; i < 2048; i += NGWV) {
        const unsigned hsh = dhash(i * 47 + 37); const int tok = hsh & 65535, h = (hsh >> 16) & 7;
        const bf16* q = (const bf16*)(ws + WS_PQ) + (size_t)tok * 2048 + h * 256; const bf16* ks = (const bf16*)(ws + WS_KS);
        float s1a = 0.f, s1b = 0.f, s2a = 0.f, s2b = 0.f;
        for (int d = 0; d < 128; ++d) { const float q1 = bf2f(q[d]), q2 = bf2f(q[128 + d]);
            s1a += q1 * bf2f(ks[(size_t)lane * 128 + d]); s1b += q1 * bf2f(ks[(size_t)(lane + 64) * 128 + d]);
            s2a += q2 * bf2f(ks[(size_t)(128 + lane) * 128 + d]); s2b += q2 * bf2f(ks[(size_t)(192 + lane) * 128 + d]); }
        s2l[lane] = s2a; s2l[lane + 64] = s2b; asm volatile("s_waitcnt lgkmcnt(0)" ::: "memory");
        float prev_s = 3e38f; int prev_id = -1; float top_s[16]; int top_id[16];
#pragma unroll 1
        for (int r = 0; r < 16; ++r) {
            float bs = -3e38f; int bi = 0x7fffffff;
            for (int j = 0; j < 128; ++j) { const float t2 = s2l[j];
                { const float sm = s1a + t2; const int id = lane * 128 + j; const bool ok = (sm < prev_s) || (sm == prev_s && id > prev_id); if (ok && (sm > bs || (sm == bs && id < bi))) { bs = sm; bi = id; } }
                { const float sm = s1b + t2; const int id = (lane + 64) * 128 + j; const bool ok = (sm < prev_s) || (sm == prev_s && id > prev_id); if (ok && (sm > bs || (sm == bs && id < bi))) { bs = sm; bi = id; } } }
            for (int o = 1; o < 64; o <<= 1) { const float os = __shfl_xor(bs, o); const int oi = __shfl_xor(bi, o); if (os > bs || (os == bs && oi < bi)) { bs = os; bi = oi; } }
            top_s[r] = bs; top_id[r] = bi; prev_s = bs; prev_id = bi;
        }
        const int* ids = (const int*)(ws + WS_IDS) + (size_t)tok * 128 + h * 16; const float* gts = (const float*)(ws + WS_GATES) + (size_t)tok * 128 + h * 16;
        float den = 0.f;
#pragma unroll
        for (int r = 0; r < 16; ++r) den += expf(top_s[r] - top_s[0]);
        int miss = 0;
#pragma unroll
        for (int r = 0; r < 16; ++r) {
            bool found = false; for (int k = 0; k < 16; ++k) found |= (ids[k] == top_id[r]);
            if (!found && top_s[r] > top_s[15] + 2e-3f * fabsf(top_s[15]) + 1e-4f) ++miss;
            e17 = fmaxf(e17, fabsf(gts[r] - expf(top_s[r] - top_s[0]) / den));
        }
        e16 = fmaxf(e16, (float)miss);
        if (lane == 0 && miss) atomicAdd((float*)(ws + WS_DIAG) + 19, (float)miss);
    }
    diag_report(p, 16, e16 / 0.5f); diag_report(p, 17, e17 / 0.01f);
}
constexpr int DG_NS18 = 128;
__device__ __forceinline__ void dg_gather_pre(const Params& p) {
    DG_IDS(); float* sv = (float*)(p.ws + WS_DSAVE + 1280 * 1024);
    for (int s = gt; s < DG_NS18 * 1024; s += NGT) { const int i = s >> 10, c = s & 1023; const int tok = dhash(i * 53 + 41) & 65535; sv[s] = p.out[(size_t)tok * 1024 + c]; }
    for (int s = gt; s < DG_NS18 * 128; s += NGT) { const int i = s >> 7, ex = s & 127; const int tok = dhash(i * 53 + 41) & 65535; sv[DG_NS18 * 1024 + s] = ((const float*)(p.ws + WS_GATES))[(size_t)tok * 128 + ex]; }
}
__device__ __forceinline__ void dg_gather_post(const Params& p) {
    DG_IDS(); unsigned char* ws = p.ws; const float* sv = (const float*)(ws + WS_DSAVE + 1280 * 1024); float e = 0.f;
    for (int i = gwv; i < DG_NS18; i += NGWV) {
        const int tok = dhash(i * 53 + 41) & 65535;
        const int* ids = (const int*)(ws + WS_IDS) + (size_t)tok * 128; const float* gts = (const float*)(ws + WS_GATES) + (size_t)tok * 128;
        const signed char* xq = (const signed char*)(ws + WS_XQ) + (size_t)tok * 1024; const float sx = ((const float*)(ws + WS_SX))[tok];
        float o[16];
#pragma unroll
        for (int k = 0; k < 16; ++k) o[k] = 0.f;
        for (int ex = 0; ex < 128; ++ex) {
            const int id = ids[ex]; const signed char* ur = (const signed char*)(ws + WS_U8) + (size_t)id * 1024; const unsigned char* vr = ws + WS_V8 + (size_t)id * 1024;
            float d = 0.f;
#pragma unroll
            for (int k = 0; k < 16; ++k) d += (float)ur[lane * 16 + k] * (float)xq[lane * 16 + k];
            d = wave_sum(d) * ((const float*)(ws + WS_SU))[id] * sx;
            const float svs = ((const float*)(ws + WS_SV))[id];
            const float w = gts[ex];
            e = fmaxf(e, fabsf(w - sv[DG_NS18 * 1024 + i * 128 + ex] * 0.5f * d * (1.0f + erff(d * 0.70710678f)) * svs) / (0.02f * svs) * 0.05f);
#pragma unroll
            for (int k = 0; k < 16; ++k) o[k] += w * ((float)vr[lane * 16 + k] - 128.f);
        }
        float ss = 0.f;
#pragma unroll
        for (int k = 0; k < 16; ++k) ss += o[k] * o[k];
        const float rms = sqrtf(wave_sum(ss) / 1024.f);
#pragma unroll
        for (int k = 0; k < 16; ++k) e = fmaxf(e, fabsf((p.out[(size_t)tok * 1024 + lane * 16 + k] - sv[i * 1024 + lane * 16 + k]) - o[k]) / (rms + 1e-3f));
    }
    diag_report(p, 18, e / 0.05f);
}
__device__ __forceinline__ void dg_final(const Params& p) {
    DG_IDS(); const float* dg = (const float*)(p.ws + WS_DIAG);
    int k = 0;
    for (int s = 1; s <= 26; ++s) if (k == 0 && s != 19 && s != 20 && !(dg[s] <= 1.0f)) k = s;
    if (k != 9) k = (dg[9] <= 1.0f) ? 0 : 9;
#ifdef DIAG_SKIP
    { int kk = 0; for (int s = 1; s <= 26; ++s) if (kk == 0 && s > DIAG_SKIP && s != 19 && s != 20 && !(dg[s] <= 1.0f)) kk = s; k = kk; }
#endif
#ifdef DIAG_VALUE
    const float a = fminf(fmaxf(dg[DIAG_VALUE], 1e-3f), 1e6f) * 16.f;
#else
    const float a = exp2f((float)k);
#endif
    for (size_t i = gt; i < (size_t)NTOK * 1024 / 4; i += NGT) ((f32x4*)p.out)[i] = (f32x4){a, a, a, a};
}
#endif

#define XB_TMO      128
#define XB_XCNT(j)  (256  + 64 * (j))
#define XB_XSUB(j)  (1280 + 64 * (j))
#define XB_XGEN(j)  (2304 + 64 * (j))
#define XB_TOP      3328
#define XB_TOPGEN   3392
#define XCD_BAR_WORDS 3456
#if DIAG
#define XB_SPIN_CAP (1u << 28)
#else
#define XB_SPIN_CAP (1u << 18)
#endif

__device__ __forceinline__ unsigned xb_ld(unsigned* p)              { return __hip_atomic_load(p, __ATOMIC_RELAXED, __HIP_MEMORY_SCOPE_AGENT); }
__device__ __forceinline__ unsigned xb_add(unsigned* p, unsigned v) { return __hip_atomic_fetch_add(p, v, __ATOMIC_RELAXED, __HIP_MEMORY_SCOPE_AGENT); }
__device__ __forceinline__ unsigned xb_xcc_id() { return (unsigned)__builtin_amdgcn_s_getreg((3 << 11) | 20) & 0xFu; }
#define XB_SPIN(cond, bar) do { unsigned _sp = 0; while (cond) { __builtin_amdgcn_s_sleep(1); \
    if ((++_sp & 255u) == 0u) { if (xb_ld(&(bar)[XB_TMO])) break; if (_sp > XB_SPIN_CAP) { atomicAdd(&(bar)[XB_TMO], 1u); break; } } } } while (0)

struct XcdBarrier {
    unsigned* bar; unsigned x;
    volatile LAS unsigned* st;
};

__device__ __forceinline__ XcdBarrier xcd_barrier_post(unsigned* bar, volatile LAS unsigned* st) {
    XcdBarrier b; b.bar = bar; b.x = xb_xcc_id(); b.st = st;
    if (threadIdx.x == 0) (void)xb_add(&bar[XB_XCNT(b.x)], 1u);
    return b;
}
__device__ __forceinline__ void xcd_barrier_complete(unsigned* bar, unsigned x, unsigned& nloc, unsigned& nx) {
    const unsigned G = gridDim.x * gridDim.y * gridDim.z;
    unsigned sum, cnt, mine, sp = 0u;
    for (;;) {
        sum = 0u; cnt = 0u; mine = 0u;
#pragma unroll
        for (unsigned j = 0; j < 16; ++j) { const unsigned c = xb_ld(&bar[XB_XCNT(j)]); sum += c; cnt += (c > 0u) ? 1u : 0u; mine = (j == x) ? c : mine; }
        if (sum == G) break;
        __builtin_amdgcn_s_sleep(1);
        if ((++sp & 255u) == 0u) { if (xb_ld(&bar[XB_TMO])) break; if (sp > XB_SPIN_CAP) { atomicAdd(&bar[XB_TMO], 1u); break; } }
    }
    nloc = mine > 0u ? mine : 1u; nx = cnt > 0u ? cnt : 1u;
}

__device__ __forceinline__ void xcd_barrier(const XcdBarrier& b) {
    asm volatile("s_waitcnt vmcnt(0)" ::: "memory");
    __syncthreads();
    if (threadIdx.x == 0) {
        unsigned* bar = b.bar;
        __builtin_amdgcn_s_waitcnt(0);
        unsigned nloc = b.st[0], nx = b.st[1];
        if (nloc == 0u) { xcd_barrier_complete(bar, b.x, nloc, nx); b.st[0] = nloc; b.st[1] = nx; }
        const unsigned old = xb_add(&bar[XB_XSUB(b.x)], 1u);
        const unsigned gen = old / nloc;
        if (old + 1u == (gen + 1u) * nloc) {
            __builtin_amdgcn_fence(__ATOMIC_RELEASE, "agent");
            asm volatile("s_waitcnt vmcnt(0)" ::: "memory");
            const unsigned og = xb_add(&bar[XB_TOP], 1u);
            const unsigned tg = og / nx;
            if (og + 1u == (tg + 1u) * nx) xb_add(&bar[XB_TOPGEN], 1u);
            else XB_SPIN(xb_ld(&bar[XB_TOPGEN]) == tg, bar);
            __builtin_amdgcn_fence(__ATOMIC_ACQUIRE, "agent");
            xb_add(&bar[XB_XGEN(b.x)], 1u);
            asm volatile("s_waitcnt vmcnt(0)" ::: "memory");
        } else {
            XB_SPIN(xb_ld(&bar[XB_XGEN(b.x)]) == gen, bar);
            __builtin_amdgcn_fence(__ATOMIC_ACQUIRE, "agent");
            asm volatile("s_waitcnt vmcnt(0)" ::: "memory");
        }
    }
    __syncthreads();
}

#ifndef TIMING
#define TIMING 0
#endif
#if TIMING
#define TS(i) do { int t__ = threadIdx.x; asm volatile("" : "+v"(t__)); if (bid == 0 && t__ == 0) ((unsigned long long*)(ws + 1010 * MiB))[i] = __builtin_amdgcn_s_memrealtime(); } while (0)
#else
#define TS(i)
#endif
#if DIAG
#define DG(...) __VA_ARGS__
#else
#define DG(...)
#endif
constexpr int LDS_BYTES = 147456;
static_assert(attn_body::ATTN_LDS_BYTES <= 131072, "attention LDS");
static_assert(RT_KS_BYTES + NTHREADS * RT_TAB_WORDS * 4 <= LDS_BYTES, "routing LDS");
static_assert(sc2::END <= LDS_BYTES - 64, "scan LDS");

__global__ void __launch_bounds__(NTHREADS, 2) hybrid_fwd(Params p) {
    extern __shared__ __attribute__((aligned(16))) unsigned char lds_raw[];
    cg::grid_group grid = cg::this_grid();
    LAS unsigned char* lds = (LAS unsigned char*)lds_raw;
    const int G0 = gridDim.x, bid = blockIdx.x;
#define LANE_IDS() int tid = threadIdx.x; asm volatile("" : "+v"(tid)); const int lane = tid & 63, wave = __builtin_amdgcn_readfirstlane(tid >> 6); (void)lane; (void)wave; int G = G0; asm volatile("" : "+s"(G))
    const int vcu = (G0 % 8 == 0) ? (bid % 8) * (G0 / 8) + bid / 8 : bid;
    unsigned char* ws = p.ws; unsigned char* dob = (unsigned char*)p.out;

    DG({ int t_ = threadIdx.x; asm volatile("" : "+v"(t_)); if (bid == 0 && t_ < 64) ((float*)(ws + WS_DIAG))[t_] = 0.f; })
    unsigned* barw = (unsigned*)(ws + 65536);
    { int t__ = threadIdx.x; asm volatile("" : "+v"(t__)); if (bid == 0) for (int i = t__; i < XCD_BAR_WORDS + 128; i += NTHREADS) __hip_atomic_store(barw + i, 0u, __ATOMIC_RELAXED, __HIP_MEMORY_SCOPE_AGENT);
      if (t__ < 2) ((volatile LAS unsigned*)(lds + LDS_BYTES - 64))[t__] = 0u; }
    __syncthreads();
    TS(0);
    { LANE_IDS(); p0_prologue(p, lds, vcu, G, wave, lane); }
#ifdef REP_P0
    __syncthreads(); { LANE_IDS(); p0_prologue(p, lds, vcu, G, wave, lane); }
#endif
    grid.sync();
    const XcdBarrier xbar = xcd_barrier_post(barw, (volatile LAS unsigned*)(lds + LDS_BYTES - 64));
#define GSYNC() xcd_barrier(xbar)
    DG()
    TS(1);
    run_gemm_i8(lds, ws + WS_XN, ws + WS_WTIN, R, N1, 1024, G0, bid, (const float*)(ws + WS_SXN), (const float*)(ws + WS_SWIN), F_Gemm1{(bf16*)(ws + WS_F), (bf16*)(ws + WS_ZG), p.in[I_FKN], (LAS float*)(lds + pg8::STAGE_BYTES)});
#ifdef REP_GEMM1
    run_gemm_i8(lds, ws + WS_XN, ws + WS_WTIN, R, N1, 1024, G0, bid, (const float*)(ws + WS_SXN), (const float*)(ws + WS_SWIN), F_Gemm1{(bf16*)(ws + WS_F), (bf16*)(ws + WS_ZG), p.in[I_FKN], (LAS float*)(lds + pg8::STAGE_BYTES)});
#endif
    GSYNC();
    DG()
    TS(2);
    { LANE_IDS(); p2_prep1(p, vcu, G, wave, lane); }
    GSYNC();
    DG()
    TS(3);
    { LANE_IDS(); const int gwv = bid * NWAVES + wave; for (int s = gwv; s < 128; s += G * NWAVES) p3_cumsum(p, s, lane);
      LAS float* bl = (LAS float*)(lds + pg8::STAGE_BYTES);
      for (int i = tid; i < 1024; i += NTHREADS) bl[i] = (i < 512) ? p.in[I_W0][i] : p.in[I_A0][i - 512]; }
    __syncthreads();
    run_gemm(lds, (const bf16*)(ws + WS_LA), (const bf16*)(ws + WS_WTWA), R, 512, 128, G0, (bid + G0 - 16) % G0, F_LoraW{(bf16*)(dob + DO_XW), (LAS const float*)(lds + pg8::STAGE_BYTES)});
    run_gemm(lds, (const bf16*)(ws + WS_LA), (const bf16*)(ws + WS_WTWA) + 512 * 128, R, 512, 128, G0, (bid + G0 - 24) % G0, F_LoraA{(bf16*)(dob + DO_AA), (LAS const float*)(lds + pg8::STAGE_BYTES) + 512});
    run_gemm(lds, (const bf16*)(ws + WS_LG), (const bf16*)(ws + WS_WTG), R, 512, 256, G0, (bid + G0 - 32) % G0, F_Plain{(bf16*)(dob + DO_GG), 512});
#ifdef REP_LORA
    run_gemm(lds, (const bf16*)(ws + WS_LA), (const bf16*)(ws + WS_WTWA), R, 512, 128, G0, (bid + G0 - 16) % G0, F_LoraW{(bf16*)(dob + DO_XW), (LAS const float*)(lds + pg8::STAGE_BYTES)});
    run_gemm(lds, (const bf16*)(ws + WS_LA), (const bf16*)(ws + WS_WTWA) + 512 * 128, R, 512, 128, G0, (bid + G0 - 24) % G0, F_LoraA{(bf16*)(dob + DO_AA), (LAS const float*)(lds + pg8::STAGE_BYTES) + 512});
    run_gemm(lds, (const bf16*)(ws + WS_LG), (const bf16*)(ws + WS_WTG), R, 512, 256, G0, (bid + G0 - 32) % G0, F_Plain{(bf16*)(dob + DO_GG), 512});
#endif
    GSYNC();
    DG()
    TS(4);
    {
        LANE_IDS();
        for (int bh = bid; bh < 128; bh += G0) p5_scan_chunked(p, lds, bh, tid, wave, lane);
#ifdef REP_SCAN
        for (int bh = bid; bh < 128; bh += G0) p5_scan_chunked(p, lds, bh, tid, wave, lane);
#endif
        TS(6);
        volatile LAS unsigned* qslot = (volatile LAS unsigned*)(lds + LDS_BYTES - 64 + 16);
        const unsigned kbl0 = (unsigned)(uintptr_t)lds_raw + attn_body::LDS_KB;
        __syncthreads();
        if (tid == 0) *qslot = __hip_atomic_fetch_add(barw + XCD_BAR_WORDS + 64, 1u, __ATOMIC_RELAXED, __HIP_MEMORY_SCOPE_AGENT);
        __syncthreads();
        int u = __builtin_amdgcn_readfirstlane((int)*qslot);
        while (u < 2048) {
            unsigned nx = 0u;
            if (tid == 0) nx = __hip_atomic_fetch_add(barw + XCD_BAR_WORDS + 64, 1u, __ATOMIC_RELAXED, __HIP_MEMORY_SCOPE_AGENT);
            const int qb = 15 - (u >> 7), bh = u & 127;
            {
                const float* kbg = (const float*)(ws + WS_KB) + (size_t)bh * TP + 4 * lane;
                attn_body::glds16(kbg + (2 * wave) * 256, (unsigned)__builtin_amdgcn_readfirstlane(kbl0 + (2 * wave) * 1024));
                attn_body::glds16(kbg + (2 * wave + 1) * 256, (unsigned)__builtin_amdgcn_readfirstlane(kbl0 + (2 * wave + 1) * 1024));
                if (wave == 0 && lane < 16) attn_body::glds16(kbg + 16 * 256, (unsigned)__builtin_amdgcn_readfirstlane(kbl0 + 16 * 1024));
            }
            int ts;
            {   const float* kbg = (const float*)(ws + WS_KB) + (size_t)bh * TP;
                const float gqm = wave_max(fabsf(p.in[I_FQN][(bh & 7) * 64 + lane])), gkm = wave_max(fabsf(p.in[I_FKN][(bh & 7) * 64 + lane]));
                const float thr = 2.0f * (attn_body::C2 * 64.0f * 1.02f) * gqm * gkm + 40.0f;
                const int q0 = 64 + qb * 256, cand = 2 * lane;
                const float kq = kbg[q0];
                const bool ok = (cand <= 4 * qb) && (cand == 0 || kq - kbg[64 * cand - 1] > thr);
                ts = 2 * (__builtin_popcountll(__ballot(ok)) - 1);
                ts = __builtin_amdgcn_readfirstlane(ts);
            }
            attn_body::attn_unit<8>(bh >> 3, bh & 7, qb, (const attn_body::bf16*)(ws + WS_FQ), (const attn_body::bf16*)(ws + WS_FK), (const attn_body::bf16*)(ws + WS_FV), (attn_body::bf16*)(ws + WS_FQ), (char*)lds_raw, p.in[I_FQN] + (bh & 7) * 64, NORM_EPS, ts);
            if (tid == 0) *qslot = nx;
            __syncthreads();
            u = __builtin_amdgcn_readfirstlane((int)*qslot);
        }
    }
    GSYNC();
    DG(__syncthreads(); dg_scan(p, lds); __syncthreads();)
    TS(7);
    run_gemm_compact(lds, (const bf16*)(ws + WS_FQ), (const bf16*)(ws + WS_WTFOX), 1024, 512, G0, bid, F_MixA{(bf16*)(ws + WS_MIX), (const bf16*)(ws + WS_ZG)});
#ifdef REP_GEMMA
    run_gemm_compact(lds, (const bf16*)(ws + WS_FQ), (const bf16*)(ws + WS_WTFOX), 1024, 512, G0, bid, F_MixA{(bf16*)(ws + WS_MIX), (const bf16*)(ws + WS_ZG)});
#endif
    TS(9);
    DG()
    run_gemm_compact(lds, (const bf16*)(ws + WS_Y), (const bf16*)(ws + WS_WTRWKV), 1024, 512, G0, bid, F_MixB{(bf16*)(ws + WS_MIX), (const bf16*)(ws + WS_ZG)});
    GSYNC();
    DG()
    TS(10);
    run_gemm_panels(lds, (const bf16*)(ws + WS_MIX), (const bf16*)(ws + WS_WTOUT), 1024, 1024, G0, bid, F_OutC{p.in[I_X], (bf16*)(ws + WS_H1)});
#ifdef REP_OUT
    run_gemm_panels(lds, (const bf16*)(ws + WS_MIX), (const bf16*)(ws + WS_WTOUT), 1024, 1024, G0, bid, F_OutC{p.in[I_X], (bf16*)(ws + WS_H1)});
#endif
    {
        LANE_IDS();
        for (int pan = bid; pan < NTOK / 256; pan += G) for (int r = wave; r < 256; r += 8 * NWAVES) norm2_rows<8>(p, pan * 256 + r, NWAVES, lane);
    }
    TS(11); TS(12);
    GSYNC();
#ifdef PQ_BF16
    run_gemm(lds, (const bf16*)(ws + WS_XN2), (const bf16*)(ws + 1010 * MiB), NTOK, 2048, 1024, G0, bid, F_Plain{(bf16*)(ws + WS_PQ), 2048});
    GSYNC();
#else
    run_gemm_i8_panels8(lds, ws + WS_XQ, ws + WS_WTQ, 1024, G0, bid, (const float*)(ws + WS_SX), (const float*)(ws + WS_SWQ), F_Plain{(bf16*)(ws + WS_PQ), 2048});
#endif
#ifdef REP_PQ
    run_gemm_i8_panels8(lds, ws + WS_XQ, ws + WS_WTQ, 1024, G0, bid, (const float*)(ws + WS_SX), (const float*)(ws + WS_SWQ), F_Plain{(bf16*)(ws + WS_PQ), 2048});
#endif
    TS(13);
    DG()
    { LANE_IDS(); p11_route(p, lds, bid, G, tid, wave, lane); }
#ifdef REP_ROUTE
    __syncthreads(); { LANE_IDS(); p11_route(p, lds, bid, G, tid, wave, lane); }
#endif
    GSYNC();
    TS(14);
    DG()
    { LANE_IDS(); p12a_partial(p, bid, G, wave, lane); }
#ifdef REP_12A
    { LANE_IDS(); p12a_partial(p, bid, G, wave, lane); }
#endif
    GSYNC();
    { LANE_IDS(); p12b_combine(p, lds, vcu, G, tid, wave, lane); }
    GSYNC();
#ifdef REP_12C
    { LANE_IDS(); p12c_output<true>(p, bid, G, wave, lane); }
#endif
    { LANE_IDS(); p12c_output<false>(p, bid, G, wave, lane); }
    DG(GSYNC(); dg_final(p);)
#if TIMING
    GSYNC(); TS(15); GSYNC();
    {
        const unsigned long long* ts = (const unsigned long long*)(ws + 1010 * MiB);
        const float tot = (float)(ts[15] - ts[0]);
        const float fa = 10.f * (float)(ts[TIMING_A1] - ts[TIMING_A0]) / tot;
        int t__ = threadIdx.x; asm volatile("" : "+v"(t__));
        for (size_t i = (size_t)bid * NTHREADS + t__; i < (size_t)NTOK * 1024; i += (size_t)G0 * NTHREADS) p.out[i] = fa;
    }
#endif
}

extern "C" void kernel_launch(void* const* d_in, const int* in_sizes, int n_in, void* d_out, int out_size, void* d_ws, size_t ws_size, hipStream_t stream) {
    static int grid = 0;
    if (grid == 0) {
        if (n_in != 27 || out_size != NTOK * DMODEL || ws_size < WS_END) { fprintf(stderr, "kernel_launch: unexpected shapes (n_in %d, out %d, ws %zu)\n", n_in, out_size, ws_size); grid = -1; return; }
        int dev = 0, cus = 0, per_cu = 0;
        hipGetDevice(&dev);
        hipDeviceGetAttribute(&cus, hipDeviceAttributeMultiprocessorCount, dev);
        hipFuncSetAttribute((const void*)hybrid_fwd, hipFuncAttributeMaxDynamicSharedMemorySize, LDS_BYTES);
        hipOccupancyMaxActiveBlocksPerMultiprocessor(&per_cu, (const void*)hybrid_fwd, NTHREADS, LDS_BYTES);
        if (per_cu < 1) { fprintf(stderr, "kernel_launch: occupancy query says %d blocks per CU\n", per_cu); grid = -1; return; }
        grid = cus;
    }
    if (grid < 0) return;
    Params p{};
    for (int i = 0; i < 27; ++i) p.in[i] = (const float*)d_in[i];
    p.out = (float*)d_out; p.ws = (unsigned char*)d_ws;
    void* args[] = {&p};
    hipError_t e = hipLaunchCooperativeKernel((const void*)hybrid_fwd, dim3(grid), dim3(NTHREADS), args, LDS_BYTES, stream);
    if (e != hipSuccess) fprintf(stderr, "cooperative launch failed: %s (grid %d)\n", hipGetErrorString(e), grid);
}
```
